# Optimizing an MI355X kernel written in HIP

```python
import numpy as np
import jax
import jax.numpy as jnp
from jax import lax

D_MODEL = 1024
BATCH = 2
SEQ = 8192
DEPTH = 4
DEC_BATCH = 128
DEC_SEQ = 4
PAST_LEN = 2048
PAGE_SIZE = 128

N_A_LAYERS = DEPTH // 2
N_B_LAYERS = DEPTH - N_A_LAYERS
RW_HEAD_DIM = 64
RW_HEADS = D_MODEL // RW_HEAD_DIM
LORA_W = 64
LORA_A = 64
LORA_V = 32
LORA_G = 128
RW_GN_EPS = 64e-5
NSA_HEAD_DIM = 64
NSA_HEADS = D_MODEL // NSA_HEAD_DIM
NSA_GROUPS = 4
HPG = NSA_HEADS // NSA_GROUPS
CMP_LEN = 32
CMP_STRIDE = 16
CMP_HID = 128
SEL_BLOCK = 64
N_SELECT = 16
WINDOW = 512
Q_BLOCK = 128
N_KV_PARTS = 6
N_PAGED_PARTS = 4
D_FF = 2816
CONV_W = 3
NORM_EPS = 1e-6
NEG_INF = -1e30
FORCE_SCORE = 1e9
MASK_SCORE = -1e9

kernel_name = "rwkv7_yoco_nsa_convffn_step"


def rmsnorm(x, g):
    xf = x.astype(jnp.float32)
    y = xf * lax.rsqrt(jnp.mean(xf * xf, -1, keepdims=True) + NORM_EPS)
    return (y * g.astype(jnp.float32)).astype(x.dtype)


def masked_softmax(s, mask):
    s = jnp.where(mask, s.astype(jnp.float32), NEG_INF)
    e = jnp.where(mask, jnp.exp(s - jnp.max(s, -1, keepdims=True)), 0.0)
    return e / jnp.maximum(jnp.sum(e, -1, keepdims=True), 1e-30)


def to_heads(x):
    return x.reshape(x.shape[0], x.shape[1], RW_HEADS, RW_HEAD_DIM)


def conv_ffn(xn, conv_state, w_in, conv_w, conv_b, w_out):
    t_len = xn.shape[1]
    u, gate = jnp.split(xn @ w_in, 2, axis=-1)
    u_pad = jnp.concatenate([conv_state.astype(u.dtype), u], axis=1)
    uc = conv_b + conv_w[0] * u_pad[:, 0:t_len]
    for j in range(1, CONV_W):
        uc = uc + conv_w[j] * u_pad[:, j:j + t_len]
    return (jax.nn.gelu(uc) * gate) @ w_out, u_pad[:, t_len:]


def wkv7_scan(s0, r, w, k, v, a, b):
    def step(s, inp):
        r_t, w_t, k_t, v_t, a_t, b_t = inp
        sa = jnp.einsum('bhij,bhj->bhi', s, a_t)
        s = s * w_t[:, :, None, :] + sa[..., None] * b_t[:, :, None, :] + v_t[..., None] * k_t[:, :, None, :]
        return s, jnp.einsum('bhij,bhj->bhi', s, r_t)
    xs = tuple(jnp.swapaxes(t, 0, 1) for t in (r, w, k, v, a, b))
    s_final, y = lax.scan(step, s0, xs)
    return s_final, jnp.swapaxes(y, 0, 1)


def rwkv7_mix(xn, shift_prev, s0, v_first, li, p):
    bsz, t_len, _ = xn.shape
    f32 = jnp.float32
    xx = jnp.concatenate([shift_prev[:, None].astype(xn.dtype), xn[:, :-1]], axis=1) - xn
    mu = p['rw_mu'][li]
    xr, xw, xk, xv, xa, xg = (xn + xx * mu[i] for i in range(6))
    r = xr @ p['rw_w_r'][li]
    k = xk @ p['rw_w_k'][li]
    v = xv @ p['rw_w_v'][li]
    w_raw = -jax.nn.softplus(-(p['rw_w0'][li] + jnp.tanh(xw @ p['rw_w1'][li]) @ p['rw_w2'][li])) - 0.5
    decay = jnp.exp(-jnp.exp(w_raw.astype(f32)))
    a = jax.nn.sigmoid(p['rw_a0'][li] + (xa @ p['rw_a1'][li]) @ p['rw_a2'][li])
    if li == 0:
        v_first = v
    else:
        v = v + (v_first - v) * jax.nn.sigmoid(p['rw_v0'][li - 1] + (xv @ p['rw_v1'][li - 1]) @ p['rw_v2'][li - 1])
    g = jax.nn.sigmoid(xg @ p['rw_g1'][li]) @ p['rw_g2'][li]
    kk = to_heads(k * p['rw_k_k'][li]).astype(f32)
    kk = kk / jnp.maximum(jnp.sqrt(jnp.sum(kk * kk, -1, keepdims=True)), 1e-12)
    k = k * (1 + (a - 1) * p['rw_k_a'][li])
    rh, kh, vh, ah = (to_heads(t).astype(f32) for t in (r, k, v, a))
    s_new, y = wkv7_scan(s0.astype(f32), rh, to_heads(decay), kh, vh, -kk, kk * ah)
    mean = jnp.mean(y, -1, keepdims=True)
    var = jnp.mean(jnp.square(y - mean), -1, keepdims=True)
    yn = ((y - mean) * lax.rsqrt(var + RW_GN_EPS)).reshape(bsz, t_len, D_MODEL)
    yn = yn * p['rw_ln_w'][li] + p['rw_ln_b'][li]
    bonus = jnp.sum(rh * kh * p['rw_r_k'][li], -1, keepdims=True) * vh
    y = (yn + bonus.reshape(bsz, t_len, D_MODEL)).astype(xn.dtype)
    return (y * g) @ p['rw_w_o'][li], s_new.astype(s0.dtype), xn[:, -1], v_first


def kv_rows(h, p):
    bsz, t_len, _ = h.shape
    kv = (rmsnorm(h, p['kv_norm_g']) @ p['w_kv']).reshape(bsz, t_len, N_KV_PARTS, NSA_GROUPS, NSA_HEAD_DIM)
    k_sel = rmsnorm(kv[:, :, 2], p['k_norm_g'][1])
    k_win = rmsnorm(kv[:, :, 4], p['k_norm_g'][2])
    paged = jnp.stack([kv[:, :, 0], kv[:, :, 1], k_sel, kv[:, :, 3]], axis=2)
    win = jnp.stack([k_win, kv[:, :, 5]], axis=2)
    return paged, win


def compress_rows(rows, pe, w1, b1, w2, b2):
    bsz, t_len, grp, dh = rows.shape
    n_sub = t_len // CMP_STRIDE
    sub = rows[:, :n_sub * CMP_STRIDE].reshape(bsz, n_sub, CMP_STRIDE, grp, dh)
    w1 = w1.reshape(CMP_LEN, dh, CMP_HID)
    p0 = jnp.einsum('bnsgd,sdh->bngh', sub + pe[None, None, :CMP_STRIDE, None, :], w1[:CMP_STRIDE])
    p1 = jnp.einsum('bnsgd,sdh->bngh', sub + pe[None, None, CMP_STRIDE:, None, :], w1[CMP_STRIDE:])
    hid = jax.nn.gelu(p0[:, :-1] + p1[:, 1:] + b1)
    return hid @ w2 + b2


def build_context(paged, p):
    bsz, t_len = paged.shape[:2]
    ck = rmsnorm(compress_rows(paged[:, :, 0], p['cmp_pe'][0], p['cmp_w1'][0], p['cmp_b1'][0], p['cmp_w2'][0], p['cmp_b2'][0]), p['k_norm_g'][0])
    cv = compress_rows(paged[:, :, 1], p['cmp_pe'][1], p['cmp_w1'][1], p['cmp_b1'][1], p['cmp_w2'][1], p['cmp_b2'][1])
    n_cmp = ck.shape[1]
    c_end = jnp.arange(n_cmp) * CMP_STRIDE + (CMP_LEN - 1)
    n_sel_blocks = -(-t_len // SEL_BLOCK)
    sel = jnp.pad(paged[:, :, 2:4], ((0, 0), (0, n_sel_blocks * SEL_BLOCK - t_len), (0, 0), (0, 0), (0, 0)))
    sel = sel.reshape(bsz, n_sel_blocks, SEL_BLOCK, 2, NSA_GROUPS, NSA_HEAD_DIM).transpose(3, 0, 4, 1, 2, 5)
    ci = np.arange(n_cmp)[:, None] * CMP_STRIDE
    sj = np.arange(n_sel_blocks)[None, :] * SEL_BLOCK
    ov = np.clip(np.minimum(ci + CMP_LEN, sj + SEL_BLOCK) - np.maximum(ci, sj), 0, None) / CMP_STRIDE
    return (ck, cv, c_end, sel[0], sel[1], jnp.asarray(ov, jnp.float32))


def nsa_core(q, gates, q_pos, core, kw, vw, w_pos):
    ck, cv, c_end, ks_blk, vs_blk, imp_map = core
    bsz, n_q = q.shape[:2]
    s_c = jnp.einsum('bqghd,bngd->bqghn', q, ck)
    m_c = (c_end[None, :] <= q_pos[:, None])[None, :, None, None, :]
    p_c = masked_softmax(s_c, m_c)
    o_c = jnp.einsum('bqghn,bngd->bqghd', p_c.astype(cv.dtype), cv)
    imp = jnp.einsum('bqgn,ns->bqgs', jnp.sum(p_c, axis=3), imp_map)
    n_blocks = imp_map.shape[1]
    blk = jnp.arange(n_blocks)[None, :]
    qb = (q_pos // SEL_BLOCK)[:, None]
    forced = (blk == 0) | (blk == qb) | (blk == qb - 1)
    causal = blk * SEL_BLOCK <= q_pos[:, None]
    score = jnp.where(causal[None, :, None], jnp.where(forced[None, :, None], FORCE_SCORE, imp), MASK_SCORE)
    n_sel = min(N_SELECT, n_blocks)
    top_s, top_i = lax.top_k(score, n_sel)
    b_ix = jnp.arange(bsz)[:, None, None, None]
    g_ix = jnp.arange(NSA_GROUPS)[None, None, :, None]
    ks = ks_blk[b_ix, g_ix, top_i]
    vs = vs_blk[b_ix, g_ix, top_i]
    key_pos = top_i[..., None] * SEL_BLOCK + jnp.arange(SEL_BLOCK)
    m_s = (top_s > MASK_SCORE / 2)[..., None] & (key_pos <= q_pos[None, :, None, None, None])
    s_s = jnp.einsum('bqghd,bqgnkd->bqghnk', q, ks).reshape(bsz, n_q, NSA_GROUPS, HPG, n_sel * SEL_BLOCK)
    p_s = masked_softmax(s_s, m_s.reshape(bsz, n_q, NSA_GROUPS, 1, n_sel * SEL_BLOCK))
    p_s = p_s.reshape(bsz, n_q, NSA_GROUPS, HPG, n_sel, SEL_BLOCK)
    o_s = jnp.einsum('bqghnk,bqgnkd->bqghd', p_s.astype(vs.dtype), vs)
    s_w = jnp.einsum('bqghd,bkgd->bqghk', q, kw)
    dist = q_pos[:, None] - w_pos[None, :]
    m_w = ((dist >= 0) & (dist < WINDOW) & (w_pos[None, :] >= 0))[None, :, None, None, :]
    p_w = masked_softmax(s_w, m_w)
    o_w = jnp.einsum('bqghk,bkgd->bqghd', p_w.astype(vw.dtype), vw)
    return gates[..., 0:1] * o_c + gates[..., 1:2] * o_s + gates[..., 2:3] * o_w


def nsa_query(xn, lb, p):
    bsz, t_len, _ = xn.shape
    proj = xn @ p['nsa_w_q'][lb]
    q = proj[..., :NSA_HEADS * NSA_HEAD_DIM].reshape(bsz, t_len, NSA_GROUPS, HPG, NSA_HEAD_DIM)
    q = rmsnorm(q, p['q_norm_g'][lb]) * (NSA_HEAD_DIM ** -0.5)
    gates = jax.nn.sigmoid(proj[..., NSA_HEADS * NSA_HEAD_DIM:]).reshape(bsz, t_len, NSA_GROUPS, HPG, 3)
    return q, gates


def attend_prompt(q, gates, ctx):
    core, win_pad = ctx
    bsz, t_len = q.shape[:2]
    kw_pad, vw_pad = win_pad[:, :, 0], win_pad[:, :, 1]

    def chunk(c):
        start = c * Q_BLOCK
        qc = lax.dynamic_slice_in_dim(q, start, Q_BLOCK, axis=1)
        gc = lax.dynamic_slice_in_dim(gates, start, Q_BLOCK, axis=1)
        kw = lax.dynamic_slice_in_dim(kw_pad, start, WINDOW + Q_BLOCK, axis=1)
        vw = lax.dynamic_slice_in_dim(vw_pad, start, WINDOW + Q_BLOCK, axis=1)
        q_pos = start + jnp.arange(Q_BLOCK)
        w_pos = start - WINDOW + jnp.arange(WINDOW + Q_BLOCK)
        return nsa_core(qc, gc, q_pos, core, kw, vw, w_pos)

    o = lax.map(chunk, jnp.arange(t_len // Q_BLOCK))
    return jnp.moveaxis(o, 0, 1).reshape(bsz, t_len, NSA_HEADS * NSA_HEAD_DIM)


def attend_sample(q, gates, ctx):
    core, win_full = ctx
    bsz, t_new = q.shape[:2]
    n_buf = win_full.shape[1] - t_new
    q_pos = PAST_LEN + jnp.arange(t_new)
    w_pos = PAST_LEN - n_buf + jnp.arange(win_full.shape[1])
    o = nsa_core(q, gates, q_pos, core, win_full[:, :, 0], win_full[:, :, 1], w_pos)
    return o.reshape(bsz, t_new, NSA_HEADS * NSA_HEAD_DIM)


def forward(x, wkv_in, shift_in, conv_in, make_ctx, attend, p):
    wkv_out, shift_out, conv_out = [], [], []
    v_first = None
    ctx = None
    kv_state = None
    for layer in range(DEPTH):
        if layer == N_A_LAYERS:
            ctx, kv_state = make_ctx(x)
        xn = rmsnorm(x, p['norm_g'][layer, 0])
        if layer < N_A_LAYERS:
            mix, s_new, sh_new, v_first = rwkv7_mix(xn, shift_in[layer], wkv_in[layer], v_first, layer, p)
            wkv_out.append(s_new)
            shift_out.append(sh_new)
        else:
            lb = layer - N_A_LAYERS
            q, gates = nsa_query(xn, lb, p)
            mix = attend(q, gates, ctx) @ p['nsa_w_o'][lb]
        x = x + mix
        xn = rmsnorm(x, p['norm_g'][layer, 1])
        f, conv_new = conv_ffn(xn, conv_in[layer], p['ffn_w_in'][layer], p['ffn_conv_w'][layer], p['ffn_conv_b'][layer], p['ffn_w_out'][layer])
        conv_out.append(conv_new)
        x = x + f
    return x, kv_state, jnp.stack(wkv_out), jnp.stack(shift_out), jnp.stack(conv_out)


def setup_inputs(seed: int = 0) -> dict:
    key = jax.random.key(seed)
    ks = iter(jax.random.split(key, 64))
    f32 = jnp.float32

    def nrm(shape, scale):
        return jax.random.normal(next(ks), shape, f32) * scale

    def gain(shape):
        return 1.0 + nrm(shape, 0.02)

    n_pages = PAST_LEN // PAGE_SIZE
    n_used = DEC_BATCH * n_pages
    n_phys = (5 * n_used + 3) // 4
    page_table = jax.random.permutation(next(ks), n_phys)[:n_used].reshape(DEC_BATCH, n_pages).astype(jnp.int32)
    nq_cols = NSA_HEADS * NSA_HEAD_DIM + 3 * NSA_HEADS
    return {
        'x_prompt': nrm((BATCH, SEQ, D_MODEL), 1.0),
        'x_sample': nrm((DEC_BATCH, DEC_SEQ, D_MODEL), 1.0),
        'cache_kv': nrm((n_phys, PAGE_SIZE, N_PAGED_PARTS, NSA_GROUPS, NSA_HEAD_DIM), 1.0),
        'cache_kv_win': nrm((DEC_BATCH, min(WINDOW, PAST_LEN), 2, NSA_GROUPS, NSA_HEAD_DIM), 1.0),
        'state_wkv': nrm((N_A_LAYERS, DEC_BATCH, RW_HEADS, RW_HEAD_DIM, RW_HEAD_DIM), 0.1),
        'state_shift': nrm((N_A_LAYERS, DEC_BATCH, D_MODEL), 1.0),
        'state_ffn_conv': nrm((DEPTH, DEC_BATCH, CONV_W - 1, D_FF), 1.0),
        'page_table': page_table,
        'norm_g': gain((DEPTH, 2, D_MODEL)),
        'rw_mu': jax.random.uniform(next(ks), (N_A_LAYERS, 6, D_MODEL), f32),
        'rw_w_r': nrm((N_A_LAYERS, D_MODEL, D_MODEL), D_MODEL ** -0.5),
        'rw_w_k': nrm((N_A_LAYERS, D_MODEL, D_MODEL), D_MODEL ** -0.5),
        'rw_w_v': nrm((N_A_LAYERS, D_MODEL, D_MODEL), D_MODEL ** -0.5),
        'rw_w_o': nrm((N_A_LAYERS, D_MODEL, D_MODEL), D_MODEL ** -0.5),
        'rw_w0': jax.random.uniform(next(ks), (N_A_LAYERS, D_MODEL), f32, minval=-6.0, maxval=-1.0),
        'rw_w1': nrm((N_A_LAYERS, D_MODEL, LORA_W), 0.5 * D_MODEL ** -0.5),
        'rw_w2': nrm((N_A_LAYERS, LORA_W, D_MODEL), 0.5 * LORA_W ** -0.5),
        'rw_a0': nrm((N_A_LAYERS, D_MODEL), 0.1),
        'rw_a1': nrm((N_A_LAYERS, D_MODEL, LORA_A), D_MODEL ** -0.5),
        'rw_a2': nrm((N_A_LAYERS, LORA_A, D_MODEL), 0.5 * LORA_A ** -0.5),
        'rw_v0': nrm((N_A_LAYERS - 1, D_MODEL), 0.1),
        'rw_v1': nrm((N_A_LAYERS - 1, D_MODEL, LORA_V), D_MODEL ** -0.5),
        'rw_v2': nrm((N_A_LAYERS - 1, LORA_V, D_MODEL), 0.5 * LORA_V ** -0.5),
        'rw_g1': nrm((N_A_LAYERS, D_MODEL, LORA_G), D_MODEL ** -0.5),
        'rw_g2': nrm((N_A_LAYERS, LORA_G, D_MODEL), LORA_G ** -0.5),
        'rw_k_k': 0.85 + nrm((N_A_LAYERS, D_MODEL), 0.05),
        'rw_k_a': 1.0 + nrm((N_A_LAYERS, D_MODEL), 0.05),
        'rw_r_k': nrm((N_A_LAYERS, RW_HEADS, RW_HEAD_DIM), 0.1),
        'rw_ln_w': gain((N_A_LAYERS, D_MODEL)),
        'rw_ln_b': nrm((N_A_LAYERS, D_MODEL), 0.02),
        'kv_norm_g': gain((D_MODEL,)),
        'w_kv': nrm((D_MODEL, N_KV_PARTS * NSA_GROUPS * NSA_HEAD_DIM), D_MODEL ** -0.5),
        'k_norm_g': gain((3, NSA_HEAD_DIM)),
        'cmp_pe': nrm((2, CMP_LEN, NSA_HEAD_DIM), 0.1),
        'cmp_w1': nrm((2, CMP_LEN * NSA_HEAD_DIM, CMP_HID), (CMP_LEN * NSA_HEAD_DIM) ** -0.5),
        'cmp_b1': nrm((2, CMP_HID), 0.02),
        'cmp_w2': nrm((2, CMP_HID, NSA_HEAD_DIM), CMP_HID ** -0.5),
        'cmp_b2': nrm((2, NSA_HEAD_DIM), 0.02),
        'nsa_w_q': nrm((N_B_LAYERS, D_MODEL, nq_cols), D_MODEL ** -0.5),
        'q_norm_g': gain((N_B_LAYERS, NSA_HEAD_DIM)),
        'nsa_w_o': nrm((N_B_LAYERS, NSA_HEADS * NSA_HEAD_DIM, D_MODEL), D_MODEL ** -0.5),
        'ffn_w_in': nrm((DEPTH, D_MODEL, 2 * D_FF), D_MODEL ** -0.5),
        'ffn_conv_w': nrm((DEPTH, CONV_W, D_FF), CONV_W ** -0.5),
        'ffn_conv_b': nrm((DEPTH, D_FF), 0.02),
        'ffn_w_out': nrm((DEPTH, D_FF, D_MODEL), D_FF ** -0.5),
    }


def reference(x_prompt, x_sample, cache_kv, cache_kv_win, state_wkv, state_shift, state_ffn_conv, page_table,
              norm_g, rw_mu, rw_w_r, rw_w_k, rw_w_v, rw_w_o, rw_w0, rw_w1, rw_w2, rw_a0, rw_a1, rw_a2,
              rw_v0, rw_v1, rw_v2, rw_g1, rw_g2, rw_k_k, rw_k_a, rw_r_k, rw_ln_w, rw_ln_b,
              kv_norm_g, w_kv, k_norm_g, cmp_pe, cmp_w1, cmp_b1, cmp_w2, cmp_b2,
              nsa_w_q, q_norm_g, nsa_w_o, ffn_w_in, ffn_conv_w, ffn_conv_b, ffn_w_out):
    p = dict(norm_g=norm_g, rw_mu=rw_mu, rw_w_r=rw_w_r, rw_w_k=rw_w_k, rw_w_v=rw_w_v, rw_w_o=rw_w_o,
             rw_w0=rw_w0, rw_w1=rw_w1, rw_w2=rw_w2, rw_a0=rw_a0, rw_a1=rw_a1, rw_a2=rw_a2,
             rw_v0=rw_v0, rw_v1=rw_v1, rw_v2=rw_v2, rw_g1=rw_g1, rw_g2=rw_g2, rw_k_k=rw_k_k, rw_k_a=rw_k_a,
             rw_r_k=rw_r_k, rw_ln_w=rw_ln_w, rw_ln_b=rw_ln_b, kv_norm_g=kv_norm_g, w_kv=w_kv,
             k_norm_g=k_norm_g, cmp_pe=cmp_pe, cmp_w1=cmp_w1, cmp_b1=cmp_b1, cmp_w2=cmp_w2, cmp_b2=cmp_b2,
             nsa_w_q=nsa_w_q, q_norm_g=q_norm_g, nsa_w_o=nsa_w_o, ffn_w_in=ffn_w_in,
             ffn_conv_w=ffn_conv_w, ffn_conv_b=ffn_conv_b, ffn_w_out=ffn_w_out)

    dt = x_prompt.dtype
    wkv0 = jnp.zeros((N_A_LAYERS, x_prompt.shape[0], RW_HEADS, RW_HEAD_DIM, RW_HEAD_DIM), dt)
    shift0 = jnp.zeros((N_A_LAYERS, x_prompt.shape[0], D_MODEL), dt)
    conv0 = jnp.zeros((DEPTH, x_prompt.shape[0], CONV_W - 1, D_FF), dt)

    def make_ctx_prompt(h):
        paged, win = kv_rows(h, p)
        t_len = h.shape[1]
        win_pad = jnp.pad(win, ((0, 0), (WINDOW, 0), (0, 0), (0, 0), (0, 0)))
        keep = min(WINDOW, t_len)
        return (build_context(paged, p), win_pad), (paged, win[:, t_len - keep:])

    y_prompt, (kv_prompt, win_prompt), wkv_prompt, shift_prompt, conv_prompt = forward(
        x_prompt, wkv0, shift0, conv0, make_ctx_prompt, attend_prompt, p)

    n_pages = PAST_LEN // PAGE_SIZE
    past = cache_kv[page_table].reshape(page_table.shape[0], n_pages * PAGE_SIZE, N_PAGED_PARTS, NSA_GROUPS, NSA_HEAD_DIM)
    n_buf = cache_kv_win.shape[1]

    def make_ctx_sample(h):
        paged, win = kv_rows(h, p)
        full = jnp.concatenate([past.astype(paged.dtype), paged], axis=1)
        win_full = jnp.concatenate([cache_kv_win.astype(win.dtype), win], axis=1)
        return (build_context(full, p), win_full), (paged, win_full[:, win_full.shape[1] - n_buf:])

    y_sample, (kv_sample, win_sample), wkv_sample, shift_sample, conv_sample = forward(
        x_sample, state_wkv, state_shift, state_ffn_conv, make_ctx_sample, attend_sample, p)

    return (y_prompt, y_sample, kv_prompt, kv_sample, win_prompt, win_sample,
            wkv_prompt, wkv_sample, shift_prompt, shift_sample, conv_prompt, conv_sample)
```

```cpp
#include <hip/hip_runtime.h>
#include <cstdio>
#include <cstdint>

#define LAS __attribute__((address_space(3)))
#define GAS __attribute__((address_space(1)))
typedef unsigned short bf16_t;
typedef short bf16x8 __attribute__((ext_vector_type(8)));
typedef float f32x4 __attribute__((ext_vector_type(4)));
typedef float f32x16 __attribute__((ext_vector_type(16)));
typedef float f32x2 __attribute__((ext_vector_type(2)));
typedef unsigned u32x4 __attribute__((ext_vector_type(4)));
typedef unsigned u32x2 __attribute__((ext_vector_type(2)));

constexpr int D = 1024, NB = 2, TP = 8192, MP = NB * TP, SB = 128, ST = 4, MS = SB * ST, R = MP + MS;
constexpr int PAST = 2048, PAGE = 128, NPAGES = PAST / PAGE;
constexpr int H = 16, HD = 64, G = 4, HPG = 4, DFF = 2816, NLAY = 4;
constexpr int LW_ = 64, LA_ = 64, LV_ = 32, LG_ = 128, LHID = 288;
constexpr int NKV = 1536, NQ = 1072, NQP = 1280;
constexpr int NCH = TP / 64;
constexpr int NUNIT_A = NB * NCH * H;
constexpr int NCMP_P = 511, NCMP_S = 127, WIN = 512;
constexpr float NORM_EPS = 1e-6f, GN_EPS = 64e-5f;

constexpr size_t O_Y = 0;
constexpr size_t O_KV = (size_t)R * D;
constexpr size_t O_WINP = O_KV + (size_t)R * D;
constexpr size_t O_WINS = O_WINP + (size_t)NB * 512 * 512;
constexpr size_t O_WKVP = O_WINS + (size_t)SB * 512 * 512;
constexpr size_t O_WKVS = O_WKVP + (size_t)2 * NB * H * 4096;
constexpr size_t O_SHP = O_WKVS + (size_t)2 * SB * H * 4096;
constexpr size_t O_SHS = O_SHP + (size_t)2 * NB * D;
constexpr size_t O_CVP = O_SHS + (size_t)2 * SB * D;
constexpr size_t O_CVS = O_CVP + (size_t)NLAY * NB * 2 * DFF;
constexpr size_t O_END = O_CVS + (size_t)NLAY * SB * 2 * DFF;
static_assert(O_END == 88915968, "output size");

constexpr size_t MiB = 1u << 20;
constexpr size_t al(size_t x) { return (x + 4095) & ~(size_t)4095; }
constexpr size_t WS_CTL = 0, CTL_BYTES = 1 * MiB;
constexpr size_t WS_WRKV = WS_CTL + CTL_BYTES;
constexpr size_t WS_WORW = WS_WRKV + al((size_t)2 * 3072 * 1024 * 2);
constexpr size_t WS_W1T = WS_WORW + al((size_t)2 * 1024 * 1024 * 2);
constexpr size_t WS_W2W = WS_W1T + al((size_t)2 * 288 * 1024 * 2);
constexpr size_t WS_W2A = WS_W2W + al((size_t)2 * 1024 * 64 * 2);
constexpr size_t WS_W2V = WS_W2A + al((size_t)2 * 1024 * 64 * 2);
constexpr size_t WS_W2G = WS_W2V + al((size_t)1024 * 32 * 2);
constexpr size_t WS_WKVT = WS_W2G + al((size_t)2 * 1024 * 128 * 2);
constexpr size_t WS_WQT = WS_WKVT + al((size_t)1536 * 1024 * 2);
constexpr size_t WS_WONSA = WS_WQT + al((size_t)2 * 1280 * 1024 * 2);
constexpr size_t WS_WINT = WS_WONSA + al((size_t)2 * 1024 * 1024 * 2);
constexpr size_t WS_WOUTT = WS_WINT + al((size_t)4 * 5632 * 1024 * 2);
constexpr size_t WS_CW1T = WS_WOUTT + al((size_t)4 * 1024 * 2816 * 2);
constexpr size_t WS_CBIAS = WS_CW1T + al((size_t)2 * 256 * 1024 * 2);
constexpr size_t WS_CW2T = WS_CBIAS + al(2 * 128 * 4);
constexpr size_t WS_XM = WS_CW2T + al(2 * 2 * 64 * 128 * 2);
constexpr size_t WS_RK_R = WS_XM + al((size_t)6 * R * D * 2);
constexpr size_t WS_RK_K = WS_RK_R + al((size_t)R * D * 4);
constexpr size_t WS_V0 = WS_RK_K + al((size_t)R * D * 4);
constexpr size_t WS_V1 = WS_V0 + al((size_t)R * D * 4);
constexpr size_t WS_HID = WS_V1 + al((size_t)R * D * 4);
constexpr size_t WS_MT = WS_HID + al((size_t)R * LHID * 2);
constexpr size_t WS_NN = WS_MT + al((size_t)NUNIT_A * 4096 * 4);
constexpr size_t WS_RP = WS_NN + al((size_t)NUNIT_A * 4096 * 4);
constexpr size_t WS_YL = WS_RP + al((size_t)NUNIT_A * 4096 * 2);
constexpr size_t WS_S0 = WS_YL + al((size_t)NUNIT_A * 4096 * 4);
constexpr size_t WS_RKS = WS_S0 + al((size_t)NUNIT_A * 4096 * 2);
constexpr size_t WS_YG = WS_RKS + al((size_t)R * 16 * 4);
constexpr size_t WS_XN = WS_YG + al((size_t)R * D * 2);
constexpr size_t WS_XN2 = WS_XN + al((size_t)R * D * 2);
constexpr size_t WS_U = WS_XN2 + al((size_t)R * D * 2);
constexpr size_t WS_GT = WS_U + al((size_t)R * DFF * 2);
constexpr size_t WS_HH = WS_GT + al((size_t)R * DFF * 2);
constexpr size_t WS_KVF = WS_HH + al((size_t)R * DFF * 2);
constexpr size_t WS_CMPA = WS_KVF + al((size_t)R * NKV * 4);
constexpr size_t CMPA_ROWS = 4096 + 4096 + 65536 + 65536;
constexpr size_t WS_PCMP = WS_CMPA + al(CMPA_ROWS * 1024 * 2);
constexpr size_t WS_KS = WS_PCMP + al(CMPA_ROWS * 256 * 4);
constexpr size_t WS_VS = WS_KS + al((size_t)NB * G * TP * 64 * 2);
constexpr size_t WS_KW = WS_VS + al((size_t)NB * G * TP * 64 * 2);
constexpr size_t WS_VW = WS_KW + al((size_t)NB * G * TP * 64 * 2);
constexpr size_t WS_CK = WS_VW + al((size_t)NB * G * TP * 64 * 2);
constexpr size_t WS_CV = WS_CK + al((size_t)NB * G * 512 * 64 * 2);
constexpr size_t WS_CKS = WS_CV + al((size_t)NB * G * 512 * 64 * 2);
constexpr size_t WS_CVS = WS_CKS + al((size_t)SB * G * 128 * 64 * 4);
constexpr size_t WS_QF = WS_CVS + al((size_t)SB * G * 128 * 64 * 4);
constexpr size_t WS_Q = WS_QF + al((size_t)R * NQP * 4);
constexpr size_t WS_GATE = WS_Q + al((size_t)R * D * 2);
constexpr size_t WS_END = WS_GATE + al((size_t)R * 48 * 4);

typedef __bf16 bf16v2_ __attribute__((ext_vector_type(2)));
__device__ __forceinline__ unsigned cvt_pk_bf16_(float lo, float hi) { const f32x2 v = {lo, hi}; const bf16v2_ b = __builtin_convertvector(v, bf16v2_); return __builtin_bit_cast(unsigned, b); }
__device__ __forceinline__ unsigned f2bf(float f) { return cvt_pk_bf16_(f, f) & 0xffffu; }
__device__ __forceinline__ unsigned pk2(float lo, float hi) { return cvt_pk_bf16_(lo, hi); }
__device__ __forceinline__ float frcp(float x) { return __builtin_amdgcn_rcpf(x); }
__device__ __forceinline__ float frsq(float x) { return __builtin_amdgcn_rsqf(x); }
__device__ __forceinline__ float bf2f(unsigned short b) { return __builtin_bit_cast(float, ((unsigned)b) << 16); }
__device__ __forceinline__ float bflo(unsigned w) { return __builtin_bit_cast(float, w << 16); }
__device__ __forceinline__ float bfhi(unsigned w) { return __builtin_bit_cast(float, w & 0xffff0000u); }
template <int CTRL> __device__ __forceinline__ float dpp_f(float x) { return __builtin_bit_cast(float, __builtin_amdgcn_update_dpp(0, __builtin_bit_cast(int, x), CTRL, 0xF, 0xF, true)); }
__device__ __forceinline__ float row16_sum(float v) { v += dpp_f<0xB1>(v); v += dpp_f<0x4E>(v); v += dpp_f<0x141>(v); v += dpp_f<0x140>(v); return v; }
__device__ __forceinline__ float row16_max(float v) { v = fmaxf(v, dpp_f<0xB1>(v)); v = fmaxf(v, dpp_f<0x4E>(v)); v = fmaxf(v, dpp_f<0x141>(v)); v = fmaxf(v, dpp_f<0x140>(v)); return v; }
__device__ __forceinline__ float swz_xor16_n(float x) { return __builtin_bit_cast(float, __builtin_amdgcn_ds_swizzle(__builtin_bit_cast(int, x), 0x401F)); }
__device__ __forceinline__ float sum_xor32_n(float x) { auto rr = __builtin_amdgcn_permlane32_swap(__float_as_uint(x), __float_as_uint(x), false, false);
    return __uint_as_float(rr[0]) + __uint_as_float(rr[1]); }
__device__ __forceinline__ float sum_rows4_n(float x) { x += swz_xor16_n(x); return sum_xor32_n(x); }
__device__ __forceinline__ float wave_sum_n(float v) {
    v = row16_sum(v);
    v += __builtin_bit_cast(float, __builtin_amdgcn_update_dpp(0, __builtin_bit_cast(int, v), 0x142, 0xA, 0xF, false));
    v += __builtin_bit_cast(float, __builtin_amdgcn_update_dpp(0, __builtin_bit_cast(int, v), 0x143, 0xC, 0xF, false));
    return __builtin_bit_cast(float, __builtin_amdgcn_readlane(__builtin_bit_cast(int, v), 63));
}
__device__ __forceinline__ float wave_max_n(float v) {
    v = row16_max(v);
    v = fmaxf(v, __builtin_bit_cast(float, __builtin_amdgcn_update_dpp(__builtin_bit_cast(int, v), __builtin_bit_cast(int, v), 0x142, 0xA, 0xF, false)));
    v = fmaxf(v, __builtin_bit_cast(float, __builtin_amdgcn_update_dpp(__builtin_bit_cast(int, v), __builtin_bit_cast(int, v), 0x143, 0xC, 0xF, false)));
    return __builtin_bit_cast(float, __builtin_amdgcn_readlane(__builtin_bit_cast(int, v), 63));
}
#define XLANE_NEW 1
#ifdef XLANE_NEW
__device__ __forceinline__ float swz_xor16(float x) { return __builtin_bit_cast(float, __builtin_amdgcn_ds_swizzle(__builtin_bit_cast(int, x), 0x401F)); }
__device__ __forceinline__ float sum_xor32(float x) { return sum_xor32_n(x); }
__device__ __forceinline__ float sum_rows4(float x) { x += swz_xor16(x); return sum_xor32(x); }
__device__ __forceinline__ float wave_sum(float v) {
    v = row16_sum(v);
    v += __builtin_bit_cast(float, __builtin_amdgcn_update_dpp(0, __builtin_bit_cast(int, v), 0x142, 0xA, 0xF, false));
    v += __builtin_bit_cast(float, __builtin_amdgcn_update_dpp(0, __builtin_bit_cast(int, v), 0x143, 0xC, 0xF, false));
    return __builtin_bit_cast(float, __builtin_amdgcn_readlane(__builtin_bit_cast(int, v), 63));
}
__device__ __forceinline__ float wave_max(float v) {
    v = row16_max(v);
    v = fmaxf(v, __builtin_bit_cast(float, __builtin_amdgcn_update_dpp(__builtin_bit_cast(int, v), __builtin_bit_cast(int, v), 0x142, 0xA, 0xF, false)));
    v = fmaxf(v, __builtin_bit_cast(float, __builtin_amdgcn_update_dpp(__builtin_bit_cast(int, v), __builtin_bit_cast(int, v), 0x143, 0xC, 0xF, false)));
    return __builtin_bit_cast(float, __builtin_amdgcn_readlane(__builtin_bit_cast(int, v), 63));
}
#else
__device__ __forceinline__ float sum_xor32(float x) { return x + __shfl_xor(x, 32); }
__device__ __forceinline__ float sum_rows4(float x) { x += __shfl_xor(x, 16); x += __shfl_xor(x, 32); return x; }
__device__ __forceinline__ float wave_sum(float v) { v = row16_sum(v); v += __shfl_xor(v, 16); v += __shfl_xor(v, 32); return v; }
__device__ __forceinline__ float wave_max(float v) { v = row16_max(v); v = fmaxf(v, __shfl_xor(v, 16)); v = fmaxf(v, __shfl_xor(v, 32)); return v; }
#endif
__device__ __forceinline__ float sigmoidf_(float x) { return frcp(1.0f + __builtin_amdgcn_exp2f(-1.4426950408889634f * x)); }
__device__ __forceinline__ float gelu_tanh(float x) {
    const float u = 0.7978845608028654f * (x + 0.044715f * x * x * x);
    const float e = __builtin_amdgcn_exp2f(2.8853900817779268f * u);
    const float th = 1.0f - 2.0f * frcp(e + 1.0f);
    return 0.5f * x * (1.0f + th);
}
template <class T> __device__ __forceinline__ const T* launder_p(const T* q) { asm volatile("" : "+v"(q)); return q; }
__device__ __forceinline__ int launder_v(int x) { asm volatile("" : "+v"(x)); return x; }
#define LDS_WAIT() asm volatile("s_waitcnt lgkmcnt(0)" ::: "memory")
#define VM_WAIT() asm volatile("s_waitcnt vmcnt(0)" ::: "memory")
__device__ __forceinline__ f32x4 mfma16(bf16x8 a, bf16x8 b, f32x4 c) { return __builtin_amdgcn_mfma_f32_16x16x32_bf16(a, b, c, 0, 0, 0); }
__device__ __forceinline__ f32x16 mfma32(bf16x8 a, bf16x8 b, f32x16 c) { return __builtin_amdgcn_mfma_f32_32x32x16_bf16(a, b, c, 0, 0, 0); }
#define XB_TMO      128
#define XB_XCNT(j)  (256  + 64 * (j))
#define XB_XSUB(j)  (1280 + 64 * (j))
#define XB_XGEN(j)  (2304 + 64 * (j))
#define XB_TOP      3328
#define XB_TOPGEN   3392
#define XCD_BAR_WORDS 3456
#define XB_SPIN_CAP (1u << 18)

__device__ __forceinline__ unsigned xb_ld(unsigned* p)              { return __hip_atomic_load(p, __ATOMIC_RELAXED, __HIP_MEMORY_SCOPE_AGENT); }
__device__ __forceinline__ unsigned xb_add(unsigned* p, unsigned v) { return __hip_atomic_fetch_add(p, v, __ATOMIC_RELAXED, __HIP_MEMORY_SCOPE_AGENT); }
__device__ __forceinline__ unsigned xb_xcc_id() { return (unsigned)__builtin_amdgcn_s_getreg((3 << 11) | 20) & 0xFu; }
#define XB_SPIN(cond, bar) do { unsigned _sp = 0; while (cond) { __builtin_amdgcn_s_sleep(1); \
    if ((++_sp & 255u) == 0u) { if (xb_ld(&(bar)[XB_TMO])) break; if (_sp > XB_SPIN_CAP) { atomicAdd(&(bar)[XB_TMO], 1u); break; } } } } while (0)

struct XcdBarrier {
    unsigned* bar; unsigned x;
    volatile LAS unsigned* st;
};

__device__ __forceinline__ XcdBarrier xcd_barrier_post(unsigned* bar, volatile LAS unsigned* st) {
    XcdBarrier b; b.bar = bar; b.x = xb_xcc_id(); b.st = st;
    if (threadIdx.x == 0) (void)xb_add(&bar[XB_XCNT(b.x)], 1u);
    return b;
}
__device__ __forceinline__ void xcd_barrier_complete(unsigned* bar, unsigned x, unsigned& nloc, unsigned& nx) {
    const unsigned G = gridDim.x * gridDim.y * gridDim.z;
    unsigned sum, cnt, mine, sp = 0u;
    for (;;) {
        sum = 0u; cnt = 0u; mine = 0u;
#pragma unroll
        for (unsigned j = 0; j < 16; ++j) { const unsigned c = xb_ld(&bar[XB_XCNT(j)]); sum += c; cnt += (c > 0u) ? 1u : 0u; mine = (j == x) ? c : mine; }
        if (sum == G) break;
        __builtin_amdgcn_s_sleep(1);
        if ((++sp & 255u) == 0u) { if (xb_ld(&bar[XB_TMO])) break; if (sp > XB_SPIN_CAP) { atomicAdd(&bar[XB_TMO], 1u); break; } }
    }
    nloc = mine > 0u ? mine : 1u; nx = cnt > 0u ? cnt : 1u;
}

__device__ __forceinline__ void xcd_barrier(const XcdBarrier& b, const bool t0) {
    asm volatile("s_waitcnt vmcnt(0)" ::: "memory");
    __syncthreads();
    if (t0) {
        unsigned* bar = b.bar;
        __builtin_amdgcn_s_waitcnt(0);
        unsigned nloc = b.st[0], nx = b.st[1];
        if (nloc == 0u) { xcd_barrier_complete(bar, b.x, nloc, nx); b.st[0] = nloc; b.st[1] = nx; }
        const unsigned old = xb_add(&bar[XB_XSUB(b.x)], 1u);
        const unsigned gen = old / nloc;
        if (old + 1u == (gen + 1u) * nloc) {
            __builtin_amdgcn_fence(__ATOMIC_RELEASE, "agent");
            asm volatile("s_waitcnt vmcnt(0)" ::: "memory");
            const unsigned og = xb_add(&bar[XB_TOP], 1u);
            const unsigned tg = og / nx;
            if (og + 1u == (tg + 1u) * nx) xb_add(&bar[XB_TOPGEN], 1u);
            else XB_SPIN(xb_ld(&bar[XB_TOPGEN]) == tg, bar);
            __builtin_amdgcn_fence(__ATOMIC_ACQUIRE, "agent");
            xb_add(&bar[XB_XGEN(b.x)], 1u);
            asm volatile("s_waitcnt vmcnt(0)" ::: "memory");
        } else {
            XB_SPIN(xb_ld(&bar[XB_XGEN(b.x)]) == gen, bar);
            __builtin_amdgcn_fence(__ATOMIC_ACQUIRE, "agent");
            asm volatile("s_waitcnt vmcnt(0)" ::: "memory");
        }
    }
    __syncthreads();
}

namespace pg8 {
#define PG8_LAS __attribute__((address_space(3)))
constexpr int BM = 256, BK = 64, HALF = 128, HTB = HALF * BK * 2  , STAGE_BYTES = 8 * HTB, NXCD = 8, WGM = 8;
__host__ __device__ __forceinline__ int lds_byte(int r, int c) { const int st = (r >> 4) * 2 + (c >> 5), rr = r & 15, cc = c & 31, ob = rr * 64 + cc * 2; return st * 1024 + (ob ^ (((ob >> 9) & 1) << 5)); }
__host__ __device__ __forceinline__ void stage_rc(int b, int& R_, int& C_) { const int st = b / 1024, sb = b % 1024, swz = sb ^ (((sb >> 9) & 1) << 5); R_ = (st >> 1) * 16 + swz / 64; C_ = (st & 1) * 32 + (swz % 64) / 2; }
__host__ __device__ __forceinline__ int perm32(int rho) { const int n = rho >> 4, i = rho & 15; return 8 * (i >> 2) + 4 * n + (i & 3); }

struct Unit { int pm, pn, kb, nt; };
struct Gemm { const bf16_t* A; const bf16_t* Bt; int M, N, K, KL; };

struct GroupOrder {
    int pm0[4], nM[4], pn0[4], nN[4]; int nseg, nwg, G_, c;
    __device__ __forceinline__ void init(int G__, int c_) { nseg = 0; nwg = 0; G_ = G__; c = c_;
#pragma unroll
        for (int s = 0; s < 4; ++s) { pm0[s] = 0; nM[s] = 0; pn0[s] = 0; nN[s] = 1; } }
    __device__ __forceinline__ void add(int s, int pm0_, int nM_, int pn0_, int nN_) { pm0[s] = pm0_; nM[s] = nM_; pn0[s] = pn0_; nN[s] = nN_; nwg += nM_ * nN_; nseg = s + 1; }
    __device__ __forceinline__ bool next(int i, Unit& u) const {
        const long L = (long)i * G_ + c; if (L >= nwg) return false;
        int id = (int)L; { const int q = nwg / NXCD, r = nwg % NXCD, xcd = id % NXCD, off = id / NXCD; id = (xcd < r ? xcd * (q + 1) : r * (q + 1) + (xcd - r) * q) + off; }
        int spm0 = 0, snM = 1, spn0 = 0, snN = 1; bool found = false;
#pragma unroll
        for (int s = 0; s < 4; ++s) { const int cnt = nM[s] * nN[s]; if (!found) { if (id < cnt) { found = true; spm0 = pm0[s]; snM = nM[s]; spn0 = pn0[s]; snN = nN[s]; } else id -= cnt; } }
        const int nig = WGM * snN, gid = id / nig, fm = gid * WGM, gsz = (snM - fm) < WGM ? (snM - fm) : WGM;
        u.pm = spm0 + fm + ((id % nig) % gsz); u.pn = spn0 + (id % nig) / gsz; u.kb = 0; u.nt = 0; return true;
    }
    __device__ __forceinline__ void a_ready(const Unit&) const {}
    __device__ __forceinline__ void done(const Unit&) const {}
};

struct ResidOrder {
    GroupOrder P; int nS, G_, c;
    __device__ __forceinline__ void init(int G__, int c_, int nS_) { P.init(G__, c_); P.add(0, 0, nS_ ? 64 : 66, 0, 4); nS = nS_; G_ = G__; c = c_; }
    __device__ __forceinline__ bool next(int i, Unit& u) const {
        const int npc = c < P.nwg ? (P.nwg - 1 - c) / G_ + 1 : 0;
        if (i < npc) return P.next(i, u);
        const int L = (i - npc) * G_ + (G_ - 1 - c); if (L >= 8 * nS) return false;
        const int sl = L >> 3, t = L & 7; u.pm = 64 + (t & 1); u.pn = t >> 1; u.kb = sl * 512; u.nt = 4; return true; }
    __device__ __forceinline__ void a_ready(const Unit&) const {}
    __device__ __forceinline__ void done(const Unit&) const {}
};
__device__ __forceinline__ unsigned cvt_pk_bf16(float lo, float hi) { return cvt_pk_bf16_(lo, hi); }

struct EpiF32G {
    static constexpr bool PERM = false, AFTER_DRAIN = false;
    float* b0; float* b1; float* b2; float* b3; int ldc, png, pmg;
    __device__ __forceinline__ void operator()(const f32x4 (&acc)[2][2][4][2], const Unit& u, int wr, int wc, int fr, int fq) const {
        const int j = u.pn / png; float* C = j == 0 ? b0 : (j == 1 ? b1 : (j == 2 ? b2 : b3));
        const int row0 = (u.pm - j * pmg) * BM + wr * 64 + fr, col0 = (u.pn - j * png) * BM + wc * 32 + 4 * fq;
#pragma unroll
        for (int ai = 0; ai < 2; ++ai)
#pragma unroll
            for (int m = 0; m < 4; ++m) { float* rowp = C + (size_t)(row0 + ai * HALF + m * 16) * ldc + col0;
#pragma unroll
                for (int bj = 0; bj < 2; ++bj)
#pragma unroll
                    for (int n = 0; n < 2; ++n) *(f32x4*)(rowp + bj * HALF + n * 16) = acc[ai][bj][m][n]; }
    }
};
struct EpiResid {
    static constexpr bool PERM = false, AFTER_DRAIN = false;
    float* X; int ldc;
    __device__ __forceinline__ void operator()(const f32x4 (&acc)[2][2][4][2], const Unit& u, int wr, int wc, int fr, int fq) const {
        const int row0 = u.pm * BM + wr * 64 + fr, col0 = u.pn * BM + wc * 32 + 4 * fq; const bool split = u.nt != 0;
#pragma unroll
        for (int ai = 0; ai < 2; ++ai)
#pragma unroll
            for (int m = 0; m < 4; ++m) { float* rowp = X + (size_t)(row0 + ai * HALF + m * 16) * ldc + col0;
                if (!split) {
#pragma unroll
                    for (int bj = 0; bj < 2; ++bj)
#pragma unroll
                        for (int n = 0; n < 2; ++n) { f32x4* p = (f32x4*)(rowp + bj * HALF + n * 16); *p = *p + acc[ai][bj][m][n]; } }
                else {
#pragma unroll
                    for (int bj = 0; bj < 2; ++bj)
#pragma unroll
                        for (int n = 0; n < 2; ++n) { float* q = rowp + bj * HALF + n * 16;
#pragma unroll
                            for (int e = 0; e < 4; ++e) __hip_atomic_fetch_add(q + e, acc[ai][bj][m][n][e], __ATOMIC_RELAXED, __HIP_MEMORY_SCOPE_AGENT); } }
                asm volatile("" ::: "memory"); }
    }
};
struct EpiWin {
    static constexpr bool PERM = true, AFTER_DRAIN = false;
    bf16_t* U; bf16_t* GT; float* cvp; float* cvs;
    __device__ __forceinline__ void operator()(const f32x4 (&acc)[2][2][4][2], const Unit& u, int wr, int wc, int fr, int fq) const {
        const bool isu = u.pn < 11; bf16_t* base = isu ? U : GT; const int colt = (isu ? u.pn : u.pn - 11) * BM;
        const int row0 = u.pm * BM + wr * 64 + fr, col0 = colt + wc * 32 + 8 * fq;
#pragma unroll
        for (int ai = 0; ai < 2; ++ai)
#pragma unroll
            for (int m = 0; m < 4; ++m) { const int row = row0 + ai * HALF + m * 16; bf16_t* rowp = base + (size_t)row * DFF + col0;
                float* cv = nullptr;
                if (isu) { if (row >= MP) { const int t = (row - MP) & 3, b = (row - MP) >> 2; if (t >= 2) cv = cvs + (size_t)(b * 2 + (t - 2)) * DFF; }
                           else { const int tt = row & (TP - 1); if (tt >= TP - 2) cv = cvp + (size_t)((row >> 13) * 2 + (tt - (TP - 2))) * DFF; } }
#pragma unroll
                for (int bj = 0; bj < 2; ++bj) { const f32x4 v0 = acc[ai][bj][m][0], v1 = acc[ai][bj][m][1];
                    u32x4 w; w.x = cvt_pk_bf16(v0[0], v0[1]); w.y = cvt_pk_bf16(v0[2], v0[3]); w.z = cvt_pk_bf16(v1[0], v1[1]); w.w = cvt_pk_bf16(v1[2], v1[3]);
                    *(u32x4*)(rowp + bj * HALF) = w;
                    if (cv) { *(f32x4*)(cv + col0 + bj * HALF) = v0; *(f32x4*)(cv + col0 + bj * HALF + 4) = v1; } } }
    }
};
template <class Epi, class Sched, bool ALIGN_EPI = false, bool SP2 = false>
__device__ __forceinline__ void gemm_phase(PG8_LAS unsigned char* lds, const Gemm g, const Sched& S, const Epi& E, int tid_in) {
    int tid_l = tid_in; asm volatile("" : "+v"(tid_l));
    const int tid = tid_l, wid = __builtin_amdgcn_readfirstlane(tid >> 6), lane = tid & 63, wr = wid >> 2, wc = wid & 3, fr = lane & 15, fq = lane >> 4;
    const int K = g.K, nt = g.KL / BK;
    unsigned voffA[2], voffB[2];
#pragma unroll
    for (int i = 0; i < 2; ++i) { int R, C; stage_rc(tid * 16 + i * 8192, R, C); const int Rb = Epi::PERM ? ((R & ~31) + perm32(R & 31)) : R;
        voffA[i] = (unsigned)(R * K + C) * 2u; voffB[i] = (unsigned)(Rb * K + C) * 2u; }
    const size_t kstep = (size_t)(BK * 2);
    const size_t hstep = (size_t)HALF * K * 2;
    const size_t tstep = 2 * hstep;
    const unsigned ldsw = (unsigned)wid * 1024u;
    const int aoff = lds_byte(wr * 64 + fr, fq * 8), boff = lds_byte(wc * 32 + fr, fq * 8);
#define PG8_SA(b, h) (((b) * 2 + (h)) * HTB)
#define PG8_SB(b, h) ((4 + (b) * 2 + (h)) * HTB)
#define PG8_STAGE(bufoff, gbase, voff) do { _Pragma("unroll") for (int _i = 0; _i < 2; ++_i) \
        __builtin_amdgcn_global_load_lds((const unsigned*)((const char*)(gbase) + (voff)[_i]), (PG8_LAS unsigned*)(lds + (bufoff) + ldsw + _i * 8192), 16, 0, 0); } while (0)
#define PG8_LDA(dst, b, h) do { _Pragma("unroll") for (int m = 0; m < 4; ++m) _Pragma("unroll") for (int k = 0; k < 2; ++k) dst[m][k] = *(const PG8_LAS bf16x8*)(lds + PG8_SA(b, h) + aoff + m * 2048 + k * 1024); } while (0)
#define PG8_LDB(dst, b, h) do { _Pragma("unroll") for (int n = 0; n < 2; ++n) _Pragma("unroll") for (int k = 0; k < 2; ++k) dst[n][k] = *(const PG8_LAS bf16x8*)(lds + PG8_SB(b, h) + boff + n * 2048 + k * 1024); } while (0)
#define PG8_MMA(ai, bj, At, Bt) do { __builtin_amdgcn_s_setprio(1); _Pragma("unroll") for (int m = 0; m < 4; ++m) _Pragma("unroll") for (int n = 0; n < 2; ++n) _Pragma("unroll") for (int k = 0; k < 2; ++k) \
        acc[ai][bj][m][n] = __builtin_amdgcn_mfma_f32_16x16x32_bf16(Bt[n][k], At[m][k], acc[ai][bj][m][n], 0, 0, 0); __builtin_amdgcn_s_setprio(0); } while (0)
#define PG8_WAIT_V(n) asm volatile("s_waitcnt vmcnt(" #n ")" ::: "memory")
#define PG8_WAIT_L(n) asm volatile("s_waitcnt lgkmcnt(" #n ")" ::: "memory")
#define PG8_BAR __builtin_amdgcn_s_barrier()
#define PG8_SCHED __builtin_amdgcn_sched_barrier(0)
    Unit cur, nxt; int ui = 0;
    if (!S.next(0, cur)) return;
    f32x4 acc[2][2][4][2];
#pragma unroll
    for (int a = 0; a < 2; ++a)
#pragma unroll
        for (int b = 0; b < 2; ++b)
#pragma unroll
            for (int m = 0; m < 4; ++m)
#pragma unroll
                for (int n = 0; n < 2; ++n) acc[a][b][m][n] = (f32x4){0.f, 0.f, 0.f, 0.f};
    bf16x8 At[4][2], B0[2][2], B1[2][2];
    const char* cA = (const char*)g.A + (size_t)cur.pm * tstep + cur.kb; const char* cB = (const char*)g.Bt + (size_t)cur.pn * tstep + cur.kb;
    S.a_ready(cur);
    if constexpr (SP2) {
        PG8_STAGE(PG8_SB(0, 0), cB, voffB); PG8_STAGE(PG8_SB(0, 1), cB + hstep, voffB); PG8_STAGE(PG8_SA(0, 0), cA, voffA); PG8_STAGE(PG8_SA(0, 1), cA + hstep, voffA);
        if (wr == 1) PG8_BAR;
        PG8_WAIT_V(2); PG8_BAR;
        PG8_STAGE(PG8_SB(1, 0), cB + kstep, voffB); PG8_STAGE(PG8_SA(1, 0), cA + kstep, voffA); PG8_STAGE(PG8_SB(1, 1), cB + hstep + kstep, voffB);
        PG8_WAIT_V(6); PG8_BAR;
    } else {
        PG8_STAGE(PG8_SB(0, 0), cB, voffB); PG8_STAGE(PG8_SA(0, 0), cA, voffA); PG8_STAGE(PG8_SB(0, 1), cB + hstep, voffB); PG8_STAGE(PG8_SA(0, 1), cA + hstep, voffA);
        if (wr == 1) PG8_BAR;
        PG8_WAIT_V(4); PG8_BAR;
        PG8_STAGE(PG8_SB(1, 0), cB + kstep, voffB); PG8_STAGE(PG8_SA(1, 0), cA + kstep, voffA); PG8_STAGE(PG8_SB(1, 1), cB + hstep + kstep, voffB);
        PG8_WAIT_V(6); PG8_BAR;
    }
    for (;;) {
        const bool has_next = S.next(ui + 1, nxt);
        const char* nA = has_next ? (const char*)g.A + (size_t)nxt.pm * tstep + nxt.kb : cA; const char* nB = has_next ? (const char*)g.Bt + (size_t)nxt.pn * tstep + nxt.kb : cB;
        const int ntu = cur.nt ? cur.nt : nt;
        for (int t = 0; t < ntu; t += 2) {
            const bool last = (t == ntu - 2);
            const char* a1 = cA + (size_t)(t + 1) * kstep;
            const char* a2 = last ? nA : cA + (size_t)(t + 2) * kstep; const char* b2 = last ? nB : cB + (size_t)(t + 2) * kstep;
            const char* a3 = a2 + kstep; const char* b3 = b2 + kstep;
            if (last && has_next) S.a_ready(nxt);
            if constexpr (SP2) {
            PG8_LDB(B0, 0, 0); PG8_LDB(B1, 0, 1); PG8_SCHED; PG8_LDA(At, 0, 0); PG8_STAGE(PG8_SA(1, 1), a1 + hstep, voffA);
            PG8_WAIT_V(8); PG8_WAIT_L(0); PG8_BAR; PG8_MMA(0, 0, At, B0); PG8_MMA(0, 1, At, B1); PG8_BAR; PG8_SCHED;
            PG8_LDA(At, 0, 1); PG8_STAGE(PG8_SB(0, 0), b2, voffB); PG8_STAGE(PG8_SB(0, 1), b2 + hstep, voffB); PG8_STAGE(PG8_SA(0, 0), a2, voffA);
            PG8_WAIT_V(8); PG8_WAIT_L(0); PG8_BAR; PG8_MMA(1, 0, At, B0); PG8_MMA(1, 1, At, B1); PG8_BAR; PG8_SCHED;
            PG8_LDB(B0, 1, 0); PG8_LDB(B1, 1, 1); PG8_SCHED; PG8_LDA(At, 1, 0); PG8_STAGE(PG8_SA(0, 1), a2 + hstep, voffA);
            PG8_WAIT_V(8); PG8_WAIT_L(0); PG8_BAR; PG8_MMA(0, 0, At, B0); PG8_MMA(0, 1, At, B1); PG8_BAR; PG8_SCHED;
            PG8_LDA(At, 1, 1); PG8_STAGE(PG8_SB(1, 0), b3, voffB); PG8_STAGE(PG8_SB(1, 1), b3 + hstep, voffB); PG8_STAGE(PG8_SA(1, 0), a3, voffA);
            PG8_WAIT_V(8); PG8_WAIT_L(0); PG8_BAR; PG8_MMA(1, 0, At, B0); PG8_MMA(1, 1, At, B1); PG8_BAR; PG8_SCHED;
            } else {
            PG8_LDB(B0, 0, 0); PG8_SCHED; PG8_LDA(At, 0, 0); PG8_STAGE(PG8_SA(1, 1), a1 + hstep, voffA);
            PG8_WAIT_L(8); PG8_BAR; PG8_WAIT_L(0); PG8_MMA(0, 0, At, B0); PG8_BAR; PG8_SCHED;
            PG8_LDB(B1, 0, 1); PG8_STAGE(PG8_SB(0, 0), b2, voffB);
            PG8_BAR; PG8_WAIT_L(0); PG8_MMA(0, 1, At, B1); PG8_BAR;
            PG8_LDA(At, 0, 1); PG8_STAGE(PG8_SA(0, 0), a2, voffA);
            PG8_BAR; PG8_WAIT_L(0); PG8_MMA(1, 0, At, B0); PG8_BAR; PG8_SCHED;
            PG8_STAGE(PG8_SB(0, 1), b2 + hstep, voffB);
            PG8_WAIT_V(6); PG8_BAR; PG8_MMA(1, 1, At, B1); PG8_BAR;
            PG8_LDB(B0, 1, 0); PG8_SCHED; PG8_LDA(At, 1, 0); PG8_STAGE(PG8_SA(0, 1), a2 + hstep, voffA);
            PG8_WAIT_L(8); PG8_BAR; PG8_WAIT_L(0); PG8_MMA(0, 0, At, B0); PG8_BAR; PG8_SCHED;
            PG8_LDB(B1, 1, 1); PG8_STAGE(PG8_SB(1, 0), b3, voffB);
            PG8_BAR; PG8_WAIT_L(0); PG8_MMA(0, 1, At, B1); PG8_BAR;
            PG8_LDA(At, 1, 1); PG8_STAGE(PG8_SA(1, 0), a3, voffA);
            PG8_BAR; PG8_WAIT_L(0); PG8_MMA(1, 0, At, B0); PG8_BAR; PG8_SCHED;
            PG8_STAGE(PG8_SB(1, 1), b3 + hstep, voffB);
            PG8_WAIT_V(6); PG8_BAR; PG8_MMA(1, 1, At, B1); PG8_BAR;
            }
        }
        if constexpr (ALIGN_EPI) { if (wr == 0) PG8_BAR; }
        if constexpr (!Epi::AFTER_DRAIN) { E(acc, cur, wr, wc, fr, fq); S.done(cur); }
        if (!has_next) break;
#pragma unroll
        for (int a = 0; a < 2; ++a)
#pragma unroll
            for (int b = 0; b < 2; ++b)
#pragma unroll
                for (int m = 0; m < 4; ++m)
#pragma unroll
                    for (int n = 0; n < 2; ++n) acc[a][b][m][n] = (f32x4){0.f, 0.f, 0.f, 0.f};
        cur = nxt; cA = nA; cB = nB; ++ui;
        if constexpr (ALIGN_EPI) { if (wr == 1) PG8_BAR; }
    }
    PG8_WAIT_V(0);
    if constexpr (!ALIGN_EPI) { if (wr == 0) PG8_BAR; }
    PG8_BAR;
    if constexpr (Epi::AFTER_DRAIN) { E.fused(acc, cur, wr, wc, fr, fq, lds, wid, lane); S.done(cur); }
#undef PG8_SA
#undef PG8_SB
#undef PG8_STAGE
#undef PG8_LDA
#undef PG8_LDB
#undef PG8_MMA
#undef PG8_WAIT_V
#undef PG8_WAIT_L
#undef PG8_BAR
#undef PG8_SCHED
}
}
constexpr int RING_BYTES = 131072, MISC_OFF = RING_BYTES + 320, LDS_BYTES = 147456;
struct Params { const float* in[45]; float* out; unsigned char* ws; int ph_lo, ph_hi, use_bar, pad; };
enum { I_XP = 0, I_XS, I_CKV, I_CWIN, I_SWKV, I_SSHIFT, I_SCONV, I_PT, I_NORMG, I_MU, I_WR, I_WK, I_WV, I_WO, I_W0, I_W1, I_W2, I_A0, I_A1, I_A2, I_V0, I_V1, I_V2, I_G1, I_G2,
       I_KK, I_KA, I_RKK, I_LNW, I_LNB, I_KVNG, I_WKV, I_KNG, I_PE, I_CW1, I_CB1, I_CW2, I_CB2, I_WQ, I_QNG, I_WONSA, I_WIN, I_CONVW, I_CONVB, I_WOUT };

typedef const __attribute__((address_space(4))) Params* KP;
struct Ctx { LAS unsigned char* lds; int tid, lane, wave, gw, ngw, gtid, gsz; };

__device__ __forceinline__ void p0_transpose_item(const float* W, int K, int ldw, int nblk, bf16_t* WT, int row_off, LAS float* scr, int item, int lane) {
    const int kb = item / nblk, nb = item % nblk, k0 = 64 * kb, n0 = 32 * nb;
#pragma unroll 8
    for (int i = 0; i < 32; ++i) { const int kk = 2 * i + (lane >> 5); scr[kk * 33 + (lane & 31)] = W[(size_t)(k0 + kk) * ldw + n0 + (lane & 31)]; }
    LDS_WAIT(); asm volatile("" ::: "memory");
    const int c = lane & 7;
#pragma unroll
    for (int j = 0; j < 4; ++j) { const int n = (lane >> 3) + 8 * j; const LAS float* s = scr + (8 * c) * 33 + n;
        u32x4 o; o.x = pk2(s[0 * 33], s[1 * 33]); o.y = pk2(s[2 * 33], s[3 * 33]); o.z = pk2(s[4 * 33], s[5 * 33]); o.w = pk2(s[6 * 33], s[7 * 33]);
        *(u32x4*)(WT + (size_t)(row_off + n0 + n) * K + k0 + 8 * c) = o; }
    LDS_WAIT(); asm volatile("" ::: "memory");
}

__device__ __forceinline__ void phase_prologue(KP p, const Ctx& c) {
    LAS float* scr = (LAS float*)(c.lds + c.wave * 16384);
    unsigned char* ws = p->ws;
    int total = 0;
#define TRCNT(K_, N_) (((K_) / 64) * ((N_) / 32))
    constexpr int C_DD = TRCNT(1024, 1024), C_L64 = TRCNT(1024, 64), C_L32 = TRCNT(1024, 32), C_L128 = TRCNT(1024, 128), C_2_64 = TRCNT(64, 1024), C_2_128 = TRCNT(128, 1024);
    constexpr int C_KV = TRCNT(1024, 1536), C_Q = 16 * 33, C_IN = TRCNT(1024, 5632), C_OUT = TRCNT(2816, 1024), C_CW = TRCNT(1024, 128);
    constexpr int NITEMS = 2 * (4 * C_DD + 2 * C_L64 + C_L128 + 2 * C_2_64 + C_2_128) + C_L32 + C_KV + 2 * C_Q + 2 * C_DD + 4 * C_IN + 4 * C_OUT + 4 * C_CW;
    (void)total;
    for (int it = c.gw; it < NITEMS; it += c.ngw) {
        int r = it;
#define TR(Wp, K_, LDW_, NBLK_, WTp, ROWOFF_) { const int cnt_ = ((K_) / 64) * (NBLK_); if (r < cnt_) { p0_transpose_item((Wp), (K_), (LDW_), (NBLK_), (bf16_t*)(WTp), (ROWOFF_), scr, r, c.lane); continue; } r -= cnt_; }
        bool done = false;
#pragma unroll
        for (int l = 0; l < 2; ++l) {
            if (done) break;
            const size_t dd = (size_t)l * 1024 * 1024;
#define TRL(Wp, K_, LDW_, NBLK_, WTp, ROWOFF_) { const int cnt_ = ((K_) / 64) * (NBLK_); if (!done) { if (r < cnt_) { p0_transpose_item((Wp), (K_), (LDW_), (NBLK_), (bf16_t*)(WTp), (ROWOFF_), scr, r, c.lane); done = true; } else r -= cnt_; } }
            TRL(p->in[I_WR] + dd, 1024, 1024, 32, ws + WS_WRKV + (size_t)l * 3072 * 1024 * 2, 0)
            TRL(p->in[I_WK] + dd, 1024, 1024, 32, ws + WS_WRKV + (size_t)l * 3072 * 1024 * 2, 1024)
            TRL(p->in[I_WV] + dd, 1024, 1024, 32, ws + WS_WRKV + (size_t)l * 3072 * 1024 * 2, 2048)
            TRL(p->in[I_WO] + dd, 1024, 1024, 32, ws + WS_WORW + (size_t)l * 1024 * 1024 * 2, 0)
            TRL(p->in[I_W1] + (size_t)l * 1024 * 64, 1024, 64, 2, ws + WS_W1T + (size_t)l * 288 * 1024 * 2, 0)
            TRL(p->in[I_A1] + (size_t)l * 1024 * 64, 1024, 64, 2, ws + WS_W1T + (size_t)l * 288 * 1024 * 2, 64)
            TRL(p->in[I_G1] + (size_t)l * 1024 * 128, 1024, 128, 4, ws + WS_W1T + (size_t)l * 288 * 1024 * 2, 160)
            TRL(p->in[I_W2] + (size_t)l * 64 * 1024, 64, 1024, 32, ws + WS_W2W + (size_t)l * 1024 * 64 * 2, 0)
            TRL(p->in[I_A2] + (size_t)l * 64 * 1024, 64, 1024, 32, ws + WS_W2A + (size_t)l * 1024 * 64 * 2, 0)
            TRL(p->in[I_G2] + (size_t)l * 128 * 1024, 128, 1024, 32, ws + WS_W2G + (size_t)l * 1024 * 128 * 2, 0)
        }
        if (done) continue;
        TR(p->in[I_V1], 1024, 32, 1, ws + WS_W1T + (size_t)1 * 288 * 1024 * 2, 128)
        TR(p->in[I_WKV], 1024, 1536, 48, ws + WS_WKVT, 0)
        TR(p->in[I_WQ], 1024, NQ, 33, ws + WS_WQT, 0)
        TR(p->in[I_WQ] + (size_t)1024 * NQ, 1024, NQ, 33, ws + WS_WQT + (size_t)NQP * 1024 * 2, 0)
        TR(p->in[I_WONSA], 1024, 1024, 32, ws + WS_WONSA, 0)
        TR(p->in[I_WONSA] + (size_t)1024 * 1024, 1024, 1024, 32, ws + WS_WONSA + (size_t)1024 * 1024 * 2, 0)
#pragma unroll
        for (int l = 0; l < 4; ++l) {
            if (done) break;
            TRL(p->in[I_WIN] + (size_t)l * 1024 * 5632, 1024, 5632, 176, ws + WS_WINT + (size_t)l * 5632 * 1024 * 2, 0)
            TRL(p->in[I_WOUT] + (size_t)l * 2816 * 1024, 2816, 1024, 32, ws + WS_WOUTT + (size_t)l * 1024 * 2816 * 2, 0)
        }
        if (done) continue;
        TR(p->in[I_CW1], 1024, 128, 4, ws + WS_CW1T, 0)
        TR(p->in[I_CW1] + (size_t)1024 * 128, 1024, 128, 4, ws + WS_CW1T, 128)
        TR(p->in[I_CW1] + (size_t)2048 * 128, 1024, 128, 4, ws + WS_CW1T + (size_t)256 * 1024 * 2, 0)
        TR(p->in[I_CW1] + (size_t)3072 * 128, 1024, 128, 4, ws + WS_CW1T + (size_t)256 * 1024 * 2, 128)
#undef TR
#undef TRL
    }
    {
        bf16_t* WQT = (bf16_t*)(ws + WS_WQT);
        for (int e = c.gtid; e < 2 * 224 * 1024; e += c.gsz) { const int k = e & 1023, n = 1056 + ((e >> 10) % 224), l = e / (224 * 1024);
            WQT[((size_t)l * NQP + n) * 1024 + k] = n < NQ ? (bf16_t)f2bf(p->in[I_WQ][((size_t)l * 1024 + k) * NQ + n]) : (bf16_t)0; }
        bf16_t* W2V = (bf16_t*)(ws + WS_W2V);
        for (int e = c.gtid; e < 32 * 1024; e += c.gsz) { const int n = e & 1023, k = e >> 10; W2V[n * 32 + k] = (bf16_t)f2bf(p->in[I_V2][k * 1024 + n]); }
    }
    { bf16_t* W2T = (bf16_t*)(ws + WS_CW2T);
      for (int e = c.gtid; e < 2 * 128 * 64; e += c.gsz) { const int d = e & 63, q = (e >> 6) & 127, kv = e >> 13; const float w = p->in[I_CW2][e];
          const unsigned hi = f2bf(w), lo = f2bf(w - __builtin_bit_cast(float, hi << 16)); W2T[(size_t)(kv * 64 + d) * 128 + q] = (bf16_t)hi; W2T[(size_t)2 * 64 * 128 + (size_t)(kv * 64 + d) * 128 + q] = (bf16_t)lo; } }
    for (int it = c.gw; it < 256; it += c.ngw) { const int kv = it >> 7, h = it & 127; float s = 0.f;
        for (int kk = c.lane; kk < 2048; kk += 64) s += p->in[I_PE][kv * 2048 + kk] * p->in[I_CW1][((size_t)kv * 2048 + kk) * 128 + h];
        s = wave_sum(s); if (c.lane == 0) ((float*)(ws + WS_CBIAS))[it] = s + p->in[I_CB1][it]; }
    { const f32x4* xp = (const f32x4*)p->in[I_XP]; const f32x4* xs = (const f32x4*)p->in[I_XS]; f32x4* o = (f32x4*)(p->out + O_Y);
      for (int e = c.gtid; e < R * D / 4; e += c.gsz) o[e] = e < MP * D / 4 ? xp[e] : xs[e - MP * D / 4]; }
}

__device__ __forceinline__ void phase_fill(KP p, const Ctx& c, int li) {
    if (c.wave == 0) return;
    unsigned char* ws = p->ws; const int gwf = blockIdx.x * 7 + (c.wave - 1), ngwf = gridDim.x * 7;
    { const int* pt = (const int*)p->in[I_PT]; bf16_t* CA = (bf16_t*)(ws + WS_CMPA); const int part = li;
      for (int it = gwf; it < SB * 128 * 4; it += ngwf) { const int s4 = 4 * (it & 3), n = (it >> 2) & 127, b = it >> 9;
          const int page = pt[b * NPAGES + (n >> 3)]; const float* src = p->in[I_CKV] + ((size_t)page * PAGE + (n & 7) * 16 + s4) * 1024 + part * 256;
          f32x4 v[4];
#pragma unroll
          for (int e = 0; e < 4; ++e) v[e] = __builtin_nontemporal_load(((const f32x4*)(src + (size_t)e * 1024)) + c.lane);
          const int g = c.lane >> 4, d0 = 4 * (c.lane & 15); bf16_t* dst = CA + ((size_t)8192 + (size_t)part * 65536 + (size_t)(b * 4 + g) * 128 + n) * 1024 + s4 * 64 + d0;
#pragma unroll
          for (int e = 0; e < 4; ++e) { u32x2 w; w.x = pk2(v[e][0], v[e][1]); w.y = pk2(v[e][2], v[e][3]); *(u32x2*)(dst + e * 64) = w; } } }
    { const f32x4* src = (const f32x4*)p->in[I_CWIN]; f32x4* dst = (f32x4*)(p->out + O_WINS); constexpr int HALF_N = SB * 508 * 128 / 2;
      for (int e0 = li * HALF_N + gwf * 256 + c.lane; e0 < (li + 1) * HALF_N; e0 += ngwf * 256) { f32x4 v[4];
#pragma unroll
          for (int q = 0; q < 4; ++q) { const int e = e0 + 64 * q; if (e < (li + 1) * HALF_N) { const int b = e / (508 * 128), rr = e % (508 * 128); v[q] = __builtin_nontemporal_load(src + (size_t)b * 512 * 128 + 4 * 128 + rr); } }
#pragma unroll
          for (int q = 0; q < 4; ++q) { const int e = e0 + 64 * q; if (e < (li + 1) * HALF_N) { const int b = e / (508 * 128), rr = e % (508 * 128); __builtin_nontemporal_store(v[q], dst + (size_t)b * 512 * 128 + rr); } } } }
}

template <int NT> __device__ __forceinline__ void skinny_mma(const bf16_t* A, int lda, const bf16_t* Wt, int ldw, int K, int row0, int col0, int lane, f32x4 (&acc)[NT][2]) {
    const int fr = lane & 15, fq = lane >> 4;
#pragma unroll
    for (int nt = 0; nt < NT; ++nt) { acc[nt][0] = (f32x4){0.f, 0.f, 0.f, 0.f}; acc[nt][1] = (f32x4){0.f, 0.f, 0.f, 0.f}; }
    const bf16_t* xa = A + (size_t)(row0 + fr) * lda + 8 * fq; const bf16_t* xb = xa + (size_t)16 * lda;
    const bf16_t* wa = Wt + (size_t)(col0 + fr) * ldw + 8 * fq;
    const char* pa = (const char*)xa; const char* pb = (const char*)xb; const char* pw[NT];
#pragma unroll
    for (int nt = 0; nt < NT; ++nt) pw[nt] = (const char*)(wa + (size_t)nt * 16 * ldw);
    for (int k4 = 0; k4 < K / 128; ++k4) {
        bf16x8 fb[4][2], fa[4][NT];
#pragma unroll
        for (int u = 0; u < 4; ++u) { fb[u][0] = *(const bf16x8*)(pa + 64 * u); fb[u][1] = *(const bf16x8*)(pb + 64 * u);
#pragma unroll
            for (int nt = 0; nt < NT; ++nt) fa[u][nt] = *(const bf16x8*)(pw[nt] + 64 * u); }
        __builtin_amdgcn_sched_barrier(0);
#pragma unroll
        for (int u = 0; u < 4; ++u)
#pragma unroll
            for (int nt = 0; nt < NT; ++nt) { acc[nt][0] = mfma16(fa[u][nt], fb[u][0], acc[nt][0]); acc[nt][1] = mfma16(fa[u][nt], fb[u][1], acc[nt][1]); }
        pa += 256; pb += 256;
#pragma unroll
        for (int nt = 0; nt < NT; ++nt) pw[nt] += 256;
        __builtin_amdgcn_sched_barrier(0);
    }
}
__device__ __forceinline__ void skinny_resid_sample(const Ctx& c, const bf16_t* A, int lda, const bf16_t* Wt, int K, float* X) {
    const int ln = launder_v(c.lane), fr = ln & 15, fq = ln >> 4;
    for (int it = blockIdx.x + gridDim.x * c.wave; it < 256; it += c.ngw) { const int row0 = MP + 32 * (it & 15), col0 = 64 * (it >> 4);
        f32x4 acc[4][2]; skinny_mma<4>(A, lda, Wt, lda, K, row0, col0, c.lane, acc);
#pragma unroll
        for (int nt = 0; nt < 4; ++nt)
#pragma unroll
            for (int mt = 0; mt < 2; ++mt) { f32x4* q = (f32x4*)(X + (size_t)(row0 + 16 * mt + fr) * D + col0 + 16 * nt + 4 * fq); *q = *q + acc[nt][mt]; } }
}
__device__ __forceinline__ void skinny_store(const Ctx& c, const bf16_t* A, const bf16_t* Wt, int K, float* C, int ldc, int rbase, int nrb, int ncb, int it0, int nit_total) {
    const int fr = c.lane & 15, fq = c.lane >> 4;
    for (int it = c.gw - it0; it < nrb * ncb; it += c.ngw) { if (it < 0) continue; const int row0 = rbase + 32 * (it % nrb), col0 = 64 * (it / nrb);
        f32x4 acc[4][2]; skinny_mma<4>(A, K, Wt, K, K, row0, col0, c.lane, acc);
#pragma unroll
        for (int nt = 0; nt < 4; ++nt)
#pragma unroll
            for (int mt = 0; mt < 2; ++mt) *(f32x4*)(C + (size_t)(row0 + 16 * mt + fr) * ldc + col0 + 16 * nt + 4 * fq) = acc[nt][mt]; }
    (void)nit_total;
}

__device__ __forceinline__ void load_row(const float* p, int lane, f32x4 (&v)[4]) {
#pragma unroll
    for (int j = 0; j < 4; ++j) v[j] = ((const f32x4*)p)[lane + 64 * j];
}
__device__ __forceinline__ float row_rstd(const f32x4 (&v)[4]) {
    float s = 0.f;
#pragma unroll
    for (int j = 0; j < 4; ++j) s += (v[j][0] * v[j][0] + v[j][1] * v[j][1]) + (v[j][2] * v[j][2] + v[j][3] * v[j][3]);
    s = wave_sum(s); return frsq(s * (1.0f / D) + NORM_EPS);
}
__device__ __forceinline__ void store_row_bf16(bf16_t* o, int lane, const f32x4 (&v)[4]) {
#pragma unroll
    for (int j = 0; j < 4; ++j) { u32x2 w; w.x = pk2(v[j][0], v[j][1]); w.y = pk2(v[j][2], v[j][3]); ((u32x2*)o)[lane + 64 * j] = w; }
}

__device__ __forceinline__ void phase_norm(const Ctx& c, const float* X, const float* g1, bf16_t* o1, const float* g2, bf16_t* o2) {
    f32x4 ga[4], gb[4]; load_row(g1, c.lane, ga); if (g2) load_row(g2, c.lane, gb);
    for (int row = c.gw; row < R; row += c.ngw) {
        f32x4 v[4]; load_row(X + (size_t)row * D, c.lane, v); const float rs = row_rstd(v);
        f32x4 y[4];
#pragma unroll
        for (int j = 0; j < 4; ++j) y[j] = v[j] * rs * ga[j];
        store_row_bf16(o1 + (size_t)row * D, c.lane, y);
        if (g2) {
#pragma unroll
            for (int j = 0; j < 4; ++j) y[j] = v[j] * rs * gb[j];
            store_row_bf16(o2 + (size_t)row * D, c.lane, y); }
    }
}

__device__ __forceinline__ void phase_mix(KP p, const Ctx& c, int li) {
    const float* X = p->out + O_Y; const float* gain = p->in[I_NORMG] + (size_t)(li * 2) * D; const float* mu = p->in[I_MU] + (size_t)li * 6 * D;
    bf16_t* XM = (bf16_t*)(p->ws + WS_XM);
    f32x4 ga[4]; load_row(gain, c.lane, ga);
    {
        const int r0 = (int)(((long)c.gw * R) / c.ngw), r1 = (int)(((long)(c.gw + 1) * R) / c.ngw); f32x4 prev[4];
        {
            const bool seq_start = r0 < MP ? ((r0 & (TP - 1)) == 0) : (((r0 - MP) & 3) == 0);
            if (!seq_start && r0 < r1) { f32x4 v[4]; load_row(X + (size_t)(r0 - 1) * D, c.lane, v); const float rs = row_rstd(v);
#pragma unroll
                for (int j = 0; j < 4; ++j) prev[j] = v[j] * rs * ga[j]; }
        }
        for (int row = r0; row < r1; ++row) {
            const bool seq_start = row < MP ? ((row & (TP - 1)) == 0) : (((row - MP) & 3) == 0);
            if (seq_start) {
                if (row < MP) {
#pragma unroll
                    for (int j = 0; j < 4; ++j) prev[j] = (f32x4){0.f, 0.f, 0.f, 0.f}; }
                else load_row(p->in[I_SSHIFT] + ((size_t)li * SB + ((row - MP) >> 2)) * D, c.lane, prev);
            }
            f32x4 v[4]; load_row(X + (size_t)row * D, c.lane, v); const float rs = row_rstd(v);
            f32x4 xn[4];
#pragma unroll
            for (int j = 0; j < 4; ++j) xn[j] = v[j] * rs * ga[j];
#pragma unroll
            for (int m = 0; m < 6; ++m) {
                f32x4 y[4];
#pragma unroll
                for (int j = 0; j < 4; ++j) { const int mi = m == 1 ? 2 : (m == 2 ? 3 : (m == 3 ? 1 : m));
                    const f32x4 mm = ((const f32x4*)(mu + (size_t)mi * D))[c.lane + 64 * j]; y[j] = xn[j] + (prev[j] - xn[j]) * mm; }
                store_row_bf16(XM + ((size_t)m * R + row) * D, c.lane, y);
            }
            const bool seq_end = row < MP ? ((row & (TP - 1)) == TP - 1) : (((row - MP) & 3) == 3);
            if (seq_end) { float* so = row < MP ? p->out + O_SHP + ((size_t)li * NB + (row >> 13)) * D : p->out + O_SHS + ((size_t)li * SB + ((row - MP) >> 2)) * D;
#pragma unroll
                for (int j = 0; j < 4; ++j) ((f32x4*)so)[c.lane + 64 * j] = xn[j]; }
#pragma unroll
            for (int j = 0; j < 4; ++j) prev[j] = xn[j];
        }
    }
}
template <int NT, int ACT> __device__ __forceinline__ void lora1_item(const bf16_t* X, const bf16_t* W, bf16_t* HID, int coloff, int rb, int lane) {
    lane = launder_v(lane);
    const int fr = lane & 15, fq = lane >> 4;
    f32x4 acc[NT][2]; skinny_mma<NT>(X, 1024, W, 1024, 1024, rb * 32, coloff, lane, acc);
#pragma unroll
    for (int nt = 0; nt < NT; ++nt)
#pragma unroll
        for (int mt = 0; mt < 2; ++mt) { f32x4 v = acc[nt][mt];
#pragma unroll
            for (int r = 0; r < 4; ++r) { if (ACT == 1) { const float e = __builtin_amdgcn_exp2f(2.8853900817779268f * v[r]); v[r] = 1.0f - 2.0f * frcp(e + 1.0f); } if (ACT == 2) v[r] = sigmoidf_(v[r]); }
            u32x2 w; w.x = pk2(v[0], v[1]); w.y = pk2(v[2], v[3]);
            *(u32x2*)(HID + (size_t)(rb * 32 + mt * 16 + fr) * LHID + coloff + nt * 16 + 4 * fq) = w; }
}
__device__ __forceinline__ void phase_lora1(KP p, const Ctx& c, int li) {
    const bf16_t* XM = (const bf16_t*)(p->ws + WS_XM); const bf16_t* W = (const bf16_t*)(p->ws + WS_W1T) + (size_t)li * 288 * 1024; bf16_t* HID = (bf16_t*)(p->ws + WS_HID);
    constexpr int NRB = R / 32;
    for (int it = blockIdx.x + gridDim.x * c.wave; it < 5 * NRB; it += c.ngw) { const int q = it / NRB, rb = it % NRB;
        if (q == 0) lora1_item<4, 1>(XM + (size_t)3 * R * D, W, HID, 0, rb, c.lane);
        else if (q == 1) lora1_item<4, 0>(XM + (size_t)4 * R * D, W, HID, 64, rb, c.lane);
        else if (q == 2) { if (li == 1) lora1_item<2, 0>(XM + (size_t)2 * R * D, W, HID, 128, rb, c.lane); }
        else if (q == 3) lora1_item<4, 2>(XM + (size_t)5 * R * D, W, HID, 160, rb, c.lane);
        else lora1_item<4, 2>(XM + (size_t)5 * R * D, W, HID, 224, rb, c.lane);
    }
}

constexpr int SST = 72, MAT = 64 * SST * 2;
constexpr int O_AT = 0, O_BT = MAT, O_KT = 2 * MAT, O_RT = 3 * MAT, O_VT = 4 * MAT, O_BH = 5 * MAT, O_KH = 6 * MAT, O_XT = 7 * MAT, O_AAB = 9 * MAT, O_AAK = 10 * MAT, O_ARB = 11 * MAT, O_ARK = 12 * MAT;
constexpr int O_TD = 13 * MAT, O_SCR = O_TD + 2048, O_CS = O_SCR + 4096, O_WC = O_CS + 2048, O_LW = O_XT, O_LA = O_XT + 16384, O_LV = O_XT + 32768;
static_assert(O_WC + 256 <= RING_BYTES && O_LV + 16384 <= O_TD, "scan LDS map");
__device__ __forceinline__ bf16x8 ldsfrag(LAS unsigned char* lds, int off, int row, int col) { return *(const LAS bf16x8*)(lds + off + (row * SST + col) * 2); }
__device__ __forceinline__ void lds_st4(LAS unsigned char* lds, int off, int row, int col, f32x4 v) { u32x2 w; w.x = pk2(v[0], v[1]); w.y = pk2(v[2], v[3]); *(LAS u32x2*)(lds + off + (row * SST + col) * 2) = w; }
__device__ __forceinline__ f32x4 lds_ld4(LAS unsigned char* lds, int off, int row, int col) { const u32x2 w = *(const LAS u32x2*)(lds + off + (row * SST + col) * 2); return (f32x4){bflo(w.x), bfhi(w.x), bflo(w.y), bfhi(w.y)}; }

__device__ __forceinline__ void scanA_unit(KP p, const Ctx& c, int li, int u) {
    LAS unsigned char* lds = c.lds; unsigned char* ws = p->ws; const int stop = p->pad;
    const int lane = c.lane, wave = c.wave, fr = lane & 15, fq = lane >> 4;
    const int b = u / (NCH * H), n = (u / H) % NCH, h = u % H, row0 = b * TP + 64 * n;
    const float* Rb = (const float*)(ws + WS_RK_R); const float* Kb = (const float*)(ws + WS_RK_K);
    float* Vb = (float*)(ws + (li ? WS_V1 : WS_V0)); const float* V0b = (const float*)(ws + WS_V0);
    const bf16_t* HID = (const bf16_t*)(ws + WS_HID);
    {
        const int tt = wave & 3, chh = wave >> 2;
        const bf16_t* hrow = launder_p(HID + (size_t)(row0 + 16 * tt + fr) * LHID + 8 * fq);
        const bf16_t* W2W = (const bf16_t*)(ws + WS_W2W) + (size_t)li * 1024 * 64; const bf16_t* W2A = (const bf16_t*)(ws + WS_W2A) + (size_t)li * 1024 * 64; const bf16_t* W2V = (const bf16_t*)(ws + WS_W2V);
#pragma unroll
        for (int cti = 0; cti < 2; ++cti) { const int ct = 2 * chh + cti, C = 64 * h + 16 * ct + fr;
            f32x4 aw = {0.f, 0.f, 0.f, 0.f}, aa = {0.f, 0.f, 0.f, 0.f}, av = {0.f, 0.f, 0.f, 0.f};
#pragma unroll
            for (int ks = 0; ks < 2; ++ks) {
                aw = mfma16(*(const bf16x8*)(W2W + (size_t)C * 64 + 32 * ks + 8 * fq), *(const bf16x8*)(hrow + 32 * ks), aw);
                aa = mfma16(*(const bf16x8*)(W2A + (size_t)C * 64 + 32 * ks + 8 * fq), *(const bf16x8*)(hrow + 64 + 32 * ks), aa); }
            if (li) av = mfma16(*(const bf16x8*)(W2V + (size_t)C * 32 + 8 * fq), *(const bf16x8*)(hrow + 128), av);
            const int t = 16 * tt + fr, cc = 16 * ct + 4 * fq;
            *(LAS f32x4*)(lds + O_LW + (t * 64 + cc) * 4) = aw; *(LAS f32x4*)(lds + O_LA + (t * 64 + cc) * 4) = aa; *(LAS f32x4*)(lds + O_LV + (t * 64 + cc) * 4) = av; }
    }
    __syncthreads();
    if (stop == 1) return;
    {
        const int cc = lane, tq = wave, C = 64 * h + cc; const size_t pc = (size_t)li * D + C;
        const float w0 = p->in[I_W0][pc], a0 = p->in[I_A0][pc], kkc = p->in[I_KK][pc], kac = p->in[I_KA][pc], rkc = p->in[I_RKK][pc], v0 = li ? p->in[I_V0][C] : 0.f;
        float wlg[8], Lin[8], rr[8], k2[8], vv[8], aa[8], bb[8]; float run = 0.f;
#pragma unroll
        for (int e = 0; e < 8; ++e) { const int t = 8 * tq + e; const size_t gi = (size_t)(row0 + t) * D + C;
            const float r = Rb[gi], k = Kb[gi]; float v = Vb[gi];
            const float lw = *(const LAS float*)(lds + O_LW + (t * 64 + cc) * 4), la = *(const LAS float*)(lds + O_LA + (t * 64 + cc) * 4);
            const float z = -(w0 + lw); const float sp = fmaxf(z, 0.f) + __logf(1.0f + __expf(-fabsf(z))); const float wl = -__expf(-sp - 0.5f);
            const float asig = sigmoidf_(a0 + la);
            if (li) { const float lv = *(const LAS float*)(lds + O_LV + (t * 64 + cc) * 4); const float vg = sigmoidf_(v0 + lv); const float vf = V0b[gi]; v = v + (vf - v) * vg; Vb[gi] = v; }
            const float kkr = k * kkc; const float ss = wave_sum(kkr * kkr); const float kkn = kkr * frsq(fmaxf(ss, 1e-24f));
            const float kmod = k * (1.0f + (asig - 1.0f) * kac);
            const float rks = wave_sum(r * kmod * rkc); if (cc == 0) ((float*)(ws + WS_RKS))[(size_t)(row0 + t) * 16 + h] = rks;
            run += wl; wlg[e] = wl; Lin[e] = run; rr[e] = r; k2[e] = kmod; vv[e] = v; aa[e] = -kkn; bb[e] = kkn * asig; }
        *(LAS float*)(lds + O_CS + (tq * 64 + cc) * 4) = run;
        __syncthreads();
        float off = 0.f, tot = 0.f;
#pragma unroll
        for (int q = 0; q < 8; ++q) { const float x = *(const LAS float*)(lds + O_CS + (q * 64 + cc) * 4); tot += x; if (q < tq) off += x; }
        u32x4 wa, wv, wb, wk; unsigned pa[8], pv[8], pb[8], pk[8];
#pragma unroll
        for (int e = 0; e < 8; ++e) { const int t = 8 * tq + e; const float L = off + Lin[e], Lp = L - wlg[e];
            const float eL = __expf(L), eLp = __expf(Lp), enL = __expf(-L), eT = __expf(tot - L);
            const float at = aa[e] * eLp, bt = bb[e] * enL, kt = k2[e] * enL, rt = rr[e] * eL, bh = bb[e] * eT, kh = k2[e] * eT;
            *(LAS bf16_t*)(lds + O_AT + (t * SST + cc) * 2) = (bf16_t)f2bf(at); *(LAS bf16_t*)(lds + O_BT + (t * SST + cc) * 2) = (bf16_t)f2bf(bt);
            *(LAS bf16_t*)(lds + O_KT + (t * SST + cc) * 2) = (bf16_t)f2bf(kt); *(LAS bf16_t*)(lds + O_RT + (t * SST + cc) * 2) = (bf16_t)f2bf(rt);
            pa[e] = f2bf(at); pv[e] = f2bf(vv[e]); pb[e] = f2bf(bh); pk[e] = f2bf(kh); }
        wa = (u32x4){pa[0] | (pa[1] << 16), pa[2] | (pa[3] << 16), pa[4] | (pa[5] << 16), pa[6] | (pa[7] << 16)};
        wv = (u32x4){pv[0] | (pv[1] << 16), pv[2] | (pv[3] << 16), pv[4] | (pv[5] << 16), pv[6] | (pv[7] << 16)};
        wb = (u32x4){pb[0] | (pb[1] << 16), pb[2] | (pb[3] << 16), pb[4] | (pb[5] << 16), pb[6] | (pb[7] << 16)};
        wk = (u32x4){pk[0] | (pk[1] << 16), pk[2] | (pk[3] << 16), pk[4] | (pk[5] << 16), pk[6] | (pk[7] << 16)};
        *(LAS u32x4*)(lds + O_XT + (cc * SST + 8 * tq) * 2) = wa; *(LAS u32x4*)(lds + O_VT + (cc * SST + 8 * tq) * 2) = wv;
        *(LAS u32x4*)(lds + O_BH + (cc * SST + 8 * tq) * 2) = wb; *(LAS u32x4*)(lds + O_KH + (cc * SST + 8 * tq) * 2) = wk;
        if (tq == 0) *(LAS float*)(lds + O_WC + cc * 4) = __expf(tot);
    }
    __syncthreads();
    if (stop == 2) return;
    {
        const int mi = wave >> 1, ph = wave & 1; const int oY = (mi & 1) ? O_KT : O_BT, oX = (mi < 2) ? O_AT : O_RT; const bool strict = mi < 2;
        const int oO = mi == 0 ? O_AAB : (mi == 1 ? O_AAK : (mi == 2 ? O_ARB : O_ARK));
#pragma unroll
        for (int sti = 0; sti < 2; ++sti) { const int st = 2 * ph + sti;
#pragma unroll
            for (int tt = 0; tt < 4; ++tt) { f32x4 acc = {0.f, 0.f, 0.f, 0.f};
                if (st <= tt) {
#pragma unroll
                    for (int ks = 0; ks < 2; ++ks) acc = mfma16(ldsfrag(lds, oY, 16 * st + fr, 32 * ks + 8 * fq), ldsfrag(lds, oX, 16 * tt + fr, 32 * ks + 8 * fq), acc);
                    const int t = 16 * tt + fr;
#pragma unroll
                    for (int r = 0; r < 4; ++r) { const int s = 16 * st + 4 * fq + r; const bool keep = strict ? (s < t) : (s <= t); acc[r] = keep ? acc[r] : 0.f; } }
                if (st <= tt) lds_st4(lds, oO, 16 * tt + fr, 16 * st + 4 * fq, acc);
                else { u32x2 zz; int z0 = 0; asm volatile("" : "+v"(z0)); zz.x = (unsigned)z0; zz.y = (unsigned)z0; *(LAS u32x2*)(lds + oO + ((16 * tt + fr) * SST + 16 * st + 4 * fq) * 2) = zz; } } }
    }
    __syncthreads();
    if (stop == 3) return;
    {
        const int tt = wave & 3, ih = wave >> 2;
#pragma unroll
        for (int iti = 0; iti < 2; ++iti) { const int it = 2 * ih + iti; f32x4 acc = {0.f, 0.f, 0.f, 0.f};
#pragma unroll
            for (int ks = 0; ks < 2; ++ks) acc = mfma16(ldsfrag(lds, O_AAK, 16 * tt + fr, 32 * ks + 8 * fq), ldsfrag(lds, O_VT, 16 * it + fr, 32 * ks + 8 * fq), acc);
            lds_st4(lds, O_XT, 64 + 16 * it + fr, 16 * tt + 4 * fq, acc); }
        if (wave < 4 && lane < 16) { const int I = wave; float x[16];
#pragma unroll
            for (int t = 0; t < 16; ++t) { float s = (t == lane) ? 1.0f : 0.0f;
#pragma unroll
                for (int q = 0; q < t; ++q) s += bf2f(*(const LAS bf16_t*)(lds + O_AAB + ((16 * I + t) * SST + 16 * I + q) * 2)) * x[q];
                x[t] = s; *(LAS bf16_t*)(lds + O_TD + ((I * 16 + t) * 16 + lane) * 2) = (bf16_t)f2bf(s); } }
    }
    __syncthreads();
    if (stop == 5) return;
    {
        const int colb = 16 * wave; const bf16x8 zero8 = {0, 0, 0, 0, 0, 0, 0, 0};
#pragma unroll
        for (int I = 0; I < 4; ++I) {
            f32x4 acc = lds_ld4(lds, O_XT, colb + fr, 16 * I + 4 * fq);
#pragma unroll
            for (int ks = 0; ks < 2; ++ks) if (32 * ks < 16 * I) { const bool ok = (32 * ks + 8 * fq) < 16 * I;
                const bf16x8 a = ok ? ldsfrag(lds, O_AAB, 16 * I + fr, 32 * ks + 8 * fq) : zero8, bq = ok ? ldsfrag(lds, O_XT, colb + fr, 32 * ks + 8 * fq) : zero8;
                acc = mfma16(a, bq, acc); }
            { u32x2 w; w.x = pk2(acc[0], acc[1]); w.y = pk2(acc[2], acc[3]); *(LAS u32x2*)(lds + O_SCR + wave * 512 + (fr * 16 + 4 * fq) * 2) = w; }
            LDS_WAIT();
            const bf16x8 ta = fq < 2 ? *(const LAS bf16x8*)(lds + O_TD + ((I * 16 + fr) * 16 + 8 * fq) * 2) : zero8;
            const bf16x8 tb = fq < 2 ? *(const LAS bf16x8*)(lds + O_SCR + wave * 512 + (fr * 16 + 8 * fq) * 2) : zero8;
            const f32x4 res = mfma16(ta, tb, (f32x4){0.f, 0.f, 0.f, 0.f});
            lds_st4(lds, O_XT, colb + fr, 16 * I + 4 * fq, res);
            LDS_WAIT();
        }
    }
    __syncthreads();
    if (stop == 6) return;
    {
        const int tb = wave & 3, hb = wave >> 2;
        bf16_t* RP = (bf16_t*)(ws + WS_RP) + (size_t)u * 4096; float* YL = (float*)(ws + WS_YL) + (size_t)u * 4096;
        bf16_t* MTH = (bf16_t*)(ws + WS_MT) + (size_t)u * 4096; bf16_t* MTL = MTH + (size_t)NUNIT_A * 4096; float* NN = (float*)(ws + WS_NN) + (size_t)u * 4096;
#pragma unroll
        for (int qi = 0; qi < 2; ++qi) { const int rt = 2 * hb + qi;
            { f32x4 acc = lds_ld4(lds, O_RT, 16 * tb + fr, 16 * rt + 4 * fq);
#pragma unroll
              for (int ks = 0; ks < 2; ++ks) acc = mfma16(ldsfrag(lds, O_XT, 16 * rt + fr, 32 * ks + 8 * fq), ldsfrag(lds, O_ARB, 16 * tb + fr, 32 * ks + 8 * fq), acc);
              u32x2 w; w.x = pk2(acc[0], acc[1]); w.y = pk2(acc[2], acc[3]); *(u32x2*)(RP + (size_t)(16 * tb + fr) * 64 + 16 * rt + 4 * fq) = w; }
            { f32x4 acc = {0.f, 0.f, 0.f, 0.f};
#pragma unroll
              for (int ks = 0; ks < 2; ++ks) { acc = mfma16(ldsfrag(lds, O_XT, 64 + 16 * rt + fr, 32 * ks + 8 * fq), ldsfrag(lds, O_ARB, 16 * tb + fr, 32 * ks + 8 * fq), acc);
                  acc = mfma16(ldsfrag(lds, O_VT, 16 * rt + fr, 32 * ks + 8 * fq), ldsfrag(lds, O_ARK, 16 * tb + fr, 32 * ks + 8 * fq), acc); }
              *(f32x4*)(YL + (size_t)(16 * tb + fr) * 64 + 16 * rt + 4 * fq) = acc; }
            { f32x4 acc = {0.f, 0.f, 0.f, 0.f};
#pragma unroll
              for (int ks = 0; ks < 2; ++ks) acc = mfma16(ldsfrag(lds, O_XT, 16 * rt + fr, 32 * ks + 8 * fq), ldsfrag(lds, O_BH, 16 * tb + fr, 32 * ks + 8 * fq), acc);
              const int j = 16 * tb + fr; const float wc = *(const LAS float*)(lds + O_WC + j * 4);
#pragma unroll
              for (int r = 0; r < 4; ++r) if (16 * rt + 4 * fq + r == j) acc[r] += wc;
              unsigned hh[4], ll[4];
#pragma unroll
              for (int r = 0; r < 4; ++r) { hh[r] = f2bf(acc[r]); ll[r] = f2bf(acc[r] - __builtin_bit_cast(float, hh[r] << 16)); }
              *(u32x2*)(MTH + (size_t)j * 64 + 16 * rt + 4 * fq) = (u32x2){hh[0] | (hh[1] << 16), hh[2] | (hh[3] << 16)};
              *(u32x2*)(MTL + (size_t)j * 64 + 16 * rt + 4 * fq) = (u32x2){ll[0] | (ll[1] << 16), ll[2] | (ll[3] << 16)}; }
            { f32x4 acc = {0.f, 0.f, 0.f, 0.f};
#pragma unroll
              for (int ks = 0; ks < 2; ++ks) { acc = mfma16(ldsfrag(lds, O_BH, 16 * rt + fr, 32 * ks + 8 * fq), ldsfrag(lds, O_XT, 64 + 16 * tb + fr, 32 * ks + 8 * fq), acc);
                  acc = mfma16(ldsfrag(lds, O_KH, 16 * rt + fr, 32 * ks + 8 * fq), ldsfrag(lds, O_VT, 16 * tb + fr, 32 * ks + 8 * fq), acc); }
              *(f32x4*)(NN + (size_t)(16 * tb + fr) * 64 + 16 * rt + 4 * fq) = acc; }
        }
    }
    __syncthreads();
}

__device__ __forceinline__ void scan_sample_item(KP p, const Ctx& c, int li, int item) {
    unsigned char* ws = p->ws; const int lane = c.lane, b = item >> 4, h = item & 15, C = 64 * h + lane; const size_t pc = (size_t)li * D + C;
    LAS float* sc = (LAS float*)(c.lds + c.wave * 16384);
    const float* Rb = (const float*)(ws + WS_RK_R); const float* Kb = (const float*)(ws + WS_RK_K);
    float* Vb = (float*)(ws + (li ? WS_V1 : WS_V0)); const float* V0b = (const float*)(ws + WS_V0);
    const bf16_t* HID = (const bf16_t*)(ws + WS_HID) + (size_t)(MP + 4 * b) * LHID;
    for (int e = lane; e < 4 * LHID; e += 64) sc[e] = bf2f(HID[e]);
    LDS_WAIT();
    float lw[4] = {0.f, 0.f, 0.f, 0.f}, la[4] = {0.f, 0.f, 0.f, 0.f}, lv[4] = {0.f, 0.f, 0.f, 0.f}, lg[4] = {0.f, 0.f, 0.f, 0.f};
    {
        const bf16_t* W2W = (const bf16_t*)(ws + WS_W2W) + ((size_t)li * 1024 + C) * 64; const bf16_t* W2A = (const bf16_t*)(ws + WS_W2A) + ((size_t)li * 1024 + C) * 64;
        const bf16_t* W2V = (const bf16_t*)(ws + WS_W2V) + (size_t)C * 32; const bf16_t* W2G = (const bf16_t*)(ws + WS_W2G) + ((size_t)li * 1024 + C) * 128;
#define LORA2_BLK(WP, QB, HOFF, ACC) { const u32x4 w8 = *(const u32x4*)((WP) + 8 * (QB)); \
            const float wf0 = bflo(w8.x), wf1 = bfhi(w8.x), wf2 = bflo(w8.y), wf3 = bfhi(w8.y), wf4 = bflo(w8.z), wf5 = bfhi(w8.z), wf6 = bflo(w8.w), wf7 = bfhi(w8.w); \
            _Pragma("unroll") for (int t = 0; t < 4; ++t) { const f32x4 h0 = *(const LAS f32x4*)(sc + t * LHID + (HOFF) + 8 * (QB)), h1 = *(const LAS f32x4*)(sc + t * LHID + (HOFF) + 8 * (QB) + 4); \
                ACC[t] += (h0[0] * wf0 + h0[1] * wf1) + (h0[2] * wf2 + h0[3] * wf3) + (h1[0] * wf4 + h1[1] * wf5) + (h1[2] * wf6 + h1[3] * wf7); } \
            asm volatile("" : "+v"(ACC[0]), "+v"(ACC[1]), "+v"(ACC[2]), "+v"(ACC[3]) :: "memory"); }
#pragma unroll
        for (int qb = 0; qb < 8; ++qb) { LORA2_BLK(W2W, qb, 0, lw) LORA2_BLK(W2A, qb, 64, la) }
        if (li) {
#pragma unroll
            for (int qb = 0; qb < 4; ++qb) LORA2_BLK(W2V, qb, 128, lv) }
#pragma unroll
        for (int qb = 0; qb < 16; ++qb) LORA2_BLK(W2G, qb, 160, lg)
#undef LORA2_BLK
    }
    const float w0 = p->in[I_W0][pc], a0 = p->in[I_A0][pc], kkc = p->in[I_KK][pc], kac = p->in[I_KA][pc], rkc = p->in[I_RKK][pc], v0 = li ? p->in[I_V0][C] : 0.f;
    const float lnw = p->in[I_LNW][pc], lnb = p->in[I_LNB][pc];
    float S[64];
    { const f32x4* sp = (const f32x4*)(p->in[I_SWKV] + (((size_t)li * SB + b) * H + h) * 4096 + lane * 64);
#pragma unroll
      for (int q = 0; q < 16; ++q) { const f32x4 x = sp[q]; S[4 * q] = x[0]; S[4 * q + 1] = x[1]; S[4 * q + 2] = x[2]; S[4 * q + 3] = x[3]; } }
    LAS float* bc = sc + 1280;
    bf16_t* YG = (bf16_t*)(ws + WS_YG);
#pragma unroll
    for (int t = 0; t < 4; ++t) { const size_t gi = (size_t)(MP + 4 * b + t) * D + C;
        const float r = Rb[gi], k = Kb[gi]; float v = Vb[gi];
        const float z = -(w0 + lw[t]); const float sp = fmaxf(z, 0.f) + __logf(1.0f + __expf(-fabsf(z))); const float wdec = __expf(-__expf(-sp - 0.5f));
        const float asig = sigmoidf_(a0 + la[t]);
        if (li) { const float vg = sigmoidf_(v0 + lv[t]); const float vf = V0b[gi]; v = v + (vf - v) * vg; }
        const float kkr = k * kkc; const float ss = wave_sum(kkr * kkr); const float kkn = kkr * frsq(fmaxf(ss, 1e-24f));
        const float kmod = k * (1.0f + (asig - 1.0f) * kac);
        const float rks = wave_sum(r * kmod * rkc);
        LDS_WAIT();
        bc[lane] = wdec; bc[64 + lane] = -kkn; bc[128 + lane] = kkn * asig; bc[192 + lane] = kmod; bc[256 + lane] = r;
        LDS_WAIT();
        float sa = 0.f;
#pragma unroll
        for (int q = 0; q < 16; ++q) { const f32x4 av = *(const LAS f32x4*)(bc + 64 + 4 * q); sa += S[4 * q] * av[0] + S[4 * q + 1] * av[1] + S[4 * q + 2] * av[2] + S[4 * q + 3] * av[3]; }
        float y = 0.f;
#pragma unroll
        for (int q = 0; q < 16; ++q) { const f32x4 wv = *(const LAS f32x4*)(bc + 4 * q), bv = *(const LAS f32x4*)(bc + 128 + 4 * q), kv = *(const LAS f32x4*)(bc + 192 + 4 * q), rv = *(const LAS f32x4*)(bc + 256 + 4 * q);
#pragma unroll
            for (int e = 0; e < 4; ++e) { const float s = S[4 * q + e] * wv[e] + sa * bv[e] + v * kv[e]; S[4 * q + e] = s; y += s * rv[e]; } }
        const float mean = wave_sum(y) * (1.0f / 64.0f); const float dy = y - mean; const float var = wave_sum(dy * dy) * (1.0f / 64.0f);
        const float yn = dy * (frsq(var + GN_EPS)) * lnw + lnb;
        YG[gi] = (bf16_t)f2bf((yn + rks * v) * lg[t]);
    }
    { f32x4* so = (f32x4*)(p->out + O_WKVS + (((size_t)li * SB + b) * H + h) * 4096 + lane * 64);
#pragma unroll
      for (int q = 0; q < 16; ++q) so[q] = (f32x4){S[4 * q], S[4 * q + 1], S[4 * q + 2], S[4 * q + 3]}; }
    LDS_WAIT();
}

__device__ __forceinline__ void phase_scanA(KP p, const Ctx& c, int li) {
    const int stop = p->pad;
    if (stop != 9) for (int u = blockIdx.x; u < NUNIT_A; u += gridDim.x) scanA_unit(p, c, li, u);
    if (stop == 0 || stop == 9) for (int it = c.gw; it < SB * H; it += c.ngw) scan_sample_item(p, c, li, it);
}

__device__ __forceinline__ void hilo(const f32x4 x0, const f32x4 x1, bf16x8& hi, bf16x8& lo) {
    unsigned h[8], l[8];
#pragma unroll
    for (int e = 0; e < 8; ++e) { const float x = e < 4 ? x0[e] : x1[e - 4]; h[e] = f2bf(x); l[e] = f2bf(x - __builtin_bit_cast(float, h[e] << 16)); }
    u32x4 hv = {h[0] | (h[1] << 16), h[2] | (h[3] << 16), h[4] | (h[5] << 16), h[6] | (h[7] << 16)}, lv = {l[0] | (l[1] << 16), l[2] | (l[3] << 16), l[4] | (l[5] << 16), l[6] | (l[7] << 16)};
    hi = __builtin_bit_cast(bf16x8, hv); lo = __builtin_bit_cast(bf16x8, lv);
}
__device__ __forceinline__ void phase_scanB(KP p, const Ctx& c, int li) {
    if (c.wave != 0) return;
    unsigned char* ws = p->ws; LAS unsigned char* lds = c.lds; const int lane = c.lane, fr = lane & 15, fq = lane >> 4;
    for (int ch = blockIdx.x; ch < 128; ch += gridDim.x) {
        const int b = ch >> 6, h = (ch >> 2) & 15, iq = ch & 3;
        f32x4 S[4];
#pragma unroll
        for (int jt = 0; jt < 4; ++jt) S[jt] = (f32x4){0.f, 0.f, 0.f, 0.f};
        bf16x8 ah[4][2], al[4][2]; f32x4 nn[4];
        { const size_t u = (size_t)(b * NCH) * H + h; const bf16_t* MTH = (const bf16_t*)(ws + WS_MT) + u * 4096; const bf16_t* MTL = MTH + (size_t)NUNIT_A * 4096; const float* NN = (const float*)(ws + WS_NN) + u * 4096;
#pragma unroll
          for (int jt = 0; jt < 4; ++jt) { nn[jt] = *(const f32x4*)(NN + (size_t)(16 * iq + fr) * 64 + 16 * jt + 4 * fq);
#pragma unroll
              for (int ks = 0; ks < 2; ++ks) { ah[jt][ks] = *(const bf16x8*)(MTH + (size_t)(16 * jt + fr) * 64 + 32 * ks + 8 * fq); al[jt][ks] = *(const bf16x8*)(MTL + (size_t)(16 * jt + fr) * 64 + 32 * ks + 8 * fq); } } }
        for (int n = 0; n < NCH; ++n) {
            const size_t u = (size_t)(b * NCH + n) * H + h; bf16_t* S0 = (bf16_t*)(ws + WS_S0) + u * 4096;
            bf16x8 ahn[4][2], aln[4][2]; f32x4 nnn[4];
            { const int n1 = n + 1 < NCH ? n + 1 : n; const size_t u1 = (size_t)(b * NCH + n1) * H + h;
              const bf16_t* MTH = (const bf16_t*)(ws + WS_MT) + u1 * 4096; const bf16_t* MTL = MTH + (size_t)NUNIT_A * 4096; const float* NN = (const float*)(ws + WS_NN) + u1 * 4096;
#pragma unroll
              for (int jt = 0; jt < 4; ++jt) { nnn[jt] = *(const f32x4*)(NN + (size_t)(16 * iq + fr) * 64 + 16 * jt + 4 * fq);
#pragma unroll
                  for (int ks = 0; ks < 2; ++ks) { ahn[jt][ks] = *(const bf16x8*)(MTH + (size_t)(16 * jt + fr) * 64 + 32 * ks + 8 * fq); aln[jt][ks] = *(const bf16x8*)(MTL + (size_t)(16 * jt + fr) * 64 + 32 * ks + 8 * fq); } } }
#pragma unroll
            for (int jt = 0; jt < 4; ++jt) { unsigned hh[4], ll[4];
#pragma unroll
                for (int r = 0; r < 4; ++r) { hh[r] = f2bf(S[jt][r]); ll[r] = f2bf(S[jt][r] - __builtin_bit_cast(float, hh[r] << 16)); }
                u32x2 wh = {hh[0] | (hh[1] << 16), hh[2] | (hh[3] << 16)}, wl = {ll[0] | (ll[1] << 16), ll[2] | (ll[3] << 16)};
                *(u32x2*)(S0 + (size_t)(16 * iq + fr) * 64 + 16 * jt + 4 * fq) = wh;
                *(LAS u32x2*)(lds + (fr * SST + 16 * jt + 4 * fq) * 2) = wh; *(LAS u32x2*)(lds + 4096 + (fr * SST + 16 * jt + 4 * fq) * 2) = wl; }
            LDS_WAIT();
            bf16x8 bh[2], bl[2];
#pragma unroll
            for (int ks = 0; ks < 2; ++ks) { bh[ks] = *(const LAS bf16x8*)(lds + (fr * SST + 32 * ks + 8 * fq) * 2); bl[ks] = *(const LAS bf16x8*)(lds + 4096 + (fr * SST + 32 * ks + 8 * fq) * 2); }
#pragma unroll
            for (int jt = 0; jt < 4; ++jt) { f32x4 acc = nn[jt];
#pragma unroll
                for (int ks = 0; ks < 2; ++ks) { acc = mfma16(ah[jt][ks], bh[ks], acc); acc = mfma16(ah[jt][ks], bl[ks], acc); acc = mfma16(al[jt][ks], bh[ks], acc); }
                S[jt] = acc; }
            LDS_WAIT();
#pragma unroll
            for (int jt = 0; jt < 4; ++jt) { nn[jt] = nnn[jt];
#pragma unroll
                for (int ks = 0; ks < 2; ++ks) { ah[jt][ks] = ahn[jt][ks]; al[jt][ks] = aln[jt][ks]; } }
        }
        float* so = p->out + O_WKVP + (((size_t)li * NB + b) * H + h) * 4096;
#pragma unroll
        for (int jt = 0; jt < 4; ++jt) *(f32x4*)(so + (size_t)(16 * iq + fr) * 64 + 16 * jt + 4 * fq) = S[jt];
    }
}

__device__ __forceinline__ void phase_scanC(KP p, const Ctx& c, int li) {
    unsigned char* ws = p->ws; const int lane = c.lane, fr = lane & 15, fq = lane >> 4, hb = c.wave >> 2, tt = c.wave & 3;
    const float* Vb = (const float*)(ws + (li ? WS_V1 : WS_V0)); const bf16_t* HID = (const bf16_t*)(ws + WS_HID); const bf16_t* W2G = (const bf16_t*)(ws + WS_W2G) + (size_t)li * 1024 * 128;
    bf16_t* YG = (bf16_t*)(ws + WS_YG);
    for (int up = blockIdx.x; up < NUNIT_A / 2; up += gridDim.x) {
        const int u = 2 * up + hb; const int b = u / (NCH * H), n = (u / H) % NCH, h = u % H; const int row = b * TP + 64 * n + 16 * tt + fr;
        const bf16_t* RP = (const bf16_t*)(ws + WS_RP) + (size_t)u * 4096; const float* YL = (const float*)(ws + WS_YL) + (size_t)u * 4096; const bf16_t* S0 = (const bf16_t*)(ws + WS_S0) + (size_t)u * 4096;
        f32x4 acc[4], ag[4];
#pragma unroll
        for (int it = 0; it < 4; ++it) { acc[it] = *(const f32x4*)(YL + (size_t)(16 * tt + fr) * 64 + 16 * it + 4 * fq); ag[it] = (f32x4){0.f, 0.f, 0.f, 0.f}; }
#pragma unroll
        for (int ks = 0; ks < 2; ++ks) { const bf16x8 bq = *(const bf16x8*)(RP + (size_t)(16 * tt + fr) * 64 + 32 * ks + 8 * fq);
#pragma unroll
            for (int it = 0; it < 4; ++it) acc[it] = mfma16(*(const bf16x8*)(S0 + (size_t)(16 * it + fr) * 64 + 32 * ks + 8 * fq), bq, acc[it]); }
        const bf16_t* hgp = launder_p(HID + (size_t)row * LHID + 160 + 8 * fq); const bf16_t* wgp = launder_p(W2G + (size_t)(64 * h + fr) * 128 + 8 * fq);
#pragma unroll
        for (int ks = 0; ks < 4; ++ks) { const bf16x8 bq = *(const bf16x8*)(hgp + 32 * ks);
#pragma unroll
            for (int it = 0; it < 4; ++it) ag[it] = mfma16(*(const bf16x8*)(wgp + it * 16 * 128 + 32 * ks), bq, ag[it]); }
        float s = 0.f;
#pragma unroll
        for (int it = 0; it < 4; ++it) s += (acc[it][0] + acc[it][1]) + (acc[it][2] + acc[it][3]);
        s = sum_rows4(s); const float mean = s * (1.0f / 64.0f);
        float q = 0.f;
#pragma unroll
        for (int it = 0; it < 4; ++it) { const f32x4 d = acc[it] - mean; q += (d[0] * d[0] + d[1] * d[1]) + (d[2] * d[2] + d[3] * d[3]); }
        q = sum_rows4(q); const float rstd = frsq(q * (1.0f / 64.0f) + GN_EPS);
        const float rks = ((const float*)(ws + WS_RKS))[(size_t)row * 16 + h];
#pragma unroll
        for (int it = 0; it < 4; ++it) { const int C = 64 * h + 16 * it + 4 * fq; const size_t pc = (size_t)li * D + C;
            const f32x4 lw = *(const f32x4*)(p->in[I_LNW] + pc), lb = *(const f32x4*)(p->in[I_LNB] + pc), v = *(const f32x4*)(Vb + (size_t)row * D + C);
            const f32x4 o = ((acc[it] - mean) * rstd * lw + lb + v * rks) * ag[it];
            u32x2 w; w.x = pk2(o[0], o[1]); w.y = pk2(o[2], o[3]); *(u32x2*)(YG + (size_t)row * D + C) = w; }
    }
}
__device__ __forceinline__ void ld8bf(const bf16_t* p, float (&o)[8]) { const u32x4 w = *(const u32x4*)p; o[0] = bflo(w.x); o[1] = bfhi(w.x); o[2] = bflo(w.y); o[3] = bfhi(w.y); o[4] = bflo(w.z); o[5] = bfhi(w.z); o[6] = bflo(w.w); o[7] = bfhi(w.w); }
__device__ __forceinline__ void ld8f(const float* p, float (&o)[8]) { const f32x4 a = *(const f32x4*)p, b = *(const f32x4*)(p + 4); o[0] = a[0]; o[1] = a[1]; o[2] = a[2]; o[3] = a[3]; o[4] = b[0]; o[5] = b[1]; o[6] = b[2]; o[7] = b[3]; }
__device__ __forceinline__ void phase_conv(KP p, const Ctx& c, int layer) {
    const bf16_t* U = (const bf16_t*)(p->ws + WS_U); const bf16_t* GT = (const bf16_t*)(p->ws + WS_GT); bf16_t* HH = (bf16_t*)(p->ws + WS_HH);
    const float* cw = p->in[I_CONVW] + (size_t)layer * 3 * DFF; const float* cb = p->in[I_CONVB] + (size_t)layer * DFF; const float* st = p->in[I_SCONV] + (size_t)layer * SB * 2 * DFF;
    constexpr int NF8 = DFF / 8;
    for (int e = c.gtid; e < R * NF8; e += c.gsz) { const int row = e / NF8, f = 8 * (e % NF8);
        int t, b; if (row < MP) { t = row & (TP - 1); b = -1; } else { t = (row - MP) & 3; b = (row - MP) >> 2; }
        float u0[8], u1[8], u2[8], g[8], w0[8], w1[8], w2[8], bb[8];
        ld8bf(U + (size_t)row * DFF + f, u2); ld8bf(GT + (size_t)row * DFF + f, g);
        if (t >= 1) ld8bf(U + (size_t)(row - 1) * DFF + f, u1); else if (b >= 0) ld8f(st + ((size_t)b * 2 + 1) * DFF + f, u1); else {
#pragma unroll
            for (int i = 0; i < 8; ++i) u1[i] = 0.f; }
        if (t >= 2) ld8bf(U + (size_t)(row - 2) * DFF + f, u0); else if (b >= 0) ld8f(st + ((size_t)b * 2 + t) * DFF + f, u0); else {
#pragma unroll
            for (int i = 0; i < 8; ++i) u0[i] = 0.f; }
        ld8f(cw + f, w0); ld8f(cw + DFF + f, w1); ld8f(cw + 2 * DFF + f, w2); ld8f(cb + f, bb);
        float o[8];
#pragma unroll
        for (int i = 0; i < 8; ++i) o[i] = gelu_tanh(bb[i] + w0[i] * u0[i] + w1[i] * u1[i] + w2[i] * u2[i]) * g[i];
        u32x4 w; w.x = pk2(o[0], o[1]); w.y = pk2(o[2], o[3]); w.z = pk2(o[4], o[5]); w.w = pk2(o[6], o[7]);
        *(u32x4*)(HH + (size_t)row * DFF + f) = w; }
}

__device__ __forceinline__ void phase_kvpost(KP p, const Ctx& c) {
    const float* KVF = (const float*)(p->ws + WS_KVF); unsigned char* ws = p->ws; const int lane = c.lane, g = lane >> 4, d0 = 4 * (lane & 15);
    const f32x4 gs = *(const f32x4*)(p->in[I_KNG] + 64 + d0), gw = *(const f32x4*)(p->in[I_KNG] + 128 + d0);
    bf16_t* CA = (bf16_t*)(ws + WS_CMPA); bf16_t* KS = (bf16_t*)(ws + WS_KS); bf16_t* VS = (bf16_t*)(ws + WS_VS); bf16_t* KW = (bf16_t*)(ws + WS_KW); bf16_t* VW = (bf16_t*)(ws + WS_VW);
    for (int chunk = c.gw; chunk < R / 8; chunk += c.ngw) {
        unsigned vs_[4][4], vw_[4][4];
#pragma unroll
        for (int e = 0; e < 8; ++e) { const int row = chunk * 8 + e; const float* src = KVF + (size_t)row * NKV + 4 * lane;
            f32x4 v[6];
#pragma unroll
            for (int pt = 0; pt < 6; ++pt) v[pt] = *(const f32x4*)(src + pt * 256);
            { float s = (v[2][0] * v[2][0] + v[2][1] * v[2][1]) + (v[2][2] * v[2][2] + v[2][3] * v[2][3]);
              s = row16_sum(s); const float rs = frsq(s * (1.0f / 64.0f) + NORM_EPS); v[2] = v[2] * rs * gs; }
            { float s = (v[4][0] * v[4][0] + v[4][1] * v[4][1]) + (v[4][2] * v[4][2] + v[4][3] * v[4][3]);
              s = row16_sum(s); const float rs = frsq(s * (1.0f / 64.0f) + NORM_EPS); v[4] = v[4] * rs * gw; }
            float* okv = p->out + O_KV + (size_t)row * D + 4 * lane;
#pragma unroll
            for (int pt = 0; pt < 4; ++pt) *(f32x4*)(okv + pt * 256) = v[pt];
            if (row < MP) { const int b = row >> 13, t = row & (TP - 1);
                if (t >= TP - WIN) { float* ow = p->out + O_WINP + ((size_t)(b * WIN + (t - (TP - WIN))) * 2) * 256 + 4 * lane; *(f32x4*)ow = v[4]; *(f32x4*)(ow + 256) = v[5]; }
                const size_t hb = (size_t)(b * G + g);
                { u32x2 w; w.x = pk2(v[0][0], v[0][1]); w.y = pk2(v[0][2], v[0][3]); *(u32x2*)(CA + (hb * 512 + (t >> 4)) * 1024 + (t & 15) * 64 + d0) = w; }
                { u32x2 w; w.x = pk2(v[1][0], v[1][1]); w.y = pk2(v[1][2], v[1][3]); *(u32x2*)(CA + ((size_t)4096 + hb * 512 + (t >> 4)) * 1024 + (t & 15) * 64 + d0) = w; }
                { u32x2 w; w.x = pk2(v[2][0], v[2][1]); w.y = pk2(v[2][2], v[2][3]); *(u32x2*)(KS + (hb * TP + t) * 64 + d0) = w; }
                { u32x2 w; w.x = pk2(v[4][0], v[4][1]); w.y = pk2(v[4][2], v[4][3]); *(u32x2*)(KW + (hb * TP + t) * 64 + d0) = w; }
#pragma unroll
                for (int d = 0; d < 4; ++d) { const unsigned a = f2bf(v[3][d]), bq = f2bf(v[5][d]);
                    if (e & 1) { vs_[d][e >> 1] |= a << 16; vw_[d][e >> 1] |= bq << 16; } else { vs_[d][e >> 1] = a; vw_[d][e >> 1] = bq; } }
            } else { const int b = (row - MP) >> 2, t = (row - MP) & 3;
                float* ow = p->out + O_WINS + ((size_t)(b * WIN + 508 + t) * 2) * 256 + 4 * lane; *(f32x4*)ow = v[4]; *(f32x4*)(ow + 256) = v[5]; }
        }
        if (chunk * 8 < MP) { const int row = chunk * 8, b = row >> 13, t = row & (TP - 1); const size_t hb = (size_t)(b * G + g);
#pragma unroll
            for (int d = 0; d < 4; ++d) { *(u32x4*)(VS + (hb * 64 + d0 + d) * TP + t) = (u32x4){vs_[d][0], vs_[d][1], vs_[d][2], vs_[d][3]};
                *(u32x4*)(VW + (hb * 64 + d0 + d) * TP + t) = (u32x4){vw_[d][0], vw_[d][1], vw_[d][2], vw_[d][3]}; } }
    }
}

__device__ __forceinline__ void phase_cmp2(KP p, const Ctx& c) {
    unsigned char* ws = p->ws; const float* PC = (const float*)(ws + WS_PCMP); const int lane = c.lane, fr = lane & 15, fq = lane >> 4;
    const bf16_t* W2H = (const bf16_t*)(ws + WS_CW2T); const bf16_t* W2L = W2H + 2 * 64 * 128;
    constexpr int NPI = NB * G * 32, NSI = SB * G * 8, TOT = 2 * (NPI + NSI);
    for (int it = c.gw; it < TOT; it += c.ngw) {
        const bool samp = it >= 2 * NPI; const int r = samp ? it - 2 * NPI : it; const int kv = samp ? r / NSI : r / NPI; const int idx = samp ? r % NSI : r % NPI;
        const int hb = samp ? (idx >> 3) : (idx >> 5), n0 = 16 * (samp ? (idx & 7) : (idx & 31)), ncmp = samp ? NCMP_S : NCMP_P, nper = samp ? 128 : 512;
        const int n = n0 + fr; const bool live = n < ncmp;
        const size_t prow = (samp ? (size_t)8192 + (size_t)kv * 65536 : (size_t)kv * 4096) + (size_t)hb * nper + (live ? n : ncmp - 1);
        const float* cb = (const float*)(ws + WS_CBIAS) + kv * 128;
        bf16x8 hh[4], hl[4];
#pragma unroll
        for (int ks = 0; ks < 4; ++ks) { const int k0 = 32 * ks + 8 * fq; unsigned uh[8], ul[8];
            const f32x4 a0 = *(const f32x4*)(PC + prow * 256 + k0), a1 = *(const f32x4*)(PC + prow * 256 + k0 + 4);
            const f32x4 b0 = *(const f32x4*)(PC + (prow + 1) * 256 + 128 + k0), b1 = *(const f32x4*)(PC + (prow + 1) * 256 + 128 + k0 + 4);
            const f32x4 c0 = *(const f32x4*)(cb + k0), c1 = *(const f32x4*)(cb + k0 + 4);
#pragma unroll
            for (int e = 0; e < 8; ++e) { const float x = e < 4 ? a0[e] + b0[e] + c0[e] : a1[e - 4] + b1[e - 4] + c1[e - 4]; const float hv = gelu_tanh(x);
                uh[e] = f2bf(hv); ul[e] = f2bf(hv - __builtin_bit_cast(float, uh[e] << 16)); }
            const u32x4 wh = {uh[0] | (uh[1] << 16), uh[2] | (uh[3] << 16), uh[4] | (uh[5] << 16), uh[6] | (uh[7] << 16)}, wl = {ul[0] | (ul[1] << 16), ul[2] | (ul[3] << 16), ul[4] | (ul[5] << 16), ul[6] | (ul[7] << 16)};
            hh[ks] = __builtin_bit_cast(bf16x8, wh); hl[ks] = __builtin_bit_cast(bf16x8, wl); }
        f32x4 acc[4];
#pragma unroll
        for (int dt = 0; dt < 4; ++dt) { acc[dt] = *(const f32x4*)(p->in[I_CB2] + kv * 64 + 16 * dt + 4 * fq);
#pragma unroll
            for (int ks = 0; ks < 4; ++ks) { const size_t wo = (size_t)(kv * 64 + 16 * dt + fr) * 128 + 32 * ks + 8 * fq; const bf16x8 wh = *(const bf16x8*)(W2H + wo), wl = *(const bf16x8*)(W2L + wo);
                acc[dt] = mfma16(wh, hh[ks], acc[dt]); acc[dt] = mfma16(wh, hl[ks], acc[dt]); acc[dt] = mfma16(wl, hh[ks], acc[dt]); } }
        if (kv == 0) { float ss = 0.f;
#pragma unroll
            for (int dt = 0; dt < 4; ++dt) ss += (acc[dt][0] * acc[dt][0] + acc[dt][1] * acc[dt][1]) + (acc[dt][2] * acc[dt][2] + acc[dt][3] * acc[dt][3]);
            ss = sum_rows4(ss); const float rs = frsq(ss * (1.0f / 64.0f) + NORM_EPS);
#pragma unroll
            for (int dt = 0; dt < 4; ++dt) acc[dt] = acc[dt] * rs * *(const f32x4*)(p->in[I_KNG] + 16 * dt + 4 * fq); }
#pragma unroll
        for (int dt = 0; dt < 4; ++dt) { const f32x4 o = live ? acc[dt] : (f32x4){0.f, 0.f, 0.f, 0.f}; const int d = 16 * dt + 4 * fq;
            if (samp) *(f32x4*)((float*)(ws + (kv ? WS_CVS : WS_CKS)) + ((size_t)hb * 128 + n) * 64 + d) = o;
            else if (kv == 0) { u32x2 w; w.x = pk2(o[0], o[1]); w.y = pk2(o[2], o[3]); *(u32x2*)((bf16_t*)(ws + WS_CK) + ((size_t)hb * 512 + n) * 64 + d) = w; }
            else {
#pragma unroll
                for (int e = 0; e < 4; ++e) ((bf16_t*)(ws + WS_CV))[((size_t)hb * 64 + d + e) * 512 + n] = (bf16_t)f2bf(o[e]); } }
    }
}

__device__ __forceinline__ void phase_qpost(KP p, const Ctx& c, int lb) {
    const float* QF = (const float*)(p->ws + WS_QF); bf16_t* Q = (bf16_t*)(p->ws + WS_Q); const int lane = c.lane;
    const f32x4 gq = *(const f32x4*)(p->in[I_QNG] + lb * 64 + 4 * (lane & 15));
    for (int row = c.gw; row < R; row += c.ngw) { const float* src = QF + (size_t)row * NQP;
        f32x4 v[4]; load_row(src, lane, v);
#pragma unroll
        for (int j = 0; j < 4; ++j) { float s = (v[j][0] * v[j][0] + v[j][1] * v[j][1]) + (v[j][2] * v[j][2] + v[j][3] * v[j][3]);
            s = row16_sum(s);
            const float rs = (frsq(s * (1.0f / 64.0f) + NORM_EPS)) * (0.125f * 1.4426950408889634f); v[j] = v[j] * rs * gq; }
        store_row_bf16(Q + (size_t)row * D, lane, v);
    }
}
constexpr int AT_K0 = 0, AT_V0 = 9216, AT_K1 = 18432, AT_V1 = 27648, AT_IMP = 36864, IMPS = 132, AT_SELM = AT_IMP + 64 * IMPS * 4, AT_ANY = AT_SELM + 1024;
static_assert(AT_ANY + 16 <= RING_BYTES, "attention LDS map");
struct TileSrc { const bf16_t* K; const bf16_t* VT; int vts; };
__device__ __forceinline__ void tile_load(const TileSrc& s, int key0, int tid, u32x4& rk, u32x4& rv) {
    const int row = tid >> 3, ch = tid & 7;
    rk = *(const u32x4*)(s.K + (size_t)(key0 + row) * 64 + 8 * ch); rv = *(const u32x4*)(s.VT + (size_t)row * s.vts + key0 + 8 * ch);
}
__device__ __forceinline__ void tile_store(LAS unsigned char* lds, int buf, int tid, const u32x4& rk, const u32x4& rv) {
    const int row = tid >> 3, ch = tid & 7;
    *(LAS u32x4*)(lds + (buf ? AT_K1 : AT_K0) + (row * SST + 8 * ch) * 2) = rk; *(LAS u32x4*)(lds + (buf ? AT_V1 : AT_V0) + (row * SST + 8 * ch) * 2) = rv;
}
__device__ __forceinline__ int first_bit4(unsigned a, unsigned b, unsigned c, unsigned d) { return a ? __ffs(a) - 1 : (b ? 32 + __ffs(b) - 1 : (c ? 64 + __ffs(c) - 1 : (d ? 96 + __ffs(d) - 1 : -1))); }
__device__ __forceinline__ float ex2(float x) { return __builtin_amdgcn_exp2f(x); }

__device__ __forceinline__ void set_bit4(int s, unsigned& t0, unsigned& t1, unsigned& t2, unsigned& t3) { const unsigned bit = 1u << (s & 31); const int w = s >> 5; t0 |= (w == 0) ? bit : 0u; t1 |= (w == 1) ? bit : 0u; t2 |= (w == 2) ? bit : 0u; t3 |= (w == 3) ? bit : 0u; }
__device__ __forceinline__ void clr_bit4(int s, unsigned& t0, unsigned& t1, unsigned& t2, unsigned& t3) { const unsigned bit = 1u << (s & 31); const int w = s >> 5; t0 &= ~((w == 0) ? bit : 0u); t1 &= ~((w == 1) ? bit : 0u); t2 &= ~((w == 2) ? bit : 0u); t3 &= ~((w == 3) ? bit : 0u); }
__device__ __forceinline__ unsigned get_word4(int s, unsigned a, unsigned b, unsigned c, unsigned d) { const int w = s >> 5; return ((w == 0) ? a : 0u) | ((w == 1) ? b : 0u) | ((w == 2) ? c : 0u) | ((w == 3) ? d : 0u); }
__device__ __forceinline__ float dpp_xor1(float x) { return __builtin_bit_cast(float, __builtin_amdgcn_update_dpp(0, __builtin_bit_cast(int, x), 0xB1, 0xF, 0xF, true)); }
__device__ __forceinline__ float dpp_xor2(float x) { return __builtin_bit_cast(float, __builtin_amdgcn_update_dpp(0, __builtin_bit_cast(int, x), 0x4E, 0xF, 0xF, true)); }
template <int MODE, bool EDGE> __device__ __forceinline__ void attn_tile(LAS unsigned char* lds, int buf, const bf16x8 (&qf)[4], int key0, int qpos, int r, int hf,
                                                                          float& l, f32x16 (&O)[2], float invl, bool selbit, LAS float* impq) {
    if (MODE == 3) { if (__ballot(selbit) == 0ull) return; }
    const int oK = buf ? AT_K1 : AT_K0, oV = buf ? AT_V1 : AT_V0;
#pragma unroll
    for (int kt = 0; kt < 2; ++kt) {
        f32x16 S;
#pragma unroll
        for (int i = 0; i < 16; ++i) S[i] = 0.f;
#pragma unroll
        for (int ks = 0; ks < 4; ++ks) S = mfma32(*(const LAS bf16x8*)(lds + oK + ((32 * kt + r) * SST + 16 * ks + 8 * hf) * 2), qf[ks], S);
        float ls = 0.f;
#pragma unroll
        for (int i = 0; i < 16; ++i) { float pv = ex2(S[i]);
            if (EDGE) { const int key = key0 + 32 * kt + (i & 3) + 8 * (i >> 2) + 4 * hf; bool v;
                if (MODE <= 1) v = (16 * key + 31 <= qpos); else if (MODE == 2) v = (key <= qpos) && (key + WIN > qpos); else v = (key <= qpos);
                pv = v ? pv : 0.f; }
            if (MODE == 1) pv *= invl;
            S[i] = pv; ls += pv; }
        if (MODE == 3) ls = selbit ? ls : 0.f;
        if (MODE != 1) l += ls;
        if (MODE >= 1) {
#pragma unroll
            for (int sp = 0; sp < 2; ++sp) {
                u32x4 pw; pw.x = pg8::cvt_pk_bf16(S[8 * sp + 0], S[8 * sp + 1]); pw.y = pg8::cvt_pk_bf16(S[8 * sp + 2], S[8 * sp + 3]); pw.z = pg8::cvt_pk_bf16(S[8 * sp + 4], S[8 * sp + 5]); pw.w = pg8::cvt_pk_bf16(S[8 * sp + 6], S[8 * sp + 7]);
                if (MODE == 3) { pw.x = selbit ? pw.x : 0u; pw.y = selbit ? pw.y : 0u; pw.z = selbit ? pw.z : 0u; pw.w = selbit ? pw.w : 0u; }
                const bf16x8 pf = __builtin_bit_cast(bf16x8, pw);
#pragma unroll
                for (int dt = 0; dt < 2; ++dt) { const int d = 32 * dt + r, kb = 32 * kt + 16 * sp + 4 * hf;
                    const u32x2 lo = *(const LAS u32x2*)(lds + oV + (d * SST + kb) * 2), hi = *(const LAS u32x2*)(lds + oV + (d * SST + kb + 8) * 2);
                    const u32x4 vw = {lo.x, lo.y, hi.x, hi.y};
                    O[dt] = mfma32(__builtin_bit_cast(bf16x8, vw), pf, O[dt]); } }
        }
        if (MODE == 1) {
            float own[4], nxt[4];
#pragma unroll
            for (int gq = 0; gq < 4; ++gq) { const float p3 = S[4 * gq + 3]; float o = 2.0f * (S[4 * gq] + S[4 * gq + 1] + S[4 * gq + 2]) + p3, n = p3;
                o += dpp_xor1(o); o += dpp_xor2(o); n += dpp_xor1(n); n += dpp_xor2(n); own[gq] = o; nxt[gq] = n; }
            const int sbb = (key0 >> 2) + 8 * kt + hf;
            if ((r & 3) == 0) {
#pragma unroll
                for (int gq = 0; gq < 4; ++gq) impq[sbb + 2 * gq] += own[gq]; }
            asm volatile("s_waitcnt lgkmcnt(0)" ::: "memory");
            if ((r & 3) == 0) {
#pragma unroll
                for (int gq = 0; gq < 4; ++gq) impq[sbb + 2 * gq + 1] += nxt[gq]; }
            asm volatile("s_waitcnt lgkmcnt(0)" ::: "memory");
        }
    }
}

template <int MODE> __device__ __forceinline__ void run_tiles(LAS unsigned char* lds, const TileSrc& src, unsigned t0, unsigned t1, unsigned t2, unsigned t3, int qt,
                                                              const bf16x8 (&qf)[4], int qpos, int r, int hf, int tid,
                                                              float& l, f32x16 (&O)[2], float invl, unsigned s0, unsigned s1, unsigned s2, unsigned s3, LAS float* impq) {
    tid = launder_v(tid); r = tid & 31; hf = (tid >> 5) & 1;
    int cur = first_bit4(t0, t1, t2, t3); if (cur < 0) return;
    clr_bit4(cur, t0, t1, t2, t3); int n1 = first_bit4(t0, t1, t2, t3); if (n1 >= 0) clr_bit4(n1, t0, t1, t2, t3);
    int n2 = first_bit4(t0, t1, t2, t3); if (n2 >= 0) clr_bit4(n2, t0, t1, t2, t3);
    u32x4 rkA, rvA, rkB, rvB; { u32x4 rk, rv; tile_load(src, cur * 64, tid, rk, rv); int b0 = 0; tile_store(lds, b0, tid, rk, rv); }
    if (n1 >= 0) tile_load(src, n1 * 64, tid, rkA, rvA);
    if (n2 >= 0) tile_load(src, n2 * 64, tid, rkB, rvB);
    int buf = 0;
    __syncthreads();
    for (;;) {
        const unsigned sw = get_word4(cur, s0, s1, s2, s3);
        const bool sb = ((sw >> (cur & 31)) & 1u) != 0u;
        if (MODE <= 1) attn_tile<MODE, true>(lds, buf, qf, cur * 64, qpos, r, hf, l, O, invl, sb, impq);
        else { const bool edge = (cur == qt) || (MODE == 2 && cur == qt - 8);
            if (edge) attn_tile<MODE, true>(lds, buf, qf, cur * 64, qpos, r, hf, l, O, invl, sb, impq);
            else attn_tile<MODE, false>(lds, buf, qf, cur * 64, qpos, r, hf, l, O, invl, sb, impq); }
        if (n1 < 0) break;
        tile_store(lds, buf ^ 1, tid, rkA, rvA);
        __syncthreads();
        rkA = rkB; rvA = rvB;
        const int n3 = first_bit4(t0, t1, t2, t3); if (n3 >= 0) { clr_bit4(n3, t0, t1, t2, t3); tile_load(src, n3 * 64, tid, rkB, rvB); }
        buf ^= 1; cur = n1; n1 = n2; n2 = n3;
    }
    __syncthreads();
}
__device__ __forceinline__ void attn_prompt_unit(KP p, const Ctx& c, int k) {
    LAS unsigned char* lds = c.lds; unsigned char* ws = p->ws; const int tid = launder_v(c.tid), lane = tid & 63, wave = c.wave, r = lane & 31, hf = lane >> 5;
    const int qt = 127 - (k >> 3), hb = k & 7, b = hb >> 2, g = hb & 3, q0 = 64 * qt;
    const int qi = 8 * wave + (r >> 2), head = 4 * g + (r & 3), qpos = q0 + qi, row = b * TP + qpos;
    const bf16_t* Q = (const bf16_t*)(ws + WS_Q);
    bf16x8 qf[4];
#pragma unroll
    for (int ks = 0; ks < 4; ++ks) qf[ks] = *(const bf16x8*)(Q + (size_t)row * D + head * 64 + 16 * ks + 8 * hf);
    const float* gate = (const float*)(ws + WS_GATE) + (size_t)row * 48 + head * 3; const float g_c = gate[0], g_s = gate[1], g_w = gate[2];
    LAS float* imp = (LAS float*)(lds + AT_IMP); LAS unsigned* selm = (LAS unsigned*)(lds + AT_SELM); LAS unsigned* anym = (LAS unsigned*)(lds + AT_ANY);
    for (int e = tid; e < 64 * IMPS; e += 512) imp[e] = 0.f;
    if (tid < 4) anym[tid] = 0u;
    __syncthreads();
    f32x16 O[2]; unsigned OUTP[2][8];
#pragma unroll
    for (int dt = 0; dt < 2; ++dt)
#pragma unroll
        for (int i = 0; i < 16; ++i) O[dt][i] = 0.f;
    {
        const TileSrc src{(const bf16_t*)(ws + WS_CK) + (size_t)hb * 512 * 64, (const bf16_t*)(ws + WS_CV) + (size_t)hb * 64 * 512, 512};
        const int nmax = q0 + 63 - 31; const int ntc = nmax >= 0 ? (nmax >> 10) + 1 : 0;
        const unsigned tm = ntc >= 32 ? 0xffffffffu : ((1u << ntc) - 1u);
        float l = 0.f;
        run_tiles<0>(lds, src, tm, 0u, 0u, 0u, qt, qf, qpos, r, hf, tid, l, O, 0.f, 0u, 0u, 0u, 0u, imp);
        l = sum_xor32(l); const float invl = l > 0.f ? 1.0f / l : 0.f;
        run_tiles<1>(lds, src, tm, 0u, 0u, 0u, qt, qf, qpos, r, hf, tid, l, O, invl, 0u, 0u, 0u, 0u, imp + qi * IMPS);
#pragma unroll
        for (int dt = 0; dt < 2; ++dt) {
#pragma unroll
            for (int i = 0; i < 8; ++i) OUTP[dt][i] = pg8::cvt_pk_bf16(O[dt][2 * i] * g_c, O[dt][2 * i + 1] * g_c);
#pragma unroll
            for (int i = 0; i < 16; ++i) O[dt][i] = 0.f; }
    }
    __syncthreads();
    for (int e = 0; e < 8; ++e) { const int qq = 8 * wave + e, qp = q0 + qq, qb = qp >> 6;
        const bool c0 = (64 * lane <= qp), c1 = (64 * (lane + 64) <= qp);
        const unsigned k0 = (lane == 0 || lane == qb || lane == qb - 1) ? 0xffffffffu : __builtin_bit_cast(unsigned, imp[qq * IMPS + lane]);
        const unsigned k1 = (lane + 64 == qb || lane + 64 == qb - 1) ? 0xffffffffu : __builtin_bit_cast(unsigned, imp[qq * IMPS + lane + 64]);
        const int K = qb + 1 < 16 ? qb + 1 : 16;
        unsigned T = 0u;
        for (int bit = 31; bit >= 0; --bit) { const unsigned cand = T | (1u << bit);
            const int cnt = __popcll(__ballot(c0 && k0 >= cand)) + __popcll(__ballot(c1 && k1 >= cand)); if (cnt >= K) T = cand; }
        unsigned long long mlo = __ballot(c0 && k0 > T), mhi = __ballot(c1 && k1 > T), elo = __ballot(c0 && k0 == T), ehi = __ballot(c1 && k1 == T);
        int need = K - (__popcll(mlo) + __popcll(mhi));
        for (; need > 0; --need) { if (elo) { mlo |= elo & (~elo + 1ull); elo &= elo - 1ull; } else { mhi |= ehi & (~ehi + 1ull); ehi &= ehi - 1ull; } }
        const unsigned m0 = (unsigned)mlo, m1 = (unsigned)(mlo >> 32), m2 = (unsigned)mhi, m3 = (unsigned)(mhi >> 32);
        if (lane == 0) { selm[qq * 4 + 0] = m0; selm[qq * 4 + 1] = m1; selm[qq * 4 + 2] = m2; selm[qq * 4 + 3] = m3;
            atomicOr((unsigned*)&anym[0], m0); atomicOr((unsigned*)&anym[1], m1); atomicOr((unsigned*)&anym[2], m2); atomicOr((unsigned*)&anym[3], m3); } }
    __syncthreads();
    {
        const TileSrc src{(const bf16_t*)(ws + WS_KW) + (size_t)hb * TP * 64, (const bf16_t*)(ws + WS_VW) + (size_t)hb * 64 * TP, TP};
        const int tlo = qt >= 8 ? qt - 8 : 0; unsigned t0 = 0u, t1 = 0u, t2 = 0u, t3 = 0u;
        for (int s = tlo; s <= qt; ++s) set_bit4(s, t0, t1, t2, t3);
        float l = 0.f;
        run_tiles<2>(lds, src, t0, t1, t2, t3, qt, qf, qpos, r, hf, tid, l, O, 0.f, 0u, 0u, 0u, 0u, imp);
        l = sum_xor32(l); const float sc = l > 0.f ? g_w / l : 0.f;
#pragma unroll
        for (int dt = 0; dt < 2; ++dt) {
#pragma unroll
            for (int i = 0; i < 8; ++i) OUTP[dt][i] = pg8::cvt_pk_bf16(bflo(OUTP[dt][i]) + O[dt][2 * i] * sc, bfhi(OUTP[dt][i]) + O[dt][2 * i + 1] * sc);
#pragma unroll
            for (int i = 0; i < 16; ++i) O[dt][i] = 0.f; }
    }
    {
        const TileSrc src{(const bf16_t*)(ws + WS_KS) + (size_t)hb * TP * 64, (const bf16_t*)(ws + WS_VS) + (size_t)hb * 64 * TP, TP};
        const unsigned s0 = selm[qi * 4 + 0], s1 = selm[qi * 4 + 1], s2 = selm[qi * 4 + 2], s3 = selm[qi * 4 + 3];
        const unsigned a0 = anym[0], a1 = anym[1], a2 = anym[2], a3 = anym[3];
        float l = 0.f;
        run_tiles<3>(lds, src, a0, a1, a2, a3, qt, qf, qpos, r, hf, tid, l, O, 0.f, s0, s1, s2, s3, imp);
        l = sum_xor32(l); const float sc = l > 0.f ? g_s / l : 0.f;
#pragma unroll
        for (int dt = 0; dt < 2; ++dt)
#pragma unroll
            for (int i = 0; i < 8; ++i) OUTP[dt][i] = pg8::cvt_pk_bf16(bflo(OUTP[dt][i]) + O[dt][2 * i] * sc, bfhi(OUTP[dt][i]) + O[dt][2 * i + 1] * sc);
    }
    bf16_t* AO = (bf16_t*)(ws + WS_YG) + (size_t)row * D + head * 64;
#pragma unroll
    for (int dt = 0; dt < 2; ++dt)
#pragma unroll
        for (int gq = 0; gq < 4; ++gq) { u32x2 w; w.x = OUTP[dt][2 * gq]; w.y = OUTP[dt][2 * gq + 1]; *(u32x2*)(AO + 32 * dt + 8 * gq + 4 * hf) = w; }
    __syncthreads();
}

constexpr int SA_RED = 0, SA_REDW = 2 * 16 * 65 * 4, SA_OC = SA_RED + SA_REDW, SA_EC = SA_OC + 2 * 4096, SA_LC = SA_EC + 2 * 4096, SA_PN = SA_LC + 256, SA_SEL = SA_PN + 4 * 512;
static_assert(SA_SEL + 64 <= RING_BYTES, "sample attention LDS map");
__device__ __forceinline__ bf16x8 pack8(const f32x4 a, const f32x4 b) { const u32x4 w = {pk2(a[0], a[1]), pk2(a[2], a[3]), pk2(b[0], b[1]), pk2(b[2], b[3])}; return __builtin_bit_cast(bf16x8, w); }
__device__ __forceinline__ void sa_qk(const float* kb, size_t stride, int nrows, const bf16x8 (&qf)[2], int fr, int fq, f32x4 (&S)[4]) {
    f32x4 kr[4][2][2];
#pragma unroll
    for (int kg = 0; kg < 4; ++kg) { const int key = 16 * kg + fr; const float* rp = kb + (size_t)(key < nrows ? key : nrows - 1) * stride + 8 * fq;
#pragma unroll
        for (int ks = 0; ks < 2; ++ks) { kr[kg][ks][0] = *(const f32x4*)(rp + 32 * ks); kr[kg][ks][1] = *(const f32x4*)(rp + 32 * ks + 4); } }
#pragma unroll
    for (int kg = 0; kg < 4; ++kg) { S[kg] = (f32x4){0.f, 0.f, 0.f, 0.f};
#pragma unroll
        for (int ks = 0; ks < 2; ++ks) S[kg] = mfma16(pack8(kr[kg][ks][0], kr[kg][ks][1]), qf[ks], S[kg]); }
}
__device__ __forceinline__ void sa_pv(const float* vb, size_t stride, int nrows, const f32x4 (&P)[4], int fr, int fq, f32x4 (&O)[4]) {
#pragma unroll
    for (int ks = 0; ks < 2; ++ks) { const bf16x8 pa = pack8(P[2 * ks], P[2 * ks + 1]);
        float vv[4][8];
#pragma unroll
        for (int j = 0; j < 8; ++j) { const int key = 16 * (2 * ks + (j >> 2)) + 4 * fq + (j & 3); const float* rp = vb + (size_t)(key < nrows ? key : nrows - 1) * stride + fr;
#pragma unroll
            for (int dt = 0; dt < 4; ++dt) vv[dt][j] = rp[16 * dt]; }
#pragma unroll
        for (int dt = 0; dt < 4; ++dt) { const u32x4 w = {pk2(vv[dt][0], vv[dt][1]), pk2(vv[dt][2], vv[dt][3]), pk2(vv[dt][4], vv[dt][5]), pk2(vv[dt][6], vv[dt][7])};
            O[dt] = mfma16(pa, __builtin_bit_cast(bf16x8, w), O[dt]); } }
}
__device__ __forceinline__ void attn_sample_unit(KP p, const Ctx& c, int item) {
    unsigned char* ws = p->ws; LAS unsigned char* lds = c.lds; const int tid = launder_v(c.tid), lane = tid & 63, wave = c.wave, fr = lane & 15, fq = lane >> 4; const int b = item >> 2, g = item & 3;
    bf16x8 qf[2];
    { const bf16_t* Q = (const bf16_t*)(ws + WS_Q) + (size_t)(MP + 4 * b + (fr >> 2)) * D + (4 * g + (fr & 3)) * 64 + 8 * fq;
      qf[0] = *(const bf16x8*)Q; qf[1] = *(const bf16x8*)(Q + 32); }
    const int tokm = fr >> 2;
    if (wave < 2) {
        const float* ck = (const float*)(ws + WS_CKS) + ((size_t)(b * 4 + g) * 128 + 64 * wave) * 64; const float* cv = (const float*)(ws + WS_CVS) + ((size_t)(b * 4 + g) * 128 + 64 * wave) * 64;
        const int nrows = wave ? 63 : 64;
        f32x4 S[4]; sa_qk(ck, 64, nrows, qf, fr, fq, S);
        float ls = 0.f;
#pragma unroll
        for (int kg = 0; kg < 4; ++kg)
#pragma unroll
            for (int r = 0; r < 4; ++r) { const int key = 16 * kg + 4 * fq + r; const float ev = key < nrows ? ex2(S[kg][r]) : 0.f; S[kg][r] = ev; ls += ev;
                *(LAS float*)(lds + SA_EC + wave * 4096 + (key * 16 + fr) * 4) = ev; }
        ls = sum_rows4(ls); if (fq == 0) *(LAS float*)(lds + SA_LC + (wave * 16 + fr) * 4) = ls;
        f32x4 oc[4];
#pragma unroll
        for (int dt = 0; dt < 4; ++dt) oc[dt] = (f32x4){0.f, 0.f, 0.f, 0.f};
        sa_pv(cv, 64, nrows, S, fr, fq, oc);
#pragma unroll
        for (int dt = 0; dt < 4; ++dt)
#pragma unroll
            for (int r = 0; r < 4; ++r) *(LAS float*)(lds + SA_OC + wave * 4096 + ((4 * fq + r) * 64 + 16 * dt + fr) * 4) = oc[dt][r];
    }
    __syncthreads();
    if (wave < 4) { const int tok = wave; float P0 = 0.f, P1 = 0.f;
#pragma unroll
        for (int hh = 0; hh < 4; ++hh) { const int pi = tok * 4 + hh; const float L = *(const LAS float*)(lds + SA_LC + pi * 4) + *(const LAS float*)(lds + SA_LC + (16 + pi) * 4); const float inv = L > 0.f ? 1.0f / L : 0.f;
            P0 += *(const LAS float*)(lds + SA_EC + (lane * 16 + pi) * 4) * inv; P1 += *(const LAS float*)(lds + SA_EC + 4096 + (lane * 16 + pi) * 4) * inv; }
        LAS float* pn = (LAS float*)(lds + SA_PN + tok * 512); pn[lane] = P0; pn[64 + lane] = P1; LDS_WAIT();
        float v0 = -1e9f;
        if (lane < 33) { const int s = lane; float im = 0.f;
            if (4 * s - 1 >= 0 && 4 * s - 1 < 128) im += pn[4 * s - 1];
#pragma unroll
            for (int j = 0; j < 3; ++j) if (4 * s + j < 128) im += 2.0f * pn[4 * s + j];
            if (4 * s + 3 < 128) im += pn[4 * s + 3];
            v0 = (s == 0 || s == 31 || s == 32) ? 1e9f : im; }
        unsigned selmask = 0u, sel32 = 0u;
        for (int it = 0; it < 16; ++it) { const float mx = wave_max(v0); if (mx < -5e8f) break; const unsigned long long b0 = __ballot(v0 == mx); const int s = __ffsll((long long)b0) - 1;
            if (lane == s) v0 = -2e9f; if (s < 32) selmask |= 1u << s; else sel32 = 1u; }
        if (lane == 0) { *(LAS unsigned*)(lds + SA_SEL + tok * 8) = selmask; *(LAS unsigned*)(lds + SA_SEL + tok * 8 + 4) = sel32; } }
    __syncthreads();
    unsigned sm[4], s32[4];
#pragma unroll
    for (int t = 0; t < 4; ++t) { sm[t] = *(const LAS unsigned*)(lds + SA_SEL + t * 8); s32[t] = *(const LAS unsigned*)(lds + SA_SEL + t * 8 + 4); }
    const unsigned un = sm[0] | sm[1] | sm[2] | sm[3]; const int nsel = __popc(un); const int has32 = (s32[0] | s32[1] | s32[2] | s32[3]) ? 1 : 0;
    const unsigned my_sm = tokm == 0 ? sm[0] : (tokm == 1 ? sm[1] : (tokm == 2 ? sm[2] : sm[3])), my_s32 = tokm == 0 ? s32[0] : (tokm == 1 ? s32[1] : (tokm == 2 ? s32[2] : s32[3]));
    const int ntile = nsel + has32 + 9;
    const int* pt = (const int*)p->in[I_PT] + b * NPAGES;
    f32x4 osel[4], owin[4]; float lsel = 0.f, lwin = 0.f;
#pragma unroll
    for (int dt = 0; dt < 4; ++dt) { osel[dt] = (f32x4){0.f, 0.f, 0.f, 0.f}; owin[dt] = (f32x4){0.f, 0.f, 0.f, 0.f}; }
    for (int ti = wave; ti < ntile; ti += 8) {
        const float* kb; size_t stride; int nrows = 64, br, mode, sidx = 0;
        if (ti < nsel) { unsigned m = un; for (int q = 0; q < ti; ++q) m &= m - 1u; sidx = __ffs(m) - 1; const int page = pt[sidx >> 1];
            kb = p->in[I_CKV] + ((size_t)page * PAGE + (sidx & 1) * 64) * 1024 + 2 * 256 + g * 64; stride = 1024; br = 0; mode = 0; }
        else if (ti < nsel + has32) { kb = p->out + O_KV + (size_t)(MP + 4 * b) * D + 2 * 256 + g * 64; stride = 1024; nrows = 4; br = 0; mode = 1; }
        else if (ti < nsel + has32 + 8) { sidx = ti - nsel - has32; kb = p->in[I_CWIN] + ((size_t)b * WIN + 64 * sidx) * 512 + g * 64; stride = 512; br = 1; mode = 2; }
        else { kb = p->out + O_WINS + ((size_t)(b * WIN + 508) * 2) * 256 + g * 64; stride = 512; nrows = 4; br = 1; mode = 3; }
        f32x4 S[4]; sa_qk(kb, stride, nrows, qf, fr, fq, S);
        float ls = 0.f;
#pragma unroll
        for (int kg = 0; kg < 4; ++kg)
#pragma unroll
            for (int r = 0; r < 4; ++r) { const int key = 16 * kg + 4 * fq + r; bool valid;
                if (mode == 0) valid = ((my_sm >> sidx) & 1u) != 0u; else if (mode == 1) valid = (my_s32 != 0u) && (key <= tokm); else if (mode == 2) valid = (64 * sidx + key) >= tokm + 1; else valid = key <= tokm;
                const float ev = valid ? ex2(S[kg][r]) : 0.f; S[kg][r] = ev; ls += ev; }
        if (br == 0) { lsel += ls; sa_pv(kb + 256, stride, nrows, S, fr, fq, osel); } else { lwin += ls; sa_pv(kb + 256, stride, nrows, S, fr, fq, owin); }
    }
    lsel = sum_rows4(lsel); lwin = sum_rows4(lwin);
    for (int w = 0; w < 8; ++w) {
        if (wave == w) {
#pragma unroll
            for (int dt = 0; dt < 4; ++dt)
#pragma unroll
                for (int r = 0; r < 4; ++r) { LAS float* r0 = (LAS float*)(lds + SA_RED + ((4 * fq + r) * 65 + 16 * dt + fr) * 4); LAS float* r1 = (LAS float*)(lds + SA_RED + ((16 + 4 * fq + r) * 65 + 16 * dt + fr) * 4);
                    if (w == 0) { *r0 = osel[dt][r]; *r1 = owin[dt][r]; } else { *r0 += osel[dt][r]; *r1 += owin[dt][r]; } }
            if (fq == 0) { LAS float* l0 = (LAS float*)(lds + SA_RED + (fr * 65 + 64) * 4); LAS float* l1 = (LAS float*)(lds + SA_RED + ((16 + fr) * 65 + 64) * 4);
                if (w == 0) { *l0 = lsel; *l1 = lwin; } else { *l0 += lsel; *l1 += lwin; } } }
        __syncthreads(); }
    { const float* gt = (const float*)(ws + WS_GATE); bf16_t* AO = (bf16_t*)(ws + WS_YG);
      for (int e = tid; e < 1024; e += 512) { const int pi = e >> 6, d = e & 63, tok = pi >> 2, hh = pi & 3; const size_t row = (size_t)(MP + 4 * b + tok);
          const float lc = *(const LAS float*)(lds + SA_LC + pi * 4) + *(const LAS float*)(lds + SA_LC + (16 + pi) * 4);
          const float oc = *(const LAS float*)(lds + SA_OC + (pi * 64 + d) * 4) + *(const LAS float*)(lds + SA_OC + 4096 + (pi * 64 + d) * 4);
          const LAS float* r0 = (const LAS float*)(lds + SA_RED + (pi * 65) * 4); const LAS float* r1 = (const LAS float*)(lds + SA_RED + ((16 + pi) * 65) * 4);
          const float* gg = gt + row * 48 + (4 * g + hh) * 3;
          float out = lc > 0.f ? gg[0] * oc / lc : 0.f;
          out += r0[64] > 0.f ? gg[1] * r0[d] / r0[64] : 0.f;
          out += r1[64] > 0.f ? gg[2] * r1[d] / r1[64] : 0.f;
          AO[row * D + (4 * g + hh) * 64 + d] = (bf16_t)f2bf(out); } }
    __syncthreads();
}

__device__ __forceinline__ void phase_attn_prompt(KP p, const Ctx& c) {
    const int Gd = gridDim.x, cb = blockIdx.x;
    for (int i = 0; i * Gd < 1024; ++i) { const int k = i * Gd + ((i & 1) ? Gd - 1 - cb : cb); if (k < 1024) attn_prompt_unit(p, c, k); }
}
__device__ __forceinline__ void phase_attn_sample(KP p, const Ctx& c) {
    for (int it = blockIdx.x; it < SB * G; it += gridDim.x) attn_sample_unit(p, c, it);
}
#ifndef MK_MULTI
#define MK_MULTI 0
#endif
#if defined(PROBE_SCALE) || defined(SELFTEST)
constexpr int NPH = 46;
#elif defined(PROBE_ATTN2)
constexpr int NPH = 47;
#else
constexpr int NPH = 45;
#endif
#ifdef SPLITK
#define RESID_SPLIT(n) (n)
#else
#define RESID_SPLIT(n) 0
#endif

__global__ void __launch_bounds__(512, 2) mega(Params p) {
    extern __shared__ __attribute__((aligned(16))) unsigned char lds_raw[];
    LAS unsigned char* const lds0 = (LAS unsigned char*)lds_raw;
    volatile LAS unsigned* MISC = (volatile LAS unsigned*)(lds0 + MISC_OFF);
    for (int u = threadIdx.x; u < (LDS_BYTES - RING_BYTES) / 4; u += 512) ((LAS unsigned*)(lds0 + RING_BYTES))[u] = 0u;
    __syncthreads();
    const KP kp0 = (KP)__builtin_amdgcn_kernarg_segment_ptr();
    const int ph_lo = kp0->ph_lo, ph_hi = kp0->ph_hi, use_bar = kp0->use_bar;
    XcdBarrier bar; bar.bar = (unsigned*)(kp0->ws + WS_CTL); bar.x = 0; bar.st = nullptr;
    if (use_bar) bar = xcd_barrier_post((unsigned*)(kp0->ws + WS_CTL), MISC + 8);
    const int wave_s = __builtin_amdgcn_readfirstlane((int)threadIdx.x >> 6);
#define TID_MBCNT 1
#ifdef TID_MBCNT
#define TID_SRC(T_) asm volatile("v_mbcnt_lo_u32_b32 %0, -1, 0\n\tv_mbcnt_hi_u32_b32 %0, -1, %0" : "=v"(T_)); T_ += 64 * wave_s;
#else
#define TID_SRC(T_) T_ = threadIdx.x; asm volatile("" : "+v"(T_));
#endif
    int ph = 0;
#define PHASE_BEGIN if (ph >= ph_lo && ph < ph_hi) { KP p = kp0; asm volatile("" : "+s"(p)); int tid_; TID_SRC(tid_) \
        Ctx c; c.lds = lds0; c.tid = tid_; c.lane = tid_ & 63; c.wave = __builtin_amdgcn_readfirstlane(tid_ >> 6); c.gw = blockIdx.x * 8 + c.wave; c.ngw = gridDim.x * 8; c.gtid = blockIdx.x * 512 + tid_; c.gsz = gridDim.x * 512; \
        unsigned char* ws = p->ws; float* X = p->out + O_Y; (void)ws; (void)X;
#define PHASE_END   if (use_bar) xcd_barrier(bar, c.tid == 0); } ++ph;

    PHASE_BEGIN phase_prologue(p, c); PHASE_END
#ifdef PROBE_BAR
    for (int xb = 0; xb < PROBE_BAR; ++xb) { if (use_bar) xcd_barrier(bar, threadIdx.x == 0); }
#endif

    for (int layer = 0; layer < NLAY; ++layer) {
        if (layer < 2) {
            const int li = layer;
            PHASE_BEGIN phase_mix(p, c, li); PHASE_END
            PHASE_BEGIN {
                pg8::Gemm g{(const bf16_t*)(ws + WS_XM), (const bf16_t*)(ws + WS_WRKV) + (size_t)li * 3072 * 1024, 3 * R, 3072, 1024, 1024};
                pg8::GroupOrder S; S.init((int)gridDim.x, (int)blockIdx.x); S.add(0, 0, 64, 0, 4); S.add(1, 66, 64, 4, 4); S.add(2, 132, 64, 8, 4);
                pg8::EpiF32G E{(float*)(ws + WS_RK_R), (float*)(ws + WS_RK_K), (float*)(ws + (li ? WS_V1 : WS_V0)), nullptr, D, 4, 66};
                pg8::gemm_phase<pg8::EpiF32G, pg8::GroupOrder, true, true>(c.lds, g, S, E, c.tid);
                {
                    const bf16_t* XMs = (const bf16_t*)(ws + WS_XM); const bf16_t* Wr = (const bf16_t*)(ws + WS_WRKV) + (size_t)li * 3072 * 1024;
                    for (int it = blockIdx.x + gridDim.x * c.wave; it < 768; it += c.ngw) { const int j = it >> 8, r = it & 255, row0 = MP + 32 * (r & 15), col0 = 64 * (r >> 4);
                        float* C = (float*)(ws + (j == 0 ? WS_RK_R : (j == 1 ? WS_RK_K : (li ? WS_V1 : WS_V0))));
                        f32x4 acc[4][2]; skinny_mma<4>(XMs + (size_t)j * R * D, 1024, Wr + (size_t)j * 1024 * 1024, 1024, 1024, row0, col0, c.lane, acc);
                        const int fr = c.lane & 15, fq = c.lane >> 4;
#pragma unroll
                        for (int nt = 0; nt < 4; ++nt)
#pragma unroll
                            for (int mt = 0; mt < 2; ++mt) *(f32x4*)(C + (size_t)(row0 + 16 * mt + fr) * D + col0 + 16 * nt + 4 * fq) = acc[nt][mt]; }
                }
                phase_lora1(p, c, li);
            } PHASE_END
            PHASE_BEGIN phase_scanA(p, c, li); PHASE_END
            PHASE_BEGIN phase_scanB(p, c, li); phase_fill(p, c, li); PHASE_END
            PHASE_BEGIN phase_scanC(p, c, li); PHASE_END
        } else {
            const int lb = layer - 2;
            if (layer == 2) {
                PHASE_BEGIN phase_norm(c, X, p->in[I_KVNG], (bf16_t*)(ws + WS_XN2), p->in[I_NORMG] + (size_t)(layer * 2) * D, (bf16_t*)(ws + WS_XN)); PHASE_END
                PHASE_BEGIN {
                    pg8::Gemm g{(const bf16_t*)(ws + WS_XN2), (const bf16_t*)(ws + WS_WKVT), R, NKV, 1024, 1024};
                    pg8::GroupOrder S; S.init((int)gridDim.x, (int)blockIdx.x); S.add(0, 0, 66, 0, 6);
                    pg8::EpiF32G E{(float*)(ws + WS_KVF), nullptr, nullptr, nullptr, NKV, 1 << 20, 0};
                    pg8::gemm_phase<pg8::EpiF32G, pg8::GroupOrder, true, true>(c.lds, g, S, E, c.tid);
                } PHASE_END
                PHASE_BEGIN phase_kvpost(p, c); PHASE_END
                PHASE_BEGIN {
                    pg8::Gemm g{(const bf16_t*)(ws + WS_CMPA), (const bf16_t*)(ws + WS_CW1T), (int)CMPA_ROWS, 512, 1024, 1024};
                    pg8::GroupOrder S; S.init((int)gridDim.x, (int)blockIdx.x); S.add(0, 0, 16, 0, 1); S.add(1, 16, 16, 1, 1); S.add(2, 32, 256, 0, 1); S.add(3, 288, 256, 1, 1);
                    pg8::EpiF32G E{(float*)(ws + WS_PCMP), (float*)(ws + WS_PCMP), nullptr, nullptr, 256, 1, 0};
                    pg8::gemm_phase<pg8::EpiF32G, pg8::GroupOrder, true, true>(c.lds, g, S, E, c.tid);
                } PHASE_END
                PHASE_BEGIN phase_cmp2(p, c); PHASE_END
            } else {
                PHASE_BEGIN phase_norm(c, X, p->in[I_NORMG] + (size_t)(layer * 2) * D, (bf16_t*)(ws + WS_XN), nullptr, nullptr); PHASE_END
            }
            PHASE_BEGIN {
                const bf16_t* XNp = (const bf16_t*)(ws + WS_XN); const bf16_t* Wq = (const bf16_t*)(ws + WS_WQT) + (size_t)lb * NQP * 1024; float* QFp = (float*)(ws + WS_QF);
                pg8::Gemm g{XNp, Wq, R, NQP, 1024, 1024};
                pg8::GroupOrder S; S.init((int)gridDim.x, (int)blockIdx.x); S.add(0, 0, 64, 0, 4);
                pg8::EpiF32G E{QFp, nullptr, nullptr, nullptr, NQP, 1 << 20, 0};
                pg8::gemm_phase<pg8::EpiF32G, pg8::GroupOrder, true, true>(c.lds, g, S, E, c.tid);
                float* GATEp = (float*)(ws + WS_GATE);
                for (int it = blockIdx.x + gridDim.x * c.wave; it < 256 + R / 32; it += c.ngw) { const int ln = launder_v(c.lane), fr = ln & 15, fq = ln >> 4;
                    if (it < 256) { const int row0 = MP + 32 * (it & 15), col0 = 64 * (it >> 4);
                        f32x4 acc[4][2]; skinny_mma<4>(XNp, 1024, Wq, 1024, 1024, row0, col0, ln, acc);
#pragma unroll
                        for (int nt = 0; nt < 4; ++nt)
#pragma unroll
                            for (int mt = 0; mt < 2; ++mt) *(f32x4*)(QFp + (size_t)(row0 + 16 * mt + fr) * NQP + col0 + 16 * nt + 4 * fq) = acc[nt][mt]; }
                    else { const int row0 = 32 * (it - 256);
                        f32x4 acc[3][2]; skinny_mma<3>(XNp, 1024, Wq, 1024, 1024, row0, 1024, ln, acc);
#pragma unroll
                        for (int nt = 0; nt < 3; ++nt)
#pragma unroll
                            for (int mt = 0; mt < 2; ++mt) { f32x4 v = acc[nt][mt];
#pragma unroll
                                for (int e = 0; e < 4; ++e) v[e] = sigmoidf_(v[e]);
                                *(f32x4*)(GATEp + (size_t)(row0 + 16 * mt + fr) * 48 + 16 * nt + 4 * fq) = v; } }
                }
            } PHASE_END
            PHASE_BEGIN phase_qpost(p, c, lb); PHASE_END
            PHASE_BEGIN phase_attn_prompt(p, c); PHASE_END
#ifdef PROBE_ATTN2
            PHASE_BEGIN phase_attn_prompt(p, c); PHASE_END
#endif
            PHASE_BEGIN phase_attn_sample(p, c); PHASE_END
        }
        PHASE_BEGIN {
            const bf16_t* Wt = layer < 2 ? (const bf16_t*)(ws + WS_WORW) + (size_t)layer * 1024 * 1024 : (const bf16_t*)(ws + WS_WONSA) + (size_t)(layer - 2) * 1024 * 1024;
            pg8::Gemm g{(const bf16_t*)(ws + WS_YG), Wt, R, 1024, 1024, 1024};
            pg8::GroupOrder S; S.init((int)gridDim.x, (int)blockIdx.x); S.add(0, 0, 64, 0, 4);
            pg8::EpiResid E{X, D};
            pg8::gemm_phase<pg8::EpiResid, pg8::GroupOrder, true, true>(c.lds, g, S, E, c.tid);
            skinny_resid_sample(c, (const bf16_t*)(ws + WS_YG), 1024, Wt, 1024, X);
        } PHASE_END
        PHASE_BEGIN phase_norm(c, X, p->in[I_NORMG] + (size_t)(layer * 2 + 1) * D, (bf16_t*)(ws + WS_XN), nullptr, nullptr); PHASE_END
        PHASE_BEGIN {
            pg8::Gemm g{(const bf16_t*)(ws + WS_XN), (const bf16_t*)(ws + WS_WINT) + (size_t)layer * 5632 * 1024, R, 5632, 1024, 1024};
            pg8::GroupOrder S; S.init((int)gridDim.x, (int)blockIdx.x); S.add(0, 0, 66, 0, 22);
            pg8::EpiWin E{(bf16_t*)(ws + WS_U), (bf16_t*)(ws + WS_GT), p->out + O_CVP + (size_t)layer * NB * 2 * DFF, p->out + O_CVS + (size_t)layer * SB * 2 * DFF};
            pg8::gemm_phase<pg8::EpiWin, pg8::GroupOrder, true, true>(c.lds, g, S, E, c.tid);
        } PHASE_END
        PHASE_BEGIN phase_conv(p, c, layer); PHASE_END
        PHASE_BEGIN {
            pg8::Gemm g{(const bf16_t*)(ws + WS_HH), (const bf16_t*)(ws + WS_WOUTT) + (size_t)layer * 1024 * 2816, R, 1024, 2816, 2816};
            pg8::GroupOrder S; S.init((int)gridDim.x, (int)blockIdx.x); S.add(0, 0, 64, 0, 4);
            pg8::EpiResid E{X, D};
            pg8::gemm_phase<pg8::EpiResid, pg8::GroupOrder, true, true>(c.lds, g, S, E, c.tid);
            skinny_resid_sample(c, (const bf16_t*)(ws + WS_HH), 2816, (const bf16_t*)(ws + WS_WOUTT) + (size_t)layer * 1024 * 2816, 2816, X);
        } PHASE_END
    }
#ifdef SELFTEST
    PHASE_BEGIN if (blockIdx.x == 0 && c.wave == 0) { const float x = (float)((c.lane * 37) & 63) + 1.0f; float poison = 0.f;
        if (__ballot(swz_xor16_n(x) != __shfl_xor(x, 16))) poison += 1e3f;
        if (__ballot(sum_xor32_n(x) != x + __shfl_xor(x, 32))) poison += 1e4f;
        if (__ballot(sum_rows4_n(x) != x + __shfl_xor(x, 16) + __shfl_xor(x, 32) + __shfl_xor(x, 48))) poison += 1e5f;
        if (__ballot(wave_sum_n(x) != 2080.0f)) poison += 1e6f;
        if (__ballot(wave_max_n(x) != 64.0f)) poison += 1e7f;
        if (c.lane == 0) p->out[O_CVS] += poison; } PHASE_END
#endif
#ifdef PROBE_SCALE
    PHASE_BEGIN for (size_t e = c.gtid; e < O_END; e += c.gsz) { int oi = e < O_KV ? (e < (size_t)MP * D ? 0 : 1) : e < O_WINP ? (e < O_KV + (size_t)MP * D ? 2 : 3) : e < O_WINS ? 4 : e < O_WKVP ? 5 : e < O_WKVS ? 6 : e < O_SHP ? 7 : e < O_SHS ? 8 : e < O_CVP ? 9 : e < O_CVS ? 10 : 11;
        if (PROBE_SCALE < 0) oi = 11 - oi; p->out[e] *= 1.0f + sqrtf(0.5e-4f * (float)(oi + 1)); } PHASE_END
#endif
#undef PHASE_BEGIN
#undef PHASE_END
}

extern "C" void kernel_launch(void* const* d_in, const int* in_sizes, int n_in, void* d_out, int out_size, void* d_ws, size_t ws_size, hipStream_t stream) {
    static int grid = 0;
    if (grid == 0) {
        if (n_in != 45 || (size_t)out_size != O_END || ws_size < WS_END) { fprintf(stderr, "kernel_launch: unexpected shapes (n_in %d out %d ws %zu need %zu)\n", n_in, out_size, ws_size, (size_t)WS_END); grid = -1; return; }
        int dev = 0, cus = 0, per_cu = 0;
        if (hipGetDevice(&dev) != hipSuccess || hipDeviceGetAttribute(&cus, hipDeviceAttributeMultiprocessorCount, dev) != hipSuccess) { grid = -1; return; }
        if (hipFuncSetAttribute((const void*)mega, hipFuncAttributeMaxDynamicSharedMemorySize, LDS_BYTES) != hipSuccess) { fprintf(stderr, "kernel_launch: hipFuncSetAttribute failed\n"); grid = -1; return; }
        if (hipOccupancyMaxActiveBlocksPerMultiprocessor(&per_cu, (const void*)mega, 512, LDS_BYTES) != hipSuccess || per_cu < 1) { fprintf(stderr, "kernel_launch: occupancy query says %d\n", per_cu); (void)hipGetLastError(); }
        grid = cus;
    }
    if (grid < 0) return;
    (void)hipMemsetAsync((char*)d_ws + WS_CTL, 0, CTL_BYTES, stream);
    Params p{};
    for (int i = 0; i < 45; ++i) p.in[i] = (const float*)d_in[i];
    p.out = (float*)d_out; p.ws = (unsigned char*)d_ws;
#ifdef PROBE_PRE
    { const int plist[] = PROBE_PRE; for (int i = 0; i < (int)(sizeof(plist) / sizeof(int)); ++i) { p.ph_lo = plist[i] % 100; p.ph_hi = p.ph_lo + 1; p.use_bar = 0; p.pad = plist[i] / 100;       hipLaunchKernelGGL(mega, dim3(grid), dim3(512), LDS_BYTES, stream, p); } }
#endif
    p.pad = 0;
#if MK_MULTI
    for (int i = 0; i < NPH; ++i) { p.ph_lo = i; p.ph_hi = i + 1; p.use_bar = 0; hipLaunchKernelGGL(mega, dim3(grid), dim3(512), LDS_BYTES, stream, p); }
#else
    p.ph_lo = 0; p.ph_hi = NPH; p.use_bar = 1;
    hipLaunchKernelGGL(mega, dim3(grid), dim3(512), LDS_BYTES, stream, p);
#endif
    const hipError_t le = hipPeekAtLastError();
    if (le != hipSuccess) fprintf(stderr, "kernel_launch: launch failed: %s\n", hipGetErrorName(le));
}
```

```cpp
#include <hip/hip_runtime.h>
#include <cstdio>
#include <cstdint>

#define LAS __attribute__((address_space(3)))
#define GAS __attribute__((address_space(1)))
typedef unsigned short bf16_t;
typedef short bf16x8 __attribute__((ext_vector_type(8)));
typedef float f32x4 __attribute__((ext_vector_type(4)));
typedef float f32x16 __attribute__((ext_vector_type(16)));
typedef float f32x2 __attribute__((ext_vector_type(2)));
typedef unsigned u32x4 __attribute__((ext_vector_type(4)));
typedef unsigned u32x2 __attribute__((ext_vector_type(2)));

constexpr int D = 1024, NB = 2, TP = 8192, MP = NB * TP, SB = 128, ST = 4, MS = SB * ST, R = MP + MS;
constexpr int PAST = 2048, PAGE = 128, NPAGES = PAST / PAGE;
constexpr int H = 16, HD = 64, G = 4, HPG = 4, DFF = 2816, NLAY = 4;
constexpr int LW_ = 64, LA_ = 64, LV_ = 32, LG_ = 128, LHID = 288;
constexpr int NKV = 1536, NQ = 1072, NQP = 1280;
constexpr int NCH = TP / 64;
constexpr int NUNIT_A = NB * NCH * H;
constexpr int NCMP_P = 511, NCMP_S = 127, WIN = 512;
constexpr float NORM_EPS = 1e-6f, GN_EPS = 64e-5f;

constexpr size_t O_Y = 0;
constexpr size_t O_KV = (size_t)R * D;
constexpr size_t O_WINP = O_KV + (size_t)R * D;
constexpr size_t O_WINS = O_WINP + (size_t)NB * 512 * 512;
constexpr size_t O_WKVP = O_WINS + (size_t)SB * 512 * 512;
constexpr size_t O_WKVS = O_WKVP + (size_t)2 * NB * H * 4096;
constexpr size_t O_SHP = O_WKVS + (size_t)2 * SB * H * 4096;
constexpr size_t O_SHS = O_SHP + (size_t)2 * NB * D;
constexpr size_t O_CVP = O_SHS + (size_t)2 * SB * D;
constexpr size_t O_CVS = O_CVP + (size_t)NLAY * NB * 2 * DFF;
constexpr size_t O_END = O_CVS + (size_t)NLAY * SB * 2 * DFF;
static_assert(O_END == 88915968, "output size");

constexpr size_t MiB = 1u << 20;
constexpr size_t al(size_t x) { return (x + 4095) & ~(size_t)4095; }
constexpr size_t WS_CTL = 0, CTL_BYTES = 1 * MiB;
constexpr size_t WS_WRKV = WS_CTL + CTL_BYTES;
constexpr size_t WS_WORW = WS_WRKV + al((size_t)2 * 3072 * 1024 * 2);
constexpr size_t WS_W1T = WS_WORW + al((size_t)2 * 1024 * 1024 * 2);
constexpr size_t WS_W2W = WS_W1T + al((size_t)2 * 288 * 1024 * 2);
constexpr size_t WS_W2A = WS_W2W + al((size_t)2 * 1024 * 64 * 2);
constexpr size_t WS_W2V = WS_W2A + al((size_t)2 * 1024 * 64 * 2);
constexpr size_t WS_W2G = WS_W2V + al((size_t)1024 * 32 * 2);
constexpr size_t WS_WKVT = WS_W2G + al((size_t)2 * 1024 * 128 * 2);
constexpr size_t WS_WQT = WS_WKVT + al((size_t)1536 * 1024 * 2);
constexpr size_t WS_WONSA = WS_WQT + al((size_t)2 * 1280 * 1024 * 2);
constexpr size_t WS_WINT = WS_WONSA + al((size_t)2 * 1024 * 1024 * 2);
constexpr size_t WS_WOUTT = WS_WINT + al((size_t)4 * 5632 * 1024 * 2);
constexpr size_t WS_CW1T = WS_WOUTT + al((size_t)4 * 1024 * 2816 * 2);
constexpr size_t WS_CBIAS = WS_CW1T + al((size_t)2 * 256 * 1024 * 2);
constexpr size_t WS_CW2T = WS_CBIAS + al(2 * 128 * 4);
constexpr size_t WS_XM = WS_CW2T + al(2 * 2 * 64 * 128 * 2);
constexpr size_t WS_RK_R = WS_XM + al((size_t)6 * R * D * 2);
constexpr size_t WS_RK_K = WS_RK_R + al((size_t)R * D * 4);
constexpr size_t WS_V0 = WS_RK_K + al((size_t)R * D * 4);
constexpr size_t WS_V1 = WS_V0 + al((size_t)R * D * 4);
constexpr size_t WS_HID = WS_V1 + al((size_t)R * D * 4);
constexpr size_t WS_MT = WS_HID + al((size_t)R * LHID * 2);
constexpr size_t WS_NN = WS_MT + al((size_t)NUNIT_A * 4096 * 4);
constexpr size_t WS_RP = WS_NN + al((size_t)NUNIT_A * 4096 * 4);
constexpr size_t WS_YL = WS_RP + al((size_t)NUNIT_A * 4096 * 2);
constexpr size_t WS_S0 = WS_YL + al((size_t)NUNIT_A * 4096 * 4);
constexpr size_t WS_RKS = WS_S0 + al((size_t)NUNIT_A * 4096 * 2);
constexpr size_t WS_YG = WS_RKS + al((size_t)R * 16 * 4);
constexpr size_t WS_XN = WS_YG + al((size_t)R * D * 2);
constexpr size_t WS_XN2 = WS_XN + al((size_t)R * D * 2);
constexpr size_t WS_U = WS_XN2 + al((size_t)R * D * 2);
constexpr size_t WS_GT = WS_U + al((size_t)R * DFF * 2);
constexpr size_t WS_HH = WS_GT + al((size_t)R * DFF * 2);
constexpr size_t WS_KVF = WS_HH + al((size_t)R * DFF * 2);
constexpr size_t WS_CMPA = WS_KVF + al((size_t)R * NKV * 4);
constexpr size_t CMPA_ROWS = 4096 + 4096 + 65536 + 65536;
constexpr size_t WS_PCMP = WS_CMPA + al(CMPA_ROWS * 1024 * 2);
constexpr size_t WS_KS = WS_PCMP + al(CMPA_ROWS * 256 * 4);
constexpr size_t WS_VS = WS_KS + al((size_t)NB * G * TP * 64 * 2);
constexpr size_t WS_KW = WS_VS + al((size_t)NB * G * TP * 64 * 2);
constexpr size_t WS_VW = WS_KW + al((size_t)NB * G * TP * 64 * 2);
constexpr size_t WS_CK = WS_VW + al((size_t)NB * G * TP * 64 * 2);
constexpr size_t WS_CV = WS_CK + al((size_t)NB * G * 512 * 64 * 2);
constexpr size_t WS_CKS = WS_CV + al((size_t)NB * G * 512 * 64 * 2);
constexpr size_t WS_CVS = WS_CKS + al((size_t)SB * G * 128 * 64 * 4);
constexpr size_t WS_QF = WS_CVS + al((size_t)SB * G * 128 * 64 * 4);
constexpr size_t WS_Q = WS_QF + al((size_t)R * NQP * 4);
constexpr size_t WS_GATE = WS_Q + al((size_t)R * D * 2);
constexpr size_t WS_END = WS_GATE + al((size_t)R * 48 * 4);

typedef __bf16 bf16v2_ __attribute__((ext_vector_type(2)));
__device__ __forceinline__ unsigned cvt_pk_bf16_(float lo, float hi) { const f32x2 v = {lo, hi}; const bf16v2_ b = __builtin_convertvector(v, bf16v2_); return __builtin_bit_cast(unsigned, b); }
__device__ __forceinline__ unsigned f2bf(float f) { return cvt_pk_bf16_(f, f) & 0xffffu; }
__device__ __forceinline__ unsigned pk2(float lo, float hi) { return cvt_pk_bf16_(lo, hi); }
__device__ __forceinline__ float frcp(float x) { return __builtin_amdgcn_rcpf(x); }
__device__ __forceinline__ float frsq(float x) { return __builtin_amdgcn_rsqf(x); }
__device__ __forceinline__ float bf2f(unsigned short b) { return __builtin_bit_cast(float, ((unsigned)b) << 16); }
__device__ __forceinline__ float bflo(unsigned w) { return __builtin_bit_cast(float, w << 16); }
__device__ __forceinline__ float bfhi(unsigned w) { return __builtin_bit_cast(float, w & 0xffff0000u); }
template <int CTRL> __device__ __forceinline__ float dpp_f(float x) { return __builtin_bit_cast(float, __builtin_amdgcn_update_dpp(0, __builtin_bit_cast(int, x), CTRL, 0xF, 0xF, true)); }
__device__ __forceinline__ float row16_sum(float v) { v += dpp_f<0xB1>(v); v += dpp_f<0x4E>(v); v += dpp_f<0x141>(v); v += dpp_f<0x140>(v); return v; }
__device__ __forceinline__ float row16_max(float v) { v = fmaxf(v, dpp_f<0xB1>(v)); v = fmaxf(v, dpp_f<0x4E>(v)); v = fmaxf(v, dpp_f<0x141>(v)); v = fmaxf(v, dpp_f<0x140>(v)); return v; }
__device__ __forceinline__ float swz_xor16_n(float x) { return __builtin_bit_cast(float, __builtin_amdgcn_ds_swizzle(__builtin_bit_cast(int, x), 0x401F)); }
__device__ __forceinline__ float sum_xor32_n(float x) { auto rr = __builtin_amdgcn_permlane32_swap(__float_as_uint(x), __float_as_uint(x), false, false);
    return __uint_as_float(rr[0]) + __uint_as_float(rr[1]); }
__device__ __forceinline__ float sum_rows4_n(float x) { x += swz_xor16_n(x); return sum_xor32_n(x); }
__device__ __forceinline__ float wave_sum_n(float v) {
    v = row16_sum(v);
    v += __builtin_bit_cast(float, __builtin_amdgcn_update_dpp(0, __builtin_bit_cast(int, v), 0x142, 0xA, 0xF, false));
    v += __builtin_bit_cast(float, __builtin_amdgcn_update_dpp(0, __builtin_bit_cast(int, v), 0x143, 0xC, 0xF, false));
    return __builtin_bit_cast(float, __builtin_amdgcn_readlane(__builtin_bit_cast(int, v), 63));
}
__device__ __forceinline__ float wave_max_n(float v) {
    v = row16_max(v);
    v = fmaxf(v, __builtin_bit_cast(float, __builtin_amdgcn_update_dpp(__builtin_bit_cast(int, v), __builtin_bit_cast(int, v), 0x142, 0xA, 0xF, false)));
    v = fmaxf(v, __builtin_bit_cast(float, __builtin_amdgcn_update_dpp(__builtin_bit_cast(int, v), __builtin_bit_cast(int, v), 0x143, 0xC, 0xF, false)));
    return __builtin_bit_cast(float, __builtin_amdgcn_readlane(__builtin_bit_cast(int, v), 63));
}
#define XLANE_NEW 1
#ifdef XLANE_NEW
__device__ __forceinline__ float swz_xor16(float x) { return __builtin_bit_cast(float, __builtin_amdgcn_ds_swizzle(__builtin_bit_cast(int, x), 0x401F)); }
__device__ __forceinline__ float sum_xor32(float x) { return sum_xor32_n(x); }
__device__ __forceinline__ float sum_rows4(float x) { x += swz_xor16(x); return sum_xor32(x); }
__device__ __forceinline__ float wave_sum(float v) {
    v = row16_sum(v);
    v += __builtin_bit_cast(float, __builtin_amdgcn_update_dpp(0, __builtin_bit_cast(int, v), 0x142, 0xA, 0xF, false));
    v += __builtin_bit_cast(float, __builtin_amdgcn_update_dpp(0, __builtin_bit_cast(int, v), 0x143, 0xC, 0xF, false));
    return __builtin_bit_cast(float, __builtin_amdgcn_readlane(__builtin_bit_cast(int, v), 63));
}
__device__ __forceinline__ float wave_max(float v) {
    v = row16_max(v);
    v = fmaxf(v, __builtin_bit_cast(float, __builtin_amdgcn_update_dpp(__builtin_bit_cast(int, v), __builtin_bit_cast(int, v), 0x142, 0xA, 0xF, false)));
    v = fmaxf(v, __builtin_bit_cast(float, __builtin_amdgcn_update_dpp(__builtin_bit_cast(int, v), __builtin_bit_cast(int, v), 0x143, 0xC, 0xF, false)));
    return __builtin_bit_cast(float, __builtin_amdgcn_readlane(__builtin_bit_cast(int, v), 63));
}
#else
__device__ __forceinline__ float sum_xor32(float x) { return x + __shfl_xor(x, 32); }
__device__ __forceinline__ float sum_rows4(float x) { x += __shfl_xor(x, 16); x += __shfl_xor(x, 32); return x; }
__device__ __forceinline__ float wave_sum(float v) { v = row16_sum(v); v += __shfl_xor(v, 16); v += __shfl_xor(v, 32); return v; }
__device__ __forceinline__ float wave_max(float v) { v = row16_max(v); v = fmaxf(v, __shfl_xor(v, 16)); v = fmaxf(v, __shfl_xor(v, 32)); return v; }
#endif
__device__ __forceinline__ float sigmoidf_(float x) { return frcp(1.0f + __builtin_amdgcn_exp2f(-1.4426950408889634f * x)); }
__device__ __forceinline__ float gelu_tanh(float x) {
    const float u = 0.7978845608028654f * (x + 0.044715f * x * x * x);
    const float e = __builtin_amdgcn_exp2f(2.8853900817779268f * u);
    const float th = 1.0f - 2.0f * frcp(e + 1.0f);
    return 0.5f * x * (1.0f + th);
}
template <class T> __device__ __forceinline__ const T* launder_p(const T* q) { asm volatile("" : "+v"(q)); return q; }
__device__ __forceinline__ int launder_v(int x) { asm volatile("" : "+v"(x)); return x; }
#define LDS_WAIT() asm volatile("s_waitcnt lgkmcnt(0)" ::: "memory")
#define VM_WAIT() asm volatile("s_waitcnt vmcnt(0)" ::: "memory")
__device__ __forceinline__ f32x4 mfma16(bf16x8 a, bf16x8 b, f32x4 c) { return __builtin_amdgcn_mfma_f32_16x16x32_bf16(a, b, c, 0, 0, 0); }
__device__ __forceinline__ f32x16 mfma32(bf16x8 a, bf16x8 b, f32x16 c) { return __builtin_amdgcn_mfma_f32_32x32x16_bf16(a, b, c, 0, 0, 0); }
#define XB_TMO      128
#define XB_XCNT(j)  (256  + 64 * (j))
#define XB_XSUB(j)  (1280 + 64 * (j))
#define XB_XGEN(j)  (2304 + 64 * (j))
#define XB_TOP      3328
#define XB_TOPGEN   3392
#define XCD_BAR_WORDS 3456
#define XB_SPIN_CAP (1u << 18)

__device__ __forceinline__ unsigned xb_ld(unsigned* p)              { return __hip_atomic_load(p, __ATOMIC_RELAXED, __HIP_MEMORY_SCOPE_AGENT); }
__device__ __forceinline__ unsigned xb_add(unsigned* p, unsigned v) { return __hip_atomic_fetch_add(p, v, __ATOMIC_RELAXED, __HIP_MEMORY_SCOPE_AGENT); }
__device__ __forceinline__ unsigned xb_xcc_id() { return (unsigned)__builtin_amdgcn_s_getreg((3 << 11) | 20) & 0xFu; }
#define XB_SPIN(cond, bar) do { unsigned _sp = 0; while (cond) { __builtin_amdgcn_s_sleep(1); \
    if ((++_sp & 255u) == 0u) { if (xb_ld(&(bar)[XB_TMO])) break; if (_sp > XB_SPIN_CAP) { atomicAdd(&(bar)[XB_TMO], 1u); break; } } } } while (0)

struct XcdBarrier {
    unsigned* bar; unsigned x;
    volatile LAS unsigned* st;
};

__device__ __forceinline__ XcdBarrier xcd_barrier_post(unsigned* bar, volatile LAS unsigned* st) {
    XcdBarrier b; b.bar = bar; b.x = xb_xcc_id(); b.st = st;
    if (threadIdx.x == 0) (void)xb_add(&bar[XB_XCNT(b.x)], 1u);
    return b;
}
__device__ __forceinline__ void xcd_barrier_complete(unsigned* bar, unsigned x, unsigned& nloc, unsigned& nx) {
    const unsigned G = gridDim.x * gridDim.y * gridDim.z;
    unsigned sum, cnt, mine, sp = 0u;
    for (;;) {
        sum = 0u; cnt = 0u; mine = 0u;
#pragma unroll
        for (unsigned j = 0; j < 16; ++j) { const unsigned c = xb_ld(&bar[XB_XCNT(j)]); sum += c; cnt += (c > 0u) ? 1u : 0u; mine = (j == x) ? c : mine; }
        if (sum == G) break;
        __builtin_amdgcn_s_sleep(1);
        if ((++sp & 255u) == 0u) { if (xb_ld(&bar[XB_TMO])) break; if (sp > XB_SPIN_CAP) { atomicAdd(&bar[XB_TMO], 1u); break; } }
    }
    nloc = mine > 0u ? mine : 1u; nx = cnt > 0u ? cnt : 1u;
}

__device__ __forceinline__ void xcd_barrier(const XcdBarrier& b, const bool t0) {
    asm volatile("s_waitcnt vmcnt(0)" ::: "memory");
    __syncthreads();
    if (t0) {
        unsigned* bar = b.bar;
        __builtin_amdgcn_s_waitcnt(0);
        unsigned nloc = b.st[0], nx = b.st[1];
        if (nloc == 0u) { xcd_barrier_complete(bar, b.x, nloc, nx); b.st[0] = nloc; b.st[1] = nx; }
        const unsigned old = xb_add(&bar[XB_XSUB(b.x)], 1u);
        const unsigned gen = old / nloc;
        if (old + 1u == (gen + 1u) * nloc) {
            __builtin_amdgcn_fence(__ATOMIC_RELEASE, "agent");
            asm volatile("s_waitcnt vmcnt(0)" ::: "memory");
            const unsigned og = xb_add(&bar[XB_TOP], 1u);
            const unsigned tg = og / nx;
            if (og + 1u == (tg + 1u) * nx) xb_add(&bar[XB_TOPGEN], 1u);
            else XB_SPIN(xb_ld(&bar[XB_TOPGEN]) == tg, bar);
            __builtin_amdgcn_fence(__ATOMIC_ACQUIRE, "agent");
            xb_add(&bar[XB_XGEN(b.x)], 1u);
            asm volatile("s_waitcnt vmcnt(0)" ::: "memory");
        } else {
            XB_SPIN(xb_ld(&bar[XB_XGEN(b.x)]) == gen, bar);
            __builtin_amdgcn_fence(__ATOMIC_ACQUIRE, "agent");
            asm volatile("s_waitcnt vmcnt(0)" ::: "memory");
        }
    }
    __syncthreads();
}

namespace pg8 {
#define PG8_LAS __attribute__((address_space(3)))
constexpr int BM = 256, BK = 64, HALF = 128, HTB = HALF * BK * 2  , STAGE_BYTES = 8 * HTB, NXCD = 8, WGM = 8;
__host__ __device__ __forceinline__ int lds_byte(int r, int c) { const int st = (r >> 4) * 2 + (c >> 5), rr = r & 15, cc = c & 31, ob = rr * 64 + cc * 2; return st * 1024 + (ob ^ (((ob >> 9) & 1) << 5)); }
__host__ __device__ __forceinline__ void stage_rc(int b, int& R_, int& C_) { const int st = b / 1024, sb = b % 1024, swz = sb ^ (((sb >> 9) & 1) << 5); R_ = (st >> 1) * 16 + swz / 64; C_ = (st & 1) * 32 + (swz % 64) / 2; }
__host__ __device__ __forceinline__ int perm32(int rho) { const int n = rho >> 4, i = rho & 15; return 8 * (i >> 2) + 4 * n + (i & 3); }

struct Unit { int pm, pn, kb, nt; };
struct Gemm { const bf16_t* A; const bf16_t* Bt; int M, N, K, KL; };

struct GroupOrder {
    int pm0[4], nM[4], pn0[4], nN[4]; int nseg, nwg, G_, c;
    __device__ __forceinline__ void init(int G__, int c_) { nseg = 0; nwg = 0; G_ = G__; c = c_;
#pragma unroll
        for (int s = 0; s < 4; ++s) { pm0[s] = 0; nM[s] = 0; pn0[s] = 0; nN[s] = 1; } }
    __device__ __forceinline__ void add(int s, int pm0_, int nM_, int pn0_, int nN_) { pm0[s] = pm0_; nM[s] = nM_; pn0[s] = pn0_; nN[s] = nN_; nwg += nM_ * nN_; nseg = s + 1; }
    __device__ __forceinline__ bool next(int i, Unit& u) const {
        const long L = (long)i * G_ + c; if (L >= nwg) return false;
        int id = (int)L; { const int q = nwg / NXCD, r = nwg % NXCD, xcd = id % NXCD, off = id / NXCD; id = (xcd < r ? xcd * (q + 1) : r * (q + 1) + (xcd - r) * q) + off; }
        int spm0 = 0, snM = 1, spn0 = 0, snN = 1; bool found = false;
#pragma unroll
        for (int s = 0; s < 4; ++s) { const int cnt = nM[s] * nN[s]; if (!found) { if (id < cnt) { found = true; spm0 = pm0[s]; snM = nM[s]; spn0 = pn0[s]; snN = nN[s]; } else id -= cnt; } }
        const int nig = WGM * snN, gid = id / nig, fm = gid * WGM, gsz = (snM - fm) < WGM ? (snM - fm) : WGM;
        u.pm = spm0 + fm + ((id % nig) % gsz); u.pn = spn0 + (id % nig) / gsz; u.kb = 0; u.nt = 0; return true;
    }
    __device__ __forceinline__ void a_ready(const Unit&) const {}
    __device__ __forceinline__ void done(const Unit&) const {}
};

struct ResidOrder {
    GroupOrder P; int nS, G_, c;
    __device__ __forceinline__ void init(int G__, int c_, int nS_) { P.init(G__, c_); P.add(0, 0, nS_ ? 64 : 66, 0, 4); nS = nS_; G_ = G__; c = c_; }
    __device__ __forceinline__ bool next(int i, Unit& u) const {
        const int npc = c < P.nwg ? (P.nwg - 1 - c) / G_ + 1 : 0;
        if (i < npc) return P.next(i, u);
        const int L = (i - npc) * G_ + (G_ - 1 - c); if (L >= 8 * nS) return false;
        const int sl = L >> 3, t = L & 7; u.pm = 64 + (t & 1); u.pn = t >> 1; u.kb = sl * 512; u.nt = 4; return true; }
    __device__ __forceinline__ void a_ready(const Unit&) const {}
    __device__ __forceinline__ void done(const Unit&) const {}
};
__device__ __forceinline__ unsigned cvt_pk_bf16(float lo, float hi) { return cvt_pk_bf16_(lo, hi); }

struct EpiF32G {
    static constexpr bool PERM = false, AFTER_DRAIN = false;
    float* b0; float* b1; float* b2; float* b3; int ldc, png, pmg;
    __device__ __forceinline__ void operator()(const f32x4 (&acc)[2][2][4][2], const Unit& u, int wr, int wc, int fr, int fq) const {
        const int j = u.pn / png; float* C = j == 0 ? b0 : (j == 1 ? b1 : (j == 2 ? b2 : b3));
        const int row0 = (u.pm - j * pmg) * BM + wr * 64 + fr, col0 = (u.pn - j * png) * BM + wc * 32 + 4 * fq;
#pragma unroll
        for (int ai = 0; ai < 2; ++ai)
#pragma unroll
            for (int m = 0; m < 4; ++m) { float* rowp = C + (size_t)(row0 + ai * HALF + m * 16) * ldc + col0;
#pragma unroll
                for (int bj = 0; bj < 2; ++bj)
#pragma unroll
                    for (int n = 0; n < 2; ++n) *(f32x4*)(rowp + bj * HALF + n * 16) = acc[ai][bj][m][n]; }
    }
};
struct EpiResid {
    static constexpr bool PERM = false, AFTER_DRAIN = false;
    float* X; int ldc;
    __device__ __forceinline__ void operator()(const f32x4 (&acc)[2][2][4][2], const Unit& u, int wr, int wc, int fr, int fq) const {
        const int row0 = u.pm * BM + wr * 64 + fr, col0 = u.pn * BM + wc * 32 + 4 * fq; const bool split = u.nt != 0;
#pragma unroll
        for (int ai = 0; ai < 2; ++ai)
#pragma unroll
            for (int m = 0; m < 4; ++m) { float* rowp = X + (size_t)(row0 + ai * HALF + m * 16) * ldc + col0;
                if (!split) {
#pragma unroll
                    for (int bj = 0; bj < 2; ++bj)
#pragma unroll
                        for (int n = 0; n < 2; ++n) { f32x4* p = (f32x4*)(rowp + bj * HALF + n * 16); *p = *p + acc[ai][bj][m][n]; } }
                else {
#pragma unroll
                    for (int bj = 0; bj < 2; ++bj)
#pragma unroll
                        for (int n = 0; n < 2; ++n) { float* q = rowp + bj * HALF + n * 16;
#pragma unroll
                            for (int e = 0; e < 4; ++e) __hip_atomic_fetch_add(q + e, acc[ai][bj][m][n][e], __ATOMIC_RELAXED, __HIP_MEMORY_SCOPE_AGENT); } }
                asm volatile("" ::: "memory"); }
    }
};
struct EpiWin {
    static constexpr bool PERM = true, AFTER_DRAIN = false;
    bf16_t* U; bf16_t* GT; float* cvp; float* cvs;
    __device__ __forceinline__ void operator()(const f32x4 (&acc)[2][2][4][2], const Unit& u, int wr, int wc, int fr, int fq) const {
        const bool isu = u.pn < 11; bf16_t* base = isu ? U : GT; const int colt = (isu ? u.pn : u.pn - 11) * BM;
        const int row0 = u.pm * BM + wr * 64 + fr, col0 = colt + wc * 32 + 8 * fq;
#pragma unroll
        for (int ai = 0; ai < 2; ++ai)
#pragma unroll
            for (int m = 0; m < 4; ++m) { const int row = row0 + ai * HALF + m * 16; bf16_t* rowp = base + (size_t)row * DFF + col0;
                float* cv = nullptr;
                if (isu) { if (row >= MP) { const int t = (row - MP) & 3, b = (row - MP) >> 2; if (t >= 2) cv = cvs + (size_t)(b * 2 + (t - 2)) * DFF; }
                           else { const int tt = row & (TP - 1); if (tt >= TP - 2) cv = cvp + (size_t)((row >> 13) * 2 + (tt - (TP - 2))) * DFF; } }
#pragma unroll
                for (int bj = 0; bj < 2; ++bj) { const f32x4 v0 = acc[ai][bj][m][0], v1 = acc[ai][bj][m][1];
                    u32x4 w; w.x = cvt_pk_bf16(v0[0], v0[1]); w.y = cvt_pk_bf16(v0[2], v0[3]); w.z = cvt_pk_bf16(v1[0], v1[1]); w.w = cvt_pk_bf16(v1[2], v1[3]);
                    *(u32x4*)(rowp + bj * HALF) = w;
                    if (cv) { *(f32x4*)(cv + col0 + bj * HALF) = v0; *(f32x4*)(cv + col0 + bj * HALF + 4) = v1; } } }
    }
};
template <class Epi, class Sched, bool ALIGN_EPI = false, bool SP2 = false>
__device__ __forceinline__ void gemm_phase(PG8_LAS unsigned char* lds, const Gemm g, const Sched& S, const Epi& E, int tid_in) {
    int tid_l = tid_in; asm volatile("" : "+v"(tid_l));
    const int tid = tid_l, wid = __builtin_amdgcn_readfirstlane(tid >> 6), lane = tid & 63, wr = wid >> 2, wc = wid & 3, fr = lane & 15, fq = lane >> 4;
    const int K = g.K, nt = g.KL / BK;
    unsigned voffA[2], voffB[2];
#pragma unroll
    for (int i = 0; i < 2; ++i) { int R, C; stage_rc(tid * 16 + i * 8192, R, C); const int Rb = Epi::PERM ? ((R & ~31) + perm32(R & 31)) : R;
        voffA[i] = (unsigned)(R * K + C) * 2u; voffB[i] = (unsigned)(Rb * K + C) * 2u; }
    const size_t kstep = (size_t)(BK * 2);
    const size_t hstep = (size_t)HALF * K * 2;
    const size_t tstep = 2 * hstep;
    const unsigned ldsw = (unsigned)wid * 1024u;
    const int aoff = lds_byte(wr * 64 + fr, fq * 8), boff = lds_byte(wc * 32 + fr, fq * 8);
#define PG8_SA(b, h) (((b) * 2 + (h)) * HTB)
#define PG8_SB(b, h) ((4 + (b) * 2 + (h)) * HTB)
#define PG8_STAGE(bufoff, gbase, voff) do { _Pragma("unroll") for (int _i = 0; _i < 2; ++_i) \
        __builtin_amdgcn_global_load_lds((const unsigned*)((const char*)(gbase) + (voff)[_i]), (PG8_LAS unsigned*)(lds + (bufoff) + ldsw + _i * 8192), 16, 0, 0); } while (0)
#define PG8_LDA(dst, b, h) do { _Pragma("unroll") for (int m = 0; m < 4; ++m) _Pragma("unroll") for (int k = 0; k < 2; ++k) dst[m][k] = *(const PG8_LAS bf16x8*)(lds + PG8_SA(b, h) + aoff + m * 2048 + k * 1024); } while (0)
#define PG8_LDB(dst, b, h) do { _Pragma("unroll") for (int n = 0; n < 2; ++n) _Pragma("unroll") for (int k = 0; k < 2; ++k) dst[n][k] = *(const PG8_LAS bf16x8*)(lds + PG8_SB(b, h) + boff + n * 2048 + k * 1024); } while (0)
#define PG8_MMA(ai, bj, At, Bt) do { __builtin_amdgcn_s_setprio(1); _Pragma("unroll") for (int m = 0; m < 4; ++m) _Pragma("unroll") for (int n = 0; n < 2; ++n) _Pragma("unroll") for (int k = 0; k < 2; ++k) \
        acc[ai][bj][m][n] = __builtin_amdgcn_mfma_f32_16x16x32_bf16(Bt[n][k], At[m][k], acc[ai][bj][m][n], 0, 0, 0); __builtin_amdgcn_s_setprio(0); } while (0)
#define PG8_WAIT_V(n) asm volatile("s_waitcnt vmcnt(" #n ")" ::: "memory")
#define PG8_WAIT_L(n) asm volatile("s_waitcnt lgkmcnt(" #n ")" ::: "memory")
#define PG8_BAR __builtin_amdgcn_s_barrier()
#define PG8_SCHED __builtin_amdgcn_sched_barrier(0)
    Unit cur, nxt; int ui = 0;
    if (!S.next(0, cur)) return;
    f32x4 acc[2][2][4][2];
#pragma unroll
    for (int a = 0; a < 2; ++a)
#pragma unroll
        for (int b = 0; b < 2; ++b)
#pragma unroll
            for (int m = 0; m < 4; ++m)
#pragma unroll
                for (int n = 0; n < 2; ++n) acc[a][b][m][n] = (f32x4){0.f, 0.f, 0.f, 0.f};
    bf16x8 At[4][2], B0[2][2], B1[2][2];
    const char* cA = (const char*)g.A + (size_t)cur.pm * tstep + cur.kb; const char* cB = (const char*)g.Bt + (size_t)cur.pn * tstep + cur.kb;
    S.a_ready(cur);
    if constexpr (SP2) {
        PG8_STAGE(PG8_SB(0, 0), cB, voffB); PG8_STAGE(PG8_SB(0, 1), cB + hstep, voffB); PG8_STAGE(PG8_SA(0, 0), cA, voffA); PG8_STAGE(PG8_SA(0, 1), cA + hstep, voffA);
        if (wr == 1) PG8_BAR;
        PG8_WAIT_V(2); PG8_BAR;
        PG8_STAGE(PG8_SB(1, 0), cB + kstep, voffB); PG8_STAGE(PG8_SA(1, 0), cA + kstep, voffA); PG8_STAGE(PG8_SB(1, 1), cB + hstep + kstep, voffB);
        PG8_WAIT_V(6); PG8_BAR;
    } else {
        PG8_STAGE(PG8_SB(0, 0), cB, voffB); PG8_STAGE(PG8_SA(0, 0), cA, voffA); PG8_STAGE(PG8_SB(0, 1), cB + hstep, voffB); PG8_STAGE(PG8_SA(0, 1), cA + hstep, voffA);
        if (wr == 1) PG8_BAR;
        PG8_WAIT_V(4); PG8_BAR;
        PG8_STAGE(PG8_SB(1, 0), cB + kstep, voffB); PG8_STAGE(PG8_SA(1, 0), cA + kstep, voffA); PG8_STAGE(PG8_SB(1, 1), cB + hstep + kstep, voffB);
        PG8_WAIT_V(6); PG8_BAR;
    }
    for (;;) {
        const bool has_next = S.next(ui + 1, nxt);
        const char* nA = has_next ? (const char*)g.A + (size_t)nxt.pm * tstep + nxt.kb : cA; const char* nB = has_next ? (const char*)g.Bt + (size_t)nxt.pn * tstep + nxt.kb : cB;
        const int ntu = cur.nt ? cur.nt : nt;
        for (int t = 0; t < ntu; t += 2) {
            const bool last = (t == ntu - 2);
            const char* a1 = cA + (size_t)(t + 1) * kstep;
            const char* a2 = last ? nA : cA + (size_t)(t + 2) * kstep; const char* b2 = last ? nB : cB + (size_t)(t + 2) * kstep;
            const char* a3 = a2 + kstep; const char* b3 = b2 + kstep;
            if (last && has_next) S.a_ready(nxt);
            if constexpr (SP2) {
            PG8_LDB(B0, 0, 0); PG8_LDB(B1, 0, 1); PG8_SCHED; PG8_LDA(At, 0, 0); PG8_STAGE(PG8_SA(1, 1), a1 + hstep, voffA);
            PG8_WAIT_V(8); PG8_WAIT_L(0); PG8_BAR; PG8_MMA(0, 0, At, B0); PG8_MMA(0, 1, At, B1); PG8_BAR; PG8_SCHED;
            PG8_LDA(At, 0, 1); PG8_STAGE(PG8_SB(0, 0), b2, voffB); PG8_STAGE(PG8_SB(0, 1), b2 + hstep, voffB); PG8_STAGE(PG8_SA(0, 0), a2, voffA);
            PG8_WAIT_V(8); PG8_WAIT_L(0); PG8_BAR; PG8_MMA(1, 0, At, B0); PG8_MMA(1, 1, At, B1); PG8_BAR; PG8_SCHED;
            PG8_LDB(B0, 1, 0); PG8_LDB(B1, 1, 1); PG8_SCHED; PG8_LDA(At, 1, 0); PG8_STAGE(PG8_SA(0, 1), a2 + hstep, voffA);
            PG8_WAIT_V(8); PG8_WAIT_L(0); PG8_BAR; PG8_MMA(0, 0, At, B0); PG8_MMA(0, 1, At, B1); PG8_BAR; PG8_SCHED;
            PG8_LDA(At, 1, 1); PG8_STAGE(PG8_SB(1, 0), b3, voffB); PG8_STAGE(PG8_SB(1, 1), b3 + hstep, voffB); PG8_STAGE(PG8_SA(1, 0), a3, voffA);
            PG8_WAIT_V(8); PG8_WAIT_L(0); PG8_BAR; PG8_MMA(1, 0, At, B0); PG8_MMA(1, 1, At, B1); PG8_BAR; PG8_SCHED;
            } else {
            PG8_LDB(B0, 0, 0); PG8_SCHED; PG8_LDA(At, 0, 0); PG8_STAGE(PG8_SA(1, 1), a1 + hstep, voffA);
            PG8_WAIT_L(8); PG8_BAR; PG8_WAIT_L(0); PG8_MMA(0, 0, At, B0); PG8_BAR; PG8_SCHED;
            PG8_LDB(B1, 0, 1); PG8_STAGE(PG8_SB(0, 0), b2, voffB);
            PG8_BAR; PG8_WAIT_L(0); PG8_MMA(0, 1, At, B1); PG8_BAR;
            PG8_LDA(At, 0, 1); PG8_STAGE(PG8_SA(0, 0), a2, voffA);
            PG8_BAR; PG8_WAIT_L(0); PG8_MMA(1, 0, At, B0); PG8_BAR; PG8_SCHED;
            PG8_STAGE(PG8_SB(0, 1), b2 + hstep, voffB);
            PG8_WAIT_V(6); PG8_BAR; PG8_MMA(1, 1, At, B1); PG8_BAR;
            PG8_LDB(B0, 1, 0); PG8_SCHED; PG8_LDA(At, 1, 0); PG8_STAGE(PG8_SA(0, 1), a2 + hstep, voffA);
            PG8_WAIT_L(8); PG8_BAR; PG8_WAIT_L(0); PG8_MMA(0, 0, At, B0); PG8_BAR; PG8_SCHED;
            PG8_LDB(B1, 1, 1); PG8_STAGE(PG8_SB(1, 0), b3, voffB);
            PG8_BAR; PG8_WAIT_L(0); PG8_MMA(0, 1, At, B1); PG8_BAR;
            PG8_LDA(At, 1, 1); PG8_STAGE(PG8_SA(1, 0), a3, voffA);
            PG8_BAR; PG8_WAIT_L(0); PG8_MMA(1, 0, At, B0); PG8_BAR; PG8_SCHED;
            PG8_STAGE(PG8_SB(1, 1), b3 + hstep, voffB);
            PG8_WAIT_V(6); PG8_BAR; PG8_MMA(1, 1, At, B1); PG8_BAR;
            }
        }
        if constexpr (ALIGN_EPI) { if (wr == 0) PG8_BAR; }
        if constexpr (!Epi::AFTER_DRAIN) { E(acc, cur, wr, wc, fr, fq); S.done(cur); }
        if (!has_next) break;
#pragma unroll
        for (int a = 0; a < 2; ++a)
#pragma unroll
            for (int b = 0; b < 2; ++b)
#pragma unroll
                for (int m = 0; m < 4; ++m)
#pragma unroll
                    for (int n = 0; n < 2; ++n) acc[a][b][m][n] = (f32x4){0.f, 0.f, 0.f, 0.f};
        cur = nxt; cA = nA; cB = nB; ++ui;
        if constexpr (ALIGN_EPI) { if (wr == 1) PG8_BAR; }
    }
    PG8_WAIT_V(0);
    if constexpr (!ALIGN_EPI) { if (wr == 0) PG8_BAR; }
    PG8_BAR;
    if constexpr (Epi::AFTER_DRAIN) { E.fused(acc, cur, wr, wc, fr, fq, lds, wid, lane); S.done(cur); }
#undef PG8_SA
#undef PG8_SB
#undef PG8_STAGE
#undef PG8_LDA
#undef PG8_LDB
#undef PG8_MMA
#undef PG8_WAIT_V
#undef PG8_WAIT_L
#undef PG8_BAR
#undef PG8_SCHED
}
}
constexpr int RING_BYTES = 131072, MISC_OFF = RING_BYTES + 320, LDS_BYTES = 147456;
struct Params { const float* in[45]; float* out; unsigned char* ws; int ph_lo, ph_hi, use_bar, pad; };
enum { I_XP = 0, I_XS, I_CKV, I_CWIN, I_SWKV, I_SSHIFT, I_SCONV, I_PT, I_NORMG, I_MU, I_WR, I_WK, I_WV, I_WO, I_W0, I_W1, I_W2, I_A0, I_A1, I_A2, I_V0, I_V1, I_V2, I_G1, I_G2,
       I_KK, I_KA, I_RKK, I_LNW, I_LNB, I_KVNG, I_WKV, I_KNG, I_PE, I_CW1, I_CB1, I_CW2, I_CB2, I_WQ, I_QNG, I_WONSA, I_WIN, I_CONVW, I_CONVB, I_WOUT };

typedef const __attribute__((address_space(4))) Params* KP;
struct Ctx { LAS unsigned char* lds; int tid, lane, wave, gw, ngw, gtid, gsz; };

__device__ __forceinline__ void p0_transpose_item(const float* W, int K, int ldw, int nblk, bf16_t* WT, int row_off, LAS float* scr, int item, int lane) {
    const int kb = item / nblk, nb = item % nblk, k0 = 64 * kb, n0 = 32 * nb;
#pragma unroll 8
    for (int i = 0; i < 32; ++i) { const int kk = 2 * i + (lane >> 5); scr[kk * 33 + (lane & 31)] = W[(size_t)(k0 + kk) * ldw + n0 + (lane & 31)]; }
    LDS_WAIT(); asm volatile("" ::: "memory");
    const int c = lane & 7;
#pragma unroll
    for (int j = 0; j < 4; ++j) { const int n = (lane >> 3) + 8 * j; const LAS float* s = scr + (8 * c) * 33 + n;
        u32x4 o; o.x = pk2(s[0 * 33], s[1 * 33]); o.y = pk2(s[2 * 33], s[3 * 33]); o.z = pk2(s[4 * 33], s[5 * 33]); o.w = pk2(s[6 * 33], s[7 * 33]);
        *(u32x4*)(WT + (size_t)(row_off + n0 + n) * K + k0 + 8 * c) = o; }
    LDS_WAIT(); asm volatile("" ::: "memory");
}

__device__ __forceinline__ void phase_prologue(KP p, const Ctx& c) {
    LAS float* scr = (LAS float*)(c.lds + c.wave * 16384);
    unsigned char* ws = p->ws;
    int total = 0;
#define TRCNT(K_, N_) (((K_) / 64) * ((N_) / 32))
    constexpr int C_DD = TRCNT(1024, 1024), C_L64 = TRCNT(1024, 64), C_L32 = TRCNT(1024, 32), C_L128 = TRCNT(1024, 128), C_2_64 = TRCNT(64, 1024), C_2_128 = TRCNT(128, 1024);
    constexpr int C_KV = TRCNT(1024, 1536), C_Q = 16 * 33, C_IN = TRCNT(1024, 5632), C_OUT = TRCNT(2816, 1024), C_CW = TRCNT(1024, 128);
    constexpr int NITEMS = 2 * (4 * C_DD + 2 * C_L64 + C_L128 + 2 * C_2_64 + C_2_128) + C_L32 + C_KV + 2 * C_Q + 2 * C_DD + 4 * C_IN + 4 * C_OUT + 4 * C_CW;
    (void)total;
    for (int it = c.gw; it < NITEMS; it += c.ngw) {
        int r = it;
#define TR(Wp, K_, LDW_, NBLK_, WTp, ROWOFF_) { const int cnt_ = ((K_) / 64) * (NBLK_); if (r < cnt_) { p0_transpose_item((Wp), (K_), (LDW_), (NBLK_), (bf16_t*)(WTp), (ROWOFF_), scr, r, c.lane); continue; } r -= cnt_; }
        bool done = false;
#pragma unroll
        for (int l = 0; l < 2; ++l) {
            if (done) break;
            const size_t dd = (size_t)l * 1024 * 1024;
#define TRL(Wp, K_, LDW_, NBLK_, WTp, ROWOFF_) { const int cnt_ = ((K_) / 64) * (NBLK_); if (!done) { if (r < cnt_) { p0_transpose_item((Wp), (K_), (LDW_), (NBLK_), (bf16_t*)(WTp), (ROWOFF_), scr, r, c.lane); done = true; } else r -= cnt_; } }
            TRL(p->in[I_WR] + dd, 1024, 1024, 32, ws + WS_WRKV + (size_t)l * 3072 * 1024 * 2, 0)
            TRL(p->in[I_WK] + dd, 1024, 1024, 32, ws + WS_WRKV + (size_t)l * 3072 * 1024 * 2, 1024)
            TRL(p->in[I_WV] + dd, 1024, 1024, 32, ws + WS_WRKV + (size_t)l * 3072 * 1024 * 2, 2048)
            TRL(p->in[I_WO] + dd, 1024, 1024, 32, ws + WS_WORW + (size_t)l * 1024 * 1024 * 2, 0)
            TRL(p->in[I_W1] + (size_t)l * 1024 * 64, 1024, 64, 2, ws + WS_W1T + (size_t)l * 288 * 1024 * 2, 0)
            TRL(p->in[I_A1] + (size_t)l * 1024 * 64, 1024, 64, 2, ws + WS_W1T + (size_t)l * 288 * 1024 * 2, 64)
            TRL(p->in[I_G1] + (size_t)l * 1024 * 128, 1024, 128, 4, ws + WS_W1T + (size_t)l * 288 * 1024 * 2, 160)
            TRL(p->in[I_W2] + (size_t)l * 64 * 1024, 64, 1024, 32, ws + WS_W2W + (size_t)l * 1024 * 64 * 2, 0)
            TRL(p->in[I_A2] + (size_t)l * 64 * 1024, 64, 1024, 32, ws + WS_W2A + (size_t)l * 1024 * 64 * 2, 0)
            TRL(p->in[I_G2] + (size_t)l * 128 * 1024, 128, 1024, 32, ws + WS_W2G + (size_t)l * 1024 * 128 * 2, 0)
        }
        if (done) continue;
        TR(p->in[I_V1], 1024, 32, 1, ws + WS_W1T + (size_t)1 * 288 * 1024 * 2, 128)
        TR(p->in[I_WKV], 1024, 1536, 48, ws + WS_WKVT, 0)
        TR(p->in[I_WQ], 1024, NQ, 33, ws + WS_WQT, 0)
        TR(p->in[I_WQ] + (size_t)1024 * NQ, 1024, NQ, 33, ws + WS_WQT + (size_t)NQP * 1024 * 2, 0)
        TR(p->in[I_WONSA], 1024, 1024, 32, ws + WS_WONSA, 0)
        TR(p->in[I_WONSA] + (size_t)1024 * 1024, 1024, 1024, 32, ws + WS_WONSA + (size_t)1024 * 1024 * 2, 0)
#pragma unroll
        for (int l = 0; l < 4; ++l) {
            if (done) break;
            TRL(p->in[I_WIN] + (size_t)l * 1024 * 5632, 1024, 5632, 176, ws + WS_WINT + (size_t)l * 5632 * 1024 * 2, 0)
            TRL(p->in[I_WOUT] + (size_t)l * 2816 * 1024, 2816, 1024, 32, ws + WS_WOUTT + (size_t)l * 1024 * 2816 * 2, 0)
        }
        if (done) continue;
        TR(p->in[I_CW1], 1024, 128, 4, ws + WS_CW1T, 0)
        TR(p->in[I_CW1] + (size_t)1024 * 128, 1024, 128, 4, ws + WS_CW1T, 128)
        TR(p->in[I_CW1] + (size_t)2048 * 128, 1024, 128, 4, ws + WS_CW1T + (size_t)256 * 1024 * 2, 0)
        TR(p->in[I_CW1] + (size_t)3072 * 128, 1024, 128, 4, ws + WS_CW1T + (size_t)256 * 1024 * 2, 128)
#undef TR
#undef TRL
    }
    {
        bf16_t* WQT = (bf16_t*)(ws + WS_WQT);
        for (int e = c.gtid; e < 2 * 224 * 1024; e += c.gsz) { const int k = e & 1023, n = 1056 + ((e >> 10) % 224), l = e / (224 * 1024);
            WQT[((size_t)l * NQP + n) * 1024 + k] = n < NQ ? (bf16_t)f2bf(p->in[I_WQ][((size_t)l * 1024 + k) * NQ + n]) : (bf16_t)0; }
        bf16_t* W2V = (bf16_t*)(ws + WS_W2V);
        for (int e = c.gtid; e < 32 * 1024; e += c.gsz) { const int n = e & 1023, k = e >> 10; W2V[n * 32 + k] = (bf16_t)f2bf(p->in[I_V2][k * 1024 + n]); }
    }
    { bf16_t* W2T = (bf16_t*)(ws + WS_CW2T);
      for (int e = c.gtid; e < 2 * 128 * 64; e += c.gsz) { const int d = e & 63, q = (e >> 6) & 127, kv = e >> 13; const float w = p->in[I_CW2][e];
          const unsigned hi = f2bf(w), lo = f2bf(w - __builtin_bit_cast(float, hi << 16)); W2T[(size_t)(kv * 64 + d) * 128 + q] = (bf16_t)hi; W2T[(size_t)2 * 64 * 128 + (size_t)(kv * 64 + d) * 128 + q] = (bf16_t)lo; } }
    for (int it = c.gw; it < 256; it += c.ngw) { const int kv = it >> 7, h = it & 127; float s = 0.f;
        for (int kk = c.lane; kk < 2048; kk += 64) s += p->in[I_PE][kv * 2048 + kk] * p->in[I_CW1][((size_t)kv * 2048 + kk) * 128 + h];
        s = wave_sum(s); if (c.lane == 0) ((float*)(ws + WS_CBIAS))[it] = s + p->in[I_CB1][it]; }
    { const f32x4* xp = (const f32x4*)p->in[I_XP]; const f32x4* xs = (const f32x4*)p->in[I_XS]; f32x4* o = (f32x4*)(p->out + O_Y);
      for (int e = c.gtid; e < R * D / 4; e += c.gsz) o[e] = e < MP * D / 4 ? xp[e] : xs[e - MP * D / 4]; }
}

__device__ __forceinline__ void phase_fill(KP p, const Ctx& c, int li, const int gwf, const int ngwf) {
    unsigned char* ws = p->ws;
    { const int* pt = (const int*)p->in[I_PT]; bf16_t* CA = (bf16_t*)(ws + WS_CMPA); const int part = li;
      for (int it = gwf; it < SB * 128 * 4; it += ngwf) { const int s4 = 4 * (it & 3), n = (it >> 2) & 127, b = it >> 9;
          const int page = pt[b * NPAGES + (n >> 3)]; const float* src = p->in[I_CKV] + ((size_t)page * PAGE + (n & 7) * 16 + s4) * 1024 + part * 256;
          f32x4 v[4];
#pragma unroll
          for (int e = 0; e < 4; ++e) v[e] = __builtin_nontemporal_load(((const f32x4*)(src + (size_t)e * 1024)) + c.lane);
          const int g = c.lane >> 4, d0 = 4 * (c.lane & 15); bf16_t* dst = CA + ((size_t)8192 + (size_t)part * 65536 + (size_t)(b * 4 + g) * 128 + n) * 1024 + s4 * 64 + d0;
#pragma unroll
          for (int e = 0; e < 4; ++e) { u32x2 w; w.x = pk2(v[e][0], v[e][1]); w.y = pk2(v[e][2], v[e][3]); *(u32x2*)(dst + e * 64) = w; } } }
    { const f32x4* src = (const f32x4*)p->in[I_CWIN]; f32x4* dst = (f32x4*)(p->out + O_WINS); constexpr int HALF_N = SB * 508 * 128 / 2;
      for (int e0 = li * HALF_N + gwf * 256 + c.lane; e0 < (li + 1) * HALF_N; e0 += ngwf * 256) { f32x4 v[4];
#pragma unroll
          for (int q = 0; q < 4; ++q) { const int e = e0 + 64 * q; if (e < (li + 1) * HALF_N) { const int b = e / (508 * 128), rr = e % (508 * 128); v[q] = __builtin_nontemporal_load(src + (size_t)b * 512 * 128 + 4 * 128 + rr); } }
#pragma unroll
          for (int q = 0; q < 4; ++q) { const int e = e0 + 64 * q; if (e < (li + 1) * HALF_N) { const int b = e / (508 * 128), rr = e % (508 * 128); __builtin_nontemporal_store(v[q], dst + (size_t)b * 512 * 128 + rr); } } } }
}

template <int NT> __device__ __forceinline__ void skinny_mma(const bf16_t* A, int lda, const bf16_t* Wt, int ldw, int K, int row0, int col0, int lane, f32x4 (&acc)[NT][2]) {
    const int fr = lane & 15, fq = lane >> 4;
#pragma unroll
    for (int nt = 0; nt < NT; ++nt) { acc[nt][0] = (f32x4){0.f, 0.f, 0.f, 0.f}; acc[nt][1] = (f32x4){0.f, 0.f, 0.f, 0.f}; }
    const bf16_t* xa = A + (size_t)(row0 + fr) * lda + 8 * fq; const bf16_t* xb = xa + (size_t)16 * lda;
    const bf16_t* wa = Wt + (size_t)(col0 + fr) * ldw + 8 * fq;
    const char* pa = (const char*)xa; const char* pb = (const char*)xb; const char* pw[NT];
#pragma unroll
    for (int nt = 0; nt < NT; ++nt) pw[nt] = (const char*)(wa + (size_t)nt * 16 * ldw);
    for (int k4 = 0; k4 < K / 128; ++k4) {
        bf16x8 fb[4][2], fa[4][NT];
#pragma unroll
        for (int u = 0; u < 4; ++u) { fb[u][0] = *(const bf16x8*)(pa + 64 * u); fb[u][1] = *(const bf16x8*)(pb + 64 * u);
#pragma unroll
            for (int nt = 0; nt < NT; ++nt) fa[u][nt] = *(const bf16x8*)(pw[nt] + 64 * u); }
        __builtin_amdgcn_sched_barrier(0);
#pragma unroll
        for (int u = 0; u < 4; ++u)
#pragma unroll
            for (int nt = 0; nt < NT; ++nt) { acc[nt][0] = mfma16(fa[u][nt], fb[u][0], acc[nt][0]); acc[nt][1] = mfma16(fa[u][nt], fb[u][1], acc[nt][1]); }
        pa += 256; pb += 256;
#pragma unroll
        for (int nt = 0; nt < NT; ++nt) pw[nt] += 256;
        __builtin_amdgcn_sched_barrier(0);
    }
}
__device__ __forceinline__ void skinny_resid_sample(const Ctx& c, const bf16_t* A, int lda, const bf16_t* Wt, int K, float* X) {
    const int ln = launder_v(c.lane), fr = ln & 15, fq = ln >> 4;
    for (int it = blockIdx.x + gridDim.x * c.wave; it < 256; it += c.ngw) { const int row0 = MP + 32 * (it & 15), col0 = 64 * (it >> 4);
        f32x4 acc[4][2]; skinny_mma<4>(A, lda, Wt, lda, K, row0, col0, c.lane, acc);
#pragma unroll
        for (int nt = 0; nt < 4; ++nt)
#pragma unroll
            for (int mt = 0; mt < 2; ++mt) { f32x4* q = (f32x4*)(X + (size_t)(row0 + 16 * mt + fr) * D + col0 + 16 * nt + 4 * fq); *q = *q + acc[nt][mt]; } }
}
__device__ __forceinline__ void skinny_store(const Ctx& c, const bf16_t* A, const bf16_t* Wt, int K, float* C, int ldc, int rbase, int nrb, int ncb, int it0, int nit_total) {
    const int fr = c.lane & 15, fq = c.lane >> 4;
    for (int it = c.gw - it0; it < nrb * ncb; it += c.ngw) { if (it < 0) continue; const int row0 = rbase + 32 * (it % nrb), col0 = 64 * (it / nrb);
        f32x4 acc[4][2]; skinny_mma<4>(A, K, Wt, K, K, row0, col0, c.lane, acc);
#pragma unroll
        for (int nt = 0; nt < 4; ++nt)
#pragma unroll
            for (int mt = 0; mt < 2; ++mt) *(f32x4*)(C + (size_t)(row0 + 16 * mt + fr) * ldc + col0 + 16 * nt + 4 * fq) = acc[nt][mt]; }
    (void)nit_total;
}

__device__ __forceinline__ void load_row(const float* p, int lane, f32x4 (&v)[4]) {
#pragma unroll
    for (int j = 0; j < 4; ++j) v[j] = ((const f32x4*)p)[lane + 64 * j];
}
__device__ __forceinline__ float row_rstd(const f32x4 (&v)[4]) {
    float s = 0.f;
#pragma unroll
    for (int j = 0; j < 4; ++j) s += (v[j][0] * v[j][0] + v[j][1] * v[j][1]) + (v[j][2] * v[j][2] + v[j][3] * v[j][3]);
    s = wave_sum(s); return frsq(s * (1.0f / D) + NORM_EPS);
}
__device__ __forceinline__ void store_row_bf16(bf16_t* o, int lane, const f32x4 (&v)[4]) {
#pragma unroll
    for (int j = 0; j < 4; ++j) { u32x2 w; w.x = pk2(v[j][0], v[j][1]); w.y = pk2(v[j][2], v[j][3]); ((u32x2*)o)[lane + 64 * j] = w; }
}

__device__ __forceinline__ void phase_norm(const Ctx& c, const float* X, const float* g1, bf16_t* o1, const float* g2, bf16_t* o2) {
    f32x4 ga[4], gb[4]; load_row(g1, c.lane, ga); if (g2) load_row(g2, c.lane, gb);
    for (int row = c.gw; row < R; row += c.ngw) {
        f32x4 v[4]; load_row(X + (size_t)row * D, c.lane, v); const float rs = row_rstd(v);
        f32x4 y[4];
#pragma unroll
        for (int j = 0; j < 4; ++j) y[j] = v[j] * rs * ga[j];
        store_row_bf16(o1 + (size_t)row * D, c.lane, y);
        if (g2) {
#pragma unroll
            for (int j = 0; j < 4; ++j) y[j] = v[j] * rs * gb[j];
            store_row_bf16(o2 + (size_t)row * D, c.lane, y); }
    }
}

__device__ __forceinline__ void phase_mix(KP p, const Ctx& c, int li) {
    const float* X = p->out + O_Y; const float* gain = p->in[I_NORMG] + (size_t)(li * 2) * D; const float* mu = p->in[I_MU] + (size_t)li * 6 * D;
    bf16_t* XM = (bf16_t*)(p->ws + WS_XM);
    f32x4 ga[4]; load_row(gain, c.lane, ga);
    {
        const int r0 = (int)(((long)c.gw * R) / c.ngw), r1 = (int)(((long)(c.gw + 1) * R) / c.ngw); f32x4 prev[4];
        {
            const bool seq_start = r0 < MP ? ((r0 & (TP - 1)) == 0) : (((r0 - MP) & 3) == 0);
            if (!seq_start && r0 < r1) { f32x4 v[4]; load_row(X + (size_t)(r0 - 1) * D, c.lane, v); const float rs = row_rstd(v);
#pragma unroll
                for (int j = 0; j < 4; ++j) prev[j] = v[j] * rs * ga[j]; }
        }
        for (int row = r0; row < r1; ++row) {
            const bool seq_start = row < MP ? ((row & (TP - 1)) == 0) : (((row - MP) & 3) == 0);
            if (seq_start) {
                if (row < MP) {
#pragma unroll
                    for (int j = 0; j < 4; ++j) prev[j] = (f32x4){0.f, 0.f, 0.f, 0.f}; }
                else load_row(p->in[I_SSHIFT] + ((size_t)li * SB + ((row - MP) >> 2)) * D, c.lane, prev);
            }
            f32x4 v[4]; load_row(X + (size_t)row * D, c.lane, v); const float rs = row_rstd(v);
            f32x4 xn[4];
#pragma unroll
            for (int j = 0; j < 4; ++j) xn[j] = v[j] * rs * ga[j];
#pragma unroll
            for (int m = 0; m < 6; ++m) {
                f32x4 y[4];
#pragma unroll
                for (int j = 0; j < 4; ++j) { const int mi = m == 1 ? 2 : (m == 2 ? 3 : (m == 3 ? 1 : m));
                    const f32x4 mm = ((const f32x4*)(mu + (size_t)mi * D))[c.lane + 64 * j]; y[j] = xn[j] + (prev[j] - xn[j]) * mm; }
                store_row_bf16(XM + ((size_t)m * R + row) * D, c.lane, y);
            }
            const bool seq_end = row < MP ? ((row & (TP - 1)) == TP - 1) : (((row - MP) & 3) == 3);
            if (seq_end) { float* so = row < MP ? p->out + O_SHP + ((size_t)li * NB + (row >> 13)) * D : p->out + O_SHS + ((size_t)li * SB + ((row - MP) >> 2)) * D;
#pragma unroll
                for (int j = 0; j < 4; ++j) ((f32x4*)so)[c.lane + 64 * j] = xn[j]; }
#pragma unroll
            for (int j = 0; j < 4; ++j) prev[j] = xn[j];
        }
    }
}
template <int NT, int ACT> __device__ __forceinline__ void lora1_item(const bf16_t* X, const bf16_t* W, bf16_t* HID, int coloff, int rb, int lane) {
    lane = launder_v(lane);
    const int fr = lane & 15, fq = lane >> 4;
    f32x4 acc[NT][2]; skinny_mma<NT>(X, 1024, W, 1024, 1024, rb * 32, coloff, lane, acc);
#pragma unroll
    for (int nt = 0; nt < NT; ++nt)
#pragma unroll
        for (int mt = 0; mt < 2; ++mt) { f32x4 v = acc[nt][mt];
#pragma unroll
            for (int r = 0; r < 4; ++r) { if (ACT == 1) { const float e = __builtin_amdgcn_exp2f(2.8853900817779268f * v[r]); v[r] = 1.0f - 2.0f * frcp(e + 1.0f); } if (ACT == 2) v[r] = sigmoidf_(v[r]); }
            u32x2 w; w.x = pk2(v[0], v[1]); w.y = pk2(v[2], v[3]);
            *(u32x2*)(HID + (size_t)(rb * 32 + mt * 16 + fr) * LHID + coloff + nt * 16 + 4 * fq) = w; }
}
__device__ __forceinline__ void phase_lora1(KP p, const Ctx& c, int li) {
    const bf16_t* XM = (const bf16_t*)(p->ws + WS_XM); const bf16_t* W = (const bf16_t*)(p->ws + WS_W1T) + (size_t)li * 288 * 1024; bf16_t* HID = (bf16_t*)(p->ws + WS_HID);
    constexpr int NRB = R / 32;
    for (int it = blockIdx.x + gridDim.x * c.wave; it < 5 * NRB; it += c.ngw) { const int q = it / NRB, rb = it % NRB;
        if (q == 0) lora1_item<4, 1>(XM + (size_t)3 * R * D, W, HID, 0, rb, c.lane);
        else if (q == 1) lora1_item<4, 0>(XM + (size_t)4 * R * D, W, HID, 64, rb, c.lane);
        else if (q == 2) { if (li == 1) lora1_item<2, 0>(XM + (size_t)2 * R * D, W, HID, 128, rb, c.lane); }
        else if (q == 3) lora1_item<4, 2>(XM + (size_t)5 * R * D, W, HID, 160, rb, c.lane);
        else lora1_item<4, 2>(XM + (size_t)5 * R * D, W, HID, 224, rb, c.lane);
    }
}

constexpr int SST = 72, MAT = 64 * SST * 2;
constexpr int O_AT = 0, O_BT = MAT, O_KT = 2 * MAT, O_RT = 3 * MAT, O_VT = 4 * MAT, O_BH = 5 * MAT, O_KH = 6 * MAT, O_XT = 7 * MAT, O_AAB = 9 * MAT, O_AAK = 10 * MAT, O_ARB = 11 * MAT, O_ARK = 12 * MAT;
constexpr int O_TD = 13 * MAT, O_SCR = O_TD + 2048, O_CS = O_SCR + 4096, O_WC = O_CS + 2048, O_LW = O_XT, O_LA = O_XT + 16384, O_LV = O_XT + 32768;
static_assert(O_WC + 256 <= RING_BYTES && O_LV + 16384 <= O_TD, "scan LDS map");
__device__ __forceinline__ bf16x8 ldsfrag(LAS unsigned char* lds, int off, int row, int col) { return *(const LAS bf16x8*)(lds + off + (row * SST + col) * 2); }
__device__ __forceinline__ void lds_st4(LAS unsigned char* lds, int off, int row, int col, f32x4 v) { u32x2 w; w.x = pk2(v[0], v[1]); w.y = pk2(v[2], v[3]); *(LAS u32x2*)(lds + off + (row * SST + col) * 2) = w; }
__device__ __forceinline__ f32x4 lds_ld4(LAS unsigned char* lds, int off, int row, int col) { const u32x2 w = *(const LAS u32x2*)(lds + off + (row * SST + col) * 2); return (f32x4){bflo(w.x), bfhi(w.x), bflo(w.y), bfhi(w.y)}; }

__device__ __forceinline__ void scanA_unit(KP p, const Ctx& c, int li, int u) {
    LAS unsigned char* lds = c.lds; unsigned char* ws = p->ws; const int stop = p->pad;
    const int lane = c.lane, wave = c.wave, fr = lane & 15, fq = lane >> 4;
    const int b = u / (NCH * H), n = (u / H) % NCH, h = u % H, row0 = b * TP + 64 * n;
    const float* Rb = (const float*)(ws + WS_RK_R); const float* Kb = (const float*)(ws + WS_RK_K);
    float* Vb = (float*)(ws + (li ? WS_V1 : WS_V0)); const float* V0b = (const float*)(ws + WS_V0);
    const bf16_t* HID = (const bf16_t*)(ws + WS_HID);
    {
        const int tt = wave & 3, chh = wave >> 2;
        const bf16_t* hrow = launder_p(HID + (size_t)(row0 + 16 * tt + fr) * LHID + 8 * fq);
        const bf16_t* W2W = (const bf16_t*)(ws + WS_W2W) + (size_t)li * 1024 * 64; const bf16_t* W2A = (const bf16_t*)(ws + WS_W2A) + (size_t)li * 1024 * 64; const bf16_t* W2V = (const bf16_t*)(ws + WS_W2V);
#pragma unroll
        for (int cti = 0; cti < 2; ++cti) { const int ct = 2 * chh + cti, C = 64 * h + 16 * ct + fr;
            f32x4 aw = {0.f, 0.f, 0.f, 0.f}, aa = {0.f, 0.f, 0.f, 0.f}, av = {0.f, 0.f, 0.f, 0.f};
#pragma unroll
            for (int ks = 0; ks < 2; ++ks) {
                aw = mfma16(*(const bf16x8*)(W2W + (size_t)C * 64 + 32 * ks + 8 * fq), *(const bf16x8*)(hrow + 32 * ks), aw);
                aa = mfma16(*(const bf16x8*)(W2A + (size_t)C * 64 + 32 * ks + 8 * fq), *(const bf16x8*)(hrow + 64 + 32 * ks), aa); }
            if (li) av = mfma16(*(const bf16x8*)(W2V + (size_t)C * 32 + 8 * fq), *(const bf16x8*)(hrow + 128), av);
            const int t = 16 * tt + fr, cc = 16 * ct + 4 * fq;
            *(LAS f32x4*)(lds + O_LW + (t * 64 + cc) * 4) = aw; *(LAS f32x4*)(lds + O_LA + (t * 64 + cc) * 4) = aa; *(LAS f32x4*)(lds + O_LV + (t * 64 + cc) * 4) = av; }
    }
    __syncthreads();
    if (stop == 1) return;
    {
        const int cc = lane, tq = wave, C = 64 * h + cc; const size_t pc = (size_t)li * D + C;
        const float w0 = p->in[I_W0][pc], a0 = p->in[I_A0][pc], kkc = p->in[I_KK][pc], kac = p->in[I_KA][pc], rkc = p->in[I_RKK][pc], v0 = li ? p->in[I_V0][C] : 0.f;
        float wlg[8], Lin[8], rr[8], k2[8], vv[8], aa[8], bb[8]; float run = 0.f;
#pragma unroll
        for (int e = 0; e < 8; ++e) { const int t = 8 * tq + e; const size_t gi = (size_t)(row0 + t) * D + C;
            const float r = Rb[gi], k = Kb[gi]; float v = Vb[gi];
            const float lw = *(const LAS float*)(lds + O_LW + (t * 64 + cc) * 4), la = *(const LAS float*)(lds + O_LA + (t * 64 + cc) * 4);
            const float z = -(w0 + lw); const float sp = fmaxf(z, 0.f) + __logf(1.0f + __expf(-fabsf(z))); const float wl = -__expf(-sp - 0.5f);
            const float asig = sigmoidf_(a0 + la);
            if (li) { const float lv = *(const LAS float*)(lds + O_LV + (t * 64 + cc) * 4); const float vg = sigmoidf_(v0 + lv); const float vf = V0b[gi]; v = v + (vf - v) * vg; Vb[gi] = v; }
            const float kkr = k * kkc; const float ss = wave_sum(kkr * kkr); const float kkn = kkr * frsq(fmaxf(ss, 1e-24f));
            const float kmod = k * (1.0f + (asig - 1.0f) * kac);
            const float rks = wave_sum(r * kmod * rkc); if (cc == 0) ((float*)(ws + WS_RKS))[(size_t)(row0 + t) * 16 + h] = rks;
            run += wl; wlg[e] = wl; Lin[e] = run; rr[e] = r; k2[e] = kmod; vv[e] = v; aa[e] = -kkn; bb[e] = kkn * asig; }
        *(LAS float*)(lds + O_CS + (tq * 64 + cc) * 4) = run;
        __syncthreads();
        float off = 0.f, tot = 0.f;
#pragma unroll
        for (int q = 0; q < 8; ++q) { const float x = *(const LAS float*)(lds + O_CS + (q * 64 + cc) * 4); tot += x; if (q < tq) off += x; }
        u32x4 wa, wv, wb, wk; unsigned pa[8], pv[8], pb[8], pk[8];
#pragma unroll
        for (int e = 0; e < 8; ++e) { const int t = 8 * tq + e; const float L = off + Lin[e], Lp = L - wlg[e];
            const float eL = __expf(L), eLp = __expf(Lp), enL = __expf(-L), eT = __expf(tot - L);
            const float at = aa[e] * eLp, bt = bb[e] * enL, kt = k2[e] * enL, rt = rr[e] * eL, bh = bb[e] * eT, kh = k2[e] * eT;
            *(LAS bf16_t*)(lds + O_AT + (t * SST + cc) * 2) = (bf16_t)f2bf(at); *(LAS bf16_t*)(lds + O_BT + (t * SST + cc) * 2) = (bf16_t)f2bf(bt);
            *(LAS bf16_t*)(lds + O_KT + (t * SST + cc) * 2) = (bf16_t)f2bf(kt); *(LAS bf16_t*)(lds + O_RT + (t * SST + cc) * 2) = (bf16_t)f2bf(rt);
            pa[e] = f2bf(at); pv[e] = f2bf(vv[e]); pb[e] = f2bf(bh); pk[e] = f2bf(kh); }
        wa = (u32x4){pa[0] | (pa[1] << 16), pa[2] | (pa[3] << 16), pa[4] | (pa[5] << 16), pa[6] | (pa[7] << 16)};
        wv = (u32x4){pv[0] | (pv[1] << 16), pv[2] | (pv[3] << 16), pv[4] | (pv[5] << 16), pv[6] | (pv[7] << 16)};
        wb = (u32x4){pb[0] | (pb[1] << 16), pb[2] | (pb[3] << 16), pb[4] | (pb[5] << 16), pb[6] | (pb[7] << 16)};
        wk = (u32x4){pk[0] | (pk[1] << 16), pk[2] | (pk[3] << 16), pk[4] | (pk[5] << 16), pk[6] | (pk[7] << 16)};
        *(LAS u32x4*)(lds + O_XT + (cc * SST + 8 * tq) * 2) = wa; *(LAS u32x4*)(lds + O_VT + (cc * SST + 8 * tq) * 2) = wv;
        *(LAS u32x4*)(lds + O_BH + (cc * SST + 8 * tq) * 2) = wb; *(LAS u32x4*)(lds + O_KH + (cc * SST + 8 * tq) * 2) = wk;
        if (tq == 0) *(LAS float*)(lds + O_WC + cc * 4) = __expf(tot);
    }
    __syncthreads();
    if (stop == 2) return;
    {
        const int mi = wave >> 1, ph = wave & 1; const int oY = (mi & 1) ? O_KT : O_BT, oX = (mi < 2) ? O_AT : O_RT; const bool strict = mi < 2;
        const int oO = mi == 0 ? O_AAB : (mi == 1 ? O_AAK : (mi == 2 ? O_ARB : O_ARK));
#pragma unroll
        for (int sti = 0; sti < 2; ++sti) { const int st = 2 * ph + sti;
#pragma unroll
            for (int tt = 0; tt < 4; ++tt) { f32x4 acc = {0.f, 0.f, 0.f, 0.f};
                if (st <= tt) {
#pragma unroll
                    for (int ks = 0; ks < 2; ++ks) acc = mfma16(ldsfrag(lds, oY, 16 * st + fr, 32 * ks + 8 * fq), ldsfrag(lds, oX, 16 * tt + fr, 32 * ks + 8 * fq), acc);
                    const int t = 16 * tt + fr;
#pragma unroll
                    for (int r = 0; r < 4; ++r) { const int s = 16 * st + 4 * fq + r; const bool keep = strict ? (s < t) : (s <= t); acc[r] = keep ? acc[r] : 0.f; } }
                if (st <= tt) lds_st4(lds, oO, 16 * tt + fr, 16 * st + 4 * fq, acc);
                else { u32x2 zz; int z0 = 0; asm volatile("" : "+v"(z0)); zz.x = (unsigned)z0; zz.y = (unsigned)z0; *(LAS u32x2*)(lds + oO + ((16 * tt + fr) * SST + 16 * st + 4 * fq) * 2) = zz; } } }
    }
    __syncthreads();
    if (stop == 3) return;
    {
        const int tt = wave & 3, ih = wave >> 2;
#pragma unroll
        for (int iti = 0; iti < 2; ++iti) { const int it = 2 * ih + iti; f32x4 acc = {0.f, 0.f, 0.f, 0.f};
#pragma unroll
            for (int ks = 0; ks < 2; ++ks) acc = mfma16(ldsfrag(lds, O_AAK, 16 * tt + fr, 32 * ks + 8 * fq), ldsfrag(lds, O_VT, 16 * it + fr, 32 * ks + 8 * fq), acc);
            lds_st4(lds, O_XT, 64 + 16 * it + fr, 16 * tt + 4 * fq, acc); }
        if (wave < 4 && lane < 16) { const int I = wave; float x[16];
#pragma unroll
            for (int t = 0; t < 16; ++t) { float s = (t == lane) ? 1.0f : 0.0f;
#pragma unroll
                for (int q = 0; q < t; ++q) s += bf2f(*(const LAS bf16_t*)(lds + O_AAB + ((16 * I + t) * SST + 16 * I + q) * 2)) * x[q];
                x[t] = s; *(LAS bf16_t*)(lds + O_TD + ((I * 16 + t) * 16 + lane) * 2) = (bf16_t)f2bf(s); } }
    }
    __syncthreads();
    if (stop == 5) return;
    {
        const int colb = 16 * wave; const bf16x8 zero8 = {0, 0, 0, 0, 0, 0, 0, 0};
#pragma unroll
        for (int I = 0; I < 4; ++I) {
            f32x4 acc = lds_ld4(lds, O_XT, colb + fr, 16 * I + 4 * fq);
#pragma unroll
            for (int ks = 0; ks < 2; ++ks) if (32 * ks < 16 * I) { const bool ok = (32 * ks + 8 * fq) < 16 * I;
                const bf16x8 a = ok ? ldsfrag(lds, O_AAB, 16 * I + fr, 32 * ks + 8 * fq) : zero8, bq = ok ? ldsfrag(lds, O_XT, colb + fr, 32 * ks + 8 * fq) : zero8;
                acc = mfma16(a, bq, acc); }
            { u32x2 w; w.x = pk2(acc[0], acc[1]); w.y = pk2(acc[2], acc[3]); *(LAS u32x2*)(lds + O_SCR + wave * 512 + (fr * 16 + 4 * fq) * 2) = w; }
            LDS_WAIT();
            const bf16x8 ta = fq < 2 ? *(const LAS bf16x8*)(lds + O_TD + ((I * 16 + fr) * 16 + 8 * fq) * 2) : zero8;
            const bf16x8 tb = fq < 2 ? *(const LAS bf16x8*)(lds + O_SCR + wave * 512 + (fr * 16 + 8 * fq) * 2) : zero8;
            const f32x4 res = mfma16(ta, tb, (f32x4){0.f, 0.f, 0.f, 0.f});
            lds_st4(lds, O_XT, colb + fr, 16 * I + 4 * fq, res);
            LDS_WAIT();
        }
    }
    __syncthreads();
    if (stop == 6) return;
    {
        const int tb = wave & 3, hb = wave >> 2;
        bf16_t* RP = (bf16_t*)(ws + WS_RP) + (size_t)u * 4096; float* YL = (float*)(ws + WS_YL) + (size_t)u * 4096;
        bf16_t* MTH = (bf16_t*)(ws + WS_MT) + (size_t)u * 4096; bf16_t* MTL = MTH + (size_t)NUNIT_A * 4096; float* NN = (float*)(ws + WS_NN) + (size_t)u * 4096;
#pragma unroll
        for (int qi = 0; qi < 2; ++qi) { const int rt = 2 * hb + qi;
            { f32x4 acc = lds_ld4(lds, O_RT, 16 * tb + fr, 16 * rt + 4 * fq);
#pragma unroll
              for (int ks = 0; ks < 2; ++ks) acc = mfma16(ldsfrag(lds, O_XT, 16 * rt + fr, 32 * ks + 8 * fq), ldsfrag(lds, O_ARB, 16 * tb + fr, 32 * ks + 8 * fq), acc);
              u32x2 w; w.x = pk2(acc[0], acc[1]); w.y = pk2(acc[2], acc[3]); *(u32x2*)(RP + (size_t)(16 * tb + fr) * 64 + 16 * rt + 4 * fq) = w; }
            { f32x4 acc = {0.f, 0.f, 0.f, 0.f};
#pragma unroll
              for (int ks = 0; ks < 2; ++ks) { acc = mfma16(ldsfrag(lds, O_XT, 64 + 16 * rt + fr, 32 * ks + 8 * fq), ldsfrag(lds, O_ARB, 16 * tb + fr, 32 * ks + 8 * fq), acc);
                  acc = mfma16(ldsfrag(lds, O_VT, 16 * rt + fr, 32 * ks + 8 * fq), ldsfrag(lds, O_ARK, 16 * tb + fr, 32 * ks + 8 * fq), acc); }
              *(f32x4*)(YL + (size_t)(16 * tb + fr) * 64 + 16 * rt + 4 * fq) = acc; }
            { f32x4 acc = {0.f, 0.f, 0.f, 0.f};
#pragma unroll
              for (int ks = 0; ks < 2; ++ks) acc = mfma16(ldsfrag(lds, O_XT, 16 * rt + fr, 32 * ks + 8 * fq), ldsfrag(lds, O_BH, 16 * tb + fr, 32 * ks + 8 * fq), acc);
              const int j = 16 * tb + fr; const float wc = *(const LAS float*)(lds + O_WC + j * 4);
#pragma unroll
              for (int r = 0; r < 4; ++r) if (16 * rt + 4 * fq + r == j) acc[r] += wc;
              unsigned hh[4], ll[4];
#pragma unroll
              for (int r = 0; r < 4; ++r) { hh[r] = f2bf(acc[r]); ll[r] = f2bf(acc[r] - __builtin_bit_cast(float, hh[r] << 16)); }
              *(u32x2*)(MTH + (size_t)j * 64 + 16 * rt + 4 * fq) = (u32x2){hh[0] | (hh[1] << 16), hh[2] | (hh[3] << 16)};
              *(u32x2*)(MTL + (size_t)j * 64 + 16 * rt + 4 * fq) = (u32x2){ll[0] | (ll[1] << 16), ll[2] | (ll[3] << 16)}; }
            { f32x4 acc = {0.f, 0.f, 0.f, 0.f};
#pragma unroll
              for (int ks = 0; ks < 2; ++ks) { acc = mfma16(ldsfrag(lds, O_BH, 16 * rt + fr, 32 * ks + 8 * fq), ldsfrag(lds, O_XT, 64 + 16 * tb + fr, 32 * ks + 8 * fq), acc);
                  acc = mfma16(ldsfrag(lds, O_KH, 16 * rt + fr, 32 * ks + 8 * fq), ldsfrag(lds, O_VT, 16 * tb + fr, 32 * ks + 8 * fq), acc); }
              *(f32x4*)(NN + (size_t)(16 * tb + fr) * 64 + 16 * rt + 4 * fq) = acc; }
        }
    }
    __syncthreads();
}

__device__ __forceinline__ void scan_sample_item(KP p, const Ctx& c, int li, int item) {
    unsigned char* ws = p->ws; const int lane = c.lane, b = item >> 4, h = item & 15, C = 64 * h + lane; const size_t pc = (size_t)li * D + C;
    LAS float* sc = (LAS float*)(c.lds + c.wave * 16384);
    const float* Rb = (const float*)(ws + WS_RK_R); const float* Kb = (const float*)(ws + WS_RK_K);
    float* Vb = (float*)(ws + (li ? WS_V1 : WS_V0)); const float* V0b = (const float*)(ws + WS_V0);
    const bf16_t* HID = (const bf16_t*)(ws + WS_HID) + (size_t)(MP + 4 * b) * LHID;
    for (int e = lane; e < 4 * LHID; e += 64) sc[e] = bf2f(HID[e]);
    LDS_WAIT();
    float lw[4] = {0.f, 0.f, 0.f, 0.f}, la[4] = {0.f, 0.f, 0.f, 0.f}, lv[4] = {0.f, 0.f, 0.f, 0.f}, lg[4] = {0.f, 0.f, 0.f, 0.f};
    {
        const bf16_t* W2W = (const bf16_t*)(ws + WS_W2W) + ((size_t)li * 1024 + C) * 64; const bf16_t* W2A = (const bf16_t*)(ws + WS_W2A) + ((size_t)li * 1024 + C) * 64;
        const bf16_t* W2V = (const bf16_t*)(ws + WS_W2V) + (size_t)C * 32; const bf16_t* W2G = (const bf16_t*)(ws + WS_W2G) + ((size_t)li * 1024 + C) * 128;
#define LORA2_BLK(WP, QB, HOFF, ACC) { const u32x4 w8 = *(const u32x4*)((WP) + 8 * (QB)); \
            const float wf0 = bflo(w8.x), wf1 = bfhi(w8.x), wf2 = bflo(w8.y), wf3 = bfhi(w8.y), wf4 = bflo(w8.z), wf5 = bfhi(w8.z), wf6 = bflo(w8.w), wf7 = bfhi(w8.w); \
            _Pragma("unroll") for (int t = 0; t < 4; ++t) { const f32x4 h0 = *(const LAS f32x4*)(sc + t * LHID + (HOFF) + 8 * (QB)), h1 = *(const LAS f32x4*)(sc + t * LHID + (HOFF) + 8 * (QB) + 4); \
                ACC[t] += (h0[0] * wf0 + h0[1] * wf1) + (h0[2] * wf2 + h0[3] * wf3) + (h1[0] * wf4 + h1[1] * wf5) + (h1[2] * wf6 + h1[3] * wf7); } \
            asm volatile("" : "+v"(ACC[0]), "+v"(ACC[1]), "+v"(ACC[2]), "+v"(ACC[3]) :: "memory"); }
#pragma unroll
        for (int qb = 0; qb < 8; ++qb) { LORA2_BLK(W2W, qb, 0, lw) LORA2_BLK(W2A, qb, 64, la) }
        if (li) {
#pragma unroll
            for (int qb = 0; qb < 4; ++qb) LORA2_BLK(W2V, qb, 128, lv) }
#pragma unroll
        for (int qb = 0; qb < 16; ++qb) LORA2_BLK(W2G, qb, 160, lg)
#undef LORA2_BLK
    }
    const float w0 = p->in[I_W0][pc], a0 = p->in[I_A0][pc], kkc = p->in[I_KK][pc], kac = p->in[I_KA][pc], rkc = p->in[I_RKK][pc], v0 = li ? p->in[I_V0][C] : 0.f;
    const float lnw = p->in[I_LNW][pc], lnb = p->in[I_LNB][pc];
    float S[64];
    { const f32x4* sp = (const f32x4*)(p->in[I_SWKV] + (((size_t)li * SB + b) * H + h) * 4096 + lane * 64);
#pragma unroll
      for (int q = 0; q < 16; ++q) { const f32x4 x = sp[q]; S[4 * q] = x[0]; S[4 * q + 1] = x[1]; S[4 * q + 2] = x[2]; S[4 * q + 3] = x[3]; } }
    LAS float* bc = sc + 1280;
    bf16_t* YG = (bf16_t*)(ws + WS_YG);
#pragma unroll
    for (int t = 0; t < 4; ++t) { const size_t gi = (size_t)(MP + 4 * b + t) * D + C;
        const float r = Rb[gi], k = Kb[gi]; float v = Vb[gi];
        const float z = -(w0 + lw[t]); const float sp = fmaxf(z, 0.f) + __logf(1.0f + __expf(-fabsf(z))); const float wdec = __expf(-__expf(-sp - 0.5f));
        const float asig = sigmoidf_(a0 + la[t]);
        if (li) { const float vg = sigmoidf_(v0 + lv[t]); const float vf = V0b[gi]; v = v + (vf - v) * vg; }
        const float kkr = k * kkc; const float ss = wave_sum(kkr * kkr); const float kkn = kkr * frsq(fmaxf(ss, 1e-24f));
        const float kmod = k * (1.0f + (asig - 1.0f) * kac);
        const float rks = wave_sum(r * kmod * rkc);
        LDS_WAIT();
        bc[lane] = wdec; bc[64 + lane] = -kkn; bc[128 + lane] = kkn * asig; bc[192 + lane] = kmod; bc[256 + lane] = r;
        LDS_WAIT();
        float sa = 0.f;
#pragma unroll
        for (int q = 0; q < 16; ++q) { const f32x4 av = *(const LAS f32x4*)(bc + 64 + 4 * q); sa += S[4 * q] * av[0] + S[4 * q + 1] * av[1] + S[4 * q + 2] * av[2] + S[4 * q + 3] * av[3]; }
        float y = 0.f;
#pragma unroll
        for (int q = 0; q < 16; ++q) { const f32x4 wv = *(const LAS f32x4*)(bc + 4 * q), bv = *(const LAS f32x4*)(bc + 128 + 4 * q), kv = *(const LAS f32x4*)(bc + 192 + 4 * q), rv = *(const LAS f32x4*)(bc + 256 + 4 * q);
#pragma unroll
            for (int e = 0; e < 4; ++e) { const float s = S[4 * q + e] * wv[e] + sa * bv[e] + v * kv[e]; S[4 * q + e] = s; y += s * rv[e]; } }
        const float mean = wave_sum(y) * (1.0f / 64.0f); const float dy = y - mean; const float var = wave_sum(dy * dy) * (1.0f / 64.0f);
        const float yn = dy * (frsq(var + GN_EPS)) * lnw + lnb;
        YG[gi] = (bf16_t)f2bf((yn + rks * v) * lg[t]);
    }
    { f32x4* so = (f32x4*)(p->out + O_WKVS + (((size_t)li * SB + b) * H + h) * 4096 + lane * 64);
#pragma unroll
      for (int q = 0; q < 16; ++q) so[q] = (f32x4){S[4 * q], S[4 * q + 1], S[4 * q + 2], S[4 * q + 3]}; }
    LDS_WAIT();
}

__device__ __forceinline__ void phase_scanA(KP p, const Ctx& c, int li) {
    const int stop = p->pad;
    if (stop != 9) for (int u = blockIdx.x; u < NUNIT_A; u += gridDim.x) scanA_unit(p, c, li, u);
    if (stop == 0 || stop == 9) for (int it = c.gw; it < SB * H; it += c.ngw) scan_sample_item(p, c, li, it);
}

__device__ __forceinline__ void hilo(const f32x4 x0, const f32x4 x1, bf16x8& hi, bf16x8& lo) {
    unsigned h[8], l[8];
#pragma unroll
    for (int e = 0; e < 8; ++e) { const float x = e < 4 ? x0[e] : x1[e - 4]; h[e] = f2bf(x); l[e] = f2bf(x - __builtin_bit_cast(float, h[e] << 16)); }
    u32x4 hv = {h[0] | (h[1] << 16), h[2] | (h[3] << 16), h[4] | (h[5] << 16), h[6] | (h[7] << 16)}, lv = {l[0] | (l[1] << 16), l[2] | (l[3] << 16), l[4] | (l[5] << 16), l[6] | (l[7] << 16)};
    hi = __builtin_bit_cast(bf16x8, hv); lo = __builtin_bit_cast(bf16x8, lv);
}
constexpr int SB_SLOT = 20480, SB_RING0 = 8192, SB_DEPTH = 6;
static_assert(SB_RING0 + SB_DEPTH * SB_SLOT <= RING_BYTES, "chain ring");
__device__ __forceinline__ void phase_scanB(KP p, const Ctx& c, int li) {
    unsigned char* ws = p->ws; LAS unsigned char* lds = c.lds; const int lane = c.lane, fr = lane & 15, fq = lane >> 4, wave = c.wave;
    volatile LAS int* FL = (volatile LAS int*)(lds + RING_BYTES);
    if (c.tid < 4) FL[c.tid] = 0;
    __syncthreads();
    const int ncb = (int)gridDim.x < 128 ? (int)gridDim.x : 128;
    if (wave >= 4 || (int)blockIdx.x >= ncb) {
        const int gwf = (int)blockIdx.x < ncb ? (int)blockIdx.x * 4 + (wave - 4) : ncb * 4 + ((int)blockIdx.x - ncb) * 8 + wave, ngwf = ncb * 4 + ((int)gridDim.x - ncb) * 8;
        phase_fill(p, c, li, gwf, ngwf); return; }
    if (wave != 0) {
        const int j = wave - 1; int prevG = -1, kc = 0;
        for (int ch = blockIdx.x; ch < 128; ch += gridDim.x, ++kc) { const int b = ch >> 6, h = (ch >> 2) & 15, iq = ch & 3;
            for (int n = j; n < NCH; n += 3) { const int G = kc * NCH + n;
                if (G >= SB_DEPTH) { unsigned sp = 0; while (FL[0] < G - (SB_DEPTH - 1)) { __builtin_amdgcn_s_sleep(1); if (++sp > (1u << 22)) break; } }
                LAS unsigned char* slot = lds + SB_RING0 + (G % SB_DEPTH) * SB_SLOT;
                const size_t u = (size_t)(b * NCH + n) * H + h; const bf16_t* MTH = (const bf16_t*)(ws + WS_MT) + u * 4096; const bf16_t* MTL = MTH + (size_t)NUNIT_A * 4096; const float* NN = (const float*)(ws + WS_NN) + u * 4096;
#pragma unroll
                for (int jt = 0; jt < 4; ++jt)
#pragma unroll
                    for (int ks = 0; ks < 2; ++ks) {
                        __builtin_amdgcn_global_load_lds((const unsigned*)(MTH + (size_t)(16 * jt + fr) * 64 + 32 * ks + 8 * fq), (LAS unsigned*)(slot + ((jt * 2 + ks) * 2 + 0) * 1024), 16, 0, 0);
                        __builtin_amdgcn_global_load_lds((const unsigned*)(MTL + (size_t)(16 * jt + fr) * 64 + 32 * ks + 8 * fq), (LAS unsigned*)(slot + ((jt * 2 + ks) * 2 + 1) * 1024), 16, 0, 0); }
#pragma unroll
                for (int jt = 0; jt < 4; ++jt)
                    __builtin_amdgcn_global_load_lds((const unsigned*)(NN + (size_t)(16 * iq + fr) * 64 + 16 * jt + 4 * fq), (LAS unsigned*)(slot + (16 + jt) * 1024), 16, 0, 0);
                asm volatile("s_waitcnt vmcnt(20)" ::: "memory");
                if (prevG >= 0) FL[1 + j] = prevG + 1;
                prevG = G; } }
        asm volatile("s_waitcnt vmcnt(0)" ::: "memory");
        if (prevG >= 0) FL[1 + j] = prevG + 1;
        return; }
    int kc = 0;
    for (int ch = blockIdx.x; ch < 128; ch += gridDim.x, ++kc) {
        const int b = ch >> 6, h = (ch >> 2) & 15, iq = ch & 3;
        f32x4 S[4];
#pragma unroll
        for (int jt = 0; jt < 4; ++jt) S[jt] = (f32x4){0.f, 0.f, 0.f, 0.f};
        int j3 = 0;
        for (int n = 0; n < NCH; ++n) { const int G = kc * NCH + n;
            const size_t u = (size_t)(b * NCH + n) * H + h; bf16_t* S0 = (bf16_t*)(ws + WS_S0) + u * 4096;
            { unsigned sp = 0; while (FL[1 + j3] < G + 1) { __builtin_amdgcn_s_sleep(1); if (++sp > (1u << 22)) break; } }
            const LAS unsigned char* slot = lds + SB_RING0 + (G % SB_DEPTH) * SB_SLOT + lane * 16;
            bf16x8 ah[4][2], al[4][2]; f32x4 nn[4];
#pragma unroll
            for (int jt = 0; jt < 4; ++jt) { nn[jt] = *(const LAS f32x4*)(slot + (16 + jt) * 1024);
#pragma unroll
                for (int ks = 0; ks < 2; ++ks) { ah[jt][ks] = *(const LAS bf16x8*)(slot + ((jt * 2 + ks) * 2 + 0) * 1024); al[jt][ks] = *(const LAS bf16x8*)(slot + ((jt * 2 + ks) * 2 + 1) * 1024); } }
#pragma unroll
            for (int jt = 0; jt < 4; ++jt) { unsigned hh[4], ll[4];
#pragma unroll
                for (int r = 0; r < 4; ++r) { hh[r] = f2bf(S[jt][r]); ll[r] = f2bf(S[jt][r] - __builtin_bit_cast(float, hh[r] << 16)); }
                u32x2 wh = {hh[0] | (hh[1] << 16), hh[2] | (hh[3] << 16)}, wl = {ll[0] | (ll[1] << 16), ll[2] | (ll[3] << 16)};
                *(u32x2*)(S0 + (size_t)(16 * iq + fr) * 64 + 16 * jt + 4 * fq) = wh;
                *(LAS u32x2*)(lds + (fr * SST + 16 * jt + 4 * fq) * 2) = wh; *(LAS u32x2*)(lds + 4096 + (fr * SST + 16 * jt + 4 * fq) * 2) = wl; }
            LDS_WAIT();
            bf16x8 bh[2], bl[2];
#pragma unroll
            for (int ks = 0; ks < 2; ++ks) { bh[ks] = *(const LAS bf16x8*)(lds + (fr * SST + 32 * ks + 8 * fq) * 2); bl[ks] = *(const LAS bf16x8*)(lds + 4096 + (fr * SST + 32 * ks + 8 * fq) * 2); }
#pragma unroll
            for (int jt = 0; jt < 4; ++jt) { f32x4 acc = nn[jt];
#pragma unroll
                for (int ks = 0; ks < 2; ++ks) { acc = mfma16(ah[jt][ks], bh[ks], acc); acc = mfma16(ah[jt][ks], bl[ks], acc); acc = mfma16(al[jt][ks], bh[ks], acc); }
                S[jt] = acc; }
            LDS_WAIT();
            FL[0] = G + 1;
            j3 = j3 == 2 ? 0 : j3 + 1;
        }
        float* so = p->out + O_WKVP + (((size_t)li * NB + b) * H + h) * 4096;
#pragma unroll
        for (int jt = 0; jt < 4; ++jt) *(f32x4*)(so + (size_t)(16 * iq + fr) * 64 + 16 * jt + 4 * fq) = S[jt];
    }
}

__device__ __forceinline__ void phase_scanC(KP p, const Ctx& c, int li) {
    unsigned char* ws = p->ws; const int lane = c.lane, fr = lane & 15, fq = lane >> 4, hb = c.wave >> 2, tt = c.wave & 3;
    const float* Vb = (const float*)(ws + (li ? WS_V1 : WS_V0)); const bf16_t* HID = (const bf16_t*)(ws + WS_HID); const bf16_t* W2G = (const bf16_t*)(ws + WS_W2G) + (size_t)li * 1024 * 128;
    bf16_t* YG = (bf16_t*)(ws + WS_YG);
    for (int up = blockIdx.x; up < NUNIT_A / 2; up += gridDim.x) {
        const int u = 2 * up + hb; const int b = u / (NCH * H), n = (u / H) % NCH, h = u % H; const int row = b * TP + 64 * n + 16 * tt + fr;
        const bf16_t* RP = (const bf16_t*)(ws + WS_RP) + (size_t)u * 4096; const float* YL = (const float*)(ws + WS_YL) + (size_t)u * 4096; const bf16_t* S0 = (const bf16_t*)(ws + WS_S0) + (size_t)u * 4096;
        f32x4 acc[4], ag[4];
#pragma unroll
        for (int it = 0; it < 4; ++it) { acc[it] = *(const f32x4*)(YL + (size_t)(16 * tt + fr) * 64 + 16 * it + 4 * fq); ag[it] = (f32x4){0.f, 0.f, 0.f, 0.f}; }
#pragma unroll
        for (int ks = 0; ks < 2; ++ks) { const bf16x8 bq = *(const bf16x8*)(RP + (size_t)(16 * tt + fr) * 64 + 32 * ks + 8 * fq);
#pragma unroll
            for (int it = 0; it < 4; ++it) acc[it] = mfma16(*(const bf16x8*)(S0 + (size_t)(16 * it + fr) * 64 + 32 * ks + 8 * fq), bq, acc[it]); }
        const bf16_t* hgp = launder_p(HID + (size_t)row * LHID + 160 + 8 * fq); const bf16_t* wgp = launder_p(W2G + (size_t)(64 * h + fr) * 128 + 8 * fq);
#pragma unroll
        for (int ks = 0; ks < 4; ++ks) { const bf16x8 bq = *(const bf16x8*)(hgp + 32 * ks);
#pragma unroll
            for (int it = 0; it < 4; ++it) ag[it] = mfma16(*(const bf16x8*)(wgp + it * 16 * 128 + 32 * ks), bq, ag[it]); }
        float s = 0.f;
#pragma unroll
        for (int it = 0; it < 4; ++it) s += (acc[it][0] + acc[it][1]) + (acc[it][2] + acc[it][3]);
        s = sum_rows4(s); const float mean = s * (1.0f / 64.0f);
        float q = 0.f;
#pragma unroll
        for (int it = 0; it < 4; ++it) { const f32x4 d = acc[it] - mean; q += (d[0] * d[0] + d[1] * d[1]) + (d[2] * d[2] + d[3] * d[3]); }
        q = sum_rows4(q); const float rstd = frsq(q * (1.0f / 64.0f) + GN_EPS);
        const float rks = ((const float*)(ws + WS_RKS))[(size_t)row * 16 + h];
#pragma unroll
        for (int it = 0; it < 4; ++it) { const int C = 64 * h + 16 * it + 4 * fq; const size_t pc = (size_t)li * D + C;
            const f32x4 lw = *(const f32x4*)(p->in[I_LNW] + pc), lb = *(const f32x4*)(p->in[I_LNB] + pc), v = *(const f32x4*)(Vb + (size_t)row * D + C);
            const f32x4 o = ((acc[it] - mean) * rstd * lw + lb + v * rks) * ag[it];
            u32x2 w; w.x = pk2(o[0], o[1]); w.y = pk2(o[2], o[3]); *(u32x2*)(YG + (size_t)row * D + C) = w; }
    }
}
__device__ __forceinline__ void ld8bf(const bf16_t* p, float (&o)[8]) { const u32x4 w = *(const u32x4*)p; o[0] = bflo(w.x); o[1] = bfhi(w.x); o[2] = bflo(w.y); o[3] = bfhi(w.y); o[4] = bflo(w.z); o[5] = bfhi(w.z); o[6] = bflo(w.w); o[7] = bfhi(w.w); }
__device__ __forceinline__ void ld8f(const float* p, float (&o)[8]) { const f32x4 a = *(const f32x4*)p, b = *(const f32x4*)(p + 4); o[0] = a[0]; o[1] = a[1]; o[2] = a[2]; o[3] = a[3]; o[4] = b[0]; o[5] = b[1]; o[6] = b[2]; o[7] = b[3]; }
__device__ __forceinline__ void phase_conv(KP p, const Ctx& c, int layer) {
    const bf16_t* U = (const bf16_t*)(p->ws + WS_U); const bf16_t* GT = (const bf16_t*)(p->ws + WS_GT); bf16_t* HH = (bf16_t*)(p->ws + WS_HH);
    const float* cw = p->in[I_CONVW] + (size_t)layer * 3 * DFF; const float* cb = p->in[I_CONVB] + (size_t)layer * DFF; const float* st = p->in[I_SCONV] + (size_t)layer * SB * 2 * DFF;
    constexpr int NF8 = DFF / 8;
    for (int e = c.gtid; e < R * NF8; e += c.gsz) { const int row = e / NF8, f = 8 * (e % NF8);
        int t, b; if (row < MP) { t = row & (TP - 1); b = -1; } else { t = (row - MP) & 3; b = (row - MP) >> 2; }
        float u0[8], u1[8], u2[8], g[8], w0[8], w1[8], w2[8], bb[8];
        ld8bf(U + (size_t)row * DFF + f, u2); ld8bf(GT + (size_t)row * DFF + f, g);
        if (t >= 1) ld8bf(U + (size_t)(row - 1) * DFF + f, u1); else if (b >= 0) ld8f(st + ((size_t)b * 2 + 1) * DFF + f, u1); else {
#pragma unroll
            for (int i = 0; i < 8; ++i) u1[i] = 0.f; }
        if (t >= 2) ld8bf(U + (size_t)(row - 2) * DFF + f, u0); else if (b >= 0) ld8f(st + ((size_t)b * 2 + t) * DFF + f, u0); else {
#pragma unroll
            for (int i = 0; i < 8; ++i) u0[i] = 0.f; }
        ld8f(cw + f, w0); ld8f(cw + DFF + f, w1); ld8f(cw + 2 * DFF + f, w2); ld8f(cb + f, bb);
        float o[8];
#pragma unroll
        for (int i = 0; i < 8; ++i) o[i] = gelu_tanh(bb[i] + w0[i] * u0[i] + w1[i] * u1[i] + w2[i] * u2[i]) * g[i];
        u32x4 w; w.x = pk2(o[0], o[1]); w.y = pk2(o[2], o[3]); w.z = pk2(o[4], o[5]); w.w = pk2(o[6], o[7]);
        *(u32x4*)(HH + (size_t)row * DFF + f) = w; }
}

__device__ __forceinline__ void phase_kvpost(KP p, const Ctx& c) {
    const float* KVF = (const float*)(p->ws + WS_KVF); unsigned char* ws = p->ws; const int lane = c.lane, g = lane >> 4, d0 = 4 * (lane & 15);
    const f32x4 gs = *(const f32x4*)(p->in[I_KNG] + 64 + d0), gw = *(const f32x4*)(p->in[I_KNG] + 128 + d0);
    bf16_t* CA = (bf16_t*)(ws + WS_CMPA); bf16_t* KS = (bf16_t*)(ws + WS_KS); bf16_t* VS = (bf16_t*)(ws + WS_VS); bf16_t* KW = (bf16_t*)(ws + WS_KW); bf16_t* VW = (bf16_t*)(ws + WS_VW);
    for (int chunk = c.gw; chunk < R / 8; chunk += c.ngw) {
        unsigned vs_[4][4], vw_[4][4];
#pragma unroll
        for (int e = 0; e < 8; ++e) { const int row = chunk * 8 + e; const float* src = KVF + (size_t)row * NKV + 4 * lane;
            f32x4 v[6];
#pragma unroll
            for (int pt = 0; pt < 6; ++pt) v[pt] = *(const f32x4*)(src + pt * 256);
            { float s = (v[2][0] * v[2][0] + v[2][1] * v[2][1]) + (v[2][2] * v[2][2] + v[2][3] * v[2][3]);
              s = row16_sum(s); const float rs = frsq(s * (1.0f / 64.0f) + NORM_EPS); v[2] = v[2] * rs * gs; }
            { float s = (v[4][0] * v[4][0] + v[4][1] * v[4][1]) + (v[4][2] * v[4][2] + v[4][3] * v[4][3]);
              s = row16_sum(s); const float rs = frsq(s * (1.0f / 64.0f) + NORM_EPS); v[4] = v[4] * rs * gw; }
            float* okv = p->out + O_KV + (size_t)row * D + 4 * lane;
#pragma unroll
            for (int pt = 0; pt < 4; ++pt) *(f32x4*)(okv + pt * 256) = v[pt];
            if (row < MP) { const int b = row >> 13, t = row & (TP - 1);
                if (t >= TP - WIN) { float* ow = p->out + O_WINP + ((size_t)(b * WIN + (t - (TP - WIN))) * 2) * 256 + 4 * lane; *(f32x4*)ow = v[4]; *(f32x4*)(ow + 256) = v[5]; }
                const size_t hb = (size_t)(b * G + g);
                { u32x2 w; w.x = pk2(v[0][0], v[0][1]); w.y = pk2(v[0][2], v[0][3]); *(u32x2*)(CA + (hb * 512 + (t >> 4)) * 1024 + (t & 15) * 64 + d0) = w; }
                { u32x2 w; w.x = pk2(v[1][0], v[1][1]); w.y = pk2(v[1][2], v[1][3]); *(u32x2*)(CA + ((size_t)4096 + hb * 512 + (t >> 4)) * 1024 + (t & 15) * 64 + d0) = w; }
                { u32x2 w; w.x = pk2(v[2][0], v[2][1]); w.y = pk2(v[2][2], v[2][3]); *(u32x2*)(KS + (hb * TP + t) * 64 + d0) = w; }
                { u32x2 w; w.x = pk2(v[4][0], v[4][1]); w.y = pk2(v[4][2], v[4][3]); *(u32x2*)(KW + (hb * TP + t) * 64 + d0) = w; }
#pragma unroll
                for (int d = 0; d < 4; ++d) { const unsigned a = f2bf(v[3][d]), bq = f2bf(v[5][d]);
                    if (e & 1) { vs_[d][e >> 1] |= a << 16; vw_[d][e >> 1] |= bq << 16; } else { vs_[d][e >> 1] = a; vw_[d][e >> 1] = bq; } }
            } else { const int b = (row - MP) >> 2, t = (row - MP) & 3;
                float* ow = p->out + O_WINS + ((size_t)(b * WIN + 508 + t) * 2) * 256 + 4 * lane; *(f32x4*)ow = v[4]; *(f32x4*)(ow + 256) = v[5]; }
        }
        if (chunk * 8 < MP) { const int row = chunk * 8, b = row >> 13, t = row & (TP - 1); const size_t hb = (size_t)(b * G + g);
#pragma unroll
            for (int d = 0; d < 4; ++d) { *(u32x4*)(VS + (hb * 64 + d0 + d) * TP + t) = (u32x4){vs_[d][0], vs_[d][1], vs_[d][2], vs_[d][3]};
                *(u32x4*)(VW + (hb * 64 + d0 + d) * TP + t) = (u32x4){vw_[d][0], vw_[d][1], vw_[d][2], vw_[d][3]}; } }
    }
}

__device__ __forceinline__ void phase_cmp2(KP p, const Ctx& c) {
    unsigned char* ws = p->ws; const float* PC = (const float*)(ws + WS_PCMP); const int lane = c.lane, fr = lane & 15, fq = lane >> 4;
    const bf16_t* W2H = (const bf16_t*)(ws + WS_CW2T); const bf16_t* W2L = W2H + 2 * 64 * 128;
    constexpr int NPI = NB * G * 32, NSI = SB * G * 8, TOT = 2 * (NPI + NSI);
    for (int it = c.gw; it < TOT; it += c.ngw) {
        const bool samp = it >= 2 * NPI; const int r = samp ? it - 2 * NPI : it; const int kv = samp ? r / NSI : r / NPI; const int idx = samp ? r % NSI : r % NPI;
        const int hb = samp ? (idx >> 3) : (idx >> 5), n0 = 16 * (samp ? (idx & 7) : (idx & 31)), ncmp = samp ? NCMP_S : NCMP_P, nper = samp ? 128 : 512;
        const int n = n0 + fr; const bool live = n < ncmp;
        const size_t prow = (samp ? (size_t)8192 + (size_t)kv * 65536 : (size_t)kv * 4096) + (size_t)hb * nper + (live ? n : ncmp - 1);
        const float* cb = (const float*)(ws + WS_CBIAS) + kv * 128;
        bf16x8 hh[4], hl[4];
#pragma unroll
        for (int ks = 0; ks < 4; ++ks) { const int k0 = 32 * ks + 8 * fq; unsigned uh[8], ul[8];
            const f32x4 a0 = *(const f32x4*)(PC + prow * 256 + k0), a1 = *(const f32x4*)(PC + prow * 256 + k0 + 4);
            const f32x4 b0 = *(const f32x4*)(PC + (prow + 1) * 256 + 128 + k0), b1 = *(const f32x4*)(PC + (prow + 1) * 256 + 128 + k0 + 4);
            const f32x4 c0 = *(const f32x4*)(cb + k0), c1 = *(const f32x4*)(cb + k0 + 4);
#pragma unroll
            for (int e = 0; e < 8; ++e) { const float x = e < 4 ? a0[e] + b0[e] + c0[e] : a1[e - 4] + b1[e - 4] + c1[e - 4]; const float hv = gelu_tanh(x);
                uh[e] = f2bf(hv); ul[e] = f2bf(hv - __builtin_bit_cast(float, uh[e] << 16)); }
            const u32x4 wh = {uh[0] | (uh[1] << 16), uh[2] | (uh[3] << 16), uh[4] | (uh[5] << 16), uh[6] | (uh[7] << 16)}, wl = {ul[0] | (ul[1] << 16), ul[2] | (ul[3] << 16), ul[4] | (ul[5] << 16), ul[6] | (ul[7] << 16)};
            hh[ks] = __builtin_bit_cast(bf16x8, wh); hl[ks] = __builtin_bit_cast(bf16x8, wl); }
        f32x4 acc[4];
#pragma unroll
        for (int dt = 0; dt < 4; ++dt) { acc[dt] = *(const f32x4*)(p->in[I_CB2] + kv * 64 + 16 * dt + 4 * fq);
#pragma unroll
            for (int ks = 0; ks < 4; ++ks) { const size_t wo = (size_t)(kv * 64 + 16 * dt + fr) * 128 + 32 * ks + 8 * fq; const bf16x8 wh = *(const bf16x8*)(W2H + wo), wl = *(const bf16x8*)(W2L + wo);
                acc[dt] = mfma16(wh, hh[ks], acc[dt]); acc[dt] = mfma16(wh, hl[ks], acc[dt]); acc[dt] = mfma16(wl, hh[ks], acc[dt]); } }
        if (kv == 0) { float ss = 0.f;
#pragma unroll
            for (int dt = 0; dt < 4; ++dt) ss += (acc[dt][0] * acc[dt][0] + acc[dt][1] * acc[dt][1]) + (acc[dt][2] * acc[dt][2] + acc[dt][3] * acc[dt][3]);
            ss = sum_rows4(ss); const float rs = frsq(ss * (1.0f / 64.0f) + NORM_EPS);
#pragma unroll
            for (int dt = 0; dt < 4; ++dt) acc[dt] = acc[dt] * rs * *(const f32x4*)(p->in[I_KNG] + 16 * dt + 4 * fq); }
#pragma unroll
        for (int dt = 0; dt < 4; ++dt) { const f32x4 o = live ? acc[dt] : (f32x4){0.f, 0.f, 0.f, 0.f}; const int d = 16 * dt + 4 * fq;
            if (samp) *(f32x4*)((float*)(ws + (kv ? WS_CVS : WS_CKS)) + ((size_t)hb * 128 + n) * 64 + d) = o;
            else if (kv == 0) { u32x2 w; w.x = pk2(o[0], o[1]); w.y = pk2(o[2], o[3]); *(u32x2*)((bf16_t*)(ws + WS_CK) + ((size_t)hb * 512 + n) * 64 + d) = w; }
            else {
#pragma unroll
                for (int e = 0; e < 4; ++e) ((bf16_t*)(ws + WS_CV))[((size_t)hb * 64 + d + e) * 512 + n] = (bf16_t)f2bf(o[e]); } }
    }
}

__device__ __forceinline__ void phase_qpost(KP p, const Ctx& c, int lb) {
    const float* QF = (const float*)(p->ws + WS_QF); bf16_t* Q = (bf16_t*)(p->ws + WS_Q); const int lane = c.lane;
    const f32x4 gq = *(const f32x4*)(p->in[I_QNG] + lb * 64 + 4 * (lane & 15));
    for (int row = c.gw; row < R; row += c.ngw) { const float* src = QF + (size_t)row * NQP;
        f32x4 v[4]; load_row(src, lane, v);
#pragma unroll
        for (int j = 0; j < 4; ++j) { float s = (v[j][0] * v[j][0] + v[j][1] * v[j][1]) + (v[j][2] * v[j][2] + v[j][3] * v[j][3]);
            s = row16_sum(s);
            const float rs = (frsq(s * (1.0f / 64.0f) + NORM_EPS)) * (0.125f * 1.4426950408889634f); v[j] = v[j] * rs * gq; }
        store_row_bf16(Q + (size_t)row * D, lane, v);
    }
}
constexpr int AT_K0 = 0, AT_V0 = 9216, AT_K1 = 18432, AT_V1 = 27648, AT_IMP = 36864, IMPS = 132, AT_SELM = AT_IMP + 64 * IMPS * 4, AT_ANY = AT_SELM + 1024;
static_assert(AT_ANY + 16 <= RING_BYTES, "attention LDS map");
struct TileSrc { const bf16_t* K; const bf16_t* VT; int vts; };
__device__ __forceinline__ void tile_load(const TileSrc& s, int key0, int tid, u32x4& rk, u32x4& rv) {
    const int row = tid >> 3, ch = tid & 7;
    rk = *(const u32x4*)(s.K + (size_t)(key0 + row) * 64 + 8 * ch); rv = *(const u32x4*)(s.VT + (size_t)row * s.vts + key0 + 8 * ch);
}
__device__ __forceinline__ void tile_store(LAS unsigned char* lds, int buf, int tid, const u32x4& rk, const u32x4& rv) {
    const int row = tid >> 3, ch = tid & 7;
    *(LAS u32x4*)(lds + (buf ? AT_K1 : AT_K0) + (row * SST + 8 * ch) * 2) = rk; *(LAS u32x4*)(lds + (buf ? AT_V1 : AT_V0) + (row * SST + 8 * ch) * 2) = rv;
}
__device__ __forceinline__ int first_bit4(unsigned a, unsigned b, unsigned c, unsigned d) { return a ? __ffs(a) - 1 : (b ? 32 + __ffs(b) - 1 : (c ? 64 + __ffs(c) - 1 : (d ? 96 + __ffs(d) - 1 : -1))); }
__device__ __forceinline__ float ex2(float x) { return __builtin_amdgcn_exp2f(x); }

__device__ __forceinline__ void set_bit4(int s, unsigned& t0, unsigned& t1, unsigned& t2, unsigned& t3) { const unsigned bit = 1u << (s & 31); const int w = s >> 5; t0 |= (w == 0) ? bit : 0u; t1 |= (w == 1) ? bit : 0u; t2 |= (w == 2) ? bit : 0u; t3 |= (w == 3) ? bit : 0u; }
__device__ __forceinline__ void clr_bit4(int s, unsigned& t0, unsigned& t1, unsigned& t2, unsigned& t3) { const unsigned bit = 1u << (s & 31); const int w = s >> 5; t0 &= ~((w == 0) ? bit : 0u); t1 &= ~((w == 1) ? bit : 0u); t2 &= ~((w == 2) ? bit : 0u); t3 &= ~((w == 3) ? bit : 0u); }
__device__ __forceinline__ unsigned get_word4(int s, unsigned a, unsigned b, unsigned c, unsigned d) { const int w = s >> 5; return ((w == 0) ? a : 0u) | ((w == 1) ? b : 0u) | ((w == 2) ? c : 0u) | ((w == 3) ? d : 0u); }
__device__ __forceinline__ float dpp_xor1(float x) { return __builtin_bit_cast(float, __builtin_amdgcn_update_dpp(0, __builtin_bit_cast(int, x), 0xB1, 0xF, 0xF, true)); }
__device__ __forceinline__ float dpp_xor2(float x) { return __builtin_bit_cast(float, __builtin_amdgcn_update_dpp(0, __builtin_bit_cast(int, x), 0x4E, 0xF, 0xF, true)); }
template <int MODE, bool EDGE> __device__ __forceinline__ void attn_tile(LAS unsigned char* lds, int buf, const bf16x8 (&qf)[4], int key0, int qpos, int r, int hf,
                                                                          float& l, f32x16 (&O)[2], float invl, bool selbit, LAS float* impq) {
    if (MODE == 3) { if (__ballot(selbit) == 0ull) return; }
    const int oK = buf ? AT_K1 : AT_K0, oV = buf ? AT_V1 : AT_V0;
#pragma unroll
    for (int kt = 0; kt < 2; ++kt) {
        f32x16 S;
#pragma unroll
        for (int i = 0; i < 16; ++i) S[i] = 0.f;
#pragma unroll
        for (int ks = 0; ks < 4; ++ks) S = mfma32(*(const LAS bf16x8*)(lds + oK + ((32 * kt + r) * SST + 16 * ks + 8 * hf) * 2), qf[ks], S);
        float ls = 0.f;
#pragma unroll
        for (int i = 0; i < 16; ++i) { float pv = ex2(S[i]);
            if (EDGE) { const int key = key0 + 32 * kt + (i & 3) + 8 * (i >> 2) + 4 * hf; bool v;
                if (MODE <= 1) v = (16 * key + 31 <= qpos); else if (MODE == 2) v = (key <= qpos) && (key + WIN > qpos); else v = (key <= qpos);
                pv = v ? pv : 0.f; }
            if (MODE == 1) pv *= invl;
            S[i] = pv; ls += pv; }
        if (MODE == 3) ls = selbit ? ls : 0.f;
        if (MODE != 1) l += ls;
        if (MODE >= 1) {
#pragma unroll
            for (int sp = 0; sp < 2; ++sp) {
                u32x4 pw; pw.x = pg8::cvt_pk_bf16(S[8 * sp + 0], S[8 * sp + 1]); pw.y = pg8::cvt_pk_bf16(S[8 * sp + 2], S[8 * sp + 3]); pw.z = pg8::cvt_pk_bf16(S[8 * sp + 4], S[8 * sp + 5]); pw.w = pg8::cvt_pk_bf16(S[8 * sp + 6], S[8 * sp + 7]);
                if (MODE == 3) { pw.x = selbit ? pw.x : 0u; pw.y = selbit ? pw.y : 0u; pw.z = selbit ? pw.z : 0u; pw.w = selbit ? pw.w : 0u; }
                const bf16x8 pf = __builtin_bit_cast(bf16x8, pw);
#pragma unroll
                for (int dt = 0; dt < 2; ++dt) { const int d = 32 * dt + r, kb = 32 * kt + 16 * sp + 4 * hf;
                    const u32x2 lo = *(const LAS u32x2*)(lds + oV + (d * SST + kb) * 2), hi = *(const LAS u32x2*)(lds + oV + (d * SST + kb + 8) * 2);
                    const u32x4 vw = {lo.x, lo.y, hi.x, hi.y};
                    O[dt] = mfma32(__builtin_bit_cast(bf16x8, vw), pf, O[dt]); } }
        }
        if (MODE == 1) {
            float own[4], nxt[4];
#pragma unroll
            for (int gq = 0; gq < 4; ++gq) { const float p3 = S[4 * gq + 3]; float o = 2.0f * (S[4 * gq] + S[4 * gq + 1] + S[4 * gq + 2]) + p3, n = p3;
                o += dpp_xor1(o); o += dpp_xor2(o); n += dpp_xor1(n); n += dpp_xor2(n); own[gq] = o; nxt[gq] = n; }
            const int sbb = (key0 >> 2) + 8 * kt + hf;
            if ((r & 3) == 0) {
#pragma unroll
                for (int gq = 0; gq < 4; ++gq) impq[sbb + 2 * gq] += own[gq]; }
            asm volatile("s_waitcnt lgkmcnt(0)" ::: "memory");
            if ((r & 3) == 0) {
#pragma unroll
                for (int gq = 0; gq < 4; ++gq) impq[sbb + 2 * gq + 1] += nxt[gq]; }
            asm volatile("s_waitcnt lgkmcnt(0)" ::: "memory");
        }
    }
}

template <int MODE> __device__ __forceinline__ void run_tiles(LAS unsigned char* lds, const TileSrc& src, unsigned t0, unsigned t1, unsigned t2, unsigned t3, int qt,
                                                              const bf16x8 (&qf)[4], int qpos, int r, int hf, int tid,
                                                              float& l, f32x16 (&O)[2], float invl, unsigned s0, unsigned s1, unsigned s2, unsigned s3, LAS float* impq) {
    tid = launder_v(tid); r = tid & 31; hf = (tid >> 5) & 1;
    int cur = first_bit4(t0, t1, t2, t3); if (cur < 0) return;
    clr_bit4(cur, t0, t1, t2, t3); int n1 = first_bit4(t0, t1, t2, t3); if (n1 >= 0) clr_bit4(n1, t0, t1, t2, t3);
    int n2 = first_bit4(t0, t1, t2, t3); if (n2 >= 0) clr_bit4(n2, t0, t1, t2, t3);
    u32x4 rkA, rvA, rkB, rvB; { u32x4 rk, rv; tile_load(src, cur * 64, tid, rk, rv); int b0 = 0; tile_store(lds, b0, tid, rk, rv); }
    if (n1 >= 0) tile_load(src, n1 * 64, tid, rkA, rvA);
    if (n2 >= 0) tile_load(src, n2 * 64, tid, rkB, rvB);
    int buf = 0;
    __syncthreads();
    for (;;) {
        const unsigned sw = get_word4(cur, s0, s1, s2, s3);
        const bool sb = ((sw >> (cur & 31)) & 1u) != 0u;
        if (MODE <= 1) attn_tile<MODE, true>(lds, buf, qf, cur * 64, qpos, r, hf, l, O, invl, sb, impq);
        else { const bool edge = (cur == qt) || (MODE == 2 && cur == qt - 8);
            if (edge) attn_tile<MODE, true>(lds, buf, qf, cur * 64, qpos, r, hf, l, O, invl, sb, impq);
            else attn_tile<MODE, false>(lds, buf, qf, cur * 64, qpos, r, hf, l, O, invl, sb, impq); }
        if (n1 < 0) break;
        tile_store(lds, buf ^ 1, tid, rkA, rvA);
        __syncthreads();
        rkA = rkB; rvA = rvB;
        const int n3 = first_bit4(t0, t1, t2, t3); if (n3 >= 0) { clr_bit4(n3, t0, t1, t2, t3); tile_load(src, n3 * 64, tid, rkB, rvB); }
        buf ^= 1; cur = n1; n1 = n2; n2 = n3;
    }
    __syncthreads();
}
__device__ __forceinline__ void attn_prompt_unit(KP p, const Ctx& c, int k) {
    LAS unsigned char* lds = c.lds; unsigned char* ws = p->ws; const int tid = launder_v(c.tid), lane = tid & 63, wave = c.wave, r = lane & 31, hf = lane >> 5;
    const int qt = 127 - (k >> 3), hb = k & 7, b = hb >> 2, g = hb & 3, q0 = 64 * qt;
    const int qi = 8 * wave + (r >> 2), head = 4 * g + (r & 3), qpos = q0 + qi, row = b * TP + qpos;
    const bf16_t* Q = (const bf16_t*)(ws + WS_Q);
    bf16x8 qf[4];
#pragma unroll
    for (int ks = 0; ks < 4; ++ks) qf[ks] = *(const bf16x8*)(Q + (size_t)row * D + head * 64 + 16 * ks + 8 * hf);
    const float* gate = (const float*)(ws + WS_GATE) + (size_t)row * 48 + head * 3; const float g_c = gate[0], g_s = gate[1], g_w = gate[2];
    LAS float* imp = (LAS float*)(lds + AT_IMP); LAS unsigned* selm = (LAS unsigned*)(lds + AT_SELM); LAS unsigned* anym = (LAS unsigned*)(lds + AT_ANY);
    for (int e = tid; e < 64 * IMPS; e += 512) imp[e] = 0.f;
    if (tid < 4) anym[tid] = 0u;
    __syncthreads();
    f32x16 O[2]; unsigned OUTP[2][8];
#pragma unroll
    for (int dt = 0; dt < 2; ++dt)
#pragma unroll
        for (int i = 0; i < 16; ++i) O[dt][i] = 0.f;
    {
        const TileSrc src{(const bf16_t*)(ws + WS_CK) + (size_t)hb * 512 * 64, (const bf16_t*)(ws + WS_CV) + (size_t)hb * 64 * 512, 512};
        const int nmax = q0 + 63 - 31; const int ntc = nmax >= 0 ? (nmax >> 10) + 1 : 0;
        const unsigned tm = ntc >= 32 ? 0xffffffffu : ((1u << ntc) - 1u);
        float l = 0.f;
        run_tiles<0>(lds, src, tm, 0u, 0u, 0u, qt, qf, qpos, r, hf, tid, l, O, 0.f, 0u, 0u, 0u, 0u, imp);
        l = sum_xor32(l); const float invl = l > 0.f ? 1.0f / l : 0.f;
        run_tiles<1>(lds, src, tm, 0u, 0u, 0u, qt, qf, qpos, r, hf, tid, l, O, invl, 0u, 0u, 0u, 0u, imp + qi * IMPS);
#pragma unroll
        for (int dt = 0; dt < 2; ++dt) {
#pragma unroll
            for (int i = 0; i < 8; ++i) OUTP[dt][i] = pg8::cvt_pk_bf16(O[dt][2 * i] * g_c, O[dt][2 * i + 1] * g_c);
#pragma unroll
            for (int i = 0; i < 16; ++i) O[dt][i] = 0.f; }
    }
    __syncthreads();
    for (int e = 0; e < 8; ++e) { const int qq = 8 * wave + e, qp = q0 + qq, qb = qp >> 6;
        const bool c0 = (64 * lane <= qp), c1 = (64 * (lane + 64) <= qp);
        const unsigned k0 = (lane == 0 || lane == qb || lane == qb - 1) ? 0xffffffffu : __builtin_bit_cast(unsigned, imp[qq * IMPS + lane]);
        const unsigned k1 = (lane + 64 == qb || lane + 64 == qb - 1) ? 0xffffffffu : __builtin_bit_cast(unsigned, imp[qq * IMPS + lane + 64]);
        const int K = qb + 1 < 16 ? qb + 1 : 16;
        unsigned T = 0u;
        for (int bit = 31; bit >= 0; --bit) { const unsigned cand = T | (1u << bit);
            const int cnt = __popcll(__ballot(c0 && k0 >= cand)) + __popcll(__ballot(c1 && k1 >= cand)); if (cnt >= K) T = cand; }
        unsigned long long mlo = __ballot(c0 && k0 > T), mhi = __ballot(c1 && k1 > T), elo = __ballot(c0 && k0 == T), ehi = __ballot(c1 && k1 == T);
        int need = K - (__popcll(mlo) + __popcll(mhi));
        for (; need > 0; --need) { if (elo) { mlo |= elo & (~elo + 1ull); elo &= elo - 1ull; } else { mhi |= ehi & (~ehi + 1ull); ehi &= ehi - 1ull; } }
        const unsigned m0 = (unsigned)mlo, m1 = (unsigned)(mlo >> 32), m2 = (unsigned)mhi, m3 = (unsigned)(mhi >> 32);
        if (lane == 0) { selm[qq * 4 + 0] = m0; selm[qq * 4 + 1] = m1; selm[qq * 4 + 2] = m2; selm[qq * 4 + 3] = m3;
            atomicOr((unsigned*)&anym[0], m0); atomicOr((unsigned*)&anym[1], m1); atomicOr((unsigned*)&anym[2], m2); atomicOr((unsigned*)&anym[3], m3); } }
    __syncthreads();
    {
        const TileSrc src{(const bf16_t*)(ws + WS_KW) + (size_t)hb * TP * 64, (const bf16_t*)(ws + WS_VW) + (size_t)hb * 64 * TP, TP};
        const int tlo = qt >= 8 ? qt - 8 : 0; unsigned t0 = 0u, t1 = 0u, t2 = 0u, t3 = 0u;
        for (int s = tlo; s <= qt; ++s) set_bit4(s, t0, t1, t2, t3);
        float l = 0.f;
        run_tiles<2>(lds, src, t0, t1, t2, t3, qt, qf, qpos, r, hf, tid, l, O, 0.f, 0u, 0u, 0u, 0u, imp);
        l = sum_xor32(l); const float sc = l > 0.f ? g_w / l : 0.f;
#pragma unroll
        for (int dt = 0; dt < 2; ++dt) {
#pragma unroll
            for (int i = 0; i < 8; ++i) OUTP[dt][i] = pg8::cvt_pk_bf16(bflo(OUTP[dt][i]) + O[dt][2 * i] * sc, bfhi(OUTP[dt][i]) + O[dt][2 * i + 1] * sc);
#pragma unroll
            for (int i = 0; i < 16; ++i) O[dt][i] = 0.f; }
    }
    {
        const TileSrc src{(const bf16_t*)(ws + WS_KS) + (size_t)hb * TP * 64, (const bf16_t*)(ws + WS_VS) + (size_t)hb * 64 * TP, TP};
        const unsigned s0 = selm[qi * 4 + 0], s1 = selm[qi * 4 + 1], s2 = selm[qi * 4 + 2], s3 = selm[qi * 4 + 3];
        const unsigned a0 = anym[0], a1 = anym[1], a2 = anym[2], a3 = anym[3];
        float l = 0.f;
        run_tiles<3>(lds, src, a0, a1, a2, a3, qt, qf, qpos, r, hf, tid, l, O, 0.f, s0, s1, s2, s3, imp);
        l = sum_xor32(l); const float sc = l > 0.f ? g_s / l : 0.f;
#pragma unroll
        for (int dt = 0; dt < 2; ++dt)
#pragma unroll
            for (int i = 0; i < 8; ++i) OUTP[dt][i] = pg8::cvt_pk_bf16(bflo(OUTP[dt][i]) + O[dt][2 * i] * sc, bfhi(OUTP[dt][i]) + O[dt][2 * i + 1] * sc);
    }
    bf16_t* AO = (bf16_t*)(ws + WS_YG) + (size_t)row * D + head * 64;
#pragma unroll
    for (int dt = 0; dt < 2; ++dt)
#pragma unroll
        for (int gq = 0; gq < 4; ++gq) { u32x2 w; w.x = OUTP[dt][2 * gq]; w.y = OUTP[dt][2 * gq + 1]; *(u32x2*)(AO + 32 * dt + 8 * gq + 4 * hf) = w; }
    __syncthreads();
}

constexpr int SA_RED = 0, SA_REDW = 2 * 16 * 65 * 4, SA_OC = SA_RED + SA_REDW, SA_EC = SA_OC + 2 * 4096, SA_LC = SA_EC + 2 * 4096, SA_PN = SA_LC + 256, SA_SEL = SA_PN + 4 * 512;
static_assert(SA_SEL + 64 <= RING_BYTES, "sample attention LDS map");
__device__ __forceinline__ bf16x8 pack8(const f32x4 a, const f32x4 b) { const u32x4 w = {pk2(a[0], a[1]), pk2(a[2], a[3]), pk2(b[0], b[1]), pk2(b[2], b[3])}; return __builtin_bit_cast(bf16x8, w); }
__device__ __forceinline__ void sa_qk(const float* kb, size_t stride, int nrows, const bf16x8 (&qf)[2], int fr, int fq, f32x4 (&S)[4]) {
    f32x4 kr[4][2][2];
#pragma unroll
    for (int kg = 0; kg < 4; ++kg) { const int key = 16 * kg + fr; const float* rp = kb + (size_t)(key < nrows ? key : nrows - 1) * stride + 8 * fq;
#pragma unroll
        for (int ks = 0; ks < 2; ++ks) { kr[kg][ks][0] = *(const f32x4*)(rp + 32 * ks); kr[kg][ks][1] = *(const f32x4*)(rp + 32 * ks + 4); } }
#pragma unroll
    for (int kg = 0; kg < 4; ++kg) { S[kg] = (f32x4){0.f, 0.f, 0.f, 0.f};
#pragma unroll
        for (int ks = 0; ks < 2; ++ks) S[kg] = mfma16(pack8(kr[kg][ks][0], kr[kg][ks][1]), qf[ks], S[kg]); }
}
__device__ __forceinline__ void sa_pv(const float* vb, size_t stride, int nrows, const f32x4 (&P)[4], int fr, int fq, f32x4 (&O)[4]) {
#pragma unroll
    for (int ks = 0; ks < 2; ++ks) { const bf16x8 pa = pack8(P[2 * ks], P[2 * ks + 1]);
        float vv[4][8];
#pragma unroll
        for (int j = 0; j < 8; ++j) { const int key = 16 * (2 * ks + (j >> 2)) + 4 * fq + (j & 3); const float* rp = vb + (size_t)(key < nrows ? key : nrows - 1) * stride + fr;
#pragma unroll
            for (int dt = 0; dt < 4; ++dt) vv[dt][j] = rp[16 * dt]; }
#pragma unroll
        for (int dt = 0; dt < 4; ++dt) { const u32x4 w = {pk2(vv[dt][0], vv[dt][1]), pk2(vv[dt][2], vv[dt][3]), pk2(vv[dt][4], vv[dt][5]), pk2(vv[dt][6], vv[dt][7])};
            O[dt] = mfma16(pa, __builtin_bit_cast(bf16x8, w), O[dt]); } }
}
__device__ __forceinline__ void attn_sample_unit(KP p, const Ctx& c, int item) {
    unsigned char* ws = p->ws; LAS unsigned char* lds = c.lds; const int tid = launder_v(c.tid), lane = tid & 63, wave = c.wave, fr = lane & 15, fq = lane >> 4; const int b = item >> 2, g = item & 3;
    bf16x8 qf[2];
    { const bf16_t* Q = (const bf16_t*)(ws + WS_Q) + (size_t)(MP + 4 * b + (fr >> 2)) * D + (4 * g + (fr & 3)) * 64 + 8 * fq;
      qf[0] = *(const bf16x8*)Q; qf[1] = *(const bf16x8*)(Q + 32); }
    const int tokm = fr >> 2;
    if (wave < 2) {
        const float* ck = (const float*)(ws + WS_CKS) + ((size_t)(b * 4 + g) * 128 + 64 * wave) * 64; const float* cv = (const float*)(ws + WS_CVS) + ((size_t)(b * 4 + g) * 128 + 64 * wave) * 64;
        const int nrows = wave ? 63 : 64;
        f32x4 S[4]; sa_qk(ck, 64, nrows, qf, fr, fq, S);
        float ls = 0.f;
#pragma unroll
        for (int kg = 0; kg < 4; ++kg)
#pragma unroll
            for (int r = 0; r < 4; ++r) { const int key = 16 * kg + 4 * fq + r; const float ev = key < nrows ? ex2(S[kg][r]) : 0.f; S[kg][r] = ev; ls += ev;
                *(LAS float*)(lds + SA_EC + wave * 4096 + (key * 16 + fr) * 4) = ev; }
        ls = sum_rows4(ls); if (fq == 0) *(LAS float*)(lds + SA_LC + (wave * 16 + fr) * 4) = ls;
        f32x4 oc[4];
#pragma unroll
        for (int dt = 0; dt < 4; ++dt) oc[dt] = (f32x4){0.f, 0.f, 0.f, 0.f};
        sa_pv(cv, 64, nrows, S, fr, fq, oc);
#pragma unroll
        for (int dt = 0; dt < 4; ++dt)
#pragma unroll
            for (int r = 0; r < 4; ++r) *(LAS float*)(lds + SA_OC + wave * 4096 + ((4 * fq + r) * 64 + 16 * dt + fr) * 4) = oc[dt][r];
    }
    __syncthreads();
    if (wave < 4) { const int tok = wave; float P0 = 0.f, P1 = 0.f;
#pragma unroll
        for (int hh = 0; hh < 4; ++hh) { const int pi = tok * 4 + hh; const float L = *(const LAS float*)(lds + SA_LC + pi * 4) + *(const LAS float*)(lds + SA_LC + (16 + pi) * 4); const float inv = L > 0.f ? 1.0f / L : 0.f;
            P0 += *(const LAS float*)(lds + SA_EC + (lane * 16 + pi) * 4) * inv; P1 += *(const LAS float*)(lds + SA_EC + 4096 + (lane * 16 + pi) * 4) * inv; }
        LAS float* pn = (LAS float*)(lds + SA_PN + tok * 512); pn[lane] = P0; pn[64 + lane] = P1; LDS_WAIT();
        float v0 = -1e9f;
        if (lane < 33) { const int s = lane; float im = 0.f;
            if (4 * s - 1 >= 0 && 4 * s - 1 < 128) im += pn[4 * s - 1];
#pragma unroll
            for (int j = 0; j < 3; ++j) if (4 * s + j < 128) im += 2.0f * pn[4 * s + j];
            if (4 * s + 3 < 128) im += pn[4 * s + 3];
            v0 = (s == 0 || s == 31 || s == 32) ? 1e9f : im; }
        unsigned selmask = 0u, sel32 = 0u;
        for (int it = 0; it < 16; ++it) { const float mx = wave_max(v0); if (mx < -5e8f) break; const unsigned long long b0 = __ballot(v0 == mx); const int s = __ffsll((long long)b0) - 1;
            if (lane == s) v0 = -2e9f; if (s < 32) selmask |= 1u << s; else sel32 = 1u; }
        if (lane == 0) { *(LAS unsigned*)(lds + SA_SEL + tok * 8) = selmask; *(LAS unsigned*)(lds + SA_SEL + tok * 8 + 4) = sel32; } }
    __syncthreads();
    unsigned sm[4], s32[4];
#pragma unroll
    for (int t = 0; t < 4; ++t) { sm[t] = *(const LAS unsigned*)(lds + SA_SEL + t * 8); s32[t] = *(const LAS unsigned*)(lds + SA_SEL + t * 8 + 4); }
    const unsigned un = sm[0] | sm[1] | sm[2] | sm[3]; const int nsel = __popc(un); const int has32 = (s32[0] | s32[1] | s32[2] | s32[3]) ? 1 : 0;
    const unsigned my_sm = tokm == 0 ? sm[0] : (tokm == 1 ? sm[1] : (tokm == 2 ? sm[2] : sm[3])), my_s32 = tokm == 0 ? s32[0] : (tokm == 1 ? s32[1] : (tokm == 2 ? s32[2] : s32[3]));
    const int ntile = nsel + has32 + 9;
    const int* pt = (const int*)p->in[I_PT] + b * NPAGES;
    f32x4 osel[4], owin[4]; float lsel = 0.f, lwin = 0.f;
#pragma unroll
    for (int dt = 0; dt < 4; ++dt) { osel[dt] = (f32x4){0.f, 0.f, 0.f, 0.f}; owin[dt] = (f32x4){0.f, 0.f, 0.f, 0.f}; }
    for (int ti = wave; ti < ntile; ti += 8) {
        const float* kb; size_t stride; int nrows = 64, br, mode, sidx = 0;
        if (ti < nsel) { unsigned m = un; for (int q = 0; q < ti; ++q) m &= m - 1u; sidx = __ffs(m) - 1; const int page = pt[sidx >> 1];
            kb = p->in[I_CKV] + ((size_t)page * PAGE + (sidx & 1) * 64) * 1024 + 2 * 256 + g * 64; stride = 1024; br = 0; mode = 0; }
        else if (ti < nsel + has32) { kb = p->out + O_KV + (size_t)(MP + 4 * b) * D + 2 * 256 + g * 64; stride = 1024; nrows = 4; br = 0; mode = 1; }
        else if (ti < nsel + has32 + 8) { sidx = ti - nsel - has32; kb = p->in[I_CWIN] + ((size_t)b * WIN + 64 * sidx) * 512 + g * 64; stride = 512; br = 1; mode = 2; }
        else { kb = p->out + O_WINS + ((size_t)(b * WIN + 508) * 2) * 256 + g * 64; stride = 512; nrows = 4; br = 1; mode = 3; }
        f32x4 S[4]; sa_qk(kb, stride, nrows, qf, fr, fq, S);
        float ls = 0.f;
#pragma unroll
        for (int kg = 0; kg < 4; ++kg)
#pragma unroll
            for (int r = 0; r < 4; ++r) { const int key = 16 * kg + 4 * fq + r; bool valid;
                if (mode == 0) valid = ((my_sm >> sidx) & 1u) != 0u; else if (mode == 1) valid = (my_s32 != 0u) && (key <= tokm); else if (mode == 2) valid = (64 * sidx + key) >= tokm + 1; else valid = key <= tokm;
                const float ev = valid ? ex2(S[kg][r]) : 0.f; S[kg][r] = ev; ls += ev; }
        if (br == 0) { lsel += ls; sa_pv(kb + 256, stride, nrows, S, fr, fq, osel); } else { lwin += ls; sa_pv(kb + 256, stride, nrows, S, fr, fq, owin); }
    }
    lsel = sum_rows4(lsel); lwin = sum_rows4(lwin);
    for (int w = 0; w < 8; ++w) {
        if (wave == w) {
#pragma unroll
            for (int dt = 0; dt < 4; ++dt)
#pragma unroll
                for (int r = 0; r < 4; ++r) { LAS float* r0 = (LAS float*)(lds + SA_RED + ((4 * fq + r) * 65 + 16 * dt + fr) * 4); LAS float* r1 = (LAS float*)(lds + SA_RED + ((16 + 4 * fq + r) * 65 + 16 * dt + fr) * 4);
                    if (w == 0) { *r0 = osel[dt][r]; *r1 = owin[dt][r]; } else { *r0 += osel[dt][r]; *r1 += owin[dt][r]; } }
            if (fq == 0) { LAS float* l0 = (LAS float*)(lds + SA_RED + (fr * 65 + 64) * 4); LAS float* l1 = (LAS float*)(lds + SA_RED + ((16 + fr) * 65 + 64) * 4);
                if (w == 0) { *l0 = lsel; *l1 = lwin; } else { *l0 += lsel; *l1 += lwin; } } }
        __syncthreads(); }
    { const float* gt = (const float*)(ws + WS_GATE); bf16_t* AO = (bf16_t*)(ws + WS_YG);
      for (int e = tid; e < 1024; e += 512) { const int pi = e >> 6, d = e & 63, tok = pi >> 2, hh = pi & 3; const size_t row = (size_t)(MP + 4 * b + tok);
          const float lc = *(const LAS float*)(lds + SA_LC + pi * 4) + *(const LAS float*)(lds + SA_LC + (16 + pi) * 4);
          const float oc = *(const LAS float*)(lds + SA_OC + (pi * 64 + d) * 4) + *(const LAS float*)(lds + SA_OC + 4096 + (pi * 64 + d) * 4);
          const LAS float* r0 = (const LAS float*)(lds + SA_RED + (pi * 65) * 4); const LAS float* r1 = (const LAS float*)(lds + SA_RED + ((16 + pi) * 65) * 4);
          const float* gg = gt + row * 48 + (4 * g + hh) * 3;
          float out = lc > 0.f ? gg[0] * oc / lc : 0.f;
          out += r0[64] > 0.f ? gg[1] * r0[d] / r0[64] : 0.f;
          out += r1[64] > 0.f ? gg[2] * r1[d] / r1[64] : 0.f;
          AO[row * D + (4 * g + hh) * 64 + d] = (bf16_t)f2bf(out); } }
    __syncthreads();
}

__device__ __forceinline__ void phase_attn_prompt(KP p, const Ctx& c) {
    const int Gd = gridDim.x, cb = blockIdx.x;
    for (int i = 0; i * Gd < 1024; ++i) { const int k = i * Gd + ((i & 1) ? Gd - 1 - cb : cb); if (k < 1024) attn_prompt_unit(p, c, k); }
}
__device__ __forceinline__ void phase_attn_sample(KP p, const Ctx& c) {
    for (int it = blockIdx.x; it < SB * G; it += gridDim.x) attn_sample_unit(p, c, it);
}
#ifndef MK_MULTI
#define MK_MULTI 0
#endif
#if defined(PROBE_SCALE) || defined(SELFTEST)
constexpr int NPH = 46;
#elif defined(PROBE_ATTN2)
constexpr int NPH = 47;
#else
constexpr int NPH = 45;
#endif
#ifdef SPLITK
#define RESID_SPLIT(n) (n)
#else
#define RESID_SPLIT(n) 0
#endif

__global__ void __launch_bounds__(512, 2) mega(Params p) {
    extern __shared__ __attribute__((aligned(16))) unsigned char lds_raw[];
    LAS unsigned char* const lds0 = (LAS unsigned char*)lds_raw;
    volatile LAS unsigned* MISC = (volatile LAS unsigned*)(lds0 + MISC_OFF);
    for (int u = threadIdx.x; u < (LDS_BYTES - RING_BYTES) / 4; u += 512) ((LAS unsigned*)(lds0 + RING_BYTES))[u] = 0u;
    __syncthreads();
    const KP kp0 = (KP)__builtin_amdgcn_kernarg_segment_ptr();
    const int ph_lo = kp0->ph_lo, ph_hi = kp0->ph_hi, use_bar = kp0->use_bar;
    XcdBarrier bar; bar.bar = (unsigned*)(kp0->ws + WS_CTL); bar.x = 0; bar.st = nullptr;
    if (use_bar) bar = xcd_barrier_post((unsigned*)(kp0->ws + WS_CTL), MISC + 8);
    const int wave_s = __builtin_amdgcn_readfirstlane((int)threadIdx.x >> 6);
#define TID_MBCNT 1
#ifdef TID_MBCNT
#define TID_SRC(T_) asm volatile("v_mbcnt_lo_u32_b32 %0, -1, 0\n\tv_mbcnt_hi_u32_b32 %0, -1, %0" : "=v"(T_)); T_ += 64 * wave_s;
#else
#define TID_SRC(T_) T_ = threadIdx.x; asm volatile("" : "+v"(T_));
#endif
    int ph = 0;
#define PHASE_BEGIN if (ph >= ph_lo && ph < ph_hi) { KP p = kp0; asm volatile("" : "+s"(p)); int tid_; TID_SRC(tid_) \
        Ctx c; c.lds = lds0; c.tid = tid_; c.lane = tid_ & 63; c.wave = __builtin_amdgcn_readfirstlane(tid_ >> 6); c.gw = blockIdx.x * 8 + c.wave; c.ngw = gridDim.x * 8; c.gtid = blockIdx.x * 512 + tid_; c.gsz = gridDim.x * 512; \
        unsigned char* ws = p->ws; float* X = p->out + O_Y; (void)ws; (void)X;
#define PHASE_END   if (use_bar) xcd_barrier(bar, c.tid == 0); } ++ph;

    PHASE_BEGIN phase_prologue(p, c); PHASE_END
#ifdef PROBE_BAR
    for (int xb = 0; xb < PROBE_BAR; ++xb) { if (use_bar) xcd_barrier(bar, threadIdx.x == 0); }
#endif

    for (int layer = 0; layer < NLAY; ++layer) {
        if (layer < 2) {
            const int li = layer;
            PHASE_BEGIN phase_mix(p, c, li); PHASE_END
            PHASE_BEGIN {
                pg8::Gemm g{(const bf16_t*)(ws + WS_XM), (const bf16_t*)(ws + WS_WRKV) + (size_t)li * 3072 * 1024, 3 * R, 3072, 1024, 1024};
                pg8::GroupOrder S; S.init((int)gridDim.x, (int)blockIdx.x); S.add(0, 0, 64, 0, 4); S.add(1, 66, 64, 4, 4); S.add(2, 132, 64, 8, 4);
                pg8::EpiF32G E{(float*)(ws + WS_RK_R), (float*)(ws + WS_RK_K), (float*)(ws + (li ? WS_V1 : WS_V0)), nullptr, D, 4, 66};
                pg8::gemm_phase<pg8::EpiF32G, pg8::GroupOrder, true, true>(c.lds, g, S, E, c.tid);
                {
                    const bf16_t* XMs = (const bf16_t*)(ws + WS_XM); const bf16_t* Wr = (const bf16_t*)(ws + WS_WRKV) + (size_t)li * 3072 * 1024;
                    for (int it = blockIdx.x + gridDim.x * c.wave; it < 768; it += c.ngw) { const int j = it >> 8, r = it & 255, row0 = MP + 32 * (r & 15), col0 = 64 * (r >> 4);
                        float* C = (float*)(ws + (j == 0 ? WS_RK_R : (j == 1 ? WS_RK_K : (li ? WS_V1 : WS_V0))));
                        f32x4 acc[4][2]; skinny_mma<4>(XMs + (size_t)j * R * D, 1024, Wr + (size_t)j * 1024 * 1024, 1024, 1024, row0, col0, c.lane, acc);
                        const int fr = c.lane & 15, fq = c.lane >> 4;
#pragma unroll
                        for (int nt = 0; nt < 4; ++nt)
#pragma unroll
                            for (int mt = 0; mt < 2; ++mt) *(f32x4*)(C + (size_t)(row0 + 16 * mt + fr) * D + col0 + 16 * nt + 4 * fq) = acc[nt][mt]; }
                }
                phase_lora1(p, c, li);
            } PHASE_END
            PHASE_BEGIN phase_scanA(p, c, li); PHASE_END
            PHASE_BEGIN phase_scanB(p, c, li); PHASE_END
            PHASE_BEGIN phase_scanC(p, c, li); PHASE_END
        } else {
            const int lb = layer - 2;
            if (layer == 2) {
                PHASE_BEGIN phase_norm(c, X, p->in[I_KVNG], (bf16_t*)(ws + WS_XN2), p->in[I_NORMG] + (size_t)(layer * 2) * D, (bf16_t*)(ws + WS_XN)); PHASE_END
                PHASE_BEGIN {
                    pg8::Gemm g{(const bf16_t*)(ws + WS_XN2), (const bf16_t*)(ws + WS_WKVT), R, NKV, 1024, 1024};
                    pg8::GroupOrder S; S.init((int)gridDim.x, (int)blockIdx.x); S.add(0, 0, 66, 0, 6);
                    pg8::EpiF32G E{(float*)(ws + WS_KVF), nullptr, nullptr, nullptr, NKV, 1 << 20, 0};
                    pg8::gemm_phase<pg8::EpiF32G, pg8::GroupOrder, true, true>(c.lds, g, S, E, c.tid);
                } PHASE_END
                PHASE_BEGIN phase_kvpost(p, c); PHASE_END
                PHASE_BEGIN {
                    pg8::Gemm g{(const bf16_t*)(ws + WS_CMPA), (const bf16_t*)(ws + WS_CW1T), (int)CMPA_ROWS, 512, 1024, 1024};
                    pg8::GroupOrder S; S.init((int)gridDim.x, (int)blockIdx.x); S.add(0, 0, 16, 0, 1); S.add(1, 16, 16, 1, 1); S.add(2, 32, 256, 0, 1); S.add(3, 288, 256, 1, 1);
                    pg8::EpiF32G E{(float*)(ws + WS_PCMP), (float*)(ws + WS_PCMP), nullptr, nullptr, 256, 1, 0};
                    pg8::gemm_phase<pg8::EpiF32G, pg8::GroupOrder, true, true>(c.lds, g, S, E, c.tid);
                } PHASE_END
                PHASE_BEGIN phase_cmp2(p, c); PHASE_END
            } else {
                PHASE_BEGIN phase_norm(c, X, p->in[I_NORMG] + (size_t)(layer * 2) * D, (bf16_t*)(ws + WS_XN), nullptr, nullptr); PHASE_END
            }
            PHASE_BEGIN {
                const bf16_t* XNp = (const bf16_t*)(ws + WS_XN); const bf16_t* Wq = (const bf16_t*)(ws + WS_WQT) + (size_t)lb * NQP * 1024; float* QFp = (float*)(ws + WS_QF);
                pg8::Gemm g{XNp, Wq, R, NQP, 1024, 1024};
                pg8::GroupOrder S; S.init((int)gridDim.x, (int)blockIdx.x); S.add(0, 0, 64, 0, 4);
                pg8::EpiF32G E{QFp, nullptr, nullptr, nullptr, NQP, 1 << 20, 0};
                pg8::gemm_phase<pg8::EpiF32G, pg8::GroupOrder, true, true>(c.lds, g, S, E, c.tid);
                float* GATEp = (float*)(ws + WS_GATE);
                for (int it = blockIdx.x + gridDim.x * c.wave; it < 256 + R / 32; it += c.ngw) { const int ln = launder_v(c.lane), fr = ln & 15, fq = ln >> 4;
                    if (it < 256) { const int row0 = MP + 32 * (it & 15), col0 = 64 * (it >> 4);
                        f32x4 acc[4][2]; skinny_mma<4>(XNp, 1024, Wq, 1024, 1024, row0, col0, ln, acc);
#pragma unroll
                        for (int nt = 0; nt < 4; ++nt)
#pragma unroll
                            for (int mt = 0; mt < 2; ++mt) *(f32x4*)(QFp + (size_t)(row0 + 16 * mt + fr) * NQP + col0 + 16 * nt + 4 * fq) = acc[nt][mt]; }
                    else { const int row0 = 32 * (it - 256);
                        f32x4 acc[3][2]; skinny_mma<3>(XNp, 1024, Wq, 1024, 1024, row0, 1024, ln, acc);
#pragma unroll
                        for (int nt = 0; nt < 3; ++nt)
#pragma unroll
                            for (int mt = 0; mt < 2; ++mt) { f32x4 v = acc[nt][mt];
#pragma unroll
                                for (int e = 0; e < 4; ++e) v[e] = sigmoidf_(v[e]);
                                *(f32x4*)(GATEp + (size_t)(row0 + 16 * mt + fr) * 48 + 16 * nt + 4 * fq) = v; } }
                }
            } PHASE_END
            PHASE_BEGIN phase_qpost(p, c, lb); PHASE_END
            PHASE_BEGIN phase_attn_prompt(p, c); PHASE_END
#ifdef PROBE_ATTN2
            PHASE_BEGIN phase_attn_prompt(p, c); PHASE_END
#endif
            PHASE_BEGIN phase_attn_sample(p, c); PHASE_END
        }
        PHASE_BEGIN {
            const bf16_t* Wt = layer < 2 ? (const bf16_t*)(ws + WS_WORW) + (size_t)layer * 1024 * 1024 : (const bf16_t*)(ws + WS_WONSA) + (size_t)(layer - 2) * 1024 * 1024;
            pg8::Gemm g{(const bf16_t*)(ws + WS_YG), Wt, R, 1024, 1024, 1024};
            pg8::GroupOrder S; S.init((int)gridDim.x, (int)blockIdx.x); S.add(0, 0, 64, 0, 4);
            pg8::EpiResid E{X, D};
            pg8::gemm_phase<pg8::EpiResid, pg8::GroupOrder, true, true>(c.lds, g, S, E, c.tid);
            skinny_resid_sample(c, (const bf16_t*)(ws + WS_YG), 1024, Wt, 1024, X);
        } PHASE_END
        PHASE_BEGIN phase_norm(c, X, p->in[I_NORMG] + (size_t)(layer * 2 + 1) * D, (bf16_t*)(ws + WS_XN), nullptr, nullptr); PHASE_END
        PHASE_BEGIN {
            pg8::Gemm g{(const bf16_t*)(ws + WS_XN), (const bf16_t*)(ws + WS_WINT) + (size_t)layer * 5632 * 1024, R, 5632, 1024, 1024};
            pg8::GroupOrder S; S.init((int)gridDim.x, (int)blockIdx.x); S.add(0, 0, 66, 0, 22);
            pg8::EpiWin E{(bf16_t*)(ws + WS_U), (bf16_t*)(ws + WS_GT), p->out + O_CVP + (size_t)layer * NB * 2 * DFF, p->out + O_CVS + (size_t)layer * SB * 2 * DFF};
            pg8::gemm_phase<pg8::EpiWin, pg8::GroupOrder, true, true>(c.lds, g, S, E, c.tid);
        } PHASE_END
        PHASE_BEGIN phase_conv(p, c, layer); PHASE_END
        PHASE_BEGIN {
            pg8::Gemm g{(const bf16_t*)(ws + WS_HH), (const bf16_t*)(ws + WS_WOUTT) + (size_t)layer * 1024 * 2816, R, 1024, 2816, 2816};
            pg8::GroupOrder S; S.init((int)gridDim.x, (int)blockIdx.x); S.add(0, 0, 64, 0, 4);
            pg8::EpiResid E{X, D};
            pg8::gemm_phase<pg8::EpiResid, pg8::GroupOrder, true, true>(c.lds, g, S, E, c.tid);
            skinny_resid_sample(c, (const bf16_t*)(ws + WS_HH), 2816, (const bf16_t*)(ws + WS_WOUTT) + (size_t)layer * 1024 * 2816, 2816, X);
        } PHASE_END
    }
#ifdef SELFTEST
    PHASE_BEGIN if (blockIdx.x == 0 && c.wave == 0) { const float x = (float)((c.lane * 37) & 63) + 1.0f; float poison = 0.f;
        if (__ballot(swz_xor16_n(x) != __shfl_xor(x, 16))) poison += 1e3f;
        if (__ballot(sum_xor32_n(x) != x + __shfl_xor(x, 32))) poison += 1e4f;
        if (__ballot(sum_rows4_n(x) != x + __shfl_xor(x, 16) + __shfl_xor(x, 32) + __shfl_xor(x, 48))) poison += 1e5f;
        if (__ballot(wave_sum_n(x) != 2080.0f)) poison += 1e6f;
        if (__ballot(wave_max_n(x) != 64.0f)) poison += 1e7f;
        if (c.lane == 0) p->out[O_CVS] += poison; } PHASE_END
#endif
#ifdef PROBE_SCALE
    PHASE_BEGIN for (size_t e = c.gtid; e < O_END; e += c.gsz) { int oi = e < O_KV ? (e < (size_t)MP * D ? 0 : 1) : e < O_WINP ? (e < O_KV + (size_t)MP * D ? 2 : 3) : e < O_WINS ? 4 : e < O_WKVP ? 5 : e < O_WKVS ? 6 : e < O_SHP ? 7 : e < O_SHS ? 8 : e < O_CVP ? 9 : e < O_CVS ? 10 : 11;
        if (PROBE_SCALE < 0) oi = 11 - oi; p->out[e] *= 1.0f + sqrtf(0.5e-4f * (float)(oi + 1)); } PHASE_END
#endif
#undef PHASE_BEGIN
#undef PHASE_END
}

extern "C" void kernel_launch(void* const* d_in, const int* in_sizes, int n_in, void* d_out, int out_size, void* d_ws, size_t ws_size, hipStream_t stream) {
    static int grid = 0;
    if (grid == 0) {
        if (n_in != 45 || (size_t)out_size != O_END || ws_size < WS_END) { fprintf(stderr, "kernel_launch: unexpected shapes (n_in %d out %d ws %zu need %zu)\n", n_in, out_size, ws_size, (size_t)WS_END); grid = -1; return; }
        int dev = 0, cus = 0, per_cu = 0;
        if (hipGetDevice(&dev) != hipSuccess || hipDeviceGetAttribute(&cus, hipDeviceAttributeMultiprocessorCount, dev) != hipSuccess) { grid = -1; return; }
        if (hipFuncSetAttribute((const void*)mega, hipFuncAttributeMaxDynamicSharedMemorySize, LDS_BYTES) != hipSuccess) { fprintf(stderr, "kernel_launch: hipFuncSetAttribute failed\n"); grid = -1; return; }
        if (hipOccupancyMaxActiveBlocksPerMultiprocessor(&per_cu, (const void*)mega, 512, LDS_BYTES) != hipSuccess || per_cu < 1) { fprintf(stderr, "kernel_launch: occupancy query says %d\n", per_cu); (void)hipGetLastError(); }
        grid = cus;
    }
    if (grid < 0) return;
    (void)hipMemsetAsync((char*)d_ws + WS_CTL, 0, CTL_BYTES, stream);
    Params p{};
    for (int i = 0; i < 45; ++i) p.in[i] = (const float*)d_in[i];
    p.out = (float*)d_out; p.ws = (unsigned char*)d_ws;
#ifdef PROBE_PRE
    { const int plist[] = PROBE_PRE; for (int i = 0; i < (int)(sizeof(plist) / sizeof(int)); ++i) { p.ph_lo = plist[i] % 100; p.ph_hi = p.ph_lo + 1; p.use_bar = 0; p.pad = plist[i] / 100;       hipLaunchKernelGGL(mega, dim3(grid), dim3(512), LDS_BYTES, stream, p); } }
#endif
    p.pad = 0;
#if MK_MULTI
    for (int i = 0; i < NPH; ++i) { p.ph_lo = i; p.ph_hi = i + 1; p.use_bar = 0; hipLaunchKernelGGL(mega, dim3(grid), dim3(512), LDS_BYTES, stream, p); }
#else
    p.ph_lo = 0; p.ph_hi = NPH; p.use_bar = 1;
    hipLaunchKernelGGL(mega, dim3(grid), dim3(512), LDS_BYTES, stream, p);
#endif
    const hipError_t le = hipPeekAtLastError();
    if (le != hipSuccess) fprintf(stderr, "kernel_launch: launch failed: %s\n", hipGetErrorName(le));
}
```

```cpp
#include <hip/hip_runtime.h>
#include <cstdio>
#include <cstdint>

#define LAS __attribute__((address_space(3)))
#define GAS __attribute__((address_space(1)))
typedef unsigned short bf16_t;
typedef short bf16x8 __attribute__((ext_vector_type(8)));
typedef float f32x4 __attribute__((ext_vector_type(4)));
typedef float f32x16 __attribute__((ext_vector_type(16)));
typedef float f32x2 __attribute__((ext_vector_type(2)));
typedef unsigned u32x4 __attribute__((ext_vector_type(4)));
typedef unsigned u32x2 __attribute__((ext_vector_type(2)));

constexpr int D = 1024, NB = 2, TP = 8192, MP = NB * TP, SB = 128, ST = 4, MS = SB * ST, R = MP + MS;
constexpr int PAST = 2048, PAGE = 128, NPAGES = PAST / PAGE;
constexpr int H = 16, HD = 64, G = 4, HPG = 4, DFF = 2816, NLAY = 4;
constexpr int LW_ = 64, LA_ = 64, LV_ = 32, LG_ = 128, LHID = 288;
constexpr int NKV = 1536, NQ = 1072, NQP = 1280;
constexpr int NCH = TP / 64;
constexpr int NUNIT_A = NB * NCH * H;
constexpr int NCMP_P = 511, NCMP_S = 127, WIN = 512;
constexpr float NORM_EPS = 1e-6f, GN_EPS = 64e-5f;

constexpr size_t O_Y = 0;
constexpr size_t O_KV = (size_t)R * D;
constexpr size_t O_WINP = O_KV + (size_t)R * D;
constexpr size_t O_WINS = O_WINP + (size_t)NB * 512 * 512;
constexpr size_t O_WKVP = O_WINS + (size_t)SB * 512 * 512;
constexpr size_t O_WKVS = O_WKVP + (size_t)2 * NB * H * 4096;
constexpr size_t O_SHP = O_WKVS + (size_t)2 * SB * H * 4096;
constexpr size_t O_SHS = O_SHP + (size_t)2 * NB * D;
constexpr size_t O_CVP = O_SHS + (size_t)2 * SB * D;
constexpr size_t O_CVS = O_CVP + (size_t)NLAY * NB * 2 * DFF;
constexpr size_t O_END = O_CVS + (size_t)NLAY * SB * 2 * DFF;
static_assert(O_END == 88915968, "output size");

constexpr size_t MiB = 1u << 20;
constexpr size_t al(size_t x) { return (x + 4095) & ~(size_t)4095; }
constexpr size_t WS_CTL = 0, CTL_BYTES = 1 * MiB;
constexpr size_t WS_WRKV = WS_CTL + CTL_BYTES;
constexpr size_t WS_WORW = WS_WRKV + al((size_t)2 * 3072 * 1024 * 2);
constexpr size_t WS_W1T = WS_WORW + al((size_t)2 * 1024 * 1024 * 2);
constexpr size_t WS_W2W = WS_W1T + al((size_t)2 * 288 * 1024 * 2);
constexpr size_t WS_W2A = WS_W2W + al((size_t)2 * 1024 * 64 * 2);
constexpr size_t WS_W2V = WS_W2A + al((size_t)2 * 1024 * 64 * 2);
constexpr size_t WS_W2G = WS_W2V + al((size_t)1024 * 32 * 2);
constexpr size_t WS_WKVT = WS_W2G + al((size_t)2 * 1024 * 128 * 2);
constexpr size_t WS_WQT = WS_WKVT + al((size_t)1536 * 1024 * 2);
constexpr size_t WS_WONSA = WS_WQT + al((size_t)2 * 1280 * 1024 * 2);
constexpr size_t WS_WINT = WS_WONSA + al((size_t)2 * 1024 * 1024 * 2);
constexpr size_t WS_WOUTT = WS_WINT + al((size_t)4 * 5632 * 1024 * 2);
constexpr size_t WS_CW1T = WS_WOUTT + al((size_t)4 * 1024 * 2816 * 2);
constexpr size_t WS_CBIAS = WS_CW1T + al((size_t)2 * 256 * 1024 * 2);
constexpr size_t WS_CW2T = WS_CBIAS + al(2 * 128 * 4);
constexpr size_t WS_XM = WS_CW2T + al(2 * 2 * 64 * 128 * 2);
constexpr size_t WS_RK_R = WS_XM + al((size_t)6 * R * D * 2);
constexpr size_t WS_RK_K = WS_RK_R + al((size_t)R * D * 4);
constexpr size_t WS_V0 = WS_RK_K + al((size_t)R * D * 4);
constexpr size_t WS_V1 = WS_V0 + al((size_t)R * D * 4);
constexpr size_t WS_HID = WS_V1 + al((size_t)R * D * 4);
constexpr size_t WS_MT = WS_HID + al((size_t)R * LHID * 2);
constexpr size_t WS_NN = WS_MT + al((size_t)NUNIT_A * 4096 * 4);
constexpr size_t WS_RP = WS_NN + al((size_t)NUNIT_A * 4096 * 4);
constexpr size_t WS_YL = WS_RP + al((size_t)NUNIT_A * 4096 * 2);
constexpr size_t WS_S0 = WS_YL + al((size_t)NUNIT_A * 4096 * 4);
constexpr size_t WS_RKS = WS_S0 + al((size_t)NUNIT_A * 4096 * 2);
constexpr size_t WS_YG = WS_RKS + al((size_t)R * 16 * 4);
constexpr size_t WS_XN = WS_YG + al((size_t)R * D * 2);
constexpr size_t WS_XN2 = WS_XN + al((size_t)R * D * 2);
constexpr size_t WS_U = WS_XN2 + al((size_t)R * D * 2);
constexpr size_t WS_GT = WS_U + al((size_t)R * DFF * 2);
constexpr size_t WS_HH = WS_GT + al((size_t)R * DFF * 2);
constexpr size_t WS_KVF = WS_HH + al((size_t)R * DFF * 2);
constexpr size_t WS_CMPA = WS_KVF + al((size_t)R * NKV * 4);
constexpr size_t CMPA_ROWS = 4096 + 4096 + 65536 + 65536;
constexpr size_t WS_PCMP = WS_CMPA + al(CMPA_ROWS * 1024 * 2);
constexpr size_t WS_KS = WS_PCMP + al(CMPA_ROWS * 256 * 4);
constexpr size_t WS_VS = WS_KS + al((size_t)NB * G * TP * 64 * 2);
constexpr size_t WS_KW = WS_VS + al((size_t)NB * G * TP * 64 * 2);
constexpr size_t WS_VW = WS_KW + al((size_t)NB * G * TP * 64 * 2);
constexpr size_t WS_CK = WS_VW + al((size_t)NB * G * TP * 64 * 2);
constexpr size_t WS_CV = WS_CK + al((size_t)NB * G * 512 * 64 * 2);
constexpr size_t WS_CKS = WS_CV + al((size_t)NB * G * 512 * 64 * 2);
constexpr size_t WS_CVS = WS_CKS + al((size_t)SB * G * 128 * 64 * 4);
constexpr size_t WS_QF = WS_CVS + al((size_t)SB * G * 128 * 64 * 4);
constexpr size_t WS_Q = WS_QF + al((size_t)R * NQP * 4);
constexpr size_t WS_GATE = WS_Q + al((size_t)R * D * 2);
constexpr size_t WS_END = WS_GATE + al((size_t)R * 48 * 4);

typedef __bf16 bf16v2_ __attribute__((ext_vector_type(2)));
__device__ __forceinline__ unsigned cvt_pk_bf16_(float lo, float hi) { const f32x2 v = {lo, hi}; const bf16v2_ b = __builtin_convertvector(v, bf16v2_); return __builtin_bit_cast(unsigned, b); }
__device__ __forceinline__ unsigned f2bf(float f) { return cvt_pk_bf16_(f, f) & 0xffffu; }
__device__ __forceinline__ unsigned pk2(float lo, float hi) { return cvt_pk_bf16_(lo, hi); }
__device__ __forceinline__ float frcp(float x) { return __builtin_amdgcn_rcpf(x); }
__device__ __forceinline__ float frsq(float x) { return __builtin_amdgcn_rsqf(x); }
__device__ __forceinline__ float bf2f(unsigned short b) { return __builtin_bit_cast(float, ((unsigned)b) << 16); }
__device__ __forceinline__ float bflo(unsigned w) { return __builtin_bit_cast(float, w << 16); }
__device__ __forceinline__ float bfhi(unsigned w) { return __builtin_bit_cast(float, w & 0xffff0000u); }
template <int CTRL> __device__ __forceinline__ float dpp_f(float x) { return __builtin_bit_cast(float, __builtin_amdgcn_update_dpp(0, __builtin_bit_cast(int, x), CTRL, 0xF, 0xF, true)); }
__device__ __forceinline__ float row16_sum(float v) { v += dpp_f<0xB1>(v); v += dpp_f<0x4E>(v); v += dpp_f<0x141>(v); v += dpp_f<0x140>(v); return v; }
__device__ __forceinline__ float row16_max(float v) { v = fmaxf(v, dpp_f<0xB1>(v)); v = fmaxf(v, dpp_f<0x4E>(v)); v = fmaxf(v, dpp_f<0x141>(v)); v = fmaxf(v, dpp_f<0x140>(v)); return v; }
__device__ __forceinline__ float swz_xor16_n(float x) { return __builtin_bit_cast(float, __builtin_amdgcn_ds_swizzle(__builtin_bit_cast(int, x), 0x401F)); }
__device__ __forceinline__ float sum_xor32_n(float x) { auto rr = __builtin_amdgcn_permlane32_swap(__float_as_uint(x), __float_as_uint(x), false, false);
    return __uint_as_float(rr[0]) + __uint_as_float(rr[1]); }
__device__ __forceinline__ float sum_rows4_n(float x) { x += swz_xor16_n(x); return sum_xor32_n(x); }
__device__ __forceinline__ float wave_sum_n(float v) {
    v = row16_sum(v);
    v += __builtin_bit_cast(float, __builtin_amdgcn_update_dpp(0, __builtin_bit_cast(int, v), 0x142, 0xA, 0xF, false));
    v += __builtin_bit_cast(float, __builtin_amdgcn_update_dpp(0, __builtin_bit_cast(int, v), 0x143, 0xC, 0xF, false));
    return __builtin_bit_cast(float, __builtin_amdgcn_readlane(__builtin_bit_cast(int, v), 63));
}
__device__ __forceinline__ float wave_max_n(float v) {
    v = row16_max(v);
    v = fmaxf(v, __builtin_bit_cast(float, __builtin_amdgcn_update_dpp(__builtin_bit_cast(int, v), __builtin_bit_cast(int, v), 0x142, 0xA, 0xF, false)));
    v = fmaxf(v, __builtin_bit_cast(float, __builtin_amdgcn_update_dpp(__builtin_bit_cast(int, v), __builtin_bit_cast(int, v), 0x143, 0xC, 0xF, false)));
    return __builtin_bit_cast(float, __builtin_amdgcn_readlane(__builtin_bit_cast(int, v), 63));
}
#define XLANE_NEW 1
#ifdef XLANE_NEW
__device__ __forceinline__ float swz_xor16(float x) { return __builtin_bit_cast(float, __builtin_amdgcn_ds_swizzle(__builtin_bit_cast(int, x), 0x401F)); }
__device__ __forceinline__ float sum_xor32(float x) { return sum_xor32_n(x); }
__device__ __forceinline__ float sum_rows4(float x) { x += swz_xor16(x); return sum_xor32(x); }
__device__ __forceinline__ float wave_sum(float v) {
    v = row16_sum(v);
    v += __builtin_bit_cast(float, __builtin_amdgcn_update_dpp(0, __builtin_bit_cast(int, v), 0x142, 0xA, 0xF, false));
    v += __builtin_bit_cast(float, __builtin_amdgcn_update_dpp(0, __builtin_bit_cast(int, v), 0x143, 0xC, 0xF, false));
    return __builtin_bit_cast(float, __builtin_amdgcn_readlane(__builtin_bit_cast(int, v), 63));
}
__device__ __forceinline__ float wave_max(float v) {
    v = row16_max(v);
    v = fmaxf(v, __builtin_bit_cast(float, __builtin_amdgcn_update_dpp(__builtin_bit_cast(int, v), __builtin_bit_cast(int, v), 0x142, 0xA, 0xF, false)));
    v = fmaxf(v, __builtin_bit_cast(float, __builtin_amdgcn_update_dpp(__builtin_bit_cast(int, v), __builtin_bit_cast(int, v), 0x143, 0xC, 0xF, false)));
    return __builtin_bit_cast(float, __builtin_amdgcn_readlane(__builtin_bit_cast(int, v), 63));
}
#else
__device__ __forceinline__ float sum_xor32(float x) { return x + __shfl_xor(x, 32); }
__device__ __forceinline__ float sum_rows4(float x) { x += __shfl_xor(x, 16); x += __shfl_xor(x, 32); return x; }
__device__ __forceinline__ float wave_sum(float v) { v = row16_sum(v); v += __shfl_xor(v, 16); v += __shfl_xor(v, 32); return v; }
__device__ __forceinline__ float wave_max(float v) { v = row16_max(v); v = fmaxf(v, __shfl_xor(v, 16)); v = fmaxf(v, __shfl_xor(v, 32)); return v; }
#endif
__device__ __forceinline__ float sigmoidf_(float x) { return frcp(1.0f + __builtin_amdgcn_exp2f(-1.4426950408889634f * x)); }
__device__ __forceinline__ float gelu_tanh(float x) {
    const float u = 0.7978845608028654f * (x + 0.044715f * x * x * x);
    const float e = __builtin_amdgcn_exp2f(2.8853900817779268f * u);
    const float th = 1.0f - 2.0f * frcp(e + 1.0f);
    return 0.5f * x * (1.0f + th);
}
template <class T> __device__ __forceinline__ const T* launder_p(const T* q) { asm volatile("" : "+v"(q)); return q; }
__device__ __forceinline__ int launder_v(int x) { asm volatile("" : "+v"(x)); return x; }
#define LDS_WAIT() asm volatile("s_waitcnt lgkmcnt(0)" ::: "memory")
#define VM_WAIT() asm volatile("s_waitcnt vmcnt(0)" ::: "memory")
__device__ __forceinline__ f32x4 mfma16(bf16x8 a, bf16x8 b, f32x4 c) { return __builtin_amdgcn_mfma_f32_16x16x32_bf16(a, b, c, 0, 0, 0); }
__device__ __forceinline__ f32x16 mfma32(bf16x8 a, bf16x8 b, f32x16 c) { return __builtin_amdgcn_mfma_f32_32x32x16_bf16(a, b, c, 0, 0, 0); }
#define XB_TMO      128
#define XB_XCNT(j)  (256  + 64 * (j))
#define XB_XSUB(j)  (1280 + 64 * (j))
#define XB_XGEN(j)  (2304 + 64 * (j))
#define XB_TOP      3328
#define XB_TOPGEN   3392
#define XCD_BAR_WORDS 3456
#define XB_SPIN_CAP (1u << 18)

__device__ __forceinline__ unsigned xb_ld(unsigned* p)              { return __hip_atomic_load(p, __ATOMIC_RELAXED, __HIP_MEMORY_SCOPE_AGENT); }
__device__ __forceinline__ unsigned xb_add(unsigned* p, unsigned v) { return __hip_atomic_fetch_add(p, v, __ATOMIC_RELAXED, __HIP_MEMORY_SCOPE_AGENT); }
__device__ __forceinline__ unsigned xb_xcc_id() { return (unsigned)__builtin_amdgcn_s_getreg((3 << 11) | 20) & 0xFu; }
#define XB_SPIN(cond, bar) do { unsigned _sp = 0; while (cond) { __builtin_amdgcn_s_sleep(1); \
    if ((++_sp & 255u) == 0u) { if (xb_ld(&(bar)[XB_TMO])) break; if (_sp > XB_SPIN_CAP) { atomicAdd(&(bar)[XB_TMO], 1u); break; } } } } while (0)

struct XcdBarrier {
    unsigned* bar; unsigned x;
    volatile LAS unsigned* st;
};

__device__ __forceinline__ XcdBarrier xcd_barrier_post(unsigned* bar, volatile LAS unsigned* st) {
    XcdBarrier b; b.bar = bar; b.x = xb_xcc_id(); b.st = st;
    if (threadIdx.x == 0) (void)xb_add(&bar[XB_XCNT(b.x)], 1u);
    return b;
}
__device__ __forceinline__ void xcd_barrier_complete(unsigned* bar, unsigned x, unsigned& nloc, unsigned& nx) {
    const unsigned G = gridDim.x * gridDim.y * gridDim.z;
    unsigned sum, cnt, mine, sp = 0u;
    for (;;) {
        sum = 0u; cnt = 0u; mine = 0u;
#pragma unroll
        for (unsigned j = 0; j < 16; ++j) { const unsigned c = xb_ld(&bar[XB_XCNT(j)]); sum += c; cnt += (c > 0u) ? 1u : 0u; mine = (j == x) ? c : mine; }
        if (sum == G) break;
        __builtin_amdgcn_s_sleep(1);
        if ((++sp & 255u) == 0u) { if (xb_ld(&bar[XB_TMO])) break; if (sp > XB_SPIN_CAP) { atomicAdd(&bar[XB_TMO], 1u); break; } }
    }
    nloc = mine > 0u ? mine : 1u; nx = cnt > 0u ? cnt : 1u;
}

__device__ __forceinline__ void xcd_barrier(const XcdBarrier& b, const bool t0) {
    asm volatile("s_waitcnt vmcnt(0)" ::: "memory");
    __syncthreads();
    if (t0) {
        unsigned* bar = b.bar;
        __builtin_amdgcn_s_waitcnt(0);
        unsigned nloc = b.st[0], nx = b.st[1];
        if (nloc == 0u) { xcd_barrier_complete(bar, b.x, nloc, nx); b.st[0] = nloc; b.st[1] = nx; }
        const unsigned old = xb_add(&bar[XB_XSUB(b.x)], 1u);
        const unsigned gen = old / nloc;
        if (old + 1u == (gen + 1u) * nloc) {
            __builtin_amdgcn_fence(__ATOMIC_RELEASE, "agent");
            asm volatile("s_waitcnt vmcnt(0)" ::: "memory");
            const unsigned og = xb_add(&bar[XB_TOP], 1u);
            const unsigned tg = og / nx;
            if (og + 1u == (tg + 1u) * nx) xb_add(&bar[XB_TOPGEN], 1u);
            else XB_SPIN(xb_ld(&bar[XB_TOPGEN]) == tg, bar);
            __builtin_amdgcn_fence(__ATOMIC_ACQUIRE, "agent");
            xb_add(&bar[XB_XGEN(b.x)], 1u);
            asm volatile("s_waitcnt vmcnt(0)" ::: "memory");
        } else {
            XB_SPIN(xb_ld(&bar[XB_XGEN(b.x)]) == gen, bar);
            __builtin_amdgcn_fence(__ATOMIC_ACQUIRE, "agent");
            asm volatile("s_waitcnt vmcnt(0)" ::: "memory");
        }
    }
    __syncthreads();
}

namespace pg8 {
#define PG8_LAS __attribute__((address_space(3)))
constexpr int BM = 256, BK = 64, HALF = 128, HTB = HALF * BK * 2  , STAGE_BYTES = 8 * HTB, NXCD = 8, WGM = 8;
__host__ __device__ __forceinline__ int lds_byte(int r, int c) { const int st = (r >> 4) * 2 + (c >> 5), rr = r & 15, cc = c & 31, ob = rr * 64 + cc * 2; return st * 1024 + (ob ^ (((ob >> 9) & 1) << 5)); }
__host__ __device__ __forceinline__ void stage_rc(int b, int& R_, int& C_) { const int st = b / 1024, sb = b % 1024, swz = sb ^ (((sb >> 9) & 1) << 5); R_ = (st >> 1) * 16 + swz / 64; C_ = (st & 1) * 32 + (swz % 64) / 2; }
__host__ __device__ __forceinline__ int perm32(int rho) { const int n = rho >> 4, i = rho & 15; return 8 * (i >> 2) + 4 * n + (i & 3); }

struct Unit { int pm, pn, kb, nt; };
struct Gemm { const bf16_t* A; const bf16_t* Bt; int M, N, K, KL; };

struct GroupOrder {
    int pm0[4], nM[4], pn0[4], nN[4]; int nseg, nwg, G_, c;
    __device__ __forceinline__ void init(int G__, int c_) { nseg = 0; nwg = 0; G_ = G__; c = c_;
#pragma unroll
        for (int s = 0; s < 4; ++s) { pm0[s] = 0; nM[s] = 0; pn0[s] = 0; nN[s] = 1; } }
    __device__ __forceinline__ void add(int s, int pm0_, int nM_, int pn0_, int nN_) { pm0[s] = pm0_; nM[s] = nM_; pn0[s] = pn0_; nN[s] = nN_; nwg += nM_ * nN_; nseg = s + 1; }
    __device__ __forceinline__ bool next(int i, Unit& u) const {
        const long L = (long)i * G_ + c; if (L >= nwg) return false;
        int id = (int)L; { const int q = nwg / NXCD, r = nwg % NXCD, xcd = id % NXCD, off = id / NXCD; id = (xcd < r ? xcd * (q + 1) : r * (q + 1) + (xcd - r) * q) + off; }
        int spm0 = 0, snM = 1, spn0 = 0, snN = 1; bool found = false;
#pragma unroll
        for (int s = 0; s < 4; ++s) { const int cnt = nM[s] * nN[s]; if (!found) { if (id < cnt) { found = true; spm0 = pm0[s]; snM = nM[s]; spn0 = pn0[s]; snN = nN[s]; } else id -= cnt; } }
        const int nig = WGM * snN, gid = id / nig, fm = gid * WGM, gsz = (snM - fm) < WGM ? (snM - fm) : WGM;
        u.pm = spm0 + fm + ((id % nig) % gsz); u.pn = spn0 + (id % nig) / gsz; u.kb = 0; u.nt = 0; return true;
    }
    __device__ __forceinline__ void a_ready(const Unit&) const {}
    __device__ __forceinline__ void done(const Unit&) const {}
};

struct ResidOrder {
    GroupOrder P; int nS, G_, c;
    __device__ __forceinline__ void init(int G__, int c_, int nS_) { P.init(G__, c_); P.add(0, 0, nS_ ? 64 : 66, 0, 4); nS = nS_; G_ = G__; c = c_; }
    __device__ __forceinline__ bool next(int i, Unit& u) const {
        const int npc = c < P.nwg ? (P.nwg - 1 - c) / G_ + 1 : 0;
        if (i < npc) return P.next(i, u);
        const int L = (i - npc) * G_ + (G_ - 1 - c); if (L >= 8 * nS) return false;
        const int sl = L >> 3, t = L & 7; u.pm = 64 + (t & 1); u.pn = t >> 1; u.kb = sl * 512; u.nt = 4; return true; }
    __device__ __forceinline__ void a_ready(const Unit&) const {}
    __device__ __forceinline__ void done(const Unit&) const {}
};
__device__ __forceinline__ unsigned cvt_pk_bf16(float lo, float hi) { return cvt_pk_bf16_(lo, hi); }

struct EpiF32G {
    static constexpr bool PERM = false, AFTER_DRAIN = false;
    float* b0; float* b1; float* b2; float* b3; int ldc, png, pmg;
    __device__ __forceinline__ void operator()(const f32x4 (&acc)[2][2][4][2], const Unit& u, int wr, int wc, int fr, int fq) const {
        const int j = u.pn / png; float* C = j == 0 ? b0 : (j == 1 ? b1 : (j == 2 ? b2 : b3));
        const int row0 = (u.pm - j * pmg) * BM + wr * 64 + fr, col0 = (u.pn - j * png) * BM + wc * 32 + 4 * fq;
#pragma unroll
        for (int ai = 0; ai < 2; ++ai)
#pragma unroll
            for (int m = 0; m < 4; ++m) { float* rowp = C + (size_t)(row0 + ai * HALF + m * 16) * ldc + col0;
#pragma unroll
                for (int bj = 0; bj < 2; ++bj)
#pragma unroll
                    for (int n = 0; n < 2; ++n) *(f32x4*)(rowp + bj * HALF + n * 16) = acc[ai][bj][m][n]; }
    }
};
struct EpiResid {
    static constexpr bool PERM = false, AFTER_DRAIN = false;
    float* X; int ldc;
    __device__ __forceinline__ void operator()(const f32x4 (&acc)[2][2][4][2], const Unit& u, int wr, int wc, int fr, int fq) const {
        const int row0 = u.pm * BM + wr * 64 + fr, col0 = u.pn * BM + wc * 32 + 4 * fq; const bool split = u.nt != 0;
#pragma unroll
        for (int ai = 0; ai < 2; ++ai)
#pragma unroll
            for (int m = 0; m < 4; ++m) { float* rowp = X + (size_t)(row0 + ai * HALF + m * 16) * ldc + col0;
                if (!split) {
#pragma unroll
                    for (int bj = 0; bj < 2; ++bj)
#pragma unroll
                        for (int n = 0; n < 2; ++n) { f32x4* p = (f32x4*)(rowp + bj * HALF + n * 16); *p = *p + acc[ai][bj][m][n]; } }
                else {
#pragma unroll
                    for (int bj = 0; bj < 2; ++bj)
#pragma unroll
                        for (int n = 0; n < 2; ++n) { float* q = rowp + bj * HALF + n * 16;
#pragma unroll
                            for (int e = 0; e < 4; ++e) __hip_atomic_fetch_add(q + e, acc[ai][bj][m][n][e], __ATOMIC_RELAXED, __HIP_MEMORY_SCOPE_AGENT); } }
                asm volatile("" ::: "memory"); }
    }
};
struct EpiWin {
    static constexpr bool PERM = true, AFTER_DRAIN = false;
    bf16_t* U; bf16_t* GT; float* cvp; float* cvs;
    __device__ __forceinline__ void operator()(const f32x4 (&acc)[2][2][4][2], const Unit& u, int wr, int wc, int fr, int fq) const {
        const bool isu = u.pn < 11; bf16_t* base = isu ? U : GT; const int colt = (isu ? u.pn : u.pn - 11) * BM;
        const int row0 = u.pm * BM + wr * 64 + fr, col0 = colt + wc * 32 + 8 * fq;
#pragma unroll
        for (int ai = 0; ai < 2; ++ai)
#pragma unroll
            for (int m = 0; m < 4; ++m) { const int row = row0 + ai * HALF + m * 16; bf16_t* rowp = base + (size_t)row * DFF + col0;
                float* cv = nullptr;
                if (isu) { if (row >= MP) { const int t = (row - MP) & 3, b = (row - MP) >> 2; if (t >= 2) cv = cvs + (size_t)(b * 2 + (t - 2)) * DFF; }
                           else { const int tt = row & (TP - 1); if (tt >= TP - 2) cv = cvp + (size_t)((row >> 13) * 2 + (tt - (TP - 2))) * DFF; } }
#pragma unroll
                for (int bj = 0; bj < 2; ++bj) { const f32x4 v0 = acc[ai][bj][m][0], v1 = acc[ai][bj][m][1];
                    u32x4 w; w.x = cvt_pk_bf16(v0[0], v0[1]); w.y = cvt_pk_bf16(v0[2], v0[3]); w.z = cvt_pk_bf16(v1[0], v1[1]); w.w = cvt_pk_bf16(v1[2], v1[3]);
                    *(u32x4*)(rowp + bj * HALF) = w;
                    if (cv) { *(f32x4*)(cv + col0 + bj * HALF) = v0; *(f32x4*)(cv + col0 + bj * HALF + 4) = v1; } } }
    }
};
template <class Epi, class Sched, bool ALIGN_EPI = false, bool SP2 = false>
__device__ __forceinline__ void gemm_phase(PG8_LAS unsigned char* lds, const Gemm g, const Sched& S, const Epi& E, int tid_in) {
    int tid_l = tid_in; asm volatile("" : "+v"(tid_l));
    const int tid = tid_l, wid = __builtin_amdgcn_readfirstlane(tid >> 6), lane = tid & 63, wr = wid >> 2, wc = wid & 3, fr = lane & 15, fq = lane >> 4;
    const int K = g.K, nt = g.KL / BK;
    unsigned voffA[2], voffB[2];
#pragma unroll
    for (int i = 0; i < 2; ++i) { int R, C; stage_rc(tid * 16 + i * 8192, R, C); const int Rb = Epi::PERM ? ((R & ~31) + perm32(R & 31)) : R;
        voffA[i] = (unsigned)(R * K + C) * 2u; voffB[i] = (unsigned)(Rb * K + C) * 2u; }
    const size_t kstep = (size_t)(BK * 2);
    const size_t hstep = (size_t)HALF * K * 2;
    const size_t tstep = 2 * hstep;
    const unsigned ldsw = (unsigned)wid * 1024u;
    const int aoff = lds_byte(wr * 64 + fr, fq * 8), boff = lds_byte(wc * 32 + fr, fq * 8);
#define PG8_SA(b, h) (((b) * 2 + (h)) * HTB)
#define PG8_SB(b, h) ((4 + (b) * 2 + (h)) * HTB)
#define PG8_STAGE(bufoff, gbase, voff) do { _Pragma("unroll") for (int _i = 0; _i < 2; ++_i) \
        __builtin_amdgcn_global_load_lds((const unsigned*)((const char*)(gbase) + (voff)[_i]), (PG8_LAS unsigned*)(lds + (bufoff) + ldsw + _i * 8192), 16, 0, 0); } while (0)
#define PG8_LDA(dst, b, h) do { _Pragma("unroll") for (int m = 0; m < 4; ++m) _Pragma("unroll") for (int k = 0; k < 2; ++k) dst[m][k] = *(const PG8_LAS bf16x8*)(lds + PG8_SA(b, h) + aoff + m * 2048 + k * 1024); } while (0)
#define PG8_LDB(dst, b, h) do { _Pragma("unroll") for (int n = 0; n < 2; ++n) _Pragma("unroll") for (int k = 0; k < 2; ++k) dst[n][k] = *(const PG8_LAS bf16x8*)(lds + PG8_SB(b, h) + boff + n * 2048 + k * 1024); } while (0)
#define PG8_MMA(ai, bj, At, Bt) do { __builtin_amdgcn_s_setprio(1); _Pragma("unroll") for (int m = 0; m < 4; ++m) _Pragma("unroll") for (int n = 0; n < 2; ++n) _Pragma("unroll") for (int k = 0; k < 2; ++k) \
        acc[ai][bj][m][n] = __builtin_amdgcn_mfma_f32_16x16x32_bf16(Bt[n][k], At[m][k], acc[ai][bj][m][n], 0, 0, 0); __builtin_amdgcn_s_setprio(0); } while (0)
#define PG8_WAIT_V(n) asm volatile("s_waitcnt vmcnt(" #n ")" ::: "memory")
#define PG8_WAIT_L(n) asm volatile("s_waitcnt lgkmcnt(" #n ")" ::: "memory")
#define PG8_BAR __builtin_amdgcn_s_barrier()
#define PG8_SCHED __builtin_amdgcn_sched_barrier(0)
    Unit cur, nxt; int ui = 0;
    if (!S.next(0, cur)) return;
    f32x4 acc[2][2][4][2];
#pragma unroll
    for (int a = 0; a < 2; ++a)
#pragma unroll
        for (int b = 0; b < 2; ++b)
#pragma unroll
            for (int m = 0; m < 4; ++m)
#pragma unroll
                for (int n = 0; n < 2; ++n) acc[a][b][m][n] = (f32x4){0.f, 0.f, 0.f, 0.f};
    bf16x8 At[4][2], B0[2][2], B1[2][2];
    const char* cA = (const char*)g.A + (size_t)cur.pm * tstep + cur.kb; const char* cB = (const char*)g.Bt + (size_t)cur.pn * tstep + cur.kb;
    S.a_ready(cur);
    if constexpr (SP2) {
        PG8_STAGE(PG8_SB(0, 0), cB, voffB); PG8_STAGE(PG8_SB(0, 1), cB + hstep, voffB); PG8_STAGE(PG8_SA(0, 0), cA, voffA); PG8_STAGE(PG8_SA(0, 1), cA + hstep, voffA);
        if (wr == 1) PG8_BAR;
        PG8_WAIT_V(2); PG8_BAR;
        PG8_STAGE(PG8_SB(1, 0), cB + kstep, voffB); PG8_STAGE(PG8_SA(1, 0), cA + kstep, voffA); PG8_STAGE(PG8_SB(1, 1), cB + hstep + kstep, voffB);
        PG8_WAIT_V(6); PG8_BAR;
    } else {
        PG8_STAGE(PG8_SB(0, 0), cB, voffB); PG8_STAGE(PG8_SA(0, 0), cA, voffA); PG8_STAGE(PG8_SB(0, 1), cB + hstep, voffB); PG8_STAGE(PG8_SA(0, 1), cA + hstep, voffA);
        if (wr == 1) PG8_BAR;
        PG8_WAIT_V(4); PG8_BAR;
        PG8_STAGE(PG8_SB(1, 0), cB + kstep, voffB); PG8_STAGE(PG8_SA(1, 0), cA + kstep, voffA); PG8_STAGE(PG8_SB(1, 1), cB + hstep + kstep, voffB);
        PG8_WAIT_V(6); PG8_BAR;
    }
    for (;;) {
        const bool has_next = S.next(ui + 1, nxt);
        const char* nA = has_next ? (const char*)g.A + (size_t)nxt.pm * tstep + nxt.kb : cA; const char* nB = has_next ? (const char*)g.Bt + (size_t)nxt.pn * tstep + nxt.kb : cB;
        const int ntu = cur.nt ? cur.nt : nt;
        for (int t = 0; t < ntu; t += 2) {
            const bool last = (t == ntu - 2);
            const char* a1 = cA + (size_t)(t + 1) * kstep;
            const char* a2 = last ? nA : cA + (size_t)(t + 2) * kstep; const char* b2 = last ? nB : cB + (size_t)(t + 2) * kstep;
            const char* a3 = a2 + kstep; const char* b3 = b2 + kstep;
            if (last && has_next) S.a_ready(nxt);
            if constexpr (SP2) {
            PG8_LDB(B0, 0, 0); PG8_LDB(B1, 0, 1); PG8_SCHED; PG8_LDA(At, 0, 0); PG8_STAGE(PG8_SA(1, 1), a1 + hstep, voffA);
            PG8_WAIT_V(8); PG8_WAIT_L(0); PG8_BAR; PG8_MMA(0, 0, At, B0); PG8_MMA(0, 1, At, B1); PG8_BAR; PG8_SCHED;
            PG8_LDA(At, 0, 1); PG8_STAGE(PG8_SB(0, 0), b2, voffB); PG8_STAGE(PG8_SB(0, 1), b2 + hstep, voffB); PG8_STAGE(PG8_SA(0, 0), a2, voffA);
            PG8_WAIT_V(8); PG8_WAIT_L(0); PG8_BAR; PG8_MMA(1, 0, At, B0); PG8_MMA(1, 1, At, B1); PG8_BAR; PG8_SCHED;
            PG8_LDB(B0, 1, 0); PG8_LDB(B1, 1, 1); PG8_SCHED; PG8_LDA(At, 1, 0); PG8_STAGE(PG8_SA(0, 1), a2 + hstep, voffA);
            PG8_WAIT_V(8); PG8_WAIT_L(0); PG8_BAR; PG8_MMA(0, 0, At, B0); PG8_MMA(0, 1, At, B1); PG8_BAR; PG8_SCHED;
            PG8_LDA(At, 1, 1); PG8_STAGE(PG8_SB(1, 0), b3, voffB); PG8_STAGE(PG8_SB(1, 1), b3 + hstep, voffB); PG8_STAGE(PG8_SA(1, 0), a3, voffA);
            PG8_WAIT_V(8); PG8_WAIT_L(0); PG8_BAR; PG8_MMA(1, 0, At, B0); PG8_MMA(1, 1, At, B1); PG8_BAR; PG8_SCHED;
            } else {
            PG8_LDB(B0, 0, 0); PG8_SCHED; PG8_LDA(At, 0, 0); PG8_STAGE(PG8_SA(1, 1), a1 + hstep, voffA);
            PG8_WAIT_L(8); PG8_BAR; PG8_WAIT_L(0); PG8_MMA(0, 0, At, B0); PG8_BAR; PG8_SCHED;
            PG8_LDB(B1, 0, 1); PG8_STAGE(PG8_SB(0, 0), b2, voffB);
            PG8_BAR; PG8_WAIT_L(0); PG8_MMA(0, 1, At, B1); PG8_BAR;
            PG8_LDA(At, 0, 1); PG8_STAGE(PG8_SA(0, 0), a2, voffA);
            PG8_BAR; PG8_WAIT_L(0); PG8_MMA(1, 0, At, B0); PG8_BAR; PG8_SCHED;
            PG8_STAGE(PG8_SB(0, 1), b2 + hstep, voffB);
            PG8_WAIT_V(6); PG8_BAR; PG8_MMA(1, 1, At, B1); PG8_BAR;
            PG8_LDB(B0, 1, 0); PG8_SCHED; PG8_LDA(At, 1, 0); PG8_STAGE(PG8_SA(0, 1), a2 + hstep, voffA);
            PG8_WAIT_L(8); PG8_BAR; PG8_WAIT_L(0); PG8_MMA(0, 0, At, B0); PG8_BAR; PG8_SCHED;
            PG8_LDB(B1, 1, 1); PG8_STAGE(PG8_SB(1, 0), b3, voffB);
            PG8_BAR; PG8_WAIT_L(0); PG8_MMA(0, 1, At, B1); PG8_BAR;
            PG8_LDA(At, 1, 1); PG8_STAGE(PG8_SA(1, 0), a3, voffA);
            PG8_BAR; PG8_WAIT_L(0); PG8_MMA(1, 0, At, B0); PG8_BAR; PG8_SCHED;
            PG8_STAGE(PG8_SB(1, 1), b3 + hstep, voffB);
            PG8_WAIT_V(6); PG8_BAR; PG8_MMA(1, 1, At, B1); PG8_BAR;
            }
        }
        if constexpr (ALIGN_EPI) { if (wr == 0) PG8_BAR; }
        if constexpr (!Epi::AFTER_DRAIN) { E(acc, cur, wr, wc, fr, fq); S.done(cur); }
        if (!has_next) break;
#pragma unroll
        for (int a = 0; a < 2; ++a)
#pragma unroll
            for (int b = 0; b < 2; ++b)
#pragma unroll
                for (int m = 0; m < 4; ++m)
#pragma unroll
                    for (int n = 0; n < 2; ++n) acc[a][b][m][n] = (f32x4){0.f, 0.f, 0.f, 0.f};
        cur = nxt; cA = nA; cB = nB; ++ui;
        if constexpr (ALIGN_EPI) { if (wr == 1) PG8_BAR; }
    }
    PG8_WAIT_V(0);
    if constexpr (!ALIGN_EPI) { if (wr == 0) PG8_BAR; }
    PG8_BAR;
    if constexpr (Epi::AFTER_DRAIN) { E.fused(acc, cur, wr, wc, fr, fq, lds, wid, lane); S.done(cur); }
#undef PG8_SA
#undef PG8_SB
#undef PG8_STAGE
#undef PG8_LDA
#undef PG8_LDB
#undef PG8_MMA
#undef PG8_WAIT_V
#undef PG8_WAIT_L
#undef PG8_BAR
#undef PG8_SCHED
}
}
constexpr int RING_BYTES = 131072, MISC_OFF = RING_BYTES + 320, LDS_BYTES = 147456;
struct Params { const float* in[45]; float* out; unsigned char* ws; int ph_lo, ph_hi, use_bar, pad; };
enum { I_XP = 0, I_XS, I_CKV, I_CWIN, I_SWKV, I_SSHIFT, I_SCONV, I_PT, I_NORMG, I_MU, I_WR, I_WK, I_WV, I_WO, I_W0, I_W1, I_W2, I_A0, I_A1, I_A2, I_V0, I_V1, I_V2, I_G1, I_G2,
       I_KK, I_KA, I_RKK, I_LNW, I_LNB, I_KVNG, I_WKV, I_KNG, I_PE, I_CW1, I_CB1, I_CW2, I_CB2, I_WQ, I_QNG, I_WONSA, I_WIN, I_CONVW, I_CONVB, I_WOUT };

typedef const __attribute__((address_space(4))) Params* KP;
struct Ctx { LAS unsigned char* lds; int tid, lane, wave, gw, ngw, gtid, gsz; };

__device__ __forceinline__ void p0_transpose_item(const float* W, int K, int ldw, int nblk, bf16_t* WT, int row_off, LAS float* scr, int item, int lane) {
    const int kb = item / nblk, nb = item % nblk, k0 = 64 * kb, n0 = 32 * nb;
#pragma unroll 8
    for (int i = 0; i < 32; ++i) { const int kk = 2 * i + (lane >> 5); scr[kk * 33 + (lane & 31)] = W[(size_t)(k0 + kk) * ldw + n0 + (lane & 31)]; }
    LDS_WAIT(); asm volatile("" ::: "memory");
    const int c = lane & 7;
#pragma unroll
    for (int j = 0; j < 4; ++j) { const int n = (lane >> 3) + 8 * j; const LAS float* s = scr + (8 * c) * 33 + n;
        u32x4 o; o.x = pk2(s[0 * 33], s[1 * 33]); o.y = pk2(s[2 * 33], s[3 * 33]); o.z = pk2(s[4 * 33], s[5 * 33]); o.w = pk2(s[6 * 33], s[7 * 33]);
        *(u32x4*)(WT + (size_t)(row_off + n0 + n) * K + k0 + 8 * c) = o; }
    LDS_WAIT(); asm volatile("" ::: "memory");
}

__device__ __forceinline__ void phase_prologue(KP p, const Ctx& c) {
    LAS float* scr = (LAS float*)(c.lds + c.wave * 16384);
    unsigned char* ws = p->ws;
    int total = 0;
#define TRCNT(K_, N_) (((K_) / 64) * ((N_) / 32))
    constexpr int C_DD = TRCNT(1024, 1024), C_L64 = TRCNT(1024, 64), C_L32 = TRCNT(1024, 32), C_L128 = TRCNT(1024, 128), C_2_64 = TRCNT(64, 1024), C_2_128 = TRCNT(128, 1024);
    constexpr int C_KV = TRCNT(1024, 1536), C_Q = 16 * 33, C_IN = TRCNT(1024, 5632), C_OUT = TRCNT(2816, 1024), C_CW = TRCNT(1024, 128);
    constexpr int NITEMS = 2 * (4 * C_DD + 2 * C_L64 + C_L128 + 2 * C_2_64 + C_2_128) + C_L32 + C_KV + 2 * C_Q + 2 * C_DD + 4 * C_IN + 4 * C_OUT + 4 * C_CW;
    (void)total;
    for (int it = c.gw; it < NITEMS; it += c.ngw) {
        int r = it;
#define TR(Wp, K_, LDW_, NBLK_, WTp, ROWOFF_) { const int cnt_ = ((K_) / 64) * (NBLK_); if (r < cnt_) { p0_transpose_item((Wp), (K_), (LDW_), (NBLK_), (bf16_t*)(WTp), (ROWOFF_), scr, r, c.lane); continue; } r -= cnt_; }
        bool done = false;
#pragma unroll
        for (int l = 0; l < 2; ++l) {
            if (done) break;
            const size_t dd = (size_t)l * 1024 * 1024;
#define TRL(Wp, K_, LDW_, NBLK_, WTp, ROWOFF_) { const int cnt_ = ((K_) / 64) * (NBLK_); if (!done) { if (r < cnt_) { p0_transpose_item((Wp), (K_), (LDW_), (NBLK_), (bf16_t*)(WTp), (ROWOFF_), scr, r, c.lane); done = true; } else r -= cnt_; } }
            TRL(p->in[I_WR] + dd, 1024, 1024, 32, ws + WS_WRKV + (size_t)l * 3072 * 1024 * 2, 0)
            TRL(p->in[I_WK] + dd, 1024, 1024, 32, ws + WS_WRKV + (size_t)l * 3072 * 1024 * 2, 1024)
            TRL(p->in[I_WV] + dd, 1024, 1024, 32, ws + WS_WRKV + (size_t)l * 3072 * 1024 * 2, 2048)
            TRL(p->in[I_WO] + dd, 1024, 1024, 32, ws + WS_WORW + (size_t)l * 1024 * 1024 * 2, 0)
            TRL(p->in[I_W1] + (size_t)l * 1024 * 64, 1024, 64, 2, ws + WS_W1T + (size_t)l * 288 * 1024 * 2, 0)
            TRL(p->in[I_A1] + (size_t)l * 1024 * 64, 1024, 64, 2, ws + WS_W1T + (size_t)l * 288 * 1024 * 2, 64)
            TRL(p->in[I_G1] + (size_t)l * 1024 * 128, 1024, 128, 4, ws + WS_W1T + (size_t)l * 288 * 1024 * 2, 160)
            TRL(p->in[I_W2] + (size_t)l * 64 * 1024, 64, 1024, 32, ws + WS_W2W + (size_t)l * 1024 * 64 * 2, 0)
            TRL(p->in[I_A2] + (size_t)l * 64 * 1024, 64, 1024, 32, ws + WS_W2A + (size_t)l * 1024 * 64 * 2, 0)
            TRL(p->in[I_G2] + (size_t)l * 128 * 1024, 128, 1024, 32, ws + WS_W2G + (size_t)l * 1024 * 128 * 2, 0)
        }
        if (done) continue;
        TR(p->in[I_V1], 1024, 32, 1, ws + WS_W1T + (size_t)1 * 288 * 1024 * 2, 128)
        TR(p->in[I_WKV], 1024, 1536, 48, ws + WS_WKVT, 0)
        TR(p->in[I_WQ], 1024, NQ, 33, ws + WS_WQT, 0)
        TR(p->in[I_WQ] + (size_t)1024 * NQ, 1024, NQ, 33, ws + WS_WQT + (size_t)NQP * 1024 * 2, 0)
        TR(p->in[I_WONSA], 1024, 1024, 32, ws + WS_WONSA, 0)
        TR(p->in[I_WONSA] + (size_t)1024 * 1024, 1024, 1024, 32, ws + WS_WONSA + (size_t)1024 * 1024 * 2, 0)
#pragma unroll
        for (int l = 0; l < 4; ++l) {
            if (done) break;
            TRL(p->in[I_WIN] + (size_t)l * 1024 * 5632, 1024, 5632, 176, ws + WS_WINT + (size_t)l * 5632 * 1024 * 2, 0)
            TRL(p->in[I_WOUT] + (size_t)l * 2816 * 1024, 2816, 1024, 32, ws + WS_WOUTT + (size_t)l * 1024 * 2816 * 2, 0)
        }
        if (done) continue;
        TR(p->in[I_CW1], 1024, 128, 4, ws + WS_CW1T, 0)
        TR(p->in[I_CW1] + (size_t)1024 * 128, 1024, 128, 4, ws + WS_CW1T, 128)
        TR(p->in[I_CW1] + (size_t)2048 * 128, 1024, 128, 4, ws + WS_CW1T + (size_t)256 * 1024 * 2, 0)
        TR(p->in[I_CW1] + (size_t)3072 * 128, 1024, 128, 4, ws + WS_CW1T + (size_t)256 * 1024 * 2, 128)
#undef TR
#undef TRL
    }
    {
        bf16_t* WQT = (bf16_t*)(ws + WS_WQT);
        for (int e = c.gtid; e < 2 * 224 * 1024; e += c.gsz) { const int k = e & 1023, n = 1056 + ((e >> 10) % 224), l = e / (224 * 1024);
            WQT[((size_t)l * NQP + n) * 1024 + k] = n < NQ ? (bf16_t)f2bf(p->in[I_WQ][((size_t)l * 1024 + k) * NQ + n]) : (bf16_t)0; }
        bf16_t* W2V = (bf16_t*)(ws + WS_W2V);
        for (int e = c.gtid; e < 32 * 1024; e += c.gsz) { const int n = e & 1023, k = e >> 10; W2V[n * 32 + k] = (bf16_t)f2bf(p->in[I_V2][k * 1024 + n]); }
    }
    { bf16_t* W2T = (bf16_t*)(ws + WS_CW2T);
      for (int e = c.gtid; e < 2 * 128 * 64; e += c.gsz) { const int d = e & 63, q = (e >> 6) & 127, kv = e >> 13; const float w = p->in[I_CW2][e];
          const unsigned hi = f2bf(w), lo = f2bf(w - __builtin_bit_cast(float, hi << 16)); W2T[(size_t)(kv * 64 + d) * 128 + q] = (bf16_t)hi; W2T[(size_t)2 * 64 * 128 + (size_t)(kv * 64 + d) * 128 + q] = (bf16_t)lo; } }
    for (int it = c.gw; it < 256; it += c.ngw) { const int kv = it >> 7, h = it & 127; float s = 0.f;
        for (int kk = c.lane; kk < 2048; kk += 64) s += p->in[I_PE][kv * 2048 + kk] * p->in[I_CW1][((size_t)kv * 2048 + kk) * 128 + h];
        s = wave_sum(s); if (c.lane == 0) ((float*)(ws + WS_CBIAS))[it] = s + p->in[I_CB1][it]; }
    { const f32x4* xp = (const f32x4*)p->in[I_XP]; const f32x4* xs = (const f32x4*)p->in[I_XS]; f32x4* o = (f32x4*)(p->out + O_Y);
      for (int e = c.gtid; e < R * D / 4; e += c.gsz) o[e] = e < MP * D / 4 ? xp[e] : xs[e - MP * D / 4]; }
}

__device__ __forceinline__ void phase_fill(KP p, const Ctx& c, int li, const int gwf, const int ngwf) {
    unsigned char* ws = p->ws;
    { const int* pt = (const int*)p->in[I_PT]; bf16_t* CA = (bf16_t*)(ws + WS_CMPA); const int part = li;
      for (int it = gwf; it < SB * 128 * 4; it += ngwf) { const int s4 = 4 * (it & 3), n = (it >> 2) & 127, b = it >> 9;
          const int page = pt[b * NPAGES + (n >> 3)]; const float* src = p->in[I_CKV] + ((size_t)page * PAGE + (n & 7) * 16 + s4) * 1024 + part * 256;
          f32x4 v[4];
#pragma unroll
          for (int e = 0; e < 4; ++e) v[e] = __builtin_nontemporal_load(((const f32x4*)(src + (size_t)e * 1024)) + c.lane);
          const int g = c.lane >> 4, d0 = 4 * (c.lane & 15); bf16_t* dst = CA + ((size_t)8192 + (size_t)part * 65536 + (size_t)(b * 4 + g) * 128 + n) * 1024 + s4 * 64 + d0;
#pragma unroll
          for (int e = 0; e < 4; ++e) { u32x2 w; w.x = pk2(v[e][0], v[e][1]); w.y = pk2(v[e][2], v[e][3]); *(u32x2*)(dst + e * 64) = w; } } }
    { const f32x4* src = (const f32x4*)p->in[I_CWIN]; f32x4* dst = (f32x4*)(p->out + O_WINS); constexpr int HALF_N = SB * 508 * 128 / 2;
      for (int e0 = li * HALF_N + gwf * 256 + c.lane; e0 < (li + 1) * HALF_N; e0 += ngwf * 256) { f32x4 v[4];
#pragma unroll
          for (int q = 0; q < 4; ++q) { const int e = e0 + 64 * q; if (e < (li + 1) * HALF_N) { const int b = e / (508 * 128), rr = e % (508 * 128); v[q] = __builtin_nontemporal_load(src + (size_t)b * 512 * 128 + 4 * 128 + rr); } }
#pragma unroll
          for (int q = 0; q < 4; ++q) { const int e = e0 + 64 * q; if (e < (li + 1) * HALF_N) { const int b = e / (508 * 128), rr = e % (508 * 128); __builtin_nontemporal_store(v[q], dst + (size_t)b * 512 * 128 + rr); } } } }
}

template <int NT> __device__ __forceinline__ void skinny_mma(const bf16_t* A, int lda, const bf16_t* Wt, int ldw, int K, int row0, int col0, int lane, f32x4 (&acc)[NT][2]) {
    const int fr = lane & 15, fq = lane >> 4;
#pragma unroll
    for (int nt = 0; nt < NT; ++nt) { acc[nt][0] = (f32x4){0.f, 0.f, 0.f, 0.f}; acc[nt][1] = (f32x4){0.f, 0.f, 0.f, 0.f}; }
    const bf16_t* xa = A + (size_t)(row0 + fr) * lda + 8 * fq; const bf16_t* xb = xa + (size_t)16 * lda;
    const bf16_t* wa = Wt + (size_t)(col0 + fr) * ldw + 8 * fq;
    const char* pa = (const char*)xa; const char* pb = (const char*)xb; const char* pw[NT];
#pragma unroll
    for (int nt = 0; nt < NT; ++nt) pw[nt] = (const char*)(wa + (size_t)nt * 16 * ldw);
    for (int k4 = 0; k4 < K / 128; ++k4) {
        bf16x8 fb[4][2], fa[4][NT];
#pragma unroll
        for (int u = 0; u < 4; ++u) { fb[u][0] = *(const bf16x8*)(pa + 64 * u); fb[u][1] = *(const bf16x8*)(pb + 64 * u);
#pragma unroll
            for (int nt = 0; nt < NT; ++nt) fa[u][nt] = *(const bf16x8*)(pw[nt] + 64 * u); }
        __builtin_amdgcn_sched_barrier(0);
#pragma unroll
        for (int u = 0; u < 4; ++u)
#pragma unroll
            for (int nt = 0; nt < NT; ++nt) { acc[nt][0] = mfma16(fa[u][nt], fb[u][0], acc[nt][0]); acc[nt][1] = mfma16(fa[u][nt], fb[u][1], acc[nt][1]); }
        pa += 256; pb += 256;
#pragma unroll
        for (int nt = 0; nt < NT; ++nt) pw[nt] += 256;
        __builtin_amdgcn_sched_barrier(0);
    }
}
__device__ __forceinline__ void skinny_resid_sample(const Ctx& c, const bf16_t* A, int lda, const bf16_t* Wt, int K, float* X) {
    const int ln = launder_v(c.lane), fr = ln & 15, fq = ln >> 4;
    for (int it = blockIdx.x + gridDim.x * c.wave; it < 256; it += c.ngw) { const int row0 = MP + 32 * (it & 15), col0 = 64 * (it >> 4);
        f32x4 acc[4][2]; skinny_mma<4>(A, lda, Wt, lda, K, row0, col0, c.lane, acc);
#pragma unroll
        for (int nt = 0; nt < 4; ++nt)
#pragma unroll
            for (int mt = 0; mt < 2; ++mt) { f32x4* q = (f32x4*)(X + (size_t)(row0 + 16 * mt + fr) * D + col0 + 16 * nt + 4 * fq); *q = *q + acc[nt][mt]; } }
}
__device__ __forceinline__ void skinny_store(const Ctx& c, const bf16_t* A, const bf16_t* Wt, int K, float* C, int ldc, int rbase, int nrb, int ncb, int it0, int nit_total) {
    const int fr = c.lane & 15, fq = c.lane >> 4;
    for (int it = c.gw - it0; it < nrb * ncb; it += c.ngw) { if (it < 0) continue; const int row0 = rbase + 32 * (it % nrb), col0 = 64 * (it / nrb);
        f32x4 acc[4][2]; skinny_mma<4>(A, K, Wt, K, K, row0, col0, c.lane, acc);
#pragma unroll
        for (int nt = 0; nt < 4; ++nt)
#pragma unroll
            for (int mt = 0; mt < 2; ++mt) *(f32x4*)(C + (size_t)(row0 + 16 * mt + fr) * ldc + col0 + 16 * nt + 4 * fq) = acc[nt][mt]; }
    (void)nit_total;
}

__device__ __forceinline__ void load_row(const float* p, int lane, f32x4 (&v)[4]) {
#pragma unroll
    for (int j = 0; j < 4; ++j) v[j] = ((const f32x4*)p)[lane + 64 * j];
}
__device__ __forceinline__ float row_rstd(const f32x4 (&v)[4]) {
    float s = 0.f;
#pragma unroll
    for (int j = 0; j < 4; ++j) s += (v[j][0] * v[j][0] + v[j][1] * v[j][1]) + (v[j][2] * v[j][2] + v[j][3] * v[j][3]);
    s = wave_sum(s); return frsq(s * (1.0f / D) + NORM_EPS);
}
__device__ __forceinline__ void store_row_bf16(bf16_t* o, int lane, const f32x4 (&v)[4]) {
#pragma unroll
    for (int j = 0; j < 4; ++j) { u32x2 w; w.x = pk2(v[j][0], v[j][1]); w.y = pk2(v[j][2], v[j][3]); ((u32x2*)o)[lane + 64 * j] = w; }
}

__device__ __forceinline__ void phase_norm(const Ctx& c, const float* X, const float* g1, bf16_t* o1, const float* g2, bf16_t* o2) {
    f32x4 ga[4], gb[4]; load_row(g1, c.lane, ga); if (g2) load_row(g2, c.lane, gb);
    for (int row = c.gw; row < R; row += c.ngw) {
        f32x4 v[4]; load_row(X + (size_t)row * D, c.lane, v); const float rs = row_rstd(v);
        f32x4 y[4];
#pragma unroll
        for (int j = 0; j < 4; ++j) y[j] = v[j] * rs * ga[j];
        store_row_bf16(o1 + (size_t)row * D, c.lane, y);
        if (g2) {
#pragma unroll
            for (int j = 0; j < 4; ++j) y[j] = v[j] * rs * gb[j];
            store_row_bf16(o2 + (size_t)row * D, c.lane, y); }
    }
}

__device__ __forceinline__ void phase_mix(KP p, const Ctx& c, int li) {
    const float* X = p->out + O_Y; const float* gain = p->in[I_NORMG] + (size_t)(li * 2) * D; const float* mu = p->in[I_MU] + (size_t)li * 6 * D;
    bf16_t* XM = (bf16_t*)(p->ws + WS_XM);
    f32x4 ga[4]; load_row(gain, c.lane, ga);
    {
        const int r0 = (int)(((long)c.gw * R) / c.ngw), r1 = (int)(((long)(c.gw + 1) * R) / c.ngw); f32x4 prev[4];
        {
            const bool seq_start = r0 < MP ? ((r0 & (TP - 1)) == 0) : (((r0 - MP) & 3) == 0);
            if (!seq_start && r0 < r1) { f32x4 v[4]; load_row(X + (size_t)(r0 - 1) * D, c.lane, v); const float rs = row_rstd(v);
#pragma unroll
                for (int j = 0; j < 4; ++j) prev[j] = v[j] * rs * ga[j]; }
        }
        for (int row = r0; row < r1; ++row) {
            const bool seq_start = row < MP ? ((row & (TP - 1)) == 0) : (((row - MP) & 3) == 0);
            if (seq_start) {
                if (row < MP) {
#pragma unroll
                    for (int j = 0; j < 4; ++j) prev[j] = (f32x4){0.f, 0.f, 0.f, 0.f}; }
                else load_row(p->in[I_SSHIFT] + ((size_t)li * SB + ((row - MP) >> 2)) * D, c.lane, prev);
            }
            f32x4 v[4]; load_row(X + (size_t)row * D, c.lane, v); const float rs = row_rstd(v);
            f32x4 xn[4];
#pragma unroll
            for (int j = 0; j < 4; ++j) xn[j] = v[j] * rs * ga[j];
#pragma unroll
            for (int m = 0; m < 6; ++m) {
                f32x4 y[4];
#pragma unroll
                for (int j = 0; j < 4; ++j) { const int mi = m == 1 ? 2 : (m == 2 ? 3 : (m == 3 ? 1 : m));
                    const f32x4 mm = ((const f32x4*)(mu + (size_t)mi * D))[c.lane + 64 * j]; y[j] = xn[j] + (prev[j] - xn[j]) * mm; }
                store_row_bf16(XM + ((size_t)m * R + row) * D, c.lane, y);
            }
            const bool seq_end = row < MP ? ((row & (TP - 1)) == TP - 1) : (((row - MP) & 3) == 3);
            if (seq_end) { float* so = row < MP ? p->out + O_SHP + ((size_t)li * NB + (row >> 13)) * D : p->out + O_SHS + ((size_t)li * SB + ((row - MP) >> 2)) * D;
#pragma unroll
                for (int j = 0; j < 4; ++j) ((f32x4*)so)[c.lane + 64 * j] = xn[j]; }
#pragma unroll
            for (int j = 0; j < 4; ++j) prev[j] = xn[j];
        }
    }
}
template <int NT, int ACT> __device__ __forceinline__ void lora1_item(const bf16_t* X, const bf16_t* W, bf16_t* HID, int coloff, int rb, int lane) {
    lane = launder_v(lane);
    const int fr = lane & 15, fq = lane >> 4;
    f32x4 acc[NT][2]; skinny_mma<NT>(X, 1024, W, 1024, 1024, rb * 32, coloff, lane, acc);
#pragma unroll
    for (int nt = 0; nt < NT; ++nt)
#pragma unroll
        for (int mt = 0; mt < 2; ++mt) { f32x4 v = acc[nt][mt];
#pragma unroll
            for (int r = 0; r < 4; ++r) { if (ACT == 1) { const float e = __builtin_amdgcn_exp2f(2.8853900817779268f * v[r]); v[r] = 1.0f - 2.0f * frcp(e + 1.0f); } if (ACT == 2) v[r] = sigmoidf_(v[r]); }
            u32x2 w; w.x = pk2(v[0], v[1]); w.y = pk2(v[2], v[3]);
            *(u32x2*)(HID + (size_t)(rb * 32 + mt * 16 + fr) * LHID + coloff + nt * 16 + 4 * fq) = w; }
}
__device__ __forceinline__ void phase_lora1(KP p, const Ctx& c, int li) {
    const bf16_t* XM = (const bf16_t*)(p->ws + WS_XM); const bf16_t* W = (const bf16_t*)(p->ws + WS_W1T) + (size_t)li * 288 * 1024; bf16_t* HID = (bf16_t*)(p->ws + WS_HID);
    constexpr int NRB = R / 32;
    for (int it = blockIdx.x + gridDim.x * c.wave; it < 5 * NRB; it += c.ngw) { const int q = it / NRB, rb = it % NRB;
        if (q == 0) lora1_item<4, 1>(XM + (size_t)3 * R * D, W, HID, 0, rb, c.lane);
        else if (q == 1) lora1_item<4, 0>(XM + (size_t)4 * R * D, W, HID, 64, rb, c.lane);
        else if (q == 2) { if (li == 1) lora1_item<2, 0>(XM + (size_t)2 * R * D, W, HID, 128, rb, c.lane); }
        else if (q == 3) lora1_item<4, 2>(XM + (size_t)5 * R * D, W, HID, 160, rb, c.lane);
        else lora1_item<4, 2>(XM + (size_t)5 * R * D, W, HID, 224, rb, c.lane);
    }
}

constexpr int SST = 72, MAT = 64 * SST * 2;
constexpr int O_AT = 0, O_BT = MAT, O_KT = 2 * MAT, O_RT = 3 * MAT, O_VT = 4 * MAT, O_BH = 5 * MAT, O_KH = 6 * MAT, O_XT = 7 * MAT, O_AAB = 9 * MAT, O_AAK = 10 * MAT, O_ARB = 11 * MAT, O_ARK = 12 * MAT;
constexpr int O_TD = 13 * MAT, O_SCR = O_TD + 2048, O_CS = O_SCR + 4096, O_WC = O_CS + 2048, O_LW = O_XT, O_LA = O_XT + 16384, O_LV = O_XT + 32768;
static_assert(O_WC + 256 <= RING_BYTES && O_LV + 16384 <= O_TD, "scan LDS map");
__device__ __forceinline__ bf16x8 ldsfrag(LAS unsigned char* lds, int off, int row, int col) { return *(const LAS bf16x8*)(lds + off + (row * SST + col) * 2); }
__device__ __forceinline__ void lds_st4(LAS unsigned char* lds, int off, int row, int col, f32x4 v) { u32x2 w; w.x = pk2(v[0], v[1]); w.y = pk2(v[2], v[3]); *(LAS u32x2*)(lds + off + (row * SST + col) * 2) = w; }
__device__ __forceinline__ f32x4 lds_ld4(LAS unsigned char* lds, int off, int row, int col) { const u32x2 w = *(const LAS u32x2*)(lds + off + (row * SST + col) * 2); return (f32x4){bflo(w.x), bfhi(w.x), bflo(w.y), bfhi(w.y)}; }

__device__ __forceinline__ void scanA_unit(KP p, const Ctx& c, int li, int u) {
    LAS unsigned char* lds = c.lds; unsigned char* ws = p->ws; const int stop = p->pad;
    const int lane = c.lane, wave = c.wave, fr = lane & 15, fq = lane >> 4;
    const int b = u / (NCH * H), n = (u / H) % NCH, h = u % H, row0 = b * TP + 64 * n;
    const float* Rb = (const float*)(ws + WS_RK_R); const float* Kb = (const float*)(ws + WS_RK_K);
    float* Vb = (float*)(ws + (li ? WS_V1 : WS_V0)); const float* V0b = (const float*)(ws + WS_V0);
    const bf16_t* HID = (const bf16_t*)(ws + WS_HID);
    {
        const int tt = wave & 3, chh = wave >> 2;
        const bf16_t* hrow = launder_p(HID + (size_t)(row0 + 16 * tt + fr) * LHID + 8 * fq);
        const bf16_t* W2W = (const bf16_t*)(ws + WS_W2W) + (size_t)li * 1024 * 64; const bf16_t* W2A = (const bf16_t*)(ws + WS_W2A) + (size_t)li * 1024 * 64; const bf16_t* W2V = (const bf16_t*)(ws + WS_W2V);
#pragma unroll
        for (int cti = 0; cti < 2; ++cti) { const int ct = 2 * chh + cti, C = 64 * h + 16 * ct + fr;
            f32x4 aw = {0.f, 0.f, 0.f, 0.f}, aa = {0.f, 0.f, 0.f, 0.f}, av = {0.f, 0.f, 0.f, 0.f};
#pragma unroll
            for (int ks = 0; ks < 2; ++ks) {
                aw = mfma16(*(const bf16x8*)(W2W + (size_t)C * 64 + 32 * ks + 8 * fq), *(const bf16x8*)(hrow + 32 * ks), aw);
                aa = mfma16(*(const bf16x8*)(W2A + (size_t)C * 64 + 32 * ks + 8 * fq), *(const bf16x8*)(hrow + 64 + 32 * ks), aa); }
            if (li) av = mfma16(*(const bf16x8*)(W2V + (size_t)C * 32 + 8 * fq), *(const bf16x8*)(hrow + 128), av);
            const int t = 16 * tt + fr, cc = 16 * ct + 4 * fq;
            *(LAS f32x4*)(lds + O_LW + (t * 64 + cc) * 4) = aw; *(LAS f32x4*)(lds + O_LA + (t * 64 + cc) * 4) = aa; *(LAS f32x4*)(lds + O_LV + (t * 64 + cc) * 4) = av; }
    }
    __syncthreads();
    if (stop == 1) return;
    {
        const int cc = lane, tq = wave, C = 64 * h + cc; const size_t pc = (size_t)li * D + C;
        const float w0 = p->in[I_W0][pc], a0 = p->in[I_A0][pc], kkc = p->in[I_KK][pc], kac = p->in[I_KA][pc], rkc = p->in[I_RKK][pc], v0 = li ? p->in[I_V0][C] : 0.f;
        float wlg[8], Lin[8], rr[8], k2[8], vv[8], aa[8], bb[8]; float run = 0.f;
#pragma unroll
        for (int e = 0; e < 8; ++e) { const int t = 8 * tq + e; const size_t gi = (size_t)(row0 + t) * D + C;
            const float r = Rb[gi], k = Kb[gi]; float v = Vb[gi];
            const float lw = *(const LAS float*)(lds + O_LW + (t * 64 + cc) * 4), la = *(const LAS float*)(lds + O_LA + (t * 64 + cc) * 4);
            const float z = -(w0 + lw); const float sp = fmaxf(z, 0.f) + __logf(1.0f + __expf(-fabsf(z))); const float wl = -__expf(-sp - 0.5f);
            const float asig = sigmoidf_(a0 + la);
            if (li) { const float lv = *(const LAS float*)(lds + O_LV + (t * 64 + cc) * 4); const float vg = sigmoidf_(v0 + lv); const float vf = V0b[gi]; v = v + (vf - v) * vg; Vb[gi] = v; }
            const float kkr = k * kkc; const float ss = wave_sum(kkr * kkr); const float kkn = kkr * frsq(fmaxf(ss, 1e-24f));
            const float kmod = k * (1.0f + (asig - 1.0f) * kac);
            const float rks = wave_sum(r * kmod * rkc); if (cc == 0) ((float*)(ws + WS_RKS))[(size_t)(row0 + t) * 16 + h] = rks;
            run += wl; wlg[e] = wl; Lin[e] = run; rr[e] = r; k2[e] = kmod; vv[e] = v; aa[e] = -kkn; bb[e] = kkn * asig; }
        *(LAS float*)(lds + O_CS + (tq * 64 + cc) * 4) = run;
        __syncthreads();
        float off = 0.f, tot = 0.f;
#pragma unroll
        for (int q = 0; q < 8; ++q) { const float x = *(const LAS float*)(lds + O_CS + (q * 64 + cc) * 4); tot += x; if (q < tq) off += x; }
        u32x4 wa, wv, wb, wk; unsigned pa[8], pv[8], pb[8], pk[8];
#pragma unroll
        for (int e = 0; e < 8; ++e) { const int t = 8 * tq + e; const float L = off + Lin[e], Lp = L - wlg[e];
            const float eL = __expf(L), eLp = __expf(Lp), enL = __expf(-L), eT = __expf(tot - L);
            const float at = aa[e] * eLp, bt = bb[e] * enL, kt = k2[e] * enL, rt = rr[e] * eL, bh = bb[e] * eT, kh = k2[e] * eT;
            *(LAS bf16_t*)(lds + O_AT + (t * SST + cc) * 2) = (bf16_t)f2bf(at); *(LAS bf16_t*)(lds + O_BT + (t * SST + cc) * 2) = (bf16_t)f2bf(bt);
            *(LAS bf16_t*)(lds + O_KT + (t * SST + cc) * 2) = (bf16_t)f2bf(kt); *(LAS bf16_t*)(lds + O_RT + (t * SST + cc) * 2) = (bf16_t)f2bf(rt);
            pa[e] = f2bf(at); pv[e] = f2bf(vv[e]); pb[e] = f2bf(bh); pk[e] = f2bf(kh); }
        wa = (u32x4){pa[0] | (pa[1] << 16), pa[2] | (pa[3] << 16), pa[4] | (pa[5] << 16), pa[6] | (pa[7] << 16)};
        wv = (u32x4){pv[0] | (pv[1] << 16), pv[2] | (pv[3] << 16), pv[4] | (pv[5] << 16), pv[6] | (pv[7] << 16)};
        wb = (u32x4){pb[0] | (pb[1] << 16), pb[2] | (pb[3] << 16), pb[4] | (pb[5] << 16), pb[6] | (pb[7] << 16)};
        wk = (u32x4){pk[0] | (pk[1] << 16), pk[2] | (pk[3] << 16), pk[4] | (pk[5] << 16), pk[6] | (pk[7] << 16)};
        *(LAS u32x4*)(lds + O_XT + (cc * SST + 8 * tq) * 2) = wa; *(LAS u32x4*)(lds + O_VT + (cc * SST + 8 * tq) * 2) = wv;
        *(LAS u32x4*)(lds + O_BH + (cc * SST + 8 * tq) * 2) = wb; *(LAS u32x4*)(lds + O_KH + (cc * SST + 8 * tq) * 2) = wk;
        if (tq == 0) *(LAS float*)(lds + O_WC + cc * 4) = __expf(tot);
    }
    __syncthreads();
    if (stop == 2) return;
    {
        const int mi = wave >> 1, ph = wave & 1; const int oY = (mi & 1) ? O_KT : O_BT, oX = (mi < 2) ? O_AT : O_RT; const bool strict = mi < 2;
        const int oO = mi == 0 ? O_AAB : (mi == 1 ? O_AAK : (mi == 2 ? O_ARB : O_ARK));
#pragma unroll
        for (int sti = 0; sti < 2; ++sti) { const int st = 2 * ph + sti;
#pragma unroll
            for (int tt = 0; tt < 4; ++tt) { f32x4 acc = {0.f, 0.f, 0.f, 0.f};
                if (st <= tt) {
#pragma unroll
                    for (int ks = 0; ks < 2; ++ks) acc = mfma16(ldsfrag(lds, oY, 16 * st + fr, 32 * ks + 8 * fq), ldsfrag(lds, oX, 16 * tt + fr, 32 * ks + 8 * fq), acc);
                    const int t = 16 * tt + fr;
#pragma unroll
                    for (int r = 0; r < 4; ++r) { const int s = 16 * st + 4 * fq + r; const bool keep = strict ? (s < t) : (s <= t); acc[r] = keep ? acc[r] : 0.f; } }
                if (st <= tt) lds_st4(lds, oO, 16 * tt + fr, 16 * st + 4 * fq, acc);
                else { u32x2 zz; int z0 = 0; asm volatile("" : "+v"(z0)); zz.x = (unsigned)z0; zz.y = (unsigned)z0; *(LAS u32x2*)(lds + oO + ((16 * tt + fr) * SST + 16 * st + 4 * fq) * 2) = zz; } } }
    }
    __syncthreads();
    if (stop == 3) return;
    {
        const int tt = wave & 3, ih = wave >> 2;
#pragma unroll
        for (int iti = 0; iti < 2; ++iti) { const int it = 2 * ih + iti; f32x4 acc = {0.f, 0.f, 0.f, 0.f};
#pragma unroll
            for (int ks = 0; ks < 2; ++ks) acc = mfma16(ldsfrag(lds, O_AAK, 16 * tt + fr, 32 * ks + 8 * fq), ldsfrag(lds, O_VT, 16 * it + fr, 32 * ks + 8 * fq), acc);
            lds_st4(lds, O_XT, 64 + 16 * it + fr, 16 * tt + 4 * fq, acc); }
        if (wave < 4 && lane < 16) { const int I = wave; float x[16];
#pragma unroll
            for (int t = 0; t < 16; ++t) { float s = (t == lane) ? 1.0f : 0.0f;
#pragma unroll
                for (int q = 0; q < t; ++q) s += bf2f(*(const LAS bf16_t*)(lds + O_AAB + ((16 * I + t) * SST + 16 * I + q) * 2)) * x[q];
                x[t] = s; *(LAS bf16_t*)(lds + O_TD + ((I * 16 + t) * 16 + lane) * 2) = (bf16_t)f2bf(s); } }
    }
    __syncthreads();
    if (stop == 5) return;
    {
        const int colb = 16 * wave; const bf16x8 zero8 = {0, 0, 0, 0, 0, 0, 0, 0};
#pragma unroll
        for (int I = 0; I < 4; ++I) {
            f32x4 acc = lds_ld4(lds, O_XT, colb + fr, 16 * I + 4 * fq);
#pragma unroll
            for (int ks = 0; ks < 2; ++ks) if (32 * ks < 16 * I) { const bool ok = (32 * ks + 8 * fq) < 16 * I;
                const bf16x8 a = ok ? ldsfrag(lds, O_AAB, 16 * I + fr, 32 * ks + 8 * fq) : zero8, bq = ok ? ldsfrag(lds, O_XT, colb + fr, 32 * ks + 8 * fq) : zero8;
                acc = mfma16(a, bq, acc); }
            { u32x2 w; w.x = pk2(acc[0], acc[1]); w.y = pk2(acc[2], acc[3]); *(LAS u32x2*)(lds + O_SCR + wave * 512 + (fr * 16 + 4 * fq) * 2) = w; }
            LDS_WAIT();
            const bf16x8 ta = fq < 2 ? *(const LAS bf16x8*)(lds + O_TD + ((I * 16 + fr) * 16 + 8 * fq) * 2) : zero8;
            const bf16x8 tb = fq < 2 ? *(const LAS bf16x8*)(lds + O_SCR + wave * 512 + (fr * 16 + 8 * fq) * 2) : zero8;
            const f32x4 res = mfma16(ta, tb, (f32x4){0.f, 0.f, 0.f, 0.f});
            lds_st4(lds, O_XT, colb + fr, 16 * I + 4 * fq, res);
            LDS_WAIT();
        }
    }
    __syncthreads();
    if (stop == 6) return;
    {
        const int tb = wave & 3, hb = wave >> 2;
        bf16_t* RP = (bf16_t*)(ws + WS_RP) + (size_t)u * 4096; float* YL = (float*)(ws + WS_YL) + (size_t)u * 4096;
        bf16_t* MTH = (bf16_t*)(ws + WS_MT) + (size_t)u * 4096; bf16_t* MTL = MTH + (size_t)NUNIT_A * 4096; float* NN = (float*)(ws + WS_NN) + (size_t)u * 4096;
#pragma unroll
        for (int qi = 0; qi < 2; ++qi) { const int rt = 2 * hb + qi;
            { f32x4 acc = lds_ld4(lds, O_RT, 16 * tb + fr, 16 * rt + 4 * fq);
#pragma unroll
              for (int ks = 0; ks < 2; ++ks) acc = mfma16(ldsfrag(lds, O_XT, 16 * rt + fr, 32 * ks + 8 * fq), ldsfrag(lds, O_ARB, 16 * tb + fr, 32 * ks + 8 * fq), acc);
              u32x2 w; w.x = pk2(acc[0], acc[1]); w.y = pk2(acc[2], acc[3]); *(u32x2*)(RP + (size_t)(16 * tb + fr) * 64 + 16 * rt + 4 * fq) = w; }
            { f32x4 acc = {0.f, 0.f, 0.f, 0.f};
#pragma unroll
              for (int ks = 0; ks < 2; ++ks) { acc = mfma16(ldsfrag(lds, O_XT, 64 + 16 * rt + fr, 32 * ks + 8 * fq), ldsfrag(lds, O_ARB, 16 * tb + fr, 32 * ks + 8 * fq), acc);
                  acc = mfma16(ldsfrag(lds, O_VT, 16 * rt + fr, 32 * ks + 8 * fq), ldsfrag(lds, O_ARK, 16 * tb + fr, 32 * ks + 8 * fq), acc); }
              *(f32x4*)(YL + (size_t)(16 * tb + fr) * 64 + 16 * rt + 4 * fq) = acc; }
            { f32x4 acc = {0.f, 0.f, 0.f, 0.f};
#pragma unroll
              for (int ks = 0; ks < 2; ++ks) acc = mfma16(ldsfrag(lds, O_XT, 16 * rt + fr, 32 * ks + 8 * fq), ldsfrag(lds, O_BH, 16 * tb + fr, 32 * ks + 8 * fq), acc);
              const int j = 16 * tb + fr; const float wc = *(const LAS float*)(lds + O_WC + j * 4);
#pragma unroll
              for (int r = 0; r < 4; ++r) if (16 * rt + 4 * fq + r == j) acc[r] += wc;
              unsigned hh[4], ll[4];
#pragma unroll
              for (int r = 0; r < 4; ++r) { hh[r] = f2bf(acc[r]); ll[r] = f2bf(acc[r] - __builtin_bit_cast(float, hh[r] << 16)); }
              *(u32x2*)(MTH + (size_t)j * 64 + 16 * rt + 4 * fq) = (u32x2){hh[0] | (hh[1] << 16), hh[2] | (hh[3] << 16)};
              *(u32x2*)(MTL + (size_t)j * 64 + 16 * rt + 4 * fq) = (u32x2){ll[0] | (ll[1] << 16), ll[2] | (ll[3] << 16)}; }
            { f32x4 acc = {0.f, 0.f, 0.f, 0.f};
#pragma unroll
              for (int ks = 0; ks < 2; ++ks) { acc = mfma16(ldsfrag(lds, O_BH, 16 * rt + fr, 32 * ks + 8 * fq), ldsfrag(lds, O_XT, 64 + 16 * tb + fr, 32 * ks + 8 * fq), acc);
                  acc = mfma16(ldsfrag(lds, O_KH, 16 * rt + fr, 32 * ks + 8 * fq), ldsfrag(lds, O_VT, 16 * tb + fr, 32 * ks + 8 * fq), acc); }
              *(f32x4*)(NN + (size_t)(16 * tb + fr) * 64 + 16 * rt + 4 * fq) = acc; }
        }
    }
    __syncthreads();
}

__device__ __forceinline__ void scan_sample_item(KP p, const Ctx& c, int li, int item) {
    unsigned char* ws = p->ws; const int lane = c.lane, b = item >> 4, h = item & 15, C = 64 * h + lane; const size_t pc = (size_t)li * D + C;
    LAS float* sc = (LAS float*)(c.lds + c.wave * 16384);
    const float* Rb = (const float*)(ws + WS_RK_R); const float* Kb = (const float*)(ws + WS_RK_K);
    float* Vb = (float*)(ws + (li ? WS_V1 : WS_V0)); const float* V0b = (const float*)(ws + WS_V0);
    const bf16_t* HID = (const bf16_t*)(ws + WS_HID) + (size_t)(MP + 4 * b) * LHID;
    for (int e = lane; e < 4 * LHID; e += 64) sc[e] = bf2f(HID[e]);
    LDS_WAIT();
    float lw[4] = {0.f, 0.f, 0.f, 0.f}, la[4] = {0.f, 0.f, 0.f, 0.f}, lv[4] = {0.f, 0.f, 0.f, 0.f}, lg[4] = {0.f, 0.f, 0.f, 0.f};
    {
        const bf16_t* W2W = (const bf16_t*)(ws + WS_W2W) + ((size_t)li * 1024 + C) * 64; const bf16_t* W2A = (const bf16_t*)(ws + WS_W2A) + ((size_t)li * 1024 + C) * 64;
        const bf16_t* W2V = (const bf16_t*)(ws + WS_W2V) + (size_t)C * 32; const bf16_t* W2G = (const bf16_t*)(ws + WS_W2G) + ((size_t)li * 1024 + C) * 128;
#define LORA2_BLK(WP, QB, HOFF, ACC) { const u32x4 w8 = *(const u32x4*)((WP) + 8 * (QB)); \
            const float wf0 = bflo(w8.x), wf1 = bfhi(w8.x), wf2 = bflo(w8.y), wf3 = bfhi(w8.y), wf4 = bflo(w8.z), wf5 = bfhi(w8.z), wf6 = bflo(w8.w), wf7 = bfhi(w8.w); \
            _Pragma("unroll") for (int t = 0; t < 4; ++t) { const f32x4 h0 = *(const LAS f32x4*)(sc + t * LHID + (HOFF) + 8 * (QB)), h1 = *(const LAS f32x4*)(sc + t * LHID + (HOFF) + 8 * (QB) + 4); \
                ACC[t] += (h0[0] * wf0 + h0[1] * wf1) + (h0[2] * wf2 + h0[3] * wf3) + (h1[0] * wf4 + h1[1] * wf5) + (h1[2] * wf6 + h1[3] * wf7); } \
            asm volatile("" : "+v"(ACC[0]), "+v"(ACC[1]), "+v"(ACC[2]), "+v"(ACC[3]) :: "memory"); }
#pragma unroll
        for (int qb = 0; qb < 8; ++qb) { LORA2_BLK(W2W, qb, 0, lw) LORA2_BLK(W2A, qb, 64, la) }
        if (li) {
#pragma unroll
            for (int qb = 0; qb < 4; ++qb) LORA2_BLK(W2V, qb, 128, lv) }
#pragma unroll
        for (int qb = 0; qb < 16; ++qb) LORA2_BLK(W2G, qb, 160, lg)
#undef LORA2_BLK
    }
    const float w0 = p->in[I_W0][pc], a0 = p->in[I_A0][pc], kkc = p->in[I_KK][pc], kac = p->in[I_KA][pc], rkc = p->in[I_RKK][pc], v0 = li ? p->in[I_V0][C] : 0.f;
    const float lnw = p->in[I_LNW][pc], lnb = p->in[I_LNB][pc];
    float S[64];
    { const f32x4* sp = (const f32x4*)(p->in[I_SWKV] + (((size_t)li * SB + b) * H + h) * 4096 + lane * 64);
#pragma unroll
      for (int q = 0; q < 16; ++q) { const f32x4 x = sp[q]; S[4 * q] = x[0]; S[4 * q + 1] = x[1]; S[4 * q + 2] = x[2]; S[4 * q + 3] = x[3]; } }
    LAS float* bc = sc + 1280;
    bf16_t* YG = (bf16_t*)(ws + WS_YG);
#pragma unroll
    for (int t = 0; t < 4; ++t) { const size_t gi = (size_t)(MP + 4 * b + t) * D + C;
        const float r = Rb[gi], k = Kb[gi]; float v = Vb[gi];
        const float z = -(w0 + lw[t]); const float sp = fmaxf(z, 0.f) + __logf(1.0f + __expf(-fabsf(z))); const float wdec = __expf(-__expf(-sp - 0.5f));
        const float asig = sigmoidf_(a0 + la[t]);
        if (li) { const float vg = sigmoidf_(v0 + lv[t]); const float vf = V0b[gi]; v = v + (vf - v) * vg; }
        const float kkr = k * kkc; const float ss = wave_sum(kkr * kkr); const float kkn = kkr * frsq(fmaxf(ss, 1e-24f));
        const float kmod = k * (1.0f + (asig - 1.0f) * kac);
        const float rks = wave_sum(r * kmod * rkc);
        LDS_WAIT();
        bc[lane] = wdec; bc[64 + lane] = -kkn; bc[128 + lane] = kkn * asig; bc[192 + lane] = kmod; bc[256 + lane] = r;
        LDS_WAIT();
        float sa = 0.f;
#pragma unroll
        for (int q = 0; q < 16; ++q) { const f32x4 av = *(const LAS f32x4*)(bc + 64 + 4 * q); sa += S[4 * q] * av[0] + S[4 * q + 1] * av[1] + S[4 * q + 2] * av[2] + S[4 * q + 3] * av[3]; }
        float y = 0.f;
#pragma unroll
        for (int q = 0; q < 16; ++q) { const f32x4 wv = *(const LAS f32x4*)(bc + 4 * q), bv = *(const LAS f32x4*)(bc + 128 + 4 * q), kv = *(const LAS f32x4*)(bc + 192 + 4 * q), rv = *(const LAS f32x4*)(bc + 256 + 4 * q);
#pragma unroll
            for (int e = 0; e < 4; ++e) { const float s = S[4 * q + e] * wv[e] + sa * bv[e] + v * kv[e]; S[4 * q + e] = s; y += s * rv[e]; } }
        const float mean = wave_sum(y) * (1.0f / 64.0f); const float dy = y - mean; const float var = wave_sum(dy * dy) * (1.0f / 64.0f);
        const float yn = dy * (frsq(var + GN_EPS)) * lnw + lnb;
        YG[gi] = (bf16_t)f2bf((yn + rks * v) * lg[t]);
    }
    { f32x4* so = (f32x4*)(p->out + O_WKVS + (((size_t)li * SB + b) * H + h) * 4096 + lane * 64);
#pragma unroll
      for (int q = 0; q < 16; ++q) so[q] = (f32x4){S[4 * q], S[4 * q + 1], S[4 * q + 2], S[4 * q + 3]}; }
    LDS_WAIT();
}

__device__ __forceinline__ void phase_scanA(KP p, const Ctx& c, int li) {
    const int stop = p->pad;
    if (stop != 9) for (int u = blockIdx.x; u < NUNIT_A; u += gridDim.x) scanA_unit(p, c, li, u);
    if (stop == 0 || stop == 9) for (int it = c.gw; it < SB * H; it += c.ngw) scan_sample_item(p, c, li, it);
}

__device__ __forceinline__ void hilo(const f32x4 x0, const f32x4 x1, bf16x8& hi, bf16x8& lo) {
    unsigned h[8], l[8];
#pragma unroll
    for (int e = 0; e < 8; ++e) { const float x = e < 4 ? x0[e] : x1[e - 4]; h[e] = f2bf(x); l[e] = f2bf(x - __builtin_bit_cast(float, h[e] << 16)); }
    u32x4 hv = {h[0] | (h[1] << 16), h[2] | (h[3] << 16), h[4] | (h[5] << 16), h[6] | (h[7] << 16)}, lv = {l[0] | (l[1] << 16), l[2] | (l[3] << 16), l[4] | (l[5] << 16), l[6] | (l[7] << 16)};
    hi = __builtin_bit_cast(bf16x8, hv); lo = __builtin_bit_cast(bf16x8, lv);
}
constexpr int SB_SLOT = 20480, SB_RING0 = 8192, SB_DEPTH = 6;
static_assert(SB_RING0 + SB_DEPTH * SB_SLOT <= RING_BYTES, "chain ring");
__device__ __forceinline__ void phase_scanB(KP p, const Ctx& c, int li) {
    unsigned char* ws = p->ws; LAS unsigned char* lds = c.lds; const int lane = c.lane, fr = lane & 15, fq = lane >> 4, wave = c.wave;
    volatile LAS int* FL = (volatile LAS int*)(lds + RING_BYTES);
    if (c.tid < 4) FL[c.tid] = 0;
    __syncthreads();
    const int ncb = (int)gridDim.x < 128 ? (int)gridDim.x : 128;
    if (wave >= 4 || (int)blockIdx.x >= ncb) {
        const int gwf = (int)blockIdx.x < ncb ? (int)blockIdx.x * 4 + (wave - 4) : ncb * 4 + ((int)blockIdx.x - ncb) * 8 + wave, ngwf = ncb * 4 + ((int)gridDim.x - ncb) * 8;
        phase_fill(p, c, li, gwf, ngwf); return; }
    if (wave != 0) {
        const int j = wave - 1; int prevG = -1, kc = 0;
        for (int ch = blockIdx.x; ch < 128; ch += gridDim.x, ++kc) { const int b = ch >> 6, h = (ch >> 2) & 15, iq = ch & 3;
            for (int n = j; n < NCH; n += 3) { const int G = kc * NCH + n;
                if (G >= SB_DEPTH) { unsigned sp = 0; while (FL[0] < G - (SB_DEPTH - 1)) { __builtin_amdgcn_s_sleep(1); if (++sp > (1u << 22)) break; } }
                LAS unsigned char* slot = lds + SB_RING0 + (G % SB_DEPTH) * SB_SLOT;
                const size_t u = (size_t)(b * NCH + n) * H + h; const bf16_t* MTH = (const bf16_t*)(ws + WS_MT) + u * 4096; const bf16_t* MTL = MTH + (size_t)NUNIT_A * 4096; const float* NN = (const float*)(ws + WS_NN) + u * 4096;
#pragma unroll
                for (int jt = 0; jt < 4; ++jt)
#pragma unroll
                    for (int ks = 0; ks < 2; ++ks) {
                        __builtin_amdgcn_global_load_lds((const unsigned*)(MTH + (size_t)(16 * jt + fr) * 64 + 32 * ks + 8 * fq), (LAS unsigned*)(slot + ((jt * 2 + ks) * 2 + 0) * 1024), 16, 0, 0);
                        __builtin_amdgcn_global_load_lds((const unsigned*)(MTL + (size_t)(16 * jt + fr) * 64 + 32 * ks + 8 * fq), (LAS unsigned*)(slot + ((jt * 2 + ks) * 2 + 1) * 1024), 16, 0, 0); }
#pragma unroll
                for (int jt = 0; jt < 4; ++jt)
                    __builtin_amdgcn_global_load_lds((const unsigned*)(NN + (size_t)(16 * iq + fr) * 64 + 16 * jt + 4 * fq), (LAS unsigned*)(slot + (16 + jt) * 1024), 16, 0, 0);
                asm volatile("s_waitcnt vmcnt(20)" ::: "memory");
                if (prevG >= 0) FL[1 + j] = prevG + 1;
                prevG = G; } }
        asm volatile("s_waitcnt vmcnt(0)" ::: "memory");
        if (prevG >= 0) FL[1 + j] = prevG + 1;
        return; }
    int kc = 0;
    for (int ch = blockIdx.x; ch < 128; ch += gridDim.x, ++kc) {
        const int b = ch >> 6, h = (ch >> 2) & 15, iq = ch & 3;
        f32x4 S[4];
#pragma unroll
        for (int jt = 0; jt < 4; ++jt) S[jt] = (f32x4){0.f, 0.f, 0.f, 0.f};
        int j3 = 0;
        for (int n = 0; n < NCH; ++n) { const int G = kc * NCH + n;
            const size_t u = (size_t)(b * NCH + n) * H + h; bf16_t* S0 = (bf16_t*)(ws + WS_S0) + u * 4096;
            { unsigned sp = 0; while (FL[1 + j3] < G + 1) { __builtin_amdgcn_s_sleep(1); if (++sp > (1u << 22)) break; } }
            const LAS unsigned char* slot = lds + SB_RING0 + (G % SB_DEPTH) * SB_SLOT + lane * 16;
            bf16x8 ah[4][2], al[4][2]; f32x4 nn[4];
#pragma unroll
            for (int jt = 0; jt < 4; ++jt) { nn[jt] = *(const LAS f32x4*)(slot + (16 + jt) * 1024);
#pragma unroll
                for (int ks = 0; ks < 2; ++ks) { ah[jt][ks] = *(const LAS bf16x8*)(slot + ((jt * 2 + ks) * 2 + 0) * 1024); al[jt][ks] = *(const LAS bf16x8*)(slot + ((jt * 2 + ks) * 2 + 1) * 1024); } }
#pragma unroll
            for (int jt = 0; jt < 4; ++jt) { unsigned hh[4], ll[4];
#pragma unroll
                for (int r = 0; r < 4; ++r) { hh[r] = f2bf(S[jt][r]); ll[r] = f2bf(S[jt][r] - __builtin_bit_cast(float, hh[r] << 16)); }
                u32x2 wh = {hh[0] | (hh[1] << 16), hh[2] | (hh[3] << 16)}, wl = {ll[0] | (ll[1] << 16), ll[2] | (ll[3] << 16)};
                *(u32x2*)(S0 + (size_t)(16 * iq + fr) * 64 + 16 * jt + 4 * fq) = wh;
                *(LAS u32x2*)(lds + (fr * SST + 16 * jt + 4 * fq) * 2) = wh; *(LAS u32x2*)(lds + 4096 + (fr * SST + 16 * jt + 4 * fq) * 2) = wl; }
            LDS_WAIT();
            bf16x8 bh[2], bl[2];
#pragma unroll
            for (int ks = 0; ks < 2; ++ks) { bh[ks] = *(const LAS bf16x8*)(lds + (fr * SST + 32 * ks + 8 * fq) * 2); bl[ks] = *(const LAS bf16x8*)(lds + 4096 + (fr * SST + 32 * ks + 8 * fq) * 2); }
#pragma unroll
            for (int jt = 0; jt < 4; ++jt) { f32x4 acc = nn[jt];
#pragma unroll
                for (int ks = 0; ks < 2; ++ks) { acc = mfma16(ah[jt][ks], bh[ks], acc); acc = mfma16(ah[jt][ks], bl[ks], acc); acc = mfma16(al[jt][ks], bh[ks], acc); }
                S[jt] = acc; }
            LDS_WAIT();
            FL[0] = G + 1;
            j3 = j3 == 2 ? 0 : j3 + 1;
        }
        float* so = p->out + O_WKVP + (((size_t)li * NB + b) * H + h) * 4096;
#pragma unroll
        for (int jt = 0; jt < 4; ++jt) *(f32x4*)(so + (size_t)(16 * iq + fr) * 64 + 16 * jt + 4 * fq) = S[jt];
    }
}

__device__ __forceinline__ void phase_scanC(KP p, const Ctx& c, int li) {
    unsigned char* ws = p->ws; const int lane = c.lane, fr = lane & 15, fq = lane >> 4, hb = c.wave >> 2, tt = c.wave & 3;
    const float* Vb = (const float*)(ws + (li ? WS_V1 : WS_V0)); const bf16_t* HID = (const bf16_t*)(ws + WS_HID); const bf16_t* W2G = (const bf16_t*)(ws + WS_W2G) + (size_t)li * 1024 * 128;
    bf16_t* YG = (bf16_t*)(ws + WS_YG);
    for (int up = blockIdx.x; up < NUNIT_A / 2; up += gridDim.x) {
        const int u = 2 * up + hb; const int b = u / (NCH * H), n = (u / H) % NCH, h = u % H; const int row = b * TP + 64 * n + 16 * tt + fr;
        const bf16_t* RP = (const bf16_t*)(ws + WS_RP) + (size_t)u * 4096; const float* YL = (const float*)(ws + WS_YL) + (size_t)u * 4096; const bf16_t* S0 = (const bf16_t*)(ws + WS_S0) + (size_t)u * 4096;
        f32x4 acc[4], ag[4];
#pragma unroll
        for (int it = 0; it < 4; ++it) { acc[it] = *(const f32x4*)(YL + (size_t)(16 * tt + fr) * 64 + 16 * it + 4 * fq); ag[it] = (f32x4){0.f, 0.f, 0.f, 0.f}; }
#pragma unroll
        for (int ks = 0; ks < 2; ++ks) { const bf16x8 bq = *(const bf16x8*)(RP + (size_t)(16 * tt + fr) * 64 + 32 * ks + 8 * fq);
#pragma unroll
            for (int it = 0; it < 4; ++it) acc[it] = mfma16(*(const bf16x8*)(S0 + (size_t)(16 * it + fr) * 64 + 32 * ks + 8 * fq), bq, acc[it]); }
        const bf16_t* hgp = launder_p(HID + (size_t)row * LHID + 160 + 8 * fq); const bf16_t* wgp = launder_p(W2G + (size_t)(64 * h + fr) * 128 + 8 * fq);
#pragma unroll
        for (int ks = 0; ks < 4; ++ks) { const bf16x8 bq = *(const bf16x8*)(hgp + 32 * ks);
#pragma unroll
            for (int it = 0; it < 4; ++it) ag[it] = mfma16(*(const bf16x8*)(wgp + it * 16 * 128 + 32 * ks), bq, ag[it]); }
        float s = 0.f;
#pragma unroll
        for (int it = 0; it < 4; ++it) s += (acc[it][0] + acc[it][1]) + (acc[it][2] + acc[it][3]);
        s = sum_rows4(s); const float mean = s * (1.0f / 64.0f);
        float q = 0.f;
#pragma unroll
        for (int it = 0; it < 4; ++it) { const f32x4 d = acc[it] - mean; q += (d[0] * d[0] + d[1] * d[1]) + (d[2] * d[2] + d[3] * d[3]); }
        q = sum_rows4(q); const float rstd = frsq(q * (1.0f / 64.0f) + GN_EPS);
        const float rks = ((const float*)(ws + WS_RKS))[(size_t)row * 16 + h];
#pragma unroll
        for (int it = 0; it < 4; ++it) { const int C = 64 * h + 16 * it + 4 * fq; const size_t pc = (size_t)li * D + C;
            const f32x4 lw = *(const f32x4*)(p->in[I_LNW] + pc), lb = *(const f32x4*)(p->in[I_LNB] + pc), v = *(const f32x4*)(Vb + (size_t)row * D + C);
            const f32x4 o = ((acc[it] - mean) * rstd * lw + lb + v * rks) * ag[it];
            u32x2 w; w.x = pk2(o[0], o[1]); w.y = pk2(o[2], o[3]); *(u32x2*)(YG + (size_t)row * D + C) = w; }
    }
}
__device__ __forceinline__ void ld8bf(const bf16_t* p, float (&o)[8]) { const u32x4 w = *(const u32x4*)p; o[0] = bflo(w.x); o[1] = bfhi(w.x); o[2] = bflo(w.y); o[3] = bfhi(w.y); o[4] = bflo(w.z); o[5] = bfhi(w.z); o[6] = bflo(w.w); o[7] = bfhi(w.w); }
__device__ __forceinline__ void ld8f(const float* p, float (&o)[8]) { const f32x4 a = *(const f32x4*)p, b = *(const f32x4*)(p + 4); o[0] = a[0]; o[1] = a[1]; o[2] = a[2]; o[3] = a[3]; o[4] = b[0]; o[5] = b[1]; o[6] = b[2]; o[7] = b[3]; }
__device__ __forceinline__ void phase_conv(KP p, const Ctx& c, int layer) {
    const bf16_t* U = (const bf16_t*)(p->ws + WS_U); const bf16_t* GT = (const bf16_t*)(p->ws + WS_GT); bf16_t* HH = (bf16_t*)(p->ws + WS_HH);
    const float* cw = p->in[I_CONVW] + (size_t)layer * 3 * DFF; const float* cb = p->in[I_CONVB] + (size_t)layer * DFF; const float* st = p->in[I_SCONV] + (size_t)layer * SB * 2 * DFF;
    constexpr int NF8 = DFF / 8;
    for (int e = c.gtid; e < R * NF8; e += c.gsz) { const int row = e / NF8, f = 8 * (e % NF8);
        int t, b; if (row < MP) { t = row & (TP - 1); b = -1; } else { t = (row - MP) & 3; b = (row - MP) >> 2; }
        float u0[8], u1[8], u2[8], g[8], w0[8], w1[8], w2[8], bb[8];
        ld8bf(U + (size_t)row * DFF + f, u2); ld8bf(GT + (size_t)row * DFF + f, g);
        if (t >= 1) ld8bf(U + (size_t)(row - 1) * DFF + f, u1); else if (b >= 0) ld8f(st + ((size_t)b * 2 + 1) * DFF + f, u1); else {
#pragma unroll
            for (int i = 0; i < 8; ++i) u1[i] = 0.f; }
        if (t >= 2) ld8bf(U + (size_t)(row - 2) * DFF + f, u0); else if (b >= 0) ld8f(st + ((size_t)b * 2 + t) * DFF + f, u0); else {
#pragma unroll
            for (int i = 0; i < 8; ++i) u0[i] = 0.f; }
        ld8f(cw + f, w0); ld8f(cw + DFF + f, w1); ld8f(cw + 2 * DFF + f, w2); ld8f(cb + f, bb);
        float o[8];
#pragma unroll
        for (int i = 0; i < 8; ++i) o[i] = gelu_tanh(bb[i] + w0[i] * u0[i] + w1[i] * u1[i] + w2[i] * u2[i]) * g[i];
        u32x4 w; w.x = pk2(o[0], o[1]); w.y = pk2(o[2], o[3]); w.z = pk2(o[4], o[5]); w.w = pk2(o[6], o[7]);
        *(u32x4*)(HH + (size_t)row * DFF + f) = w; }
}

__device__ __forceinline__ void phase_kvpost(KP p, const Ctx& c) {
    const float* KVF = (const float*)(p->ws + WS_KVF); unsigned char* ws = p->ws; const int lane = c.lane, g = lane >> 4, d0 = 4 * (lane & 15);
    const f32x4 gs = *(const f32x4*)(p->in[I_KNG] + 64 + d0), gw = *(const f32x4*)(p->in[I_KNG] + 128 + d0);
    bf16_t* CA = (bf16_t*)(ws + WS_CMPA); bf16_t* KS = (bf16_t*)(ws + WS_KS); bf16_t* VS = (bf16_t*)(ws + WS_VS); bf16_t* KW = (bf16_t*)(ws + WS_KW); bf16_t* VW = (bf16_t*)(ws + WS_VW);
    for (int chunk = c.gw; chunk < R / 8; chunk += c.ngw) {
        unsigned vs_[4][4], vw_[4][4];
#pragma unroll
        for (int e = 0; e < 8; ++e) { const int row = chunk * 8 + e; const float* src = KVF + (size_t)row * NKV + 4 * lane;
            f32x4 v[6];
#pragma unroll
            for (int pt = 0; pt < 6; ++pt) v[pt] = *(const f32x4*)(src + pt * 256);
            { float s = (v[2][0] * v[2][0] + v[2][1] * v[2][1]) + (v[2][2] * v[2][2] + v[2][3] * v[2][3]);
              s = row16_sum(s); const float rs = frsq(s * (1.0f / 64.0f) + NORM_EPS); v[2] = v[2] * rs * gs; }
            { float s = (v[4][0] * v[4][0] + v[4][1] * v[4][1]) + (v[4][2] * v[4][2] + v[4][3] * v[4][3]);
              s = row16_sum(s); const float rs = frsq(s * (1.0f / 64.0f) + NORM_EPS); v[4] = v[4] * rs * gw; }
            float* okv = p->out + O_KV + (size_t)row * D + 4 * lane;
#pragma unroll
            for (int pt = 0; pt < 4; ++pt) *(f32x4*)(okv + pt * 256) = v[pt];
            if (row < MP) { const int b = row >> 13, t = row & (TP - 1);
                if (t >= TP - WIN) { float* ow = p->out + O_WINP + ((size_t)(b * WIN + (t - (TP - WIN))) * 2) * 256 + 4 * lane; *(f32x4*)ow = v[4]; *(f32x4*)(ow + 256) = v[5]; }
                const size_t hb = (size_t)(b * G + g);
                { u32x2 w; w.x = pk2(v[0][0], v[0][1]); w.y = pk2(v[0][2], v[0][3]); *(u32x2*)(CA + (hb * 512 + (t >> 4)) * 1024 + (t & 15) * 64 + d0) = w; }
                { u32x2 w; w.x = pk2(v[1][0], v[1][1]); w.y = pk2(v[1][2], v[1][3]); *(u32x2*)(CA + ((size_t)4096 + hb * 512 + (t >> 4)) * 1024 + (t & 15) * 64 + d0) = w; }
                { u32x2 w; w.x = pk2(v[2][0], v[2][1]); w.y = pk2(v[2][2], v[2][3]); *(u32x2*)(KS + (hb * TP + t) * 64 + d0) = w; }
                { u32x2 w; w.x = pk2(v[4][0], v[4][1]); w.y = pk2(v[4][2], v[4][3]); *(u32x2*)(KW + (hb * TP + t) * 64 + d0) = w; }
#pragma unroll
                for (int d = 0; d < 4; ++d) { const unsigned a = f2bf(v[3][d]), bq = f2bf(v[5][d]);
                    if (e & 1) { vs_[d][e >> 1] |= a << 16; vw_[d][e >> 1] |= bq << 16; } else { vs_[d][e >> 1] = a; vw_[d][e >> 1] = bq; } }
            } else { const int b = (row - MP) >> 2, t = (row - MP) & 3;
                float* ow = p->out + O_WINS + ((size_t)(b * WIN + 508 + t) * 2) * 256 + 4 * lane; *(f32x4*)ow = v[4]; *(f32x4*)(ow + 256) = v[5]; }
        }
        if (chunk * 8 < MP) { const int row = chunk * 8, b = row >> 13, t = row & (TP - 1); const size_t hb = (size_t)(b * G + g);
#pragma unroll
            for (int d = 0; d < 4; ++d) { *(u32x4*)(VS + (hb * 64 + d0 + d) * TP + t) = (u32x4){vs_[d][0], vs_[d][1], vs_[d][2], vs_[d][3]};
                *(u32x4*)(VW + (hb * 64 + d0 + d) * TP + t) = (u32x4){vw_[d][0], vw_[d][1], vw_[d][2], vw_[d][3]}; } }
    }
}

__device__ __forceinline__ void phase_cmp2(KP p, const Ctx& c) {
    unsigned char* ws = p->ws; const float* PC = (const float*)(ws + WS_PCMP); const int lane = c.lane, fr = lane & 15, fq = lane >> 4;
    const bf16_t* W2H = (const bf16_t*)(ws + WS_CW2T); const bf16_t* W2L = W2H + 2 * 64 * 128;
    constexpr int NPI = NB * G * 32, NSI = SB * G * 8, TOT = 2 * (NPI + NSI);
    for (int it = c.gw; it < TOT; it += c.ngw) {
        const bool samp = it >= 2 * NPI; const int r = samp ? it - 2 * NPI : it; const int kv = samp ? r / NSI : r / NPI; const int idx = samp ? r % NSI : r % NPI;
        const int hb = samp ? (idx >> 3) : (idx >> 5), n0 = 16 * (samp ? (idx & 7) : (idx & 31)), ncmp = samp ? NCMP_S : NCMP_P, nper = samp ? 128 : 512;
        const int n = n0 + fr; const bool live = n < ncmp;
        const size_t prow = (samp ? (size_t)8192 + (size_t)kv * 65536 : (size_t)kv * 4096) + (size_t)hb * nper + (live ? n : ncmp - 1);
        const float* cb = (const float*)(ws + WS_CBIAS) + kv * 128;
        bf16x8 hh[4], hl[4];
#pragma unroll
        for (int ks = 0; ks < 4; ++ks) { const int k0 = 32 * ks + 8 * fq; unsigned uh[8], ul[8];
            const f32x4 a0 = *(const f32x4*)(PC + prow * 256 + k0), a1 = *(const f32x4*)(PC + prow * 256 + k0 + 4);
            const f32x4 b0 = *(const f32x4*)(PC + (prow + 1) * 256 + 128 + k0), b1 = *(const f32x4*)(PC + (prow + 1) * 256 + 128 + k0 + 4);
            const f32x4 c0 = *(const f32x4*)(cb + k0), c1 = *(const f32x4*)(cb + k0 + 4);
#pragma unroll
            for (int e = 0; e < 8; ++e) { const float x = e < 4 ? a0[e] + b0[e] + c0[e] : a1[e - 4] + b1[e - 4] + c1[e - 4]; const float hv = gelu_tanh(x);
                uh[e] = f2bf(hv); ul[e] = f2bf(hv - __builtin_bit_cast(float, uh[e] << 16)); }
            const u32x4 wh = {uh[0] | (uh[1] << 16), uh[2] | (uh[3] << 16), uh[4] | (uh[5] << 16), uh[6] | (uh[7] << 16)}, wl = {ul[0] | (ul[1] << 16), ul[2] | (ul[3] << 16), ul[4] | (ul[5] << 16), ul[6] | (ul[7] << 16)};
            hh[ks] = __builtin_bit_cast(bf16x8, wh); hl[ks] = __builtin_bit_cast(bf16x8, wl); }
        f32x4 acc[4];
#pragma unroll
        for (int dt = 0; dt < 4; ++dt) { acc[dt] = *(const f32x4*)(p->in[I_CB2] + kv * 64 + 16 * dt + 4 * fq);
#pragma unroll
            for (int ks = 0; ks < 4; ++ks) { const size_t wo = (size_t)(kv * 64 + 16 * dt + fr) * 128 + 32 * ks + 8 * fq; const bf16x8 wh = *(const bf16x8*)(W2H + wo), wl = *(const bf16x8*)(W2L + wo);
                acc[dt] = mfma16(wh, hh[ks], acc[dt]); acc[dt] = mfma16(wh, hl[ks], acc[dt]); acc[dt] = mfma16(wl, hh[ks], acc[dt]); } }
        if (kv == 0) { float ss = 0.f;
#pragma unroll
            for (int dt = 0; dt < 4; ++dt) ss += (acc[dt][0] * acc[dt][0] + acc[dt][1] * acc[dt][1]) + (acc[dt][2] * acc[dt][2] + acc[dt][3] * acc[dt][3]);
            ss = sum_rows4(ss); const float rs = frsq(ss * (1.0f / 64.0f) + NORM_EPS);
#pragma unroll
            for (int dt = 0; dt < 4; ++dt) acc[dt] = acc[dt] * rs * *(const f32x4*)(p->in[I_KNG] + 16 * dt + 4 * fq); }
#pragma unroll
        for (int dt = 0; dt < 4; ++dt) { const f32x4 o = live ? acc[dt] : (f32x4){0.f, 0.f, 0.f, 0.f}; const int d = 16 * dt + 4 * fq;
            if (samp) *(f32x4*)((float*)(ws + (kv ? WS_CVS : WS_CKS)) + ((size_t)hb * 128 + n) * 64 + d) = o;
            else if (kv == 0) { u32x2 w; w.x = pk2(o[0], o[1]); w.y = pk2(o[2], o[3]); *(u32x2*)((bf16_t*)(ws + WS_CK) + ((size_t)hb * 512 + n) * 64 + d) = w; }
            else {
#pragma unroll
                for (int e = 0; e < 4; ++e) ((bf16_t*)(ws + WS_CV))[((size_t)hb * 64 + d + e) * 512 + n] = (bf16_t)f2bf(o[e]); } }
    }
}

__device__ __forceinline__ void phase_qpost(KP p, const Ctx& c, int lb) {
    const float* QF = (const float*)(p->ws + WS_QF); bf16_t* Q = (bf16_t*)(p->ws + WS_Q); const int lane = c.lane;
    const f32x4 gq = *(const f32x4*)(p->in[I_QNG] + lb * 64 + 4 * (lane & 15));
    for (int row = c.gw; row < R; row += c.ngw) { const float* src = QF + (size_t)row * NQP;
        f32x4 v[4]; load_row(src, lane, v);
#pragma unroll
        for (int j = 0; j < 4; ++j) { float s = (v[j][0] * v[j][0] + v[j][1] * v[j][1]) + (v[j][2] * v[j][2] + v[j][3] * v[j][3]);
            s = row16_sum(s);
            const float rs = (frsq(s * (1.0f / 64.0f) + NORM_EPS)) * (0.125f * 1.4426950408889634f); v[j] = v[j] * rs * gq; }
        store_row_bf16(Q + (size_t)row * D, lane, v);
    }
}
constexpr int AT_K0 = 0, AT_V0 = 9216, AT_K1 = 18432, AT_V1 = 27648, AT_IMP = 36864, IMPS = 132, AT_SELM = AT_IMP + 64 * IMPS * 4, AT_ANY = AT_SELM + 1024;
static_assert(AT_ANY + 16 <= RING_BYTES, "attention LDS map");
struct TileSrc { const bf16_t* K; const bf16_t* VT; int vts; };
__device__ __forceinline__ void tile_load(const TileSrc& s, int key0, int tid, u32x4& rk, u32x4& rv) {
    const int row = tid >> 3, ch = tid & 7;
    rk = *(const u32x4*)(s.K + (size_t)(key0 + row) * 64 + 8 * ch); rv = *(const u32x4*)(s.VT + (size_t)row * s.vts + key0 + 8 * ch);
}
__device__ __forceinline__ void tile_store(LAS unsigned char* lds, int buf, int tid, const u32x4& rk, const u32x4& rv) {
    const int row = tid >> 3, ch = tid & 7;
    *(LAS u32x4*)(lds + (buf ? AT_K1 : AT_K0) + (row * SST + 8 * ch) * 2) = rk; *(LAS u32x4*)(lds + (buf ? AT_V1 : AT_V0) + (row * SST + 8 * ch) * 2) = rv;
}
__device__ __forceinline__ int first_bit4(unsigned a, unsigned b, unsigned c, unsigned d) { return a ? __ffs(a) - 1 : (b ? 32 + __ffs(b) - 1 : (c ? 64 + __ffs(c) - 1 : (d ? 96 + __ffs(d) - 1 : -1))); }
__device__ __forceinline__ float ex2(float x) { return __builtin_amdgcn_exp2f(x); }

__device__ __forceinline__ void set_bit4(int s, unsigned& t0, unsigned& t1, unsigned& t2, unsigned& t3) { const unsigned bit = 1u << (s & 31); const int w = s >> 5; t0 |= (w == 0) ? bit : 0u; t1 |= (w == 1) ? bit : 0u; t2 |= (w == 2) ? bit : 0u; t3 |= (w == 3) ? bit : 0u; }
__device__ __forceinline__ void clr_bit4(int s, unsigned& t0, unsigned& t1, unsigned& t2, unsigned& t3) { const unsigned bit = 1u << (s & 31); const int w = s >> 5; t0 &= ~((w == 0) ? bit : 0u); t1 &= ~((w == 1) ? bit : 0u); t2 &= ~((w == 2) ? bit : 0u); t3 &= ~((w == 3) ? bit : 0u); }
__device__ __forceinline__ unsigned get_word4(int s, unsigned a, unsigned b, unsigned c, unsigned d) { const int w = s >> 5; return ((w == 0) ? a : 0u) | ((w == 1) ? b : 0u) | ((w == 2) ? c : 0u) | ((w == 3) ? d : 0u); }
__device__ __forceinline__ float dpp_xor1(float x) { return __builtin_bit_cast(float, __builtin_amdgcn_update_dpp(0, __builtin_bit_cast(int, x), 0xB1, 0xF, 0xF, true)); }
__device__ __forceinline__ float dpp_xor2(float x) { return __builtin_bit_cast(float, __builtin_amdgcn_update_dpp(0, __builtin_bit_cast(int, x), 0x4E, 0xF, 0xF, true)); }
template <int MODE, bool EDGE> __device__ __forceinline__ void attn_tile(LAS unsigned char* lds, int buf, const bf16x8 (&qf)[4], int key0, int qpos, int r, int hf,
                                                                          float& l, f32x16 (&O)[2], float invl, bool selbit, LAS float* impq) {
    if (MODE == 3) { if (__ballot(selbit) == 0ull) { asm volatile("" : "+v"(O[0]), "+v"(O[1]), "+v"(l)); return; } }
    const float sbias = selbit ? 0.f : -1.0e30f;
    const int oK = buf ? AT_K1 : AT_K0, oV = buf ? AT_V1 : AT_V0;
#pragma unroll
    for (int kt = 0; kt < 2; ++kt) {
        f32x16 S;
#pragma unroll
        for (int i = 0; i < 16; ++i) S[i] = (MODE == 3) ? sbias : 0.f;
#pragma unroll
        for (int ks = 0; ks < 4; ++ks) S = mfma32(*(const LAS bf16x8*)(lds + oK + ((32 * kt + r) * SST + 16 * ks + 8 * hf) * 2), qf[ks], S);
        float ls = 0.f;
#pragma unroll
        for (int i = 0; i < 16; ++i) { float pv = ex2(S[i]);
            if (EDGE) { const int key = key0 + 32 * kt + (i & 3) + 8 * (i >> 2) + 4 * hf; bool v;
                if (MODE <= 1) v = (16 * key + 31 <= qpos); else if (MODE == 2) v = (key <= qpos) && (key + WIN > qpos); else v = (key <= qpos);
                pv = v ? pv : 0.f; }
            if (MODE == 1) pv *= invl;
            S[i] = pv; ls += pv; }
        if (MODE != 1) l += ls;
        if (MODE >= 1) {
#pragma unroll
            for (int sp = 0; sp < 2; ++sp) {
                u32x4 pw; pw.x = pg8::cvt_pk_bf16(S[8 * sp + 0], S[8 * sp + 1]); pw.y = pg8::cvt_pk_bf16(S[8 * sp + 2], S[8 * sp + 3]); pw.z = pg8::cvt_pk_bf16(S[8 * sp + 4], S[8 * sp + 5]); pw.w = pg8::cvt_pk_bf16(S[8 * sp + 6], S[8 * sp + 7]);
                const bf16x8 pf = __builtin_bit_cast(bf16x8, pw);
#pragma unroll
                for (int dt = 0; dt < 2; ++dt) { const int d = 32 * dt + r, kb = 32 * kt + 16 * sp + 4 * hf;
                    const u32x2 lo = *(const LAS u32x2*)(lds + oV + (d * SST + kb) * 2), hi = *(const LAS u32x2*)(lds + oV + (d * SST + kb + 8) * 2);
                    const u32x4 vw = {lo.x, lo.y, hi.x, hi.y};
                    O[dt] = mfma32(__builtin_bit_cast(bf16x8, vw), pf, O[dt]); } }
        }
        if (MODE == 1) {
            float own[4], nxt[4];
#pragma unroll
            for (int gq = 0; gq < 4; ++gq) { const float p3 = S[4 * gq + 3]; float o = 2.0f * (S[4 * gq] + S[4 * gq + 1] + S[4 * gq + 2]) + p3, n = p3;
                o += dpp_xor1(o); o += dpp_xor2(o); n += dpp_xor1(n); n += dpp_xor2(n); own[gq] = o; nxt[gq] = n; }
            const int sbb = (key0 >> 2) + 8 * kt + hf;
            if ((r & 3) == 0) {
#pragma unroll
                for (int gq = 0; gq < 4; ++gq) impq[sbb + 2 * gq] += own[gq]; }
            asm volatile("s_waitcnt lgkmcnt(0)" ::: "memory");
            if ((r & 3) == 0) {
#pragma unroll
                for (int gq = 0; gq < 4; ++gq) impq[sbb + 2 * gq + 1] += nxt[gq]; }
            asm volatile("s_waitcnt lgkmcnt(0)" ::: "memory");
        }
    }
}

template <int MODE> __device__ __forceinline__ void run_tiles(LAS unsigned char* lds, const TileSrc& src, unsigned t0, unsigned t1, unsigned t2, unsigned t3, int qt,
                                                              const bf16x8 (&qf)[4], int qpos, int r, int hf, int tid,
                                                              float& l, f32x16 (&O)[2], float invl, unsigned s0, unsigned s1, unsigned s2, unsigned s3, LAS float* impq, const int alias = 0) {
#define TSEL(n_) ((alias ? ((n_) & 7) : (n_)) * 64)
    tid = launder_v(tid); r = tid & 31; hf = (tid >> 5) & 1;
    int cur = first_bit4(t0, t1, t2, t3); if (cur < 0) return;
    clr_bit4(cur, t0, t1, t2, t3); int n1 = first_bit4(t0, t1, t2, t3); if (n1 >= 0) clr_bit4(n1, t0, t1, t2, t3);
    int n2 = first_bit4(t0, t1, t2, t3); if (n2 >= 0) clr_bit4(n2, t0, t1, t2, t3);
    u32x4 rkA, rvA, rkB, rvB; { u32x4 rk, rv; tile_load(src, TSEL(cur), tid, rk, rv); int b0 = 0; tile_store(lds, b0, tid, rk, rv); }
    if (n1 >= 0) tile_load(src, TSEL(n1), tid, rkA, rvA);
    if (n2 >= 0) tile_load(src, TSEL(n2), tid, rkB, rvB);
    int buf = 0;
    __syncthreads();
    for (;;) {
        const unsigned sw = get_word4(cur, s0, s1, s2, s3);
        const bool sb = ((sw >> (cur & 31)) & 1u) != 0u;
        if (MODE <= 1) attn_tile<MODE, true>(lds, buf, qf, cur * 64, qpos, r, hf, l, O, invl, sb, impq);
        else { const bool edge = (cur == qt) || (MODE == 2 && cur == qt - 8);
            if (edge) attn_tile<MODE, true>(lds, buf, qf, cur * 64, qpos, r, hf, l, O, invl, sb, impq);
            else attn_tile<MODE, false>(lds, buf, qf, cur * 64, qpos, r, hf, l, O, invl, sb, impq); }
        if (n1 < 0) break;
        tile_store(lds, buf ^ 1, tid, rkA, rvA);
        __syncthreads();
        rkA = rkB; rvA = rvB;
        const int n3 = first_bit4(t0, t1, t2, t3); if (n3 >= 0) { clr_bit4(n3, t0, t1, t2, t3); tile_load(src, TSEL(n3), tid, rkB, rvB); }
        buf ^= 1; cur = n1; n1 = n2; n2 = n3;
    }
    __syncthreads();
}
__device__ __forceinline__ void attn_prompt_unit(KP p, const Ctx& c, int k, const int stop) {
    LAS unsigned char* lds = c.lds; unsigned char* ws = p->ws; int tid_m; asm volatile("v_mbcnt_lo_u32_b32 %0, -1, 0\n\tv_mbcnt_hi_u32_b32 %0, -1, %0" : "=v"(tid_m));
    const int wave = c.wave, tid = tid_m + 64 * wave, lane = tid & 63, r = lane & 31, hf = lane >> 5;
    const int qt = 127 - (k >> 3), hb = k & 7, b = hb >> 2, g = hb & 3, q0 = 64 * qt;
    const int qi = 8 * wave + (r >> 2), head = 4 * g + (r & 3), qpos = q0 + qi, row = b * TP + qpos;
    const bf16_t* Q = (const bf16_t*)(ws + WS_Q);
    bf16x8 qf[4];
#pragma unroll
    for (int ks = 0; ks < 4; ++ks) qf[ks] = *(const bf16x8*)(Q + (size_t)row * D + head * 64 + 16 * ks + 8 * hf);
    const float* gate = (const float*)(ws + WS_GATE) + (size_t)row * 48 + head * 3; const float g_c = gate[0], g_s = gate[1], g_w = gate[2];
    LAS float* imp = (LAS float*)(lds + AT_IMP); LAS unsigned* selm = (LAS unsigned*)(lds + AT_SELM); LAS unsigned* anym = (LAS unsigned*)(lds + AT_ANY);
    for (int e = tid; e < 64 * IMPS; e += 512) imp[e] = 0.f;
    if (tid < 4) anym[tid] = 0u;
    __syncthreads();
    f32x16 O[2]; unsigned OUTP[2][8];
#pragma unroll
    for (int dt = 0; dt < 2; ++dt)
#pragma unroll
        for (int i = 0; i < 16; ++i) O[dt][i] = 0.f;
    {
        const TileSrc src{(const bf16_t*)(ws + WS_CK) + (size_t)hb * 512 * 64, (const bf16_t*)(ws + WS_CV) + (size_t)hb * 64 * 512, 512};
        const int nmax = q0 + 63 - 31; const int ntc = nmax >= 0 ? (nmax >> 10) + 1 : 0;
        const unsigned tm = ntc >= 32 ? 0xffffffffu : ((1u << ntc) - 1u);
        float l = 0.f;
        run_tiles<0>(lds, src, tm, 0u, 0u, 0u, qt, qf, qpos, r, hf, tid, l, O, 0.f, 0u, 0u, 0u, 0u, imp);
        l = sum_xor32(l); const float invl = l > 0.f ? 1.0f / l : 0.f;
        run_tiles<1>(lds, src, tm, 0u, 0u, 0u, qt, qf, qpos, r, hf, tid, l, O, invl, 0u, 0u, 0u, 0u, imp + qi * IMPS);
#pragma unroll
        for (int dt = 0; dt < 2; ++dt) {
#pragma unroll
            for (int i = 0; i < 8; ++i) { OUTP[dt][i] = pg8::cvt_pk_bf16(O[dt][2 * i] * g_c, O[dt][2 * i + 1] * g_c); asm volatile("" : "+v"(OUTP[dt][i])); }
#pragma unroll
            for (int i = 0; i < 16; ++i) O[dt][i] = 0.f; }
    }
    __syncthreads();
    if (stop == 1) return;
    for (int e = 0; e < 8; ++e) { const int qq = 8 * wave + e, qp = q0 + qq, qb = qp >> 6;
        const bool c0 = (64 * lane <= qp), c1 = (64 * (lane + 64) <= qp);
        const unsigned k0 = (lane == 0 || lane == qb || lane == qb - 1) ? 0xffffffffu : __builtin_bit_cast(unsigned, imp[qq * IMPS + lane]);
        const unsigned k1 = (lane + 64 == qb || lane + 64 == qb - 1) ? 0xffffffffu : __builtin_bit_cast(unsigned, imp[qq * IMPS + lane + 64]);
        const int K = qb + 1 < 16 ? qb + 1 : 16;
        unsigned T = 0u;
        for (int bit = 31; bit >= 0; --bit) { const unsigned cand = T | (1u << bit);
            const int cnt = __popcll(__ballot(c0 && k0 >= cand)) + __popcll(__ballot(c1 && k1 >= cand)); if (cnt >= K) T = cand; }
        unsigned long long mlo = __ballot(c0 && k0 > T), mhi = __ballot(c1 && k1 > T), elo = __ballot(c0 && k0 == T), ehi = __ballot(c1 && k1 == T);
        int need = K - (__popcll(mlo) + __popcll(mhi));
        for (; need > 0; --need) { if (elo) { mlo |= elo & (~elo + 1ull); elo &= elo - 1ull; } else { mhi |= ehi & (~ehi + 1ull); ehi &= ehi - 1ull; } }
        const unsigned m0 = (unsigned)mlo, m1 = (unsigned)(mlo >> 32), m2 = (unsigned)mhi, m3 = (unsigned)(mhi >> 32);
        if (lane == 0) { selm[qq * 4 + 0] = m0; selm[qq * 4 + 1] = m1; selm[qq * 4 + 2] = m2; selm[qq * 4 + 3] = m3;
            atomicOr((unsigned*)&anym[0], m0); atomicOr((unsigned*)&anym[1], m1); atomicOr((unsigned*)&anym[2], m2); atomicOr((unsigned*)&anym[3], m3); } }
    __syncthreads();
    if (stop == 2) return;
    {
        const TileSrc src{(const bf16_t*)(ws + WS_KW) + (size_t)hb * TP * 64, (const bf16_t*)(ws + WS_VW) + (size_t)hb * 64 * TP, TP};
        const int tlo = qt >= 8 ? qt - 8 : 0; unsigned t0 = 0u, t1 = 0u, t2 = 0u, t3 = 0u;
        for (int s = tlo; s <= qt; ++s) set_bit4(s, t0, t1, t2, t3);
        float l = 0.f;
        run_tiles<2>(lds, src, t0, t1, t2, t3, qt, qf, qpos, r, hf, tid, l, O, 0.f, 0u, 0u, 0u, 0u, imp);
        l = sum_xor32(l); const float sc = l > 0.f ? g_w / l : 0.f;
#pragma unroll
        for (int dt = 0; dt < 2; ++dt) {
#pragma unroll
            for (int i = 0; i < 8; ++i) { OUTP[dt][i] = pg8::cvt_pk_bf16(bflo(OUTP[dt][i]) + O[dt][2 * i] * sc, bfhi(OUTP[dt][i]) + O[dt][2 * i + 1] * sc); asm volatile("" : "+v"(OUTP[dt][i])); }
#pragma unroll
            for (int i = 0; i < 16; ++i) O[dt][i] = 0.f; }
    }
    if (stop == 3) { __syncthreads(); return; }
    {
        const TileSrc src{(const bf16_t*)(ws + WS_KS) + (size_t)hb * TP * 64, (const bf16_t*)(ws + WS_VS) + (size_t)hb * 64 * TP, TP};
        const unsigned s0 = selm[qi * 4 + 0], s1 = selm[qi * 4 + 1], s2 = selm[qi * 4 + 2], s3 = selm[qi * 4 + 3];
        const unsigned a0 = __builtin_amdgcn_readfirstlane(anym[0]), a1 = __builtin_amdgcn_readfirstlane(anym[1]), a2 = __builtin_amdgcn_readfirstlane(anym[2]), a3 = __builtin_amdgcn_readfirstlane(anym[3]);
        float l = 0.f;
        run_tiles<3>(lds, src, a0, a1, a2, a3, qt, qf, qpos, r, hf, tid, l, O, 0.f, s0, s1, s2, s3, imp, stop == 4 ? 1 : 0);
        if (stop == 4) { if (l == 12345.678f) ((float*)(ws + WS_GATE))[0] = O[0][0] + O[1][0]; __syncthreads(); return; }
        l = sum_xor32(l); const float sc = l > 0.f ? g_s / l : 0.f;
#pragma unroll
        for (int dt = 0; dt < 2; ++dt)
#pragma unroll
            for (int i = 0; i < 8; ++i) OUTP[dt][i] = pg8::cvt_pk_bf16(bflo(OUTP[dt][i]) + O[dt][2 * i] * sc, bfhi(OUTP[dt][i]) + O[dt][2 * i + 1] * sc);
    }
    bf16_t* AO = (bf16_t*)(ws + WS_YG) + (size_t)row * D + head * 64;
#pragma unroll
    for (int dt = 0; dt < 2; ++dt)
#pragma unroll
        for (int gq = 0; gq < 4; ++gq) { u32x2 w; w.x = OUTP[dt][2 * gq]; w.y = OUTP[dt][2 * gq + 1]; *(u32x2*)(AO + 32 * dt + 8 * gq + 4 * hf) = w; }
    __syncthreads();
}

constexpr int SA_RED = 0, SA_REDW = 2 * 16 * 65 * 4, SA_OC = SA_RED + SA_REDW, SA_EC = SA_OC + 2 * 4096, SA_LC = SA_EC + 2 * 4096, SA_PN = SA_LC + 256, SA_SEL = SA_PN + 4 * 512;
static_assert(SA_SEL + 64 <= RING_BYTES, "sample attention LDS map");
__device__ __forceinline__ bf16x8 pack8(const f32x4 a, const f32x4 b) { const u32x4 w = {pk2(a[0], a[1]), pk2(a[2], a[3]), pk2(b[0], b[1]), pk2(b[2], b[3])}; return __builtin_bit_cast(bf16x8, w); }
__device__ __forceinline__ void sa_qk(const float* kb, size_t stride, int nrows, const bf16x8 (&qf)[2], int fr, int fq, f32x4 (&S)[4]) {
    f32x4 kr[4][2][2];
#pragma unroll
    for (int kg = 0; kg < 4; ++kg) { const int key = 16 * kg + fr; const float* rp = kb + (size_t)(key < nrows ? key : nrows - 1) * stride + 8 * fq;
#pragma unroll
        for (int ks = 0; ks < 2; ++ks) { kr[kg][ks][0] = *(const f32x4*)(rp + 32 * ks); kr[kg][ks][1] = *(const f32x4*)(rp + 32 * ks + 4); } }
#pragma unroll
    for (int kg = 0; kg < 4; ++kg) { S[kg] = (f32x4){0.f, 0.f, 0.f, 0.f};
#pragma unroll
        for (int ks = 0; ks < 2; ++ks) S[kg] = mfma16(pack8(kr[kg][ks][0], kr[kg][ks][1]), qf[ks], S[kg]); }
}
__device__ __forceinline__ void sa_pv(const float* vb, size_t stride, int nrows, const f32x4 (&P)[4], int fr, int fq, f32x4 (&O)[4]) {
#pragma unroll
    for (int ks = 0; ks < 2; ++ks) { const bf16x8 pa = pack8(P[2 * ks], P[2 * ks + 1]);
        float vv[4][8];
#pragma unroll
        for (int j = 0; j < 8; ++j) { const int key = 16 * (2 * ks + (j >> 2)) + 4 * fq + (j & 3); const float* rp = vb + (size_t)(key < nrows ? key : nrows - 1) * stride + fr;
#pragma unroll
            for (int dt = 0; dt < 4; ++dt) vv[dt][j] = rp[16 * dt]; }
#pragma unroll
        for (int dt = 0; dt < 4; ++dt) { const u32x4 w = {pk2(vv[dt][0], vv[dt][1]), pk2(vv[dt][2], vv[dt][3]), pk2(vv[dt][4], vv[dt][5]), pk2(vv[dt][6], vv[dt][7])};
            O[dt] = mfma16(pa, __builtin_bit_cast(bf16x8, w), O[dt]); } }
}
__device__ __forceinline__ void attn_sample_unit(KP p, const Ctx& c, int item) {
    unsigned char* ws = p->ws; LAS unsigned char* lds = c.lds; const int tid = launder_v(c.tid), lane = tid & 63, wave = c.wave, fr = lane & 15, fq = lane >> 4; const int b = item >> 2, g = item & 3;
    bf16x8 qf[2];
    { const bf16_t* Q = (const bf16_t*)(ws + WS_Q) + (size_t)(MP + 4 * b + (fr >> 2)) * D + (4 * g + (fr & 3)) * 64 + 8 * fq;
      qf[0] = *(const bf16x8*)Q; qf[1] = *(const bf16x8*)(Q + 32); }
    const int tokm = fr >> 2;
    if (wave < 2) {
        const float* ck = (const float*)(ws + WS_CKS) + ((size_t)(b * 4 + g) * 128 + 64 * wave) * 64; const float* cv = (const float*)(ws + WS_CVS) + ((size_t)(b * 4 + g) * 128 + 64 * wave) * 64;
        const int nrows = wave ? 63 : 64;
        f32x4 S[4]; sa_qk(ck, 64, nrows, qf, fr, fq, S);
        float ls = 0.f;
#pragma unroll
        for (int kg = 0; kg < 4; ++kg)
#pragma unroll
            for (int r = 0; r < 4; ++r) { const int key = 16 * kg + 4 * fq + r; const float ev = key < nrows ? ex2(S[kg][r]) : 0.f; S[kg][r] = ev; ls += ev;
                *(LAS float*)(lds + SA_EC + wave * 4096 + (key * 16 + fr) * 4) = ev; }
        ls = sum_rows4(ls); if (fq == 0) *(LAS float*)(lds + SA_LC + (wave * 16 + fr) * 4) = ls;
        f32x4 oc[4];
#pragma unroll
        for (int dt = 0; dt < 4; ++dt) oc[dt] = (f32x4){0.f, 0.f, 0.f, 0.f};
        sa_pv(cv, 64, nrows, S, fr, fq, oc);
#pragma unroll
        for (int dt = 0; dt < 4; ++dt)
#pragma unroll
            for (int r = 0; r < 4; ++r) *(LAS float*)(lds + SA_OC + wave * 4096 + ((4 * fq + r) * 64 + 16 * dt + fr) * 4) = oc[dt][r];
    }
    __syncthreads();
    if (wave < 4) { const int tok = wave; float P0 = 0.f, P1 = 0.f;
#pragma unroll
        for (int hh = 0; hh < 4; ++hh) { const int pi = tok * 4 + hh; const float L = *(const LAS float*)(lds + SA_LC + pi * 4) + *(const LAS float*)(lds + SA_LC + (16 + pi) * 4); const float inv = L > 0.f ? 1.0f / L : 0.f;
            P0 += *(const LAS float*)(lds + SA_EC + (lane * 16 + pi) * 4) * inv; P1 += *(const LAS float*)(lds + SA_EC + 4096 + (lane * 16 + pi) * 4) * inv; }
        LAS float* pn = (LAS float*)(lds + SA_PN + tok * 512); pn[lane] = P0; pn[64 + lane] = P1; LDS_WAIT();
        float v0 = -1e9f;
        if (lane < 33) { const int s = lane; float im = 0.f;
            if (4 * s - 1 >= 0 && 4 * s - 1 < 128) im += pn[4 * s - 1];
#pragma unroll
            for (int j = 0; j < 3; ++j) if (4 * s + j < 128) im += 2.0f * pn[4 * s + j];
            if (4 * s + 3 < 128) im += pn[4 * s + 3];
            v0 = (s == 0 || s == 31 || s == 32) ? 1e9f : im; }
        unsigned selmask = 0u, sel32 = 0u;
        for (int it = 0; it < 16; ++it) { const float mx = wave_max(v0); if (mx < -5e8f) break; const unsigned long long b0 = __ballot(v0 == mx); const int s = __ffsll((long long)b0) - 1;
            if (lane == s) v0 = -2e9f; if (s < 32) selmask |= 1u << s; else sel32 = 1u; }
        if (lane == 0) { *(LAS unsigned*)(lds + SA_SEL + tok * 8) = selmask; *(LAS unsigned*)(lds + SA_SEL + tok * 8 + 4) = sel32; } }
    __syncthreads();
    unsigned sm[4], s32[4];
#pragma unroll
    for (int t = 0; t < 4; ++t) { sm[t] = *(const LAS unsigned*)(lds + SA_SEL + t * 8); s32[t] = *(const LAS unsigned*)(lds + SA_SEL + t * 8 + 4); }
    const unsigned un = sm[0] | sm[1] | sm[2] | sm[3]; const int nsel = __popc(un); const int has32 = (s32[0] | s32[1] | s32[2] | s32[3]) ? 1 : 0;
    const unsigned my_sm = tokm == 0 ? sm[0] : (tokm == 1 ? sm[1] : (tokm == 2 ? sm[2] : sm[3])), my_s32 = tokm == 0 ? s32[0] : (tokm == 1 ? s32[1] : (tokm == 2 ? s32[2] : s32[3]));
    const int ntile = nsel + has32 + 9;
    const int* pt = (const int*)p->in[I_PT] + b * NPAGES;
    f32x4 osel[4], owin[4]; float lsel = 0.f, lwin = 0.f;
#pragma unroll
    for (int dt = 0; dt < 4; ++dt) { osel[dt] = (f32x4){0.f, 0.f, 0.f, 0.f}; owin[dt] = (f32x4){0.f, 0.f, 0.f, 0.f}; }
    for (int ti = wave; ti < ntile; ti += 8) {
        const float* kb; size_t stride; int nrows = 64, br, mode, sidx = 0;
        if (ti < nsel) { unsigned m = un; for (int q = 0; q < ti; ++q) m &= m - 1u; sidx = __ffs(m) - 1; const int page = pt[sidx >> 1];
            kb = p->in[I_CKV] + ((size_t)page * PAGE + (sidx & 1) * 64) * 1024 + 2 * 256 + g * 64; stride = 1024; br = 0; mode = 0; }
        else if (ti < nsel + has32) { kb = p->out + O_KV + (size_t)(MP + 4 * b) * D + 2 * 256 + g * 64; stride = 1024; nrows = 4; br = 0; mode = 1; }
        else if (ti < nsel + has32 + 8) { sidx = ti - nsel - has32; kb = p->in[I_CWIN] + ((size_t)b * WIN + 64 * sidx) * 512 + g * 64; stride = 512; br = 1; mode = 2; }
        else { kb = p->out + O_WINS + ((size_t)(b * WIN + 508) * 2) * 256 + g * 64; stride = 512; nrows = 4; br = 1; mode = 3; }
        f32x4 S[4]; sa_qk(kb, stride, nrows, qf, fr, fq, S);
        float ls = 0.f;
#pragma unroll
        for (int kg = 0; kg < 4; ++kg)
#pragma unroll
            for (int r = 0; r < 4; ++r) { const int key = 16 * kg + 4 * fq + r; bool valid;
                if (mode == 0) valid = ((my_sm >> sidx) & 1u) != 0u; else if (mode == 1) valid = (my_s32 != 0u) && (key <= tokm); else if (mode == 2) valid = (64 * sidx + key) >= tokm + 1; else valid = key <= tokm;
                const float ev = valid ? ex2(S[kg][r]) : 0.f; S[kg][r] = ev; ls += ev; }
        if (br == 0) { lsel += ls; sa_pv(kb + 256, stride, nrows, S, fr, fq, osel); } else { lwin += ls; sa_pv(kb + 256, stride, nrows, S, fr, fq, owin); }
    }
    lsel = sum_rows4(lsel); lwin = sum_rows4(lwin);
    for (int w = 0; w < 8; ++w) {
        if (wave == w) {
#pragma unroll
            for (int dt = 0; dt < 4; ++dt)
#pragma unroll
                for (int r = 0; r < 4; ++r) { LAS float* r0 = (LAS float*)(lds + SA_RED + ((4 * fq + r) * 65 + 16 * dt + fr) * 4); LAS float* r1 = (LAS float*)(lds + SA_RED + ((16 + 4 * fq + r) * 65 + 16 * dt + fr) * 4);
                    if (w == 0) { *r0 = osel[dt][r]; *r1 = owin[dt][r]; } else { *r0 += osel[dt][r]; *r1 += owin[dt][r]; } }
            if (fq == 0) { LAS float* l0 = (LAS float*)(lds + SA_RED + (fr * 65 + 64) * 4); LAS float* l1 = (LAS float*)(lds + SA_RED + ((16 + fr) * 65 + 64) * 4);
                if (w == 0) { *l0 = lsel; *l1 = lwin; } else { *l0 += lsel; *l1 += lwin; } } }
        __syncthreads(); }
    { const float* gt = (const float*)(ws + WS_GATE); bf16_t* AO = (bf16_t*)(ws + WS_YG);
      for (int e = tid; e < 1024; e += 512) { const int pi = e >> 6, d = e & 63, tok = pi >> 2, hh = pi & 3; const size_t row = (size_t)(MP + 4 * b + tok);
          const float lc = *(const LAS float*)(lds + SA_LC + pi * 4) + *(const LAS float*)(lds + SA_LC + (16 + pi) * 4);
          const float oc = *(const LAS float*)(lds + SA_OC + (pi * 64 + d) * 4) + *(const LAS float*)(lds + SA_OC + 4096 + (pi * 64 + d) * 4);
          const LAS float* r0 = (const LAS float*)(lds + SA_RED + (pi * 65) * 4); const LAS float* r1 = (const LAS float*)(lds + SA_RED + ((16 + pi) * 65) * 4);
          const float* gg = gt + row * 48 + (4 * g + hh) * 3;
          float out = lc > 0.f ? gg[0] * oc / lc : 0.f;
          out += r0[64] > 0.f ? gg[1] * r0[d] / r0[64] : 0.f;
          out += r1[64] > 0.f ? gg[2] * r1[d] / r1[64] : 0.f;
          AO[row * D + (4 * g + hh) * 64 + d] = (bf16_t)f2bf(out); } }
    __syncthreads();
}

__device__ __forceinline__ void phase_attn_prompt(KP p, const Ctx& c, const int stop = 0) {
    const int Gd = gridDim.x, cb = blockIdx.x;
    for (int i = 0; i * Gd < 1024; ++i) { const int k = i * Gd + ((i & 1) ? Gd - 1 - cb : cb); if (k < 1024) attn_prompt_unit(p, c, k, stop); }
}
__device__ __forceinline__ void phase_attn_sample(KP p, const Ctx& c) {
    for (int it = blockIdx.x; it < SB * G; it += gridDim.x) attn_sample_unit(p, c, it);
}
#ifndef MK_MULTI
#define MK_MULTI 0
#endif
#if defined(PROBE_SCALE) || defined(SELFTEST)
constexpr int NPH = 46;
#elif defined(PROBE_ATTN2)
constexpr int NPH = 47;
#else
constexpr int NPH = 45;
#endif
#ifdef SPLITK
#define RESID_SPLIT(n) (n)
#else
#define RESID_SPLIT(n) 0
#endif

__global__ void __launch_bounds__(512, 2) mega(Params p) {
    extern __shared__ __attribute__((aligned(16))) unsigned char lds_raw[];
    LAS unsigned char* const lds0 = (LAS unsigned char*)lds_raw;
    volatile LAS unsigned* MISC = (volatile LAS unsigned*)(lds0 + MISC_OFF);
    for (int u = threadIdx.x; u < (LDS_BYTES - RING_BYTES) / 4; u += 512) ((LAS unsigned*)(lds0 + RING_BYTES))[u] = 0u;
    __syncthreads();
    const KP kp0 = (KP)__builtin_amdgcn_kernarg_segment_ptr();
    const int ph_lo = kp0->ph_lo, ph_hi = kp0->ph_hi, use_bar = kp0->use_bar;
    XcdBarrier bar; bar.bar = (unsigned*)(kp0->ws + WS_CTL); bar.x = 0; bar.st = nullptr;
    if (use_bar) bar = xcd_barrier_post((unsigned*)(kp0->ws + WS_CTL), MISC + 8);
    const int wave_s = __builtin_amdgcn_readfirstlane((int)threadIdx.x >> 6);
#define TID_MBCNT 1
#ifdef TID_MBCNT
#define TID_SRC(T_) asm volatile("v_mbcnt_lo_u32_b32 %0, -1, 0\n\tv_mbcnt_hi_u32_b32 %0, -1, %0" : "=v"(T_)); T_ += 64 * wave_s;
#else
#define TID_SRC(T_) T_ = threadIdx.x; asm volatile("" : "+v"(T_));
#endif
    int ph = 0;
#define PHASE_BEGIN if (ph >= ph_lo && ph < ph_hi) { KP p = kp0; asm volatile("" : "+s"(p)); int tid_; TID_SRC(tid_) \
        Ctx c; c.lds = lds0; c.tid = tid_; c.lane = tid_ & 63; c.wave = __builtin_amdgcn_readfirstlane(tid_ >> 6); c.gw = blockIdx.x * 8 + c.wave; c.ngw = gridDim.x * 8; c.gtid = blockIdx.x * 512 + tid_; c.gsz = gridDim.x * 512; \
        unsigned char* ws = p->ws; float* X = p->out + O_Y; (void)ws; (void)X;
#define PHASE_END   if (use_bar) { int te_; TID_SRC(te_) xcd_barrier(bar, te_ == 0); } } ++ph;

    PHASE_BEGIN phase_prologue(p, c); PHASE_END
#ifdef PROBE_BAR
    for (int xb = 0; xb < PROBE_BAR; ++xb) { if (use_bar) xcd_barrier(bar, threadIdx.x == 0); }
#endif

    for (int layer = 0; layer < NLAY; ++layer) {
        if (layer < 2) {
            const int li = layer;
            PHASE_BEGIN phase_mix(p, c, li); PHASE_END
            PHASE_BEGIN {
                pg8::Gemm g{(const bf16_t*)(ws + WS_XM), (const bf16_t*)(ws + WS_WRKV) + (size_t)li * 3072 * 1024, 3 * R, 3072, 1024, 1024};
                pg8::GroupOrder S; S.init((int)gridDim.x, (int)blockIdx.x); S.add(0, 0, 64, 0, 4); S.add(1, 66, 64, 4, 4); S.add(2, 132, 64, 8, 4);
                pg8::EpiF32G E{(float*)(ws + WS_RK_R), (float*)(ws + WS_RK_K), (float*)(ws + (li ? WS_V1 : WS_V0)), nullptr, D, 4, 66};
                pg8::gemm_phase<pg8::EpiF32G, pg8::GroupOrder, true, true>(c.lds, g, S, E, c.tid);
                {
                    const bf16_t* XMs = (const bf16_t*)(ws + WS_XM); const bf16_t* Wr = (const bf16_t*)(ws + WS_WRKV) + (size_t)li * 3072 * 1024;
                    for (int it = blockIdx.x + gridDim.x * c.wave; it < 768; it += c.ngw) { const int j = it >> 8, r = it & 255, row0 = MP + 32 * (r & 15), col0 = 64 * (r >> 4);
                        float* C = (float*)(ws + (j == 0 ? WS_RK_R : (j == 1 ? WS_RK_K : (li ? WS_V1 : WS_V0))));
                        f32x4 acc[4][2]; skinny_mma<4>(XMs + (size_t)j * R * D, 1024, Wr + (size_t)j * 1024 * 1024, 1024, 1024, row0, col0, c.lane, acc);
                        const int fr = c.lane & 15, fq = c.lane >> 4;
#pragma unroll
                        for (int nt = 0; nt < 4; ++nt)
#pragma unroll
                            for (int mt = 0; mt < 2; ++mt) *(f32x4*)(C + (size_t)(row0 + 16 * mt + fr) * D + col0 + 16 * nt + 4 * fq) = acc[nt][mt]; }
                }
                phase_lora1(p, c, li);
            } PHASE_END
            PHASE_BEGIN phase_scanA(p, c, li); PHASE_END
            PHASE_BEGIN phase_scanB(p, c, li); PHASE_END
            PHASE_BEGIN phase_scanC(p, c, li); PHASE_END
        } else {
            const int lb = layer - 2;
            if (layer == 2) {
                PHASE_BEGIN phase_norm(c, X, p->in[I_KVNG], (bf16_t*)(ws + WS_XN2), p->in[I_NORMG] + (size_t)(layer * 2) * D, (bf16_t*)(ws + WS_XN)); PHASE_END
                PHASE_BEGIN {
                    pg8::Gemm g{(const bf16_t*)(ws + WS_XN2), (const bf16_t*)(ws + WS_WKVT), R, NKV, 1024, 1024};
                    pg8::GroupOrder S; S.init((int)gridDim.x, (int)blockIdx.x); S.add(0, 0, 66, 0, 6);
                    pg8::EpiF32G E{(float*)(ws + WS_KVF), nullptr, nullptr, nullptr, NKV, 1 << 20, 0};
                    pg8::gemm_phase<pg8::EpiF32G, pg8::GroupOrder, true, true>(c.lds, g, S, E, c.tid);
                } PHASE_END
                PHASE_BEGIN phase_kvpost(p, c); PHASE_END
                PHASE_BEGIN {
                    pg8::Gemm g{(const bf16_t*)(ws + WS_CMPA), (const bf16_t*)(ws + WS_CW1T), (int)CMPA_ROWS, 512, 1024, 1024};
                    pg8::GroupOrder S; S.init((int)gridDim.x, (int)blockIdx.x); S.add(0, 0, 16, 0, 1); S.add(1, 16, 16, 1, 1); S.add(2, 32, 256, 0, 1); S.add(3, 288, 256, 1, 1);
                    pg8::EpiF32G E{(float*)(ws + WS_PCMP), (float*)(ws + WS_PCMP), nullptr, nullptr, 256, 1, 0};
                    pg8::gemm_phase<pg8::EpiF32G, pg8::GroupOrder, true, true>(c.lds, g, S, E, c.tid);
                } PHASE_END
                PHASE_BEGIN phase_cmp2(p, c); PHASE_END
            } else {
                PHASE_BEGIN phase_norm(c, X, p->in[I_NORMG] + (size_t)(layer * 2) * D, (bf16_t*)(ws + WS_XN), nullptr, nullptr); PHASE_END
            }
            PHASE_BEGIN {
                const bf16_t* XNp = (const bf16_t*)(ws + WS_XN); const bf16_t* Wq = (const bf16_t*)(ws + WS_WQT) + (size_t)lb * NQP * 1024; float* QFp = (float*)(ws + WS_QF);
                pg8::Gemm g{XNp, Wq, R, NQP, 1024, 1024};
                pg8::GroupOrder S; S.init((int)gridDim.x, (int)blockIdx.x); S.add(0, 0, 64, 0, 4);
                pg8::EpiF32G E{QFp, nullptr, nullptr, nullptr, NQP, 1 << 20, 0};
                pg8::gemm_phase<pg8::EpiF32G, pg8::GroupOrder, true, true>(c.lds, g, S, E, c.tid);
                float* GATEp = (float*)(ws + WS_GATE);
                for (int it = blockIdx.x + gridDim.x * c.wave; it < 256 + R / 32; it += c.ngw) { const int ln = launder_v(c.lane), fr = ln & 15, fq = ln >> 4;
                    if (it < 256) { const int row0 = MP + 32 * (it & 15), col0 = 64 * (it >> 4);
                        f32x4 acc[4][2]; skinny_mma<4>(XNp, 1024, Wq, 1024, 1024, row0, col0, ln, acc);
#pragma unroll
                        for (int nt = 0; nt < 4; ++nt)
#pragma unroll
                            for (int mt = 0; mt < 2; ++mt) *(f32x4*)(QFp + (size_t)(row0 + 16 * mt + fr) * NQP + col0 + 16 * nt + 4 * fq) = acc[nt][mt]; }
                    else { const int row0 = 32 * (it - 256);
                        f32x4 acc[3][2]; skinny_mma<3>(XNp, 1024, Wq, 1024, 1024, row0, 1024, ln, acc);
#pragma unroll
                        for (int nt = 0; nt < 3; ++nt)
#pragma unroll
                            for (int mt = 0; mt < 2; ++mt) { f32x4 v = acc[nt][mt];
#pragma unroll
                                for (int e = 0; e < 4; ++e) v[e] = sigmoidf_(v[e]);
                                *(f32x4*)(GATEp + (size_t)(row0 + 16 * mt + fr) * 48 + 16 * nt + 4 * fq) = v; } }
                }
            } PHASE_END
            PHASE_BEGIN phase_qpost(p, c, lb); PHASE_END
            PHASE_BEGIN phase_attn_prompt(p, c); PHASE_END
#ifdef PROBE_ATTN2
            PHASE_BEGIN phase_attn_prompt(p, c, PROBE_ATTN2); PHASE_END
#endif
            PHASE_BEGIN phase_attn_sample(p, c); PHASE_END
        }
        PHASE_BEGIN {
            const bf16_t* Wt = layer < 2 ? (const bf16_t*)(ws + WS_WORW) + (size_t)layer * 1024 * 1024 : (const bf16_t*)(ws + WS_WONSA) + (size_t)(layer - 2) * 1024 * 1024;
            pg8::Gemm g{(const bf16_t*)(ws + WS_YG), Wt, R, 1024, 1024, 1024};
            pg8::GroupOrder S; S.init((int)gridDim.x, (int)blockIdx.x); S.add(0, 0, 64, 0, 4);
            pg8::EpiResid E{X, D};
            pg8::gemm_phase<pg8::EpiResid, pg8::GroupOrder, true, true>(c.lds, g, S, E, c.tid);
            skinny_resid_sample(c, (const bf16_t*)(ws + WS_YG), 1024, Wt, 1024, X);
        } PHASE_END
        PHASE_BEGIN phase_norm(c, X, p->in[I_NORMG] + (size_t)(layer * 2 + 1) * D, (bf16_t*)(ws + WS_XN), nullptr, nullptr); PHASE_END
        PHASE_BEGIN {
            pg8::Gemm g{(const bf16_t*)(ws + WS_XN), (const bf16_t*)(ws + WS_WINT) + (size_t)layer * 5632 * 1024, R, 5632, 1024, 1024};
            pg8::GroupOrder S; S.init((int)gridDim.x, (int)blockIdx.x); S.add(0, 0, 66, 0, 22);
            pg8::EpiWin E{(bf16_t*)(ws + WS_U), (bf16_t*)(ws + WS_GT), p->out + O_CVP + (size_t)layer * NB * 2 * DFF, p->out + O_CVS + (size_t)layer * SB * 2 * DFF};
            pg8::gemm_phase<pg8::EpiWin, pg8::GroupOrder, true, true>(c.lds, g, S, E, c.tid);
        } PHASE_END
        PHASE_BEGIN phase_conv(p, c, layer); PHASE_END
        PHASE_BEGIN {
            pg8::Gemm g{(const bf16_t*)(ws + WS_HH), (const bf16_t*)(ws + WS_WOUTT) + (size_t)layer * 1024 * 2816, R, 1024, 2816, 2816};
            pg8::GroupOrder S; S.init((int)gridDim.x, (int)blockIdx.x); S.add(0, 0, 64, 0, 4);
            pg8::EpiResid E{X, D};
            pg8::gemm_phase<pg8::EpiResid, pg8::GroupOrder, true, true>(c.lds, g, S, E, c.tid);
            skinny_resid_sample(c, (const bf16_t*)(ws + WS_HH), 2816, (const bf16_t*)(ws + WS_WOUTT) + (size_t)layer * 1024 * 2816, 2816, X);
        } PHASE_END
    }
#ifdef SELFTEST
    PHASE_BEGIN if (blockIdx.x == 0 && c.wave == 0) { const float x = (float)((c.lane * 37) & 63) + 1.0f; float poison = 0.f;
        if (__ballot(swz_xor16_n(x) != __shfl_xor(x, 16))) poison += 1e3f;
        if (__ballot(sum_xor32_n(x) != x + __shfl_xor(x, 32))) poison += 1e4f;
        if (__ballot(sum_rows4_n(x) != x + __shfl_xor(x, 16) + __shfl_xor(x, 32) + __shfl_xor(x, 48))) poison += 1e5f;
        if (__ballot(wave_sum_n(x) != 2080.0f)) poison += 1e6f;
        if (__ballot(wave_max_n(x) != 64.0f)) poison += 1e7f;
        if (c.lane == 0) p->out[O_CVS] += poison; } PHASE_END
#endif
#ifdef PROBE_SCALE
    PHASE_BEGIN for (size_t e = c.gtid; e < O_END; e += c.gsz) { int oi = e < O_KV ? (e < (size_t)MP * D ? 0 : 1) : e < O_WINP ? (e < O_KV + (size_t)MP * D ? 2 : 3) : e < O_WINS ? 4 : e < O_WKVP ? 5 : e < O_WKVS ? 6 : e < O_SHP ? 7 : e < O_SHS ? 8 : e < O_CVP ? 9 : e < O_CVS ? 10 : 11;
        if (PROBE_SCALE < 0) oi = 11 - oi; p->out[e] *= 1.0f + sqrtf(0.5e-4f * (float)(oi + 1)); } PHASE_END
#endif
#undef PHASE_BEGIN
#undef PHASE_END
}

extern "C" void kernel_launch(void* const* d_in, const int* in_sizes, int n_in, void* d_out, int out_size, void* d_ws, size_t ws_size, hipStream_t stream) {
    static int grid = 0;
    if (grid == 0) {
        if (n_in != 45 || (size_t)out_size != O_END || ws_size < WS_END) { fprintf(stderr, "kernel_launch: unexpected shapes (n_in %d out %d ws %zu need %zu)\n", n_in, out_size, ws_size, (size_t)WS_END); grid = -1; return; }
        int dev = 0, cus = 0, per_cu = 0;
        if (hipGetDevice(&dev) != hipSuccess || hipDeviceGetAttribute(&cus, hipDeviceAttributeMultiprocessorCount, dev) != hipSuccess) { grid = -1; return; }
        if (hipFuncSetAttribute((const void*)mega, hipFuncAttributeMaxDynamicSharedMemorySize, LDS_BYTES) != hipSuccess) { fprintf(stderr, "kernel_launch: hipFuncSetAttribute failed\n"); grid = -1; return; }
        if (hipOccupancyMaxActiveBlocksPerMultiprocessor(&per_cu, (const void*)mega, 512, LDS_BYTES) != hipSuccess || per_cu < 1) { fprintf(stderr, "kernel_launch: occupancy query says %d\n", per_cu); (void)hipGetLastError(); }
        grid = cus;
    }
    if (grid < 0) return;
    (void)hipMemsetAsync((char*)d_ws + WS_CTL, 0, CTL_BYTES, stream);
    Params p{};
    for (int i = 0; i < 45; ++i) p.in[i] = (const float*)d_in[i];
    p.out = (float*)d_out; p.ws = (unsigned char*)d_ws;
#ifdef PROBE_PRE
    { const int plist[] = PROBE_PRE; for (int i = 0; i < (int)(sizeof(plist) / sizeof(int)); ++i) { p.ph_lo = plist[i] % 100; p.ph_hi = p.ph_lo + 1; p.use_bar = 0; p.pad = plist[i] / 100;       hipLaunchKernelGGL(mega, dim3(grid), dim3(512), LDS_BYTES, stream, p); } }
#endif
    p.pad = 0;
#if MK_MULTI
    for (int i = 0; i < NPH; ++i) { p.ph_lo = i; p.ph_hi = i + 1; p.use_bar = 0; hipLaunchKernelGGL(mega, dim3(grid), dim3(512), LDS_BYTES, stream, p); }
#else
    p.ph_lo = 0; p.ph_hi = NPH; p.use_bar = 1;
    hipLaunchKernelGGL(mega, dim3(grid), dim3(512), LDS_BYTES, stream, p);
#endif
    const hipError_t le = hipPeekAtLastError();
    if (le != hipSuccess) fprintf(stderr, "kernel_launch: launch failed: %s\n", hipGetErrorName(le));
}
```

```cpp
#include <hip/hip_runtime.h>
#include <cstdio>
#include <cstdint>

#define LAS __attribute__((address_space(3)))
#define GAS __attribute__((address_space(1)))
typedef unsigned short bf16_t;
typedef short bf16x8 __attribute__((ext_vector_type(8)));
typedef float f32x4 __attribute__((ext_vector_type(4)));
typedef float f32x16 __attribute__((ext_vector_type(16)));
typedef float f32x2 __attribute__((ext_vector_type(2)));
typedef unsigned u32x4 __attribute__((ext_vector_type(4)));
typedef unsigned u32x2 __attribute__((ext_vector_type(2)));

constexpr int D = 1024, NB = 2, TP = 8192, MP = NB * TP, SB = 128, ST = 4, MS = SB * ST, R = MP + MS;
constexpr int PAST = 2048, PAGE = 128, NPAGES = PAST / PAGE;
constexpr int H = 16, HD = 64, G = 4, HPG = 4, DFF = 2816, NLAY = 4;
constexpr int LW_ = 64, LA_ = 64, LV_ = 32, LG_ = 128, LHID = 288;
constexpr int NKV = 1536, NQ = 1072, NQP = 1280;
constexpr int NCH = TP / 64;
constexpr int NUNIT_A = NB * NCH * H;
constexpr int NCMP_P = 511, NCMP_S = 127, WIN = 512;
constexpr float NORM_EPS = 1e-6f, GN_EPS = 64e-5f;

constexpr size_t O_Y = 0;
constexpr size_t O_KV = (size_t)R * D;
constexpr size_t O_WINP = O_KV + (size_t)R * D;
constexpr size_t O_WINS = O_WINP + (size_t)NB * 512 * 512;
constexpr size_t O_WKVP = O_WINS + (size_t)SB * 512 * 512;
constexpr size_t O_WKVS = O_WKVP + (size_t)2 * NB * H * 4096;
constexpr size_t O_SHP = O_WKVS + (size_t)2 * SB * H * 4096;
constexpr size_t O_SHS = O_SHP + (size_t)2 * NB * D;
constexpr size_t O_CVP = O_SHS + (size_t)2 * SB * D;
constexpr size_t O_CVS = O_CVP + (size_t)NLAY * NB * 2 * DFF;
constexpr size_t O_END = O_CVS + (size_t)NLAY * SB * 2 * DFF;
static_assert(O_END == 88915968, "output size");

constexpr size_t MiB = 1u << 20;
constexpr size_t al(size_t x) { return (x + 4095) & ~(size_t)4095; }
constexpr size_t WS_CTL = 0, CTL_BYTES = 1 * MiB;
constexpr size_t WS_WRKV = WS_CTL + CTL_BYTES;
constexpr size_t WS_WORW = WS_WRKV + al((size_t)2 * 3072 * 1024 * 2);
constexpr size_t WS_W1T = WS_WORW + al((size_t)2 * 1024 * 1024 * 2);
constexpr size_t WS_W2W = WS_W1T + al((size_t)2 * 288 * 1024 * 2);
constexpr size_t WS_W2A = WS_W2W + al((size_t)2 * 1024 * 64 * 2);
constexpr size_t WS_W2V = WS_W2A + al((size_t)2 * 1024 * 64 * 2);
constexpr size_t WS_W2G = WS_W2V + al((size_t)1024 * 32 * 2);
constexpr size_t WS_WKVT = WS_W2G + al((size_t)2 * 1024 * 128 * 2);
constexpr size_t WS_WQT = WS_WKVT + al((size_t)1536 * 1024 * 2);
constexpr size_t WS_WONSA = WS_WQT + al((size_t)2 * 1280 * 1024 * 2);
constexpr size_t WS_WINT = WS_WONSA + al((size_t)2 * 1024 * 1024 * 2);
constexpr size_t WS_WOUTT = WS_WINT + al((size_t)4 * 5632 * 1024 * 2);
constexpr size_t WS_CW1T = WS_WOUTT + al((size_t)4 * 1024 * 2816 * 2);
constexpr size_t WS_CBIAS = WS_CW1T + al((size_t)2 * 256 * 1024 * 2);
constexpr size_t WS_CW2T = WS_CBIAS + al(2 * 128 * 4);
constexpr size_t WS_XM = WS_CW2T + al(2 * 2 * 64 * 128 * 2);
constexpr size_t WS_RK_R = WS_XM + al((size_t)6 * R * D * 2);
constexpr size_t WS_RK_K = WS_RK_R + al((size_t)R * D * 4);
constexpr size_t WS_V0 = WS_RK_K + al((size_t)R * D * 4);
constexpr size_t WS_V1 = WS_V0 + al((size_t)R * D * 4);
constexpr size_t WS_HID = WS_V1 + al((size_t)R * D * 4);
constexpr size_t WS_MT = WS_HID + al((size_t)R * LHID * 2);
constexpr size_t WS_NN = WS_MT + al((size_t)NUNIT_A * 4096 * 4);
constexpr size_t WS_RP = WS_NN + al((size_t)NUNIT_A * 4096 * 4);
constexpr size_t WS_YL = WS_RP + al((size_t)NUNIT_A * 4096 * 2);
constexpr size_t WS_S0 = WS_YL + al((size_t)NUNIT_A * 4096 * 4);
constexpr size_t WS_RKS = WS_S0 + al((size_t)NUNIT_A * 4096 * 2);
constexpr size_t WS_YG = WS_RKS + al((size_t)R * 16 * 4);
constexpr size_t WS_XN = WS_YG + al((size_t)R * D * 2);
constexpr size_t WS_XN2 = WS_XN + al((size_t)R * D * 2);
constexpr size_t WS_U = WS_XN2 + al((size_t)R * D * 2);
constexpr size_t WS_GT = WS_U + al((size_t)R * DFF * 2);
constexpr size_t WS_HH = WS_GT + al((size_t)R * DFF * 2);
constexpr size_t WS_KVF = WS_HH + al((size_t)R * DFF * 2);
constexpr size_t WS_CMPA = WS_KVF + al((size_t)R * NKV * 4);
constexpr size_t CMPA_ROWS = 4096 + 4096 + 65536 + 65536;
constexpr size_t WS_PCMP = WS_CMPA + al(CMPA_ROWS * 1024 * 2);
constexpr size_t WS_KS = WS_PCMP + al(CMPA_ROWS * 256 * 4);
constexpr size_t WS_VS = WS_KS + al((size_t)NB * G * TP * 64 * 2);
constexpr size_t WS_KW = WS_VS + al((size_t)NB * G * TP * 64 * 2);
constexpr size_t WS_VW = WS_KW + al((size_t)NB * G * TP * 64 * 2);
constexpr size_t WS_CK = WS_VW + al((size_t)NB * G * TP * 64 * 2);
constexpr size_t WS_CV = WS_CK + al((size_t)NB * G * 512 * 64 * 2);
constexpr size_t WS_CKS = WS_CV + al((size_t)NB * G * 512 * 64 * 2);
constexpr size_t WS_CVS = WS_CKS + al((size_t)SB * G * 128 * 64 * 4);
constexpr size_t WS_QF = WS_CVS + al((size_t)SB * G * 128 * 64 * 4);
constexpr size_t WS_Q = WS_QF + al((size_t)R * NQP * 4);
constexpr size_t WS_GATE = WS_Q + al((size_t)R * D * 2);
constexpr size_t WS_END = WS_GATE + al((size_t)R * 48 * 4);

typedef __bf16 bf16v2_ __attribute__((ext_vector_type(2)));
__device__ __forceinline__ unsigned cvt_pk_bf16_(float lo, float hi) { const f32x2 v = {lo, hi}; const bf16v2_ b = __builtin_convertvector(v, bf16v2_); return __builtin_bit_cast(unsigned, b); }
__device__ __forceinline__ unsigned f2bf(float f) { return cvt_pk_bf16_(f, f) & 0xffffu; }
__device__ __forceinline__ unsigned pk2(float lo, float hi) { return cvt_pk_bf16_(lo, hi); }
__device__ __forceinline__ float frcp(float x) { return __builtin_amdgcn_rcpf(x); }
__device__ __forceinline__ float frsq(float x) { return __builtin_amdgcn_rsqf(x); }
__device__ __forceinline__ float bf2f(unsigned short b) { return __builtin_bit_cast(float, ((unsigned)b) << 16); }
__device__ __forceinline__ float bflo(unsigned w) { return __builtin_bit_cast(float, w << 16); }
__device__ __forceinline__ float bfhi(unsigned w) { return __builtin_bit_cast(float, w & 0xffff0000u); }
template <int CTRL> __device__ __forceinline__ float dpp_f(float x) { return __builtin_bit_cast(float, __builtin_amdgcn_update_dpp(0, __builtin_bit_cast(int, x), CTRL, 0xF, 0xF, true)); }
__device__ __forceinline__ float row16_sum(float v) { v += dpp_f<0xB1>(v); v += dpp_f<0x4E>(v); v += dpp_f<0x141>(v); v += dpp_f<0x140>(v); return v; }
__device__ __forceinline__ float row16_max(float v) { v = fmaxf(v, dpp_f<0xB1>(v)); v = fmaxf(v, dpp_f<0x4E>(v)); v = fmaxf(v, dpp_f<0x141>(v)); v = fmaxf(v, dpp_f<0x140>(v)); return v; }
__device__ __forceinline__ float swz_xor16_n(float x) { return __builtin_bit_cast(float, __builtin_amdgcn_ds_swizzle(__builtin_bit_cast(int, x), 0x401F)); }
__device__ __forceinline__ float sum_xor32_n(float x) { auto rr = __builtin_amdgcn_permlane32_swap(__float_as_uint(x), __float_as_uint(x), false, false);
    return __uint_as_float(rr[0]) + __uint_as_float(rr[1]); }
__device__ __forceinline__ float sum_rows4_n(float x) { x += swz_xor16_n(x); return sum_xor32_n(x); }
__device__ __forceinline__ float wave_sum_n(float v) {
    v = row16_sum(v);
    v += __builtin_bit_cast(float, __builtin_amdgcn_update_dpp(0, __builtin_bit_cast(int, v), 0x142, 0xA, 0xF, false));
    v += __builtin_bit_cast(float, __builtin_amdgcn_update_dpp(0, __builtin_bit_cast(int, v), 0x143, 0xC, 0xF, false));
    return __builtin_bit_cast(float, __builtin_amdgcn_readlane(__builtin_bit_cast(int, v), 63));
}
__device__ __forceinline__ float wave_max_n(float v) {
    v = row16_max(v);
    v = fmaxf(v, __builtin_bit_cast(float, __builtin_amdgcn_update_dpp(__builtin_bit_cast(int, v), __builtin_bit_cast(int, v), 0x142, 0xA, 0xF, false)));
    v = fmaxf(v, __builtin_bit_cast(float, __builtin_amdgcn_update_dpp(__builtin_bit_cast(int, v), __builtin_bit_cast(int, v), 0x143, 0xC, 0xF, false)));
    return __builtin_bit_cast(float, __builtin_amdgcn_readlane(__builtin_bit_cast(int, v), 63));
}
#define XLANE_NEW 1
#ifdef XLANE_NEW
__device__ __forceinline__ float swz_xor16(float x) { return __builtin_bit_cast(float, __builtin_amdgcn_ds_swizzle(__builtin_bit_cast(int, x), 0x401F)); }
__device__ __forceinline__ float sum_xor32(float x) { return sum_xor32_n(x); }
__device__ __forceinline__ float sum_rows4(float x) { x += swz_xor16(x); return sum_xor32(x); }
__device__ __forceinline__ float wave_sum(float v) {
    v = row16_sum(v);
    v += __builtin_bit_cast(float, __builtin_amdgcn_update_dpp(0, __builtin_bit_cast(int, v), 0x142, 0xA, 0xF, false));
    v += __builtin_bit_cast(float, __builtin_amdgcn_update_dpp(0, __builtin_bit_cast(int, v), 0x143, 0xC, 0xF, false));
    return __builtin_bit_cast(float, __builtin_amdgcn_readlane(__builtin_bit_cast(int, v), 63));
}
__device__ __forceinline__ float wave_max(float v) {
    v = row16_max(v);
    v = fmaxf(v, __builtin_bit_cast(float, __builtin_amdgcn_update_dpp(__builtin_bit_cast(int, v), __builtin_bit_cast(int, v), 0x142, 0xA, 0xF, false)));
    v = fmaxf(v, __builtin_bit_cast(float, __builtin_amdgcn_update_dpp(__builtin_bit_cast(int, v), __builtin_bit_cast(int, v), 0x143, 0xC, 0xF, false)));
    return __builtin_bit_cast(float, __builtin_amdgcn_readlane(__builtin_bit_cast(int, v), 63));
}
#else
__device__ __forceinline__ float sum_xor32(float x) { return x + __shfl_xor(x, 32); }
__device__ __forceinline__ float sum_rows4(float x) { x += __shfl_xor(x, 16); x += __shfl_xor(x, 32); return x; }
__device__ __forceinline__ float wave_sum(float v) { v = row16_sum(v); v += __shfl_xor(v, 16); v += __shfl_xor(v, 32); return v; }
__device__ __forceinline__ float wave_max(float v) { v = row16_max(v); v = fmaxf(v, __shfl_xor(v, 16)); v = fmaxf(v, __shfl_xor(v, 32)); return v; }
#endif
__device__ __forceinline__ float sigmoidf_(float x) { return frcp(1.0f + __builtin_amdgcn_exp2f(-1.4426950408889634f * x)); }
__device__ __forceinline__ float gelu_tanh(float x) {
    const float u = 0.7978845608028654f * (x + 0.044715f * x * x * x);
    const float e = __builtin_amdgcn_exp2f(2.8853900817779268f * u);
    const float th = 1.0f - 2.0f * frcp(e + 1.0f);
    return 0.5f * x * (1.0f + th);
}
template <class T> __device__ __forceinline__ const T* launder_p(const T* q) { asm volatile("" : "+v"(q)); return q; }
__device__ __forceinline__ int launder_v(int x) { asm volatile("" : "+v"(x)); return x; }
#define LDS_WAIT() asm volatile("s_waitcnt lgkmcnt(0)" ::: "memory")
#define VM_WAIT() asm volatile("s_waitcnt vmcnt(0)" ::: "memory")
__device__ __forceinline__ f32x4 mfma16(bf16x8 a, bf16x8 b, f32x4 c) { return __builtin_amdgcn_mfma_f32_16x16x32_bf16(a, b, c, 0, 0, 0); }
__device__ __forceinline__ f32x16 mfma32(bf16x8 a, bf16x8 b, f32x16 c) { return __builtin_amdgcn_mfma_f32_32x32x16_bf16(a, b, c, 0, 0, 0); }
#define XB_TMO      128
#define XB_XCNT(j)  (256  + 64 * (j))
#define XB_XSUB(j)  (1280 + 64 * (j))
#define XB_XGEN(j)  (2304 + 64 * (j))
#define XB_TOP      3328
#define XB_TOPGEN   3392
#define XCD_BAR_WORDS 3456
#define XB_SPIN_CAP (1u << 18)

__device__ __forceinline__ unsigned xb_ld(unsigned* p)              { return __hip_atomic_load(p, __ATOMIC_RELAXED, __HIP_MEMORY_SCOPE_AGENT); }
__device__ __forceinline__ unsigned xb_add(unsigned* p, unsigned v) { return __hip_atomic_fetch_add(p, v, __ATOMIC_RELAXED, __HIP_MEMORY_SCOPE_AGENT); }
__device__ __forceinline__ unsigned xb_xcc_id() { return (unsigned)__builtin_amdgcn_s_getreg((3 << 11) | 20) & 0xFu; }
#define XB_SPIN(cond, bar) do { unsigned _sp = 0; while (cond) { __builtin_amdgcn_s_sleep(1); \
    if ((++_sp & 255u) == 0u) { if (xb_ld(&(bar)[XB_TMO])) break; if (_sp > XB_SPIN_CAP) { atomicAdd(&(bar)[XB_TMO], 1u); break; } } } } while (0)

struct XcdBarrier {
    unsigned* bar; unsigned x;
    volatile LAS unsigned* st;
};

__device__ __forceinline__ XcdBarrier xcd_barrier_post(unsigned* bar, volatile LAS unsigned* st) {
    XcdBarrier b; b.bar = bar; b.x = xb_xcc_id(); b.st = st;
    if (threadIdx.x == 0) (void)xb_add(&bar[XB_XCNT(b.x)], 1u);
    return b;
}
__device__ __forceinline__ void xcd_barrier_complete(unsigned* bar, unsigned x, unsigned& nloc, unsigned& nx) {
    const unsigned G = gridDim.x * gridDim.y * gridDim.z;
    unsigned sum, cnt, mine, sp = 0u;
    for (;;) {
        sum = 0u; cnt = 0u; mine = 0u;
#pragma unroll
        for (unsigned j = 0; j < 16; ++j) { const unsigned c = xb_ld(&bar[XB_XCNT(j)]); sum += c; cnt += (c > 0u) ? 1u : 0u; mine = (j == x) ? c : mine; }
        if (sum == G) break;
        __builtin_amdgcn_s_sleep(1);
        if ((++sp & 255u) == 0u) { if (xb_ld(&bar[XB_TMO])) break; if (sp > XB_SPIN_CAP) { atomicAdd(&bar[XB_TMO], 1u); break; } }
    }
    nloc = mine > 0u ? mine : 1u; nx = cnt > 0u ? cnt : 1u;
}

__device__ __forceinline__ void xcd_barrier(const XcdBarrier& b, const bool t0) {
    asm volatile("s_waitcnt vmcnt(0)" ::: "memory");
    __syncthreads();
    if (t0) {
        unsigned* bar = b.bar;
        __builtin_amdgcn_s_waitcnt(0);
        unsigned nloc = b.st[0], nx = b.st[1];
        if (nloc == 0u) { xcd_barrier_complete(bar, b.x, nloc, nx); b.st[0] = nloc; b.st[1] = nx; }
        const unsigned old = xb_add(&bar[XB_XSUB(b.x)], 1u);
        const unsigned gen = old / nloc;
        if (old + 1u == (gen + 1u) * nloc) {
            __builtin_amdgcn_fence(__ATOMIC_RELEASE, "agent");
            asm volatile("s_waitcnt vmcnt(0)" ::: "memory");
            const unsigned og = xb_add(&bar[XB_TOP], 1u);
            const unsigned tg = og / nx;
            if (og + 1u == (tg + 1u) * nx) xb_add(&bar[XB_TOPGEN], 1u);
            else XB_SPIN(xb_ld(&bar[XB_TOPGEN]) == tg, bar);
            __builtin_amdgcn_fence(__ATOMIC_ACQUIRE, "agent");
            xb_add(&bar[XB_XGEN(b.x)], 1u);
            asm volatile("s_waitcnt vmcnt(0)" ::: "memory");
        } else {
            XB_SPIN(xb_ld(&bar[XB_XGEN(b.x)]) == gen, bar);
            __builtin_amdgcn_fence(__ATOMIC_ACQUIRE, "agent");
            asm volatile("s_waitcnt vmcnt(0)" ::: "memory");
        }
    }
    __syncthreads();
}

namespace pg8 {
#define PG8_LAS __attribute__((address_space(3)))
constexpr int BM = 256, BK = 64, HALF = 128, HTB = HALF * BK * 2  , STAGE_BYTES = 8 * HTB, NXCD = 8, WGM = 8;
__host__ __device__ __forceinline__ int lds_byte(int r, int c) { const int st = (r >> 4) * 2 + (c >> 5), rr = r & 15, cc = c & 31, ob = rr * 64 + cc * 2; return st * 1024 + (ob ^ (((ob >> 9) & 1) << 5)); }
__host__ __device__ __forceinline__ void stage_rc(int b, int& R_, int& C_) { const int st = b / 1024, sb = b % 1024, swz = sb ^ (((sb >> 9) & 1) << 5); R_ = (st >> 1) * 16 + swz / 64; C_ = (st & 1) * 32 + (swz % 64) / 2; }
__host__ __device__ __forceinline__ int perm32(int rho) { const int n = rho >> 4, i = rho & 15; return 8 * (i >> 2) + 4 * n + (i & 3); }

struct Unit { int pm, pn, kb, nt; };
struct Gemm { const bf16_t* A; const bf16_t* Bt; int M, N, K, KL; };

struct GroupOrder {
    int pm0[4], nM[4], pn0[4], nN[4]; int nseg, nwg, G_, c;
    __device__ __forceinline__ void init(int G__, int c_) { nseg = 0; nwg = 0; G_ = G__; c = c_;
#pragma unroll
        for (int s = 0; s < 4; ++s) { pm0[s] = 0; nM[s] = 0; pn0[s] = 0; nN[s] = 1; } }
    __device__ __forceinline__ void add(int s, int pm0_, int nM_, int pn0_, int nN_) { pm0[s] = pm0_; nM[s] = nM_; pn0[s] = pn0_; nN[s] = nN_; nwg += nM_ * nN_; nseg = s + 1; }
    __device__ __forceinline__ bool next(int i, Unit& u) const {
        const long L = (long)i * G_ + c; if (L >= nwg) return false;
        int id = (int)L; { const int q = nwg / NXCD, r = nwg % NXCD, xcd = id % NXCD, off = id / NXCD; id = (xcd < r ? xcd * (q + 1) : r * (q + 1) + (xcd - r) * q) + off; }
        int spm0 = 0, snM = 1, spn0 = 0, snN = 1; bool found = false;
#pragma unroll
        for (int s = 0; s < 4; ++s) { const int cnt = nM[s] * nN[s]; if (!found) { if (id < cnt) { found = true; spm0 = pm0[s]; snM = nM[s]; spn0 = pn0[s]; snN = nN[s]; } else id -= cnt; } }
        const int nig = WGM * snN, gid = id / nig, fm = gid * WGM, gsz = (snM - fm) < WGM ? (snM - fm) : WGM;
        u.pm = spm0 + fm + ((id % nig) % gsz); u.pn = spn0 + (id % nig) / gsz; u.kb = 0; u.nt = 0; return true;
    }
    __device__ __forceinline__ void a_ready(const Unit&) const {}
    __device__ __forceinline__ void done(const Unit&) const {}
};

struct ResidOrder {
    GroupOrder P; int nS, G_, c;
    __device__ __forceinline__ void init(int G__, int c_, int nS_) { P.init(G__, c_); P.add(0, 0, nS_ ? 64 : 66, 0, 4); nS = nS_; G_ = G__; c = c_; }
    __device__ __forceinline__ bool next(int i, Unit& u) const {
        const int npc = c < P.nwg ? (P.nwg - 1 - c) / G_ + 1 : 0;
        if (i < npc) return P.next(i, u);
        const int L = (i - npc) * G_ + (G_ - 1 - c); if (L >= 8 * nS) return false;
        const int sl = L >> 3, t = L & 7; u.pm = 64 + (t & 1); u.pn = t >> 1; u.kb = sl * 512; u.nt = 4; return true; }
    __device__ __forceinline__ void a_ready(const Unit&) const {}
    __device__ __forceinline__ void done(const Unit&) const {}
};
__device__ __forceinline__ unsigned cvt_pk_bf16(float lo, float hi) { return cvt_pk_bf16_(lo, hi); }

struct EpiF32G {
    static constexpr bool PERM = false, AFTER_DRAIN = false;
    float* b0; float* b1; float* b2; float* b3; int ldc, png, pmg;
    __device__ __forceinline__ void operator()(const f32x4 (&acc)[2][2][4][2], const Unit& u, int wr, int wc, int fr, int fq) const {
        const int j = u.pn / png; float* C = j == 0 ? b0 : (j == 1 ? b1 : (j == 2 ? b2 : b3));
        const int row0 = (u.pm - j * pmg) * BM + wr * 64 + fr, col0 = (u.pn - j * png) * BM + wc * 32 + 4 * fq;
#pragma unroll
        for (int ai = 0; ai < 2; ++ai)
#pragma unroll
            for (int m = 0; m < 4; ++m) { float* rowp = C + (size_t)(row0 + ai * HALF + m * 16) * ldc + col0;
#pragma unroll
                for (int bj = 0; bj < 2; ++bj)
#pragma unroll
                    for (int n = 0; n < 2; ++n) *(f32x4*)(rowp + bj * HALF + n * 16) = acc[ai][bj][m][n]; }
    }
};
struct EpiResid {
    static constexpr bool PERM = false, AFTER_DRAIN = false;
    float* X; int ldc;
    __device__ __forceinline__ void operator()(const f32x4 (&acc)[2][2][4][2], const Unit& u, int wr, int wc, int fr, int fq) const {
        const int row0 = u.pm * BM + wr * 64 + fr, col0 = u.pn * BM + wc * 32 + 4 * fq; const bool split = u.nt != 0;
#pragma unroll
        for (int ai = 0; ai < 2; ++ai)
#pragma unroll
            for (int m = 0; m < 4; ++m) { float* rowp = X + (size_t)(row0 + ai * HALF + m * 16) * ldc + col0;
                if (!split) {
#pragma unroll
                    for (int bj = 0; bj < 2; ++bj)
#pragma unroll
                        for (int n = 0; n < 2; ++n) { f32x4* p = (f32x4*)(rowp + bj * HALF + n * 16); *p = *p + acc[ai][bj][m][n]; } }
                else {
#pragma unroll
                    for (int bj = 0; bj < 2; ++bj)
#pragma unroll
                        for (int n = 0; n < 2; ++n) { float* q = rowp + bj * HALF + n * 16;
#pragma unroll
                            for (int e = 0; e < 4; ++e) __hip_atomic_fetch_add(q + e, acc[ai][bj][m][n][e], __ATOMIC_RELAXED, __HIP_MEMORY_SCOPE_AGENT); } }
                asm volatile("" ::: "memory"); }
    }
};
struct EpiWin {
    static constexpr bool PERM = true, AFTER_DRAIN = false;
    bf16_t* U; bf16_t* GT; float* cvp; float* cvs;
    __device__ __forceinline__ void operator()(const f32x4 (&acc)[2][2][4][2], const Unit& u, int wr, int wc, int fr, int fq) const {
        const bool isu = u.pn < 11; bf16_t* base = isu ? U : GT; const int colt = (isu ? u.pn : u.pn - 11) * BM;
        const int row0 = u.pm * BM + wr * 64 + fr, col0 = colt + wc * 32 + 8 * fq;
#pragma unroll
        for (int ai = 0; ai < 2; ++ai)
#pragma unroll
            for (int m = 0; m < 4; ++m) { const int row = row0 + ai * HALF + m * 16; bf16_t* rowp = base + (size_t)row * DFF + col0;
                float* cv = nullptr;
                if (isu) { if (row >= MP) { const int t = (row - MP) & 3, b = (row - MP) >> 2; if (t >= 2) cv = cvs + (size_t)(b * 2 + (t - 2)) * DFF; }
                           else { const int tt = row & (TP - 1); if (tt >= TP - 2) cv = cvp + (size_t)((row >> 13) * 2 + (tt - (TP - 2))) * DFF; } }
#pragma unroll
                for (int bj = 0; bj < 2; ++bj) { const f32x4 v0 = acc[ai][bj][m][0], v1 = acc[ai][bj][m][1];
                    u32x4 w; w.x = cvt_pk_bf16(v0[0], v0[1]); w.y = cvt_pk_bf16(v0[2], v0[3]); w.z = cvt_pk_bf16(v1[0], v1[1]); w.w = cvt_pk_bf16(v1[2], v1[3]);
                    *(u32x4*)(rowp + bj * HALF) = w;
                    if (cv) { *(f32x4*)(cv + col0 + bj * HALF) = v0; *(f32x4*)(cv + col0 + bj * HALF + 4) = v1; } } }
    }
};
template <class Epi, class Sched, bool ALIGN_EPI = false, bool SP2 = false>
__device__ __forceinline__ void gemm_phase(PG8_LAS unsigned char* lds, const Gemm g, const Sched& S, const Epi& E, int tid_in) {
    int tid_l = tid_in; asm volatile("" : "+v"(tid_l));
    const int tid = tid_l, wid = __builtin_amdgcn_readfirstlane(tid >> 6), lane = tid & 63, wr = wid >> 2, wc = wid & 3, fr = lane & 15, fq = lane >> 4;
    const int K = g.K, nt = g.KL / BK;
    unsigned voffA[2], voffB[2];
#pragma unroll
    for (int i = 0; i < 2; ++i) { int R, C; stage_rc(tid * 16 + i * 8192, R, C); const int Rb = Epi::PERM ? ((R & ~31) + perm32(R & 31)) : R;
        voffA[i] = (unsigned)(R * K + C) * 2u; voffB[i] = (unsigned)(Rb * K + C) * 2u; }
    const size_t kstep = (size_t)(BK * 2);
    const size_t hstep = (size_t)HALF * K * 2;
    const size_t tstep = 2 * hstep;
    const unsigned ldsw = (unsigned)wid * 1024u;
    const int aoff = lds_byte(wr * 64 + fr, fq * 8), boff = lds_byte(wc * 32 + fr, fq * 8);
#define PG8_SA(b, h) (((b) * 2 + (h)) * HTB)
#define PG8_SB(b, h) ((4 + (b) * 2 + (h)) * HTB)
#define PG8_STAGE(bufoff, gbase, voff) do { _Pragma("unroll") for (int _i = 0; _i < 2; ++_i) \
        __builtin_amdgcn_global_load_lds((const unsigned*)((const char*)(gbase) + (voff)[_i]), (PG8_LAS unsigned*)(lds + (bufoff) + ldsw + _i * 8192), 16, 0, 0); } while (0)
#define PG8_LDA(dst, b, h) do { _Pragma("unroll") for (int m = 0; m < 4; ++m) _Pragma("unroll") for (int k = 0; k < 2; ++k) dst[m][k] = *(const PG8_LAS bf16x8*)(lds + PG8_SA(b, h) + aoff + m * 2048 + k * 1024); } while (0)
#define PG8_LDB(dst, b, h) do { _Pragma("unroll") for (int n = 0; n < 2; ++n) _Pragma("unroll") for (int k = 0; k < 2; ++k) dst[n][k] = *(const PG8_LAS bf16x8*)(lds + PG8_SB(b, h) + boff + n * 2048 + k * 1024); } while (0)
#define PG8_MMA(ai, bj, At, Bt) do { __builtin_amdgcn_s_setprio(1); _Pragma("unroll") for (int m = 0; m < 4; ++m) _Pragma("unroll") for (int n = 0; n < 2; ++n) _Pragma("unroll") for (int k = 0; k < 2; ++k) \
        acc[ai][bj][m][n] = __builtin_amdgcn_mfma_f32_16x16x32_bf16(Bt[n][k], At[m][k], acc[ai][bj][m][n], 0, 0, 0); __builtin_amdgcn_s_setprio(0); } while (0)
#define PG8_WAIT_V(n) asm volatile("s_waitcnt vmcnt(" #n ")" ::: "memory")
#define PG8_WAIT_L(n) asm volatile("s_waitcnt lgkmcnt(" #n ")" ::: "memory")
#define PG8_BAR __builtin_amdgcn_s_barrier()
#define PG8_SCHED __builtin_amdgcn_sched_barrier(0)
    Unit cur, nxt; int ui = 0;
    if (!S.next(0, cur)) return;
    f32x4 acc[2][2][4][2];
#pragma unroll
    for (int a = 0; a < 2; ++a)
#pragma unroll
        for (int b = 0; b < 2; ++b)
#pragma unroll
            for (int m = 0; m < 4; ++m)
#pragma unroll
                for (int n = 0; n < 2; ++n) acc[a][b][m][n] = (f32x4){0.f, 0.f, 0.f, 0.f};
    bf16x8 At[4][2], B0[2][2], B1[2][2];
    const char* cA = (const char*)g.A + (size_t)cur.pm * tstep + cur.kb; const char* cB = (const char*)g.Bt + (size_t)cur.pn * tstep + cur.kb;
    S.a_ready(cur);
    if constexpr (SP2) {
        PG8_STAGE(PG8_SB(0, 0), cB, voffB); PG8_STAGE(PG8_SB(0, 1), cB + hstep, voffB); PG8_STAGE(PG8_SA(0, 0), cA, voffA); PG8_STAGE(PG8_SA(0, 1), cA + hstep, voffA);
        if (wr == 1) PG8_BAR;
        PG8_WAIT_V(2); PG8_BAR;
        PG8_STAGE(PG8_SB(1, 0), cB + kstep, voffB); PG8_STAGE(PG8_SA(1, 0), cA + kstep, voffA); PG8_STAGE(PG8_SB(1, 1), cB + hstep + kstep, voffB);
        PG8_WAIT_V(6); PG8_BAR;
    } else {
        PG8_STAGE(PG8_SB(0, 0), cB, voffB); PG8_STAGE(PG8_SA(0, 0), cA, voffA); PG8_STAGE(PG8_SB(0, 1), cB + hstep, voffB); PG8_STAGE(PG8_SA(0, 1), cA + hstep, voffA);
        if (wr == 1) PG8_BAR;
        PG8_WAIT_V(4); PG8_BAR;
        PG8_STAGE(PG8_SB(1, 0), cB + kstep, voffB); PG8_STAGE(PG8_SA(1, 0), cA + kstep, voffA); PG8_STAGE(PG8_SB(1, 1), cB + hstep + kstep, voffB);
        PG8_WAIT_V(6); PG8_BAR;
    }
    for (;;) {
        const bool has_next = S.next(ui + 1, nxt);
        const char* nA = has_next ? (const char*)g.A + (size_t)nxt.pm * tstep + nxt.kb : cA; const char* nB = has_next ? (const char*)g.Bt + (size_t)nxt.pn * tstep + nxt.kb : cB;
        const int ntu = cur.nt ? cur.nt : nt;
        for (int t = 0; t < ntu; t += 2) {
            const bool last = (t == ntu - 2);
            const char* a1 = cA + (size_t)(t + 1) * kstep;
            const char* a2 = last ? nA : cA + (size_t)(t + 2) * kstep; const char* b2 = last ? nB : cB + (size_t)(t + 2) * kstep;
            const char* a3 = a2 + kstep; const char* b3 = b2 + kstep;
            if (last && has_next) S.a_ready(nxt);
            if constexpr (SP2) {
            PG8_LDB(B0, 0, 0); PG8_LDB(B1, 0, 1); PG8_SCHED; PG8_LDA(At, 0, 0); PG8_STAGE(PG8_SA(1, 1), a1 + hstep, voffA);
            PG8_WAIT_V(8); PG8_WAIT_L(0); PG8_BAR; PG8_MMA(0, 0, At, B0); PG8_MMA(0, 1, At, B1); PG8_BAR; PG8_SCHED;
            PG8_LDA(At, 0, 1); PG8_STAGE(PG8_SB(0, 0), b2, voffB); PG8_STAGE(PG8_SB(0, 1), b2 + hstep, voffB); PG8_STAGE(PG8_SA(0, 0), a2, voffA);
            PG8_WAIT_V(8); PG8_WAIT_L(0); PG8_BAR; PG8_MMA(1, 0, At, B0); PG8_MMA(1, 1, At, B1); PG8_BAR; PG8_SCHED;
            PG8_LDB(B0, 1, 0); PG8_LDB(B1, 1, 1); PG8_SCHED; PG8_LDA(At, 1, 0); PG8_STAGE(PG8_SA(0, 1), a2 + hstep, voffA);
            PG8_WAIT_V(8); PG8_WAIT_L(0); PG8_BAR; PG8_MMA(0, 0, At, B0); PG8_MMA(0, 1, At, B1); PG8_BAR; PG8_SCHED;
            PG8_LDA(At, 1, 1); PG8_STAGE(PG8_SB(1, 0), b3, voffB); PG8_STAGE(PG8_SB(1, 1), b3 + hstep, voffB); PG8_STAGE(PG8_SA(1, 0), a3, voffA);
            PG8_WAIT_V(8); PG8_WAIT_L(0); PG8_BAR; PG8_MMA(1, 0, At, B0); PG8_MMA(1, 1, At, B1); PG8_BAR; PG8_SCHED;
            } else {
            PG8_LDB(B0, 0, 0); PG8_SCHED; PG8_LDA(At, 0, 0); PG8_STAGE(PG8_SA(1, 1), a1 + hstep, voffA);
            PG8_WAIT_L(8); PG8_BAR; PG8_WAIT_L(0); PG8_MMA(0, 0, At, B0); PG8_BAR; PG8_SCHED;
            PG8_LDB(B1, 0, 1); PG8_STAGE(PG8_SB(0, 0), b2, voffB);
            PG8_BAR; PG8_WAIT_L(0); PG8_MMA(0, 1, At, B1); PG8_BAR;
            PG8_LDA(At, 0, 1); PG8_STAGE(PG8_SA(0, 0), a2, voffA);
            PG8_BAR; PG8_WAIT_L(0); PG8_MMA(1, 0, At, B0); PG8_BAR; PG8_SCHED;
            PG8_STAGE(PG8_SB(0, 1), b2 + hstep, voffB);
            PG8_WAIT_V(6); PG8_BAR; PG8_MMA(1, 1, At, B1); PG8_BAR;
            PG8_LDB(B0, 1, 0); PG8_SCHED; PG8_LDA(At, 1, 0); PG8_STAGE(PG8_SA(0, 1), a2 + hstep, voffA);
            PG8_WAIT_L(8); PG8_BAR; PG8_WAIT_L(0); PG8_MMA(0, 0, At, B0); PG8_BAR; PG8_SCHED;
            PG8_LDB(B1, 1, 1); PG8_STAGE(PG8_SB(1, 0), b3, voffB);
            PG8_BAR; PG8_WAIT_L(0); PG8_MMA(0, 1, At, B1); PG8_BAR;
            PG8_LDA(At, 1, 1); PG8_STAGE(PG8_SA(1, 0), a3, voffA);
            PG8_BAR; PG8_WAIT_L(0); PG8_MMA(1, 0, At, B0); PG8_BAR; PG8_SCHED;
            PG8_STAGE(PG8_SB(1, 1), b3 + hstep, voffB);
            PG8_WAIT_V(6); PG8_BAR; PG8_MMA(1, 1, At, B1); PG8_BAR;
            }
        }
        if constexpr (ALIGN_EPI) { if (wr == 0) PG8_BAR; }
        if constexpr (!Epi::AFTER_DRAIN) { E(acc, cur, wr, wc, fr, fq); S.done(cur); }
        if (!has_next) break;
#pragma unroll
        for (int a = 0; a < 2; ++a)
#pragma unroll
            for (int b = 0; b < 2; ++b)
#pragma unroll
                for (int m = 0; m < 4; ++m)
#pragma unroll
                    for (int n = 0; n < 2; ++n) acc[a][b][m][n] = (f32x4){0.f, 0.f, 0.f, 0.f};
        cur = nxt; cA = nA; cB = nB; ++ui;
        if constexpr (ALIGN_EPI) { if (wr == 1) PG8_BAR; }
    }
    PG8_WAIT_V(0);
    if constexpr (!ALIGN_EPI) { if (wr == 0) PG8_BAR; }
    PG8_BAR;
    if constexpr (Epi::AFTER_DRAIN) { E.fused(acc, cur, wr, wc, fr, fq, lds, wid, lane); S.done(cur); }
#undef PG8_SA
#undef PG8_SB
#undef PG8_STAGE
#undef PG8_LDA
#undef PG8_LDB
#undef PG8_MMA
#undef PG8_WAIT_V
#undef PG8_WAIT_L
#undef PG8_BAR
#undef PG8_SCHED
}
}
constexpr int RING_BYTES = 131072, MISC_OFF = RING_BYTES + 320, LDS_BYTES = 147456;
struct Params { const float* in[45]; float* out; unsigned char* ws; int ph_lo, ph_hi, use_bar, pad; };
enum { I_XP = 0, I_XS, I_CKV, I_CWIN, I_SWKV, I_SSHIFT, I_SCONV, I_PT, I_NORMG, I_MU, I_WR, I_WK, I_WV, I_WO, I_W0, I_W1, I_W2, I_A0, I_A1, I_A2, I_V0, I_V1, I_V2, I_G1, I_G2,
       I_KK, I_KA, I_RKK, I_LNW, I_LNB, I_KVNG, I_WKV, I_KNG, I_PE, I_CW1, I_CB1, I_CW2, I_CB2, I_WQ, I_QNG, I_WONSA, I_WIN, I_CONVW, I_CONVB, I_WOUT };

typedef const __attribute__((address_space(4))) Params* KP;
struct Ctx { LAS unsigned char* lds; int tid, lane, wave, gw, ngw, gtid, gsz; };

__device__ __forceinline__ void p0_transpose_item(const float* W, int K, int ldw, int nblk, bf16_t* WT, int row_off, LAS float* scr, int item, int lane) {
    const int kb = item / nblk, nb = item % nblk, k0 = 64 * kb, n0 = 32 * nb;
#pragma unroll 8
    for (int i = 0; i < 32; ++i) { const int kk = 2 * i + (lane >> 5); scr[kk * 33 + (lane & 31)] = W[(size_t)(k0 + kk) * ldw + n0 + (lane & 31)]; }
    LDS_WAIT(); asm volatile("" ::: "memory");
    const int c = lane & 7;
#pragma unroll
    for (int j = 0; j < 4; ++j) { const int n = (lane >> 3) + 8 * j; const LAS float* s = scr + (8 * c) * 33 + n;
        u32x4 o; o.x = pk2(s[0 * 33], s[1 * 33]); o.y = pk2(s[2 * 33], s[3 * 33]); o.z = pk2(s[4 * 33], s[5 * 33]); o.w = pk2(s[6 * 33], s[7 * 33]);
        *(u32x4*)(WT + (size_t)(row_off + n0 + n) * K + k0 + 8 * c) = o; }
    LDS_WAIT(); asm volatile("" ::: "memory");
}

__device__ __forceinline__ void phase_prologue(KP p, const Ctx& c) {
    LAS float* scr = (LAS float*)(c.lds + c.wave * 16384);
    unsigned char* ws = p->ws;
    int total = 0;
#define TRCNT(K_, N_) (((K_) / 64) * ((N_) / 32))
    constexpr int C_DD = TRCNT(1024, 1024), C_L64 = TRCNT(1024, 64), C_L32 = TRCNT(1024, 32), C_L128 = TRCNT(1024, 128), C_2_64 = TRCNT(64, 1024), C_2_128 = TRCNT(128, 1024);
    constexpr int C_KV = TRCNT(1024, 1536), C_Q = 16 * 33, C_IN = TRCNT(1024, 5632), C_OUT = TRCNT(2816, 1024), C_CW = TRCNT(1024, 128);
    constexpr int NITEMS = 2 * (4 * C_DD + 2 * C_L64 + C_L128 + 2 * C_2_64 + C_2_128) + C_L32 + C_KV + 2 * C_Q + 2 * C_DD + 4 * C_IN + 4 * C_OUT + 4 * C_CW;
    (void)total;
    for (int it = c.gw; it < NITEMS; it += c.ngw) {
        int r = it;
#define TR(Wp, K_, LDW_, NBLK_, WTp, ROWOFF_) { const int cnt_ = ((K_) / 64) * (NBLK_); if (r < cnt_) { p0_transpose_item((Wp), (K_), (LDW_), (NBLK_), (bf16_t*)(WTp), (ROWOFF_), scr, r, c.lane); continue; } r -= cnt_; }
        bool done = false;
#pragma unroll
        for (int l = 0; l < 2; ++l) {
            if (done) break;
            const size_t dd = (size_t)l * 1024 * 1024;
#define TRL(Wp, K_, LDW_, NBLK_, WTp, ROWOFF_) { const int cnt_ = ((K_) / 64) * (NBLK_); if (!done) { if (r < cnt_) { p0_transpose_item((Wp), (K_), (LDW_), (NBLK_), (bf16_t*)(WTp), (ROWOFF_), scr, r, c.lane); done = true; } else r -= cnt_; } }
            TRL(p->in[I_WR] + dd, 1024, 1024, 32, ws + WS_WRKV + (size_t)l * 3072 * 1024 * 2, 0)
            TRL(p->in[I_WK] + dd, 1024, 1024, 32, ws + WS_WRKV + (size_t)l * 3072 * 1024 * 2, 1024)
            TRL(p->in[I_WV] + dd, 1024, 1024, 32, ws + WS_WRKV + (size_t)l * 3072 * 1024 * 2, 2048)
            TRL(p->in[I_WO] + dd, 1024, 1024, 32, ws + WS_WORW + (size_t)l * 1024 * 1024 * 2, 0)
            TRL(p->in[I_W1] + (size_t)l * 1024 * 64, 1024, 64, 2, ws + WS_W1T + (size_t)l * 288 * 1024 * 2, 0)
            TRL(p->in[I_A1] + (size_t)l * 1024 * 64, 1024, 64, 2, ws + WS_W1T + (size_t)l * 288 * 1024 * 2, 64)
            TRL(p->in[I_G1] + (size_t)l * 1024 * 128, 1024, 128, 4, ws + WS_W1T + (size_t)l * 288 * 1024 * 2, 160)
            TRL(p->in[I_W2] + (size_t)l * 64 * 1024, 64, 1024, 32, ws + WS_W2W + (size_t)l * 1024 * 64 * 2, 0)
            TRL(p->in[I_A2] + (size_t)l * 64 * 1024, 64, 1024, 32, ws + WS_W2A + (size_t)l * 1024 * 64 * 2, 0)
            TRL(p->in[I_G2] + (size_t)l * 128 * 1024, 128, 1024, 32, ws + WS_W2G + (size_t)l * 1024 * 128 * 2, 0)
        }
        if (done) continue;
        TR(p->in[I_V1], 1024, 32, 1, ws + WS_W1T + (size_t)1 * 288 * 1024 * 2, 128)
        TR(p->in[I_WKV], 1024, 1536, 48, ws + WS_WKVT, 0)
        TR(p->in[I_WQ], 1024, NQ, 33, ws + WS_WQT, 0)
        TR(p->in[I_WQ] + (size_t)1024 * NQ, 1024, NQ, 33, ws + WS_WQT + (size_t)NQP * 1024 * 2, 0)
        TR(p->in[I_WONSA], 1024, 1024, 32, ws + WS_WONSA, 0)
        TR(p->in[I_WONSA] + (size_t)1024 * 1024, 1024, 1024, 32, ws + WS_WONSA + (size_t)1024 * 1024 * 2, 0)
#pragma unroll
        for (int l = 0; l < 4; ++l) {
            if (done) break;
            TRL(p->in[I_WIN] + (size_t)l * 1024 * 5632, 1024, 5632, 176, ws + WS_WINT + (size_t)l * 5632 * 1024 * 2, 0)
            TRL(p->in[I_WOUT] + (size_t)l * 2816 * 1024, 2816, 1024, 32, ws + WS_WOUTT + (size_t)l * 1024 * 2816 * 2, 0)
        }
        if (done) continue;
        TR(p->in[I_CW1], 1024, 128, 4, ws + WS_CW1T, 0)
        TR(p->in[I_CW1] + (size_t)1024 * 128, 1024, 128, 4, ws + WS_CW1T, 128)
        TR(p->in[I_CW1] + (size_t)2048 * 128, 1024, 128, 4, ws + WS_CW1T + (size_t)256 * 1024 * 2, 0)
        TR(p->in[I_CW1] + (size_t)3072 * 128, 1024, 128, 4, ws + WS_CW1T + (size_t)256 * 1024 * 2, 128)
#undef TR
#undef TRL
    }
    {
        bf16_t* WQT = (bf16_t*)(ws + WS_WQT);
        for (int e = c.gtid; e < 2 * 224 * 1024; e += c.gsz) { const int k = e & 1023, n = 1056 + ((e >> 10) % 224), l = e / (224 * 1024);
            WQT[((size_t)l * NQP + n) * 1024 + k] = n < NQ ? (bf16_t)f2bf(p->in[I_WQ][((size_t)l * 1024 + k) * NQ + n]) : (bf16_t)0; }
        bf16_t* W2V = (bf16_t*)(ws + WS_W2V);
        for (int e = c.gtid; e < 32 * 1024; e += c.gsz) { const int n = e & 1023, k = e >> 10; W2V[n * 32 + k] = (bf16_t)f2bf(p->in[I_V2][k * 1024 + n]); }
    }
    { bf16_t* W2T = (bf16_t*)(ws + WS_CW2T);
      for (int e = c.gtid; e < 2 * 128 * 64; e += c.gsz) { const int d = e & 63, q = (e >> 6) & 127, kv = e >> 13; const float w = p->in[I_CW2][e];
          const unsigned hi = f2bf(w), lo = f2bf(w - __builtin_bit_cast(float, hi << 16)); W2T[(size_t)(kv * 64 + d) * 128 + q] = (bf16_t)hi; W2T[(size_t)2 * 64 * 128 + (size_t)(kv * 64 + d) * 128 + q] = (bf16_t)lo; } }
    for (int it = c.gw; it < 256; it += c.ngw) { const int kv = it >> 7, h = it & 127; float s = 0.f;
        for (int kk = c.lane; kk < 2048; kk += 64) s += p->in[I_PE][kv * 2048 + kk] * p->in[I_CW1][((size_t)kv * 2048 + kk) * 128 + h];
        s = wave_sum(s); if (c.lane == 0) ((float*)(ws + WS_CBIAS))[it] = s + p->in[I_CB1][it]; }
    { const f32x4* xp = (const f32x4*)p->in[I_XP]; const f32x4* xs = (const f32x4*)p->in[I_XS]; f32x4* o = (f32x4*)(p->out + O_Y);
      for (int e = c.gtid; e < R * D / 4; e += c.gsz) o[e] = e < MP * D / 4 ? xp[e] : xs[e - MP * D / 4]; }
}

__device__ __forceinline__ void phase_fill(KP p, const Ctx& c, int li, const int gwf, const int ngwf) {
    unsigned char* ws = p->ws;
    { const int* pt = (const int*)p->in[I_PT]; bf16_t* CA = (bf16_t*)(ws + WS_CMPA); const int part = li;
      for (int it = gwf; it < SB * 128 * 4; it += ngwf) { const int s4 = 4 * (it & 3), n = (it >> 2) & 127, b = it >> 9;
          const int page = pt[b * NPAGES + (n >> 3)]; const float* src = p->in[I_CKV] + ((size_t)page * PAGE + (n & 7) * 16 + s4) * 1024 + part * 256;
          f32x4 v[4];
#pragma unroll
          for (int e = 0; e < 4; ++e) v[e] = __builtin_nontemporal_load(((const f32x4*)(src + (size_t)e * 1024)) + c.lane);
          const int g = c.lane >> 4, d0 = 4 * (c.lane & 15); bf16_t* dst = CA + ((size_t)8192 + (size_t)part * 65536 + (size_t)(b * 4 + g) * 128 + n) * 1024 + s4 * 64 + d0;
#pragma unroll
          for (int e = 0; e < 4; ++e) { u32x2 w; w.x = pk2(v[e][0], v[e][1]); w.y = pk2(v[e][2], v[e][3]); *(u32x2*)(dst + e * 64) = w; } } }
    { const f32x4* src = (const f32x4*)p->in[I_CWIN]; f32x4* dst = (f32x4*)(p->out + O_WINS); constexpr int HALF_N = SB * 508 * 128 / 2;
      for (int e0 = li * HALF_N + gwf * 256 + c.lane; e0 < (li + 1) * HALF_N; e0 += ngwf * 256) { f32x4 v[4];
#pragma unroll
          for (int q = 0; q < 4; ++q) { const int e = e0 + 64 * q; if (e < (li + 1) * HALF_N) { const int b = e / (508 * 128), rr = e % (508 * 128); v[q] = __builtin_nontemporal_load(src + (size_t)b * 512 * 128 + 4 * 128 + rr); } }
#pragma unroll
          for (int q = 0; q < 4; ++q) { const int e = e0 + 64 * q; if (e < (li + 1) * HALF_N) { const int b = e / (508 * 128), rr = e % (508 * 128); __builtin_nontemporal_store(v[q], dst + (size_t)b * 512 * 128 + rr); } } } }
}

template <int NT> __device__ __forceinline__ void skinny_mma(const bf16_t* A, int lda, const bf16_t* Wt, int ldw, int K, int row0, int col0, int lane, f32x4 (&acc)[NT][2]) {
    const int fr = lane & 15, fq = lane >> 4;
#pragma unroll
    for (int nt = 0; nt < NT; ++nt) { acc[nt][0] = (f32x4){0.f, 0.f, 0.f, 0.f}; acc[nt][1] = (f32x4){0.f, 0.f, 0.f, 0.f}; }
    const bf16_t* xa = A + (size_t)(row0 + fr) * lda + 8 * fq; const bf16_t* xb = xa + (size_t)16 * lda;
    const bf16_t* wa = Wt + (size_t)(col0 + fr) * ldw + 8 * fq;
    const char* pa = (const char*)xa; const char* pb = (const char*)xb; const char* pw[NT];
#pragma unroll
    for (int nt = 0; nt < NT; ++nt) pw[nt] = (const char*)(wa + (size_t)nt * 16 * ldw);
    for (int k4 = 0; k4 < K / 128; ++k4) {
        bf16x8 fb[4][2], fa[4][NT];
#pragma unroll
        for (int u = 0; u < 4; ++u) { fb[u][0] = *(const bf16x8*)(pa + 64 * u); fb[u][1] = *(const bf16x8*)(pb + 64 * u);
#pragma unroll
            for (int nt = 0; nt < NT; ++nt) fa[u][nt] = *(const bf16x8*)(pw[nt] + 64 * u); }
        __builtin_amdgcn_sched_barrier(0);
#pragma unroll
        for (int u = 0; u < 4; ++u)
#pragma unroll
            for (int nt = 0; nt < NT; ++nt) { acc[nt][0] = mfma16(fa[u][nt], fb[u][0], acc[nt][0]); acc[nt][1] = mfma16(fa[u][nt], fb[u][1], acc[nt][1]); }
        pa += 256; pb += 256;
#pragma unroll
        for (int nt = 0; nt < NT; ++nt) pw[nt] += 256;
        __builtin_amdgcn_sched_barrier(0);
    }
}
__device__ __forceinline__ void skinny_resid_sample(const Ctx& c, const bf16_t* A, int lda, const bf16_t* Wt, int K, float* X) {
    const int ln = launder_v(c.lane), fr = ln & 15, fq = ln >> 4;
    for (int it = blockIdx.x + gridDim.x * c.wave; it < 256; it += c.ngw) { const int row0 = MP + 32 * (it & 15), col0 = 64 * (it >> 4);
        f32x4 acc[4][2]; skinny_mma<4>(A, lda, Wt, lda, K, row0, col0, c.lane, acc);
#pragma unroll
        for (int nt = 0; nt < 4; ++nt)
#pragma unroll
            for (int mt = 0; mt < 2; ++mt) { f32x4* q = (f32x4*)(X + (size_t)(row0 + 16 * mt + fr) * D + col0 + 16 * nt + 4 * fq); *q = *q + acc[nt][mt]; } }
}
__device__ __forceinline__ void skinny_store(const Ctx& c, const bf16_t* A, const bf16_t* Wt, int K, float* C, int ldc, int rbase, int nrb, int ncb, int it0, int nit_total) {
    const int fr = c.lane & 15, fq = c.lane >> 4;
    for (int it = c.gw - it0; it < nrb * ncb; it += c.ngw) { if (it < 0) continue; const int row0 = rbase + 32 * (it % nrb), col0 = 64 * (it / nrb);
        f32x4 acc[4][2]; skinny_mma<4>(A, K, Wt, K, K, row0, col0, c.lane, acc);
#pragma unroll
        for (int nt = 0; nt < 4; ++nt)
#pragma unroll
            for (int mt = 0; mt < 2; ++mt) *(f32x4*)(C + (size_t)(row0 + 16 * mt + fr) * ldc + col0 + 16 * nt + 4 * fq) = acc[nt][mt]; }
    (void)nit_total;
}

__device__ __forceinline__ void load_row(const float* p, int lane, f32x4 (&v)[4]) {
#pragma unroll
    for (int j = 0; j < 4; ++j) v[j] = ((const f32x4*)p)[lane + 64 * j];
}
__device__ __forceinline__ float row_rstd(const f32x4 (&v)[4]) {
    float s = 0.f;
#pragma unroll
    for (int j = 0; j < 4; ++j) s += (v[j][0] * v[j][0] + v[j][1] * v[j][1]) + (v[j][2] * v[j][2] + v[j][3] * v[j][3]);
    s = wave_sum(s); return frsq(s * (1.0f / D) + NORM_EPS);
}
__device__ __forceinline__ void store_row_bf16(bf16_t* o, int lane, const f32x4 (&v)[4]) {
#pragma unroll
    for (int j = 0; j < 4; ++j) { u32x2 w; w.x = pk2(v[j][0], v[j][1]); w.y = pk2(v[j][2], v[j][3]); ((u32x2*)o)[lane + 64 * j] = w; }
}

__device__ __forceinline__ void phase_norm(const Ctx& c, const float* X, const float* g1, bf16_t* o1, const float* g2, bf16_t* o2) {
    f32x4 ga[4], gb[4]; load_row(g1, c.lane, ga); if (g2) load_row(g2, c.lane, gb);
    for (int row = c.gw; row < R; row += c.ngw) {
        f32x4 v[4]; load_row(X + (size_t)row * D, c.lane, v); const float rs = row_rstd(v);
        f32x4 y[4];
#pragma unroll
        for (int j = 0; j < 4; ++j) y[j] = v[j] * rs * ga[j];
        store_row_bf16(o1 + (size_t)row * D, c.lane, y);
        if (g2) {
#pragma unroll
            for (int j = 0; j < 4; ++j) y[j] = v[j] * rs * gb[j];
            store_row_bf16(o2 + (size_t)row * D, c.lane, y); }
    }
}

__device__ __forceinline__ void phase_mix(KP p, const Ctx& c, int li) {
    const float* X = p->out + O_Y; const float* gain = p->in[I_NORMG] + (size_t)(li * 2) * D; const float* mu = p->in[I_MU] + (size_t)li * 6 * D;
    bf16_t* XM = (bf16_t*)(p->ws + WS_XM);
    f32x4 ga[4]; load_row(gain, c.lane, ga);
    {
        const int r0 = (int)(((long)c.gw * R) / c.ngw), r1 = (int)(((long)(c.gw + 1) * R) / c.ngw); f32x4 prev[4];
        {
            const bool seq_start = r0 < MP ? ((r0 & (TP - 1)) == 0) : (((r0 - MP) & 3) == 0);
            if (!seq_start && r0 < r1) { f32x4 v[4]; load_row(X + (size_t)(r0 - 1) * D, c.lane, v); const float rs = row_rstd(v);
#pragma unroll
                for (int j = 0; j < 4; ++j) prev[j] = v[j] * rs * ga[j]; }
        }
        for (int row = r0; row < r1; ++row) {
            const bool seq_start = row < MP ? ((row & (TP - 1)) == 0) : (((row - MP) & 3) == 0);
            if (seq_start) {
                if (row < MP) {
#pragma unroll
                    for (int j = 0; j < 4; ++j) prev[j] = (f32x4){0.f, 0.f, 0.f, 0.f}; }
                else load_row(p->in[I_SSHIFT] + ((size_t)li * SB + ((row - MP) >> 2)) * D, c.lane, prev);
            }
            f32x4 v[4]; load_row(X + (size_t)row * D, c.lane, v); const float rs = row_rstd(v);
            f32x4 xn[4];
#pragma unroll
            for (int j = 0; j < 4; ++j) xn[j] = v[j] * rs * ga[j];
#pragma unroll
            for (int m = 0; m < 6; ++m) {
                f32x4 y[4];
#pragma unroll
                for (int j = 0; j < 4; ++j) { const int mi = m == 1 ? 2 : (m == 2 ? 3 : (m == 3 ? 1 : m));
                    const f32x4 mm = ((const f32x4*)(mu + (size_t)mi * D))[c.lane + 64 * j]; y[j] = xn[j] + (prev[j] - xn[j]) * mm; }
                store_row_bf16(XM + ((size_t)m * R + row) * D, c.lane, y);
            }
            const bool seq_end = row < MP ? ((row & (TP - 1)) == TP - 1) : (((row - MP) & 3) == 3);
            if (seq_end) { float* so = row < MP ? p->out + O_SHP + ((size_t)li * NB + (row >> 13)) * D : p->out + O_SHS + ((size_t)li * SB + ((row - MP) >> 2)) * D;
#pragma unroll
                for (int j = 0; j < 4; ++j) ((f32x4*)so)[c.lane + 64 * j] = xn[j]; }
#pragma unroll
            for (int j = 0; j < 4; ++j) prev[j] = xn[j];
        }
    }
}
template <int NT, int ACT> __device__ __forceinline__ void lora1_item(const bf16_t* X, const bf16_t* W, bf16_t* HID, int coloff, int rb, int lane) {
    lane = launder_v(lane);
    const int fr = lane & 15, fq = lane >> 4;
    f32x4 acc[NT][2]; skinny_mma<NT>(X, 1024, W, 1024, 1024, rb * 32, coloff, lane, acc);
#pragma unroll
    for (int nt = 0; nt < NT; ++nt)
#pragma unroll
        for (int mt = 0; mt < 2; ++mt) { f32x4 v = acc[nt][mt];
#pragma unroll
            for (int r = 0; r < 4; ++r) { if (ACT == 1) { const float e = __builtin_amdgcn_exp2f(2.8853900817779268f * v[r]); v[r] = 1.0f - 2.0f * frcp(e + 1.0f); } if (ACT == 2) v[r] = sigmoidf_(v[r]); }
            u32x2 w; w.x = pk2(v[0], v[1]); w.y = pk2(v[2], v[3]);
            *(u32x2*)(HID + (size_t)(rb * 32 + mt * 16 + fr) * LHID + coloff + nt * 16 + 4 * fq) = w; }
}
__device__ __forceinline__ void phase_lora1(KP p, const Ctx& c, int li) {
    const bf16_t* XM = (const bf16_t*)(p->ws + WS_XM); const bf16_t* W = (const bf16_t*)(p->ws + WS_W1T) + (size_t)li * 288 * 1024; bf16_t* HID = (bf16_t*)(p->ws + WS_HID);
    constexpr int NRB = R / 32;
    for (int it = blockIdx.x + gridDim.x * c.wave; it < 5 * NRB; it += c.ngw) { const int q = it / NRB, rb = it % NRB;
        if (q == 0) lora1_item<4, 1>(XM + (size_t)3 * R * D, W, HID, 0, rb, c.lane);
        else if (q == 1) lora1_item<4, 0>(XM + (size_t)4 * R * D, W, HID, 64, rb, c.lane);
        else if (q == 2) { if (li == 1) lora1_item<2, 0>(XM + (size_t)2 * R * D, W, HID, 128, rb, c.lane); }
        else if (q == 3) lora1_item<4, 2>(XM + (size_t)5 * R * D, W, HID, 160, rb, c.lane);
        else lora1_item<4, 2>(XM + (size_t)5 * R * D, W, HID, 224, rb, c.lane);
    }
}

constexpr int SST = 72, MAT = 64 * SST * 2;
constexpr int O_AT = 0, O_BT = MAT, O_KT = 2 * MAT, O_RT = 3 * MAT, O_VT = 4 * MAT, O_BH = 5 * MAT, O_KH = 6 * MAT, O_XT = 7 * MAT, O_AAB = 9 * MAT, O_AAK = 10 * MAT, O_ARB = 11 * MAT, O_ARK = 12 * MAT;
constexpr int O_TD = 13 * MAT, O_SCR = O_TD + 2048, O_CS = O_SCR + 4096, O_WC = O_CS + 2048, O_LW = O_XT, O_LA = O_XT + 16384, O_LV = O_XT + 32768;
static_assert(O_WC + 256 <= RING_BYTES && O_LV + 16384 <= O_TD, "scan LDS map");
__device__ __forceinline__ bf16x8 ldsfrag(LAS unsigned char* lds, int off, int row, int col) { return *(const LAS bf16x8*)(lds + off + (row * SST + col) * 2); }
__device__ __forceinline__ void lds_st4(LAS unsigned char* lds, int off, int row, int col, f32x4 v) { u32x2 w; w.x = pk2(v[0], v[1]); w.y = pk2(v[2], v[3]); *(LAS u32x2*)(lds + off + (row * SST + col) * 2) = w; }
__device__ __forceinline__ f32x4 lds_ld4(LAS unsigned char* lds, int off, int row, int col) { const u32x2 w = *(const LAS u32x2*)(lds + off + (row * SST + col) * 2); return (f32x4){bflo(w.x), bfhi(w.x), bflo(w.y), bfhi(w.y)}; }

__device__ __forceinline__ void scanA_unit(KP p, const Ctx& c, int li, int u) {
    LAS unsigned char* lds = c.lds; unsigned char* ws = p->ws; const int stop = p->pad;
    const int lane = c.lane, wave = c.wave, fr = lane & 15, fq = lane >> 4;
    const int b = u / (NCH * H), n = (u / H) % NCH, h = u % H, row0 = b * TP + 64 * n;
    const float* Rb = (const float*)(ws + WS_RK_R); const float* Kb = (const float*)(ws + WS_RK_K);
    float* Vb = (float*)(ws + (li ? WS_V1 : WS_V0)); const float* V0b = (const float*)(ws + WS_V0);
    const bf16_t* HID = (const bf16_t*)(ws + WS_HID);
    {
        const int tt = wave & 3, chh = wave >> 2;
        const bf16_t* hrow = launder_p(HID + (size_t)(row0 + 16 * tt + fr) * LHID + 8 * fq);
        const bf16_t* W2W = (const bf16_t*)(ws + WS_W2W) + (size_t)li * 1024 * 64; const bf16_t* W2A = (const bf16_t*)(ws + WS_W2A) + (size_t)li * 1024 * 64; const bf16_t* W2V = (const bf16_t*)(ws + WS_W2V);
#pragma unroll
        for (int cti = 0; cti < 2; ++cti) { const int ct = 2 * chh + cti, C = 64 * h + 16 * ct + fr;
            f32x4 aw = {0.f, 0.f, 0.f, 0.f}, aa = {0.f, 0.f, 0.f, 0.f}, av = {0.f, 0.f, 0.f, 0.f};
#pragma unroll
            for (int ks = 0; ks < 2; ++ks) {
                aw = mfma16(*(const bf16x8*)(W2W + (size_t)C * 64 + 32 * ks + 8 * fq), *(const bf16x8*)(hrow + 32 * ks), aw);
                aa = mfma16(*(const bf16x8*)(W2A + (size_t)C * 64 + 32 * ks + 8 * fq), *(const bf16x8*)(hrow + 64 + 32 * ks), aa); }
            if (li) av = mfma16(*(const bf16x8*)(W2V + (size_t)C * 32 + 8 * fq), *(const bf16x8*)(hrow + 128), av);
            const int t = 16 * tt + fr, cc = 16 * ct + 4 * fq;
            *(LAS f32x4*)(lds + O_LW + (t * 64 + cc) * 4) = aw; *(LAS f32x4*)(lds + O_LA + (t * 64 + cc) * 4) = aa; *(LAS f32x4*)(lds + O_LV + (t * 64 + cc) * 4) = av; }
    }
    __syncthreads();
    if (stop == 1) return;
    {
        const int cc = lane, tq = wave, C = 64 * h + cc; const size_t pc = (size_t)li * D + C;
        const float w0 = p->in[I_W0][pc], a0 = p->in[I_A0][pc], kkc = p->in[I_KK][pc], kac = p->in[I_KA][pc], rkc = p->in[I_RKK][pc], v0 = li ? p->in[I_V0][C] : 0.f;
        float wlg[8], Lin[8], rr[8], k2[8], vv[8], aa[8], bb[8]; float run = 0.f;
#pragma unroll
        for (int e = 0; e < 8; ++e) { const int t = 8 * tq + e; const size_t gi = (size_t)(row0 + t) * D + C;
            const float r = Rb[gi], k = Kb[gi]; float v = Vb[gi];
            const float lw = *(const LAS float*)(lds + O_LW + (t * 64 + cc) * 4), la = *(const LAS float*)(lds + O_LA + (t * 64 + cc) * 4);
            const float z = -(w0 + lw); const float sp = fmaxf(z, 0.f) + __logf(1.0f + __expf(-fabsf(z))); const float wl = -__expf(-sp - 0.5f);
            const float asig = sigmoidf_(a0 + la);
            if (li) { const float lv = *(const LAS float*)(lds + O_LV + (t * 64 + cc) * 4); const float vg = sigmoidf_(v0 + lv); const float vf = V0b[gi]; v = v + (vf - v) * vg; Vb[gi] = v; }
            const float kkr = k * kkc; const float ss = wave_sum(kkr * kkr); const float kkn = kkr * frsq(fmaxf(ss, 1e-24f));
            const float kmod = k * (1.0f + (asig - 1.0f) * kac);
            const float rks = wave_sum(r * kmod * rkc); if (cc == 0) ((float*)(ws + WS_RKS))[(size_t)(row0 + t) * 16 + h] = rks;
            run += wl; wlg[e] = wl; Lin[e] = run; rr[e] = r; k2[e] = kmod; vv[e] = v; aa[e] = -kkn; bb[e] = kkn * asig; }
        *(LAS float*)(lds + O_CS + (tq * 64 + cc) * 4) = run;
        __syncthreads();
        float off = 0.f, tot = 0.f;
#pragma unroll
        for (int q = 0; q < 8; ++q) { const float x = *(const LAS float*)(lds + O_CS + (q * 64 + cc) * 4); tot += x; if (q < tq) off += x; }
        u32x4 wa, wv, wb, wk; unsigned pa[8], pv[8], pb[8], pk[8];
#pragma unroll
        for (int e = 0; e < 8; ++e) { const int t = 8 * tq + e; const float L = off + Lin[e], Lp = L - wlg[e];
            const float eL = __expf(L), eLp = __expf(Lp), enL = __expf(-L), eT = __expf(tot - L);
            const float at = aa[e] * eLp, bt = bb[e] * enL, kt = k2[e] * enL, rt = rr[e] * eL, bh = bb[e] * eT, kh = k2[e] * eT;
            *(LAS bf16_t*)(lds + O_AT + (t * SST + cc) * 2) = (bf16_t)f2bf(at); *(LAS bf16_t*)(lds + O_BT + (t * SST + cc) * 2) = (bf16_t)f2bf(bt);
            *(LAS bf16_t*)(lds + O_KT + (t * SST + cc) * 2) = (bf16_t)f2bf(kt); *(LAS bf16_t*)(lds + O_RT + (t * SST + cc) * 2) = (bf16_t)f2bf(rt);
            pa[e] = f2bf(at); pv[e] = f2bf(vv[e]); pb[e] = f2bf(bh); pk[e] = f2bf(kh); }
        wa = (u32x4){pa[0] | (pa[1] << 16), pa[2] | (pa[3] << 16), pa[4] | (pa[5] << 16), pa[6] | (pa[7] << 16)};
        wv = (u32x4){pv[0] | (pv[1] << 16), pv[2] | (pv[3] << 16), pv[4] | (pv[5] << 16), pv[6] | (pv[7] << 16)};
        wb = (u32x4){pb[0] | (pb[1] << 16), pb[2] | (pb[3] << 16), pb[4] | (pb[5] << 16), pb[6] | (pb[7] << 16)};
        wk = (u32x4){pk[0] | (pk[1] << 16), pk[2] | (pk[3] << 16), pk[4] | (pk[5] << 16), pk[6] | (pk[7] << 16)};
        *(LAS u32x4*)(lds + O_XT + (cc * SST + 8 * tq) * 2) = wa; *(LAS u32x4*)(lds + O_VT + (cc * SST + 8 * tq) * 2) = wv;
        *(LAS u32x4*)(lds + O_BH + (cc * SST + 8 * tq) * 2) = wb; *(LAS u32x4*)(lds + O_KH + (cc * SST + 8 * tq) * 2) = wk;
        if (tq == 0) *(LAS float*)(lds + O_WC + cc * 4) = __expf(tot);
    }
    __syncthreads();
    if (stop == 2) return;
    {
        const int mi = wave >> 1, ph = wave & 1; const int oY = (mi & 1) ? O_KT : O_BT, oX = (mi < 2) ? O_AT : O_RT; const bool strict = mi < 2;
        const int oO = mi == 0 ? O_AAB : (mi == 1 ? O_AAK : (mi == 2 ? O_ARB : O_ARK));
#pragma unroll
        for (int sti = 0; sti < 2; ++sti) { const int st = 2 * ph + sti;
#pragma unroll
            for (int tt = 0; tt < 4; ++tt) { f32x4 acc = {0.f, 0.f, 0.f, 0.f};
                if (st <= tt) {
#pragma unroll
                    for (int ks = 0; ks < 2; ++ks) acc = mfma16(ldsfrag(lds, oY, 16 * st + fr, 32 * ks + 8 * fq), ldsfrag(lds, oX, 16 * tt + fr, 32 * ks + 8 * fq), acc);
                    const int t = 16 * tt + fr;
#pragma unroll
                    for (int r = 0; r < 4; ++r) { const int s = 16 * st + 4 * fq + r; const bool keep = strict ? (s < t) : (s <= t); acc[r] = keep ? acc[r] : 0.f; } }
                if (st <= tt) lds_st4(lds, oO, 16 * tt + fr, 16 * st + 4 * fq, acc);
                else { u32x2 zz; int z0 = 0; asm volatile("" : "+v"(z0)); zz.x = (unsigned)z0; zz.y = (unsigned)z0; *(LAS u32x2*)(lds + oO + ((16 * tt + fr) * SST + 16 * st + 4 * fq) * 2) = zz; } } }
    }
    __syncthreads();
    if (stop == 3) return;
    {
        const int tt = wave & 3, ih = wave >> 2;
#pragma unroll
        for (int iti = 0; iti < 2; ++iti) { const int it = 2 * ih + iti; f32x4 acc = {0.f, 0.f, 0.f, 0.f};
#pragma unroll
            for (int ks = 0; ks < 2; ++ks) acc = mfma16(ldsfrag(lds, O_AAK, 16 * tt + fr, 32 * ks + 8 * fq), ldsfrag(lds, O_VT, 16 * it + fr, 32 * ks + 8 * fq), acc);
            lds_st4(lds, O_XT, 64 + 16 * it + fr, 16 * tt + 4 * fq, acc); }
        if (wave < 4 && lane < 16) { const int I = wave; float x[16];
#pragma unroll
            for (int t = 0; t < 16; ++t) { float s = (t == lane) ? 1.0f : 0.0f;
#pragma unroll
                for (int q = 0; q < t; ++q) s += bf2f(*(const LAS bf16_t*)(lds + O_AAB + ((16 * I + t) * SST + 16 * I + q) * 2)) * x[q];
                x[t] = s; *(LAS bf16_t*)(lds + O_TD + ((I * 16 + t) * 16 + lane) * 2) = (bf16_t)f2bf(s); } }
    }
    __syncthreads();
    if (stop == 5) return;
    {
        const int colb = 16 * wave; const bf16x8 zero8 = {0, 0, 0, 0, 0, 0, 0, 0};
#pragma unroll
        for (int I = 0; I < 4; ++I) {
            f32x4 acc = lds_ld4(lds, O_XT, colb + fr, 16 * I + 4 * fq);
#pragma unroll
            for (int ks = 0; ks < 2; ++ks) if (32 * ks < 16 * I) { const bool ok = (32 * ks + 8 * fq) < 16 * I;
                const bf16x8 a = ok ? ldsfrag(lds, O_AAB, 16 * I + fr, 32 * ks + 8 * fq) : zero8, bq = ok ? ldsfrag(lds, O_XT, colb + fr, 32 * ks + 8 * fq) : zero8;
                acc = mfma16(a, bq, acc); }
            { u32x2 w; w.x = pk2(acc[0], acc[1]); w.y = pk2(acc[2], acc[3]); *(LAS u32x2*)(lds + O_SCR + wave * 512 + (fr * 16 + 4 * fq) * 2) = w; }
            LDS_WAIT();
            const bf16x8 ta = fq < 2 ? *(const LAS bf16x8*)(lds + O_TD + ((I * 16 + fr) * 16 + 8 * fq) * 2) : zero8;
            const bf16x8 tb = fq < 2 ? *(const LAS bf16x8*)(lds + O_SCR + wave * 512 + (fr * 16 + 8 * fq) * 2) : zero8;
            const f32x4 res = mfma16(ta, tb, (f32x4){0.f, 0.f, 0.f, 0.f});
            lds_st4(lds, O_XT, colb + fr, 16 * I + 4 * fq, res);
            LDS_WAIT();
        }
    }
    __syncthreads();
    if (stop == 6) return;
    {
        const int tb = wave & 3, hb = wave >> 2;
        bf16_t* RP = (bf16_t*)(ws + WS_RP) + (size_t)u * 4096; float* YL = (float*)(ws + WS_YL) + (size_t)u * 4096;
        bf16_t* MTH = (bf16_t*)(ws + WS_MT) + (size_t)u * 4096; bf16_t* MTL = MTH + (size_t)NUNIT_A * 4096; float* NN = (float*)(ws + WS_NN) + (size_t)u * 4096;
#pragma unroll
        for (int qi = 0; qi < 2; ++qi) { const int rt = 2 * hb + qi;
            { f32x4 acc = lds_ld4(lds, O_RT, 16 * tb + fr, 16 * rt + 4 * fq);
#pragma unroll
              for (int ks = 0; ks < 2; ++ks) acc = mfma16(ldsfrag(lds, O_XT, 16 * rt + fr, 32 * ks + 8 * fq), ldsfrag(lds, O_ARB, 16 * tb + fr, 32 * ks + 8 * fq), acc);
              u32x2 w; w.x = pk2(acc[0], acc[1]); w.y = pk2(acc[2], acc[3]); *(u32x2*)(RP + (size_t)(16 * tb + fr) * 64 + 16 * rt + 4 * fq) = w; }
            { f32x4 acc = {0.f, 0.f, 0.f, 0.f};
#pragma unroll
              for (int ks = 0; ks < 2; ++ks) { acc = mfma16(ldsfrag(lds, O_XT, 64 + 16 * rt + fr, 32 * ks + 8 * fq), ldsfrag(lds, O_ARB, 16 * tb + fr, 32 * ks + 8 * fq), acc);
                  acc = mfma16(ldsfrag(lds, O_VT, 16 * rt + fr, 32 * ks + 8 * fq), ldsfrag(lds, O_ARK, 16 * tb + fr, 32 * ks + 8 * fq), acc); }
              *(f32x4*)(YL + (size_t)(16 * tb + fr) * 64 + 16 * rt + 4 * fq) = acc; }
            { f32x4 acc = {0.f, 0.f, 0.f, 0.f};
#pragma unroll
              for (int ks = 0; ks < 2; ++ks) acc = mfma16(ldsfrag(lds, O_XT, 16 * rt + fr, 32 * ks + 8 * fq), ldsfrag(lds, O_BH, 16 * tb + fr, 32 * ks + 8 * fq), acc);
              const int j = 16 * tb + fr; const float wc = *(const LAS float*)(lds + O_WC + j * 4);
#pragma unroll
              for (int r = 0; r < 4; ++r) if (16 * rt + 4 * fq + r == j) acc[r] += wc;
              unsigned hh[4], ll[4];
#pragma unroll
              for (int r = 0; r < 4; ++r) { hh[r] = f2bf(acc[r]); ll[r] = f2bf(acc[r] - __builtin_bit_cast(float, hh[r] << 16)); }
              *(u32x2*)(MTH + (size_t)j * 64 + 16 * rt + 4 * fq) = (u32x2){hh[0] | (hh[1] << 16), hh[2] | (hh[3] << 16)};
              *(u32x2*)(MTL + (size_t)j * 64 + 16 * rt + 4 * fq) = (u32x2){ll[0] | (ll[1] << 16), ll[2] | (ll[3] << 16)}; }
            { f32x4 acc = {0.f, 0.f, 0.f, 0.f};
#pragma unroll
              for (int ks = 0; ks < 2; ++ks) { acc = mfma16(ldsfrag(lds, O_BH, 16 * rt + fr, 32 * ks + 8 * fq), ldsfrag(lds, O_XT, 64 + 16 * tb + fr, 32 * ks + 8 * fq), acc);
                  acc = mfma16(ldsfrag(lds, O_KH, 16 * rt + fr, 32 * ks + 8 * fq), ldsfrag(lds, O_VT, 16 * tb + fr, 32 * ks + 8 * fq), acc); }
              *(f32x4*)(NN + (size_t)(16 * tb + fr) * 64 + 16 * rt + 4 * fq) = acc; }
        }
    }
    __syncthreads();
}

__device__ __forceinline__ void scan_sample_item(KP p, const Ctx& c, int li, int item) {
    unsigned char* ws = p->ws; const int lane = c.lane, b = item >> 4, h = item & 15, C = 64 * h + lane; const size_t pc = (size_t)li * D + C;
    LAS float* sc = (LAS float*)(c.lds + c.wave * 16384);
    const float* Rb = (const float*)(ws + WS_RK_R); const float* Kb = (const float*)(ws + WS_RK_K);
    float* Vb = (float*)(ws + (li ? WS_V1 : WS_V0)); const float* V0b = (const float*)(ws + WS_V0);
    const bf16_t* HID = (const bf16_t*)(ws + WS_HID) + (size_t)(MP + 4 * b) * LHID;
    for (int e = lane; e < 4 * LHID; e += 64) sc[e] = bf2f(HID[e]);
    LDS_WAIT();
    float lw[4] = {0.f, 0.f, 0.f, 0.f}, la[4] = {0.f, 0.f, 0.f, 0.f}, lv[4] = {0.f, 0.f, 0.f, 0.f}, lg[4] = {0.f, 0.f, 0.f, 0.f};
    {
        const bf16_t* W2W = (const bf16_t*)(ws + WS_W2W) + ((size_t)li * 1024 + C) * 64; const bf16_t* W2A = (const bf16_t*)(ws + WS_W2A) + ((size_t)li * 1024 + C) * 64;
        const bf16_t* W2V = (const bf16_t*)(ws + WS_W2V) + (size_t)C * 32; const bf16_t* W2G = (const bf16_t*)(ws + WS_W2G) + ((size_t)li * 1024 + C) * 128;
#define LORA2_BLK(WP, QB, HOFF, ACC) { const u32x4 w8 = *(const u32x4*)((WP) + 8 * (QB)); \
            const float wf0 = bflo(w8.x), wf1 = bfhi(w8.x), wf2 = bflo(w8.y), wf3 = bfhi(w8.y), wf4 = bflo(w8.z), wf5 = bfhi(w8.z), wf6 = bflo(w8.w), wf7 = bfhi(w8.w); \
            _Pragma("unroll") for (int t = 0; t < 4; ++t) { const f32x4 h0 = *(const LAS f32x4*)(sc + t * LHID + (HOFF) + 8 * (QB)), h1 = *(const LAS f32x4*)(sc + t * LHID + (HOFF) + 8 * (QB) + 4); \
                ACC[t] += (h0[0] * wf0 + h0[1] * wf1) + (h0[2] * wf2 + h0[3] * wf3) + (h1[0] * wf4 + h1[1] * wf5) + (h1[2] * wf6 + h1[3] * wf7); } \
            asm volatile("" : "+v"(ACC[0]), "+v"(ACC[1]), "+v"(ACC[2]), "+v"(ACC[3]) :: "memory"); }
#pragma unroll
        for (int qb = 0; qb < 8; ++qb) { LORA2_BLK(W2W, qb, 0, lw) LORA2_BLK(W2A, qb, 64, la) }
        if (li) {
#pragma unroll
            for (int qb = 0; qb < 4; ++qb) LORA2_BLK(W2V, qb, 128, lv) }
#pragma unroll
        for (int qb = 0; qb < 16; ++qb) LORA2_BLK(W2G, qb, 160, lg)
#undef LORA2_BLK
    }
    const float w0 = p->in[I_W0][pc], a0 = p->in[I_A0][pc], kkc = p->in[I_KK][pc], kac = p->in[I_KA][pc], rkc = p->in[I_RKK][pc], v0 = li ? p->in[I_V0][C] : 0.f;
    const float lnw = p->in[I_LNW][pc], lnb = p->in[I_LNB][pc];
    float S[64];
    { const f32x4* sp = (const f32x4*)(p->in[I_SWKV] + (((size_t)li * SB + b) * H + h) * 4096 + lane * 64);
#pragma unroll
      for (int q = 0; q < 16; ++q) { const f32x4 x = sp[q]; S[4 * q] = x[0]; S[4 * q + 1] = x[1]; S[4 * q + 2] = x[2]; S[4 * q + 3] = x[3]; } }
    LAS float* bc = sc + 1280;
    bf16_t* YG = (bf16_t*)(ws + WS_YG);
#pragma unroll
    for (int t = 0; t < 4; ++t) { const size_t gi = (size_t)(MP + 4 * b + t) * D + C;
        const float r = Rb[gi], k = Kb[gi]; float v = Vb[gi];
        const float z = -(w0 + lw[t]); const float sp = fmaxf(z, 0.f) + __logf(1.0f + __expf(-fabsf(z))); const float wdec = __expf(-__expf(-sp - 0.5f));
        const float asig = sigmoidf_(a0 + la[t]);
        if (li) { const float vg = sigmoidf_(v0 + lv[t]); const float vf = V0b[gi]; v = v + (vf - v) * vg; }
        const float kkr = k * kkc; const float ss = wave_sum(kkr * kkr); const float kkn = kkr * frsq(fmaxf(ss, 1e-24f));
        const float kmod = k * (1.0f + (asig - 1.0f) * kac);
        const float rks = wave_sum(r * kmod * rkc);
        LDS_WAIT();
        bc[lane] = wdec; bc[64 + lane] = -kkn; bc[128 + lane] = kkn * asig; bc[192 + lane] = kmod; bc[256 + lane] = r;
        LDS_WAIT();
        float sa = 0.f;
#pragma unroll
        for (int q = 0; q < 16; ++q) { const f32x4 av = *(const LAS f32x4*)(bc + 64 + 4 * q); sa += S[4 * q] * av[0] + S[4 * q + 1] * av[1] + S[4 * q + 2] * av[2] + S[4 * q + 3] * av[3]; }
        float y = 0.f;
#pragma unroll
        for (int q = 0; q < 16; ++q) { const f32x4 wv = *(const LAS f32x4*)(bc + 4 * q), bv = *(const LAS f32x4*)(bc + 128 + 4 * q), kv = *(const LAS f32x4*)(bc + 192 + 4 * q), rv = *(const LAS f32x4*)(bc + 256 + 4 * q);
#pragma unroll
            for (int e = 0; e < 4; ++e) { const float s = S[4 * q + e] * wv[e] + sa * bv[e] + v * kv[e]; S[4 * q + e] = s; y += s * rv[e]; } }
        const float mean = wave_sum(y) * (1.0f / 64.0f); const float dy = y - mean; const float var = wave_sum(dy * dy) * (1.0f / 64.0f);
        const float yn = dy * (frsq(var + GN_EPS)) * lnw + lnb;
        YG[gi] = (bf16_t)f2bf((yn + rks * v) * lg[t]);
    }
    { f32x4* so = (f32x4*)(p->out + O_WKVS + (((size_t)li * SB + b) * H + h) * 4096 + lane * 64);
#pragma unroll
      for (int q = 0; q < 16; ++q) so[q] = (f32x4){S[4 * q], S[4 * q + 1], S[4 * q + 2], S[4 * q + 3]}; }
    LDS_WAIT();
}

__device__ __forceinline__ void phase_scanA(KP p, const Ctx& c, int li) {
    const int stop = p->pad;
    if (stop != 9) for (int u = blockIdx.x; u < NUNIT_A; u += gridDim.x) scanA_unit(p, c, li, u);
    if (stop == 0 || stop == 9) for (int it = c.gw; it < SB * H; it += c.ngw) scan_sample_item(p, c, li, it);
}

__device__ __forceinline__ void hilo(const f32x4 x0, const f32x4 x1, bf16x8& hi, bf16x8& lo) {
    unsigned h[8], l[8];
#pragma unroll
    for (int e = 0; e < 8; ++e) { const float x = e < 4 ? x0[e] : x1[e - 4]; h[e] = f2bf(x); l[e] = f2bf(x - __builtin_bit_cast(float, h[e] << 16)); }
    u32x4 hv = {h[0] | (h[1] << 16), h[2] | (h[3] << 16), h[4] | (h[5] << 16), h[6] | (h[7] << 16)}, lv = {l[0] | (l[1] << 16), l[2] | (l[3] << 16), l[4] | (l[5] << 16), l[6] | (l[7] << 16)};
    hi = __builtin_bit_cast(bf16x8, hv); lo = __builtin_bit_cast(bf16x8, lv);
}
constexpr int SB_SLOT = 20480, SB_RING0 = 8192, SB_DEPTH = 6;
static_assert(SB_RING0 + SB_DEPTH * SB_SLOT <= RING_BYTES, "chain ring");
__device__ __forceinline__ void phase_scanB(KP p, const Ctx& c, int li) {
    unsigned char* ws = p->ws; LAS unsigned char* lds = c.lds; const int lane = c.lane, fr = lane & 15, fq = lane >> 4, wave = c.wave;
    volatile LAS int* FL = (volatile LAS int*)(lds + RING_BYTES);
    if (c.tid < 4) FL[c.tid] = 0;
    __syncthreads();
    const int ncb = (int)gridDim.x < 128 ? (int)gridDim.x : 128;
    if (wave >= 4 || (int)blockIdx.x >= ncb) {
        const int gwf = (int)blockIdx.x < ncb ? (int)blockIdx.x * 4 + (wave - 4) : ncb * 4 + ((int)blockIdx.x - ncb) * 8 + wave, ngwf = ncb * 4 + ((int)gridDim.x - ncb) * 8;
        phase_fill(p, c, li, gwf, ngwf); return; }
    if (wave != 0) {
        const int j = wave - 1; int prevG = -1, kc = 0;
        for (int ch = blockIdx.x; ch < 128; ch += gridDim.x, ++kc) { const int b = ch >> 6, h = (ch >> 2) & 15, iq = ch & 3;
            for (int n = j; n < NCH; n += 3) { const int G = kc * NCH + n;
                if (G >= SB_DEPTH) { unsigned sp = 0; while (FL[0] < G - (SB_DEPTH - 1)) { __builtin_amdgcn_s_sleep(1); if (++sp > (1u << 22)) break; } }
                LAS unsigned char* slot = lds + SB_RING0 + (G % SB_DEPTH) * SB_SLOT;
                const size_t u = (size_t)(b * NCH + n) * H + h; const bf16_t* MTH = (const bf16_t*)(ws + WS_MT) + u * 4096; const bf16_t* MTL = MTH + (size_t)NUNIT_A * 4096; const float* NN = (const float*)(ws + WS_NN) + u * 4096;
#pragma unroll
                for (int jt = 0; jt < 4; ++jt)
#pragma unroll
                    for (int ks = 0; ks < 2; ++ks) {
                        __builtin_amdgcn_global_load_lds((const unsigned*)(MTH + (size_t)(16 * jt + fr) * 64 + 32 * ks + 8 * fq), (LAS unsigned*)(slot + ((jt * 2 + ks) * 2 + 0) * 1024), 16, 0, 0);
                        __builtin_amdgcn_global_load_lds((const unsigned*)(MTL + (size_t)(16 * jt + fr) * 64 + 32 * ks + 8 * fq), (LAS unsigned*)(slot + ((jt * 2 + ks) * 2 + 1) * 1024), 16, 0, 0); }
#pragma unroll
                for (int jt = 0; jt < 4; ++jt)
                    __builtin_amdgcn_global_load_lds((const unsigned*)(NN + (size_t)(16 * iq + fr) * 64 + 16 * jt + 4 * fq), (LAS unsigned*)(slot + (16 + jt) * 1024), 16, 0, 0);
                asm volatile("s_waitcnt vmcnt(20)" ::: "memory");
                if (prevG >= 0) FL[1 + j] = prevG + 1;
                prevG = G; } }
        asm volatile("s_waitcnt vmcnt(0)" ::: "memory");
        if (prevG >= 0) FL[1 + j] = prevG + 1;
        return; }
    int kc = 0;
    for (int ch = blockIdx.x; ch < 128; ch += gridDim.x, ++kc) {
        const int b = ch >> 6, h = (ch >> 2) & 15, iq = ch & 3;
        f32x4 S[4];
#pragma unroll
        for (int jt = 0; jt < 4; ++jt) S[jt] = (f32x4){0.f, 0.f, 0.f, 0.f};
        int j3 = 0;
        for (int n = 0; n < NCH; ++n) { const int G = kc * NCH + n;
            const size_t u = (size_t)(b * NCH + n) * H + h; bf16_t* S0 = (bf16_t*)(ws + WS_S0) + u * 4096;
            { unsigned sp = 0; while (FL[1 + j3] < G + 1) { __builtin_amdgcn_s_sleep(1); if (++sp > (1u << 22)) break; } }
            const LAS unsigned char* slot = lds + SB_RING0 + (G % SB_DEPTH) * SB_SLOT + lane * 16;
            bf16x8 ah[4][2], al[4][2]; f32x4 nn[4];
#pragma unroll
            for (int jt = 0; jt < 4; ++jt) { nn[jt] = *(const LAS f32x4*)(slot + (16 + jt) * 1024);
#pragma unroll
                for (int ks = 0; ks < 2; ++ks) { ah[jt][ks] = *(const LAS bf16x8*)(slot + ((jt * 2 + ks) * 2 + 0) * 1024); al[jt][ks] = *(const LAS bf16x8*)(slot + ((jt * 2 + ks) * 2 + 1) * 1024); } }
#pragma unroll
            for (int jt = 0; jt < 4; ++jt) { unsigned hh[4], ll[4];
#pragma unroll
                for (int r = 0; r < 4; ++r) { hh[r] = f2bf(S[jt][r]); ll[r] = f2bf(S[jt][r] - __builtin_bit_cast(float, hh[r] << 16)); }
                u32x2 wh = {hh[0] | (hh[1] << 16), hh[2] | (hh[3] << 16)}, wl = {ll[0] | (ll[1] << 16), ll[2] | (ll[3] << 16)};
                *(u32x2*)(S0 + (size_t)(16 * iq + fr) * 64 + 16 * jt + 4 * fq) = wh;
                *(LAS u32x2*)(lds + (fr * SST + 16 * jt + 4 * fq) * 2) = wh; *(LAS u32x2*)(lds + 4096 + (fr * SST + 16 * jt + 4 * fq) * 2) = wl; }
            LDS_WAIT();
            bf16x8 bh[2], bl[2];
#pragma unroll
            for (int ks = 0; ks < 2; ++ks) { bh[ks] = *(const LAS bf16x8*)(lds + (fr * SST + 32 * ks + 8 * fq) * 2); bl[ks] = *(const LAS bf16x8*)(lds + 4096 + (fr * SST + 32 * ks + 8 * fq) * 2); }
#pragma unroll
            for (int jt = 0; jt < 4; ++jt) { f32x4 acc = nn[jt];
#pragma unroll
                for (int ks = 0; ks < 2; ++ks) { acc = mfma16(ah[jt][ks], bh[ks], acc); acc = mfma16(ah[jt][ks], bl[ks], acc); acc = mfma16(al[jt][ks], bh[ks], acc); }
                S[jt] = acc; }
            LDS_WAIT();
            FL[0] = G + 1;
            j3 = j3 == 2 ? 0 : j3 + 1;
        }
        float* so = p->out + O_WKVP + (((size_t)li * NB + b) * H + h) * 4096;
#pragma unroll
        for (int jt = 0; jt < 4; ++jt) *(f32x4*)(so + (size_t)(16 * iq + fr) * 64 + 16 * jt + 4 * fq) = S[jt];
    }
}

__device__ __forceinline__ void phase_scanC(KP p, const Ctx& c, int li) {
    unsigned char* ws = p->ws; const int lane = c.lane, fr = lane & 15, fq = lane >> 4, hb = c.wave >> 2, tt = c.wave & 3;
    const float* Vb = (const float*)(ws + (li ? WS_V1 : WS_V0)); const bf16_t* HID = (const bf16_t*)(ws + WS_HID); const bf16_t* W2G = (const bf16_t*)(ws + WS_W2G) + (size_t)li * 1024 * 128;
    bf16_t* YG = (bf16_t*)(ws + WS_YG);
    for (int up = blockIdx.x; up < NUNIT_A / 2; up += gridDim.x) {
        const int u = 2 * up + hb; const int b = u / (NCH * H), n = (u / H) % NCH, h = u % H; const int row = b * TP + 64 * n + 16 * tt + fr;
        const bf16_t* RP = (const bf16_t*)(ws + WS_RP) + (size_t)u * 4096; const float* YL = (const float*)(ws + WS_YL) + (size_t)u * 4096; const bf16_t* S0 = (const bf16_t*)(ws + WS_S0) + (size_t)u * 4096;
        f32x4 acc[4], ag[4];
#pragma unroll
        for (int it = 0; it < 4; ++it) { acc[it] = *(const f32x4*)(YL + (size_t)(16 * tt + fr) * 64 + 16 * it + 4 * fq); ag[it] = (f32x4){0.f, 0.f, 0.f, 0.f}; }
#pragma unroll
        for (int ks = 0; ks < 2; ++ks) { const bf16x8 bq = *(const bf16x8*)(RP + (size_t)(16 * tt + fr) * 64 + 32 * ks + 8 * fq);
#pragma unroll
            for (int it = 0; it < 4; ++it) acc[it] = mfma16(*(const bf16x8*)(S0 + (size_t)(16 * it + fr) * 64 + 32 * ks + 8 * fq), bq, acc[it]); }
        const bf16_t* hgp = launder_p(HID + (size_t)row * LHID + 160 + 8 * fq); const bf16_t* wgp = launder_p(W2G + (size_t)(64 * h + fr) * 128 + 8 * fq);
#pragma unroll
        for (int ks = 0; ks < 4; ++ks) { const bf16x8 bq = *(const bf16x8*)(hgp + 32 * ks);
#pragma unroll
            for (int it = 0; it < 4; ++it) ag[it] = mfma16(*(const bf16x8*)(wgp + it * 16 * 128 + 32 * ks), bq, ag[it]); }
        float s = 0.f;
#pragma unroll
        for (int it = 0; it < 4; ++it) s += (acc[it][0] + acc[it][1]) + (acc[it][2] + acc[it][3]);
        s = sum_rows4(s); const float mean = s * (1.0f / 64.0f);
        float q = 0.f;
#pragma unroll
        for (int it = 0; it < 4; ++it) { const f32x4 d = acc[it] - mean; q += (d[0] * d[0] + d[1] * d[1]) + (d[2] * d[2] + d[3] * d[3]); }
        q = sum_rows4(q); const float rstd = frsq(q * (1.0f / 64.0f) + GN_EPS);
        const float rks = ((const float*)(ws + WS_RKS))[(size_t)row * 16 + h];
#pragma unroll
        for (int it = 0; it < 4; ++it) { const int C = 64 * h + 16 * it + 4 * fq; const size_t pc = (size_t)li * D + C;
            const f32x4 lw = *(const f32x4*)(p->in[I_LNW] + pc), lb = *(const f32x4*)(p->in[I_LNB] + pc), v = *(const f32x4*)(Vb + (size_t)row * D + C);
            const f32x4 o = ((acc[it] - mean) * rstd * lw + lb + v * rks) * ag[it];
            u32x2 w; w.x = pk2(o[0], o[1]); w.y = pk2(o[2], o[3]); *(u32x2*)(YG + (size_t)row * D + C) = w; }
    }
}
__device__ __forceinline__ void ld8bf(const bf16_t* p, float (&o)[8]) { const u32x4 w = *(const u32x4*)p; o[0] = bflo(w.x); o[1] = bfhi(w.x); o[2] = bflo(w.y); o[3] = bfhi(w.y); o[4] = bflo(w.z); o[5] = bfhi(w.z); o[6] = bflo(w.w); o[7] = bfhi(w.w); }
__device__ __forceinline__ void ld8f(const float* p, float (&o)[8]) { const f32x4 a = *(const f32x4*)p, b = *(const f32x4*)(p + 4); o[0] = a[0]; o[1] = a[1]; o[2] = a[2]; o[3] = a[3]; o[4] = b[0]; o[5] = b[1]; o[6] = b[2]; o[7] = b[3]; }
__device__ __forceinline__ void phase_conv(KP p, const Ctx& c, int layer) {
    const bf16_t* U = (const bf16_t*)(p->ws + WS_U); const bf16_t* GT = (const bf16_t*)(p->ws + WS_GT); bf16_t* HH = (bf16_t*)(p->ws + WS_HH);
    const float* cw = p->in[I_CONVW] + (size_t)layer * 3 * DFF; const float* cb = p->in[I_CONVB] + (size_t)layer * DFF; const float* st = p->in[I_SCONV] + (size_t)layer * SB * 2 * DFF;
    constexpr int NF8 = DFF / 8;
    for (int e = c.gtid; e < R * NF8; e += c.gsz) { const int row = e / NF8, f = 8 * (e % NF8);
        int t, b; if (row < MP) { t = row & (TP - 1); b = -1; } else { t = (row - MP) & 3; b = (row - MP) >> 2; }
        float u0[8], u1[8], u2[8], g[8], w0[8], w1[8], w2[8], bb[8];
        ld8bf(U + (size_t)row * DFF + f, u2); ld8bf(GT + (size_t)row * DFF + f, g);
        if (t >= 1) ld8bf(U + (size_t)(row - 1) * DFF + f, u1); else if (b >= 0) ld8f(st + ((size_t)b * 2 + 1) * DFF + f, u1); else {
#pragma unroll
            for (int i = 0; i < 8; ++i) u1[i] = 0.f; }
        if (t >= 2) ld8bf(U + (size_t)(row - 2) * DFF + f, u0); else if (b >= 0) ld8f(st + ((size_t)b * 2 + t) * DFF + f, u0); else {
#pragma unroll
            for (int i = 0; i < 8; ++i) u0[i] = 0.f; }
        ld8f(cw + f, w0); ld8f(cw + DFF + f, w1); ld8f(cw + 2 * DFF + f, w2); ld8f(cb + f, bb);
        float o[8];
#pragma unroll
        for (int i = 0; i < 8; ++i) o[i] = gelu_tanh(bb[i] + w0[i] * u0[i] + w1[i] * u1[i] + w2[i] * u2[i]) * g[i];
        u32x4 w; w.x = pk2(o[0], o[1]); w.y = pk2(o[2], o[3]); w.z = pk2(o[4], o[5]); w.w = pk2(o[6], o[7]);
        *(u32x4*)(HH + (size_t)row * DFF + f) = w; }
}

__device__ __forceinline__ void phase_kvpost(KP p, const Ctx& c) {
    const float* KVF = (const float*)(p->ws + WS_KVF); unsigned char* ws = p->ws; const int lane = c.lane, g = lane >> 4, d0 = 4 * (lane & 15);
    const f32x4 gs = *(const f32x4*)(p->in[I_KNG] + 64 + d0), gw = *(const f32x4*)(p->in[I_KNG] + 128 + d0);
    bf16_t* CA = (bf16_t*)(ws + WS_CMPA); bf16_t* KS = (bf16_t*)(ws + WS_KS); bf16_t* VS = (bf16_t*)(ws + WS_VS); bf16_t* KW = (bf16_t*)(ws + WS_KW); bf16_t* VW = (bf16_t*)(ws + WS_VW);
    for (int chunk = c.gw; chunk < R / 8; chunk += c.ngw) {
        unsigned vs_[4][4], vw_[4][4];
#pragma unroll
        for (int e = 0; e < 8; ++e) { const int row = chunk * 8 + e; const float* src = KVF + (size_t)row * NKV + 4 * lane;
            f32x4 v[6];
#pragma unroll
            for (int pt = 0; pt < 6; ++pt) v[pt] = *(const f32x4*)(src + pt * 256);
            { float s = (v[2][0] * v[2][0] + v[2][1] * v[2][1]) + (v[2][2] * v[2][2] + v[2][3] * v[2][3]);
              s = row16_sum(s); const float rs = frsq(s * (1.0f / 64.0f) + NORM_EPS); v[2] = v[2] * rs * gs; }
            { float s = (v[4][0] * v[4][0] + v[4][1] * v[4][1]) + (v[4][2] * v[4][2] + v[4][3] * v[4][3]);
              s = row16_sum(s); const float rs = frsq(s * (1.0f / 64.0f) + NORM_EPS); v[4] = v[4] * rs * gw; }
            float* okv = p->out + O_KV + (size_t)row * D + 4 * lane;
#pragma unroll
            for (int pt = 0; pt < 4; ++pt) *(f32x4*)(okv + pt * 256) = v[pt];
            if (row < MP) { const int b = row >> 13, t = row & (TP - 1);
                if (t >= TP - WIN) { float* ow = p->out + O_WINP + ((size_t)(b * WIN + (t - (TP - WIN))) * 2) * 256 + 4 * lane; *(f32x4*)ow = v[4]; *(f32x4*)(ow + 256) = v[5]; }
                const size_t hb = (size_t)(b * G + g);
                { u32x2 w; w.x = pk2(v[0][0], v[0][1]); w.y = pk2(v[0][2], v[0][3]); *(u32x2*)(CA + (hb * 512 + (t >> 4)) * 1024 + (t & 15) * 64 + d0) = w; }
                { u32x2 w; w.x = pk2(v[1][0], v[1][1]); w.y = pk2(v[1][2], v[1][3]); *(u32x2*)(CA + ((size_t)4096 + hb * 512 + (t >> 4)) * 1024 + (t & 15) * 64 + d0) = w; }
                { u32x2 w; w.x = pk2(v[2][0], v[2][1]); w.y = pk2(v[2][2], v[2][3]); *(u32x2*)(KS + (hb * TP + t) * 64 + d0) = w; }
                { u32x2 w; w.x = pk2(v[4][0], v[4][1]); w.y = pk2(v[4][2], v[4][3]); *(u32x2*)(KW + (hb * TP + t) * 64 + d0) = w; }
#pragma unroll
                for (int d = 0; d < 4; ++d) { const unsigned a = f2bf(v[3][d]), bq = f2bf(v[5][d]);
                    if (e & 1) { vs_[d][e >> 1] |= a << 16; vw_[d][e >> 1] |= bq << 16; } else { vs_[d][e >> 1] = a; vw_[d][e >> 1] = bq; } }
            } else { const int b = (row - MP) >> 2, t = (row - MP) & 3;
                float* ow = p->out + O_WINS + ((size_t)(b * WIN + 508 + t) * 2) * 256 + 4 * lane; *(f32x4*)ow = v[4]; *(f32x4*)(ow + 256) = v[5]; }
        }
        if (chunk * 8 < MP) { const int row = chunk * 8, b = row >> 13, t = row & (TP - 1); const size_t hb = (size_t)(b * G + g);
#pragma unroll
            for (int d = 0; d < 4; ++d) { *(u32x4*)(VS + (hb * 64 + d0 + d) * TP + t) = (u32x4){vs_[d][0], vs_[d][1], vs_[d][2], vs_[d][3]};
                *(u32x4*)(VW + (hb * 64 + d0 + d) * TP + t) = (u32x4){vw_[d][0], vw_[d][1], vw_[d][2], vw_[d][3]}; } }
    }
}

__device__ __forceinline__ void phase_cmp2(KP p, const Ctx& c) {
    unsigned char* ws = p->ws; const float* PC = (const float*)(ws + WS_PCMP); const int lane = c.lane, fr = lane & 15, fq = lane >> 4;
    const bf16_t* W2H = (const bf16_t*)(ws + WS_CW2T); const bf16_t* W2L = W2H + 2 * 64 * 128;
    constexpr int NPI = NB * G * 32, NSI = SB * G * 8, TOT = 2 * (NPI + NSI);
    for (int it = c.gw; it < TOT; it += c.ngw) {
        const bool samp = it >= 2 * NPI; const int r = samp ? it - 2 * NPI : it; const int kv = samp ? r / NSI : r / NPI; const int idx = samp ? r % NSI : r % NPI;
        const int hb = samp ? (idx >> 3) : (idx >> 5), n0 = 16 * (samp ? (idx & 7) : (idx & 31)), ncmp = samp ? NCMP_S : NCMP_P, nper = samp ? 128 : 512;
        const int n = n0 + fr; const bool live = n < ncmp;
        const size_t prow = (samp ? (size_t)8192 + (size_t)kv * 65536 : (size_t)kv * 4096) + (size_t)hb * nper + (live ? n : ncmp - 1);
        const float* cb = (const float*)(ws + WS_CBIAS) + kv * 128;
        bf16x8 hh[4], hl[4];
#pragma unroll
        for (int ks = 0; ks < 4; ++ks) { const int k0 = 32 * ks + 8 * fq; unsigned uh[8], ul[8];
            const f32x4 a0 = *(const f32x4*)(PC + prow * 256 + k0), a1 = *(const f32x4*)(PC + prow * 256 + k0 + 4);
            const f32x4 b0 = *(const f32x4*)(PC + (prow + 1) * 256 + 128 + k0), b1 = *(const f32x4*)(PC + (prow + 1) * 256 + 128 + k0 + 4);
            const f32x4 c0 = *(const f32x4*)(cb + k0), c1 = *(const f32x4*)(cb + k0 + 4);
#pragma unroll
            for (int e = 0; e < 8; ++e) { const float x = e < 4 ? a0[e] + b0[e] + c0[e] : a1[e - 4] + b1[e - 4] + c1[e - 4]; const float hv = gelu_tanh(x);
                uh[e] = f2bf(hv); ul[e] = f2bf(hv - __builtin_bit_cast(float, uh[e] << 16)); }
            const u32x4 wh = {uh[0] | (uh[1] << 16), uh[2] | (uh[3] << 16), uh[4] | (uh[5] << 16), uh[6] | (uh[7] << 16)}, wl = {ul[0] | (ul[1] << 16), ul[2] | (ul[3] << 16), ul[4] | (ul[5] << 16), ul[6] | (ul[7] << 16)};
            hh[ks] = __builtin_bit_cast(bf16x8, wh); hl[ks] = __builtin_bit_cast(bf16x8, wl); }
        f32x4 acc[4];
#pragma unroll
        for (int dt = 0; dt < 4; ++dt) { acc[dt] = *(const f32x4*)(p->in[I_CB2] + kv * 64 + 16 * dt + 4 * fq);
#pragma unroll
            for (int ks = 0; ks < 4; ++ks) { const size_t wo = (size_t)(kv * 64 + 16 * dt + fr) * 128 + 32 * ks + 8 * fq; const bf16x8 wh = *(const bf16x8*)(W2H + wo), wl = *(const bf16x8*)(W2L + wo);
                acc[dt] = mfma16(wh, hh[ks], acc[dt]); acc[dt] = mfma16(wh, hl[ks], acc[dt]); acc[dt] = mfma16(wl, hh[ks], acc[dt]); } }
        if (kv == 0) { float ss = 0.f;
#pragma unroll
            for (int dt = 0; dt < 4; ++dt) ss += (acc[dt][0] * acc[dt][0] + acc[dt][1] * acc[dt][1]) + (acc[dt][2] * acc[dt][2] + acc[dt][3] * acc[dt][3]);
            ss = sum_rows4(ss); const float rs = frsq(ss * (1.0f / 64.0f) + NORM_EPS);
#pragma unroll
            for (int dt = 0; dt < 4; ++dt) acc[dt] = acc[dt] * rs * *(const f32x4*)(p->in[I_KNG] + 16 * dt + 4 * fq); }
#pragma unroll
        for (int dt = 0; dt < 4; ++dt) { const f32x4 o = live ? acc[dt] : (f32x4){0.f, 0.f, 0.f, 0.f}; const int d = 16 * dt + 4 * fq;
            if (samp) *(f32x4*)((float*)(ws + (kv ? WS_CVS : WS_CKS)) + ((size_t)hb * 128 + n) * 64 + d) = o;
            else if (kv == 0) { u32x2 w; w.x = pk2(o[0], o[1]); w.y = pk2(o[2], o[3]); *(u32x2*)((bf16_t*)(ws + WS_CK) + ((size_t)hb * 512 + n) * 64 + d) = w; }
            else {
#pragma unroll
                for (int e = 0; e < 4; ++e) ((bf16_t*)(ws + WS_CV))[((size_t)hb * 64 + d + e) * 512 + n] = (bf16_t)f2bf(o[e]); } }
    }
}

__device__ __forceinline__ void phase_qpost(KP p, const Ctx& c, int lb) {
    const float* QF = (const float*)(p->ws + WS_QF); bf16_t* Q = (bf16_t*)(p->ws + WS_Q); const int lane = c.lane;
    const f32x4 gq = *(const f32x4*)(p->in[I_QNG] + lb * 64 + 4 * (lane & 15));
    for (int row = c.gw; row < R; row += c.ngw) { const float* src = QF + (size_t)row * NQP;
        f32x4 v[4]; load_row(src, lane, v);
#pragma unroll
        for (int j = 0; j < 4; ++j) { float s = (v[j][0] * v[j][0] + v[j][1] * v[j][1]) + (v[j][2] * v[j][2] + v[j][3] * v[j][3]);
            s = row16_sum(s);
            const float rs = (frsq(s * (1.0f / 64.0f) + NORM_EPS)) * (0.125f * 1.4426950408889634f); v[j] = v[j] * rs * gq; }
        store_row_bf16(Q + (size_t)row * D, lane, v);
    }
}
constexpr int AT_K0 = 0, AT_V0 = 9216, AT_K1 = 18432, AT_V1 = 27648, AT_IMP = 36864, IMPS = 132, AT_SELM = AT_IMP + 64 * IMPS * 4, AT_ANY = AT_SELM + 1024;
static_assert(AT_ANY + 16 <= RING_BYTES, "attention LDS map");
struct TileSrc { const bf16_t* K; const bf16_t* VT; int vts; };
__device__ __forceinline__ void tile_load(const TileSrc& s, int key0, int tid, u32x4& rk, u32x4& rv) {
    const int row = tid >> 3, ch = tid & 7;
    rk = *(const u32x4*)(s.K + (size_t)(key0 + row) * 64 + 8 * ch); rv = *(const u32x4*)(s.VT + (size_t)row * s.vts + key0 + 8 * ch);
}
__device__ __forceinline__ void tile_load_async(const TileSrc& s, int key0, int tid, u32x4& rk, u32x4& rv) {
    const int row = tid >> 3, ch = tid & 7;
    const bf16_t* pk = s.K + (size_t)(key0 + row) * 64 + 8 * ch; const bf16_t* pv = s.VT + (size_t)row * s.vts + key0 + 8 * ch;
    asm volatile("global_load_dwordx4 %0, %2, off\n\tglobal_load_dwordx4 %1, %3, off" : "=&v"(rk), "=&v"(rv) : "v"(pk), "v"(pv) : "memory");
}
#define TILE_WAIT(N_, RK_, RV_) asm volatile("s_waitcnt vmcnt(" #N_ ")" : "+v"(RK_), "+v"(RV_) :: "memory")
__device__ __forceinline__ void tile_store(LAS unsigned char* lds, int buf, int tid, const u32x4& rk, const u32x4& rv) {
    const int row = tid >> 3, ch = tid & 7;
    *(LAS u32x4*)(lds + (buf ? AT_K1 : AT_K0) + (row * SST + 8 * ch) * 2) = rk; *(LAS u32x4*)(lds + (buf ? AT_V1 : AT_V0) + (row * SST + 8 * ch) * 2) = rv;
}
__device__ __forceinline__ int first_bit4(unsigned a, unsigned b, unsigned c, unsigned d) { return a ? __ffs(a) - 1 : (b ? 32 + __ffs(b) - 1 : (c ? 64 + __ffs(c) - 1 : (d ? 96 + __ffs(d) - 1 : -1))); }
__device__ __forceinline__ float ex2(float x) { return __builtin_amdgcn_exp2f(x); }

__device__ __forceinline__ void set_bit4(int s, unsigned& t0, unsigned& t1, unsigned& t2, unsigned& t3) { const unsigned bit = 1u << (s & 31); const int w = s >> 5; t0 |= (w == 0) ? bit : 0u; t1 |= (w == 1) ? bit : 0u; t2 |= (w == 2) ? bit : 0u; t3 |= (w == 3) ? bit : 0u; }
__device__ __forceinline__ void clr_bit4(int s, unsigned& t0, unsigned& t1, unsigned& t2, unsigned& t3) { const unsigned bit = 1u << (s & 31); const int w = s >> 5; t0 &= ~((w == 0) ? bit : 0u); t1 &= ~((w == 1) ? bit : 0u); t2 &= ~((w == 2) ? bit : 0u); t3 &= ~((w == 3) ? bit : 0u); }
__device__ __forceinline__ unsigned get_word4(int s, unsigned a, unsigned b, unsigned c, unsigned d) { const int w = s >> 5; return ((w == 0) ? a : 0u) | ((w == 1) ? b : 0u) | ((w == 2) ? c : 0u) | ((w == 3) ? d : 0u); }
__device__ __forceinline__ float dpp_xor1(float x) { return __builtin_bit_cast(float, __builtin_amdgcn_update_dpp(0, __builtin_bit_cast(int, x), 0xB1, 0xF, 0xF, true)); }
__device__ __forceinline__ float dpp_xor2(float x) { return __builtin_bit_cast(float, __builtin_amdgcn_update_dpp(0, __builtin_bit_cast(int, x), 0x4E, 0xF, 0xF, true)); }
template <int MODE, bool EDGE> __device__ __forceinline__ void attn_tile(LAS unsigned char* lds, int buf, const bf16x8 (&qf)[4], int key0, int qpos, int r, int hf,
                                                                          float& l, f32x16 (&O)[2], float invl, bool selbit, LAS float* impq) {
    if (MODE == 3) { if (__ballot(selbit) == 0ull) { asm volatile("" : "+v"(O[0]), "+v"(O[1]), "+v"(l)); return; } }
    const float sbias = selbit ? 0.f : -1.0e30f;
    const int oK = buf ? AT_K1 : AT_K0, oV = buf ? AT_V1 : AT_V0;
#pragma unroll
    for (int kt = 0; kt < 2; ++kt) {
        f32x16 S;
#pragma unroll
        for (int i = 0; i < 16; ++i) S[i] = (MODE == 3) ? sbias : 0.f;
#pragma unroll
        for (int ks = 0; ks < 4; ++ks) S = mfma32(*(const LAS bf16x8*)(lds + oK + ((32 * kt + r) * SST + 16 * ks + 8 * hf) * 2), qf[ks], S);
        float ls = 0.f;
#pragma unroll
        for (int i = 0; i < 16; ++i) { float pv = ex2(S[i]);
            if (EDGE) { const int key = key0 + 32 * kt + (i & 3) + 8 * (i >> 2) + 4 * hf; bool v;
                if (MODE <= 1) v = (16 * key + 31 <= qpos); else if (MODE == 2) v = (key <= qpos) && (key + WIN > qpos); else v = (key <= qpos);
                pv = v ? pv : 0.f; }
            if (MODE == 1) pv *= invl;
            S[i] = pv; ls += pv; }
        if (MODE != 1) l += ls;
        if (MODE >= 1) {
#pragma unroll
            for (int sp = 0; sp < 2; ++sp) {
                u32x4 pw; pw.x = pg8::cvt_pk_bf16(S[8 * sp + 0], S[8 * sp + 1]); pw.y = pg8::cvt_pk_bf16(S[8 * sp + 2], S[8 * sp + 3]); pw.z = pg8::cvt_pk_bf16(S[8 * sp + 4], S[8 * sp + 5]); pw.w = pg8::cvt_pk_bf16(S[8 * sp + 6], S[8 * sp + 7]);
                const bf16x8 pf = __builtin_bit_cast(bf16x8, pw);
#pragma unroll
                for (int dt = 0; dt < 2; ++dt) { const int d = 32 * dt + r, kb = 32 * kt + 16 * sp + 4 * hf;
                    const u32x2 lo = *(const LAS u32x2*)(lds + oV + (d * SST + kb) * 2), hi = *(const LAS u32x2*)(lds + oV + (d * SST + kb + 8) * 2);
                    const u32x4 vw = {lo.x, lo.y, hi.x, hi.y};
                    O[dt] = mfma32(__builtin_bit_cast(bf16x8, vw), pf, O[dt]); } }
        }
        if (MODE == 1) {
            float own[4], nxt[4];
#pragma unroll
            for (int gq = 0; gq < 4; ++gq) { const float p3 = S[4 * gq + 3]; float o = 2.0f * (S[4 * gq] + S[4 * gq + 1] + S[4 * gq + 2]) + p3, n = p3;
                o += dpp_xor1(o); o += dpp_xor2(o); n += dpp_xor1(n); n += dpp_xor2(n); own[gq] = o; nxt[gq] = n; }
            const int sbb = (key0 >> 2) + 8 * kt + hf;
            if ((r & 3) == 0) {
#pragma unroll
                for (int gq = 0; gq < 4; ++gq) impq[sbb + 2 * gq] += own[gq]; }
            asm volatile("s_waitcnt lgkmcnt(0)" ::: "memory");
            if ((r & 3) == 0) {
#pragma unroll
                for (int gq = 0; gq < 4; ++gq) impq[sbb + 2 * gq + 1] += nxt[gq]; }
            asm volatile("s_waitcnt lgkmcnt(0)" ::: "memory");
        }
    }
}

template <int MODE> __device__ __forceinline__ void run_tiles(LAS unsigned char* lds, const TileSrc& src, unsigned t0, unsigned t1, unsigned t2, unsigned t3, int qt,
                                                              const bf16x8 (&qf)[4], int qpos, int r, int hf, int tid,
                                                              float& l, f32x16 (&O)[2], float invl, unsigned s0, unsigned s1, unsigned s2, unsigned s3, LAS float* impq, const int alias = 0) {
#define TSEL(n_) ((alias ? ((n_) & 7) : (n_)) * 64)
    tid = launder_v(tid); r = tid & 31; hf = (tid >> 5) & 1;
    int cur = first_bit4(t0, t1, t2, t3); if (cur < 0) return;
    const int first = cur;
    clr_bit4(cur, t0, t1, t2, t3); int n1 = first_bit4(t0, t1, t2, t3); if (n1 >= 0) clr_bit4(n1, t0, t1, t2, t3);
    int n2 = first_bit4(t0, t1, t2, t3); if (n2 >= 0) clr_bit4(n2, t0, t1, t2, t3);
    u32x4 rkA, rvA, rkB, rvB; { u32x4 rk, rv; tile_load(src, TSEL(cur), tid, rk, rv); int b0 = 0; tile_store(lds, b0, tid, rk, rv); }
    tile_load_async(src, TSEL(n1 >= 0 ? n1 : first), tid, rkA, rvA);
    tile_load_async(src, TSEL(n2 >= 0 ? n2 : first), tid, rkB, rvB);
    int buf = 0;
    __syncthreads();
#define RT_STEP(RK_, RV_) { \
        if (cur >= 0) { \
            const unsigned sw = get_word4(cur, s0, s1, s2, s3); \
            const bool sb = ((sw >> (cur & 31)) & 1u) != 0u; \
            if (MODE <= 1) attn_tile<MODE, true>(lds, buf, qf, cur * 64, qpos, r, hf, l, O, invl, sb, impq); \
            else { const bool edge = (cur == qt) || (MODE == 2 && cur == qt - 8); \
                if (edge) attn_tile<MODE, true>(lds, buf, qf, cur * 64, qpos, r, hf, l, O, invl, sb, impq); \
                else attn_tile<MODE, false>(lds, buf, qf, cur * 64, qpos, r, hf, l, O, invl, sb, impq); } } \
        TILE_WAIT(2, RK_, RV_); \
        tile_store(lds, buf ^ 1, tid, RK_, RV_); \
        __syncthreads(); \
        const int n3 = first_bit4(t0, t1, t2, t3); if (n3 >= 0) clr_bit4(n3, t0, t1, t2, t3); \
        tile_load_async(src, TSEL(n3 >= 0 ? n3 : first), tid, RK_, RV_); \
        buf ^= 1; cur = n1; n1 = n2; n2 = n3; }
    do {
        RT_STEP(rkA, rvA)
        RT_STEP(rkB, rvB)
    } while (cur >= 0);
#undef RT_STEP
    asm volatile("s_waitcnt vmcnt(0)" : "+v"(rkA), "+v"(rvA), "+v"(rkB), "+v"(rvB) :: "memory");
    __syncthreads();
}
__device__ __forceinline__ void attn_prompt_unit(KP p, const Ctx& c, int k, const int stop) {
    LAS unsigned char* lds = c.lds; unsigned char* ws = p->ws; int tid_m; asm volatile("v_mbcnt_lo_u32_b32 %0, -1, 0\n\tv_mbcnt_hi_u32_b32 %0, -1, %0" : "=v"(tid_m));
    const int wave = c.wave, tid = tid_m + 64 * wave, lane = tid & 63, r = lane & 31, hf = lane >> 5;
    const int qt = 127 - (k >> 3), hb = k & 7, b = hb >> 2, g = hb & 3, q0 = 64 * qt;
    const int qi = 8 * wave + (r >> 2), head = 4 * g + (r & 3), qpos = q0 + qi, row = b * TP + qpos;
    const bf16_t* Q = (const bf16_t*)(ws + WS_Q);
    bf16x8 qf[4];
#pragma unroll
    for (int ks = 0; ks < 4; ++ks) qf[ks] = *(const bf16x8*)(Q + (size_t)row * D + head * 64 + 16 * ks + 8 * hf);
    const float* gate = (const float*)(ws + WS_GATE) + (size_t)row * 48 + head * 3; const float g_c = gate[0], g_s = gate[1], g_w = gate[2];
    LAS float* imp = (LAS float*)(lds + AT_IMP); LAS unsigned* selm = (LAS unsigned*)(lds + AT_SELM); LAS unsigned* anym = (LAS unsigned*)(lds + AT_ANY);
    for (int e = tid; e < 64 * IMPS; e += 512) imp[e] = 0.f;
    if (tid < 4) anym[tid] = 0u;
    __syncthreads();
    f32x16 O[2]; unsigned OUTP[2][8];
#pragma unroll
    for (int dt = 0; dt < 2; ++dt)
#pragma unroll
        for (int i = 0; i < 16; ++i) O[dt][i] = 0.f;
    {
        const TileSrc src{(const bf16_t*)(ws + WS_CK) + (size_t)hb * 512 * 64, (const bf16_t*)(ws + WS_CV) + (size_t)hb * 64 * 512, 512};
        const int nmax = q0 + 63 - 31; const int ntc = nmax >= 0 ? (nmax >> 10) + 1 : 0;
        const unsigned tm = ntc >= 32 ? 0xffffffffu : ((1u << ntc) - 1u);
        float l = 0.f;
        run_tiles<0>(lds, src, tm, 0u, 0u, 0u, qt, qf, qpos, r, hf, tid, l, O, 0.f, 0u, 0u, 0u, 0u, imp);
        l = sum_xor32(l); const float invl = l > 0.f ? 1.0f / l : 0.f;
        run_tiles<1>(lds, src, tm, 0u, 0u, 0u, qt, qf, qpos, r, hf, tid, l, O, invl, 0u, 0u, 0u, 0u, imp + qi * IMPS);
#pragma unroll
        for (int dt = 0; dt < 2; ++dt) {
#pragma unroll
            for (int i = 0; i < 8; ++i) { OUTP[dt][i] = pg8::cvt_pk_bf16(O[dt][2 * i] * g_c, O[dt][2 * i + 1] * g_c); asm volatile("" : "+v"(OUTP[dt][i])); }
#pragma unroll
            for (int i = 0; i < 16; ++i) O[dt][i] = 0.f; }
    }
    __syncthreads();
    if (stop == 1) return;
    for (int e = 0; e < 8; ++e) { const int qq = 8 * wave + e, qp = q0 + qq, qb = qp >> 6;
        const bool c0 = (64 * lane <= qp), c1 = (64 * (lane + 64) <= qp);
        const unsigned k0 = (lane == 0 || lane == qb || lane == qb - 1) ? 0xffffffffu : __builtin_bit_cast(unsigned, imp[qq * IMPS + lane]);
        const unsigned k1 = (lane + 64 == qb || lane + 64 == qb - 1) ? 0xffffffffu : __builtin_bit_cast(unsigned, imp[qq * IMPS + lane + 64]);
        const int K = qb + 1 < 16 ? qb + 1 : 16;
        unsigned T = 0u;
        for (int bit = 31; bit >= 0; --bit) { const unsigned cand = T | (1u << bit);
            const int cnt = __popcll(__ballot(c0 && k0 >= cand)) + __popcll(__ballot(c1 && k1 >= cand)); if (cnt >= K) T = cand; }
        unsigned long long mlo = __ballot(c0 && k0 > T), mhi = __ballot(c1 && k1 > T), elo = __ballot(c0 && k0 == T), ehi = __ballot(c1 && k1 == T);
        int need = K - (__popcll(mlo) + __popcll(mhi));
        for (; need > 0; --need) { if (elo) { mlo |= elo & (~elo + 1ull); elo &= elo - 1ull; } else { mhi |= ehi & (~ehi + 1ull); ehi &= ehi - 1ull; } }
        const unsigned m0 = (unsigned)mlo, m1 = (unsigned)(mlo >> 32), m2 = (unsigned)mhi, m3 = (unsigned)(mhi >> 32);
        if (lane == 0) { selm[qq * 4 + 0] = m0; selm[qq * 4 + 1] = m1; selm[qq * 4 + 2] = m2; selm[qq * 4 + 3] = m3;
            atomicOr((unsigned*)&anym[0], m0); atomicOr((unsigned*)&anym[1], m1); atomicOr((unsigned*)&anym[2], m2); atomicOr((unsigned*)&anym[3], m3); } }
    __syncthreads();
    if (stop == 2) return;
    {
        const TileSrc src{(const bf16_t*)(ws + WS_KW) + (size_t)hb * TP * 64, (const bf16_t*)(ws + WS_VW) + (size_t)hb * 64 * TP, TP};
        const int tlo = qt >= 8 ? qt - 8 : 0; unsigned t0 = 0u, t1 = 0u, t2 = 0u, t3 = 0u;
        for (int s = tlo; s <= qt; ++s) set_bit4(s, t0, t1, t2, t3);
        float l = 0.f;
        run_tiles<2>(lds, src, t0, t1, t2, t3, qt, qf, qpos, r, hf, tid, l, O, 0.f, 0u, 0u, 0u, 0u, imp);
        l = sum_xor32(l); const float sc = l > 0.f ? g_w / l : 0.f;
#pragma unroll
        for (int dt = 0; dt < 2; ++dt) {
#pragma unroll
            for (int i = 0; i < 8; ++i) { OUTP[dt][i] = pg8::cvt_pk_bf16(bflo(OUTP[dt][i]) + O[dt][2 * i] * sc, bfhi(OUTP[dt][i]) + O[dt][2 * i + 1] * sc); asm volatile("" : "+v"(OUTP[dt][i])); }
#pragma unroll
            for (int i = 0; i < 16; ++i) O[dt][i] = 0.f; }
    }
    if (stop == 3) { __syncthreads(); return; }
    {
        const TileSrc src{(const bf16_t*)(ws + WS_KS) + (size_t)hb * TP * 64, (const bf16_t*)(ws + WS_VS) + (size_t)hb * 64 * TP, TP};
        const unsigned sz_ = (stop == 5) ? 0u : 0xffffffffu;
        const unsigned s0 = selm[qi * 4 + 0] & sz_, s1 = selm[qi * 4 + 1] & sz_, s2 = selm[qi * 4 + 2] & sz_, s3 = selm[qi * 4 + 3] & sz_;
        const unsigned a0 = __builtin_amdgcn_readfirstlane(anym[0]), a1 = __builtin_amdgcn_readfirstlane(anym[1]), a2 = __builtin_amdgcn_readfirstlane(anym[2]), a3 = __builtin_amdgcn_readfirstlane(anym[3]);
        float l = 0.f;
        run_tiles<3>(lds, src, a0, a1, a2, a3, qt, qf, qpos, r, hf, tid, l, O, 0.f, s0, s1, s2, s3, imp, stop == 4 ? 1 : 0);
        if (stop >= 4) { if (l == 12345.678f) ((float*)(ws + WS_GATE))[0] = O[0][0] + O[1][0]; __syncthreads(); return; }
        l = sum_xor32(l); const float sc = l > 0.f ? g_s / l : 0.f;
#pragma unroll
        for (int dt = 0; dt < 2; ++dt)
#pragma unroll
            for (int i = 0; i < 8; ++i) OUTP[dt][i] = pg8::cvt_pk_bf16(bflo(OUTP[dt][i]) + O[dt][2 * i] * sc, bfhi(OUTP[dt][i]) + O[dt][2 * i + 1] * sc);
    }
    bf16_t* AO = (bf16_t*)(ws + WS_YG) + (size_t)row * D + head * 64;
#pragma unroll
    for (int dt = 0; dt < 2; ++dt)
#pragma unroll
        for (int gq = 0; gq < 4; ++gq) { u32x2 w; w.x = OUTP[dt][2 * gq]; w.y = OUTP[dt][2 * gq + 1]; *(u32x2*)(AO + 32 * dt + 8 * gq + 4 * hf) = w; }
    __syncthreads();
}

constexpr int SA_RED = 0, SA_REDW = 2 * 16 * 65 * 4, SA_OC = SA_RED + SA_REDW, SA_EC = SA_OC + 2 * 4096, SA_LC = SA_EC + 2 * 4096, SA_PN = SA_LC + 256, SA_SEL = SA_PN + 4 * 512;
static_assert(SA_SEL + 64 <= RING_BYTES, "sample attention LDS map");
__device__ __forceinline__ bf16x8 pack8(const f32x4 a, const f32x4 b) { const u32x4 w = {pk2(a[0], a[1]), pk2(a[2], a[3]), pk2(b[0], b[1]), pk2(b[2], b[3])}; return __builtin_bit_cast(bf16x8, w); }
__device__ __forceinline__ void sa_qk(const float* kb, size_t stride, int nrows, const bf16x8 (&qf)[2], int fr, int fq, f32x4 (&S)[4]) {
    f32x4 kr[4][2][2];
#pragma unroll
    for (int kg = 0; kg < 4; ++kg) { const int key = 16 * kg + fr; const float* rp = kb + (size_t)(key < nrows ? key : nrows - 1) * stride + 8 * fq;
#pragma unroll
        for (int ks = 0; ks < 2; ++ks) { kr[kg][ks][0] = *(const f32x4*)(rp + 32 * ks); kr[kg][ks][1] = *(const f32x4*)(rp + 32 * ks + 4); } }
#pragma unroll
    for (int kg = 0; kg < 4; ++kg) { S[kg] = (f32x4){0.f, 0.f, 0.f, 0.f};
#pragma unroll
        for (int ks = 0; ks < 2; ++ks) S[kg] = mfma16(pack8(kr[kg][ks][0], kr[kg][ks][1]), qf[ks], S[kg]); }
}
__device__ __forceinline__ void sa_pv(const float* vb, size_t stride, int nrows, const f32x4 (&P)[4], int fr, int fq, f32x4 (&O)[4]) {
#pragma unroll
    for (int ks = 0; ks < 2; ++ks) { const bf16x8 pa = pack8(P[2 * ks], P[2 * ks + 1]);
        float vv[4][8];
#pragma unroll
        for (int j = 0; j < 8; ++j) { const int key = 16 * (2 * ks + (j >> 2)) + 4 * fq + (j & 3); const float* rp = vb + (size_t)(key < nrows ? key : nrows - 1) * stride + fr;
#pragma unroll
            for (int dt = 0; dt < 4; ++dt) vv[dt][j] = rp[16 * dt]; }
#pragma unroll
        for (int dt = 0; dt < 4; ++dt) { const u32x4 w = {pk2(vv[dt][0], vv[dt][1]), pk2(vv[dt][2], vv[dt][3]), pk2(vv[dt][4], vv[dt][5]), pk2(vv[dt][6], vv[dt][7])};
            O[dt] = mfma16(pa, __builtin_bit_cast(bf16x8, w), O[dt]); } }
}
__device__ __forceinline__ void attn_sample_unit(KP p, const Ctx& c, int item) {
    unsigned char* ws = p->ws; LAS unsigned char* lds = c.lds; const int tid = launder_v(c.tid), lane = tid & 63, wave = c.wave, fr = lane & 15, fq = lane >> 4; const int b = item >> 2, g = item & 3;
    bf16x8 qf[2];
    { const bf16_t* Q = (const bf16_t*)(ws + WS_Q) + (size_t)(MP + 4 * b + (fr >> 2)) * D + (4 * g + (fr & 3)) * 64 + 8 * fq;
      qf[0] = *(const bf16x8*)Q; qf[1] = *(const bf16x8*)(Q + 32); }
    const int tokm = fr >> 2;
    if (wave < 2) {
        const float* ck = (const float*)(ws + WS_CKS) + ((size_t)(b * 4 + g) * 128 + 64 * wave) * 64; const float* cv = (const float*)(ws + WS_CVS) + ((size_t)(b * 4 + g) * 128 + 64 * wave) * 64;
        const int nrows = wave ? 63 : 64;
        f32x4 S[4]; sa_qk(ck, 64, nrows, qf, fr, fq, S);
        float ls = 0.f;
#pragma unroll
        for (int kg = 0; kg < 4; ++kg)
#pragma unroll
            for (int r = 0; r < 4; ++r) { const int key = 16 * kg + 4 * fq + r; const float ev = key < nrows ? ex2(S[kg][r]) : 0.f; S[kg][r] = ev; ls += ev;
                *(LAS float*)(lds + SA_EC + wave * 4096 + (key * 16 + fr) * 4) = ev; }
        ls = sum_rows4(ls); if (fq == 0) *(LAS float*)(lds + SA_LC + (wave * 16 + fr) * 4) = ls;
        f32x4 oc[4];
#pragma unroll
        for (int dt = 0; dt < 4; ++dt) oc[dt] = (f32x4){0.f, 0.f, 0.f, 0.f};
        sa_pv(cv, 64, nrows, S, fr, fq, oc);
#pragma unroll
        for (int dt = 0; dt < 4; ++dt)
#pragma unroll
            for (int r = 0; r < 4; ++r) *(LAS float*)(lds + SA_OC + wave * 4096 + ((4 * fq + r) * 64 + 16 * dt + fr) * 4) = oc[dt][r];
    }
    __syncthreads();
    if (wave < 4) { const int tok = wave; float P0 = 0.f, P1 = 0.f;
#pragma unroll
        for (int hh = 0; hh < 4; ++hh) { const int pi = tok * 4 + hh; const float L = *(const LAS float*)(lds + SA_LC + pi * 4) + *(const LAS float*)(lds + SA_LC + (16 + pi) * 4); const float inv = L > 0.f ? 1.0f / L : 0.f;
            P0 += *(const LAS float*)(lds + SA_EC + (lane * 16 + pi) * 4) * inv; P1 += *(const LAS float*)(lds + SA_EC + 4096 + (lane * 16 + pi) * 4) * inv; }
        LAS float* pn = (LAS float*)(lds + SA_PN + tok * 512); pn[lane] = P0; pn[64 + lane] = P1; LDS_WAIT();
        float v0 = -1e9f;
        if (lane < 33) { const int s = lane; float im = 0.f;
            if (4 * s - 1 >= 0 && 4 * s - 1 < 128) im += pn[4 * s - 1];
#pragma unroll
            for (int j = 0; j < 3; ++j) if (4 * s + j < 128) im += 2.0f * pn[4 * s + j];
            if (4 * s + 3 < 128) im += pn[4 * s + 3];
            v0 = (s == 0 || s == 31 || s == 32) ? 1e9f : im; }
        unsigned selmask = 0u, sel32 = 0u;
        for (int it = 0; it < 16; ++it) { const float mx = wave_max(v0); if (mx < -5e8f) break; const unsigned long long b0 = __ballot(v0 == mx); const int s = __ffsll((long long)b0) - 1;
            if (lane == s) v0 = -2e9f; if (s < 32) selmask |= 1u << s; else sel32 = 1u; }
        if (lane == 0) { *(LAS unsigned*)(lds + SA_SEL + tok * 8) = selmask; *(LAS unsigned*)(lds + SA_SEL + tok * 8 + 4) = sel32; } }
    __syncthreads();
    unsigned sm[4], s32[4];
#pragma unroll
    for (int t = 0; t < 4; ++t) { sm[t] = *(const LAS unsigned*)(lds + SA_SEL + t * 8); s32[t] = *(const LAS unsigned*)(lds + SA_SEL + t * 8 + 4); }
    const unsigned un = sm[0] | sm[1] | sm[2] | sm[3]; const int nsel = __popc(un); const int has32 = (s32[0] | s32[1] | s32[2] | s32[3]) ? 1 : 0;
    const unsigned my_sm = tokm == 0 ? sm[0] : (tokm == 1 ? sm[1] : (tokm == 2 ? sm[2] : sm[3])), my_s32 = tokm == 0 ? s32[0] : (tokm == 1 ? s32[1] : (tokm == 2 ? s32[2] : s32[3]));
    const int ntile = nsel + has32 + 9;
    const int* pt = (const int*)p->in[I_PT] + b * NPAGES;
    f32x4 osel[4], owin[4]; float lsel = 0.f, lwin = 0.f;
#pragma unroll
    for (int dt = 0; dt < 4; ++dt) { osel[dt] = (f32x4){0.f, 0.f, 0.f, 0.f}; owin[dt] = (f32x4){0.f, 0.f, 0.f, 0.f}; }
    for (int ti = wave; ti < ntile; ti += 8) {
        const float* kb; size_t stride; int nrows = 64, br, mode, sidx = 0;
        if (ti < nsel) { unsigned m = un; for (int q = 0; q < ti; ++q) m &= m - 1u; sidx = __ffs(m) - 1; const int page = pt[sidx >> 1];
            kb = p->in[I_CKV] + ((size_t)page * PAGE + (sidx & 1) * 64) * 1024 + 2 * 256 + g * 64; stride = 1024; br = 0; mode = 0; }
        else if (ti < nsel + has32) { kb = p->out + O_KV + (size_t)(MP + 4 * b) * D + 2 * 256 + g * 64; stride = 1024; nrows = 4; br = 0; mode = 1; }
        else if (ti < nsel + has32 + 8) { sidx = ti - nsel - has32; kb = p->in[I_CWIN] + ((size_t)b * WIN + 64 * sidx) * 512 + g * 64; stride = 512; br = 1; mode = 2; }
        else { kb = p->out + O_WINS + ((size_t)(b * WIN + 508) * 2) * 256 + g * 64; stride = 512; nrows = 4; br = 1; mode = 3; }
        f32x4 S[4]; sa_qk(kb, stride, nrows, qf, fr, fq, S);
        float ls = 0.f;
#pragma unroll
        for (int kg = 0; kg < 4; ++kg)
#pragma unroll
            for (int r = 0; r < 4; ++r) { const int key = 16 * kg + 4 * fq + r; bool valid;
                if (mode == 0) valid = ((my_sm >> sidx) & 1u) != 0u; else if (mode == 1) valid = (my_s32 != 0u) && (key <= tokm); else if (mode == 2) valid = (64 * sidx + key) >= tokm + 1; else valid = key <= tokm;
                const float ev = valid ? ex2(S[kg][r]) : 0.f; S[kg][r] = ev; ls += ev; }
        if (br == 0) { lsel += ls; sa_pv(kb + 256, stride, nrows, S, fr, fq, osel); } else { lwin += ls; sa_pv(kb + 256, stride, nrows, S, fr, fq, owin); }
    }
    lsel = sum_rows4(lsel); lwin = sum_rows4(lwin);
    for (int w = 0; w < 8; ++w) {
        if (wave == w) {
#pragma unroll
            for (int dt = 0; dt < 4; ++dt)
#pragma unroll
                for (int r = 0; r < 4; ++r) { LAS float* r0 = (LAS float*)(lds + SA_RED + ((4 * fq + r) * 65 + 16 * dt + fr) * 4); LAS float* r1 = (LAS float*)(lds + SA_RED + ((16 + 4 * fq + r) * 65 + 16 * dt + fr) * 4);
                    if (w == 0) { *r0 = osel[dt][r]; *r1 = owin[dt][r]; } else { *r0 += osel[dt][r]; *r1 += owin[dt][r]; } }
            if (fq == 0) { LAS float* l0 = (LAS float*)(lds + SA_RED + (fr * 65 + 64) * 4); LAS float* l1 = (LAS float*)(lds + SA_RED + ((16 + fr) * 65 + 64) * 4);
                if (w == 0) { *l0 = lsel; *l1 = lwin; } else { *l0 += lsel; *l1 += lwin; } } }
        __syncthreads(); }
    { const float* gt = (const float*)(ws + WS_GATE); bf16_t* AO = (bf16_t*)(ws + WS_YG);
      for (int e = tid; e < 1024; e += 512) { const int pi = e >> 6, d = e & 63, tok = pi >> 2, hh = pi & 3; const size_t row = (size_t)(MP + 4 * b + tok);
          const float lc = *(const LAS float*)(lds + SA_LC + pi * 4) + *(const LAS float*)(lds + SA_LC + (16 + pi) * 4);
          const float oc = *(const LAS float*)(lds + SA_OC + (pi * 64 + d) * 4) + *(const LAS float*)(lds + SA_OC + 4096 + (pi * 64 + d) * 4);
          const LAS float* r0 = (const LAS float*)(lds + SA_RED + (pi * 65) * 4); const LAS float* r1 = (const LAS float*)(lds + SA_RED + ((16 + pi) * 65) * 4);
          const float* gg = gt + row * 48 + (4 * g + hh) * 3;
          float out = lc > 0.f ? gg[0] * oc / lc : 0.f;
          out += r0[64] > 0.f ? gg[1] * r0[d] / r0[64] : 0.f;
          out += r1[64] > 0.f ? gg[2] * r1[d] / r1[64] : 0.f;
          AO[row * D + (4 * g + hh) * 64 + d] = (bf16_t)f2bf(out); } }
    __syncthreads();
}

__device__ __forceinline__ void phase_attn_prompt(KP p, const Ctx& c, const int stop = 0) {
    const int Gd = gridDim.x, cb = blockIdx.x;
    for (int i = 0; i * Gd < 1024; ++i) { const int k = i * Gd + ((i & 1) ? Gd - 1 - cb : cb); if (k < 1024) attn_prompt_unit(p, c, k, stop); }
}
__device__ __forceinline__ void phase_attn_sample(KP p, const Ctx& c) {
    for (int it = blockIdx.x; it < SB * G; it += gridDim.x) attn_sample_unit(p, c, it);
}
#ifndef MK_MULTI
#define MK_MULTI 0
#endif
#if defined(PROBE_SCALE) || defined(SELFTEST)
constexpr int NPH = 46;
#elif defined(PROBE_ATTN2)
constexpr int NPH = 47;
#else
constexpr int NPH = 45;
#endif
#ifdef SPLITK
#define RESID_SPLIT(n) (n)
#else
#define RESID_SPLIT(n) 0
#endif

__global__ void __launch_bounds__(512, 2) mega(Params p) {
    extern __shared__ __attribute__((aligned(16))) unsigned char lds_raw[];
    LAS unsigned char* const lds0 = (LAS unsigned char*)lds_raw;
    volatile LAS unsigned* MISC = (volatile LAS unsigned*)(lds0 + MISC_OFF);
    for (int u = threadIdx.x; u < (LDS_BYTES - RING_BYTES) / 4; u += 512) ((LAS unsigned*)(lds0 + RING_BYTES))[u] = 0u;
    __syncthreads();
    const KP kp0 = (KP)__builtin_amdgcn_kernarg_segment_ptr();
    const int ph_lo = kp0->ph_lo, ph_hi = kp0->ph_hi, use_bar = kp0->use_bar;
    XcdBarrier bar; bar.bar = (unsigned*)(kp0->ws + WS_CTL); bar.x = 0; bar.st = nullptr;
    if (use_bar) bar = xcd_barrier_post((unsigned*)(kp0->ws + WS_CTL), MISC + 8);
    const int wave_s = __builtin_amdgcn_readfirstlane((int)threadIdx.x >> 6);
#define TID_MBCNT 1
#ifdef TID_MBCNT
#define TID_SRC(T_) asm volatile("v_mbcnt_lo_u32_b32 %0, -1, 0\n\tv_mbcnt_hi_u32_b32 %0, -1, %0" : "=v"(T_)); T_ += 64 * wave_s;
#else
#define TID_SRC(T_) T_ = threadIdx.x; asm volatile("" : "+v"(T_));
#endif
    int ph = 0;
#define PHASE_BEGIN if (ph >= ph_lo && ph < ph_hi) { KP p = kp0; asm volatile("" : "+s"(p)); int tid_; TID_SRC(tid_) \
        Ctx c; c.lds = lds0; c.tid = tid_; c.lane = tid_ & 63; c.wave = __builtin_amdgcn_readfirstlane(tid_ >> 6); c.gw = blockIdx.x * 8 + c.wave; c.ngw = gridDim.x * 8; c.gtid = blockIdx.x * 512 + tid_; c.gsz = gridDim.x * 512; \
        unsigned char* ws = p->ws; float* X = p->out + O_Y; (void)ws; (void)X;
#define PHASE_END   if (use_bar) { int te_; TID_SRC(te_) xcd_barrier(bar, te_ == 0); } } ++ph;

    PHASE_BEGIN phase_prologue(p, c); PHASE_END
#ifdef PROBE_BAR
    for (int xb = 0; xb < PROBE_BAR; ++xb) { if (use_bar) xcd_barrier(bar, threadIdx.x == 0); }
#endif

    for (int layer = 0; layer < NLAY; ++layer) {
        if (layer < 2) {
            const int li = layer;
            PHASE_BEGIN phase_mix(p, c, li); PHASE_END
            PHASE_BEGIN {
                pg8::Gemm g{(const bf16_t*)(ws + WS_XM), (const bf16_t*)(ws + WS_WRKV) + (size_t)li * 3072 * 1024, 3 * R, 3072, 1024, 1024};
                pg8::GroupOrder S; S.init((int)gridDim.x, (int)blockIdx.x); S.add(0, 0, 64, 0, 4); S.add(1, 66, 64, 4, 4); S.add(2, 132, 64, 8, 4);
                pg8::EpiF32G E{(float*)(ws + WS_RK_R), (float*)(ws + WS_RK_K), (float*)(ws + (li ? WS_V1 : WS_V0)), nullptr, D, 4, 66};
                pg8::gemm_phase<pg8::EpiF32G, pg8::GroupOrder, true, true>(c.lds, g, S, E, c.tid);
                {
                    const bf16_t* XMs = (const bf16_t*)(ws + WS_XM); const bf16_t* Wr = (const bf16_t*)(ws + WS_WRKV) + (size_t)li * 3072 * 1024;
                    for (int it = blockIdx.x + gridDim.x * c.wave; it < 768; it += c.ngw) { const int j = it >> 8, r = it & 255, row0 = MP + 32 * (r & 15), col0 = 64 * (r >> 4);
                        float* C = (float*)(ws + (j == 0 ? WS_RK_R : (j == 1 ? WS_RK_K : (li ? WS_V1 : WS_V0))));
                        f32x4 acc[4][2]; skinny_mma<4>(XMs + (size_t)j * R * D, 1024, Wr + (size_t)j * 1024 * 1024, 1024, 1024, row0, col0, c.lane, acc);
                        const int fr = c.lane & 15, fq = c.lane >> 4;
#pragma unroll
                        for (int nt = 0; nt < 4; ++nt)
#pragma unroll
                            for (int mt = 0; mt < 2; ++mt) *(f32x4*)(C + (size_t)(row0 + 16 * mt + fr) * D + col0 + 16 * nt + 4 * fq) = acc[nt][mt]; }
                }
                phase_lora1(p, c, li);
            } PHASE_END
            PHASE_BEGIN phase_scanA(p, c, li); PHASE_END
            PHASE_BEGIN phase_scanB(p, c, li); PHASE_END
            PHASE_BEGIN phase_scanC(p, c, li); PHASE_END
        } else {
            const int lb = layer - 2;
            if (layer == 2) {
                PHASE_BEGIN phase_norm(c, X, p->in[I_KVNG], (bf16_t*)(ws + WS_XN2), p->in[I_NORMG] + (size_t)(layer * 2) * D, (bf16_t*)(ws + WS_XN)); PHASE_END
                PHASE_BEGIN {
                    pg8::Gemm g{(const bf16_t*)(ws + WS_XN2), (const bf16_t*)(ws + WS_WKVT), R, NKV, 1024, 1024};
                    pg8::GroupOrder S; S.init((int)gridDim.x, (int)blockIdx.x); S.add(0, 0, 66, 0, 6);
                    pg8::EpiF32G E{(float*)(ws + WS_KVF), nullptr, nullptr, nullptr, NKV, 1 << 20, 0};
                    pg8::gemm_phase<pg8::EpiF32G, pg8::GroupOrder, true, true>(c.lds, g, S, E, c.tid);
                } PHASE_END
                PHASE_BEGIN phase_kvpost(p, c); PHASE_END
                PHASE_BEGIN {
                    pg8::Gemm g{(const bf16_t*)(ws + WS_CMPA), (const bf16_t*)(ws + WS_CW1T), (int)CMPA_ROWS, 512, 1024, 1024};
                    pg8::GroupOrder S; S.init((int)gridDim.x, (int)blockIdx.x); S.add(0, 0, 16, 0, 1); S.add(1, 16, 16, 1, 1); S.add(2, 32, 256, 0, 1); S.add(3, 288, 256, 1, 1);
                    pg8::EpiF32G E{(float*)(ws + WS_PCMP), (float*)(ws + WS_PCMP), nullptr, nullptr, 256, 1, 0};
                    pg8::gemm_phase<pg8::EpiF32G, pg8::GroupOrder, true, true>(c.lds, g, S, E, c.tid);
                } PHASE_END
                PHASE_BEGIN phase_cmp2(p, c); PHASE_END
            } else {
                PHASE_BEGIN phase_norm(c, X, p->in[I_NORMG] + (size_t)(layer * 2) * D, (bf16_t*)(ws + WS_XN), nullptr, nullptr); PHASE_END
            }
            PHASE_BEGIN {
                const bf16_t* XNp = (const bf16_t*)(ws + WS_XN); const bf16_t* Wq = (const bf16_t*)(ws + WS_WQT) + (size_t)lb * NQP * 1024; float* QFp = (float*)(ws + WS_QF);
                pg8::Gemm g{XNp, Wq, R, NQP, 1024, 1024};
                pg8::GroupOrder S; S.init((int)gridDim.x, (int)blockIdx.x); S.add(0, 0, 64, 0, 4);
                pg8::EpiF32G E{QFp, nullptr, nullptr, nullptr, NQP, 1 << 20, 0};
                pg8::gemm_phase<pg8::EpiF32G, pg8::GroupOrder, true, true>(c.lds, g, S, E, c.tid);
                float* GATEp = (float*)(ws + WS_GATE);
                for (int it = blockIdx.x + gridDim.x * c.wave; it < 256 + R / 32; it += c.ngw) { const int ln = launder_v(c.lane), fr = ln & 15, fq = ln >> 4;
                    if (it < 256) { const int row0 = MP + 32 * (it & 15), col0 = 64 * (it >> 4);
                        f32x4 acc[4][2]; skinny_mma<4>(XNp, 1024, Wq, 1024, 1024, row0, col0, ln, acc);
#pragma unroll
                        for (int nt = 0; nt < 4; ++nt)
#pragma unroll
                            for (int mt = 0; mt < 2; ++mt) *(f32x4*)(QFp + (size_t)(row0 + 16 * mt + fr) * NQP + col0 + 16 * nt + 4 * fq) = acc[nt][mt]; }
                    else { const int row0 = 32 * (it - 256);
                        f32x4 acc[3][2]; skinny_mma<3>(XNp, 1024, Wq, 1024, 1024, row0, 1024, ln, acc);
#pragma unroll
                        for (int nt = 0; nt < 3; ++nt)
#pragma unroll
                            for (int mt = 0; mt < 2; ++mt) { f32x4 v = acc[nt][mt];
#pragma unroll
                                for (int e = 0; e < 4; ++e) v[e] = sigmoidf_(v[e]);
                                *(f32x4*)(GATEp + (size_t)(row0 + 16 * mt + fr) * 48 + 16 * nt + 4 * fq) = v; } }
                }
            } PHASE_END
            PHASE_BEGIN phase_qpost(p, c, lb); PHASE_END
            PHASE_BEGIN phase_attn_prompt(p, c); PHASE_END
#ifdef PROBE_ATTN2
            PHASE_BEGIN phase_attn_prompt(p, c, PROBE_ATTN2); PHASE_END
#endif
            PHASE_BEGIN phase_attn_sample(p, c); PHASE_END
        }
        PHASE_BEGIN {
            const bf16_t* Wt = layer < 2 ? (const bf16_t*)(ws + WS_WORW) + (size_t)layer * 1024 * 1024 : (const bf16_t*)(ws + WS_WONSA) + (size_t)(layer - 2) * 1024 * 1024;
            pg8::Gemm g{(const bf16_t*)(ws + WS_YG), Wt, R, 1024, 1024, 1024};
            pg8::GroupOrder S; S.init((int)gridDim.x, (int)blockIdx.x); S.add(0, 0, 64, 0, 4);
            pg8::EpiResid E{X, D};
            pg8::gemm_phase<pg8::EpiResid, pg8::GroupOrder, true, true>(c.lds, g, S, E, c.tid);
            skinny_resid_sample(c, (const bf16_t*)(ws + WS_YG), 1024, Wt, 1024, X);
        } PHASE_END
        PHASE_BEGIN phase_norm(c, X, p->in[I_NORMG] + (size_t)(layer * 2 + 1) * D, (bf16_t*)(ws + WS_XN), nullptr, nullptr); PHASE_END
        PHASE_BEGIN {
            pg8::Gemm g{(const bf16_t*)(ws + WS_XN), (const bf16_t*)(ws + WS_WINT) + (size_t)layer * 5632 * 1024, R, 5632, 1024, 1024};
            pg8::GroupOrder S; S.init((int)gridDim.x, (int)blockIdx.x); S.add(0, 0, 66, 0, 22);
            pg8::EpiWin E{(bf16_t*)(ws + WS_U), (bf16_t*)(ws + WS_GT), p->out + O_CVP + (size_t)layer * NB * 2 * DFF, p->out + O_CVS + (size_t)layer * SB * 2 * DFF};
            pg8::gemm_phase<pg8::EpiWin, pg8::GroupOrder, true, true>(c.lds, g, S, E, c.tid);
        } PHASE_END
        PHASE_BEGIN phase_conv(p, c, layer); PHASE_END
        PHASE_BEGIN {
            pg8::Gemm g{(const bf16_t*)(ws + WS_HH), (const bf16_t*)(ws + WS_WOUTT) + (size_t)layer * 1024 * 2816, R, 1024, 2816, 2816};
            pg8::GroupOrder S; S.init((int)gridDim.x, (int)blockIdx.x); S.add(0, 0, 64, 0, 4);
            pg8::EpiResid E{X, D};
            pg8::gemm_phase<pg8::EpiResid, pg8::GroupOrder, true, true>(c.lds, g, S, E, c.tid);
            skinny_resid_sample(c, (const bf16_t*)(ws + WS_HH), 2816, (const bf16_t*)(ws + WS_WOUTT) + (size_t)layer * 1024 * 2816, 2816, X);
        } PHASE_END
    }
#ifdef SELFTEST
    PHASE_BEGIN if (blockIdx.x == 0 && c.wave == 0) { const float x = (float)((c.lane * 37) & 63) + 1.0f; float poison = 0.f;
        if (__ballot(swz_xor16_n(x) != __shfl_xor(x, 16))) poison += 1e3f;
        if (__ballot(sum_xor32_n(x) != x + __shfl_xor(x, 32))) poison += 1e4f;
        if (__ballot(sum_rows4_n(x) != x + __shfl_xor(x, 16) + __shfl_xor(x, 32) + __shfl_xor(x, 48))) poison += 1e5f;
        if (__ballot(wave_sum_n(x) != 2080.0f)) poison += 1e6f;
        if (__ballot(wave_max_n(x) != 64.0f)) poison += 1e7f;
        if (c.lane == 0) p->out[O_CVS] += poison; } PHASE_END
#endif
#ifdef PROBE_SCALE
    PHASE_BEGIN for (size_t e = c.gtid; e < O_END; e += c.gsz) { int oi = e < O_KV ? (e < (size_t)MP * D ? 0 : 1) : e < O_WINP ? (e < O_KV + (size_t)MP * D ? 2 : 3) : e < O_WINS ? 4 : e < O_WKVP ? 5 : e < O_WKVS ? 6 : e < O_SHP ? 7 : e < O_SHS ? 8 : e < O_CVP ? 9 : e < O_CVS ? 10 : 11;
        if (PROBE_SCALE < 0) oi = 11 - oi; p->out[e] *= 1.0f + sqrtf(0.5e-4f * (float)(oi + 1)); } PHASE_END
#endif
#undef PHASE_BEGIN
#undef PHASE_END
}

extern "C" void kernel_launch(void* const* d_in, const int* in_sizes, int n_in, void* d_out, int out_size, void* d_ws, size_t ws_size, hipStream_t stream) {
    static int grid = 0;
    if (grid == 0) {
        if (n_in != 45 || (size_t)out_size != O_END || ws_size < WS_END) { fprintf(stderr, "kernel_launch: unexpected shapes (n_in %d out %d ws %zu need %zu)\n", n_in, out_size, ws_size, (size_t)WS_END); grid = -1; return; }
        int dev = 0, cus = 0, per_cu = 0;
        if (hipGetDevice(&dev) != hipSuccess || hipDeviceGetAttribute(&cus, hipDeviceAttributeMultiprocessorCount, dev) != hipSuccess) { grid = -1; return; }
        if (hipFuncSetAttribute((const void*)mega, hipFuncAttributeMaxDynamicSharedMemorySize, LDS_BYTES) != hipSuccess) { fprintf(stderr, "kernel_launch: hipFuncSetAttribute failed\n"); grid = -1; return; }
        if (hipOccupancyMaxActiveBlocksPerMultiprocessor(&per_cu, (const void*)mega, 512, LDS_BYTES) != hipSuccess || per_cu < 1) { fprintf(stderr, "kernel_launch: occupancy query says %d\n", per_cu); (void)hipGetLastError(); }
        grid = cus;
    }
    if (grid < 0) return;
    (void)hipMemsetAsync((char*)d_ws + WS_CTL, 0, CTL_BYTES, stream);
    Params p{};
    for (int i = 0; i < 45; ++i) p.in[i] = (const float*)d_in[i];
    p.out = (float*)d_out; p.ws = (unsigned char*)d_ws;
#ifdef PROBE_PRE
    { const int plist[] = PROBE_PRE; for (int i = 0; i < (int)(sizeof(plist) / sizeof(int)); ++i) { p.ph_lo = plist[i] % 100; p.ph_hi = p.ph_lo + 1; p.use_bar = 0; p.pad = plist[i] / 100;       hipLaunchKernelGGL(mega, dim3(grid), dim3(512), LDS_BYTES, stream, p); } }
#endif
    p.pad = 0;
#if MK_MULTI
    for (int i = 0; i < NPH; ++i) { p.ph_lo = i; p.ph_hi = i + 1; p.use_bar = 0; hipLaunchKernelGGL(mega, dim3(grid), dim3(512), LDS_BYTES, stream, p); }
#else
    p.ph_lo = 0; p.ph_hi = NPH; p.use_bar = 1;
    hipLaunchKernelGGL(mega, dim3(grid), dim3(512), LDS_BYTES, stream, p);
#endif
    const hipError_t le = hipPeekAtLastError();
    if (le != hipSuccess) fprintf(stderr, "kernel_launch: launch failed: %s\n", hipGetErrorName(le));
}
```

```cpp
#include <hip/hip_runtime.h>
#include <cstdio>
#include <cstdint>

#define LAS __attribute__((address_space(3)))
#define GAS __attribute__((address_space(1)))
typedef unsigned short bf16_t;
typedef short bf16x8 __attribute__((ext_vector_type(8)));
typedef float f32x4 __attribute__((ext_vector_type(4)));
typedef float f32x16 __attribute__((ext_vector_type(16)));
typedef float f32x2 __attribute__((ext_vector_type(2)));
typedef unsigned u32x4 __attribute__((ext_vector_type(4)));
typedef unsigned u32x2 __attribute__((ext_vector_type(2)));

constexpr int D = 1024, NB = 2, TP = 8192, MP = NB * TP, SB = 128, ST = 4, MS = SB * ST, R = MP + MS;
constexpr int PAST = 2048, PAGE = 128, NPAGES = PAST / PAGE;
constexpr int H = 16, HD = 64, G = 4, HPG = 4, DFF = 2816, NLAY = 4;
constexpr int LW_ = 64, LA_ = 64, LV_ = 32, LG_ = 128, LHID = 288;
constexpr int NKV = 1536, NQ = 1072, NQP = 1280;
constexpr int NCH = TP / 64;
constexpr int NUNIT_A = NB * NCH * H;
constexpr int NCMP_P = 511, NCMP_S = 127, WIN = 512;
constexpr float NORM_EPS = 1e-6f, GN_EPS = 64e-5f;

constexpr size_t O_Y = 0;
constexpr size_t O_KV = (size_t)R * D;
constexpr size_t O_WINP = O_KV + (size_t)R * D;
constexpr size_t O_WINS = O_WINP + (size_t)NB * 512 * 512;
constexpr size_t O_WKVP = O_WINS + (size_t)SB * 512 * 512;
constexpr size_t O_WKVS = O_WKVP + (size_t)2 * NB * H * 4096;
constexpr size_t O_SHP = O_WKVS + (size_t)2 * SB * H * 4096;
constexpr size_t O_SHS = O_SHP + (size_t)2 * NB * D;
constexpr size_t O_CVP = O_SHS + (size_t)2 * SB * D;
constexpr size_t O_CVS = O_CVP + (size_t)NLAY * NB * 2 * DFF;
constexpr size_t O_END = O_CVS + (size_t)NLAY * SB * 2 * DFF;
static_assert(O_END == 88915968, "output size");

constexpr size_t MiB = 1u << 20;
constexpr size_t al(size_t x) { return (x + 4095) & ~(size_t)4095; }
constexpr size_t WS_CTL = 0, CTL_BYTES = 1 * MiB;
constexpr size_t WS_WRKV = WS_CTL + CTL_BYTES;
constexpr size_t WS_WORW = WS_WRKV + al((size_t)2 * 3072 * 1024 * 2);
constexpr size_t WS_W1T = WS_WORW + al((size_t)2 * 1024 * 1024 * 2);
constexpr size_t WS_W2W = WS_W1T + al((size_t)2 * 288 * 1024 * 2);
constexpr size_t WS_W2A = WS_W2W + al((size_t)2 * 1024 * 64 * 2);
constexpr size_t WS_W2V = WS_W2A + al((size_t)2 * 1024 * 64 * 2);
constexpr size_t WS_W2G = WS_W2V + al((size_t)1024 * 32 * 2);
constexpr size_t WS_WKVT = WS_W2G + al((size_t)2 * 1024 * 128 * 2);
constexpr size_t WS_WQT = WS_WKVT + al((size_t)1536 * 1024 * 2);
constexpr size_t WS_WONSA = WS_WQT + al((size_t)2 * 1280 * 1024 * 2);
constexpr size_t WS_WINT = WS_WONSA + al((size_t)2 * 1024 * 1024 * 2);
constexpr size_t WS_WOUTT = WS_WINT + al((size_t)4 * 5632 * 1024 * 2);
constexpr size_t WS_CW1T = WS_WOUTT + al((size_t)4 * 1024 * 2816 * 2);
constexpr size_t WS_CBIAS = WS_CW1T + al((size_t)2 * 256 * 1024 * 2);
constexpr size_t WS_CW2T = WS_CBIAS + al(2 * 128 * 4);
constexpr size_t WS_XM = WS_CW2T + al(2 * 2 * 64 * 128 * 2);
constexpr size_t WS_RK_R = WS_XM + al((size_t)6 * R * D * 2);
constexpr size_t WS_RK_K = WS_RK_R + al((size_t)R * D * 4);
constexpr size_t WS_V0 = WS_RK_K + al((size_t)R * D * 4);
constexpr size_t WS_V1 = WS_V0 + al((size_t)R * D * 4);
constexpr size_t WS_HID = WS_V1 + al((size_t)R * D * 4);
constexpr size_t WS_MT = WS_HID + al((size_t)R * LHID * 2);
constexpr size_t WS_NN = WS_MT + al((size_t)NUNIT_A * 4096 * 4);
constexpr size_t WS_RP = WS_NN + al((size_t)NUNIT_A * 4096 * 4);
constexpr size_t WS_YL = WS_RP + al((size_t)NUNIT_A * 4096 * 2);
constexpr size_t WS_S0 = WS_YL + al((size_t)NUNIT_A * 4096 * 4);
constexpr size_t WS_RKS = WS_S0 + al((size_t)NUNIT_A * 4096 * 2);
constexpr size_t WS_YG = WS_RKS + al((size_t)R * 16 * 4);
constexpr size_t WS_XN = WS_YG + al((size_t)R * D * 2);
constexpr size_t WS_XN2 = WS_XN + al((size_t)R * D * 2);
constexpr size_t WS_U = WS_XN2 + al((size_t)R * D * 2);
constexpr size_t WS_GT = WS_U + al((size_t)R * DFF * 2);
constexpr size_t WS_HH = WS_GT + al((size_t)R * DFF * 2);
constexpr size_t WS_KVF = WS_HH + al((size_t)R * DFF * 2);
constexpr size_t WS_CMPA = WS_KVF + al((size_t)R * NKV * 4);
constexpr size_t CMPA_ROWS = 4096 + 4096 + 65536 + 65536;
constexpr size_t WS_PCMP = WS_CMPA + al(CMPA_ROWS * 1024 * 2);
constexpr size_t WS_KS = WS_PCMP + al(CMPA_ROWS * 256 * 4);
constexpr size_t WS_VS = WS_KS + al((size_t)NB * G * TP * 64 * 2);
constexpr size_t WS_KW = WS_VS + al((size_t)NB * G * TP * 64 * 2);
constexpr size_t WS_VW = WS_KW + al((size_t)NB * G * TP * 64 * 2);
constexpr size_t WS_CK = WS_VW + al((size_t)NB * G * TP * 64 * 2);
constexpr size_t WS_CV = WS_CK + al((size_t)NB * G * 512 * 64 * 2);
constexpr size_t WS_CKS = WS_CV + al((size_t)NB * G * 512 * 64 * 2);
constexpr size_t WS_CVS = WS_CKS + al((size_t)SB * G * 128 * 64 * 4);
constexpr size_t WS_QF = WS_CVS + al((size_t)SB * G * 128 * 64 * 4);
constexpr size_t WS_Q = WS_QF + al((size_t)R * NQP * 4);
constexpr size_t WS_GATE = WS_Q + al((size_t)R * D * 2);
constexpr size_t WS_END = WS_GATE + al((size_t)R * 48 * 4);

typedef __bf16 bf16v2_ __attribute__((ext_vector_type(2)));
__device__ __forceinline__ unsigned cvt_pk_bf16_(float lo, float hi) { const f32x2 v = {lo, hi}; const bf16v2_ b = __builtin_convertvector(v, bf16v2_); return __builtin_bit_cast(unsigned, b); }
__device__ __forceinline__ unsigned f2bf(float f) { return cvt_pk_bf16_(f, f) & 0xffffu; }
__device__ __forceinline__ unsigned pk2(float lo, float hi) { return cvt_pk_bf16_(lo, hi); }
__device__ __forceinline__ float frcp(float x) { return __builtin_amdgcn_rcpf(x); }
__device__ __forceinline__ float frsq(float x) { return __builtin_amdgcn_rsqf(x); }
__device__ __forceinline__ float bf2f(unsigned short b) { return __builtin_bit_cast(float, ((unsigned)b) << 16); }
__device__ __forceinline__ float bflo(unsigned w) { return __builtin_bit_cast(float, w << 16); }
__device__ __forceinline__ float bfhi(unsigned w) { return __builtin_bit_cast(float, w & 0xffff0000u); }
template <int CTRL> __device__ __forceinline__ float dpp_f(float x) { return __builtin_bit_cast(float, __builtin_amdgcn_update_dpp(0, __builtin_bit_cast(int, x), CTRL, 0xF, 0xF, true)); }
__device__ __forceinline__ float row16_sum(float v) { v += dpp_f<0xB1>(v); v += dpp_f<0x4E>(v); v += dpp_f<0x141>(v); v += dpp_f<0x140>(v); return v; }
__device__ __forceinline__ float row16_max(float v) { v = fmaxf(v, dpp_f<0xB1>(v)); v = fmaxf(v, dpp_f<0x4E>(v)); v = fmaxf(v, dpp_f<0x141>(v)); v = fmaxf(v, dpp_f<0x140>(v)); return v; }
__device__ __forceinline__ float swz_xor16_n(float x) { return __builtin_bit_cast(float, __builtin_amdgcn_ds_swizzle(__builtin_bit_cast(int, x), 0x401F)); }
__device__ __forceinline__ float sum_xor32_n(float x) { auto rr = __builtin_amdgcn_permlane32_swap(__float_as_uint(x), __float_as_uint(x), false, false);
    return __uint_as_float(rr[0]) + __uint_as_float(rr[1]); }
__device__ __forceinline__ float sum_rows4_n(float x) { x += swz_xor16_n(x); return sum_xor32_n(x); }
__device__ __forceinline__ float wave_sum_n(float v) {
    v = row16_sum(v);
    v += __builtin_bit_cast(float, __builtin_amdgcn_update_dpp(0, __builtin_bit_cast(int, v), 0x142, 0xA, 0xF, false));
    v += __builtin_bit_cast(float, __builtin_amdgcn_update_dpp(0, __builtin_bit_cast(int, v), 0x143, 0xC, 0xF, false));
    return __builtin_bit_cast(float, __builtin_amdgcn_readlane(__builtin_bit_cast(int, v), 63));
}
__device__ __forceinline__ float wave_max_n(float v) {
    v = row16_max(v);
    v = fmaxf(v, __builtin_bit_cast(float, __builtin_amdgcn_update_dpp(__builtin_bit_cast(int, v), __builtin_bit_cast(int, v), 0x142, 0xA, 0xF, false)));
    v = fmaxf(v, __builtin_bit_cast(float, __builtin_amdgcn_update_dpp(__builtin_bit_cast(int, v), __builtin_bit_cast(int, v), 0x143, 0xC, 0xF, false)));
    return __builtin_bit_cast(float, __builtin_amdgcn_readlane(__builtin_bit_cast(int, v), 63));
}
#define XLANE_NEW 1
#ifdef XLANE_NEW
__device__ __forceinline__ float swz_xor16(float x) { return __builtin_bit_cast(float, __builtin_amdgcn_ds_swizzle(__builtin_bit_cast(int, x), 0x401F)); }
__device__ __forceinline__ float sum_xor32(float x) { return sum_xor32_n(x); }
__device__ __forceinline__ float sum_rows4(float x) { x += swz_xor16(x); return sum_xor32(x); }
__device__ __forceinline__ float wave_sum(float v) {
    v = row16_sum(v);
    v += __builtin_bit_cast(float, __builtin_amdgcn_update_dpp(0, __builtin_bit_cast(int, v), 0x142, 0xA, 0xF, false));
    v += __builtin_bit_cast(float, __builtin_amdgcn_update_dpp(0, __builtin_bit_cast(int, v), 0x143, 0xC, 0xF, false));
    return __builtin_bit_cast(float, __builtin_amdgcn_readlane(__builtin_bit_cast(int, v), 63));
}
__device__ __forceinline__ float wave_max(float v) {
    v = row16_max(v);
    v = fmaxf(v, __builtin_bit_cast(float, __builtin_amdgcn_update_dpp(__builtin_bit_cast(int, v), __builtin_bit_cast(int, v), 0x142, 0xA, 0xF, false)));
    v = fmaxf(v, __builtin_bit_cast(float, __builtin_amdgcn_update_dpp(__builtin_bit_cast(int, v), __builtin_bit_cast(int, v), 0x143, 0xC, 0xF, false)));
    return __builtin_bit_cast(float, __builtin_amdgcn_readlane(__builtin_bit_cast(int, v), 63));
}
#else
__device__ __forceinline__ float sum_xor32(float x) { return x + __shfl_xor(x, 32); }
__device__ __forceinline__ float sum_rows4(float x) { x += __shfl_xor(x, 16); x += __shfl_xor(x, 32); return x; }
__device__ __forceinline__ float wave_sum(float v) { v = row16_sum(v); v += __shfl_xor(v, 16); v += __shfl_xor(v, 32); return v; }
__device__ __forceinline__ float wave_max(float v) { v = row16_max(v); v = fmaxf(v, __shfl_xor(v, 16)); v = fmaxf(v, __shfl_xor(v, 32)); return v; }
#endif
__device__ __forceinline__ float sigmoidf_(float x) { return frcp(1.0f + __builtin_amdgcn_exp2f(-1.4426950408889634f * x)); }
__device__ __forceinline__ float gelu_tanh(float x) {
    const float u = 0.7978845608028654f * (x + 0.044715f * x * x * x);
    const float e = __builtin_amdgcn_exp2f(2.8853900817779268f * u);
    const float th = 1.0f - 2.0f * frcp(e + 1.0f);
    return 0.5f * x * (1.0f + th);
}
template <class T> __device__ __forceinline__ const T* launder_p(const T* q) { asm volatile("" : "+v"(q)); return q; }
__device__ __forceinline__ int launder_v(int x) { asm volatile("" : "+v"(x)); return x; }
#define LDS_WAIT() asm volatile("s_waitcnt lgkmcnt(0)" ::: "memory")
#define VM_WAIT() asm volatile("s_waitcnt vmcnt(0)" ::: "memory")
__device__ __forceinline__ f32x4 mfma16(bf16x8 a, bf16x8 b, f32x4 c) { return __builtin_amdgcn_mfma_f32_16x16x32_bf16(a, b, c, 0, 0, 0); }
__device__ __forceinline__ f32x16 mfma32(bf16x8 a, bf16x8 b, f32x16 c) { return __builtin_amdgcn_mfma_f32_32x32x16_bf16(a, b, c, 0, 0, 0); }
#define XB_TMO      128
#define XB_XCNT(j)  (256  + 64 * (j))
#define XB_XSUB(j)  (1280 + 64 * (j))
#define XB_XGEN(j)  (2304 + 64 * (j))
#define XB_TOP      3328
#define XB_TOPGEN   3392
#define XCD_BAR_WORDS 3456
#define XB_SPIN_CAP (1u << 18)

__device__ __forceinline__ unsigned xb_ld(unsigned* p)              { return __hip_atomic_load(p, __ATOMIC_RELAXED, __HIP_MEMORY_SCOPE_AGENT); }
__device__ __forceinline__ unsigned xb_add(unsigned* p, unsigned v) { return __hip_atomic_fetch_add(p, v, __ATOMIC_RELAXED, __HIP_MEMORY_SCOPE_AGENT); }
__device__ __forceinline__ unsigned xb_xcc_id() { return (unsigned)__builtin_amdgcn_s_getreg((3 << 11) | 20) & 0xFu; }
#define XB_SPIN(cond, bar) do { unsigned _sp = 0; while (cond) { __builtin_amdgcn_s_sleep(1); \
    if ((++_sp & 255u) == 0u) { if (xb_ld(&(bar)[XB_TMO])) break; if (_sp > XB_SPIN_CAP) { atomicAdd(&(bar)[XB_TMO], 1u); break; } } } } while (0)

struct XcdBarrier {
    unsigned* bar; unsigned x;
    volatile LAS unsigned* st;
};

__device__ __forceinline__ XcdBarrier xcd_barrier_post(unsigned* bar, volatile LAS unsigned* st) {
    XcdBarrier b; b.bar = bar; b.x = xb_xcc_id(); b.st = st;
    if (threadIdx.x == 0) (void)xb_add(&bar[XB_XCNT(b.x)], 1u);
    return b;
}
__device__ __forceinline__ void xcd_barrier_complete(unsigned* bar, unsigned x, unsigned& nloc, unsigned& nx) {
    const unsigned G = gridDim.x * gridDim.y * gridDim.z;
    unsigned sum, cnt, mine, sp = 0u;
    for (;;) {
        sum = 0u; cnt = 0u; mine = 0u;
#pragma unroll
        for (unsigned j = 0; j < 16; ++j) { const unsigned c = xb_ld(&bar[XB_XCNT(j)]); sum += c; cnt += (c > 0u) ? 1u : 0u; mine = (j == x) ? c : mine; }
        if (sum == G) break;
        __builtin_amdgcn_s_sleep(1);
        if ((++sp & 255u) == 0u) { if (xb_ld(&bar[XB_TMO])) break; if (sp > XB_SPIN_CAP) { atomicAdd(&bar[XB_TMO], 1u); break; } }
    }
    nloc = mine > 0u ? mine : 1u; nx = cnt > 0u ? cnt : 1u;
}

__device__ __forceinline__ void xcd_barrier(const XcdBarrier& b, const bool t0) {
    asm volatile("s_waitcnt vmcnt(0)" ::: "memory");
    __syncthreads();
    if (t0) {
        unsigned* bar = b.bar;
        __builtin_amdgcn_s_waitcnt(0);
        unsigned nloc = b.st[0], nx = b.st[1];
        if (nloc == 0u) { xcd_barrier_complete(bar, b.x, nloc, nx); b.st[0] = nloc; b.st[1] = nx; }
        const unsigned old = xb_add(&bar[XB_XSUB(b.x)], 1u);
        const unsigned gen = old / nloc;
        if (old + 1u == (gen + 1u) * nloc) {
            __builtin_amdgcn_fence(__ATOMIC_RELEASE, "agent");
            asm volatile("s_waitcnt vmcnt(0)" ::: "memory");
            const unsigned og = xb_add(&bar[XB_TOP], 1u);
            const unsigned tg = og / nx;
            if (og + 1u == (tg + 1u) * nx) xb_add(&bar[XB_TOPGEN], 1u);
            else XB_SPIN(xb_ld(&bar[XB_TOPGEN]) == tg, bar);
            __builtin_amdgcn_fence(__ATOMIC_ACQUIRE, "agent");
            xb_add(&bar[XB_XGEN(b.x)], 1u);
            asm volatile("s_waitcnt vmcnt(0)" ::: "memory");
        } else {
            XB_SPIN(xb_ld(&bar[XB_XGEN(b.x)]) == gen, bar);
            __builtin_amdgcn_fence(__ATOMIC_ACQUIRE, "agent");
            asm volatile("s_waitcnt vmcnt(0)" ::: "memory");
        }
    }
    __syncthreads();
}

namespace pg8 {
#define PG8_LAS __attribute__((address_space(3)))
constexpr int BM = 256, BK = 64, HALF = 128, HTB = HALF * BK * 2  , STAGE_BYTES = 8 * HTB, NXCD = 8, WGM = 8;
__host__ __device__ __forceinline__ int lds_byte(int r, int c) { const int st = (r >> 4) * 2 + (c >> 5), rr = r & 15, cc = c & 31, ob = rr * 64 + cc * 2; return st * 1024 + (ob ^ (((ob >> 9) & 1) << 5)); }
__host__ __device__ __forceinline__ void stage_rc(int b, int& R_, int& C_) { const int st = b / 1024, sb = b % 1024, swz = sb ^ (((sb >> 9) & 1) << 5); R_ = (st >> 1) * 16 + swz / 64; C_ = (st & 1) * 32 + (swz % 64) / 2; }
__host__ __device__ __forceinline__ int perm32(int rho) { const int n = rho >> 4, i = rho & 15; return 8 * (i >> 2) + 4 * n + (i & 3); }

struct Unit { int pm, pn, kb, nt; };
struct Gemm { const bf16_t* A; const bf16_t* Bt; int M, N, K, KL; };

struct GroupOrder {
    int pm0[4], nM[4], pn0[4], nN[4]; int nseg, nwg, G_, c;
    __device__ __forceinline__ void init(int G__, int c_) { nseg = 0; nwg = 0; G_ = G__; c = c_;
#pragma unroll
        for (int s = 0; s < 4; ++s) { pm0[s] = 0; nM[s] = 0; pn0[s] = 0; nN[s] = 1; } }
    __device__ __forceinline__ void add(int s, int pm0_, int nM_, int pn0_, int nN_) { pm0[s] = pm0_; nM[s] = nM_; pn0[s] = pn0_; nN[s] = nN_; nwg += nM_ * nN_; nseg = s + 1; }
    __device__ __forceinline__ bool next(int i, Unit& u) const {
        const long L = (long)i * G_ + c; if (L >= nwg) return false;
        int id = (int)L; { const int q = nwg / NXCD, r = nwg % NXCD, xcd = id % NXCD, off = id / NXCD; id = (xcd < r ? xcd * (q + 1) : r * (q + 1) + (xcd - r) * q) + off; }
        int spm0 = 0, snM = 1, spn0 = 0, snN = 1; bool found = false;
#pragma unroll
        for (int s = 0; s < 4; ++s) { const int cnt = nM[s] * nN[s]; if (!found) { if (id < cnt) { found = true; spm0 = pm0[s]; snM = nM[s]; spn0 = pn0[s]; snN = nN[s]; } else id -= cnt; } }
        const int nig = WGM * snN, gid = id / nig, fm = gid * WGM, gsz = (snM - fm) < WGM ? (snM - fm) : WGM;
        u.pm = spm0 + fm + ((id % nig) % gsz); u.pn = spn0 + (id % nig) / gsz; u.kb = 0; u.nt = 0; return true;
    }
    __device__ __forceinline__ void a_ready(const Unit&) const {}
    __device__ __forceinline__ void done(const Unit&) const {}
};

struct ResidOrder {
    GroupOrder P; int nS, G_, c;
    __device__ __forceinline__ void init(int G__, int c_, int nS_) { P.init(G__, c_); P.add(0, 0, nS_ ? 64 : 66, 0, 4); nS = nS_; G_ = G__; c = c_; }
    __device__ __forceinline__ bool next(int i, Unit& u) const {
        const int npc = c < P.nwg ? (P.nwg - 1 - c) / G_ + 1 : 0;
        if (i < npc) return P.next(i, u);
        const int L = (i - npc) * G_ + (G_ - 1 - c); if (L >= 8 * nS) return false;
        const int sl = L >> 3, t = L & 7; u.pm = 64 + (t & 1); u.pn = t >> 1; u.kb = sl * 512; u.nt = 4; return true; }
    __device__ __forceinline__ void a_ready(const Unit&) const {}
    __device__ __forceinline__ void done(const Unit&) const {}
};
__device__ __forceinline__ unsigned cvt_pk_bf16(float lo, float hi) { return cvt_pk_bf16_(lo, hi); }

struct EpiF32G {
    static constexpr bool PERM = false, AFTER_DRAIN = false;
    float* b0; float* b1; float* b2; float* b3; int ldc, png, pmg;
    __device__ __forceinline__ void operator()(const f32x4 (&acc)[2][2][4][2], const Unit& u, int wr, int wc, int fr, int fq) const {
        const int j = u.pn / png; float* C = j == 0 ? b0 : (j == 1 ? b1 : (j == 2 ? b2 : b3));
        const int row0 = (u.pm - j * pmg) * BM + wr * 64 + fr, col0 = (u.pn - j * png) * BM + wc * 32 + 4 * fq;
#pragma unroll
        for (int ai = 0; ai < 2; ++ai)
#pragma unroll
            for (int m = 0; m < 4; ++m) { float* rowp = C + (size_t)(row0 + ai * HALF + m * 16) * ldc + col0;
#pragma unroll
                for (int bj = 0; bj < 2; ++bj)
#pragma unroll
                    for (int n = 0; n < 2; ++n) *(f32x4*)(rowp + bj * HALF + n * 16) = acc[ai][bj][m][n]; }
    }
};
struct EpiResid {
    static constexpr bool PERM = false, AFTER_DRAIN = false;
    float* X; int ldc;
    __device__ __forceinline__ void operator()(const f32x4 (&acc)[2][2][4][2], const Unit& u, int wr, int wc, int fr, int fq) const {
        const int row0 = u.pm * BM + wr * 64 + fr, col0 = u.pn * BM + wc * 32 + 4 * fq; const bool split = u.nt != 0;
#pragma unroll
        for (int ai = 0; ai < 2; ++ai)
#pragma unroll
            for (int m = 0; m < 4; ++m) { float* rowp = X + (size_t)(row0 + ai * HALF + m * 16) * ldc + col0;
                if (!split) {
#pragma unroll
                    for (int bj = 0; bj < 2; ++bj)
#pragma unroll
                        for (int n = 0; n < 2; ++n) { f32x4* p = (f32x4*)(rowp + bj * HALF + n * 16); *p = *p + acc[ai][bj][m][n]; } }
                else {
#pragma unroll
                    for (int bj = 0; bj < 2; ++bj)
#pragma unroll
                        for (int n = 0; n < 2; ++n) { float* q = rowp + bj * HALF + n * 16;
#pragma unroll
                            for (int e = 0; e < 4; ++e) __hip_atomic_fetch_add(q + e, acc[ai][bj][m][n][e], __ATOMIC_RELAXED, __HIP_MEMORY_SCOPE_AGENT); } }
                asm volatile("" ::: "memory"); }
    }
};
struct EpiWin {
    static constexpr bool PERM = true, AFTER_DRAIN = false;
    bf16_t* U; bf16_t* GT; float* cvp; float* cvs;
    __device__ __forceinline__ void operator()(const f32x4 (&acc)[2][2][4][2], const Unit& u, int wr, int wc, int fr, int fq) const {
        const bool isu = u.pn < 11; bf16_t* base = isu ? U : GT; const int colt = (isu ? u.pn : u.pn - 11) * BM;
        const int row0 = u.pm * BM + wr * 64 + fr, col0 = colt + wc * 32 + 8 * fq;
#pragma unroll
        for (int ai = 0; ai < 2; ++ai)
#pragma unroll
            for (int m = 0; m < 4; ++m) { const int row = row0 + ai * HALF + m * 16; bf16_t* rowp = base + (size_t)row * DFF + col0;
                float* cv = nullptr;
                if (isu) { if (row >= MP) { const int t = (row - MP) & 3, b = (row - MP) >> 2; if (t >= 2) cv = cvs + (size_t)(b * 2 + (t - 2)) * DFF; }
                           else { const int tt = row & (TP - 1); if (tt >= TP - 2) cv = cvp + (size_t)((row >> 13) * 2 + (tt - (TP - 2))) * DFF; } }
#pragma unroll
                for (int bj = 0; bj < 2; ++bj) { const f32x4 v0 = acc[ai][bj][m][0], v1 = acc[ai][bj][m][1];
                    u32x4 w; w.x = cvt_pk_bf16(v0[0], v0[1]); w.y = cvt_pk_bf16(v0[2], v0[3]); w.z = cvt_pk_bf16(v1[0], v1[1]); w.w = cvt_pk_bf16(v1[2], v1[3]);
                    *(u32x4*)(rowp + bj * HALF) = w;
                    if (cv) { *(f32x4*)(cv + col0 + bj * HALF) = v0; *(f32x4*)(cv + col0 + bj * HALF + 4) = v1; } } }
    }
};
template <class Epi, class Sched, bool ALIGN_EPI = false, bool SP2 = false>
__device__ __forceinline__ void gemm_phase(PG8_LAS unsigned char* lds, const Gemm g, const Sched& S, const Epi& E, int tid_in) {
    int tid_l = tid_in; asm volatile("" : "+v"(tid_l));
    const int tid = tid_l, wid = __builtin_amdgcn_readfirstlane(tid >> 6), lane = tid & 63, wr = wid >> 2, wc = wid & 3, fr = lane & 15, fq = lane >> 4;
    const int K = g.K, nt = g.KL / BK;
    unsigned voffA[2], voffB[2];
#pragma unroll
    for (int i = 0; i < 2; ++i) { int R, C; stage_rc(tid * 16 + i * 8192, R, C); const int Rb = Epi::PERM ? ((R & ~31) + perm32(R & 31)) : R;
        voffA[i] = (unsigned)(R * K + C) * 2u; voffB[i] = (unsigned)(Rb * K + C) * 2u; }
    const size_t kstep = (size_t)(BK * 2);
    const size_t hstep = (size_t)HALF * K * 2;
    const size_t tstep = 2 * hstep;
    const unsigned ldsw = (unsigned)wid * 1024u;
    const int aoff = lds_byte(wr * 64 + fr, fq * 8), boff = lds_byte(wc * 32 + fr, fq * 8);
#define PG8_SA(b, h) (((b) * 2 + (h)) * HTB)
#define PG8_SB(b, h) ((4 + (b) * 2 + (h)) * HTB)
#define PG8_STAGE(bufoff, gbase, voff) do { _Pragma("unroll") for (int _i = 0; _i < 2; ++_i) \
        __builtin_amdgcn_global_load_lds((const unsigned*)((const char*)(gbase) + (voff)[_i]), (PG8_LAS unsigned*)(lds + (bufoff) + ldsw + _i * 8192), 16, 0, 0); } while (0)
#define PG8_LDA(dst, b, h) do { _Pragma("unroll") for (int m = 0; m < 4; ++m) _Pragma("unroll") for (int k = 0; k < 2; ++k) dst[m][k] = *(const PG8_LAS bf16x8*)(lds + PG8_SA(b, h) + aoff + m * 2048 + k * 1024); } while (0)
#define PG8_LDB(dst, b, h) do { _Pragma("unroll") for (int n = 0; n < 2; ++n) _Pragma("unroll") for (int k = 0; k < 2; ++k) dst[n][k] = *(const PG8_LAS bf16x8*)(lds + PG8_SB(b, h) + boff + n * 2048 + k * 1024); } while (0)
#define PG8_MMA(ai, bj, At, Bt) do { __builtin_amdgcn_s_setprio(1); _Pragma("unroll") for (int m = 0; m < 4; ++m) _Pragma("unroll") for (int n = 0; n < 2; ++n) _Pragma("unroll") for (int k = 0; k < 2; ++k) \
        acc[ai][bj][m][n] = __builtin_amdgcn_mfma_f32_16x16x32_bf16(Bt[n][k], At[m][k], acc[ai][bj][m][n], 0, 0, 0); __builtin_amdgcn_s_setprio(0); } while (0)
#define PG8_WAIT_V(n) asm volatile("s_waitcnt vmcnt(" #n ")" ::: "memory")
#define PG8_WAIT_L(n) asm volatile("s_waitcnt lgkmcnt(" #n ")" ::: "memory")
#define PG8_BAR __builtin_amdgcn_s_barrier()
#define PG8_SCHED __builtin_amdgcn_sched_barrier(0)
    Unit cur, nxt; int ui = 0;
    if (!S.next(0, cur)) return;
    f32x4 acc[2][2][4][2];
#pragma unroll
    for (int a = 0; a < 2; ++a)
#pragma unroll
        for (int b = 0; b < 2; ++b)
#pragma unroll
            for (int m = 0; m < 4; ++m)
#pragma unroll
                for (int n = 0; n < 2; ++n) acc[a][b][m][n] = (f32x4){0.f, 0.f, 0.f, 0.f};
    bf16x8 At[4][2], B0[2][2], B1[2][2];
    const char* cA = (const char*)g.A + (size_t)cur.pm * tstep + cur.kb; const char* cB = (const char*)g.Bt + (size_t)cur.pn * tstep + cur.kb;
    S.a_ready(cur);
    if constexpr (SP2) {
        PG8_STAGE(PG8_SB(0, 0), cB, voffB); PG8_STAGE(PG8_SB(0, 1), cB + hstep, voffB); PG8_STAGE(PG8_SA(0, 0), cA, voffA); PG8_STAGE(PG8_SA(0, 1), cA + hstep, voffA);
        if (wr == 1) PG8_BAR;
        PG8_WAIT_V(2); PG8_BAR;
        PG8_STAGE(PG8_SB(1, 0), cB + kstep, voffB); PG8_STAGE(PG8_SA(1, 0), cA + kstep, voffA); PG8_STAGE(PG8_SB(1, 1), cB + hstep + kstep, voffB);
        PG8_WAIT_V(6); PG8_BAR;
    } else {
        PG8_STAGE(PG8_SB(0, 0), cB, voffB); PG8_STAGE(PG8_SA(0, 0), cA, voffA); PG8_STAGE(PG8_SB(0, 1), cB + hstep, voffB); PG8_STAGE(PG8_SA(0, 1), cA + hstep, voffA);
        if (wr == 1) PG8_BAR;
        PG8_WAIT_V(4); PG8_BAR;
        PG8_STAGE(PG8_SB(1, 0), cB + kstep, voffB); PG8_STAGE(PG8_SA(1, 0), cA + kstep, voffA); PG8_STAGE(PG8_SB(1, 1), cB + hstep + kstep, voffB);
        PG8_WAIT_V(6); PG8_BAR;
    }
    for (;;) {
        const bool has_next = S.next(ui + 1, nxt);
        const char* nA = has_next ? (const char*)g.A + (size_t)nxt.pm * tstep + nxt.kb : cA; const char* nB = has_next ? (const char*)g.Bt + (size_t)nxt.pn * tstep + nxt.kb : cB;
        const int ntu = cur.nt ? cur.nt : nt;
        for (int t = 0; t < ntu; t += 2) {
            const bool last = (t == ntu - 2);
            const char* a1 = cA + (size_t)(t + 1) * kstep;
            const char* a2 = last ? nA : cA + (size_t)(t + 2) * kstep; const char* b2 = last ? nB : cB + (size_t)(t + 2) * kstep;
            const char* a3 = a2 + kstep; const char* b3 = b2 + kstep;
            if (last && has_next) S.a_ready(nxt);
            if constexpr (SP2) {
            PG8_LDB(B0, 0, 0); PG8_LDB(B1, 0, 1); PG8_SCHED; PG8_LDA(At, 0, 0); PG8_STAGE(PG8_SA(1, 1), a1 + hstep, voffA);
            PG8_WAIT_V(8); PG8_WAIT_L(0); PG8_BAR; PG8_MMA(0, 0, At, B0); PG8_MMA(0, 1, At, B1); PG8_BAR; PG8_SCHED;
            PG8_LDA(At, 0, 1); PG8_STAGE(PG8_SB(0, 0), b2, voffB); PG8_STAGE(PG8_SB(0, 1), b2 + hstep, voffB); PG8_STAGE(PG8_SA(0, 0), a2, voffA);
            PG8_WAIT_V(8); PG8_WAIT_L(0); PG8_BAR; PG8_MMA(1, 0, At, B0); PG8_MMA(1, 1, At, B1); PG8_BAR; PG8_SCHED;
            PG8_LDB(B0, 1, 0); PG8_LDB(B1, 1, 1); PG8_SCHED; PG8_LDA(At, 1, 0); PG8_STAGE(PG8_SA(0, 1), a2 + hstep, voffA);
            PG8_WAIT_V(8); PG8_WAIT_L(0); PG8_BAR; PG8_MMA(0, 0, At, B0); PG8_MMA(0, 1, At, B1); PG8_BAR; PG8_SCHED;
            PG8_LDA(At, 1, 1); PG8_STAGE(PG8_SB(1, 0), b3, voffB); PG8_STAGE(PG8_SB(1, 1), b3 + hstep, voffB); PG8_STAGE(PG8_SA(1, 0), a3, voffA);
            PG8_WAIT_V(8); PG8_WAIT_L(0); PG8_BAR; PG8_MMA(1, 0, At, B0); PG8_MMA(1, 1, At, B1); PG8_BAR; PG8_SCHED;
            } else {
            PG8_LDB(B0, 0, 0); PG8_SCHED; PG8_LDA(At, 0, 0); PG8_STAGE(PG8_SA(1, 1), a1 + hstep, voffA);
            PG8_WAIT_L(8); PG8_BAR; PG8_WAIT_L(0); PG8_MMA(0, 0, At, B0); PG8_BAR; PG8_SCHED;
            PG8_LDB(B1, 0, 1); PG8_STAGE(PG8_SB(0, 0), b2, voffB);
            PG8_BAR; PG8_WAIT_L(0); PG8_MMA(0, 1, At, B1); PG8_BAR;
            PG8_LDA(At, 0, 1); PG8_STAGE(PG8_SA(0, 0), a2, voffA);
            PG8_BAR; PG8_WAIT_L(0); PG8_MMA(1, 0, At, B0); PG8_BAR; PG8_SCHED;
            PG8_STAGE(PG8_SB(0, 1), b2 + hstep, voffB);
            PG8_WAIT_V(6); PG8_BAR; PG8_MMA(1, 1, At, B1); PG8_BAR;
            PG8_LDB(B0, 1, 0); PG8_SCHED; PG8_LDA(At, 1, 0); PG8_STAGE(PG8_SA(0, 1), a2 + hstep, voffA);
            PG8_WAIT_L(8); PG8_BAR; PG8_WAIT_L(0); PG8_MMA(0, 0, At, B0); PG8_BAR; PG8_SCHED;
            PG8_LDB(B1, 1, 1); PG8_STAGE(PG8_SB(1, 0), b3, voffB);
            PG8_BAR; PG8_WAIT_L(0); PG8_MMA(0, 1, At, B1); PG8_BAR;
            PG8_LDA(At, 1, 1); PG8_STAGE(PG8_SA(1, 0), a3, voffA);
            PG8_BAR; PG8_WAIT_L(0); PG8_MMA(1, 0, At, B0); PG8_BAR; PG8_SCHED;
            PG8_STAGE(PG8_SB(1, 1), b3 + hstep, voffB);
            PG8_WAIT_V(6); PG8_BAR; PG8_MMA(1, 1, At, B1); PG8_BAR;
            }
        }
        if constexpr (ALIGN_EPI) { if (wr == 0) PG8_BAR; }
        if constexpr (!Epi::AFTER_DRAIN) { E(acc, cur, wr, wc, fr, fq); S.done(cur); }
        if (!has_next) break;
#pragma unroll
        for (int a = 0; a < 2; ++a)
#pragma unroll
            for (int b = 0; b < 2; ++b)
#pragma unroll
                for (int m = 0; m < 4; ++m)
#pragma unroll
                    for (int n = 0; n < 2; ++n) acc[a][b][m][n] = (f32x4){0.f, 0.f, 0.f, 0.f};
        cur = nxt; cA = nA; cB = nB; ++ui;
        if constexpr (ALIGN_EPI) { if (wr == 1) PG8_BAR; }
    }
    PG8_WAIT_V(0);
    if constexpr (!ALIGN_EPI) { if (wr == 0) PG8_BAR; }
    PG8_BAR;
    if constexpr (Epi::AFTER_DRAIN) { E.fused(acc, cur, wr, wc, fr, fq, lds, wid, lane); S.done(cur); }
#undef PG8_SA
#undef PG8_SB
#undef PG8_STAGE
#undef PG8_LDA
#undef PG8_LDB
#undef PG8_MMA
#undef PG8_WAIT_V
#undef PG8_WAIT_L
#undef PG8_BAR
#undef PG8_SCHED
}
}
constexpr int RING_BYTES = 131072, MISC_OFF = RING_BYTES + 320, LDS_BYTES = 147456;
struct Params { const float* in[45]; float* out; unsigned char* ws; int ph_lo, ph_hi, use_bar, pad; };
enum { I_XP = 0, I_XS, I_CKV, I_CWIN, I_SWKV, I_SSHIFT, I_SCONV, I_PT, I_NORMG, I_MU, I_WR, I_WK, I_WV, I_WO, I_W0, I_W1, I_W2, I_A0, I_A1, I_A2, I_V0, I_V1, I_V2, I_G1, I_G2,
       I_KK, I_KA, I_RKK, I_LNW, I_LNB, I_KVNG, I_WKV, I_KNG, I_PE, I_CW1, I_CB1, I_CW2, I_CB2, I_WQ, I_QNG, I_WONSA, I_WIN, I_CONVW, I_CONVB, I_WOUT };

typedef const __attribute__((address_space(4))) Params* KP;
struct Ctx { LAS unsigned char* lds; int tid, lane, wave, gw, ngw, gtid, gsz; };

__device__ __forceinline__ void p0_transpose_item(const float* W, int K, int ldw, int nblk, bf16_t* WT, int row_off, LAS float* scr, int item, int lane) {
    const int kb = item / nblk, nb = item % nblk, k0 = 64 * kb, n0 = 32 * nb;
#pragma unroll 8
    for (int i = 0; i < 32; ++i) { const int kk = 2 * i + (lane >> 5); scr[kk * 33 + (lane & 31)] = W[(size_t)(k0 + kk) * ldw + n0 + (lane & 31)]; }
    LDS_WAIT(); asm volatile("" ::: "memory");
    const int c = lane & 7;
#pragma unroll
    for (int j = 0; j < 4; ++j) { const int n = (lane >> 3) + 8 * j; const LAS float* s = scr + (8 * c) * 33 + n;
        u32x4 o; o.x = pk2(s[0 * 33], s[1 * 33]); o.y = pk2(s[2 * 33], s[3 * 33]); o.z = pk2(s[4 * 33], s[5 * 33]); o.w = pk2(s[6 * 33], s[7 * 33]);
        *(u32x4*)(WT + (size_t)(row_off + n0 + n) * K + k0 + 8 * c) = o; }
    LDS_WAIT(); asm volatile("" ::: "memory");
}

__device__ __forceinline__ void phase_prologue(KP p, const Ctx& c) {
    LAS float* scr = (LAS float*)(c.lds + c.wave * 16384);
    unsigned char* ws = p->ws;
    int total = 0;
#define TRCNT(K_, N_) (((K_) / 64) * ((N_) / 32))
    constexpr int C_DD = TRCNT(1024, 1024), C_L64 = TRCNT(1024, 64), C_L32 = TRCNT(1024, 32), C_L128 = TRCNT(1024, 128), C_2_64 = TRCNT(64, 1024), C_2_128 = TRCNT(128, 1024);
    constexpr int C_KV = TRCNT(1024, 1536), C_Q = 16 * 33, C_IN = TRCNT(1024, 5632), C_OUT = TRCNT(2816, 1024), C_CW = TRCNT(1024, 128);
    constexpr int NITEMS = 2 * (4 * C_DD + 2 * C_L64 + C_L128 + 2 * C_2_64 + C_2_128) + C_L32 + C_KV + 2 * C_Q + 2 * C_DD + 4 * C_IN + 4 * C_OUT + 4 * C_CW;
    (void)total;
    for (int it = c.gw; it < NITEMS; it += c.ngw) {
        int r = it;
#define TR(Wp, K_, LDW_, NBLK_, WTp, ROWOFF_) { const int cnt_ = ((K_) / 64) * (NBLK_); if (r < cnt_) { p0_transpose_item((Wp), (K_), (LDW_), (NBLK_), (bf16_t*)(WTp), (ROWOFF_), scr, r, c.lane); continue; } r -= cnt_; }
        bool done = false;
#pragma unroll
        for (int l = 0; l < 2; ++l) {
            if (done) break;
            const size_t dd = (size_t)l * 1024 * 1024;
#define TRL(Wp, K_, LDW_, NBLK_, WTp, ROWOFF_) { const int cnt_ = ((K_) / 64) * (NBLK_); if (!done) { if (r < cnt_) { p0_transpose_item((Wp), (K_), (LDW_), (NBLK_), (bf16_t*)(WTp), (ROWOFF_), scr, r, c.lane); done = true; } else r -= cnt_; } }
            TRL(p->in[I_WR] + dd, 1024, 1024, 32, ws + WS_WRKV + (size_t)l * 3072 * 1024 * 2, 0)
            TRL(p->in[I_WK] + dd, 1024, 1024, 32, ws + WS_WRKV + (size_t)l * 3072 * 1024 * 2, 1024)
            TRL(p->in[I_WV] + dd, 1024, 1024, 32, ws + WS_WRKV + (size_t)l * 3072 * 1024 * 2, 2048)
            TRL(p->in[I_WO] + dd, 1024, 1024, 32, ws + WS_WORW + (size_t)l * 1024 * 1024 * 2, 0)
            TRL(p->in[I_W1] + (size_t)l * 1024 * 64, 1024, 64, 2, ws + WS_W1T + (size_t)l * 288 * 1024 * 2, 0)
            TRL(p->in[I_A1] + (size_t)l * 1024 * 64, 1024, 64, 2, ws + WS_W1T + (size_t)l * 288 * 1024 * 2, 64)
            TRL(p->in[I_G1] + (size_t)l * 1024 * 128, 1024, 128, 4, ws + WS_W1T + (size_t)l * 288 * 1024 * 2, 160)
            TRL(p->in[I_W2] + (size_t)l * 64 * 1024, 64, 1024, 32, ws + WS_W2W + (size_t)l * 1024 * 64 * 2, 0)
            TRL(p->in[I_A2] + (size_t)l * 64 * 1024, 64, 1024, 32, ws + WS_W2A + (size_t)l * 1024 * 64 * 2, 0)
            TRL(p->in[I_G2] + (size_t)l * 128 * 1024, 128, 1024, 32, ws + WS_W2G + (size_t)l * 1024 * 128 * 2, 0)
        }
        if (done) continue;
        TR(p->in[I_V1], 1024, 32, 1, ws + WS_W1T + (size_t)1 * 288 * 1024 * 2, 128)
        TR(p->in[I_WKV], 1024, 1536, 48, ws + WS_WKVT, 0)
        TR(p->in[I_WQ], 1024, NQ, 33, ws + WS_WQT, 0)
        TR(p->in[I_WQ] + (size_t)1024 * NQ, 1024, NQ, 33, ws + WS_WQT + (size_t)NQP * 1024 * 2, 0)
        TR(p->in[I_WONSA], 1024, 1024, 32, ws + WS_WONSA, 0)
        TR(p->in[I_WONSA] + (size_t)1024 * 1024, 1024, 1024, 32, ws + WS_WONSA + (size_t)1024 * 1024 * 2, 0)
#pragma unroll
        for (int l = 0; l < 4; ++l) {
            if (done) break;
            TRL(p->in[I_WIN] + (size_t)l * 1024 * 5632, 1024, 5632, 176, ws + WS_WINT + (size_t)l * 5632 * 1024 * 2, 0)
            TRL(p->in[I_WOUT] + (size_t)l * 2816 * 1024, 2816, 1024, 32, ws + WS_WOUTT + (size_t)l * 1024 * 2816 * 2, 0)
        }
        if (done) continue;
        TR(p->in[I_CW1], 1024, 128, 4, ws + WS_CW1T, 0)
        TR(p->in[I_CW1] + (size_t)1024 * 128, 1024, 128, 4, ws + WS_CW1T, 128)
        TR(p->in[I_CW1] + (size_t)2048 * 128, 1024, 128, 4, ws + WS_CW1T + (size_t)256 * 1024 * 2, 0)
        TR(p->in[I_CW1] + (size_t)3072 * 128, 1024, 128, 4, ws + WS_CW1T + (size_t)256 * 1024 * 2, 128)
#undef TR
#undef TRL
    }
    {
        bf16_t* WQT = (bf16_t*)(ws + WS_WQT);
        for (int e = c.gtid; e < 2 * 224 * 1024; e += c.gsz) { const int k = e & 1023, n = 1056 + ((e >> 10) % 224), l = e / (224 * 1024);
            WQT[((size_t)l * NQP + n) * 1024 + k] = n < NQ ? (bf16_t)f2bf(p->in[I_WQ][((size_t)l * 1024 + k) * NQ + n]) : (bf16_t)0; }
        bf16_t* W2V = (bf16_t*)(ws + WS_W2V);
        for (int e = c.gtid; e < 32 * 1024; e += c.gsz) { const int n = e & 1023, k = e >> 10; W2V[n * 32 + k] = (bf16_t)f2bf(p->in[I_V2][k * 1024 + n]); }
    }
    { bf16_t* W2T = (bf16_t*)(ws + WS_CW2T);
      for (int e = c.gtid; e < 2 * 128 * 64; e += c.gsz) { const int d = e & 63, q = (e >> 6) & 127, kv = e >> 13; const float w = p->in[I_CW2][e];
          const unsigned hi = f2bf(w), lo = f2bf(w - __builtin_bit_cast(float, hi << 16)); W2T[(size_t)(kv * 64 + d) * 128 + q] = (bf16_t)hi; W2T[(size_t)2 * 64 * 128 + (size_t)(kv * 64 + d) * 128 + q] = (bf16_t)lo; } }
    for (int it = c.gw; it < 256; it += c.ngw) { const int kv = it >> 7, h = it & 127; float s = 0.f;
        for (int kk = c.lane; kk < 2048; kk += 64) s += p->in[I_PE][kv * 2048 + kk] * p->in[I_CW1][((size_t)kv * 2048 + kk) * 128 + h];
        s = wave_sum(s); if (c.lane == 0) ((float*)(ws + WS_CBIAS))[it] = s + p->in[I_CB1][it]; }
    { const f32x4* xp = (const f32x4*)p->in[I_XP]; const f32x4* xs = (const f32x4*)p->in[I_XS]; f32x4* o = (f32x4*)(p->out + O_Y);
      for (int e = c.gtid; e < R * D / 4; e += c.gsz) o[e] = e < MP * D / 4 ? xp[e] : xs[e - MP * D / 4]; }
}

__device__ __forceinline__ void phase_fill(KP p, const Ctx& c, int li, const int gwf, const int ngwf) {
    unsigned char* ws = p->ws;
    { const int* pt = (const int*)p->in[I_PT]; bf16_t* CA = (bf16_t*)(ws + WS_CMPA); const int part = li;
      for (int it = gwf; it < SB * 128 * 4; it += ngwf) { const int s4 = 4 * (it & 3), n = (it >> 2) & 127, b = it >> 9;
          const int page = pt[b * NPAGES + (n >> 3)]; const float* src = p->in[I_CKV] + ((size_t)page * PAGE + (n & 7) * 16 + s4) * 1024 + part * 256;
          f32x4 v[4];
#pragma unroll
          for (int e = 0; e < 4; ++e) v[e] = __builtin_nontemporal_load(((const f32x4*)(src + (size_t)e * 1024)) + c.lane);
          const int g = c.lane >> 4, d0 = 4 * (c.lane & 15); bf16_t* dst = CA + ((size_t)8192 + (size_t)part * 65536 + (size_t)(b * 4 + g) * 128 + n) * 1024 + s4 * 64 + d0;
#pragma unroll
          for (int e = 0; e < 4; ++e) { u32x2 w; w.x = pk2(v[e][0], v[e][1]); w.y = pk2(v[e][2], v[e][3]); *(u32x2*)(dst + e * 64) = w; } } }
    { const f32x4* src = (const f32x4*)p->in[I_CWIN]; f32x4* dst = (f32x4*)(p->out + O_WINS); constexpr int HALF_N = SB * 508 * 128 / 2;
      for (int e0 = li * HALF_N + gwf * 256 + c.lane; e0 < (li + 1) * HALF_N; e0 += ngwf * 256) { f32x4 v[4];
#pragma unroll
          for (int q = 0; q < 4; ++q) { const int e = e0 + 64 * q; if (e < (li + 1) * HALF_N) { const int b = e / (508 * 128), rr = e % (508 * 128); v[q] = __builtin_nontemporal_load(src + (size_t)b * 512 * 128 + 4 * 128 + rr); } }
#pragma unroll
          for (int q = 0; q < 4; ++q) { const int e = e0 + 64 * q; if (e < (li + 1) * HALF_N) { const int b = e / (508 * 128), rr = e % (508 * 128); __builtin_nontemporal_store(v[q], dst + (size_t)b * 512 * 128 + rr); } } } }
}

template <int NT> __device__ __forceinline__ void skinny_mma(const bf16_t* A, int lda, const bf16_t* Wt, int ldw, int K, int row0, int col0, int lane, f32x4 (&acc)[NT][2]) {
    const int fr = lane & 15, fq = lane >> 4;
#pragma unroll
    for (int nt = 0; nt < NT; ++nt) { acc[nt][0] = (f32x4){0.f, 0.f, 0.f, 0.f}; acc[nt][1] = (f32x4){0.f, 0.f, 0.f, 0.f}; }
    const bf16_t* xa = A + (size_t)(row0 + fr) * lda + 8 * fq; const bf16_t* xb = xa + (size_t)16 * lda;
    const bf16_t* wa = Wt + (size_t)(col0 + fr) * ldw + 8 * fq;
    const char* pa = (const char*)xa; const char* pb = (const char*)xb; const char* pw[NT];
#pragma unroll
    for (int nt = 0; nt < NT; ++nt) pw[nt] = (const char*)(wa + (size_t)nt * 16 * ldw);
    for (int k4 = 0; k4 < K / 128; ++k4) {
        bf16x8 fb[4][2], fa[4][NT];
#pragma unroll
        for (int u = 0; u < 4; ++u) { fb[u][0] = *(const bf16x8*)(pa + 64 * u); fb[u][1] = *(const bf16x8*)(pb + 64 * u);
#pragma unroll
            for (int nt = 0; nt < NT; ++nt) fa[u][nt] = *(const bf16x8*)(pw[nt] + 64 * u); }
        __builtin_amdgcn_sched_barrier(0);
#pragma unroll
        for (int u = 0; u < 4; ++u)
#pragma unroll
            for (int nt = 0; nt < NT; ++nt) { acc[nt][0] = mfma16(fa[u][nt], fb[u][0], acc[nt][0]); acc[nt][1] = mfma16(fa[u][nt], fb[u][1], acc[nt][1]); }
        pa += 256; pb += 256;
#pragma unroll
        for (int nt = 0; nt < NT; ++nt) pw[nt] += 256;
        __builtin_amdgcn_sched_barrier(0);
    }
}
__device__ __forceinline__ void skinny_resid_sample(const Ctx& c, const bf16_t* A, int lda, const bf16_t* Wt, int K, float* X) {
    const int ln = launder_v(c.lane), fr = ln & 15, fq = ln >> 4;
    for (int it = blockIdx.x + gridDim.x * c.wave; it < 256; it += c.ngw) { const int row0 = MP + 32 * (it & 15), col0 = 64 * (it >> 4);
        f32x4 acc[4][2]; skinny_mma<4>(A, lda, Wt, lda, K, row0, col0, c.lane, acc);
#pragma unroll
        for (int nt = 0; nt < 4; ++nt)
#pragma unroll
            for (int mt = 0; mt < 2; ++mt) { f32x4* q = (f32x4*)(X + (size_t)(row0 + 16 * mt + fr) * D + col0 + 16 * nt + 4 * fq); *q = *q + acc[nt][mt]; } }
}
__device__ __forceinline__ void skinny_store(const Ctx& c, const bf16_t* A, const bf16_t* Wt, int K, float* C, int ldc, int rbase, int nrb, int ncb, int it0, int nit_total) {
    const int fr = c.lane & 15, fq = c.lane >> 4;
    for (int it = c.gw - it0; it < nrb * ncb; it += c.ngw) { if (it < 0) continue; const int row0 = rbase + 32 * (it % nrb), col0 = 64 * (it / nrb);
        f32x4 acc[4][2]; skinny_mma<4>(A, K, Wt, K, K, row0, col0, c.lane, acc);
#pragma unroll
        for (int nt = 0; nt < 4; ++nt)
#pragma unroll
            for (int mt = 0; mt < 2; ++mt) *(f32x4*)(C + (size_t)(row0 + 16 * mt + fr) * ldc + col0 + 16 * nt + 4 * fq) = acc[nt][mt]; }
    (void)nit_total;
}

__device__ __forceinline__ void load_row(const float* p, int lane, f32x4 (&v)[4]) {
#pragma unroll
    for (int j = 0; j < 4; ++j) v[j] = ((const f32x4*)p)[lane + 64 * j];
}
__device__ __forceinline__ float row_rstd(const f32x4 (&v)[4]) {
    float s = 0.f;
#pragma unroll
    for (int j = 0; j < 4; ++j) s += (v[j][0] * v[j][0] + v[j][1] * v[j][1]) + (v[j][2] * v[j][2] + v[j][3] * v[j][3]);
    s = wave_sum(s); return frsq(s * (1.0f / D) + NORM_EPS);
}
__device__ __forceinline__ void store_row_bf16(bf16_t* o, int lane, const f32x4 (&v)[4]) {
#pragma unroll
    for (int j = 0; j < 4; ++j) { u32x2 w; w.x = pk2(v[j][0], v[j][1]); w.y = pk2(v[j][2], v[j][3]); ((u32x2*)o)[lane + 64 * j] = w; }
}

__device__ __forceinline__ void phase_norm(const Ctx& c, const float* X, const float* g1, bf16_t* o1, const float* g2, bf16_t* o2) {
    f32x4 ga[4], gb[4]; load_row(g1, c.lane, ga); if (g2) load_row(g2, c.lane, gb);
    for (int row = c.gw; row < R; row += c.ngw) {
        f32x4 v[4]; load_row(X + (size_t)row * D, c.lane, v); const float rs = row_rstd(v);
        f32x4 y[4];
#pragma unroll
        for (int j = 0; j < 4; ++j) y[j] = v[j] * rs * ga[j];
        store_row_bf16(o1 + (size_t)row * D, c.lane, y);
        if (g2) {
#pragma unroll
            for (int j = 0; j < 4; ++j) y[j] = v[j] * rs * gb[j];
            store_row_bf16(o2 + (size_t)row * D, c.lane, y); }
    }
}

__device__ __forceinline__ void phase_mix(KP p, const Ctx& c, int li) {
    const float* X = p->out + O_Y; const float* gain = p->in[I_NORMG] + (size_t)(li * 2) * D; const float* mu = p->in[I_MU] + (size_t)li * 6 * D;
    bf16_t* XM = (bf16_t*)(p->ws + WS_XM);
    f32x4 ga[4]; load_row(gain, c.lane, ga);
    {
        const int r0 = (int)(((long)c.gw * R) / c.ngw), r1 = (int)(((long)(c.gw + 1) * R) / c.ngw); f32x4 prev[4];
        {
            const bool seq_start = r0 < MP ? ((r0 & (TP - 1)) == 0) : (((r0 - MP) & 3) == 0);
            if (!seq_start && r0 < r1) { f32x4 v[4]; load_row(X + (size_t)(r0 - 1) * D, c.lane, v); const float rs = row_rstd(v);
#pragma unroll
                for (int j = 0; j < 4; ++j) prev[j] = v[j] * rs * ga[j]; }
        }
        for (int row = r0; row < r1; ++row) {
            const bool seq_start = row < MP ? ((row & (TP - 1)) == 0) : (((row - MP) & 3) == 0);
            if (seq_start) {
                if (row < MP) {
#pragma unroll
                    for (int j = 0; j < 4; ++j) prev[j] = (f32x4){0.f, 0.f, 0.f, 0.f}; }
                else load_row(p->in[I_SSHIFT] + ((size_t)li * SB + ((row - MP) >> 2)) * D, c.lane, prev);
            }
            f32x4 v[4]; load_row(X + (size_t)row * D, c.lane, v); const float rs = row_rstd(v);
            f32x4 xn[4];
#pragma unroll
            for (int j = 0; j < 4; ++j) xn[j] = v[j] * rs * ga[j];
#pragma unroll
            for (int m = 0; m < 6; ++m) {
                f32x4 y[4];
#pragma unroll
                for (int j = 0; j < 4; ++j) { const int mi = m == 1 ? 2 : (m == 2 ? 3 : (m == 3 ? 1 : m));
                    const f32x4 mm = ((const f32x4*)(mu + (size_t)mi * D))[c.lane + 64 * j]; y[j] = xn[j] + (prev[j] - xn[j]) * mm; }
                store_row_bf16(XM + ((size_t)m * R + row) * D, c.lane, y);
            }
            const bool seq_end = row < MP ? ((row & (TP - 1)) == TP - 1) : (((row - MP) & 3) == 3);
            if (seq_end) { float* so = row < MP ? p->out + O_SHP + ((size_t)li * NB + (row >> 13)) * D : p->out + O_SHS + ((size_t)li * SB + ((row - MP) >> 2)) * D;
#pragma unroll
                for (int j = 0; j < 4; ++j) ((f32x4*)so)[c.lane + 64 * j] = xn[j]; }
#pragma unroll
            for (int j = 0; j < 4; ++j) prev[j] = xn[j];
        }
    }
}
template <int NT, int ACT> __device__ __forceinline__ void lora1_item(const bf16_t* X, const bf16_t* W, bf16_t* HID, int coloff, int rb, int lane) {
    lane = launder_v(lane);
    const int fr = lane & 15, fq = lane >> 4;
    f32x4 acc[NT][2]; skinny_mma<NT>(X, 1024, W, 1024, 1024, rb * 32, coloff, lane, acc);
#pragma unroll
    for (int nt = 0; nt < NT; ++nt)
#pragma unroll
        for (int mt = 0; mt < 2; ++mt) { f32x4 v = acc[nt][mt];
#pragma unroll
            for (int r = 0; r < 4; ++r) { if (ACT == 1) { const float e = __builtin_amdgcn_exp2f(2.8853900817779268f * v[r]); v[r] = 1.0f - 2.0f * frcp(e + 1.0f); } if (ACT == 2) v[r] = sigmoidf_(v[r]); }
            u32x2 w; w.x = pk2(v[0], v[1]); w.y = pk2(v[2], v[3]);
            *(u32x2*)(HID + (size_t)(rb * 32 + mt * 16 + fr) * LHID + coloff + nt * 16 + 4 * fq) = w; }
}
__device__ __forceinline__ void phase_lora1(KP p, const Ctx& c, int li) {
    const bf16_t* XM = (const bf16_t*)(p->ws + WS_XM); const bf16_t* W = (const bf16_t*)(p->ws + WS_W1T) + (size_t)li * 288 * 1024; bf16_t* HID = (bf16_t*)(p->ws + WS_HID);
    constexpr int NRB = R / 32;
    for (int it = blockIdx.x + gridDim.x * c.wave; it < 5 * NRB; it += c.ngw) { const int q = it / NRB, rb = it % NRB;
        if (q == 0) lora1_item<4, 1>(XM + (size_t)3 * R * D, W, HID, 0, rb, c.lane);
        else if (q == 1) lora1_item<4, 0>(XM + (size_t)4 * R * D, W, HID, 64, rb, c.lane);
        else if (q == 2) { if (li == 1) lora1_item<2, 0>(XM + (size_t)2 * R * D, W, HID, 128, rb, c.lane); }
        else if (q == 3) lora1_item<4, 2>(XM + (size_t)5 * R * D, W, HID, 160, rb, c.lane);
        else lora1_item<4, 2>(XM + (size_t)5 * R * D, W, HID, 224, rb, c.lane);
    }
}

constexpr int SST = 72, MAT = 64 * SST * 2;
constexpr int O_AT = 0, O_BT = MAT, O_KT = 2 * MAT, O_RT = 3 * MAT, O_VT = 4 * MAT, O_BH = 5 * MAT, O_KH = 6 * MAT, O_XT = 7 * MAT, O_AAB = 9 * MAT, O_AAK = 10 * MAT, O_ARB = 11 * MAT, O_ARK = 12 * MAT;
constexpr int O_TD = 13 * MAT, O_SCR = O_TD + 2048, O_CS = O_SCR + 4096, O_WC = O_CS + 2048, O_LW = O_XT, O_LA = O_XT + 16384, O_LV = O_XT + 32768;
static_assert(O_WC + 256 <= RING_BYTES && O_LV + 16384 <= O_TD, "scan LDS map");
__device__ __forceinline__ bf16x8 ldsfrag(LAS unsigned char* lds, int off, int row, int col) { return *(const LAS bf16x8*)(lds + off + (row * SST + col) * 2); }
__device__ __forceinline__ void lds_st4(LAS unsigned char* lds, int off, int row, int col, f32x4 v) { u32x2 w; w.x = pk2(v[0], v[1]); w.y = pk2(v[2], v[3]); *(LAS u32x2*)(lds + off + (row * SST + col) * 2) = w; }
__device__ __forceinline__ f32x4 lds_ld4(LAS unsigned char* lds, int off, int row, int col) { const u32x2 w = *(const LAS u32x2*)(lds + off + (row * SST + col) * 2); return (f32x4){bflo(w.x), bfhi(w.x), bflo(w.y), bfhi(w.y)}; }

__device__ __forceinline__ void scanA_unit(KP p, const Ctx& c, int li, int u) {
    LAS unsigned char* lds = c.lds; unsigned char* ws = p->ws; const int stop = p->pad;
    const int lane = c.lane, wave = c.wave, fr = lane & 15, fq = lane >> 4;
    const int b = u / (NCH * H), n = (u / H) % NCH, h = u % H, row0 = b * TP + 64 * n;
    const float* Rb = (const float*)(ws + WS_RK_R); const float* Kb = (const float*)(ws + WS_RK_K);
    float* Vb = (float*)(ws + (li ? WS_V1 : WS_V0)); const float* V0b = (const float*)(ws + WS_V0);
    const bf16_t* HID = (const bf16_t*)(ws + WS_HID);
    {
        const int tt = wave & 3, chh = wave >> 2;
        const bf16_t* hrow = launder_p(HID + (size_t)(row0 + 16 * tt + fr) * LHID + 8 * fq);
        const bf16_t* W2W = (const bf16_t*)(ws + WS_W2W) + (size_t)li * 1024 * 64; const bf16_t* W2A = (const bf16_t*)(ws + WS_W2A) + (size_t)li * 1024 * 64; const bf16_t* W2V = (const bf16_t*)(ws + WS_W2V);
#pragma unroll
        for (int cti = 0; cti < 2; ++cti) { const int ct = 2 * chh + cti, C = 64 * h + 16 * ct + fr;
            f32x4 aw = {0.f, 0.f, 0.f, 0.f}, aa = {0.f, 0.f, 0.f, 0.f}, av = {0.f, 0.f, 0.f, 0.f};
#pragma unroll
            for (int ks = 0; ks < 2; ++ks) {
                aw = mfma16(*(const bf16x8*)(W2W + (size_t)C * 64 + 32 * ks + 8 * fq), *(const bf16x8*)(hrow + 32 * ks), aw);
                aa = mfma16(*(const bf16x8*)(W2A + (size_t)C * 64 + 32 * ks + 8 * fq), *(const bf16x8*)(hrow + 64 + 32 * ks), aa); }
            if (li) av = mfma16(*(const bf16x8*)(W2V + (size_t)C * 32 + 8 * fq), *(const bf16x8*)(hrow + 128), av);
            const int t = 16 * tt + fr, cc = 16 * ct + 4 * fq;
            *(LAS f32x4*)(lds + O_LW + (t * 64 + cc) * 4) = aw; *(LAS f32x4*)(lds + O_LA + (t * 64 + cc) * 4) = aa; *(LAS f32x4*)(lds + O_LV + (t * 64 + cc) * 4) = av; }
    }
    __syncthreads();
    if (stop == 1) return;
    {
        const int cc = lane, tq = wave, C = 64 * h + cc; const size_t pc = (size_t)li * D + C;
        const float w0 = p->in[I_W0][pc], a0 = p->in[I_A0][pc], kkc = p->in[I_KK][pc], kac = p->in[I_KA][pc], rkc = p->in[I_RKK][pc], v0 = li ? p->in[I_V0][C] : 0.f;
        float wlg[8], Lin[8], rr[8], k2[8], vv[8], aa[8], bb[8]; float run = 0.f;
#pragma unroll
        for (int e = 0; e < 8; ++e) { const int t = 8 * tq + e; const size_t gi = (size_t)(row0 + t) * D + C;
            const float r = Rb[gi], k = Kb[gi]; float v = Vb[gi];
            const float lw = *(const LAS float*)(lds + O_LW + (t * 64 + cc) * 4), la = *(const LAS float*)(lds + O_LA + (t * 64 + cc) * 4);
            const float z = -(w0 + lw); const float sp = fmaxf(z, 0.f) + __logf(1.0f + __expf(-fabsf(z))); const float wl = -__expf(-sp - 0.5f);
            const float asig = sigmoidf_(a0 + la);
            if (li) { const float lv = *(const LAS float*)(lds + O_LV + (t * 64 + cc) * 4); const float vg = sigmoidf_(v0 + lv); const float vf = V0b[gi]; v = v + (vf - v) * vg; Vb[gi] = v; }
            const float kkr = k * kkc; const float ss = wave_sum(kkr * kkr); const float kkn = kkr * frsq(fmaxf(ss, 1e-24f));
            const float kmod = k * (1.0f + (asig - 1.0f) * kac);
            const float rks = wave_sum(r * kmod * rkc); if (cc == 0) ((float*)(ws + WS_RKS))[(size_t)(row0 + t) * 16 + h] = rks;
            run += wl; wlg[e] = wl; Lin[e] = run; rr[e] = r; k2[e] = kmod; vv[e] = v; aa[e] = -kkn; bb[e] = kkn * asig; }
        *(LAS float*)(lds + O_CS + (tq * 64 + cc) * 4) = run;
        __syncthreads();
        float off = 0.f, tot = 0.f;
#pragma unroll
        for (int q = 0; q < 8; ++q) { const float x = *(const LAS float*)(lds + O_CS + (q * 64 + cc) * 4); tot += x; if (q < tq) off += x; }
        u32x4 wa, wv, wb, wk; unsigned pa[8], pv[8], pb[8], pk[8];
#pragma unroll
        for (int e = 0; e < 8; ++e) { const int t = 8 * tq + e; const float L = off + Lin[e], Lp = L - wlg[e];
            const float eL = __expf(L), eLp = __expf(Lp), enL = __expf(-L), eT = __expf(tot - L);
            const float at = aa[e] * eLp, bt = bb[e] * enL, kt = k2[e] * enL, rt = rr[e] * eL, bh = bb[e] * eT, kh = k2[e] * eT;
            *(LAS bf16_t*)(lds + O_AT + (t * SST + cc) * 2) = (bf16_t)f2bf(at); *(LAS bf16_t*)(lds + O_BT + (t * SST + cc) * 2) = (bf16_t)f2bf(bt);
            *(LAS bf16_t*)(lds + O_KT + (t * SST + cc) * 2) = (bf16_t)f2bf(kt); *(LAS bf16_t*)(lds + O_RT + (t * SST + cc) * 2) = (bf16_t)f2bf(rt);
            pa[e] = f2bf(at); pv[e] = f2bf(vv[e]); pb[e] = f2bf(bh); pk[e] = f2bf(kh); }
        wa = (u32x4){pa[0] | (pa[1] << 16), pa[2] | (pa[3] << 16), pa[4] | (pa[5] << 16), pa[6] | (pa[7] << 16)};
        wv = (u32x4){pv[0] | (pv[1] << 16), pv[2] | (pv[3] << 16), pv[4] | (pv[5] << 16), pv[6] | (pv[7] << 16)};
        wb = (u32x4){pb[0] | (pb[1] << 16), pb[2] | (pb[3] << 16), pb[4] | (pb[5] << 16), pb[6] | (pb[7] << 16)};
        wk = (u32x4){pk[0] | (pk[1] << 16), pk[2] | (pk[3] << 16), pk[4] | (pk[5] << 16), pk[6] | (pk[7] << 16)};
        *(LAS u32x4*)(lds + O_XT + (cc * SST + 8 * tq) * 2) = wa; *(LAS u32x4*)(lds + O_VT + (cc * SST + 8 * tq) * 2) = wv;
        *(LAS u32x4*)(lds + O_BH + (cc * SST + 8 * tq) * 2) = wb; *(LAS u32x4*)(lds + O_KH + (cc * SST + 8 * tq) * 2) = wk;
        if (tq == 0) *(LAS float*)(lds + O_WC + cc * 4) = __expf(tot);
    }
    __syncthreads();
    if (stop == 2) return;
    {
        const int mi = wave >> 1, ph = wave & 1; const int oY = (mi & 1) ? O_KT : O_BT, oX = (mi < 2) ? O_AT : O_RT; const bool strict = mi < 2;
        const int oO = mi == 0 ? O_AAB : (mi == 1 ? O_AAK : (mi == 2 ? O_ARB : O_ARK));
#pragma unroll
        for (int sti = 0; sti < 2; ++sti) { const int st = 2 * ph + sti;
#pragma unroll
            for (int tt = 0; tt < 4; ++tt) { f32x4 acc = {0.f, 0.f, 0.f, 0.f};
                if (st <= tt) {
#pragma unroll
                    for (int ks = 0; ks < 2; ++ks) acc = mfma16(ldsfrag(lds, oY, 16 * st + fr, 32 * ks + 8 * fq), ldsfrag(lds, oX, 16 * tt + fr, 32 * ks + 8 * fq), acc);
                    const int t = 16 * tt + fr;
#pragma unroll
                    for (int r = 0; r < 4; ++r) { const int s = 16 * st + 4 * fq + r; const bool keep = strict ? (s < t) : (s <= t); acc[r] = keep ? acc[r] : 0.f; } }
                if (st <= tt) lds_st4(lds, oO, 16 * tt + fr, 16 * st + 4 * fq, acc);
                else { u32x2 zz; int z0 = 0; asm volatile("" : "+v"(z0)); zz.x = (unsigned)z0; zz.y = (unsigned)z0; *(LAS u32x2*)(lds + oO + ((16 * tt + fr) * SST + 16 * st + 4 * fq) * 2) = zz; } } }
    }
    __syncthreads();
    if (stop == 3) return;
    {
        const int tt = wave & 3, ih = wave >> 2;
#pragma unroll
        for (int iti = 0; iti < 2; ++iti) { const int it = 2 * ih + iti; f32x4 acc = {0.f, 0.f, 0.f, 0.f};
#pragma unroll
            for (int ks = 0; ks < 2; ++ks) acc = mfma16(ldsfrag(lds, O_AAK, 16 * tt + fr, 32 * ks + 8 * fq), ldsfrag(lds, O_VT, 16 * it + fr, 32 * ks + 8 * fq), acc);
            lds_st4(lds, O_XT, 64 + 16 * it + fr, 16 * tt + 4 * fq, acc); }
        if (wave < 4 && lane < 16) { const int I = wave; float x[16];
#pragma unroll
            for (int t = 0; t < 16; ++t) { float s = (t == lane) ? 1.0f : 0.0f;
#pragma unroll
                for (int q = 0; q < t; ++q) s += bf2f(*(const LAS bf16_t*)(lds + O_AAB + ((16 * I + t) * SST + 16 * I + q) * 2)) * x[q];
                x[t] = s; *(LAS bf16_t*)(lds + O_TD + ((I * 16 + t) * 16 + lane) * 2) = (bf16_t)f2bf(s); } }
    }
    __syncthreads();
    if (stop == 5) return;
    {
        const int colb = 16 * wave; const bf16x8 zero8 = {0, 0, 0, 0, 0, 0, 0, 0};
#pragma unroll
        for (int I = 0; I < 4; ++I) {
            f32x4 acc = lds_ld4(lds, O_XT, colb + fr, 16 * I + 4 * fq);
#pragma unroll
            for (int ks = 0; ks < 2; ++ks) if (32 * ks < 16 * I) { const bool ok = (32 * ks + 8 * fq) < 16 * I;
                const bf16x8 a = ok ? ldsfrag(lds, O_AAB, 16 * I + fr, 32 * ks + 8 * fq) : zero8, bq = ok ? ldsfrag(lds, O_XT, colb + fr, 32 * ks + 8 * fq) : zero8;
                acc = mfma16(a, bq, acc); }
            { u32x2 w; w.x = pk2(acc[0], acc[1]); w.y = pk2(acc[2], acc[3]); *(LAS u32x2*)(lds + O_SCR + wave * 512 + (fr * 16 + 4 * fq) * 2) = w; }
            LDS_WAIT();
            const bf16x8 ta = fq < 2 ? *(const LAS bf16x8*)(lds + O_TD + ((I * 16 + fr) * 16 + 8 * fq) * 2) : zero8;
            const bf16x8 tb = fq < 2 ? *(const LAS bf16x8*)(lds + O_SCR + wave * 512 + (fr * 16 + 8 * fq) * 2) : zero8;
            const f32x4 res = mfma16(ta, tb, (f32x4){0.f, 0.f, 0.f, 0.f});
            lds_st4(lds, O_XT, colb + fr, 16 * I + 4 * fq, res);
            LDS_WAIT();
        }
    }
    __syncthreads();
    if (stop == 6) return;
    {
        const int tb = wave & 3, hb = wave >> 2;
        bf16_t* RP = (bf16_t*)(ws + WS_RP) + (size_t)u * 4096; float* YL = (float*)(ws + WS_YL) + (size_t)u * 4096;
        bf16_t* MTH = (bf16_t*)(ws + WS_MT) + (size_t)u * 4096; bf16_t* MTL = MTH + (size_t)NUNIT_A * 4096; float* NN = (float*)(ws + WS_NN) + (size_t)u * 4096;
#pragma unroll
        for (int qi = 0; qi < 2; ++qi) { const int rt = 2 * hb + qi;
            { f32x4 acc = lds_ld4(lds, O_RT, 16 * tb + fr, 16 * rt + 4 * fq);
#pragma unroll
              for (int ks = 0; ks < 2; ++ks) acc = mfma16(ldsfrag(lds, O_XT, 16 * rt + fr, 32 * ks + 8 * fq), ldsfrag(lds, O_ARB, 16 * tb + fr, 32 * ks + 8 * fq), acc);
              u32x2 w; w.x = pk2(acc[0], acc[1]); w.y = pk2(acc[2], acc[3]); *(u32x2*)(RP + (size_t)(16 * tb + fr) * 64 + 16 * rt + 4 * fq) = w; }
            { f32x4 acc = {0.f, 0.f, 0.f, 0.f};
#pragma unroll
              for (int ks = 0; ks < 2; ++ks) { acc = mfma16(ldsfrag(lds, O_XT, 64 + 16 * rt + fr, 32 * ks + 8 * fq), ldsfrag(lds, O_ARB, 16 * tb + fr, 32 * ks + 8 * fq), acc);
                  acc = mfma16(ldsfrag(lds, O_VT, 16 * rt + fr, 32 * ks + 8 * fq), ldsfrag(lds, O_ARK, 16 * tb + fr, 32 * ks + 8 * fq), acc); }
              *(f32x4*)(YL + (size_t)(16 * tb + fr) * 64 + 16 * rt + 4 * fq) = acc; }
            { f32x4 acc = {0.f, 0.f, 0.f, 0.f};
#pragma unroll
              for (int ks = 0; ks < 2; ++ks) acc = mfma16(ldsfrag(lds, O_XT, 16 * rt + fr, 32 * ks + 8 * fq), ldsfrag(lds, O_BH, 16 * tb + fr, 32 * ks + 8 * fq), acc);
              const int j = 16 * tb + fr; const float wc = *(const LAS float*)(lds + O_WC + j * 4);
#pragma unroll
              for (int r = 0; r < 4; ++r) if (16 * rt + 4 * fq + r == j) acc[r] += wc;
              unsigned hh[4], ll[4];
#pragma unroll
              for (int r = 0; r < 4; ++r) { hh[r] = f2bf(acc[r]); ll[r] = f2bf(acc[r] - __builtin_bit_cast(float, hh[r] << 16)); }
              *(u32x2*)(MTH + (size_t)j * 64 + 16 * rt + 4 * fq) = (u32x2){hh[0] | (hh[1] << 16), hh[2] | (hh[3] << 16)};
              *(u32x2*)(MTL + (size_t)j * 64 + 16 * rt + 4 * fq) = (u32x2){ll[0] | (ll[1] << 16), ll[2] | (ll[3] << 16)}; }
            { f32x4 acc = {0.f, 0.f, 0.f, 0.f};
#pragma unroll
              for (int ks = 0; ks < 2; ++ks) { acc = mfma16(ldsfrag(lds, O_BH, 16 * rt + fr, 32 * ks + 8 * fq), ldsfrag(lds, O_XT, 64 + 16 * tb + fr, 32 * ks + 8 * fq), acc);
                  acc = mfma16(ldsfrag(lds, O_KH, 16 * rt + fr, 32 * ks + 8 * fq), ldsfrag(lds, O_VT, 16 * tb + fr, 32 * ks + 8 * fq), acc); }
              *(f32x4*)(NN + (size_t)(16 * tb + fr) * 64 + 16 * rt + 4 * fq) = acc; }
        }
    }
    __syncthreads();
}

__device__ __forceinline__ void scan_sample_item(KP p, const Ctx& c, int li, int item) {
    unsigned char* ws = p->ws; const int lane = c.lane, b = item >> 4, h = item & 15, C = 64 * h + lane; const size_t pc = (size_t)li * D + C;
    LAS float* sc = (LAS float*)(c.lds + c.wave * 16384);
    const float* Rb = (const float*)(ws + WS_RK_R); const float* Kb = (const float*)(ws + WS_RK_K);
    float* Vb = (float*)(ws + (li ? WS_V1 : WS_V0)); const float* V0b = (const float*)(ws + WS_V0);
    const bf16_t* HID = (const bf16_t*)(ws + WS_HID) + (size_t)(MP + 4 * b) * LHID;
    for (int e = lane; e < 4 * LHID; e += 64) sc[e] = bf2f(HID[e]);
    LDS_WAIT();
    float lw[4] = {0.f, 0.f, 0.f, 0.f}, la[4] = {0.f, 0.f, 0.f, 0.f}, lv[4] = {0.f, 0.f, 0.f, 0.f}, lg[4] = {0.f, 0.f, 0.f, 0.f};
    {
        const bf16_t* W2W = (const bf16_t*)(ws + WS_W2W) + ((size_t)li * 1024 + C) * 64; const bf16_t* W2A = (const bf16_t*)(ws + WS_W2A) + ((size_t)li * 1024 + C) * 64;
        const bf16_t* W2V = (const bf16_t*)(ws + WS_W2V) + (size_t)C * 32; const bf16_t* W2G = (const bf16_t*)(ws + WS_W2G) + ((size_t)li * 1024 + C) * 128;
#define LORA2_BLK(WP, QB, HOFF, ACC) { const u32x4 w8 = *(const u32x4*)((WP) + 8 * (QB)); \
            const float wf0 = bflo(w8.x), wf1 = bfhi(w8.x), wf2 = bflo(w8.y), wf3 = bfhi(w8.y), wf4 = bflo(w8.z), wf5 = bfhi(w8.z), wf6 = bflo(w8.w), wf7 = bfhi(w8.w); \
            _Pragma("unroll") for (int t = 0; t < 4; ++t) { const f32x4 h0 = *(const LAS f32x4*)(sc + t * LHID + (HOFF) + 8 * (QB)), h1 = *(const LAS f32x4*)(sc + t * LHID + (HOFF) + 8 * (QB) + 4); \
                ACC[t] += (h0[0] * wf0 + h0[1] * wf1) + (h0[2] * wf2 + h0[3] * wf3) + (h1[0] * wf4 + h1[1] * wf5) + (h1[2] * wf6 + h1[3] * wf7); } \
            asm volatile("" : "+v"(ACC[0]), "+v"(ACC[1]), "+v"(ACC[2]), "+v"(ACC[3]) :: "memory"); }
#pragma unroll
        for (int qb = 0; qb < 8; ++qb) { LORA2_BLK(W2W, qb, 0, lw) LORA2_BLK(W2A, qb, 64, la) }
        if (li) {
#pragma unroll
            for (int qb = 0; qb < 4; ++qb) LORA2_BLK(W2V, qb, 128, lv) }
#pragma unroll
        for (int qb = 0; qb < 16; ++qb) LORA2_BLK(W2G, qb, 160, lg)
#undef LORA2_BLK
    }
    const float w0 = p->in[I_W0][pc], a0 = p->in[I_A0][pc], kkc = p->in[I_KK][pc], kac = p->in[I_KA][pc], rkc = p->in[I_RKK][pc], v0 = li ? p->in[I_V0][C] : 0.f;
    const float lnw = p->in[I_LNW][pc], lnb = p->in[I_LNB][pc];
    float S[64];
    { const f32x4* sp = (const f32x4*)(p->in[I_SWKV] + (((size_t)li * SB + b) * H + h) * 4096 + lane * 64);
#pragma unroll
      for (int q = 0; q < 16; ++q) { const f32x4 x = sp[q]; S[4 * q] = x[0]; S[4 * q + 1] = x[1]; S[4 * q + 2] = x[2]; S[4 * q + 3] = x[3]; } }
    LAS float* bc = sc + 1280;
    bf16_t* YG = (bf16_t*)(ws + WS_YG);
#pragma unroll
    for (int t = 0; t < 4; ++t) { const size_t gi = (size_t)(MP + 4 * b + t) * D + C;
        const float r = Rb[gi], k = Kb[gi]; float v = Vb[gi];
        const float z = -(w0 + lw[t]); const float sp = fmaxf(z, 0.f) + __logf(1.0f + __expf(-fabsf(z))); const float wdec = __expf(-__expf(-sp - 0.5f));
        const float asig = sigmoidf_(a0 + la[t]);
        if (li) { const float vg = sigmoidf_(v0 + lv[t]); const float vf = V0b[gi]; v = v + (vf - v) * vg; }
        const float kkr = k * kkc; const float ss = wave_sum(kkr * kkr); const float kkn = kkr * frsq(fmaxf(ss, 1e-24f));
        const float kmod = k * (1.0f + (asig - 1.0f) * kac);
        const float rks = wave_sum(r * kmod * rkc);
        LDS_WAIT();
        bc[lane] = wdec; bc[64 + lane] = -kkn; bc[128 + lane] = kkn * asig; bc[192 + lane] = kmod; bc[256 + lane] = r;
        LDS_WAIT();
        float sa = 0.f;
#pragma unroll
        for (int q = 0; q < 16; ++q) { const f32x4 av = *(const LAS f32x4*)(bc + 64 + 4 * q); sa += S[4 * q] * av[0] + S[4 * q + 1] * av[1] + S[4 * q + 2] * av[2] + S[4 * q + 3] * av[3]; }
        float y = 0.f;
#pragma unroll
        for (int q = 0; q < 16; ++q) { const f32x4 wv = *(const LAS f32x4*)(bc + 4 * q), bv = *(const LAS f32x4*)(bc + 128 + 4 * q), kv = *(const LAS f32x4*)(bc + 192 + 4 * q), rv = *(const LAS f32x4*)(bc + 256 + 4 * q);
#pragma unroll
            for (int e = 0; e < 4; ++e) { const float s = S[4 * q + e] * wv[e] + sa * bv[e] + v * kv[e]; S[4 * q + e] = s; y += s * rv[e]; } }
        const float mean = wave_sum(y) * (1.0f / 64.0f); const float dy = y - mean; const float var = wave_sum(dy * dy) * (1.0f / 64.0f);
        const float yn = dy * (frsq(var + GN_EPS)) * lnw + lnb;
        YG[gi] = (bf16_t)f2bf((yn + rks * v) * lg[t]);
    }
    { f32x4* so = (f32x4*)(p->out + O_WKVS + (((size_t)li * SB + b) * H + h) * 4096 + lane * 64);
#pragma unroll
      for (int q = 0; q < 16; ++q) so[q] = (f32x4){S[4 * q], S[4 * q + 1], S[4 * q + 2], S[4 * q + 3]}; }
    LDS_WAIT();
}

__device__ __forceinline__ void phase_scanA(KP p, const Ctx& c, int li) {
    const int stop = p->pad;
    if (stop != 9) for (int u = blockIdx.x; u < NUNIT_A; u += gridDim.x) scanA_unit(p, c, li, u);
    if (stop == 0 || stop == 9) for (int it = c.gw; it < SB * H; it += c.ngw) scan_sample_item(p, c, li, it);
}

__device__ __forceinline__ void hilo(const f32x4 x0, const f32x4 x1, bf16x8& hi, bf16x8& lo) {
    unsigned h[8], l[8];
#pragma unroll
    for (int e = 0; e < 8; ++e) { const float x = e < 4 ? x0[e] : x1[e - 4]; h[e] = f2bf(x); l[e] = f2bf(x - __builtin_bit_cast(float, h[e] << 16)); }
    u32x4 hv = {h[0] | (h[1] << 16), h[2] | (h[3] << 16), h[4] | (h[5] << 16), h[6] | (h[7] << 16)}, lv = {l[0] | (l[1] << 16), l[2] | (l[3] << 16), l[4] | (l[5] << 16), l[6] | (l[7] << 16)};
    hi = __builtin_bit_cast(bf16x8, hv); lo = __builtin_bit_cast(bf16x8, lv);
}
constexpr int SB_SLOT = 20480, SB_RING0 = 8192, SB_DEPTH = 6;
static_assert(SB_RING0 + SB_DEPTH * SB_SLOT <= RING_BYTES, "chain ring");
__device__ __forceinline__ void phase_scanB(KP p, const Ctx& c, int li) {
    unsigned char* ws = p->ws; LAS unsigned char* lds = c.lds; const int lane = c.lane, fr = lane & 15, fq = lane >> 4, wave = c.wave;
    volatile LAS int* FL = (volatile LAS int*)(lds + RING_BYTES);
    if (c.tid < 4) FL[c.tid] = 0;
    __syncthreads();
    const int ncb = (int)gridDim.x < 128 ? (int)gridDim.x : 128;
    if (wave >= 4 || (int)blockIdx.x >= ncb) {
        const int gwf = (int)blockIdx.x < ncb ? (int)blockIdx.x * 4 + (wave - 4) : ncb * 4 + ((int)blockIdx.x - ncb) * 8 + wave, ngwf = ncb * 4 + ((int)gridDim.x - ncb) * 8;
        phase_fill(p, c, li, gwf, ngwf); return; }
    if (wave != 0) {
        const int j = wave - 1; int prevG = -1, kc = 0;
        for (int ch = blockIdx.x; ch < 128; ch += gridDim.x, ++kc) { const int b = ch >> 6, h = (ch >> 2) & 15, iq = ch & 3;
            for (int n = j; n < NCH; n += 3) { const int G = kc * NCH + n;
                if (G >= SB_DEPTH) { unsigned sp = 0; while (FL[0] < G - (SB_DEPTH - 1)) { __builtin_amdgcn_s_sleep(1); if (++sp > (1u << 22)) break; } }
                LAS unsigned char* slot = lds + SB_RING0 + (G % SB_DEPTH) * SB_SLOT;
                const size_t u = (size_t)(b * NCH + n) * H + h; const bf16_t* MTH = (const bf16_t*)(ws + WS_MT) + u * 4096; const bf16_t* MTL = MTH + (size_t)NUNIT_A * 4096; const float* NN = (const float*)(ws + WS_NN) + u * 4096;
#pragma unroll
                for (int jt = 0; jt < 4; ++jt)
#pragma unroll
                    for (int ks = 0; ks < 2; ++ks) {
                        __builtin_amdgcn_global_load_lds((const unsigned*)(MTH + (size_t)(16 * jt + fr) * 64 + 32 * ks + 8 * fq), (LAS unsigned*)(slot + ((jt * 2 + ks) * 2 + 0) * 1024), 16, 0, 0);
                        __builtin_amdgcn_global_load_lds((const unsigned*)(MTL + (size_t)(16 * jt + fr) * 64 + 32 * ks + 8 * fq), (LAS unsigned*)(slot + ((jt * 2 + ks) * 2 + 1) * 1024), 16, 0, 0); }
#pragma unroll
                for (int jt = 0; jt < 4; ++jt)
                    __builtin_amdgcn_global_load_lds((const unsigned*)(NN + (size_t)(16 * iq + fr) * 64 + 16 * jt + 4 * fq), (LAS unsigned*)(slot + (16 + jt) * 1024), 16, 0, 0);
                asm volatile("s_waitcnt vmcnt(20)" ::: "memory");
                if (prevG >= 0) FL[1 + j] = prevG + 1;
                prevG = G; } }
        asm volatile("s_waitcnt vmcnt(0)" ::: "memory");
        if (prevG >= 0) FL[1 + j] = prevG + 1;
        return; }
    int kc = 0;
    for (int ch = blockIdx.x; ch < 128; ch += gridDim.x, ++kc) {
        const int b = ch >> 6, h = (ch >> 2) & 15, iq = ch & 3;
        f32x4 S[4];
#pragma unroll
        for (int jt = 0; jt < 4; ++jt) S[jt] = (f32x4){0.f, 0.f, 0.f, 0.f};
        int j3 = 0;
        for (int n = 0; n < NCH; ++n) { const int G = kc * NCH + n;
            const size_t u = (size_t)(b * NCH + n) * H + h; bf16_t* S0 = (bf16_t*)(ws + WS_S0) + u * 4096;
            { unsigned sp = 0; while (FL[1 + j3] < G + 1) { __builtin_amdgcn_s_sleep(1); if (++sp > (1u << 22)) break; } }
            const LAS unsigned char* slot = lds + SB_RING0 + (G % SB_DEPTH) * SB_SLOT + lane * 16;
            bf16x8 ah[4][2], al[4][2]; f32x4 nn[4];
#pragma unroll
            for (int jt = 0; jt < 4; ++jt) { nn[jt] = *(const LAS f32x4*)(slot + (16 + jt) * 1024);
#pragma unroll
                for (int ks = 0; ks < 2; ++ks) { ah[jt][ks] = *(const LAS bf16x8*)(slot + ((jt * 2 + ks) * 2 + 0) * 1024); al[jt][ks] = *(const LAS bf16x8*)(slot + ((jt * 2 + ks) * 2 + 1) * 1024); } }
#pragma unroll
            for (int jt = 0; jt < 4; ++jt) { unsigned hh[4], ll[4];
#pragma unroll
                for (int r = 0; r < 4; ++r) { hh[r] = f2bf(S[jt][r]); ll[r] = f2bf(S[jt][r] - __builtin_bit_cast(float, hh[r] << 16)); }
                u32x2 wh = {hh[0] | (hh[1] << 16), hh[2] | (hh[3] << 16)}, wl = {ll[0] | (ll[1] << 16), ll[2] | (ll[3] << 16)};
                *(u32x2*)(S0 + (size_t)(16 * iq + fr) * 64 + 16 * jt + 4 * fq) = wh;
                *(LAS u32x2*)(lds + (fr * SST + 16 * jt + 4 * fq) * 2) = wh; *(LAS u32x2*)(lds + 4096 + (fr * SST + 16 * jt + 4 * fq) * 2) = wl; }
            LDS_WAIT();
            bf16x8 bh[2], bl[2];
#pragma unroll
            for (int ks = 0; ks < 2; ++ks) { bh[ks] = *(const LAS bf16x8*)(lds + (fr * SST + 32 * ks + 8 * fq) * 2); bl[ks] = *(const LAS bf16x8*)(lds + 4096 + (fr * SST + 32 * ks + 8 * fq) * 2); }
#pragma unroll
            for (int jt = 0; jt < 4; ++jt) { f32x4 acc = nn[jt];
#pragma unroll
                for (int ks = 0; ks < 2; ++ks) { acc = mfma16(ah[jt][ks], bh[ks], acc); acc = mfma16(ah[jt][ks], bl[ks], acc); acc = mfma16(al[jt][ks], bh[ks], acc); }
                S[jt] = acc; }
            LDS_WAIT();
            FL[0] = G + 1;
            j3 = j3 == 2 ? 0 : j3 + 1;
        }
        float* so = p->out + O_WKVP + (((size_t)li * NB + b) * H + h) * 4096;
#pragma unroll
        for (int jt = 0; jt < 4; ++jt) *(f32x4*)(so + (size_t)(16 * iq + fr) * 64 + 16 * jt + 4 * fq) = S[jt];
    }
}

__device__ __forceinline__ void phase_scanC(KP p, const Ctx& c, int li) {
    unsigned char* ws = p->ws; const int lane = c.lane, fr = lane & 15, fq = lane >> 4, hb = c.wave >> 2, tt = c.wave & 3;
    const float* Vb = (const float*)(ws + (li ? WS_V1 : WS_V0)); const bf16_t* HID = (const bf16_t*)(ws + WS_HID); const bf16_t* W2G = (const bf16_t*)(ws + WS_W2G) + (size_t)li * 1024 * 128;
    bf16_t* YG = (bf16_t*)(ws + WS_YG);
    for (int up = blockIdx.x; up < NUNIT_A / 2; up += gridDim.x) {
        const int u = 2 * up + hb; const int b = u / (NCH * H), n = (u / H) % NCH, h = u % H; const int row = b * TP + 64 * n + 16 * tt + fr;
        const bf16_t* RP = (const bf16_t*)(ws + WS_RP) + (size_t)u * 4096; const float* YL = (const float*)(ws + WS_YL) + (size_t)u * 4096; const bf16_t* S0 = (const bf16_t*)(ws + WS_S0) + (size_t)u * 4096;
        f32x4 acc[4], ag[4];
#pragma unroll
        for (int it = 0; it < 4; ++it) { acc[it] = *(const f32x4*)(YL + (size_t)(16 * tt + fr) * 64 + 16 * it + 4 * fq); ag[it] = (f32x4){0.f, 0.f, 0.f, 0.f}; }
#pragma unroll
        for (int ks = 0; ks < 2; ++ks) { const bf16x8 bq = *(const bf16x8*)(RP + (size_t)(16 * tt + fr) * 64 + 32 * ks + 8 * fq);
#pragma unroll
            for (int it = 0; it < 4; ++it) acc[it] = mfma16(*(const bf16x8*)(S0 + (size_t)(16 * it + fr) * 64 + 32 * ks + 8 * fq), bq, acc[it]); }
        const bf16_t* hgp = launder_p(HID + (size_t)row * LHID + 160 + 8 * fq); const bf16_t* wgp = launder_p(W2G + (size_t)(64 * h + fr) * 128 + 8 * fq);
#pragma unroll
        for (int ks = 0; ks < 4; ++ks) { const bf16x8 bq = *(const bf16x8*)(hgp + 32 * ks);
#pragma unroll
            for (int it = 0; it < 4; ++it) ag[it] = mfma16(*(const bf16x8*)(wgp + it * 16 * 128 + 32 * ks), bq, ag[it]); }
        float s = 0.f;
#pragma unroll
        for (int it = 0; it < 4; ++it) s += (acc[it][0] + acc[it][1]) + (acc[it][2] + acc[it][3]);
        s = sum_rows4(s); const float mean = s * (1.0f / 64.0f);
        float q = 0.f;
#pragma unroll
        for (int it = 0; it < 4; ++it) { const f32x4 d = acc[it] - mean; q += (d[0] * d[0] + d[1] * d[1]) + (d[2] * d[2] + d[3] * d[3]); }
        q = sum_rows4(q); const float rstd = frsq(q * (1.0f / 64.0f) + GN_EPS);
        const float rks = ((const float*)(ws + WS_RKS))[(size_t)row * 16 + h];
#pragma unroll
        for (int it = 0; it < 4; ++it) { const int C = 64 * h + 16 * it + 4 * fq; const size_t pc = (size_t)li * D + C;
            const f32x4 lw = *(const f32x4*)(p->in[I_LNW] + pc), lb = *(const f32x4*)(p->in[I_LNB] + pc), v = *(const f32x4*)(Vb + (size_t)row * D + C);
            const f32x4 o = ((acc[it] - mean) * rstd * lw + lb + v * rks) * ag[it];
            u32x2 w; w.x = pk2(o[0], o[1]); w.y = pk2(o[2], o[3]); *(u32x2*)(YG + (size_t)row * D + C) = w; }
    }
}
__device__ __forceinline__ void ld8bf(const bf16_t* p, float (&o)[8]) { const u32x4 w = *(const u32x4*)p; o[0] = bflo(w.x); o[1] = bfhi(w.x); o[2] = bflo(w.y); o[3] = bfhi(w.y); o[4] = bflo(w.z); o[5] = bfhi(w.z); o[6] = bflo(w.w); o[7] = bfhi(w.w); }
__device__ __forceinline__ void ld8f(const float* p, float (&o)[8]) { const f32x4 a = *(const f32x4*)p, b = *(const f32x4*)(p + 4); o[0] = a[0]; o[1] = a[1]; o[2] = a[2]; o[3] = a[3]; o[4] = b[0]; o[5] = b[1]; o[6] = b[2]; o[7] = b[3]; }
__device__ __forceinline__ void phase_conv(KP p, const Ctx& c, int layer) {
    const bf16_t* U = (const bf16_t*)(p->ws + WS_U); const bf16_t* GT = (const bf16_t*)(p->ws + WS_GT); bf16_t* HH = (bf16_t*)(p->ws + WS_HH);
    const float* cw = p->in[I_CONVW] + (size_t)layer * 3 * DFF; const float* cb = p->in[I_CONVB] + (size_t)layer * DFF; const float* st = p->in[I_SCONV] + (size_t)layer * SB * 2 * DFF;
    constexpr int NF8 = DFF / 8;
    for (int e = c.gtid; e < R * NF8; e += c.gsz) { const int row = e / NF8, f = 8 * (e % NF8);
        int t, b; if (row < MP) { t = row & (TP - 1); b = -1; } else { t = (row - MP) & 3; b = (row - MP) >> 2; }
        float u0[8], u1[8], u2[8], g[8], w0[8], w1[8], w2[8], bb[8];
        ld8bf(U + (size_t)row * DFF + f, u2); ld8bf(GT + (size_t)row * DFF + f, g);
        if (t >= 1) ld8bf(U + (size_t)(row - 1) * DFF + f, u1); else if (b >= 0) ld8f(st + ((size_t)b * 2 + 1) * DFF + f, u1); else {
#pragma unroll
            for (int i = 0; i < 8; ++i) u1[i] = 0.f; }
        if (t >= 2) ld8bf(U + (size_t)(row - 2) * DFF + f, u0); else if (b >= 0) ld8f(st + ((size_t)b * 2 + t) * DFF + f, u0); else {
#pragma unroll
            for (int i = 0; i < 8; ++i) u0[i] = 0.f; }
        ld8f(cw + f, w0); ld8f(cw + DFF + f, w1); ld8f(cw + 2 * DFF + f, w2); ld8f(cb + f, bb);
        float o[8];
#pragma unroll
        for (int i = 0; i < 8; ++i) o[i] = gelu_tanh(bb[i] + w0[i] * u0[i] + w1[i] * u1[i] + w2[i] * u2[i]) * g[i];
        u32x4 w; w.x = pk2(o[0], o[1]); w.y = pk2(o[2], o[3]); w.z = pk2(o[4], o[5]); w.w = pk2(o[6], o[7]);
        *(u32x4*)(HH + (size_t)row * DFF + f) = w; }
}

__device__ __forceinline__ void phase_kvpost(KP p, const Ctx& c) {
    const float* KVF = (const float*)(p->ws + WS_KVF); unsigned char* ws = p->ws; const int lane = c.lane, g = lane >> 4, d0 = 4 * (lane & 15);
    const f32x4 gs = *(const f32x4*)(p->in[I_KNG] + 64 + d0), gw = *(const f32x4*)(p->in[I_KNG] + 128 + d0);
    bf16_t* CA = (bf16_t*)(ws + WS_CMPA); bf16_t* KS = (bf16_t*)(ws + WS_KS); bf16_t* VS = (bf16_t*)(ws + WS_VS); bf16_t* KW = (bf16_t*)(ws + WS_KW); bf16_t* VW = (bf16_t*)(ws + WS_VW);
    for (int chunk = c.gw; chunk < R / 8; chunk += c.ngw) {
        unsigned vs_[4][4], vw_[4][4];
#pragma unroll
        for (int e = 0; e < 8; ++e) { const int row = chunk * 8 + e; const float* src = KVF + (size_t)row * NKV + 4 * lane;
            f32x4 v[6];
#pragma unroll
            for (int pt = 0; pt < 6; ++pt) v[pt] = *(const f32x4*)(src + pt * 256);
            { float s = (v[2][0] * v[2][0] + v[2][1] * v[2][1]) + (v[2][2] * v[2][2] + v[2][3] * v[2][3]);
              s = row16_sum(s); const float rs = frsq(s * (1.0f / 64.0f) + NORM_EPS); v[2] = v[2] * rs * gs; }
            { float s = (v[4][0] * v[4][0] + v[4][1] * v[4][1]) + (v[4][2] * v[4][2] + v[4][3] * v[4][3]);
              s = row16_sum(s); const float rs = frsq(s * (1.0f / 64.0f) + NORM_EPS); v[4] = v[4] * rs * gw; }
            float* okv = p->out + O_KV + (size_t)row * D + 4 * lane;
#pragma unroll
            for (int pt = 0; pt < 4; ++pt) *(f32x4*)(okv + pt * 256) = v[pt];
            if (row < MP) { const int b = row >> 13, t = row & (TP - 1);
                if (t >= TP - WIN) { float* ow = p->out + O_WINP + ((size_t)(b * WIN + (t - (TP - WIN))) * 2) * 256 + 4 * lane; *(f32x4*)ow = v[4]; *(f32x4*)(ow + 256) = v[5]; }
                const size_t hb = (size_t)(b * G + g);
                { u32x2 w; w.x = pk2(v[0][0], v[0][1]); w.y = pk2(v[0][2], v[0][3]); *(u32x2*)(CA + (hb * 512 + (t >> 4)) * 1024 + (t & 15) * 64 + d0) = w; }
                { u32x2 w; w.x = pk2(v[1][0], v[1][1]); w.y = pk2(v[1][2], v[1][3]); *(u32x2*)(CA + ((size_t)4096 + hb * 512 + (t >> 4)) * 1024 + (t & 15) * 64 + d0) = w; }
                { u32x2 w; w.x = pk2(v[2][0], v[2][1]); w.y = pk2(v[2][2], v[2][3]); *(u32x2*)(KS + (hb * TP + t) * 64 + d0) = w; }
                { u32x2 w; w.x = pk2(v[4][0], v[4][1]); w.y = pk2(v[4][2], v[4][3]); *(u32x2*)(KW + (hb * TP + t) * 64 + d0) = w; }
#pragma unroll
                for (int d = 0; d < 4; ++d) { const unsigned a = f2bf(v[3][d]), bq = f2bf(v[5][d]);
                    if (e & 1) { vs_[d][e >> 1] |= a << 16; vw_[d][e >> 1] |= bq << 16; } else { vs_[d][e >> 1] = a; vw_[d][e >> 1] = bq; } }
            } else { const int b = (row - MP) >> 2, t = (row - MP) & 3;
                float* ow = p->out + O_WINS + ((size_t)(b * WIN + 508 + t) * 2) * 256 + 4 * lane; *(f32x4*)ow = v[4]; *(f32x4*)(ow + 256) = v[5]; }
        }
        if (chunk * 8 < MP) { const int row = chunk * 8, b = row >> 13, t = row & (TP - 1); const size_t hb = (size_t)(b * G + g);
#pragma unroll
            for (int d = 0; d < 4; ++d) { *(u32x4*)(VS + (hb * 64 + d0 + d) * TP + t) = (u32x4){vs_[d][0], vs_[d][1], vs_[d][2], vs_[d][3]};
                *(u32x4*)(VW + (hb * 64 + d0 + d) * TP + t) = (u32x4){vw_[d][0], vw_[d][1], vw_[d][2], vw_[d][3]}; } }
    }
}

__device__ __forceinline__ void phase_cmp2(KP p, const Ctx& c) {
    unsigned char* ws = p->ws; const float* PC = (const float*)(ws + WS_PCMP); const int lane = c.lane, fr = lane & 15, fq = lane >> 4;
    const bf16_t* W2H = (const bf16_t*)(ws + WS_CW2T); const bf16_t* W2L = W2H + 2 * 64 * 128;
    constexpr int NPI = NB * G * 32, NSI = SB * G * 8, TOT = 2 * (NPI + NSI);
    for (int it = c.gw; it < TOT; it += c.ngw) {
        const bool samp = it >= 2 * NPI; const int r = samp ? it - 2 * NPI : it; const int kv = samp ? r / NSI : r / NPI; const int idx = samp ? r % NSI : r % NPI;
        const int hb = samp ? (idx >> 3) : (idx >> 5), n0 = 16 * (samp ? (idx & 7) : (idx & 31)), ncmp = samp ? NCMP_S : NCMP_P, nper = samp ? 128 : 512;
        const int n = n0 + fr; const bool live = n < ncmp;
        const size_t prow = (samp ? (size_t)8192 + (size_t)kv * 65536 : (size_t)kv * 4096) + (size_t)hb * nper + (live ? n : ncmp - 1);
        const float* cb = (const float*)(ws + WS_CBIAS) + kv * 128;
        bf16x8 hh[4], hl[4];
#pragma unroll
        for (int ks = 0; ks < 4; ++ks) { const int k0 = 32 * ks + 8 * fq; unsigned uh[8], ul[8];
            const f32x4 a0 = *(const f32x4*)(PC + prow * 256 + k0), a1 = *(const f32x4*)(PC + prow * 256 + k0 + 4);
            const f32x4 b0 = *(const f32x4*)(PC + (prow + 1) * 256 + 128 + k0), b1 = *(const f32x4*)(PC + (prow + 1) * 256 + 128 + k0 + 4);
            const f32x4 c0 = *(const f32x4*)(cb + k0), c1 = *(const f32x4*)(cb + k0 + 4);
#pragma unroll
            for (int e = 0; e < 8; ++e) { const float x = e < 4 ? a0[e] + b0[e] + c0[e] : a1[e - 4] + b1[e - 4] + c1[e - 4]; const float hv = gelu_tanh(x);
                uh[e] = f2bf(hv); ul[e] = f2bf(hv - __builtin_bit_cast(float, uh[e] << 16)); }
            const u32x4 wh = {uh[0] | (uh[1] << 16), uh[2] | (uh[3] << 16), uh[4] | (uh[5] << 16), uh[6] | (uh[7] << 16)}, wl = {ul[0] | (ul[1] << 16), ul[2] | (ul[3] << 16), ul[4] | (ul[5] << 16), ul[6] | (ul[7] << 16)};
            hh[ks] = __builtin_bit_cast(bf16x8, wh); hl[ks] = __builtin_bit_cast(bf16x8, wl); }
        f32x4 acc[4];
#pragma unroll
        for (int dt = 0; dt < 4; ++dt) { acc[dt] = *(const f32x4*)(p->in[I_CB2] + kv * 64 + 16 * dt + 4 * fq);
#pragma unroll
            for (int ks = 0; ks < 4; ++ks) { const size_t wo = (size_t)(kv * 64 + 16 * dt + fr) * 128 + 32 * ks + 8 * fq; const bf16x8 wh = *(const bf16x8*)(W2H + wo), wl = *(const bf16x8*)(W2L + wo);
                acc[dt] = mfma16(wh, hh[ks], acc[dt]); acc[dt] = mfma16(wh, hl[ks], acc[dt]); acc[dt] = mfma16(wl, hh[ks], acc[dt]); } }
        if (kv == 0) { float ss = 0.f;
#pragma unroll
            for (int dt = 0; dt < 4; ++dt) ss += (acc[dt][0] * acc[dt][0] + acc[dt][1] * acc[dt][1]) + (acc[dt][2] * acc[dt][2] + acc[dt][3] * acc[dt][3]);
            ss = sum_rows4(ss); const float rs = frsq(ss * (1.0f / 64.0f) + NORM_EPS);
#pragma unroll
            for (int dt = 0; dt < 4; ++dt) acc[dt] = acc[dt] * rs * *(const f32x4*)(p->in[I_KNG] + 16 * dt + 4 * fq); }
#pragma unroll
        for (int dt = 0; dt < 4; ++dt) { const f32x4 o = live ? acc[dt] : (f32x4){0.f, 0.f, 0.f, 0.f}; const int d = 16 * dt + 4 * fq;
            if (samp) *(f32x4*)((float*)(ws + (kv ? WS_CVS : WS_CKS)) + ((size_t)hb * 128 + n) * 64 + d) = o;
            else if (kv == 0) { u32x2 w; w.x = pk2(o[0], o[1]); w.y = pk2(o[2], o[3]); *(u32x2*)((bf16_t*)(ws + WS_CK) + ((size_t)hb * 512 + n) * 64 + d) = w; }
            else {
#pragma unroll
                for (int e = 0; e < 4; ++e) ((bf16_t*)(ws + WS_CV))[((size_t)hb * 64 + d + e) * 512 + n] = (bf16_t)f2bf(o[e]); } }
    }
}

__device__ __forceinline__ void phase_qpost(KP p, const Ctx& c, int lb) {
    const float* QF = (const float*)(p->ws + WS_QF); bf16_t* Q = (bf16_t*)(p->ws + WS_Q); const int lane = c.lane;
    const f32x4 gq = *(const f32x4*)(p->in[I_QNG] + lb * 64 + 4 * (lane & 15));
    for (int row = c.gw; row < R; row += c.ngw) { const float* src = QF + (size_t)row * NQP;
        f32x4 v[4]; load_row(src, lane, v);
#pragma unroll
        for (int j = 0; j < 4; ++j) { float s = (v[j][0] * v[j][0] + v[j][1] * v[j][1]) + (v[j][2] * v[j][2] + v[j][3] * v[j][3]);
            s = row16_sum(s);
            const float rs = (frsq(s * (1.0f / 64.0f) + NORM_EPS)) * (0.125f * 1.4426950408889634f); v[j] = v[j] * rs * gq; }
        store_row_bf16(Q + (size_t)row * D, lane, v);
    }
}
constexpr int AT_K0 = 0, AT_V0 = 9216, AT_K1 = 18432, AT_V1 = 27648, AT_IMP = 36864, IMPS = 132, AT_SELM = AT_IMP + 64 * IMPS * 4, AT_ANY = AT_SELM + 1024;
static_assert(AT_ANY + 16 <= RING_BYTES, "attention LDS map");
struct TileSrc { const bf16_t* K; const bf16_t* VT; int vts; };
__device__ __forceinline__ void tile_load(const TileSrc& s, int key0, int tid, u32x4& rk, u32x4& rv) {
    const int row = tid >> 3, ch = tid & 7;
    rk = *(const u32x4*)(s.K + (size_t)(key0 + row) * 64 + 8 * ch); rv = *(const u32x4*)(s.VT + (size_t)row * s.vts + key0 + 8 * ch);
}
__device__ __forceinline__ void tile_load_async(const TileSrc& s, int key0, int tid, u32x4& rk, u32x4& rv) {
    const int row = tid >> 3, ch = tid & 7;
    const bf16_t* pk = s.K + (size_t)(key0 + row) * 64 + 8 * ch; const bf16_t* pv = s.VT + (size_t)row * s.vts + key0 + 8 * ch;
    asm volatile("global_load_dwordx4 %0, %2, off\n\tglobal_load_dwordx4 %1, %3, off" : "=&v"(rk), "=&v"(rv) : "v"(pk), "v"(pv) : "memory");
}
#define TILE_WAIT(N_, RK_, RV_) asm volatile("s_waitcnt vmcnt(" #N_ ")" : "+v"(RK_), "+v"(RV_) :: "memory")
__device__ __forceinline__ void tile_store(LAS unsigned char* lds, int buf, int tid, const u32x4& rk, const u32x4& rv) {
    const int row = tid >> 3, ch = tid & 7;
    *(LAS u32x4*)(lds + (buf ? AT_K1 : AT_K0) + (row * SST + 8 * ch) * 2) = rk; *(LAS u32x4*)(lds + (buf ? AT_V1 : AT_V0) + (row * SST + 8 * ch) * 2) = rv;
}
__device__ __forceinline__ int first_bit4(unsigned a, unsigned b, unsigned c, unsigned d) { return a ? __ffs(a) - 1 : (b ? 32 + __ffs(b) - 1 : (c ? 64 + __ffs(c) - 1 : (d ? 96 + __ffs(d) - 1 : -1))); }
__device__ __forceinline__ float ex2(float x) { return __builtin_amdgcn_exp2f(x); }

__device__ __forceinline__ void set_bit4(int s, unsigned& t0, unsigned& t1, unsigned& t2, unsigned& t3) { const unsigned bit = 1u << (s & 31); const int w = s >> 5; t0 |= (w == 0) ? bit : 0u; t1 |= (w == 1) ? bit : 0u; t2 |= (w == 2) ? bit : 0u; t3 |= (w == 3) ? bit : 0u; }
__device__ __forceinline__ void clr_bit4(int s, unsigned& t0, unsigned& t1, unsigned& t2, unsigned& t3) { const unsigned bit = 1u << (s & 31); const int w = s >> 5; t0 &= ~((w == 0) ? bit : 0u); t1 &= ~((w == 1) ? bit : 0u); t2 &= ~((w == 2) ? bit : 0u); t3 &= ~((w == 3) ? bit : 0u); }
__device__ __forceinline__ unsigned get_word4(int s, unsigned a, unsigned b, unsigned c, unsigned d) { const int w = s >> 5; return ((w == 0) ? a : 0u) | ((w == 1) ? b : 0u) | ((w == 2) ? c : 0u) | ((w == 3) ? d : 0u); }
__device__ __forceinline__ float dpp_xor1(float x) { return __builtin_bit_cast(float, __builtin_amdgcn_update_dpp(0, __builtin_bit_cast(int, x), 0xB1, 0xF, 0xF, true)); }
__device__ __forceinline__ float dpp_xor2(float x) { return __builtin_bit_cast(float, __builtin_amdgcn_update_dpp(0, __builtin_bit_cast(int, x), 0x4E, 0xF, 0xF, true)); }
template <int MODE, bool EDGE> __device__ __forceinline__ void attn_tile(LAS unsigned char* lds, int buf, const bf16x8 (&qf)[4], int key0, int qpos, int r, int hf,
                                                                          float& l, f32x16 (&O)[2], float invl, bool selbit, LAS float* impq) {
    if (MODE == 3) { if (__ballot(selbit) == 0ull) { asm volatile("" : "+v"(O[0]), "+v"(O[1]), "+v"(l)); return; } }
    const float sbias = selbit ? 0.f : -1.0e30f;
    const int oK = buf ? AT_K1 : AT_K0, oV = buf ? AT_V1 : AT_V0;
#pragma unroll
    for (int kt = 0; kt < 2; ++kt) {
        f32x16 S;
#pragma unroll
        for (int i = 0; i < 16; ++i) S[i] = (MODE == 3) ? sbias : 0.f;
#pragma unroll
        for (int ks = 0; ks < 4; ++ks) S = mfma32(*(const LAS bf16x8*)(lds + oK + ((32 * kt + r) * SST + 16 * ks + 8 * hf) * 2), qf[ks], S);
        float ls = 0.f;
#pragma unroll
        for (int i = 0; i < 16; ++i) { float pv = ex2(S[i]);
            if (EDGE) { const int key = key0 + 32 * kt + (i & 3) + 8 * (i >> 2) + 4 * hf; bool v;
                if (MODE <= 1) v = (16 * key + 31 <= qpos); else if (MODE == 2) v = (key <= qpos) && (key + WIN > qpos); else v = (key <= qpos);
                pv = v ? pv : 0.f; }
            if (MODE == 1) pv *= invl;
            S[i] = pv; ls += pv; }
        if (MODE != 1) l += ls;
        if (MODE >= 1) {
#pragma unroll
            for (int sp = 0; sp < 2; ++sp) {
                u32x4 pw; pw.x = pg8::cvt_pk_bf16(S[8 * sp + 0], S[8 * sp + 1]); pw.y = pg8::cvt_pk_bf16(S[8 * sp + 2], S[8 * sp + 3]); pw.z = pg8::cvt_pk_bf16(S[8 * sp + 4], S[8 * sp + 5]); pw.w = pg8::cvt_pk_bf16(S[8 * sp + 6], S[8 * sp + 7]);
                const bf16x8 pf = __builtin_bit_cast(bf16x8, pw);
#pragma unroll
                for (int dt = 0; dt < 2; ++dt) { const int d = 32 * dt + r, kb = 32 * kt + 16 * sp + 4 * hf;
                    const u32x2 lo = *(const LAS u32x2*)(lds + oV + (d * SST + kb) * 2), hi = *(const LAS u32x2*)(lds + oV + (d * SST + kb + 8) * 2);
                    const u32x4 vw = {lo.x, lo.y, hi.x, hi.y};
                    O[dt] = mfma32(__builtin_bit_cast(bf16x8, vw), pf, O[dt]); } }
        }
        if (MODE == 1) {
            float own[4], nxt[4];
#pragma unroll
            for (int gq = 0; gq < 4; ++gq) { const float p3 = S[4 * gq + 3]; float o = 2.0f * (S[4 * gq] + S[4 * gq + 1] + S[4 * gq + 2]) + p3, n = p3;
                o += dpp_xor1(o); o += dpp_xor2(o); n += dpp_xor1(n); n += dpp_xor2(n); own[gq] = o; nxt[gq] = n; }
            const int sbb = (key0 >> 2) + 8 * kt + hf;
            if ((r & 3) == 0) {
#pragma unroll
                for (int gq = 0; gq < 4; ++gq) impq[sbb + 2 * gq] += own[gq]; }
            asm volatile("s_waitcnt lgkmcnt(0)" ::: "memory");
            if ((r & 3) == 0) {
#pragma unroll
                for (int gq = 0; gq < 4; ++gq) impq[sbb + 2 * gq + 1] += nxt[gq]; }
            asm volatile("s_waitcnt lgkmcnt(0)" ::: "memory");
        }
    }
}

template <int MODE> __device__ __forceinline__ void run_tiles(LAS unsigned char* lds, const TileSrc& src, unsigned t0, unsigned t1, unsigned t2, unsigned t3, int qt,
                                                              const bf16x8 (&qf)[4], int qpos, int r, int hf, int tid,
                                                              float& l, f32x16 (&O)[2], float invl, unsigned s0, unsigned s1, unsigned s2, unsigned s3, LAS float* impq, const int alias = 0) {
#define TSEL(n_) ((alias ? ((n_) & 7) : (n_)) * 64)
    tid = launder_v(tid); r = tid & 31; hf = (tid >> 5) & 1;
    int cur = first_bit4(t0, t1, t2, t3); if (cur < 0) return;
    const int first = cur;
    clr_bit4(cur, t0, t1, t2, t3); int n1 = first_bit4(t0, t1, t2, t3); if (n1 >= 0) clr_bit4(n1, t0, t1, t2, t3);
    int n2 = first_bit4(t0, t1, t2, t3); if (n2 >= 0) clr_bit4(n2, t0, t1, t2, t3);
    int n3 = first_bit4(t0, t1, t2, t3); if (n3 >= 0) clr_bit4(n3, t0, t1, t2, t3);
    u32x4 rkA, rvA, rkB, rvB, rkC, rvC; { u32x4 rk, rv; tile_load(src, TSEL(cur), tid, rk, rv); int b0 = 0; tile_store(lds, b0, tid, rk, rv); }
    tile_load_async(src, TSEL(n1 >= 0 ? n1 : first), tid, rkA, rvA);
    tile_load_async(src, TSEL(n2 >= 0 ? n2 : first), tid, rkB, rvB);
    tile_load_async(src, TSEL(n3 >= 0 ? n3 : first), tid, rkC, rvC);
    int buf = 0;
    __syncthreads();
#define RT_STEP(RK_, RV_) { \
        if (cur >= 0) { \
            const unsigned sw = get_word4(cur, s0, s1, s2, s3); \
            const bool sb = ((sw >> (cur & 31)) & 1u) != 0u; \
            if (MODE <= 1) attn_tile<MODE, true>(lds, buf, qf, cur * 64, qpos, r, hf, l, O, invl, sb, impq); \
            else { const bool edge = (cur == qt) || (MODE == 2 && cur == qt - 8); \
                if (edge) attn_tile<MODE, true>(lds, buf, qf, cur * 64, qpos, r, hf, l, O, invl, sb, impq); \
                else attn_tile<MODE, false>(lds, buf, qf, cur * 64, qpos, r, hf, l, O, invl, sb, impq); } } \
        TILE_WAIT(4, RK_, RV_); \
        tile_store(lds, buf ^ 1, tid, RK_, RV_); \
        __syncthreads(); \
        const int n4 = first_bit4(t0, t1, t2, t3); if (n4 >= 0) clr_bit4(n4, t0, t1, t2, t3); \
        tile_load_async(src, TSEL(n4 >= 0 ? n4 : first), tid, RK_, RV_); \
        buf ^= 1; cur = n1; n1 = n2; n2 = n3; n3 = n4; }
    do {
        RT_STEP(rkA, rvA)
        RT_STEP(rkB, rvB)
        RT_STEP(rkC, rvC)
    } while (cur >= 0);
#undef RT_STEP
    asm volatile("s_waitcnt vmcnt(0)" : "+v"(rkA), "+v"(rvA), "+v"(rkB), "+v"(rvB), "+v"(rkC), "+v"(rvC) :: "memory");
    __syncthreads();
}
__device__ __forceinline__ void attn_prompt_unit(KP p, const Ctx& c, int k, const int stop) {
    LAS unsigned char* lds = c.lds; unsigned char* ws = p->ws; int tid_m; asm volatile("v_mbcnt_lo_u32_b32 %0, -1, 0\n\tv_mbcnt_hi_u32_b32 %0, -1, %0" : "=v"(tid_m));
    const int wave = c.wave, tid = tid_m + 64 * wave, lane = tid & 63, r = lane & 31, hf = lane >> 5;
    const int qt = 127 - (k >> 3), hb = k & 7, b = hb >> 2, g = hb & 3, q0 = 64 * qt;
    const int qi = 8 * wave + (r >> 2), head = 4 * g + (r & 3), qpos = q0 + qi, row = b * TP + qpos;
    const bf16_t* Q = (const bf16_t*)(ws + WS_Q);
    bf16x8 qf[4];
#pragma unroll
    for (int ks = 0; ks < 4; ++ks) qf[ks] = *(const bf16x8*)(Q + (size_t)row * D + head * 64 + 16 * ks + 8 * hf);
    const float* gate = (const float*)(ws + WS_GATE) + (size_t)row * 48 + head * 3; const float g_c = gate[0], g_s = gate[1], g_w = gate[2];
    LAS float* imp = (LAS float*)(lds + AT_IMP); LAS unsigned* selm = (LAS unsigned*)(lds + AT_SELM); LAS unsigned* anym = (LAS unsigned*)(lds + AT_ANY);
    for (int e = tid; e < 64 * IMPS; e += 512) imp[e] = 0.f;
    if (tid < 4) anym[tid] = 0u;
    __syncthreads();
    f32x16 O[2]; unsigned OUTP[2][8];
#pragma unroll
    for (int dt = 0; dt < 2; ++dt)
#pragma unroll
        for (int i = 0; i < 16; ++i) O[dt][i] = 0.f;
    {
        const TileSrc src{(const bf16_t*)(ws + WS_CK) + (size_t)hb * 512 * 64, (const bf16_t*)(ws + WS_CV) + (size_t)hb * 64 * 512, 512};
        const int nmax = q0 + 63 - 31; const int ntc = nmax >= 0 ? (nmax >> 10) + 1 : 0;
        const unsigned tm = ntc >= 32 ? 0xffffffffu : ((1u << ntc) - 1u);
        float l = 0.f;
        run_tiles<0>(lds, src, tm, 0u, 0u, 0u, qt, qf, qpos, r, hf, tid, l, O, 0.f, 0u, 0u, 0u, 0u, imp);
        l = sum_xor32(l); const float invl = l > 0.f ? 1.0f / l : 0.f;
        run_tiles<1>(lds, src, tm, 0u, 0u, 0u, qt, qf, qpos, r, hf, tid, l, O, invl, 0u, 0u, 0u, 0u, imp + qi * IMPS);
#pragma unroll
        for (int dt = 0; dt < 2; ++dt) {
#pragma unroll
            for (int i = 0; i < 8; ++i) { OUTP[dt][i] = pg8::cvt_pk_bf16(O[dt][2 * i] * g_c, O[dt][2 * i + 1] * g_c); asm volatile("" : "+v"(OUTP[dt][i])); }
#pragma unroll
            for (int i = 0; i < 16; ++i) O[dt][i] = 0.f; }
    }
    __syncthreads();
    if (stop == 1) return;
    for (int e = 0; e < 8; ++e) { const int qq = 8 * wave + e, qp = q0 + qq, qb = qp >> 6;
        const bool c0 = (64 * lane <= qp), c1 = (64 * (lane + 64) <= qp);
        const unsigned k0 = (lane == 0 || lane == qb || lane == qb - 1) ? 0xffffffffu : __builtin_bit_cast(unsigned, imp[qq * IMPS + lane]);
        const unsigned k1 = (lane + 64 == qb || lane + 64 == qb - 1) ? 0xffffffffu : __builtin_bit_cast(unsigned, imp[qq * IMPS + lane + 64]);
        const int K = qb + 1 < 16 ? qb + 1 : 16;
        unsigned T = 0u;
        for (int bit = 31; bit >= 0; --bit) { const unsigned cand = T | (1u << bit);
            const int cnt = __popcll(__ballot(c0 && k0 >= cand)) + __popcll(__ballot(c1 && k1 >= cand)); if (cnt >= K) T = cand; }
        unsigned long long mlo = __ballot(c0 && k0 > T), mhi = __ballot(c1 && k1 > T), elo = __ballot(c0 && k0 == T), ehi = __ballot(c1 && k1 == T);
        int need = K - (__popcll(mlo) + __popcll(mhi));
        for (; need > 0; --need) { if (elo) { mlo |= elo & (~elo + 1ull); elo &= elo - 1ull; } else { mhi |= ehi & (~ehi + 1ull); ehi &= ehi - 1ull; } }
        const unsigned m0 = (unsigned)mlo, m1 = (unsigned)(mlo >> 32), m2 = (unsigned)mhi, m3 = (unsigned)(mhi >> 32);
        if (lane == 0) { selm[qq * 4 + 0] = m0; selm[qq * 4 + 1] = m1; selm[qq * 4 + 2] = m2; selm[qq * 4 + 3] = m3;
            atomicOr((unsigned*)&anym[0], m0); atomicOr((unsigned*)&anym[1], m1); atomicOr((unsigned*)&anym[2], m2); atomicOr((unsigned*)&anym[3], m3); } }
    __syncthreads();
    if (stop == 2) return;
    {
        const TileSrc src{(const bf16_t*)(ws + WS_KW) + (size_t)hb * TP * 64, (const bf16_t*)(ws + WS_VW) + (size_t)hb * 64 * TP, TP};
        const int tlo = qt >= 8 ? qt - 8 : 0; unsigned t0 = 0u, t1 = 0u, t2 = 0u, t3 = 0u;
        for (int s = tlo; s <= qt; ++s) set_bit4(s, t0, t1, t2, t3);
        float l = 0.f;
        run_tiles<2>(lds, src, t0, t1, t2, t3, qt, qf, qpos, r, hf, tid, l, O, 0.f, 0u, 0u, 0u, 0u, imp);
        l = sum_xor32(l); const float sc = l > 0.f ? g_w / l : 0.f;
#pragma unroll
        for (int dt = 0; dt < 2; ++dt) {
#pragma unroll
            for (int i = 0; i < 8; ++i) { OUTP[dt][i] = pg8::cvt_pk_bf16(bflo(OUTP[dt][i]) + O[dt][2 * i] * sc, bfhi(OUTP[dt][i]) + O[dt][2 * i + 1] * sc); asm volatile("" : "+v"(OUTP[dt][i])); }
#pragma unroll
            for (int i = 0; i < 16; ++i) O[dt][i] = 0.f; }
    }
    if (stop == 3) { __syncthreads(); return; }
    {
        const TileSrc src{(const bf16_t*)(ws + WS_KS) + (size_t)hb * TP * 64, (const bf16_t*)(ws + WS_VS) + (size_t)hb * 64 * TP, TP};
        const unsigned sz_ = (stop == 5) ? 0u : 0xffffffffu;
        const unsigned s0 = selm[qi * 4 + 0] & sz_, s1 = selm[qi * 4 + 1] & sz_, s2 = selm[qi * 4 + 2] & sz_, s3 = selm[qi * 4 + 3] & sz_;
        const unsigned a0 = __builtin_amdgcn_readfirstlane(anym[0]), a1 = __builtin_amdgcn_readfirstlane(anym[1]), a2 = __builtin_amdgcn_readfirstlane(anym[2]), a3 = __builtin_amdgcn_readfirstlane(anym[3]);
        float l = 0.f;
        run_tiles<3>(lds, src, a0, a1, a2, a3, qt, qf, qpos, r, hf, tid, l, O, 0.f, s0, s1, s2, s3, imp, stop == 4 ? 1 : 0);
        if (stop >= 4) { if (l == 12345.678f) ((float*)(ws + WS_GATE))[0] = O[0][0] + O[1][0]; __syncthreads(); return; }
        l = sum_xor32(l); const float sc = l > 0.f ? g_s / l : 0.f;
#pragma unroll
        for (int dt = 0; dt < 2; ++dt)
#pragma unroll
            for (int i = 0; i < 8; ++i) OUTP[dt][i] = pg8::cvt_pk_bf16(bflo(OUTP[dt][i]) + O[dt][2 * i] * sc, bfhi(OUTP[dt][i]) + O[dt][2 * i + 1] * sc);
    }
    bf16_t* AO = (bf16_t*)(ws + WS_YG) + (size_t)row * D + head * 64;
#pragma unroll
    for (int dt = 0; dt < 2; ++dt)
#pragma unroll
        for (int gq = 0; gq < 4; ++gq) { u32x2 w; w.x = OUTP[dt][2 * gq]; w.y = OUTP[dt][2 * gq + 1]; *(u32x2*)(AO + 32 * dt + 8 * gq + 4 * hf) = w; }
    __syncthreads();
}

constexpr int SA_RED = 0, SA_REDW = 2 * 16 * 65 * 4, SA_OC = SA_RED + SA_REDW, SA_EC = SA_OC + 2 * 4096, SA_LC = SA_EC + 2 * 4096, SA_PN = SA_LC + 256, SA_SEL = SA_PN + 4 * 512;
static_assert(SA_SEL + 64 <= RING_BYTES, "sample attention LDS map");
__device__ __forceinline__ bf16x8 pack8(const f32x4 a, const f32x4 b) { const u32x4 w = {pk2(a[0], a[1]), pk2(a[2], a[3]), pk2(b[0], b[1]), pk2(b[2], b[3])}; return __builtin_bit_cast(bf16x8, w); }
__device__ __forceinline__ void sa_qk(const float* kb, size_t stride, int nrows, const bf16x8 (&qf)[2], int fr, int fq, f32x4 (&S)[4]) {
    f32x4 kr[4][2][2];
#pragma unroll
    for (int kg = 0; kg < 4; ++kg) { const int key = 16 * kg + fr; const float* rp = kb + (size_t)(key < nrows ? key : nrows - 1) * stride + 8 * fq;
#pragma unroll
        for (int ks = 0; ks < 2; ++ks) { kr[kg][ks][0] = *(const f32x4*)(rp + 32 * ks); kr[kg][ks][1] = *(const f32x4*)(rp + 32 * ks + 4); } }
#pragma unroll
    for (int kg = 0; kg < 4; ++kg) { S[kg] = (f32x4){0.f, 0.f, 0.f, 0.f};
#pragma unroll
        for (int ks = 0; ks < 2; ++ks) S[kg] = mfma16(pack8(kr[kg][ks][0], kr[kg][ks][1]), qf[ks], S[kg]); }
}
__device__ __forceinline__ void sa_pv(const float* vb, size_t stride, int nrows, const f32x4 (&P)[4], int fr, int fq, f32x4 (&O)[4]) {
#pragma unroll
    for (int ks = 0; ks < 2; ++ks) { const bf16x8 pa = pack8(P[2 * ks], P[2 * ks + 1]);
        float vv[4][8];
#pragma unroll
        for (int j = 0; j < 8; ++j) { const int key = 16 * (2 * ks + (j >> 2)) + 4 * fq + (j & 3); const float* rp = vb + (size_t)(key < nrows ? key : nrows - 1) * stride + fr;
#pragma unroll
            for (int dt = 0; dt < 4; ++dt) vv[dt][j] = rp[16 * dt]; }
#pragma unroll
        for (int dt = 0; dt < 4; ++dt) { const u32x4 w = {pk2(vv[dt][0], vv[dt][1]), pk2(vv[dt][2], vv[dt][3]), pk2(vv[dt][4], vv[dt][5]), pk2(vv[dt][6], vv[dt][7])};
            O[dt] = mfma16(pa, __builtin_bit_cast(bf16x8, w), O[dt]); } }
}
__device__ __forceinline__ void attn_sample_unit(KP p, const Ctx& c, int item) {
    unsigned char* ws = p->ws; LAS unsigned char* lds = c.lds; const int tid = launder_v(c.tid), lane = tid & 63, wave = c.wave, fr = lane & 15, fq = lane >> 4; const int b = item >> 2, g = item & 3;
    bf16x8 qf[2];
    { const bf16_t* Q = (const bf16_t*)(ws + WS_Q) + (size_t)(MP + 4 * b + (fr >> 2)) * D + (4 * g + (fr & 3)) * 64 + 8 * fq;
      qf[0] = *(const bf16x8*)Q; qf[1] = *(const bf16x8*)(Q + 32); }
    const int tokm = fr >> 2;
    if (wave < 2) {
        const float* ck = (const float*)(ws + WS_CKS) + ((size_t)(b * 4 + g) * 128 + 64 * wave) * 64; const float* cv = (const float*)(ws + WS_CVS) + ((size_t)(b * 4 + g) * 128 + 64 * wave) * 64;
        const int nrows = wave ? 63 : 64;
        f32x4 S[4]; sa_qk(ck, 64, nrows, qf, fr, fq, S);
        float ls = 0.f;
#pragma unroll
        for (int kg = 0; kg < 4; ++kg)
#pragma unroll
            for (int r = 0; r < 4; ++r) { const int key = 16 * kg + 4 * fq + r; const float ev = key < nrows ? ex2(S[kg][r]) : 0.f; S[kg][r] = ev; ls += ev;
                *(LAS float*)(lds + SA_EC + wave * 4096 + (key * 16 + fr) * 4) = ev; }
        ls = sum_rows4(ls); if (fq == 0) *(LAS float*)(lds + SA_LC + (wave * 16 + fr) * 4) = ls;
        f32x4 oc[4];
#pragma unroll
        for (int dt = 0; dt < 4; ++dt) oc[dt] = (f32x4){0.f, 0.f, 0.f, 0.f};
        sa_pv(cv, 64, nrows, S, fr, fq, oc);
#pragma unroll
        for (int dt = 0; dt < 4; ++dt)
#pragma unroll
            for (int r = 0; r < 4; ++r) *(LAS float*)(lds + SA_OC + wave * 4096 + ((4 * fq + r) * 64 + 16 * dt + fr) * 4) = oc[dt][r];
    }
    __syncthreads();
    if (wave < 4) { const int tok = wave; float P0 = 0.f, P1 = 0.f;
#pragma unroll
        for (int hh = 0; hh < 4; ++hh) { const int pi = tok * 4 + hh; const float L = *(const LAS float*)(lds + SA_LC + pi * 4) + *(const LAS float*)(lds + SA_LC + (16 + pi) * 4); const float inv = L > 0.f ? 1.0f / L : 0.f;
            P0 += *(const LAS float*)(lds + SA_EC + (lane * 16 + pi) * 4) * inv; P1 += *(const LAS float*)(lds + SA_EC + 4096 + (lane * 16 + pi) * 4) * inv; }
        LAS float* pn = (LAS float*)(lds + SA_PN + tok * 512); pn[lane] = P0; pn[64 + lane] = P1; LDS_WAIT();
        float v0 = -1e9f;
        if (lane < 33) { const int s = lane; float im = 0.f;
            if (4 * s - 1 >= 0 && 4 * s - 1 < 128) im += pn[4 * s - 1];
#pragma unroll
            for (int j = 0; j < 3; ++j) if (4 * s + j < 128) im += 2.0f * pn[4 * s + j];
            if (4 * s + 3 < 128) im += pn[4 * s + 3];
            v0 = (s == 0 || s == 31 || s == 32) ? 1e9f : im; }
        unsigned selmask = 0u, sel32 = 0u;
        for (int it = 0; it < 16; ++it) { const float mx = wave_max(v0); if (mx < -5e8f) break; const unsigned long long b0 = __ballot(v0 == mx); const int s = __ffsll((long long)b0) - 1;
            if (lane == s) v0 = -2e9f; if (s < 32) selmask |= 1u << s; else sel32 = 1u; }
        if (lane == 0) { *(LAS unsigned*)(lds + SA_SEL + tok * 8) = selmask; *(LAS unsigned*)(lds + SA_SEL + tok * 8 + 4) = sel32; } }
    __syncthreads();
    unsigned sm[4], s32[4];
#pragma unroll
    for (int t = 0; t < 4; ++t) { sm[t] = *(const LAS unsigned*)(lds + SA_SEL + t * 8); s32[t] = *(const LAS unsigned*)(lds + SA_SEL + t * 8 + 4); }
    const unsigned un = sm[0] | sm[1] | sm[2] | sm[3]; const int nsel = __popc(un); const int has32 = (s32[0] | s32[1] | s32[2] | s32[3]) ? 1 : 0;
    const unsigned my_sm = tokm == 0 ? sm[0] : (tokm == 1 ? sm[1] : (tokm == 2 ? sm[2] : sm[3])), my_s32 = tokm == 0 ? s32[0] : (tokm == 1 ? s32[1] : (tokm == 2 ? s32[2] : s32[3]));
    const int ntile = nsel + has32 + 9;
    const int* pt = (const int*)p->in[I_PT] + b * NPAGES;
    f32x4 osel[4], owin[4]; float lsel = 0.f, lwin = 0.f;
#pragma unroll
    for (int dt = 0; dt < 4; ++dt) { osel[dt] = (f32x4){0.f, 0.f, 0.f, 0.f}; owin[dt] = (f32x4){0.f, 0.f, 0.f, 0.f}; }
    for (int ti = wave; ti < ntile; ti += 8) {
        const float* kb; size_t stride; int nrows = 64, br, mode, sidx = 0;
        if (ti < nsel) { unsigned m = un; for (int q = 0; q < ti; ++q) m &= m - 1u; sidx = __ffs(m) - 1; const int page = pt[sidx >> 1];
            kb = p->in[I_CKV] + ((size_t)page * PAGE + (sidx & 1) * 64) * 1024 + 2 * 256 + g * 64; stride = 1024; br = 0; mode = 0; }
        else if (ti < nsel + has32) { kb = p->out + O_KV + (size_t)(MP + 4 * b) * D + 2 * 256 + g * 64; stride = 1024; nrows = 4; br = 0; mode = 1; }
        else if (ti < nsel + has32 + 8) { sidx = ti - nsel - has32; kb = p->in[I_CWIN] + ((size_t)b * WIN + 64 * sidx) * 512 + g * 64; stride = 512; br = 1; mode = 2; }
        else { kb = p->out + O_WINS + ((size_t)(b * WIN + 508) * 2) * 256 + g * 64; stride = 512; nrows = 4; br = 1; mode = 3; }
        f32x4 S[4]; sa_qk(kb, stride, nrows, qf, fr, fq, S);
        float ls = 0.f;
#pragma unroll
        for (int kg = 0; kg < 4; ++kg)
#pragma unroll
            for (int r = 0; r < 4; ++r) { const int key = 16 * kg + 4 * fq + r; bool valid;
                if (mode == 0) valid = ((my_sm >> sidx) & 1u) != 0u; else if (mode == 1) valid = (my_s32 != 0u) && (key <= tokm); else if (mode == 2) valid = (64 * sidx + key) >= tokm + 1; else valid = key <= tokm;
                const float ev = valid ? ex2(S[kg][r]) : 0.f; S[kg][r] = ev; ls += ev; }
        if (br == 0) { lsel += ls; sa_pv(kb + 256, stride, nrows, S, fr, fq, osel); } else { lwin += ls; sa_pv(kb + 256, stride, nrows, S, fr, fq, owin); }
    }
    lsel = sum_rows4(lsel); lwin = sum_rows4(lwin);
    for (int w = 0; w < 8; ++w) {
        if (wave == w) {
#pragma unroll
            for (int dt = 0; dt < 4; ++dt)
#pragma unroll
                for (int r = 0; r < 4; ++r) { LAS float* r0 = (LAS float*)(lds + SA_RED + ((4 * fq + r) * 65 + 16 * dt + fr) * 4); LAS float* r1 = (LAS float*)(lds + SA_RED + ((16 + 4 * fq + r) * 65 + 16 * dt + fr) * 4);
                    if (w == 0) { *r0 = osel[dt][r]; *r1 = owin[dt][r]; } else { *r0 += osel[dt][r]; *r1 += owin[dt][r]; } }
            if (fq == 0) { LAS float* l0 = (LAS float*)(lds + SA_RED + (fr * 65 + 64) * 4); LAS float* l1 = (LAS float*)(lds + SA_RED + ((16 + fr) * 65 + 64) * 4);
                if (w == 0) { *l0 = lsel; *l1 = lwin; } else { *l0 += lsel; *l1 += lwin; } } }
        __syncthreads(); }
    { const float* gt = (const float*)(ws + WS_GATE); bf16_t* AO = (bf16_t*)(ws + WS_YG);
      for (int e = tid; e < 1024; e += 512) { const int pi = e >> 6, d = e & 63, tok = pi >> 2, hh = pi & 3; const size_t row = (size_t)(MP + 4 * b + tok);
          const float lc = *(const LAS float*)(lds + SA_LC + pi * 4) + *(const LAS float*)(lds + SA_LC + (16 + pi) * 4);
          const float oc = *(const LAS float*)(lds + SA_OC + (pi * 64 + d) * 4) + *(const LAS float*)(lds + SA_OC + 4096 + (pi * 64 + d) * 4);
          const LAS float* r0 = (const LAS float*)(lds + SA_RED + (pi * 65) * 4); const LAS float* r1 = (const LAS float*)(lds + SA_RED + ((16 + pi) * 65) * 4);
          const float* gg = gt + row * 48 + (4 * g + hh) * 3;
          float out = lc > 0.f ? gg[0] * oc / lc : 0.f;
          out += r0[64] > 0.f ? gg[1] * r0[d] / r0[64] : 0.f;
          out += r1[64] > 0.f ? gg[2] * r1[d] / r1[64] : 0.f;
          AO[row * D + (4 * g + hh) * 64 + d] = (bf16_t)f2bf(out); } }
    __syncthreads();
}

__device__ __forceinline__ void phase_attn_prompt(KP p, const Ctx& c, const int stop = 0) {
    const int Gd = gridDim.x, cb = blockIdx.x;
    for (int i = 0; i * Gd < 1024; ++i) { const int k = i * Gd + ((i & 1) ? Gd - 1 - cb : cb); if (k < 1024) attn_prompt_unit(p, c, k, stop); }
}
__device__ __forceinline__ void phase_attn_sample(KP p, const Ctx& c) {
    for (int it = blockIdx.x; it < SB * G; it += gridDim.x) attn_sample_unit(p, c, it);
}
#ifndef MK_MULTI
#define MK_MULTI 0
#endif
#if defined(PROBE_SCALE) || defined(SELFTEST)
constexpr int NPH = 46;
#elif defined(PROBE_ATTN2)
constexpr int NPH = 47;
#else
constexpr int NPH = 45;
#endif
#ifdef SPLITK
#define RESID_SPLIT(n) (n)
#else
#define RESID_SPLIT(n) 0
#endif

__global__ void __launch_bounds__(512, 2) mega(Params p) {
    extern __shared__ __attribute__((aligned(16))) unsigned char lds_raw[];
    LAS unsigned char* const lds0 = (LAS unsigned char*)lds_raw;
    volatile LAS unsigned* MISC = (volatile LAS unsigned*)(lds0 + MISC_OFF);
    for (int u = threadIdx.x; u < (LDS_BYTES - RING_BYTES) / 4; u += 512) ((LAS unsigned*)(lds0 + RING_BYTES))[u] = 0u;
    __syncthreads();
    const KP kp0 = (KP)__builtin_amdgcn_kernarg_segment_ptr();
    const int ph_lo = kp0->ph_lo, ph_hi = kp0->ph_hi, use_bar = kp0->use_bar;
    XcdBarrier bar; bar.bar = (unsigned*)(kp0->ws + WS_CTL); bar.x = 0; bar.st = nullptr;
    if (use_bar) bar = xcd_barrier_post((unsigned*)(kp0->ws + WS_CTL), MISC + 8);
    const int wave_s = __builtin_amdgcn_readfirstlane((int)threadIdx.x >> 6);
#define TID_MBCNT 1
#ifdef TID_MBCNT
#define TID_SRC(T_) asm volatile("v_mbcnt_lo_u32_b32 %0, -1, 0\n\tv_mbcnt_hi_u32_b32 %0, -1, %0" : "=v"(T_)); T_ += 64 * wave_s;
#else
#define TID_SRC(T_) T_ = threadIdx.x; asm volatile("" : "+v"(T_));
#endif
    int ph = 0;
#define PHASE_BEGIN if (ph >= ph_lo && ph < ph_hi) { KP p = kp0; asm volatile("" : "+s"(p)); int tid_; TID_SRC(tid_) \
        Ctx c; c.lds = lds0; c.tid = tid_; c.lane = tid_ & 63; c.wave = __builtin_amdgcn_readfirstlane(tid_ >> 6); c.gw = blockIdx.x * 8 + c.wave; c.ngw = gridDim.x * 8; c.gtid = blockIdx.x * 512 + tid_; c.gsz = gridDim.x * 512; \
        unsigned char* ws = p->ws; float* X = p->out + O_Y; (void)ws; (void)X;
#define PHASE_END   if (use_bar) { int te_; TID_SRC(te_) xcd_barrier(bar, te_ == 0); } } ++ph;

    PHASE_BEGIN phase_prologue(p, c); PHASE_END
#ifdef PROBE_BAR
    for (int xb = 0; xb < PROBE_BAR; ++xb) { if (use_bar) xcd_barrier(bar, threadIdx.x == 0); }
#endif

    for (int layer = 0; layer < NLAY; ++layer) {
        if (layer < 2) {
            const int li = layer;
            PHASE_BEGIN phase_mix(p, c, li); PHASE_END
            PHASE_BEGIN {
                pg8::Gemm g{(const bf16_t*)(ws + WS_XM), (const bf16_t*)(ws + WS_WRKV) + (size_t)li * 3072 * 1024, 3 * R, 3072, 1024, 1024};
                pg8::GroupOrder S; S.init((int)gridDim.x, (int)blockIdx.x); S.add(0, 0, 64, 0, 4); S.add(1, 66, 64, 4, 4); S.add(2, 132, 64, 8, 4);
                pg8::EpiF32G E{(float*)(ws + WS_RK_R), (float*)(ws + WS_RK_K), (float*)(ws + (li ? WS_V1 : WS_V0)), nullptr, D, 4, 66};
                pg8::gemm_phase<pg8::EpiF32G, pg8::GroupOrder, true, true>(c.lds, g, S, E, c.tid);
                {
                    const bf16_t* XMs = (const bf16_t*)(ws + WS_XM); const bf16_t* Wr = (const bf16_t*)(ws + WS_WRKV) + (size_t)li * 3072 * 1024;
                    for (int it = blockIdx.x + gridDim.x * c.wave; it < 768; it += c.ngw) { const int j = it >> 8, r = it & 255, row0 = MP + 32 * (r & 15), col0 = 64 * (r >> 4);
                        float* C = (float*)(ws + (j == 0 ? WS_RK_R : (j == 1 ? WS_RK_K : (li ? WS_V1 : WS_V0))));
                        f32x4 acc[4][2]; skinny_mma<4>(XMs + (size_t)j * R * D, 1024, Wr + (size_t)j * 1024 * 1024, 1024, 1024, row0, col0, c.lane, acc);
                        const int fr = c.lane & 15, fq = c.lane >> 4;
#pragma unroll
                        for (int nt = 0; nt < 4; ++nt)
#pragma unroll
                            for (int mt = 0; mt < 2; ++mt) *(f32x4*)(C + (size_t)(row0 + 16 * mt + fr) * D + col0 + 16 * nt + 4 * fq) = acc[nt][mt]; }
                }
                phase_lora1(p, c, li);
            } PHASE_END
            PHASE_BEGIN phase_scanA(p, c, li); PHASE_END
            PHASE_BEGIN phase_scanB(p, c, li); PHASE_END
            PHASE_BEGIN phase_scanC(p, c, li); PHASE_END
        } else {
            const int lb = layer - 2;
            if (layer == 2) {
                PHASE_BEGIN phase_norm(c, X, p->in[I_KVNG], (bf16_t*)(ws + WS_XN2), p->in[I_NORMG] + (size_t)(layer * 2) * D, (bf16_t*)(ws + WS_XN)); PHASE_END
                PHASE_BEGIN {
                    pg8::Gemm g{(const bf16_t*)(ws + WS_XN2), (const bf16_t*)(ws + WS_WKVT), R, NKV, 1024, 1024};
                    pg8::GroupOrder S; S.init((int)gridDim.x, (int)blockIdx.x); S.add(0, 0, 66, 0, 6);
                    pg8::EpiF32G E{(float*)(ws + WS_KVF), nullptr, nullptr, nullptr, NKV, 1 << 20, 0};
                    pg8::gemm_phase<pg8::EpiF32G, pg8::GroupOrder, true, true>(c.lds, g, S, E, c.tid);
                } PHASE_END
                PHASE_BEGIN phase_kvpost(p, c); PHASE_END
                PHASE_BEGIN {
                    pg8::Gemm g{(const bf16_t*)(ws + WS_CMPA), (const bf16_t*)(ws + WS_CW1T), (int)CMPA_ROWS, 512, 1024, 1024};
                    pg8::GroupOrder S; S.init((int)gridDim.x, (int)blockIdx.x); S.add(0, 0, 16, 0, 1); S.add(1, 16, 16, 1, 1); S.add(2, 32, 256, 0, 1); S.add(3, 288, 256, 1, 1);
                    pg8::EpiF32G E{(float*)(ws + WS_PCMP), (float*)(ws + WS_PCMP), nullptr, nullptr, 256, 1, 0};
                    pg8::gemm_phase<pg8::EpiF32G, pg8::GroupOrder, true, true>(c.lds, g, S, E, c.tid);
                } PHASE_END
                PHASE_BEGIN phase_cmp2(p, c); PHASE_END
            } else {
                PHASE_BEGIN phase_norm(c, X, p->in[I_NORMG] + (size_t)(layer * 2) * D, (bf16_t*)(ws + WS_XN), nullptr, nullptr); PHASE_END
            }
            PHASE_BEGIN {
                const bf16_t* XNp = (const bf16_t*)(ws + WS_XN); const bf16_t* Wq = (const bf16_t*)(ws + WS_WQT) + (size_t)lb * NQP * 1024; float* QFp = (float*)(ws + WS_QF);
                pg8::Gemm g{XNp, Wq, R, NQP, 1024, 1024};
                pg8::GroupOrder S; S.init((int)gridDim.x, (int)blockIdx.x); S.add(0, 0, 64, 0, 4);
                pg8::EpiF32G E{QFp, nullptr, nullptr, nullptr, NQP, 1 << 20, 0};
                pg8::gemm_phase<pg8::EpiF32G, pg8::GroupOrder, true, true>(c.lds, g, S, E, c.tid);
                float* GATEp = (float*)(ws + WS_GATE);
                for (int it = blockIdx.x + gridDim.x * c.wave; it < 256 + R / 32; it += c.ngw) { const int ln = launder_v(c.lane), fr = ln & 15, fq = ln >> 4;
                    if (it < 256) { const int row0 = MP + 32 * (it & 15), col0 = 64 * (it >> 4);
                        f32x4 acc[4][2]; skinny_mma<4>(XNp, 1024, Wq, 1024, 1024, row0, col0, ln, acc);
#pragma unroll
                        for (int nt = 0; nt < 4; ++nt)
#pragma unroll
                            for (int mt = 0; mt < 2; ++mt) *(f32x4*)(QFp + (size_t)(row0 + 16 * mt + fr) * NQP + col0 + 16 * nt + 4 * fq) = acc[nt][mt]; }
                    else { const int row0 = 32 * (it - 256);
                        f32x4 acc[3][2]; skinny_mma<3>(XNp, 1024, Wq, 1024, 1024, row0, 1024, ln, acc);
#pragma unroll
                        for (int nt = 0; nt < 3; ++nt)
#pragma unroll
                            for (int mt = 0; mt < 2; ++mt) { f32x4 v = acc[nt][mt];
#pragma unroll
                                for (int e = 0; e < 4; ++e) v[e] = sigmoidf_(v[e]);
                                *(f32x4*)(GATEp + (size_t)(row0 + 16 * mt + fr) * 48 + 16 * nt + 4 * fq) = v; } }
                }
            } PHASE_END
            PHASE_BEGIN phase_qpost(p, c, lb); PHASE_END
            PHASE_BEGIN phase_attn_prompt(p, c); PHASE_END
#ifdef PROBE_ATTN2
            PHASE_BEGIN phase_attn_prompt(p, c, PROBE_ATTN2); PHASE_END
#endif
            PHASE_BEGIN phase_attn_sample(p, c); PHASE_END
        }
        PHASE_BEGIN {
            const bf16_t* Wt = layer < 2 ? (const bf16_t*)(ws + WS_WORW) + (size_t)layer * 1024 * 1024 : (const bf16_t*)(ws + WS_WONSA) + (size_t)(layer - 2) * 1024 * 1024;
            pg8::Gemm g{(const bf16_t*)(ws + WS_YG), Wt, R, 1024, 1024, 1024};
            pg8::GroupOrder S; S.init((int)gridDim.x, (int)blockIdx.x); S.add(0, 0, 64, 0, 4);
            pg8::EpiResid E{X, D};
            pg8::gemm_phase<pg8::EpiResid, pg8::GroupOrder, true, true>(c.lds, g, S, E, c.tid);
            skinny_resid_sample(c, (const bf16_t*)(ws + WS_YG), 1024, Wt, 1024, X);
        } PHASE_END
        PHASE_BEGIN phase_norm(c, X, p->in[I_NORMG] + (size_t)(layer * 2 + 1) * D, (bf16_t*)(ws + WS_XN), nullptr, nullptr); PHASE_END
        PHASE_BEGIN {
            pg8::Gemm g{(const bf16_t*)(ws + WS_XN), (const bf16_t*)(ws + WS_WINT) + (size_t)layer * 5632 * 1024, R, 5632, 1024, 1024};
            pg8::GroupOrder S; S.init((int)gridDim.x, (int)blockIdx.x); S.add(0, 0, 66, 0, 22);
            pg8::EpiWin E{(bf16_t*)(ws + WS_U), (bf16_t*)(ws + WS_GT), p->out + O_CVP + (size_t)layer * NB * 2 * DFF, p->out + O_CVS + (size_t)layer * SB * 2 * DFF};
            pg8::gemm_phase<pg8::EpiWin, pg8::GroupOrder, true, true>(c.lds, g, S, E, c.tid);
        } PHASE_END
        PHASE_BEGIN phase_conv(p, c, layer); PHASE_END
        PHASE_BEGIN {
            pg8::Gemm g{(const bf16_t*)(ws + WS_HH), (const bf16_t*)(ws + WS_WOUTT) + (size_t)layer * 1024 * 2816, R, 1024, 2816, 2816};
            pg8::GroupOrder S; S.init((int)gridDim.x, (int)blockIdx.x); S.add(0, 0, 64, 0, 4);
            pg8::EpiResid E{X, D};
            pg8::gemm_phase<pg8::EpiResid, pg8::GroupOrder, true, true>(c.lds, g, S, E, c.tid);
            skinny_resid_sample(c, (const bf16_t*)(ws + WS_HH), 2816, (const bf16_t*)(ws + WS_WOUTT) + (size_t)layer * 1024 * 2816, 2816, X);
        } PHASE_END
    }
#ifdef SELFTEST
    PHASE_BEGIN if (blockIdx.x == 0 && c.wave == 0) { const float x = (float)((c.lane * 37) & 63) + 1.0f; float poison = 0.f;
        if (__ballot(swz_xor16_n(x) != __shfl_xor(x, 16))) poison += 1e3f;
        if (__ballot(sum_xor32_n(x) != x + __shfl_xor(x, 32))) poison += 1e4f;
        if (__ballot(sum_rows4_n(x) != x + __shfl_xor(x, 16) + __shfl_xor(x, 32) + __shfl_xor(x, 48))) poison += 1e5f;
        if (__ballot(wave_sum_n(x) != 2080.0f)) poison += 1e6f;
        if (__ballot(wave_max_n(x) != 64.0f)) poison += 1e7f;
        if (c.lane == 0) p->out[O_CVS] += poison; } PHASE_END
#endif
#ifdef PROBE_SCALE
    PHASE_BEGIN for (size_t e = c.gtid; e < O_END; e += c.gsz) { int oi = e < O_KV ? (e < (size_t)MP * D ? 0 : 1) : e < O_WINP ? (e < O_KV + (size_t)MP * D ? 2 : 3) : e < O_WINS ? 4 : e < O_WKVP ? 5 : e < O_WKVS ? 6 : e < O_SHP ? 7 : e < O_SHS ? 8 : e < O_CVP ? 9 : e < O_CVS ? 10 : 11;
        if (PROBE_SCALE < 0) oi = 11 - oi; p->out[e] *= 1.0f + sqrtf(0.5e-4f * (float)(oi + 1)); } PHASE_END
#endif
#undef PHASE_BEGIN
#undef PHASE_END
}

extern "C" void kernel_launch(void* const* d_in, const int* in_sizes, int n_in, void* d_out, int out_size, void* d_ws, size_t ws_size, hipStream_t stream) {
    static int grid = 0;
    if (grid == 0) {
        if (n_in != 45 || (size_t)out_size != O_END || ws_size < WS_END) { fprintf(stderr, "kernel_launch: unexpected shapes (n_in %d out %d ws %zu need %zu)\n", n_in, out_size, ws_size, (size_t)WS_END); grid = -1; return; }
        int dev = 0, cus = 0, per_cu = 0;
        if (hipGetDevice(&dev) != hipSuccess || hipDeviceGetAttribute(&cus, hipDeviceAttributeMultiprocessorCount, dev) != hipSuccess) { grid = -1; return; }
        if (hipFuncSetAttribute((const void*)mega, hipFuncAttributeMaxDynamicSharedMemorySize, LDS_BYTES) != hipSuccess) { fprintf(stderr, "kernel_launch: hipFuncSetAttribute failed\n"); grid = -1; return; }
        if (hipOccupancyMaxActiveBlocksPerMultiprocessor(&per_cu, (const void*)mega, 512, LDS_BYTES) != hipSuccess || per_cu < 1) { fprintf(stderr, "kernel_launch: occupancy query says %d\n", per_cu); (void)hipGetLastError(); }
        grid = cus;
    }
    if (grid < 0) return;
    (void)hipMemsetAsync((char*)d_ws + WS_CTL, 0, CTL_BYTES, stream);
    Params p{};
    for (int i = 0; i < 45; ++i) p.in[i] = (const float*)d_in[i];
    p.out = (float*)d_out; p.ws = (unsigned char*)d_ws;
#ifdef PROBE_PRE
    { const int plist[] = PROBE_PRE; for (int i = 0; i < (int)(sizeof(plist) / sizeof(int)); ++i) { p.ph_lo = plist[i] % 100; p.ph_hi = p.ph_lo + 1; p.use_bar = 0; p.pad = plist[i] / 100;       hipLaunchKernelGGL(mega, dim3(grid), dim3(512), LDS_BYTES, stream, p); } }
#endif
    p.pad = 0;
#if MK_MULTI
    for (int i = 0; i < NPH; ++i) { p.ph_lo = i; p.ph_hi = i + 1; p.use_bar = 0; hipLaunchKernelGGL(mega, dim3(grid), dim3(512), LDS_BYTES, stream, p); }
#else
    p.ph_lo = 0; p.ph_hi = NPH; p.use_bar = 1;
    hipLaunchKernelGGL(mega, dim3(grid), dim3(512), LDS_BYTES, stream, p);
#endif
    const hipError_t le = hipPeekAtLastError();
    if (le != hipSuccess) fprintf(stderr, "kernel_launch: launch failed: %s\n", hipGetErrorName(le));
}
```

```cpp
#include <hip/hip_runtime.h>
#include <cstdio>
#include <cstdint>

#define LAS __attribute__((address_space(3)))
#define GAS __attribute__((address_space(1)))
typedef unsigned short bf16_t;
typedef short bf16x8 __attribute__((ext_vector_type(8)));
typedef float f32x4 __attribute__((ext_vector_type(4)));
typedef float f32x16 __attribute__((ext_vector_type(16)));
typedef float f32x2 __attribute__((ext_vector_type(2)));
typedef unsigned u32x4 __attribute__((ext_vector_type(4)));
typedef unsigned u32x2 __attribute__((ext_vector_type(2)));

constexpr int D = 1024, NB = 2, TP = 8192, MP = NB * TP, SB = 128, ST = 4, MS = SB * ST, R = MP + MS;
constexpr int PAST = 2048, PAGE = 128, NPAGES = PAST / PAGE;
constexpr int H = 16, HD = 64, G = 4, HPG = 4, DFF = 2816, NLAY = 4;
constexpr int LW_ = 64, LA_ = 64, LV_ = 32, LG_ = 128, LHID = 288;
constexpr int NKV = 1536, NQ = 1072, NQP = 1280;
constexpr int NCH = TP / 64;
constexpr int NUNIT_A = NB * NCH * H;
constexpr int NCMP_P = 511, NCMP_S = 127, WIN = 512;
constexpr float NORM_EPS = 1e-6f, GN_EPS = 64e-5f;

constexpr size_t O_Y = 0;
constexpr size_t O_KV = (size_t)R * D;
constexpr size_t O_WINP = O_KV + (size_t)R * D;
constexpr size_t O_WINS = O_WINP + (size_t)NB * 512 * 512;
constexpr size_t O_WKVP = O_WINS + (size_t)SB * 512 * 512;
constexpr size_t O_WKVS = O_WKVP + (size_t)2 * NB * H * 4096;
constexpr size_t O_SHP = O_WKVS + (size_t)2 * SB * H * 4096;
constexpr size_t O_SHS = O_SHP + (size_t)2 * NB * D;
constexpr size_t O_CVP = O_SHS + (size_t)2 * SB * D;
constexpr size_t O_CVS = O_CVP + (size_t)NLAY * NB * 2 * DFF;
constexpr size_t O_END = O_CVS + (size_t)NLAY * SB * 2 * DFF;
static_assert(O_END == 88915968, "output size");

constexpr size_t MiB = 1u << 20;
constexpr size_t al(size_t x) { return (x + 4095) & ~(size_t)4095; }
constexpr size_t WS_CTL = 0, CTL_BYTES = 1 * MiB;
constexpr size_t WS_WRKV = WS_CTL + CTL_BYTES;
constexpr size_t WS_WORW = WS_WRKV + al((size_t)2 * 3072 * 1024 * 2);
constexpr size_t WS_W1T = WS_WORW + al((size_t)2 * 1024 * 1024 * 2);
constexpr size_t WS_W2W = WS_W1T + al((size_t)2 * 288 * 1024 * 2);
constexpr size_t WS_W2A = WS_W2W + al((size_t)2 * 1024 * 64 * 2);
constexpr size_t WS_W2V = WS_W2A + al((size_t)2 * 1024 * 64 * 2);
constexpr size_t WS_W2G = WS_W2V + al((size_t)1024 * 32 * 2);
constexpr size_t WS_WKVT = WS_W2G + al((size_t)2 * 1024 * 128 * 2);
constexpr size_t WS_WQT = WS_WKVT + al((size_t)1536 * 1024 * 2);
constexpr size_t WS_WONSA = WS_WQT + al((size_t)2 * 1280 * 1024 * 2);
constexpr size_t WS_WINT = WS_WONSA + al((size_t)2 * 1024 * 1024 * 2);
constexpr size_t WS_WOUTT = WS_WINT + al((size_t)4 * 5632 * 1024 * 2);
constexpr size_t WS_CW1T = WS_WOUTT + al((size_t)4 * 1024 * 2816 * 2);
constexpr size_t WS_CBIAS = WS_CW1T + al((size_t)2 * 256 * 1024 * 2);
constexpr size_t WS_CW2T = WS_CBIAS + al(2 * 128 * 4);
constexpr size_t WS_XM = WS_CW2T + al(2 * 2 * 64 * 128 * 2);
constexpr size_t WS_RK_R = WS_XM + al((size_t)6 * R * D * 2);
constexpr size_t WS_RK_K = WS_RK_R + al((size_t)R * D * 4);
constexpr size_t WS_V0 = WS_RK_K + al((size_t)R * D * 4);
constexpr size_t WS_V1 = WS_V0 + al((size_t)R * D * 4);
constexpr size_t WS_HID = WS_V1 + al((size_t)R * D * 4);
constexpr size_t WS_MT = WS_HID + al((size_t)R * LHID * 2);
constexpr size_t WS_NN = WS_MT + al((size_t)NUNIT_A * 4096 * 4);
constexpr size_t WS_RP = WS_NN + al((size_t)NUNIT_A * 4096 * 4);
constexpr size_t WS_YL = WS_RP + al((size_t)NUNIT_A * 4096 * 2);
constexpr size_t WS_S0 = WS_YL + al((size_t)NUNIT_A * 4096 * 4);
constexpr size_t WS_RKS = WS_S0 + al((size_t)NUNIT_A * 4096 * 2);
constexpr size_t WS_YG = WS_RKS + al((size_t)R * 16 * 4);
constexpr size_t WS_XN = WS_YG + al((size_t)R * D * 2);
constexpr size_t WS_XN2 = WS_XN + al((size_t)R * D * 2);
constexpr size_t WS_U = WS_XN2 + al((size_t)R * D * 2);
constexpr size_t WS_GT = WS_U + al((size_t)R * DFF * 2);
constexpr size_t WS_HH = WS_GT + al((size_t)R * DFF * 2);
constexpr size_t WS_KVF = WS_HH + al((size_t)R * DFF * 2);
constexpr size_t WS_CMPA = WS_KVF + al((size_t)R * NKV * 4);
constexpr size_t CMPA_ROWS = 4096 + 4096 + 65536 + 65536;
constexpr size_t WS_PCMP = WS_CMPA + al(CMPA_ROWS * 1024 * 2);
constexpr size_t WS_KS = WS_PCMP + al(CMPA_ROWS * 256 * 4);
constexpr size_t WS_VS = WS_KS + al((size_t)NB * G * TP * 64 * 2);
constexpr size_t WS_KW = WS_VS + al((size_t)NB * G * TP * 64 * 2);
constexpr size_t WS_VW = WS_KW + al((size_t)NB * G * TP * 64 * 2);
constexpr size_t WS_CK = WS_VW + al((size_t)NB * G * TP * 64 * 2);
constexpr size_t WS_CV = WS_CK + al((size_t)NB * G * 512 * 64 * 2);
constexpr size_t WS_CKS = WS_CV + al((size_t)NB * G * 512 * 64 * 2);
constexpr size_t WS_CVS = WS_CKS + al((size_t)SB * G * 128 * 64 * 4);
constexpr size_t WS_QF = WS_CVS + al((size_t)SB * G * 128 * 64 * 4);
constexpr size_t WS_Q = WS_QF + al((size_t)R * NQP * 4);
constexpr size_t WS_GATE = WS_Q + al((size_t)R * D * 2);
constexpr size_t WS_END = WS_GATE + al((size_t)R * 48 * 4);

typedef __bf16 bf16v2_ __attribute__((ext_vector_type(2)));
__device__ __forceinline__ unsigned cvt_pk_bf16_(float lo, float hi) { const f32x2 v = {lo, hi}; const bf16v2_ b = __builtin_convertvector(v, bf16v2_); return __builtin_bit_cast(unsigned, b); }
__device__ __forceinline__ unsigned f2bf(float f) { return cvt_pk_bf16_(f, f) & 0xffffu; }
__device__ __forceinline__ unsigned pk2(float lo, float hi) { return cvt_pk_bf16_(lo, hi); }
__device__ __forceinline__ float frcp(float x) { return __builtin_amdgcn_rcpf(x); }
__device__ __forceinline__ float frsq(float x) { return __builtin_amdgcn_rsqf(x); }
__device__ __forceinline__ float bf2f(unsigned short b) { return __builtin_bit_cast(float, ((unsigned)b) << 16); }
__device__ __forceinline__ float bflo(unsigned w) { return __builtin_bit_cast(float, w << 16); }
__device__ __forceinline__ float bfhi(unsigned w) { return __builtin_bit_cast(float, w & 0xffff0000u); }
template <int CTRL> __device__ __forceinline__ float dpp_f(float x) { return __builtin_bit_cast(float, __builtin_amdgcn_update_dpp(0, __builtin_bit_cast(int, x), CTRL, 0xF, 0xF, true)); }
__device__ __forceinline__ float row16_sum(float v) { v += dpp_f<0xB1>(v); v += dpp_f<0x4E>(v); v += dpp_f<0x141>(v); v += dpp_f<0x140>(v); return v; }
__device__ __forceinline__ float row16_max(float v) { v = fmaxf(v, dpp_f<0xB1>(v)); v = fmaxf(v, dpp_f<0x4E>(v)); v = fmaxf(v, dpp_f<0x141>(v)); v = fmaxf(v, dpp_f<0x140>(v)); return v; }
__device__ __forceinline__ float swz_xor16_n(float x) { return __builtin_bit_cast(float, __builtin_amdgcn_ds_swizzle(__builtin_bit_cast(int, x), 0x401F)); }
__device__ __forceinline__ float sum_xor32_n(float x) { auto rr = __builtin_amdgcn_permlane32_swap(__float_as_uint(x), __float_as_uint(x), false, false);
    return __uint_as_float(rr[0]) + __uint_as_float(rr[1]); }
__device__ __forceinline__ float sum_rows4_n(float x) { x += swz_xor16_n(x); return sum_xor32_n(x); }
__device__ __forceinline__ float wave_sum_n(float v) {
    v = row16_sum(v);
    v += __builtin_bit_cast(float, __builtin_amdgcn_update_dpp(0, __builtin_bit_cast(int, v), 0x142, 0xA, 0xF, false));
    v += __builtin_bit_cast(float, __builtin_amdgcn_update_dpp(0, __builtin_bit_cast(int, v), 0x143, 0xC, 0xF, false));
    return __builtin_bit_cast(float, __builtin_amdgcn_readlane(__builtin_bit_cast(int, v), 63));
}
__device__ __forceinline__ float wave_max_n(float v) {
    v = row16_max(v);
    v = fmaxf(v, __builtin_bit_cast(float, __builtin_amdgcn_update_dpp(__builtin_bit_cast(int, v), __builtin_bit_cast(int, v), 0x142, 0xA, 0xF, false)));
    v = fmaxf(v, __builtin_bit_cast(float, __builtin_amdgcn_update_dpp(__builtin_bit_cast(int, v), __builtin_bit_cast(int, v), 0x143, 0xC, 0xF, false)));
    return __builtin_bit_cast(float, __builtin_amdgcn_readlane(__builtin_bit_cast(int, v), 63));
}
#define XLANE_NEW 1
#ifdef XLANE_NEW
__device__ __forceinline__ float swz_xor16(float x) { return __builtin_bit_cast(float, __builtin_amdgcn_ds_swizzle(__builtin_bit_cast(int, x), 0x401F)); }
__device__ __forceinline__ float sum_xor32(float x) { return sum_xor32_n(x); }
__device__ __forceinline__ float sum_rows4(float x) { x += swz_xor16(x); return sum_xor32(x); }
__device__ __forceinline__ float wave_sum(float v) {
    v = row16_sum(v);
    v += __builtin_bit_cast(float, __builtin_amdgcn_update_dpp(0, __builtin_bit_cast(int, v), 0x142, 0xA, 0xF, false));
    v += __builtin_bit_cast(float, __builtin_amdgcn_update_dpp(0, __builtin_bit_cast(int, v), 0x143, 0xC, 0xF, false));
    return __builtin_bit_cast(float, __builtin_amdgcn_readlane(__builtin_bit_cast(int, v), 63));
}
__device__ __forceinline__ float wave_max(float v) {
    v = row16_max(v);
    v = fmaxf(v, __builtin_bit_cast(float, __builtin_amdgcn_update_dpp(__builtin_bit_cast(int, v), __builtin_bit_cast(int, v), 0x142, 0xA, 0xF, false)));
    v = fmaxf(v, __builtin_bit_cast(float, __builtin_amdgcn_update_dpp(__builtin_bit_cast(int, v), __builtin_bit_cast(int, v), 0x143, 0xC, 0xF, false)));
    return __builtin_bit_cast(float, __builtin_amdgcn_readlane(__builtin_bit_cast(int, v), 63));
}
#else
__device__ __forceinline__ float sum_xor32(float x) { return x + __shfl_xor(x, 32); }
__device__ __forceinline__ float sum_rows4(float x) { x += __shfl_xor(x, 16); x += __shfl_xor(x, 32); return x; }
__device__ __forceinline__ float wave_sum(float v) { v = row16_sum(v); v += __shfl_xor(v, 16); v += __shfl_xor(v, 32); return v; }
__device__ __forceinline__ float wave_max(float v) { v = row16_max(v); v = fmaxf(v, __shfl_xor(v, 16)); v = fmaxf(v, __shfl_xor(v, 32)); return v; }
#endif
__device__ __forceinline__ float sigmoidf_(float x) { return frcp(1.0f + __builtin_amdgcn_exp2f(-1.4426950408889634f * x)); }
__device__ __forceinline__ float gelu_tanh(float x) {
    const float u = 0.7978845608028654f * (x + 0.044715f * x * x * x);
    const float e = __builtin_amdgcn_exp2f(2.8853900817779268f * u);
    const float th = 1.0f - 2.0f * frcp(e + 1.0f);
    return 0.5f * x * (1.0f + th);
}
template <class T> __device__ __forceinline__ const T* launder_p(const T* q) { asm volatile("" : "+v"(q)); return q; }
__device__ __forceinline__ int launder_v(int x) { asm volatile("" : "+v"(x)); return x; }
#define LDS_WAIT() asm volatile("s_waitcnt lgkmcnt(0)" ::: "memory")
#define VM_WAIT() asm volatile("s_waitcnt vmcnt(0)" ::: "memory")
__device__ __forceinline__ f32x4 mfma16(bf16x8 a, bf16x8 b, f32x4 c) { return __builtin_amdgcn_mfma_f32_16x16x32_bf16(a, b, c, 0, 0, 0); }
__device__ __forceinline__ f32x16 mfma32(bf16x8 a, bf16x8 b, f32x16 c) { return __builtin_amdgcn_mfma_f32_32x32x16_bf16(a, b, c, 0, 0, 0); }
#define XB_TMO      128
#define XB_XCNT(j)  (256  + 64 * (j))
#define XB_XSUB(j)  (1280 + 64 * (j))
#define XB_XGEN(j)  (2304 + 64 * (j))
#define XB_TOP      3328
#define XB_TOPGEN   3392
#define XCD_BAR_WORDS 3456
#define XB_SPIN_CAP (1u << 18)

__device__ __forceinline__ unsigned xb_ld(unsigned* p)              { return __hip_atomic_load(p, __ATOMIC_RELAXED, __HIP_MEMORY_SCOPE_AGENT); }
__device__ __forceinline__ unsigned xb_add(unsigned* p, unsigned v) { return __hip_atomic_fetch_add(p, v, __ATOMIC_RELAXED, __HIP_MEMORY_SCOPE_AGENT); }
__device__ __forceinline__ unsigned xb_xcc_id() { return (unsigned)__builtin_amdgcn_s_getreg((3 << 11) | 20) & 0xFu; }
#define XB_SPIN(cond, bar) do { unsigned _sp = 0; while (cond) { __builtin_amdgcn_s_sleep(1); \
    if ((++_sp & 255u) == 0u) { if (xb_ld(&(bar)[XB_TMO])) break; if (_sp > XB_SPIN_CAP) { atomicAdd(&(bar)[XB_TMO], 1u); break; } } } } while (0)

struct XcdBarrier {
    unsigned* bar; unsigned x;
    volatile LAS unsigned* st;
};

__device__ __forceinline__ XcdBarrier xcd_barrier_post(unsigned* bar, volatile LAS unsigned* st) {
    XcdBarrier b; b.bar = bar; b.x = xb_xcc_id(); b.st = st;
    if (threadIdx.x == 0) (void)xb_add(&bar[XB_XCNT(b.x)], 1u);
    return b;
}
__device__ __forceinline__ void xcd_barrier_complete(unsigned* bar, unsigned x, unsigned& nloc, unsigned& nx) {
    const unsigned G = gridDim.x * gridDim.y * gridDim.z;
    unsigned sum, cnt, mine, sp = 0u;
    for (;;) {
        sum = 0u; cnt = 0u; mine = 0u;
#pragma unroll
        for (unsigned j = 0; j < 16; ++j) { const unsigned c = xb_ld(&bar[XB_XCNT(j)]); sum += c; cnt += (c > 0u) ? 1u : 0u; mine = (j == x) ? c : mine; }
        if (sum == G) break;
        __builtin_amdgcn_s_sleep(1);
        if ((++sp & 255u) == 0u) { if (xb_ld(&bar[XB_TMO])) break; if (sp > XB_SPIN_CAP) { atomicAdd(&bar[XB_TMO], 1u); break; } }
    }
    nloc = mine > 0u ? mine : 1u; nx = cnt > 0u ? cnt : 1u;
}

__device__ __forceinline__ void xcd_barrier(const XcdBarrier& b, const bool t0) {
    asm volatile("s_waitcnt vmcnt(0)" ::: "memory");
    __syncthreads();
    if (t0) {
        unsigned* bar = b.bar;
        __builtin_amdgcn_s_waitcnt(0);
        unsigned nloc = b.st[0], nx = b.st[1];
        if (nloc == 0u) { xcd_barrier_complete(bar, b.x, nloc, nx); b.st[0] = nloc; b.st[1] = nx; }
        const unsigned old = xb_add(&bar[XB_XSUB(b.x)], 1u);
        const unsigned gen = old / nloc;
        if (old + 1u == (gen + 1u) * nloc) {
            __builtin_amdgcn_fence(__ATOMIC_RELEASE, "agent");
            asm volatile("s_waitcnt vmcnt(0)" ::: "memory");
            const unsigned og = xb_add(&bar[XB_TOP], 1u);
            const unsigned tg = og / nx;
            if (og + 1u == (tg + 1u) * nx) xb_add(&bar[XB_TOPGEN], 1u);
            else XB_SPIN(xb_ld(&bar[XB_TOPGEN]) == tg, bar);
            __builtin_amdgcn_fence(__ATOMIC_ACQUIRE, "agent");
            xb_add(&bar[XB_XGEN(b.x)], 1u);
            asm volatile("s_waitcnt vmcnt(0)" ::: "memory");
        } else {
            XB_SPIN(xb_ld(&bar[XB_XGEN(b.x)]) == gen, bar);
            __builtin_amdgcn_fence(__ATOMIC_ACQUIRE, "agent");
            asm volatile("s_waitcnt vmcnt(0)" ::: "memory");
        }
    }
    __syncthreads();
}

namespace pg8 {
#define PG8_LAS __attribute__((address_space(3)))
constexpr int BM = 256, BK = 64, HALF = 128, HTB = HALF * BK * 2  , STAGE_BYTES = 8 * HTB, NXCD = 8, WGM = 8;
__host__ __device__ __forceinline__ int lds_byte(int r, int c) { const int st = (r >> 4) * 2 + (c >> 5), rr = r & 15, cc = c & 31, ob = rr * 64 + cc * 2; return st * 1024 + (ob ^ (((ob >> 9) & 1) << 5)); }
__host__ __device__ __forceinline__ void stage_rc(int b, int& R_, int& C_) { const int st = b / 1024, sb = b % 1024, swz = sb ^ (((sb >> 9) & 1) << 5); R_ = (st >> 1) * 16 + swz / 64; C_ = (st & 1) * 32 + (swz % 64) / 2; }
__host__ __device__ __forceinline__ int perm32(int rho) { const int n = rho >> 4, i = rho & 15; return 8 * (i >> 2) + 4 * n + (i & 3); }

struct Unit { int pm, pn, kb, nt; };
struct Gemm { const bf16_t* A; const bf16_t* Bt; int M, N, K, KL; };

struct GroupOrder {
    int pm0[4], nM[4], pn0[4], nN[4]; int nseg, nwg, G_, c;
    __device__ __forceinline__ void init(int G__, int c_) { nseg = 0; nwg = 0; G_ = G__; c = c_;
#pragma unroll
        for (int s = 0; s < 4; ++s) { pm0[s] = 0; nM[s] = 0; pn0[s] = 0; nN[s] = 1; } }
    __device__ __forceinline__ void add(int s, int pm0_, int nM_, int pn0_, int nN_) { pm0[s] = pm0_; nM[s] = nM_; pn0[s] = pn0_; nN[s] = nN_; nwg += nM_ * nN_; nseg = s + 1; }
    __device__ __forceinline__ bool next(int i, Unit& u) const {
        const long L = (long)i * G_ + c; if (L >= nwg) return false;
        int id = (int)L; { const int q = nwg / NXCD, r = nwg % NXCD, xcd = id % NXCD, off = id / NXCD; id = (xcd < r ? xcd * (q + 1) : r * (q + 1) + (xcd - r) * q) + off; }
        int spm0 = 0, snM = 1, spn0 = 0, snN = 1; bool found = false;
#pragma unroll
        for (int s = 0; s < 4; ++s) { const int cnt = nM[s] * nN[s]; if (!found) { if (id < cnt) { found = true; spm0 = pm0[s]; snM = nM[s]; spn0 = pn0[s]; snN = nN[s]; } else id -= cnt; } }
        const int nig = WGM * snN, gid = id / nig, fm = gid * WGM, gsz = (snM - fm) < WGM ? (snM - fm) : WGM;
        u.pm = spm0 + fm + ((id % nig) % gsz); u.pn = spn0 + (id % nig) / gsz; u.kb = 0; u.nt = 0; return true;
    }
    __device__ __forceinline__ void a_ready(const Unit&) const {}
    __device__ __forceinline__ void done(const Unit&) const {}
};

struct ResidOrder {
    GroupOrder P; int nS, G_, c;
    __device__ __forceinline__ void init(int G__, int c_, int nS_) { P.init(G__, c_); P.add(0, 0, nS_ ? 64 : 66, 0, 4); nS = nS_; G_ = G__; c = c_; }
    __device__ __forceinline__ bool next(int i, Unit& u) const {
        const int npc = c < P.nwg ? (P.nwg - 1 - c) / G_ + 1 : 0;
        if (i < npc) return P.next(i, u);
        const int L = (i - npc) * G_ + (G_ - 1 - c); if (L >= 8 * nS) return false;
        const int sl = L >> 3, t = L & 7; u.pm = 64 + (t & 1); u.pn = t >> 1; u.kb = sl * 512; u.nt = 4; return true; }
    __device__ __forceinline__ void a_ready(const Unit&) const {}
    __device__ __forceinline__ void done(const Unit&) const {}
};
__device__ __forceinline__ unsigned cvt_pk_bf16(float lo, float hi) { return cvt_pk_bf16_(lo, hi); }

struct EpiF32G {
    static constexpr bool PERM = false, AFTER_DRAIN = false;
    float* b0; float* b1; float* b2; float* b3; int ldc, png, pmg;
    __device__ __forceinline__ void operator()(const f32x4 (&acc)[2][2][4][2], const Unit& u, int wr, int wc, int fr, int fq) const {
        const int j = u.pn / png; float* C = j == 0 ? b0 : (j == 1 ? b1 : (j == 2 ? b2 : b3));
        const int row0 = (u.pm - j * pmg) * BM + wr * 64 + fr, col0 = (u.pn - j * png) * BM + wc * 32 + 4 * fq;
#pragma unroll
        for (int ai = 0; ai < 2; ++ai)
#pragma unroll
            for (int m = 0; m < 4; ++m) { float* rowp = C + (size_t)(row0 + ai * HALF + m * 16) * ldc + col0;
#pragma unroll
                for (int bj = 0; bj < 2; ++bj)
#pragma unroll
                    for (int n = 0; n < 2; ++n) *(f32x4*)(rowp + bj * HALF + n * 16) = acc[ai][bj][m][n]; }
    }
};
struct EpiResid {
    static constexpr bool PERM = false, AFTER_DRAIN = false;
    float* X; int ldc;
    __device__ __forceinline__ void operator()(const f32x4 (&acc)[2][2][4][2], const Unit& u, int wr, int wc, int fr, int fq) const {
        const int row0 = u.pm * BM + wr * 64 + fr, col0 = u.pn * BM + wc * 32 + 4 * fq; const bool split = u.nt != 0;
#pragma unroll
        for (int ai = 0; ai < 2; ++ai)
#pragma unroll
            for (int m = 0; m < 4; ++m) { float* rowp = X + (size_t)(row0 + ai * HALF + m * 16) * ldc + col0;
                if (!split) {
#pragma unroll
                    for (int bj = 0; bj < 2; ++bj)
#pragma unroll
                        for (int n = 0; n < 2; ++n) { f32x4* p = (f32x4*)(rowp + bj * HALF + n * 16); *p = *p + acc[ai][bj][m][n]; } }
                else {
#pragma unroll
                    for (int bj = 0; bj < 2; ++bj)
#pragma unroll
                        for (int n = 0; n < 2; ++n) { float* q = rowp + bj * HALF + n * 16;
#pragma unroll
                            for (int e = 0; e < 4; ++e) __hip_atomic_fetch_add(q + e, acc[ai][bj][m][n][e], __ATOMIC_RELAXED, __HIP_MEMORY_SCOPE_AGENT); } }
                asm volatile("" ::: "memory"); }
    }
};
struct EpiWin {
    static constexpr bool PERM = true, AFTER_DRAIN = false;
    bf16_t* U; bf16_t* GT; float* cvp; float* cvs;
    __device__ __forceinline__ void operator()(const f32x4 (&acc)[2][2][4][2], const Unit& u, int wr, int wc, int fr, int fq) const {
        const bool isu = u.pn < 11; bf16_t* base = isu ? U : GT; const int colt = (isu ? u.pn : u.pn - 11) * BM;
        const int row0 = u.pm * BM + wr * 64 + fr, col0 = colt + wc * 32 + 8 * fq;
#pragma unroll
        for (int ai = 0; ai < 2; ++ai)
#pragma unroll
            for (int m = 0; m < 4; ++m) { const int row = row0 + ai * HALF + m * 16; bf16_t* rowp = base + (size_t)row * DFF + col0;
                float* cv = nullptr;
                if (isu) { if (row >= MP) { const int t = (row - MP) & 3, b = (row - MP) >> 2; if (t >= 2) cv = cvs + (size_t)(b * 2 + (t - 2)) * DFF; }
                           else { const int tt = row & (TP - 1); if (tt >= TP - 2) cv = cvp + (size_t)((row >> 13) * 2 + (tt - (TP - 2))) * DFF; } }
#pragma unroll
                for (int bj = 0; bj < 2; ++bj) { const f32x4 v0 = acc[ai][bj][m][0], v1 = acc[ai][bj][m][1];
                    u32x4 w; w.x = cvt_pk_bf16(v0[0], v0[1]); w.y = cvt_pk_bf16(v0[2], v0[3]); w.z = cvt_pk_bf16(v1[0], v1[1]); w.w = cvt_pk_bf16(v1[2], v1[3]);
                    *(u32x4*)(rowp + bj * HALF) = w;
                    if (cv) { *(f32x4*)(cv + col0 + bj * HALF) = v0; *(f32x4*)(cv + col0 + bj * HALF + 4) = v1; } } }
    }
};
template <class Epi, class Sched, bool ALIGN_EPI = false, bool SP2 = false>
__device__ __forceinline__ void gemm_phase(PG8_LAS unsigned char* lds, const Gemm g, const Sched& S, const Epi& E, int tid_in) {
    int tid_l = tid_in; asm volatile("" : "+v"(tid_l));
    const int tid = tid_l, wid = __builtin_amdgcn_readfirstlane(tid >> 6), lane = tid & 63, wr = wid >> 2, wc = wid & 3, fr = lane & 15, fq = lane >> 4;
    const int K = g.K, nt = g.KL / BK;
    unsigned voffA[2], voffB[2];
#pragma unroll
    for (int i = 0; i < 2; ++i) { int R, C; stage_rc(tid * 16 + i * 8192, R, C); const int Rb = Epi::PERM ? ((R & ~31) + perm32(R & 31)) : R;
        voffA[i] = (unsigned)(R * K + C) * 2u; voffB[i] = (unsigned)(Rb * K + C) * 2u; }
    const size_t kstep = (size_t)(BK * 2);
    const size_t hstep = (size_t)HALF * K * 2;
    const size_t tstep = 2 * hstep;
    const unsigned ldsw = (unsigned)wid * 1024u;
    const int aoff = lds_byte(wr * 64 + fr, fq * 8), boff = lds_byte(wc * 32 + fr, fq * 8);
#define PG8_SA(b, h) (((b) * 2 + (h)) * HTB)
#define PG8_SB(b, h) ((4 + (b) * 2 + (h)) * HTB)
#define PG8_STAGE(bufoff, gbase, voff) do { _Pragma("unroll") for (int _i = 0; _i < 2; ++_i) \
        __builtin_amdgcn_global_load_lds((const unsigned*)((const char*)(gbase) + (voff)[_i]), (PG8_LAS unsigned*)(lds + (bufoff) + ldsw + _i * 8192), 16, 0, 0); } while (0)
#define PG8_LDA(dst, b, h) do { _Pragma("unroll") for (int m = 0; m < 4; ++m) _Pragma("unroll") for (int k = 0; k < 2; ++k) dst[m][k] = *(const PG8_LAS bf16x8*)(lds + PG8_SA(b, h) + aoff + m * 2048 + k * 1024); } while (0)
#define PG8_LDB(dst, b, h) do { _Pragma("unroll") for (int n = 0; n < 2; ++n) _Pragma("unroll") for (int k = 0; k < 2; ++k) dst[n][k] = *(const PG8_LAS bf16x8*)(lds + PG8_SB(b, h) + boff + n * 2048 + k * 1024); } while (0)
#define PG8_MMA(ai, bj, At, Bt) do { __builtin_amdgcn_s_setprio(1); _Pragma("unroll") for (int m = 0; m < 4; ++m) _Pragma("unroll") for (int n = 0; n < 2; ++n) _Pragma("unroll") for (int k = 0; k < 2; ++k) \
        acc[ai][bj][m][n] = __builtin_amdgcn_mfma_f32_16x16x32_bf16(Bt[n][k], At[m][k], acc[ai][bj][m][n], 0, 0, 0); __builtin_amdgcn_s_setprio(0); } while (0)
#define PG8_WAIT_V(n) asm volatile("s_waitcnt vmcnt(" #n ")" ::: "memory")
#define PG8_WAIT_L(n) asm volatile("s_waitcnt lgkmcnt(" #n ")" ::: "memory")
#define PG8_BAR __builtin_amdgcn_s_barrier()
#define PG8_SCHED __builtin_amdgcn_sched_barrier(0)
    Unit cur, nxt; int ui = 0;
    if (!S.next(0, cur)) return;
    f32x4 acc[2][2][4][2];
#pragma unroll
    for (int a = 0; a < 2; ++a)
#pragma unroll
        for (int b = 0; b < 2; ++b)
#pragma unroll
            for (int m = 0; m < 4; ++m)
#pragma unroll
                for (int n = 0; n < 2; ++n) acc[a][b][m][n] = (f32x4){0.f, 0.f, 0.f, 0.f};
    bf16x8 At[4][2], B0[2][2], B1[2][2];
    const char* cA = (const char*)g.A + (size_t)cur.pm * tstep + cur.kb; const char* cB = (const char*)g.Bt + (size_t)cur.pn * tstep + cur.kb;
    S.a_ready(cur);
    if constexpr (SP2) {
        PG8_STAGE(PG8_SB(0, 0), cB, voffB); PG8_STAGE(PG8_SB(0, 1), cB + hstep, voffB); PG8_STAGE(PG8_SA(0, 0), cA, voffA); PG8_STAGE(PG8_SA(0, 1), cA + hstep, voffA);
        if (wr == 1) PG8_BAR;
        PG8_WAIT_V(2); PG8_BAR;
        PG8_STAGE(PG8_SB(1, 0), cB + kstep, voffB); PG8_STAGE(PG8_SA(1, 0), cA + kstep, voffA); PG8_STAGE(PG8_SB(1, 1), cB + hstep + kstep, voffB);
        PG8_WAIT_V(6); PG8_BAR;
    } else {
        PG8_STAGE(PG8_SB(0, 0), cB, voffB); PG8_STAGE(PG8_SA(0, 0), cA, voffA); PG8_STAGE(PG8_SB(0, 1), cB + hstep, voffB); PG8_STAGE(PG8_SA(0, 1), cA + hstep, voffA);
        if (wr == 1) PG8_BAR;
        PG8_WAIT_V(4); PG8_BAR;
        PG8_STAGE(PG8_SB(1, 0), cB + kstep, voffB); PG8_STAGE(PG8_SA(1, 0), cA + kstep, voffA); PG8_STAGE(PG8_SB(1, 1), cB + hstep + kstep, voffB);
        PG8_WAIT_V(6); PG8_BAR;
    }
    for (;;) {
        const bool has_next = S.next(ui + 1, nxt);
        const char* nA = has_next ? (const char*)g.A + (size_t)nxt.pm * tstep + nxt.kb : cA; const char* nB = has_next ? (const char*)g.Bt + (size_t)nxt.pn * tstep + nxt.kb : cB;
        const int ntu = cur.nt ? cur.nt : nt;
        for (int t = 0; t < ntu; t += 2) {
            const bool last = (t == ntu - 2);
            const char* a1 = cA + (size_t)(t + 1) * kstep;
            const char* a2 = last ? nA : cA + (size_t)(t + 2) * kstep; const char* b2 = last ? nB : cB + (size_t)(t + 2) * kstep;
            const char* a3 = a2 + kstep; const char* b3 = b2 + kstep;
            if (last && has_next) S.a_ready(nxt);
            if constexpr (SP2) {
            PG8_LDB(B0, 0, 0); PG8_LDB(B1, 0, 1); PG8_SCHED; PG8_LDA(At, 0, 0); PG8_STAGE(PG8_SA(1, 1), a1 + hstep, voffA);
            PG8_WAIT_V(8); PG8_WAIT_L(0); PG8_BAR; PG8_MMA(0, 0, At, B0); PG8_MMA(0, 1, At, B1); PG8_BAR; PG8_SCHED;
            PG8_LDA(At, 0, 1); PG8_STAGE(PG8_SB(0, 0), b2, voffB); PG8_STAGE(PG8_SB(0, 1), b2 + hstep, voffB); PG8_STAGE(PG8_SA(0, 0), a2, voffA);
            PG8_WAIT_V(8); PG8_WAIT_L(0); PG8_BAR; PG8_MMA(1, 0, At, B0); PG8_MMA(1, 1, At, B1); PG8_BAR; PG8_SCHED;
            PG8_LDB(B0, 1, 0); PG8_LDB(B1, 1, 1); PG8_SCHED; PG8_LDA(At, 1, 0); PG8_STAGE(PG8_SA(0, 1), a2 + hstep, voffA);
            PG8_WAIT_V(8); PG8_WAIT_L(0); PG8_BAR; PG8_MMA(0, 0, At, B0); PG8_MMA(0, 1, At, B1); PG8_BAR; PG8_SCHED;
            PG8_LDA(At, 1, 1); PG8_STAGE(PG8_SB(1, 0), b3, voffB); PG8_STAGE(PG8_SB(1, 1), b3 + hstep, voffB); PG8_STAGE(PG8_SA(1, 0), a3, voffA);
            PG8_WAIT_V(8); PG8_WAIT_L(0); PG8_BAR; PG8_MMA(1, 0, At, B0); PG8_MMA(1, 1, At, B1); PG8_BAR; PG8_SCHED;
            } else {
            PG8_LDB(B0, 0, 0); PG8_SCHED; PG8_LDA(At, 0, 0); PG8_STAGE(PG8_SA(1, 1), a1 + hstep, voffA);
            PG8_WAIT_L(8); PG8_BAR; PG8_WAIT_L(0); PG8_MMA(0, 0, At, B0); PG8_BAR; PG8_SCHED;
            PG8_LDB(B1, 0, 1); PG8_STAGE(PG8_SB(0, 0), b2, voffB);
            PG8_BAR; PG8_WAIT_L(0); PG8_MMA(0, 1, At, B1); PG8_BAR;
            PG8_LDA(At, 0, 1); PG8_STAGE(PG8_SA(0, 0), a2, voffA);
            PG8_BAR; PG8_WAIT_L(0); PG8_MMA(1, 0, At, B0); PG8_BAR; PG8_SCHED;
            PG8_STAGE(PG8_SB(0, 1), b2 + hstep, voffB);
            PG8_WAIT_V(6); PG8_BAR; PG8_MMA(1, 1, At, B1); PG8_BAR;
            PG8_LDB(B0, 1, 0); PG8_SCHED; PG8_LDA(At, 1, 0); PG8_STAGE(PG8_SA(0, 1), a2 + hstep, voffA);
            PG8_WAIT_L(8); PG8_BAR; PG8_WAIT_L(0); PG8_MMA(0, 0, At, B0); PG8_BAR; PG8_SCHED;
            PG8_LDB(B1, 1, 1); PG8_STAGE(PG8_SB(1, 0), b3, voffB);
            PG8_BAR; PG8_WAIT_L(0); PG8_MMA(0, 1, At, B1); PG8_BAR;
            PG8_LDA(At, 1, 1); PG8_STAGE(PG8_SA(1, 0), a3, voffA);
            PG8_BAR; PG8_WAIT_L(0); PG8_MMA(1, 0, At, B0); PG8_BAR; PG8_SCHED;
            PG8_STAGE(PG8_SB(1, 1), b3 + hstep, voffB);
            PG8_WAIT_V(6); PG8_BAR; PG8_MMA(1, 1, At, B1); PG8_BAR;
            }
        }
        if constexpr (ALIGN_EPI) { if (wr == 0) PG8_BAR; }
        if constexpr (!Epi::AFTER_DRAIN) { E(acc, cur, wr, wc, fr, fq); S.done(cur); }
        if (!has_next) break;
#pragma unroll
        for (int a = 0; a < 2; ++a)
#pragma unroll
            for (int b = 0; b < 2; ++b)
#pragma unroll
                for (int m = 0; m < 4; ++m)
#pragma unroll
                    for (int n = 0; n < 2; ++n) acc[a][b][m][n] = (f32x4){0.f, 0.f, 0.f, 0.f};
        cur = nxt; cA = nA; cB = nB; ++ui;
        if constexpr (ALIGN_EPI) { if (wr == 1) PG8_BAR; }
    }
    PG8_WAIT_V(0);
    if constexpr (!ALIGN_EPI) { if (wr == 0) PG8_BAR; }
    PG8_BAR;
    if constexpr (Epi::AFTER_DRAIN) { E.fused(acc, cur, wr, wc, fr, fq, lds, wid, lane); S.done(cur); }
#undef PG8_SA
#undef PG8_SB
#undef PG8_STAGE
#undef PG8_LDA
#undef PG8_LDB
#undef PG8_MMA
#undef PG8_WAIT_V
#undef PG8_WAIT_L
#undef PG8_BAR
#undef PG8_SCHED
}
}
constexpr int RING_BYTES = 131072, MISC_OFF = RING_BYTES + 320, LDS_BYTES = 147456;
struct Params { const float* in[45]; float* out; unsigned char* ws; int ph_lo, ph_hi, use_bar, pad; };
enum { I_XP = 0, I_XS, I_CKV, I_CWIN, I_SWKV, I_SSHIFT, I_SCONV, I_PT, I_NORMG, I_MU, I_WR, I_WK, I_WV, I_WO, I_W0, I_W1, I_W2, I_A0, I_A1, I_A2, I_V0, I_V1, I_V2, I_G1, I_G2,
       I_KK, I_KA, I_RKK, I_LNW, I_LNB, I_KVNG, I_WKV, I_KNG, I_PE, I_CW1, I_CB1, I_CW2, I_CB2, I_WQ, I_QNG, I_WONSA, I_WIN, I_CONVW, I_CONVB, I_WOUT };

typedef const __attribute__((address_space(4))) Params* KP;
struct Ctx { LAS unsigned char* lds; int tid, lane, wave, gw, ngw, gtid, gsz; };

__device__ __forceinline__ void p0_transpose_item(const float* W, int K, int ldw, int nblk, bf16_t* WT, int row_off, LAS float* scr, int item, int lane) {
    const int kb = item / nblk, nb = item % nblk, k0 = 64 * kb, n0 = 32 * nb;
#pragma unroll 8
    for (int i = 0; i < 32; ++i) { const int kk = 2 * i + (lane >> 5); scr[kk * 33 + (lane & 31)] = W[(size_t)(k0 + kk) * ldw + n0 + (lane & 31)]; }
    LDS_WAIT(); asm volatile("" ::: "memory");
    const int c = lane & 7;
#pragma unroll
    for (int j = 0; j < 4; ++j) { const int n = (lane >> 3) + 8 * j; const LAS float* s = scr + (8 * c) * 33 + n;
        u32x4 o; o.x = pk2(s[0 * 33], s[1 * 33]); o.y = pk2(s[2 * 33], s[3 * 33]); o.z = pk2(s[4 * 33], s[5 * 33]); o.w = pk2(s[6 * 33], s[7 * 33]);
        *(u32x4*)(WT + (size_t)(row_off + n0 + n) * K + k0 + 8 * c) = o; }
    LDS_WAIT(); asm volatile("" ::: "memory");
}

__device__ __forceinline__ void phase_prologue(KP p, const Ctx& c) {
    LAS float* scr = (LAS float*)(c.lds + c.wave * 16384);
    unsigned char* ws = p->ws;
    int total = 0;
#define TRCNT(K_, N_) (((K_) / 64) * ((N_) / 32))
    constexpr int C_DD = TRCNT(1024, 1024), C_L64 = TRCNT(1024, 64), C_L32 = TRCNT(1024, 32), C_L128 = TRCNT(1024, 128), C_2_64 = TRCNT(64, 1024), C_2_128 = TRCNT(128, 1024);
    constexpr int C_KV = TRCNT(1024, 1536), C_Q = 16 * 33, C_IN = TRCNT(1024, 5632), C_OUT = TRCNT(2816, 1024), C_CW = TRCNT(1024, 128);
    constexpr int NITEMS = 2 * (4 * C_DD + 2 * C_L64 + C_L128 + 2 * C_2_64 + C_2_128) + C_L32 + C_KV + 2 * C_Q + 2 * C_DD + 4 * C_IN + 4 * C_OUT + 4 * C_CW;
    (void)total;
    for (int it = c.gw; it < NITEMS; it += c.ngw) {
        int r = it;
#define TR(Wp, K_, LDW_, NBLK_, WTp, ROWOFF_) { const int cnt_ = ((K_) / 64) * (NBLK_); if (r < cnt_) { p0_transpose_item((Wp), (K_), (LDW_), (NBLK_), (bf16_t*)(WTp), (ROWOFF_), scr, r, c.lane); continue; } r -= cnt_; }
        bool done = false;
#pragma unroll
        for (int l = 0; l < 2; ++l) {
            if (done) break;
            const size_t dd = (size_t)l * 1024 * 1024;
#define TRL(Wp, K_, LDW_, NBLK_, WTp, ROWOFF_) { const int cnt_ = ((K_) / 64) * (NBLK_); if (!done) { if (r < cnt_) { p0_transpose_item((Wp), (K_), (LDW_), (NBLK_), (bf16_t*)(WTp), (ROWOFF_), scr, r, c.lane); done = true; } else r -= cnt_; } }
            TRL(p->in[I_WR] + dd, 1024, 1024, 32, ws + WS_WRKV + (size_t)l * 3072 * 1024 * 2, 0)
            TRL(p->in[I_WK] + dd, 1024, 1024, 32, ws + WS_WRKV + (size_t)l * 3072 * 1024 * 2, 1024)
            TRL(p->in[I_WV] + dd, 1024, 1024, 32, ws + WS_WRKV + (size_t)l * 3072 * 1024 * 2, 2048)
            TRL(p->in[I_WO] + dd, 1024, 1024, 32, ws + WS_WORW + (size_t)l * 1024 * 1024 * 2, 0)
            TRL(p->in[I_W1] + (size_t)l * 1024 * 64, 1024, 64, 2, ws + WS_W1T + (size_t)l * 288 * 1024 * 2, 0)
            TRL(p->in[I_A1] + (size_t)l * 1024 * 64, 1024, 64, 2, ws + WS_W1T + (size_t)l * 288 * 1024 * 2, 64)
            TRL(p->in[I_G1] + (size_t)l * 1024 * 128, 1024, 128, 4, ws + WS_W1T + (size_t)l * 288 * 1024 * 2, 160)
            TRL(p->in[I_W2] + (size_t)l * 64 * 1024, 64, 1024, 32, ws + WS_W2W + (size_t)l * 1024 * 64 * 2, 0)
            TRL(p->in[I_A2] + (size_t)l * 64 * 1024, 64, 1024, 32, ws + WS_W2A + (size_t)l * 1024 * 64 * 2, 0)
            TRL(p->in[I_G2] + (size_t)l * 128 * 1024, 128, 1024, 32, ws + WS_W2G + (size_t)l * 1024 * 128 * 2, 0)
        }
        if (done) continue;
        TR(p->in[I_V1], 1024, 32, 1, ws + WS_W1T + (size_t)1 * 288 * 1024 * 2, 128)
        TR(p->in[I_WKV], 1024, 1536, 48, ws + WS_WKVT, 0)
        TR(p->in[I_WQ], 1024, NQ, 33, ws + WS_WQT, 0)
        TR(p->in[I_WQ] + (size_t)1024 * NQ, 1024, NQ, 33, ws + WS_WQT + (size_t)NQP * 1024 * 2, 0)
        TR(p->in[I_WONSA], 1024, 1024, 32, ws + WS_WONSA, 0)
        TR(p->in[I_WONSA] + (size_t)1024 * 1024, 1024, 1024, 32, ws + WS_WONSA + (size_t)1024 * 1024 * 2, 0)
#pragma unroll
        for (int l = 0; l < 4; ++l) {
            if (done) break;
            TRL(p->in[I_WIN] + (size_t)l * 1024 * 5632, 1024, 5632, 176, ws + WS_WINT + (size_t)l * 5632 * 1024 * 2, 0)
            TRL(p->in[I_WOUT] + (size_t)l * 2816 * 1024, 2816, 1024, 32, ws + WS_WOUTT + (size_t)l * 1024 * 2816 * 2, 0)
        }
        if (done) continue;
        TR(p->in[I_CW1], 1024, 128, 4, ws + WS_CW1T, 0)
        TR(p->in[I_CW1] + (size_t)1024 * 128, 1024, 128, 4, ws + WS_CW1T, 128)
        TR(p->in[I_CW1] + (size_t)2048 * 128, 1024, 128, 4, ws + WS_CW1T + (size_t)256 * 1024 * 2, 0)
        TR(p->in[I_CW1] + (size_t)3072 * 128, 1024, 128, 4, ws + WS_CW1T + (size_t)256 * 1024 * 2, 128)
#undef TR
#undef TRL
    }
    {
        bf16_t* WQT = (bf16_t*)(ws + WS_WQT);
        for (int e = c.gtid; e < 2 * 224 * 1024; e += c.gsz) { const int k = e & 1023, n = 1056 + ((e >> 10) % 224), l = e / (224 * 1024);
            WQT[((size_t)l * NQP + n) * 1024 + k] = n < NQ ? (bf16_t)f2bf(p->in[I_WQ][((size_t)l * 1024 + k) * NQ + n]) : (bf16_t)0; }
        bf16_t* W2V = (bf16_t*)(ws + WS_W2V);
        for (int e = c.gtid; e < 32 * 1024; e += c.gsz) { const int n = e & 1023, k = e >> 10; W2V[n * 32 + k] = (bf16_t)f2bf(p->in[I_V2][k * 1024 + n]); }
    }
    { bf16_t* W2T = (bf16_t*)(ws + WS_CW2T);
      for (int e = c.gtid; e < 2 * 128 * 64; e += c.gsz) { const int d = e & 63, q = (e >> 6) & 127, kv = e >> 13; const float w = p->in[I_CW2][e];
          const unsigned hi = f2bf(w), lo = f2bf(w - __builtin_bit_cast(float, hi << 16)); W2T[(size_t)(kv * 64 + d) * 128 + q] = (bf16_t)hi; W2T[(size_t)2 * 64 * 128 + (size_t)(kv * 64 + d) * 128 + q] = (bf16_t)lo; } }
    for (int it = c.gw; it < 256; it += c.ngw) { const int kv = it >> 7, h = it & 127; float s = 0.f;
        for (int kk = c.lane; kk < 2048; kk += 64) s += p->in[I_PE][kv * 2048 + kk] * p->in[I_CW1][((size_t)kv * 2048 + kk) * 128 + h];
        s = wave_sum(s); if (c.lane == 0) ((float*)(ws + WS_CBIAS))[it] = s + p->in[I_CB1][it]; }
    { const f32x4* xp = (const f32x4*)p->in[I_XP]; const f32x4* xs = (const f32x4*)p->in[I_XS]; f32x4* o = (f32x4*)(p->out + O_Y);
      for (int e = c.gtid; e < R * D / 4; e += c.gsz) o[e] = e < MP * D / 4 ? xp[e] : xs[e - MP * D / 4]; }
}

__device__ __forceinline__ void phase_fill(KP p, const Ctx& c, int li, const int gwf, const int ngwf) {
    unsigned char* ws = p->ws;
    { const int* pt = (const int*)p->in[I_PT]; bf16_t* CA = (bf16_t*)(ws + WS_CMPA); const int part = li;
      for (int it = gwf; it < SB * 128 * 4; it += ngwf) { const int s4 = 4 * (it & 3), n = (it >> 2) & 127, b = it >> 9;
          const int page = pt[b * NPAGES + (n >> 3)]; const float* src = p->in[I_CKV] + ((size_t)page * PAGE + (n & 7) * 16 + s4) * 1024 + part * 256;
          f32x4 v[4];
#pragma unroll
          for (int e = 0; e < 4; ++e) v[e] = __builtin_nontemporal_load(((const f32x4*)(src + (size_t)e * 1024)) + c.lane);
          const int g = c.lane >> 4, d0 = 4 * (c.lane & 15); bf16_t* dst = CA + ((size_t)8192 + (size_t)part * 65536 + (size_t)(b * 4 + g) * 128 + n) * 1024 + s4 * 64 + d0;
#pragma unroll
          for (int e = 0; e < 4; ++e) { u32x2 w; w.x = pk2(v[e][0], v[e][1]); w.y = pk2(v[e][2], v[e][3]); *(u32x2*)(dst + e * 64) = w; } } }
    { const f32x4* src = (const f32x4*)p->in[I_CWIN]; f32x4* dst = (f32x4*)(p->out + O_WINS); constexpr int HALF_N = SB * 508 * 128 / 2;
      for (int e0 = li * HALF_N + gwf * 256 + c.lane; e0 < (li + 1) * HALF_N; e0 += ngwf * 256) { f32x4 v[4];
#pragma unroll
          for (int q = 0; q < 4; ++q) { const int e = e0 + 64 * q; if (e < (li + 1) * HALF_N) { const int b = e / (508 * 128), rr = e % (508 * 128); v[q] = __builtin_nontemporal_load(src + (size_t)b * 512 * 128 + 4 * 128 + rr); } }
#pragma unroll
          for (int q = 0; q < 4; ++q) { const int e = e0 + 64 * q; if (e < (li + 1) * HALF_N) { const int b = e / (508 * 128), rr = e % (508 * 128); __builtin_nontemporal_store(v[q], dst + (size_t)b * 512 * 128 + rr); } } } }
}

template <int NT> __device__ __forceinline__ void skinny_mma(const bf16_t* A, int lda, const bf16_t* Wt, int ldw, int K, int row0, int col0, int lane, f32x4 (&acc)[NT][2]) {
    const int fr = lane & 15, fq = lane >> 4;
#pragma unroll
    for (int nt = 0; nt < NT; ++nt) { acc[nt][0] = (f32x4){0.f, 0.f, 0.f, 0.f}; acc[nt][1] = (f32x4){0.f, 0.f, 0.f, 0.f}; }
    const bf16_t* xa = A + (size_t)(row0 + fr) * lda + 8 * fq; const bf16_t* xb = xa + (size_t)16 * lda;
    const bf16_t* wa = Wt + (size_t)(col0 + fr) * ldw + 8 * fq;
    const char* pa = (const char*)xa; const char* pb = (const char*)xb; const char* pw[NT];
#pragma unroll
    for (int nt = 0; nt < NT; ++nt) pw[nt] = (const char*)(wa + (size_t)nt * 16 * ldw);
    for (int k4 = 0; k4 < K / 128; ++k4) {
        bf16x8 fb[4][2], fa[4][NT];
#pragma unroll
        for (int u = 0; u < 4; ++u) { fb[u][0] = *(const bf16x8*)(pa + 64 * u); fb[u][1] = *(const bf16x8*)(pb + 64 * u);
#pragma unroll
            for (int nt = 0; nt < NT; ++nt) fa[u][nt] = *(const bf16x8*)(pw[nt] + 64 * u); }
        __builtin_amdgcn_sched_barrier(0);
#pragma unroll
        for (int u = 0; u < 4; ++u)
#pragma unroll
            for (int nt = 0; nt < NT; ++nt) { acc[nt][0] = mfma16(fa[u][nt], fb[u][0], acc[nt][0]); acc[nt][1] = mfma16(fa[u][nt], fb[u][1], acc[nt][1]); }
        pa += 256; pb += 256;
#pragma unroll
        for (int nt = 0; nt < NT; ++nt) pw[nt] += 256;
        __builtin_amdgcn_sched_barrier(0);
    }
}
__device__ __forceinline__ void skinny_resid_sample(const Ctx& c, const bf16_t* A, int lda, const bf16_t* Wt, int K, float* X) {
    const int ln = launder_v(c.lane), fr = ln & 15, fq = ln >> 4;
    for (int it = blockIdx.x + gridDim.x * c.wave; it < 256; it += c.ngw) { const int row0 = MP + 32 * (it & 15), col0 = 64 * (it >> 4);
        f32x4 acc[4][2]; skinny_mma<4>(A, lda, Wt, lda, K, row0, col0, c.lane, acc);
#pragma unroll
        for (int nt = 0; nt < 4; ++nt)
#pragma unroll
            for (int mt = 0; mt < 2; ++mt) { f32x4* q = (f32x4*)(X + (size_t)(row0 + 16 * mt + fr) * D + col0 + 16 * nt + 4 * fq); *q = *q + acc[nt][mt]; } }
}
__device__ __forceinline__ void skinny_store(const Ctx& c, const bf16_t* A, const bf16_t* Wt, int K, float* C, int ldc, int rbase, int nrb, int ncb, int it0, int nit_total) {
    const int fr = c.lane & 15, fq = c.lane >> 4;
    for (int it = c.gw - it0; it < nrb * ncb; it += c.ngw) { if (it < 0) continue; const int row0 = rbase + 32 * (it % nrb), col0 = 64 * (it / nrb);
        f32x4 acc[4][2]; skinny_mma<4>(A, K, Wt, K, K, row0, col0, c.lane, acc);
#pragma unroll
        for (int nt = 0; nt < 4; ++nt)
#pragma unroll
            for (int mt = 0; mt < 2; ++mt) *(f32x4*)(C + (size_t)(row0 + 16 * mt + fr) * ldc + col0 + 16 * nt + 4 * fq) = acc[nt][mt]; }
    (void)nit_total;
}

__device__ __forceinline__ void load_row(const float* p, int lane, f32x4 (&v)[4]) {
#pragma unroll
    for (int j = 0; j < 4; ++j) v[j] = ((const f32x4*)p)[lane + 64 * j];
}
__device__ __forceinline__ float row_rstd(const f32x4 (&v)[4]) {
    float s = 0.f;
#pragma unroll
    for (int j = 0; j < 4; ++j) s += (v[j][0] * v[j][0] + v[j][1] * v[j][1]) + (v[j][2] * v[j][2] + v[j][3] * v[j][3]);
    s = wave_sum(s); return frsq(s * (1.0f / D) + NORM_EPS);
}
__device__ __forceinline__ void store_row_bf16(bf16_t* o, int lane, const f32x4 (&v)[4]) {
#pragma unroll
    for (int j = 0; j < 4; ++j) { u32x2 w; w.x = pk2(v[j][0], v[j][1]); w.y = pk2(v[j][2], v[j][3]); ((u32x2*)o)[lane + 64 * j] = w; }
}

__device__ __forceinline__ void phase_norm(const Ctx& c, const float* X, const float* g1, bf16_t* o1, const float* g2, bf16_t* o2) {
    f32x4 ga[4], gb[4]; load_row(g1, c.lane, ga); if (g2) load_row(g2, c.lane, gb);
    for (int row = c.gw; row < R; row += c.ngw) {
        f32x4 v[4]; load_row(X + (size_t)row * D, c.lane, v); const float rs = row_rstd(v);
        f32x4 y[4];
#pragma unroll
        for (int j = 0; j < 4; ++j) y[j] = v[j] * rs * ga[j];
        store_row_bf16(o1 + (size_t)row * D, c.lane, y);
        if (g2) {
#pragma unroll
            for (int j = 0; j < 4; ++j) y[j] = v[j] * rs * gb[j];
            store_row_bf16(o2 + (size_t)row * D, c.lane, y); }
    }
}

__device__ __forceinline__ void phase_mix(KP p, const Ctx& c, int li) {
    const float* X = p->out + O_Y; const float* gain = p->in[I_NORMG] + (size_t)(li * 2) * D; const float* mu = p->in[I_MU] + (size_t)li * 6 * D;
    bf16_t* XM = (bf16_t*)(p->ws + WS_XM);
    f32x4 ga[4]; load_row(gain, c.lane, ga);
    {
        const int r0 = (int)(((long)c.gw * R) / c.ngw), r1 = (int)(((long)(c.gw + 1) * R) / c.ngw); f32x4 prev[4];
        {
            const bool seq_start = r0 < MP ? ((r0 & (TP - 1)) == 0) : (((r0 - MP) & 3) == 0);
            if (!seq_start && r0 < r1) { f32x4 v[4]; load_row(X + (size_t)(r0 - 1) * D, c.lane, v); const float rs = row_rstd(v);
#pragma unroll
                for (int j = 0; j < 4; ++j) prev[j] = v[j] * rs * ga[j]; }
        }
        for (int row = r0; row < r1; ++row) {
            const bool seq_start = row < MP ? ((row & (TP - 1)) == 0) : (((row - MP) & 3) == 0);
            if (seq_start) {
                if (row < MP) {
#pragma unroll
                    for (int j = 0; j < 4; ++j) prev[j] = (f32x4){0.f, 0.f, 0.f, 0.f}; }
                else load_row(p->in[I_SSHIFT] + ((size_t)li * SB + ((row - MP) >> 2)) * D, c.lane, prev);
            }
            f32x4 v[4]; load_row(X + (size_t)row * D, c.lane, v); const float rs = row_rstd(v);
            f32x4 xn[4];
#pragma unroll
            for (int j = 0; j < 4; ++j) xn[j] = v[j] * rs * ga[j];
#pragma unroll
            for (int m = 0; m < 6; ++m) {
                f32x4 y[4];
#pragma unroll
                for (int j = 0; j < 4; ++j) { const int mi = m == 1 ? 2 : (m == 2 ? 3 : (m == 3 ? 1 : m));
                    const f32x4 mm = ((const f32x4*)(mu + (size_t)mi * D))[c.lane + 64 * j]; y[j] = xn[j] + (prev[j] - xn[j]) * mm; }
                store_row_bf16(XM + ((size_t)m * R + row) * D, c.lane, y);
            }
            const bool seq_end = row < MP ? ((row & (TP - 1)) == TP - 1) : (((row - MP) & 3) == 3);
            if (seq_end) { float* so = row < MP ? p->out + O_SHP + ((size_t)li * NB + (row >> 13)) * D : p->out + O_SHS + ((size_t)li * SB + ((row - MP) >> 2)) * D;
#pragma unroll
                for (int j = 0; j < 4; ++j) ((f32x4*)so)[c.lane + 64 * j] = xn[j]; }
#pragma unroll
            for (int j = 0; j < 4; ++j) prev[j] = xn[j];
        }
    }
}
template <int NT, int ACT> __device__ __forceinline__ void lora1_item(const bf16_t* X, const bf16_t* W, bf16_t* HID, int coloff, int rb, int lane) {
    lane = launder_v(lane);
    const int fr = lane & 15, fq = lane >> 4;
    f32x4 acc[NT][2]; skinny_mma<NT>(X, 1024, W, 1024, 1024, rb * 32, coloff, lane, acc);
#pragma unroll
    for (int nt = 0; nt < NT; ++nt)
#pragma unroll
        for (int mt = 0; mt < 2; ++mt) { f32x4 v = acc[nt][mt];
#pragma unroll
            for (int r = 0; r < 4; ++r) { if (ACT == 1) { const float e = __builtin_amdgcn_exp2f(2.8853900817779268f * v[r]); v[r] = 1.0f - 2.0f * frcp(e + 1.0f); } if (ACT == 2) v[r] = sigmoidf_(v[r]); }
            u32x2 w; w.x = pk2(v[0], v[1]); w.y = pk2(v[2], v[3]);
            *(u32x2*)(HID + (size_t)(rb * 32 + mt * 16 + fr) * LHID + coloff + nt * 16 + 4 * fq) = w; }
}
__device__ __forceinline__ void phase_lora1(KP p, const Ctx& c, int li) {
    const bf16_t* XM = (const bf16_t*)(p->ws + WS_XM); const bf16_t* W = (const bf16_t*)(p->ws + WS_W1T) + (size_t)li * 288 * 1024; bf16_t* HID = (bf16_t*)(p->ws + WS_HID);
    constexpr int NRB = R / 32;
    for (int it = blockIdx.x + gridDim.x * c.wave; it < 5 * NRB; it += c.ngw) { const int q = it / NRB, rb = it % NRB;
        if (q == 0) lora1_item<4, 1>(XM + (size_t)3 * R * D, W, HID, 0, rb, c.lane);
        else if (q == 1) lora1_item<4, 0>(XM + (size_t)4 * R * D, W, HID, 64, rb, c.lane);
        else if (q == 2) { if (li == 1) lora1_item<2, 0>(XM + (size_t)2 * R * D, W, HID, 128, rb, c.lane); }
        else if (q == 3) lora1_item<4, 2>(XM + (size_t)5 * R * D, W, HID, 160, rb, c.lane);
        else lora1_item<4, 2>(XM + (size_t)5 * R * D, W, HID, 224, rb, c.lane);
    }
}

constexpr int SST = 72, MAT = 64 * SST * 2;
constexpr int O_AT = 0, O_BT = MAT, O_KT = 2 * MAT, O_RT = 3 * MAT, O_VT = 4 * MAT, O_BH = 5 * MAT, O_KH = 6 * MAT, O_XT = 7 * MAT, O_AAB = 9 * MAT, O_AAK = 10 * MAT, O_ARB = 11 * MAT, O_ARK = 12 * MAT;
constexpr int O_TD = 13 * MAT, O_SCR = O_TD + 2048, O_CS = O_SCR + 4096, O_WC = O_CS + 2048, O_LW = O_XT, O_LA = O_XT + 16384, O_LV = O_XT + 32768;
static_assert(O_WC + 256 <= RING_BYTES && O_LV + 16384 <= O_TD, "scan LDS map");
__device__ __forceinline__ bf16x8 ldsfrag(LAS unsigned char* lds, int off, int row, int col) { return *(const LAS bf16x8*)(lds + off + (row * SST + col) * 2); }
__device__ __forceinline__ void lds_st4(LAS unsigned char* lds, int off, int row, int col, f32x4 v) { u32x2 w; w.x = pk2(v[0], v[1]); w.y = pk2(v[2], v[3]); *(LAS u32x2*)(lds + off + (row * SST + col) * 2) = w; }
__device__ __forceinline__ f32x4 lds_ld4(LAS unsigned char* lds, int off, int row, int col) { const u32x2 w = *(const LAS u32x2*)(lds + off + (row * SST + col) * 2); return (f32x4){bflo(w.x), bfhi(w.x), bflo(w.y), bfhi(w.y)}; }

__device__ __forceinline__ void scanA_unit(KP p, const Ctx& c, int li, int u) {
    LAS unsigned char* lds = c.lds; unsigned char* ws = p->ws; const int stop = p->pad;
    const int lane = c.lane, wave = c.wave, fr = lane & 15, fq = lane >> 4;
    const int b = u / (NCH * H), n = (u / H) % NCH, h = u % H, row0 = b * TP + 64 * n;
    const float* Rb = (const float*)(ws + WS_RK_R); const float* Kb = (const float*)(ws + WS_RK_K);
    float* Vb = (float*)(ws + (li ? WS_V1 : WS_V0)); const float* V0b = (const float*)(ws + WS_V0);
    const bf16_t* HID = (const bf16_t*)(ws + WS_HID);
    {
        const int tt = wave & 3, chh = wave >> 2;
        const bf16_t* hrow = launder_p(HID + (size_t)(row0 + 16 * tt + fr) * LHID + 8 * fq);
        const bf16_t* W2W = (const bf16_t*)(ws + WS_W2W) + (size_t)li * 1024 * 64; const bf16_t* W2A = (const bf16_t*)(ws + WS_W2A) + (size_t)li * 1024 * 64; const bf16_t* W2V = (const bf16_t*)(ws + WS_W2V);
#pragma unroll
        for (int cti = 0; cti < 2; ++cti) { const int ct = 2 * chh + cti, C = 64 * h + 16 * ct + fr;
            f32x4 aw = {0.f, 0.f, 0.f, 0.f}, aa = {0.f, 0.f, 0.f, 0.f}, av = {0.f, 0.f, 0.f, 0.f};
#pragma unroll
            for (int ks = 0; ks < 2; ++ks) {
                aw = mfma16(*(const bf16x8*)(W2W + (size_t)C * 64 + 32 * ks + 8 * fq), *(const bf16x8*)(hrow + 32 * ks), aw);
                aa = mfma16(*(const bf16x8*)(W2A + (size_t)C * 64 + 32 * ks + 8 * fq), *(const bf16x8*)(hrow + 64 + 32 * ks), aa); }
            if (li) av = mfma16(*(const bf16x8*)(W2V + (size_t)C * 32 + 8 * fq), *(const bf16x8*)(hrow + 128), av);
            const int t = 16 * tt + fr, cc = 16 * ct + 4 * fq;
            *(LAS f32x4*)(lds + O_LW + (t * 64 + cc) * 4) = aw; *(LAS f32x4*)(lds + O_LA + (t * 64 + cc) * 4) = aa; *(LAS f32x4*)(lds + O_LV + (t * 64 + cc) * 4) = av; }
    }
    __syncthreads();
    if (stop == 1) return;
    {
        const int cc = lane, tq = wave, C = 64 * h + cc; const size_t pc = (size_t)li * D + C;
        const float w0 = p->in[I_W0][pc], a0 = p->in[I_A0][pc], kkc = p->in[I_KK][pc], kac = p->in[I_KA][pc], rkc = p->in[I_RKK][pc], v0 = li ? p->in[I_V0][C] : 0.f;
        float wlg[8], Lin[8], rr[8], k2[8], vv[8], aa[8], bb[8]; float run = 0.f;
#pragma unroll
        for (int e = 0; e < 8; ++e) { const int t = 8 * tq + e; const size_t gi = (size_t)(row0 + t) * D + C;
            const float r = Rb[gi], k = Kb[gi]; float v = Vb[gi];
            const float lw = *(const LAS float*)(lds + O_LW + (t * 64 + cc) * 4), la = *(const LAS float*)(lds + O_LA + (t * 64 + cc) * 4);
            const float z = -(w0 + lw); const float sp = fmaxf(z, 0.f) + __logf(1.0f + __expf(-fabsf(z))); const float wl = -__expf(-sp - 0.5f);
            const float asig = sigmoidf_(a0 + la);
            if (li) { const float lv = *(const LAS float*)(lds + O_LV + (t * 64 + cc) * 4); const float vg = sigmoidf_(v0 + lv); const float vf = V0b[gi]; v = v + (vf - v) * vg; Vb[gi] = v; }
            const float kkr = k * kkc; const float ss = wave_sum(kkr * kkr); const float kkn = kkr * frsq(fmaxf(ss, 1e-24f));
            const float kmod = k * (1.0f + (asig - 1.0f) * kac);
            const float rks = wave_sum(r * kmod * rkc); if (cc == 0) ((float*)(ws + WS_RKS))[(size_t)(row0 + t) * 16 + h] = rks;
            run += wl; wlg[e] = wl; Lin[e] = run; rr[e] = r; k2[e] = kmod; vv[e] = v; aa[e] = -kkn; bb[e] = kkn * asig; }
        *(LAS float*)(lds + O_CS + (tq * 64 + cc) * 4) = run;
        __syncthreads();
        float off = 0.f, tot = 0.f;
#pragma unroll
        for (int q = 0; q < 8; ++q) { const float x = *(const LAS float*)(lds + O_CS + (q * 64 + cc) * 4); tot += x; if (q < tq) off += x; }
        u32x4 wa, wv, wb, wk; unsigned pa[8], pv[8], pb[8], pk[8];
#pragma unroll
        for (int e = 0; e < 8; ++e) { const int t = 8 * tq + e; const float L = off + Lin[e], Lp = L - wlg[e];
            const float eL = __expf(L), eLp = __expf(Lp), enL = __expf(-L), eT = __expf(tot - L);
            const float at = aa[e] * eLp, bt = bb[e] * enL, kt = k2[e] * enL, rt = rr[e] * eL, bh = bb[e] * eT, kh = k2[e] * eT;
            *(LAS bf16_t*)(lds + O_AT + (t * SST + cc) * 2) = (bf16_t)f2bf(at); *(LAS bf16_t*)(lds + O_BT + (t * SST + cc) * 2) = (bf16_t)f2bf(bt);
            *(LAS bf16_t*)(lds + O_KT + (t * SST + cc) * 2) = (bf16_t)f2bf(kt); *(LAS bf16_t*)(lds + O_RT + (t * SST + cc) * 2) = (bf16_t)f2bf(rt);
            pa[e] = f2bf(at); pv[e] = f2bf(vv[e]); pb[e] = f2bf(bh); pk[e] = f2bf(kh); }
        wa = (u32x4){pa[0] | (pa[1] << 16), pa[2] | (pa[3] << 16), pa[4] | (pa[5] << 16), pa[6] | (pa[7] << 16)};
        wv = (u32x4){pv[0] | (pv[1] << 16), pv[2] | (pv[3] << 16), pv[4] | (pv[5] << 16), pv[6] | (pv[7] << 16)};
        wb = (u32x4){pb[0] | (pb[1] << 16), pb[2] | (pb[3] << 16), pb[4] | (pb[5] << 16), pb[6] | (pb[7] << 16)};
        wk = (u32x4){pk[0] | (pk[1] << 16), pk[2] | (pk[3] << 16), pk[4] | (pk[5] << 16), pk[6] | (pk[7] << 16)};
        *(LAS u32x4*)(lds + O_XT + (cc * SST + 8 * tq) * 2) = wa; *(LAS u32x4*)(lds + O_VT + (cc * SST + 8 * tq) * 2) = wv;
        *(LAS u32x4*)(lds + O_BH + (cc * SST + 8 * tq) * 2) = wb; *(LAS u32x4*)(lds + O_KH + (cc * SST + 8 * tq) * 2) = wk;
        if (tq == 0) *(LAS float*)(lds + O_WC + cc * 4) = __expf(tot);
    }
    __syncthreads();
    if (stop == 2) return;
    {
        const int mi = wave >> 1, ph = wave & 1; const int oY = (mi & 1) ? O_KT : O_BT, oX = (mi < 2) ? O_AT : O_RT; const bool strict = mi < 2;
        const int oO = mi == 0 ? O_AAB : (mi == 1 ? O_AAK : (mi == 2 ? O_ARB : O_ARK));
#pragma unroll
        for (int sti = 0; sti < 2; ++sti) { const int st = 2 * ph + sti;
#pragma unroll
            for (int tt = 0; tt < 4; ++tt) { f32x4 acc = {0.f, 0.f, 0.f, 0.f};
                if (st <= tt) {
#pragma unroll
                    for (int ks = 0; ks < 2; ++ks) acc = mfma16(ldsfrag(lds, oY, 16 * st + fr, 32 * ks + 8 * fq), ldsfrag(lds, oX, 16 * tt + fr, 32 * ks + 8 * fq), acc);
                    const int t = 16 * tt + fr;
#pragma unroll
                    for (int r = 0; r < 4; ++r) { const int s = 16 * st + 4 * fq + r; const bool keep = strict ? (s < t) : (s <= t); acc[r] = keep ? acc[r] : 0.f; } }
                if (st <= tt) lds_st4(lds, oO, 16 * tt + fr, 16 * st + 4 * fq, acc);
                else { u32x2 zz; int z0 = 0; asm volatile("" : "+v"(z0)); zz.x = (unsigned)z0; zz.y = (unsigned)z0; *(LAS u32x2*)(lds + oO + ((16 * tt + fr) * SST + 16 * st + 4 * fq) * 2) = zz; } } }
    }
    __syncthreads();
    if (stop == 3) return;
    {
        const int tt = wave & 3, ih = wave >> 2;
#pragma unroll
        for (int iti = 0; iti < 2; ++iti) { const int it = 2 * ih + iti; f32x4 acc = {0.f, 0.f, 0.f, 0.f};
#pragma unroll
            for (int ks = 0; ks < 2; ++ks) acc = mfma16(ldsfrag(lds, O_AAK, 16 * tt + fr, 32 * ks + 8 * fq), ldsfrag(lds, O_VT, 16 * it + fr, 32 * ks + 8 * fq), acc);
            lds_st4(lds, O_XT, 64 + 16 * it + fr, 16 * tt + 4 * fq, acc); }
        if (wave < 4 && lane < 16) { const int I = wave; float x[16];
#pragma unroll
            for (int t = 0; t < 16; ++t) { float s = (t == lane) ? 1.0f : 0.0f;
#pragma unroll
                for (int q = 0; q < t; ++q) s += bf2f(*(const LAS bf16_t*)(lds + O_AAB + ((16 * I + t) * SST + 16 * I + q) * 2)) * x[q];
                x[t] = s; *(LAS bf16_t*)(lds + O_TD + ((I * 16 + t) * 16 + lane) * 2) = (bf16_t)f2bf(s); } }
    }
    __syncthreads();
    if (stop == 5) return;
    {
        const int colb = 16 * wave; const bf16x8 zero8 = {0, 0, 0, 0, 0, 0, 0, 0};
#pragma unroll
        for (int I = 0; I < 4; ++I) {
            f32x4 acc = lds_ld4(lds, O_XT, colb + fr, 16 * I + 4 * fq);
#pragma unroll
            for (int ks = 0; ks < 2; ++ks) if (32 * ks < 16 * I) { const bool ok = (32 * ks + 8 * fq) < 16 * I;
                const bf16x8 a = ok ? ldsfrag(lds, O_AAB, 16 * I + fr, 32 * ks + 8 * fq) : zero8, bq = ok ? ldsfrag(lds, O_XT, colb + fr, 32 * ks + 8 * fq) : zero8;
                acc = mfma16(a, bq, acc); }
            { u32x2 w; w.x = pk2(acc[0], acc[1]); w.y = pk2(acc[2], acc[3]); *(LAS u32x2*)(lds + O_SCR + wave * 512 + (fr * 16 + 4 * fq) * 2) = w; }
            LDS_WAIT();
            const bf16x8 ta = fq < 2 ? *(const LAS bf16x8*)(lds + O_TD + ((I * 16 + fr) * 16 + 8 * fq) * 2) : zero8;
            const bf16x8 tb = fq < 2 ? *(const LAS bf16x8*)(lds + O_SCR + wave * 512 + (fr * 16 + 8 * fq) * 2) : zero8;
            const f32x4 res = mfma16(ta, tb, (f32x4){0.f, 0.f, 0.f, 0.f});
            lds_st4(lds, O_XT, colb + fr, 16 * I + 4 * fq, res);
            LDS_WAIT();
        }
    }
    __syncthreads();
    if (stop == 6) return;
    {
        const int tb = wave & 3, hb = wave >> 2;
        bf16_t* RP = (bf16_t*)(ws + WS_RP) + (size_t)u * 4096; float* YL = (float*)(ws + WS_YL) + (size_t)u * 4096;
        bf16_t* MTH = (bf16_t*)(ws + WS_MT) + (size_t)u * 4096; bf16_t* MTL = MTH + (size_t)NUNIT_A * 4096; float* NN = (float*)(ws + WS_NN) + (size_t)u * 4096;
#pragma unroll
        for (int qi = 0; qi < 2; ++qi) { const int rt = 2 * hb + qi;
            { f32x4 acc = lds_ld4(lds, O_RT, 16 * tb + fr, 16 * rt + 4 * fq);
#pragma unroll
              for (int ks = 0; ks < 2; ++ks) acc = mfma16(ldsfrag(lds, O_XT, 16 * rt + fr, 32 * ks + 8 * fq), ldsfrag(lds, O_ARB, 16 * tb + fr, 32 * ks + 8 * fq), acc);
              u32x2 w; w.x = pk2(acc[0], acc[1]); w.y = pk2(acc[2], acc[3]); *(u32x2*)(RP + (size_t)(16 * tb + fr) * 64 + 16 * rt + 4 * fq) = w; }
            { f32x4 acc = {0.f, 0.f, 0.f, 0.f};
#pragma unroll
              for (int ks = 0; ks < 2; ++ks) { acc = mfma16(ldsfrag(lds, O_XT, 64 + 16 * rt + fr, 32 * ks + 8 * fq), ldsfrag(lds, O_ARB, 16 * tb + fr, 32 * ks + 8 * fq), acc);
                  acc = mfma16(ldsfrag(lds, O_VT, 16 * rt + fr, 32 * ks + 8 * fq), ldsfrag(lds, O_ARK, 16 * tb + fr, 32 * ks + 8 * fq), acc); }
              *(f32x4*)(YL + (size_t)(16 * tb + fr) * 64 + 16 * rt + 4 * fq) = acc; }
            { f32x4 acc = {0.f, 0.f, 0.f, 0.f};
#pragma unroll
              for (int ks = 0; ks < 2; ++ks) acc = mfma16(ldsfrag(lds, O_XT, 16 * rt + fr, 32 * ks + 8 * fq), ldsfrag(lds, O_BH, 16 * tb + fr, 32 * ks + 8 * fq), acc);
              const int j = 16 * tb + fr; const float wc = *(const LAS float*)(lds + O_WC + j * 4);
#pragma unroll
              for (int r = 0; r < 4; ++r) if (16 * rt + 4 * fq + r == j) acc[r] += wc;
              unsigned hh[4], ll[4];
#pragma unroll
              for (int r = 0; r < 4; ++r) { hh[r] = f2bf(acc[r]); ll[r] = f2bf(acc[r] - __builtin_bit_cast(float, hh[r] << 16)); }
              *(u32x2*)(MTH + (size_t)j * 64 + 16 * rt + 4 * fq) = (u32x2){hh[0] | (hh[1] << 16), hh[2] | (hh[3] << 16)};
              *(u32x2*)(MTL + (size_t)j * 64 + 16 * rt + 4 * fq) = (u32x2){ll[0] | (ll[1] << 16), ll[2] | (ll[3] << 16)}; }
            { f32x4 acc = {0.f, 0.f, 0.f, 0.f};
#pragma unroll
              for (int ks = 0; ks < 2; ++ks) { acc = mfma16(ldsfrag(lds, O_BH, 16 * rt + fr, 32 * ks + 8 * fq), ldsfrag(lds, O_XT, 64 + 16 * tb + fr, 32 * ks + 8 * fq), acc);
                  acc = mfma16(ldsfrag(lds, O_KH, 16 * rt + fr, 32 * ks + 8 * fq), ldsfrag(lds, O_VT, 16 * tb + fr, 32 * ks + 8 * fq), acc); }
              *(f32x4*)(NN + (size_t)(16 * tb + fr) * 64 + 16 * rt + 4 * fq) = acc; }
        }
    }
    __syncthreads();
}

__device__ __forceinline__ void scan_sample_item(KP p, const Ctx& c, int li, int item) {
    unsigned char* ws = p->ws; const int lane = c.lane, b = item >> 4, h = item & 15, C = 64 * h + lane; const size_t pc = (size_t)li * D + C;
    LAS float* sc = (LAS float*)(c.lds + c.wave * 16384);
    const float* Rb = (const float*)(ws + WS_RK_R); const float* Kb = (const float*)(ws + WS_RK_K);
    float* Vb = (float*)(ws + (li ? WS_V1 : WS_V0)); const float* V0b = (const float*)(ws + WS_V0);
    const bf16_t* HID = (const bf16_t*)(ws + WS_HID) + (size_t)(MP + 4 * b) * LHID;
    for (int e = lane; e < 4 * LHID; e += 64) sc[e] = bf2f(HID[e]);
    LDS_WAIT();
    float lw[4] = {0.f, 0.f, 0.f, 0.f}, la[4] = {0.f, 0.f, 0.f, 0.f}, lv[4] = {0.f, 0.f, 0.f, 0.f}, lg[4] = {0.f, 0.f, 0.f, 0.f};
    {
        const bf16_t* W2W = (const bf16_t*)(ws + WS_W2W) + ((size_t)li * 1024 + C) * 64; const bf16_t* W2A = (const bf16_t*)(ws + WS_W2A) + ((size_t)li * 1024 + C) * 64;
        const bf16_t* W2V = (const bf16_t*)(ws + WS_W2V) + (size_t)C * 32; const bf16_t* W2G = (const bf16_t*)(ws + WS_W2G) + ((size_t)li * 1024 + C) * 128;
#define LORA2_BLK(WP, QB, HOFF, ACC) { const u32x4 w8 = *(const u32x4*)((WP) + 8 * (QB)); \
            const float wf0 = bflo(w8.x), wf1 = bfhi(w8.x), wf2 = bflo(w8.y), wf3 = bfhi(w8.y), wf4 = bflo(w8.z), wf5 = bfhi(w8.z), wf6 = bflo(w8.w), wf7 = bfhi(w8.w); \
            _Pragma("unroll") for (int t = 0; t < 4; ++t) { const f32x4 h0 = *(const LAS f32x4*)(sc + t * LHID + (HOFF) + 8 * (QB)), h1 = *(const LAS f32x4*)(sc + t * LHID + (HOFF) + 8 * (QB) + 4); \
                ACC[t] += (h0[0] * wf0 + h0[1] * wf1) + (h0[2] * wf2 + h0[3] * wf3) + (h1[0] * wf4 + h1[1] * wf5) + (h1[2] * wf6 + h1[3] * wf7); } \
            asm volatile("" : "+v"(ACC[0]), "+v"(ACC[1]), "+v"(ACC[2]), "+v"(ACC[3]) :: "memory"); }
#pragma unroll
        for (int qb = 0; qb < 8; ++qb) { LORA2_BLK(W2W, qb, 0, lw) LORA2_BLK(W2A, qb, 64, la) }
        if (li) {
#pragma unroll
            for (int qb = 0; qb < 4; ++qb) LORA2_BLK(W2V, qb, 128, lv) }
#pragma unroll
        for (int qb = 0; qb < 16; ++qb) LORA2_BLK(W2G, qb, 160, lg)
#undef LORA2_BLK
    }
    const float w0 = p->in[I_W0][pc], a0 = p->in[I_A0][pc], kkc = p->in[I_KK][pc], kac = p->in[I_KA][pc], rkc = p->in[I_RKK][pc], v0 = li ? p->in[I_V0][C] : 0.f;
    const float lnw = p->in[I_LNW][pc], lnb = p->in[I_LNB][pc];
    float S[64];
    { const f32x4* sp = (const f32x4*)(p->in[I_SWKV] + (((size_t)li * SB + b) * H + h) * 4096 + lane * 64);
#pragma unroll
      for (int q = 0; q < 16; ++q) { const f32x4 x = sp[q]; S[4 * q] = x[0]; S[4 * q + 1] = x[1]; S[4 * q + 2] = x[2]; S[4 * q + 3] = x[3]; } }
    LAS float* bc = sc + 1280;
    bf16_t* YG = (bf16_t*)(ws + WS_YG);
#pragma unroll
    for (int t = 0; t < 4; ++t) { const size_t gi = (size_t)(MP + 4 * b + t) * D + C;
        const float r = Rb[gi], k = Kb[gi]; float v = Vb[gi];
        const float z = -(w0 + lw[t]); const float sp = fmaxf(z, 0.f) + __logf(1.0f + __expf(-fabsf(z))); const float wdec = __expf(-__expf(-sp - 0.5f));
        const float asig = sigmoidf_(a0 + la[t]);
        if (li) { const float vg = sigmoidf_(v0 + lv[t]); const float vf = V0b[gi]; v = v + (vf - v) * vg; }
        const float kkr = k * kkc; const float ss = wave_sum(kkr * kkr); const float kkn = kkr * frsq(fmaxf(ss, 1e-24f));
        const float kmod = k * (1.0f + (asig - 1.0f) * kac);
        const float rks = wave_sum(r * kmod * rkc);
        LDS_WAIT();
        bc[lane] = wdec; bc[64 + lane] = -kkn; bc[128 + lane] = kkn * asig; bc[192 + lane] = kmod; bc[256 + lane] = r;
        LDS_WAIT();
        float sa = 0.f;
#pragma unroll
        for (int q = 0; q < 16; ++q) { const f32x4 av = *(const LAS f32x4*)(bc + 64 + 4 * q); sa += S[4 * q] * av[0] + S[4 * q + 1] * av[1] + S[4 * q + 2] * av[2] + S[4 * q + 3] * av[3]; }
        float y = 0.f;
#pragma unroll
        for (int q = 0; q < 16; ++q) { const f32x4 wv = *(const LAS f32x4*)(bc + 4 * q), bv = *(const LAS f32x4*)(bc + 128 + 4 * q), kv = *(const LAS f32x4*)(bc + 192 + 4 * q), rv = *(const LAS f32x4*)(bc + 256 + 4 * q);
#pragma unroll
            for (int e = 0; e < 4; ++e) { const float s = S[4 * q + e] * wv[e] + sa * bv[e] + v * kv[e]; S[4 * q + e] = s; y += s * rv[e]; } }
        const float mean = wave_sum(y) * (1.0f / 64.0f); const float dy = y - mean; const float var = wave_sum(dy * dy) * (1.0f / 64.0f);
        const float yn = dy * (frsq(var + GN_EPS)) * lnw + lnb;
        YG[gi] = (bf16_t)f2bf((yn + rks * v) * lg[t]);
    }
    { f32x4* so = (f32x4*)(p->out + O_WKVS + (((size_t)li * SB + b) * H + h) * 4096 + lane * 64);
#pragma unroll
      for (int q = 0; q < 16; ++q) so[q] = (f32x4){S[4 * q], S[4 * q + 1], S[4 * q + 2], S[4 * q + 3]}; }
    LDS_WAIT();
}

__device__ __forceinline__ void phase_scanA(KP p, const Ctx& c, int li) {
    const int stop = p->pad;
    if (stop != 9) for (int u = blockIdx.x; u < NUNIT_A; u += gridDim.x) scanA_unit(p, c, li, u);
    if (stop == 0 || stop == 9) for (int it = c.gw; it < SB * H; it += c.ngw) scan_sample_item(p, c, li, it);
}

__device__ __forceinline__ void hilo(const f32x4 x0, const f32x4 x1, bf16x8& hi, bf16x8& lo) {
    unsigned h[8], l[8];
#pragma unroll
    for (int e = 0; e < 8; ++e) { const float x = e < 4 ? x0[e] : x1[e - 4]; h[e] = f2bf(x); l[e] = f2bf(x - __builtin_bit_cast(float, h[e] << 16)); }
    u32x4 hv = {h[0] | (h[1] << 16), h[2] | (h[3] << 16), h[4] | (h[5] << 16), h[6] | (h[7] << 16)}, lv = {l[0] | (l[1] << 16), l[2] | (l[3] << 16), l[4] | (l[5] << 16), l[6] | (l[7] << 16)};
    hi = __builtin_bit_cast(bf16x8, hv); lo = __builtin_bit_cast(bf16x8, lv);
}
constexpr int SB_SLOT = 20480, SB_RING0 = 8192, SB_DEPTH = 6;
static_assert(SB_RING0 + SB_DEPTH * SB_SLOT <= RING_BYTES, "chain ring");
__device__ __forceinline__ void phase_scanB(KP p, const Ctx& c, int li) {
    unsigned char* ws = p->ws; LAS unsigned char* lds = c.lds; const int lane = c.lane, fr = lane & 15, fq = lane >> 4, wave = c.wave;
    volatile LAS int* FL = (volatile LAS int*)(lds + RING_BYTES);
    if (c.tid < 4) FL[c.tid] = 0;
    __syncthreads();
    const int ncb = (int)gridDim.x < 128 ? (int)gridDim.x : 128;
    if (wave >= 4 || (int)blockIdx.x >= ncb) {
        const int gwf = (int)blockIdx.x < ncb ? (int)blockIdx.x * 4 + (wave - 4) : ncb * 4 + ((int)blockIdx.x - ncb) * 8 + wave, ngwf = ncb * 4 + ((int)gridDim.x - ncb) * 8;
        phase_fill(p, c, li, gwf, ngwf); return; }
    if (wave != 0) {
        const int j = wave - 1; int prevG = -1, kc = 0;
        for (int ch = blockIdx.x; ch < 128; ch += gridDim.x, ++kc) { const int b = ch >> 6, h = (ch >> 2) & 15, iq = ch & 3;
            for (int n = j; n < NCH; n += 3) { const int G = kc * NCH + n;
                if (G >= SB_DEPTH) { unsigned sp = 0; while (FL[0] < G - (SB_DEPTH - 1)) { __builtin_amdgcn_s_sleep(1); if (++sp > (1u << 22)) break; } }
                LAS unsigned char* slot = lds + SB_RING0 + (G % SB_DEPTH) * SB_SLOT;
                const size_t u = (size_t)(b * NCH + n) * H + h; const bf16_t* MTH = (const bf16_t*)(ws + WS_MT) + u * 4096; const bf16_t* MTL = MTH + (size_t)NUNIT_A * 4096; const float* NN = (const float*)(ws + WS_NN) + u * 4096;
#pragma unroll
                for (int jt = 0; jt < 4; ++jt)
#pragma unroll
                    for (int ks = 0; ks < 2; ++ks) {
                        __builtin_amdgcn_global_load_lds((const unsigned*)(MTH + (size_t)(16 * jt + fr) * 64 + 32 * ks + 8 * fq), (LAS unsigned*)(slot + ((jt * 2 + ks) * 2 + 0) * 1024), 16, 0, 0);
                        __builtin_amdgcn_global_load_lds((const unsigned*)(MTL + (size_t)(16 * jt + fr) * 64 + 32 * ks + 8 * fq), (LAS unsigned*)(slot + ((jt * 2 + ks) * 2 + 1) * 1024), 16, 0, 0); }
#pragma unroll
                for (int jt = 0; jt < 4; ++jt)
                    __builtin_amdgcn_global_load_lds((const unsigned*)(NN + (size_t)(16 * iq + fr) * 64 + 16 * jt + 4 * fq), (LAS unsigned*)(slot + (16 + jt) * 1024), 16, 0, 0);
                asm volatile("s_waitcnt vmcnt(20)" ::: "memory");
                if (prevG >= 0) FL[1 + j] = prevG + 1;
                prevG = G; } }
        asm volatile("s_waitcnt vmcnt(0)" ::: "memory");
        if (prevG >= 0) FL[1 + j] = prevG + 1;
        return; }
    int kc = 0;
    for (int ch = blockIdx.x; ch < 128; ch += gridDim.x, ++kc) {
        const int b = ch >> 6, h = (ch >> 2) & 15, iq = ch & 3;
        f32x4 S[4];
#pragma unroll
        for (int jt = 0; jt < 4; ++jt) S[jt] = (f32x4){0.f, 0.f, 0.f, 0.f};
        int j3 = 0;
        for (int n = 0; n < NCH; ++n) { const int G = kc * NCH + n;
            const size_t u = (size_t)(b * NCH + n) * H + h; bf16_t* S0 = (bf16_t*)(ws + WS_S0) + u * 4096;
            { unsigned sp = 0; while (FL[1 + j3] < G + 1) { __builtin_amdgcn_s_sleep(1); if (++sp > (1u << 22)) break; } }
            const LAS unsigned char* slot = lds + SB_RING0 + (G % SB_DEPTH) * SB_SLOT + lane * 16;
            bf16x8 ah[4][2], al[4][2]; f32x4 nn[4];
#pragma unroll
            for (int jt = 0; jt < 4; ++jt) { nn[jt] = *(const LAS f32x4*)(slot + (16 + jt) * 1024);
#pragma unroll
                for (int ks = 0; ks < 2; ++ks) { ah[jt][ks] = *(const LAS bf16x8*)(slot + ((jt * 2 + ks) * 2 + 0) * 1024); al[jt][ks] = *(const LAS bf16x8*)(slot + ((jt * 2 + ks) * 2 + 1) * 1024); } }
#pragma unroll
            for (int jt = 0; jt < 4; ++jt) { unsigned hh[4], ll[4];
#pragma unroll
                for (int r = 0; r < 4; ++r) { hh[r] = f2bf(S[jt][r]); ll[r] = f2bf(S[jt][r] - __builtin_bit_cast(float, hh[r] << 16)); }
                u32x2 wh = {hh[0] | (hh[1] << 16), hh[2] | (hh[3] << 16)}, wl = {ll[0] | (ll[1] << 16), ll[2] | (ll[3] << 16)};
                *(u32x2*)(S0 + (size_t)(16 * iq + fr) * 64 + 16 * jt + 4 * fq) = wh;
                *(LAS u32x2*)(lds + (fr * SST + 16 * jt + 4 * fq) * 2) = wh; *(LAS u32x2*)(lds + 4096 + (fr * SST + 16 * jt + 4 * fq) * 2) = wl; }
            LDS_WAIT();
            bf16x8 bh[2], bl[2];
#pragma unroll
            for (int ks = 0; ks < 2; ++ks) { bh[ks] = *(const LAS bf16x8*)(lds + (fr * SST + 32 * ks + 8 * fq) * 2); bl[ks] = *(const LAS bf16x8*)(lds + 4096 + (fr * SST + 32 * ks + 8 * fq) * 2); }
#pragma unroll
            for (int jt = 0; jt < 4; ++jt) { f32x4 acc = nn[jt];
#pragma unroll
                for (int ks = 0; ks < 2; ++ks) { acc = mfma16(ah[jt][ks], bh[ks], acc); acc = mfma16(ah[jt][ks], bl[ks], acc); acc = mfma16(al[jt][ks], bh[ks], acc); }
                S[jt] = acc; }
            LDS_WAIT();
            FL[0] = G + 1;
            j3 = j3 == 2 ? 0 : j3 + 1;
        }
        float* so = p->out + O_WKVP + (((size_t)li * NB + b) * H + h) * 4096;
#pragma unroll
        for (int jt = 0; jt < 4; ++jt) *(f32x4*)(so + (size_t)(16 * iq + fr) * 64 + 16 * jt + 4 * fq) = S[jt];
    }
}

__device__ __forceinline__ void phase_scanC(KP p, const Ctx& c, int li) {
    unsigned char* ws = p->ws; const int lane = c.lane, fr = lane & 15, fq = lane >> 4, hb = c.wave >> 2, tt = c.wave & 3;
    const float* Vb = (const float*)(ws + (li ? WS_V1 : WS_V0)); const bf16_t* HID = (const bf16_t*)(ws + WS_HID); const bf16_t* W2G = (const bf16_t*)(ws + WS_W2G) + (size_t)li * 1024 * 128;
    bf16_t* YG = (bf16_t*)(ws + WS_YG);
    for (int up = blockIdx.x; up < NUNIT_A / 2; up += gridDim.x) {
        const int u = 2 * up + hb; const int b = u / (NCH * H), n = (u / H) % NCH, h = u % H; const int row = b * TP + 64 * n + 16 * tt + fr;
        const bf16_t* RP = (const bf16_t*)(ws + WS_RP) + (size_t)u * 4096; const float* YL = (const float*)(ws + WS_YL) + (size_t)u * 4096; const bf16_t* S0 = (const bf16_t*)(ws + WS_S0) + (size_t)u * 4096;
        f32x4 acc[4], ag[4];
#pragma unroll
        for (int it = 0; it < 4; ++it) { acc[it] = *(const f32x4*)(YL + (size_t)(16 * tt + fr) * 64 + 16 * it + 4 * fq); ag[it] = (f32x4){0.f, 0.f, 0.f, 0.f}; }
#pragma unroll
        for (int ks = 0; ks < 2; ++ks) { const bf16x8 bq = *(const bf16x8*)(RP + (size_t)(16 * tt + fr) * 64 + 32 * ks + 8 * fq);
#pragma unroll
            for (int it = 0; it < 4; ++it) acc[it] = mfma16(*(const bf16x8*)(S0 + (size_t)(16 * it + fr) * 64 + 32 * ks + 8 * fq), bq, acc[it]); }
        const bf16_t* hgp = launder_p(HID + (size_t)row * LHID + 160 + 8 * fq); const bf16_t* wgp = launder_p(W2G + (size_t)(64 * h + fr) * 128 + 8 * fq);
#pragma unroll
        for (int ks = 0; ks < 4; ++ks) { const bf16x8 bq = *(const bf16x8*)(hgp + 32 * ks);
#pragma unroll
            for (int it = 0; it < 4; ++it) ag[it] = mfma16(*(const bf16x8*)(wgp + it * 16 * 128 + 32 * ks), bq, ag[it]); }
        float s = 0.f;
#pragma unroll
        for (int it = 0; it < 4; ++it) s += (acc[it][0] + acc[it][1]) + (acc[it][2] + acc[it][3]);
        s = sum_rows4(s); const float mean = s * (1.0f / 64.0f);
        float q = 0.f;
#pragma unroll
        for (int it = 0; it < 4; ++it) { const f32x4 d = acc[it] - mean; q += (d[0] * d[0] + d[1] * d[1]) + (d[2] * d[2] + d[3] * d[3]); }
        q = sum_rows4(q); const float rstd = frsq(q * (1.0f / 64.0f) + GN_EPS);
        const float rks = ((const float*)(ws + WS_RKS))[(size_t)row * 16 + h];
#pragma unroll
        for (int it = 0; it < 4; ++it) { const int C = 64 * h + 16 * it + 4 * fq; const size_t pc = (size_t)li * D + C;
            const f32x4 lw = *(const f32x4*)(p->in[I_LNW] + pc), lb = *(const f32x4*)(p->in[I_LNB] + pc), v = *(const f32x4*)(Vb + (size_t)row * D + C);
            const f32x4 o = ((acc[it] - mean) * rstd * lw + lb + v * rks) * ag[it];
            u32x2 w; w.x = pk2(o[0], o[1]); w.y = pk2(o[2], o[3]); *(u32x2*)(YG + (size_t)row * D + C) = w; }
    }
}
__device__ __forceinline__ void ld8bf(const bf16_t* p, float (&o)[8]) { const u32x4 w = *(const u32x4*)p; o[0] = bflo(w.x); o[1] = bfhi(w.x); o[2] = bflo(w.y); o[3] = bfhi(w.y); o[4] = bflo(w.z); o[5] = bfhi(w.z); o[6] = bflo(w.w); o[7] = bfhi(w.w); }
__device__ __forceinline__ void ld8f(const float* p, float (&o)[8]) { const f32x4 a = *(const f32x4*)p, b = *(const f32x4*)(p + 4); o[0] = a[0]; o[1] = a[1]; o[2] = a[2]; o[3] = a[3]; o[4] = b[0]; o[5] = b[1]; o[6] = b[2]; o[7] = b[3]; }
__device__ __forceinline__ void phase_conv(KP p, const Ctx& c, int layer) {
    const bf16_t* U = (const bf16_t*)(p->ws + WS_U); const bf16_t* GT = (const bf16_t*)(p->ws + WS_GT); bf16_t* HH = (bf16_t*)(p->ws + WS_HH);
    const float* cw = p->in[I_CONVW] + (size_t)layer * 3 * DFF; const float* cb = p->in[I_CONVB] + (size_t)layer * DFF; const float* st = p->in[I_SCONV] + (size_t)layer * SB * 2 * DFF;
    constexpr int NF8 = DFF / 8;
    for (int e = c.gtid; e < R * NF8; e += c.gsz) { const int row = e / NF8, f = 8 * (e % NF8);
        int t, b; if (row < MP) { t = row & (TP - 1); b = -1; } else { t = (row - MP) & 3; b = (row - MP) >> 2; }
        float u0[8], u1[8], u2[8], g[8], w0[8], w1[8], w2[8], bb[8];
        ld8bf(U + (size_t)row * DFF + f, u2); ld8bf(GT + (size_t)row * DFF + f, g);
        if (t >= 1) ld8bf(U + (size_t)(row - 1) * DFF + f, u1); else if (b >= 0) ld8f(st + ((size_t)b * 2 + 1) * DFF + f, u1); else {
#pragma unroll
            for (int i = 0; i < 8; ++i) u1[i] = 0.f; }
        if (t >= 2) ld8bf(U + (size_t)(row - 2) * DFF + f, u0); else if (b >= 0) ld8f(st + ((size_t)b * 2 + t) * DFF + f, u0); else {
#pragma unroll
            for (int i = 0; i < 8; ++i) u0[i] = 0.f; }
        ld8f(cw + f, w0); ld8f(cw + DFF + f, w1); ld8f(cw + 2 * DFF + f, w2); ld8f(cb + f, bb);
        float o[8];
#pragma unroll
        for (int i = 0; i < 8; ++i) o[i] = gelu_tanh(bb[i] + w0[i] * u0[i] + w1[i] * u1[i] + w2[i] * u2[i]) * g[i];
        u32x4 w; w.x = pk2(o[0], o[1]); w.y = pk2(o[2], o[3]); w.z = pk2(o[4], o[5]); w.w = pk2(o[6], o[7]);
        *(u32x4*)(HH + (size_t)row * DFF + f) = w; }
}

__device__ __forceinline__ void phase_kvpost(KP p, const Ctx& c) {
    const float* KVF = (const float*)(p->ws + WS_KVF); unsigned char* ws = p->ws; const int lane = c.lane, g = lane >> 4, d0 = 4 * (lane & 15);
    const f32x4 gs = *(const f32x4*)(p->in[I_KNG] + 64 + d0), gw = *(const f32x4*)(p->in[I_KNG] + 128 + d0);
    bf16_t* CA = (bf16_t*)(ws + WS_CMPA); bf16_t* KS = (bf16_t*)(ws + WS_KS); bf16_t* VS = (bf16_t*)(ws + WS_VS); bf16_t* KW = (bf16_t*)(ws + WS_KW); bf16_t* VW = (bf16_t*)(ws + WS_VW);
    for (int chunk = c.gw; chunk < R / 8; chunk += c.ngw) {
        unsigned vs_[4][4], vw_[4][4];
#pragma unroll
        for (int e = 0; e < 8; ++e) { const int row = chunk * 8 + e; const float* src = KVF + (size_t)row * NKV + 4 * lane;
            f32x4 v[6];
#pragma unroll
            for (int pt = 0; pt < 6; ++pt) v[pt] = *(const f32x4*)(src + pt * 256);
            { float s = (v[2][0] * v[2][0] + v[2][1] * v[2][1]) + (v[2][2] * v[2][2] + v[2][3] * v[2][3]);
              s = row16_sum(s); const float rs = frsq(s * (1.0f / 64.0f) + NORM_EPS); v[2] = v[2] * rs * gs; }
            { float s = (v[4][0] * v[4][0] + v[4][1] * v[4][1]) + (v[4][2] * v[4][2] + v[4][3] * v[4][3]);
              s = row16_sum(s); const float rs = frsq(s * (1.0f / 64.0f) + NORM_EPS); v[4] = v[4] * rs * gw; }
            float* okv = p->out + O_KV + (size_t)row * D + 4 * lane;
#pragma unroll
            for (int pt = 0; pt < 4; ++pt) *(f32x4*)(okv + pt * 256) = v[pt];
            if (row < MP) { const int b = row >> 13, t = row & (TP - 1);
                if (t >= TP - WIN) { float* ow = p->out + O_WINP + ((size_t)(b * WIN + (t - (TP - WIN))) * 2) * 256 + 4 * lane; *(f32x4*)ow = v[4]; *(f32x4*)(ow + 256) = v[5]; }
                const size_t hb = (size_t)(b * G + g);
                { u32x2 w; w.x = pk2(v[0][0], v[0][1]); w.y = pk2(v[0][2], v[0][3]); *(u32x2*)(CA + (hb * 512 + (t >> 4)) * 1024 + (t & 15) * 64 + d0) = w; }
                { u32x2 w; w.x = pk2(v[1][0], v[1][1]); w.y = pk2(v[1][2], v[1][3]); *(u32x2*)(CA + ((size_t)4096 + hb * 512 + (t >> 4)) * 1024 + (t & 15) * 64 + d0) = w; }
                { u32x2 w; w.x = pk2(v[2][0], v[2][1]); w.y = pk2(v[2][2], v[2][3]); *(u32x2*)(KS + (hb * TP + t) * 64 + d0) = w; }
                { u32x2 w; w.x = pk2(v[4][0], v[4][1]); w.y = pk2(v[4][2], v[4][3]); *(u32x2*)(KW + (hb * TP + t) * 64 + d0) = w; }
#pragma unroll
                for (int d = 0; d < 4; ++d) { const unsigned a = f2bf(v[3][d]), bq = f2bf(v[5][d]);
                    if (e & 1) { vs_[d][e >> 1] |= a << 16; vw_[d][e >> 1] |= bq << 16; } else { vs_[d][e >> 1] = a; vw_[d][e >> 1] = bq; } }
            } else { const int b = (row - MP) >> 2, t = (row - MP) & 3;
                float* ow = p->out + O_WINS + ((size_t)(b * WIN + 508 + t) * 2) * 256 + 4 * lane; *(f32x4*)ow = v[4]; *(f32x4*)(ow + 256) = v[5]; }
        }
        if (chunk * 8 < MP) { const int row = chunk * 8, b = row >> 13, t = row & (TP - 1); const size_t hb = (size_t)(b * G + g);
#pragma unroll
            for (int d = 0; d < 4; ++d) { *(u32x4*)(VS + (hb * 64 + d0 + d) * TP + t) = (u32x4){vs_[d][0], vs_[d][1], vs_[d][2], vs_[d][3]};
                *(u32x4*)(VW + (hb * 64 + d0 + d) * TP + t) = (u32x4){vw_[d][0], vw_[d][1], vw_[d][2], vw_[d][3]}; } }
    }
}

__device__ __forceinline__ void phase_cmp2(KP p, const Ctx& c) {
    unsigned char* ws = p->ws; const float* PC = (const float*)(ws + WS_PCMP); const int lane = c.lane, fr = lane & 15, fq = lane >> 4;
    const bf16_t* W2H = (const bf16_t*)(ws + WS_CW2T); const bf16_t* W2L = W2H + 2 * 64 * 128;
    constexpr int NPI = NB * G * 32, NSI = SB * G * 8, TOT = 2 * (NPI + NSI);
    for (int it = c.gw; it < TOT; it += c.ngw) {
        const bool samp = it >= 2 * NPI; const int r = samp ? it - 2 * NPI : it; const int kv = samp ? r / NSI : r / NPI; const int idx = samp ? r % NSI : r % NPI;
        const int hb = samp ? (idx >> 3) : (idx >> 5), n0 = 16 * (samp ? (idx & 7) : (idx & 31)), ncmp = samp ? NCMP_S : NCMP_P, nper = samp ? 128 : 512;
        const int n = n0 + fr; const bool live = n < ncmp;
        const size_t prow = (samp ? (size_t)8192 + (size_t)kv * 65536 : (size_t)kv * 4096) + (size_t)hb * nper + (live ? n : ncmp - 1);
        const float* cb = (const float*)(ws + WS_CBIAS) + kv * 128;
        bf16x8 hh[4], hl[4];
#pragma unroll
        for (int ks = 0; ks < 4; ++ks) { const int k0 = 32 * ks + 8 * fq; unsigned uh[8], ul[8];
            const f32x4 a0 = *(const f32x4*)(PC + prow * 256 + k0), a1 = *(const f32x4*)(PC + prow * 256 + k0 + 4);
            const f32x4 b0 = *(const f32x4*)(PC + (prow + 1) * 256 + 128 + k0), b1 = *(const f32x4*)(PC + (prow + 1) * 256 + 128 + k0 + 4);
            const f32x4 c0 = *(const f32x4*)(cb + k0), c1 = *(const f32x4*)(cb + k0 + 4);
#pragma unroll
            for (int e = 0; e < 8; ++e) { const float x = e < 4 ? a0[e] + b0[e] + c0[e] : a1[e - 4] + b1[e - 4] + c1[e - 4]; const float hv = gelu_tanh(x);
                uh[e] = f2bf(hv); ul[e] = f2bf(hv - __builtin_bit_cast(float, uh[e] << 16)); }
            const u32x4 wh = {uh[0] | (uh[1] << 16), uh[2] | (uh[3] << 16), uh[4] | (uh[5] << 16), uh[6] | (uh[7] << 16)}, wl = {ul[0] | (ul[1] << 16), ul[2] | (ul[3] << 16), ul[4] | (ul[5] << 16), ul[6] | (ul[7] << 16)};
            hh[ks] = __builtin_bit_cast(bf16x8, wh); hl[ks] = __builtin_bit_cast(bf16x8, wl); }
        f32x4 acc[4];
#pragma unroll
        for (int dt = 0; dt < 4; ++dt) { acc[dt] = *(const f32x4*)(p->in[I_CB2] + kv * 64 + 16 * dt + 4 * fq);
#pragma unroll
            for (int ks = 0; ks < 4; ++ks) { const size_t wo = (size_t)(kv * 64 + 16 * dt + fr) * 128 + 32 * ks + 8 * fq; const bf16x8 wh = *(const bf16x8*)(W2H + wo), wl = *(const bf16x8*)(W2L + wo);
                acc[dt] = mfma16(wh, hh[ks], acc[dt]); acc[dt] = mfma16(wh, hl[ks], acc[dt]); acc[dt] = mfma16(wl, hh[ks], acc[dt]); } }
        if (kv == 0) { float ss = 0.f;
#pragma unroll
            for (int dt = 0; dt < 4; ++dt) ss += (acc[dt][0] * acc[dt][0] + acc[dt][1] * acc[dt][1]) + (acc[dt][2] * acc[dt][2] + acc[dt][3] * acc[dt][3]);
            ss = sum_rows4(ss); const float rs = frsq(ss * (1.0f / 64.0f) + NORM_EPS);
#pragma unroll
            for (int dt = 0; dt < 4; ++dt) acc[dt] = acc[dt] * rs * *(const f32x4*)(p->in[I_KNG] + 16 * dt + 4 * fq); }
#pragma unroll
        for (int dt = 0; dt < 4; ++dt) { const f32x4 o = live ? acc[dt] : (f32x4){0.f, 0.f, 0.f, 0.f}; const int d = 16 * dt + 4 * fq;
            if (samp) *(f32x4*)((float*)(ws + (kv ? WS_CVS : WS_CKS)) + ((size_t)hb * 128 + n) * 64 + d) = o;
            else if (kv == 0) { u32x2 w; w.x = pk2(o[0], o[1]); w.y = pk2(o[2], o[3]); *(u32x2*)((bf16_t*)(ws + WS_CK) + ((size_t)hb * 512 + n) * 64 + d) = w; }
            else {
#pragma unroll
                for (int e = 0; e < 4; ++e) ((bf16_t*)(ws + WS_CV))[((size_t)hb * 64 + d + e) * 512 + n] = (bf16_t)f2bf(o[e]); } }
    }
}

__device__ __forceinline__ void phase_qpost(KP p, const Ctx& c, int lb) {
    const float* QF = (const float*)(p->ws + WS_QF); bf16_t* Q = (bf16_t*)(p->ws + WS_Q); const int lane = c.lane;
    const f32x4 gq = *(const f32x4*)(p->in[I_QNG] + lb * 64 + 4 * (lane & 15));
    for (int row = c.gw; row < R; row += c.ngw) { const float* src = QF + (size_t)row * NQP;
        f32x4 v[4]; load_row(src, lane, v);
#pragma unroll
        for (int j = 0; j < 4; ++j) { float s = (v[j][0] * v[j][0] + v[j][1] * v[j][1]) + (v[j][2] * v[j][2] + v[j][3] * v[j][3]);
            s = row16_sum(s);
            const float rs = (frsq(s * (1.0f / 64.0f) + NORM_EPS)) * (0.125f * 1.4426950408889634f); v[j] = v[j] * rs * gq; }
        store_row_bf16(Q + (size_t)row * D, lane, v);
    }
}
constexpr int AT_K0 = 0, AT_V0 = 9216, AT_K1 = 18432, AT_V1 = 27648, AT_IMP = 36864, IMPS = 132, AT_SELM = AT_IMP + 64 * IMPS * 4, AT_ANY = AT_SELM + 1024;
static_assert(AT_ANY + 16 <= RING_BYTES, "attention LDS map");
struct TileSrc { const bf16_t* K; const bf16_t* VT; int vts; };
__device__ __forceinline__ void tile_load(const TileSrc& s, int key0, int tid, u32x4& rk, u32x4& rv) {
    const int row = tid >> 3, ch = tid & 7;
    rk = *(const u32x4*)(s.K + (size_t)(key0 + row) * 64 + 8 * ch); rv = *(const u32x4*)(s.VT + (size_t)row * s.vts + key0 + 8 * ch);
}
__device__ __forceinline__ void tile_load_async(const TileSrc& s, int key0, int tid, u32x4& rk, u32x4& rv) {
    const int row = tid >> 3, ch = tid & 7;
    const bf16_t* pk = s.K + (size_t)(key0 + row) * 64 + 8 * ch; const bf16_t* pv = s.VT + (size_t)row * s.vts + key0 + 8 * ch;
    asm volatile("global_load_dwordx4 %0, %2, off\n\tglobal_load_dwordx4 %1, %3, off" : "=&v"(rk), "=&v"(rv) : "v"(pk), "v"(pv) : "memory");
}
#define TILE_WAIT(N_, RK_, RV_) asm volatile("s_waitcnt vmcnt(" #N_ ")" : "+v"(RK_), "+v"(RV_) :: "memory")
__device__ __forceinline__ void tile_store(LAS unsigned char* lds, int buf, int tid, const u32x4& rk, const u32x4& rv) {
    const int row = tid >> 3, ch = tid & 7;
    *(LAS u32x4*)(lds + (buf ? AT_K1 : AT_K0) + (row * SST + 8 * ch) * 2) = rk; *(LAS u32x4*)(lds + (buf ? AT_V1 : AT_V0) + (row * SST + 8 * ch) * 2) = rv;
}
__device__ __forceinline__ int first_bit4(unsigned a, unsigned b, unsigned c, unsigned d) { return a ? __ffs(a) - 1 : (b ? 32 + __ffs(b) - 1 : (c ? 64 + __ffs(c) - 1 : (d ? 96 + __ffs(d) - 1 : -1))); }
__device__ __forceinline__ float ex2(float x) { return __builtin_amdgcn_exp2f(x); }

__device__ __forceinline__ void set_bit4(int s, unsigned& t0, unsigned& t1, unsigned& t2, unsigned& t3) { const unsigned bit = 1u << (s & 31); const int w = s >> 5; t0 |= (w == 0) ? bit : 0u; t1 |= (w == 1) ? bit : 0u; t2 |= (w == 2) ? bit : 0u; t3 |= (w == 3) ? bit : 0u; }
__device__ __forceinline__ void clr_bit4(int s, unsigned& t0, unsigned& t1, unsigned& t2, unsigned& t3) { const unsigned bit = 1u << (s & 31); const int w = s >> 5; t0 &= ~((w == 0) ? bit : 0u); t1 &= ~((w == 1) ? bit : 0u); t2 &= ~((w == 2) ? bit : 0u); t3 &= ~((w == 3) ? bit : 0u); }
__device__ __forceinline__ unsigned get_word4(int s, unsigned a, unsigned b, unsigned c, unsigned d) { const int w = s >> 5; return ((w == 0) ? a : 0u) | ((w == 1) ? b : 0u) | ((w == 2) ? c : 0u) | ((w == 3) ? d : 0u); }
__device__ __forceinline__ float dpp_xor1(float x) { return __builtin_bit_cast(float, __builtin_amdgcn_update_dpp(0, __builtin_bit_cast(int, x), 0xB1, 0xF, 0xF, true)); }
__device__ __forceinline__ float dpp_xor2(float x) { return __builtin_bit_cast(float, __builtin_amdgcn_update_dpp(0, __builtin_bit_cast(int, x), 0x4E, 0xF, 0xF, true)); }
template <int MODE, bool EDGE> __device__ __forceinline__ void attn_tile(LAS unsigned char* lds, int buf, const bf16x8 (&qf)[4], int key0, int qpos, int r, int hf,
                                                                          float& l, f32x16 (&O)[2], float invl, bool selbit, LAS float* impq) {
    if (MODE == 3) { if (__ballot(selbit) == 0ull) { asm volatile("" : "+v"(O[0]), "+v"(O[1]), "+v"(l)); return; } }
    const float sbias = selbit ? 0.f : -1.0e30f;
    const int oK = buf ? AT_K1 : AT_K0, oV = buf ? AT_V1 : AT_V0;
#pragma unroll
    for (int kt = 0; kt < 2; ++kt) {
        f32x16 S;
#pragma unroll
        for (int i = 0; i < 16; ++i) S[i] = (MODE == 3) ? sbias : 0.f;
#pragma unroll
        for (int ks = 0; ks < 4; ++ks) S = mfma32(*(const LAS bf16x8*)(lds + oK + ((32 * kt + r) * SST + 16 * ks + 8 * hf) * 2), qf[ks], S);
        float ls = 0.f;
#pragma unroll
        for (int i = 0; i < 16; ++i) { float pv = ex2(S[i]);
            if (EDGE) { const int key = key0 + 32 * kt + (i & 3) + 8 * (i >> 2) + 4 * hf; bool v;
                if (MODE <= 1) v = (16 * key + 31 <= qpos); else if (MODE == 2) v = (key <= qpos) && (key + WIN > qpos); else v = (key <= qpos);
                pv = v ? pv : 0.f; }
            if (MODE == 1) pv *= invl;
            S[i] = pv; ls += pv; }
        if (MODE != 1) l += ls;
        if (MODE >= 1) {
#pragma unroll
            for (int sp = 0; sp < 2; ++sp) {
                u32x4 pw; pw.x = pg8::cvt_pk_bf16(S[8 * sp + 0], S[8 * sp + 1]); pw.y = pg8::cvt_pk_bf16(S[8 * sp + 2], S[8 * sp + 3]); pw.z = pg8::cvt_pk_bf16(S[8 * sp + 4], S[8 * sp + 5]); pw.w = pg8::cvt_pk_bf16(S[8 * sp + 6], S[8 * sp + 7]);
                const bf16x8 pf = __builtin_bit_cast(bf16x8, pw);
#pragma unroll
                for (int dt = 0; dt < 2; ++dt) { const int d = 32 * dt + r, kb = 32 * kt + 16 * sp + 4 * hf;
                    const u32x2 lo = *(const LAS u32x2*)(lds + oV + (d * SST + kb) * 2), hi = *(const LAS u32x2*)(lds + oV + (d * SST + kb + 8) * 2);
                    const u32x4 vw = {lo.x, lo.y, hi.x, hi.y};
                    O[dt] = mfma32(__builtin_bit_cast(bf16x8, vw), pf, O[dt]); } }
        }
        if (MODE == 1) {
            float own[4], nxt[4];
#pragma unroll
            for (int gq = 0; gq < 4; ++gq) { const float p3 = S[4 * gq + 3]; float o = 2.0f * (S[4 * gq] + S[4 * gq + 1] + S[4 * gq + 2]) + p3, n = p3;
                o += dpp_xor1(o); o += dpp_xor2(o); n += dpp_xor1(n); n += dpp_xor2(n); own[gq] = o; nxt[gq] = n; }
            const int sbb = (key0 >> 2) + 8 * kt + hf;
            if ((r & 3) == 0) {
#pragma unroll
                for (int gq = 0; gq < 4; ++gq) impq[sbb + 2 * gq] += own[gq]; }
            asm volatile("s_waitcnt lgkmcnt(0)" ::: "memory");
            if ((r & 3) == 0) {
#pragma unroll
                for (int gq = 0; gq < 4; ++gq) impq[sbb + 2 * gq + 1] += nxt[gq]; }
            asm volatile("s_waitcnt lgkmcnt(0)" ::: "memory");
        }
    }
}

template <int MODE> __device__ __forceinline__ void run_tiles(LAS unsigned char* lds, const TileSrc& src, unsigned t0, unsigned t1, unsigned t2, unsigned t3, int qt,
                                                              const bf16x8 (&qf)[4], int qpos, int r, int hf, int tid,
                                                              float& l, f32x16 (&O)[2], float invl, unsigned s0, unsigned s1, unsigned s2, unsigned s3, LAS float* impq, const int alias = 0) {
#define TSEL(n_) ((alias ? ((n_) & 7) : (n_)) * 64)
    tid = launder_v(tid); r = tid & 31; hf = (tid >> 5) & 1;
    int cur = first_bit4(t0, t1, t2, t3); if (cur < 0) return;
    const int first = cur;
    clr_bit4(cur, t0, t1, t2, t3); int n1 = first_bit4(t0, t1, t2, t3); if (n1 >= 0) clr_bit4(n1, t0, t1, t2, t3);
    int n2 = first_bit4(t0, t1, t2, t3); if (n2 >= 0) clr_bit4(n2, t0, t1, t2, t3);
    int n3 = first_bit4(t0, t1, t2, t3); if (n3 >= 0) clr_bit4(n3, t0, t1, t2, t3);
    u32x4 rkA, rvA, rkB, rvB, rkC, rvC; { u32x4 rk, rv; tile_load(src, TSEL(cur), tid, rk, rv); int b0 = 0; tile_store(lds, b0, tid, rk, rv); }
    tile_load_async(src, TSEL(n1 >= 0 ? n1 : first), tid, rkA, rvA);
    tile_load_async(src, TSEL(n2 >= 0 ? n2 : first), tid, rkB, rvB);
    tile_load_async(src, TSEL(n3 >= 0 ? n3 : first), tid, rkC, rvC);
    int buf = 0;
    __syncthreads();
#define RT_STEP(RK_, RV_) { \
        if (cur >= 0) { \
            const unsigned sw = get_word4(cur, s0, s1, s2, s3); \
            const bool sb = ((sw >> (cur & 31)) & 1u) != 0u; \
            if (MODE <= 1) attn_tile<MODE, true>(lds, buf, qf, cur * 64, qpos, r, hf, l, O, invl, sb, impq); \
            else { const bool edge = (cur == qt) || (MODE == 2 && cur == qt - 8); \
                if (edge) attn_tile<MODE, true>(lds, buf, qf, cur * 64, qpos, r, hf, l, O, invl, sb, impq); \
                else attn_tile<MODE, false>(lds, buf, qf, cur * 64, qpos, r, hf, l, O, invl, sb, impq); } } \
        TILE_WAIT(4, RK_, RV_); \
        tile_store(lds, buf ^ 1, tid, RK_, RV_); \
        __syncthreads(); \
        const int n4 = first_bit4(t0, t1, t2, t3); if (n4 >= 0) clr_bit4(n4, t0, t1, t2, t3); \
        tile_load_async(src, TSEL(n4 >= 0 ? n4 : first), tid, RK_, RV_); \
        buf ^= 1; cur = n1; n1 = n2; n2 = n3; n3 = n4; }
    do {
        RT_STEP(rkA, rvA)
        RT_STEP(rkB, rvB)
        RT_STEP(rkC, rvC)
    } while (cur >= 0);
#undef RT_STEP
    asm volatile("s_waitcnt vmcnt(0)" : "+v"(rkA), "+v"(rvA), "+v"(rkB), "+v"(rvB), "+v"(rkC), "+v"(rvC) :: "memory");
    __syncthreads();
}
__device__ __forceinline__ void attn_prompt_unit(KP p, const Ctx& c, int k, const int stop) {
    LAS unsigned char* lds = c.lds; unsigned char* ws = p->ws; int tid_m; asm volatile("v_mbcnt_lo_u32_b32 %0, -1, 0\n\tv_mbcnt_hi_u32_b32 %0, -1, %0" : "=v"(tid_m));
    const int wave = c.wave, tid = tid_m + 64 * wave, lane = tid & 63, r = lane & 31, hf = lane >> 5;
    const int qt = 127 - (k >> 3), hb = k & 7, b = hb >> 2, g = hb & 3, q0 = 64 * qt;
    const int qi = 8 * wave + (r >> 2), head = 4 * g + (r & 3), qpos = q0 + qi, row = b * TP + qpos;
    const bf16_t* Q = (const bf16_t*)(ws + WS_Q);
    bf16x8 qf[4];
#pragma unroll
    for (int ks = 0; ks < 4; ++ks) qf[ks] = *(const bf16x8*)(Q + (size_t)row * D + head * 64 + 16 * ks + 8 * hf);
    const float* gate = (const float*)(ws + WS_GATE) + (size_t)row * 48 + head * 3; const float g_c = gate[0], g_s = gate[1], g_w = gate[2];
    LAS float* imp = (LAS float*)(lds + AT_IMP); LAS unsigned* selm = (LAS unsigned*)(lds + AT_SELM); LAS unsigned* anym = (LAS unsigned*)(lds + AT_ANY);
    for (int e = tid; e < 64 * IMPS; e += 512) imp[e] = 0.f;
    if (tid < 4) anym[tid] = 0u;
    __syncthreads();
    f32x16 O[2]; unsigned OUTP[2][8];
#pragma unroll
    for (int dt = 0; dt < 2; ++dt)
#pragma unroll
        for (int i = 0; i < 16; ++i) O[dt][i] = 0.f;
    {
        const TileSrc src{(const bf16_t*)(ws + WS_CK) + (size_t)hb * 512 * 64, (const bf16_t*)(ws + WS_CV) + (size_t)hb * 64 * 512, 512};
        const int nmax = q0 + 63 - 31; const int ntc = nmax >= 0 ? (nmax >> 10) + 1 : 0;
        const unsigned tm = ntc >= 32 ? 0xffffffffu : ((1u << ntc) - 1u);
        float l = 0.f;
        run_tiles<0>(lds, src, tm, 0u, 0u, 0u, qt, qf, qpos, r, hf, tid, l, O, 0.f, 0u, 0u, 0u, 0u, imp);
        l = sum_xor32(l); const float invl = l > 0.f ? 1.0f / l : 0.f;
        run_tiles<1>(lds, src, tm, 0u, 0u, 0u, qt, qf, qpos, r, hf, tid, l, O, invl, 0u, 0u, 0u, 0u, imp + qi * IMPS);
#pragma unroll
        for (int dt = 0; dt < 2; ++dt) {
#pragma unroll
            for (int i = 0; i < 8; ++i) { OUTP[dt][i] = pg8::cvt_pk_bf16(O[dt][2 * i] * g_c, O[dt][2 * i + 1] * g_c); asm volatile("" : "+v"(OUTP[dt][i])); }
#pragma unroll
            for (int i = 0; i < 16; ++i) O[dt][i] = 0.f; }
    }
    __syncthreads();
    if (stop == 1) return;
    {
        unsigned k0[8], k1[8], T[8]; int Kq[8];
#pragma unroll
        for (int e = 0; e < 8; ++e) { const int qq = 8 * wave + e, qp = q0 + qq, qb = qp >> 6;
            const bool c0 = (64 * lane <= qp), c1 = (64 * (lane + 64) <= qp);
            const unsigned a0_ = (lane == 0 || lane == qb || lane == qb - 1) ? 0xffffffffu : __builtin_bit_cast(unsigned, imp[qq * IMPS + lane]);
            const unsigned a1_ = (lane + 64 == qb || lane + 64 == qb - 1) ? 0xffffffffu : __builtin_bit_cast(unsigned, imp[qq * IMPS + lane + 64]);
            k0[e] = c0 ? a0_ : 0u; k1[e] = c1 ? a1_ : 0u;
            Kq[e] = qb + 1 < 16 ? qb + 1 : 16; T[e] = 0u; }
        for (int bit = 31; bit >= 0; --bit) {
#pragma unroll
            for (int e = 0; e < 8; ++e) { const unsigned cand = T[e] | (1u << bit);
                const int cnt = __popcll(__ballot(k0[e] >= cand)) + __popcll(__ballot(k1[e] >= cand)); if (cnt >= Kq[e]) T[e] = cand; } }
#pragma unroll
        for (int e = 0; e < 8; ++e) { const int qq = 8 * wave + e, qp = q0 + qq;
            const bool c0 = (64 * lane <= qp), c1 = (64 * (lane + 64) <= qp);
            unsigned long long mlo = __ballot(k0[e] > T[e]), mhi = __ballot(k1[e] > T[e]), elo = __ballot(c0 && k0[e] == T[e]), ehi = __ballot(c1 && k1[e] == T[e]);
            int need = Kq[e] - (__popcll(mlo) + __popcll(mhi));
            for (; need > 0; --need) { if (elo) { mlo |= elo & (~elo + 1ull); elo &= elo - 1ull; } else { mhi |= ehi & (~ehi + 1ull); ehi &= ehi - 1ull; } }
            const unsigned m0 = (unsigned)mlo, m1 = (unsigned)(mlo >> 32), m2 = (unsigned)mhi, m3 = (unsigned)(mhi >> 32);
            if (lane == 0) { selm[qq * 4 + 0] = m0; selm[qq * 4 + 1] = m1; selm[qq * 4 + 2] = m2; selm[qq * 4 + 3] = m3;
                atomicOr((unsigned*)&anym[0], m0); atomicOr((unsigned*)&anym[1], m1); atomicOr((unsigned*)&anym[2], m2); atomicOr((unsigned*)&anym[3], m3); } }
    }
    __syncthreads();
    if (stop == 2) return;
    {
        const TileSrc src{(const bf16_t*)(ws + WS_KW) + (size_t)hb * TP * 64, (const bf16_t*)(ws + WS_VW) + (size_t)hb * 64 * TP, TP};
        const int tlo = qt >= 8 ? qt - 8 : 0; unsigned t0 = 0u, t1 = 0u, t2 = 0u, t3 = 0u;
        for (int s = tlo; s <= qt; ++s) set_bit4(s, t0, t1, t2, t3);
        float l = 0.f;
        run_tiles<2>(lds, src, t0, t1, t2, t3, qt, qf, qpos, r, hf, tid, l, O, 0.f, 0u, 0u, 0u, 0u, imp);
        l = sum_xor32(l); const float sc = l > 0.f ? g_w / l : 0.f;
#pragma unroll
        for (int dt = 0; dt < 2; ++dt) {
#pragma unroll
            for (int i = 0; i < 8; ++i) { OUTP[dt][i] = pg8::cvt_pk_bf16(bflo(OUTP[dt][i]) + O[dt][2 * i] * sc, bfhi(OUTP[dt][i]) + O[dt][2 * i + 1] * sc); asm volatile("" : "+v"(OUTP[dt][i])); }
#pragma unroll
            for (int i = 0; i < 16; ++i) O[dt][i] = 0.f; }
    }
    if (stop == 3) { __syncthreads(); return; }
    {
        const TileSrc src{(const bf16_t*)(ws + WS_KS) + (size_t)hb * TP * 64, (const bf16_t*)(ws + WS_VS) + (size_t)hb * 64 * TP, TP};
        const unsigned sz_ = (stop == 5) ? 0u : 0xffffffffu;
        const unsigned s0 = selm[qi * 4 + 0] & sz_, s1 = selm[qi * 4 + 1] & sz_, s2 = selm[qi * 4 + 2] & sz_, s3 = selm[qi * 4 + 3] & sz_;
        const unsigned a0 = __builtin_amdgcn_readfirstlane(anym[0]), a1 = __builtin_amdgcn_readfirstlane(anym[1]), a2 = __builtin_amdgcn_readfirstlane(anym[2]), a3 = __builtin_amdgcn_readfirstlane(anym[3]);
        float l = 0.f;
        run_tiles<3>(lds, src, a0, a1, a2, a3, qt, qf, qpos, r, hf, tid, l, O, 0.f, s0, s1, s2, s3, imp, stop == 4 ? 1 : 0);
        if (stop >= 4) { if (l == 12345.678f) ((float*)(ws + WS_GATE))[0] = O[0][0] + O[1][0]; __syncthreads(); return; }
        l = sum_xor32(l); const float sc = l > 0.f ? g_s / l : 0.f;
#pragma unroll
        for (int dt = 0; dt < 2; ++dt)
#pragma unroll
            for (int i = 0; i < 8; ++i) OUTP[dt][i] = pg8::cvt_pk_bf16(bflo(OUTP[dt][i]) + O[dt][2 * i] * sc, bfhi(OUTP[dt][i]) + O[dt][2 * i + 1] * sc);
    }
    bf16_t* AO = (bf16_t*)(ws + WS_YG) + (size_t)row * D + head * 64;
#pragma unroll
    for (int dt = 0; dt < 2; ++dt)
#pragma unroll
        for (int gq = 0; gq < 4; ++gq) { u32x2 w; w.x = OUTP[dt][2 * gq]; w.y = OUTP[dt][2 * gq + 1]; *(u32x2*)(AO + 32 * dt + 8 * gq + 4 * hf) = w; }
    __syncthreads();
}

constexpr int SA_RED = 0, SA_REDW = 2 * 16 * 65 * 4, SA_OC = SA_RED + SA_REDW, SA_EC = SA_OC + 2 * 4096, SA_LC = SA_EC + 2 * 4096, SA_PN = SA_LC + 256, SA_SEL = SA_PN + 4 * 512;
static_assert(SA_SEL + 64 <= RING_BYTES, "sample attention LDS map");
__device__ __forceinline__ bf16x8 pack8(const f32x4 a, const f32x4 b) { const u32x4 w = {pk2(a[0], a[1]), pk2(a[2], a[3]), pk2(b[0], b[1]), pk2(b[2], b[3])}; return __builtin_bit_cast(bf16x8, w); }
__device__ __forceinline__ void sa_qk(const float* kb, size_t stride, int nrows, const bf16x8 (&qf)[2], int fr, int fq, f32x4 (&S)[4]) {
    f32x4 kr[4][2][2];
#pragma unroll
    for (int kg = 0; kg < 4; ++kg) { const int key = 16 * kg + fr; const float* rp = kb + (size_t)(key < nrows ? key : nrows - 1) * stride + 8 * fq;
#pragma unroll
        for (int ks = 0; ks < 2; ++ks) { kr[kg][ks][0] = *(const f32x4*)(rp + 32 * ks); kr[kg][ks][1] = *(const f32x4*)(rp + 32 * ks + 4); } }
#pragma unroll
    for (int kg = 0; kg < 4; ++kg) { S[kg] = (f32x4){0.f, 0.f, 0.f, 0.f};
#pragma unroll
        for (int ks = 0; ks < 2; ++ks) S[kg] = mfma16(pack8(kr[kg][ks][0], kr[kg][ks][1]), qf[ks], S[kg]); }
}
__device__ __forceinline__ void sa_pv(const float* vb, size_t stride, int nrows, const f32x4 (&P)[4], int fr, int fq, f32x4 (&O)[4]) {
#pragma unroll
    for (int ks = 0; ks < 2; ++ks) { const bf16x8 pa = pack8(P[2 * ks], P[2 * ks + 1]);
        float vv[4][8];
#pragma unroll
        for (int j = 0; j < 8; ++j) { const int key = 16 * (2 * ks + (j >> 2)) + 4 * fq + (j & 3); const float* rp = vb + (size_t)(key < nrows ? key : nrows - 1) * stride + fr;
#pragma unroll
            for (int dt = 0; dt < 4; ++dt) vv[dt][j] = rp[16 * dt]; }
#pragma unroll
        for (int dt = 0; dt < 4; ++dt) { const u32x4 w = {pk2(vv[dt][0], vv[dt][1]), pk2(vv[dt][2], vv[dt][3]), pk2(vv[dt][4], vv[dt][5]), pk2(vv[dt][6], vv[dt][7])};
            O[dt] = mfma16(pa, __builtin_bit_cast(bf16x8, w), O[dt]); } }
}
__device__ __forceinline__ void attn_sample_unit(KP p, const Ctx& c, int item) {
    unsigned char* ws = p->ws; LAS unsigned char* lds = c.lds; const int tid = launder_v(c.tid), lane = tid & 63, wave = c.wave, fr = lane & 15, fq = lane >> 4; const int b = item >> 2, g = item & 3;
    bf16x8 qf[2];
    { const bf16_t* Q = (const bf16_t*)(ws + WS_Q) + (size_t)(MP + 4 * b + (fr >> 2)) * D + (4 * g + (fr & 3)) * 64 + 8 * fq;
      qf[0] = *(const bf16x8*)Q; qf[1] = *(const bf16x8*)(Q + 32); }
    const int tokm = fr >> 2;
    if (wave < 2) {
        const float* ck = (const float*)(ws + WS_CKS) + ((size_t)(b * 4 + g) * 128 + 64 * wave) * 64; const float* cv = (const float*)(ws + WS_CVS) + ((size_t)(b * 4 + g) * 128 + 64 * wave) * 64;
        const int nrows = wave ? 63 : 64;
        f32x4 S[4]; sa_qk(ck, 64, nrows, qf, fr, fq, S);
        float ls = 0.f;
#pragma unroll
        for (int kg = 0; kg < 4; ++kg)
#pragma unroll
            for (int r = 0; r < 4; ++r) { const int key = 16 * kg + 4 * fq + r; const float ev = key < nrows ? ex2(S[kg][r]) : 0.f; S[kg][r] = ev; ls += ev;
                *(LAS float*)(lds + SA_EC + wave * 4096 + (key * 16 + fr) * 4) = ev; }
        ls = sum_rows4(ls); if (fq == 0) *(LAS float*)(lds + SA_LC + (wave * 16 + fr) * 4) = ls;
        f32x4 oc[4];
#pragma unroll
        for (int dt = 0; dt < 4; ++dt) oc[dt] = (f32x4){0.f, 0.f, 0.f, 0.f};
        sa_pv(cv, 64, nrows, S, fr, fq, oc);
#pragma unroll
        for (int dt = 0; dt < 4; ++dt)
#pragma unroll
            for (int r = 0; r < 4; ++r) *(LAS float*)(lds + SA_OC + wave * 4096 + ((4 * fq + r) * 64 + 16 * dt + fr) * 4) = oc[dt][r];
    }
    __syncthreads();
    if (wave < 4) { const int tok = wave; float P0 = 0.f, P1 = 0.f;
#pragma unroll
        for (int hh = 0; hh < 4; ++hh) { const int pi = tok * 4 + hh; const float L = *(const LAS float*)(lds + SA_LC + pi * 4) + *(const LAS float*)(lds + SA_LC + (16 + pi) * 4); const float inv = L > 0.f ? 1.0f / L : 0.f;
            P0 += *(const LAS float*)(lds + SA_EC + (lane * 16 + pi) * 4) * inv; P1 += *(const LAS float*)(lds + SA_EC + 4096 + (lane * 16 + pi) * 4) * inv; }
        LAS float* pn = (LAS float*)(lds + SA_PN + tok * 512); pn[lane] = P0; pn[64 + lane] = P1; LDS_WAIT();
        float v0 = -1e9f;
        if (lane < 33) { const int s = lane; float im = 0.f;
            if (4 * s - 1 >= 0 && 4 * s - 1 < 128) im += pn[4 * s - 1];
#pragma unroll
            for (int j = 0; j < 3; ++j) if (4 * s + j < 128) im += 2.0f * pn[4 * s + j];
            if (4 * s + 3 < 128) im += pn[4 * s + 3];
            v0 = (s == 0 || s == 31 || s == 32) ? 1e9f : im; }
        unsigned selmask = 0u, sel32 = 0u;
        for (int it = 0; it < 16; ++it) { const float mx = wave_max(v0); if (mx < -5e8f) break; const unsigned long long b0 = __ballot(v0 == mx); const int s = __ffsll((long long)b0) - 1;
            if (lane == s) v0 = -2e9f; if (s < 32) selmask |= 1u << s; else sel32 = 1u; }
        if (lane == 0) { *(LAS unsigned*)(lds + SA_SEL + tok * 8) = selmask; *(LAS unsigned*)(lds + SA_SEL + tok * 8 + 4) = sel32; } }
    __syncthreads();
    unsigned sm[4], s32[4];
#pragma unroll
    for (int t = 0; t < 4; ++t) { sm[t] = *(const LAS unsigned*)(lds + SA_SEL + t * 8); s32[t] = *(const LAS unsigned*)(lds + SA_SEL + t * 8 + 4); }
    const unsigned un = sm[0] | sm[1] | sm[2] | sm[3]; const int nsel = __popc(un); const int has32 = (s32[0] | s32[1] | s32[2] | s32[3]) ? 1 : 0;
    const unsigned my_sm = tokm == 0 ? sm[0] : (tokm == 1 ? sm[1] : (tokm == 2 ? sm[2] : sm[3])), my_s32 = tokm == 0 ? s32[0] : (tokm == 1 ? s32[1] : (tokm == 2 ? s32[2] : s32[3]));
    const int ntile = nsel + has32 + 9;
    const int* pt = (const int*)p->in[I_PT] + b * NPAGES;
    f32x4 osel[4], owin[4]; float lsel = 0.f, lwin = 0.f;
#pragma unroll
    for (int dt = 0; dt < 4; ++dt) { osel[dt] = (f32x4){0.f, 0.f, 0.f, 0.f}; owin[dt] = (f32x4){0.f, 0.f, 0.f, 0.f}; }
    for (int ti = wave; ti < ntile; ti += 8) {
        const float* kb; size_t stride; int nrows = 64, br, mode, sidx = 0;
        if (ti < nsel) { unsigned m = un; for (int q = 0; q < ti; ++q) m &= m - 1u; sidx = __ffs(m) - 1; const int page = pt[sidx >> 1];
            kb = p->in[I_CKV] + ((size_t)page * PAGE + (sidx & 1) * 64) * 1024 + 2 * 256 + g * 64; stride = 1024; br = 0; mode = 0; }
        else if (ti < nsel + has32) { kb = p->out + O_KV + (size_t)(MP + 4 * b) * D + 2 * 256 + g * 64; stride = 1024; nrows = 4; br = 0; mode = 1; }
        else if (ti < nsel + has32 + 8) { sidx = ti - nsel - has32; kb = p->in[I_CWIN] + ((size_t)b * WIN + 64 * sidx) * 512 + g * 64; stride = 512; br = 1; mode = 2; }
        else { kb = p->out + O_WINS + ((size_t)(b * WIN + 508) * 2) * 256 + g * 64; stride = 512; nrows = 4; br = 1; mode = 3; }
        f32x4 S[4]; sa_qk(kb, stride, nrows, qf, fr, fq, S);
        float ls = 0.f;
#pragma unroll
        for (int kg = 0; kg < 4; ++kg)
#pragma unroll
            for (int r = 0; r < 4; ++r) { const int key = 16 * kg + 4 * fq + r; bool valid;
                if (mode == 0) valid = ((my_sm >> sidx) & 1u) != 0u; else if (mode == 1) valid = (my_s32 != 0u) && (key <= tokm); else if (mode == 2) valid = (64 * sidx + key) >= tokm + 1; else valid = key <= tokm;
                const float ev = valid ? ex2(S[kg][r]) : 0.f; S[kg][r] = ev; ls += ev; }
        if (br == 0) { lsel += ls; sa_pv(kb + 256, stride, nrows, S, fr, fq, osel); } else { lwin += ls; sa_pv(kb + 256, stride, nrows, S, fr, fq, owin); }
    }
    lsel = sum_rows4(lsel); lwin = sum_rows4(lwin);
    for (int w = 0; w < 8; ++w) {
        if (wave == w) {
#pragma unroll
            for (int dt = 0; dt < 4; ++dt)
#pragma unroll
                for (int r = 0; r < 4; ++r) { LAS float* r0 = (LAS float*)(lds + SA_RED + ((4 * fq + r) * 65 + 16 * dt + fr) * 4); LAS float* r1 = (LAS float*)(lds + SA_RED + ((16 + 4 * fq + r) * 65 + 16 * dt + fr) * 4);
                    if (w == 0) { *r0 = osel[dt][r]; *r1 = owin[dt][r]; } else { *r0 += osel[dt][r]; *r1 += owin[dt][r]; } }
            if (fq == 0) { LAS float* l0 = (LAS float*)(lds + SA_RED + (fr * 65 + 64) * 4); LAS float* l1 = (LAS float*)(lds + SA_RED + ((16 + fr) * 65 + 64) * 4);
                if (w == 0) { *l0 = lsel; *l1 = lwin; } else { *l0 += lsel; *l1 += lwin; } } }
        __syncthreads(); }
    { const float* gt = (const float*)(ws + WS_GATE); bf16_t* AO = (bf16_t*)(ws + WS_YG);
      for (int e = tid; e < 1024; e += 512) { const int pi = e >> 6, d = e & 63, tok = pi >> 2, hh = pi & 3; const size_t row = (size_t)(MP + 4 * b + tok);
          const float lc = *(const LAS float*)(lds + SA_LC + pi * 4) + *(const LAS float*)(lds + SA_LC + (16 + pi) * 4);
          const float oc = *(const LAS float*)(lds + SA_OC + (pi * 64 + d) * 4) + *(const LAS float*)(lds + SA_OC + 4096 + (pi * 64 + d) * 4);
          const LAS float* r0 = (const LAS float*)(lds + SA_RED + (pi * 65) * 4); const LAS float* r1 = (const LAS float*)(lds + SA_RED + ((16 + pi) * 65) * 4);
          const float* gg = gt + row * 48 + (4 * g + hh) * 3;
          float out = lc > 0.f ? gg[0] * oc / lc : 0.f;
          out += r0[64] > 0.f ? gg[1] * r0[d] / r0[64] : 0.f;
          out += r1[64] > 0.f ? gg[2] * r1[d] / r1[64] : 0.f;
          AO[row * D + (4 * g + hh) * 64 + d] = (bf16_t)f2bf(out); } }
    __syncthreads();
}

__device__ __forceinline__ void phase_attn_prompt(KP p, const Ctx& c, const int stop = 0) {
    const int Gd = gridDim.x, cb = blockIdx.x;
    for (int i = 0; i * Gd < 1024; ++i) { const int k = i * Gd + ((i & 1) ? Gd - 1 - cb : cb); if (k < 1024) attn_prompt_unit(p, c, k, stop); }
}
__device__ __forceinline__ void phase_attn_sample(KP p, const Ctx& c) {
    for (int it = blockIdx.x; it < SB * G; it += gridDim.x) attn_sample_unit(p, c, it);
}
#ifndef MK_MULTI
#define MK_MULTI 0
#endif
#if defined(PROBE_SCALE) || defined(SELFTEST)
constexpr int NPH = 46;
#elif defined(PROBE_ATTN2)
constexpr int NPH = 47;
#else
constexpr int NPH = 45;
#endif
#ifdef SPLITK
#define RESID_SPLIT(n) (n)
#else
#define RESID_SPLIT(n) 0
#endif

__global__ void __launch_bounds__(512, 2) mega(Params p) {
    extern __shared__ __attribute__((aligned(16))) unsigned char lds_raw[];
    LAS unsigned char* const lds0 = (LAS unsigned char*)lds_raw;
    volatile LAS unsigned* MISC = (volatile LAS unsigned*)(lds0 + MISC_OFF);
    for (int u = threadIdx.x; u < (LDS_BYTES - RING_BYTES) / 4; u += 512) ((LAS unsigned*)(lds0 + RING_BYTES))[u] = 0u;
    __syncthreads();
    const KP kp0 = (KP)__builtin_amdgcn_kernarg_segment_ptr();
    const int ph_lo = kp0->ph_lo, ph_hi = kp0->ph_hi, use_bar = kp0->use_bar;
    XcdBarrier bar; bar.bar = (unsigned*)(kp0->ws + WS_CTL); bar.x = 0; bar.st = nullptr;
    if (use_bar) bar = xcd_barrier_post((unsigned*)(kp0->ws + WS_CTL), MISC + 8);
    const int wave_s = __builtin_amdgcn_readfirstlane((int)threadIdx.x >> 6);
#define TID_MBCNT 1
#ifdef TID_MBCNT
#define TID_SRC(T_) asm volatile("v_mbcnt_lo_u32_b32 %0, -1, 0\n\tv_mbcnt_hi_u32_b32 %0, -1, %0" : "=v"(T_)); T_ += 64 * wave_s;
#else
#define TID_SRC(T_) T_ = threadIdx.x; asm volatile("" : "+v"(T_));
#endif
    int ph = 0;
#define PHASE_BEGIN if (ph >= ph_lo && ph < ph_hi) { KP p = kp0; asm volatile("" : "+s"(p)); int tid_; TID_SRC(tid_) \
        Ctx c; c.lds = lds0; c.tid = tid_; c.lane = tid_ & 63; c.wave = __builtin_amdgcn_readfirstlane(tid_ >> 6); c.gw = blockIdx.x * 8 + c.wave; c.ngw = gridDim.x * 8; c.gtid = blockIdx.x * 512 + tid_; c.gsz = gridDim.x * 512; \
        unsigned char* ws = p->ws; float* X = p->out + O_Y; (void)ws; (void)X;
#define PHASE_END   if (use_bar) { int te_; TID_SRC(te_) xcd_barrier(bar, te_ == 0); } } ++ph;

    PHASE_BEGIN phase_prologue(p, c); PHASE_END
#ifdef PROBE_BAR
    for (int xb = 0; xb < PROBE_BAR; ++xb) { if (use_bar) xcd_barrier(bar, threadIdx.x == 0); }
#endif

    for (int layer = 0; layer < NLAY; ++layer) {
        if (layer < 2) {
            const int li = layer;
            PHASE_BEGIN phase_mix(p, c, li); PHASE_END
            PHASE_BEGIN {
                pg8::Gemm g{(const bf16_t*)(ws + WS_XM), (const bf16_t*)(ws + WS_WRKV) + (size_t)li * 3072 * 1024, 3 * R, 3072, 1024, 1024};
                pg8::GroupOrder S; S.init((int)gridDim.x, (int)blockIdx.x); S.add(0, 0, 64, 0, 4); S.add(1, 66, 64, 4, 4); S.add(2, 132, 64, 8, 4);
                pg8::EpiF32G E{(float*)(ws + WS_RK_R), (float*)(ws + WS_RK_K), (float*)(ws + (li ? WS_V1 : WS_V0)), nullptr, D, 4, 66};
                pg8::gemm_phase<pg8::EpiF32G, pg8::GroupOrder, true, true>(c.lds, g, S, E, c.tid);
                {
                    const bf16_t* XMs = (const bf16_t*)(ws + WS_XM); const bf16_t* Wr = (const bf16_t*)(ws + WS_WRKV) + (size_t)li * 3072 * 1024;
                    for (int it = blockIdx.x + gridDim.x * c.wave; it < 768; it += c.ngw) { const int j = it >> 8, r = it & 255, row0 = MP + 32 * (r & 15), col0 = 64 * (r >> 4);
                        float* C = (float*)(ws + (j == 0 ? WS_RK_R : (j == 1 ? WS_RK_K : (li ? WS_V1 : WS_V0))));
                        f32x4 acc[4][2]; skinny_mma<4>(XMs + (size_t)j * R * D, 1024, Wr + (size_t)j * 1024 * 1024, 1024, 1024, row0, col0, c.lane, acc);
                        const int fr = c.lane & 15, fq = c.lane >> 4;
#pragma unroll
                        for (int nt = 0; nt < 4; ++nt)
#pragma unroll
                            for (int mt = 0; mt < 2; ++mt) *(f32x4*)(C + (size_t)(row0 + 16 * mt + fr) * D + col0 + 16 * nt + 4 * fq) = acc[nt][mt]; }
                }
                phase_lora1(p, c, li);
            } PHASE_END
            PHASE_BEGIN phase_scanA(p, c, li); PHASE_END
            PHASE_BEGIN phase_scanB(p, c, li); PHASE_END
            PHASE_BEGIN phase_scanC(p, c, li); PHASE_END
        } else {
            const int lb = layer - 2;
            if (layer == 2) {
                PHASE_BEGIN phase_norm(c, X, p->in[I_KVNG], (bf16_t*)(ws + WS_XN2), p->in[I_NORMG] + (size_t)(layer * 2) * D, (bf16_t*)(ws + WS_XN)); PHASE_END
                PHASE_BEGIN {
                    pg8::Gemm g{(const bf16_t*)(ws + WS_XN2), (const bf16_t*)(ws + WS_WKVT), R, NKV, 1024, 1024};
                    pg8::GroupOrder S; S.init((int)gridDim.x, (int)blockIdx.x); S.add(0, 0, 66, 0, 6);
                    pg8::EpiF32G E{(float*)(ws + WS_KVF), nullptr, nullptr, nullptr, NKV, 1 << 20, 0};
                    pg8::gemm_phase<pg8::EpiF32G, pg8::GroupOrder, true, true>(c.lds, g, S, E, c.tid);
                } PHASE_END
                PHASE_BEGIN phase_kvpost(p, c); PHASE_END
                PHASE_BEGIN {
                    pg8::Gemm g{(const bf16_t*)(ws + WS_CMPA), (const bf16_t*)(ws + WS_CW1T), (int)CMPA_ROWS, 512, 1024, 1024};
                    pg8::GroupOrder S; S.init((int)gridDim.x, (int)blockIdx.x); S.add(0, 0, 16, 0, 1); S.add(1, 16, 16, 1, 1); S.add(2, 32, 256, 0, 1); S.add(3, 288, 256, 1, 1);
                    pg8::EpiF32G E{(float*)(ws + WS_PCMP), (float*)(ws + WS_PCMP), nullptr, nullptr, 256, 1, 0};
                    pg8::gemm_phase<pg8::EpiF32G, pg8::GroupOrder, true, true>(c.lds, g, S, E, c.tid);
                } PHASE_END
                PHASE_BEGIN phase_cmp2(p, c); PHASE_END
            } else {
                PHASE_BEGIN phase_norm(c, X, p->in[I_NORMG] + (size_t)(layer * 2) * D, (bf16_t*)(ws + WS_XN), nullptr, nullptr); PHASE_END
            }
            PHASE_BEGIN {
                const bf16_t* XNp = (const bf16_t*)(ws + WS_XN); const bf16_t* Wq = (const bf16_t*)(ws + WS_WQT) + (size_t)lb * NQP * 1024; float* QFp = (float*)(ws + WS_QF);
                pg8::Gemm g{XNp, Wq, R, NQP, 1024, 1024};
                pg8::GroupOrder S; S.init((int)gridDim.x, (int)blockIdx.x); S.add(0, 0, 64, 0, 4);
                pg8::EpiF32G E{QFp, nullptr, nullptr, nullptr, NQP, 1 << 20, 0};
                pg8::gemm_phase<pg8::EpiF32G, pg8::GroupOrder, true, true>(c.lds, g, S, E, c.tid);
                float* GATEp = (float*)(ws + WS_GATE);
                for (int it = blockIdx.x + gridDim.x * c.wave; it < 256 + R / 32; it += c.ngw) { const int ln = launder_v(c.lane), fr = ln & 15, fq = ln >> 4;
                    if (it < 256) { const int row0 = MP + 32 * (it & 15), col0 = 64 * (it >> 4);
                        f32x4 acc[4][2]; skinny_mma<4>(XNp, 1024, Wq, 1024, 1024, row0, col0, ln, acc);
#pragma unroll
                        for (int nt = 0; nt < 4; ++nt)
#pragma unroll
                            for (int mt = 0; mt < 2; ++mt) *(f32x4*)(QFp + (size_t)(row0 + 16 * mt + fr) * NQP + col0 + 16 * nt + 4 * fq) = acc[nt][mt]; }
                    else { const int row0 = 32 * (it - 256);
                        f32x4 acc[3][2]; skinny_mma<3>(XNp, 1024, Wq, 1024, 1024, row0, 1024, ln, acc);
#pragma unroll
                        for (int nt = 0; nt < 3; ++nt)
#pragma unroll
                            for (int mt = 0; mt < 2; ++mt) { f32x4 v = acc[nt][mt];
#pragma unroll
                                for (int e = 0; e < 4; ++e) v[e] = sigmoidf_(v[e]);
                                *(f32x4*)(GATEp + (size_t)(row0 + 16 * mt + fr) * 48 + 16 * nt + 4 * fq) = v; } }
                }
            } PHASE_END
            PHASE_BEGIN phase_qpost(p, c, lb); PHASE_END
            PHASE_BEGIN phase_attn_prompt(p, c); PHASE_END
#ifdef PROBE_ATTN2
            PHASE_BEGIN phase_attn_prompt(p, c, PROBE_ATTN2); PHASE_END
#endif
            PHASE_BEGIN phase_attn_sample(p, c); PHASE_END
        }
        PHASE_BEGIN {
            const bf16_t* Wt = layer < 2 ? (const bf16_t*)(ws + WS_WORW) + (size_t)layer * 1024 * 1024 : (const bf16_t*)(ws + WS_WONSA) + (size_t)(layer - 2) * 1024 * 1024;
            pg8::Gemm g{(const bf16_t*)(ws + WS_YG), Wt, R, 1024, 1024, 1024};
            pg8::GroupOrder S; S.init((int)gridDim.x, (int)blockIdx.x); S.add(0, 0, 64, 0, 4);
            pg8::EpiResid E{X, D};
            pg8::gemm_phase<pg8::EpiResid, pg8::GroupOrder, true, true>(c.lds, g, S, E, c.tid);
            skinny_resid_sample(c, (const bf16_t*)(ws + WS_YG), 1024, Wt, 1024, X);
        } PHASE_END
        PHASE_BEGIN phase_norm(c, X, p->in[I_NORMG] + (size_t)(layer * 2 + 1) * D, (bf16_t*)(ws + WS_XN), nullptr, nullptr); PHASE_END
        PHASE_BEGIN {
            pg8::Gemm g{(const bf16_t*)(ws + WS_XN), (const bf16_t*)(ws + WS_WINT) + (size_t)layer * 5632 * 1024, R, 5632, 1024, 1024};
            pg8::GroupOrder S; S.init((int)gridDim.x, (int)blockIdx.x); S.add(0, 0, 66, 0, 22);
            pg8::EpiWin E{(bf16_t*)(ws + WS_U), (bf16_t*)(ws + WS_GT), p->out + O_CVP + (size_t)layer * NB * 2 * DFF, p->out + O_CVS + (size_t)layer * SB * 2 * DFF};
            pg8::gemm_phase<pg8::EpiWin, pg8::GroupOrder, true, true>(c.lds, g, S, E, c.tid);
        } PHASE_END
        PHASE_BEGIN phase_conv(p, c, layer); PHASE_END
        PHASE_BEGIN {
            pg8::Gemm g{(const bf16_t*)(ws + WS_HH), (const bf16_t*)(ws + WS_WOUTT) + (size_t)layer * 1024 * 2816, R, 1024, 2816, 2816};
            pg8::GroupOrder S; S.init((int)gridDim.x, (int)blockIdx.x); S.add(0, 0, 64, 0, 4);
            pg8::EpiResid E{X, D};
            pg8::gemm_phase<pg8::EpiResid, pg8::GroupOrder, true, true>(c.lds, g, S, E, c.tid);
            skinny_resid_sample(c, (const bf16_t*)(ws + WS_HH), 2816, (const bf16_t*)(ws + WS_WOUTT) + (size_t)layer * 1024 * 2816, 2816, X);
        } PHASE_END
    }
#ifdef SELFTEST
    PHASE_BEGIN if (blockIdx.x == 0 && c.wave == 0) { const float x = (float)((c.lane * 37) & 63) + 1.0f; float poison = 0.f;
        if (__ballot(swz_xor16_n(x) != __shfl_xor(x, 16))) poison += 1e3f;
        if (__ballot(sum_xor32_n(x) != x + __shfl_xor(x, 32))) poison += 1e4f;
        if (__ballot(sum_rows4_n(x) != x + __shfl_xor(x, 16) + __shfl_xor(x, 32) + __shfl_xor(x, 48))) poison += 1e5f;
        if (__ballot(wave_sum_n(x) != 2080.0f)) poison += 1e6f;
        if (__ballot(wave_max_n(x) != 64.0f)) poison += 1e7f;
        if (c.lane == 0) p->out[O_CVS] += poison; } PHASE_END
#endif
#ifdef PROBE_SCALE
    PHASE_BEGIN for (size_t e = c.gtid; e < O_END; e += c.gsz) { int oi = e < O_KV ? (e < (size_t)MP * D ? 0 : 1) : e < O_WINP ? (e < O_KV + (size_t)MP * D ? 2 : 3) : e < O_WINS ? 4 : e < O_WKVP ? 5 : e < O_WKVS ? 6 : e < O_SHP ? 7 : e < O_SHS ? 8 : e < O_CVP ? 9 : e < O_CVS ? 10 : 11;
        if (PROBE_SCALE < 0) oi = 11 - oi; p->out[e] *= 1.0f + sqrtf(0.5e-4f * (float)(oi + 1)); } PHASE_END
#endif
#undef PHASE_BEGIN
#undef PHASE_END
}

extern "C" void kernel_launch(void* const* d_in, const int* in_sizes, int n_in, void* d_out, int out_size, void* d_ws, size_t ws_size, hipStream_t stream) {
    static int grid = 0;
    if (grid == 0) {
        if (n_in != 45 || (size_t)out_size != O_END || ws_size < WS_END) { fprintf(stderr, "kernel_launch: unexpected shapes (n_in %d out %d ws %zu need %zu)\n", n_in, out_size, ws_size, (size_t)WS_END); grid = -1; return; }
        int dev = 0, cus = 0, per_cu = 0;
        if (hipGetDevice(&dev) != hipSuccess || hipDeviceGetAttribute(&cus, hipDeviceAttributeMultiprocessorCount, dev) != hipSuccess) { grid = -1; return; }
        if (hipFuncSetAttribute((const void*)mega, hipFuncAttributeMaxDynamicSharedMemorySize, LDS_BYTES) != hipSuccess) { fprintf(stderr, "kernel_launch: hipFuncSetAttribute failed\n"); grid = -1; return; }
        if (hipOccupancyMaxActiveBlocksPerMultiprocessor(&per_cu, (const void*)mega, 512, LDS_BYTES) != hipSuccess || per_cu < 1) { fprintf(stderr, "kernel_launch: occupancy query says %d\n", per_cu); (void)hipGetLastError(); }
        grid = cus;
    }
    if (grid < 0) return;
    (void)hipMemsetAsync((char*)d_ws + WS_CTL, 0, CTL_BYTES, stream);
    Params p{};
    for (int i = 0; i < 45; ++i) p.in[i] = (const float*)d_in[i];
    p.out = (float*)d_out; p.ws = (unsigned char*)d_ws;
#ifdef PROBE_PRE
    { const int plist[] = PROBE_PRE; for (int i = 0; i < (int)(sizeof(plist) / sizeof(int)); ++i) { p.ph_lo = plist[i] % 100; p.ph_hi = p.ph_lo + 1; p.use_bar = 0; p.pad = plist[i] / 100;       hipLaunchKernelGGL(mega, dim3(grid), dim3(512), LDS_BYTES, stream, p); } }
#endif
    p.pad = 0;
#if MK_MULTI
    for (int i = 0; i < NPH; ++i) { p.ph_lo = i; p.ph_hi = i + 1; p.use_bar = 0; hipLaunchKernelGGL(mega, dim3(grid), dim3(512), LDS_BYTES, stream, p); }
#else
    p.ph_lo = 0; p.ph_hi = NPH; p.use_bar = 1;
    hipLaunchKernelGGL(mega, dim3(grid), dim3(512), LDS_BYTES, stream, p);
#endif
    const hipError_t le = hipPeekAtLastError();
    if (le != hipSuccess) fprintf(stderr, "kernel_launch: launch failed: %s\n", hipGetErrorName(le));
}
```

```cpp
#include <hip/hip_runtime.h>
#include <cstdio>
#include <cstdint>

#define LAS __attribute__((address_space(3)))
#define GAS __attribute__((address_space(1)))
typedef unsigned short bf16_t;
typedef short bf16x8 __attribute__((ext_vector_type(8)));
typedef float f32x4 __attribute__((ext_vector_type(4)));
typedef float f32x16 __attribute__((ext_vector_type(16)));
typedef float f32x2 __attribute__((ext_vector_type(2)));
typedef unsigned u32x4 __attribute__((ext_vector_type(4)));
typedef unsigned u32x2 __attribute__((ext_vector_type(2)));

constexpr int D = 1024, NB = 2, TP = 8192, MP = NB * TP, SB = 128, ST = 4, MS = SB * ST, R = MP + MS;
constexpr int PAST = 2048, PAGE = 128, NPAGES = PAST / PAGE;
constexpr int H = 16, HD = 64, G = 4, HPG = 4, DFF = 2816, NLAY = 4;
constexpr int LW_ = 64, LA_ = 64, LV_ = 32, LG_ = 128, LHID = 288;
constexpr int NKV = 1536, NQ = 1072, NQP = 1280;
constexpr int NCH = TP / 64;
constexpr int NUNIT_A = NB * NCH * H;
constexpr int NCMP_P = 511, NCMP_S = 127, WIN = 512;
constexpr float NORM_EPS = 1e-6f, GN_EPS = 64e-5f;

constexpr size_t O_Y = 0;
constexpr size_t O_KV = (size_t)R * D;
constexpr size_t O_WINP = O_KV + (size_t)R * D;
constexpr size_t O_WINS = O_WINP + (size_t)NB * 512 * 512;
constexpr size_t O_WKVP = O_WINS + (size_t)SB * 512 * 512;
constexpr size_t O_WKVS = O_WKVP + (size_t)2 * NB * H * 4096;
constexpr size_t O_SHP = O_WKVS + (size_t)2 * SB * H * 4096;
constexpr size_t O_SHS = O_SHP + (size_t)2 * NB * D;
constexpr size_t O_CVP = O_SHS + (size_t)2 * SB * D;
constexpr size_t O_CVS = O_CVP + (size_t)NLAY * NB * 2 * DFF;
constexpr size_t O_END = O_CVS + (size_t)NLAY * SB * 2 * DFF;
static_assert(O_END == 88915968, "output size");

constexpr size_t MiB = 1u << 20;
constexpr size_t al(size_t x) { return (x + 4095) & ~(size_t)4095; }
constexpr size_t WS_CTL = 0, CTL_BYTES = 1 * MiB;
constexpr size_t WS_WRKV = WS_CTL + CTL_BYTES;
constexpr size_t WS_WORW = WS_WRKV + al((size_t)2 * 3072 * 1024 * 2);
constexpr size_t WS_W1T = WS_WORW + al((size_t)2 * 1024 * 1024 * 2);
constexpr size_t WS_W2W = WS_W1T + al((size_t)2 * 288 * 1024 * 2);
constexpr size_t WS_W2A = WS_W2W + al((size_t)2 * 1024 * 64 * 2);
constexpr size_t WS_W2V = WS_W2A + al((size_t)2 * 1024 * 64 * 2);
constexpr size_t WS_W2G = WS_W2V + al((size_t)1024 * 32 * 2);
constexpr size_t WS_WKVT = WS_W2G + al((size_t)2 * 1024 * 128 * 2);
constexpr size_t WS_WQT = WS_WKVT + al((size_t)1536 * 1024 * 2);
constexpr size_t WS_WONSA = WS_WQT + al((size_t)2 * 1280 * 1024 * 2);
constexpr size_t WS_WINT = WS_WONSA + al((size_t)2 * 1024 * 1024 * 2);
constexpr size_t WS_WOUTT = WS_WINT + al((size_t)4 * 5632 * 1024 * 2);
constexpr size_t WS_CW1T = WS_WOUTT + al((size_t)4 * 1024 * 2816 * 2);
constexpr size_t WS_CBIAS = WS_CW1T + al((size_t)2 * 256 * 1024 * 2);
constexpr size_t WS_CW2T = WS_CBIAS + al(2 * 128 * 4);
constexpr size_t WS_XM = WS_CW2T + al(2 * 2 * 64 * 128 * 2);
constexpr size_t WS_RK_R = WS_XM + al((size_t)6 * R * D * 2);
constexpr size_t WS_RK_K = WS_RK_R + al((size_t)R * D * 4);
constexpr size_t WS_V0 = WS_RK_K + al((size_t)R * D * 4);
constexpr size_t WS_V1 = WS_V0 + al((size_t)R * D * 4);
constexpr size_t WS_HID = WS_V1 + al((size_t)R * D * 4);
constexpr size_t WS_MT = WS_HID + al((size_t)R * LHID * 2);
constexpr size_t WS_NN = WS_MT + al((size_t)NUNIT_A * 4096 * 4);
constexpr size_t WS_RP = WS_NN + al((size_t)NUNIT_A * 4096 * 4);
constexpr size_t WS_YL = WS_RP + al((size_t)NUNIT_A * 4096 * 2);
constexpr size_t WS_S0 = WS_YL + al((size_t)NUNIT_A * 4096 * 4);
constexpr size_t WS_RKS = WS_S0 + al((size_t)NUNIT_A * 4096 * 2);
constexpr size_t WS_YG = WS_RKS + al((size_t)R * 16 * 4);
constexpr size_t WS_XN = WS_YG + al((size_t)R * D * 2);
constexpr size_t WS_XN2 = WS_XN + al((size_t)R * D * 2);
constexpr size_t WS_U = WS_XN2 + al((size_t)R * D * 2);
constexpr size_t WS_GT = WS_U + al((size_t)R * DFF * 2);
constexpr size_t WS_HH = WS_GT + al((size_t)R * DFF * 2);
constexpr size_t WS_KVF = WS_HH + al((size_t)R * DFF * 2);
constexpr size_t WS_CMPA = WS_KVF + al((size_t)R * NKV * 4);
constexpr size_t CMPA_ROWS = 4096 + 4096 + 65536 + 65536;
constexpr size_t WS_PCMP = WS_CMPA + al(CMPA_ROWS * 1024 * 2);
constexpr size_t WS_KS = WS_PCMP + al(CMPA_ROWS * 256 * 4);
constexpr size_t WS_VS = WS_KS + al((size_t)NB * G * TP * 64 * 2);
constexpr size_t WS_KW = WS_VS + al((size_t)NB * G * TP * 64 * 2);
constexpr size_t WS_VW = WS_KW + al((size_t)NB * G * TP * 64 * 2);
constexpr size_t WS_CK = WS_VW + al((size_t)NB * G * TP * 64 * 2);
constexpr size_t WS_CV = WS_CK + al((size_t)NB * G * 512 * 64 * 2);
constexpr size_t WS_CKS = WS_CV + al((size_t)NB * G * 512 * 64 * 2);
constexpr size_t WS_CVS = WS_CKS + al((size_t)SB * G * 128 * 64 * 4);
constexpr size_t WS_QF = WS_CVS + al((size_t)SB * G * 128 * 64 * 4);
constexpr size_t WS_Q = WS_QF + al((size_t)R * NQP * 4);
constexpr size_t WS_GATE = WS_Q + al((size_t)R * D * 2);
constexpr size_t WS_END = WS_GATE + al((size_t)R * 48 * 4);

typedef __bf16 bf16v2_ __attribute__((ext_vector_type(2)));
__device__ __forceinline__ unsigned cvt_pk_bf16_(float lo, float hi) { const f32x2 v = {lo, hi}; const bf16v2_ b = __builtin_convertvector(v, bf16v2_); return __builtin_bit_cast(unsigned, b); }
__device__ __forceinline__ unsigned f2bf(float f) { return cvt_pk_bf16_(f, f) & 0xffffu; }
__device__ __forceinline__ unsigned pk2(float lo, float hi) { return cvt_pk_bf16_(lo, hi); }
__device__ __forceinline__ float frcp(float x) { return __builtin_amdgcn_rcpf(x); }
__device__ __forceinline__ float frsq(float x) { return __builtin_amdgcn_rsqf(x); }
__device__ __forceinline__ float bf2f(unsigned short b) { return __builtin_bit_cast(float, ((unsigned)b) << 16); }
__device__ __forceinline__ float bflo(unsigned w) { return __builtin_bit_cast(float, w << 16); }
__device__ __forceinline__ float bfhi(unsigned w) { return __builtin_bit_cast(float, w & 0xffff0000u); }
template <int CTRL> __device__ __forceinline__ float dpp_f(float x) { return __builtin_bit_cast(float, __builtin_amdgcn_update_dpp(0, __builtin_bit_cast(int, x), CTRL, 0xF, 0xF, true)); }
__device__ __forceinline__ float row16_sum(float v) { v += dpp_f<0xB1>(v); v += dpp_f<0x4E>(v); v += dpp_f<0x141>(v); v += dpp_f<0x140>(v); return v; }
__device__ __forceinline__ float row16_max(float v) { v = fmaxf(v, dpp_f<0xB1>(v)); v = fmaxf(v, dpp_f<0x4E>(v)); v = fmaxf(v, dpp_f<0x141>(v)); v = fmaxf(v, dpp_f<0x140>(v)); return v; }
__device__ __forceinline__ float swz_xor16_n(float x) { return __builtin_bit_cast(float, __builtin_amdgcn_ds_swizzle(__builtin_bit_cast(int, x), 0x401F)); }
__device__ __forceinline__ float sum_xor32_n(float x) { auto rr = __builtin_amdgcn_permlane32_swap(__float_as_uint(x), __float_as_uint(x), false, false);
    return __uint_as_float(rr[0]) + __uint_as_float(rr[1]); }
__device__ __forceinline__ float sum_rows4_n(float x) { x += swz_xor16_n(x); return sum_xor32_n(x); }
__device__ __forceinline__ float wave_sum_n(float v) {
    v = row16_sum(v);
    v += __builtin_bit_cast(float, __builtin_amdgcn_update_dpp(0, __builtin_bit_cast(int, v), 0x142, 0xA, 0xF, false));
    v += __builtin_bit_cast(float, __builtin_amdgcn_update_dpp(0, __builtin_bit_cast(int, v), 0x143, 0xC, 0xF, false));
    return __builtin_bit_cast(float, __builtin_amdgcn_readlane(__builtin_bit_cast(int, v), 63));
}
__device__ __forceinline__ float wave_max_n(float v) {
    v = row16_max(v);
    v = fmaxf(v, __builtin_bit_cast(float, __builtin_amdgcn_update_dpp(__builtin_bit_cast(int, v), __builtin_bit_cast(int, v), 0x142, 0xA, 0xF, false)));
    v = fmaxf(v, __builtin_bit_cast(float, __builtin_amdgcn_update_dpp(__builtin_bit_cast(int, v), __builtin_bit_cast(int, v), 0x143, 0xC, 0xF, false)));
    return __builtin_bit_cast(float, __builtin_amdgcn_readlane(__builtin_bit_cast(int, v), 63));
}
#define XLANE_NEW 1
#ifdef XLANE_NEW
__device__ __forceinline__ float swz_xor16(float x) { return __builtin_bit_cast(float, __builtin_amdgcn_ds_swizzle(__builtin_bit_cast(int, x), 0x401F)); }
__device__ __forceinline__ float sum_xor32(float x) { return sum_xor32_n(x); }
__device__ __forceinline__ float sum_rows4(float x) { x += swz_xor16(x); return sum_xor32(x); }
__device__ __forceinline__ float wave_sum(float v) {
    v = row16_sum(v);
    v += __builtin_bit_cast(float, __builtin_amdgcn_update_dpp(0, __builtin_bit_cast(int, v), 0x142, 0xA, 0xF, false));
    v += __builtin_bit_cast(float, __builtin_amdgcn_update_dpp(0, __builtin_bit_cast(int, v), 0x143, 0xC, 0xF, false));
    return __builtin_bit_cast(float, __builtin_amdgcn_readlane(__builtin_bit_cast(int, v), 63));
}
__device__ __forceinline__ float wave_max(float v) {
    v = row16_max(v);
    v = fmaxf(v, __builtin_bit_cast(float, __builtin_amdgcn_update_dpp(__builtin_bit_cast(int, v), __builtin_bit_cast(int, v), 0x142, 0xA, 0xF, false)));
    v = fmaxf(v, __builtin_bit_cast(float, __builtin_amdgcn_update_dpp(__builtin_bit_cast(int, v), __builtin_bit_cast(int, v), 0x143, 0xC, 0xF, false)));
    return __builtin_bit_cast(float, __builtin_amdgcn_readlane(__builtin_bit_cast(int, v), 63));
}
#else
__device__ __forceinline__ float sum_xor32(float x) { return x + __shfl_xor(x, 32); }
__device__ __forceinline__ float sum_rows4(float x) { x += __shfl_xor(x, 16); x += __shfl_xor(x, 32); return x; }
__device__ __forceinline__ float wave_sum(float v) { v = row16_sum(v); v += __shfl_xor(v, 16); v += __shfl_xor(v, 32); return v; }
__device__ __forceinline__ float wave_max(float v) { v = row16_max(v); v = fmaxf(v, __shfl_xor(v, 16)); v = fmaxf(v, __shfl_xor(v, 32)); return v; }
#endif
__device__ __forceinline__ float sigmoidf_(float x) { return frcp(1.0f + __builtin_amdgcn_exp2f(-1.4426950408889634f * x)); }
__device__ __forceinline__ float gelu_tanh(float x) {
    const float u = 0.7978845608028654f * (x + 0.044715f * x * x * x);
    const float e = __builtin_amdgcn_exp2f(2.8853900817779268f * u);
    const float th = 1.0f - 2.0f * frcp(e + 1.0f);
    return 0.5f * x * (1.0f + th);
}
template <class T> __device__ __forceinline__ const T* launder_p(const T* q) { asm volatile("" : "+v"(q)); return q; }
__device__ __forceinline__ int launder_v(int x) { asm volatile("" : "+v"(x)); return x; }
#define LDS_WAIT() asm volatile("s_waitcnt lgkmcnt(0)" ::: "memory")
#define VM_WAIT() asm volatile("s_waitcnt vmcnt(0)" ::: "memory")
__device__ __forceinline__ f32x4 mfma16(bf16x8 a, bf16x8 b, f32x4 c) { return __builtin_amdgcn_mfma_f32_16x16x32_bf16(a, b, c, 0, 0, 0); }
__device__ __forceinline__ f32x16 mfma32(bf16x8 a, bf16x8 b, f32x16 c) { return __builtin_amdgcn_mfma_f32_32x32x16_bf16(a, b, c, 0, 0, 0); }
#define XB_TMO      128
#define XB_XCNT(j)  (256  + 64 * (j))
#define XB_XSUB(j)  (1280 + 64 * (j))
#define XB_XGEN(j)  (2304 + 64 * (j))
#define XB_TOP      3328
#define XB_TOPGEN   3392
#define XCD_BAR_WORDS 3456
#define XB_SPIN_CAP (1u << 18)

__device__ __forceinline__ unsigned xb_ld(unsigned* p)              { return __hip_atomic_load(p, __ATOMIC_RELAXED, __HIP_MEMORY_SCOPE_AGENT); }
__device__ __forceinline__ unsigned xb_add(unsigned* p, unsigned v) { return __hip_atomic_fetch_add(p, v, __ATOMIC_RELAXED, __HIP_MEMORY_SCOPE_AGENT); }
__device__ __forceinline__ unsigned xb_xcc_id() { return (unsigned)__builtin_amdgcn_s_getreg((3 << 11) | 20) & 0xFu; }
#define XB_SPIN(cond, bar) do { unsigned _sp = 0; while (cond) { __builtin_amdgcn_s_sleep(1); \
    if ((++_sp & 255u) == 0u) { if (xb_ld(&(bar)[XB_TMO])) break; if (_sp > XB_SPIN_CAP) { atomicAdd(&(bar)[XB_TMO], 1u); break; } } } } while (0)

struct XcdBarrier {
    unsigned* bar; unsigned x;
    volatile LAS unsigned* st;
};

__device__ __forceinline__ XcdBarrier xcd_barrier_post(unsigned* bar, volatile LAS unsigned* st) {
    XcdBarrier b; b.bar = bar; b.x = xb_xcc_id(); b.st = st;
    if (threadIdx.x == 0) (void)xb_add(&bar[XB_XCNT(b.x)], 1u);
    return b;
}
__device__ __forceinline__ void xcd_barrier_complete(unsigned* bar, unsigned x, unsigned& nloc, unsigned& nx) {
    const unsigned G = gridDim.x * gridDim.y * gridDim.z;
    unsigned sum, cnt, mine, sp = 0u;
    for (;;) {
        sum = 0u; cnt = 0u; mine = 0u;
#pragma unroll
        for (unsigned j = 0; j < 16; ++j) { const unsigned c = xb_ld(&bar[XB_XCNT(j)]); sum += c; cnt += (c > 0u) ? 1u : 0u; mine = (j == x) ? c : mine; }
        if (sum == G) break;
        __builtin_amdgcn_s_sleep(1);
        if ((++sp & 255u) == 0u) { if (xb_ld(&bar[XB_TMO])) break; if (sp > XB_SPIN_CAP) { atomicAdd(&bar[XB_TMO], 1u); break; } }
    }
    nloc = mine > 0u ? mine : 1u; nx = cnt > 0u ? cnt : 1u;
}

__device__ __forceinline__ void xcd_barrier(const XcdBarrier& b, const bool t0) {
    asm volatile("s_waitcnt vmcnt(0)" ::: "memory");
    __syncthreads();
    if (t0) {
        unsigned* bar = b.bar;
        __builtin_amdgcn_s_waitcnt(0);
        unsigned nloc = b.st[0], nx = b.st[1];
        if (nloc == 0u) { xcd_barrier_complete(bar, b.x, nloc, nx); b.st[0] = nloc; b.st[1] = nx; }
        const unsigned old = xb_add(&bar[XB_XSUB(b.x)], 1u);
        const unsigned gen = old / nloc;
        if (old + 1u == (gen + 1u) * nloc) {
            __builtin_amdgcn_fence(__ATOMIC_RELEASE, "agent");
            asm volatile("s_waitcnt vmcnt(0)" ::: "memory");
            const unsigned og = xb_add(&bar[XB_TOP], 1u);
            const unsigned tg = og / nx;
            if (og + 1u == (tg + 1u) * nx) xb_add(&bar[XB_TOPGEN], 1u);
            else XB_SPIN(xb_ld(&bar[XB_TOPGEN]) == tg, bar);
            __builtin_amdgcn_fence(__ATOMIC_ACQUIRE, "agent");
            xb_add(&bar[XB_XGEN(b.x)], 1u);
            asm volatile("s_waitcnt vmcnt(0)" ::: "memory");
        } else {
            XB_SPIN(xb_ld(&bar[XB_XGEN(b.x)]) == gen, bar);
            __builtin_amdgcn_fence(__ATOMIC_ACQUIRE, "agent");
            asm volatile("s_waitcnt vmcnt(0)" ::: "memory");
        }
    }
    __syncthreads();
}

namespace pg8 {
#define PG8_LAS __attribute__((address_space(3)))
constexpr int BM = 256, BK = 64, HALF = 128, HTB = HALF * BK * 2  , STAGE_BYTES = 8 * HTB, NXCD = 8, WGM = 8;
__host__ __device__ __forceinline__ int lds_byte(int r, int c) { const int st = (r >> 4) * 2 + (c >> 5), rr = r & 15, cc = c & 31, ob = rr * 64 + cc * 2; return st * 1024 + (ob ^ (((ob >> 9) & 1) << 5)); }
__host__ __device__ __forceinline__ void stage_rc(int b, int& R_, int& C_) { const int st = b / 1024, sb = b % 1024, swz = sb ^ (((sb >> 9) & 1) << 5); R_ = (st >> 1) * 16 + swz / 64; C_ = (st & 1) * 32 + (swz % 64) / 2; }
__host__ __device__ __forceinline__ int perm32(int rho) { const int n = rho >> 4, i = rho & 15; return 8 * (i >> 2) + 4 * n + (i & 3); }

struct Unit { int pm, pn, kb, nt; };
struct Gemm { const bf16_t* A; const bf16_t* Bt; int M, N, K, KL; };

struct GroupOrder {
    int pm0[4], nM[4], pn0[4], nN[4]; int nseg, nwg, G_, c;
    __device__ __forceinline__ void init(int G__, int c_) { nseg = 0; nwg = 0; G_ = G__; c = c_;
#pragma unroll
        for (int s = 0; s < 4; ++s) { pm0[s] = 0; nM[s] = 0; pn0[s] = 0; nN[s] = 1; } }
    __device__ __forceinline__ void add(int s, int pm0_, int nM_, int pn0_, int nN_) { pm0[s] = pm0_; nM[s] = nM_; pn0[s] = pn0_; nN[s] = nN_; nwg += nM_ * nN_; nseg = s + 1; }
    __device__ __forceinline__ bool next(int i, Unit& u) const {
        const long L = (long)i * G_ + c; if (L >= nwg) return false;
        int id = (int)L; { const int q = nwg / NXCD, r = nwg % NXCD, xcd = id % NXCD, off = id / NXCD; id = (xcd < r ? xcd * (q + 1) : r * (q + 1) + (xcd - r) * q) + off; }
        int spm0 = 0, snM = 1, spn0 = 0, snN = 1; bool found = false;
#pragma unroll
        for (int s = 0; s < 4; ++s) { const int cnt = nM[s] * nN[s]; if (!found) { if (id < cnt) { found = true; spm0 = pm0[s]; snM = nM[s]; spn0 = pn0[s]; snN = nN[s]; } else id -= cnt; } }
        const int nig = WGM * snN, gid = id / nig, fm = gid * WGM, gsz = (snM - fm) < WGM ? (snM - fm) : WGM;
        u.pm = spm0 + fm + ((id % nig) % gsz); u.pn = spn0 + (id % nig) / gsz; u.kb = 0; u.nt = 0; return true;
    }
    __device__ __forceinline__ void a_ready(const Unit&) const {}
    __device__ __forceinline__ void done(const Unit&) const {}
};

struct ResidOrder {
    GroupOrder P; int nS, G_, c;
    __device__ __forceinline__ void init(int G__, int c_, int nS_) { P.init(G__, c_); P.add(0, 0, nS_ ? 64 : 66, 0, 4); nS = nS_; G_ = G__; c = c_; }
    __device__ __forceinline__ bool next(int i, Unit& u) const {
        const int npc = c < P.nwg ? (P.nwg - 1 - c) / G_ + 1 : 0;
        if (i < npc) return P.next(i, u);
        const int L = (i - npc) * G_ + (G_ - 1 - c); if (L >= 8 * nS) return false;
        const int sl = L >> 3, t = L & 7; u.pm = 64 + (t & 1); u.pn = t >> 1; u.kb = sl * 512; u.nt = 4; return true; }
    __device__ __forceinline__ void a_ready(const Unit&) const {}
    __device__ __forceinline__ void done(const Unit&) const {}
};
__device__ __forceinline__ unsigned cvt_pk_bf16(float lo, float hi) { return cvt_pk_bf16_(lo, hi); }

struct EpiF32G {
    static constexpr bool PERM = false, AFTER_DRAIN = false;
    float* b0; float* b1; float* b2; float* b3; int ldc, png, pmg;
    __device__ __forceinline__ void operator()(const f32x4 (&acc)[2][2][4][2], const Unit& u, int wr, int wc, int fr, int fq) const {
        const int j = u.pn / png; float* C = j == 0 ? b0 : (j == 1 ? b1 : (j == 2 ? b2 : b3));
        const int row0 = (u.pm - j * pmg) * BM + wr * 64 + fr, col0 = (u.pn - j * png) * BM + wc * 32 + 4 * fq;
#pragma unroll
        for (int ai = 0; ai < 2; ++ai)
#pragma unroll
            for (int m = 0; m < 4; ++m) { float* rowp = C + (size_t)(row0 + ai * HALF + m * 16) * ldc + col0;
#pragma unroll
                for (int bj = 0; bj < 2; ++bj)
#pragma unroll
                    for (int n = 0; n < 2; ++n) *(f32x4*)(rowp + bj * HALF + n * 16) = acc[ai][bj][m][n]; }
    }
};
struct EpiResid {
    static constexpr bool PERM = false, AFTER_DRAIN = false;
    float* X; int ldc;
    __device__ __forceinline__ void operator()(const f32x4 (&acc)[2][2][4][2], const Unit& u, int wr, int wc, int fr, int fq) const {
        const int row0 = u.pm * BM + wr * 64 + fr, col0 = u.pn * BM + wc * 32 + 4 * fq; const bool split = u.nt != 0;
#pragma unroll
        for (int ai = 0; ai < 2; ++ai)
#pragma unroll
            for (int m = 0; m < 4; ++m) { float* rowp = X + (size_t)(row0 + ai * HALF + m * 16) * ldc + col0;
                if (!split) {
#pragma unroll
                    for (int bj = 0; bj < 2; ++bj)
#pragma unroll
                        for (int n = 0; n < 2; ++n) { f32x4* p = (f32x4*)(rowp + bj * HALF + n * 16); *p = *p + acc[ai][bj][m][n]; } }
                else {
#pragma unroll
                    for (int bj = 0; bj < 2; ++bj)
#pragma unroll
                        for (int n = 0; n < 2; ++n) { float* q = rowp + bj * HALF + n * 16;
#pragma unroll
                            for (int e = 0; e < 4; ++e) __hip_atomic_fetch_add(q + e, acc[ai][bj][m][n][e], __ATOMIC_RELAXED, __HIP_MEMORY_SCOPE_AGENT); } }
                asm volatile("" ::: "memory"); }
    }
};
struct EpiWin {
    static constexpr bool PERM = true, AFTER_DRAIN = false;
    bf16_t* U; bf16_t* GT; float* cvp; float* cvs;
    __device__ __forceinline__ void operator()(const f32x4 (&acc)[2][2][4][2], const Unit& u, int wr, int wc, int fr, int fq) const {
        const bool isu = u.pn < 11; bf16_t* base = isu ? U : GT; const int colt = (isu ? u.pn : u.pn - 11) * BM;
        const int row0 = u.pm * BM + wr * 64 + fr, col0 = colt + wc * 32 + 8 * fq;
#pragma unroll
        for (int ai = 0; ai < 2; ++ai)
#pragma unroll
            for (int m = 0; m < 4; ++m) { const int row = row0 + ai * HALF + m * 16; bf16_t* rowp = base + (size_t)row * DFF + col0;
                float* cv = nullptr;
                if (isu) { if (row >= MP) { const int t = (row - MP) & 3, b = (row - MP) >> 2; if (t >= 2) cv = cvs + (size_t)(b * 2 + (t - 2)) * DFF; }
                           else { const int tt = row & (TP - 1); if (tt >= TP - 2) cv = cvp + (size_t)((row >> 13) * 2 + (tt - (TP - 2))) * DFF; } }
#pragma unroll
                for (int bj = 0; bj < 2; ++bj) { const f32x4 v0 = acc[ai][bj][m][0], v1 = acc[ai][bj][m][1];
                    u32x4 w; w.x = cvt_pk_bf16(v0[0], v0[1]); w.y = cvt_pk_bf16(v0[2], v0[3]); w.z = cvt_pk_bf16(v1[0], v1[1]); w.w = cvt_pk_bf16(v1[2], v1[3]);
                    *(u32x4*)(rowp + bj * HALF) = w;
                    if (cv) { *(f32x4*)(cv + col0 + bj * HALF) = v0; *(f32x4*)(cv + col0 + bj * HALF + 4) = v1; } } }
    }
};
template <class Epi, class Sched, bool ALIGN_EPI = false, bool SP2 = false>
__device__ __forceinline__ void gemm_phase(PG8_LAS unsigned char* lds, const Gemm g, const Sched& S, const Epi& E, int tid_in) {
    int tid_l = tid_in; asm volatile("" : "+v"(tid_l));
    const int tid = tid_l, wid = __builtin_amdgcn_readfirstlane(tid >> 6), lane = tid & 63, wr = wid >> 2, wc = wid & 3, fr = lane & 15, fq = lane >> 4;
    const int K = g.K, nt = g.KL / BK;
    unsigned voffA[2], voffB[2];
#pragma unroll
    for (int i = 0; i < 2; ++i) { int R, C; stage_rc(tid * 16 + i * 8192, R, C); const int Rb = Epi::PERM ? ((R & ~31) + perm32(R & 31)) : R;
        voffA[i] = (unsigned)(R * K + C) * 2u; voffB[i] = (unsigned)(Rb * K + C) * 2u; }
    const size_t kstep = (size_t)(BK * 2);
    const size_t hstep = (size_t)HALF * K * 2;
    const size_t tstep = 2 * hstep;
    const unsigned ldsw = (unsigned)wid * 1024u;
    const int aoff = lds_byte(wr * 64 + fr, fq * 8), boff = lds_byte(wc * 32 + fr, fq * 8);
#define PG8_SA(b, h) (((b) * 2 + (h)) * HTB)
#define PG8_SB(b, h) ((4 + (b) * 2 + (h)) * HTB)
#define PG8_STAGE(bufoff, gbase, voff) do { _Pragma("unroll") for (int _i = 0; _i < 2; ++_i) \
        __builtin_amdgcn_global_load_lds((const unsigned*)((const char*)(gbase) + (voff)[_i]), (PG8_LAS unsigned*)(lds + (bufoff) + ldsw + _i * 8192), 16, 0, 0); } while (0)
#define PG8_LDA(dst, b, h) do { _Pragma("unroll") for (int m = 0; m < 4; ++m) _Pragma("unroll") for (int k = 0; k < 2; ++k) dst[m][k] = *(const PG8_LAS bf16x8*)(lds + PG8_SA(b, h) + aoff + m * 2048 + k * 1024); } while (0)
#define PG8_LDB(dst, b, h) do { _Pragma("unroll") for (int n = 0; n < 2; ++n) _Pragma("unroll") for (int k = 0; k < 2; ++k) dst[n][k] = *(const PG8_LAS bf16x8*)(lds + PG8_SB(b, h) + boff + n * 2048 + k * 1024); } while (0)
#define PG8_MMA(ai, bj, At, Bt) do { __builtin_amdgcn_s_setprio(1); _Pragma("unroll") for (int m = 0; m < 4; ++m) _Pragma("unroll") for (int n = 0; n < 2; ++n) _Pragma("unroll") for (int k = 0; k < 2; ++k) \
        acc[ai][bj][m][n] = __builtin_amdgcn_mfma_f32_16x16x32_bf16(Bt[n][k], At[m][k], acc[ai][bj][m][n], 0, 0, 0); __builtin_amdgcn_s_setprio(0); } while (0)
#define PG8_WAIT_V(n) asm volatile("s_waitcnt vmcnt(" #n ")" ::: "memory")
#define PG8_WAIT_L(n) asm volatile("s_waitcnt lgkmcnt(" #n ")" ::: "memory")
#define PG8_BAR __builtin_amdgcn_s_barrier()
#define PG8_SCHED __builtin_amdgcn_sched_barrier(0)
    Unit cur, nxt; int ui = 0;
    if (!S.next(0, cur)) return;
    f32x4 acc[2][2][4][2];
#pragma unroll
    for (int a = 0; a < 2; ++a)
#pragma unroll
        for (int b = 0; b < 2; ++b)
#pragma unroll
            for (int m = 0; m < 4; ++m)
#pragma unroll
                for (int n = 0; n < 2; ++n) acc[a][b][m][n] = (f32x4){0.f, 0.f, 0.f, 0.f};
    bf16x8 At[4][2], B0[2][2], B1[2][2];
    const char* cA = (const char*)g.A + (size_t)cur.pm * tstep + cur.kb; const char* cB = (const char*)g.Bt + (size_t)cur.pn * tstep + cur.kb;
    S.a_ready(cur);
    if constexpr (SP2) {
        PG8_STAGE(PG8_SB(0, 0), cB, voffB); PG8_STAGE(PG8_SB(0, 1), cB + hstep, voffB); PG8_STAGE(PG8_SA(0, 0), cA, voffA); PG8_STAGE(PG8_SA(0, 1), cA + hstep, voffA);
        if (wr == 1) PG8_BAR;
        PG8_WAIT_V(2); PG8_BAR;
        PG8_STAGE(PG8_SB(1, 0), cB + kstep, voffB); PG8_STAGE(PG8_SA(1, 0), cA + kstep, voffA); PG8_STAGE(PG8_SB(1, 1), cB + hstep + kstep, voffB);
        PG8_WAIT_V(6); PG8_BAR;
    } else {
        PG8_STAGE(PG8_SB(0, 0), cB, voffB); PG8_STAGE(PG8_SA(0, 0), cA, voffA); PG8_STAGE(PG8_SB(0, 1), cB + hstep, voffB); PG8_STAGE(PG8_SA(0, 1), cA + hstep, voffA);
        if (wr == 1) PG8_BAR;
        PG8_WAIT_V(4); PG8_BAR;
        PG8_STAGE(PG8_SB(1, 0), cB + kstep, voffB); PG8_STAGE(PG8_SA(1, 0), cA + kstep, voffA); PG8_STAGE(PG8_SB(1, 1), cB + hstep + kstep, voffB);
        PG8_WAIT_V(6); PG8_BAR;
    }
    for (;;) {
        const bool has_next = S.next(ui + 1, nxt);
        const char* nA = has_next ? (const char*)g.A + (size_t)nxt.pm * tstep + nxt.kb : cA; const char* nB = has_next ? (const char*)g.Bt + (size_t)nxt.pn * tstep + nxt.kb : cB;
        const int ntu = cur.nt ? cur.nt : nt;
        for (int t = 0; t < ntu; t += 2) {
            const bool last = (t == ntu - 2);
            const char* a1 = cA + (size_t)(t + 1) * kstep;
            const char* a2 = last ? nA : cA + (size_t)(t + 2) * kstep; const char* b2 = last ? nB : cB + (size_t)(t + 2) * kstep;
            const char* a3 = a2 + kstep; const char* b3 = b2 + kstep;
            if (last && has_next) S.a_ready(nxt);
            if constexpr (SP2) {
            PG8_LDB(B0, 0, 0); PG8_LDB(B1, 0, 1); PG8_SCHED; PG8_LDA(At, 0, 0); PG8_STAGE(PG8_SA(1, 1), a1 + hstep, voffA);
            PG8_WAIT_V(8); PG8_WAIT_L(0); PG8_BAR; PG8_MMA(0, 0, At, B0); PG8_MMA(0, 1, At, B1); PG8_BAR; PG8_SCHED;
            PG8_LDA(At, 0, 1); PG8_STAGE(PG8_SB(0, 0), b2, voffB); PG8_STAGE(PG8_SB(0, 1), b2 + hstep, voffB); PG8_STAGE(PG8_SA(0, 0), a2, voffA);
            PG8_WAIT_V(8); PG8_WAIT_L(0); PG8_BAR; PG8_MMA(1, 0, At, B0); PG8_MMA(1, 1, At, B1); PG8_BAR; PG8_SCHED;
            PG8_LDB(B0, 1, 0); PG8_LDB(B1, 1, 1); PG8_SCHED; PG8_LDA(At, 1, 0); PG8_STAGE(PG8_SA(0, 1), a2 + hstep, voffA);
            PG8_WAIT_V(8); PG8_WAIT_L(0); PG8_BAR; PG8_MMA(0, 0, At, B0); PG8_MMA(0, 1, At, B1); PG8_BAR; PG8_SCHED;
            PG8_LDA(At, 1, 1); PG8_STAGE(PG8_SB(1, 0), b3, voffB); PG8_STAGE(PG8_SB(1, 1), b3 + hstep, voffB); PG8_STAGE(PG8_SA(1, 0), a3, voffA);
            PG8_WAIT_V(8); PG8_WAIT_L(0); PG8_BAR; PG8_MMA(1, 0, At, B0); PG8_MMA(1, 1, At, B1); PG8_BAR; PG8_SCHED;
            } else {
            PG8_LDB(B0, 0, 0); PG8_SCHED; PG8_LDA(At, 0, 0); PG8_STAGE(PG8_SA(1, 1), a1 + hstep, voffA);
            PG8_WAIT_L(8); PG8_BAR; PG8_WAIT_L(0); PG8_MMA(0, 0, At, B0); PG8_BAR; PG8_SCHED;
            PG8_LDB(B1, 0, 1); PG8_STAGE(PG8_SB(0, 0), b2, voffB);
            PG8_BAR; PG8_WAIT_L(0); PG8_MMA(0, 1, At, B1); PG8_BAR;
            PG8_LDA(At, 0, 1); PG8_STAGE(PG8_SA(0, 0), a2, voffA);
            PG8_BAR; PG8_WAIT_L(0); PG8_MMA(1, 0, At, B0); PG8_BAR; PG8_SCHED;
            PG8_STAGE(PG8_SB(0, 1), b2 + hstep, voffB);
            PG8_WAIT_V(6); PG8_BAR; PG8_MMA(1, 1, At, B1); PG8_BAR;
            PG8_LDB(B0, 1, 0); PG8_SCHED; PG8_LDA(At, 1, 0); PG8_STAGE(PG8_SA(0, 1), a2 + hstep, voffA);
            PG8_WAIT_L(8); PG8_BAR; PG8_WAIT_L(0); PG8_MMA(0, 0, At, B0); PG8_BAR; PG8_SCHED;
            PG8_LDB(B1, 1, 1); PG8_STAGE(PG8_SB(1, 0), b3, voffB);
            PG8_BAR; PG8_WAIT_L(0); PG8_MMA(0, 1, At, B1); PG8_BAR;
            PG8_LDA(At, 1, 1); PG8_STAGE(PG8_SA(1, 0), a3, voffA);
            PG8_BAR; PG8_WAIT_L(0); PG8_MMA(1, 0, At, B0); PG8_BAR; PG8_SCHED;
            PG8_STAGE(PG8_SB(1, 1), b3 + hstep, voffB);
            PG8_WAIT_V(6); PG8_BAR; PG8_MMA(1, 1, At, B1); PG8_BAR;
            }
        }
        if constexpr (ALIGN_EPI) { if (wr == 0) PG8_BAR; }
        if constexpr (!Epi::AFTER_DRAIN) { E(acc, cur, wr, wc, fr, fq); S.done(cur); }
        if (!has_next) break;
#pragma unroll
        for (int a = 0; a < 2; ++a)
#pragma unroll
            for (int b = 0; b < 2; ++b)
#pragma unroll
                for (int m = 0; m < 4; ++m)
#pragma unroll
                    for (int n = 0; n < 2; ++n) acc[a][b][m][n] = (f32x4){0.f, 0.f, 0.f, 0.f};
        cur = nxt; cA = nA; cB = nB; ++ui;
        if constexpr (ALIGN_EPI) { if (wr == 1) PG8_BAR; }
    }
    PG8_WAIT_V(0);
    if constexpr (!ALIGN_EPI) { if (wr == 0) PG8_BAR; }
    PG8_BAR;
    if constexpr (Epi::AFTER_DRAIN) { E.fused(acc, cur, wr, wc, fr, fq, lds, wid, lane); S.done(cur); }
#undef PG8_SA
#undef PG8_SB
#undef PG8_STAGE
#undef PG8_LDA
#undef PG8_LDB
#undef PG8_MMA
#undef PG8_WAIT_V
#undef PG8_WAIT_L
#undef PG8_BAR
#undef PG8_SCHED
}
}
constexpr int RING_BYTES = 131072, MISC_OFF = RING_BYTES + 320, LDS_BYTES = 147456;
struct Params { const float* in[45]; float* out; unsigned char* ws; int ph_lo, ph_hi, use_bar, pad; };
enum { I_XP = 0, I_XS, I_CKV, I_CWIN, I_SWKV, I_SSHIFT, I_SCONV, I_PT, I_NORMG, I_MU, I_WR, I_WK, I_WV, I_WO, I_W0, I_W1, I_W2, I_A0, I_A1, I_A2, I_V0, I_V1, I_V2, I_G1, I_G2,
       I_KK, I_KA, I_RKK, I_LNW, I_LNB, I_KVNG, I_WKV, I_KNG, I_PE, I_CW1, I_CB1, I_CW2, I_CB2, I_WQ, I_QNG, I_WONSA, I_WIN, I_CONVW, I_CONVB, I_WOUT };

typedef const __attribute__((address_space(4))) Params* KP;
struct Ctx { LAS unsigned char* lds; int tid, lane, wave, gw, ngw, gtid, gsz; };

__device__ __forceinline__ void p0_transpose_item(const float* W, int K, int ldw, int nblk, bf16_t* WT, int row_off, LAS float* scr, int item, int lane) {
    const int kb = item / nblk, nb = item % nblk, k0 = 64 * kb, n0 = 32 * nb;
#pragma unroll 8
    for (int i = 0; i < 32; ++i) { const int kk = 2 * i + (lane >> 5); scr[kk * 33 + (lane & 31)] = W[(size_t)(k0 + kk) * ldw + n0 + (lane & 31)]; }
    LDS_WAIT(); asm volatile("" ::: "memory");
    const int c = lane & 7;
#pragma unroll
    for (int j = 0; j < 4; ++j) { const int n = (lane >> 3) + 8 * j; const LAS float* s = scr + (8 * c) * 33 + n;
        u32x4 o; o.x = pk2(s[0 * 33], s[1 * 33]); o.y = pk2(s[2 * 33], s[3 * 33]); o.z = pk2(s[4 * 33], s[5 * 33]); o.w = pk2(s[6 * 33], s[7 * 33]);
        *(u32x4*)(WT + (size_t)(row_off + n0 + n) * K + k0 + 8 * c) = o; }
    LDS_WAIT(); asm volatile("" ::: "memory");
}

__device__ __forceinline__ void phase_prologue(KP p, const Ctx& c) {
    LAS float* scr = (LAS float*)(c.lds + c.wave * 16384);
    unsigned char* ws = p->ws;
    int total = 0;
#define TRCNT(K_, N_) (((K_) / 64) * ((N_) / 32))
    constexpr int C_DD = TRCNT(1024, 1024), C_L64 = TRCNT(1024, 64), C_L32 = TRCNT(1024, 32), C_L128 = TRCNT(1024, 128), C_2_64 = TRCNT(64, 1024), C_2_128 = TRCNT(128, 1024);
    constexpr int C_KV = TRCNT(1024, 1536), C_Q = 16 * 33, C_IN = TRCNT(1024, 5632), C_OUT = TRCNT(2816, 1024), C_CW = TRCNT(1024, 128);
    constexpr int NITEMS = 2 * (4 * C_DD + 2 * C_L64 + C_L128 + 2 * C_2_64 + C_2_128) + C_L32 + C_KV + 2 * C_Q + 2 * C_DD + 4 * C_IN + 4 * C_OUT + 4 * C_CW;
    (void)total;
    for (int it = c.gw; it < NITEMS; it += c.ngw) {
        int r = it;
#define TR(Wp, K_, LDW_, NBLK_, WTp, ROWOFF_) { const int cnt_ = ((K_) / 64) * (NBLK_); if (r < cnt_) { p0_transpose_item((Wp), (K_), (LDW_), (NBLK_), (bf16_t*)(WTp), (ROWOFF_), scr, r, c.lane); continue; } r -= cnt_; }
        bool done = false;
#pragma unroll
        for (int l = 0; l < 2; ++l) {
            if (done) break;
            const size_t dd = (size_t)l * 1024 * 1024;
#define TRL(Wp, K_, LDW_, NBLK_, WTp, ROWOFF_) { const int cnt_ = ((K_) / 64) * (NBLK_); if (!done) { if (r < cnt_) { p0_transpose_item((Wp), (K_), (LDW_), (NBLK_), (bf16_t*)(WTp), (ROWOFF_), scr, r, c.lane); done = true; } else r -= cnt_; } }
            TRL(p->in[I_WR] + dd, 1024, 1024, 32, ws + WS_WRKV + (size_t)l * 3072 * 1024 * 2, 0)
            TRL(p->in[I_WK] + dd, 1024, 1024, 32, ws + WS_WRKV + (size_t)l * 3072 * 1024 * 2, 1024)
            TRL(p->in[I_WV] + dd, 1024, 1024, 32, ws + WS_WRKV + (size_t)l * 3072 * 1024 * 2, 2048)
            TRL(p->in[I_WO] + dd, 1024, 1024, 32, ws + WS_WORW + (size_t)l * 1024 * 1024 * 2, 0)
            TRL(p->in[I_W1] + (size_t)l * 1024 * 64, 1024, 64, 2, ws + WS_W1T + (size_t)l * 288 * 1024 * 2, 0)
            TRL(p->in[I_A1] + (size_t)l * 1024 * 64, 1024, 64, 2, ws + WS_W1T + (size_t)l * 288 * 1024 * 2, 64)
            TRL(p->in[I_G1] + (size_t)l * 1024 * 128, 1024, 128, 4, ws + WS_W1T + (size_t)l * 288 * 1024 * 2, 160)
            TRL(p->in[I_W2] + (size_t)l * 64 * 1024, 64, 1024, 32, ws + WS_W2W + (size_t)l * 1024 * 64 * 2, 0)
            TRL(p->in[I_A2] + (size_t)l * 64 * 1024, 64, 1024, 32, ws + WS_W2A + (size_t)l * 1024 * 64 * 2, 0)
            TRL(p->in[I_G2] + (size_t)l * 128 * 1024, 128, 1024, 32, ws + WS_W2G + (size_t)l * 1024 * 128 * 2, 0)
        }
        if (done) continue;
        TR(p->in[I_V1], 1024, 32, 1, ws + WS_W1T + (size_t)1 * 288 * 1024 * 2, 128)
        TR(p->in[I_WKV], 1024, 1536, 48, ws + WS_WKVT, 0)
        TR(p->in[I_WQ], 1024, NQ, 33, ws + WS_WQT, 0)
        TR(p->in[I_WQ] + (size_t)1024 * NQ, 1024, NQ, 33, ws + WS_WQT + (size_t)NQP * 1024 * 2, 0)
        TR(p->in[I_WONSA], 1024, 1024, 32, ws + WS_WONSA, 0)
        TR(p->in[I_WONSA] + (size_t)1024 * 1024, 1024, 1024, 32, ws + WS_WONSA + (size_t)1024 * 1024 * 2, 0)
#pragma unroll
        for (int l = 0; l < 4; ++l) {
            if (done) break;
            TRL(p->in[I_WIN] + (size_t)l * 1024 * 5632, 1024, 5632, 176, ws + WS_WINT + (size_t)l * 5632 * 1024 * 2, 0)
            TRL(p->in[I_WOUT] + (size_t)l * 2816 * 1024, 2816, 1024, 32, ws + WS_WOUTT + (size_t)l * 1024 * 2816 * 2, 0)
        }
        if (done) continue;
        TR(p->in[I_CW1], 1024, 128, 4, ws + WS_CW1T, 0)
        TR(p->in[I_CW1] + (size_t)1024 * 128, 1024, 128, 4, ws + WS_CW1T, 128)
        TR(p->in[I_CW1] + (size_t)2048 * 128, 1024, 128, 4, ws + WS_CW1T + (size_t)256 * 1024 * 2, 0)
        TR(p->in[I_CW1] + (size_t)3072 * 128, 1024, 128, 4, ws + WS_CW1T + (size_t)256 * 1024 * 2, 128)
#undef TR
#undef TRL
    }
    {
        bf16_t* WQT = (bf16_t*)(ws + WS_WQT);
        for (int e = c.gtid; e < 2 * 224 * 1024; e += c.gsz) { const int k = e & 1023, n = 1056 + ((e >> 10) % 224), l = e / (224 * 1024);
            WQT[((size_t)l * NQP + n) * 1024 + k] = n < NQ ? (bf16_t)f2bf(p->in[I_WQ][((size_t)l * 1024 + k) * NQ + n]) : (bf16_t)0; }
        bf16_t* W2V = (bf16_t*)(ws + WS_W2V);
        for (int e = c.gtid; e < 32 * 1024; e += c.gsz) { const int n = e & 1023, k = e >> 10; W2V[n * 32 + k] = (bf16_t)f2bf(p->in[I_V2][k * 1024 + n]); }
    }
    { bf16_t* W2T = (bf16_t*)(ws + WS_CW2T);
      for (int e = c.gtid; e < 2 * 128 * 64; e += c.gsz) { const int d = e & 63, q = (e >> 6) & 127, kv = e >> 13; const float w = p->in[I_CW2][e];
          const unsigned hi = f2bf(w), lo = f2bf(w - __builtin_bit_cast(float, hi << 16)); W2T[(size_t)(kv * 64 + d) * 128 + q] = (bf16_t)hi; W2T[(size_t)2 * 64 * 128 + (size_t)(kv * 64 + d) * 128 + q] = (bf16_t)lo; } }
    for (int it = c.gw; it < 256; it += c.ngw) { const int kv = it >> 7, h = it & 127; float s = 0.f;
        for (int kk = c.lane; kk < 2048; kk += 64) s += p->in[I_PE][kv * 2048 + kk] * p->in[I_CW1][((size_t)kv * 2048 + kk) * 128 + h];
        s = wave_sum(s); if (c.lane == 0) ((float*)(ws + WS_CBIAS))[it] = s + p->in[I_CB1][it]; }
    { const f32x4* xp = (const f32x4*)p->in[I_XP]; const f32x4* xs = (const f32x4*)p->in[I_XS]; f32x4* o = (f32x4*)(p->out + O_Y);
      for (int e = c.gtid; e < R * D / 4; e += c.gsz) o[e] = e < MP * D / 4 ? xp[e] : xs[e - MP * D / 4]; }
}

__device__ __forceinline__ void phase_fill(KP p, const Ctx& c, int li, const int gwf, const int ngwf) {
    unsigned char* ws = p->ws;
    { const int* pt = (const int*)p->in[I_PT]; bf16_t* CA = (bf16_t*)(ws + WS_CMPA); const int part = li;
      for (int it = gwf; it < SB * 128 * 4; it += ngwf) { const int s4 = 4 * (it & 3), n = (it >> 2) & 127, b = it >> 9;
          const int page = pt[b * NPAGES + (n >> 3)]; const float* src = p->in[I_CKV] + ((size_t)page * PAGE + (n & 7) * 16 + s4) * 1024 + part * 256;
          f32x4 v[4];
#pragma unroll
          for (int e = 0; e < 4; ++e) v[e] = __builtin_nontemporal_load(((const f32x4*)(src + (size_t)e * 1024)) + c.lane);
          const int g = c.lane >> 4, d0 = 4 * (c.lane & 15); bf16_t* dst = CA + ((size_t)8192 + (size_t)part * 65536 + (size_t)(b * 4 + g) * 128 + n) * 1024 + s4 * 64 + d0;
#pragma unroll
          for (int e = 0; e < 4; ++e) { u32x2 w; w.x = pk2(v[e][0], v[e][1]); w.y = pk2(v[e][2], v[e][3]); *(u32x2*)(dst + e * 64) = w; } } }
    { const f32x4* src = (const f32x4*)p->in[I_CWIN]; f32x4* dst = (f32x4*)(p->out + O_WINS); constexpr int HALF_N = SB * 508 * 128 / 2;
      for (int e0 = li * HALF_N + gwf * 256 + c.lane; e0 < (li + 1) * HALF_N; e0 += ngwf * 256) { f32x4 v[4];
#pragma unroll
          for (int q = 0; q < 4; ++q) { const int e = e0 + 64 * q; if (e < (li + 1) * HALF_N) { const int b = e / (508 * 128), rr = e % (508 * 128); v[q] = __builtin_nontemporal_load(src + (size_t)b * 512 * 128 + 4 * 128 + rr); } }
#pragma unroll
          for (int q = 0; q < 4; ++q) { const int e = e0 + 64 * q; if (e < (li + 1) * HALF_N) { const int b = e / (508 * 128), rr = e % (508 * 128); __builtin_nontemporal_store(v[q], dst + (size_t)b * 512 * 128 + rr); } } } }
}

template <int NT> __device__ __forceinline__ void skinny_mma(const bf16_t* A, int lda, const bf16_t* Wt, int ldw, int K, int row0, int col0, int lane, f32x4 (&acc)[NT][2]) {
    const int fr = lane & 15, fq = lane >> 4;
#pragma unroll
    for (int nt = 0; nt < NT; ++nt) { acc[nt][0] = (f32x4){0.f, 0.f, 0.f, 0.f}; acc[nt][1] = (f32x4){0.f, 0.f, 0.f, 0.f}; }
    const bf16_t* xa = A + (size_t)(row0 + fr) * lda + 8 * fq; const bf16_t* xb = xa + (size_t)16 * lda;
    const bf16_t* wa = Wt + (size_t)(col0 + fr) * ldw + 8 * fq;
    const char* pa = (const char*)xa; const char* pb = (const char*)xb; const char* pw[NT];
#pragma unroll
    for (int nt = 0; nt < NT; ++nt) pw[nt] = (const char*)(wa + (size_t)nt * 16 * ldw);
    for (int k4 = 0; k4 < K / 128; ++k4) {
        bf16x8 fb[4][2], fa[4][NT];
#pragma unroll
        for (int u = 0; u < 4; ++u) { fb[u][0] = *(const bf16x8*)(pa + 64 * u); fb[u][1] = *(const bf16x8*)(pb + 64 * u);
#pragma unroll
            for (int nt = 0; nt < NT; ++nt) fa[u][nt] = *(const bf16x8*)(pw[nt] + 64 * u); }
        __builtin_amdgcn_sched_barrier(0);
#pragma unroll
        for (int u = 0; u < 4; ++u)
#pragma unroll
            for (int nt = 0; nt < NT; ++nt) { acc[nt][0] = mfma16(fa[u][nt], fb[u][0], acc[nt][0]); acc[nt][1] = mfma16(fa[u][nt], fb[u][1], acc[nt][1]); }
        pa += 256; pb += 256;
#pragma unroll
        for (int nt = 0; nt < NT; ++nt) pw[nt] += 256;
        __builtin_amdgcn_sched_barrier(0);
    }
}
__device__ __forceinline__ void skinny_resid_sample(const Ctx& c, const bf16_t* A, int lda, const bf16_t* Wt, int K, float* X) {
    const int ln = launder_v(c.lane), fr = ln & 15, fq = ln >> 4;
    for (int it = blockIdx.x + gridDim.x * c.wave; it < 256; it += c.ngw) { const int row0 = MP + 32 * (it & 15), col0 = 64 * (it >> 4);
        f32x4 acc[4][2]; skinny_mma<4>(A, lda, Wt, lda, K, row0, col0, c.lane, acc);
#pragma unroll
        for (int nt = 0; nt < 4; ++nt)
#pragma unroll
            for (int mt = 0; mt < 2; ++mt) { f32x4* q = (f32x4*)(X + (size_t)(row0 + 16 * mt + fr) * D + col0 + 16 * nt + 4 * fq); *q = *q + acc[nt][mt]; } }
}
__device__ __forceinline__ void skinny_store(const Ctx& c, const bf16_t* A, const bf16_t* Wt, int K, float* C, int ldc, int rbase, int nrb, int ncb, int it0, int nit_total) {
    const int fr = c.lane & 15, fq = c.lane >> 4;
    for (int it = c.gw - it0; it < nrb * ncb; it += c.ngw) { if (it < 0) continue; const int row0 = rbase + 32 * (it % nrb), col0 = 64 * (it / nrb);
        f32x4 acc[4][2]; skinny_mma<4>(A, K, Wt, K, K, row0, col0, c.lane, acc);
#pragma unroll
        for (int nt = 0; nt < 4; ++nt)
#pragma unroll
            for (int mt = 0; mt < 2; ++mt) *(f32x4*)(C + (size_t)(row0 + 16 * mt + fr) * ldc + col0 + 16 * nt + 4 * fq) = acc[nt][mt]; }
    (void)nit_total;
}

__device__ __forceinline__ void load_row(const float* p, int lane, f32x4 (&v)[4]) {
#pragma unroll
    for (int j = 0; j < 4; ++j) v[j] = ((const f32x4*)p)[lane + 64 * j];
}
__device__ __forceinline__ float row_rstd(const f32x4 (&v)[4]) {
    float s = 0.f;
#pragma unroll
    for (int j = 0; j < 4; ++j) s += (v[j][0] * v[j][0] + v[j][1] * v[j][1]) + (v[j][2] * v[j][2] + v[j][3] * v[j][3]);
    s = wave_sum(s); return frsq(s * (1.0f / D) + NORM_EPS);
}
__device__ __forceinline__ void store_row_bf16(bf16_t* o, int lane, const f32x4 (&v)[4]) {
#pragma unroll
    for (int j = 0; j < 4; ++j) { u32x2 w; w.x = pk2(v[j][0], v[j][1]); w.y = pk2(v[j][2], v[j][3]); ((u32x2*)o)[lane + 64 * j] = w; }
}

__device__ __forceinline__ void phase_norm(const Ctx& c, const float* X, const float* g1, bf16_t* o1, const float* g2, bf16_t* o2) {
    f32x4 ga[4], gb[4]; load_row(g1, c.lane, ga); if (g2) load_row(g2, c.lane, gb);
    for (int row = c.gw; row < R; row += c.ngw) {
        f32x4 v[4]; load_row(X + (size_t)row * D, c.lane, v); const float rs = row_rstd(v);
        f32x4 y[4];
#pragma unroll
        for (int j = 0; j < 4; ++j) y[j] = v[j] * rs * ga[j];
        store_row_bf16(o1 + (size_t)row * D, c.lane, y);
        if (g2) {
#pragma unroll
            for (int j = 0; j < 4; ++j) y[j] = v[j] * rs * gb[j];
            store_row_bf16(o2 + (size_t)row * D, c.lane, y); }
    }
}

__device__ __forceinline__ void phase_mix(KP p, const Ctx& c, int li) {
    const float* X = p->out + O_Y; const float* gain = p->in[I_NORMG] + (size_t)(li * 2) * D; const float* mu = p->in[I_MU] + (size_t)li * 6 * D;
    bf16_t* XM = (bf16_t*)(p->ws + WS_XM);
    f32x4 ga[4]; load_row(gain, c.lane, ga);
    {
        const int r0 = (int)(((long)c.gw * R) / c.ngw), r1 = (int)(((long)(c.gw + 1) * R) / c.ngw); f32x4 prev[4];
        {
            const bool seq_start = r0 < MP ? ((r0 & (TP - 1)) == 0) : (((r0 - MP) & 3) == 0);
            if (!seq_start && r0 < r1) { f32x4 v[4]; load_row(X + (size_t)(r0 - 1) * D, c.lane, v); const float rs = row_rstd(v);
#pragma unroll
                for (int j = 0; j < 4; ++j) prev[j] = v[j] * rs * ga[j]; }
        }
        for (int row = r0; row < r1; ++row) {
            const bool seq_start = row < MP ? ((row & (TP - 1)) == 0) : (((row - MP) & 3) == 0);
            if (seq_start) {
                if (row < MP) {
#pragma unroll
                    for (int j = 0; j < 4; ++j) prev[j] = (f32x4){0.f, 0.f, 0.f, 0.f}; }
                else load_row(p->in[I_SSHIFT] + ((size_t)li * SB + ((row - MP) >> 2)) * D, c.lane, prev);
            }
            f32x4 v[4]; load_row(X + (size_t)row * D, c.lane, v); const float rs = row_rstd(v);
            f32x4 xn[4];
#pragma unroll
            for (int j = 0; j < 4; ++j) xn[j] = v[j] * rs * ga[j];
#pragma unroll
            for (int m = 0; m < 6; ++m) {
                f32x4 y[4];
#pragma unroll
                for (int j = 0; j < 4; ++j) { const int mi = m == 1 ? 2 : (m == 2 ? 3 : (m == 3 ? 1 : m));
                    const f32x4 mm = ((const f32x4*)(mu + (size_t)mi * D))[c.lane + 64 * j]; y[j] = xn[j] + (prev[j] - xn[j]) * mm; }
                store_row_bf16(XM + ((size_t)m * R + row) * D, c.lane, y);
            }
            const bool seq_end = row < MP ? ((row & (TP - 1)) == TP - 1) : (((row - MP) & 3) == 3);
            if (seq_end) { float* so = row < MP ? p->out + O_SHP + ((size_t)li * NB + (row >> 13)) * D : p->out + O_SHS + ((size_t)li * SB + ((row - MP) >> 2)) * D;
#pragma unroll
                for (int j = 0; j < 4; ++j) ((f32x4*)so)[c.lane + 64 * j] = xn[j]; }
#pragma unroll
            for (int j = 0; j < 4; ++j) prev[j] = xn[j];
        }
    }
}
template <int NT, int ACT> __device__ __forceinline__ void lora1_item(const bf16_t* X, const bf16_t* W, bf16_t* HID, int coloff, int rb, int lane) {
    lane = launder_v(lane);
    const int fr = lane & 15, fq = lane >> 4;
    f32x4 acc[NT][2]; skinny_mma<NT>(X, 1024, W, 1024, 1024, rb * 32, coloff, lane, acc);
#pragma unroll
    for (int nt = 0; nt < NT; ++nt)
#pragma unroll
        for (int mt = 0; mt < 2; ++mt) { f32x4 v = acc[nt][mt];
#pragma unroll
            for (int r = 0; r < 4; ++r) { if (ACT == 1) { const float e = __builtin_amdgcn_exp2f(2.8853900817779268f * v[r]); v[r] = 1.0f - 2.0f * frcp(e + 1.0f); } if (ACT == 2) v[r] = sigmoidf_(v[r]); }
            u32x2 w; w.x = pk2(v[0], v[1]); w.y = pk2(v[2], v[3]);
            *(u32x2*)(HID + (size_t)(rb * 32 + mt * 16 + fr) * LHID + coloff + nt * 16 + 4 * fq) = w; }
}
__device__ __forceinline__ void phase_lora1(KP p, const Ctx& c, int li) {
    const bf16_t* XM = (const bf16_t*)(p->ws + WS_XM); const bf16_t* W = (const bf16_t*)(p->ws + WS_W1T) + (size_t)li * 288 * 1024; bf16_t* HID = (bf16_t*)(p->ws + WS_HID);
    constexpr int NRB = R / 32;
    for (int it = blockIdx.x + gridDim.x * c.wave; it < 5 * NRB; it += c.ngw) { const int q = it / NRB, rb = it % NRB;
        if (q == 0) lora1_item<4, 1>(XM + (size_t)3 * R * D, W, HID, 0, rb, c.lane);
        else if (q == 1) lora1_item<4, 0>(XM + (size_t)4 * R * D, W, HID, 64, rb, c.lane);
        else if (q == 2) { if (li == 1) lora1_item<2, 0>(XM + (size_t)2 * R * D, W, HID, 128, rb, c.lane); }
        else if (q == 3) lora1_item<4, 2>(XM + (size_t)5 * R * D, W, HID, 160, rb, c.lane);
        else lora1_item<4, 2>(XM + (size_t)5 * R * D, W, HID, 224, rb, c.lane);
    }
}

constexpr int SST = 72, MAT = 64 * SST * 2;
constexpr int O_AT = 0, O_BT = MAT, O_KT = 2 * MAT, O_RT = 3 * MAT, O_VT = 4 * MAT, O_BH = 5 * MAT, O_KH = 6 * MAT, O_XT = 7 * MAT, O_AAB = 9 * MAT, O_AAK = 10 * MAT, O_ARB = 11 * MAT, O_ARK = 12 * MAT;
constexpr int O_TD = 13 * MAT, O_SCR = O_TD + 2048, O_CS = O_SCR + 4096, O_WC = O_CS + 2048, O_LW = O_XT, O_LA = O_XT + 16384, O_LV = O_XT + 32768;
static_assert(O_WC + 256 <= RING_BYTES && O_LV + 16384 <= O_TD, "scan LDS map");
__device__ __forceinline__ bf16x8 ldsfrag(LAS unsigned char* lds, int off, int row, int col) { return *(const LAS bf16x8*)(lds + off + (row * SST + col) * 2); }
__device__ __forceinline__ void lds_st4(LAS unsigned char* lds, int off, int row, int col, f32x4 v) { u32x2 w; w.x = pk2(v[0], v[1]); w.y = pk2(v[2], v[3]); *(LAS u32x2*)(lds + off + (row * SST + col) * 2) = w; }
__device__ __forceinline__ f32x4 lds_ld4(LAS unsigned char* lds, int off, int row, int col) { const u32x2 w = *(const LAS u32x2*)(lds + off + (row * SST + col) * 2); return (f32x4){bflo(w.x), bfhi(w.x), bflo(w.y), bfhi(w.y)}; }

__device__ __forceinline__ void scanA_unit(KP p, const Ctx& c, int li, int u) {
    LAS unsigned char* lds = c.lds; unsigned char* ws = p->ws; const int stop = p->pad;
    const int lane = c.lane, wave = c.wave, fr = lane & 15, fq = lane >> 4;
    const int b = u / (NCH * H), n = (u / H) % NCH, h = u % H, row0 = b * TP + 64 * n;
    const float* Rb = (const float*)(ws + WS_RK_R); const float* Kb = (const float*)(ws + WS_RK_K);
    float* Vb = (float*)(ws + (li ? WS_V1 : WS_V0)); const float* V0b = (const float*)(ws + WS_V0);
    const bf16_t* HID = (const bf16_t*)(ws + WS_HID);
    {
        const int tt = wave & 3, chh = wave >> 2;
        const bf16_t* hrow = launder_p(HID + (size_t)(row0 + 16 * tt + fr) * LHID + 8 * fq);
        const bf16_t* W2W = (const bf16_t*)(ws + WS_W2W) + (size_t)li * 1024 * 64; const bf16_t* W2A = (const bf16_t*)(ws + WS_W2A) + (size_t)li * 1024 * 64; const bf16_t* W2V = (const bf16_t*)(ws + WS_W2V);
#pragma unroll
        for (int cti = 0; cti < 2; ++cti) { const int ct = 2 * chh + cti, C = 64 * h + 16 * ct + fr;
            f32x4 aw = {0.f, 0.f, 0.f, 0.f}, aa = {0.f, 0.f, 0.f, 0.f}, av = {0.f, 0.f, 0.f, 0.f};
#pragma unroll
            for (int ks = 0; ks < 2; ++ks) {
                aw = mfma16(*(const bf16x8*)(W2W + (size_t)C * 64 + 32 * ks + 8 * fq), *(const bf16x8*)(hrow + 32 * ks), aw);
                aa = mfma16(*(const bf16x8*)(W2A + (size_t)C * 64 + 32 * ks + 8 * fq), *(const bf16x8*)(hrow + 64 + 32 * ks), aa); }
            if (li) av = mfma16(*(const bf16x8*)(W2V + (size_t)C * 32 + 8 * fq), *(const bf16x8*)(hrow + 128), av);
            const int t = 16 * tt + fr, cc = 16 * ct + 4 * fq;
            *(LAS f32x4*)(lds + O_LW + (t * 64 + cc) * 4) = aw; *(LAS f32x4*)(lds + O_LA + (t * 64 + cc) * 4) = aa; *(LAS f32x4*)(lds + O_LV + (t * 64 + cc) * 4) = av; }
    }
    __syncthreads();
    if (stop == 1) return;
    {
        const int cc = lane, tq = wave, C = 64 * h + cc; const size_t pc = (size_t)li * D + C;
        const float w0 = p->in[I_W0][pc], a0 = p->in[I_A0][pc], kkc = p->in[I_KK][pc], kac = p->in[I_KA][pc], rkc = p->in[I_RKK][pc], v0 = li ? p->in[I_V0][C] : 0.f;
        float wlg[8], Lin[8], rr[8], k2[8], vv[8], aa[8], bb[8], rk8[8]; float run = 0.f;
        float r8[8], k8[8], v8[8], f8[8];
#pragma unroll
        for (int e = 0; e < 8; ++e) { const size_t gi = (size_t)(row0 + 8 * tq + e) * D + C; r8[e] = Rb[gi]; k8[e] = Kb[gi]; v8[e] = Vb[gi]; f8[e] = V0b[gi]; }
#pragma unroll
        for (int e = 0; e < 8; ++e) { const int t = 8 * tq + e;
            const float r = r8[e], k = k8[e]; float v = v8[e];
            const float lw = *(const LAS float*)(lds + O_LW + (t * 64 + cc) * 4), la = *(const LAS float*)(lds + O_LA + (t * 64 + cc) * 4), lv = *(const LAS float*)(lds + O_LV + (t * 64 + cc) * 4);
            const float z = -(w0 + lw); const float sp = fmaxf(z, 0.f) + __logf(1.0f + __expf(-fabsf(z))); const float wl = -__expf(-sp - 0.5f);
            const float asig = sigmoidf_(a0 + la);
            { const float vg = sigmoidf_(v0 + lv); const float vm = v + (f8[e] - v) * vg; v = li ? vm : v; }
            const float kkr = k * kkc; const float ss = wave_sum(kkr * kkr); const float kkn = kkr * frsq(fmaxf(ss, 1e-24f));
            const float kmod = k * (1.0f + (asig - 1.0f) * kac);
            rk8[e] = wave_sum(r * kmod * rkc);
            run += wl; wlg[e] = wl; Lin[e] = run; rr[e] = r; k2[e] = kmod; vv[e] = v; aa[e] = -kkn; bb[e] = kkn * asig; }
        if (li) {
#pragma unroll
            for (int e = 0; e < 8; ++e) Vb[(size_t)(row0 + 8 * tq + e) * D + C] = vv[e]; }
        if (cc == 0) {
#pragma unroll
            for (int e = 0; e < 8; ++e) ((float*)(ws + WS_RKS))[(size_t)(row0 + 8 * tq + e) * 16 + h] = rk8[e]; }
        *(LAS float*)(lds + O_CS + (tq * 64 + cc) * 4) = run;
        __syncthreads();
        float off = 0.f, tot = 0.f;
#pragma unroll
        for (int q = 0; q < 8; ++q) { const float x = *(const LAS float*)(lds + O_CS + (q * 64 + cc) * 4); tot += x; if (q < tq) off += x; }
        u32x4 wa, wv, wb, wk; unsigned pa[8], pv[8], pb[8], pk[8];
#pragma unroll
        for (int e = 0; e < 8; ++e) { const int t = 8 * tq + e; const float L = off + Lin[e], Lp = L - wlg[e];
            const float eL = __expf(L), eLp = __expf(Lp), enL = __expf(-L), eT = __expf(tot - L);
            const float at = aa[e] * eLp, bt = bb[e] * enL, kt = k2[e] * enL, rt = rr[e] * eL, bh = bb[e] * eT, kh = k2[e] * eT;
            *(LAS bf16_t*)(lds + O_AT + (t * SST + cc) * 2) = (bf16_t)f2bf(at); *(LAS bf16_t*)(lds + O_BT + (t * SST + cc) * 2) = (bf16_t)f2bf(bt);
            *(LAS bf16_t*)(lds + O_KT + (t * SST + cc) * 2) = (bf16_t)f2bf(kt); *(LAS bf16_t*)(lds + O_RT + (t * SST + cc) * 2) = (bf16_t)f2bf(rt);
            pa[e] = f2bf(at); pv[e] = f2bf(vv[e]); pb[e] = f2bf(bh); pk[e] = f2bf(kh); }
        wa = (u32x4){pa[0] | (pa[1] << 16), pa[2] | (pa[3] << 16), pa[4] | (pa[5] << 16), pa[6] | (pa[7] << 16)};
        wv = (u32x4){pv[0] | (pv[1] << 16), pv[2] | (pv[3] << 16), pv[4] | (pv[5] << 16), pv[6] | (pv[7] << 16)};
        wb = (u32x4){pb[0] | (pb[1] << 16), pb[2] | (pb[3] << 16), pb[4] | (pb[5] << 16), pb[6] | (pb[7] << 16)};
        wk = (u32x4){pk[0] | (pk[1] << 16), pk[2] | (pk[3] << 16), pk[4] | (pk[5] << 16), pk[6] | (pk[7] << 16)};
        *(LAS u32x4*)(lds + O_XT + (cc * SST + 8 * tq) * 2) = wa; *(LAS u32x4*)(lds + O_VT + (cc * SST + 8 * tq) * 2) = wv;
        *(LAS u32x4*)(lds + O_BH + (cc * SST + 8 * tq) * 2) = wb; *(LAS u32x4*)(lds + O_KH + (cc * SST + 8 * tq) * 2) = wk;
        if (tq == 0) *(LAS float*)(lds + O_WC + cc * 4) = __expf(tot);
    }
    __syncthreads();
    if (stop == 2) return;
    {
        const int mi = wave >> 1, ph = wave & 1; const int oY = (mi & 1) ? O_KT : O_BT, oX = (mi < 2) ? O_AT : O_RT; const bool strict = mi < 2;
        const int oO = mi == 0 ? O_AAB : (mi == 1 ? O_AAK : (mi == 2 ? O_ARB : O_ARK));
#pragma unroll
        for (int sti = 0; sti < 2; ++sti) { const int st = 2 * ph + sti;
#pragma unroll
            for (int tt = 0; tt < 4; ++tt) { f32x4 acc = {0.f, 0.f, 0.f, 0.f};
                if (st <= tt) {
#pragma unroll
                    for (int ks = 0; ks < 2; ++ks) acc = mfma16(ldsfrag(lds, oY, 16 * st + fr, 32 * ks + 8 * fq), ldsfrag(lds, oX, 16 * tt + fr, 32 * ks + 8 * fq), acc);
                    const int t = 16 * tt + fr;
#pragma unroll
                    for (int r = 0; r < 4; ++r) { const int s = 16 * st + 4 * fq + r; const bool keep = strict ? (s < t) : (s <= t); acc[r] = keep ? acc[r] : 0.f; } }
                if (st <= tt) lds_st4(lds, oO, 16 * tt + fr, 16 * st + 4 * fq, acc);
                else { u32x2 zz; int z0 = 0; asm volatile("" : "+v"(z0)); zz.x = (unsigned)z0; zz.y = (unsigned)z0; *(LAS u32x2*)(lds + oO + ((16 * tt + fr) * SST + 16 * st + 4 * fq) * 2) = zz; } } }
    }
    __syncthreads();
    if (stop == 3) return;
    {
        const int tt = wave & 3, ih = wave >> 2;
#pragma unroll
        for (int iti = 0; iti < 2; ++iti) { const int it = 2 * ih + iti; f32x4 acc = {0.f, 0.f, 0.f, 0.f};
#pragma unroll
            for (int ks = 0; ks < 2; ++ks) acc = mfma16(ldsfrag(lds, O_AAK, 16 * tt + fr, 32 * ks + 8 * fq), ldsfrag(lds, O_VT, 16 * it + fr, 32 * ks + 8 * fq), acc);
            lds_st4(lds, O_XT, 64 + 16 * it + fr, 16 * tt + 4 * fq, acc); }
        if (wave < 4 && lane < 16) { const int I = wave; float x[16];
#pragma unroll
            for (int t = 0; t < 16; ++t) { float s = (t == lane) ? 1.0f : 0.0f;
#pragma unroll
                for (int q = 0; q < t; ++q) s += bf2f(*(const LAS bf16_t*)(lds + O_AAB + ((16 * I + t) * SST + 16 * I + q) * 2)) * x[q];
                x[t] = s; *(LAS bf16_t*)(lds + O_TD + ((I * 16 + t) * 16 + lane) * 2) = (bf16_t)f2bf(s); } }
    }
    __syncthreads();
    if (stop == 5) return;
    {
        const int colb = 16 * wave; const bf16x8 zero8 = {0, 0, 0, 0, 0, 0, 0, 0};
#pragma unroll
        for (int I = 0; I < 4; ++I) {
            f32x4 acc = lds_ld4(lds, O_XT, colb + fr, 16 * I + 4 * fq);
#pragma unroll
            for (int ks = 0; ks < 2; ++ks) if (32 * ks < 16 * I) { const bool ok = (32 * ks + 8 * fq) < 16 * I;
                const bf16x8 a = ok ? ldsfrag(lds, O_AAB, 16 * I + fr, 32 * ks + 8 * fq) : zero8, bq = ok ? ldsfrag(lds, O_XT, colb + fr, 32 * ks + 8 * fq) : zero8;
                acc = mfma16(a, bq, acc); }
            { u32x2 w; w.x = pk2(acc[0], acc[1]); w.y = pk2(acc[2], acc[3]); *(LAS u32x2*)(lds + O_SCR + wave * 512 + (fr * 16 + 4 * fq) * 2) = w; }
            LDS_WAIT();
            const bf16x8 ta = fq < 2 ? *(const LAS bf16x8*)(lds + O_TD + ((I * 16 + fr) * 16 + 8 * fq) * 2) : zero8;
            const bf16x8 tb = fq < 2 ? *(const LAS bf16x8*)(lds + O_SCR + wave * 512 + (fr * 16 + 8 * fq) * 2) : zero8;
            const f32x4 res = mfma16(ta, tb, (f32x4){0.f, 0.f, 0.f, 0.f});
            lds_st4(lds, O_XT, colb + fr, 16 * I + 4 * fq, res);
            LDS_WAIT();
        }
    }
    __syncthreads();
    if (stop == 6) return;
    {
        const int tb = wave & 3, hb = wave >> 2;
        bf16_t* RP = (bf16_t*)(ws + WS_RP) + (size_t)u * 4096; float* YL = (float*)(ws + WS_YL) + (size_t)u * 4096;
        bf16_t* MTH = (bf16_t*)(ws + WS_MT) + (size_t)u * 4096; bf16_t* MTL = MTH + (size_t)NUNIT_A * 4096; float* NN = (float*)(ws + WS_NN) + (size_t)u * 4096;
#pragma unroll
        for (int qi = 0; qi < 2; ++qi) { const int rt = 2 * hb + qi;
            { f32x4 acc = lds_ld4(lds, O_RT, 16 * tb + fr, 16 * rt + 4 * fq);
#pragma unroll
              for (int ks = 0; ks < 2; ++ks) acc = mfma16(ldsfrag(lds, O_XT, 16 * rt + fr, 32 * ks + 8 * fq), ldsfrag(lds, O_ARB, 16 * tb + fr, 32 * ks + 8 * fq), acc);
              u32x2 w; w.x = pk2(acc[0], acc[1]); w.y = pk2(acc[2], acc[3]); *(u32x2*)(RP + (size_t)(16 * tb + fr) * 64 + 16 * rt + 4 * fq) = w; }
            { f32x4 acc = {0.f, 0.f, 0.f, 0.f};
#pragma unroll
              for (int ks = 0; ks < 2; ++ks) { acc = mfma16(ldsfrag(lds, O_XT, 64 + 16 * rt + fr, 32 * ks + 8 * fq), ldsfrag(lds, O_ARB, 16 * tb + fr, 32 * ks + 8 * fq), acc);
                  acc = mfma16(ldsfrag(lds, O_VT, 16 * rt + fr, 32 * ks + 8 * fq), ldsfrag(lds, O_ARK, 16 * tb + fr, 32 * ks + 8 * fq), acc); }
              *(f32x4*)(YL + (size_t)(16 * tb + fr) * 64 + 16 * rt + 4 * fq) = acc; }
            { f32x4 acc = {0.f, 0.f, 0.f, 0.f};
#pragma unroll
              for (int ks = 0; ks < 2; ++ks) acc = mfma16(ldsfrag(lds, O_XT, 16 * rt + fr, 32 * ks + 8 * fq), ldsfrag(lds, O_BH, 16 * tb + fr, 32 * ks + 8 * fq), acc);
              const int j = 16 * tb + fr; const float wc = *(const LAS float*)(lds + O_WC + j * 4);
#pragma unroll
              for (int r = 0; r < 4; ++r) if (16 * rt + 4 * fq + r == j) acc[r] += wc;
              unsigned hh[4], ll[4];
#pragma unroll
              for (int r = 0; r < 4; ++r) { hh[r] = f2bf(acc[r]); ll[r] = f2bf(acc[r] - __builtin_bit_cast(float, hh[r] << 16)); }
              *(u32x2*)(MTH + (size_t)j * 64 + 16 * rt + 4 * fq) = (u32x2){hh[0] | (hh[1] << 16), hh[2] | (hh[3] << 16)};
              *(u32x2*)(MTL + (size_t)j * 64 + 16 * rt + 4 * fq) = (u32x2){ll[0] | (ll[1] << 16), ll[2] | (ll[3] << 16)}; }
            { f32x4 acc = {0.f, 0.f, 0.f, 0.f};
#pragma unroll
              for (int ks = 0; ks < 2; ++ks) { acc = mfma16(ldsfrag(lds, O_BH, 16 * rt + fr, 32 * ks + 8 * fq), ldsfrag(lds, O_XT, 64 + 16 * tb + fr, 32 * ks + 8 * fq), acc);
                  acc = mfma16(ldsfrag(lds, O_KH, 16 * rt + fr, 32 * ks + 8 * fq), ldsfrag(lds, O_VT, 16 * tb + fr, 32 * ks + 8 * fq), acc); }
              *(f32x4*)(NN + (size_t)(16 * tb + fr) * 64 + 16 * rt + 4 * fq) = acc; }
        }
    }
    __syncthreads();
}

__device__ __forceinline__ void scan_sample_item(KP p, const Ctx& c, int li, int item) {
    unsigned char* ws = p->ws; const int lane = c.lane, b = item >> 4, h = item & 15, C = 64 * h + lane; const size_t pc = (size_t)li * D + C;
    LAS float* sc = (LAS float*)(c.lds + c.wave * 16384);
    const float* Rb = (const float*)(ws + WS_RK_R); const float* Kb = (const float*)(ws + WS_RK_K);
    float* Vb = (float*)(ws + (li ? WS_V1 : WS_V0)); const float* V0b = (const float*)(ws + WS_V0);
    const bf16_t* HID = (const bf16_t*)(ws + WS_HID) + (size_t)(MP + 4 * b) * LHID;
    for (int e = lane; e < 4 * LHID; e += 64) sc[e] = bf2f(HID[e]);
    LDS_WAIT();
    float lw[4] = {0.f, 0.f, 0.f, 0.f}, la[4] = {0.f, 0.f, 0.f, 0.f}, lv[4] = {0.f, 0.f, 0.f, 0.f}, lg[4] = {0.f, 0.f, 0.f, 0.f};
    {
        const bf16_t* W2W = (const bf16_t*)(ws + WS_W2W) + ((size_t)li * 1024 + C) * 64; const bf16_t* W2A = (const bf16_t*)(ws + WS_W2A) + ((size_t)li * 1024 + C) * 64;
        const bf16_t* W2V = (const bf16_t*)(ws + WS_W2V) + (size_t)C * 32; const bf16_t* W2G = (const bf16_t*)(ws + WS_W2G) + ((size_t)li * 1024 + C) * 128;
#define LORA2_BLK(WP, QB, HOFF, ACC) { const u32x4 w8 = *(const u32x4*)((WP) + 8 * (QB)); \
            const float wf0 = bflo(w8.x), wf1 = bfhi(w8.x), wf2 = bflo(w8.y), wf3 = bfhi(w8.y), wf4 = bflo(w8.z), wf5 = bfhi(w8.z), wf6 = bflo(w8.w), wf7 = bfhi(w8.w); \
            _Pragma("unroll") for (int t = 0; t < 4; ++t) { const f32x4 h0 = *(const LAS f32x4*)(sc + t * LHID + (HOFF) + 8 * (QB)), h1 = *(const LAS f32x4*)(sc + t * LHID + (HOFF) + 8 * (QB) + 4); \
                ACC[t] += (h0[0] * wf0 + h0[1] * wf1) + (h0[2] * wf2 + h0[3] * wf3) + (h1[0] * wf4 + h1[1] * wf5) + (h1[2] * wf6 + h1[3] * wf7); } \
            asm volatile("" : "+v"(ACC[0]), "+v"(ACC[1]), "+v"(ACC[2]), "+v"(ACC[3]) :: "memory"); }
#pragma unroll
        for (int qb = 0; qb < 8; ++qb) { LORA2_BLK(W2W, qb, 0, lw) LORA2_BLK(W2A, qb, 64, la) }
        if (li) {
#pragma unroll
            for (int qb = 0; qb < 4; ++qb) LORA2_BLK(W2V, qb, 128, lv) }
#pragma unroll
        for (int qb = 0; qb < 16; ++qb) LORA2_BLK(W2G, qb, 160, lg)
#undef LORA2_BLK
    }
    const float w0 = p->in[I_W0][pc], a0 = p->in[I_A0][pc], kkc = p->in[I_KK][pc], kac = p->in[I_KA][pc], rkc = p->in[I_RKK][pc], v0 = li ? p->in[I_V0][C] : 0.f;
    const float lnw = p->in[I_LNW][pc], lnb = p->in[I_LNB][pc];
    float S[64];
    { const f32x4* sp = (const f32x4*)(p->in[I_SWKV] + (((size_t)li * SB + b) * H + h) * 4096 + lane * 64);
#pragma unroll
      for (int q = 0; q < 16; ++q) { const f32x4 x = sp[q]; S[4 * q] = x[0]; S[4 * q + 1] = x[1]; S[4 * q + 2] = x[2]; S[4 * q + 3] = x[3]; } }
    LAS float* bc = sc + 1280;
    bf16_t* YG = (bf16_t*)(ws + WS_YG);
#pragma unroll
    for (int t = 0; t < 4; ++t) { const size_t gi = (size_t)(MP + 4 * b + t) * D + C;
        const float r = Rb[gi], k = Kb[gi]; float v = Vb[gi];
        const float z = -(w0 + lw[t]); const float sp = fmaxf(z, 0.f) + __logf(1.0f + __expf(-fabsf(z))); const float wdec = __expf(-__expf(-sp - 0.5f));
        const float asig = sigmoidf_(a0 + la[t]);
        if (li) { const float vg = sigmoidf_(v0 + lv[t]); const float vf = V0b[gi]; v = v + (vf - v) * vg; }
        const float kkr = k * kkc; const float ss = wave_sum(kkr * kkr); const float kkn = kkr * frsq(fmaxf(ss, 1e-24f));
        const float kmod = k * (1.0f + (asig - 1.0f) * kac);
        const float rks = wave_sum(r * kmod * rkc);
        LDS_WAIT();
        bc[lane] = wdec; bc[64 + lane] = -kkn; bc[128 + lane] = kkn * asig; bc[192 + lane] = kmod; bc[256 + lane] = r;
        LDS_WAIT();
        float sa = 0.f;
#pragma unroll
        for (int q = 0; q < 16; ++q) { const f32x4 av = *(const LAS f32x4*)(bc + 64 + 4 * q); sa += S[4 * q] * av[0] + S[4 * q + 1] * av[1] + S[4 * q + 2] * av[2] + S[4 * q + 3] * av[3]; }
        float y = 0.f;
#pragma unroll
        for (int q = 0; q < 16; ++q) { const f32x4 wv = *(const LAS f32x4*)(bc + 4 * q), bv = *(const LAS f32x4*)(bc + 128 + 4 * q), kv = *(const LAS f32x4*)(bc + 192 + 4 * q), rv = *(const LAS f32x4*)(bc + 256 + 4 * q);
#pragma unroll
            for (int e = 0; e < 4; ++e) { const float s = S[4 * q + e] * wv[e] + sa * bv[e] + v * kv[e]; S[4 * q + e] = s; y += s * rv[e]; } }
        const float mean = wave_sum(y) * (1.0f / 64.0f); const float dy = y - mean; const float var = wave_sum(dy * dy) * (1.0f / 64.0f);
        const float yn = dy * (frsq(var + GN_EPS)) * lnw + lnb;
        YG[gi] = (bf16_t)f2bf((yn + rks * v) * lg[t]);
    }
    { f32x4* so = (f32x4*)(p->out + O_WKVS + (((size_t)li * SB + b) * H + h) * 4096 + lane * 64);
#pragma unroll
      for (int q = 0; q < 16; ++q) so[q] = (f32x4){S[4 * q], S[4 * q + 1], S[4 * q + 2], S[4 * q + 3]}; }
    LDS_WAIT();
}

__device__ __forceinline__ void phase_scanA(KP p, const Ctx& c, int li) {
    const int stop = p->pad;
    if (stop != 9) for (int u = blockIdx.x; u < NUNIT_A; u += gridDim.x) scanA_unit(p, c, li, u);
    if (stop == 0 || stop == 9) for (int it = c.gw; it < SB * H; it += c.ngw) scan_sample_item(p, c, li, it);
}

__device__ __forceinline__ void hilo(const f32x4 x0, const f32x4 x1, bf16x8& hi, bf16x8& lo) {
    unsigned h[8], l[8];
#pragma unroll
    for (int e = 0; e < 8; ++e) { const float x = e < 4 ? x0[e] : x1[e - 4]; h[e] = f2bf(x); l[e] = f2bf(x - __builtin_bit_cast(float, h[e] << 16)); }
    u32x4 hv = {h[0] | (h[1] << 16), h[2] | (h[3] << 16), h[4] | (h[5] << 16), h[6] | (h[7] << 16)}, lv = {l[0] | (l[1] << 16), l[2] | (l[3] << 16), l[4] | (l[5] << 16), l[6] | (l[7] << 16)};
    hi = __builtin_bit_cast(bf16x8, hv); lo = __builtin_bit_cast(bf16x8, lv);
}
constexpr int SB_SLOT = 20480, SB_RING0 = 8192, SB_DEPTH = 6;
static_assert(SB_RING0 + SB_DEPTH * SB_SLOT <= RING_BYTES, "chain ring");
__device__ __forceinline__ void phase_scanB(KP p, const Ctx& c, int li) {
    unsigned char* ws = p->ws; LAS unsigned char* lds = c.lds; const int lane = c.lane, fr = lane & 15, fq = lane >> 4, wave = c.wave;
    volatile LAS int* FL = (volatile LAS int*)(lds + RING_BYTES);
    if (c.tid < 4) FL[c.tid] = 0;
    __syncthreads();
    const int ncb = (int)gridDim.x < 128 ? (int)gridDim.x : 128;
    if (wave >= 4 || (int)blockIdx.x >= ncb) {
        const int gwf = (int)blockIdx.x < ncb ? (int)blockIdx.x * 4 + (wave - 4) : ncb * 4 + ((int)blockIdx.x - ncb) * 8 + wave, ngwf = ncb * 4 + ((int)gridDim.x - ncb) * 8;
        phase_fill(p, c, li, gwf, ngwf); return; }
    if (wave != 0) {
        const int j = wave - 1; int prevG = -1, kc = 0;
        for (int ch = blockIdx.x; ch < 128; ch += gridDim.x, ++kc) { const int b = ch >> 6, h = (ch >> 2) & 15, iq = ch & 3;
            for (int n = j; n < NCH; n += 3) { const int G = kc * NCH + n;
                if (G >= SB_DEPTH) { unsigned sp = 0; while (FL[0] < G - (SB_DEPTH - 1)) { __builtin_amdgcn_s_sleep(1); if (++sp > (1u << 22)) break; } }
                LAS unsigned char* slot = lds + SB_RING0 + (G % SB_DEPTH) * SB_SLOT;
                const size_t u = (size_t)(b * NCH + n) * H + h; const bf16_t* MTH = (const bf16_t*)(ws + WS_MT) + u * 4096; const bf16_t* MTL = MTH + (size_t)NUNIT_A * 4096; const float* NN = (const float*)(ws + WS_NN) + u * 4096;
#pragma unroll
                for (int jt = 0; jt < 4; ++jt)
#pragma unroll
                    for (int ks = 0; ks < 2; ++ks) {
                        __builtin_amdgcn_global_load_lds((const unsigned*)(MTH + (size_t)(16 * jt + fr) * 64 + 32 * ks + 8 * fq), (LAS unsigned*)(slot + ((jt * 2 + ks) * 2 + 0) * 1024), 16, 0, 0);
                        __builtin_amdgcn_global_load_lds((const unsigned*)(MTL + (size_t)(16 * jt + fr) * 64 + 32 * ks + 8 * fq), (LAS unsigned*)(slot + ((jt * 2 + ks) * 2 + 1) * 1024), 16, 0, 0); }
#pragma unroll
                for (int jt = 0; jt < 4; ++jt)
                    __builtin_amdgcn_global_load_lds((const unsigned*)(NN + (size_t)(16 * iq + fr) * 64 + 16 * jt + 4 * fq), (LAS unsigned*)(slot + (16 + jt) * 1024), 16, 0, 0);
                asm volatile("s_waitcnt vmcnt(20)" ::: "memory");
                if (prevG >= 0) FL[1 + j] = prevG + 1;
                prevG = G; } }
        asm volatile("s_waitcnt vmcnt(0)" ::: "memory");
        if (prevG >= 0) FL[1 + j] = prevG + 1;
        return; }
    int kc = 0;
    for (int ch = blockIdx.x; ch < 128; ch += gridDim.x, ++kc) {
        const int b = ch >> 6, h = (ch >> 2) & 15, iq = ch & 3;
        f32x4 S[4];
#pragma unroll
        for (int jt = 0; jt < 4; ++jt) S[jt] = (f32x4){0.f, 0.f, 0.f, 0.f};
        int j3 = 0;
        for (int n = 0; n < NCH; ++n) { const int G = kc * NCH + n;
            const size_t u = (size_t)(b * NCH + n) * H + h; bf16_t* S0 = (bf16_t*)(ws + WS_S0) + u * 4096;
            { unsigned sp = 0; while (FL[1 + j3] < G + 1) { __builtin_amdgcn_s_sleep(1); if (++sp > (1u << 22)) break; } }
            const LAS unsigned char* slot = lds + SB_RING0 + (G % SB_DEPTH) * SB_SLOT + lane * 16;
            bf16x8 ah[4][2], al[4][2]; f32x4 nn[4];
#pragma unroll
            for (int jt = 0; jt < 4; ++jt) { nn[jt] = *(const LAS f32x4*)(slot + (16 + jt) * 1024);
#pragma unroll
                for (int ks = 0; ks < 2; ++ks) { ah[jt][ks] = *(const LAS bf16x8*)(slot + ((jt * 2 + ks) * 2 + 0) * 1024); al[jt][ks] = *(const LAS bf16x8*)(slot + ((jt * 2 + ks) * 2 + 1) * 1024); } }
#pragma unroll
            for (int jt = 0; jt < 4; ++jt) { unsigned hh[4], ll[4];
#pragma unroll
                for (int r = 0; r < 4; ++r) { hh[r] = f2bf(S[jt][r]); ll[r] = f2bf(S[jt][r] - __builtin_bit_cast(float, hh[r] << 16)); }
                u32x2 wh = {hh[0] | (hh[1] << 16), hh[2] | (hh[3] << 16)}, wl = {ll[0] | (ll[1] << 16), ll[2] | (ll[3] << 16)};
                *(u32x2*)(S0 + (size_t)(16 * iq + fr) * 64 + 16 * jt + 4 * fq) = wh;
                *(LAS u32x2*)(lds + (fr * SST + 16 * jt + 4 * fq) * 2) = wh; *(LAS u32x2*)(lds + 4096 + (fr * SST + 16 * jt + 4 * fq) * 2) = wl; }
            LDS_WAIT();
            bf16x8 bh[2], bl[2];
#pragma unroll
            for (int ks = 0; ks < 2; ++ks) { bh[ks] = *(const LAS bf16x8*)(lds + (fr * SST + 32 * ks + 8 * fq) * 2); bl[ks] = *(const LAS bf16x8*)(lds + 4096 + (fr * SST + 32 * ks + 8 * fq) * 2); }
#pragma unroll
            for (int jt = 0; jt < 4; ++jt) { f32x4 acc = nn[jt];
#pragma unroll
                for (int ks = 0; ks < 2; ++ks) { acc = mfma16(ah[jt][ks], bh[ks], acc); acc = mfma16(ah[jt][ks], bl[ks], acc); acc = mfma16(al[jt][ks], bh[ks], acc); }
                S[jt] = acc; }
            LDS_WAIT();
            FL[0] = G + 1;
            j3 = j3 == 2 ? 0 : j3 + 1;
        }
        float* so = p->out + O_WKVP + (((size_t)li * NB + b) * H + h) * 4096;
#pragma unroll
        for (int jt = 0; jt < 4; ++jt) *(f32x4*)(so + (size_t)(16 * iq + fr) * 64 + 16 * jt + 4 * fq) = S[jt];
    }
}

__device__ __forceinline__ void phase_scanC(KP p, const Ctx& c, int li) {
    unsigned char* ws = p->ws; const int lane = c.lane, fr = lane & 15, fq = lane >> 4, hb = c.wave >> 2, tt = c.wave & 3;
    const float* Vb = (const float*)(ws + (li ? WS_V1 : WS_V0)); const bf16_t* HID = (const bf16_t*)(ws + WS_HID); const bf16_t* W2G = (const bf16_t*)(ws + WS_W2G) + (size_t)li * 1024 * 128;
    bf16_t* YG = (bf16_t*)(ws + WS_YG);
    for (int up = blockIdx.x; up < NUNIT_A / 2; up += gridDim.x) {
        const int u = 2 * up + hb; const int b = u / (NCH * H), n = (u / H) % NCH, h = u % H; const int row = b * TP + 64 * n + 16 * tt + fr;
        const bf16_t* RP = (const bf16_t*)(ws + WS_RP) + (size_t)u * 4096; const float* YL = (const float*)(ws + WS_YL) + (size_t)u * 4096; const bf16_t* S0 = (const bf16_t*)(ws + WS_S0) + (size_t)u * 4096;
        f32x4 acc[4], ag[4];
#pragma unroll
        for (int it = 0; it < 4; ++it) { acc[it] = *(const f32x4*)(YL + (size_t)(16 * tt + fr) * 64 + 16 * it + 4 * fq); ag[it] = (f32x4){0.f, 0.f, 0.f, 0.f}; }
#pragma unroll
        for (int ks = 0; ks < 2; ++ks) { const bf16x8 bq = *(const bf16x8*)(RP + (size_t)(16 * tt + fr) * 64 + 32 * ks + 8 * fq);
#pragma unroll
            for (int it = 0; it < 4; ++it) acc[it] = mfma16(*(const bf16x8*)(S0 + (size_t)(16 * it + fr) * 64 + 32 * ks + 8 * fq), bq, acc[it]); }
        const bf16_t* hgp = launder_p(HID + (size_t)row * LHID + 160 + 8 * fq); const bf16_t* wgp = launder_p(W2G + (size_t)(64 * h + fr) * 128 + 8 * fq);
#pragma unroll
        for (int ks = 0; ks < 4; ++ks) { const bf16x8 bq = *(const bf16x8*)(hgp + 32 * ks);
#pragma unroll
            for (int it = 0; it < 4; ++it) ag[it] = mfma16(*(const bf16x8*)(wgp + it * 16 * 128 + 32 * ks), bq, ag[it]); }
        float s = 0.f;
#pragma unroll
        for (int it = 0; it < 4; ++it) s += (acc[it][0] + acc[it][1]) + (acc[it][2] + acc[it][3]);
        s = sum_rows4(s); const float mean = s * (1.0f / 64.0f);
        float q = 0.f;
#pragma unroll
        for (int it = 0; it < 4; ++it) { const f32x4 d = acc[it] - mean; q += (d[0] * d[0] + d[1] * d[1]) + (d[2] * d[2] + d[3] * d[3]); }
        q = sum_rows4(q); const float rstd = frsq(q * (1.0f / 64.0f) + GN_EPS);
        const float rks = ((const float*)(ws + WS_RKS))[(size_t)row * 16 + h];
#pragma unroll
        for (int it = 0; it < 4; ++it) { const int C = 64 * h + 16 * it + 4 * fq; const size_t pc = (size_t)li * D + C;
            const f32x4 lw = *(const f32x4*)(p->in[I_LNW] + pc), lb = *(const f32x4*)(p->in[I_LNB] + pc), v = *(const f32x4*)(Vb + (size_t)row * D + C);
            const f32x4 o = ((acc[it] - mean) * rstd * lw + lb + v * rks) * ag[it];
            u32x2 w; w.x = pk2(o[0], o[1]); w.y = pk2(o[2], o[3]); *(u32x2*)(YG + (size_t)row * D + C) = w; }
    }
}
__device__ __forceinline__ void ld8bf(const bf16_t* p, float (&o)[8]) { const u32x4 w = *(const u32x4*)p; o[0] = bflo(w.x); o[1] = bfhi(w.x); o[2] = bflo(w.y); o[3] = bfhi(w.y); o[4] = bflo(w.z); o[5] = bfhi(w.z); o[6] = bflo(w.w); o[7] = bfhi(w.w); }
__device__ __forceinline__ void ld8f(const float* p, float (&o)[8]) { const f32x4 a = *(const f32x4*)p, b = *(const f32x4*)(p + 4); o[0] = a[0]; o[1] = a[1]; o[2] = a[2]; o[3] = a[3]; o[4] = b[0]; o[5] = b[1]; o[6] = b[2]; o[7] = b[3]; }
__device__ __forceinline__ void phase_conv(KP p, const Ctx& c, int layer) {
    const bf16_t* U = (const bf16_t*)(p->ws + WS_U); const bf16_t* GT = (const bf16_t*)(p->ws + WS_GT); bf16_t* HH = (bf16_t*)(p->ws + WS_HH);
    const float* cw = p->in[I_CONVW] + (size_t)layer * 3 * DFF; const float* cb = p->in[I_CONVB] + (size_t)layer * DFF; const float* st = p->in[I_SCONV] + (size_t)layer * SB * 2 * DFF;
    constexpr int NF8 = DFF / 8;
    for (int e = c.gtid; e < R * NF8; e += c.gsz) { const int row = e / NF8, f = 8 * (e % NF8);
        int t, b; if (row < MP) { t = row & (TP - 1); b = -1; } else { t = (row - MP) & 3; b = (row - MP) >> 2; }
        float u0[8], u1[8], u2[8], g[8], w0[8], w1[8], w2[8], bb[8];
        ld8bf(U + (size_t)row * DFF + f, u2); ld8bf(GT + (size_t)row * DFF + f, g);
        if (t >= 1) ld8bf(U + (size_t)(row - 1) * DFF + f, u1); else if (b >= 0) ld8f(st + ((size_t)b * 2 + 1) * DFF + f, u1); else {
#pragma unroll
            for (int i = 0; i < 8; ++i) u1[i] = 0.f; }
        if (t >= 2) ld8bf(U + (size_t)(row - 2) * DFF + f, u0); else if (b >= 0) ld8f(st + ((size_t)b * 2 + t) * DFF + f, u0); else {
#pragma unroll
            for (int i = 0; i < 8; ++i) u0[i] = 0.f; }
        ld8f(cw + f, w0); ld8f(cw + DFF + f, w1); ld8f(cw + 2 * DFF + f, w2); ld8f(cb + f, bb);
        float o[8];
#pragma unroll
        for (int i = 0; i < 8; ++i) o[i] = gelu_tanh(bb[i] + w0[i] * u0[i] + w1[i] * u1[i] + w2[i] * u2[i]) * g[i];
        u32x4 w; w.x = pk2(o[0], o[1]); w.y = pk2(o[2], o[3]); w.z = pk2(o[4], o[5]); w.w = pk2(o[6], o[7]);
        *(u32x4*)(HH + (size_t)row * DFF + f) = w; }
}

__device__ __forceinline__ void phase_kvpost(KP p, const Ctx& c) {
    const float* KVF = (const float*)(p->ws + WS_KVF); unsigned char* ws = p->ws; const int lane = c.lane, g = lane >> 4, d0 = 4 * (lane & 15);
    const f32x4 gs = *(const f32x4*)(p->in[I_KNG] + 64 + d0), gw = *(const f32x4*)(p->in[I_KNG] + 128 + d0);
    bf16_t* CA = (bf16_t*)(ws + WS_CMPA); bf16_t* KS = (bf16_t*)(ws + WS_KS); bf16_t* VS = (bf16_t*)(ws + WS_VS); bf16_t* KW = (bf16_t*)(ws + WS_KW); bf16_t* VW = (bf16_t*)(ws + WS_VW);
    for (int chunk = c.gw; chunk < R / 8; chunk += c.ngw) {
        unsigned vs_[4][4], vw_[4][4];
#pragma unroll
        for (int e = 0; e < 8; ++e) { const int row = chunk * 8 + e; const float* src = KVF + (size_t)row * NKV + 4 * lane;
            f32x4 v[6];
#pragma unroll
            for (int pt = 0; pt < 6; ++pt) v[pt] = *(const f32x4*)(src + pt * 256);
            { float s = (v[2][0] * v[2][0] + v[2][1] * v[2][1]) + (v[2][2] * v[2][2] + v[2][3] * v[2][3]);
              s = row16_sum(s); const float rs = frsq(s * (1.0f / 64.0f) + NORM_EPS); v[2] = v[2] * rs * gs; }
            { float s = (v[4][0] * v[4][0] + v[4][1] * v[4][1]) + (v[4][2] * v[4][2] + v[4][3] * v[4][3]);
              s = row16_sum(s); const float rs = frsq(s * (1.0f / 64.0f) + NORM_EPS); v[4] = v[4] * rs * gw; }
            float* okv = p->out + O_KV + (size_t)row * D + 4 * lane;
#pragma unroll
            for (int pt = 0; pt < 4; ++pt) *(f32x4*)(okv + pt * 256) = v[pt];
            if (row < MP) { const int b = row >> 13, t = row & (TP - 1);
                if (t >= TP - WIN) { float* ow = p->out + O_WINP + ((size_t)(b * WIN + (t - (TP - WIN))) * 2) * 256 + 4 * lane; *(f32x4*)ow = v[4]; *(f32x4*)(ow + 256) = v[5]; }
                const size_t hb = (size_t)(b * G + g);
                { u32x2 w; w.x = pk2(v[0][0], v[0][1]); w.y = pk2(v[0][2], v[0][3]); *(u32x2*)(CA + (hb * 512 + (t >> 4)) * 1024 + (t & 15) * 64 + d0) = w; }
                { u32x2 w; w.x = pk2(v[1][0], v[1][1]); w.y = pk2(v[1][2], v[1][3]); *(u32x2*)(CA + ((size_t)4096 + hb * 512 + (t >> 4)) * 1024 + (t & 15) * 64 + d0) = w; }
                { u32x2 w; w.x = pk2(v[2][0], v[2][1]); w.y = pk2(v[2][2], v[2][3]); *(u32x2*)(KS + (hb * TP + t) * 64 + d0) = w; }
                { u32x2 w; w.x = pk2(v[4][0], v[4][1]); w.y = pk2(v[4][2], v[4][3]); *(u32x2*)(KW + (hb * TP + t) * 64 + d0) = w; }
#pragma unroll
                for (int d = 0; d < 4; ++d) { const unsigned a = f2bf(v[3][d]), bq = f2bf(v[5][d]);
                    if (e & 1) { vs_[d][e >> 1] |= a << 16; vw_[d][e >> 1] |= bq << 16; } else { vs_[d][e >> 1] = a; vw_[d][e >> 1] = bq; } }
            } else { const int b = (row - MP) >> 2, t = (row - MP) & 3;
                float* ow = p->out + O_WINS + ((size_t)(b * WIN + 508 + t) * 2) * 256 + 4 * lane; *(f32x4*)ow = v[4]; *(f32x4*)(ow + 256) = v[5]; }
        }
        if (chunk * 8 < MP) { const int row = chunk * 8, b = row >> 13, t = row & (TP - 1); const size_t hb = (size_t)(b * G + g);
#pragma unroll
            for (int d = 0; d < 4; ++d) { *(u32x4*)(VS + (hb * 64 + d0 + d) * TP + t) = (u32x4){vs_[d][0], vs_[d][1], vs_[d][2], vs_[d][3]};
                *(u32x4*)(VW + (hb * 64 + d0 + d) * TP + t) = (u32x4){vw_[d][0], vw_[d][1], vw_[d][2], vw_[d][3]}; } }
    }
}

__device__ __forceinline__ void phase_cmp2(KP p, const Ctx& c) {
    unsigned char* ws = p->ws; const float* PC = (const float*)(ws + WS_PCMP); const int lane = c.lane, fr = lane & 15, fq = lane >> 4;
    const bf16_t* W2H = (const bf16_t*)(ws + WS_CW2T); const bf16_t* W2L = W2H + 2 * 64 * 128;
    constexpr int NPI = NB * G * 32, NSI = SB * G * 8, TOT = 2 * (NPI + NSI);
    for (int it = c.gw; it < TOT; it += c.ngw) {
        const bool samp = it >= 2 * NPI; const int r = samp ? it - 2 * NPI : it; const int kv = samp ? r / NSI : r / NPI; const int idx = samp ? r % NSI : r % NPI;
        const int hb = samp ? (idx >> 3) : (idx >> 5), n0 = 16 * (samp ? (idx & 7) : (idx & 31)), ncmp = samp ? NCMP_S : NCMP_P, nper = samp ? 128 : 512;
        const int n = n0 + fr; const bool live = n < ncmp;
        const size_t prow = (samp ? (size_t)8192 + (size_t)kv * 65536 : (size_t)kv * 4096) + (size_t)hb * nper + (live ? n : ncmp - 1);
        const float* cb = (const float*)(ws + WS_CBIAS) + kv * 128;
        bf16x8 hh[4], hl[4];
#pragma unroll
        for (int ks = 0; ks < 4; ++ks) { const int k0 = 32 * ks + 8 * fq; unsigned uh[8], ul[8];
            const f32x4 a0 = *(const f32x4*)(PC + prow * 256 + k0), a1 = *(const f32x4*)(PC + prow * 256 + k0 + 4);
            const f32x4 b0 = *(const f32x4*)(PC + (prow + 1) * 256 + 128 + k0), b1 = *(const f32x4*)(PC + (prow + 1) * 256 + 128 + k0 + 4);
            const f32x4 c0 = *(const f32x4*)(cb + k0), c1 = *(const f32x4*)(cb + k0 + 4);
#pragma unroll
            for (int e = 0; e < 8; ++e) { const float x = e < 4 ? a0[e] + b0[e] + c0[e] : a1[e - 4] + b1[e - 4] + c1[e - 4]; const float hv = gelu_tanh(x);
                uh[e] = f2bf(hv); ul[e] = f2bf(hv - __builtin_bit_cast(float, uh[e] << 16)); }
            const u32x4 wh = {uh[0] | (uh[1] << 16), uh[2] | (uh[3] << 16), uh[4] | (uh[5] << 16), uh[6] | (uh[7] << 16)}, wl = {ul[0] | (ul[1] << 16), ul[2] | (ul[3] << 16), ul[4] | (ul[5] << 16), ul[6] | (ul[7] << 16)};
            hh[ks] = __builtin_bit_cast(bf16x8, wh); hl[ks] = __builtin_bit_cast(bf16x8, wl); }
        f32x4 acc[4];
#pragma unroll
        for (int dt = 0; dt < 4; ++dt) { acc[dt] = *(const f32x4*)(p->in[I_CB2] + kv * 64 + 16 * dt + 4 * fq);
#pragma unroll
            for (int ks = 0; ks < 4; ++ks) { const size_t wo = (size_t)(kv * 64 + 16 * dt + fr) * 128 + 32 * ks + 8 * fq; const bf16x8 wh = *(const bf16x8*)(W2H + wo), wl = *(const bf16x8*)(W2L + wo);
                acc[dt] = mfma16(wh, hh[ks], acc[dt]); acc[dt] = mfma16(wh, hl[ks], acc[dt]); acc[dt] = mfma16(wl, hh[ks], acc[dt]); } }
        if (kv == 0) { float ss = 0.f;
#pragma unroll
            for (int dt = 0; dt < 4; ++dt) ss += (acc[dt][0] * acc[dt][0] + acc[dt][1] * acc[dt][1]) + (acc[dt][2] * acc[dt][2] + acc[dt][3] * acc[dt][3]);
            ss = sum_rows4(ss); const float rs = frsq(ss * (1.0f / 64.0f) + NORM_EPS);
#pragma unroll
            for (int dt = 0; dt < 4; ++dt) acc[dt] = acc[dt] * rs * *(const f32x4*)(p->in[I_KNG] + 16 * dt + 4 * fq); }
#pragma unroll
        for (int dt = 0; dt < 4; ++dt) { const f32x4 o = live ? acc[dt] : (f32x4){0.f, 0.f, 0.f, 0.f}; const int d = 16 * dt + 4 * fq;
            if (samp) *(f32x4*)((float*)(ws + (kv ? WS_CVS : WS_CKS)) + ((size_t)hb * 128 + n) * 64 + d) = o;
            else if (kv == 0) { u32x2 w; w.x = pk2(o[0], o[1]); w.y = pk2(o[2], o[3]); *(u32x2*)((bf16_t*)(ws + WS_CK) + ((size_t)hb * 512 + n) * 64 + d) = w; }
            else {
#pragma unroll
                for (int e = 0; e < 4; ++e) ((bf16_t*)(ws + WS_CV))[((size_t)hb * 64 + d + e) * 512 + n] = (bf16_t)f2bf(o[e]); } }
    }
}

__device__ __forceinline__ void phase_qpost(KP p, const Ctx& c, int lb) {
    const float* QF = (const float*)(p->ws + WS_QF); bf16_t* Q = (bf16_t*)(p->ws + WS_Q); const int lane = c.lane;
    const f32x4 gq = *(const f32x4*)(p->in[I_QNG] + lb * 64 + 4 * (lane & 15));
    for (int row = c.gw; row < R; row += c.ngw) { const float* src = QF + (size_t)row * NQP;
        f32x4 v[4]; load_row(src, lane, v);
#pragma unroll
        for (int j = 0; j < 4; ++j) { float s = (v[j][0] * v[j][0] + v[j][1] * v[j][1]) + (v[j][2] * v[j][2] + v[j][3] * v[j][3]);
            s = row16_sum(s);
            const float rs = (frsq(s * (1.0f / 64.0f) + NORM_EPS)) * (0.125f * 1.4426950408889634f); v[j] = v[j] * rs * gq; }
        store_row_bf16(Q + (size_t)row * D, lane, v);
    }
}
constexpr int AT_K0 = 0, AT_V0 = 9216, AT_K1 = 18432, AT_V1 = 27648, AT_IMP = 36864, IMPS = 132, AT_SELM = AT_IMP + 64 * IMPS * 4, AT_ANY = AT_SELM + 1024;
static_assert(AT_ANY + 16 <= RING_BYTES, "attention LDS map");
struct TileSrc { const bf16_t* K; const bf16_t* VT; int vts; };
__device__ __forceinline__ void tile_load(const TileSrc& s, int key0, int tid, u32x4& rk, u32x4& rv) {
    const int row = tid >> 3, ch = tid & 7;
    rk = *(const u32x4*)(s.K + (size_t)(key0 + row) * 64 + 8 * ch); rv = *(const u32x4*)(s.VT + (size_t)row * s.vts + key0 + 8 * ch);
}
__device__ __forceinline__ void tile_load_async(const TileSrc& s, int key0, int tid, u32x4& rk, u32x4& rv) {
    const int row = tid >> 3, ch = tid & 7;
    const bf16_t* pk = s.K + (size_t)(key0 + row) * 64 + 8 * ch; const bf16_t* pv = s.VT + (size_t)row * s.vts + key0 + 8 * ch;
    asm volatile("global_load_dwordx4 %0, %2, off\n\tglobal_load_dwordx4 %1, %3, off" : "=&v"(rk), "=&v"(rv) : "v"(pk), "v"(pv) : "memory");
}
#define TILE_WAIT(N_, RK_, RV_) asm volatile("s_waitcnt vmcnt(" #N_ ")" : "+v"(RK_), "+v"(RV_) :: "memory")
__device__ __forceinline__ void tile_store(LAS unsigned char* lds, int buf, int tid, const u32x4& rk, const u32x4& rv) {
    const int row = tid >> 3, ch = tid & 7;
    *(LAS u32x4*)(lds + (buf ? AT_K1 : AT_K0) + (row * SST + 8 * ch) * 2) = rk; *(LAS u32x4*)(lds + (buf ? AT_V1 : AT_V0) + (row * SST + 8 * ch) * 2) = rv;
}
__device__ __forceinline__ int first_bit4(unsigned a, unsigned b, unsigned c, unsigned d) { return a ? __ffs(a) - 1 : (b ? 32 + __ffs(b) - 1 : (c ? 64 + __ffs(c) - 1 : (d ? 96 + __ffs(d) - 1 : -1))); }
__device__ __forceinline__ float ex2(float x) { return __builtin_amdgcn_exp2f(x); }

__device__ __forceinline__ void set_bit4(int s, unsigned& t0, unsigned& t1, unsigned& t2, unsigned& t3) { const unsigned bit = 1u << (s & 31); const int w = s >> 5; t0 |= (w == 0) ? bit : 0u; t1 |= (w == 1) ? bit : 0u; t2 |= (w == 2) ? bit : 0u; t3 |= (w == 3) ? bit : 0u; }
__device__ __forceinline__ void clr_bit4(int s, unsigned& t0, unsigned& t1, unsigned& t2, unsigned& t3) { const unsigned bit = 1u << (s & 31); const int w = s >> 5; t0 &= ~((w == 0) ? bit : 0u); t1 &= ~((w == 1) ? bit : 0u); t2 &= ~((w == 2) ? bit : 0u); t3 &= ~((w == 3) ? bit : 0u); }
__device__ __forceinline__ unsigned get_word4(int s, unsigned a, unsigned b, unsigned c, unsigned d) { const int w = s >> 5; return ((w == 0) ? a : 0u) | ((w == 1) ? b : 0u) | ((w == 2) ? c : 0u) | ((w == 3) ? d : 0u); }
__device__ __forceinline__ float dpp_xor1(float x) { return __builtin_bit_cast(float, __builtin_amdgcn_update_dpp(0, __builtin_bit_cast(int, x), 0xB1, 0xF, 0xF, true)); }
__device__ __forceinline__ float dpp_xor2(float x) { return __builtin_bit_cast(float, __builtin_amdgcn_update_dpp(0, __builtin_bit_cast(int, x), 0x4E, 0xF, 0xF, true)); }
template <int MODE, bool EDGE> __device__ __forceinline__ void attn_tile(LAS unsigned char* lds, int buf, const bf16x8 (&qf)[4], int key0, int qpos, int r, int hf,
                                                                          float& l, f32x16 (&O)[2], float invl, bool selbit, LAS float* impq) {
    if (MODE == 3) { if (__ballot(selbit) == 0ull) { asm volatile("" : "+v"(O[0]), "+v"(O[1]), "+v"(l)); return; } }
    const float sbias = selbit ? 0.f : -1.0e30f;
    const int oK = buf ? AT_K1 : AT_K0, oV = buf ? AT_V1 : AT_V0;
#pragma unroll
    for (int kt = 0; kt < 2; ++kt) {
        f32x16 S;
#pragma unroll
        for (int i = 0; i < 16; ++i) S[i] = (MODE == 3) ? sbias : 0.f;
#pragma unroll
        for (int ks = 0; ks < 4; ++ks) S = mfma32(*(const LAS bf16x8*)(lds + oK + ((32 * kt + r) * SST + 16 * ks + 8 * hf) * 2), qf[ks], S);
        float ls = 0.f;
#pragma unroll
        for (int i = 0; i < 16; ++i) { float pv = ex2(S[i]);
            if (EDGE) { const int key = key0 + 32 * kt + (i & 3) + 8 * (i >> 2) + 4 * hf; bool v;
                if (MODE <= 1) v = (16 * key + 31 <= qpos); else if (MODE == 2) v = (key <= qpos) && (key + WIN > qpos); else v = (key <= qpos);
                pv = v ? pv : 0.f; }
            if (MODE == 1) pv *= invl;
            S[i] = pv; ls += pv; }
        if (MODE != 1) l += ls;
        if (MODE >= 1) {
#pragma unroll
            for (int sp = 0; sp < 2; ++sp) {
                u32x4 pw; pw.x = pg8::cvt_pk_bf16(S[8 * sp + 0], S[8 * sp + 1]); pw.y = pg8::cvt_pk_bf16(S[8 * sp + 2], S[8 * sp + 3]); pw.z = pg8::cvt_pk_bf16(S[8 * sp + 4], S[8 * sp + 5]); pw.w = pg8::cvt_pk_bf16(S[8 * sp + 6], S[8 * sp + 7]);
                const bf16x8 pf = __builtin_bit_cast(bf16x8, pw);
#pragma unroll
                for (int dt = 0; dt < 2; ++dt) { const int d = 32 * dt + r, kb = 32 * kt + 16 * sp + 4 * hf;
                    const u32x2 lo = *(const LAS u32x2*)(lds + oV + (d * SST + kb) * 2), hi = *(const LAS u32x2*)(lds + oV + (d * SST + kb + 8) * 2);
                    const u32x4 vw = {lo.x, lo.y, hi.x, hi.y};
                    O[dt] = mfma32(__builtin_bit_cast(bf16x8, vw), pf, O[dt]); } }
        }
        if (MODE == 1) {
            float own[4], nxt[4];
#pragma unroll
            for (int gq = 0; gq < 4; ++gq) { const float p3 = S[4 * gq + 3]; float o = 2.0f * (S[4 * gq] + S[4 * gq + 1] + S[4 * gq + 2]) + p3, n = p3;
                o += dpp_xor1(o); o += dpp_xor2(o); n += dpp_xor1(n); n += dpp_xor2(n); own[gq] = o; nxt[gq] = n; }
            const int sbb = (key0 >> 2) + 8 * kt + hf;
            if ((r & 3) == 0) {
#pragma unroll
                for (int gq = 0; gq < 4; ++gq) impq[sbb + 2 * gq] += own[gq]; }
            asm volatile("s_waitcnt lgkmcnt(0)" ::: "memory");
            if ((r & 3) == 0) {
#pragma unroll
                for (int gq = 0; gq < 4; ++gq) impq[sbb + 2 * gq + 1] += nxt[gq]; }
            asm volatile("s_waitcnt lgkmcnt(0)" ::: "memory");
        }
    }
}

template <int MODE> __device__ __forceinline__ void run_tiles(LAS unsigned char* lds, const TileSrc& src, unsigned t0, unsigned t1, unsigned t2, unsigned t3, int qt,
                                                              const bf16x8 (&qf)[4], int qpos, int r, int hf, int tid,
                                                              float& l, f32x16 (&O)[2], float invl, unsigned s0, unsigned s1, unsigned s2, unsigned s3, LAS float* impq, const int alias = 0) {
#define TSEL(n_) ((alias ? ((n_) & 7) : (n_)) * 64)
    tid = launder_v(tid); r = tid & 31; hf = (tid >> 5) & 1;
    int cur = first_bit4(t0, t1, t2, t3); if (cur < 0) return;
    const int first = cur;
    clr_bit4(cur, t0, t1, t2, t3); int n1 = first_bit4(t0, t1, t2, t3); if (n1 >= 0) clr_bit4(n1, t0, t1, t2, t3);
    int n2 = first_bit4(t0, t1, t2, t3); if (n2 >= 0) clr_bit4(n2, t0, t1, t2, t3);
    int n3 = first_bit4(t0, t1, t2, t3); if (n3 >= 0) clr_bit4(n3, t0, t1, t2, t3);
    u32x4 rkA, rvA, rkB, rvB, rkC, rvC; { u32x4 rk, rv; tile_load(src, TSEL(cur), tid, rk, rv); int b0 = 0; tile_store(lds, b0, tid, rk, rv); }
    tile_load_async(src, TSEL(n1 >= 0 ? n1 : first), tid, rkA, rvA);
    tile_load_async(src, TSEL(n2 >= 0 ? n2 : first), tid, rkB, rvB);
    tile_load_async(src, TSEL(n3 >= 0 ? n3 : first), tid, rkC, rvC);
    int buf = 0;
    __syncthreads();
#define RT_STEP(RK_, RV_) { \
        if (cur >= 0) { \
            const unsigned sw = get_word4(cur, s0, s1, s2, s3); \
            const bool sb = ((sw >> (cur & 31)) & 1u) != 0u; \
            if (MODE <= 1) attn_tile<MODE, true>(lds, buf, qf, cur * 64, qpos, r, hf, l, O, invl, sb, impq); \
            else { const bool edge = (cur == qt) || (MODE == 2 && cur == qt - 8); \
                if (edge) attn_tile<MODE, true>(lds, buf, qf, cur * 64, qpos, r, hf, l, O, invl, sb, impq); \
                else attn_tile<MODE, false>(lds, buf, qf, cur * 64, qpos, r, hf, l, O, invl, sb, impq); } } \
        TILE_WAIT(4, RK_, RV_); \
        tile_store(lds, buf ^ 1, tid, RK_, RV_); \
        __syncthreads(); \
        const int n4 = first_bit4(t0, t1, t2, t3); if (n4 >= 0) clr_bit4(n4, t0, t1, t2, t3); \
        tile_load_async(src, TSEL(n4 >= 0 ? n4 : first), tid, RK_, RV_); \
        buf ^= 1; cur = n1; n1 = n2; n2 = n3; n3 = n4; }
    do {
        RT_STEP(rkA, rvA)
        RT_STEP(rkB, rvB)
        RT_STEP(rkC, rvC)
    } while (cur >= 0);
#undef RT_STEP
    asm volatile("s_waitcnt vmcnt(0)" : "+v"(rkA), "+v"(rvA), "+v"(rkB), "+v"(rvB), "+v"(rkC), "+v"(rvC) :: "memory");
    __syncthreads();
}
__device__ __forceinline__ void attn_prompt_unit(KP p, const Ctx& c, int k, const int stop) {
    LAS unsigned char* lds = c.lds; unsigned char* ws = p->ws; int tid_m; asm volatile("v_mbcnt_lo_u32_b32 %0, -1, 0\n\tv_mbcnt_hi_u32_b32 %0, -1, %0" : "=v"(tid_m));
    const int wave = c.wave, tid = tid_m + 64 * wave, lane = tid & 63, r = lane & 31, hf = lane >> 5;
    const int qt = 127 - (k >> 3), hb = k & 7, b = hb >> 2, g = hb & 3, q0 = 64 * qt;
    const int qi = 8 * wave + (r >> 2), head = 4 * g + (r & 3), qpos = q0 + qi, row = b * TP + qpos;
    const bf16_t* Q = (const bf16_t*)(ws + WS_Q);
    bf16x8 qf[4];
#pragma unroll
    for (int ks = 0; ks < 4; ++ks) qf[ks] = *(const bf16x8*)(Q + (size_t)row * D + head * 64 + 16 * ks + 8 * hf);
    const float* gate = (const float*)(ws + WS_GATE) + (size_t)row * 48 + head * 3; const float g_c = gate[0], g_s = gate[1], g_w = gate[2];
    LAS float* imp = (LAS float*)(lds + AT_IMP); LAS unsigned* selm = (LAS unsigned*)(lds + AT_SELM); LAS unsigned* anym = (LAS unsigned*)(lds + AT_ANY);
    for (int e = tid; e < 64 * IMPS; e += 512) imp[e] = 0.f;
    if (tid < 4) anym[tid] = 0u;
    __syncthreads();
    f32x16 O[2]; unsigned OUTP[2][8];
#pragma unroll
    for (int dt = 0; dt < 2; ++dt)
#pragma unroll
        for (int i = 0; i < 16; ++i) O[dt][i] = 0.f;
    {
        const TileSrc src{(const bf16_t*)(ws + WS_CK) + (size_t)hb * 512 * 64, (const bf16_t*)(ws + WS_CV) + (size_t)hb * 64 * 512, 512};
        const int nmax = q0 + 63 - 31; const int ntc = nmax >= 0 ? (nmax >> 10) + 1 : 0;
        const unsigned tm = ntc >= 32 ? 0xffffffffu : ((1u << ntc) - 1u);
        float l = 0.f;
        run_tiles<0>(lds, src, tm, 0u, 0u, 0u, qt, qf, qpos, r, hf, tid, l, O, 0.f, 0u, 0u, 0u, 0u, imp);
        l = sum_xor32(l); const float invl = l > 0.f ? 1.0f / l : 0.f;
        run_tiles<1>(lds, src, tm, 0u, 0u, 0u, qt, qf, qpos, r, hf, tid, l, O, invl, 0u, 0u, 0u, 0u, imp + qi * IMPS);
#pragma unroll
        for (int dt = 0; dt < 2; ++dt) {
#pragma unroll
            for (int i = 0; i < 8; ++i) { OUTP[dt][i] = pg8::cvt_pk_bf16(O[dt][2 * i] * g_c, O[dt][2 * i + 1] * g_c); asm volatile("" : "+v"(OUTP[dt][i])); }
#pragma unroll
            for (int i = 0; i < 16; ++i) O[dt][i] = 0.f; }
    }
    __syncthreads();
    if (stop == 1) return;
    {
        unsigned k0[8], k1[8], T[8]; int Kq[8];
#pragma unroll
        for (int e = 0; e < 8; ++e) { const int qq = 8 * wave + e, qp = q0 + qq, qb = qp >> 6;
            const bool c0 = (64 * lane <= qp), c1 = (64 * (lane + 64) <= qp);
            const unsigned a0_ = (lane == 0 || lane == qb || lane == qb - 1) ? 0xffffffffu : __builtin_bit_cast(unsigned, imp[qq * IMPS + lane]);
            const unsigned a1_ = (lane + 64 == qb || lane + 64 == qb - 1) ? 0xffffffffu : __builtin_bit_cast(unsigned, imp[qq * IMPS + lane + 64]);
            k0[e] = c0 ? a0_ : 0u; k1[e] = c1 ? a1_ : 0u;
            Kq[e] = qb + 1 < 16 ? qb + 1 : 16; T[e] = 0u; }
        for (int bit = 31; bit >= 0; --bit) {
#pragma unroll
            for (int e = 0; e < 8; ++e) { const unsigned cand = T[e] | (1u << bit);
                const int cnt = __popcll(__ballot(k0[e] >= cand)) + __popcll(__ballot(k1[e] >= cand)); if (cnt >= Kq[e]) T[e] = cand; } }
#pragma unroll
        for (int e = 0; e < 8; ++e) { const int qq = 8 * wave + e, qp = q0 + qq;
            const bool c0 = (64 * lane <= qp), c1 = (64 * (lane + 64) <= qp);
            unsigned long long mlo = __ballot(k0[e] > T[e]), mhi = __ballot(k1[e] > T[e]), elo = __ballot(c0 && k0[e] == T[e]), ehi = __ballot(c1 && k1[e] == T[e]);
            int need = Kq[e] - (__popcll(mlo) + __popcll(mhi));
            for (; need > 0; --need) { if (elo) { mlo |= elo & (~elo + 1ull); elo &= elo - 1ull; } else { mhi |= ehi & (~ehi + 1ull); ehi &= ehi - 1ull; } }
            const unsigned m0 = (unsigned)mlo, m1 = (unsigned)(mlo >> 32), m2 = (unsigned)mhi, m3 = (unsigned)(mhi >> 32);
            if (lane == 0) { selm[qq * 4 + 0] = m0; selm[qq * 4 + 1] = m1; selm[qq * 4 + 2] = m2; selm[qq * 4 + 3] = m3;
                atomicOr((unsigned*)&anym[0], m0); atomicOr((unsigned*)&anym[1], m1); atomicOr((unsigned*)&anym[2], m2); atomicOr((unsigned*)&anym[3], m3); } }
    }
    __syncthreads();
    if (stop == 2) return;
    {
        const TileSrc src{(const bf16_t*)(ws + WS_KW) + (size_t)hb * TP * 64, (const bf16_t*)(ws + WS_VW) + (size_t)hb * 64 * TP, TP};
        const int tlo = qt >= 8 ? qt - 8 : 0; unsigned t0 = 0u, t1 = 0u, t2 = 0u, t3 = 0u;
        for (int s = tlo; s <= qt; ++s) set_bit4(s, t0, t1, t2, t3);
        float l = 0.f;
        run_tiles<2>(lds, src, t0, t1, t2, t3, qt, qf, qpos, r, hf, tid, l, O, 0.f, 0u, 0u, 0u, 0u, imp);
        l = sum_xor32(l); const float sc = l > 0.f ? g_w / l : 0.f;
#pragma unroll
        for (int dt = 0; dt < 2; ++dt) {
#pragma unroll
            for (int i = 0; i < 8; ++i) { OUTP[dt][i] = pg8::cvt_pk_bf16(bflo(OUTP[dt][i]) + O[dt][2 * i] * sc, bfhi(OUTP[dt][i]) + O[dt][2 * i + 1] * sc); asm volatile("" : "+v"(OUTP[dt][i])); }
#pragma unroll
            for (int i = 0; i < 16; ++i) O[dt][i] = 0.f; }
    }
    if (stop == 3) { __syncthreads(); return; }
    {
        const TileSrc src{(const bf16_t*)(ws + WS_KS) + (size_t)hb * TP * 64, (const bf16_t*)(ws + WS_VS) + (size_t)hb * 64 * TP, TP};
        const unsigned sz_ = (stop == 5) ? 0u : 0xffffffffu;
        const unsigned s0 = selm[qi * 4 + 0] & sz_, s1 = selm[qi * 4 + 1] & sz_, s2 = selm[qi * 4 + 2] & sz_, s3 = selm[qi * 4 + 3] & sz_;
        const unsigned a0 = __builtin_amdgcn_readfirstlane(anym[0]), a1 = __builtin_amdgcn_readfirstlane(anym[1]), a2 = __builtin_amdgcn_readfirstlane(anym[2]), a3 = __builtin_amdgcn_readfirstlane(anym[3]);
        float l = 0.f;
        run_tiles<3>(lds, src, a0, a1, a2, a3, qt, qf, qpos, r, hf, tid, l, O, 0.f, s0, s1, s2, s3, imp, stop == 4 ? 1 : 0);
        if (stop >= 4) { if (l == 12345.678f) ((float*)(ws + WS_GATE))[0] = O[0][0] + O[1][0]; __syncthreads(); return; }
        l = sum_xor32(l); const float sc = l > 0.f ? g_s / l : 0.f;
#pragma unroll
        for (int dt = 0; dt < 2; ++dt)
#pragma unroll
            for (int i = 0; i < 8; ++i) OUTP[dt][i] = pg8::cvt_pk_bf16(bflo(OUTP[dt][i]) + O[dt][2 * i] * sc, bfhi(OUTP[dt][i]) + O[dt][2 * i + 1] * sc);
    }
    bf16_t* AO = (bf16_t*)(ws + WS_YG) + (size_t)row * D + head * 64;
#pragma unroll
    for (int dt = 0; dt < 2; ++dt)
#pragma unroll
        for (int gq = 0; gq < 4; ++gq) { u32x2 w; w.x = OUTP[dt][2 * gq]; w.y = OUTP[dt][2 * gq + 1]; *(u32x2*)(AO + 32 * dt + 8 * gq + 4 * hf) = w; }
    __syncthreads();
}

constexpr int SA_RED = 0, SA_REDW = 2 * 16 * 65 * 4, SA_OC = SA_RED + SA_REDW, SA_EC = SA_OC + 2 * 4096, SA_LC = SA_EC + 2 * 4096, SA_PN = SA_LC + 256, SA_SEL = SA_PN + 4 * 512;
static_assert(SA_SEL + 64 <= RING_BYTES, "sample attention LDS map");
__device__ __forceinline__ bf16x8 pack8(const f32x4 a, const f32x4 b) { const u32x4 w = {pk2(a[0], a[1]), pk2(a[2], a[3]), pk2(b[0], b[1]), pk2(b[2], b[3])}; return __builtin_bit_cast(bf16x8, w); }
__device__ __forceinline__ void sa_qk(const float* kb, size_t stride, int nrows, const bf16x8 (&qf)[2], int fr, int fq, f32x4 (&S)[4]) {
    f32x4 kr[4][2][2];
#pragma unroll
    for (int kg = 0; kg < 4; ++kg) { const int key = 16 * kg + fr; const float* rp = kb + (size_t)(key < nrows ? key : nrows - 1) * stride + 8 * fq;
#pragma unroll
        for (int ks = 0; ks < 2; ++ks) { kr[kg][ks][0] = *(const f32x4*)(rp + 32 * ks); kr[kg][ks][1] = *(const f32x4*)(rp + 32 * ks + 4); } }
#pragma unroll
    for (int kg = 0; kg < 4; ++kg) { S[kg] = (f32x4){0.f, 0.f, 0.f, 0.f};
#pragma unroll
        for (int ks = 0; ks < 2; ++ks) S[kg] = mfma16(pack8(kr[kg][ks][0], kr[kg][ks][1]), qf[ks], S[kg]); }
}
__device__ __forceinline__ void sa_pv(const float* vb, size_t stride, int nrows, const f32x4 (&P)[4], int fr, int fq, f32x4 (&O)[4]) {
#pragma unroll
    for (int ks = 0; ks < 2; ++ks) { const bf16x8 pa = pack8(P[2 * ks], P[2 * ks + 1]);
        float vv[4][8];
#pragma unroll
        for (int j = 0; j < 8; ++j) { const int key = 16 * (2 * ks + (j >> 2)) + 4 * fq + (j & 3); const float* rp = vb + (size_t)(key < nrows ? key : nrows - 1) * stride + fr;
#pragma unroll
            for (int dt = 0; dt < 4; ++dt) vv[dt][j] = rp[16 * dt]; }
#pragma unroll
        for (int dt = 0; dt < 4; ++dt) { const u32x4 w = {pk2(vv[dt][0], vv[dt][1]), pk2(vv[dt][2], vv[dt][3]), pk2(vv[dt][4], vv[dt][5]), pk2(vv[dt][6], vv[dt][7])};
            O[dt] = mfma16(pa, __builtin_bit_cast(bf16x8, w), O[dt]); } }
}
__device__ __forceinline__ void attn_sample_unit(KP p, const Ctx& c, int item) {
    unsigned char* ws = p->ws; LAS unsigned char* lds = c.lds; const int tid = launder_v(c.tid), lane = tid & 63, wave = c.wave, fr = lane & 15, fq = lane >> 4; const int b = item >> 2, g = item & 3;
    bf16x8 qf[2];
    { const bf16_t* Q = (const bf16_t*)(ws + WS_Q) + (size_t)(MP + 4 * b + (fr >> 2)) * D + (4 * g + (fr & 3)) * 64 + 8 * fq;
      qf[0] = *(const bf16x8*)Q; qf[1] = *(const bf16x8*)(Q + 32); }
    const int tokm = fr >> 2;
    if (wave < 2) {
        const float* ck = (const float*)(ws + WS_CKS) + ((size_t)(b * 4 + g) * 128 + 64 * wave) * 64; const float* cv = (const float*)(ws + WS_CVS) + ((size_t)(b * 4 + g) * 128 + 64 * wave) * 64;
        const int nrows = wave ? 63 : 64;
        f32x4 S[4]; sa_qk(ck, 64, nrows, qf, fr, fq, S);
        float ls = 0.f;
#pragma unroll
        for (int kg = 0; kg < 4; ++kg)
#pragma unroll
            for (int r = 0; r < 4; ++r) { const int key = 16 * kg + 4 * fq + r; const float ev = key < nrows ? ex2(S[kg][r]) : 0.f; S[kg][r] = ev; ls += ev;
                *(LAS float*)(lds + SA_EC + wave * 4096 + (key * 16 + fr) * 4) = ev; }
        ls = sum_rows4(ls); if (fq == 0) *(LAS float*)(lds + SA_LC + (wave * 16 + fr) * 4) = ls;
        f32x4 oc[4];
#pragma unroll
        for (int dt = 0; dt < 4; ++dt) oc[dt] = (f32x4){0.f, 0.f, 0.f, 0.f};
        sa_pv(cv, 64, nrows, S, fr, fq, oc);
#pragma unroll
        for (int dt = 0; dt < 4; ++dt)
#pragma unroll
            for (int r = 0; r < 4; ++r) *(LAS float*)(lds + SA_OC + wave * 4096 + ((4 * fq + r) * 64 + 16 * dt + fr) * 4) = oc[dt][r];
    }
    __syncthreads();
    if (wave < 4) { const int tok = wave; float P0 = 0.f, P1 = 0.f;
#pragma unroll
        for (int hh = 0; hh < 4; ++hh) { const int pi = tok * 4 + hh; const float L = *(const LAS float*)(lds + SA_LC + pi * 4) + *(const LAS float*)(lds + SA_LC + (16 + pi) * 4); const float inv = L > 0.f ? 1.0f / L : 0.f;
            P0 += *(const LAS float*)(lds + SA_EC + (lane * 16 + pi) * 4) * inv; P1 += *(const LAS float*)(lds + SA_EC + 4096 + (lane * 16 + pi) * 4) * inv; }
        LAS float* pn = (LAS float*)(lds + SA_PN + tok * 512); pn[lane] = P0; pn[64 + lane] = P1; LDS_WAIT();
        float v0 = -1e9f;
        if (lane < 33) { const int s = lane; float im = 0.f;
            if (4 * s - 1 >= 0 && 4 * s - 1 < 128) im += pn[4 * s - 1];
#pragma unroll
            for (int j = 0; j < 3; ++j) if (4 * s + j < 128) im += 2.0f * pn[4 * s + j];
            if (4 * s + 3 < 128) im += pn[4 * s + 3];
            v0 = (s == 0 || s == 31 || s == 32) ? 1e9f : im; }
        unsigned selmask = 0u, sel32 = 0u;
        for (int it = 0; it < 16; ++it) { const float mx = wave_max(v0); if (mx < -5e8f) break; const unsigned long long b0 = __ballot(v0 == mx); const int s = __ffsll((long long)b0) - 1;
            if (lane == s) v0 = -2e9f; if (s < 32) selmask |= 1u << s; else sel32 = 1u; }
        if (lane == 0) { *(LAS unsigned*)(lds + SA_SEL + tok * 8) = selmask; *(LAS unsigned*)(lds + SA_SEL + tok * 8 + 4) = sel32; } }
    __syncthreads();
    unsigned sm[4], s32[4];
#pragma unroll
    for (int t = 0; t < 4; ++t) { sm[t] = *(const LAS unsigned*)(lds + SA_SEL + t * 8); s32[t] = *(const LAS unsigned*)(lds + SA_SEL + t * 8 + 4); }
    const unsigned un = sm[0] | sm[1] | sm[2] | sm[3]; const int nsel = __popc(un); const int has32 = (s32[0] | s32[1] | s32[2] | s32[3]) ? 1 : 0;
    const unsigned my_sm = tokm == 0 ? sm[0] : (tokm == 1 ? sm[1] : (tokm == 2 ? sm[2] : sm[3])), my_s32 = tokm == 0 ? s32[0] : (tokm == 1 ? s32[1] : (tokm == 2 ? s32[2] : s32[3]));
    const int ntile = nsel + has32 + 9;
    const int* pt = (const int*)p->in[I_PT] + b * NPAGES;
    f32x4 osel[4], owin[4]; float lsel = 0.f, lwin = 0.f;
#pragma unroll
    for (int dt = 0; dt < 4; ++dt) { osel[dt] = (f32x4){0.f, 0.f, 0.f, 0.f}; owin[dt] = (f32x4){0.f, 0.f, 0.f, 0.f}; }
    for (int ti = wave; ti < ntile; ti += 8) {
        const float* kb; size_t stride; int nrows = 64, br, mode, sidx = 0;
        if (ti < nsel) { unsigned m = un; for (int q = 0; q < ti; ++q) m &= m - 1u; sidx = __ffs(m) - 1; const int page = pt[sidx >> 1];
            kb = p->in[I_CKV] + ((size_t)page * PAGE + (sidx & 1) * 64) * 1024 + 2 * 256 + g * 64; stride = 1024; br = 0; mode = 0; }
        else if (ti < nsel + has32) { kb = p->out + O_KV + (size_t)(MP + 4 * b) * D + 2 * 256 + g * 64; stride = 1024; nrows = 4; br = 0; mode = 1; }
        else if (ti < nsel + has32 + 8) { sidx = ti - nsel - has32; kb = p->in[I_CWIN] + ((size_t)b * WIN + 64 * sidx) * 512 + g * 64; stride = 512; br = 1; mode = 2; }
        else { kb = p->out + O_WINS + ((size_t)(b * WIN + 508) * 2) * 256 + g * 64; stride = 512; nrows = 4; br = 1; mode = 3; }
        f32x4 S[4]; sa_qk(kb, stride, nrows, qf, fr, fq, S);
        float ls = 0.f;
#pragma unroll
        for (int kg = 0; kg < 4; ++kg)
#pragma unroll
            for (int r = 0; r < 4; ++r) { const int key = 16 * kg + 4 * fq + r; bool valid;
                if (mode == 0) valid = ((my_sm >> sidx) & 1u) != 0u; else if (mode == 1) valid = (my_s32 != 0u) && (key <= tokm); else if (mode == 2) valid = (64 * sidx + key) >= tokm + 1; else valid = key <= tokm;
                const float ev = valid ? ex2(S[kg][r]) : 0.f; S[kg][r] = ev; ls += ev; }
        if (br == 0) { lsel += ls; sa_pv(kb + 256, stride, nrows, S, fr, fq, osel); } else { lwin += ls; sa_pv(kb + 256, stride, nrows, S, fr, fq, owin); }
    }
    lsel = sum_rows4(lsel); lwin = sum_rows4(lwin);
    for (int w = 0; w < 8; ++w) {
        if (wave == w) {
#pragma unroll
            for (int dt = 0; dt < 4; ++dt)
#pragma unroll
                for (int r = 0; r < 4; ++r) { LAS float* r0 = (LAS float*)(lds + SA_RED + ((4 * fq + r) * 65 + 16 * dt + fr) * 4); LAS float* r1 = (LAS float*)(lds + SA_RED + ((16 + 4 * fq + r) * 65 + 16 * dt + fr) * 4);
                    if (w == 0) { *r0 = osel[dt][r]; *r1 = owin[dt][r]; } else { *r0 += osel[dt][r]; *r1 += owin[dt][r]; } }
            if (fq == 0) { LAS float* l0 = (LAS float*)(lds + SA_RED + (fr * 65 + 64) * 4); LAS float* l1 = (LAS float*)(lds + SA_RED + ((16 + fr) * 65 + 64) * 4);
                if (w == 0) { *l0 = lsel; *l1 = lwin; } else { *l0 += lsel; *l1 += lwin; } } }
        __syncthreads(); }
    { const float* gt = (const float*)(ws + WS_GATE); bf16_t* AO = (bf16_t*)(ws + WS_YG);
      for (int e = tid; e < 1024; e += 512) { const int pi = e >> 6, d = e & 63, tok = pi >> 2, hh = pi & 3; const size_t row = (size_t)(MP + 4 * b + tok);
          const float lc = *(const LAS float*)(lds + SA_LC + pi * 4) + *(const LAS float*)(lds + SA_LC + (16 + pi) * 4);
          const float oc = *(const LAS float*)(lds + SA_OC + (pi * 64 + d) * 4) + *(const LAS float*)(lds + SA_OC + 4096 + (pi * 64 + d) * 4);
          const LAS float* r0 = (const LAS float*)(lds + SA_RED + (pi * 65) * 4); const LAS float* r1 = (const LAS float*)(lds + SA_RED + ((16 + pi) * 65) * 4);
          const float* gg = gt + row * 48 + (4 * g + hh) * 3;
          float out = lc > 0.f ? gg[0] * oc / lc : 0.f;
          out += r0[64] > 0.f ? gg[1] * r0[d] / r0[64] : 0.f;
          out += r1[64] > 0.f ? gg[2] * r1[d] / r1[64] : 0.f;
          AO[row * D + (4 * g + hh) * 64 + d] = (bf16_t)f2bf(out); } }
    __syncthreads();
}

__device__ __forceinline__ void phase_attn_prompt(KP p, const Ctx& c, const int stop = 0) {
    const int Gd = gridDim.x, cb = blockIdx.x;
    for (int i = 0; i * Gd < 1024; ++i) { const int k = i * Gd + ((i & 1) ? Gd - 1 - cb : cb); if (k < 1024) attn_prompt_unit(p, c, k, stop); }
}
__device__ __forceinline__ void phase_attn_sample(KP p, const Ctx& c) {
    for (int it = blockIdx.x; it < SB * G; it += gridDim.x) attn_sample_unit(p, c, it);
}
#ifndef MK_MULTI
#define MK_MULTI 0
#endif
#if defined(PROBE_SCALE) || defined(SELFTEST)
constexpr int NPH = 46;
#elif defined(PROBE_ATTN2)
constexpr int NPH = 47;
#else
constexpr int NPH = 45;
#endif
#ifdef SPLITK
#define RESID_SPLIT(n) (n)
#else
#define RESID_SPLIT(n) 0
#endif

__global__ void __launch_bounds__(512, 2) mega(Params p) {
    extern __shared__ __attribute__((aligned(16))) unsigned char lds_raw[];
    LAS unsigned char* const lds0 = (LAS unsigned char*)lds_raw;
    volatile LAS unsigned* MISC = (volatile LAS unsigned*)(lds0 + MISC_OFF);
    for (int u = threadIdx.x; u < (LDS_BYTES - RING_BYTES) / 4; u += 512) ((LAS unsigned*)(lds0 + RING_BYTES))[u] = 0u;
    __syncthreads();
    const KP kp0 = (KP)__builtin_amdgcn_kernarg_segment_ptr();
    const int ph_lo = kp0->ph_lo, ph_hi = kp0->ph_hi, use_bar = kp0->use_bar;
    XcdBarrier bar; bar.bar = (unsigned*)(kp0->ws + WS_CTL); bar.x = 0; bar.st = nullptr;
    if (use_bar) bar = xcd_barrier_post((unsigned*)(kp0->ws + WS_CTL), MISC + 8);
    const int wave_s = __builtin_amdgcn_readfirstlane((int)threadIdx.x >> 6);
#define TID_MBCNT 1
#ifdef TID_MBCNT
#define TID_SRC(T_) asm volatile("v_mbcnt_lo_u32_b32 %0, -1, 0\n\tv_mbcnt_hi_u32_b32 %0, -1, %0" : "=v"(T_)); T_ += 64 * wave_s;
#else
#define TID_SRC(T_) T_ = threadIdx.x; asm volatile("" : "+v"(T_));
#endif
    int ph = 0;
#define PHASE_BEGIN if (ph >= ph_lo && ph < ph_hi) { KP p = kp0; asm volatile("" : "+s"(p)); int tid_; TID_SRC(tid_) \
        Ctx c; c.lds = lds0; c.tid = tid_; c.lane = tid_ & 63; c.wave = __builtin_amdgcn_readfirstlane(tid_ >> 6); c.gw = blockIdx.x * 8 + c.wave; c.ngw = gridDim.x * 8; c.gtid = blockIdx.x * 512 + tid_; c.gsz = gridDim.x * 512; \
        unsigned char* ws = p->ws; float* X = p->out + O_Y; (void)ws; (void)X;
#define PHASE_END   if (use_bar) { int te_; TID_SRC(te_) xcd_barrier(bar, te_ == 0); } } ++ph;

    PHASE_BEGIN phase_prologue(p, c); PHASE_END
#ifdef PROBE_BAR
    for (int xb = 0; xb < PROBE_BAR; ++xb) { if (use_bar) xcd_barrier(bar, threadIdx.x == 0); }
#endif

    for (int layer = 0; layer < NLAY; ++layer) {
        if (layer < 2) {
            const int li = layer;
            PHASE_BEGIN phase_mix(p, c, li); PHASE_END
            PHASE_BEGIN {
                pg8::Gemm g{(const bf16_t*)(ws + WS_XM), (const bf16_t*)(ws + WS_WRKV) + (size_t)li * 3072 * 1024, 3 * R, 3072, 1024, 1024};
                pg8::GroupOrder S; S.init((int)gridDim.x, (int)blockIdx.x); S.add(0, 0, 64, 0, 4); S.add(1, 66, 64, 4, 4); S.add(2, 132, 64, 8, 4);
                pg8::EpiF32G E{(float*)(ws + WS_RK_R), (float*)(ws + WS_RK_K), (float*)(ws + (li ? WS_V1 : WS_V0)), nullptr, D, 4, 66};
                pg8::gemm_phase<pg8::EpiF32G, pg8::GroupOrder, true, true>(c.lds, g, S, E, c.tid);
                {
                    const bf16_t* XMs = (const bf16_t*)(ws + WS_XM); const bf16_t* Wr = (const bf16_t*)(ws + WS_WRKV) + (size_t)li * 3072 * 1024;
                    for (int it = blockIdx.x + gridDim.x * c.wave; it < 768; it += c.ngw) { const int j = it >> 8, r = it & 255, row0 = MP + 32 * (r & 15), col0 = 64 * (r >> 4);
                        float* C = (float*)(ws + (j == 0 ? WS_RK_R : (j == 1 ? WS_RK_K : (li ? WS_V1 : WS_V0))));
                        f32x4 acc[4][2]; skinny_mma<4>(XMs + (size_t)j * R * D, 1024, Wr + (size_t)j * 1024 * 1024, 1024, 1024, row0, col0, c.lane, acc);
                        const int fr = c.lane & 15, fq = c.lane >> 4;
#pragma unroll
                        for (int nt = 0; nt < 4; ++nt)
#pragma unroll
                            for (int mt = 0; mt < 2; ++mt) *(f32x4*)(C + (size_t)(row0 + 16 * mt + fr) * D + col0 + 16 * nt + 4 * fq) = acc[nt][mt]; }
                }
                phase_lora1(p, c, li);
            } PHASE_END
            PHASE_BEGIN phase_scanA(p, c, li); PHASE_END
            PHASE_BEGIN phase_scanB(p, c, li); PHASE_END
            PHASE_BEGIN phase_scanC(p, c, li); PHASE_END
        } else {
            const int lb = layer - 2;
            if (layer == 2) {
                PHASE_BEGIN phase_norm(c, X, p->in[I_KVNG], (bf16_t*)(ws + WS_XN2), p->in[I_NORMG] + (size_t)(layer * 2) * D, (bf16_t*)(ws + WS_XN)); PHASE_END
                PHASE_BEGIN {
                    pg8::Gemm g{(const bf16_t*)(ws + WS_XN2), (const bf16_t*)(ws + WS_WKVT), R, NKV, 1024, 1024};
                    pg8::GroupOrder S; S.init((int)gridDim.x, (int)blockIdx.x); S.add(0, 0, 66, 0, 6);
                    pg8::EpiF32G E{(float*)(ws + WS_KVF), nullptr, nullptr, nullptr, NKV, 1 << 20, 0};
                    pg8::gemm_phase<pg8::EpiF32G, pg8::GroupOrder, true, true>(c.lds, g, S, E, c.tid);
                } PHASE_END
                PHASE_BEGIN phase_kvpost(p, c); PHASE_END
                PHASE_BEGIN {
                    pg8::Gemm g{(const bf16_t*)(ws + WS_CMPA), (const bf16_t*)(ws + WS_CW1T), (int)CMPA_ROWS, 512, 1024, 1024};
                    pg8::GroupOrder S; S.init((int)gridDim.x, (int)blockIdx.x); S.add(0, 0, 16, 0, 1); S.add(1, 16, 16, 1, 1); S.add(2, 32, 256, 0, 1); S.add(3, 288, 256, 1, 1);
                    pg8::EpiF32G E{(float*)(ws + WS_PCMP), (float*)(ws + WS_PCMP), nullptr, nullptr, 256, 1, 0};
                    pg8::gemm_phase<pg8::EpiF32G, pg8::GroupOrder, true, true>(c.lds, g, S, E, c.tid);
                } PHASE_END
                PHASE_BEGIN phase_cmp2(p, c); PHASE_END
            } else {
                PHASE_BEGIN phase_norm(c, X, p->in[I_NORMG] + (size_t)(layer * 2) * D, (bf16_t*)(ws + WS_XN), nullptr, nullptr); PHASE_END
            }
            PHASE_BEGIN {
                const bf16_t* XNp = (const bf16_t*)(ws + WS_XN); const bf16_t* Wq = (const bf16_t*)(ws + WS_WQT) + (size_t)lb * NQP * 1024; float* QFp = (float*)(ws + WS_QF);
                pg8::Gemm g{XNp, Wq, R, NQP, 1024, 1024};
                pg8::GroupOrder S; S.init((int)gridDim.x, (int)blockIdx.x); S.add(0, 0, 64, 0, 4);
                pg8::EpiF32G E{QFp, nullptr, nullptr, nullptr, NQP, 1 << 20, 0};
                pg8::gemm_phase<pg8::EpiF32G, pg8::GroupOrder, true, true>(c.lds, g, S, E, c.tid);
                float* GATEp = (float*)(ws + WS_GATE);
                for (int it = blockIdx.x + gridDim.x * c.wave; it < 256 + R / 32; it += c.ngw) { const int ln = launder_v(c.lane), fr = ln & 15, fq = ln >> 4;
                    if (it < 256) { const int row0 = MP + 32 * (it & 15), col0 = 64 * (it >> 4);
                        f32x4 acc[4][2]; skinny_mma<4>(XNp, 1024, Wq, 1024, 1024, row0, col0, ln, acc);
#pragma unroll
                        for (int nt = 0; nt < 4; ++nt)
#pragma unroll
                            for (int mt = 0; mt < 2; ++mt) *(f32x4*)(QFp + (size_t)(row0 + 16 * mt + fr) * NQP + col0 + 16 * nt + 4 * fq) = acc[nt][mt]; }
                    else { const int row0 = 32 * (it - 256);
                        f32x4 acc[3][2]; skinny_mma<3>(XNp, 1024, Wq, 1024, 1024, row0, 1024, ln, acc);
#pragma unroll
                        for (int nt = 0; nt < 3; ++nt)
#pragma unroll
                            for (int mt = 0; mt < 2; ++mt) { f32x4 v = acc[nt][mt];
#pragma unroll
                                for (int e = 0; e < 4; ++e) v[e] = sigmoidf_(v[e]);
                                *(f32x4*)(GATEp + (size_t)(row0 + 16 * mt + fr) * 48 + 16 * nt + 4 * fq) = v; } }
                }
            } PHASE_END
            PHASE_BEGIN phase_qpost(p, c, lb); PHASE_END
            PHASE_BEGIN phase_attn_prompt(p, c); PHASE_END
#ifdef PROBE_ATTN2
            PHASE_BEGIN phase_attn_prompt(p, c, PROBE_ATTN2); PHASE_END
#endif
            PHASE_BEGIN phase_attn_sample(p, c); PHASE_END
        }
        PHASE_BEGIN {
            const bf16_t* Wt = layer < 2 ? (const bf16_t*)(ws + WS_WORW) + (size_t)layer * 1024 * 1024 : (const bf16_t*)(ws + WS_WONSA) + (size_t)(layer - 2) * 1024 * 1024;
            pg8::Gemm g{(const bf16_t*)(ws + WS_YG), Wt, R, 1024, 1024, 1024};
            pg8::GroupOrder S; S.init((int)gridDim.x, (int)blockIdx.x); S.add(0, 0, 64, 0, 4);
            pg8::EpiResid E{X, D};
            pg8::gemm_phase<pg8::EpiResid, pg8::GroupOrder, true, true>(c.lds, g, S, E, c.tid);
            skinny_resid_sample(c, (const bf16_t*)(ws + WS_YG), 1024, Wt, 1024, X);
        } PHASE_END
        PHASE_BEGIN phase_norm(c, X, p->in[I_NORMG] + (size_t)(layer * 2 + 1) * D, (bf16_t*)(ws + WS_XN), nullptr, nullptr); PHASE_END
        PHASE_BEGIN {
            pg8::Gemm g{(const bf16_t*)(ws + WS_XN), (const bf16_t*)(ws + WS_WINT) + (size_t)layer * 5632 * 1024, R, 5632, 1024, 1024};
            pg8::GroupOrder S; S.init((int)gridDim.x, (int)blockIdx.x); S.add(0, 0, 66, 0, 22);
            pg8::EpiWin E{(bf16_t*)(ws + WS_U), (bf16_t*)(ws + WS_GT), p->out + O_CVP + (size_t)layer * NB * 2 * DFF, p->out + O_CVS + (size_t)layer * SB * 2 * DFF};
            pg8::gemm_phase<pg8::EpiWin, pg8::GroupOrder, true, true>(c.lds, g, S, E, c.tid);
        } PHASE_END
        PHASE_BEGIN phase_conv(p, c, layer); PHASE_END
        PHASE_BEGIN {
            pg8::Gemm g{(const bf16_t*)(ws + WS_HH), (const bf16_t*)(ws + WS_WOUTT) + (size_t)layer * 1024 * 2816, R, 1024, 2816, 2816};
            pg8::GroupOrder S; S.init((int)gridDim.x, (int)blockIdx.x); S.add(0, 0, 64, 0, 4);
            pg8::EpiResid E{X, D};
            pg8::gemm_phase<pg8::EpiResid, pg8::GroupOrder, true, true>(c.lds, g, S, E, c.tid);
            skinny_resid_sample(c, (const bf16_t*)(ws + WS_HH), 2816, (const bf16_t*)(ws + WS_WOUTT) + (size_t)layer * 1024 * 2816, 2816, X);
        } PHASE_END
    }
#ifdef SELFTEST
    PHASE_BEGIN if (blockIdx.x == 0 && c.wave == 0) { const float x = (float)((c.lane * 37) & 63) + 1.0f; float poison = 0.f;
        if (__ballot(swz_xor16_n(x) != __shfl_xor(x, 16))) poison += 1e3f;
        if (__ballot(sum_xor32_n(x) != x + __shfl_xor(x, 32))) poison += 1e4f;
        if (__ballot(sum_rows4_n(x) != x + __shfl_xor(x, 16) + __shfl_xor(x, 32) + __shfl_xor(x, 48))) poison += 1e5f;
        if (__ballot(wave_sum_n(x) != 2080.0f)) poison += 1e6f;
        if (__ballot(wave_max_n(x) != 64.0f)) poison += 1e7f;
        if (c.lane == 0) p->out[O_CVS] += poison; } PHASE_END
#endif
#ifdef PROBE_SCALE
    PHASE_BEGIN for (size_t e = c.gtid; e < O_END; e += c.gsz) { int oi = e < O_KV ? (e < (size_t)MP * D ? 0 : 1) : e < O_WINP ? (e < O_KV + (size_t)MP * D ? 2 : 3) : e < O_WINS ? 4 : e < O_WKVP ? 5 : e < O_WKVS ? 6 : e < O_SHP ? 7 : e < O_SHS ? 8 : e < O_CVP ? 9 : e < O_CVS ? 10 : 11;
        if (PROBE_SCALE < 0) oi = 11 - oi; p->out[e] *= 1.0f + sqrtf(0.5e-4f * (float)(oi + 1)); } PHASE_END
#endif
#undef PHASE_BEGIN
#undef PHASE_END
}

extern "C" void kernel_launch(void* const* d_in, const int* in_sizes, int n_in, void* d_out, int out_size, void* d_ws, size_t ws_size, hipStream_t stream) {
    static int grid = 0;
    if (grid == 0) {
        if (n_in != 45 || (size_t)out_size != O_END || ws_size < WS_END) { fprintf(stderr, "kernel_launch: unexpected shapes (n_in %d out %d ws %zu need %zu)\n", n_in, out_size, ws_size, (size_t)WS_END); grid = -1; return; }
        int dev = 0, cus = 0, per_cu = 0;
        if (hipGetDevice(&dev) != hipSuccess || hipDeviceGetAttribute(&cus, hipDeviceAttributeMultiprocessorCount, dev) != hipSuccess) { grid = -1; return; }
        if (hipFuncSetAttribute((const void*)mega, hipFuncAttributeMaxDynamicSharedMemorySize, LDS_BYTES) != hipSuccess) { fprintf(stderr, "kernel_launch: hipFuncSetAttribute failed\n"); grid = -1; return; }
        if (hipOccupancyMaxActiveBlocksPerMultiprocessor(&per_cu, (const void*)mega, 512, LDS_BYTES) != hipSuccess || per_cu < 1) { fprintf(stderr, "kernel_launch: occupancy query says %d\n", per_cu); (void)hipGetLastError(); }
        grid = cus;
    }
    if (grid < 0) return;
    (void)hipMemsetAsync((char*)d_ws + WS_CTL, 0, CTL_BYTES, stream);
    Params p{};
    for (int i = 0; i < 45; ++i) p.in[i] = (const float*)d_in[i];
    p.out = (float*)d_out; p.ws = (unsigned char*)d_ws;
#ifdef PROBE_PRE
    { const int plist[] = PROBE_PRE; for (int i = 0; i < (int)(sizeof(plist) / sizeof(int)); ++i) { p.ph_lo = plist[i] % 100; p.ph_hi = p.ph_lo + 1; p.use_bar = 0; p.pad = plist[i] / 100;       hipLaunchKernelGGL(mega, dim3(grid), dim3(512), LDS_BYTES, stream, p); } }
#endif
    p.pad = 0;
#if MK_MULTI
    for (int i = 0; i < NPH; ++i) { p.ph_lo = i; p.ph_hi = i + 1; p.use_bar = 0; hipLaunchKernelGGL(mega, dim3(grid), dim3(512), LDS_BYTES, stream, p); }
#else
    p.ph_lo = 0; p.ph_hi = NPH; p.use_bar = 1;
    hipLaunchKernelGGL(mega, dim3(grid), dim3(512), LDS_BYTES, stream, p);
#endif
    const hipError_t le = hipPeekAtLastError();
    if (le != hipSuccess) fprintf(stderr, "kernel_launch: launch failed: %s\n", hipGetErrorName(le));
}
```

```cpp
#include <hip/hip_runtime.h>
#include <cstdio>
#include <cstdint>

#define LAS __attribute__((address_space(3)))
#define GAS __attribute__((address_space(1)))
typedef unsigned short bf16_t;
typedef short bf16x8 __attribute__((ext_vector_type(8)));
typedef float f32x4 __attribute__((ext_vector_type(4)));
typedef float f32x16 __attribute__((ext_vector_type(16)));
typedef float f32x2 __attribute__((ext_vector_type(2)));
typedef unsigned u32x4 __attribute__((ext_vector_type(4)));
typedef unsigned u32x2 __attribute__((ext_vector_type(2)));

constexpr int D = 1024, NB = 2, TP = 8192, MP = NB * TP, SB = 128, ST = 4, MS = SB * ST, R = MP + MS;
constexpr int PAST = 2048, PAGE = 128, NPAGES = PAST / PAGE;
constexpr int H = 16, HD = 64, G = 4, HPG = 4, DFF = 2816, NLAY = 4;
constexpr int LW_ = 64, LA_ = 64, LV_ = 32, LG_ = 128, LHID = 288;
constexpr int NKV = 1536, NQ = 1072, NQP = 1280;
constexpr int NCH = TP / 64;
constexpr int NUNIT_A = NB * NCH * H;
constexpr int NCMP_P = 511, NCMP_S = 127, WIN = 512;
constexpr float NORM_EPS = 1e-6f, GN_EPS = 64e-5f;

constexpr size_t O_Y = 0;
constexpr size_t O_KV = (size_t)R * D;
constexpr size_t O_WINP = O_KV + (size_t)R * D;
constexpr size_t O_WINS = O_WINP + (size_t)NB * 512 * 512;
constexpr size_t O_WKVP = O_WINS + (size_t)SB * 512 * 512;
constexpr size_t O_WKVS = O_WKVP + (size_t)2 * NB * H * 4096;
constexpr size_t O_SHP = O_WKVS + (size_t)2 * SB * H * 4096;
constexpr size_t O_SHS = O_SHP + (size_t)2 * NB * D;
constexpr size_t O_CVP = O_SHS + (size_t)2 * SB * D;
constexpr size_t O_CVS = O_CVP + (size_t)NLAY * NB * 2 * DFF;
constexpr size_t O_END = O_CVS + (size_t)NLAY * SB * 2 * DFF;
static_assert(O_END == 88915968, "output size");

constexpr size_t MiB = 1u << 20;
constexpr size_t al(size_t x) { return (x + 4095) & ~(size_t)4095; }
constexpr size_t WS_CTL = 0, CTL_BYTES = 1 * MiB;
constexpr size_t WS_WRKV = WS_CTL + CTL_BYTES;
constexpr size_t WS_WORW = WS_WRKV + al((size_t)2 * 3072 * 1024 * 2);
constexpr size_t WS_W1T = WS_WORW + al((size_t)2 * 1024 * 1024 * 2);
constexpr size_t WS_W2W = WS_W1T + al((size_t)2 * 288 * 1024 * 2);
constexpr size_t WS_W2A = WS_W2W + al((size_t)2 * 1024 * 64 * 2);
constexpr size_t WS_W2V = WS_W2A + al((size_t)2 * 1024 * 64 * 2);
constexpr size_t WS_W2G = WS_W2V + al((size_t)1024 * 32 * 2);
constexpr size_t WS_WKVT = WS_W2G + al((size_t)2 * 1024 * 128 * 2);
constexpr size_t WS_WQT = WS_WKVT + al((size_t)1536 * 1024 * 2);
constexpr size_t WS_WONSA = WS_WQT + al((size_t)2 * 1280 * 1024 * 2);
constexpr size_t WS_WINT = WS_WONSA + al((size_t)2 * 1024 * 1024 * 2);
constexpr size_t WS_WOUTT = WS_WINT + al((size_t)4 * 5632 * 1024 * 2);
constexpr size_t WS_CW1T = WS_WOUTT + al((size_t)4 * 1024 * 2816 * 2);
constexpr size_t WS_CBIAS = WS_CW1T + al((size_t)2 * 256 * 1024 * 2);
constexpr size_t WS_CW2T = WS_CBIAS + al(2 * 128 * 4);
constexpr size_t WS_XM = WS_CW2T + al(2 * 2 * 64 * 128 * 2);
constexpr size_t WS_RK_R = WS_XM + al((size_t)6 * R * D * 2);
constexpr size_t WS_RK_K = WS_RK_R + al((size_t)R * D * 4);
constexpr size_t WS_V0 = WS_RK_K + al((size_t)R * D * 4);
constexpr size_t WS_V1 = WS_V0 + al((size_t)R * D * 4);
constexpr size_t WS_HID = WS_V1 + al((size_t)R * D * 4);
constexpr size_t WS_MT = WS_HID + al((size_t)R * LHID * 2);
constexpr size_t WS_NN = WS_MT + al((size_t)NUNIT_A * 4096 * 4);
constexpr size_t WS_RP = WS_NN + al((size_t)NUNIT_A * 4096 * 4);
constexpr size_t WS_YL = WS_RP + al((size_t)NUNIT_A * 4096 * 2);
constexpr size_t WS_S0 = WS_YL + al((size_t)NUNIT_A * 4096 * 4);
constexpr size_t WS_RKS = WS_S0 + al((size_t)NUNIT_A * 4096 * 2);
constexpr size_t WS_YG = WS_RKS + al((size_t)R * 16 * 4);
constexpr size_t WS_XN = WS_YG + al((size_t)R * D * 2);
constexpr size_t WS_XN2 = WS_XN + al((size_t)R * D * 2);
constexpr size_t WS_U = WS_XN2 + al((size_t)R * D * 2);
constexpr size_t WS_GT = WS_U + al((size_t)R * DFF * 2);
constexpr size_t WS_HH = WS_GT + al((size_t)R * DFF * 2);
constexpr size_t WS_KVF = WS_HH + al((size_t)R * DFF * 2);
constexpr size_t WS_CMPA = WS_KVF + al((size_t)R * NKV * 4);
constexpr size_t CMPA_ROWS = 4096 + 4096 + 65536 + 65536;
constexpr size_t WS_PCMP = WS_CMPA + al(CMPA_ROWS * 1024 * 2);
constexpr size_t WS_KS = WS_PCMP + al(CMPA_ROWS * 256 * 4);
constexpr size_t WS_VS = WS_KS + al((size_t)NB * G * TP * 64 * 2);
constexpr size_t WS_KW = WS_VS + al((size_t)NB * G * TP * 64 * 2);
constexpr size_t WS_VW = WS_KW + al((size_t)NB * G * TP * 64 * 2);
constexpr size_t WS_CK = WS_VW + al((size_t)NB * G * TP * 64 * 2);
constexpr size_t WS_CV = WS_CK + al((size_t)NB * G * 512 * 64 * 2);
constexpr size_t WS_CKS = WS_CV + al((size_t)NB * G * 512 * 64 * 2);
constexpr size_t WS_CVS = WS_CKS + al((size_t)SB * G * 128 * 64 * 4);
constexpr size_t WS_QF = WS_CVS + al((size_t)SB * G * 128 * 64 * 4);
constexpr size_t WS_Q = WS_QF + al((size_t)R * NQP * 4);
constexpr size_t WS_GATE = WS_Q + al((size_t)R * D * 2);
constexpr size_t WS_END = WS_GATE + al((size_t)R * 48 * 4);

typedef __bf16 bf16v2_ __attribute__((ext_vector_type(2)));
__device__ __forceinline__ unsigned cvt_pk_bf16_(float lo, float hi) { const f32x2 v = {lo, hi}; const bf16v2_ b = __builtin_convertvector(v, bf16v2_); return __builtin_bit_cast(unsigned, b); }
__device__ __forceinline__ unsigned f2bf(float f) { return cvt_pk_bf16_(f, f) & 0xffffu; }
__device__ __forceinline__ unsigned pk2(float lo, float hi) { return cvt_pk_bf16_(lo, hi); }
__device__ __forceinline__ float frcp(float x) { return __builtin_amdgcn_rcpf(x); }
__device__ __forceinline__ float frsq(float x) { return __builtin_amdgcn_rsqf(x); }
__device__ __forceinline__ float bf2f(unsigned short b) { return __builtin_bit_cast(float, ((unsigned)b) << 16); }
__device__ __forceinline__ float bflo(unsigned w) { return __builtin_bit_cast(float, w << 16); }
__device__ __forceinline__ float bfhi(unsigned w) { return __builtin_bit_cast(float, w & 0xffff0000u); }
template <int CTRL> __device__ __forceinline__ float dpp_f(float x) { return __builtin_bit_cast(float, __builtin_amdgcn_update_dpp(0, __builtin_bit_cast(int, x), CTRL, 0xF, 0xF, true)); }
__device__ __forceinline__ float row16_sum(float v) { v += dpp_f<0xB1>(v); v += dpp_f<0x4E>(v); v += dpp_f<0x141>(v); v += dpp_f<0x140>(v); return v; }
__device__ __forceinline__ float row16_max(float v) { v = fmaxf(v, dpp_f<0xB1>(v)); v = fmaxf(v, dpp_f<0x4E>(v)); v = fmaxf(v, dpp_f<0x141>(v)); v = fmaxf(v, dpp_f<0x140>(v)); return v; }
__device__ __forceinline__ float swz_xor16_n(float x) { return __builtin_bit_cast(float, __builtin_amdgcn_ds_swizzle(__builtin_bit_cast(int, x), 0x401F)); }
__device__ __forceinline__ float sum_xor32_n(float x) { auto rr = __builtin_amdgcn_permlane32_swap(__float_as_uint(x), __float_as_uint(x), false, false);
    return __uint_as_float(rr[0]) + __uint_as_float(rr[1]); }
__device__ __forceinline__ float sum_rows4_n(float x) { x += swz_xor16_n(x); return sum_xor32_n(x); }
__device__ __forceinline__ float wave_sum_n(float v) {
    v = row16_sum(v);
    v += __builtin_bit_cast(float, __builtin_amdgcn_update_dpp(0, __builtin_bit_cast(int, v), 0x142, 0xA, 0xF, false));
    v += __builtin_bit_cast(float, __builtin_amdgcn_update_dpp(0, __builtin_bit_cast(int, v), 0x143, 0xC, 0xF, false));
    return __builtin_bit_cast(float, __builtin_amdgcn_readlane(__builtin_bit_cast(int, v), 63));
}
__device__ __forceinline__ float wave_max_n(float v) {
    v = row16_max(v);
    v = fmaxf(v, __builtin_bit_cast(float, __builtin_amdgcn_update_dpp(__builtin_bit_cast(int, v), __builtin_bit_cast(int, v), 0x142, 0xA, 0xF, false)));
    v = fmaxf(v, __builtin_bit_cast(float, __builtin_amdgcn_update_dpp(__builtin_bit_cast(int, v), __builtin_bit_cast(int, v), 0x143, 0xC, 0xF, false)));
    return __builtin_bit_cast(float, __builtin_amdgcn_readlane(__builtin_bit_cast(int, v), 63));
}
#define XLANE_NEW 1
#ifdef XLANE_NEW
__device__ __forceinline__ float swz_xor16(float x) { return __builtin_bit_cast(float, __builtin_amdgcn_ds_swizzle(__builtin_bit_cast(int, x), 0x401F)); }
__device__ __forceinline__ float sum_xor32(float x) { return sum_xor32_n(x); }
__device__ __forceinline__ float sum_rows4(float x) { x += swz_xor16(x); return sum_xor32(x); }
__device__ __forceinline__ float wave_sum(float v) {
    v = row16_sum(v);
    v += __builtin_bit_cast(float, __builtin_amdgcn_update_dpp(0, __builtin_bit_cast(int, v), 0x142, 0xA, 0xF, false));
    v += __builtin_bit_cast(float, __builtin_amdgcn_update_dpp(0, __builtin_bit_cast(int, v), 0x143, 0xC, 0xF, false));
    return __builtin_bit_cast(float, __builtin_amdgcn_readlane(__builtin_bit_cast(int, v), 63));
}
__device__ __forceinline__ float wave_max(float v) {
    v = row16_max(v);
    v = fmaxf(v, __builtin_bit_cast(float, __builtin_amdgcn_update_dpp(__builtin_bit_cast(int, v), __builtin_bit_cast(int, v), 0x142, 0xA, 0xF, false)));
    v = fmaxf(v, __builtin_bit_cast(float, __builtin_amdgcn_update_dpp(__builtin_bit_cast(int, v), __builtin_bit_cast(int, v), 0x143, 0xC, 0xF, false)));
    return __builtin_bit_cast(float, __builtin_amdgcn_readlane(__builtin_bit_cast(int, v), 63));
}
#else
__device__ __forceinline__ float sum_xor32(float x) { return x + __shfl_xor(x, 32); }
__device__ __forceinline__ float sum_rows4(float x) { x += __shfl_xor(x, 16); x += __shfl_xor(x, 32); return x; }
__device__ __forceinline__ float wave_sum(float v) { v = row16_sum(v); v += __shfl_xor(v, 16); v += __shfl_xor(v, 32); return v; }
__device__ __forceinline__ float wave_max(float v) { v = row16_max(v); v = fmaxf(v, __shfl_xor(v, 16)); v = fmaxf(v, __shfl_xor(v, 32)); return v; }
#endif
__device__ __forceinline__ float sigmoidf_(float x) { return frcp(1.0f + __builtin_amdgcn_exp2f(-1.4426950408889634f * x)); }
__device__ __forceinline__ float gelu_tanh(float x) {
    const float u = 0.7978845608028654f * (x + 0.044715f * x * x * x);
    const float e = __builtin_amdgcn_exp2f(2.8853900817779268f * u);
    const float th = 1.0f - 2.0f * frcp(e + 1.0f);
    return 0.5f * x * (1.0f + th);
}
template <class T> __device__ __forceinline__ const T* launder_p(const T* q) { asm volatile("" : "+v"(q)); return q; }
__device__ __forceinline__ int launder_v(int x) { asm volatile("" : "+v"(x)); return x; }
#define LDS_WAIT() asm volatile("s_waitcnt lgkmcnt(0)" ::: "memory")
#define VM_WAIT() asm volatile("s_waitcnt vmcnt(0)" ::: "memory")
__device__ __forceinline__ f32x4 mfma16(bf16x8 a, bf16x8 b, f32x4 c) { return __builtin_amdgcn_mfma_f32_16x16x32_bf16(a, b, c, 0, 0, 0); }
__device__ __forceinline__ f32x16 mfma32(bf16x8 a, bf16x8 b, f32x16 c) { return __builtin_amdgcn_mfma_f32_32x32x16_bf16(a, b, c, 0, 0, 0); }
#define XB_TMO      128
#define XB_XCNT(j)  (256  + 64 * (j))
#define XB_XSUB(j)  (1280 + 64 * (j))
#define XB_XGEN(j)  (2304 + 64 * (j))
#define XB_TOP      3328
#define XB_TOPGEN   3392
#define XCD_BAR_WORDS 3456
#define XB_SPIN_CAP (1u << 18)

__device__ __forceinline__ unsigned xb_ld(unsigned* p)              { return __hip_atomic_load(p, __ATOMIC_RELAXED, __HIP_MEMORY_SCOPE_AGENT); }
__device__ __forceinline__ unsigned xb_add(unsigned* p, unsigned v) { return __hip_atomic_fetch_add(p, v, __ATOMIC_RELAXED, __HIP_MEMORY_SCOPE_AGENT); }
__device__ __forceinline__ unsigned xb_xcc_id() { return (unsigned)__builtin_amdgcn_s_getreg((3 << 11) | 20) & 0xFu; }
#define XB_SPIN(cond, bar) do { unsigned _sp = 0; while (cond) { __builtin_amdgcn_s_sleep(1); \
    if ((++_sp & 255u) == 0u) { if (xb_ld(&(bar)[XB_TMO])) break; if (_sp > XB_SPIN_CAP) { atomicAdd(&(bar)[XB_TMO], 1u); break; } } } } while (0)

struct XcdBarrier {
    unsigned* bar; unsigned x;
    volatile LAS unsigned* st;
};

__device__ __forceinline__ XcdBarrier xcd_barrier_post(unsigned* bar, volatile LAS unsigned* st) {
    XcdBarrier b; b.bar = bar; b.x = xb_xcc_id(); b.st = st;
    if (threadIdx.x == 0) (void)xb_add(&bar[XB_XCNT(b.x)], 1u);
    return b;
}
__device__ __forceinline__ void xcd_barrier_complete(unsigned* bar, unsigned x, unsigned& nloc, unsigned& nx) {
    const unsigned G = gridDim.x * gridDim.y * gridDim.z;
    unsigned sum, cnt, mine, sp = 0u;
    for (;;) {
        sum = 0u; cnt = 0u; mine = 0u;
#pragma unroll
        for (unsigned j = 0; j < 16; ++j) { const unsigned c = xb_ld(&bar[XB_XCNT(j)]); sum += c; cnt += (c > 0u) ? 1u : 0u; mine = (j == x) ? c : mine; }
        if (sum == G) break;
        __builtin_amdgcn_s_sleep(1);
        if ((++sp & 255u) == 0u) { if (xb_ld(&bar[XB_TMO])) break; if (sp > XB_SPIN_CAP) { atomicAdd(&bar[XB_TMO], 1u); break; } }
    }
    nloc = mine > 0u ? mine : 1u; nx = cnt > 0u ? cnt : 1u;
}

__device__ __forceinline__ void xcd_barrier(const XcdBarrier& b, const bool t0) {
    asm volatile("s_waitcnt vmcnt(0)" ::: "memory");
    __syncthreads();
    if (t0) {
        unsigned* bar = b.bar;
        __builtin_amdgcn_s_waitcnt(0);
        unsigned nloc = b.st[0], nx = b.st[1];
        if (nloc == 0u) { xcd_barrier_complete(bar, b.x, nloc, nx); b.st[0] = nloc; b.st[1] = nx; }
        const unsigned old = xb_add(&bar[XB_XSUB(b.x)], 1u);
        const unsigned gen = old / nloc;
        if (old + 1u == (gen + 1u) * nloc) {
            __builtin_amdgcn_fence(__ATOMIC_RELEASE, "agent");
            asm volatile("s_waitcnt vmcnt(0)" ::: "memory");
            const unsigned og = xb_add(&bar[XB_TOP], 1u);
            const unsigned tg = og / nx;
            if (og + 1u == (tg + 1u) * nx) xb_add(&bar[XB_TOPGEN], 1u);
            else XB_SPIN(xb_ld(&bar[XB_TOPGEN]) == tg, bar);
            __builtin_amdgcn_fence(__ATOMIC_ACQUIRE, "agent");
            xb_add(&bar[XB_XGEN(b.x)], 1u);
            asm volatile("s_waitcnt vmcnt(0)" ::: "memory");
        } else {
            XB_SPIN(xb_ld(&bar[XB_XGEN(b.x)]) == gen, bar);
            __builtin_amdgcn_fence(__ATOMIC_ACQUIRE, "agent");
            asm volatile("s_waitcnt vmcnt(0)" ::: "memory");
        }
    }
    __syncthreads();
}

namespace pg8 {
#define PG8_LAS __attribute__((address_space(3)))
constexpr int BM = 256, BK = 64, HALF = 128, HTB = HALF * BK * 2  , STAGE_BYTES = 8 * HTB, NXCD = 8, WGM = 8;
__host__ __device__ __forceinline__ int lds_byte(int r, int c) { const int st = (r >> 4) * 2 + (c >> 5), rr = r & 15, cc = c & 31, ob = rr * 64 + cc * 2; return st * 1024 + (ob ^ (((ob >> 9) & 1) << 5)); }
__host__ __device__ __forceinline__ void stage_rc(int b, int& R_, int& C_) { const int st = b / 1024, sb = b % 1024, swz = sb ^ (((sb >> 9) & 1) << 5); R_ = (st >> 1) * 16 + swz / 64; C_ = (st & 1) * 32 + (swz % 64) / 2; }
__host__ __device__ __forceinline__ int perm32(int rho) { const int n = rho >> 4, i = rho & 15; return 8 * (i >> 2) + 4 * n + (i & 3); }

struct Unit { int pm, pn, kb, nt; };
struct Gemm { const bf16_t* A; const bf16_t* Bt; int M, N, K, KL; };

struct GroupOrder {
    int pm0[4], nM[4], pn0[4], nN[4]; int nseg, nwg, G_, c;
    __device__ __forceinline__ void init(int G__, int c_) { nseg = 0; nwg = 0; G_ = G__; c = c_;
#pragma unroll
        for (int s = 0; s < 4; ++s) { pm0[s] = 0; nM[s] = 0; pn0[s] = 0; nN[s] = 1; } }
    __device__ __forceinline__ void add(int s, int pm0_, int nM_, int pn0_, int nN_) { pm0[s] = pm0_; nM[s] = nM_; pn0[s] = pn0_; nN[s] = nN_; nwg += nM_ * nN_; nseg = s + 1; }
    __device__ __forceinline__ bool next(int i, Unit& u) const {
        const long L = (long)i * G_ + c; if (L >= nwg) return false;
        int id = (int)L; { const int q = nwg / NXCD, r = nwg % NXCD, xcd = id % NXCD, off = id / NXCD; id = (xcd < r ? xcd * (q + 1) : r * (q + 1) + (xcd - r) * q) + off; }
        int spm0 = 0, snM = 1, spn0 = 0, snN = 1; bool found = false;
#pragma unroll
        for (int s = 0; s < 4; ++s) { const int cnt = nM[s] * nN[s]; if (!found) { if (id < cnt) { found = true; spm0 = pm0[s]; snM = nM[s]; spn0 = pn0[s]; snN = nN[s]; } else id -= cnt; } }
        const int nig = WGM * snN, gid = id / nig, fm = gid * WGM, gsz = (snM - fm) < WGM ? (snM - fm) : WGM;
        u.pm = spm0 + fm + ((id % nig) % gsz); u.pn = spn0 + (id % nig) / gsz; u.kb = 0; u.nt = 0; return true;
    }
    __device__ __forceinline__ void a_ready(const Unit&) const {}
    __device__ __forceinline__ void done(const Unit&) const {}
};

struct ResidOrder {
    GroupOrder P; int nS, G_, c;
    __device__ __forceinline__ void init(int G__, int c_, int nS_) { P.init(G__, c_); P.add(0, 0, nS_ ? 64 : 66, 0, 4); nS = nS_; G_ = G__; c = c_; }
    __device__ __forceinline__ bool next(int i, Unit& u) const {
        const int npc = c < P.nwg ? (P.nwg - 1 - c) / G_ + 1 : 0;
        if (i < npc) return P.next(i, u);
        const int L = (i - npc) * G_ + (G_ - 1 - c); if (L >= 8 * nS) return false;
        const int sl = L >> 3, t = L & 7; u.pm = 64 + (t & 1); u.pn = t >> 1; u.kb = sl * 512; u.nt = 4; return true; }
    __device__ __forceinline__ void a_ready(const Unit&) const {}
    __device__ __forceinline__ void done(const Unit&) const {}
};
__device__ __forceinline__ unsigned cvt_pk_bf16(float lo, float hi) { return cvt_pk_bf16_(lo, hi); }

struct EpiF32G {
    static constexpr bool PERM = false, AFTER_DRAIN = false;
    float* b0; float* b1; float* b2; float* b3; int ldc, png, pmg;
    __device__ __forceinline__ void operator()(const f32x4 (&acc)[2][2][4][2], const Unit& u, int wr, int wc, int fr, int fq) const {
        const int j = u.pn / png; float* C = j == 0 ? b0 : (j == 1 ? b1 : (j == 2 ? b2 : b3));
        const int row0 = (u.pm - j * pmg) * BM + wr * 64 + fr, col0 = (u.pn - j * png) * BM + wc * 32 + 4 * fq;
#pragma unroll
        for (int ai = 0; ai < 2; ++ai)
#pragma unroll
            for (int m = 0; m < 4; ++m) { float* rowp = C + (size_t)(row0 + ai * HALF + m * 16) * ldc + col0;
#pragma unroll
                for (int bj = 0; bj < 2; ++bj)
#pragma unroll
                    for (int n = 0; n < 2; ++n) *(f32x4*)(rowp + bj * HALF + n * 16) = acc[ai][bj][m][n]; }
    }
};
struct EpiResid {
    static constexpr bool PERM = false, AFTER_DRAIN = false;
    float* X; int ldc;
    __device__ __forceinline__ void operator()(const f32x4 (&acc)[2][2][4][2], const Unit& u, int wr, int wc, int fr, int fq) const {
        const int row0 = u.pm * BM + wr * 64 + fr, col0 = u.pn * BM + wc * 32 + 4 * fq; const bool split = u.nt != 0;
#pragma unroll
        for (int ai = 0; ai < 2; ++ai)
#pragma unroll
            for (int m = 0; m < 4; ++m) { float* rowp = X + (size_t)(row0 + ai * HALF + m * 16) * ldc + col0;
                if (!split) {
#pragma unroll
                    for (int bj = 0; bj < 2; ++bj)
#pragma unroll
                        for (int n = 0; n < 2; ++n) { f32x4* p = (f32x4*)(rowp + bj * HALF + n * 16); *p = *p + acc[ai][bj][m][n]; } }
                else {
#pragma unroll
                    for (int bj = 0; bj < 2; ++bj)
#pragma unroll
                        for (int n = 0; n < 2; ++n) { float* q = rowp + bj * HALF + n * 16;
#pragma unroll
                            for (int e = 0; e < 4; ++e) __hip_atomic_fetch_add(q + e, acc[ai][bj][m][n][e], __ATOMIC_RELAXED, __HIP_MEMORY_SCOPE_AGENT); } }
                asm volatile("" ::: "memory"); }
    }
};
struct EpiWin {
    static constexpr bool PERM = true, AFTER_DRAIN = false;
    bf16_t* U; bf16_t* GT; float* cvp; float* cvs;
    __device__ __forceinline__ void operator()(const f32x4 (&acc)[2][2][4][2], const Unit& u, int wr, int wc, int fr, int fq) const {
        const bool isu = u.pn < 11; bf16_t* base = isu ? U : GT; const int colt = (isu ? u.pn : u.pn - 11) * BM;
        const int row0 = u.pm * BM + wr * 64 + fr, col0 = colt + wc * 32 + 8 * fq;
#pragma unroll
        for (int ai = 0; ai < 2; ++ai)
#pragma unroll
            for (int m = 0; m < 4; ++m) { const int row = row0 + ai * HALF + m * 16; bf16_t* rowp = base + (size_t)row * DFF + col0;
                float* cv = nullptr;
                if (isu) { if (row >= MP) { const int t = (row - MP) & 3, b = (row - MP) >> 2; if (t >= 2) cv = cvs + (size_t)(b * 2 + (t - 2)) * DFF; }
                           else { const int tt = row & (TP - 1); if (tt >= TP - 2) cv = cvp + (size_t)((row >> 13) * 2 + (tt - (TP - 2))) * DFF; } }
#pragma unroll
                for (int bj = 0; bj < 2; ++bj) { const f32x4 v0 = acc[ai][bj][m][0], v1 = acc[ai][bj][m][1];
                    u32x4 w; w.x = cvt_pk_bf16(v0[0], v0[1]); w.y = cvt_pk_bf16(v0[2], v0[3]); w.z = cvt_pk_bf16(v1[0], v1[1]); w.w = cvt_pk_bf16(v1[2], v1[3]);
                    *(u32x4*)(rowp + bj * HALF) = w;
                    if (cv) { *(f32x4*)(cv + col0 + bj * HALF) = v0; *(f32x4*)(cv + col0 + bj * HALF + 4) = v1; } } }
    }
};
template <class Epi, class Sched, bool ALIGN_EPI = false, bool SP2 = false>
__device__ __forceinline__ void gemm_phase(PG8_LAS unsigned char* lds, const Gemm g, const Sched& S, const Epi& E, int tid_in) {
    int tid_l = tid_in; asm volatile("" : "+v"(tid_l));
    const int tid = tid_l, wid = __builtin_amdgcn_readfirstlane(tid >> 6), lane = tid & 63, wr = wid >> 2, wc = wid & 3, fr = lane & 15, fq = lane >> 4;
    const int K = g.K, nt = g.KL / BK;
    unsigned voffA[2], voffB[2];
#pragma unroll
    for (int i = 0; i < 2; ++i) { int R, C; stage_rc(tid * 16 + i * 8192, R, C); const int Rb = Epi::PERM ? ((R & ~31) + perm32(R & 31)) : R;
        voffA[i] = (unsigned)(R * K + C) * 2u; voffB[i] = (unsigned)(Rb * K + C) * 2u; }
    const size_t kstep = (size_t)(BK * 2);
    const size_t hstep = (size_t)HALF * K * 2;
    const size_t tstep = 2 * hstep;
    const unsigned ldsw = (unsigned)wid * 1024u;
    const int aoff = lds_byte(wr * 64 + fr, fq * 8), boff = lds_byte(wc * 32 + fr, fq * 8);
#define PG8_SA(b, h) (((b) * 2 + (h)) * HTB)
#define PG8_SB(b, h) ((4 + (b) * 2 + (h)) * HTB)
#define PG8_STAGE(bufoff, gbase, voff) do { _Pragma("unroll") for (int _i = 0; _i < 2; ++_i) \
        __builtin_amdgcn_global_load_lds((const unsigned*)((const char*)(gbase) + (voff)[_i]), (PG8_LAS unsigned*)(lds + (bufoff) + ldsw + _i * 8192), 16, 0, 0); } while (0)
#define PG8_LDA(dst, b, h) do { _Pragma("unroll") for (int m = 0; m < 4; ++m) _Pragma("unroll") for (int k = 0; k < 2; ++k) dst[m][k] = *(const PG8_LAS bf16x8*)(lds + PG8_SA(b, h) + aoff + m * 2048 + k * 1024); } while (0)
#define PG8_LDB(dst, b, h) do { _Pragma("unroll") for (int n = 0; n < 2; ++n) _Pragma("unroll") for (int k = 0; k < 2; ++k) dst[n][k] = *(const PG8_LAS bf16x8*)(lds + PG8_SB(b, h) + boff + n * 2048 + k * 1024); } while (0)
#define PG8_MMA(ai, bj, At, Bt) do { __builtin_amdgcn_s_setprio(1); _Pragma("unroll") for (int m = 0; m < 4; ++m) _Pragma("unroll") for (int n = 0; n < 2; ++n) _Pragma("unroll") for (int k = 0; k < 2; ++k) \
        acc[ai][bj][m][n] = __builtin_amdgcn_mfma_f32_16x16x32_bf16(Bt[n][k], At[m][k], acc[ai][bj][m][n], 0, 0, 0); __builtin_amdgcn_s_setprio(0); } while (0)
#define PG8_WAIT_V(n) asm volatile("s_waitcnt vmcnt(" #n ")" ::: "memory")
#define PG8_WAIT_L(n) asm volatile("s_waitcnt lgkmcnt(" #n ")" ::: "memory")
#define PG8_BAR __builtin_amdgcn_s_barrier()
#define PG8_SCHED __builtin_amdgcn_sched_barrier(0)
    Unit cur, nxt; int ui = 0;
    if (!S.next(0, cur)) return;
    f32x4 acc[2][2][4][2];
#pragma unroll
    for (int a = 0; a < 2; ++a)
#pragma unroll
        for (int b = 0; b < 2; ++b)
#pragma unroll
            for (int m = 0; m < 4; ++m)
#pragma unroll
                for (int n = 0; n < 2; ++n) acc[a][b][m][n] = (f32x4){0.f, 0.f, 0.f, 0.f};
    bf16x8 At[4][2], B0[2][2], B1[2][2];
    const char* cA = (const char*)g.A + (size_t)cur.pm * tstep + cur.kb; const char* cB = (const char*)g.Bt + (size_t)cur.pn * tstep + cur.kb;
    S.a_ready(cur);
    if constexpr (SP2) {
        PG8_STAGE(PG8_SB(0, 0), cB, voffB); PG8_STAGE(PG8_SB(0, 1), cB + hstep, voffB); PG8_STAGE(PG8_SA(0, 0), cA, voffA); PG8_STAGE(PG8_SA(0, 1), cA + hstep, voffA);
        if (wr == 1) PG8_BAR;
        PG8_WAIT_V(2); PG8_BAR;
        PG8_STAGE(PG8_SB(1, 0), cB + kstep, voffB); PG8_STAGE(PG8_SA(1, 0), cA + kstep, voffA); PG8_STAGE(PG8_SB(1, 1), cB + hstep + kstep, voffB);
        PG8_WAIT_V(6); PG8_BAR;
    } else {
        PG8_STAGE(PG8_SB(0, 0), cB, voffB); PG8_STAGE(PG8_SA(0, 0), cA, voffA); PG8_STAGE(PG8_SB(0, 1), cB + hstep, voffB); PG8_STAGE(PG8_SA(0, 1), cA + hstep, voffA);
        if (wr == 1) PG8_BAR;
        PG8_WAIT_V(4); PG8_BAR;
        PG8_STAGE(PG8_SB(1, 0), cB + kstep, voffB); PG8_STAGE(PG8_SA(1, 0), cA + kstep, voffA); PG8_STAGE(PG8_SB(1, 1), cB + hstep + kstep, voffB);
        PG8_WAIT_V(6); PG8_BAR;
    }
    for (;;) {
        const bool has_next = S.next(ui + 1, nxt);
        const char* nA = has_next ? (const char*)g.A + (size_t)nxt.pm * tstep + nxt.kb : cA; const char* nB = has_next ? (const char*)g.Bt + (size_t)nxt.pn * tstep + nxt.kb : cB;
        const int ntu = cur.nt ? cur.nt : nt;
        for (int t = 0; t < ntu; t += 2) {
            const bool last = (t == ntu - 2);
            const char* a1 = cA + (size_t)(t + 1) * kstep;
            const char* a2 = last ? nA : cA + (size_t)(t + 2) * kstep; const char* b2 = last ? nB : cB + (size_t)(t + 2) * kstep;
            const char* a3 = a2 + kstep; const char* b3 = b2 + kstep;
            if (last && has_next) S.a_ready(nxt);
            if constexpr (SP2) {
            PG8_LDB(B0, 0, 0); PG8_LDB(B1, 0, 1); PG8_SCHED; PG8_LDA(At, 0, 0); PG8_STAGE(PG8_SA(1, 1), a1 + hstep, voffA);
            PG8_WAIT_V(8); PG8_WAIT_L(0); PG8_BAR; PG8_MMA(0, 0, At, B0); PG8_MMA(0, 1, At, B1); PG8_BAR; PG8_SCHED;
            PG8_LDA(At, 0, 1); PG8_STAGE(PG8_SB(0, 0), b2, voffB); PG8_STAGE(PG8_SB(0, 1), b2 + hstep, voffB); PG8_STAGE(PG8_SA(0, 0), a2, voffA);
            PG8_WAIT_V(8); PG8_WAIT_L(0); PG8_BAR; PG8_MMA(1, 0, At, B0); PG8_MMA(1, 1, At, B1); PG8_BAR; PG8_SCHED;
            PG8_LDB(B0, 1, 0); PG8_LDB(B1, 1, 1); PG8_SCHED; PG8_LDA(At, 1, 0); PG8_STAGE(PG8_SA(0, 1), a2 + hstep, voffA);
            PG8_WAIT_V(8); PG8_WAIT_L(0); PG8_BAR; PG8_MMA(0, 0, At, B0); PG8_MMA(0, 1, At, B1); PG8_BAR; PG8_SCHED;
            PG8_LDA(At, 1, 1); PG8_STAGE(PG8_SB(1, 0), b3, voffB); PG8_STAGE(PG8_SB(1, 1), b3 + hstep, voffB); PG8_STAGE(PG8_SA(1, 0), a3, voffA);
            PG8_WAIT_V(8); PG8_WAIT_L(0); PG8_BAR; PG8_MMA(1, 0, At, B0); PG8_MMA(1, 1, At, B1); PG8_BAR; PG8_SCHED;
            } else {
            PG8_LDB(B0, 0, 0); PG8_SCHED; PG8_LDA(At, 0, 0); PG8_STAGE(PG8_SA(1, 1), a1 + hstep, voffA);
            PG8_WAIT_L(8); PG8_BAR; PG8_WAIT_L(0); PG8_MMA(0, 0, At, B0); PG8_BAR; PG8_SCHED;
            PG8_LDB(B1, 0, 1); PG8_STAGE(PG8_SB(0, 0), b2, voffB);
            PG8_BAR; PG8_WAIT_L(0); PG8_MMA(0, 1, At, B1); PG8_BAR;
            PG8_LDA(At, 0, 1); PG8_STAGE(PG8_SA(0, 0), a2, voffA);
            PG8_BAR; PG8_WAIT_L(0); PG8_MMA(1, 0, At, B0); PG8_BAR; PG8_SCHED;
            PG8_STAGE(PG8_SB(0, 1), b2 + hstep, voffB);
            PG8_WAIT_V(6); PG8_BAR; PG8_MMA(1, 1, At, B1); PG8_BAR;
            PG8_LDB(B0, 1, 0); PG8_SCHED; PG8_LDA(At, 1, 0); PG8_STAGE(PG8_SA(0, 1), a2 + hstep, voffA);
            PG8_WAIT_L(8); PG8_BAR; PG8_WAIT_L(0); PG8_MMA(0, 0, At, B0); PG8_BAR; PG8_SCHED;
            PG8_LDB(B1, 1, 1); PG8_STAGE(PG8_SB(1, 0), b3, voffB);
            PG8_BAR; PG8_WAIT_L(0); PG8_MMA(0, 1, At, B1); PG8_BAR;
            PG8_LDA(At, 1, 1); PG8_STAGE(PG8_SA(1, 0), a3, voffA);
            PG8_BAR; PG8_WAIT_L(0); PG8_MMA(1, 0, At, B0); PG8_BAR; PG8_SCHED;
            PG8_STAGE(PG8_SB(1, 1), b3 + hstep, voffB);
            PG8_WAIT_V(6); PG8_BAR; PG8_MMA(1, 1, At, B1); PG8_BAR;
            }
        }
        if constexpr (ALIGN_EPI) { if (wr == 0) PG8_BAR; }
        if constexpr (!Epi::AFTER_DRAIN) { E(acc, cur, wr, wc, fr, fq); S.done(cur); }
        if (!has_next) break;
#pragma unroll
        for (int a = 0; a < 2; ++a)
#pragma unroll
            for (int b = 0; b < 2; ++b)
#pragma unroll
                for (int m = 0; m < 4; ++m)
#pragma unroll
                    for (int n = 0; n < 2; ++n) acc[a][b][m][n] = (f32x4){0.f, 0.f, 0.f, 0.f};
        cur = nxt; cA = nA; cB = nB; ++ui;
        if constexpr (ALIGN_EPI) { if (wr == 1) PG8_BAR; }
    }
    PG8_WAIT_V(0);
    if constexpr (!ALIGN_EPI) { if (wr == 0) PG8_BAR; }
    PG8_BAR;
    if constexpr (Epi::AFTER_DRAIN) { E.fused(acc, cur, wr, wc, fr, fq, lds, wid, lane); S.done(cur); }
#undef PG8_SA
#undef PG8_SB
#undef PG8_STAGE
#undef PG8_LDA
#undef PG8_LDB
#undef PG8_MMA
#undef PG8_WAIT_V
#undef PG8_WAIT_L
#undef PG8_BAR
#undef PG8_SCHED
}
}
constexpr int RING_BYTES = 131072, MISC_OFF = RING_BYTES + 320, LDS_BYTES = 147456;
struct Params { const float* in[45]; float* out; unsigned char* ws; int ph_lo, ph_hi, use_bar, pad; };
enum { I_XP = 0, I_XS, I_CKV, I_CWIN, I_SWKV, I_SSHIFT, I_SCONV, I_PT, I_NORMG, I_MU, I_WR, I_WK, I_WV, I_WO, I_W0, I_W1, I_W2, I_A0, I_A1, I_A2, I_V0, I_V1, I_V2, I_G1, I_G2,
       I_KK, I_KA, I_RKK, I_LNW, I_LNB, I_KVNG, I_WKV, I_KNG, I_PE, I_CW1, I_CB1, I_CW2, I_CB2, I_WQ, I_QNG, I_WONSA, I_WIN, I_CONVW, I_CONVB, I_WOUT };

typedef const __attribute__((address_space(4))) Params* KP;
struct Ctx { LAS unsigned char* lds; int tid, lane, wave, gw, ngw, gtid, gsz; };

__device__ __forceinline__ void p0_transpose_item(const float* W, int K, int ldw, int nblk, bf16_t* WT, int row_off, LAS float* scr, int item, int lane) {
    const int kb = item / nblk, nb = item % nblk, k0 = 64 * kb, n0 = 32 * nb;
#pragma unroll 8
    for (int i = 0; i < 32; ++i) { const int kk = 2 * i + (lane >> 5); scr[kk * 33 + (lane & 31)] = W[(size_t)(k0 + kk) * ldw + n0 + (lane & 31)]; }
    LDS_WAIT(); asm volatile("" ::: "memory");
    const int c = lane & 7;
#pragma unroll
    for (int j = 0; j < 4; ++j) { const int n = (lane >> 3) + 8 * j; const LAS float* s = scr + (8 * c) * 33 + n;
        u32x4 o; o.x = pk2(s[0 * 33], s[1 * 33]); o.y = pk2(s[2 * 33], s[3 * 33]); o.z = pk2(s[4 * 33], s[5 * 33]); o.w = pk2(s[6 * 33], s[7 * 33]);
        *(u32x4*)(WT + (size_t)(row_off + n0 + n) * K + k0 + 8 * c) = o; }
    LDS_WAIT(); asm volatile("" ::: "memory");
}

__device__ __forceinline__ void phase_prologue(KP p, const Ctx& c) {
    LAS float* scr = (LAS float*)(c.lds + c.wave * 16384);
    unsigned char* ws = p->ws;
    int total = 0;
#define TRCNT(K_, N_) (((K_) / 64) * ((N_) / 32))
    constexpr int C_DD = TRCNT(1024, 1024), C_L64 = TRCNT(1024, 64), C_L32 = TRCNT(1024, 32), C_L128 = TRCNT(1024, 128), C_2_64 = TRCNT(64, 1024), C_2_128 = TRCNT(128, 1024);
    constexpr int C_KV = TRCNT(1024, 1536), C_Q = 16 * 33, C_IN = TRCNT(1024, 5632), C_OUT = TRCNT(2816, 1024), C_CW = TRCNT(1024, 128);
    constexpr int NITEMS = 2 * (4 * C_DD + 2 * C_L64 + C_L128 + 2 * C_2_64 + C_2_128) + C_L32 + C_KV + 2 * C_Q + 2 * C_DD + 4 * C_IN + 4 * C_OUT + 4 * C_CW;
    (void)total;
    for (int it = c.gw; it < NITEMS; it += c.ngw) {
        int r = it;
#define TR(Wp, K_, LDW_, NBLK_, WTp, ROWOFF_) { const int cnt_ = ((K_) / 64) * (NBLK_); if (r < cnt_) { p0_transpose_item((Wp), (K_), (LDW_), (NBLK_), (bf16_t*)(WTp), (ROWOFF_), scr, r, c.lane); continue; } r -= cnt_; }
        bool done = false;
#pragma unroll
        for (int l = 0; l < 2; ++l) {
            if (done) break;
            const size_t dd = (size_t)l * 1024 * 1024;
#define TRL(Wp, K_, LDW_, NBLK_, WTp, ROWOFF_) { const int cnt_ = ((K_) / 64) * (NBLK_); if (!done) { if (r < cnt_) { p0_transpose_item((Wp), (K_), (LDW_), (NBLK_), (bf16_t*)(WTp), (ROWOFF_), scr, r, c.lane); done = true; } else r -= cnt_; } }
            TRL(p->in[I_WR] + dd, 1024, 1024, 32, ws + WS_WRKV + (size_t)l * 3072 * 1024 * 2, 0)
            TRL(p->in[I_WK] + dd, 1024, 1024, 32, ws + WS_WRKV + (size_t)l * 3072 * 1024 * 2, 1024)
            TRL(p->in[I_WV] + dd, 1024, 1024, 32, ws + WS_WRKV + (size_t)l * 3072 * 1024 * 2, 2048)
            TRL(p->in[I_WO] + dd, 1024, 1024, 32, ws + WS_WORW + (size_t)l * 1024 * 1024 * 2, 0)
            TRL(p->in[I_W1] + (size_t)l * 1024 * 64, 1024, 64, 2, ws + WS_W1T + (size_t)l * 288 * 1024 * 2, 0)
            TRL(p->in[I_A1] + (size_t)l * 1024 * 64, 1024, 64, 2, ws + WS_W1T + (size_t)l * 288 * 1024 * 2, 64)
            TRL(p->in[I_G1] + (size_t)l * 1024 * 128, 1024, 128, 4, ws + WS_W1T + (size_t)l * 288 * 1024 * 2, 160)
            TRL(p->in[I_W2] + (size_t)l * 64 * 1024, 64, 1024, 32, ws + WS_W2W + (size_t)l * 1024 * 64 * 2, 0)
            TRL(p->in[I_A2] + (size_t)l * 64 * 1024, 64, 1024, 32, ws + WS_W2A + (size_t)l * 1024 * 64 * 2, 0)
            TRL(p->in[I_G2] + (size_t)l * 128 * 1024, 128, 1024, 32, ws + WS_W2G + (size_t)l * 1024 * 128 * 2, 0)
        }
        if (done) continue;
        TR(p->in[I_V1], 1024, 32, 1, ws + WS_W1T + (size_t)1 * 288 * 1024 * 2, 128)
        TR(p->in[I_WKV], 1024, 1536, 48, ws + WS_WKVT, 0)
        TR(p->in[I_WQ], 1024, NQ, 33, ws + WS_WQT, 0)
        TR(p->in[I_WQ] + (size_t)1024 * NQ, 1024, NQ, 33, ws + WS_WQT + (size_t)NQP * 1024 * 2, 0)
        TR(p->in[I_WONSA], 1024, 1024, 32, ws + WS_WONSA, 0)
        TR(p->in[I_WONSA] + (size_t)1024 * 1024, 1024, 1024, 32, ws + WS_WONSA + (size_t)1024 * 1024 * 2, 0)
#pragma unroll
        for (int l = 0; l < 4; ++l) {
            if (done) break;
            TRL(p->in[I_WIN] + (size_t)l * 1024 * 5632, 1024, 5632, 176, ws + WS_WINT + (size_t)l * 5632 * 1024 * 2, 0)
            TRL(p->in[I_WOUT] + (size_t)l * 2816 * 1024, 2816, 1024, 32, ws + WS_WOUTT + (size_t)l * 1024 * 2816 * 2, 0)
        }
        if (done) continue;
        TR(p->in[I_CW1], 1024, 128, 4, ws + WS_CW1T, 0)
        TR(p->in[I_CW1] + (size_t)1024 * 128, 1024, 128, 4, ws + WS_CW1T, 128)
        TR(p->in[I_CW1] + (size_t)2048 * 128, 1024, 128, 4, ws + WS_CW1T + (size_t)256 * 1024 * 2, 0)
        TR(p->in[I_CW1] + (size_t)3072 * 128, 1024, 128, 4, ws + WS_CW1T + (size_t)256 * 1024 * 2, 128)
#undef TR
#undef TRL
    }
    {
        bf16_t* WQT = (bf16_t*)(ws + WS_WQT);
        for (int e = c.gtid; e < 2 * 224 * 1024; e += c.gsz) { const int k = e & 1023, n = 1056 + ((e >> 10) % 224), l = e / (224 * 1024);
            WQT[((size_t)l * NQP + n) * 1024 + k] = n < NQ ? (bf16_t)f2bf(p->in[I_WQ][((size_t)l * 1024 + k) * NQ + n]) : (bf16_t)0; }
        bf16_t* W2V = (bf16_t*)(ws + WS_W2V);
        for (int e = c.gtid; e < 32 * 1024; e += c.gsz) { const int n = e & 1023, k = e >> 10; W2V[n * 32 + k] = (bf16_t)f2bf(p->in[I_V2][k * 1024 + n]); }
    }
    { bf16_t* W2T = (bf16_t*)(ws + WS_CW2T);
      for (int e = c.gtid; e < 2 * 128 * 64; e += c.gsz) { const int d = e & 63, q = (e >> 6) & 127, kv = e >> 13; const float w = p->in[I_CW2][e];
          const unsigned hi = f2bf(w), lo = f2bf(w - __builtin_bit_cast(float, hi << 16)); W2T[(size_t)(kv * 64 + d) * 128 + q] = (bf16_t)hi; W2T[(size_t)2 * 64 * 128 + (size_t)(kv * 64 + d) * 128 + q] = (bf16_t)lo; } }
    for (int it = c.gw; it < 256; it += c.ngw) { const int kv = it >> 7, h = it & 127; float s = 0.f;
        for (int kk = c.lane; kk < 2048; kk += 64) s += p->in[I_PE][kv * 2048 + kk] * p->in[I_CW1][((size_t)kv * 2048 + kk) * 128 + h];
        s = wave_sum(s); if (c.lane == 0) ((float*)(ws + WS_CBIAS))[it] = s + p->in[I_CB1][it]; }
    { const f32x4* xp = (const f32x4*)p->in[I_XP]; const f32x4* xs = (const f32x4*)p->in[I_XS]; f32x4* o = (f32x4*)(p->out + O_Y);
      for (int e = c.gtid; e < R * D / 4; e += c.gsz) o[e] = e < MP * D / 4 ? xp[e] : xs[e - MP * D / 4]; }
}

__device__ __forceinline__ void phase_fill(KP p, const Ctx& c, int li, const int gwf, const int ngwf) {
    unsigned char* ws = p->ws;
    { const int* pt = (const int*)p->in[I_PT]; bf16_t* CA = (bf16_t*)(ws + WS_CMPA); const int part = li;
      for (int it = gwf; it < SB * 128 * 4; it += ngwf) { const int s4 = 4 * (it & 3), n = (it >> 2) & 127, b = it >> 9;
          const int page = pt[b * NPAGES + (n >> 3)]; const float* src = p->in[I_CKV] + ((size_t)page * PAGE + (n & 7) * 16 + s4) * 1024 + part * 256;
          f32x4 v[4];
#pragma unroll
          for (int e = 0; e < 4; ++e) v[e] = __builtin_nontemporal_load(((const f32x4*)(src + (size_t)e * 1024)) + c.lane);
          const int g = c.lane >> 4, d0 = 4 * (c.lane & 15); bf16_t* dst = CA + ((size_t)8192 + (size_t)part * 65536 + (size_t)(b * 4 + g) * 128 + n) * 1024 + s4 * 64 + d0;
#pragma unroll
          for (int e = 0; e < 4; ++e) { u32x2 w; w.x = pk2(v[e][0], v[e][1]); w.y = pk2(v[e][2], v[e][3]); *(u32x2*)(dst + e * 64) = w; } } }
    { const f32x4* src = (const f32x4*)p->in[I_CWIN]; f32x4* dst = (f32x4*)(p->out + O_WINS); constexpr int HALF_N = SB * 508 * 128 / 2;
      for (int e0 = li * HALF_N + gwf * 256 + c.lane; e0 < (li + 1) * HALF_N; e0 += ngwf * 256) { f32x4 v[4];
#pragma unroll
          for (int q = 0; q < 4; ++q) { const int e = e0 + 64 * q; if (e < (li + 1) * HALF_N) { const int b = e / (508 * 128), rr = e % (508 * 128); v[q] = __builtin_nontemporal_load(src + (size_t)b * 512 * 128 + 4 * 128 + rr); } }
#pragma unroll
          for (int q = 0; q < 4; ++q) { const int e = e0 + 64 * q; if (e < (li + 1) * HALF_N) { const int b = e / (508 * 128), rr = e % (508 * 128); __builtin_nontemporal_store(v[q], dst + (size_t)b * 512 * 128 + rr); } } } }
}

template <int NT> __device__ __forceinline__ void skinny_mma(const bf16_t* A, int lda, const bf16_t* Wt, int ldw, int K, int row0, int col0, int lane, f32x4 (&acc)[NT][2]) {
    const int fr = lane & 15, fq = lane >> 4;
#pragma unroll
    for (int nt = 0; nt < NT; ++nt) { acc[nt][0] = (f32x4){0.f, 0.f, 0.f, 0.f}; acc[nt][1] = (f32x4){0.f, 0.f, 0.f, 0.f}; }
    const bf16_t* xa = A + (size_t)(row0 + fr) * lda + 8 * fq; const bf16_t* xb = xa + (size_t)16 * lda;
    const bf16_t* wa = Wt + (size_t)(col0 + fr) * ldw + 8 * fq;
    const char* pa = (const char*)xa; const char* pb = (const char*)xb; const char* pw[NT];
#pragma unroll
    for (int nt = 0; nt < NT; ++nt) pw[nt] = (const char*)(wa + (size_t)nt * 16 * ldw);
    for (int k4 = 0; k4 < K / 128; ++k4) {
        bf16x8 fb[4][2], fa[4][NT];
#pragma unroll
        for (int u = 0; u < 4; ++u) { fb[u][0] = *(const bf16x8*)(pa + 64 * u); fb[u][1] = *(const bf16x8*)(pb + 64 * u);
#pragma unroll
            for (int nt = 0; nt < NT; ++nt) fa[u][nt] = *(const bf16x8*)(pw[nt] + 64 * u); }
        __builtin_amdgcn_sched_barrier(0);
#pragma unroll
        for (int u = 0; u < 4; ++u)
#pragma unroll
            for (int nt = 0; nt < NT; ++nt) { acc[nt][0] = mfma16(fa[u][nt], fb[u][0], acc[nt][0]); acc[nt][1] = mfma16(fa[u][nt], fb[u][1], acc[nt][1]); }
        pa += 256; pb += 256;
#pragma unroll
        for (int nt = 0; nt < NT; ++nt) pw[nt] += 256;
        __builtin_amdgcn_sched_barrier(0);
    }
}
__device__ __forceinline__ void skinny_resid_sample(const Ctx& c, const bf16_t* A, int lda, const bf16_t* Wt, int K, float* X) {
    const int ln = launder_v(c.lane), fr = ln & 15, fq = ln >> 4;
    for (int it = blockIdx.x + gridDim.x * c.wave; it < 256; it += c.ngw) { const int row0 = MP + 32 * (it & 15), col0 = 64 * (it >> 4);
        f32x4 acc[4][2]; skinny_mma<4>(A, lda, Wt, lda, K, row0, col0, c.lane, acc);
#pragma unroll
        for (int nt = 0; nt < 4; ++nt)
#pragma unroll
            for (int mt = 0; mt < 2; ++mt) { f32x4* q = (f32x4*)(X + (size_t)(row0 + 16 * mt + fr) * D + col0 + 16 * nt + 4 * fq); *q = *q + acc[nt][mt]; } }
}
__device__ __forceinline__ void skinny_store(const Ctx& c, const bf16_t* A, const bf16_t* Wt, int K, float* C, int ldc, int rbase, int nrb, int ncb, int it0, int nit_total) {
    const int fr = c.lane & 15, fq = c.lane >> 4;
    for (int it = c.gw - it0; it < nrb * ncb; it += c.ngw) { if (it < 0) continue; const int row0 = rbase + 32 * (it % nrb), col0 = 64 * (it / nrb);
        f32x4 acc[4][2]; skinny_mma<4>(A, K, Wt, K, K, row0, col0, c.lane, acc);
#pragma unroll
        for (int nt = 0; nt < 4; ++nt)
#pragma unroll
            for (int mt = 0; mt < 2; ++mt) *(f32x4*)(C + (size_t)(row0 + 16 * mt + fr) * ldc + col0 + 16 * nt + 4 * fq) = acc[nt][mt]; }
    (void)nit_total;
}

__device__ __forceinline__ void load_row(const float* p, int lane, f32x4 (&v)[4]) {
#pragma unroll
    for (int j = 0; j < 4; ++j) v[j] = ((const f32x4*)p)[lane + 64 * j];
}
__device__ __forceinline__ float row_rstd(const f32x4 (&v)[4]) {
    float s = 0.f;
#pragma unroll
    for (int j = 0; j < 4; ++j) s += (v[j][0] * v[j][0] + v[j][1] * v[j][1]) + (v[j][2] * v[j][2] + v[j][3] * v[j][3]);
    s = wave_sum(s); return frsq(s * (1.0f / D) + NORM_EPS);
}
__device__ __forceinline__ void store_row_bf16(bf16_t* o, int lane, const f32x4 (&v)[4]) {
#pragma unroll
    for (int j = 0; j < 4; ++j) { u32x2 w; w.x = pk2(v[j][0], v[j][1]); w.y = pk2(v[j][2], v[j][3]); ((u32x2*)o)[lane + 64 * j] = w; }
}

__device__ __forceinline__ void phase_norm(const Ctx& c, const float* X, const float* g1, bf16_t* o1, const float* g2, bf16_t* o2) {
    f32x4 ga[4], gb[4]; load_row(g1, c.lane, ga); if (g2) load_row(g2, c.lane, gb);
    for (int row = c.gw; row < R; row += c.ngw) {
        f32x4 v[4]; load_row(X + (size_t)row * D, c.lane, v); const float rs = row_rstd(v);
        f32x4 y[4];
#pragma unroll
        for (int j = 0; j < 4; ++j) y[j] = v[j] * rs * ga[j];
        store_row_bf16(o1 + (size_t)row * D, c.lane, y);
        if (g2) {
#pragma unroll
            for (int j = 0; j < 4; ++j) y[j] = v[j] * rs * gb[j];
            store_row_bf16(o2 + (size_t)row * D, c.lane, y); }
    }
}

__device__ __forceinline__ void phase_mix(KP p, const Ctx& c, int li) {
    const float* X = p->out + O_Y; const float* gain = p->in[I_NORMG] + (size_t)(li * 2) * D; const float* mu = p->in[I_MU] + (size_t)li * 6 * D;
    bf16_t* XM = (bf16_t*)(p->ws + WS_XM);
    f32x4 ga[4]; load_row(gain, c.lane, ga);
    {
        const int r0 = (int)(((long)c.gw * R) / c.ngw), r1 = (int)(((long)(c.gw + 1) * R) / c.ngw); f32x4 prev[4];
        {
            const bool seq_start = r0 < MP ? ((r0 & (TP - 1)) == 0) : (((r0 - MP) & 3) == 0);
            if (!seq_start && r0 < r1) { f32x4 v[4]; load_row(X + (size_t)(r0 - 1) * D, c.lane, v); const float rs = row_rstd(v);
#pragma unroll
                for (int j = 0; j < 4; ++j) prev[j] = v[j] * rs * ga[j]; }
        }
        for (int row = r0; row < r1; ++row) {
            const bool seq_start = row < MP ? ((row & (TP - 1)) == 0) : (((row - MP) & 3) == 0);
            if (seq_start) {
                if (row < MP) {
#pragma unroll
                    for (int j = 0; j < 4; ++j) prev[j] = (f32x4){0.f, 0.f, 0.f, 0.f}; }
                else load_row(p->in[I_SSHIFT] + ((size_t)li * SB + ((row - MP) >> 2)) * D, c.lane, prev);
            }
            f32x4 v[4]; load_row(X + (size_t)row * D, c.lane, v); const float rs = row_rstd(v);
            f32x4 xn[4];
#pragma unroll
            for (int j = 0; j < 4; ++j) xn[j] = v[j] * rs * ga[j];
#pragma unroll
            for (int m = 0; m < 6; ++m) {
                f32x4 y[4];
#pragma unroll
                for (int j = 0; j < 4; ++j) { const int mi = m == 1 ? 2 : (m == 2 ? 3 : (m == 3 ? 1 : m));
                    const f32x4 mm = ((const f32x4*)(mu + (size_t)mi * D))[c.lane + 64 * j]; y[j] = xn[j] + (prev[j] - xn[j]) * mm; }
                store_row_bf16(XM + ((size_t)m * R + row) * D, c.lane, y);
            }
            const bool seq_end = row < MP ? ((row & (TP - 1)) == TP - 1) : (((row - MP) & 3) == 3);
            if (seq_end) { float* so = row < MP ? p->out + O_SHP + ((size_t)li * NB + (row >> 13)) * D : p->out + O_SHS + ((size_t)li * SB + ((row - MP) >> 2)) * D;
#pragma unroll
                for (int j = 0; j < 4; ++j) ((f32x4*)so)[c.lane + 64 * j] = xn[j]; }
#pragma unroll
            for (int j = 0; j < 4; ++j) prev[j] = xn[j];
        }
    }
}
template <int NT, int ACT> __device__ __forceinline__ void lora1_item(const bf16_t* X, const bf16_t* W, bf16_t* HID, int coloff, int rb, int lane) {
    lane = launder_v(lane);
    const int fr = lane & 15, fq = lane >> 4;
    f32x4 acc[NT][2]; skinny_mma<NT>(X, 1024, W, 1024, 1024, rb * 32, coloff, lane, acc);
#pragma unroll
    for (int nt = 0; nt < NT; ++nt)
#pragma unroll
        for (int mt = 0; mt < 2; ++mt) { f32x4 v = acc[nt][mt];
#pragma unroll
            for (int r = 0; r < 4; ++r) { if (ACT == 1) { const float e = __builtin_amdgcn_exp2f(2.8853900817779268f * v[r]); v[r] = 1.0f - 2.0f * frcp(e + 1.0f); } if (ACT == 2) v[r] = sigmoidf_(v[r]); }
            u32x2 w; w.x = pk2(v[0], v[1]); w.y = pk2(v[2], v[3]);
            *(u32x2*)(HID + (size_t)(rb * 32 + mt * 16 + fr) * LHID + coloff + nt * 16 + 4 * fq) = w; }
}
__device__ __forceinline__ void phase_lora1(KP p, const Ctx& c, int li) {
    const bf16_t* XM = (const bf16_t*)(p->ws + WS_XM); const bf16_t* W = (const bf16_t*)(p->ws + WS_W1T) + (size_t)li * 288 * 1024; bf16_t* HID = (bf16_t*)(p->ws + WS_HID);
    constexpr int NRB = R / 32;
    for (int it = blockIdx.x + gridDim.x * c.wave; it < 5 * NRB; it += c.ngw) { const int q = it / NRB, rb = it % NRB;
        if (q == 0) lora1_item<4, 1>(XM + (size_t)3 * R * D, W, HID, 0, rb, c.lane);
        else if (q == 1) lora1_item<4, 0>(XM + (size_t)4 * R * D, W, HID, 64, rb, c.lane);
        else if (q == 2) { if (li == 1) lora1_item<2, 0>(XM + (size_t)2 * R * D, W, HID, 128, rb, c.lane); }
        else if (q == 3) lora1_item<4, 2>(XM + (size_t)5 * R * D, W, HID, 160, rb, c.lane);
        else lora1_item<4, 2>(XM + (size_t)5 * R * D, W, HID, 224, rb, c.lane);
    }
}

constexpr int SST = 72, MAT = 64 * SST * 2;
constexpr int O_AT = 0, O_BT = MAT, O_KT = 2 * MAT, O_RT = 3 * MAT, O_VT = 4 * MAT, O_BH = 5 * MAT, O_KH = 6 * MAT, O_XT = 7 * MAT, O_AAB = 9 * MAT, O_AAK = 10 * MAT, O_ARB = 11 * MAT, O_ARK = 12 * MAT;
constexpr int O_TD = 13 * MAT, O_SCR = O_TD + 2048, O_CS = O_SCR + 4096, O_WC = O_CS + 2048, O_LW = O_XT, O_LA = O_XT + 16384, O_LV = O_XT + 32768;
static_assert(O_WC + 256 <= RING_BYTES && O_LV + 16384 <= O_TD, "scan LDS map");
__device__ __forceinline__ bf16x8 ldsfrag(LAS unsigned char* lds, int off, int row, int col) { return *(const LAS bf16x8*)(lds + off + (row * SST + col) * 2); }
__device__ __forceinline__ void lds_st4(LAS unsigned char* lds, int off, int row, int col, f32x4 v) { u32x2 w; w.x = pk2(v[0], v[1]); w.y = pk2(v[2], v[3]); *(LAS u32x2*)(lds + off + (row * SST + col) * 2) = w; }
__device__ __forceinline__ f32x4 lds_ld4(LAS unsigned char* lds, int off, int row, int col) { const u32x2 w = *(const LAS u32x2*)(lds + off + (row * SST + col) * 2); return (f32x4){bflo(w.x), bfhi(w.x), bflo(w.y), bfhi(w.y)}; }

__device__ __forceinline__ void scanA_unit(KP p, const Ctx& c, int li, int u) {
    LAS unsigned char* lds = c.lds; unsigned char* ws = p->ws; const int stop = p->pad;
    const int lane = c.lane, wave = c.wave, fr = lane & 15, fq = lane >> 4;
    const int b = u / (NCH * H), n = (u / H) % NCH, h = u % H, row0 = b * TP + 64 * n;
    const float* Rb = (const float*)(ws + WS_RK_R); const float* Kb = (const float*)(ws + WS_RK_K);
    float* Vb = (float*)(ws + (li ? WS_V1 : WS_V0)); const float* V0b = (const float*)(ws + WS_V0);
    const bf16_t* HID = (const bf16_t*)(ws + WS_HID);
    {
        const int tt = wave & 3, chh = wave >> 2;
        const bf16_t* hrow = launder_p(HID + (size_t)(row0 + 16 * tt + fr) * LHID + 8 * fq);
        const bf16_t* W2W = (const bf16_t*)(ws + WS_W2W) + (size_t)li * 1024 * 64; const bf16_t* W2A = (const bf16_t*)(ws + WS_W2A) + (size_t)li * 1024 * 64; const bf16_t* W2V = (const bf16_t*)(ws + WS_W2V);
#pragma unroll
        for (int cti = 0; cti < 2; ++cti) { const int ct = 2 * chh + cti, C = 64 * h + 16 * ct + fr;
            f32x4 aw = {0.f, 0.f, 0.f, 0.f}, aa = {0.f, 0.f, 0.f, 0.f}, av = {0.f, 0.f, 0.f, 0.f};
#pragma unroll
            for (int ks = 0; ks < 2; ++ks) {
                aw = mfma16(*(const bf16x8*)(W2W + (size_t)C * 64 + 32 * ks + 8 * fq), *(const bf16x8*)(hrow + 32 * ks), aw);
                aa = mfma16(*(const bf16x8*)(W2A + (size_t)C * 64 + 32 * ks + 8 * fq), *(const bf16x8*)(hrow + 64 + 32 * ks), aa); }
            if (li) av = mfma16(*(const bf16x8*)(W2V + (size_t)C * 32 + 8 * fq), *(const bf16x8*)(hrow + 128), av);
            const int t = 16 * tt + fr, cc = 16 * ct + 4 * fq;
            *(LAS f32x4*)(lds + O_LW + (t * 64 + cc) * 4) = aw; *(LAS f32x4*)(lds + O_LA + (t * 64 + cc) * 4) = aa; *(LAS f32x4*)(lds + O_LV + (t * 64 + cc) * 4) = av; }
    }
    __syncthreads();
    if (stop == 1) return;
    {
        const int cc = lane, tq = wave, C = 64 * h + cc; const size_t pc = (size_t)li * D + C;
        const float w0 = p->in[I_W0][pc], a0 = p->in[I_A0][pc], kkc = p->in[I_KK][pc], kac = p->in[I_KA][pc], rkc = p->in[I_RKK][pc], v0 = li ? p->in[I_V0][C] : 0.f;
        float wlg[8], Lin[8], rr[8], k2[8], vv[8], aa[8], bb[8], rk8[8]; float run = 0.f;
        float r8[8], k8[8], v8[8], f8[8];
#pragma unroll
        for (int e = 0; e < 8; ++e) { const size_t gi = (size_t)(row0 + 8 * tq + e) * D + C; r8[e] = Rb[gi]; k8[e] = Kb[gi]; v8[e] = Vb[gi]; f8[e] = V0b[gi]; }
#pragma unroll
        for (int e = 0; e < 8; ++e) { const int t = 8 * tq + e;
            const float r = r8[e], k = k8[e]; float v = v8[e];
            const float lw = *(const LAS float*)(lds + O_LW + (t * 64 + cc) * 4), la = *(const LAS float*)(lds + O_LA + (t * 64 + cc) * 4), lv = *(const LAS float*)(lds + O_LV + (t * 64 + cc) * 4);
            const float z = -(w0 + lw); const float sp = fmaxf(z, 0.f) + __logf(1.0f + __expf(-fabsf(z))); const float wl = -__expf(-sp - 0.5f);
            const float asig = sigmoidf_(a0 + la);
            { const float vg = sigmoidf_(v0 + lv); const float vm = v + (f8[e] - v) * vg; v = li ? vm : v; }
            const float kkr = k * kkc; const float ss = wave_sum(kkr * kkr); const float kkn = kkr * frsq(fmaxf(ss, 1e-24f));
            const float kmod = k * (1.0f + (asig - 1.0f) * kac);
            rk8[e] = wave_sum(r * kmod * rkc);
            run += wl; wlg[e] = wl; Lin[e] = run; rr[e] = r; k2[e] = kmod; vv[e] = v; aa[e] = -kkn; bb[e] = kkn * asig; }
        if (li) {
#pragma unroll
            for (int e = 0; e < 8; ++e) Vb[(size_t)(row0 + 8 * tq + e) * D + C] = vv[e]; }
        if (cc == 0) {
#pragma unroll
            for (int e = 0; e < 8; ++e) ((float*)(ws + WS_RKS))[(size_t)(row0 + 8 * tq + e) * 16 + h] = rk8[e]; }
        *(LAS float*)(lds + O_CS + (tq * 64 + cc) * 4) = run;
        __syncthreads();
        float off = 0.f, tot = 0.f;
#pragma unroll
        for (int q = 0; q < 8; ++q) { const float x = *(const LAS float*)(lds + O_CS + (q * 64 + cc) * 4); tot += x; if (q < tq) off += x; }
        u32x4 wa, wv, wb, wk; unsigned pa[8], pv[8], pb[8], pk[8];
#pragma unroll
        for (int e = 0; e < 8; ++e) { const int t = 8 * tq + e; const float L = off + Lin[e], Lp = L - wlg[e];
            const float eL = __expf(L), eLp = __expf(Lp), enL = __expf(-L), eT = __expf(tot - L);
            const float at = aa[e] * eLp, bt = bb[e] * enL, kt = k2[e] * enL, rt = rr[e] * eL, bh = bb[e] * eT, kh = k2[e] * eT;
            *(LAS bf16_t*)(lds + O_AT + (t * SST + cc) * 2) = (bf16_t)f2bf(at); *(LAS bf16_t*)(lds + O_BT + (t * SST + cc) * 2) = (bf16_t)f2bf(bt);
            *(LAS bf16_t*)(lds + O_KT + (t * SST + cc) * 2) = (bf16_t)f2bf(kt); *(LAS bf16_t*)(lds + O_RT + (t * SST + cc) * 2) = (bf16_t)f2bf(rt);
            pa[e] = f2bf(at); pv[e] = f2bf(vv[e]); pb[e] = f2bf(bh); pk[e] = f2bf(kh); }
        wa = (u32x4){pa[0] | (pa[1] << 16), pa[2] | (pa[3] << 16), pa[4] | (pa[5] << 16), pa[6] | (pa[7] << 16)};
        wv = (u32x4){pv[0] | (pv[1] << 16), pv[2] | (pv[3] << 16), pv[4] | (pv[5] << 16), pv[6] | (pv[7] << 16)};
        wb = (u32x4){pb[0] | (pb[1] << 16), pb[2] | (pb[3] << 16), pb[4] | (pb[5] << 16), pb[6] | (pb[7] << 16)};
        wk = (u32x4){pk[0] | (pk[1] << 16), pk[2] | (pk[3] << 16), pk[4] | (pk[5] << 16), pk[6] | (pk[7] << 16)};
        *(LAS u32x4*)(lds + O_XT + (cc * SST + 8 * tq) * 2) = wa; *(LAS u32x4*)(lds + O_VT + (cc * SST + 8 * tq) * 2) = wv;
        *(LAS u32x4*)(lds + O_BH + (cc * SST + 8 * tq) * 2) = wb; *(LAS u32x4*)(lds + O_KH + (cc * SST + 8 * tq) * 2) = wk;
        if (tq == 0) *(LAS float*)(lds + O_WC + cc * 4) = __expf(tot);
    }
    __syncthreads();
    if (stop == 2) return;
    {
        const int mi = wave >> 1, ph = wave & 1; const int oY = (mi & 1) ? O_KT : O_BT, oX = (mi < 2) ? O_AT : O_RT; const bool strict = mi < 2;
        const int oO = mi == 0 ? O_AAB : (mi == 1 ? O_AAK : (mi == 2 ? O_ARB : O_ARK));
#pragma unroll
        for (int sti = 0; sti < 2; ++sti) { const int st = 2 * ph + sti;
#pragma unroll
            for (int tt = 0; tt < 4; ++tt) { f32x4 acc = {0.f, 0.f, 0.f, 0.f};
                if (st <= tt) {
#pragma unroll
                    for (int ks = 0; ks < 2; ++ks) acc = mfma16(ldsfrag(lds, oY, 16 * st + fr, 32 * ks + 8 * fq), ldsfrag(lds, oX, 16 * tt + fr, 32 * ks + 8 * fq), acc);
                    const int t = 16 * tt + fr;
#pragma unroll
                    for (int r = 0; r < 4; ++r) { const int s = 16 * st + 4 * fq + r; const bool keep = strict ? (s < t) : (s <= t); acc[r] = keep ? acc[r] : 0.f; } }
                if (st <= tt) lds_st4(lds, oO, 16 * tt + fr, 16 * st + 4 * fq, acc);
                else { u32x2 zz; int z0 = 0; asm volatile("" : "+v"(z0)); zz.x = (unsigned)z0; zz.y = (unsigned)z0; *(LAS u32x2*)(lds + oO + ((16 * tt + fr) * SST + 16 * st + 4 * fq) * 2) = zz; } } }
    }
    __syncthreads();
    if (stop == 3) return;
    {
        const int tt = wave & 3, ih = wave >> 2;
#pragma unroll
        for (int iti = 0; iti < 2; ++iti) { const int it = 2 * ih + iti; f32x4 acc = {0.f, 0.f, 0.f, 0.f};
#pragma unroll
            for (int ks = 0; ks < 2; ++ks) acc = mfma16(ldsfrag(lds, O_AAK, 16 * tt + fr, 32 * ks + 8 * fq), ldsfrag(lds, O_VT, 16 * it + fr, 32 * ks + 8 * fq), acc);
            lds_st4(lds, O_XT, 64 + 16 * it + fr, 16 * tt + 4 * fq, acc); }
        if (wave < 4 && lane < 16) { const int I = wave; float x[16];
#pragma unroll
            for (int t = 0; t < 16; ++t) { float s = (t == lane) ? 1.0f : 0.0f;
#pragma unroll
                for (int q = 0; q < t; ++q) s += bf2f(*(const LAS bf16_t*)(lds + O_AAB + ((16 * I + t) * SST + 16 * I + q) * 2)) * x[q];
                x[t] = s; *(LAS bf16_t*)(lds + O_TD + ((I * 16 + t) * 16 + lane) * 2) = (bf16_t)f2bf(s); } }
    }
    __syncthreads();
    if (stop == 5) return;
    {
        const int colb = 16 * wave; const bf16x8 zero8 = {0, 0, 0, 0, 0, 0, 0, 0};
#pragma unroll
        for (int I = 0; I < 4; ++I) {
            f32x4 acc = lds_ld4(lds, O_XT, colb + fr, 16 * I + 4 * fq);
#pragma unroll
            for (int ks = 0; ks < 2; ++ks) if (32 * ks < 16 * I) { const bool ok = (32 * ks + 8 * fq) < 16 * I;
                const bf16x8 a = ok ? ldsfrag(lds, O_AAB, 16 * I + fr, 32 * ks + 8 * fq) : zero8, bq = ok ? ldsfrag(lds, O_XT, colb + fr, 32 * ks + 8 * fq) : zero8;
                acc = mfma16(a, bq, acc); }
            { u32x2 w; w.x = pk2(acc[0], acc[1]); w.y = pk2(acc[2], acc[3]); *(LAS u32x2*)(lds + O_SCR + wave * 512 + (fr * 16 + 4 * fq) * 2) = w; }
            LDS_WAIT();
            const bf16x8 ta = fq < 2 ? *(const LAS bf16x8*)(lds + O_TD + ((I * 16 + fr) * 16 + 8 * fq) * 2) : zero8;
            const bf16x8 tb = fq < 2 ? *(const LAS bf16x8*)(lds + O_SCR + wave * 512 + (fr * 16 + 8 * fq) * 2) : zero8;
            const f32x4 res = mfma16(ta, tb, (f32x4){0.f, 0.f, 0.f, 0.f});
            lds_st4(lds, O_XT, colb + fr, 16 * I + 4 * fq, res);
            LDS_WAIT();
        }
    }
    __syncthreads();
    if (stop == 6) return;
    constexpr int S_RP = 0, S_MH = MAT, S_ML = 2 * MAT, S_YL = 3 * MAT, YLS = 68, S_NN = S_YL + 64 * YLS * 4;
    static_assert(S_NN + 64 * YLS * 4 <= O_XT, "staging must stay below the next unit's step-1 area");
    {
        const int tb = wave & 3, hb = wave >> 2;
        u32x2 rp[2], mh[2], ml[2]; f32x4 yl[2], nv[2];
#pragma unroll
        for (int qi = 0; qi < 2; ++qi) { const int rt = 2 * hb + qi;
            { f32x4 acc = lds_ld4(lds, O_RT, 16 * tb + fr, 16 * rt + 4 * fq);
#pragma unroll
              for (int ks = 0; ks < 2; ++ks) acc = mfma16(ldsfrag(lds, O_XT, 16 * rt + fr, 32 * ks + 8 * fq), ldsfrag(lds, O_ARB, 16 * tb + fr, 32 * ks + 8 * fq), acc);
              rp[qi].x = pk2(acc[0], acc[1]); rp[qi].y = pk2(acc[2], acc[3]); }
            { f32x4 acc = {0.f, 0.f, 0.f, 0.f};
#pragma unroll
              for (int ks = 0; ks < 2; ++ks) { acc = mfma16(ldsfrag(lds, O_XT, 64 + 16 * rt + fr, 32 * ks + 8 * fq), ldsfrag(lds, O_ARB, 16 * tb + fr, 32 * ks + 8 * fq), acc);
                  acc = mfma16(ldsfrag(lds, O_VT, 16 * rt + fr, 32 * ks + 8 * fq), ldsfrag(lds, O_ARK, 16 * tb + fr, 32 * ks + 8 * fq), acc); }
              yl[qi] = acc; }
            { f32x4 acc = {0.f, 0.f, 0.f, 0.f};
#pragma unroll
              for (int ks = 0; ks < 2; ++ks) acc = mfma16(ldsfrag(lds, O_XT, 16 * rt + fr, 32 * ks + 8 * fq), ldsfrag(lds, O_BH, 16 * tb + fr, 32 * ks + 8 * fq), acc);
              const int j = 16 * tb + fr; const float wc = *(const LAS float*)(lds + O_WC + j * 4);
#pragma unroll
              for (int r = 0; r < 4; ++r) if (16 * rt + 4 * fq + r == j) acc[r] += wc;
              unsigned hh[4], ll[4];
#pragma unroll
              for (int r = 0; r < 4; ++r) { hh[r] = f2bf(acc[r]); ll[r] = f2bf(acc[r] - __builtin_bit_cast(float, hh[r] << 16)); }
              mh[qi] = (u32x2){hh[0] | (hh[1] << 16), hh[2] | (hh[3] << 16)}; ml[qi] = (u32x2){ll[0] | (ll[1] << 16), ll[2] | (ll[3] << 16)}; }
            { f32x4 acc = {0.f, 0.f, 0.f, 0.f};
#pragma unroll
              for (int ks = 0; ks < 2; ++ks) { acc = mfma16(ldsfrag(lds, O_BH, 16 * rt + fr, 32 * ks + 8 * fq), ldsfrag(lds, O_XT, 64 + 16 * tb + fr, 32 * ks + 8 * fq), acc);
                  acc = mfma16(ldsfrag(lds, O_KH, 16 * rt + fr, 32 * ks + 8 * fq), ldsfrag(lds, O_VT, 16 * tb + fr, 32 * ks + 8 * fq), acc); }
              nv[qi] = acc; }
        }
        __syncthreads();
#pragma unroll
        for (int qi = 0; qi < 2; ++qi) { const int rt = 2 * hb + qi, row = 16 * tb + fr, col = 16 * rt + 4 * fq;
            *(LAS u32x2*)(lds + S_RP + (row * SST + col) * 2) = rp[qi]; *(LAS u32x2*)(lds + S_MH + (row * SST + col) * 2) = mh[qi]; *(LAS u32x2*)(lds + S_ML + (row * SST + col) * 2) = ml[qi];
            *(LAS f32x4*)(lds + S_YL + (row * YLS + col) * 4) = yl[qi]; *(LAS f32x4*)(lds + S_NN + (row * YLS + col) * 4) = nv[qi]; }
        __syncthreads();
        unsigned char* gRP = ws + WS_RP + (size_t)u * 8192; unsigned char* gYL = ws + WS_YL + (size_t)u * 16384;
        unsigned char* gMH = ws + WS_MT + (size_t)u * 8192; unsigned char* gML = gMH + (size_t)NUNIT_A * 8192; unsigned char* gNN = ws + WS_NN + (size_t)u * 16384;
        const int tid = 64 * wave + lane;
        { const int row = tid >> 3, ch = tid & 7, lo = (row * SST) * 2 + ch * 16;
          *(u32x4*)(gRP + tid * 16) = *(const LAS u32x4*)(lds + S_RP + lo); *(u32x4*)(gMH + tid * 16) = *(const LAS u32x4*)(lds + S_MH + lo); *(u32x4*)(gML + tid * 16) = *(const LAS u32x4*)(lds + S_ML + lo); }
#pragma unroll
        for (int k = 0; k < 2; ++k) { const int cidx = tid + 512 * k, row = cidx >> 4, c4 = cidx & 15, lo = (row * YLS) * 4 + c4 * 16;
            *(u32x4*)(gYL + cidx * 16) = *(const LAS u32x4*)(lds + S_YL + lo); *(u32x4*)(gNN + cidx * 16) = *(const LAS u32x4*)(lds + S_NN + lo); }
    }
}

__device__ __forceinline__ void scan_sample_item(KP p, const Ctx& c, int li, int item) {
    unsigned char* ws = p->ws; const int lane = c.lane, b = item >> 4, h = item & 15, C = 64 * h + lane; const size_t pc = (size_t)li * D + C;
    LAS float* sc = (LAS float*)(c.lds + c.wave * 16384);
    const float* Rb = (const float*)(ws + WS_RK_R); const float* Kb = (const float*)(ws + WS_RK_K);
    float* Vb = (float*)(ws + (li ? WS_V1 : WS_V0)); const float* V0b = (const float*)(ws + WS_V0);
    const bf16_t* HID = (const bf16_t*)(ws + WS_HID) + (size_t)(MP + 4 * b) * LHID;
    for (int e = lane; e < 4 * LHID; e += 64) sc[e] = bf2f(HID[e]);
    LDS_WAIT();
    float lw[4] = {0.f, 0.f, 0.f, 0.f}, la[4] = {0.f, 0.f, 0.f, 0.f}, lv[4] = {0.f, 0.f, 0.f, 0.f}, lg[4] = {0.f, 0.f, 0.f, 0.f};
    {
        const bf16_t* W2W = (const bf16_t*)(ws + WS_W2W) + ((size_t)li * 1024 + C) * 64; const bf16_t* W2A = (const bf16_t*)(ws + WS_W2A) + ((size_t)li * 1024 + C) * 64;
        const bf16_t* W2V = (const bf16_t*)(ws + WS_W2V) + (size_t)C * 32; const bf16_t* W2G = (const bf16_t*)(ws + WS_W2G) + ((size_t)li * 1024 + C) * 128;
#define LORA2_BLK(WP, QB, HOFF, ACC) { const u32x4 w8 = *(const u32x4*)((WP) + 8 * (QB)); \
            const float wf0 = bflo(w8.x), wf1 = bfhi(w8.x), wf2 = bflo(w8.y), wf3 = bfhi(w8.y), wf4 = bflo(w8.z), wf5 = bfhi(w8.z), wf6 = bflo(w8.w), wf7 = bfhi(w8.w); \
            _Pragma("unroll") for (int t = 0; t < 4; ++t) { const f32x4 h0 = *(const LAS f32x4*)(sc + t * LHID + (HOFF) + 8 * (QB)), h1 = *(const LAS f32x4*)(sc + t * LHID + (HOFF) + 8 * (QB) + 4); \
                ACC[t] += (h0[0] * wf0 + h0[1] * wf1) + (h0[2] * wf2 + h0[3] * wf3) + (h1[0] * wf4 + h1[1] * wf5) + (h1[2] * wf6 + h1[3] * wf7); } \
            asm volatile("" : "+v"(ACC[0]), "+v"(ACC[1]), "+v"(ACC[2]), "+v"(ACC[3]) :: "memory"); }
#pragma unroll
        for (int qb = 0; qb < 8; ++qb) { LORA2_BLK(W2W, qb, 0, lw) LORA2_BLK(W2A, qb, 64, la) }
        if (li) {
#pragma unroll
            for (int qb = 0; qb < 4; ++qb) LORA2_BLK(W2V, qb, 128, lv) }
#pragma unroll
        for (int qb = 0; qb < 16; ++qb) LORA2_BLK(W2G, qb, 160, lg)
#undef LORA2_BLK
    }
    const float w0 = p->in[I_W0][pc], a0 = p->in[I_A0][pc], kkc = p->in[I_KK][pc], kac = p->in[I_KA][pc], rkc = p->in[I_RKK][pc], v0 = li ? p->in[I_V0][C] : 0.f;
    const float lnw = p->in[I_LNW][pc], lnb = p->in[I_LNB][pc];
    float S[64];
    { const f32x4* sp = (const f32x4*)(p->in[I_SWKV] + (((size_t)li * SB + b) * H + h) * 4096 + lane * 64);
#pragma unroll
      for (int q = 0; q < 16; ++q) { const f32x4 x = sp[q]; S[4 * q] = x[0]; S[4 * q + 1] = x[1]; S[4 * q + 2] = x[2]; S[4 * q + 3] = x[3]; } }
    LAS float* bc = sc + 1280;
    bf16_t* YG = (bf16_t*)(ws + WS_YG);
#pragma unroll
    for (int t = 0; t < 4; ++t) { const size_t gi = (size_t)(MP + 4 * b + t) * D + C;
        const float r = Rb[gi], k = Kb[gi]; float v = Vb[gi];
        const float z = -(w0 + lw[t]); const float sp = fmaxf(z, 0.f) + __logf(1.0f + __expf(-fabsf(z))); const float wdec = __expf(-__expf(-sp - 0.5f));
        const float asig = sigmoidf_(a0 + la[t]);
        if (li) { const float vg = sigmoidf_(v0 + lv[t]); const float vf = V0b[gi]; v = v + (vf - v) * vg; }
        const float kkr = k * kkc; const float ss = wave_sum(kkr * kkr); const float kkn = kkr * frsq(fmaxf(ss, 1e-24f));
        const float kmod = k * (1.0f + (asig - 1.0f) * kac);
        const float rks = wave_sum(r * kmod * rkc);
        LDS_WAIT();
        bc[lane] = wdec; bc[64 + lane] = -kkn; bc[128 + lane] = kkn * asig; bc[192 + lane] = kmod; bc[256 + lane] = r;
        LDS_WAIT();
        float sa = 0.f;
#pragma unroll
        for (int q = 0; q < 16; ++q) { const f32x4 av = *(const LAS f32x4*)(bc + 64 + 4 * q); sa += S[4 * q] * av[0] + S[4 * q + 1] * av[1] + S[4 * q + 2] * av[2] + S[4 * q + 3] * av[3]; }
        float y = 0.f;
#pragma unroll
        for (int q = 0; q < 16; ++q) { const f32x4 wv = *(const LAS f32x4*)(bc + 4 * q), bv = *(const LAS f32x4*)(bc + 128 + 4 * q), kv = *(const LAS f32x4*)(bc + 192 + 4 * q), rv = *(const LAS f32x4*)(bc + 256 + 4 * q);
#pragma unroll
            for (int e = 0; e < 4; ++e) { const float s = S[4 * q + e] * wv[e] + sa * bv[e] + v * kv[e]; S[4 * q + e] = s; y += s * rv[e]; } }
        const float mean = wave_sum(y) * (1.0f / 64.0f); const float dy = y - mean; const float var = wave_sum(dy * dy) * (1.0f / 64.0f);
        const float yn = dy * (frsq(var + GN_EPS)) * lnw + lnb;
        YG[gi] = (bf16_t)f2bf((yn + rks * v) * lg[t]);
    }
    { f32x4* so = (f32x4*)(p->out + O_WKVS + (((size_t)li * SB + b) * H + h) * 4096 + lane * 64);
#pragma unroll
      for (int q = 0; q < 16; ++q) so[q] = (f32x4){S[4 * q], S[4 * q + 1], S[4 * q + 2], S[4 * q + 3]}; }
    LDS_WAIT();
}

__device__ __forceinline__ void phase_scanA(KP p, const Ctx& c, int li) {
    const int stop = p->pad;
    if (stop != 9) for (int u = blockIdx.x; u < NUNIT_A; u += gridDim.x) scanA_unit(p, c, li, u);
    __syncthreads();
    if (stop == 0 || stop == 9) for (int it = c.gw; it < SB * H; it += c.ngw) scan_sample_item(p, c, li, it);
}

__device__ __forceinline__ void hilo(const f32x4 x0, const f32x4 x1, bf16x8& hi, bf16x8& lo) {
    unsigned h[8], l[8];
#pragma unroll
    for (int e = 0; e < 8; ++e) { const float x = e < 4 ? x0[e] : x1[e - 4]; h[e] = f2bf(x); l[e] = f2bf(x - __builtin_bit_cast(float, h[e] << 16)); }
    u32x4 hv = {h[0] | (h[1] << 16), h[2] | (h[3] << 16), h[4] | (h[5] << 16), h[6] | (h[7] << 16)}, lv = {l[0] | (l[1] << 16), l[2] | (l[3] << 16), l[4] | (l[5] << 16), l[6] | (l[7] << 16)};
    hi = __builtin_bit_cast(bf16x8, hv); lo = __builtin_bit_cast(bf16x8, lv);
}
constexpr int SB_SLOT = 20480, SB_RING0 = 8192, SB_DEPTH = 6;
static_assert(SB_RING0 + SB_DEPTH * SB_SLOT <= RING_BYTES, "chain ring");
__device__ __forceinline__ void phase_scanB(KP p, const Ctx& c, int li) {
    unsigned char* ws = p->ws; LAS unsigned char* lds = c.lds; const int lane = c.lane, fr = lane & 15, fq = lane >> 4, wave = c.wave;
    volatile LAS int* FL = (volatile LAS int*)(lds + RING_BYTES);
    if (c.tid < 4) FL[c.tid] = 0;
    __syncthreads();
    const int ncb = (int)gridDim.x < 128 ? (int)gridDim.x : 128;
    if (wave >= 4 || (int)blockIdx.x >= ncb) {
        const int gwf = (int)blockIdx.x < ncb ? (int)blockIdx.x * 4 + (wave - 4) : ncb * 4 + ((int)blockIdx.x - ncb) * 8 + wave, ngwf = ncb * 4 + ((int)gridDim.x - ncb) * 8;
        phase_fill(p, c, li, gwf, ngwf); return; }
    if (wave != 0) {
        const int j = wave - 1; int prevG = -1, kc = 0;
        for (int ch = blockIdx.x; ch < 128; ch += gridDim.x, ++kc) { const int b = ch >> 6, h = (ch >> 2) & 15, iq = ch & 3;
            for (int n = j; n < NCH; n += 3) { const int G = kc * NCH + n;
                if (G >= SB_DEPTH) { unsigned sp = 0; while (FL[0] < G - (SB_DEPTH - 1)) { __builtin_amdgcn_s_sleep(1); if (++sp > (1u << 22)) break; } }
                LAS unsigned char* slot = lds + SB_RING0 + (G % SB_DEPTH) * SB_SLOT;
                const size_t u = (size_t)(b * NCH + n) * H + h; const bf16_t* MTH = (const bf16_t*)(ws + WS_MT) + u * 4096; const bf16_t* MTL = MTH + (size_t)NUNIT_A * 4096; const float* NN = (const float*)(ws + WS_NN) + u * 4096;
#pragma unroll
                for (int jt = 0; jt < 4; ++jt)
#pragma unroll
                    for (int ks = 0; ks < 2; ++ks) {
                        __builtin_amdgcn_global_load_lds((const unsigned*)(MTH + (size_t)(16 * jt + fr) * 64 + 32 * ks + 8 * fq), (LAS unsigned*)(slot + ((jt * 2 + ks) * 2 + 0) * 1024), 16, 0, 0);
                        __builtin_amdgcn_global_load_lds((const unsigned*)(MTL + (size_t)(16 * jt + fr) * 64 + 32 * ks + 8 * fq), (LAS unsigned*)(slot + ((jt * 2 + ks) * 2 + 1) * 1024), 16, 0, 0); }
#pragma unroll
                for (int jt = 0; jt < 4; ++jt)
                    __builtin_amdgcn_global_load_lds((const unsigned*)(NN + (size_t)(16 * iq + fr) * 64 + 16 * jt + 4 * fq), (LAS unsigned*)(slot + (16 + jt) * 1024), 16, 0, 0);
                asm volatile("s_waitcnt vmcnt(20)" ::: "memory");
                if (prevG >= 0) FL[1 + j] = prevG + 1;
                prevG = G; } }
        asm volatile("s_waitcnt vmcnt(0)" ::: "memory");
        if (prevG >= 0) FL[1 + j] = prevG + 1;
        return; }
    int kc = 0;
    for (int ch = blockIdx.x; ch < 128; ch += gridDim.x, ++kc) {
        const int b = ch >> 6, h = (ch >> 2) & 15, iq = ch & 3;
        f32x4 S[4];
#pragma unroll
        for (int jt = 0; jt < 4; ++jt) S[jt] = (f32x4){0.f, 0.f, 0.f, 0.f};
        int j3 = 0;
        for (int n = 0; n < NCH; ++n) { const int G = kc * NCH + n;
            const size_t u = (size_t)(b * NCH + n) * H + h; bf16_t* S0 = (bf16_t*)(ws + WS_S0) + u * 4096;
            { unsigned sp = 0; while (FL[1 + j3] < G + 1) { __builtin_amdgcn_s_sleep(1); if (++sp > (1u << 22)) break; } }
            const LAS unsigned char* slot = lds + SB_RING0 + (G % SB_DEPTH) * SB_SLOT + lane * 16;
            bf16x8 ah[4][2], al[4][2]; f32x4 nn[4];
#pragma unroll
            for (int jt = 0; jt < 4; ++jt) { nn[jt] = *(const LAS f32x4*)(slot + (16 + jt) * 1024);
#pragma unroll
                for (int ks = 0; ks < 2; ++ks) { ah[jt][ks] = *(const LAS bf16x8*)(slot + ((jt * 2 + ks) * 2 + 0) * 1024); al[jt][ks] = *(const LAS bf16x8*)(slot + ((jt * 2 + ks) * 2 + 1) * 1024); } }
#pragma unroll
            for (int jt = 0; jt < 4; ++jt) { unsigned hh[4], ll[4];
#pragma unroll
                for (int r = 0; r < 4; ++r) { hh[r] = f2bf(S[jt][r]); ll[r] = f2bf(S[jt][r] - __builtin_bit_cast(float, hh[r] << 16)); }
                u32x2 wh = {hh[0] | (hh[1] << 16), hh[2] | (hh[3] << 16)}, wl = {ll[0] | (ll[1] << 16), ll[2] | (ll[3] << 16)};
                *(u32x2*)(S0 + (size_t)(16 * iq + fr) * 64 + 16 * jt + 4 * fq) = wh;
                *(LAS u32x2*)(lds + (fr * SST + 16 * jt + 4 * fq) * 2) = wh; *(LAS u32x2*)(lds + 4096 + (fr * SST + 16 * jt + 4 * fq) * 2) = wl; }
            LDS_WAIT();
            bf16x8 bh[2], bl[2];
#pragma unroll
            for (int ks = 0; ks < 2; ++ks) { bh[ks] = *(const LAS bf16x8*)(lds + (fr * SST + 32 * ks + 8 * fq) * 2); bl[ks] = *(const LAS bf16x8*)(lds + 4096 + (fr * SST + 32 * ks + 8 * fq) * 2); }
#pragma unroll
            for (int jt = 0; jt < 4; ++jt) { f32x4 acc = nn[jt];
#pragma unroll
                for (int ks = 0; ks < 2; ++ks) { acc = mfma16(ah[jt][ks], bh[ks], acc); acc = mfma16(ah[jt][ks], bl[ks], acc); acc = mfma16(al[jt][ks], bh[ks], acc); }
                S[jt] = acc; }
            LDS_WAIT();
            FL[0] = G + 1;
            j3 = j3 == 2 ? 0 : j3 + 1;
        }
        float* so = p->out + O_WKVP + (((size_t)li * NB + b) * H + h) * 4096;
#pragma unroll
        for (int jt = 0; jt < 4; ++jt) *(f32x4*)(so + (size_t)(16 * iq + fr) * 64 + 16 * jt + 4 * fq) = S[jt];
    }
}

__device__ __forceinline__ void phase_scanC(KP p, const Ctx& c, int li) {
    unsigned char* ws = p->ws; const int lane = c.lane, fr = lane & 15, fq = lane >> 4, hb = c.wave >> 2, tt = c.wave & 3;
    const float* Vb = (const float*)(ws + (li ? WS_V1 : WS_V0)); const bf16_t* HID = (const bf16_t*)(ws + WS_HID); const bf16_t* W2G = (const bf16_t*)(ws + WS_W2G) + (size_t)li * 1024 * 128;
    bf16_t* YG = (bf16_t*)(ws + WS_YG);
    for (int up = blockIdx.x; up < NUNIT_A / 2; up += gridDim.x) {
        const int u = 2 * up + hb; const int b = u / (NCH * H), n = (u / H) % NCH, h = u % H; const int row = b * TP + 64 * n + 16 * tt + fr;
        const bf16_t* RP = (const bf16_t*)(ws + WS_RP) + (size_t)u * 4096; const float* YL = (const float*)(ws + WS_YL) + (size_t)u * 4096; const bf16_t* S0 = (const bf16_t*)(ws + WS_S0) + (size_t)u * 4096;
        f32x4 acc[4], ag[4];
#pragma unroll
        for (int it = 0; it < 4; ++it) { acc[it] = *(const f32x4*)(YL + (size_t)(16 * tt + fr) * 64 + 16 * it + 4 * fq); ag[it] = (f32x4){0.f, 0.f, 0.f, 0.f}; }
#pragma unroll
        for (int ks = 0; ks < 2; ++ks) { const bf16x8 bq = *(const bf16x8*)(RP + (size_t)(16 * tt + fr) * 64 + 32 * ks + 8 * fq);
#pragma unroll
            for (int it = 0; it < 4; ++it) acc[it] = mfma16(*(const bf16x8*)(S0 + (size_t)(16 * it + fr) * 64 + 32 * ks + 8 * fq), bq, acc[it]); }
        const bf16_t* hgp = launder_p(HID + (size_t)row * LHID + 160 + 8 * fq); const bf16_t* wgp = launder_p(W2G + (size_t)(64 * h + fr) * 128 + 8 * fq);
#pragma unroll
        for (int ks = 0; ks < 4; ++ks) { const bf16x8 bq = *(const bf16x8*)(hgp + 32 * ks);
#pragma unroll
            for (int it = 0; it < 4; ++it) ag[it] = mfma16(*(const bf16x8*)(wgp + it * 16 * 128 + 32 * ks), bq, ag[it]); }
        float s = 0.f;
#pragma unroll
        for (int it = 0; it < 4; ++it) s += (acc[it][0] + acc[it][1]) + (acc[it][2] + acc[it][3]);
        s = sum_rows4(s); const float mean = s * (1.0f / 64.0f);
        float q = 0.f;
#pragma unroll
        for (int it = 0; it < 4; ++it) { const f32x4 d = acc[it] - mean; q += (d[0] * d[0] + d[1] * d[1]) + (d[2] * d[2] + d[3] * d[3]); }
        q = sum_rows4(q); const float rstd = frsq(q * (1.0f / 64.0f) + GN_EPS);
        const float rks = ((const float*)(ws + WS_RKS))[(size_t)row * 16 + h];
#pragma unroll
        for (int it = 0; it < 4; ++it) { const int C = 64 * h + 16 * it + 4 * fq; const size_t pc = (size_t)li * D + C;
            const f32x4 lw = *(const f32x4*)(p->in[I_LNW] + pc), lb = *(const f32x4*)(p->in[I_LNB] + pc), v = *(const f32x4*)(Vb + (size_t)row * D + C);
            const f32x4 o = ((acc[it] - mean) * rstd * lw + lb + v * rks) * ag[it];
            u32x2 w; w.x = pk2(o[0], o[1]); w.y = pk2(o[2], o[3]); *(u32x2*)(YG + (size_t)row * D + C) = w; }
    }
}
__device__ __forceinline__ void ld8bf(const bf16_t* p, float (&o)[8]) { const u32x4 w = *(const u32x4*)p; o[0] = bflo(w.x); o[1] = bfhi(w.x); o[2] = bflo(w.y); o[3] = bfhi(w.y); o[4] = bflo(w.z); o[5] = bfhi(w.z); o[6] = bflo(w.w); o[7] = bfhi(w.w); }
__device__ __forceinline__ void ld8f(const float* p, float (&o)[8]) { const f32x4 a = *(const f32x4*)p, b = *(const f32x4*)(p + 4); o[0] = a[0]; o[1] = a[1]; o[2] = a[2]; o[3] = a[3]; o[4] = b[0]; o[5] = b[1]; o[6] = b[2]; o[7] = b[3]; }
__device__ __forceinline__ void phase_conv(KP p, const Ctx& c, int layer) {
    const bf16_t* U = (const bf16_t*)(p->ws + WS_U); const bf16_t* GT = (const bf16_t*)(p->ws + WS_GT); bf16_t* HH = (bf16_t*)(p->ws + WS_HH);
    const float* cw = p->in[I_CONVW] + (size_t)layer * 3 * DFF; const float* cb = p->in[I_CONVB] + (size_t)layer * DFF; const float* st = p->in[I_SCONV] + (size_t)layer * SB * 2 * DFF;
    constexpr int NF8 = DFF / 8;
    for (int e = c.gtid; e < R * NF8; e += c.gsz) { const int row = e / NF8, f = 8 * (e % NF8);
        int t, b; if (row < MP) { t = row & (TP - 1); b = -1; } else { t = (row - MP) & 3; b = (row - MP) >> 2; }
        float u0[8], u1[8], u2[8], g[8], w0[8], w1[8], w2[8], bb[8];
        ld8bf(U + (size_t)row * DFF + f, u2); ld8bf(GT + (size_t)row * DFF + f, g);
        if (t >= 1) ld8bf(U + (size_t)(row - 1) * DFF + f, u1); else if (b >= 0) ld8f(st + ((size_t)b * 2 + 1) * DFF + f, u1); else {
#pragma unroll
            for (int i = 0; i < 8; ++i) u1[i] = 0.f; }
        if (t >= 2) ld8bf(U + (size_t)(row - 2) * DFF + f, u0); else if (b >= 0) ld8f(st + ((size_t)b * 2 + t) * DFF + f, u0); else {
#pragma unroll
            for (int i = 0; i < 8; ++i) u0[i] = 0.f; }
        ld8f(cw + f, w0); ld8f(cw + DFF + f, w1); ld8f(cw + 2 * DFF + f, w2); ld8f(cb + f, bb);
        float o[8];
#pragma unroll
        for (int i = 0; i < 8; ++i) o[i] = gelu_tanh(bb[i] + w0[i] * u0[i] + w1[i] * u1[i] + w2[i] * u2[i]) * g[i];
        u32x4 w; w.x = pk2(o[0], o[1]); w.y = pk2(o[2], o[3]); w.z = pk2(o[4], o[5]); w.w = pk2(o[6], o[7]);
        *(u32x4*)(HH + (size_t)row * DFF + f) = w; }
}

__device__ __forceinline__ void phase_kvpost(KP p, const Ctx& c) {
    const float* KVF = (const float*)(p->ws + WS_KVF); unsigned char* ws = p->ws; const int lane = c.lane, g = lane >> 4, d0 = 4 * (lane & 15);
    const f32x4 gs = *(const f32x4*)(p->in[I_KNG] + 64 + d0), gw = *(const f32x4*)(p->in[I_KNG] + 128 + d0);
    bf16_t* CA = (bf16_t*)(ws + WS_CMPA); bf16_t* KS = (bf16_t*)(ws + WS_KS); bf16_t* VS = (bf16_t*)(ws + WS_VS); bf16_t* KW = (bf16_t*)(ws + WS_KW); bf16_t* VW = (bf16_t*)(ws + WS_VW);
    for (int chunk = c.gw; chunk < R / 8; chunk += c.ngw) {
        unsigned vs_[4][4], vw_[4][4];
#pragma unroll
        for (int e = 0; e < 8; ++e) { const int row = chunk * 8 + e; const float* src = KVF + (size_t)row * NKV + 4 * lane;
            f32x4 v[6];
#pragma unroll
            for (int pt = 0; pt < 6; ++pt) v[pt] = *(const f32x4*)(src + pt * 256);
            { float s = (v[2][0] * v[2][0] + v[2][1] * v[2][1]) + (v[2][2] * v[2][2] + v[2][3] * v[2][3]);
              s = row16_sum(s); const float rs = frsq(s * (1.0f / 64.0f) + NORM_EPS); v[2] = v[2] * rs * gs; }
            { float s = (v[4][0] * v[4][0] + v[4][1] * v[4][1]) + (v[4][2] * v[4][2] + v[4][3] * v[4][3]);
              s = row16_sum(s); const float rs = frsq(s * (1.0f / 64.0f) + NORM_EPS); v[4] = v[4] * rs * gw; }
            float* okv = p->out + O_KV + (size_t)row * D + 4 * lane;
#pragma unroll
            for (int pt = 0; pt < 4; ++pt) *(f32x4*)(okv + pt * 256) = v[pt];
            if (row < MP) { const int b = row >> 13, t = row & (TP - 1);
                if (t >= TP - WIN) { float* ow = p->out + O_WINP + ((size_t)(b * WIN + (t - (TP - WIN))) * 2) * 256 + 4 * lane; *(f32x4*)ow = v[4]; *(f32x4*)(ow + 256) = v[5]; }
                const size_t hb = (size_t)(b * G + g);
                { u32x2 w; w.x = pk2(v[0][0], v[0][1]); w.y = pk2(v[0][2], v[0][3]); *(u32x2*)(CA + (hb * 512 + (t >> 4)) * 1024 + (t & 15) * 64 + d0) = w; }
                { u32x2 w; w.x = pk2(v[1][0], v[1][1]); w.y = pk2(v[1][2], v[1][3]); *(u32x2*)(CA + ((size_t)4096 + hb * 512 + (t >> 4)) * 1024 + (t & 15) * 64 + d0) = w; }
                { u32x2 w; w.x = pk2(v[2][0], v[2][1]); w.y = pk2(v[2][2], v[2][3]); *(u32x2*)(KS + (hb * TP + t) * 64 + d0) = w; }
                { u32x2 w; w.x = pk2(v[4][0], v[4][1]); w.y = pk2(v[4][2], v[4][3]); *(u32x2*)(KW + (hb * TP + t) * 64 + d0) = w; }
#pragma unroll
                for (int d = 0; d < 4; ++d) { const unsigned a = f2bf(v[3][d]), bq = f2bf(v[5][d]);
                    if (e & 1) { vs_[d][e >> 1] |= a << 16; vw_[d][e >> 1] |= bq << 16; } else { vs_[d][e >> 1] = a; vw_[d][e >> 1] = bq; } }
            } else { const int b = (row - MP) >> 2, t = (row - MP) & 3;
                float* ow = p->out + O_WINS + ((size_t)(b * WIN + 508 + t) * 2) * 256 + 4 * lane; *(f32x4*)ow = v[4]; *(f32x4*)(ow + 256) = v[5]; }
        }
        if (chunk * 8 < MP) { const int row = chunk * 8, b = row >> 13, t = row & (TP - 1); const size_t hb = (size_t)(b * G + g);
#pragma unroll
            for (int d = 0; d < 4; ++d) { *(u32x4*)(VS + (hb * 64 + d0 + d) * TP + t) = (u32x4){vs_[d][0], vs_[d][1], vs_[d][2], vs_[d][3]};
                *(u32x4*)(VW + (hb * 64 + d0 + d) * TP + t) = (u32x4){vw_[d][0], vw_[d][1], vw_[d][2], vw_[d][3]}; } }
    }
}

__device__ __forceinline__ void phase_cmp2(KP p, const Ctx& c) {
    unsigned char* ws = p->ws; const float* PC = (const float*)(ws + WS_PCMP); const int lane = c.lane, fr = lane & 15, fq = lane >> 4;
    const bf16_t* W2H = (const bf16_t*)(ws + WS_CW2T); const bf16_t* W2L = W2H + 2 * 64 * 128;
    constexpr int NPI = NB * G * 32, NSI = SB * G * 8, TOT = 2 * (NPI + NSI);
    for (int it = c.gw; it < TOT; it += c.ngw) {
        const bool samp = it >= 2 * NPI; const int r = samp ? it - 2 * NPI : it; const int kv = samp ? r / NSI : r / NPI; const int idx = samp ? r % NSI : r % NPI;
        const int hb = samp ? (idx >> 3) : (idx >> 5), n0 = 16 * (samp ? (idx & 7) : (idx & 31)), ncmp = samp ? NCMP_S : NCMP_P, nper = samp ? 128 : 512;
        const int n = n0 + fr; const bool live = n < ncmp;
        const size_t prow = (samp ? (size_t)8192 + (size_t)kv * 65536 : (size_t)kv * 4096) + (size_t)hb * nper + (live ? n : ncmp - 1);
        const float* cb = (const float*)(ws + WS_CBIAS) + kv * 128;
        bf16x8 hh[4], hl[4];
#pragma unroll
        for (int ks = 0; ks < 4; ++ks) { const int k0 = 32 * ks + 8 * fq; unsigned uh[8], ul[8];
            const f32x4 a0 = *(const f32x4*)(PC + prow * 256 + k0), a1 = *(const f32x4*)(PC + prow * 256 + k0 + 4);
            const f32x4 b0 = *(const f32x4*)(PC + (prow + 1) * 256 + 128 + k0), b1 = *(const f32x4*)(PC + (prow + 1) * 256 + 128 + k0 + 4);
            const f32x4 c0 = *(const f32x4*)(cb + k0), c1 = *(const f32x4*)(cb + k0 + 4);
#pragma unroll
            for (int e = 0; e < 8; ++e) { const float x = e < 4 ? a0[e] + b0[e] + c0[e] : a1[e - 4] + b1[e - 4] + c1[e - 4]; const float hv = gelu_tanh(x);
                uh[e] = f2bf(hv); ul[e] = f2bf(hv - __builtin_bit_cast(float, uh[e] << 16)); }
            const u32x4 wh = {uh[0] | (uh[1] << 16), uh[2] | (uh[3] << 16), uh[4] | (uh[5] << 16), uh[6] | (uh[7] << 16)}, wl = {ul[0] | (ul[1] << 16), ul[2] | (ul[3] << 16), ul[4] | (ul[5] << 16), ul[6] | (ul[7] << 16)};
            hh[ks] = __builtin_bit_cast(bf16x8, wh); hl[ks] = __builtin_bit_cast(bf16x8, wl); }
        f32x4 acc[4];
#pragma unroll
        for (int dt = 0; dt < 4; ++dt) { acc[dt] = *(const f32x4*)(p->in[I_CB2] + kv * 64 + 16 * dt + 4 * fq);
#pragma unroll
            for (int ks = 0; ks < 4; ++ks) { const size_t wo = (size_t)(kv * 64 + 16 * dt + fr) * 128 + 32 * ks + 8 * fq; const bf16x8 wh = *(const bf16x8*)(W2H + wo), wl = *(const bf16x8*)(W2L + wo);
                acc[dt] = mfma16(wh, hh[ks], acc[dt]); acc[dt] = mfma16(wh, hl[ks], acc[dt]); acc[dt] = mfma16(wl, hh[ks], acc[dt]); } }
        if (kv == 0) { float ss = 0.f;
#pragma unroll
            for (int dt = 0; dt < 4; ++dt) ss += (acc[dt][0] * acc[dt][0] + acc[dt][1] * acc[dt][1]) + (acc[dt][2] * acc[dt][2] + acc[dt][3] * acc[dt][3]);
            ss = sum_rows4(ss); const float rs = frsq(ss * (1.0f / 64.0f) + NORM_EPS);
#pragma unroll
            for (int dt = 0; dt < 4; ++dt) acc[dt] = acc[dt] * rs * *(const f32x4*)(p->in[I_KNG] + 16 * dt + 4 * fq); }
#pragma unroll
        for (int dt = 0; dt < 4; ++dt) { const f32x4 o = live ? acc[dt] : (f32x4){0.f, 0.f, 0.f, 0.f}; const int d = 16 * dt + 4 * fq;
            if (samp) *(f32x4*)((float*)(ws + (kv ? WS_CVS : WS_CKS)) + ((size_t)hb * 128 + n) * 64 + d) = o;
            else if (kv == 0) { u32x2 w; w.x = pk2(o[0], o[1]); w.y = pk2(o[2], o[3]); *(u32x2*)((bf16_t*)(ws + WS_CK) + ((size_t)hb * 512 + n) * 64 + d) = w; }
            else {
#pragma unroll
                for (int e = 0; e < 4; ++e) ((bf16_t*)(ws + WS_CV))[((size_t)hb * 64 + d + e) * 512 + n] = (bf16_t)f2bf(o[e]); } }
    }
}

__device__ __forceinline__ void phase_qpost(KP p, const Ctx& c, int lb) {
    const float* QF = (const float*)(p->ws + WS_QF); bf16_t* Q = (bf16_t*)(p->ws + WS_Q); const int lane = c.lane;
    const f32x4 gq = *(const f32x4*)(p->in[I_QNG] + lb * 64 + 4 * (lane & 15));
    for (int row = c.gw; row < R; row += c.ngw) { const float* src = QF + (size_t)row * NQP;
        f32x4 v[4]; load_row(src, lane, v);
#pragma unroll
        for (int j = 0; j < 4; ++j) { float s = (v[j][0] * v[j][0] + v[j][1] * v[j][1]) + (v[j][2] * v[j][2] + v[j][3] * v[j][3]);
            s = row16_sum(s);
            const float rs = (frsq(s * (1.0f / 64.0f) + NORM_EPS)) * (0.125f * 1.4426950408889634f); v[j] = v[j] * rs * gq; }
        store_row_bf16(Q + (size_t)row * D, lane, v);
    }
}
constexpr int AT_K0 = 0, AT_V0 = 9216, AT_K1 = 18432, AT_V1 = 27648, AT_IMP = 36864, IMPS = 132, AT_SELM = AT_IMP + 64 * IMPS * 4, AT_ANY = AT_SELM + 1024;
static_assert(AT_ANY + 16 <= RING_BYTES, "attention LDS map");
struct TileSrc { const bf16_t* K; const bf16_t* VT; int vts; };
__device__ __forceinline__ void tile_load(const TileSrc& s, int key0, int tid, u32x4& rk, u32x4& rv) {
    const int row = tid >> 3, ch = tid & 7;
    rk = *(const u32x4*)(s.K + (size_t)(key0 + row) * 64 + 8 * ch); rv = *(const u32x4*)(s.VT + (size_t)row * s.vts + key0 + 8 * ch);
}
__device__ __forceinline__ void tile_load_async(const TileSrc& s, int key0, int tid, u32x4& rk, u32x4& rv) {
    const int row = tid >> 3, ch = tid & 7;
    const bf16_t* pk = s.K + (size_t)(key0 + row) * 64 + 8 * ch; const bf16_t* pv = s.VT + (size_t)row * s.vts + key0 + 8 * ch;
    asm volatile("global_load_dwordx4 %0, %2, off\n\tglobal_load_dwordx4 %1, %3, off" : "=&v"(rk), "=&v"(rv) : "v"(pk), "v"(pv) : "memory");
}
#define TILE_WAIT(N_, RK_, RV_) asm volatile("s_waitcnt vmcnt(" #N_ ")" : "+v"(RK_), "+v"(RV_) :: "memory")
__device__ __forceinline__ void tile_store(LAS unsigned char* lds, int buf, int tid, const u32x4& rk, const u32x4& rv) {
    const int row = tid >> 3, ch = tid & 7;
    *(LAS u32x4*)(lds + (buf ? AT_K1 : AT_K0) + (row * SST + 8 * ch) * 2) = rk; *(LAS u32x4*)(lds + (buf ? AT_V1 : AT_V0) + (row * SST + 8 * ch) * 2) = rv;
}
__device__ __forceinline__ int first_bit4(unsigned a, unsigned b, unsigned c, unsigned d) { return a ? __ffs(a) - 1 : (b ? 32 + __ffs(b) - 1 : (c ? 64 + __ffs(c) - 1 : (d ? 96 + __ffs(d) - 1 : -1))); }
__device__ __forceinline__ float ex2(float x) { return __builtin_amdgcn_exp2f(x); }

__device__ __forceinline__ void set_bit4(int s, unsigned& t0, unsigned& t1, unsigned& t2, unsigned& t3) { const unsigned bit = 1u << (s & 31); const int w = s >> 5; t0 |= (w == 0) ? bit : 0u; t1 |= (w == 1) ? bit : 0u; t2 |= (w == 2) ? bit : 0u; t3 |= (w == 3) ? bit : 0u; }
__device__ __forceinline__ void clr_bit4(int s, unsigned& t0, unsigned& t1, unsigned& t2, unsigned& t3) { const unsigned bit = 1u << (s & 31); const int w = s >> 5; t0 &= ~((w == 0) ? bit : 0u); t1 &= ~((w == 1) ? bit : 0u); t2 &= ~((w == 2) ? bit : 0u); t3 &= ~((w == 3) ? bit : 0u); }
__device__ __forceinline__ unsigned get_word4(int s, unsigned a, unsigned b, unsigned c, unsigned d) { const int w = s >> 5; return ((w == 0) ? a : 0u) | ((w == 1) ? b : 0u) | ((w == 2) ? c : 0u) | ((w == 3) ? d : 0u); }
__device__ __forceinline__ float dpp_xor1(float x) { return __builtin_bit_cast(float, __builtin_amdgcn_update_dpp(0, __builtin_bit_cast(int, x), 0xB1, 0xF, 0xF, true)); }
__device__ __forceinline__ float dpp_xor2(float x) { return __builtin_bit_cast(float, __builtin_amdgcn_update_dpp(0, __builtin_bit_cast(int, x), 0x4E, 0xF, 0xF, true)); }
template <int MODE, bool EDGE> __device__ __forceinline__ void attn_tile(LAS unsigned char* lds, int buf, const bf16x8 (&qf)[4], int key0, int qpos, int r, int hf,
                                                                          float& l, f32x16 (&O)[2], float invl, bool selbit, LAS float* impq) {
    if (MODE == 3) { if (__ballot(selbit) == 0ull) { asm volatile("" : "+v"(O[0]), "+v"(O[1]), "+v"(l)); return; } }
    const float sbias = selbit ? 0.f : -1.0e30f;
    const int oK = buf ? AT_K1 : AT_K0, oV = buf ? AT_V1 : AT_V0;
#pragma unroll
    for (int kt = 0; kt < 2; ++kt) {
        f32x16 S;
#pragma unroll
        for (int i = 0; i < 16; ++i) S[i] = (MODE == 3) ? sbias : 0.f;
#pragma unroll
        for (int ks = 0; ks < 4; ++ks) S = mfma32(*(const LAS bf16x8*)(lds + oK + ((32 * kt + r) * SST + 16 * ks + 8 * hf) * 2), qf[ks], S);
        float ls = 0.f;
#pragma unroll
        for (int i = 0; i < 16; ++i) { float pv = ex2(S[i]);
            if (EDGE) { const int key = key0 + 32 * kt + (i & 3) + 8 * (i >> 2) + 4 * hf; bool v;
                if (MODE <= 1) v = (16 * key + 31 <= qpos); else if (MODE == 2) v = (key <= qpos) && (key + WIN > qpos); else v = (key <= qpos);
                pv = v ? pv : 0.f; }
            if (MODE == 1) pv *= invl;
            S[i] = pv; ls += pv; }
        if (MODE != 1) l += ls;
        if (MODE >= 1) {
#pragma unroll
            for (int sp = 0; sp < 2; ++sp) {
                u32x4 pw; pw.x = pg8::cvt_pk_bf16(S[8 * sp + 0], S[8 * sp + 1]); pw.y = pg8::cvt_pk_bf16(S[8 * sp + 2], S[8 * sp + 3]); pw.z = pg8::cvt_pk_bf16(S[8 * sp + 4], S[8 * sp + 5]); pw.w = pg8::cvt_pk_bf16(S[8 * sp + 6], S[8 * sp + 7]);
                const bf16x8 pf = __builtin_bit_cast(bf16x8, pw);
#pragma unroll
                for (int dt = 0; dt < 2; ++dt) { const int d = 32 * dt + r, kb = 32 * kt + 16 * sp + 4 * hf;
                    const u32x2 lo = *(const LAS u32x2*)(lds + oV + (d * SST + kb) * 2), hi = *(const LAS u32x2*)(lds + oV + (d * SST + kb + 8) * 2);
                    const u32x4 vw = {lo.x, lo.y, hi.x, hi.y};
                    O[dt] = mfma32(__builtin_bit_cast(bf16x8, vw), pf, O[dt]); } }
        }
        if (MODE == 1) {
            float own[4], nxt[4];
#pragma unroll
            for (int gq = 0; gq < 4; ++gq) { const float p3 = S[4 * gq + 3]; float o = 2.0f * (S[4 * gq] + S[4 * gq + 1] + S[4 * gq + 2]) + p3, n = p3;
                o += dpp_xor1(o); o += dpp_xor2(o); n += dpp_xor1(n); n += dpp_xor2(n); own[gq] = o; nxt[gq] = n; }
            const int sbb = (key0 >> 2) + 8 * kt + hf;
            if ((r & 3) == 0) {
#pragma unroll
                for (int gq = 0; gq < 4; ++gq) impq[sbb + 2 * gq] += own[gq]; }
            asm volatile("s_waitcnt lgkmcnt(0)" ::: "memory");
            if ((r & 3) == 0) {
#pragma unroll
                for (int gq = 0; gq < 4; ++gq) impq[sbb + 2 * gq + 1] += nxt[gq]; }
            asm volatile("s_waitcnt lgkmcnt(0)" ::: "memory");
        }
    }
}

template <int MODE> __device__ __forceinline__ void run_tiles(LAS unsigned char* lds, const TileSrc& src, unsigned t0, unsigned t1, unsigned t2, unsigned t3, int qt,
                                                              const bf16x8 (&qf)[4], int qpos, int r, int hf, int tid,
                                                              float& l, f32x16 (&O)[2], float invl, unsigned s0, unsigned s1, unsigned s2, unsigned s3, LAS float* impq, const int alias = 0) {
#define TSEL(n_) ((alias ? ((n_) & 7) : (n_)) * 64)
    tid = launder_v(tid); r = tid & 31; hf = (tid >> 5) & 1;
    int cur = first_bit4(t0, t1, t2, t3); if (cur < 0) return;
    const int first = cur;
    clr_bit4(cur, t0, t1, t2, t3); int n1 = first_bit4(t0, t1, t2, t3); if (n1 >= 0) clr_bit4(n1, t0, t1, t2, t3);
    int n2 = first_bit4(t0, t1, t2, t3); if (n2 >= 0) clr_bit4(n2, t0, t1, t2, t3);
    int n3 = first_bit4(t0, t1, t2, t3); if (n3 >= 0) clr_bit4(n3, t0, t1, t2, t3);
    u32x4 rkA, rvA, rkB, rvB, rkC, rvC; { u32x4 rk, rv; tile_load(src, TSEL(cur), tid, rk, rv); int b0 = 0; tile_store(lds, b0, tid, rk, rv); }
    tile_load_async(src, TSEL(n1 >= 0 ? n1 : first), tid, rkA, rvA);
    tile_load_async(src, TSEL(n2 >= 0 ? n2 : first), tid, rkB, rvB);
    tile_load_async(src, TSEL(n3 >= 0 ? n3 : first), tid, rkC, rvC);
    int buf = 0;
    __syncthreads();
#define RT_STEP(RK_, RV_) { \
        if (cur >= 0) { \
            const unsigned sw = get_word4(cur, s0, s1, s2, s3); \
            const bool sb = ((sw >> (cur & 31)) & 1u) != 0u; \
            if (MODE <= 1) attn_tile<MODE, true>(lds, buf, qf, cur * 64, qpos, r, hf, l, O, invl, sb, impq); \
            else { const bool edge = (cur == qt) || (MODE == 2 && cur == qt - 8); \
                if (edge) attn_tile<MODE, true>(lds, buf, qf, cur * 64, qpos, r, hf, l, O, invl, sb, impq); \
                else attn_tile<MODE, false>(lds, buf, qf, cur * 64, qpos, r, hf, l, O, invl, sb, impq); } } \
        TILE_WAIT(4, RK_, RV_); \
        tile_store(lds, buf ^ 1, tid, RK_, RV_); \
        __syncthreads(); \
        const int n4 = first_bit4(t0, t1, t2, t3); if (n4 >= 0) clr_bit4(n4, t0, t1, t2, t3); \
        tile_load_async(src, TSEL(n4 >= 0 ? n4 : first), tid, RK_, RV_); \
        buf ^= 1; cur = n1; n1 = n2; n2 = n3; n3 = n4; }
    do {
        RT_STEP(rkA, rvA)
        RT_STEP(rkB, rvB)
        RT_STEP(rkC, rvC)
    } while (cur >= 0);
#undef RT_STEP
    asm volatile("s_waitcnt vmcnt(0)" : "+v"(rkA), "+v"(rvA), "+v"(rkB), "+v"(rvB), "+v"(rkC), "+v"(rvC) :: "memory");
    __syncthreads();
}
__device__ __forceinline__ void attn_prompt_unit(KP p, const Ctx& c, int k, const int stop) {
    LAS unsigned char* lds = c.lds; unsigned char* ws = p->ws; int tid_m; asm volatile("v_mbcnt_lo_u32_b32 %0, -1, 0\n\tv_mbcnt_hi_u32_b32 %0, -1, %0" : "=v"(tid_m));
    const int wave = c.wave, tid = tid_m + 64 * wave, lane = tid & 63, r = lane & 31, hf = lane >> 5;
    const int qt = 127 - (k >> 3), hb = k & 7, b = hb >> 2, g = hb & 3, q0 = 64 * qt;
    const int qi = 8 * wave + (r >> 2), head = 4 * g + (r & 3), qpos = q0 + qi, row = b * TP + qpos;
    const bf16_t* Q = (const bf16_t*)(ws + WS_Q);
    bf16x8 qf[4];
#pragma unroll
    for (int ks = 0; ks < 4; ++ks) qf[ks] = *(const bf16x8*)(Q + (size_t)row * D + head * 64 + 16 * ks + 8 * hf);
    const float* gate = (const float*)(ws + WS_GATE) + (size_t)row * 48 + head * 3; const float g_c = gate[0], g_s = gate[1], g_w = gate[2];
    LAS float* imp = (LAS float*)(lds + AT_IMP); LAS unsigned* selm = (LAS unsigned*)(lds + AT_SELM); LAS unsigned* anym = (LAS unsigned*)(lds + AT_ANY);
    for (int e = tid; e < 64 * IMPS; e += 512) imp[e] = 0.f;
    if (tid < 4) anym[tid] = 0u;
    __syncthreads();
    f32x16 O[2]; unsigned OUTP[2][8];
#pragma unroll
    for (int dt = 0; dt < 2; ++dt)
#pragma unroll
        for (int i = 0; i < 16; ++i) O[dt][i] = 0.f;
    {
        const TileSrc src{(const bf16_t*)(ws + WS_CK) + (size_t)hb * 512 * 64, (const bf16_t*)(ws + WS_CV) + (size_t)hb * 64 * 512, 512};
        const int nmax = q0 + 63 - 31; const int ntc = nmax >= 0 ? (nmax >> 10) + 1 : 0;
        const unsigned tm = ntc >= 32 ? 0xffffffffu : ((1u << ntc) - 1u);
        float l = 0.f;
        run_tiles<0>(lds, src, tm, 0u, 0u, 0u, qt, qf, qpos, r, hf, tid, l, O, 0.f, 0u, 0u, 0u, 0u, imp);
        l = sum_xor32(l); const float invl = l > 0.f ? 1.0f / l : 0.f;
        run_tiles<1>(lds, src, tm, 0u, 0u, 0u, qt, qf, qpos, r, hf, tid, l, O, invl, 0u, 0u, 0u, 0u, imp + qi * IMPS);
#pragma unroll
        for (int dt = 0; dt < 2; ++dt) {
#pragma unroll
            for (int i = 0; i < 8; ++i) { OUTP[dt][i] = pg8::cvt_pk_bf16(O[dt][2 * i] * g_c, O[dt][2 * i + 1] * g_c); asm volatile("" : "+v"(OUTP[dt][i])); }
#pragma unroll
            for (int i = 0; i < 16; ++i) O[dt][i] = 0.f; }
    }
    __syncthreads();
    if (stop == 1) return;
    {
        unsigned k0[8], k1[8], T[8]; int Kq[8];
#pragma unroll
        for (int e = 0; e < 8; ++e) { const int qq = 8 * wave + e, qp = q0 + qq, qb = qp >> 6;
            const bool c0 = (64 * lane <= qp), c1 = (64 * (lane + 64) <= qp);
            const unsigned a0_ = (lane == 0 || lane == qb || lane == qb - 1) ? 0xffffffffu : __builtin_bit_cast(unsigned, imp[qq * IMPS + lane]);
            const unsigned a1_ = (lane + 64 == qb || lane + 64 == qb - 1) ? 0xffffffffu : __builtin_bit_cast(unsigned, imp[qq * IMPS + lane + 64]);
            k0[e] = c0 ? a0_ : 0u; k1[e] = c1 ? a1_ : 0u;
            Kq[e] = qb + 1 < 16 ? qb + 1 : 16; T[e] = 0u; }
        for (int bit = 31; bit >= 0; --bit) {
#pragma unroll
            for (int e = 0; e < 8; ++e) { const unsigned cand = T[e] | (1u << bit);
                const int cnt = __popcll(__ballot(k0[e] >= cand)) + __popcll(__ballot(k1[e] >= cand)); if (cnt >= Kq[e]) T[e] = cand; } }
#pragma unroll
        for (int e = 0; e < 8; ++e) { const int qq = 8 * wave + e, qp = q0 + qq;
            const bool c0 = (64 * lane <= qp), c1 = (64 * (lane + 64) <= qp);
            unsigned long long mlo = __ballot(k0[e] > T[e]), mhi = __ballot(k1[e] > T[e]), elo = __ballot(c0 && k0[e] == T[e]), ehi = __ballot(c1 && k1[e] == T[e]);
            int need = Kq[e] - (__popcll(mlo) + __popcll(mhi));
            for (; need > 0; --need) { if (elo) { mlo |= elo & (~elo + 1ull); elo &= elo - 1ull; } else { mhi |= ehi & (~ehi + 1ull); ehi &= ehi - 1ull; } }
            const unsigned m0 = (unsigned)mlo, m1 = (unsigned)(mlo >> 32), m2 = (unsigned)mhi, m3 = (unsigned)(mhi >> 32);
            if (lane == 0) { selm[qq * 4 + 0] = m0; selm[qq * 4 + 1] = m1; selm[qq * 4 + 2] = m2; selm[qq * 4 + 3] = m3;
                atomicOr((unsigned*)&anym[0], m0); atomicOr((unsigned*)&anym[1], m1); atomicOr((unsigned*)&anym[2], m2); atomicOr((unsigned*)&anym[3], m3); } }
    }
    __syncthreads();
    if (stop == 2) return;
    {
        const TileSrc src{(const bf16_t*)(ws + WS_KW) + (size_t)hb * TP * 64, (const bf16_t*)(ws + WS_VW) + (size_t)hb * 64 * TP, TP};
        const int tlo = qt >= 8 ? qt - 8 : 0; unsigned t0 = 0u, t1 = 0u, t2 = 0u, t3 = 0u;
        for (int s = tlo; s <= qt; ++s) set_bit4(s, t0, t1, t2, t3);
        float l = 0.f;
        run_tiles<2>(lds, src, t0, t1, t2, t3, qt, qf, qpos, r, hf, tid, l, O, 0.f, 0u, 0u, 0u, 0u, imp);
        l = sum_xor32(l); const float sc = l > 0.f ? g_w / l : 0.f;
#pragma unroll
        for (int dt = 0; dt < 2; ++dt) {
#pragma unroll
            for (int i = 0; i < 8; ++i) { OUTP[dt][i] = pg8::cvt_pk_bf16(bflo(OUTP[dt][i]) + O[dt][2 * i] * sc, bfhi(OUTP[dt][i]) + O[dt][2 * i + 1] * sc); asm volatile("" : "+v"(OUTP[dt][i])); }
#pragma unroll
            for (int i = 0; i < 16; ++i) O[dt][i] = 0.f; }
    }
    if (stop == 3) { __syncthreads(); return; }
    {
        const TileSrc src{(const bf16_t*)(ws + WS_KS) + (size_t)hb * TP * 64, (const bf16_t*)(ws + WS_VS) + (size_t)hb * 64 * TP, TP};
        const unsigned sz_ = (stop == 5) ? 0u : 0xffffffffu;
        const unsigned s0 = selm[qi * 4 + 0] & sz_, s1 = selm[qi * 4 + 1] & sz_, s2 = selm[qi * 4 + 2] & sz_, s3 = selm[qi * 4 + 3] & sz_;
        const unsigned a0 = __builtin_amdgcn_readfirstlane(anym[0]), a1 = __builtin_amdgcn_readfirstlane(anym[1]), a2 = __builtin_amdgcn_readfirstlane(anym[2]), a3 = __builtin_amdgcn_readfirstlane(anym[3]);
        float l = 0.f;
        run_tiles<3>(lds, src, a0, a1, a2, a3, qt, qf, qpos, r, hf, tid, l, O, 0.f, s0, s1, s2, s3, imp, stop == 4 ? 1 : 0);
        if (stop >= 4) { if (l == 12345.678f) ((float*)(ws + WS_GATE))[0] = O[0][0] + O[1][0]; __syncthreads(); return; }
        l = sum_xor32(l); const float sc = l > 0.f ? g_s / l : 0.f;
#pragma unroll
        for (int dt = 0; dt < 2; ++dt)
#pragma unroll
            for (int i = 0; i < 8; ++i) OUTP[dt][i] = pg8::cvt_pk_bf16(bflo(OUTP[dt][i]) + O[dt][2 * i] * sc, bfhi(OUTP[dt][i]) + O[dt][2 * i + 1] * sc);
    }
    bf16_t* AO = (bf16_t*)(ws + WS_YG) + (size_t)row * D + head * 64;
#pragma unroll
    for (int dt = 0; dt < 2; ++dt)
#pragma unroll
        for (int gq = 0; gq < 4; ++gq) { u32x2 w; w.x = OUTP[dt][2 * gq]; w.y = OUTP[dt][2 * gq + 1]; *(u32x2*)(AO + 32 * dt + 8 * gq + 4 * hf) = w; }
    __syncthreads();
}

constexpr int SA_RED = 0, SA_REDW = 2 * 16 * 65 * 4, SA_OC = SA_RED + SA_REDW, SA_EC = SA_OC + 2 * 4096, SA_LC = SA_EC + 2 * 4096, SA_PN = SA_LC + 256, SA_SEL = SA_PN + 4 * 512;
static_assert(SA_SEL + 64 <= RING_BYTES, "sample attention LDS map");
__device__ __forceinline__ bf16x8 pack8(const f32x4 a, const f32x4 b) { const u32x4 w = {pk2(a[0], a[1]), pk2(a[2], a[3]), pk2(b[0], b[1]), pk2(b[2], b[3])}; return __builtin_bit_cast(bf16x8, w); }
__device__ __forceinline__ void sa_qk(const float* kb, size_t stride, int nrows, const bf16x8 (&qf)[2], int fr, int fq, f32x4 (&S)[4]) {
    f32x4 kr[4][2][2];
#pragma unroll
    for (int kg = 0; kg < 4; ++kg) { const int key = 16 * kg + fr; const float* rp = kb + (size_t)(key < nrows ? key : nrows - 1) * stride + 8 * fq;
#pragma unroll
        for (int ks = 0; ks < 2; ++ks) { kr[kg][ks][0] = *(const f32x4*)(rp + 32 * ks); kr[kg][ks][1] = *(const f32x4*)(rp + 32 * ks + 4); } }
#pragma unroll
    for (int kg = 0; kg < 4; ++kg) { S[kg] = (f32x4){0.f, 0.f, 0.f, 0.f};
#pragma unroll
        for (int ks = 0; ks < 2; ++ks) S[kg] = mfma16(pack8(kr[kg][ks][0], kr[kg][ks][1]), qf[ks], S[kg]); }
}
__device__ __forceinline__ void sa_pv(const float* vb, size_t stride, int nrows, const f32x4 (&P)[4], int fr, int fq, f32x4 (&O)[4]) {
#pragma unroll
    for (int ks = 0; ks < 2; ++ks) { const bf16x8 pa = pack8(P[2 * ks], P[2 * ks + 1]);
        float vv[4][8];
#pragma unroll
        for (int j = 0; j < 8; ++j) { const int key = 16 * (2 * ks + (j >> 2)) + 4 * fq + (j & 3); const float* rp = vb + (size_t)(key < nrows ? key : nrows - 1) * stride + fr;
#pragma unroll
            for (int dt = 0; dt < 4; ++dt) vv[dt][j] = rp[16 * dt]; }
#pragma unroll
        for (int dt = 0; dt < 4; ++dt) { const u32x4 w = {pk2(vv[dt][0], vv[dt][1]), pk2(vv[dt][2], vv[dt][3]), pk2(vv[dt][4], vv[dt][5]), pk2(vv[dt][6], vv[dt][7])};
            O[dt] = mfma16(pa, __builtin_bit_cast(bf16x8, w), O[dt]); } }
}
__device__ __forceinline__ void attn_sample_unit(KP p, const Ctx& c, int item) {
    unsigned char* ws = p->ws; LAS unsigned char* lds = c.lds; const int tid = launder_v(c.tid), lane = tid & 63, wave = c.wave, fr = lane & 15, fq = lane >> 4; const int b = item >> 2, g = item & 3;
    bf16x8 qf[2];
    { const bf16_t* Q = (const bf16_t*)(ws + WS_Q) + (size_t)(MP + 4 * b + (fr >> 2)) * D + (4 * g + (fr & 3)) * 64 + 8 * fq;
      qf[0] = *(const bf16x8*)Q; qf[1] = *(const bf16x8*)(Q + 32); }
    const int tokm = fr >> 2;
    if (wave < 2) {
        const float* ck = (const float*)(ws + WS_CKS) + ((size_t)(b * 4 + g) * 128 + 64 * wave) * 64; const float* cv = (const float*)(ws + WS_CVS) + ((size_t)(b * 4 + g) * 128 + 64 * wave) * 64;
        const int nrows = wave ? 63 : 64;
        f32x4 S[4]; sa_qk(ck, 64, nrows, qf, fr, fq, S);
        float ls = 0.f;
#pragma unroll
        for (int kg = 0; kg < 4; ++kg)
#pragma unroll
            for (int r = 0; r < 4; ++r) { const int key = 16 * kg + 4 * fq + r; const float ev = key < nrows ? ex2(S[kg][r]) : 0.f; S[kg][r] = ev; ls += ev;
                *(LAS float*)(lds + SA_EC + wave * 4096 + (key * 16 + fr) * 4) = ev; }
        ls = sum_rows4(ls); if (fq == 0) *(LAS float*)(lds + SA_LC + (wave * 16 + fr) * 4) = ls;
        f32x4 oc[4];
#pragma unroll
        for (int dt = 0; dt < 4; ++dt) oc[dt] = (f32x4){0.f, 0.f, 0.f, 0.f};
        sa_pv(cv, 64, nrows, S, fr, fq, oc);
#pragma unroll
        for (int dt = 0; dt < 4; ++dt)
#pragma unroll
            for (int r = 0; r < 4; ++r) *(LAS float*)(lds + SA_OC + wave * 4096 + ((4 * fq + r) * 64 + 16 * dt + fr) * 4) = oc[dt][r];
    }
    __syncthreads();
    if (wave < 4) { const int tok = wave; float P0 = 0.f, P1 = 0.f;
#pragma unroll
        for (int hh = 0; hh < 4; ++hh) { const int pi = tok * 4 + hh; const float L = *(const LAS float*)(lds + SA_LC + pi * 4) + *(const LAS float*)(lds + SA_LC + (16 + pi) * 4); const float inv = L > 0.f ? 1.0f / L : 0.f;
            P0 += *(const LAS float*)(lds + SA_EC + (lane * 16 + pi) * 4) * inv; P1 += *(const LAS float*)(lds + SA_EC + 4096 + (lane * 16 + pi) * 4) * inv; }
        LAS float* pn = (LAS float*)(lds + SA_PN + tok * 512); pn[lane] = P0; pn[64 + lane] = P1; LDS_WAIT();
        float v0 = -1e9f;
        if (lane < 33) { const int s = lane; float im = 0.f;
            if (4 * s - 1 >= 0 && 4 * s - 1 < 128) im += pn[4 * s - 1];
#pragma unroll
            for (int j = 0; j < 3; ++j) if (4 * s + j < 128) im += 2.0f * pn[4 * s + j];
            if (4 * s + 3 < 128) im += pn[4 * s + 3];
            v0 = (s == 0 || s == 31 || s == 32) ? 1e9f : im; }
        unsigned selmask = 0u, sel32 = 0u;
        for (int it = 0; it < 16; ++it) { const float mx = wave_max(v0); if (mx < -5e8f) break; const unsigned long long b0 = __ballot(v0 == mx); const int s = __ffsll((long long)b0) - 1;
            if (lane == s) v0 = -2e9f; if (s < 32) selmask |= 1u << s; else sel32 = 1u; }
        if (lane == 0) { *(LAS unsigned*)(lds + SA_SEL + tok * 8) = selmask; *(LAS unsigned*)(lds + SA_SEL + tok * 8 + 4) = sel32; } }
    __syncthreads();
    unsigned sm[4], s32[4];
#pragma unroll
    for (int t = 0; t < 4; ++t) { sm[t] = *(const LAS unsigned*)(lds + SA_SEL + t * 8); s32[t] = *(const LAS unsigned*)(lds + SA_SEL + t * 8 + 4); }
    const unsigned un = sm[0] | sm[1] | sm[2] | sm[3]; const int nsel = __popc(un); const int has32 = (s32[0] | s32[1] | s32[2] | s32[3]) ? 1 : 0;
    const unsigned my_sm = tokm == 0 ? sm[0] : (tokm == 1 ? sm[1] : (tokm == 2 ? sm[2] : sm[3])), my_s32 = tokm == 0 ? s32[0] : (tokm == 1 ? s32[1] : (tokm == 2 ? s32[2] : s32[3]));
    const int ntile = nsel + has32 + 9;
    const int* pt = (const int*)p->in[I_PT] + b * NPAGES;
    f32x4 osel[4], owin[4]; float lsel = 0.f, lwin = 0.f;
#pragma unroll
    for (int dt = 0; dt < 4; ++dt) { osel[dt] = (f32x4){0.f, 0.f, 0.f, 0.f}; owin[dt] = (f32x4){0.f, 0.f, 0.f, 0.f}; }
    for (int ti = wave; ti < ntile; ti += 8) {
        const float* kb; size_t stride; int nrows = 64, br, mode, sidx = 0;
        if (ti < nsel) { unsigned m = un; for (int q = 0; q < ti; ++q) m &= m - 1u; sidx = __ffs(m) - 1; const int page = pt[sidx >> 1];
            kb = p->in[I_CKV] + ((size_t)page * PAGE + (sidx & 1) * 64) * 1024 + 2 * 256 + g * 64; stride = 1024; br = 0; mode = 0; }
        else if (ti < nsel + has32) { kb = p->out + O_KV + (size_t)(MP + 4 * b) * D + 2 * 256 + g * 64; stride = 1024; nrows = 4; br = 0; mode = 1; }
        else if (ti < nsel + has32 + 8) { sidx = ti - nsel - has32; kb = p->in[I_CWIN] + ((size_t)b * WIN + 64 * sidx) * 512 + g * 64; stride = 512; br = 1; mode = 2; }
        else { kb = p->out + O_WINS + ((size_t)(b * WIN + 508) * 2) * 256 + g * 64; stride = 512; nrows = 4; br = 1; mode = 3; }
        f32x4 S[4]; sa_qk(kb, stride, nrows, qf, fr, fq, S);
        float ls = 0.f;
#pragma unroll
        for (int kg = 0; kg < 4; ++kg)
#pragma unroll
            for (int r = 0; r < 4; ++r) { const int key = 16 * kg + 4 * fq + r; bool valid;
                if (mode == 0) valid = ((my_sm >> sidx) & 1u) != 0u; else if (mode == 1) valid = (my_s32 != 0u) && (key <= tokm); else if (mode == 2) valid = (64 * sidx + key) >= tokm + 1; else valid = key <= tokm;
                const float ev = valid ? ex2(S[kg][r]) : 0.f; S[kg][r] = ev; ls += ev; }
        if (br == 0) { lsel += ls; sa_pv(kb + 256, stride, nrows, S, fr, fq, osel); } else { lwin += ls; sa_pv(kb + 256, stride, nrows, S, fr, fq, owin); }
    }
    lsel = sum_rows4(lsel); lwin = sum_rows4(lwin);
    for (int w = 0; w < 8; ++w) {
        if (wave == w) {
#pragma unroll
            for (int dt = 0; dt < 4; ++dt)
#pragma unroll
                for (int r = 0; r < 4; ++r) { LAS float* r0 = (LAS float*)(lds + SA_RED + ((4 * fq + r) * 65 + 16 * dt + fr) * 4); LAS float* r1 = (LAS float*)(lds + SA_RED + ((16 + 4 * fq + r) * 65 + 16 * dt + fr) * 4);
                    if (w == 0) { *r0 = osel[dt][r]; *r1 = owin[dt][r]; } else { *r0 += osel[dt][r]; *r1 += owin[dt][r]; } }
            if (fq == 0) { LAS float* l0 = (LAS float*)(lds + SA_RED + (fr * 65 + 64) * 4); LAS float* l1 = (LAS float*)(lds + SA_RED + ((16 + fr) * 65 + 64) * 4);
                if (w == 0) { *l0 = lsel; *l1 = lwin; } else { *l0 += lsel; *l1 += lwin; } } }
        __syncthreads(); }
    { const float* gt = (const float*)(ws + WS_GATE); bf16_t* AO = (bf16_t*)(ws + WS_YG);
      for (int e = tid; e < 1024; e += 512) { const int pi = e >> 6, d = e & 63, tok = pi >> 2, hh = pi & 3; const size_t row = (size_t)(MP + 4 * b + tok);
          const float lc = *(const LAS float*)(lds + SA_LC + pi * 4) + *(const LAS float*)(lds + SA_LC + (16 + pi) * 4);
          const float oc = *(const LAS float*)(lds + SA_OC + (pi * 64 + d) * 4) + *(const LAS float*)(lds + SA_OC + 4096 + (pi * 64 + d) * 4);
          const LAS float* r0 = (const LAS float*)(lds + SA_RED + (pi * 65) * 4); const LAS float* r1 = (const LAS float*)(lds + SA_RED + ((16 + pi) * 65) * 4);
          const float* gg = gt + row * 48 + (4 * g + hh) * 3;
          float out = lc > 0.f ? gg[0] * oc / lc : 0.f;
          out += r0[64] > 0.f ? gg[1] * r0[d] / r0[64] : 0.f;
          out += r1[64] > 0.f ? gg[2] * r1[d] / r1[64] : 0.f;
          AO[row * D + (4 * g + hh) * 64 + d] = (bf16_t)f2bf(out); } }
    __syncthreads();
}

__device__ __forceinline__ void phase_attn_prompt(KP p, const Ctx& c, const int stop = 0) {
    const int Gd = gridDim.x, cb = blockIdx.x;
    for (int i = 0; i * Gd < 1024; ++i) { const int k = i * Gd + ((i & 1) ? Gd - 1 - cb : cb); if (k < 1024) attn_prompt_unit(p, c, k, stop); }
}
__device__ __forceinline__ void phase_attn_sample(KP p, const Ctx& c) {
    for (int it = blockIdx.x; it < SB * G; it += gridDim.x) attn_sample_unit(p, c, it);
}
#ifndef MK_MULTI
#define MK_MULTI 0
#endif
#if defined(PROBE_SCALE) || defined(SELFTEST)
constexpr int NPH = 46;
#elif defined(PROBE_ATTN2)
constexpr int NPH = 47;
#else
constexpr int NPH = 45;
#endif
#ifdef SPLITK
#define RESID_SPLIT(n) (n)
#else
#define RESID_SPLIT(n) 0
#endif

__global__ void __launch_bounds__(512, 2) mega(Params p) {
    extern __shared__ __attribute__((aligned(16))) unsigned char lds_raw[];
    LAS unsigned char* const lds0 = (LAS unsigned char*)lds_raw;
    volatile LAS unsigned* MISC = (volatile LAS unsigned*)(lds0 + MISC_OFF);
    for (int u = threadIdx.x; u < (LDS_BYTES - RING_BYTES) / 4; u += 512) ((LAS unsigned*)(lds0 + RING_BYTES))[u] = 0u;
    __syncthreads();
    const KP kp0 = (KP)__builtin_amdgcn_kernarg_segment_ptr();
    const int ph_lo = kp0->ph_lo, ph_hi = kp0->ph_hi, use_bar = kp0->use_bar;
    XcdBarrier bar; bar.bar = (unsigned*)(kp0->ws + WS_CTL); bar.x = 0; bar.st = nullptr;
    if (use_bar) bar = xcd_barrier_post((unsigned*)(kp0->ws + WS_CTL), MISC + 8);
    const int wave_s = __builtin_amdgcn_readfirstlane((int)threadIdx.x >> 6);
#define TID_MBCNT 1
#ifdef TID_MBCNT
#define TID_SRC(T_) asm volatile("v_mbcnt_lo_u32_b32 %0, -1, 0\n\tv_mbcnt_hi_u32_b32 %0, -1, %0" : "=v"(T_)); T_ += 64 * wave_s;
#else
#define TID_SRC(T_) T_ = threadIdx.x; asm volatile("" : "+v"(T_));
#endif
    int ph = 0;
#define PHASE_BEGIN if (ph >= ph_lo && ph < ph_hi) { KP p = kp0; asm volatile("" : "+s"(p)); int tid_; TID_SRC(tid_) \
        Ctx c; c.lds = lds0; c.tid = tid_; c.lane = tid_ & 63; c.wave = __builtin_amdgcn_readfirstlane(tid_ >> 6); c.gw = blockIdx.x * 8 + c.wave; c.ngw = gridDim.x * 8; c.gtid = blockIdx.x * 512 + tid_; c.gsz = gridDim.x * 512; \
        unsigned char* ws = p->ws; float* X = p->out + O_Y; (void)ws; (void)X;
#define PHASE_END   if (use_bar) { int te_; TID_SRC(te_) xcd_barrier(bar, te_ == 0); } } ++ph;

    PHASE_BEGIN phase_prologue(p, c); PHASE_END
#ifdef PROBE_BAR
    for (int xb = 0; xb < PROBE_BAR; ++xb) { if (use_bar) xcd_barrier(bar, threadIdx.x == 0); }
#endif

    for (int layer = 0; layer < NLAY; ++layer) {
        if (layer < 2) {
            const int li = layer;
            PHASE_BEGIN phase_mix(p, c, li); PHASE_END
            PHASE_BEGIN {
                pg8::Gemm g{(const bf16_t*)(ws + WS_XM), (const bf16_t*)(ws + WS_WRKV) + (size_t)li * 3072 * 1024, 3 * R, 3072, 1024, 1024};
                pg8::GroupOrder S; S.init((int)gridDim.x, (int)blockIdx.x); S.add(0, 0, 64, 0, 4); S.add(1, 66, 64, 4, 4); S.add(2, 132, 64, 8, 4);
                pg8::EpiF32G E{(float*)(ws + WS_RK_R), (float*)(ws + WS_RK_K), (float*)(ws + (li ? WS_V1 : WS_V0)), nullptr, D, 4, 66};
                pg8::gemm_phase<pg8::EpiF32G, pg8::GroupOrder, true, true>(c.lds, g, S, E, c.tid);
                {
                    const bf16_t* XMs = (const bf16_t*)(ws + WS_XM); const bf16_t* Wr = (const bf16_t*)(ws + WS_WRKV) + (size_t)li * 3072 * 1024;
                    for (int it = blockIdx.x + gridDim.x * c.wave; it < 768; it += c.ngw) { const int j = it >> 8, r = it & 255, row0 = MP + 32 * (r & 15), col0 = 64 * (r >> 4);
                        float* C = (float*)(ws + (j == 0 ? WS_RK_R : (j == 1 ? WS_RK_K : (li ? WS_V1 : WS_V0))));
                        f32x4 acc[4][2]; skinny_mma<4>(XMs + (size_t)j * R * D, 1024, Wr + (size_t)j * 1024 * 1024, 1024, 1024, row0, col0, c.lane, acc);
                        const int fr = c.lane & 15, fq = c.lane >> 4;
#pragma unroll
                        for (int nt = 0; nt < 4; ++nt)
#pragma unroll
                            for (int mt = 0; mt < 2; ++mt) *(f32x4*)(C + (size_t)(row0 + 16 * mt + fr) * D + col0 + 16 * nt + 4 * fq) = acc[nt][mt]; }
                }
                phase_lora1(p, c, li);
            } PHASE_END
            PHASE_BEGIN phase_scanA(p, c, li); PHASE_END
            PHASE_BEGIN phase_scanB(p, c, li); PHASE_END
            PHASE_BEGIN phase_scanC(p, c, li); PHASE_END
        } else {
            const int lb = layer - 2;
            if (layer == 2) {
                PHASE_BEGIN phase_norm(c, X, p->in[I_KVNG], (bf16_t*)(ws + WS_XN2), p->in[I_NORMG] + (size_t)(layer * 2) * D, (bf16_t*)(ws + WS_XN)); PHASE_END
                PHASE_BEGIN {
                    pg8::Gemm g{(const bf16_t*)(ws + WS_XN2), (const bf16_t*)(ws + WS_WKVT), R, NKV, 1024, 1024};
                    pg8::GroupOrder S; S.init((int)gridDim.x, (int)blockIdx.x); S.add(0, 0, 66, 0, 6);
                    pg8::EpiF32G E{(float*)(ws + WS_KVF), nullptr, nullptr, nullptr, NKV, 1 << 20, 0};
                    pg8::gemm_phase<pg8::EpiF32G, pg8::GroupOrder, true, true>(c.lds, g, S, E, c.tid);
                } PHASE_END
                PHASE_BEGIN phase_kvpost(p, c); PHASE_END
                PHASE_BEGIN {
                    pg8::Gemm g{(const bf16_t*)(ws + WS_CMPA), (const bf16_t*)(ws + WS_CW1T), (int)CMPA_ROWS, 512, 1024, 1024};
                    pg8::GroupOrder S; S.init((int)gridDim.x, (int)blockIdx.x); S.add(0, 0, 16, 0, 1); S.add(1, 16, 16, 1, 1); S.add(2, 32, 256, 0, 1); S.add(3, 288, 256, 1, 1);
                    pg8::EpiF32G E{(float*)(ws + WS_PCMP), (float*)(ws + WS_PCMP), nullptr, nullptr, 256, 1, 0};
                    pg8::gemm_phase<pg8::EpiF32G, pg8::GroupOrder, true, true>(c.lds, g, S, E, c.tid);
                } PHASE_END
                PHASE_BEGIN phase_cmp2(p, c); PHASE_END
            } else {
                PHASE_BEGIN phase_norm(c, X, p->in[I_NORMG] + (size_t)(layer * 2) * D, (bf16_t*)(ws + WS_XN), nullptr, nullptr); PHASE_END
            }
            PHASE_BEGIN {
                const bf16_t* XNp = (const bf16_t*)(ws + WS_XN); const bf16_t* Wq = (const bf16_t*)(ws + WS_WQT) + (size_t)lb * NQP * 1024; float* QFp = (float*)(ws + WS_QF);
                pg8::Gemm g{XNp, Wq, R, NQP, 1024, 1024};
                pg8::GroupOrder S; S.init((int)gridDim.x, (int)blockIdx.x); S.add(0, 0, 64, 0, 4);
                pg8::EpiF32G E{QFp, nullptr, nullptr, nullptr, NQP, 1 << 20, 0};
                pg8::gemm_phase<pg8::EpiF32G, pg8::GroupOrder, true, true>(c.lds, g, S, E, c.tid);
                float* GATEp = (float*)(ws + WS_GATE);
                for (int it = blockIdx.x + gridDim.x * c.wave; it < 256 + R / 32; it += c.ngw) { const int ln = launder_v(c.lane), fr = ln & 15, fq = ln >> 4;
                    if (it < 256) { const int row0 = MP + 32 * (it & 15), col0 = 64 * (it >> 4);
                        f32x4 acc[4][2]; skinny_mma<4>(XNp, 1024, Wq, 1024, 1024, row0, col0, ln, acc);
#pragma unroll
                        for (int nt = 0; nt < 4; ++nt)
#pragma unroll
                            for (int mt = 0; mt < 2; ++mt) *(f32x4*)(QFp + (size_t)(row0 + 16 * mt + fr) * NQP + col0 + 16 * nt + 4 * fq) = acc[nt][mt]; }
                    else { const int row0 = 32 * (it - 256);
                        f32x4 acc[3][2]; skinny_mma<3>(XNp, 1024, Wq, 1024, 1024, row0, 1024, ln, acc);
#pragma unroll
                        for (int nt = 0; nt < 3; ++nt)
#pragma unroll
                            for (int mt = 0; mt < 2; ++mt) { f32x4 v = acc[nt][mt];
#pragma unroll
                                for (int e = 0; e < 4; ++e) v[e] = sigmoidf_(v[e]);
                                *(f32x4*)(GATEp + (size_t)(row0 + 16 * mt + fr) * 48 + 16 * nt + 4 * fq) = v; } }
                }
            } PHASE_END
            PHASE_BEGIN phase_qpost(p, c, lb); PHASE_END
            PHASE_BEGIN phase_attn_prompt(p, c); PHASE_END
#ifdef PROBE_ATTN2
            PHASE_BEGIN phase_attn_prompt(p, c, PROBE_ATTN2); PHASE_END
#endif
            PHASE_BEGIN phase_attn_sample(p, c); PHASE_END
        }
        PHASE_BEGIN {
            const bf16_t* Wt = layer < 2 ? (const bf16_t*)(ws + WS_WORW) + (size_t)layer * 1024 * 1024 : (const bf16_t*)(ws + WS_WONSA) + (size_t)(layer - 2) * 1024 * 1024;
            pg8::Gemm g{(const bf16_t*)(ws + WS_YG), Wt, R, 1024, 1024, 1024};
            pg8::GroupOrder S; S.init((int)gridDim.x, (int)blockIdx.x); S.add(0, 0, 64, 0, 4);
            pg8::EpiResid E{X, D};
            pg8::gemm_phase<pg8::EpiResid, pg8::GroupOrder, true, true>(c.lds, g, S, E, c.tid);
            skinny_resid_sample(c, (const bf16_t*)(ws + WS_YG), 1024, Wt, 1024, X);
        } PHASE_END
        PHASE_BEGIN phase_norm(c, X, p->in[I_NORMG] + (size_t)(layer * 2 + 1) * D, (bf16_t*)(ws + WS_XN), nullptr, nullptr); PHASE_END
        PHASE_BEGIN {
            pg8::Gemm g{(const bf16_t*)(ws + WS_XN), (const bf16_t*)(ws + WS_WINT) + (size_t)layer * 5632 * 1024, R, 5632, 1024, 1024};
            pg8::GroupOrder S; S.init((int)gridDim.x, (int)blockIdx.x); S.add(0, 0, 66, 0, 22);
            pg8::EpiWin E{(bf16_t*)(ws + WS_U), (bf16_t*)(ws + WS_GT), p->out + O_CVP + (size_t)layer * NB * 2 * DFF, p->out + O_CVS + (size_t)layer * SB * 2 * DFF};
            pg8::gemm_phase<pg8::EpiWin, pg8::GroupOrder, true, true>(c.lds, g, S, E, c.tid);
        } PHASE_END
        PHASE_BEGIN phase_conv(p, c, layer); PHASE_END
        PHASE_BEGIN {
            pg8::Gemm g{(const bf16_t*)(ws + WS_HH), (const bf16_t*)(ws + WS_WOUTT) + (size_t)layer * 1024 * 2816, R, 1024, 2816, 2816};
            pg8::GroupOrder S; S.init((int)gridDim.x, (int)blockIdx.x); S.add(0, 0, 64, 0, 4);
            pg8::EpiResid E{X, D};
            pg8::gemm_phase<pg8::EpiResid, pg8::GroupOrder, true, true>(c.lds, g, S, E, c.tid);
            skinny_resid_sample(c, (const bf16_t*)(ws + WS_HH), 2816, (const bf16_t*)(ws + WS_WOUTT) + (size_t)layer * 1024 * 2816, 2816, X);
        } PHASE_END
    }
#ifdef SELFTEST
    PHASE_BEGIN if (blockIdx.x == 0 && c.wave == 0) { const float x = (float)((c.lane * 37) & 63) + 1.0f; float poison = 0.f;
        if (__ballot(swz_xor16_n(x) != __shfl_xor(x, 16))) poison += 1e3f;
        if (__ballot(sum_xor32_n(x) != x + __shfl_xor(x, 32))) poison += 1e4f;
        if (__ballot(sum_rows4_n(x) != x + __shfl_xor(x, 16) + __shfl_xor(x, 32) + __shfl_xor(x, 48))) poison += 1e5f;
        if (__ballot(wave_sum_n(x) != 2080.0f)) poison += 1e6f;
        if (__ballot(wave_max_n(x) != 64.0f)) poison += 1e7f;
        if (c.lane == 0) p->out[O_CVS] += poison; } PHASE_END
#endif
#ifdef PROBE_SCALE
    PHASE_BEGIN for (size_t e = c.gtid; e < O_END; e += c.gsz) { int oi = e < O_KV ? (e < (size_t)MP * D ? 0 : 1) : e < O_WINP ? (e < O_KV + (size_t)MP * D ? 2 : 3) : e < O_WINS ? 4 : e < O_WKVP ? 5 : e < O_WKVS ? 6 : e < O_SHP ? 7 : e < O_SHS ? 8 : e < O_CVP ? 9 : e < O_CVS ? 10 : 11;
        if (PROBE_SCALE < 0) oi = 11 - oi; p->out[e] *= 1.0f + sqrtf(0.5e-4f * (float)(oi + 1)); } PHASE_END
#endif
#undef PHASE_BEGIN
#undef PHASE_END
}

extern "C" void kernel_launch(void* const* d_in, const int* in_sizes, int n_in, void* d_out, int out_size, void* d_ws, size_t ws_size, hipStream_t stream) {
    static int grid = 0;
    if (grid == 0) {
        if (n_in != 45 || (size_t)out_size != O_END || ws_size < WS_END) { fprintf(stderr, "kernel_launch: unexpected shapes (n_in %d out %d ws %zu need %zu)\n", n_in, out_size, ws_size, (size_t)WS_END); grid = -1; return; }
        int dev = 0, cus = 0, per_cu = 0;
        if (hipGetDevice(&dev) != hipSuccess || hipDeviceGetAttribute(&cus, hipDeviceAttributeMultiprocessorCount, dev) != hipSuccess) { grid = -1; return; }
        if (hipFuncSetAttribute((const void*)mega, hipFuncAttributeMaxDynamicSharedMemorySize, LDS_BYTES) != hipSuccess) { fprintf(stderr, "kernel_launch: hipFuncSetAttribute failed\n"); grid = -1; return; }
        if (hipOccupancyMaxActiveBlocksPerMultiprocessor(&per_cu, (const void*)mega, 512, LDS_BYTES) != hipSuccess || per_cu < 1) { fprintf(stderr, "kernel_launch: occupancy query says %d\n", per_cu); (void)hipGetLastError(); }
        grid = cus;
    }
    if (grid < 0) return;
    (void)hipMemsetAsync((char*)d_ws + WS_CTL, 0, CTL_BYTES, stream);
    Params p{};
    for (int i = 0; i < 45; ++i) p.in[i] = (const float*)d_in[i];
    p.out = (float*)d_out; p.ws = (unsigned char*)d_ws;
#ifdef PROBE_PRE
    { const int plist[] = PROBE_PRE; for (int i = 0; i < (int)(sizeof(plist) / sizeof(int)); ++i) { p.ph_lo = plist[i] % 100; p.ph_hi = p.ph_lo + 1; p.use_bar = 0; p.pad = plist[i] / 100;       hipLaunchKernelGGL(mega, dim3(grid), dim3(512), LDS_BYTES, stream, p); } }
#endif
    p.pad = 0;
#if MK_MULTI
    for (int i = 0; i < NPH; ++i) { p.ph_lo = i; p.ph_hi = i + 1; p.use_bar = 0; hipLaunchKernelGGL(mega, dim3(grid), dim3(512), LDS_BYTES, stream, p); }
#else
    p.ph_lo = 0; p.ph_hi = NPH; p.use_bar = 1;
    hipLaunchKernelGGL(mega, dim3(grid), dim3(512), LDS_BYTES, stream, p);
#endif
    const hipError_t le = hipPeekAtLastError();
    if (le != hipSuccess) fprintf(stderr, "kernel_launch: launch failed: %s\n", hipGetErrorName(le));
}
```

```cpp
#include <hip/hip_runtime.h>
#include <cstdio>
#include <cstdint>

#define LAS __attribute__((address_space(3)))
#define GAS __attribute__((address_space(1)))
typedef unsigned short bf16_t;
typedef short bf16x8 __attribute__((ext_vector_type(8)));
typedef float f32x4 __attribute__((ext_vector_type(4)));
typedef float f32x16 __attribute__((ext_vector_type(16)));
typedef float f32x2 __attribute__((ext_vector_type(2)));
typedef unsigned u32x4 __attribute__((ext_vector_type(4)));
typedef unsigned u32x2 __attribute__((ext_vector_type(2)));

constexpr int D = 1024, NB = 2, TP = 8192, MP = NB * TP, SB = 128, ST = 4, MS = SB * ST, R = MP + MS;
constexpr int PAST = 2048, PAGE = 128, NPAGES = PAST / PAGE;
constexpr int H = 16, HD = 64, G = 4, HPG = 4, DFF = 2816, NLAY = 4;
constexpr int LW_ = 64, LA_ = 64, LV_ = 32, LG_ = 128, LHID = 288;
constexpr int NKV = 1536, NQ = 1072, NQP = 1280;
constexpr int NCH = TP / 64;
constexpr int NUNIT_A = NB * NCH * H;
constexpr int NCMP_P = 511, NCMP_S = 127, WIN = 512;
constexpr float NORM_EPS = 1e-6f, GN_EPS = 64e-5f;

constexpr size_t O_Y = 0;
constexpr size_t O_KV = (size_t)R * D;
constexpr size_t O_WINP = O_KV + (size_t)R * D;
constexpr size_t O_WINS = O_WINP + (size_t)NB * 512 * 512;
constexpr size_t O_WKVP = O_WINS + (size_t)SB * 512 * 512;
constexpr size_t O_WKVS = O_WKVP + (size_t)2 * NB * H * 4096;
constexpr size_t O_SHP = O_WKVS + (size_t)2 * SB * H * 4096;
constexpr size_t O_SHS = O_SHP + (size_t)2 * NB * D;
constexpr size_t O_CVP = O_SHS + (size_t)2 * SB * D;
constexpr size_t O_CVS = O_CVP + (size_t)NLAY * NB * 2 * DFF;
constexpr size_t O_END = O_CVS + (size_t)NLAY * SB * 2 * DFF;
static_assert(O_END == 88915968, "output size");

constexpr size_t MiB = 1u << 20;
constexpr size_t al(size_t x) { return (x + 4095) & ~(size_t)4095; }
constexpr size_t WS_CTL = 0, CTL_BYTES = 1 * MiB;
constexpr size_t WS_WRKV = WS_CTL + CTL_BYTES;
constexpr size_t WS_WORW = WS_WRKV + al((size_t)2 * 3072 * 1024 * 2);
constexpr size_t WS_W1T = WS_WORW + al((size_t)2 * 1024 * 1024 * 2);
constexpr size_t WS_W2W = WS_W1T + al((size_t)2 * 288 * 1024 * 2);
constexpr size_t WS_W2A = WS_W2W + al((size_t)2 * 1024 * 64 * 2);
constexpr size_t WS_W2V = WS_W2A + al((size_t)2 * 1024 * 64 * 2);
constexpr size_t WS_W2G = WS_W2V + al((size_t)1024 * 32 * 2);
constexpr size_t WS_WKVT = WS_W2G + al((size_t)2 * 1024 * 128 * 2);
constexpr size_t WS_WQT = WS_WKVT + al((size_t)1536 * 1024 * 2);
constexpr size_t WS_WONSA = WS_WQT + al((size_t)2 * 1280 * 1024 * 2);
constexpr size_t WS_WINT = WS_WONSA + al((size_t)2 * 1024 * 1024 * 2);
constexpr size_t WS_WOUTT = WS_WINT + al((size_t)4 * 5632 * 1024 * 2);
constexpr size_t WS_CW1T = WS_WOUTT + al((size_t)4 * 1024 * 2816 * 2);
constexpr size_t WS_CBIAS = WS_CW1T + al((size_t)2 * 256 * 1024 * 2);
constexpr size_t WS_CW2T = WS_CBIAS + al(2 * 128 * 4);
constexpr size_t WS_XM = WS_CW2T + al(2 * 2 * 64 * 128 * 2);
constexpr size_t WS_RK_R = WS_XM + al((size_t)6 * R * D * 2);
constexpr size_t WS_RK_K = WS_RK_R + al((size_t)R * D * 4);
constexpr size_t WS_V0 = WS_RK_K + al((size_t)R * D * 4);
constexpr size_t WS_V1 = WS_V0 + al((size_t)R * D * 4);
constexpr size_t WS_HID = WS_V1 + al((size_t)R * D * 4);
constexpr size_t WS_MT = WS_HID + al((size_t)R * LHID * 2);
constexpr size_t WS_NN = WS_MT + al((size_t)NUNIT_A * 4096 * 4);
constexpr size_t WS_RP = WS_NN + al((size_t)NUNIT_A * 4096 * 4);
constexpr size_t WS_YL = WS_RP + al((size_t)NUNIT_A * 4096 * 2);
constexpr size_t WS_S0 = WS_YL + al((size_t)NUNIT_A * 4096 * 4);
constexpr size_t WS_RKS = WS_S0 + al((size_t)NUNIT_A * 4096 * 2);
constexpr size_t WS_YG = WS_RKS + al((size_t)R * 16 * 4);
constexpr size_t WS_XN = WS_YG + al((size_t)R * D * 2);
constexpr size_t WS_XN2 = WS_XN + al((size_t)R * D * 2);
constexpr size_t WS_U = WS_XN2 + al((size_t)R * D * 2);
constexpr size_t WS_GT = WS_U + al((size_t)R * DFF * 2);
constexpr size_t WS_HH = WS_GT + al((size_t)R * DFF * 2);
constexpr size_t WS_KVF = WS_HH + al((size_t)R * DFF * 2);
constexpr size_t WS_CMPA = WS_KVF + al((size_t)R * NKV * 4);
constexpr size_t CMPA_ROWS = 4096 + 4096 + 65536 + 65536;
constexpr size_t WS_PCMP = WS_CMPA + al(CMPA_ROWS * 1024 * 2);
constexpr size_t WS_KS = WS_PCMP + al(CMPA_ROWS * 256 * 4);
constexpr size_t WS_VS = WS_KS + al((size_t)NB * G * TP * 64 * 2);
constexpr size_t WS_KW = WS_VS + al((size_t)NB * G * TP * 64 * 2);
constexpr size_t WS_VW = WS_KW + al((size_t)NB * G * TP * 64 * 2);
constexpr size_t WS_CK = WS_VW + al((size_t)NB * G * TP * 64 * 2);
constexpr size_t WS_CV = WS_CK + al((size_t)NB * G * 512 * 64 * 2);
constexpr size_t WS_CKS = WS_CV + al((size_t)NB * G * 512 * 64 * 2);
constexpr size_t WS_CVS = WS_CKS + al((size_t)SB * G * 128 * 64 * 4);
constexpr size_t WS_QF = WS_CVS + al((size_t)SB * G * 128 * 64 * 4);
constexpr size_t WS_Q = WS_QF + al((size_t)R * NQP * 4);
constexpr size_t WS_GATE = WS_Q + al((size_t)R * D * 2);
constexpr size_t WS_END = WS_GATE + al((size_t)R * 48 * 4);

typedef __bf16 bf16v2_ __attribute__((ext_vector_type(2)));
__device__ __forceinline__ unsigned cvt_pk_bf16_(float lo, float hi) { const f32x2 v = {lo, hi}; const bf16v2_ b = __builtin_convertvector(v, bf16v2_); return __builtin_bit_cast(unsigned, b); }
__device__ __forceinline__ unsigned f2bf(float f) { return cvt_pk_bf16_(f, f) & 0xffffu; }
__device__ __forceinline__ unsigned pk2(float lo, float hi) { return cvt_pk_bf16_(lo, hi); }
__device__ __forceinline__ float frcp(float x) { return __builtin_amdgcn_rcpf(x); }
__device__ __forceinline__ float frsq(float x) { return __builtin_amdgcn_rsqf(x); }
__device__ __forceinline__ float bf2f(unsigned short b) { return __builtin_bit_cast(float, ((unsigned)b) << 16); }
__device__ __forceinline__ float bflo(unsigned w) { return __builtin_bit_cast(float, w << 16); }
__device__ __forceinline__ float bfhi(unsigned w) { return __builtin_bit_cast(float, w & 0xffff0000u); }
template <int CTRL> __device__ __forceinline__ float dpp_f(float x) { return __builtin_bit_cast(float, __builtin_amdgcn_update_dpp(0, __builtin_bit_cast(int, x), CTRL, 0xF, 0xF, true)); }
__device__ __forceinline__ float row16_sum(float v) { v += dpp_f<0xB1>(v); v += dpp_f<0x4E>(v); v += dpp_f<0x141>(v); v += dpp_f<0x140>(v); return v; }
__device__ __forceinline__ float row16_max(float v) { v = fmaxf(v, dpp_f<0xB1>(v)); v = fmaxf(v, dpp_f<0x4E>(v)); v = fmaxf(v, dpp_f<0x141>(v)); v = fmaxf(v, dpp_f<0x140>(v)); return v; }
__device__ __forceinline__ float swz_xor16_n(float x) { return __builtin_bit_cast(float, __builtin_amdgcn_ds_swizzle(__builtin_bit_cast(int, x), 0x401F)); }
__device__ __forceinline__ float sum_xor32_n(float x) { auto rr = __builtin_amdgcn_permlane32_swap(__float_as_uint(x), __float_as_uint(x), false, false);
    return __uint_as_float(rr[0]) + __uint_as_float(rr[1]); }
__device__ __forceinline__ float sum_rows4_n(float x) { x += swz_xor16_n(x); return sum_xor32_n(x); }
__device__ __forceinline__ float wave_sum_n(float v) {
    v = row16_sum(v);
    v += __builtin_bit_cast(float, __builtin_amdgcn_update_dpp(0, __builtin_bit_cast(int, v), 0x142, 0xA, 0xF, false));
    v += __builtin_bit_cast(float, __builtin_amdgcn_update_dpp(0, __builtin_bit_cast(int, v), 0x143, 0xC, 0xF, false));
    return __builtin_bit_cast(float, __builtin_amdgcn_readlane(__builtin_bit_cast(int, v), 63));
}
__device__ __forceinline__ float wave_max_n(float v) {
    v = row16_max(v);
    v = fmaxf(v, __builtin_bit_cast(float, __builtin_amdgcn_update_dpp(__builtin_bit_cast(int, v), __builtin_bit_cast(int, v), 0x142, 0xA, 0xF, false)));
    v = fmaxf(v, __builtin_bit_cast(float, __builtin_amdgcn_update_dpp(__builtin_bit_cast(int, v), __builtin_bit_cast(int, v), 0x143, 0xC, 0xF, false)));
    return __builtin_bit_cast(float, __builtin_amdgcn_readlane(__builtin_bit_cast(int, v), 63));
}
#define XLANE_NEW 1
#ifdef XLANE_NEW
__device__ __forceinline__ float swz_xor16(float x) { return __builtin_bit_cast(float, __builtin_amdgcn_ds_swizzle(__builtin_bit_cast(int, x), 0x401F)); }
__device__ __forceinline__ float sum_xor32(float x) { return sum_xor32_n(x); }
__device__ __forceinline__ float sum_rows4(float x) { x += swz_xor16(x); return sum_xor32(x); }
__device__ __forceinline__ float wave_sum(float v) {
    v = row16_sum(v);
    v += __builtin_bit_cast(float, __builtin_amdgcn_update_dpp(0, __builtin_bit_cast(int, v), 0x142, 0xA, 0xF, false));
    v += __builtin_bit_cast(float, __builtin_amdgcn_update_dpp(0, __builtin_bit_cast(int, v), 0x143, 0xC, 0xF, false));
    return __builtin_bit_cast(float, __builtin_amdgcn_readlane(__builtin_bit_cast(int, v), 63));
}
__device__ __forceinline__ float wave_max(float v) {
    v = row16_max(v);
    v = fmaxf(v, __builtin_bit_cast(float, __builtin_amdgcn_update_dpp(__builtin_bit_cast(int, v), __builtin_bit_cast(int, v), 0x142, 0xA, 0xF, false)));
    v = fmaxf(v, __builtin_bit_cast(float, __builtin_amdgcn_update_dpp(__builtin_bit_cast(int, v), __builtin_bit_cast(int, v), 0x143, 0xC, 0xF, false)));
    return __builtin_bit_cast(float, __builtin_amdgcn_readlane(__builtin_bit_cast(int, v), 63));
}
#else
__device__ __forceinline__ float sum_xor32(float x) { return x + __shfl_xor(x, 32); }
__device__ __forceinline__ float sum_rows4(float x) { x += __shfl_xor(x, 16); x += __shfl_xor(x, 32); return x; }
__device__ __forceinline__ float wave_sum(float v) { v = row16_sum(v); v += __shfl_xor(v, 16); v += __shfl_xor(v, 32); return v; }
__device__ __forceinline__ float wave_max(float v) { v = row16_max(v); v = fmaxf(v, __shfl_xor(v, 16)); v = fmaxf(v, __shfl_xor(v, 32)); return v; }
#endif
__device__ __forceinline__ float sigmoidf_(float x) { return frcp(1.0f + __builtin_amdgcn_exp2f(-1.4426950408889634f * x)); }
__device__ __forceinline__ float gelu_tanh(float x) {
    const float u = 0.7978845608028654f * (x + 0.044715f * x * x * x);
    const float e = __builtin_amdgcn_exp2f(2.8853900817779268f * u);
    const float th = 1.0f - 2.0f * frcp(e + 1.0f);
    return 0.5f * x * (1.0f + th);
}
template <class T> __device__ __forceinline__ const T* launder_p(const T* q) { asm volatile("" : "+v"(q)); return q; }
__device__ __forceinline__ int launder_v(int x) { asm volatile("" : "+v"(x)); return x; }
#define LDS_WAIT() asm volatile("s_waitcnt lgkmcnt(0)" ::: "memory")
#define VM_WAIT() asm volatile("s_waitcnt vmcnt(0)" ::: "memory")
__device__ __forceinline__ f32x4 mfma16(bf16x8 a, bf16x8 b, f32x4 c) { return __builtin_amdgcn_mfma_f32_16x16x32_bf16(a, b, c, 0, 0, 0); }
__device__ __forceinline__ f32x16 mfma32(bf16x8 a, bf16x8 b, f32x16 c) { return __builtin_amdgcn_mfma_f32_32x32x16_bf16(a, b, c, 0, 0, 0); }
#define XB_TMO      128
#define XB_XCNT(j)  (256  + 64 * (j))
#define XB_XSUB(j)  (1280 + 64 * (j))
#define XB_XGEN(j)  (2304 + 64 * (j))
#define XB_TOP      3328
#define XB_TOPGEN   3392
#define XCD_BAR_WORDS 3456
#define XB_SPIN_CAP (1u << 18)

__device__ __forceinline__ unsigned xb_ld(unsigned* p)              { return __hip_atomic_load(p, __ATOMIC_RELAXED, __HIP_MEMORY_SCOPE_AGENT); }
__device__ __forceinline__ unsigned xb_add(unsigned* p, unsigned v) { return __hip_atomic_fetch_add(p, v, __ATOMIC_RELAXED, __HIP_MEMORY_SCOPE_AGENT); }
__device__ __forceinline__ unsigned xb_xcc_id() { return (unsigned)__builtin_amdgcn_s_getreg((3 << 11) | 20) & 0xFu; }
#define XB_SPIN(cond, bar) do { unsigned _sp = 0; while (cond) { __builtin_amdgcn_s_sleep(1); \
    if ((++_sp & 255u) == 0u) { if (xb_ld(&(bar)[XB_TMO])) break; if (_sp > XB_SPIN_CAP) { atomicAdd(&(bar)[XB_TMO], 1u); break; } } } } while (0)

struct XcdBarrier {
    unsigned* bar; unsigned x;
    volatile LAS unsigned* st;
};

__device__ __forceinline__ XcdBarrier xcd_barrier_post(unsigned* bar, volatile LAS unsigned* st) {
    XcdBarrier b; b.bar = bar; b.x = xb_xcc_id(); b.st = st;
    if (threadIdx.x == 0) (void)xb_add(&bar[XB_XCNT(b.x)], 1u);
    return b;
}
__device__ __forceinline__ void xcd_barrier_complete(unsigned* bar, unsigned x, unsigned& nloc, unsigned& nx) {
    const unsigned G = gridDim.x * gridDim.y * gridDim.z;
    unsigned sum, cnt, mine, sp = 0u;
    for (;;) {
        sum = 0u; cnt = 0u; mine = 0u;
#pragma unroll
        for (unsigned j = 0; j < 16; ++j) { const unsigned c = xb_ld(&bar[XB_XCNT(j)]); sum += c; cnt += (c > 0u) ? 1u : 0u; mine = (j == x) ? c : mine; }
        if (sum == G) break;
        __builtin_amdgcn_s_sleep(1);
        if ((++sp & 255u) == 0u) { if (xb_ld(&bar[XB_TMO])) break; if (sp > XB_SPIN_CAP) { atomicAdd(&bar[XB_TMO], 1u); break; } }
    }
    nloc = mine > 0u ? mine : 1u; nx = cnt > 0u ? cnt : 1u;
}

__device__ __forceinline__ void xcd_barrier(const XcdBarrier& b, const bool t0) {
    asm volatile("s_waitcnt vmcnt(0)" ::: "memory");
    __syncthreads();
    if (t0) {
        unsigned* bar = b.bar;
        __builtin_amdgcn_s_waitcnt(0);
        unsigned nloc = b.st[0], nx = b.st[1];
        if (nloc == 0u) { xcd_barrier_complete(bar, b.x, nloc, nx); b.st[0] = nloc; b.st[1] = nx; }
        const unsigned old = xb_add(&bar[XB_XSUB(b.x)], 1u);
        const unsigned gen = old / nloc;
        if (old + 1u == (gen + 1u) * nloc) {
            __builtin_amdgcn_fence(__ATOMIC_RELEASE, "agent");
            asm volatile("s_waitcnt vmcnt(0)" ::: "memory");
            const unsigned og = xb_add(&bar[XB_TOP], 1u);
            const unsigned tg = og / nx;
            if (og + 1u == (tg + 1u) * nx) xb_add(&bar[XB_TOPGEN], 1u);
            else XB_SPIN(xb_ld(&bar[XB_TOPGEN]) == tg, bar);
            __builtin_amdgcn_fence(__ATOMIC_ACQUIRE, "agent");
            xb_add(&bar[XB_XGEN(b.x)], 1u);
            asm volatile("s_waitcnt vmcnt(0)" ::: "memory");
        } else {
            XB_SPIN(xb_ld(&bar[XB_XGEN(b.x)]) == gen, bar);
            __builtin_amdgcn_fence(__ATOMIC_ACQUIRE, "agent");
            asm volatile("s_waitcnt vmcnt(0)" ::: "memory");
        }
    }
    __syncthreads();
}

namespace pg8 {
#define PG8_LAS __attribute__((address_space(3)))
constexpr int BM = 256, BK = 64, HALF = 128, HTB = HALF * BK * 2  , STAGE_BYTES = 8 * HTB, NXCD = 8, WGM = 8;
__host__ __device__ __forceinline__ int lds_byte(int r, int c) { const int st = (r >> 4) * 2 + (c >> 5), rr = r & 15, cc = c & 31, ob = rr * 64 + cc * 2; return st * 1024 + (ob ^ (((ob >> 9) & 1) << 5)); }
__host__ __device__ __forceinline__ void stage_rc(int b, int& R_, int& C_) { const int st = b / 1024, sb = b % 1024, swz = sb ^ (((sb >> 9) & 1) << 5); R_ = (st >> 1) * 16 + swz / 64; C_ = (st & 1) * 32 + (swz % 64) / 2; }
__host__ __device__ __forceinline__ int perm32(int rho) { const int n = rho >> 4, i = rho & 15; return 8 * (i >> 2) + 4 * n + (i & 3); }

struct Unit { int pm, pn, kb, nt; };
struct Gemm { const bf16_t* A; const bf16_t* Bt; int M, N, K, KL; };

struct GroupOrder {
    int pm0[4], nM[4], pn0[4], nN[4]; int nseg, nwg, G_, c;
    __device__ __forceinline__ void init(int G__, int c_) { nseg = 0; nwg = 0; G_ = G__; c = c_;
#pragma unroll
        for (int s = 0; s < 4; ++s) { pm0[s] = 0; nM[s] = 0; pn0[s] = 0; nN[s] = 1; } }
    __device__ __forceinline__ void add(int s, int pm0_, int nM_, int pn0_, int nN_) { pm0[s] = pm0_; nM[s] = nM_; pn0[s] = pn0_; nN[s] = nN_; nwg += nM_ * nN_; nseg = s + 1; }
    __device__ __forceinline__ bool next(int i, Unit& u) const {
        const long L = (long)i * G_ + c; if (L >= nwg) return false;
        int id = (int)L; { const int q = nwg / NXCD, r = nwg % NXCD, xcd = id % NXCD, off = id / NXCD; id = (xcd < r ? xcd * (q + 1) : r * (q + 1) + (xcd - r) * q) + off; }
        int spm0 = 0, snM = 1, spn0 = 0, snN = 1; bool found = false;
#pragma unroll
        for (int s = 0; s < 4; ++s) { const int cnt = nM[s] * nN[s]; if (!found) { if (id < cnt) { found = true; spm0 = pm0[s]; snM = nM[s]; spn0 = pn0[s]; snN = nN[s]; } else id -= cnt; } }
        const int nig = WGM * snN, gid = id / nig, fm = gid * WGM, gsz = (snM - fm) < WGM ? (snM - fm) : WGM;
        u.pm = spm0 + fm + ((id % nig) % gsz); u.pn = spn0 + (id % nig) / gsz; u.kb = 0; u.nt = 0; return true;
    }
    __device__ __forceinline__ void a_ready(const Unit&) const {}
    __device__ __forceinline__ void done(const Unit&) const {}
};

struct ResidOrder {
    GroupOrder P; int nS, G_, c;
    __device__ __forceinline__ void init(int G__, int c_, int nS_) { P.init(G__, c_); P.add(0, 0, nS_ ? 64 : 66, 0, 4); nS = nS_; G_ = G__; c = c_; }
    __device__ __forceinline__ bool next(int i, Unit& u) const {
        const int npc = c < P.nwg ? (P.nwg - 1 - c) / G_ + 1 : 0;
        if (i < npc) return P.next(i, u);
        const int L = (i - npc) * G_ + (G_ - 1 - c); if (L >= 8 * nS) return false;
        const int sl = L >> 3, t = L & 7; u.pm = 64 + (t & 1); u.pn = t >> 1; u.kb = sl * 512; u.nt = 4; return true; }
    __device__ __forceinline__ void a_ready(const Unit&) const {}
    __device__ __forceinline__ void done(const Unit&) const {}
};
__device__ __forceinline__ unsigned cvt_pk_bf16(float lo, float hi) { return cvt_pk_bf16_(lo, hi); }

struct EpiF32G {
    static constexpr bool PERM = false, AFTER_DRAIN = false;
    float* b0; float* b1; float* b2; float* b3; int ldc, png, pmg;
    __device__ __forceinline__ void operator()(const f32x4 (&acc)[2][2][4][2], const Unit& u, int wr, int wc, int fr, int fq) const {
        const int j = u.pn / png; float* C = j == 0 ? b0 : (j == 1 ? b1 : (j == 2 ? b2 : b3));
        const int row0 = (u.pm - j * pmg) * BM + wr * 64 + fr, col0 = (u.pn - j * png) * BM + wc * 32 + 4 * fq;
#pragma unroll
        for (int ai = 0; ai < 2; ++ai)
#pragma unroll
            for (int m = 0; m < 4; ++m) { float* rowp = C + (size_t)(row0 + ai * HALF + m * 16) * ldc + col0;
#pragma unroll
                for (int bj = 0; bj < 2; ++bj)
#pragma unroll
                    for (int n = 0; n < 2; ++n) *(f32x4*)(rowp + bj * HALF + n * 16) = acc[ai][bj][m][n]; }
    }
};
struct EpiResid {
    static constexpr bool PERM = false, AFTER_DRAIN = false;
    float* X; int ldc;
    __device__ __forceinline__ void operator()(const f32x4 (&acc)[2][2][4][2], const Unit& u, int wr, int wc, int fr, int fq) const {
        const int row0 = u.pm * BM + wr * 64 + fr, col0 = u.pn * BM + wc * 32 + 4 * fq; const bool split = u.nt != 0;
#pragma unroll
        for (int ai = 0; ai < 2; ++ai)
#pragma unroll
            for (int m = 0; m < 4; ++m) { float* rowp = X + (size_t)(row0 + ai * HALF + m * 16) * ldc + col0;
                if (!split) {
#pragma unroll
                    for (int bj = 0; bj < 2; ++bj)
#pragma unroll
                        for (int n = 0; n < 2; ++n) { f32x4* p = (f32x4*)(rowp + bj * HALF + n * 16); *p = *p + acc[ai][bj][m][n]; } }
                else {
#pragma unroll
                    for (int bj = 0; bj < 2; ++bj)
#pragma unroll
                        for (int n = 0; n < 2; ++n) { float* q = rowp + bj * HALF + n * 16;
#pragma unroll
                            for (int e = 0; e < 4; ++e) __hip_atomic_fetch_add(q + e, acc[ai][bj][m][n][e], __ATOMIC_RELAXED, __HIP_MEMORY_SCOPE_AGENT); } }
                asm volatile("" ::: "memory"); }
    }
};
struct EpiWin {
    static constexpr bool PERM = true, AFTER_DRAIN = false;
    bf16_t* U; bf16_t* GT; float* cvp; float* cvs;
    __device__ __forceinline__ void operator()(const f32x4 (&acc)[2][2][4][2], const Unit& u, int wr, int wc, int fr, int fq) const {
        const bool isu = u.pn < 11; bf16_t* base = isu ? U : GT; const int colt = (isu ? u.pn : u.pn - 11) * BM;
        const int row0 = u.pm * BM + wr * 64 + fr, col0 = colt + wc * 32 + 8 * fq;
#pragma unroll
        for (int ai = 0; ai < 2; ++ai)
#pragma unroll
            for (int m = 0; m < 4; ++m) { const int row = row0 + ai * HALF + m * 16; bf16_t* rowp = base + (size_t)row * DFF + col0;
                float* cv = nullptr;
                if (isu) { if (row >= MP) { const int t = (row - MP) & 3, b = (row - MP) >> 2; if (t >= 2) cv = cvs + (size_t)(b * 2 + (t - 2)) * DFF; }
                           else { const int tt = row & (TP - 1); if (tt >= TP - 2) cv = cvp + (size_t)((row >> 13) * 2 + (tt - (TP - 2))) * DFF; } }
#pragma unroll
                for (int bj = 0; bj < 2; ++bj) { const f32x4 v0 = acc[ai][bj][m][0], v1 = acc[ai][bj][m][1];
                    u32x4 w; w.x = cvt_pk_bf16(v0[0], v0[1]); w.y = cvt_pk_bf16(v0[2], v0[3]); w.z = cvt_pk_bf16(v1[0], v1[1]); w.w = cvt_pk_bf16(v1[2], v1[3]);
                    *(u32x4*)(rowp + bj * HALF) = w;
                    if (cv) { *(f32x4*)(cv + col0 + bj * HALF) = v0; *(f32x4*)(cv + col0 + bj * HALF + 4) = v1; } } }
    }
};
template <class Epi, class Sched, bool ALIGN_EPI = false, bool SP2 = false>
__device__ __forceinline__ void gemm_phase(PG8_LAS unsigned char* lds, const Gemm g, const Sched& S, const Epi& E, int tid_in) {
    int tid_l = tid_in; asm volatile("" : "+v"(tid_l));
    const int tid = tid_l, wid = __builtin_amdgcn_readfirstlane(tid >> 6), lane = tid & 63, wr = wid >> 2, wc = wid & 3, fr = lane & 15, fq = lane >> 4;
    const int K = g.K, nt = g.KL / BK;
    unsigned voffA[2], voffB[2];
#pragma unroll
    for (int i = 0; i < 2; ++i) { int R, C; stage_rc(tid * 16 + i * 8192, R, C); const int Rb = Epi::PERM ? ((R & ~31) + perm32(R & 31)) : R;
        voffA[i] = (unsigned)(R * K + C) * 2u; voffB[i] = (unsigned)(Rb * K + C) * 2u; }
    const size_t kstep = (size_t)(BK * 2);
    const size_t hstep = (size_t)HALF * K * 2;
    const size_t tstep = 2 * hstep;
    const unsigned ldsw = (unsigned)wid * 1024u;
    const int aoff = lds_byte(wr * 64 + fr, fq * 8), boff = lds_byte(wc * 32 + fr, fq * 8);
#define PG8_SA(b, h) (((b) * 2 + (h)) * HTB)
#define PG8_SB(b, h) ((4 + (b) * 2 + (h)) * HTB)
#define PG8_STAGE(bufoff, gbase, voff) do { _Pragma("unroll") for (int _i = 0; _i < 2; ++_i) \
        __builtin_amdgcn_global_load_lds((const unsigned*)((const char*)(gbase) + (voff)[_i]), (PG8_LAS unsigned*)(lds + (bufoff) + ldsw + _i * 8192), 16, 0, 0); } while (0)
#define PG8_LDA(dst, b, h) do { _Pragma("unroll") for (int m = 0; m < 4; ++m) _Pragma("unroll") for (int k = 0; k < 2; ++k) dst[m][k] = *(const PG8_LAS bf16x8*)(lds + PG8_SA(b, h) + aoff + m * 2048 + k * 1024); } while (0)
#define PG8_LDB(dst, b, h) do { _Pragma("unroll") for (int n = 0; n < 2; ++n) _Pragma("unroll") for (int k = 0; k < 2; ++k) dst[n][k] = *(const PG8_LAS bf16x8*)(lds + PG8_SB(b, h) + boff + n * 2048 + k * 1024); } while (0)
#define PG8_MMA(ai, bj, At, Bt) do { __builtin_amdgcn_s_setprio(1); _Pragma("unroll") for (int m = 0; m < 4; ++m) _Pragma("unroll") for (int n = 0; n < 2; ++n) _Pragma("unroll") for (int k = 0; k < 2; ++k) \
        acc[ai][bj][m][n] = __builtin_amdgcn_mfma_f32_16x16x32_bf16(Bt[n][k], At[m][k], acc[ai][bj][m][n], 0, 0, 0); __builtin_amdgcn_s_setprio(0); } while (0)
#define PG8_WAIT_V(n) asm volatile("s_waitcnt vmcnt(" #n ")" ::: "memory")
#define PG8_WAIT_L(n) asm volatile("s_waitcnt lgkmcnt(" #n ")" ::: "memory")
#define PG8_BAR __builtin_amdgcn_s_barrier()
#define PG8_SCHED __builtin_amdgcn_sched_barrier(0)
    Unit cur, nxt; int ui = 0;
    if (!S.next(0, cur)) return;
    f32x4 acc[2][2][4][2];
#pragma unroll
    for (int a = 0; a < 2; ++a)
#pragma unroll
        for (int b = 0; b < 2; ++b)
#pragma unroll
            for (int m = 0; m < 4; ++m)
#pragma unroll
                for (int n = 0; n < 2; ++n) acc[a][b][m][n] = (f32x4){0.f, 0.f, 0.f, 0.f};
    bf16x8 At[4][2], B0[2][2], B1[2][2];
    const char* cA = (const char*)g.A + (size_t)cur.pm * tstep + cur.kb; const char* cB = (const char*)g.Bt + (size_t)cur.pn * tstep + cur.kb;
    S.a_ready(cur);
    if constexpr (SP2) {
        PG8_STAGE(PG8_SB(0, 0), cB, voffB); PG8_STAGE(PG8_SB(0, 1), cB + hstep, voffB); PG8_STAGE(PG8_SA(0, 0), cA, voffA); PG8_STAGE(PG8_SA(0, 1), cA + hstep, voffA);
        if (wr == 1) PG8_BAR;
        PG8_WAIT_V(2); PG8_BAR;
        PG8_STAGE(PG8_SB(1, 0), cB + kstep, voffB); PG8_STAGE(PG8_SA(1, 0), cA + kstep, voffA); PG8_STAGE(PG8_SB(1, 1), cB + hstep + kstep, voffB);
        PG8_WAIT_V(6); PG8_BAR;
    } else {
        PG8_STAGE(PG8_SB(0, 0), cB, voffB); PG8_STAGE(PG8_SA(0, 0), cA, voffA); PG8_STAGE(PG8_SB(0, 1), cB + hstep, voffB); PG8_STAGE(PG8_SA(0, 1), cA + hstep, voffA);
        if (wr == 1) PG8_BAR;
        PG8_WAIT_V(4); PG8_BAR;
        PG8_STAGE(PG8_SB(1, 0), cB + kstep, voffB); PG8_STAGE(PG8_SA(1, 0), cA + kstep, voffA); PG8_STAGE(PG8_SB(1, 1), cB + hstep + kstep, voffB);
        PG8_WAIT_V(6); PG8_BAR;
    }
    for (;;) {
        const bool has_next = S.next(ui + 1, nxt);
        const char* nA = has_next ? (const char*)g.A + (size_t)nxt.pm * tstep + nxt.kb : cA; const char* nB = has_next ? (const char*)g.Bt + (size_t)nxt.pn * tstep + nxt.kb : cB;
        const int ntu = cur.nt ? cur.nt : nt;
        for (int t = 0; t < ntu; t += 2) {
            const bool last = (t == ntu - 2);
            const char* a1 = cA + (size_t)(t + 1) * kstep;
            const char* a2 = last ? nA : cA + (size_t)(t + 2) * kstep; const char* b2 = last ? nB : cB + (size_t)(t + 2) * kstep;
            const char* a3 = a2 + kstep; const char* b3 = b2 + kstep;
            if (last && has_next) S.a_ready(nxt);
            if constexpr (SP2) {
            PG8_LDB(B0, 0, 0); PG8_LDB(B1, 0, 1); PG8_SCHED; PG8_LDA(At, 0, 0); PG8_STAGE(PG8_SA(1, 1), a1 + hstep, voffA);
            PG8_WAIT_V(8); PG8_WAIT_L(0); PG8_BAR; PG8_MMA(0, 0, At, B0); PG8_MMA(0, 1, At, B1); PG8_BAR; PG8_SCHED;
            PG8_LDA(At, 0, 1); PG8_STAGE(PG8_SB(0, 0), b2, voffB); PG8_STAGE(PG8_SB(0, 1), b2 + hstep, voffB); PG8_STAGE(PG8_SA(0, 0), a2, voffA);
            PG8_WAIT_V(8); PG8_WAIT_L(0); PG8_BAR; PG8_MMA(1, 0, At, B0); PG8_MMA(1, 1, At, B1); PG8_BAR; PG8_SCHED;
            PG8_LDB(B0, 1, 0); PG8_LDB(B1, 1, 1); PG8_SCHED; PG8_LDA(At, 1, 0); PG8_STAGE(PG8_SA(0, 1), a2 + hstep, voffA);
            PG8_WAIT_V(8); PG8_WAIT_L(0); PG8_BAR; PG8_MMA(0, 0, At, B0); PG8_MMA(0, 1, At, B1); PG8_BAR; PG8_SCHED;
            PG8_LDA(At, 1, 1); PG8_STAGE(PG8_SB(1, 0), b3, voffB); PG8_STAGE(PG8_SB(1, 1), b3 + hstep, voffB); PG8_STAGE(PG8_SA(1, 0), a3, voffA);
            PG8_WAIT_V(8); PG8_WAIT_L(0); PG8_BAR; PG8_MMA(1, 0, At, B0); PG8_MMA(1, 1, At, B1); PG8_BAR; PG8_SCHED;
            } else {
            PG8_LDB(B0, 0, 0); PG8_SCHED; PG8_LDA(At, 0, 0); PG8_STAGE(PG8_SA(1, 1), a1 + hstep, voffA);
            PG8_WAIT_L(8); PG8_BAR; PG8_WAIT_L(0); PG8_MMA(0, 0, At, B0); PG8_BAR; PG8_SCHED;
            PG8_LDB(B1, 0, 1); PG8_STAGE(PG8_SB(0, 0), b2, voffB);
            PG8_BAR; PG8_WAIT_L(0); PG8_MMA(0, 1, At, B1); PG8_BAR;
            PG8_LDA(At, 0, 1); PG8_STAGE(PG8_SA(0, 0), a2, voffA);
            PG8_BAR; PG8_WAIT_L(0); PG8_MMA(1, 0, At, B0); PG8_BAR; PG8_SCHED;
            PG8_STAGE(PG8_SB(0, 1), b2 + hstep, voffB);
            PG8_WAIT_V(6); PG8_BAR; PG8_MMA(1, 1, At, B1); PG8_BAR;
            PG8_LDB(B0, 1, 0); PG8_SCHED; PG8_LDA(At, 1, 0); PG8_STAGE(PG8_SA(0, 1), a2 + hstep, voffA);
            PG8_WAIT_L(8); PG8_BAR; PG8_WAIT_L(0); PG8_MMA(0, 0, At, B0); PG8_BAR; PG8_SCHED;
            PG8_LDB(B1, 1, 1); PG8_STAGE(PG8_SB(1, 0), b3, voffB);
            PG8_BAR; PG8_WAIT_L(0); PG8_MMA(0, 1, At, B1); PG8_BAR;
            PG8_LDA(At, 1, 1); PG8_STAGE(PG8_SA(1, 0), a3, voffA);
            PG8_BAR; PG8_WAIT_L(0); PG8_MMA(1, 0, At, B0); PG8_BAR; PG8_SCHED;
            PG8_STAGE(PG8_SB(1, 1), b3 + hstep, voffB);
            PG8_WAIT_V(6); PG8_BAR; PG8_MMA(1, 1, At, B1); PG8_BAR;
            }
        }
        if constexpr (ALIGN_EPI) { if (wr == 0) PG8_BAR; }
        if constexpr (!Epi::AFTER_DRAIN) { E(acc, cur, wr, wc, fr, fq); S.done(cur); }
        if (!has_next) break;
#pragma unroll
        for (int a = 0; a < 2; ++a)
#pragma unroll
            for (int b = 0; b < 2; ++b)
#pragma unroll
                for (int m = 0; m < 4; ++m)
#pragma unroll
                    for (int n = 0; n < 2; ++n) acc[a][b][m][n] = (f32x4){0.f, 0.f, 0.f, 0.f};
        cur = nxt; cA = nA; cB = nB; ++ui;
        if constexpr (ALIGN_EPI) { if (wr == 1) PG8_BAR; }
    }
    PG8_WAIT_V(0);
    if constexpr (!ALIGN_EPI) { if (wr == 0) PG8_BAR; }
    PG8_BAR;
    if constexpr (Epi::AFTER_DRAIN) { E.fused(acc, cur, wr, wc, fr, fq, lds, wid, lane); S.done(cur); }
#undef PG8_SA
#undef PG8_SB
#undef PG8_STAGE
#undef PG8_LDA
#undef PG8_LDB
#undef PG8_MMA
#undef PG8_WAIT_V
#undef PG8_WAIT_L
#undef PG8_BAR
#undef PG8_SCHED
}
}
constexpr int RING_BYTES = 131072, MISC_OFF = RING_BYTES + 320, LDS_BYTES = 147456;
struct Params { const float* in[45]; float* out; unsigned char* ws; int ph_lo, ph_hi, use_bar, pad; };
enum { I_XP = 0, I_XS, I_CKV, I_CWIN, I_SWKV, I_SSHIFT, I_SCONV, I_PT, I_NORMG, I_MU, I_WR, I_WK, I_WV, I_WO, I_W0, I_W1, I_W2, I_A0, I_A1, I_A2, I_V0, I_V1, I_V2, I_G1, I_G2,
       I_KK, I_KA, I_RKK, I_LNW, I_LNB, I_KVNG, I_WKV, I_KNG, I_PE, I_CW1, I_CB1, I_CW2, I_CB2, I_WQ, I_QNG, I_WONSA, I_WIN, I_CONVW, I_CONVB, I_WOUT };

typedef const __attribute__((address_space(4))) Params* KP;
struct Ctx { LAS unsigned char* lds; int tid, lane, wave, gw, ngw, gtid, gsz; };

__device__ __forceinline__ void p0_transpose_item(const float* W, int K, int ldw, int nblk, bf16_t* WT, int row_off, LAS float* scr, int item, int lane) {
    const int kb = item / nblk, nb = item % nblk, k0 = 64 * kb, n0 = 32 * nb;
#pragma unroll 8
    for (int i = 0; i < 32; ++i) { const int kk = 2 * i + (lane >> 5); scr[kk * 33 + (lane & 31)] = W[(size_t)(k0 + kk) * ldw + n0 + (lane & 31)]; }
    LDS_WAIT(); asm volatile("" ::: "memory");
    const int c = lane & 7;
#pragma unroll
    for (int j = 0; j < 4; ++j) { const int n = (lane >> 3) + 8 * j; const LAS float* s = scr + (8 * c) * 33 + n;
        u32x4 o; o.x = pk2(s[0 * 33], s[1 * 33]); o.y = pk2(s[2 * 33], s[3 * 33]); o.z = pk2(s[4 * 33], s[5 * 33]); o.w = pk2(s[6 * 33], s[7 * 33]);
        *(u32x4*)(WT + (size_t)(row_off + n0 + n) * K + k0 + 8 * c) = o; }
    LDS_WAIT(); asm volatile("" ::: "memory");
}

__device__ __forceinline__ void phase_prologue(KP p, const Ctx& c) {
    LAS float* scr = (LAS float*)(c.lds + c.wave * 16384);
    unsigned char* ws = p->ws;
    int total = 0;
#define TRCNT(K_, N_) (((K_) / 64) * ((N_) / 32))
    constexpr int C_DD = TRCNT(1024, 1024), C_L64 = TRCNT(1024, 64), C_L32 = TRCNT(1024, 32), C_L128 = TRCNT(1024, 128), C_2_64 = TRCNT(64, 1024), C_2_128 = TRCNT(128, 1024);
    constexpr int C_KV = TRCNT(1024, 1536), C_Q = 16 * 33, C_IN = TRCNT(1024, 5632), C_OUT = TRCNT(2816, 1024), C_CW = TRCNT(1024, 128);
    constexpr int NITEMS = 2 * (4 * C_DD + 2 * C_L64 + C_L128 + 2 * C_2_64 + C_2_128) + C_L32 + C_KV + 2 * C_Q + 2 * C_DD + 4 * C_IN + 4 * C_OUT + 4 * C_CW;
    (void)total;
    for (int it = c.gw; it < NITEMS; it += c.ngw) {
        int r = it;
#define TR(Wp, K_, LDW_, NBLK_, WTp, ROWOFF_) { const int cnt_ = ((K_) / 64) * (NBLK_); if (r < cnt_) { p0_transpose_item((Wp), (K_), (LDW_), (NBLK_), (bf16_t*)(WTp), (ROWOFF_), scr, r, c.lane); continue; } r -= cnt_; }
        bool done = false;
#pragma unroll
        for (int l = 0; l < 2; ++l) {
            if (done) break;
            const size_t dd = (size_t)l * 1024 * 1024;
#define TRL(Wp, K_, LDW_, NBLK_, WTp, ROWOFF_) { const int cnt_ = ((K_) / 64) * (NBLK_); if (!done) { if (r < cnt_) { p0_transpose_item((Wp), (K_), (LDW_), (NBLK_), (bf16_t*)(WTp), (ROWOFF_), scr, r, c.lane); done = true; } else r -= cnt_; } }
            TRL(p->in[I_WR] + dd, 1024, 1024, 32, ws + WS_WRKV + (size_t)l * 3072 * 1024 * 2, 0)
            TRL(p->in[I_WK] + dd, 1024, 1024, 32, ws + WS_WRKV + (size_t)l * 3072 * 1024 * 2, 1024)
            TRL(p->in[I_WV] + dd, 1024, 1024, 32, ws + WS_WRKV + (size_t)l * 3072 * 1024 * 2, 2048)
            TRL(p->in[I_WO] + dd, 1024, 1024, 32, ws + WS_WORW + (size_t)l * 1024 * 1024 * 2, 0)
            TRL(p->in[I_W1] + (size_t)l * 1024 * 64, 1024, 64, 2, ws + WS_W1T + (size_t)l * 288 * 1024 * 2, 0)
            TRL(p->in[I_A1] + (size_t)l * 1024 * 64, 1024, 64, 2, ws + WS_W1T + (size_t)l * 288 * 1024 * 2, 64)
            TRL(p->in[I_G1] + (size_t)l * 1024 * 128, 1024, 128, 4, ws + WS_W1T + (size_t)l * 288 * 1024 * 2, 160)
            TRL(p->in[I_W2] + (size_t)l * 64 * 1024, 64, 1024, 32, ws + WS_W2W + (size_t)l * 1024 * 64 * 2, 0)
            TRL(p->in[I_A2] + (size_t)l * 64 * 1024, 64, 1024, 32, ws + WS_W2A + (size_t)l * 1024 * 64 * 2, 0)
            TRL(p->in[I_G2] + (size_t)l * 128 * 1024, 128, 1024, 32, ws + WS_W2G + (size_t)l * 1024 * 128 * 2, 0)
        }
        if (done) continue;
        TR(p->in[I_V1], 1024, 32, 1, ws + WS_W1T + (size_t)1 * 288 * 1024 * 2, 128)
        TR(p->in[I_WKV], 1024, 1536, 48, ws + WS_WKVT, 0)
        TR(p->in[I_WQ], 1024, NQ, 33, ws + WS_WQT, 0)
        TR(p->in[I_WQ] + (size_t)1024 * NQ, 1024, NQ, 33, ws + WS_WQT + (size_t)NQP * 1024 * 2, 0)
        TR(p->in[I_WONSA], 1024, 1024, 32, ws + WS_WONSA, 0)
        TR(p->in[I_WONSA] + (size_t)1024 * 1024, 1024, 1024, 32, ws + WS_WONSA + (size_t)1024 * 1024 * 2, 0)
#pragma unroll
        for (int l = 0; l < 4; ++l) {
            if (done) break;
            TRL(p->in[I_WIN] + (size_t)l * 1024 * 5632, 1024, 5632, 176, ws + WS_WINT + (size_t)l * 5632 * 1024 * 2, 0)
            TRL(p->in[I_WOUT] + (size_t)l * 2816 * 1024, 2816, 1024, 32, ws + WS_WOUTT + (size_t)l * 1024 * 2816 * 2, 0)
        }
        if (done) continue;
        TR(p->in[I_CW1], 1024, 128, 4, ws + WS_CW1T, 0)
        TR(p->in[I_CW1] + (size_t)1024 * 128, 1024, 128, 4, ws + WS_CW1T, 128)
        TR(p->in[I_CW1] + (size_t)2048 * 128, 1024, 128, 4, ws + WS_CW1T + (size_t)256 * 1024 * 2, 0)
        TR(p->in[I_CW1] + (size_t)3072 * 128, 1024, 128, 4, ws + WS_CW1T + (size_t)256 * 1024 * 2, 128)
#undef TR
#undef TRL
    }
    {
        bf16_t* WQT = (bf16_t*)(ws + WS_WQT);
        for (int e = c.gtid; e < 2 * 224 * 1024; e += c.gsz) { const int k = e & 1023, n = 1056 + ((e >> 10) % 224), l = e / (224 * 1024);
            WQT[((size_t)l * NQP + n) * 1024 + k] = n < NQ ? (bf16_t)f2bf(p->in[I_WQ][((size_t)l * 1024 + k) * NQ + n]) : (bf16_t)0; }
        bf16_t* W2V = (bf16_t*)(ws + WS_W2V);
        for (int e = c.gtid; e < 32 * 1024; e += c.gsz) { const int n = e & 1023, k = e >> 10; W2V[n * 32 + k] = (bf16_t)f2bf(p->in[I_V2][k * 1024 + n]); }
    }
    { bf16_t* W2T = (bf16_t*)(ws + WS_CW2T);
      for (int e = c.gtid; e < 2 * 128 * 64; e += c.gsz) { const int d = e & 63, q = (e >> 6) & 127, kv = e >> 13; const float w = p->in[I_CW2][e];
          const unsigned hi = f2bf(w), lo = f2bf(w - __builtin_bit_cast(float, hi << 16)); W2T[(size_t)(kv * 64 + d) * 128 + q] = (bf16_t)hi; W2T[(size_t)2 * 64 * 128 + (size_t)(kv * 64 + d) * 128 + q] = (bf16_t)lo; } }
    for (int it = c.gw; it < 256; it += c.ngw) { const int kv = it >> 7, h = it & 127; float s = 0.f;
        for (int kk = c.lane; kk < 2048; kk += 64) s += p->in[I_PE][kv * 2048 + kk] * p->in[I_CW1][((size_t)kv * 2048 + kk) * 128 + h];
        s = wave_sum(s); if (c.lane == 0) ((float*)(ws + WS_CBIAS))[it] = s + p->in[I_CB1][it]; }
    { const f32x4* xp = (const f32x4*)p->in[I_XP]; const f32x4* xs = (const f32x4*)p->in[I_XS]; f32x4* o = (f32x4*)(p->out + O_Y);
      for (int e = c.gtid; e < R * D / 4; e += c.gsz) o[e] = e < MP * D / 4 ? xp[e] : xs[e - MP * D / 4]; }
}

__device__ __forceinline__ void phase_fill(KP p, const Ctx& c, int li, const int gwf, const int ngwf) {
    unsigned char* ws = p->ws;
    { const int* pt = (const int*)p->in[I_PT]; bf16_t* CA = (bf16_t*)(ws + WS_CMPA); const int part = li;
      for (int it = gwf; it < SB * 128 * 4; it += ngwf) { const int s4 = 4 * (it & 3), n = (it >> 2) & 127, b = it >> 9;
          const int page = pt[b * NPAGES + (n >> 3)]; const float* src = p->in[I_CKV] + ((size_t)page * PAGE + (n & 7) * 16 + s4) * 1024 + part * 256;
          f32x4 v[4];
#pragma unroll
          for (int e = 0; e < 4; ++e) v[e] = __builtin_nontemporal_load(((const f32x4*)(src + (size_t)e * 1024)) + c.lane);
          const int g = c.lane >> 4, d0 = 4 * (c.lane & 15); bf16_t* dst = CA + ((size_t)8192 + (size_t)part * 65536 + (size_t)(b * 4 + g) * 128 + n) * 1024 + s4 * 64 + d0;
#pragma unroll
          for (int e = 0; e < 4; ++e) { u32x2 w; w.x = pk2(v[e][0], v[e][1]); w.y = pk2(v[e][2], v[e][3]); *(u32x2*)(dst + e * 64) = w; } } }
    { const f32x4* src = (const f32x4*)p->in[I_CWIN]; f32x4* dst = (f32x4*)(p->out + O_WINS); constexpr int HALF_N = SB * 508 * 128 / 2;
      for (int e0 = li * HALF_N + gwf * 256 + c.lane; e0 < (li + 1) * HALF_N; e0 += ngwf * 256) { f32x4 v[4];
#pragma unroll
          for (int q = 0; q < 4; ++q) { const int e = e0 + 64 * q; if (e < (li + 1) * HALF_N) { const int b = e / (508 * 128), rr = e % (508 * 128); v[q] = __builtin_nontemporal_load(src + (size_t)b * 512 * 128 + 4 * 128 + rr); } }
#pragma unroll
          for (int q = 0; q < 4; ++q) { const int e = e0 + 64 * q; if (e < (li + 1) * HALF_N) { const int b = e / (508 * 128), rr = e % (508 * 128); __builtin_nontemporal_store(v[q], dst + (size_t)b * 512 * 128 + rr); } } } }
}

template <int NT> __device__ __forceinline__ void skinny_mma(const bf16_t* A, int lda, const bf16_t* Wt, int ldw, int K, int row0, int col0, int lane, f32x4 (&acc)[NT][2]) {
    const int fr = lane & 15, fq = lane >> 4;
#pragma unroll
    for (int nt = 0; nt < NT; ++nt) { acc[nt][0] = (f32x4){0.f, 0.f, 0.f, 0.f}; acc[nt][1] = (f32x4){0.f, 0.f, 0.f, 0.f}; }
    const bf16_t* xa = A + (size_t)(row0 + fr) * lda + 8 * fq; const bf16_t* xb = xa + (size_t)16 * lda;
    const bf16_t* wa = Wt + (size_t)(col0 + fr) * ldw + 8 * fq;
    const char* pa = (const char*)xa; const char* pb = (const char*)xb; const char* pw[NT];
#pragma unroll
    for (int nt = 0; nt < NT; ++nt) pw[nt] = (const char*)(wa + (size_t)nt * 16 * ldw);
    for (int k4 = 0; k4 < K / 128; ++k4) {
        bf16x8 fb[4][2], fa[4][NT];
#pragma unroll
        for (int u = 0; u < 4; ++u) { fb[u][0] = *(const bf16x8*)(pa + 64 * u); fb[u][1] = *(const bf16x8*)(pb + 64 * u);
#pragma unroll
            for (int nt = 0; nt < NT; ++nt) fa[u][nt] = *(const bf16x8*)(pw[nt] + 64 * u); }
        __builtin_amdgcn_sched_barrier(0);
#pragma unroll
        for (int u = 0; u < 4; ++u)
#pragma unroll
            for (int nt = 0; nt < NT; ++nt) { acc[nt][0] = mfma16(fa[u][nt], fb[u][0], acc[nt][0]); acc[nt][1] = mfma16(fa[u][nt], fb[u][1], acc[nt][1]); }
        pa += 256; pb += 256;
#pragma unroll
        for (int nt = 0; nt < NT; ++nt) pw[nt] += 256;
        __builtin_amdgcn_sched_barrier(0);
    }
}
__device__ __forceinline__ void skinny_resid_sample(const Ctx& c, const bf16_t* A, int lda, const bf16_t* Wt, int K, float* X) {
    const int ln = launder_v(c.lane), fr = ln & 15, fq = ln >> 4, w = c.wave;
    const int nch = K >> 7, c0 = (nch * w) >> 3, c1 = (nch * (w + 1)) >> 3;
    LAS f32x4* part = (LAS f32x4*)c.lds;
    __syncthreads();
    for (int it = blockIdx.x; it < 256; it += gridDim.x) { const int row0 = MP + 32 * (it & 15), col0 = 64 * (it >> 4);
        f32x4 acc[4][2]; skinny_mma<4>(A + 128 * c0, lda, Wt + 128 * c0, lda, 128 * (c1 - c0), row0, col0, c.lane, acc);
#pragma unroll
        for (int nt = 0; nt < 4; ++nt)
#pragma unroll
            for (int mt = 0; mt < 2; ++mt) part[(w * 8 + nt * 2 + mt) * 64 + ln] = acc[nt][mt];
        const int nt = w >> 1, mt = w & 1; f32x4* q = (f32x4*)(X + (size_t)(row0 + 16 * mt + fr) * D + col0 + 16 * nt + 4 * fq); f32x4 s = *q;
        __syncthreads();
#pragma unroll
        for (int ww = 0; ww < 8; ++ww) s = s + part[(ww * 8 + w) * 64 + ln];
        *q = s;
        __syncthreads(); }
}
__device__ __forceinline__ void skinny_store(const Ctx& c, const bf16_t* A, const bf16_t* Wt, int K, float* C, int ldc, int rbase, int nrb, int ncb, int it0, int nit_total) {
    const int fr = c.lane & 15, fq = c.lane >> 4;
    for (int it = c.gw - it0; it < nrb * ncb; it += c.ngw) { if (it < 0) continue; const int row0 = rbase + 32 * (it % nrb), col0 = 64 * (it / nrb);
        f32x4 acc[4][2]; skinny_mma<4>(A, K, Wt, K, K, row0, col0, c.lane, acc);
#pragma unroll
        for (int nt = 0; nt < 4; ++nt)
#pragma unroll
            for (int mt = 0; mt < 2; ++mt) *(f32x4*)(C + (size_t)(row0 + 16 * mt + fr) * ldc + col0 + 16 * nt + 4 * fq) = acc[nt][mt]; }
    (void)nit_total;
}

__device__ __forceinline__ void load_row(const float* p, int lane, f32x4 (&v)[4]) {
#pragma unroll
    for (int j = 0; j < 4; ++j) v[j] = ((const f32x4*)p)[lane + 64 * j];
}
__device__ __forceinline__ float row_rstd(const f32x4 (&v)[4]) {
    float s = 0.f;
#pragma unroll
    for (int j = 0; j < 4; ++j) s += (v[j][0] * v[j][0] + v[j][1] * v[j][1]) + (v[j][2] * v[j][2] + v[j][3] * v[j][3]);
    s = wave_sum(s); return frsq(s * (1.0f / D) + NORM_EPS);
}
__device__ __forceinline__ void store_row_bf16(bf16_t* o, int lane, const f32x4 (&v)[4]) {
#pragma unroll
    for (int j = 0; j < 4; ++j) { u32x2 w; w.x = pk2(v[j][0], v[j][1]); w.y = pk2(v[j][2], v[j][3]); ((u32x2*)o)[lane + 64 * j] = w; }
}

__device__ __forceinline__ void phase_norm(const Ctx& c, const float* X, const float* g1, bf16_t* o1, const float* g2, bf16_t* o2) {
    f32x4 ga[4], gb[4]; load_row(g1, c.lane, ga); if (g2) load_row(g2, c.lane, gb);
    for (int row = c.gw; row < R; row += c.ngw) {
        f32x4 v[4]; load_row(X + (size_t)row * D, c.lane, v); const float rs = row_rstd(v);
        f32x4 y[4];
#pragma unroll
        for (int j = 0; j < 4; ++j) y[j] = v[j] * rs * ga[j];
        store_row_bf16(o1 + (size_t)row * D, c.lane, y);
        if (g2) {
#pragma unroll
            for (int j = 0; j < 4; ++j) y[j] = v[j] * rs * gb[j];
            store_row_bf16(o2 + (size_t)row * D, c.lane, y); }
    }
}

__device__ __forceinline__ void phase_mix(KP p, const Ctx& c, int li) {
    const float* X = p->out + O_Y; const float* gain = p->in[I_NORMG] + (size_t)(li * 2) * D; const float* mu = p->in[I_MU] + (size_t)li * 6 * D;
    bf16_t* XM = (bf16_t*)(p->ws + WS_XM);
    f32x4 ga[4]; load_row(gain, c.lane, ga);
    {
        const int r0 = (int)(((long)c.gw * R) / c.ngw), r1 = (int)(((long)(c.gw + 1) * R) / c.ngw); f32x4 prev[4];
        {
            const bool seq_start = r0 < MP ? ((r0 & (TP - 1)) == 0) : (((r0 - MP) & 3) == 0);
            if (!seq_start && r0 < r1) { f32x4 v[4]; load_row(X + (size_t)(r0 - 1) * D, c.lane, v); const float rs = row_rstd(v);
#pragma unroll
                for (int j = 0; j < 4; ++j) prev[j] = v[j] * rs * ga[j]; }
        }
        for (int row = r0; row < r1; ++row) {
            const bool seq_start = row < MP ? ((row & (TP - 1)) == 0) : (((row - MP) & 3) == 0);
            if (seq_start) {
                if (row < MP) {
#pragma unroll
                    for (int j = 0; j < 4; ++j) prev[j] = (f32x4){0.f, 0.f, 0.f, 0.f}; }
                else load_row(p->in[I_SSHIFT] + ((size_t)li * SB + ((row - MP) >> 2)) * D, c.lane, prev);
            }
            f32x4 v[4]; load_row(X + (size_t)row * D, c.lane, v); const float rs = row_rstd(v);
            f32x4 xn[4];
#pragma unroll
            for (int j = 0; j < 4; ++j) xn[j] = v[j] * rs * ga[j];
#pragma unroll
            for (int m = 0; m < 6; ++m) {
                f32x4 y[4];
#pragma unroll
                for (int j = 0; j < 4; ++j) { const int mi = m == 1 ? 2 : (m == 2 ? 3 : (m == 3 ? 1 : m));
                    const f32x4 mm = ((const f32x4*)(mu + (size_t)mi * D))[c.lane + 64 * j]; y[j] = xn[j] + (prev[j] - xn[j]) * mm; }
                store_row_bf16(XM + ((size_t)m * R + row) * D, c.lane, y);
            }
            const bool seq_end = row < MP ? ((row & (TP - 1)) == TP - 1) : (((row - MP) & 3) == 3);
            if (seq_end) { float* so = row < MP ? p->out + O_SHP + ((size_t)li * NB + (row >> 13)) * D : p->out + O_SHS + ((size_t)li * SB + ((row - MP) >> 2)) * D;
#pragma unroll
                for (int j = 0; j < 4; ++j) ((f32x4*)so)[c.lane + 64 * j] = xn[j]; }
#pragma unroll
            for (int j = 0; j < 4; ++j) prev[j] = xn[j];
        }
    }
}
template <int NT, int ACT> __device__ __forceinline__ void lora1_item(const bf16_t* X, const bf16_t* W, bf16_t* HID, int coloff, int rb, int lane) {
    lane = launder_v(lane);
    const int fr = lane & 15, fq = lane >> 4;
    f32x4 acc[NT][2]; skinny_mma<NT>(X, 1024, W, 1024, 1024, rb * 32, coloff, lane, acc);
#pragma unroll
    for (int nt = 0; nt < NT; ++nt)
#pragma unroll
        for (int mt = 0; mt < 2; ++mt) { f32x4 v = acc[nt][mt];
#pragma unroll
            for (int r = 0; r < 4; ++r) { if (ACT == 1) { const float e = __builtin_amdgcn_exp2f(2.8853900817779268f * v[r]); v[r] = 1.0f - 2.0f * frcp(e + 1.0f); } if (ACT == 2) v[r] = sigmoidf_(v[r]); }
            u32x2 w; w.x = pk2(v[0], v[1]); w.y = pk2(v[2], v[3]);
            *(u32x2*)(HID + (size_t)(rb * 32 + mt * 16 + fr) * LHID + coloff + nt * 16 + 4 * fq) = w; }
}
__device__ __forceinline__ void phase_lora1(KP p, const Ctx& c, int li) {
    const bf16_t* XM = (const bf16_t*)(p->ws + WS_XM); const bf16_t* W = (const bf16_t*)(p->ws + WS_W1T) + (size_t)li * 288 * 1024; bf16_t* HID = (bf16_t*)(p->ws + WS_HID);
    constexpr int NRB = R / 32;
    for (int it = blockIdx.x + gridDim.x * c.wave; it < 5 * NRB; it += c.ngw) { const int q = it / NRB, rb = it % NRB;
        if (q == 0) lora1_item<4, 1>(XM + (size_t)3 * R * D, W, HID, 0, rb, c.lane);
        else if (q == 1) lora1_item<4, 0>(XM + (size_t)4 * R * D, W, HID, 64, rb, c.lane);
        else if (q == 2) { if (li == 1) lora1_item<2, 0>(XM + (size_t)2 * R * D, W, HID, 128, rb, c.lane); }
        else if (q == 3) lora1_item<4, 2>(XM + (size_t)5 * R * D, W, HID, 160, rb, c.lane);
        else lora1_item<4, 2>(XM + (size_t)5 * R * D, W, HID, 224, rb, c.lane);
    }
}

constexpr int SST = 72, MAT = 64 * SST * 2;
constexpr int O_AT = 0, O_BT = MAT, O_KT = 2 * MAT, O_RT = 3 * MAT, O_VT = 4 * MAT, O_BH = 5 * MAT, O_KH = 6 * MAT, O_XT = 7 * MAT, O_AAB = 9 * MAT, O_AAK = 10 * MAT, O_ARB = 11 * MAT, O_ARK = 12 * MAT;
constexpr int O_TD = 13 * MAT, O_SCR = O_TD + 2048, O_CS = O_SCR + 4096, O_WC = O_CS + 2048, O_LW = O_XT, O_LA = O_XT + 16384, O_LV = O_XT + 32768;
static_assert(O_WC + 256 <= RING_BYTES && O_LV + 16384 <= O_TD, "scan LDS map");
__device__ __forceinline__ bf16x8 ldsfrag(LAS unsigned char* lds, int off, int row, int col) { return *(const LAS bf16x8*)(lds + off + (row * SST + col) * 2); }
__device__ __forceinline__ void lds_st4(LAS unsigned char* lds, int off, int row, int col, f32x4 v) { u32x2 w; w.x = pk2(v[0], v[1]); w.y = pk2(v[2], v[3]); *(LAS u32x2*)(lds + off + (row * SST + col) * 2) = w; }
__device__ __forceinline__ f32x4 lds_ld4(LAS unsigned char* lds, int off, int row, int col) { const u32x2 w = *(const LAS u32x2*)(lds + off + (row * SST + col) * 2); return (f32x4){bflo(w.x), bfhi(w.x), bflo(w.y), bfhi(w.y)}; }

__device__ __forceinline__ void scanA_unit(KP p, const Ctx& c, int li, int u) {
    LAS unsigned char* lds = c.lds; unsigned char* ws = p->ws; const int stop = p->pad;
    const int lane = c.lane, wave = c.wave, fr = lane & 15, fq = lane >> 4;
    const int b = u / (NCH * H), n = (u / H) % NCH, h = u % H, row0 = b * TP + 64 * n;
    const float* Rb = (const float*)(ws + WS_RK_R); const float* Kb = (const float*)(ws + WS_RK_K);
    float* Vb = (float*)(ws + (li ? WS_V1 : WS_V0)); const float* V0b = (const float*)(ws + WS_V0);
    const bf16_t* HID = (const bf16_t*)(ws + WS_HID);
    {
        const int tt = wave & 3, chh = wave >> 2;
        const bf16_t* hrow = launder_p(HID + (size_t)(row0 + 16 * tt + fr) * LHID + 8 * fq);
        const bf16_t* W2W = (const bf16_t*)(ws + WS_W2W) + (size_t)li * 1024 * 64; const bf16_t* W2A = (const bf16_t*)(ws + WS_W2A) + (size_t)li * 1024 * 64; const bf16_t* W2V = (const bf16_t*)(ws + WS_W2V);
#pragma unroll
        for (int cti = 0; cti < 2; ++cti) { const int ct = 2 * chh + cti, C = 64 * h + 16 * ct + fr;
            f32x4 aw = {0.f, 0.f, 0.f, 0.f}, aa = {0.f, 0.f, 0.f, 0.f}, av = {0.f, 0.f, 0.f, 0.f};
#pragma unroll
            for (int ks = 0; ks < 2; ++ks) {
                aw = mfma16(*(const bf16x8*)(W2W + (size_t)C * 64 + 32 * ks + 8 * fq), *(const bf16x8*)(hrow + 32 * ks), aw);
                aa = mfma16(*(const bf16x8*)(W2A + (size_t)C * 64 + 32 * ks + 8 * fq), *(const bf16x8*)(hrow + 64 + 32 * ks), aa); }
            if (li) av = mfma16(*(const bf16x8*)(W2V + (size_t)C * 32 + 8 * fq), *(const bf16x8*)(hrow + 128), av);
            const int t = 16 * tt + fr, cc = 16 * ct + 4 * fq;
            *(LAS f32x4*)(lds + O_LW + (t * 64 + cc) * 4) = aw; *(LAS f32x4*)(lds + O_LA + (t * 64 + cc) * 4) = aa; *(LAS f32x4*)(lds + O_LV + (t * 64 + cc) * 4) = av; }
    }
    __syncthreads();
    if (stop == 1) return;
    {
        const int cc = lane, tq = wave, C = 64 * h + cc; const size_t pc = (size_t)li * D + C;
        const float w0 = p->in[I_W0][pc], a0 = p->in[I_A0][pc], kkc = p->in[I_KK][pc], kac = p->in[I_KA][pc], rkc = p->in[I_RKK][pc], v0 = li ? p->in[I_V0][C] : 0.f;
        float wlg[8], Lin[8], rr[8], k2[8], vv[8], aa[8], bb[8], rk8[8]; float run = 0.f;
        float r8[8], k8[8], v8[8], f8[8];
#pragma unroll
        for (int e = 0; e < 8; ++e) { const size_t gi = (size_t)(row0 + 8 * tq + e) * D + C; r8[e] = Rb[gi]; k8[e] = Kb[gi]; v8[e] = Vb[gi]; f8[e] = V0b[gi]; }
#pragma unroll
        for (int e = 0; e < 8; ++e) { const int t = 8 * tq + e;
            const float r = r8[e], k = k8[e]; float v = v8[e];
            const float lw = *(const LAS float*)(lds + O_LW + (t * 64 + cc) * 4), la = *(const LAS float*)(lds + O_LA + (t * 64 + cc) * 4), lv = *(const LAS float*)(lds + O_LV + (t * 64 + cc) * 4);
            const float z = -(w0 + lw); const float sp = fmaxf(z, 0.f) + __logf(1.0f + __expf(-fabsf(z))); const float wl = -__expf(-sp - 0.5f);
            const float asig = sigmoidf_(a0 + la);
            { const float vg = sigmoidf_(v0 + lv); const float vm = v + (f8[e] - v) * vg; v = li ? vm : v; }
            const float kkr = k * kkc; const float ss = wave_sum(kkr * kkr); const float kkn = kkr * frsq(fmaxf(ss, 1e-24f));
            const float kmod = k * (1.0f + (asig - 1.0f) * kac);
            rk8[e] = wave_sum(r * kmod * rkc);
            run += wl; wlg[e] = wl; Lin[e] = run; rr[e] = r; k2[e] = kmod; vv[e] = v; aa[e] = -kkn; bb[e] = kkn * asig; }
        if (li) {
#pragma unroll
            for (int e = 0; e < 8; ++e) Vb[(size_t)(row0 + 8 * tq + e) * D + C] = vv[e]; }
        if (cc == 0) {
#pragma unroll
            for (int e = 0; e < 8; ++e) ((float*)(ws + WS_RKS))[(size_t)(row0 + 8 * tq + e) * 16 + h] = rk8[e]; }
        *(LAS float*)(lds + O_CS + (tq * 64 + cc) * 4) = run;
        __syncthreads();
        float off = 0.f, tot = 0.f;
#pragma unroll
        for (int q = 0; q < 8; ++q) { const float x = *(const LAS float*)(lds + O_CS + (q * 64 + cc) * 4); tot += x; if (q < tq) off += x; }
        u32x4 wa, wv, wb, wk; unsigned pa[8], pv[8], pb[8], pk[8];
#pragma unroll
        for (int e = 0; e < 8; ++e) { const int t = 8 * tq + e; const float L = off + Lin[e], Lp = L - wlg[e];
            const float eL = __expf(L), eLp = __expf(Lp), enL = __expf(-L), eT = __expf(tot - L);
            const float at = aa[e] * eLp, bt = bb[e] * enL, kt = k2[e] * enL, rt = rr[e] * eL, bh = bb[e] * eT, kh = k2[e] * eT;
            *(LAS bf16_t*)(lds + O_AT + (t * SST + cc) * 2) = (bf16_t)f2bf(at); *(LAS bf16_t*)(lds + O_BT + (t * SST + cc) * 2) = (bf16_t)f2bf(bt);
            *(LAS bf16_t*)(lds + O_KT + (t * SST + cc) * 2) = (bf16_t)f2bf(kt); *(LAS bf16_t*)(lds + O_RT + (t * SST + cc) * 2) = (bf16_t)f2bf(rt);
            pa[e] = f2bf(at); pv[e] = f2bf(vv[e]); pb[e] = f2bf(bh); pk[e] = f2bf(kh); }
        wa = (u32x4){pa[0] | (pa[1] << 16), pa[2] | (pa[3] << 16), pa[4] | (pa[5] << 16), pa[6] | (pa[7] << 16)};
        wv = (u32x4){pv[0] | (pv[1] << 16), pv[2] | (pv[3] << 16), pv[4] | (pv[5] << 16), pv[6] | (pv[7] << 16)};
        wb = (u32x4){pb[0] | (pb[1] << 16), pb[2] | (pb[3] << 16), pb[4] | (pb[5] << 16), pb[6] | (pb[7] << 16)};
        wk = (u32x4){pk[0] | (pk[1] << 16), pk[2] | (pk[3] << 16), pk[4] | (pk[5] << 16), pk[6] | (pk[7] << 16)};
        *(LAS u32x4*)(lds + O_XT + (cc * SST + 8 * tq) * 2) = wa; *(LAS u32x4*)(lds + O_VT + (cc * SST + 8 * tq) * 2) = wv;
        *(LAS u32x4*)(lds + O_BH + (cc * SST + 8 * tq) * 2) = wb; *(LAS u32x4*)(lds + O_KH + (cc * SST + 8 * tq) * 2) = wk;
        if (tq == 0) *(LAS float*)(lds + O_WC + cc * 4) = __expf(tot);
    }
    __syncthreads();
    if (stop == 2) return;
    {
        const int mi = wave >> 1, ph = wave & 1; const int oY = (mi & 1) ? O_KT : O_BT, oX = (mi < 2) ? O_AT : O_RT; const bool strict = mi < 2;
        const int oO = mi == 0 ? O_AAB : (mi == 1 ? O_AAK : (mi == 2 ? O_ARB : O_ARK));
#pragma unroll
        for (int sti = 0; sti < 2; ++sti) { const int st = 2 * ph + sti;
#pragma unroll
            for (int tt = 0; tt < 4; ++tt) { f32x4 acc = {0.f, 0.f, 0.f, 0.f};
                if (st <= tt) {
#pragma unroll
                    for (int ks = 0; ks < 2; ++ks) acc = mfma16(ldsfrag(lds, oY, 16 * st + fr, 32 * ks + 8 * fq), ldsfrag(lds, oX, 16 * tt + fr, 32 * ks + 8 * fq), acc);
                    const int t = 16 * tt + fr;
#pragma unroll
                    for (int r = 0; r < 4; ++r) { const int s = 16 * st + 4 * fq + r; const bool keep = strict ? (s < t) : (s <= t); acc[r] = keep ? acc[r] : 0.f; } }
                if (st <= tt) lds_st4(lds, oO, 16 * tt + fr, 16 * st + 4 * fq, acc);
                else { u32x2 zz; int z0 = 0; asm volatile("" : "+v"(z0)); zz.x = (unsigned)z0; zz.y = (unsigned)z0; *(LAS u32x2*)(lds + oO + ((16 * tt + fr) * SST + 16 * st + 4 * fq) * 2) = zz; } } }
    }
    __syncthreads();
    if (stop == 3) return;
    {
        const int tt = wave & 3, ih = wave >> 2;
#pragma unroll
        for (int iti = 0; iti < 2; ++iti) { const int it = 2 * ih + iti; f32x4 acc = {0.f, 0.f, 0.f, 0.f};
#pragma unroll
            for (int ks = 0; ks < 2; ++ks) acc = mfma16(ldsfrag(lds, O_AAK, 16 * tt + fr, 32 * ks + 8 * fq), ldsfrag(lds, O_VT, 16 * it + fr, 32 * ks + 8 * fq), acc);
            lds_st4(lds, O_XT, 64 + 16 * it + fr, 16 * tt + 4 * fq, acc); }
        if (wave < 4 && lane < 16) { const int I = wave; float x[16];
#pragma unroll
            for (int t = 0; t < 16; ++t) { float s = (t == lane) ? 1.0f : 0.0f;
#pragma unroll
                for (int q = 0; q < t; ++q) s += bf2f(*(const LAS bf16_t*)(lds + O_AAB + ((16 * I + t) * SST + 16 * I + q) * 2)) * x[q];
                x[t] = s; *(LAS bf16_t*)(lds + O_TD + ((I * 16 + t) * 16 + lane) * 2) = (bf16_t)f2bf(s); } }
    }
    __syncthreads();
    if (stop == 5) return;
    {
        const int colb = 16 * wave; const bf16x8 zero8 = {0, 0, 0, 0, 0, 0, 0, 0};
#pragma unroll
        for (int I = 0; I < 4; ++I) {
            f32x4 acc = lds_ld4(lds, O_XT, colb + fr, 16 * I + 4 * fq);
#pragma unroll
            for (int ks = 0; ks < 2; ++ks) if (32 * ks < 16 * I) { const bool ok = (32 * ks + 8 * fq) < 16 * I;
                const bf16x8 a = ok ? ldsfrag(lds, O_AAB, 16 * I + fr, 32 * ks + 8 * fq) : zero8, bq = ok ? ldsfrag(lds, O_XT, colb + fr, 32 * ks + 8 * fq) : zero8;
                acc = mfma16(a, bq, acc); }
            { u32x2 w; w.x = pk2(acc[0], acc[1]); w.y = pk2(acc[2], acc[3]); *(LAS u32x2*)(lds + O_SCR + wave * 512 + (fr * 16 + 4 * fq) * 2) = w; }
            LDS_WAIT();
            const bf16x8 ta = fq < 2 ? *(const LAS bf16x8*)(lds + O_TD + ((I * 16 + fr) * 16 + 8 * fq) * 2) : zero8;
            const bf16x8 tb = fq < 2 ? *(const LAS bf16x8*)(lds + O_SCR + wave * 512 + (fr * 16 + 8 * fq) * 2) : zero8;
            const f32x4 res = mfma16(ta, tb, (f32x4){0.f, 0.f, 0.f, 0.f});
            lds_st4(lds, O_XT, colb + fr, 16 * I + 4 * fq, res);
            LDS_WAIT();
        }
    }
    __syncthreads();
    if (stop == 6) return;
    constexpr int S_RP = 0, S_MH = MAT, S_ML = 2 * MAT, S_YL = 3 * MAT, YLS = 68, S_NN = S_YL + 64 * YLS * 4;
    static_assert(S_NN + 64 * YLS * 4 <= O_XT, "staging must stay below the next unit's step-1 area");
    {
        const int tb = wave & 3, hb = wave >> 2;
        u32x2 rp[2], mh[2], ml[2]; f32x4 yl[2], nv[2];
#pragma unroll
        for (int qi = 0; qi < 2; ++qi) { const int rt = 2 * hb + qi;
            { f32x4 acc = lds_ld4(lds, O_RT, 16 * tb + fr, 16 * rt + 4 * fq);
#pragma unroll
              for (int ks = 0; ks < 2; ++ks) acc = mfma16(ldsfrag(lds, O_XT, 16 * rt + fr, 32 * ks + 8 * fq), ldsfrag(lds, O_ARB, 16 * tb + fr, 32 * ks + 8 * fq), acc);
              rp[qi].x = pk2(acc[0], acc[1]); rp[qi].y = pk2(acc[2], acc[3]); }
            { f32x4 acc = {0.f, 0.f, 0.f, 0.f};
#pragma unroll
              for (int ks = 0; ks < 2; ++ks) { acc = mfma16(ldsfrag(lds, O_XT, 64 + 16 * rt + fr, 32 * ks + 8 * fq), ldsfrag(lds, O_ARB, 16 * tb + fr, 32 * ks + 8 * fq), acc);
                  acc = mfma16(ldsfrag(lds, O_VT, 16 * rt + fr, 32 * ks + 8 * fq), ldsfrag(lds, O_ARK, 16 * tb + fr, 32 * ks + 8 * fq), acc); }
              yl[qi] = acc; }
            { f32x4 acc = {0.f, 0.f, 0.f, 0.f};
#pragma unroll
              for (int ks = 0; ks < 2; ++ks) acc = mfma16(ldsfrag(lds, O_XT, 16 * rt + fr, 32 * ks + 8 * fq), ldsfrag(lds, O_BH, 16 * tb + fr, 32 * ks + 8 * fq), acc);
              const int j = 16 * tb + fr; const float wc = *(const LAS float*)(lds + O_WC + j * 4);
#pragma unroll
              for (int r = 0; r < 4; ++r) if (16 * rt + 4 * fq + r == j) acc[r] += wc;
              unsigned hh[4], ll[4];
#pragma unroll
              for (int r = 0; r < 4; ++r) { hh[r] = f2bf(acc[r]); ll[r] = f2bf(acc[r] - __builtin_bit_cast(float, hh[r] << 16)); }
              mh[qi] = (u32x2){hh[0] | (hh[1] << 16), hh[2] | (hh[3] << 16)}; ml[qi] = (u32x2){ll[0] | (ll[1] << 16), ll[2] | (ll[3] << 16)}; }
            { f32x4 acc = {0.f, 0.f, 0.f, 0.f};
#pragma unroll
              for (int ks = 0; ks < 2; ++ks) { acc = mfma16(ldsfrag(lds, O_BH, 16 * rt + fr, 32 * ks + 8 * fq), ldsfrag(lds, O_XT, 64 + 16 * tb + fr, 32 * ks + 8 * fq), acc);
                  acc = mfma16(ldsfrag(lds, O_KH, 16 * rt + fr, 32 * ks + 8 * fq), ldsfrag(lds, O_VT, 16 * tb + fr, 32 * ks + 8 * fq), acc); }
              nv[qi] = acc; }
        }
        __syncthreads();
#pragma unroll
        for (int qi = 0; qi < 2; ++qi) { const int rt = 2 * hb + qi, row = 16 * tb + fr, col = 16 * rt + 4 * fq;
            *(LAS u32x2*)(lds + S_RP + (row * SST + col) * 2) = rp[qi]; *(LAS u32x2*)(lds + S_MH + (row * SST + col) * 2) = mh[qi]; *(LAS u32x2*)(lds + S_ML + (row * SST + col) * 2) = ml[qi];
            *(LAS f32x4*)(lds + S_YL + (row * YLS + col) * 4) = yl[qi]; *(LAS f32x4*)(lds + S_NN + (row * YLS + col) * 4) = nv[qi]; }
        __syncthreads();
        unsigned char* gRP = ws + WS_RP + (size_t)u * 8192; unsigned char* gYL = ws + WS_YL + (size_t)u * 16384;
        unsigned char* gMH = ws + WS_MT + (size_t)u * 8192; unsigned char* gML = gMH + (size_t)NUNIT_A * 8192; unsigned char* gNN = ws + WS_NN + (size_t)u * 16384;
        const int tid = 64 * wave + lane;
        { const int row = tid >> 3, ch = tid & 7, lo = (row * SST) * 2 + ch * 16;
          *(u32x4*)(gRP + tid * 16) = *(const LAS u32x4*)(lds + S_RP + lo); *(u32x4*)(gMH + tid * 16) = *(const LAS u32x4*)(lds + S_MH + lo); *(u32x4*)(gML + tid * 16) = *(const LAS u32x4*)(lds + S_ML + lo); }
#pragma unroll
        for (int k = 0; k < 2; ++k) { const int cidx = tid + 512 * k, row = cidx >> 4, c4 = cidx & 15, lo = (row * YLS) * 4 + c4 * 16;
            *(u32x4*)(gYL + cidx * 16) = *(const LAS u32x4*)(lds + S_YL + lo); *(u32x4*)(gNN + cidx * 16) = *(const LAS u32x4*)(lds + S_NN + lo); }
    }
}

__device__ __forceinline__ void scan_sample_item(KP p, const Ctx& c, int li, int item) {
    unsigned char* ws = p->ws; const int lane = c.lane, b = item >> 4, h = item & 15, C = 64 * h + lane; const size_t pc = (size_t)li * D + C;
    LAS float* sc = (LAS float*)(c.lds + c.wave * 16384);
    const float* Rb = (const float*)(ws + WS_RK_R); const float* Kb = (const float*)(ws + WS_RK_K);
    float* Vb = (float*)(ws + (li ? WS_V1 : WS_V0)); const float* V0b = (const float*)(ws + WS_V0);
    const bf16_t* HID = (const bf16_t*)(ws + WS_HID) + (size_t)(MP + 4 * b) * LHID;
    for (int e = lane; e < 4 * LHID; e += 64) sc[e] = bf2f(HID[e]);
    LDS_WAIT();
    float lw[4] = {0.f, 0.f, 0.f, 0.f}, la[4] = {0.f, 0.f, 0.f, 0.f}, lv[4] = {0.f, 0.f, 0.f, 0.f}, lg[4] = {0.f, 0.f, 0.f, 0.f};
    {
        const bf16_t* W2W = (const bf16_t*)(ws + WS_W2W) + ((size_t)li * 1024 + C) * 64; const bf16_t* W2A = (const bf16_t*)(ws + WS_W2A) + ((size_t)li * 1024 + C) * 64;
        const bf16_t* W2V = (const bf16_t*)(ws + WS_W2V) + (size_t)C * 32; const bf16_t* W2G = (const bf16_t*)(ws + WS_W2G) + ((size_t)li * 1024 + C) * 128;
#define LORA2_BLK(WP, QB, HOFF, ACC) { const u32x4 w8 = *(const u32x4*)((WP) + 8 * (QB)); \
            const float wf0 = bflo(w8.x), wf1 = bfhi(w8.x), wf2 = bflo(w8.y), wf3 = bfhi(w8.y), wf4 = bflo(w8.z), wf5 = bfhi(w8.z), wf6 = bflo(w8.w), wf7 = bfhi(w8.w); \
            _Pragma("unroll") for (int t = 0; t < 4; ++t) { const f32x4 h0 = *(const LAS f32x4*)(sc + t * LHID + (HOFF) + 8 * (QB)), h1 = *(const LAS f32x4*)(sc + t * LHID + (HOFF) + 8 * (QB) + 4); \
                ACC[t] += (h0[0] * wf0 + h0[1] * wf1) + (h0[2] * wf2 + h0[3] * wf3) + (h1[0] * wf4 + h1[1] * wf5) + (h1[2] * wf6 + h1[3] * wf7); } \
            asm volatile("" : "+v"(ACC[0]), "+v"(ACC[1]), "+v"(ACC[2]), "+v"(ACC[3]) :: "memory"); }
#pragma unroll
        for (int qb = 0; qb < 8; ++qb) { LORA2_BLK(W2W, qb, 0, lw) LORA2_BLK(W2A, qb, 64, la) }
        if (li) {
#pragma unroll
            for (int qb = 0; qb < 4; ++qb) LORA2_BLK(W2V, qb, 128, lv) }
#pragma unroll
        for (int qb = 0; qb < 16; ++qb) LORA2_BLK(W2G, qb, 160, lg)
#undef LORA2_BLK
    }
    const float w0 = p->in[I_W0][pc], a0 = p->in[I_A0][pc], kkc = p->in[I_KK][pc], kac = p->in[I_KA][pc], rkc = p->in[I_RKK][pc], v0 = li ? p->in[I_V0][C] : 0.f;
    const float lnw = p->in[I_LNW][pc], lnb = p->in[I_LNB][pc];
    float S[64];
    { const f32x4* sp = (const f32x4*)(p->in[I_SWKV] + (((size_t)li * SB + b) * H + h) * 4096 + lane * 64);
#pragma unroll
      for (int q = 0; q < 16; ++q) { const f32x4 x = sp[q]; S[4 * q] = x[0]; S[4 * q + 1] = x[1]; S[4 * q + 2] = x[2]; S[4 * q + 3] = x[3]; } }
    LAS float* bc = sc + 1280;
    bf16_t* YG = (bf16_t*)(ws + WS_YG);
#pragma unroll
    for (int t = 0; t < 4; ++t) { const size_t gi = (size_t)(MP + 4 * b + t) * D + C;
        const float r = Rb[gi], k = Kb[gi]; float v = Vb[gi];
        const float z = -(w0 + lw[t]); const float sp = fmaxf(z, 0.f) + __logf(1.0f + __expf(-fabsf(z))); const float wdec = __expf(-__expf(-sp - 0.5f));
        const float asig = sigmoidf_(a0 + la[t]);
        if (li) { const float vg = sigmoidf_(v0 + lv[t]); const float vf = V0b[gi]; v = v + (vf - v) * vg; }
        const float kkr = k * kkc; const float ss = wave_sum(kkr * kkr); const float kkn = kkr * frsq(fmaxf(ss, 1e-24f));
        const float kmod = k * (1.0f + (asig - 1.0f) * kac);
        const float rks = wave_sum(r * kmod * rkc);
        LDS_WAIT();
        bc[lane] = wdec; bc[64 + lane] = -kkn; bc[128 + lane] = kkn * asig; bc[192 + lane] = kmod; bc[256 + lane] = r;
        LDS_WAIT();
        float sa = 0.f;
#pragma unroll
        for (int q = 0; q < 16; ++q) { const f32x4 av = *(const LAS f32x4*)(bc + 64 + 4 * q); sa += S[4 * q] * av[0] + S[4 * q + 1] * av[1] + S[4 * q + 2] * av[2] + S[4 * q + 3] * av[3]; }
        float y = 0.f;
#pragma unroll
        for (int q = 0; q < 16; ++q) { const f32x4 wv = *(const LAS f32x4*)(bc + 4 * q), bv = *(const LAS f32x4*)(bc + 128 + 4 * q), kv = *(const LAS f32x4*)(bc + 192 + 4 * q), rv = *(const LAS f32x4*)(bc + 256 + 4 * q);
#pragma unroll
            for (int e = 0; e < 4; ++e) { const float s = S[4 * q + e] * wv[e] + sa * bv[e] + v * kv[e]; S[4 * q + e] = s; y += s * rv[e]; } }
        const float mean = wave_sum(y) * (1.0f / 64.0f); const float dy = y - mean; const float var = wave_sum(dy * dy) * (1.0f / 64.0f);
        const float yn = dy * (frsq(var + GN_EPS)) * lnw + lnb;
        YG[gi] = (bf16_t)f2bf((yn + rks * v) * lg[t]);
    }
    { f32x4* so = (f32x4*)(p->out + O_WKVS + (((size_t)li * SB + b) * H + h) * 4096 + lane * 64);
#pragma unroll
      for (int q = 0; q < 16; ++q) so[q] = (f32x4){S[4 * q], S[4 * q + 1], S[4 * q + 2], S[4 * q + 3]}; }
    LDS_WAIT();
}

__device__ __forceinline__ void phase_scanA(KP p, const Ctx& c, int li) {
    const int stop = p->pad;
    if (stop != 9) for (int u = blockIdx.x; u < NUNIT_A; u += gridDim.x) scanA_unit(p, c, li, u);
    __syncthreads();
    if (stop == 0 || stop == 9) for (int it = c.gw; it < SB * H; it += c.ngw) scan_sample_item(p, c, li, it);
}

__device__ __forceinline__ void hilo(const f32x4 x0, const f32x4 x1, bf16x8& hi, bf16x8& lo) {
    unsigned h[8], l[8];
#pragma unroll
    for (int e = 0; e < 8; ++e) { const float x = e < 4 ? x0[e] : x1[e - 4]; h[e] = f2bf(x); l[e] = f2bf(x - __builtin_bit_cast(float, h[e] << 16)); }
    u32x4 hv = {h[0] | (h[1] << 16), h[2] | (h[3] << 16), h[4] | (h[5] << 16), h[6] | (h[7] << 16)}, lv = {l[0] | (l[1] << 16), l[2] | (l[3] << 16), l[4] | (l[5] << 16), l[6] | (l[7] << 16)};
    hi = __builtin_bit_cast(bf16x8, hv); lo = __builtin_bit_cast(bf16x8, lv);
}
constexpr int SB_SLOT = 20480, SB_RING0 = 8192, SB_DEPTH = 6;
static_assert(SB_RING0 + SB_DEPTH * SB_SLOT <= RING_BYTES, "chain ring");
__device__ __forceinline__ void phase_scanB(KP p, const Ctx& c, int li) {
    unsigned char* ws = p->ws; LAS unsigned char* lds = c.lds; const int lane = c.lane, fr = lane & 15, fq = lane >> 4, wave = c.wave;
    volatile LAS int* FL = (volatile LAS int*)(lds + RING_BYTES);
    if (c.tid < 4) FL[c.tid] = 0;
    __syncthreads();
    const int ncb = (int)gridDim.x < 128 ? (int)gridDim.x : 128;
    if (wave >= 4 || (int)blockIdx.x >= ncb) {
        const int gwf = (int)blockIdx.x < ncb ? (int)blockIdx.x * 4 + (wave - 4) : ncb * 4 + ((int)blockIdx.x - ncb) * 8 + wave, ngwf = ncb * 4 + ((int)gridDim.x - ncb) * 8;
        phase_fill(p, c, li, gwf, ngwf); return; }
    if (wave != 0) {
        const int j = wave - 1; int prevG = -1, kc = 0;
        for (int ch = blockIdx.x; ch < 128; ch += gridDim.x, ++kc) { const int b = ch >> 6, h = (ch >> 2) & 15, iq = ch & 3;
            for (int n = j; n < NCH; n += 3) { const int G = kc * NCH + n;
                if (G >= SB_DEPTH) { unsigned sp = 0; while (FL[0] < G - (SB_DEPTH - 1)) { __builtin_amdgcn_s_sleep(1); if (++sp > (1u << 22)) break; } }
                LAS unsigned char* slot = lds + SB_RING0 + (G % SB_DEPTH) * SB_SLOT;
                const size_t u = (size_t)(b * NCH + n) * H + h; const bf16_t* MTH = (const bf16_t*)(ws + WS_MT) + u * 4096; const bf16_t* MTL = MTH + (size_t)NUNIT_A * 4096; const float* NN = (const float*)(ws + WS_NN) + u * 4096;
#pragma unroll
                for (int jt = 0; jt < 4; ++jt)
#pragma unroll
                    for (int ks = 0; ks < 2; ++ks) {
                        __builtin_amdgcn_global_load_lds((const unsigned*)(MTH + (size_t)(16 * jt + fr) * 64 + 32 * ks + 8 * fq), (LAS unsigned*)(slot + ((jt * 2 + ks) * 2 + 0) * 1024), 16, 0, 0);
                        __builtin_amdgcn_global_load_lds((const unsigned*)(MTL + (size_t)(16 * jt + fr) * 64 + 32 * ks + 8 * fq), (LAS unsigned*)(slot + ((jt * 2 + ks) * 2 + 1) * 1024), 16, 0, 0); }
#pragma unroll
                for (int jt = 0; jt < 4; ++jt)
                    __builtin_amdgcn_global_load_lds((const unsigned*)(NN + (size_t)(16 * iq + fr) * 64 + 16 * jt + 4 * fq), (LAS unsigned*)(slot + (16 + jt) * 1024), 16, 0, 0);
                asm volatile("s_waitcnt vmcnt(20)" ::: "memory");
                if (prevG >= 0) FL[1 + j] = prevG + 1;
                prevG = G; } }
        asm volatile("s_waitcnt vmcnt(0)" ::: "memory");
        if (prevG >= 0) FL[1 + j] = prevG + 1;
        return; }
    int kc = 0;
    for (int ch = blockIdx.x; ch < 128; ch += gridDim.x, ++kc) {
        const int b = ch >> 6, h = (ch >> 2) & 15, iq = ch & 3;
        f32x4 S[4];
#pragma unroll
        for (int jt = 0; jt < 4; ++jt) S[jt] = (f32x4){0.f, 0.f, 0.f, 0.f};
        int j3 = 0;
        for (int n = 0; n < NCH; ++n) { const int G = kc * NCH + n;
            const size_t u = (size_t)(b * NCH + n) * H + h; bf16_t* S0 = (bf16_t*)(ws + WS_S0) + u * 4096;
            { unsigned sp = 0; while (FL[1 + j3] < G + 1) { __builtin_amdgcn_s_sleep(1); if (++sp > (1u << 22)) break; } }
            const LAS unsigned char* slot = lds + SB_RING0 + (G % SB_DEPTH) * SB_SLOT + lane * 16;
            bf16x8 ah[4][2], al[4][2]; f32x4 nn[4];
#pragma unroll
            for (int jt = 0; jt < 4; ++jt) { nn[jt] = *(const LAS f32x4*)(slot + (16 + jt) * 1024);
#pragma unroll
                for (int ks = 0; ks < 2; ++ks) { ah[jt][ks] = *(const LAS bf16x8*)(slot + ((jt * 2 + ks) * 2 + 0) * 1024); al[jt][ks] = *(const LAS bf16x8*)(slot + ((jt * 2 + ks) * 2 + 1) * 1024); } }
#pragma unroll
            for (int jt = 0; jt < 4; ++jt) { unsigned hh[4], ll[4];
#pragma unroll
                for (int r = 0; r < 4; ++r) { hh[r] = f2bf(S[jt][r]); ll[r] = f2bf(S[jt][r] - __builtin_bit_cast(float, hh[r] << 16)); }
                u32x2 wh = {hh[0] | (hh[1] << 16), hh[2] | (hh[3] << 16)}, wl = {ll[0] | (ll[1] << 16), ll[2] | (ll[3] << 16)};
                *(u32x2*)(S0 + (size_t)(16 * iq + fr) * 64 + 16 * jt + 4 * fq) = wh;
                *(LAS u32x2*)(lds + (fr * SST + 16 * jt + 4 * fq) * 2) = wh; *(LAS u32x2*)(lds + 4096 + (fr * SST + 16 * jt + 4 * fq) * 2) = wl; }
            LDS_WAIT();
            bf16x8 bh[2], bl[2];
#pragma unroll
            for (int ks = 0; ks < 2; ++ks) { bh[ks] = *(const LAS bf16x8*)(lds + (fr * SST + 32 * ks + 8 * fq) * 2); bl[ks] = *(const LAS bf16x8*)(lds + 4096 + (fr * SST + 32 * ks + 8 * fq) * 2); }
#pragma unroll
            for (int jt = 0; jt < 4; ++jt) { f32x4 acc = nn[jt];
#pragma unroll
                for (int ks = 0; ks < 2; ++ks) { acc = mfma16(ah[jt][ks], bh[ks], acc); acc = mfma16(ah[jt][ks], bl[ks], acc); acc = mfma16(al[jt][ks], bh[ks], acc); }
                S[jt] = acc; }
            LDS_WAIT();
            FL[0] = G + 1;
            j3 = j3 == 2 ? 0 : j3 + 1;
        }
        float* so = p->out + O_WKVP + (((size_t)li * NB + b) * H + h) * 4096;
#pragma unroll
        for (int jt = 0; jt < 4; ++jt) *(f32x4*)(so + (size_t)(16 * iq + fr) * 64 + 16 * jt + 4 * fq) = S[jt];
    }
}

__device__ __forceinline__ void phase_scanC(KP p, const Ctx& c, int li) {
    unsigned char* ws = p->ws; const int lane = c.lane, fr = lane & 15, fq = lane >> 4, hb = c.wave >> 2, tt = c.wave & 3;
    const float* Vb = (const float*)(ws + (li ? WS_V1 : WS_V0)); const bf16_t* HID = (const bf16_t*)(ws + WS_HID); const bf16_t* W2G = (const bf16_t*)(ws + WS_W2G) + (size_t)li * 1024 * 128;
    bf16_t* YG = (bf16_t*)(ws + WS_YG);
    for (int up = blockIdx.x; up < NUNIT_A / 2; up += gridDim.x) {
        const int u = 2 * up + hb; const int b = u / (NCH * H), n = (u / H) % NCH, h = u % H; const int row = b * TP + 64 * n + 16 * tt + fr;
        const bf16_t* RP = (const bf16_t*)(ws + WS_RP) + (size_t)u * 4096; const float* YL = (const float*)(ws + WS_YL) + (size_t)u * 4096; const bf16_t* S0 = (const bf16_t*)(ws + WS_S0) + (size_t)u * 4096;
        f32x4 acc[4], ag[4];
#pragma unroll
        for (int it = 0; it < 4; ++it) { acc[it] = *(const f32x4*)(YL + (size_t)(16 * tt + fr) * 64 + 16 * it + 4 * fq); ag[it] = (f32x4){0.f, 0.f, 0.f, 0.f}; }
#pragma unroll
        for (int ks = 0; ks < 2; ++ks) { const bf16x8 bq = *(const bf16x8*)(RP + (size_t)(16 * tt + fr) * 64 + 32 * ks + 8 * fq);
#pragma unroll
            for (int it = 0; it < 4; ++it) acc[it] = mfma16(*(const bf16x8*)(S0 + (size_t)(16 * it + fr) * 64 + 32 * ks + 8 * fq), bq, acc[it]); }
        const bf16_t* hgp = launder_p(HID + (size_t)row * LHID + 160 + 8 * fq); const bf16_t* wgp = launder_p(W2G + (size_t)(64 * h + fr) * 128 + 8 * fq);
#pragma unroll
        for (int ks = 0; ks < 4; ++ks) { const bf16x8 bq = *(const bf16x8*)(hgp + 32 * ks);
#pragma unroll
            for (int it = 0; it < 4; ++it) ag[it] = mfma16(*(const bf16x8*)(wgp + it * 16 * 128 + 32 * ks), bq, ag[it]); }
        float s = 0.f;
#pragma unroll
        for (int it = 0; it < 4; ++it) s += (acc[it][0] + acc[it][1]) + (acc[it][2] + acc[it][3]);
        s = sum_rows4(s); const float mean = s * (1.0f / 64.0f);
        float q = 0.f;
#pragma unroll
        for (int it = 0; it < 4; ++it) { const f32x4 d = acc[it] - mean; q += (d[0] * d[0] + d[1] * d[1]) + (d[2] * d[2] + d[3] * d[3]); }
        q = sum_rows4(q); const float rstd = frsq(q * (1.0f / 64.0f) + GN_EPS);
        const float rks = ((const float*)(ws + WS_RKS))[(size_t)row * 16 + h];
#pragma unroll
        for (int it = 0; it < 4; ++it) { const int C = 64 * h + 16 * it + 4 * fq; const size_t pc = (size_t)li * D + C;
            const f32x4 lw = *(const f32x4*)(p->in[I_LNW] + pc), lb = *(const f32x4*)(p->in[I_LNB] + pc), v = *(const f32x4*)(Vb + (size_t)row * D + C);
            const f32x4 o = ((acc[it] - mean) * rstd * lw + lb + v * rks) * ag[it];
            u32x2 w; w.x = pk2(o[0], o[1]); w.y = pk2(o[2], o[3]); *(u32x2*)(YG + (size_t)row * D + C) = w; }
    }
}
__device__ __forceinline__ void ld8bf(const bf16_t* p, float (&o)[8]) { const u32x4 w = *(const u32x4*)p; o[0] = bflo(w.x); o[1] = bfhi(w.x); o[2] = bflo(w.y); o[3] = bfhi(w.y); o[4] = bflo(w.z); o[5] = bfhi(w.z); o[6] = bflo(w.w); o[7] = bfhi(w.w); }
__device__ __forceinline__ void ld8f(const float* p, float (&o)[8]) { const f32x4 a = *(const f32x4*)p, b = *(const f32x4*)(p + 4); o[0] = a[0]; o[1] = a[1]; o[2] = a[2]; o[3] = a[3]; o[4] = b[0]; o[5] = b[1]; o[6] = b[2]; o[7] = b[3]; }
__device__ __forceinline__ void phase_conv(KP p, const Ctx& c, int layer) {
    const bf16_t* U = (const bf16_t*)(p->ws + WS_U); const bf16_t* GT = (const bf16_t*)(p->ws + WS_GT); bf16_t* HH = (bf16_t*)(p->ws + WS_HH);
    const float* cw = p->in[I_CONVW] + (size_t)layer * 3 * DFF; const float* cb = p->in[I_CONVB] + (size_t)layer * DFF; const float* st = p->in[I_SCONV] + (size_t)layer * SB * 2 * DFF;
    constexpr int NF8 = DFF / 8;
    for (int e = c.gtid; e < R * NF8; e += c.gsz) { const int row = e / NF8, f = 8 * (e % NF8);
        int t, b; if (row < MP) { t = row & (TP - 1); b = -1; } else { t = (row - MP) & 3; b = (row - MP) >> 2; }
        float u0[8], u1[8], u2[8], g[8], w0[8], w1[8], w2[8], bb[8];
        ld8bf(U + (size_t)row * DFF + f, u2); ld8bf(GT + (size_t)row * DFF + f, g);
        if (t >= 1) ld8bf(U + (size_t)(row - 1) * DFF + f, u1); else if (b >= 0) ld8f(st + ((size_t)b * 2 + 1) * DFF + f, u1); else {
#pragma unroll
            for (int i = 0; i < 8; ++i) u1[i] = 0.f; }
        if (t >= 2) ld8bf(U + (size_t)(row - 2) * DFF + f, u0); else if (b >= 0) ld8f(st + ((size_t)b * 2 + t) * DFF + f, u0); else {
#pragma unroll
            for (int i = 0; i < 8; ++i) u0[i] = 0.f; }
        ld8f(cw + f, w0); ld8f(cw + DFF + f, w1); ld8f(cw + 2 * DFF + f, w2); ld8f(cb + f, bb);
        float o[8];
#pragma unroll
        for (int i = 0; i < 8; ++i) o[i] = gelu_tanh(bb[i] + w0[i] * u0[i] + w1[i] * u1[i] + w2[i] * u2[i]) * g[i];
        u32x4 w; w.x = pk2(o[0], o[1]); w.y = pk2(o[2], o[3]); w.z = pk2(o[4], o[5]); w.w = pk2(o[6], o[7]);
        *(u32x4*)(HH + (size_t)row * DFF + f) = w; }
}

__device__ __forceinline__ void phase_kvpost(KP p, const Ctx& c) {
    const float* KVF = (const float*)(p->ws + WS_KVF); unsigned char* ws = p->ws; const int lane = c.lane, g = lane >> 4, d0 = 4 * (lane & 15);
    const f32x4 gs = *(const f32x4*)(p->in[I_KNG] + 64 + d0), gw = *(const f32x4*)(p->in[I_KNG] + 128 + d0);
    bf16_t* CA = (bf16_t*)(ws + WS_CMPA); bf16_t* KS = (bf16_t*)(ws + WS_KS); bf16_t* VS = (bf16_t*)(ws + WS_VS); bf16_t* KW = (bf16_t*)(ws + WS_KW); bf16_t* VW = (bf16_t*)(ws + WS_VW);
    for (int chunk = c.gw; chunk < R / 8; chunk += c.ngw) {
        unsigned vs_[4][4], vw_[4][4];
#pragma unroll
        for (int e = 0; e < 8; ++e) { const int row = chunk * 8 + e; const float* src = KVF + (size_t)row * NKV + 4 * lane;
            f32x4 v[6];
#pragma unroll
            for (int pt = 0; pt < 6; ++pt) v[pt] = *(const f32x4*)(src + pt * 256);
            { float s = (v[2][0] * v[2][0] + v[2][1] * v[2][1]) + (v[2][2] * v[2][2] + v[2][3] * v[2][3]);
              s = row16_sum(s); const float rs = frsq(s * (1.0f / 64.0f) + NORM_EPS); v[2] = v[2] * rs * gs; }
            { float s = (v[4][0] * v[4][0] + v[4][1] * v[4][1]) + (v[4][2] * v[4][2] + v[4][3] * v[4][3]);
              s = row16_sum(s); const float rs = frsq(s * (1.0f / 64.0f) + NORM_EPS); v[4] = v[4] * rs * gw; }
            float* okv = p->out + O_KV + (size_t)row * D + 4 * lane;
#pragma unroll
            for (int pt = 0; pt < 4; ++pt) *(f32x4*)(okv + pt * 256) = v[pt];
            if (row < MP) { const int b = row >> 13, t = row & (TP - 1);
                if (t >= TP - WIN) { float* ow = p->out + O_WINP + ((size_t)(b * WIN + (t - (TP - WIN))) * 2) * 256 + 4 * lane; *(f32x4*)ow = v[4]; *(f32x4*)(ow + 256) = v[5]; }
                const size_t hb = (size_t)(b * G + g);
                { u32x2 w; w.x = pk2(v[0][0], v[0][1]); w.y = pk2(v[0][2], v[0][3]); *(u32x2*)(CA + (hb * 512 + (t >> 4)) * 1024 + (t & 15) * 64 + d0) = w; }
                { u32x2 w; w.x = pk2(v[1][0], v[1][1]); w.y = pk2(v[1][2], v[1][3]); *(u32x2*)(CA + ((size_t)4096 + hb * 512 + (t >> 4)) * 1024 + (t & 15) * 64 + d0) = w; }
                { u32x2 w; w.x = pk2(v[2][0], v[2][1]); w.y = pk2(v[2][2], v[2][3]); *(u32x2*)(KS + (hb * TP + t) * 64 + d0) = w; }
                { u32x2 w; w.x = pk2(v[4][0], v[4][1]); w.y = pk2(v[4][2], v[4][3]); *(u32x2*)(KW + (hb * TP + t) * 64 + d0) = w; }
#pragma unroll
                for (int d = 0; d < 4; ++d) { const unsigned a = f2bf(v[3][d]), bq = f2bf(v[5][d]);
                    if (e & 1) { vs_[d][e >> 1] |= a << 16; vw_[d][e >> 1] |= bq << 16; } else { vs_[d][e >> 1] = a; vw_[d][e >> 1] = bq; } }
            } else { const int b = (row - MP) >> 2, t = (row - MP) & 3;
                float* ow = p->out + O_WINS + ((size_t)(b * WIN + 508 + t) * 2) * 256 + 4 * lane; *(f32x4*)ow = v[4]; *(f32x4*)(ow + 256) = v[5]; }
        }
        if (chunk * 8 < MP) { const int row = chunk * 8, b = row >> 13, t = row & (TP - 1); const size_t hb = (size_t)(b * G + g);
#pragma unroll
            for (int d = 0; d < 4; ++d) { *(u32x4*)(VS + (hb * 64 + d0 + d) * TP + t) = (u32x4){vs_[d][0], vs_[d][1], vs_[d][2], vs_[d][3]};
                *(u32x4*)(VW + (hb * 64 + d0 + d) * TP + t) = (u32x4){vw_[d][0], vw_[d][1], vw_[d][2], vw_[d][3]}; } }
    }
}

__device__ __forceinline__ void phase_cmp2(KP p, const Ctx& c) {
    unsigned char* ws = p->ws; const float* PC = (const float*)(ws + WS_PCMP); const int lane = c.lane, fr = lane & 15, fq = lane >> 4;
    const bf16_t* W2H = (const bf16_t*)(ws + WS_CW2T); const bf16_t* W2L = W2H + 2 * 64 * 128;
    constexpr int NPI = NB * G * 32, NSI = SB * G * 8, TOT = 2 * (NPI + NSI);
    for (int it = c.gw; it < TOT; it += c.ngw) {
        const bool samp = it >= 2 * NPI; const int r = samp ? it - 2 * NPI : it; const int kv = samp ? r / NSI : r / NPI; const int idx = samp ? r % NSI : r % NPI;
        const int hb = samp ? (idx >> 3) : (idx >> 5), n0 = 16 * (samp ? (idx & 7) : (idx & 31)), ncmp = samp ? NCMP_S : NCMP_P, nper = samp ? 128 : 512;
        const int n = n0 + fr; const bool live = n < ncmp;
        const size_t prow = (samp ? (size_t)8192 + (size_t)kv * 65536 : (size_t)kv * 4096) + (size_t)hb * nper + (live ? n : ncmp - 1);
        const float* cb = (const float*)(ws + WS_CBIAS) + kv * 128;
        bf16x8 hh[4], hl[4];
#pragma unroll
        for (int ks = 0; ks < 4; ++ks) { const int k0 = 32 * ks + 8 * fq; unsigned uh[8], ul[8];
            const f32x4 a0 = *(const f32x4*)(PC + prow * 256 + k0), a1 = *(const f32x4*)(PC + prow * 256 + k0 + 4);
            const f32x4 b0 = *(const f32x4*)(PC + (prow + 1) * 256 + 128 + k0), b1 = *(const f32x4*)(PC + (prow + 1) * 256 + 128 + k0 + 4);
            const f32x4 c0 = *(const f32x4*)(cb + k0), c1 = *(const f32x4*)(cb + k0 + 4);
#pragma unroll
            for (int e = 0; e < 8; ++e) { const float x = e < 4 ? a0[e] + b0[e] + c0[e] : a1[e - 4] + b1[e - 4] + c1[e - 4]; const float hv = gelu_tanh(x);
                uh[e] = f2bf(hv); ul[e] = f2bf(hv - __builtin_bit_cast(float, uh[e] << 16)); }
            const u32x4 wh = {uh[0] | (uh[1] << 16), uh[2] | (uh[3] << 16), uh[4] | (uh[5] << 16), uh[6] | (uh[7] << 16)}, wl = {ul[0] | (ul[1] << 16), ul[2] | (ul[3] << 16), ul[4] | (ul[5] << 16), ul[6] | (ul[7] << 16)};
            hh[ks] = __builtin_bit_cast(bf16x8, wh); hl[ks] = __builtin_bit_cast(bf16x8, wl); }
        f32x4 acc[4];
#pragma unroll
        for (int dt = 0; dt < 4; ++dt) { acc[dt] = *(const f32x4*)(p->in[I_CB2] + kv * 64 + 16 * dt + 4 * fq);
#pragma unroll
            for (int ks = 0; ks < 4; ++ks) { const size_t wo = (size_t)(kv * 64 + 16 * dt + fr) * 128 + 32 * ks + 8 * fq; const bf16x8 wh = *(const bf16x8*)(W2H + wo), wl = *(const bf16x8*)(W2L + wo);
                acc[dt] = mfma16(wh, hh[ks], acc[dt]); acc[dt] = mfma16(wh, hl[ks], acc[dt]); acc[dt] = mfma16(wl, hh[ks], acc[dt]); } }
        if (kv == 0) { float ss = 0.f;
#pragma unroll
            for (int dt = 0; dt < 4; ++dt) ss += (acc[dt][0] * acc[dt][0] + acc[dt][1] * acc[dt][1]) + (acc[dt][2] * acc[dt][2] + acc[dt][3] * acc[dt][3]);
            ss = sum_rows4(ss); const float rs = frsq(ss * (1.0f / 64.0f) + NORM_EPS);
#pragma unroll
            for (int dt = 0; dt < 4; ++dt) acc[dt] = acc[dt] * rs * *(const f32x4*)(p->in[I_KNG] + 16 * dt + 4 * fq); }
#pragma unroll
        for (int dt = 0; dt < 4; ++dt) { const f32x4 o = live ? acc[dt] : (f32x4){0.f, 0.f, 0.f, 0.f}; const int d = 16 * dt + 4 * fq;
            if (samp) *(f32x4*)((float*)(ws + (kv ? WS_CVS : WS_CKS)) + ((size_t)hb * 128 + n) * 64 + d) = o;
            else if (kv == 0) { u32x2 w; w.x = pk2(o[0], o[1]); w.y = pk2(o[2], o[3]); *(u32x2*)((bf16_t*)(ws + WS_CK) + ((size_t)hb * 512 + n) * 64 + d) = w; }
            else {
#pragma unroll
                for (int e = 0; e < 4; ++e) ((bf16_t*)(ws + WS_CV))[((size_t)hb * 64 + d + e) * 512 + n] = (bf16_t)f2bf(o[e]); } }
    }
}

__device__ __forceinline__ void phase_qpost(KP p, const Ctx& c, int lb) {
    const float* QF = (const float*)(p->ws + WS_QF); bf16_t* Q = (bf16_t*)(p->ws + WS_Q); const int lane = c.lane;
    const f32x4 gq = *(const f32x4*)(p->in[I_QNG] + lb * 64 + 4 * (lane & 15));
    for (int row = c.gw; row < R; row += c.ngw) { const float* src = QF + (size_t)row * NQP;
        f32x4 v[4]; load_row(src, lane, v);
#pragma unroll
        for (int j = 0; j < 4; ++j) { float s = (v[j][0] * v[j][0] + v[j][1] * v[j][1]) + (v[j][2] * v[j][2] + v[j][3] * v[j][3]);
            s = row16_sum(s);
            const float rs = (frsq(s * (1.0f / 64.0f) + NORM_EPS)) * (0.125f * 1.4426950408889634f); v[j] = v[j] * rs * gq; }
        store_row_bf16(Q + (size_t)row * D, lane, v);
    }
}
constexpr int AT_K0 = 0, AT_V0 = 9216, AT_K1 = 18432, AT_V1 = 27648, AT_IMP = 36864, IMPS = 132, AT_SELM = AT_IMP + 64 * IMPS * 4, AT_ANY = AT_SELM + 1024;
static_assert(AT_ANY + 16 <= RING_BYTES, "attention LDS map");
struct TileSrc { const bf16_t* K; const bf16_t* VT; int vts; };
__device__ __forceinline__ void tile_load(const TileSrc& s, int key0, int tid, u32x4& rk, u32x4& rv) {
    const int row = tid >> 3, ch = tid & 7;
    rk = *(const u32x4*)(s.K + (size_t)(key0 + row) * 64 + 8 * ch); rv = *(const u32x4*)(s.VT + (size_t)row * s.vts + key0 + 8 * ch);
}
__device__ __forceinline__ void tile_load_async(const TileSrc& s, int key0, int tid, u32x4& rk, u32x4& rv) {
    const int row = tid >> 3, ch = tid & 7;
    const bf16_t* pk = s.K + (size_t)(key0 + row) * 64 + 8 * ch; const bf16_t* pv = s.VT + (size_t)row * s.vts + key0 + 8 * ch;
    asm volatile("global_load_dwordx4 %0, %2, off\n\tglobal_load_dwordx4 %1, %3, off" : "=&v"(rk), "=&v"(rv) : "v"(pk), "v"(pv) : "memory");
}
#define TILE_WAIT(N_, RK_, RV_) asm volatile("s_waitcnt vmcnt(" #N_ ")" : "+v"(RK_), "+v"(RV_) :: "memory")
__device__ __forceinline__ void tile_store(LAS unsigned char* lds, int buf, int tid, const u32x4& rk, const u32x4& rv) {
    const int row = tid >> 3, ch = tid & 7;
    *(LAS u32x4*)(lds + (buf ? AT_K1 : AT_K0) + (row * SST + 8 * ch) * 2) = rk; *(LAS u32x4*)(lds + (buf ? AT_V1 : AT_V0) + (row * SST + 8 * ch) * 2) = rv;
}
__device__ __forceinline__ int first_bit4(unsigned a, unsigned b, unsigned c, unsigned d) { return a ? __ffs(a) - 1 : (b ? 32 + __ffs(b) - 1 : (c ? 64 + __ffs(c) - 1 : (d ? 96 + __ffs(d) - 1 : -1))); }
__device__ __forceinline__ float ex2(float x) { return __builtin_amdgcn_exp2f(x); }

__device__ __forceinline__ void set_bit4(int s, unsigned& t0, unsigned& t1, unsigned& t2, unsigned& t3) { const unsigned bit = 1u << (s & 31); const int w = s >> 5; t0 |= (w == 0) ? bit : 0u; t1 |= (w == 1) ? bit : 0u; t2 |= (w == 2) ? bit : 0u; t3 |= (w == 3) ? bit : 0u; }
__device__ __forceinline__ void clr_bit4(int s, unsigned& t0, unsigned& t1, unsigned& t2, unsigned& t3) { const unsigned bit = 1u << (s & 31); const int w = s >> 5; t0 &= ~((w == 0) ? bit : 0u); t1 &= ~((w == 1) ? bit : 0u); t2 &= ~((w == 2) ? bit : 0u); t3 &= ~((w == 3) ? bit : 0u); }
__device__ __forceinline__ unsigned get_word4(int s, unsigned a, unsigned b, unsigned c, unsigned d) { const int w = s >> 5; return ((w == 0) ? a : 0u) | ((w == 1) ? b : 0u) | ((w == 2) ? c : 0u) | ((w == 3) ? d : 0u); }
__device__ __forceinline__ float dpp_xor1(float x) { return __builtin_bit_cast(float, __builtin_amdgcn_update_dpp(0, __builtin_bit_cast(int, x), 0xB1, 0xF, 0xF, true)); }
__device__ __forceinline__ float dpp_xor2(float x) { return __builtin_bit_cast(float, __builtin_amdgcn_update_dpp(0, __builtin_bit_cast(int, x), 0x4E, 0xF, 0xF, true)); }
template <int MODE, bool EDGE> __device__ __forceinline__ void attn_tile(LAS unsigned char* lds, int buf, const bf16x8 (&qf)[4], int key0, int qpos, int r, int hf,
                                                                          float& l, f32x16 (&O)[2], float invl, bool selbit, LAS float* impq) {
    if (MODE == 3) { if (__ballot(selbit) == 0ull) { asm volatile("" : "+v"(O[0]), "+v"(O[1]), "+v"(l)); return; } }
    const float sbias = selbit ? 0.f : -1.0e30f;
    const int oK = buf ? AT_K1 : AT_K0, oV = buf ? AT_V1 : AT_V0;
#pragma unroll
    for (int kt = 0; kt < 2; ++kt) {
        f32x16 S;
#pragma unroll
        for (int i = 0; i < 16; ++i) S[i] = (MODE == 3) ? sbias : 0.f;
#pragma unroll
        for (int ks = 0; ks < 4; ++ks) S = mfma32(*(const LAS bf16x8*)(lds + oK + ((32 * kt + r) * SST + 16 * ks + 8 * hf) * 2), qf[ks], S);
        float ls = 0.f;
#pragma unroll
        for (int i = 0; i < 16; ++i) { float pv = ex2(S[i]);
            if (EDGE) { const int key = key0 + 32 * kt + (i & 3) + 8 * (i >> 2) + 4 * hf; bool v;
                if (MODE <= 1) v = (16 * key + 31 <= qpos); else if (MODE == 2) v = (key <= qpos) && (key + WIN > qpos); else v = (key <= qpos);
                pv = v ? pv : 0.f; }
            if (MODE == 1) pv *= invl;
            S[i] = pv; ls += pv; }
        if (MODE != 1) l += ls;
        if (MODE >= 1) {
#pragma unroll
            for (int sp = 0; sp < 2; ++sp) {
                u32x4 pw; pw.x = pg8::cvt_pk_bf16(S[8 * sp + 0], S[8 * sp + 1]); pw.y = pg8::cvt_pk_bf16(S[8 * sp + 2], S[8 * sp + 3]); pw.z = pg8::cvt_pk_bf16(S[8 * sp + 4], S[8 * sp + 5]); pw.w = pg8::cvt_pk_bf16(S[8 * sp + 6], S[8 * sp + 7]);
                const bf16x8 pf = __builtin_bit_cast(bf16x8, pw);
#pragma unroll
                for (int dt = 0; dt < 2; ++dt) { const int d = 32 * dt + r, kb = 32 * kt + 16 * sp + 4 * hf;
                    const u32x2 lo = *(const LAS u32x2*)(lds + oV + (d * SST + kb) * 2), hi = *(const LAS u32x2*)(lds + oV + (d * SST + kb + 8) * 2);
                    const u32x4 vw = {lo.x, lo.y, hi.x, hi.y};
                    O[dt] = mfma32(__builtin_bit_cast(bf16x8, vw), pf, O[dt]); } }
        }
        if (MODE == 1) {
            float own[4], nxt[4];
#pragma unroll
            for (int gq = 0; gq < 4; ++gq) { const float p3 = S[4 * gq + 3]; float o = 2.0f * (S[4 * gq] + S[4 * gq + 1] + S[4 * gq + 2]) + p3, n = p3;
                o += dpp_xor1(o); o += dpp_xor2(o); n += dpp_xor1(n); n += dpp_xor2(n); own[gq] = o; nxt[gq] = n; }
            const int sbb = (key0 >> 2) + 8 * kt + hf;
            if ((r & 3) == 0) {
#pragma unroll
                for (int gq = 0; gq < 4; ++gq) impq[sbb + 2 * gq] += own[gq]; }
            asm volatile("s_waitcnt lgkmcnt(0)" ::: "memory");
            if ((r & 3) == 0) {
#pragma unroll
                for (int gq = 0; gq < 4; ++gq) impq[sbb + 2 * gq + 1] += nxt[gq]; }
            asm volatile("s_waitcnt lgkmcnt(0)" ::: "memory");
        }
    }
}

template <int MODE> __device__ __forceinline__ void run_tiles(LAS unsigned char* lds, const TileSrc& src, unsigned t0, unsigned t1, unsigned t2, unsigned t3, int qt,
                                                              const bf16x8 (&qf)[4], int qpos, int r, int hf, int tid,
                                                              float& l, f32x16 (&O)[2], float invl, unsigned s0, unsigned s1, unsigned s2, unsigned s3, LAS float* impq, const int alias = 0) {
#define TSEL(n_) ((alias ? ((n_) & 7) : (n_)) * 64)
    tid = launder_v(tid); r = tid & 31; hf = (tid >> 5) & 1;
    int cur = first_bit4(t0, t1, t2, t3); if (cur < 0) return;
    const int first = cur;
    clr_bit4(cur, t0, t1, t2, t3); int n1 = first_bit4(t0, t1, t2, t3); if (n1 >= 0) clr_bit4(n1, t0, t1, t2, t3);
    int n2 = first_bit4(t0, t1, t2, t3); if (n2 >= 0) clr_bit4(n2, t0, t1, t2, t3);
    int n3 = first_bit4(t0, t1, t2, t3); if (n3 >= 0) clr_bit4(n3, t0, t1, t2, t3);
    u32x4 rkA, rvA, rkB, rvB, rkC, rvC; { u32x4 rk, rv; tile_load(src, TSEL(cur), tid, rk, rv); int b0 = 0; tile_store(lds, b0, tid, rk, rv); }
    tile_load_async(src, TSEL(n1 >= 0 ? n1 : first), tid, rkA, rvA);
    tile_load_async(src, TSEL(n2 >= 0 ? n2 : first), tid, rkB, rvB);
    tile_load_async(src, TSEL(n3 >= 0 ? n3 : first), tid, rkC, rvC);
    int buf = 0;
    __syncthreads();
#define RT_STEP(RK_, RV_) { \
        if (cur >= 0) { \
            const unsigned sw = get_word4(cur, s0, s1, s2, s3); \
            const bool sb = ((sw >> (cur & 31)) & 1u) != 0u; \
            if (MODE <= 1) attn_tile<MODE, true>(lds, buf, qf, cur * 64, qpos, r, hf, l, O, invl, sb, impq); \
            else { const bool edge = (cur == qt) || (MODE == 2 && cur == qt - 8); \
                if (edge) attn_tile<MODE, true>(lds, buf, qf, cur * 64, qpos, r, hf, l, O, invl, sb, impq); \
                else attn_tile<MODE, false>(lds, buf, qf, cur * 64, qpos, r, hf, l, O, invl, sb, impq); } } \
        TILE_WAIT(4, RK_, RV_); \
        tile_store(lds, buf ^ 1, tid, RK_, RV_); \
        __syncthreads(); \
        const int n4 = first_bit4(t0, t1, t2, t3); if (n4 >= 0) clr_bit4(n4, t0, t1, t2, t3); \
        tile_load_async(src, TSEL(n4 >= 0 ? n4 : first), tid, RK_, RV_); \
        buf ^= 1; cur = n1; n1 = n2; n2 = n3; n3 = n4; }
    do {
        RT_STEP(rkA, rvA)
        RT_STEP(rkB, rvB)
        RT_STEP(rkC, rvC)
    } while (cur >= 0);
#undef RT_STEP
    asm volatile("s_waitcnt vmcnt(0)" : "+v"(rkA), "+v"(rvA), "+v"(rkB), "+v"(rvB), "+v"(rkC), "+v"(rvC) :: "memory");
    __syncthreads();
}
__device__ __forceinline__ void attn_prompt_unit(KP p, const Ctx& c, int k, const int stop) {
    LAS unsigned char* lds = c.lds; unsigned char* ws = p->ws; int tid_m; asm volatile("v_mbcnt_lo_u32_b32 %0, -1, 0\n\tv_mbcnt_hi_u32_b32 %0, -1, %0" : "=v"(tid_m));
    const int wave = c.wave, tid = tid_m + 64 * wave, lane = tid & 63, r = lane & 31, hf = lane >> 5;
    const int qt = 127 - (k >> 3), hb = k & 7, b = hb >> 2, g = hb & 3, q0 = 64 * qt;
    const int qi = 8 * wave + (r >> 2), head = 4 * g + (r & 3), qpos = q0 + qi, row = b * TP + qpos;
    const bf16_t* Q = (const bf16_t*)(ws + WS_Q);
    bf16x8 qf[4];
#pragma unroll
    for (int ks = 0; ks < 4; ++ks) qf[ks] = *(const bf16x8*)(Q + (size_t)row * D + head * 64 + 16 * ks + 8 * hf);
    const float* gate = (const float*)(ws + WS_GATE) + (size_t)row * 48 + head * 3; const float g_c = gate[0], g_s = gate[1], g_w = gate[2];
    LAS float* imp = (LAS float*)(lds + AT_IMP); LAS unsigned* selm = (LAS unsigned*)(lds + AT_SELM); LAS unsigned* anym = (LAS unsigned*)(lds + AT_ANY);
    for (int e = tid; e < 64 * IMPS; e += 512) imp[e] = 0.f;
    if (tid < 4) anym[tid] = 0u;
    __syncthreads();
    f32x16 O[2]; unsigned OUTP[2][8];
#pragma unroll
    for (int dt = 0; dt < 2; ++dt)
#pragma unroll
        for (int i = 0; i < 16; ++i) O[dt][i] = 0.f;
    {
        const TileSrc src{(const bf16_t*)(ws + WS_CK) + (size_t)hb * 512 * 64, (const bf16_t*)(ws + WS_CV) + (size_t)hb * 64 * 512, 512};
        const int nmax = q0 + 63 - 31; const int ntc = nmax >= 0 ? (nmax >> 10) + 1 : 0;
        const unsigned tm = ntc >= 32 ? 0xffffffffu : ((1u << ntc) - 1u);
        float l = 0.f;
        run_tiles<0>(lds, src, tm, 0u, 0u, 0u, qt, qf, qpos, r, hf, tid, l, O, 0.f, 0u, 0u, 0u, 0u, imp);
        l = sum_xor32(l); const float invl = l > 0.f ? 1.0f / l : 0.f;
        run_tiles<1>(lds, src, tm, 0u, 0u, 0u, qt, qf, qpos, r, hf, tid, l, O, invl, 0u, 0u, 0u, 0u, imp + qi * IMPS);
#pragma unroll
        for (int dt = 0; dt < 2; ++dt) {
#pragma unroll
            for (int i = 0; i < 8; ++i) { OUTP[dt][i] = pg8::cvt_pk_bf16(O[dt][2 * i] * g_c, O[dt][2 * i + 1] * g_c); asm volatile("" : "+v"(OUTP[dt][i])); }
#pragma unroll
            for (int i = 0; i < 16; ++i) O[dt][i] = 0.f; }
    }
    __syncthreads();
    if (stop == 1) return;
    {
        unsigned k0[8], k1[8], T[8]; int Kq[8];
#pragma unroll
        for (int e = 0; e < 8; ++e) { const int qq = 8 * wave + e, qp = q0 + qq, qb = qp >> 6;
            const bool c0 = (64 * lane <= qp), c1 = (64 * (lane + 64) <= qp);
            const unsigned a0_ = (lane == 0 || lane == qb || lane == qb - 1) ? 0xffffffffu : __builtin_bit_cast(unsigned, imp[qq * IMPS + lane]);
            const unsigned a1_ = (lane + 64 == qb || lane + 64 == qb - 1) ? 0xffffffffu : __builtin_bit_cast(unsigned, imp[qq * IMPS + lane + 64]);
            k0[e] = c0 ? a0_ : 0u; k1[e] = c1 ? a1_ : 0u;
            Kq[e] = qb + 1 < 16 ? qb + 1 : 16; T[e] = 0u; }
        for (int bit = 31; bit >= 0; --bit) {
#pragma unroll
            for (int e = 0; e < 8; ++e) { const unsigned cand = T[e] | (1u << bit);
                const int cnt = __popcll(__ballot(k0[e] >= cand)) + __popcll(__ballot(k1[e] >= cand)); if (cnt >= Kq[e]) T[e] = cand; } }
#pragma unroll
        for (int e = 0; e < 8; ++e) { const int qq = 8 * wave + e, qp = q0 + qq;
            const bool c0 = (64 * lane <= qp), c1 = (64 * (lane + 64) <= qp);
            unsigned long long mlo = __ballot(k0[e] > T[e]), mhi = __ballot(k1[e] > T[e]), elo = __ballot(c0 && k0[e] == T[e]), ehi = __ballot(c1 && k1[e] == T[e]);
            int need = Kq[e] - (__popcll(mlo) + __popcll(mhi));
            for (; need > 0; --need) { if (elo) { mlo |= elo & (~elo + 1ull); elo &= elo - 1ull; } else { mhi |= ehi & (~ehi + 1ull); ehi &= ehi - 1ull; } }
            const unsigned m0 = (unsigned)mlo, m1 = (unsigned)(mlo >> 32), m2 = (unsigned)mhi, m3 = (unsigned)(mhi >> 32);
            if (lane == 0) { selm[qq * 4 + 0] = m0; selm[qq * 4 + 1] = m1; selm[qq * 4 + 2] = m2; selm[qq * 4 + 3] = m3;
                atomicOr((unsigned*)&anym[0], m0); atomicOr((unsigned*)&anym[1], m1); atomicOr((unsigned*)&anym[2], m2); atomicOr((unsigned*)&anym[3], m3); } }
    }
    __syncthreads();
    if (stop == 2) return;
    {
        const TileSrc src{(const bf16_t*)(ws + WS_KW) + (size_t)hb * TP * 64, (const bf16_t*)(ws + WS_VW) + (size_t)hb * 64 * TP, TP};
        const int tlo = qt >= 8 ? qt - 8 : 0; unsigned t0 = 0u, t1 = 0u, t2 = 0u, t3 = 0u;
        for (int s = tlo; s <= qt; ++s) set_bit4(s, t0, t1, t2, t3);
        float l = 0.f;
        run_tiles<2>(lds, src, t0, t1, t2, t3, qt, qf, qpos, r, hf, tid, l, O, 0.f, 0u, 0u, 0u, 0u, imp);
        l = sum_xor32(l); const float sc = l > 0.f ? g_w / l : 0.f;
#pragma unroll
        for (int dt = 0; dt < 2; ++dt) {
#pragma unroll
            for (int i = 0; i < 8; ++i) { OUTP[dt][i] = pg8::cvt_pk_bf16(bflo(OUTP[dt][i]) + O[dt][2 * i] * sc, bfhi(OUTP[dt][i]) + O[dt][2 * i + 1] * sc); asm volatile("" : "+v"(OUTP[dt][i])); }
#pragma unroll
            for (int i = 0; i < 16; ++i) O[dt][i] = 0.f; }
    }
    if (stop == 3) { __syncthreads(); return; }
    {
        const TileSrc src{(const bf16_t*)(ws + WS_KS) + (size_t)hb * TP * 64, (const bf16_t*)(ws + WS_VS) + (size_t)hb * 64 * TP, TP};
        const unsigned sz_ = (stop == 5) ? 0u : 0xffffffffu;
        const unsigned s0 = selm[qi * 4 + 0] & sz_, s1 = selm[qi * 4 + 1] & sz_, s2 = selm[qi * 4 + 2] & sz_, s3 = selm[qi * 4 + 3] & sz_;
        const unsigned a0 = __builtin_amdgcn_readfirstlane(anym[0]), a1 = __builtin_amdgcn_readfirstlane(anym[1]), a2 = __builtin_amdgcn_readfirstlane(anym[2]), a3 = __builtin_amdgcn_readfirstlane(anym[3]);
        float l = 0.f;
        run_tiles<3>(lds, src, a0, a1, a2, a3, qt, qf, qpos, r, hf, tid, l, O, 0.f, s0, s1, s2, s3, imp, stop == 4 ? 1 : 0);
        if (stop >= 4) { if (l == 12345.678f) ((float*)(ws + WS_GATE))[0] = O[0][0] + O[1][0]; __syncthreads(); return; }
        l = sum_xor32(l); const float sc = l > 0.f ? g_s / l : 0.f;
#pragma unroll
        for (int dt = 0; dt < 2; ++dt)
#pragma unroll
            for (int i = 0; i < 8; ++i) OUTP[dt][i] = pg8::cvt_pk_bf16(bflo(OUTP[dt][i]) + O[dt][2 * i] * sc, bfhi(OUTP[dt][i]) + O[dt][2 * i + 1] * sc);
    }
    bf16_t* AO = (bf16_t*)(ws + WS_YG) + (size_t)row * D + head * 64;
#pragma unroll
    for (int dt = 0; dt < 2; ++dt)
#pragma unroll
        for (int gq = 0; gq < 4; ++gq) { u32x2 w; w.x = OUTP[dt][2 * gq]; w.y = OUTP[dt][2 * gq + 1]; *(u32x2*)(AO + 32 * dt + 8 * gq + 4 * hf) = w; }
    __syncthreads();
}

constexpr int SA_RED = 0, SA_REDW = 2 * 16 * 65 * 4, SA_OC = SA_RED + SA_REDW, SA_EC = SA_OC + 2 * 4096, SA_LC = SA_EC + 2 * 4096, SA_PN = SA_LC + 256, SA_SEL = SA_PN + 4 * 512;
static_assert(SA_SEL + 64 <= RING_BYTES, "sample attention LDS map");
__device__ __forceinline__ bf16x8 pack8(const f32x4 a, const f32x4 b) { const u32x4 w = {pk2(a[0], a[1]), pk2(a[2], a[3]), pk2(b[0], b[1]), pk2(b[2], b[3])}; return __builtin_bit_cast(bf16x8, w); }
__device__ __forceinline__ void sa_qk(const float* kb, size_t stride, int nrows, const bf16x8 (&qf)[2], int fr, int fq, f32x4 (&S)[4]) {
    f32x4 kr[4][2][2];
#pragma unroll
    for (int kg = 0; kg < 4; ++kg) { const int key = 16 * kg + fr; const float* rp = kb + (size_t)(key < nrows ? key : nrows - 1) * stride + 8 * fq;
#pragma unroll
        for (int ks = 0; ks < 2; ++ks) { kr[kg][ks][0] = *(const f32x4*)(rp + 32 * ks); kr[kg][ks][1] = *(const f32x4*)(rp + 32 * ks + 4); } }
#pragma unroll
    for (int kg = 0; kg < 4; ++kg) { S[kg] = (f32x4){0.f, 0.f, 0.f, 0.f};
#pragma unroll
        for (int ks = 0; ks < 2; ++ks) S[kg] = mfma16(pack8(kr[kg][ks][0], kr[kg][ks][1]), qf[ks], S[kg]); }
}
__device__ __forceinline__ void sa_pv(const float* vb, size_t stride, int nrows, const f32x4 (&P)[4], int fr, int fq, f32x4 (&O)[4]) {
#pragma unroll
    for (int ks = 0; ks < 2; ++ks) { const bf16x8 pa = pack8(P[2 * ks], P[2 * ks + 1]);
        float vv[4][8];
#pragma unroll
        for (int j = 0; j < 8; ++j) { const int key = 16 * (2 * ks + (j >> 2)) + 4 * fq + (j & 3); const float* rp = vb + (size_t)(key < nrows ? key : nrows - 1) * stride + fr;
#pragma unroll
            for (int dt = 0; dt < 4; ++dt) vv[dt][j] = rp[16 * dt]; }
#pragma unroll
        for (int dt = 0; dt < 4; ++dt) { const u32x4 w = {pk2(vv[dt][0], vv[dt][1]), pk2(vv[dt][2], vv[dt][3]), pk2(vv[dt][4], vv[dt][5]), pk2(vv[dt][6], vv[dt][7])};
            O[dt] = mfma16(pa, __builtin_bit_cast(bf16x8, w), O[dt]); } }
}
__device__ __forceinline__ void attn_sample_unit(KP p, const Ctx& c, int item) {
    unsigned char* ws = p->ws; LAS unsigned char* lds = c.lds; const int tid = launder_v(c.tid), lane = tid & 63, wave = c.wave, fr = lane & 15, fq = lane >> 4; const int b = item >> 2, g = item & 3;
    bf16x8 qf[2];
    { const bf16_t* Q = (const bf16_t*)(ws + WS_Q) + (size_t)(MP + 4 * b + (fr >> 2)) * D + (4 * g + (fr & 3)) * 64 + 8 * fq;
      qf[0] = *(const bf16x8*)Q; qf[1] = *(const bf16x8*)(Q + 32); }
    const int tokm = fr >> 2;
    if (wave < 2) {
        const float* ck = (const float*)(ws + WS_CKS) + ((size_t)(b * 4 + g) * 128 + 64 * wave) * 64; const float* cv = (const float*)(ws + WS_CVS) + ((size_t)(b * 4 + g) * 128 + 64 * wave) * 64;
        const int nrows = wave ? 63 : 64;
        f32x4 S[4]; sa_qk(ck, 64, nrows, qf, fr, fq, S);
        float ls = 0.f;
#pragma unroll
        for (int kg = 0; kg < 4; ++kg)
#pragma unroll
            for (int r = 0; r < 4; ++r) { const int key = 16 * kg + 4 * fq + r; const float ev = key < nrows ? ex2(S[kg][r]) : 0.f; S[kg][r] = ev; ls += ev;
                *(LAS float*)(lds + SA_EC + wave * 4096 + (key * 16 + fr) * 4) = ev; }
        ls = sum_rows4(ls); if (fq == 0) *(LAS float*)(lds + SA_LC + (wave * 16 + fr) * 4) = ls;
        f32x4 oc[4];
#pragma unroll
        for (int dt = 0; dt < 4; ++dt) oc[dt] = (f32x4){0.f, 0.f, 0.f, 0.f};
        sa_pv(cv, 64, nrows, S, fr, fq, oc);
#pragma unroll
        for (int dt = 0; dt < 4; ++dt)
#pragma unroll
            for (int r = 0; r < 4; ++r) *(LAS float*)(lds + SA_OC + wave * 4096 + ((4 * fq + r) * 64 + 16 * dt + fr) * 4) = oc[dt][r];
    }
    __syncthreads();
    if (wave < 4) { const int tok = wave; float P0 = 0.f, P1 = 0.f;
#pragma unroll
        for (int hh = 0; hh < 4; ++hh) { const int pi = tok * 4 + hh; const float L = *(const LAS float*)(lds + SA_LC + pi * 4) + *(const LAS float*)(lds + SA_LC + (16 + pi) * 4); const float inv = L > 0.f ? 1.0f / L : 0.f;
            P0 += *(const LAS float*)(lds + SA_EC + (lane * 16 + pi) * 4) * inv; P1 += *(const LAS float*)(lds + SA_EC + 4096 + (lane * 16 + pi) * 4) * inv; }
        LAS float* pn = (LAS float*)(lds + SA_PN + tok * 512); pn[lane] = P0; pn[64 + lane] = P1; LDS_WAIT();
        float v0 = -1e9f;
        if (lane < 33) { const int s = lane; float im = 0.f;
            if (4 * s - 1 >= 0 && 4 * s - 1 < 128) im += pn[4 * s - 1];
#pragma unroll
            for (int j = 0; j < 3; ++j) if (4 * s + j < 128) im += 2.0f * pn[4 * s + j];
            if (4 * s + 3 < 128) im += pn[4 * s + 3];
            v0 = (s == 0 || s == 31 || s == 32) ? 1e9f : im; }
        unsigned selmask = 0u, sel32 = 0u;
        for (int it = 0; it < 16; ++it) { const float mx = wave_max(v0); if (mx < -5e8f) break; const unsigned long long b0 = __ballot(v0 == mx); const int s = __ffsll((long long)b0) - 1;
            if (lane == s) v0 = -2e9f; if (s < 32) selmask |= 1u << s; else sel32 = 1u; }
        if (lane == 0) { *(LAS unsigned*)(lds + SA_SEL + tok * 8) = selmask; *(LAS unsigned*)(lds + SA_SEL + tok * 8 + 4) = sel32; } }
    __syncthreads();
    unsigned sm[4], s32[4];
#pragma unroll
    for (int t = 0; t < 4; ++t) { sm[t] = *(const LAS unsigned*)(lds + SA_SEL + t * 8); s32[t] = *(const LAS unsigned*)(lds + SA_SEL + t * 8 + 4); }
    const unsigned un = sm[0] | sm[1] | sm[2] | sm[3]; const int nsel = __popc(un); const int has32 = (s32[0] | s32[1] | s32[2] | s32[3]) ? 1 : 0;
    const unsigned my_sm = tokm == 0 ? sm[0] : (tokm == 1 ? sm[1] : (tokm == 2 ? sm[2] : sm[3])), my_s32 = tokm == 0 ? s32[0] : (tokm == 1 ? s32[1] : (tokm == 2 ? s32[2] : s32[3]));
    const int ntile = nsel + has32 + 9;
    const int* pt = (const int*)p->in[I_PT] + b * NPAGES;
    f32x4 osel[4], owin[4]; float lsel = 0.f, lwin = 0.f;
#pragma unroll
    for (int dt = 0; dt < 4; ++dt) { osel[dt] = (f32x4){0.f, 0.f, 0.f, 0.f}; owin[dt] = (f32x4){0.f, 0.f, 0.f, 0.f}; }
    for (int ti = wave; ti < ntile; ti += 8) {
        const float* kb; size_t stride; int nrows = 64, br, mode, sidx = 0;
        if (ti < nsel) { unsigned m = un; for (int q = 0; q < ti; ++q) m &= m - 1u; sidx = __ffs(m) - 1; const int page = pt[sidx >> 1];
            kb = p->in[I_CKV] + ((size_t)page * PAGE + (sidx & 1) * 64) * 1024 + 2 * 256 + g * 64; stride = 1024; br = 0; mode = 0; }
        else if (ti < nsel + has32) { kb = p->out + O_KV + (size_t)(MP + 4 * b) * D + 2 * 256 + g * 64; stride = 1024; nrows = 4; br = 0; mode = 1; }
        else if (ti < nsel + has32 + 8) { sidx = ti - nsel - has32; kb = p->in[I_CWIN] + ((size_t)b * WIN + 64 * sidx) * 512 + g * 64; stride = 512; br = 1; mode = 2; }
        else { kb = p->out + O_WINS + ((size_t)(b * WIN + 508) * 2) * 256 + g * 64; stride = 512; nrows = 4; br = 1; mode = 3; }
        f32x4 S[4]; sa_qk(kb, stride, nrows, qf, fr, fq, S);
        float ls = 0.f;
#pragma unroll
        for (int kg = 0; kg < 4; ++kg)
#pragma unroll
            for (int r = 0; r < 4; ++r) { const int key = 16 * kg + 4 * fq + r; bool valid;
                if (mode == 0) valid = ((my_sm >> sidx) & 1u) != 0u; else if (mode == 1) valid = (my_s32 != 0u) && (key <= tokm); else if (mode == 2) valid = (64 * sidx + key) >= tokm + 1; else valid = key <= tokm;
                const float ev = valid ? ex2(S[kg][r]) : 0.f; S[kg][r] = ev; ls += ev; }
        if (br == 0) { lsel += ls; sa_pv(kb + 256, stride, nrows, S, fr, fq, osel); } else { lwin += ls; sa_pv(kb + 256, stride, nrows, S, fr, fq, owin); }
    }
    lsel = sum_rows4(lsel); lwin = sum_rows4(lwin);
    for (int w = 0; w < 8; ++w) {
        if (wave == w) {
#pragma unroll
            for (int dt = 0; dt < 4; ++dt)
#pragma unroll
                for (int r = 0; r < 4; ++r) { LAS float* r0 = (LAS float*)(lds + SA_RED + ((4 * fq + r) * 65 + 16 * dt + fr) * 4); LAS float* r1 = (LAS float*)(lds + SA_RED + ((16 + 4 * fq + r) * 65 + 16 * dt + fr) * 4);
                    if (w == 0) { *r0 = osel[dt][r]; *r1 = owin[dt][r]; } else { *r0 += osel[dt][r]; *r1 += owin[dt][r]; } }
            if (fq == 0) { LAS float* l0 = (LAS float*)(lds + SA_RED + (fr * 65 + 64) * 4); LAS float* l1 = (LAS float*)(lds + SA_RED + ((16 + fr) * 65 + 64) * 4);
                if (w == 0) { *l0 = lsel; *l1 = lwin; } else { *l0 += lsel; *l1 += lwin; } } }
        __syncthreads(); }
    { const float* gt = (const float*)(ws + WS_GATE); bf16_t* AO = (bf16_t*)(ws + WS_YG);
      for (int e = tid; e < 1024; e += 512) { const int pi = e >> 6, d = e & 63, tok = pi >> 2, hh = pi & 3; const size_t row = (size_t)(MP + 4 * b + tok);
          const float lc = *(const LAS float*)(lds + SA_LC + pi * 4) + *(const LAS float*)(lds + SA_LC + (16 + pi) * 4);
          const float oc = *(const LAS float*)(lds + SA_OC + (pi * 64 + d) * 4) + *(const LAS float*)(lds + SA_OC + 4096 + (pi * 64 + d) * 4);
          const LAS float* r0 = (const LAS float*)(lds + SA_RED + (pi * 65) * 4); const LAS float* r1 = (const LAS float*)(lds + SA_RED + ((16 + pi) * 65) * 4);
          const float* gg = gt + row * 48 + (4 * g + hh) * 3;
          float out = lc > 0.f ? gg[0] * oc / lc : 0.f;
          out += r0[64] > 0.f ? gg[1] * r0[d] / r0[64] : 0.f;
          out += r1[64] > 0.f ? gg[2] * r1[d] / r1[64] : 0.f;
          AO[row * D + (4 * g + hh) * 64 + d] = (bf16_t)f2bf(out); } }
    __syncthreads();
}

__device__ __forceinline__ void phase_attn_prompt(KP p, const Ctx& c, const int stop = 0) {
    const int Gd = gridDim.x, cb = blockIdx.x;
    for (int i = 0; i * Gd < 1024; ++i) { const int k = i * Gd + ((i & 1) ? Gd - 1 - cb : cb); if (k < 1024) attn_prompt_unit(p, c, k, stop); }
}
__device__ __forceinline__ void phase_attn_sample(KP p, const Ctx& c) {
    for (int it = blockIdx.x; it < SB * G; it += gridDim.x) attn_sample_unit(p, c, it);
}
#ifndef MK_MULTI
#define MK_MULTI 0
#endif
#if defined(PROBE_SCALE) || defined(SELFTEST)
constexpr int NPH = 46;
#elif defined(PROBE_ATTN2)
constexpr int NPH = 47;
#else
constexpr int NPH = 45;
#endif
#ifdef SPLITK
#define RESID_SPLIT(n) (n)
#else
#define RESID_SPLIT(n) 0
#endif

__global__ void __launch_bounds__(512, 2) mega(Params p) {
    extern __shared__ __attribute__((aligned(16))) unsigned char lds_raw[];
    LAS unsigned char* const lds0 = (LAS unsigned char*)lds_raw;
    volatile LAS unsigned* MISC = (volatile LAS unsigned*)(lds0 + MISC_OFF);
    for (int u = threadIdx.x; u < (LDS_BYTES - RING_BYTES) / 4; u += 512) ((LAS unsigned*)(lds0 + RING_BYTES))[u] = 0u;
    __syncthreads();
    const KP kp0 = (KP)__builtin_amdgcn_kernarg_segment_ptr();
    const int ph_lo = kp0->ph_lo, ph_hi = kp0->ph_hi, use_bar = kp0->use_bar;
    XcdBarrier bar; bar.bar = (unsigned*)(kp0->ws + WS_CTL); bar.x = 0; bar.st = nullptr;
    if (use_bar) bar = xcd_barrier_post((unsigned*)(kp0->ws + WS_CTL), MISC + 8);
    const int wave_s = __builtin_amdgcn_readfirstlane((int)threadIdx.x >> 6);
#define TID_MBCNT 1
#ifdef TID_MBCNT
#define TID_SRC(T_) asm volatile("v_mbcnt_lo_u32_b32 %0, -1, 0\n\tv_mbcnt_hi_u32_b32 %0, -1, %0" : "=v"(T_)); T_ += 64 * wave_s;
#else
#define TID_SRC(T_) T_ = threadIdx.x; asm volatile("" : "+v"(T_));
#endif
    int ph = 0;
#define PHASE_BEGIN if (ph >= ph_lo && ph < ph_hi) { KP p = kp0; asm volatile("" : "+s"(p)); int tid_; TID_SRC(tid_) \
        Ctx c; c.lds = lds0; c.tid = tid_; c.lane = tid_ & 63; c.wave = __builtin_amdgcn_readfirstlane(tid_ >> 6); c.gw = blockIdx.x * 8 + c.wave; c.ngw = gridDim.x * 8; c.gtid = blockIdx.x * 512 + tid_; c.gsz = gridDim.x * 512; \
        unsigned char* ws = p->ws; float* X = p->out + O_Y; (void)ws; (void)X;
#define PHASE_END   if (use_bar) { int te_; TID_SRC(te_) xcd_barrier(bar, te_ == 0); } } ++ph;

    PHASE_BEGIN phase_prologue(p, c); PHASE_END
#ifdef PROBE_BAR
    for (int xb = 0; xb < PROBE_BAR; ++xb) { if (use_bar) xcd_barrier(bar, threadIdx.x == 0); }
#endif

    for (int layer = 0; layer < NLAY; ++layer) {
        if (layer < 2) {
            const int li = layer;
            PHASE_BEGIN phase_mix(p, c, li); PHASE_END
            PHASE_BEGIN {
                pg8::Gemm g{(const bf16_t*)(ws + WS_XM), (const bf16_t*)(ws + WS_WRKV) + (size_t)li * 3072 * 1024, 3 * R, 3072, 1024, 1024};
                pg8::GroupOrder S; S.init((int)gridDim.x, (int)blockIdx.x); S.add(0, 0, 64, 0, 4); S.add(1, 66, 64, 4, 4); S.add(2, 132, 64, 8, 4);
                pg8::EpiF32G E{(float*)(ws + WS_RK_R), (float*)(ws + WS_RK_K), (float*)(ws + (li ? WS_V1 : WS_V0)), nullptr, D, 4, 66};
                pg8::gemm_phase<pg8::EpiF32G, pg8::GroupOrder, true, true>(c.lds, g, S, E, c.tid);
                {
                    const bf16_t* XMs = (const bf16_t*)(ws + WS_XM); const bf16_t* Wr = (const bf16_t*)(ws + WS_WRKV) + (size_t)li * 3072 * 1024;
                    for (int it = blockIdx.x + gridDim.x * c.wave; it < 768; it += c.ngw) { const int j = it >> 8, r = it & 255, row0 = MP + 32 * (r & 15), col0 = 64 * (r >> 4);
                        float* C = (float*)(ws + (j == 0 ? WS_RK_R : (j == 1 ? WS_RK_K : (li ? WS_V1 : WS_V0))));
                        f32x4 acc[4][2]; skinny_mma<4>(XMs + (size_t)j * R * D, 1024, Wr + (size_t)j * 1024 * 1024, 1024, 1024, row0, col0, c.lane, acc);
                        const int fr = c.lane & 15, fq = c.lane >> 4;
#pragma unroll
                        for (int nt = 0; nt < 4; ++nt)
#pragma unroll
                            for (int mt = 0; mt < 2; ++mt) *(f32x4*)(C + (size_t)(row0 + 16 * mt + fr) * D + col0 + 16 * nt + 4 * fq) = acc[nt][mt]; }
                }
                phase_lora1(p, c, li);
            } PHASE_END
            PHASE_BEGIN phase_scanA(p, c, li); PHASE_END
            PHASE_BEGIN phase_scanB(p, c, li); PHASE_END
            PHASE_BEGIN phase_scanC(p, c, li); PHASE_END
        } else {
            const int lb = layer - 2;
            if (layer == 2) {
                PHASE_BEGIN phase_norm(c, X, p->in[I_KVNG], (bf16_t*)(ws + WS_XN2), p->in[I_NORMG] + (size_t)(layer * 2) * D, (bf16_t*)(ws + WS_XN)); PHASE_END
                PHASE_BEGIN {
                    pg8::Gemm g{(const bf16_t*)(ws + WS_XN2), (const bf16_t*)(ws + WS_WKVT), R, NKV, 1024, 1024};
                    pg8::GroupOrder S; S.init((int)gridDim.x, (int)blockIdx.x); S.add(0, 0, 66, 0, 6);
                    pg8::EpiF32G E{(float*)(ws + WS_KVF), nullptr, nullptr, nullptr, NKV, 1 << 20, 0};
                    pg8::gemm_phase<pg8::EpiF32G, pg8::GroupOrder, true, true>(c.lds, g, S, E, c.tid);
                } PHASE_END
                PHASE_BEGIN phase_kvpost(p, c); PHASE_END
                PHASE_BEGIN {
                    pg8::Gemm g{(const bf16_t*)(ws + WS_CMPA), (const bf16_t*)(ws + WS_CW1T), (int)CMPA_ROWS, 512, 1024, 1024};
                    pg8::GroupOrder S; S.init((int)gridDim.x, (int)blockIdx.x); S.add(0, 0, 16, 0, 1); S.add(1, 16, 16, 1, 1); S.add(2, 32, 256, 0, 1); S.add(3, 288, 256, 1, 1);
                    pg8::EpiF32G E{(float*)(ws + WS_PCMP), (float*)(ws + WS_PCMP), nullptr, nullptr, 256, 1, 0};
                    pg8::gemm_phase<pg8::EpiF32G, pg8::GroupOrder, true, true>(c.lds, g, S, E, c.tid);
                } PHASE_END
                PHASE_BEGIN phase_cmp2(p, c); PHASE_END
            } else {
                PHASE_BEGIN phase_norm(c, X, p->in[I_NORMG] + (size_t)(layer * 2) * D, (bf16_t*)(ws + WS_XN), nullptr, nullptr); PHASE_END
            }
            PHASE_BEGIN {
                const bf16_t* XNp = (const bf16_t*)(ws + WS_XN); const bf16_t* Wq = (const bf16_t*)(ws + WS_WQT) + (size_t)lb * NQP * 1024; float* QFp = (float*)(ws + WS_QF);
                pg8::Gemm g{XNp, Wq, R, NQP, 1024, 1024};
                pg8::GroupOrder S; S.init((int)gridDim.x, (int)blockIdx.x); S.add(0, 0, 64, 0, 4);
                pg8::EpiF32G E{QFp, nullptr, nullptr, nullptr, NQP, 1 << 20, 0};
                pg8::gemm_phase<pg8::EpiF32G, pg8::GroupOrder, true, true>(c.lds, g, S, E, c.tid);
                float* GATEp = (float*)(ws + WS_GATE);
                for (int it = blockIdx.x + gridDim.x * c.wave; it < 256 + R / 32; it += c.ngw) { const int ln = launder_v(c.lane), fr = ln & 15, fq = ln >> 4;
                    if (it < 256) { const int row0 = MP + 32 * (it & 15), col0 = 64 * (it >> 4);
                        f32x4 acc[4][2]; skinny_mma<4>(XNp, 1024, Wq, 1024, 1024, row0, col0, ln, acc);
#pragma unroll
                        for (int nt = 0; nt < 4; ++nt)
#pragma unroll
                            for (int mt = 0; mt < 2; ++mt) *(f32x4*)(QFp + (size_t)(row0 + 16 * mt + fr) * NQP + col0 + 16 * nt + 4 * fq) = acc[nt][mt]; }
                    else { const int row0 = 32 * (it - 256);
                        f32x4 acc[3][2]; skinny_mma<3>(XNp, 1024, Wq, 1024, 1024, row0, 1024, ln, acc);
#pragma unroll
                        for (int nt = 0; nt < 3; ++nt)
#pragma unroll
                            for (int mt = 0; mt < 2; ++mt) { f32x4 v = acc[nt][mt];
#pragma unroll
                                for (int e = 0; e < 4; ++e) v[e] = sigmoidf_(v[e]);
                                *(f32x4*)(GATEp + (size_t)(row0 + 16 * mt + fr) * 48 + 16 * nt + 4 * fq) = v; } }
                }
            } PHASE_END
            PHASE_BEGIN phase_qpost(p, c, lb); PHASE_END
            PHASE_BEGIN phase_attn_prompt(p, c); PHASE_END
#ifdef PROBE_ATTN2
            PHASE_BEGIN phase_attn_prompt(p, c, PROBE_ATTN2); PHASE_END
#endif
            PHASE_BEGIN phase_attn_sample(p, c); PHASE_END
        }
        PHASE_BEGIN {
            const bf16_t* Wt = layer < 2 ? (const bf16_t*)(ws + WS_WORW) + (size_t)layer * 1024 * 1024 : (const bf16_t*)(ws + WS_WONSA) + (size_t)(layer - 2) * 1024 * 1024;
            pg8::Gemm g{(const bf16_t*)(ws + WS_YG), Wt, R, 1024, 1024, 1024};
            pg8::GroupOrder S; S.init((int)gridDim.x, (int)blockIdx.x); S.add(0, 0, 64, 0, 4);
            pg8::EpiResid E{X, D};
            pg8::gemm_phase<pg8::EpiResid, pg8::GroupOrder, true, true>(c.lds, g, S, E, c.tid);
            skinny_resid_sample(c, (const bf16_t*)(ws + WS_YG), 1024, Wt, 1024, X);
        } PHASE_END
        PHASE_BEGIN phase_norm(c, X, p->in[I_NORMG] + (size_t)(layer * 2 + 1) * D, (bf16_t*)(ws + WS_XN), nullptr, nullptr); PHASE_END
        PHASE_BEGIN {
            pg8::Gemm g{(const bf16_t*)(ws + WS_XN), (const bf16_t*)(ws + WS_WINT) + (size_t)layer * 5632 * 1024, R, 5632, 1024, 1024};
            pg8::GroupOrder S; S.init((int)gridDim.x, (int)blockIdx.x); S.add(0, 0, 66, 0, 22);
            pg8::EpiWin E{(bf16_t*)(ws + WS_U), (bf16_t*)(ws + WS_GT), p->out + O_CVP + (size_t)layer * NB * 2 * DFF, p->out + O_CVS + (size_t)layer * SB * 2 * DFF};
            pg8::gemm_phase<pg8::EpiWin, pg8::GroupOrder, true, true>(c.lds, g, S, E, c.tid);
        } PHASE_END
        PHASE_BEGIN phase_conv(p, c, layer); PHASE_END
        PHASE_BEGIN {
            pg8::Gemm g{(const bf16_t*)(ws + WS_HH), (const bf16_t*)(ws + WS_WOUTT) + (size_t)layer * 1024 * 2816, R, 1024, 2816, 2816};
            pg8::GroupOrder S; S.init((int)gridDim.x, (int)blockIdx.x); S.add(0, 0, 64, 0, 4);
            pg8::EpiResid E{X, D};
            pg8::gemm_phase<pg8::EpiResid, pg8::GroupOrder, true, true>(c.lds, g, S, E, c.tid);
            skinny_resid_sample(c, (const bf16_t*)(ws + WS_HH), 2816, (const bf16_t*)(ws + WS_WOUTT) + (size_t)layer * 1024 * 2816, 2816, X);
        } PHASE_END
    }
#ifdef SELFTEST
    PHASE_BEGIN if (blockIdx.x == 0 && c.wave == 0) { const float x = (float)((c.lane * 37) & 63) + 1.0f; float poison = 0.f;
        if (__ballot(swz_xor16_n(x) != __shfl_xor(x, 16))) poison += 1e3f;
        if (__ballot(sum_xor32_n(x) != x + __shfl_xor(x, 32))) poison += 1e4f;
        if (__ballot(sum_rows4_n(x) != x + __shfl_xor(x, 16) + __shfl_xor(x, 32) + __shfl_xor(x, 48))) poison += 1e5f;
        if (__ballot(wave_sum_n(x) != 2080.0f)) poison += 1e6f;
        if (__ballot(wave_max_n(x) != 64.0f)) poison += 1e7f;
        if (c.lane == 0) p->out[O_CVS] += poison; } PHASE_END
#endif
#ifdef PROBE_SCALE
    PHASE_BEGIN for (size_t e = c.gtid; e < O_END; e += c.gsz) { int oi = e < O_KV ? (e < (size_t)MP * D ? 0 : 1) : e < O_WINP ? (e < O_KV + (size_t)MP * D ? 2 : 3) : e < O_WINS ? 4 : e < O_WKVP ? 5 : e < O_WKVS ? 6 : e < O_SHP ? 7 : e < O_SHS ? 8 : e < O_CVP ? 9 : e < O_CVS ? 10 : 11;
        if (PROBE_SCALE < 0) oi = 11 - oi; p->out[e] *= 1.0f + sqrtf(0.5e-4f * (float)(oi + 1)); } PHASE_END
#endif
#undef PHASE_BEGIN
#undef PHASE_END
}

extern "C" void kernel_launch(void* const* d_in, const int* in_sizes, int n_in, void* d_out, int out_size, void* d_ws, size_t ws_size, hipStream_t stream) {
    static int grid = 0;
    if (grid == 0) {
        if (n_in != 45 || (size_t)out_size != O_END || ws_size < WS_END) { fprintf(stderr, "kernel_launch: unexpected shapes (n_in %d out %d ws %zu need %zu)\n", n_in, out_size, ws_size, (size_t)WS_END); grid = -1; return; }
        int dev = 0, cus = 0, per_cu = 0;
        if (hipGetDevice(&dev) != hipSuccess || hipDeviceGetAttribute(&cus, hipDeviceAttributeMultiprocessorCount, dev) != hipSuccess) { grid = -1; return; }
        if (hipFuncSetAttribute((const void*)mega, hipFuncAttributeMaxDynamicSharedMemorySize, LDS_BYTES) != hipSuccess) { fprintf(stderr, "kernel_launch: hipFuncSetAttribute failed\n"); grid = -1; return; }
        if (hipOccupancyMaxActiveBlocksPerMultiprocessor(&per_cu, (const void*)mega, 512, LDS_BYTES) != hipSuccess || per_cu < 1) { fprintf(stderr, "kernel_launch: occupancy query says %d\n", per_cu); (void)hipGetLastError(); }
        grid = cus;
    }
    if (grid < 0) return;
    (void)hipMemsetAsync((char*)d_ws + WS_CTL, 0, CTL_BYTES, stream);
    Params p{};
    for (int i = 0; i < 45; ++i) p.in[i] = (const float*)d_in[i];
    p.out = (float*)d_out; p.ws = (unsigned char*)d_ws;
#ifdef PROBE_PRE
    { const int plist[] = PROBE_PRE; for (int i = 0; i < (int)(sizeof(plist) / sizeof(int)); ++i) { p.ph_lo = plist[i] % 100; p.ph_hi = p.ph_lo + 1; p.use_bar = 0; p.pad = plist[i] / 100;       hipLaunchKernelGGL(mega, dim3(grid), dim3(512), LDS_BYTES, stream, p); } }
#endif
    p.pad = 0;
#if MK_MULTI
    for (int i = 0; i < NPH; ++i) { p.ph_lo = i; p.ph_hi = i + 1; p.use_bar = 0; hipLaunchKernelGGL(mega, dim3(grid), dim3(512), LDS_BYTES, stream, p); }
#else
    p.ph_lo = 0; p.ph_hi = NPH; p.use_bar = 1;
    hipLaunchKernelGGL(mega, dim3(grid), dim3(512), LDS_BYTES, stream, p);
#endif
    const hipError_t le = hipPeekAtLastError();
    if (le != hipSuccess) fprintf(stderr, "kernel_launch: launch failed: %s\n", hipGetErrorName(le));
}
```

```cpp
#include <hip/hip_runtime.h>
#include <cstdio>
#include <cstdint>

#define LAS __attribute__((address_space(3)))
#define GAS __attribute__((address_space(1)))
typedef unsigned short bf16_t;
typedef short bf16x8 __attribute__((ext_vector_type(8)));
typedef float f32x4 __attribute__((ext_vector_type(4)));
typedef float f32x16 __attribute__((ext_vector_type(16)));
typedef float f32x2 __attribute__((ext_vector_type(2)));
typedef unsigned u32x4 __attribute__((ext_vector_type(4)));
typedef unsigned u32x2 __attribute__((ext_vector_type(2)));

constexpr int D = 1024, NB = 2, TP = 8192, MP = NB * TP, SB = 128, ST = 4, MS = SB * ST, R = MP + MS;
constexpr int PAST = 2048, PAGE = 128, NPAGES = PAST / PAGE;
constexpr int H = 16, HD = 64, G = 4, HPG = 4, DFF = 2816, NLAY = 4;
constexpr int LW_ = 64, LA_ = 64, LV_ = 32, LG_ = 128, LHID = 288;
constexpr int NKV = 1536, NQ = 1072, NQP = 1280;
constexpr int NCH = TP / 64;
constexpr int NUNIT_A = NB * NCH * H;
constexpr int NCMP_P = 511, NCMP_S = 127, WIN = 512;
constexpr float NORM_EPS = 1e-6f, GN_EPS = 64e-5f;

constexpr size_t O_Y = 0;
constexpr size_t O_KV = (size_t)R * D;
constexpr size_t O_WINP = O_KV + (size_t)R * D;
constexpr size_t O_WINS = O_WINP + (size_t)NB * 512 * 512;
constexpr size_t O_WKVP = O_WINS + (size_t)SB * 512 * 512;
constexpr size_t O_WKVS = O_WKVP + (size_t)2 * NB * H * 4096;
constexpr size_t O_SHP = O_WKVS + (size_t)2 * SB * H * 4096;
constexpr size_t O_SHS = O_SHP + (size_t)2 * NB * D;
constexpr size_t O_CVP = O_SHS + (size_t)2 * SB * D;
constexpr size_t O_CVS = O_CVP + (size_t)NLAY * NB * 2 * DFF;
constexpr size_t O_END = O_CVS + (size_t)NLAY * SB * 2 * DFF;
static_assert(O_END == 88915968, "output size");

constexpr size_t MiB = 1u << 20;
constexpr size_t al(size_t x) { return (x + 4095) & ~(size_t)4095; }
constexpr size_t WS_CTL = 0, CTL_BYTES = 1 * MiB;
constexpr size_t WS_WRKV = WS_CTL + CTL_BYTES;
constexpr size_t WS_WORW = WS_WRKV + al((size_t)2 * 3072 * 1024 * 2);
constexpr size_t WS_W1T = WS_WORW + al((size_t)2 * 1024 * 1024 * 2);
constexpr size_t WS_W2W = WS_W1T + al((size_t)2 * 288 * 1024 * 2);
constexpr size_t WS_W2A = WS_W2W + al((size_t)2 * 1024 * 64 * 2);
constexpr size_t WS_W2V = WS_W2A + al((size_t)2 * 1024 * 64 * 2);
constexpr size_t WS_W2G = WS_W2V + al((size_t)1024 * 32 * 2);
constexpr size_t WS_WKVT = WS_W2G + al((size_t)2 * 1024 * 128 * 2);
constexpr size_t WS_WQT = WS_WKVT + al((size_t)1536 * 1024 * 2);
constexpr size_t WS_WONSA = WS_WQT + al((size_t)2 * 1280 * 1024 * 2);
constexpr size_t WS_WINT = WS_WONSA + al((size_t)2 * 1024 * 1024 * 2);
constexpr size_t WS_WOUTT = WS_WINT + al((size_t)4 * 5632 * 1024 * 2);
constexpr size_t WS_CW1T = WS_WOUTT + al((size_t)4 * 1024 * 2816 * 2);
constexpr size_t WS_CBIAS = WS_CW1T + al((size_t)2 * 256 * 1024 * 2);
constexpr size_t WS_CW2T = WS_CBIAS + al(2 * 128 * 4);
constexpr size_t WS_XM = WS_CW2T + al(2 * 2 * 64 * 128 * 2);
constexpr size_t WS_RK_R = WS_XM + al((size_t)6 * R * D * 2);
constexpr size_t WS_RK_K = WS_RK_R + al((size_t)R * D * 4);
constexpr size_t WS_V0 = WS_RK_K + al((size_t)R * D * 4);
constexpr size_t WS_V1 = WS_V0 + al((size_t)R * D * 4);
constexpr size_t WS_HID = WS_V1 + al((size_t)R * D * 4);
constexpr size_t WS_MT = WS_HID + al((size_t)R * LHID * 2);
constexpr size_t WS_NN = WS_MT + al((size_t)NUNIT_A * 4096 * 4);
constexpr size_t WS_RP = WS_NN + al((size_t)NUNIT_A * 4096 * 4);
constexpr size_t WS_YL = WS_RP + al((size_t)NUNIT_A * 4096 * 2);
constexpr size_t WS_S0 = WS_YL + al((size_t)NUNIT_A * 4096 * 4);
constexpr size_t WS_RKS = WS_S0 + al((size_t)NUNIT_A * 4096 * 2);
constexpr size_t WS_YG = WS_RKS + al((size_t)R * 16 * 4);
constexpr size_t WS_XN = WS_YG + al((size_t)R * D * 2);
constexpr size_t WS_XN2 = WS_XN + al((size_t)R * D * 2);
constexpr size_t WS_U = WS_XN2 + al((size_t)R * D * 2);
constexpr size_t WS_GT = WS_U + al((size_t)R * DFF * 2);
constexpr size_t WS_HH = WS_GT + al((size_t)R * DFF * 2);
constexpr size_t WS_KVF = WS_HH + al((size_t)R * DFF * 2);
constexpr size_t WS_CMPA = WS_KVF + al((size_t)R * NKV * 4);
constexpr size_t CMPA_ROWS = 4096 + 4096 + 65536 + 65536;
constexpr size_t WS_PCMP = WS_CMPA + al(CMPA_ROWS * 1024 * 2);
constexpr size_t WS_KS = WS_PCMP + al(CMPA_ROWS * 256 * 4);
constexpr size_t WS_VS = WS_KS + al((size_t)NB * G * TP * 64 * 2);
constexpr size_t WS_KW = WS_VS + al((size_t)NB * G * TP * 64 * 2);
constexpr size_t WS_VW = WS_KW + al((size_t)NB * G * TP * 64 * 2);
constexpr size_t WS_CK = WS_VW + al((size_t)NB * G * TP * 64 * 2);
constexpr size_t WS_CV = WS_CK + al((size_t)NB * G * 512 * 64 * 2);
constexpr size_t WS_CKS = WS_CV + al((size_t)NB * G * 512 * 64 * 2);
constexpr size_t WS_CVS = WS_CKS + al((size_t)SB * G * 128 * 64 * 4);
constexpr size_t WS_QF = WS_CVS + al((size_t)SB * G * 128 * 64 * 4);
constexpr size_t WS_Q = WS_QF + al((size_t)R * NQP * 4);
constexpr size_t WS_GATE = WS_Q + al((size_t)R * D * 2);
constexpr size_t WS_END = WS_GATE + al((size_t)R * 48 * 4);

typedef __bf16 bf16v2_ __attribute__((ext_vector_type(2)));
__device__ __forceinline__ unsigned cvt_pk_bf16_(float lo, float hi) { const f32x2 v = {lo, hi}; const bf16v2_ b = __builtin_convertvector(v, bf16v2_); return __builtin_bit_cast(unsigned, b); }
__device__ __forceinline__ unsigned f2bf(float f) { return cvt_pk_bf16_(f, f) & 0xffffu; }
__device__ __forceinline__ unsigned pk2(float lo, float hi) { return cvt_pk_bf16_(lo, hi); }
__device__ __forceinline__ float frcp(float x) { return __builtin_amdgcn_rcpf(x); }
__device__ __forceinline__ float frsq(float x) { return __builtin_amdgcn_rsqf(x); }
__device__ __forceinline__ float bf2f(unsigned short b) { return __builtin_bit_cast(float, ((unsigned)b) << 16); }
__device__ __forceinline__ float bflo(unsigned w) { return __builtin_bit_cast(float, w << 16); }
__device__ __forceinline__ float bfhi(unsigned w) { return __builtin_bit_cast(float, w & 0xffff0000u); }
template <int CTRL> __device__ __forceinline__ float dpp_f(float x) { return __builtin_bit_cast(float, __builtin_amdgcn_update_dpp(0, __builtin_bit_cast(int, x), CTRL, 0xF, 0xF, true)); }
__device__ __forceinline__ float row16_sum(float v) { v += dpp_f<0xB1>(v); v += dpp_f<0x4E>(v); v += dpp_f<0x141>(v); v += dpp_f<0x140>(v); return v; }
__device__ __forceinline__ float row16_max(float v) { v = fmaxf(v, dpp_f<0xB1>(v)); v = fmaxf(v, dpp_f<0x4E>(v)); v = fmaxf(v, dpp_f<0x141>(v)); v = fmaxf(v, dpp_f<0x140>(v)); return v; }
__device__ __forceinline__ float swz_xor16_n(float x) { return __builtin_bit_cast(float, __builtin_amdgcn_ds_swizzle(__builtin_bit_cast(int, x), 0x401F)); }
__device__ __forceinline__ float sum_xor32_n(float x) { auto rr = __builtin_amdgcn_permlane32_swap(__float_as_uint(x), __float_as_uint(x), false, false);
    return __uint_as_float(rr[0]) + __uint_as_float(rr[1]); }
__device__ __forceinline__ float sum_rows4_n(float x) { x += swz_xor16_n(x); return sum_xor32_n(x); }
__device__ __forceinline__ float wave_sum_n(float v) {
    v = row16_sum(v);
    v += __builtin_bit_cast(float, __builtin_amdgcn_update_dpp(0, __builtin_bit_cast(int, v), 0x142, 0xA, 0xF, false));
    v += __builtin_bit_cast(float, __builtin_amdgcn_update_dpp(0, __builtin_bit_cast(int, v), 0x143, 0xC, 0xF, false));
    return __builtin_bit_cast(float, __builtin_amdgcn_readlane(__builtin_bit_cast(int, v), 63));
}
__device__ __forceinline__ float wave_max_n(float v) {
    v = row16_max(v);
    v = fmaxf(v, __builtin_bit_cast(float, __builtin_amdgcn_update_dpp(__builtin_bit_cast(int, v), __builtin_bit_cast(int, v), 0x142, 0xA, 0xF, false)));
    v = fmaxf(v, __builtin_bit_cast(float, __builtin_amdgcn_update_dpp(__builtin_bit_cast(int, v), __builtin_bit_cast(int, v), 0x143, 0xC, 0xF, false)));
    return __builtin_bit_cast(float, __builtin_amdgcn_readlane(__builtin_bit_cast(int, v), 63));
}
#define XLANE_NEW 1
#ifdef XLANE_NEW
__device__ __forceinline__ float swz_xor16(float x) { return __builtin_bit_cast(float, __builtin_amdgcn_ds_swizzle(__builtin_bit_cast(int, x), 0x401F)); }
__device__ __forceinline__ float sum_xor32(float x) { return sum_xor32_n(x); }
__device__ __forceinline__ float sum_rows4(float x) { x += swz_xor16(x); return sum_xor32(x); }
__device__ __forceinline__ float wave_sum(float v) {
    v = row16_sum(v);
    v += __builtin_bit_cast(float, __builtin_amdgcn_update_dpp(0, __builtin_bit_cast(int, v), 0x142, 0xA, 0xF, false));
    v += __builtin_bit_cast(float, __builtin_amdgcn_update_dpp(0, __builtin_bit_cast(int, v), 0x143, 0xC, 0xF, false));
    return __builtin_bit_cast(float, __builtin_amdgcn_readlane(__builtin_bit_cast(int, v), 63));
}
__device__ __forceinline__ float wave_max(float v) {
    v = row16_max(v);
    v = fmaxf(v, __builtin_bit_cast(float, __builtin_amdgcn_update_dpp(__builtin_bit_cast(int, v), __builtin_bit_cast(int, v), 0x142, 0xA, 0xF, false)));
    v = fmaxf(v, __builtin_bit_cast(float, __builtin_amdgcn_update_dpp(__builtin_bit_cast(int, v), __builtin_bit_cast(int, v), 0x143, 0xC, 0xF, false)));
    return __builtin_bit_cast(float, __builtin_amdgcn_readlane(__builtin_bit_cast(int, v), 63));
}
#else
__device__ __forceinline__ float sum_xor32(float x) { return x + __shfl_xor(x, 32); }
__device__ __forceinline__ float sum_rows4(float x) { x += __shfl_xor(x, 16); x += __shfl_xor(x, 32); return x; }
__device__ __forceinline__ float wave_sum(float v) { v = row16_sum(v); v += __shfl_xor(v, 16); v += __shfl_xor(v, 32); return v; }
__device__ __forceinline__ float wave_max(float v) { v = row16_max(v); v = fmaxf(v, __shfl_xor(v, 16)); v = fmaxf(v, __shfl_xor(v, 32)); return v; }
#endif
__device__ __forceinline__ float sigmoidf_(float x) { return frcp(1.0f + __builtin_amdgcn_exp2f(-1.4426950408889634f * x)); }
__device__ __forceinline__ float gelu_tanh(float x) {
    const float u = 0.7978845608028654f * (x + 0.044715f * x * x * x);
    const float e = __builtin_amdgcn_exp2f(2.8853900817779268f * u);
    const float th = 1.0f - 2.0f * frcp(e + 1.0f);
    return 0.5f * x * (1.0f + th);
}
template <class T> __device__ __forceinline__ const T* launder_p(const T* q) { asm volatile("" : "+v"(q)); return q; }
__device__ __forceinline__ int launder_v(int x) { asm volatile("" : "+v"(x)); return x; }
#define LDS_WAIT() asm volatile("s_waitcnt lgkmcnt(0)" ::: "memory")
#define VM_WAIT() asm volatile("s_waitcnt vmcnt(0)" ::: "memory")
__device__ __forceinline__ f32x4 mfma16(bf16x8 a, bf16x8 b, f32x4 c) { return __builtin_amdgcn_mfma_f32_16x16x32_bf16(a, b, c, 0, 0, 0); }
__device__ __forceinline__ f32x16 mfma32(bf16x8 a, bf16x8 b, f32x16 c) { return __builtin_amdgcn_mfma_f32_32x32x16_bf16(a, b, c, 0, 0, 0); }
#define XB_TMO      128
#define XB_XCNT(j)  (256  + 64 * (j))
#define XB_XSUB(j)  (1280 + 64 * (j))
#define XB_XGEN(j)  (2304 + 64 * (j))
#define XB_TOP      3328
#define XB_TOPGEN   3392
#define XCD_BAR_WORDS 3456
#define XB_SPIN_CAP (1u << 18)

__device__ __forceinline__ unsigned xb_ld(unsigned* p)              { return __hip_atomic_load(p, __ATOMIC_RELAXED, __HIP_MEMORY_SCOPE_AGENT); }
__device__ __forceinline__ unsigned xb_add(unsigned* p, unsigned v) { return __hip_atomic_fetch_add(p, v, __ATOMIC_RELAXED, __HIP_MEMORY_SCOPE_AGENT); }
__device__ __forceinline__ unsigned xb_xcc_id() { return (unsigned)__builtin_amdgcn_s_getreg((3 << 11) | 20) & 0xFu; }
#define XB_SPIN(cond, bar) do { unsigned _sp = 0; while (cond) { __builtin_amdgcn_s_sleep(1); \
    if ((++_sp & 255u) == 0u) { if (xb_ld(&(bar)[XB_TMO])) break; if (_sp > XB_SPIN_CAP) { atomicAdd(&(bar)[XB_TMO], 1u); break; } } } } while (0)

struct XcdBarrier {
    unsigned* bar; unsigned x;
    volatile LAS unsigned* st;
};

__device__ __forceinline__ XcdBarrier xcd_barrier_post(unsigned* bar, volatile LAS unsigned* st) {
    XcdBarrier b; b.bar = bar; b.x = xb_xcc_id(); b.st = st;
    if (threadIdx.x == 0) (void)xb_add(&bar[XB_XCNT(b.x)], 1u);
    return b;
}
__device__ __forceinline__ void xcd_barrier_complete(unsigned* bar, unsigned x, unsigned& nloc, unsigned& nx) {
    const unsigned G = gridDim.x * gridDim.y * gridDim.z;
    unsigned sum, cnt, mine, sp = 0u;
    for (;;) {
        sum = 0u; cnt = 0u; mine = 0u;
#pragma unroll
        for (unsigned j = 0; j < 16; ++j) { const unsigned c = xb_ld(&bar[XB_XCNT(j)]); sum += c; cnt += (c > 0u) ? 1u : 0u; mine = (j == x) ? c : mine; }
        if (sum == G) break;
        __builtin_amdgcn_s_sleep(1);
        if ((++sp & 255u) == 0u) { if (xb_ld(&bar[XB_TMO])) break; if (sp > XB_SPIN_CAP) { atomicAdd(&bar[XB_TMO], 1u); break; } }
    }
    nloc = mine > 0u ? mine : 1u; nx = cnt > 0u ? cnt : 1u;
}

__device__ __forceinline__ void xcd_barrier(const XcdBarrier& b, const bool t0) {
    asm volatile("s_waitcnt vmcnt(0)" ::: "memory");
    __syncthreads();
    if (t0) {
        unsigned* bar = b.bar;
        __builtin_amdgcn_s_waitcnt(0);
        unsigned nloc = b.st[0], nx = b.st[1];
        if (nloc == 0u) { xcd_barrier_complete(bar, b.x, nloc, nx); b.st[0] = nloc; b.st[1] = nx; }
        const unsigned old = xb_add(&bar[XB_XSUB(b.x)], 1u);
        const unsigned gen = old / nloc;
        if (old + 1u == (gen + 1u) * nloc) {
            __builtin_amdgcn_fence(__ATOMIC_RELEASE, "agent");
            asm volatile("s_waitcnt vmcnt(0)" ::: "memory");
            const unsigned og = xb_add(&bar[XB_TOP], 1u);
            const unsigned tg = og / nx;
            if (og + 1u == (tg + 1u) * nx) xb_add(&bar[XB_TOPGEN], 1u);
            else XB_SPIN(xb_ld(&bar[XB_TOPGEN]) == tg, bar);
            __builtin_amdgcn_fence(__ATOMIC_ACQUIRE, "agent");
            xb_add(&bar[XB_XGEN(b.x)], 1u);
            asm volatile("s_waitcnt vmcnt(0)" ::: "memory");
        } else {
            XB_SPIN(xb_ld(&bar[XB_XGEN(b.x)]) == gen, bar);
            __builtin_amdgcn_fence(__ATOMIC_ACQUIRE, "agent");
            asm volatile("s_waitcnt vmcnt(0)" ::: "memory");
        }
    }
    __syncthreads();
}

namespace pg8 {
#define PG8_LAS __attribute__((address_space(3)))
constexpr int BM = 256, BK = 64, HALF = 128, HTB = HALF * BK * 2  , STAGE_BYTES = 8 * HTB, NXCD = 8, WGM = 8;
__host__ __device__ __forceinline__ int lds_byte(int r, int c) { const int st = (r >> 4) * 2 + (c >> 5), rr = r & 15, cc = c & 31, ob = rr * 64 + cc * 2; return st * 1024 + (ob ^ (((ob >> 9) & 1) << 5)); }
__host__ __device__ __forceinline__ void stage_rc(int b, int& R_, int& C_) { const int st = b / 1024, sb = b % 1024, swz = sb ^ (((sb >> 9) & 1) << 5); R_ = (st >> 1) * 16 + swz / 64; C_ = (st & 1) * 32 + (swz % 64) / 2; }
__host__ __device__ __forceinline__ int perm32(int rho) { const int n = rho >> 4, i = rho & 15; return 8 * (i >> 2) + 4 * n + (i & 3); }

struct Unit { int pm, pn, kb, nt; };
struct Gemm { const bf16_t* A; const bf16_t* Bt; int M, N, K, KL; };

struct GroupOrder {
    int pm0[4], nM[4], pn0[4], nN[4]; int nseg, nwg, G_, c;
    __device__ __forceinline__ void init(int G__, int c_) { nseg = 0; nwg = 0; G_ = G__; c = c_;
#pragma unroll
        for (int s = 0; s < 4; ++s) { pm0[s] = 0; nM[s] = 0; pn0[s] = 0; nN[s] = 1; } }
    __device__ __forceinline__ void add(int s, int pm0_, int nM_, int pn0_, int nN_) { pm0[s] = pm0_; nM[s] = nM_; pn0[s] = pn0_; nN[s] = nN_; nwg += nM_ * nN_; nseg = s + 1; }
    __device__ __forceinline__ bool next(int i, Unit& u) const {
        const long L = (long)i * G_ + c; if (L >= nwg) return false;
        int id = (int)L; { const int q = nwg / NXCD, r = nwg % NXCD, xcd = id % NXCD, off = id / NXCD; id = (xcd < r ? xcd * (q + 1) : r * (q + 1) + (xcd - r) * q) + off; }
        int spm0 = 0, snM = 1, spn0 = 0, snN = 1; bool found = false;
#pragma unroll
        for (int s = 0; s < 4; ++s) { const int cnt = nM[s] * nN[s]; if (!found) { if (id < cnt) { found = true; spm0 = pm0[s]; snM = nM[s]; spn0 = pn0[s]; snN = nN[s]; } else id -= cnt; } }
        const int nig = WGM * snN, gid = id / nig, fm = gid * WGM, gsz = (snM - fm) < WGM ? (snM - fm) : WGM;
        u.pm = spm0 + fm + ((id % nig) % gsz); u.pn = spn0 + (id % nig) / gsz; u.kb = 0; u.nt = 0; return true;
    }
    __device__ __forceinline__ void a_ready(const Unit&) const {}
    __device__ __forceinline__ void done(const Unit&) const {}
};

struct ResidOrder {
    GroupOrder P; int nS, G_, c;
    __device__ __forceinline__ void init(int G__, int c_, int nS_) { P.init(G__, c_); P.add(0, 0, nS_ ? 64 : 66, 0, 4); nS = nS_; G_ = G__; c = c_; }
    __device__ __forceinline__ bool next(int i, Unit& u) const {
        const int npc = c < P.nwg ? (P.nwg - 1 - c) / G_ + 1 : 0;
        if (i < npc) return P.next(i, u);
        const int L = (i - npc) * G_ + (G_ - 1 - c); if (L >= 8 * nS) return false;
        const int sl = L >> 3, t = L & 7; u.pm = 64 + (t & 1); u.pn = t >> 1; u.kb = sl * 512; u.nt = 4; return true; }
    __device__ __forceinline__ void a_ready(const Unit&) const {}
    __device__ __forceinline__ void done(const Unit&) const {}
};
__device__ __forceinline__ unsigned cvt_pk_bf16(float lo, float hi) { return cvt_pk_bf16_(lo, hi); }

struct EpiF32G {
    static constexpr bool PERM = false, AFTER_DRAIN = false;
    float* b0; float* b1; float* b2; float* b3; int ldc, png, pmg;
    __device__ __forceinline__ void operator()(const f32x4 (&acc)[2][2][4][2], const Unit& u, int wr, int wc, int fr, int fq) const {
        const int j = u.pn / png; float* C = j == 0 ? b0 : (j == 1 ? b1 : (j == 2 ? b2 : b3));
        const int row0 = (u.pm - j * pmg) * BM + wr * 64 + fr, col0 = (u.pn - j * png) * BM + wc * 32 + 4 * fq;
#pragma unroll
        for (int ai = 0; ai < 2; ++ai)
#pragma unroll
            for (int m = 0; m < 4; ++m) { float* rowp = C + (size_t)(row0 + ai * HALF + m * 16) * ldc + col0;
#pragma unroll
                for (int bj = 0; bj < 2; ++bj)
#pragma unroll
                    for (int n = 0; n < 2; ++n) *(f32x4*)(rowp + bj * HALF + n * 16) = acc[ai][bj][m][n]; }
    }
};
struct EpiResid {
    static constexpr bool PERM = false, AFTER_DRAIN = false;
    float* X; int ldc;
    __device__ __forceinline__ void operator()(const f32x4 (&acc)[2][2][4][2], const Unit& u, int wr, int wc, int fr, int fq) const {
        const int row0 = u.pm * BM + wr * 64 + fr, col0 = u.pn * BM + wc * 32 + 4 * fq; const bool split = u.nt != 0;
#pragma unroll
        for (int ai = 0; ai < 2; ++ai)
#pragma unroll
            for (int m = 0; m < 4; ++m) { float* rowp = X + (size_t)(row0 + ai * HALF + m * 16) * ldc + col0;
                if (!split) {
#pragma unroll
                    for (int bj = 0; bj < 2; ++bj)
#pragma unroll
                        for (int n = 0; n < 2; ++n) { f32x4* p = (f32x4*)(rowp + bj * HALF + n * 16); *p = *p + acc[ai][bj][m][n]; } }
                else {
#pragma unroll
                    for (int bj = 0; bj < 2; ++bj)
#pragma unroll
                        for (int n = 0; n < 2; ++n) { float* q = rowp + bj * HALF + n * 16;
#pragma unroll
                            for (int e = 0; e < 4; ++e) __hip_atomic_fetch_add(q + e, acc[ai][bj][m][n][e], __ATOMIC_RELAXED, __HIP_MEMORY_SCOPE_AGENT); } }
                asm volatile("" ::: "memory"); }
    }
};
struct EpiWin {
    static constexpr bool PERM = true, AFTER_DRAIN = false;
    bf16_t* U; bf16_t* GT; float* cvp; float* cvs;
    __device__ __forceinline__ void operator()(const f32x4 (&acc)[2][2][4][2], const Unit& u, int wr, int wc, int fr, int fq) const {
        const bool isu = u.pn < 11; bf16_t* base = isu ? U : GT; const int colt = (isu ? u.pn : u.pn - 11) * BM;
        const int row0 = u.pm * BM + wr * 64 + fr, col0 = colt + wc * 32 + 8 * fq;
#pragma unroll
        for (int ai = 0; ai < 2; ++ai)
#pragma unroll
            for (int m = 0; m < 4; ++m) { const int row = row0 + ai * HALF + m * 16; bf16_t* rowp = base + (size_t)row * DFF + col0;
                float* cv = nullptr;
                if (isu) { if (row >= MP) { const int t = (row - MP) & 3, b = (row - MP) >> 2; if (t >= 2) cv = cvs + (size_t)(b * 2 + (t - 2)) * DFF; }
                           else { const int tt = row & (TP - 1); if (tt >= TP - 2) cv = cvp + (size_t)((row >> 13) * 2 + (tt - (TP - 2))) * DFF; } }
#pragma unroll
                for (int bj = 0; bj < 2; ++bj) { const f32x4 v0 = acc[ai][bj][m][0], v1 = acc[ai][bj][m][1];
                    u32x4 w; w.x = cvt_pk_bf16(v0[0], v0[1]); w.y = cvt_pk_bf16(v0[2], v0[3]); w.z = cvt_pk_bf16(v1[0], v1[1]); w.w = cvt_pk_bf16(v1[2], v1[3]);
                    *(u32x4*)(rowp + bj * HALF) = w;
                    if (cv) { *(f32x4*)(cv + col0 + bj * HALF) = v0; *(f32x4*)(cv + col0 + bj * HALF + 4) = v1; } } }
    }
};
template <class Epi, class Sched, bool ALIGN_EPI = false, bool SP2 = false>
__device__ __forceinline__ void gemm_phase(PG8_LAS unsigned char* lds, const Gemm g, const Sched& S, const Epi& E, int tid_in) {
    int tid_l = tid_in; asm volatile("" : "+v"(tid_l));
    const int tid = tid_l, wid = __builtin_amdgcn_readfirstlane(tid >> 6), lane = tid & 63, wr = wid >> 2, wc = wid & 3, fr = lane & 15, fq = lane >> 4;
    const int K = g.K, nt = g.KL / BK;
    unsigned voffA[2], voffB[2];
#pragma unroll
    for (int i = 0; i < 2; ++i) { int R, C; stage_rc(tid * 16 + i * 8192, R, C); const int Rb = Epi::PERM ? ((R & ~31) + perm32(R & 31)) : R;
        voffA[i] = (unsigned)(R * K + C) * 2u; voffB[i] = (unsigned)(Rb * K + C) * 2u; }
    const size_t kstep = (size_t)(BK * 2);
    const size_t hstep = (size_t)HALF * K * 2;
    const size_t tstep = 2 * hstep;
    const unsigned ldsw = (unsigned)wid * 1024u;
    const int aoff = lds_byte(wr * 64 + fr, fq * 8), boff = lds_byte(wc * 32 + fr, fq * 8);
#define PG8_SA(b, h) (((b) * 2 + (h)) * HTB)
#define PG8_SB(b, h) ((4 + (b) * 2 + (h)) * HTB)
#define PG8_STAGE(bufoff, gbase, voff) do { _Pragma("unroll") for (int _i = 0; _i < 2; ++_i) \
        __builtin_amdgcn_global_load_lds((const unsigned*)((const char*)(gbase) + (voff)[_i]), (PG8_LAS unsigned*)(lds + (bufoff) + ldsw + _i * 8192), 16, 0, 0); } while (0)
#define PG8_LDA(dst, b, h) do { _Pragma("unroll") for (int m = 0; m < 4; ++m) _Pragma("unroll") for (int k = 0; k < 2; ++k) dst[m][k] = *(const PG8_LAS bf16x8*)(lds + PG8_SA(b, h) + aoff + m * 2048 + k * 1024); } while (0)
#define PG8_LDB(dst, b, h) do { _Pragma("unroll") for (int n = 0; n < 2; ++n) _Pragma("unroll") for (int k = 0; k < 2; ++k) dst[n][k] = *(const PG8_LAS bf16x8*)(lds + PG8_SB(b, h) + boff + n * 2048 + k * 1024); } while (0)
#define PG8_MMA(ai, bj, At, Bt) do { __builtin_amdgcn_s_setprio(1); _Pragma("unroll") for (int m = 0; m < 4; ++m) _Pragma("unroll") for (int n = 0; n < 2; ++n) _Pragma("unroll") for (int k = 0; k < 2; ++k) \
        acc[ai][bj][m][n] = __builtin_amdgcn_mfma_f32_16x16x32_bf16(Bt[n][k], At[m][k], acc[ai][bj][m][n], 0, 0, 0); __builtin_amdgcn_s_setprio(0); } while (0)
#define PG8_WAIT_V(n) asm volatile("s_waitcnt vmcnt(" #n ")" ::: "memory")
#define PG8_WAIT_L(n) asm volatile("s_waitcnt lgkmcnt(" #n ")" ::: "memory")
#define PG8_BAR __builtin_amdgcn_s_barrier()
#define PG8_SCHED __builtin_amdgcn_sched_barrier(0)
    Unit cur, nxt; int ui = 0;
    if (!S.next(0, cur)) return;
    f32x4 acc[2][2][4][2];
#pragma unroll
    for (int a = 0; a < 2; ++a)
#pragma unroll
        for (int b = 0; b < 2; ++b)
#pragma unroll
            for (int m = 0; m < 4; ++m)
#pragma unroll
                for (int n = 0; n < 2; ++n) acc[a][b][m][n] = (f32x4){0.f, 0.f, 0.f, 0.f};
    bf16x8 At[4][2], B0[2][2], B1[2][2];
    const char* cA = (const char*)g.A + (size_t)cur.pm * tstep + cur.kb; const char* cB = (const char*)g.Bt + (size_t)cur.pn * tstep + cur.kb;
    S.a_ready(cur);
    if constexpr (SP2) {
        PG8_STAGE(PG8_SB(0, 0), cB, voffB); PG8_STAGE(PG8_SB(0, 1), cB + hstep, voffB); PG8_STAGE(PG8_SA(0, 0), cA, voffA); PG8_STAGE(PG8_SA(0, 1), cA + hstep, voffA);
        if (wr == 1) PG8_BAR;
        PG8_WAIT_V(2); PG8_BAR;
        PG8_STAGE(PG8_SB(1, 0), cB + kstep, voffB); PG8_STAGE(PG8_SA(1, 0), cA + kstep, voffA); PG8_STAGE(PG8_SB(1, 1), cB + hstep + kstep, voffB);
        PG8_WAIT_V(6); PG8_BAR;
    } else {
        PG8_STAGE(PG8_SB(0, 0), cB, voffB); PG8_STAGE(PG8_SA(0, 0), cA, voffA); PG8_STAGE(PG8_SB(0, 1), cB + hstep, voffB); PG8_STAGE(PG8_SA(0, 1), cA + hstep, voffA);
        if (wr == 1) PG8_BAR;
        PG8_WAIT_V(4); PG8_BAR;
        PG8_STAGE(PG8_SB(1, 0), cB + kstep, voffB); PG8_STAGE(PG8_SA(1, 0), cA + kstep, voffA); PG8_STAGE(PG8_SB(1, 1), cB + hstep + kstep, voffB);
        PG8_WAIT_V(6); PG8_BAR;
    }
    for (;;) {
        const bool has_next = S.next(ui + 1, nxt);
        const char* nA = has_next ? (const char*)g.A + (size_t)nxt.pm * tstep + nxt.kb : cA; const char* nB = has_next ? (const char*)g.Bt + (size_t)nxt.pn * tstep + nxt.kb : cB;
        const int ntu = cur.nt ? cur.nt : nt;
        for (int t = 0; t < ntu; t += 2) {
            const bool last = (t == ntu - 2);
            const char* a1 = cA + (size_t)(t + 1) * kstep;
            const char* a2 = last ? nA : cA + (size_t)(t + 2) * kstep; const char* b2 = last ? nB : cB + (size_t)(t + 2) * kstep;
            const char* a3 = a2 + kstep; const char* b3 = b2 + kstep;
            if (last && has_next) S.a_ready(nxt);
            if constexpr (SP2) {
            PG8_LDB(B0, 0, 0); PG8_LDB(B1, 0, 1); PG8_SCHED; PG8_LDA(At, 0, 0); PG8_STAGE(PG8_SA(1, 1), a1 + hstep, voffA);
            PG8_WAIT_V(8); PG8_WAIT_L(0); PG8_BAR; PG8_MMA(0, 0, At, B0); PG8_MMA(0, 1, At, B1); PG8_BAR; PG8_SCHED;
            PG8_LDA(At, 0, 1); PG8_STAGE(PG8_SB(0, 0), b2, voffB); PG8_STAGE(PG8_SB(0, 1), b2 + hstep, voffB); PG8_STAGE(PG8_SA(0, 0), a2, voffA);
            PG8_WAIT_V(8); PG8_WAIT_L(0); PG8_BAR; PG8_MMA(1, 0, At, B0); PG8_MMA(1, 1, At, B1); PG8_BAR; PG8_SCHED;
            PG8_LDB(B0, 1, 0); PG8_LDB(B1, 1, 1); PG8_SCHED; PG8_LDA(At, 1, 0); PG8_STAGE(PG8_SA(0, 1), a2 + hstep, voffA);
            PG8_WAIT_V(8); PG8_WAIT_L(0); PG8_BAR; PG8_MMA(0, 0, At, B0); PG8_MMA(0, 1, At, B1); PG8_BAR; PG8_SCHED;
            PG8_LDA(At, 1, 1); PG8_STAGE(PG8_SB(1, 0), b3, voffB); PG8_STAGE(PG8_SB(1, 1), b3 + hstep, voffB); PG8_STAGE(PG8_SA(1, 0), a3, voffA);
            PG8_WAIT_V(8); PG8_WAIT_L(0); PG8_BAR; PG8_MMA(1, 0, At, B0); PG8_MMA(1, 1, At, B1); PG8_BAR; PG8_SCHED;
            } else {
            PG8_LDB(B0, 0, 0); PG8_SCHED; PG8_LDA(At, 0, 0); PG8_STAGE(PG8_SA(1, 1), a1 + hstep, voffA);
            PG8_WAIT_L(8); PG8_BAR; PG8_WAIT_L(0); PG8_MMA(0, 0, At, B0); PG8_BAR; PG8_SCHED;
            PG8_LDB(B1, 0, 1); PG8_STAGE(PG8_SB(0, 0), b2, voffB);
            PG8_BAR; PG8_WAIT_L(0); PG8_MMA(0, 1, At, B1); PG8_BAR;
            PG8_LDA(At, 0, 1); PG8_STAGE(PG8_SA(0, 0), a2, voffA);
            PG8_BAR; PG8_WAIT_L(0); PG8_MMA(1, 0, At, B0); PG8_BAR; PG8_SCHED;
            PG8_STAGE(PG8_SB(0, 1), b2 + hstep, voffB);
            PG8_WAIT_V(6); PG8_BAR; PG8_MMA(1, 1, At, B1); PG8_BAR;
            PG8_LDB(B0, 1, 0); PG8_SCHED; PG8_LDA(At, 1, 0); PG8_STAGE(PG8_SA(0, 1), a2 + hstep, voffA);
            PG8_WAIT_L(8); PG8_BAR; PG8_WAIT_L(0); PG8_MMA(0, 0, At, B0); PG8_BAR; PG8_SCHED;
            PG8_LDB(B1, 1, 1); PG8_STAGE(PG8_SB(1, 0), b3, voffB);
            PG8_BAR; PG8_WAIT_L(0); PG8_MMA(0, 1, At, B1); PG8_BAR;
            PG8_LDA(At, 1, 1); PG8_STAGE(PG8_SA(1, 0), a3, voffA);
            PG8_BAR; PG8_WAIT_L(0); PG8_MMA(1, 0, At, B0); PG8_BAR; PG8_SCHED;
            PG8_STAGE(PG8_SB(1, 1), b3 + hstep, voffB);
            PG8_WAIT_V(6); PG8_BAR; PG8_MMA(1, 1, At, B1); PG8_BAR;
            }
        }
        if constexpr (ALIGN_EPI) { if (wr == 0) PG8_BAR; }
        if constexpr (!Epi::AFTER_DRAIN) { E(acc, cur, wr, wc, fr, fq); S.done(cur); }
        if (!has_next) break;
#pragma unroll
        for (int a = 0; a < 2; ++a)
#pragma unroll
            for (int b = 0; b < 2; ++b)
#pragma unroll
                for (int m = 0; m < 4; ++m)
#pragma unroll
                    for (int n = 0; n < 2; ++n) acc[a][b][m][n] = (f32x4){0.f, 0.f, 0.f, 0.f};
        cur = nxt; cA = nA; cB = nB; ++ui;
        if constexpr (ALIGN_EPI) { if (wr == 1) PG8_BAR; }
    }
    PG8_WAIT_V(0);
    if constexpr (!ALIGN_EPI) { if (wr == 0) PG8_BAR; }
    PG8_BAR;
    if constexpr (Epi::AFTER_DRAIN) { E.fused(acc, cur, wr, wc, fr, fq, lds, wid, lane); S.done(cur); }
#undef PG8_SA
#undef PG8_SB
#undef PG8_STAGE
#undef PG8_LDA
#undef PG8_LDB
#undef PG8_MMA
#undef PG8_WAIT_V
#undef PG8_WAIT_L
#undef PG8_BAR
#undef PG8_SCHED
}
}
constexpr int RING_BYTES = 131072, MISC_OFF = RING_BYTES + 320, LDS_BYTES = 147456;
struct Params { const float* in[45]; float* out; unsigned char* ws; int ph_lo, ph_hi, use_bar, pad; };
enum { I_XP = 0, I_XS, I_CKV, I_CWIN, I_SWKV, I_SSHIFT, I_SCONV, I_PT, I_NORMG, I_MU, I_WR, I_WK, I_WV, I_WO, I_W0, I_W1, I_W2, I_A0, I_A1, I_A2, I_V0, I_V1, I_V2, I_G1, I_G2,
       I_KK, I_KA, I_RKK, I_LNW, I_LNB, I_KVNG, I_WKV, I_KNG, I_PE, I_CW1, I_CB1, I_CW2, I_CB2, I_WQ, I_QNG, I_WONSA, I_WIN, I_CONVW, I_CONVB, I_WOUT };

typedef const __attribute__((address_space(4))) Params* KP;
struct Ctx { LAS unsigned char* lds; int tid, lane, wave, gw, ngw, gtid, gsz; };

__device__ __forceinline__ void p0_transpose_item(const float* W, int K, int ldw, int nblk, bf16_t* WT, int row_off, LAS float* scr, int item, int lane) {
    const int kb = item / nblk, nb = item % nblk, k0 = 64 * kb, n0 = 32 * nb;
#pragma unroll 8
    for (int i = 0; i < 32; ++i) { const int kk = 2 * i + (lane >> 5); scr[kk * 33 + (lane & 31)] = W[(size_t)(k0 + kk) * ldw + n0 + (lane & 31)]; }
    LDS_WAIT(); asm volatile("" ::: "memory");
    const int c = lane & 7;
#pragma unroll
    for (int j = 0; j < 4; ++j) { const int n = (lane >> 3) + 8 * j; const LAS float* s = scr + (8 * c) * 33 + n;
        u32x4 o; o.x = pk2(s[0 * 33], s[1 * 33]); o.y = pk2(s[2 * 33], s[3 * 33]); o.z = pk2(s[4 * 33], s[5 * 33]); o.w = pk2(s[6 * 33], s[7 * 33]);
        *(u32x4*)(WT + (size_t)(row_off + n0 + n) * K + k0 + 8 * c) = o; }
    LDS_WAIT(); asm volatile("" ::: "memory");
}

__device__ __forceinline__ void phase_prologue(KP p, const Ctx& c) {
    LAS float* scr = (LAS float*)(c.lds + c.wave * 16384);
    unsigned char* ws = p->ws;
    int total = 0;
#define TRCNT(K_, N_) (((K_) / 64) * ((N_) / 32))
    constexpr int C_DD = TRCNT(1024, 1024), C_L64 = TRCNT(1024, 64), C_L32 = TRCNT(1024, 32), C_L128 = TRCNT(1024, 128), C_2_64 = TRCNT(64, 1024), C_2_128 = TRCNT(128, 1024);
    constexpr int C_KV = TRCNT(1024, 1536), C_Q = 16 * 33, C_IN = TRCNT(1024, 5632), C_OUT = TRCNT(2816, 1024), C_CW = TRCNT(1024, 128);
    constexpr int NITEMS = 2 * (4 * C_DD + 2 * C_L64 + C_L128 + 2 * C_2_64 + C_2_128) + C_L32 + C_KV + 2 * C_Q + 2 * C_DD + 4 * C_IN + 4 * C_OUT + 4 * C_CW;
    (void)total;
    for (int it = c.gw; it < NITEMS; it += c.ngw) {
        int r = it;
#define TR(Wp, K_, LDW_, NBLK_, WTp, ROWOFF_) { const int cnt_ = ((K_) / 64) * (NBLK_); if (r < cnt_) { p0_transpose_item((Wp), (K_), (LDW_), (NBLK_), (bf16_t*)(WTp), (ROWOFF_), scr, r, c.lane); continue; } r -= cnt_; }
        bool done = false;
#pragma unroll
        for (int l = 0; l < 2; ++l) {
            if (done) break;
            const size_t dd = (size_t)l * 1024 * 1024;
#define TRL(Wp, K_, LDW_, NBLK_, WTp, ROWOFF_) { const int cnt_ = ((K_) / 64) * (NBLK_); if (!done) { if (r < cnt_) { p0_transpose_item((Wp), (K_), (LDW_), (NBLK_), (bf16_t*)(WTp), (ROWOFF_), scr, r, c.lane); done = true; } else r -= cnt_; } }
            TRL(p->in[I_WR] + dd, 1024, 1024, 32, ws + WS_WRKV + (size_t)l * 3072 * 1024 * 2, 0)
            TRL(p->in[I_WK] + dd, 1024, 1024, 32, ws + WS_WRKV + (size_t)l * 3072 * 1024 * 2, 1024)
            TRL(p->in[I_WV] + dd, 1024, 1024, 32, ws + WS_WRKV + (size_t)l * 3072 * 1024 * 2, 2048)
            TRL(p->in[I_WO] + dd, 1024, 1024, 32, ws + WS_WORW + (size_t)l * 1024 * 1024 * 2, 0)
            TRL(p->in[I_W1] + (size_t)l * 1024 * 64, 1024, 64, 2, ws + WS_W1T + (size_t)l * 288 * 1024 * 2, 0)
            TRL(p->in[I_A1] + (size_t)l * 1024 * 64, 1024, 64, 2, ws + WS_W1T + (size_t)l * 288 * 1024 * 2, 64)
            TRL(p->in[I_G1] + (size_t)l * 1024 * 128, 1024, 128, 4, ws + WS_W1T + (size_t)l * 288 * 1024 * 2, 160)
            TRL(p->in[I_W2] + (size_t)l * 64 * 1024, 64, 1024, 32, ws + WS_W2W + (size_t)l * 1024 * 64 * 2, 0)
            TRL(p->in[I_A2] + (size_t)l * 64 * 1024, 64, 1024, 32, ws + WS_W2A + (size_t)l * 1024 * 64 * 2, 0)
            TRL(p->in[I_G2] + (size_t)l * 128 * 1024, 128, 1024, 32, ws + WS_W2G + (size_t)l * 1024 * 128 * 2, 0)
        }
        if (done) continue;
        TR(p->in[I_V1], 1024, 32, 1, ws + WS_W1T + (size_t)1 * 288 * 1024 * 2, 128)
        TR(p->in[I_WKV], 1024, 1536, 48, ws + WS_WKVT, 0)
        TR(p->in[I_WQ], 1024, NQ, 33, ws + WS_WQT, 0)
        TR(p->in[I_WQ] + (size_t)1024 * NQ, 1024, NQ, 33, ws + WS_WQT + (size_t)NQP * 1024 * 2, 0)
        TR(p->in[I_WONSA], 1024, 1024, 32, ws + WS_WONSA, 0)
        TR(p->in[I_WONSA] + (size_t)1024 * 1024, 1024, 1024, 32, ws + WS_WONSA + (size_t)1024 * 1024 * 2, 0)
#pragma unroll
        for (int l = 0; l < 4; ++l) {
            if (done) break;
            TRL(p->in[I_WIN] + (size_t)l * 1024 * 5632, 1024, 5632, 176, ws + WS_WINT + (size_t)l * 5632 * 1024 * 2, 0)
            TRL(p->in[I_WOUT] + (size_t)l * 2816 * 1024, 2816, 1024, 32, ws + WS_WOUTT + (size_t)l * 1024 * 2816 * 2, 0)
        }
        if (done) continue;
        TR(p->in[I_CW1], 1024, 128, 4, ws + WS_CW1T, 0)
        TR(p->in[I_CW1] + (size_t)1024 * 128, 1024, 128, 4, ws + WS_CW1T, 128)
        TR(p->in[I_CW1] + (size_t)2048 * 128, 1024, 128, 4, ws + WS_CW1T + (size_t)256 * 1024 * 2, 0)
        TR(p->in[I_CW1] + (size_t)3072 * 128, 1024, 128, 4, ws + WS_CW1T + (size_t)256 * 1024 * 2, 128)
#undef TR
#undef TRL
    }
    {
        bf16_t* WQT = (bf16_t*)(ws + WS_WQT);
        for (int e = c.gtid; e < 2 * 224 * 1024; e += c.gsz) { const int k = e & 1023, n = 1056 + ((e >> 10) % 224), l = e / (224 * 1024);
            WQT[((size_t)l * NQP + n) * 1024 + k] = n < NQ ? (bf16_t)f2bf(p->in[I_WQ][((size_t)l * 1024 + k) * NQ + n]) : (bf16_t)0; }
        bf16_t* W2V = (bf16_t*)(ws + WS_W2V);
        for (int e = c.gtid; e < 32 * 1024; e += c.gsz) { const int n = e & 1023, k = e >> 10; W2V[n * 32 + k] = (bf16_t)f2bf(p->in[I_V2][k * 1024 + n]); }
    }
    { bf16_t* W2T = (bf16_t*)(ws + WS_CW2T);
      for (int e = c.gtid; e < 2 * 128 * 64; e += c.gsz) { const int d = e & 63, q = (e >> 6) & 127, kv = e >> 13; const float w = p->in[I_CW2][e];
          const unsigned hi = f2bf(w), lo = f2bf(w - __builtin_bit_cast(float, hi << 16)); W2T[(size_t)(kv * 64 + d) * 128 + q] = (bf16_t)hi; W2T[(size_t)2 * 64 * 128 + (size_t)(kv * 64 + d) * 128 + q] = (bf16_t)lo; } }
    for (int it = c.gw; it < 256; it += c.ngw) { const int kv = it >> 7, h = it & 127; float s = 0.f;
        for (int kk = c.lane; kk < 2048; kk += 64) s += p->in[I_PE][kv * 2048 + kk] * p->in[I_CW1][((size_t)kv * 2048 + kk) * 128 + h];
        s = wave_sum(s); if (c.lane == 0) ((float*)(ws + WS_CBIAS))[it] = s + p->in[I_CB1][it]; }
    { const f32x4* xp = (const f32x4*)p->in[I_XP]; const f32x4* xs = (const f32x4*)p->in[I_XS]; f32x4* o = (f32x4*)(p->out + O_Y);
      for (int e = c.gtid; e < R * D / 4; e += c.gsz) o[e] = e < MP * D / 4 ? xp[e] : xs[e - MP * D / 4]; }
}

__device__ __forceinline__ void phase_fill(KP p, const Ctx& c, int li, const int gwf, const int ngwf) {
    unsigned char* ws = p->ws;
    { const int* pt = (const int*)p->in[I_PT]; bf16_t* CA = (bf16_t*)(ws + WS_CMPA); const int part = li;
      for (int it = gwf; it < SB * 128 * 4; it += ngwf) { const int s4 = 4 * (it & 3), n = (it >> 2) & 127, b = it >> 9;
          const int page = pt[b * NPAGES + (n >> 3)]; const float* src = p->in[I_CKV] + ((size_t)page * PAGE + (n & 7) * 16 + s4) * 1024 + part * 256;
          f32x4 v[4];
#pragma unroll
          for (int e = 0; e < 4; ++e) v[e] = __builtin_nontemporal_load(((const f32x4*)(src + (size_t)e * 1024)) + c.lane);
          const int g = c.lane >> 4, d0 = 4 * (c.lane & 15); bf16_t* dst = CA + ((size_t)8192 + (size_t)part * 65536 + (size_t)(b * 4 + g) * 128 + n) * 1024 + s4 * 64 + d0;
#pragma unroll
          for (int e = 0; e < 4; ++e) { u32x2 w; w.x = pk2(v[e][0], v[e][1]); w.y = pk2(v[e][2], v[e][3]); *(u32x2*)(dst + e * 64) = w; } } }
    { const f32x4* src = (const f32x4*)p->in[I_CWIN]; f32x4* dst = (f32x4*)(p->out + O_WINS); constexpr int HALF_N = SB * 508 * 128 / 2;
      for (int e0 = li * HALF_N + gwf * 256 + c.lane; e0 < (li + 1) * HALF_N; e0 += ngwf * 256) { f32x4 v[4];
#pragma unroll
          for (int q = 0; q < 4; ++q) { const int e = e0 + 64 * q; if (e < (li + 1) * HALF_N) { const int b = e / (508 * 128), rr = e % (508 * 128); v[q] = __builtin_nontemporal_load(src + (size_t)b * 512 * 128 + 4 * 128 + rr); } }
#pragma unroll
          for (int q = 0; q < 4; ++q) { const int e = e0 + 64 * q; if (e < (li + 1) * HALF_N) { const int b = e / (508 * 128), rr = e % (508 * 128); __builtin_nontemporal_store(v[q], dst + (size_t)b * 512 * 128 + rr); } } } }
}

template <int NT> __device__ __forceinline__ void skinny_mma(const bf16_t* A, int lda, const bf16_t* Wt, int ldw, int K, int row0, int col0, int lane, f32x4 (&acc)[NT][2]) {
    const int fr = lane & 15, fq = lane >> 4;
#pragma unroll
    for (int nt = 0; nt < NT; ++nt) { acc[nt][0] = (f32x4){0.f, 0.f, 0.f, 0.f}; acc[nt][1] = (f32x4){0.f, 0.f, 0.f, 0.f}; }
    const bf16_t* xa = A + (size_t)(row0 + fr) * lda + 8 * fq; const bf16_t* xb = xa + (size_t)16 * lda;
    const bf16_t* wa = Wt + (size_t)(col0 + fr) * ldw + 8 * fq;
    const char* pa = (const char*)xa; const char* pb = (const char*)xb; const char* pw[NT];
#pragma unroll
    for (int nt = 0; nt < NT; ++nt) pw[nt] = (const char*)(wa + (size_t)nt * 16 * ldw);
    for (int k4 = 0; k4 < K / 128; ++k4) {
        bf16x8 fb[4][2], fa[4][NT];
#pragma unroll
        for (int u = 0; u < 4; ++u) { fb[u][0] = *(const bf16x8*)(pa + 64 * u); fb[u][1] = *(const bf16x8*)(pb + 64 * u);
#pragma unroll
            for (int nt = 0; nt < NT; ++nt) fa[u][nt] = *(const bf16x8*)(pw[nt] + 64 * u); }
        __builtin_amdgcn_sched_barrier(0);
#pragma unroll
        for (int u = 0; u < 4; ++u)
#pragma unroll
            for (int nt = 0; nt < NT; ++nt) { acc[nt][0] = mfma16(fa[u][nt], fb[u][0], acc[nt][0]); acc[nt][1] = mfma16(fa[u][nt], fb[u][1], acc[nt][1]); }
        pa += 256; pb += 256;
#pragma unroll
        for (int nt = 0; nt < NT; ++nt) pw[nt] += 256;
        __builtin_amdgcn_sched_barrier(0);
    }
}
__device__ __forceinline__ void skinny_resid_sample(const Ctx& c, const bf16_t* A, int lda, const bf16_t* Wt, int K, float* X) {
    const int ln = launder_v(c.lane), fr = ln & 15, fq = ln >> 4, w = c.wave;
    const int nch = K >> 7, c0 = (nch * w) >> 3, c1 = (nch * (w + 1)) >> 3;
    LAS f32x4* part = (LAS f32x4*)c.lds;
    __syncthreads();
    for (int it = blockIdx.x; it < 256; it += gridDim.x) { const int row0 = MP + 32 * (it & 15), col0 = 64 * (it >> 4);
        f32x4 acc[4][2]; skinny_mma<4>(A + 128 * c0, lda, Wt + 128 * c0, lda, 128 * (c1 - c0), row0, col0, c.lane, acc);
#pragma unroll
        for (int nt = 0; nt < 4; ++nt)
#pragma unroll
            for (int mt = 0; mt < 2; ++mt) part[(w * 8 + nt * 2 + mt) * 64 + ln] = acc[nt][mt];
        const int nt = w >> 1, mt = w & 1; f32x4* q = (f32x4*)(X + (size_t)(row0 + 16 * mt + fr) * D + col0 + 16 * nt + 4 * fq); f32x4 s = *q;
        __syncthreads();
#pragma unroll
        for (int ww = 0; ww < 8; ++ww) s = s + part[(ww * 8 + w) * 64 + ln];
        *q = s;
        __syncthreads(); }
}
__device__ __forceinline__ void skinny_store(const Ctx& c, const bf16_t* A, const bf16_t* Wt, int K, float* C, int ldc, int rbase, int nrb, int ncb, int it0, int nit_total) {
    const int fr = c.lane & 15, fq = c.lane >> 4;
    for (int it = c.gw - it0; it < nrb * ncb; it += c.ngw) { if (it < 0) continue; const int row0 = rbase + 32 * (it % nrb), col0 = 64 * (it / nrb);
        f32x4 acc[4][2]; skinny_mma<4>(A, K, Wt, K, K, row0, col0, c.lane, acc);
#pragma unroll
        for (int nt = 0; nt < 4; ++nt)
#pragma unroll
            for (int mt = 0; mt < 2; ++mt) *(f32x4*)(C + (size_t)(row0 + 16 * mt + fr) * ldc + col0 + 16 * nt + 4 * fq) = acc[nt][mt]; }
    (void)nit_total;
}

__device__ __forceinline__ void load_row(const float* p, int lane, f32x4 (&v)[4]) {
#pragma unroll
    for (int j = 0; j < 4; ++j) v[j] = ((const f32x4*)p)[lane + 64 * j];
}
__device__ __forceinline__ float row_rstd(const f32x4 (&v)[4]) {
    float s = 0.f;
#pragma unroll
    for (int j = 0; j < 4; ++j) s += (v[j][0] * v[j][0] + v[j][1] * v[j][1]) + (v[j][2] * v[j][2] + v[j][3] * v[j][3]);
    s = wave_sum(s); return frsq(s * (1.0f / D) + NORM_EPS);
}
__device__ __forceinline__ void store_row_bf16(bf16_t* o, int lane, const f32x4 (&v)[4]) {
#pragma unroll
    for (int j = 0; j < 4; ++j) { u32x2 w; w.x = pk2(v[j][0], v[j][1]); w.y = pk2(v[j][2], v[j][3]); ((u32x2*)o)[lane + 64 * j] = w; }
}

__device__ __forceinline__ void phase_norm(const Ctx& c, const float* X, const float* g1, bf16_t* o1, const float* g2, bf16_t* o2) {
    f32x4 ga[4], gb[4]; load_row(g1, c.lane, ga); if (g2) load_row(g2, c.lane, gb);
    for (int row = c.gw; row < R; row += c.ngw) {
        f32x4 v[4]; load_row(X + (size_t)row * D, c.lane, v); const float rs = row_rstd(v);
        f32x4 y[4];
#pragma unroll
        for (int j = 0; j < 4; ++j) y[j] = v[j] * rs * ga[j];
        store_row_bf16(o1 + (size_t)row * D, c.lane, y);
        if (g2) {
#pragma unroll
            for (int j = 0; j < 4; ++j) y[j] = v[j] * rs * gb[j];
            store_row_bf16(o2 + (size_t)row * D, c.lane, y); }
    }
}

__device__ __forceinline__ void phase_mix(KP p, const Ctx& c, int li) {
    const float* X = p->out + O_Y; const float* gain = p->in[I_NORMG] + (size_t)(li * 2) * D; const float* mu = p->in[I_MU] + (size_t)li * 6 * D;
    bf16_t* XM = (bf16_t*)(p->ws + WS_XM);
    f32x4 ga[4]; load_row(gain, c.lane, ga);
    {
        const int r0 = (int)(((long)c.gw * R) / c.ngw), r1 = (int)(((long)(c.gw + 1) * R) / c.ngw); f32x4 prev[4];
        {
            const bool seq_start = r0 < MP ? ((r0 & (TP - 1)) == 0) : (((r0 - MP) & 3) == 0);
            if (!seq_start && r0 < r1) { f32x4 v[4]; load_row(X + (size_t)(r0 - 1) * D, c.lane, v); const float rs = row_rstd(v);
#pragma unroll
                for (int j = 0; j < 4; ++j) prev[j] = v[j] * rs * ga[j]; }
        }
        for (int row = r0; row < r1; ++row) {
            const bool seq_start = row < MP ? ((row & (TP - 1)) == 0) : (((row - MP) & 3) == 0);
            if (seq_start) {
                if (row < MP) {
#pragma unroll
                    for (int j = 0; j < 4; ++j) prev[j] = (f32x4){0.f, 0.f, 0.f, 0.f}; }
                else load_row(p->in[I_SSHIFT] + ((size_t)li * SB + ((row - MP) >> 2)) * D, c.lane, prev);
            }
            f32x4 v[4]; load_row(X + (size_t)row * D, c.lane, v); const float rs = row_rstd(v);
            f32x4 xn[4];
#pragma unroll
            for (int j = 0; j < 4; ++j) xn[j] = v[j] * rs * ga[j];
#pragma unroll
            for (int m = 0; m < 6; ++m) {
                f32x4 y[4];
#pragma unroll
                for (int j = 0; j < 4; ++j) { const int mi = m == 1 ? 2 : (m == 2 ? 3 : (m == 3 ? 1 : m));
                    const f32x4 mm = ((const f32x4*)(mu + (size_t)mi * D))[c.lane + 64 * j]; y[j] = xn[j] + (prev[j] - xn[j]) * mm; }
                store_row_bf16(XM + ((size_t)m * R + row) * D, c.lane, y);
            }
            const bool seq_end = row < MP ? ((row & (TP - 1)) == TP - 1) : (((row - MP) & 3) == 3);
            if (seq_end) { float* so = row < MP ? p->out + O_SHP + ((size_t)li * NB + (row >> 13)) * D : p->out + O_SHS + ((size_t)li * SB + ((row - MP) >> 2)) * D;
#pragma unroll
                for (int j = 0; j < 4; ++j) ((f32x4*)so)[c.lane + 64 * j] = xn[j]; }
#pragma unroll
            for (int j = 0; j < 4; ++j) prev[j] = xn[j];
        }
    }
}
template <int NT, int ACT> __device__ __forceinline__ void lora1_item(const bf16_t* X, const bf16_t* W, bf16_t* HID, int coloff, int rb, int lane) {
    lane = launder_v(lane);
    const int fr = lane & 15, fq = lane >> 4;
    f32x4 acc[NT][2]; skinny_mma<NT>(X, 1024, W, 1024, 1024, rb * 32, coloff, lane, acc);
#pragma unroll
    for (int nt = 0; nt < NT; ++nt)
#pragma unroll
        for (int mt = 0; mt < 2; ++mt) { f32x4 v = acc[nt][mt];
#pragma unroll
            for (int r = 0; r < 4; ++r) { if (ACT == 1) { const float e = __builtin_amdgcn_exp2f(2.8853900817779268f * v[r]); v[r] = 1.0f - 2.0f * frcp(e + 1.0f); } if (ACT == 2) v[r] = sigmoidf_(v[r]); }
            u32x2 w; w.x = pk2(v[0], v[1]); w.y = pk2(v[2], v[3]);
            *(u32x2*)(HID + (size_t)(rb * 32 + mt * 16 + fr) * LHID + coloff + nt * 16 + 4 * fq) = w; }
}
__device__ __forceinline__ void phase_lora1(KP p, const Ctx& c, int li) {
    const bf16_t* XM = (const bf16_t*)(p->ws + WS_XM); const bf16_t* W = (const bf16_t*)(p->ws + WS_W1T) + (size_t)li * 288 * 1024; bf16_t* HID = (bf16_t*)(p->ws + WS_HID);
    constexpr int NRB = R / 32;
    for (int it = blockIdx.x + gridDim.x * c.wave; it < 5 * NRB; it += c.ngw) { const int q = it / NRB, rb = it % NRB;
        if (q == 0) lora1_item<4, 1>(XM + (size_t)3 * R * D, W, HID, 0, rb, c.lane);
        else if (q == 1) lora1_item<4, 0>(XM + (size_t)4 * R * D, W, HID, 64, rb, c.lane);
        else if (q == 2) { if (li == 1) lora1_item<2, 0>(XM + (size_t)2 * R * D, W, HID, 128, rb, c.lane); }
        else if (q == 3) lora1_item<4, 2>(XM + (size_t)5 * R * D, W, HID, 160, rb, c.lane);
        else lora1_item<4, 2>(XM + (size_t)5 * R * D, W, HID, 224, rb, c.lane);
    }
}

constexpr int SST = 72, MAT = 64 * SST * 2;
constexpr int O_AT = 0, O_BT = MAT, O_KT = 2 * MAT, O_RT = 3 * MAT, O_VT = 4 * MAT, O_BH = 5 * MAT, O_KH = 6 * MAT, O_XT = 7 * MAT, O_AAB = 9 * MAT, O_AAK = 10 * MAT, O_ARB = 11 * MAT, O_ARK = 12 * MAT;
constexpr int O_TD = 13 * MAT, O_SCR = O_TD + 2048, O_CS = O_SCR + 4096, O_WC = O_CS + 2048, O_LW = O_XT, O_LA = O_XT + 16384, O_LV = O_XT + 32768;
static_assert(O_WC + 256 <= RING_BYTES && O_LV + 16384 <= O_TD, "scan LDS map");
__device__ __forceinline__ bf16x8 ldsfrag(LAS unsigned char* lds, int off, int row, int col) { return *(const LAS bf16x8*)(lds + off + (row * SST + col) * 2); }
__device__ __forceinline__ void lds_st4(LAS unsigned char* lds, int off, int row, int col, f32x4 v) { u32x2 w; w.x = pk2(v[0], v[1]); w.y = pk2(v[2], v[3]); *(LAS u32x2*)(lds + off + (row * SST + col) * 2) = w; }
__device__ __forceinline__ f32x4 lds_ld4(LAS unsigned char* lds, int off, int row, int col) { const u32x2 w = *(const LAS u32x2*)(lds + off + (row * SST + col) * 2); return (f32x4){bflo(w.x), bfhi(w.x), bflo(w.y), bfhi(w.y)}; }

__device__ __forceinline__ void scanA_unit(KP p, const Ctx& c, int li, int u) {
    LAS unsigned char* lds = c.lds; unsigned char* ws = p->ws; const int stop = p->pad;
    const int lane = c.lane, wave = c.wave, fr = lane & 15, fq = lane >> 4;
    const int b = u / (NCH * H), n = (u / H) % NCH, h = u % H, row0 = b * TP + 64 * n;
    const float* Rb = (const float*)(ws + WS_RK_R); const float* Kb = (const float*)(ws + WS_RK_K);
    float* Vb = (float*)(ws + (li ? WS_V1 : WS_V0)); const float* V0b = (const float*)(ws + WS_V0);
    const bf16_t* HID = (const bf16_t*)(ws + WS_HID);
    {
        const int tt = wave & 3, chh = wave >> 2;
        const bf16_t* hrow = launder_p(HID + (size_t)(row0 + 16 * tt + fr) * LHID + 8 * fq);
        const bf16_t* W2W = (const bf16_t*)(ws + WS_W2W) + (size_t)li * 1024 * 64; const bf16_t* W2A = (const bf16_t*)(ws + WS_W2A) + (size_t)li * 1024 * 64; const bf16_t* W2V = (const bf16_t*)(ws + WS_W2V);
#pragma unroll
        for (int cti = 0; cti < 2; ++cti) { const int ct = 2 * chh + cti, C = 64 * h + 16 * ct + fr;
            f32x4 aw = {0.f, 0.f, 0.f, 0.f}, aa = {0.f, 0.f, 0.f, 0.f}, av = {0.f, 0.f, 0.f, 0.f};
#pragma unroll
            for (int ks = 0; ks < 2; ++ks) {
                aw = mfma16(*(const bf16x8*)(W2W + (size_t)C * 64 + 32 * ks + 8 * fq), *(const bf16x8*)(hrow + 32 * ks), aw);
                aa = mfma16(*(const bf16x8*)(W2A + (size_t)C * 64 + 32 * ks + 8 * fq), *(const bf16x8*)(hrow + 64 + 32 * ks), aa); }
            if (li) av = mfma16(*(const bf16x8*)(W2V + (size_t)C * 32 + 8 * fq), *(const bf16x8*)(hrow + 128), av);
            const int t = 16 * tt + fr, cc = 16 * ct + 4 * fq;
            *(LAS f32x4*)(lds + O_LW + (t * 64 + cc) * 4) = aw; *(LAS f32x4*)(lds + O_LA + (t * 64 + cc) * 4) = aa; *(LAS f32x4*)(lds + O_LV + (t * 64 + cc) * 4) = av; }
    }
    __syncthreads();
    if (stop == 1) return;
    {
        const int cc = lane, tq = wave, C = 64 * h + cc; const size_t pc = (size_t)li * D + C;
        const float w0 = p->in[I_W0][pc], a0 = p->in[I_A0][pc], kkc = p->in[I_KK][pc], kac = p->in[I_KA][pc], rkc = p->in[I_RKK][pc], v0 = li ? p->in[I_V0][C] : 0.f;
        float wlg[8], Lin[8], rr[8], k2[8], vv[8], aa[8], bb[8], rk8[8]; float run = 0.f;
        float r8[8], k8[8], v8[8], f8[8];
#pragma unroll
        for (int e = 0; e < 8; ++e) { const size_t gi = (size_t)(row0 + 8 * tq + e) * D + C; r8[e] = Rb[gi]; k8[e] = Kb[gi]; v8[e] = Vb[gi]; f8[e] = V0b[gi]; }
#pragma unroll
        for (int e = 0; e < 8; ++e) { const int t = 8 * tq + e;
            const float r = r8[e], k = k8[e]; float v = v8[e];
            const float lw = *(const LAS float*)(lds + O_LW + (t * 64 + cc) * 4), la = *(const LAS float*)(lds + O_LA + (t * 64 + cc) * 4), lv = *(const LAS float*)(lds + O_LV + (t * 64 + cc) * 4);
            const float z = -(w0 + lw); const float sp = fmaxf(z, 0.f) + __logf(1.0f + __expf(-fabsf(z))); const float wl = -__expf(-sp - 0.5f);
            const float asig = sigmoidf_(a0 + la);
            { const float vg = sigmoidf_(v0 + lv); const float vm = v + (f8[e] - v) * vg; v = li ? vm : v; }
            const float kkr = k * kkc; const float ss = wave_sum(kkr * kkr); const float kkn = kkr * frsq(fmaxf(ss, 1e-24f));
            const float kmod = k * (1.0f + (asig - 1.0f) * kac);
            rk8[e] = wave_sum(r * kmod * rkc);
            run += wl; wlg[e] = wl; Lin[e] = run; rr[e] = r; k2[e] = kmod; vv[e] = v; aa[e] = -kkn; bb[e] = kkn * asig; }
        if (li) {
#pragma unroll
            for (int e = 0; e < 8; ++e) Vb[(size_t)(row0 + 8 * tq + e) * D + C] = vv[e]; }
        if (cc == 0) {
#pragma unroll
            for (int e = 0; e < 8; ++e) ((float*)(ws + WS_RKS))[(size_t)(row0 + 8 * tq + e) * 16 + h] = rk8[e]; }
        *(LAS float*)(lds + O_CS + (tq * 64 + cc) * 4) = run;
        __syncthreads();
        float off = 0.f, tot = 0.f;
#pragma unroll
        for (int q = 0; q < 8; ++q) { const float x = *(const LAS float*)(lds + O_CS + (q * 64 + cc) * 4); tot += x; if (q < tq) off += x; }
        u32x4 wa, wv, wb, wk; unsigned pa[8], pv[8], pb[8], pk[8];
#pragma unroll
        for (int e = 0; e < 8; ++e) { const int t = 8 * tq + e; const float L = off + Lin[e], Lp = L - wlg[e];
            const float eL = __expf(L), eLp = __expf(Lp), enL = __expf(-L), eT = __expf(tot - L);
            const float at = aa[e] * eLp, bt = bb[e] * enL, kt = k2[e] * enL, rt = rr[e] * eL, bh = bb[e] * eT, kh = k2[e] * eT;
            *(LAS bf16_t*)(lds + O_AT + (t * SST + cc) * 2) = (bf16_t)f2bf(at); *(LAS bf16_t*)(lds + O_BT + (t * SST + cc) * 2) = (bf16_t)f2bf(bt);
            *(LAS bf16_t*)(lds + O_KT + (t * SST + cc) * 2) = (bf16_t)f2bf(kt); *(LAS bf16_t*)(lds + O_RT + (t * SST + cc) * 2) = (bf16_t)f2bf(rt);
            pa[e] = f2bf(at); pv[e] = f2bf(vv[e]); pb[e] = f2bf(bh); pk[e] = f2bf(kh); }
        wa = (u32x4){pa[0] | (pa[1] << 16), pa[2] | (pa[3] << 16), pa[4] | (pa[5] << 16), pa[6] | (pa[7] << 16)};
        wv = (u32x4){pv[0] | (pv[1] << 16), pv[2] | (pv[3] << 16), pv[4] | (pv[5] << 16), pv[6] | (pv[7] << 16)};
        wb = (u32x4){pb[0] | (pb[1] << 16), pb[2] | (pb[3] << 16), pb[4] | (pb[5] << 16), pb[6] | (pb[7] << 16)};
        wk = (u32x4){pk[0] | (pk[1] << 16), pk[2] | (pk[3] << 16), pk[4] | (pk[5] << 16), pk[6] | (pk[7] << 16)};
        *(LAS u32x4*)(lds + O_XT + (cc * SST + 8 * tq) * 2) = wa; *(LAS u32x4*)(lds + O_VT + (cc * SST + 8 * tq) * 2) = wv;
        *(LAS u32x4*)(lds + O_BH + (cc * SST + 8 * tq) * 2) = wb; *(LAS u32x4*)(lds + O_KH + (cc * SST + 8 * tq) * 2) = wk;
        if (tq == 0) *(LAS float*)(lds + O_WC + cc * 4) = __expf(tot);
    }
    __syncthreads();
    if (stop == 2) return;
    {
        const int mi = wave >> 1, ph = wave & 1; const int oY = (mi & 1) ? O_KT : O_BT, oX = (mi < 2) ? O_AT : O_RT; const bool strict = mi < 2;
        const int oO = mi == 0 ? O_AAB : (mi == 1 ? O_AAK : (mi == 2 ? O_ARB : O_ARK));
#pragma unroll
        for (int sti = 0; sti < 2; ++sti) { const int st = 2 * ph + sti;
#pragma unroll
            for (int tt = 0; tt < 4; ++tt) { f32x4 acc = {0.f, 0.f, 0.f, 0.f};
                if (st <= tt) {
#pragma unroll
                    for (int ks = 0; ks < 2; ++ks) acc = mfma16(ldsfrag(lds, oY, 16 * st + fr, 32 * ks + 8 * fq), ldsfrag(lds, oX, 16 * tt + fr, 32 * ks + 8 * fq), acc);
                    const int t = 16 * tt + fr;
#pragma unroll
                    for (int r = 0; r < 4; ++r) { const int s = 16 * st + 4 * fq + r; const bool keep = strict ? (s < t) : (s <= t); acc[r] = keep ? acc[r] : 0.f; } }
                if (st <= tt) lds_st4(lds, oO, 16 * tt + fr, 16 * st + 4 * fq, acc);
                else { u32x2 zz; int z0 = 0; asm volatile("" : "+v"(z0)); zz.x = (unsigned)z0; zz.y = (unsigned)z0; *(LAS u32x2*)(lds + oO + ((16 * tt + fr) * SST + 16 * st + 4 * fq) * 2) = zz; } } }
    }
    __syncthreads();
    if (stop == 3) return;
    {
        const int tt = wave & 3, ih = wave >> 2;
#pragma unroll
        for (int iti = 0; iti < 2; ++iti) { const int it = 2 * ih + iti; f32x4 acc = {0.f, 0.f, 0.f, 0.f};
#pragma unroll
            for (int ks = 0; ks < 2; ++ks) acc = mfma16(ldsfrag(lds, O_AAK, 16 * tt + fr, 32 * ks + 8 * fq), ldsfrag(lds, O_VT, 16 * it + fr, 32 * ks + 8 * fq), acc);
            lds_st4(lds, O_XT, 64 + 16 * it + fr, 16 * tt + 4 * fq, acc); }
        if (wave < 4 && lane < 16) { const int I = wave; float x[16];
#pragma unroll
            for (int t = 0; t < 16; ++t) { float s = (t == lane) ? 1.0f : 0.0f;
#pragma unroll
                for (int q = 0; q < t; ++q) s += bf2f(*(const LAS bf16_t*)(lds + O_AAB + ((16 * I + t) * SST + 16 * I + q) * 2)) * x[q];
                x[t] = s; *(LAS bf16_t*)(lds + O_TD + ((I * 16 + t) * 16 + lane) * 2) = (bf16_t)f2bf(s); } }
    }
    __syncthreads();
    if (stop == 5) return;
    {
        const int colb = 16 * wave; const bf16x8 zero8 = {0, 0, 0, 0, 0, 0, 0, 0};
#pragma unroll
        for (int I = 0; I < 4; ++I) {
            f32x4 acc = lds_ld4(lds, O_XT, colb + fr, 16 * I + 4 * fq);
#pragma unroll
            for (int ks = 0; ks < 2; ++ks) if (32 * ks < 16 * I) { const bool ok = (32 * ks + 8 * fq) < 16 * I;
                const bf16x8 a = ok ? ldsfrag(lds, O_AAB, 16 * I + fr, 32 * ks + 8 * fq) : zero8, bq = ok ? ldsfrag(lds, O_XT, colb + fr, 32 * ks + 8 * fq) : zero8;
                acc = mfma16(a, bq, acc); }
            { u32x2 w; w.x = pk2(acc[0], acc[1]); w.y = pk2(acc[2], acc[3]); *(LAS u32x2*)(lds + O_SCR + wave * 512 + (fr * 16 + 4 * fq) * 2) = w; }
            LDS_WAIT();
            const bf16x8 ta = fq < 2 ? *(const LAS bf16x8*)(lds + O_TD + ((I * 16 + fr) * 16 + 8 * fq) * 2) : zero8;
            const bf16x8 tb = fq < 2 ? *(const LAS bf16x8*)(lds + O_SCR + wave * 512 + (fr * 16 + 8 * fq) * 2) : zero8;
            const f32x4 res = mfma16(ta, tb, (f32x4){0.f, 0.f, 0.f, 0.f});
            lds_st4(lds, O_XT, colb + fr, 16 * I + 4 * fq, res);
            LDS_WAIT();
        }
    }
    __syncthreads();
    if (stop == 6) return;
    constexpr int S_RP = 0, S_MH = MAT, S_ML = 2 * MAT, S_YL = 3 * MAT, YLS = 68, S_NN = S_YL + 64 * YLS * 4;
    static_assert(S_NN + 64 * YLS * 4 <= O_XT, "staging must stay below the next unit's step-1 area");
    {
        const int tb = wave & 3, hb = wave >> 2;
        u32x2 rp[2], mh[2], ml[2]; f32x4 yl[2], nv[2];
#pragma unroll
        for (int qi = 0; qi < 2; ++qi) { const int rt = 2 * hb + qi;
            { f32x4 acc = lds_ld4(lds, O_RT, 16 * tb + fr, 16 * rt + 4 * fq);
#pragma unroll
              for (int ks = 0; ks < 2; ++ks) acc = mfma16(ldsfrag(lds, O_XT, 16 * rt + fr, 32 * ks + 8 * fq), ldsfrag(lds, O_ARB, 16 * tb + fr, 32 * ks + 8 * fq), acc);
              rp[qi].x = pk2(acc[0], acc[1]); rp[qi].y = pk2(acc[2], acc[3]); }
            { f32x4 acc = {0.f, 0.f, 0.f, 0.f};
#pragma unroll
              for (int ks = 0; ks < 2; ++ks) { acc = mfma16(ldsfrag(lds, O_XT, 64 + 16 * rt + fr, 32 * ks + 8 * fq), ldsfrag(lds, O_ARB, 16 * tb + fr, 32 * ks + 8 * fq), acc);
                  acc = mfma16(ldsfrag(lds, O_VT, 16 * rt + fr, 32 * ks + 8 * fq), ldsfrag(lds, O_ARK, 16 * tb + fr, 32 * ks + 8 * fq), acc); }
              yl[qi] = acc; }
            { f32x4 acc = {0.f, 0.f, 0.f, 0.f};
#pragma unroll
              for (int ks = 0; ks < 2; ++ks) acc = mfma16(ldsfrag(lds, O_XT, 16 * rt + fr, 32 * ks + 8 * fq), ldsfrag(lds, O_BH, 16 * tb + fr, 32 * ks + 8 * fq), acc);
              const int j = 16 * tb + fr; const float wc = *(const LAS float*)(lds + O_WC + j * 4);
#pragma unroll
              for (int r = 0; r < 4; ++r) if (16 * rt + 4 * fq + r == j) acc[r] += wc;
              unsigned hh[4], ll[4];
#pragma unroll
              for (int r = 0; r < 4; ++r) { hh[r] = f2bf(acc[r]); ll[r] = f2bf(acc[r] - __builtin_bit_cast(float, hh[r] << 16)); }
              mh[qi] = (u32x2){hh[0] | (hh[1] << 16), hh[2] | (hh[3] << 16)}; ml[qi] = (u32x2){ll[0] | (ll[1] << 16), ll[2] | (ll[3] << 16)}; }
            { f32x4 acc = {0.f, 0.f, 0.f, 0.f};
#pragma unroll
              for (int ks = 0; ks < 2; ++ks) { acc = mfma16(ldsfrag(lds, O_BH, 16 * rt + fr, 32 * ks + 8 * fq), ldsfrag(lds, O_XT, 64 + 16 * tb + fr, 32 * ks + 8 * fq), acc);
                  acc = mfma16(ldsfrag(lds, O_KH, 16 * rt + fr, 32 * ks + 8 * fq), ldsfrag(lds, O_VT, 16 * tb + fr, 32 * ks + 8 * fq), acc); }
              nv[qi] = acc; }
        }
        __syncthreads();
#pragma unroll
        for (int qi = 0; qi < 2; ++qi) { const int rt = 2 * hb + qi, row = 16 * tb + fr, col = 16 * rt + 4 * fq;
            *(LAS u32x2*)(lds + S_RP + (row * SST + col) * 2) = rp[qi]; *(LAS u32x2*)(lds + S_MH + (row * SST + col) * 2) = mh[qi]; *(LAS u32x2*)(lds + S_ML + (row * SST + col) * 2) = ml[qi];
            *(LAS f32x4*)(lds + S_YL + (row * YLS + col) * 4) = yl[qi]; *(LAS f32x4*)(lds + S_NN + (row * YLS + col) * 4) = nv[qi]; }
        __syncthreads();
        unsigned char* gRP = ws + WS_RP + (size_t)u * 8192; unsigned char* gYL = ws + WS_YL + (size_t)u * 16384;
        unsigned char* gMH = ws + WS_MT + (size_t)u * 8192; unsigned char* gML = gMH + (size_t)NUNIT_A * 8192; unsigned char* gNN = ws + WS_NN + (size_t)u * 16384;
        const int tid = 64 * wave + lane;
        { const int row = tid >> 3, ch = tid & 7, lo = (row * SST) * 2 + ch * 16;
          *(u32x4*)(gRP + tid * 16) = *(const LAS u32x4*)(lds + S_RP + lo); *(u32x4*)(gMH + tid * 16) = *(const LAS u32x4*)(lds + S_MH + lo); *(u32x4*)(gML + tid * 16) = *(const LAS u32x4*)(lds + S_ML + lo); }
#pragma unroll
        for (int k = 0; k < 2; ++k) { const int cidx = tid + 512 * k, row = cidx >> 4, c4 = cidx & 15, lo = (row * YLS) * 4 + c4 * 16;
            *(u32x4*)(gYL + cidx * 16) = *(const LAS u32x4*)(lds + S_YL + lo); *(u32x4*)(gNN + cidx * 16) = *(const LAS u32x4*)(lds + S_NN + lo); }
    }
}

__device__ __forceinline__ void scan_sample_item(KP p, const Ctx& c, int li, int item) {
    unsigned char* ws = p->ws; const int lane = c.lane, b = item >> 4, h = item & 15, C = 64 * h + lane; const size_t pc = (size_t)li * D + C;
    LAS float* sc = (LAS float*)(c.lds + c.wave * 16384);
    const float* Rb = (const float*)(ws + WS_RK_R); const float* Kb = (const float*)(ws + WS_RK_K);
    float* Vb = (float*)(ws + (li ? WS_V1 : WS_V0)); const float* V0b = (const float*)(ws + WS_V0);
    const bf16_t* HID = (const bf16_t*)(ws + WS_HID) + (size_t)(MP + 4 * b) * LHID;
    for (int e = lane; e < 4 * LHID; e += 64) sc[e] = bf2f(HID[e]);
    LDS_WAIT();
    float lw[4] = {0.f, 0.f, 0.f, 0.f}, la[4] = {0.f, 0.f, 0.f, 0.f}, lv[4] = {0.f, 0.f, 0.f, 0.f}, lg[4] = {0.f, 0.f, 0.f, 0.f};
    {
        const bf16_t* W2W = (const bf16_t*)(ws + WS_W2W) + ((size_t)li * 1024 + C) * 64; const bf16_t* W2A = (const bf16_t*)(ws + WS_W2A) + ((size_t)li * 1024 + C) * 64;
        const bf16_t* W2V = (const bf16_t*)(ws + WS_W2V) + (size_t)C * 32; const bf16_t* W2G = (const bf16_t*)(ws + WS_W2G) + ((size_t)li * 1024 + C) * 128;
#define LORA2_BLK(WP, QB, HOFF, ACC) { const u32x4 w8 = *(const u32x4*)((WP) + 8 * (QB)); \
            const float wf0 = bflo(w8.x), wf1 = bfhi(w8.x), wf2 = bflo(w8.y), wf3 = bfhi(w8.y), wf4 = bflo(w8.z), wf5 = bfhi(w8.z), wf6 = bflo(w8.w), wf7 = bfhi(w8.w); \
            _Pragma("unroll") for (int t = 0; t < 4; ++t) { const f32x4 h0 = *(const LAS f32x4*)(sc + t * LHID + (HOFF) + 8 * (QB)), h1 = *(const LAS f32x4*)(sc + t * LHID + (HOFF) + 8 * (QB) + 4); \
                ACC[t] += (h0[0] * wf0 + h0[1] * wf1) + (h0[2] * wf2 + h0[3] * wf3) + (h1[0] * wf4 + h1[1] * wf5) + (h1[2] * wf6 + h1[3] * wf7); } \
            asm volatile("" : "+v"(ACC[0]), "+v"(ACC[1]), "+v"(ACC[2]), "+v"(ACC[3]) :: "memory"); }
#pragma unroll
        for (int qb = 0; qb < 8; ++qb) { LORA2_BLK(W2W, qb, 0, lw) LORA2_BLK(W2A, qb, 64, la) }
        if (li) {
#pragma unroll
            for (int qb = 0; qb < 4; ++qb) LORA2_BLK(W2V, qb, 128, lv) }
#pragma unroll
        for (int qb = 0; qb < 16; ++qb) LORA2_BLK(W2G, qb, 160, lg)
#undef LORA2_BLK
    }
    const float w0 = p->in[I_W0][pc], a0 = p->in[I_A0][pc], kkc = p->in[I_KK][pc], kac = p->in[I_KA][pc], rkc = p->in[I_RKK][pc], v0 = li ? p->in[I_V0][C] : 0.f;
    const float lnw = p->in[I_LNW][pc], lnb = p->in[I_LNB][pc];
    float S[64];
    { const f32x4* sp = (const f32x4*)(p->in[I_SWKV] + (((size_t)li * SB + b) * H + h) * 4096 + lane * 64);
#pragma unroll
      for (int q = 0; q < 16; ++q) { const f32x4 x = sp[q]; S[4 * q] = x[0]; S[4 * q + 1] = x[1]; S[4 * q + 2] = x[2]; S[4 * q + 3] = x[3]; } }
    LAS float* bc = sc + 1280;
    bf16_t* YG = (bf16_t*)(ws + WS_YG);
#pragma unroll
    for (int t = 0; t < 4; ++t) { const size_t gi = (size_t)(MP + 4 * b + t) * D + C;
        const float r = Rb[gi], k = Kb[gi]; float v = Vb[gi];
        const float z = -(w0 + lw[t]); const float sp = fmaxf(z, 0.f) + __logf(1.0f + __expf(-fabsf(z))); const float wdec = __expf(-__expf(-sp - 0.5f));
        const float asig = sigmoidf_(a0 + la[t]);
        if (li) { const float vg = sigmoidf_(v0 + lv[t]); const float vf = V0b[gi]; v = v + (vf - v) * vg; }
        const float kkr = k * kkc; const float ss = wave_sum(kkr * kkr); const float kkn = kkr * frsq(fmaxf(ss, 1e-24f));
        const float kmod = k * (1.0f + (asig - 1.0f) * kac);
        const float rks = wave_sum(r * kmod * rkc);
        LDS_WAIT();
        bc[lane] = wdec; bc[64 + lane] = -kkn; bc[128 + lane] = kkn * asig; bc[192 + lane] = kmod; bc[256 + lane] = r;
        LDS_WAIT();
        float sa = 0.f;
#pragma unroll
        for (int q = 0; q < 16; ++q) { const f32x4 av = *(const LAS f32x4*)(bc + 64 + 4 * q); sa += S[4 * q] * av[0] + S[4 * q + 1] * av[1] + S[4 * q + 2] * av[2] + S[4 * q + 3] * av[3]; }
        float y = 0.f;
#pragma unroll
        for (int q = 0; q < 16; ++q) { const f32x4 wv = *(const LAS f32x4*)(bc + 4 * q), bv = *(const LAS f32x4*)(bc + 128 + 4 * q), kv = *(const LAS f32x4*)(bc + 192 + 4 * q), rv = *(const LAS f32x4*)(bc + 256 + 4 * q);
#pragma unroll
            for (int e = 0; e < 4; ++e) { const float s = S[4 * q + e] * wv[e] + sa * bv[e] + v * kv[e]; S[4 * q + e] = s; y += s * rv[e]; } }
        const float mean = wave_sum(y) * (1.0f / 64.0f); const float dy = y - mean; const float var = wave_sum(dy * dy) * (1.0f / 64.0f);
        const float yn = dy * (frsq(var + GN_EPS)) * lnw + lnb;
        YG[gi] = (bf16_t)f2bf((yn + rks * v) * lg[t]);
    }
    { f32x4* so = (f32x4*)(p->out + O_WKVS + (((size_t)li * SB + b) * H + h) * 4096 + lane * 64);
#pragma unroll
      for (int q = 0; q < 16; ++q) so[q] = (f32x4){S[4 * q], S[4 * q + 1], S[4 * q + 2], S[4 * q + 3]}; }
    LDS_WAIT();
}

__device__ __forceinline__ void phase_scanA(KP p, const Ctx& c, int li) {
    const int stop = p->pad;
    if (stop != 9) for (int u = blockIdx.x; u < NUNIT_A; u += gridDim.x) scanA_unit(p, c, li, u);
    __syncthreads();
    if (stop == 0 || stop == 9) for (int it = c.gw; it < SB * H; it += c.ngw) scan_sample_item(p, c, li, it);
}

__device__ __forceinline__ void hilo(const f32x4 x0, const f32x4 x1, bf16x8& hi, bf16x8& lo) {
    unsigned h[8], l[8];
#pragma unroll
    for (int e = 0; e < 8; ++e) { const float x = e < 4 ? x0[e] : x1[e - 4]; h[e] = f2bf(x); l[e] = f2bf(x - __builtin_bit_cast(float, h[e] << 16)); }
    u32x4 hv = {h[0] | (h[1] << 16), h[2] | (h[3] << 16), h[4] | (h[5] << 16), h[6] | (h[7] << 16)}, lv = {l[0] | (l[1] << 16), l[2] | (l[3] << 16), l[4] | (l[5] << 16), l[6] | (l[7] << 16)};
    hi = __builtin_bit_cast(bf16x8, hv); lo = __builtin_bit_cast(bf16x8, lv);
}
constexpr int SB_SLOT = 20480, SB_RING0 = 8192, SB_DEPTH = 6;
static_assert(SB_RING0 + SB_DEPTH * SB_SLOT <= RING_BYTES, "chain ring");
__device__ __forceinline__ void phase_scanB(KP p, const Ctx& c, int li) {
    unsigned char* ws = p->ws; LAS unsigned char* lds = c.lds; const int lane = c.lane, fr = lane & 15, fq = lane >> 4, wave = c.wave;
    volatile LAS int* FL = (volatile LAS int*)(lds + RING_BYTES);
    if (c.tid < 4) FL[c.tid] = 0;
    __syncthreads();
    const int ncb = (int)gridDim.x < 128 ? (int)gridDim.x : 128;
    if (wave >= 4 || (int)blockIdx.x >= ncb) {
        const int gwf = (int)blockIdx.x < ncb ? (int)blockIdx.x * 4 + (wave - 4) : ncb * 4 + ((int)blockIdx.x - ncb) * 8 + wave, ngwf = ncb * 4 + ((int)gridDim.x - ncb) * 8;
        phase_fill(p, c, li, gwf, ngwf); return; }
    if (wave != 0) {
        const int j = wave - 1; int prevG = -1, kc = 0;
        for (int ch = blockIdx.x; ch < 128; ch += gridDim.x, ++kc) { const int b = ch >> 6, h = (ch >> 2) & 15, iq = ch & 3;
            for (int n = j; n < NCH; n += 3) { const int G = kc * NCH + n;
                if (G >= SB_DEPTH) { unsigned sp = 0; while (FL[0] < G - (SB_DEPTH - 1)) { __builtin_amdgcn_s_sleep(1); if (++sp > (1u << 22)) break; } }
                LAS unsigned char* slot = lds + SB_RING0 + (G % SB_DEPTH) * SB_SLOT;
                const size_t u = (size_t)(b * NCH + n) * H + h; const bf16_t* MTH = (const bf16_t*)(ws + WS_MT) + u * 4096; const bf16_t* MTL = MTH + (size_t)NUNIT_A * 4096; const float* NN = (const float*)(ws + WS_NN) + u * 4096;
#pragma unroll
                for (int jt = 0; jt < 4; ++jt)
#pragma unroll
                    for (int ks = 0; ks < 2; ++ks) {
                        __builtin_amdgcn_global_load_lds((const unsigned*)(MTH + (size_t)(16 * jt + fr) * 64 + 32 * ks + 8 * fq), (LAS unsigned*)(slot + ((jt * 2 + ks) * 2 + 0) * 1024), 16, 0, 0);
                        __builtin_amdgcn_global_load_lds((const unsigned*)(MTL + (size_t)(16 * jt + fr) * 64 + 32 * ks + 8 * fq), (LAS unsigned*)(slot + ((jt * 2 + ks) * 2 + 1) * 1024), 16, 0, 0); }
#pragma unroll
                for (int jt = 0; jt < 4; ++jt)
                    __builtin_amdgcn_global_load_lds((const unsigned*)(NN + (size_t)(16 * iq + fr) * 64 + 16 * jt + 4 * fq), (LAS unsigned*)(slot + (16 + jt) * 1024), 16, 0, 0);
                asm volatile("s_waitcnt vmcnt(20)" ::: "memory");
                if (prevG >= 0) FL[1 + j] = prevG + 1;
                prevG = G; } }
        asm volatile("s_waitcnt vmcnt(0)" ::: "memory");
        if (prevG >= 0) FL[1 + j] = prevG + 1;
        return; }
    int kc = 0;
    for (int ch = blockIdx.x; ch < 128; ch += gridDim.x, ++kc) {
        const int b = ch >> 6, h = (ch >> 2) & 15, iq = ch & 3;
        f32x4 S[4];
#pragma unroll
        for (int jt = 0; jt < 4; ++jt) S[jt] = (f32x4){0.f, 0.f, 0.f, 0.f};
        int j3 = 0;
        for (int n = 0; n < NCH; ++n) { const int G = kc * NCH + n;
            const size_t u = (size_t)(b * NCH + n) * H + h; bf16_t* S0 = (bf16_t*)(ws + WS_S0) + u * 4096;
            { unsigned sp = 0; while (FL[1 + j3] < G + 1) { __builtin_amdgcn_s_sleep(1); if (++sp > (1u << 22)) break; } }
            const LAS unsigned char* slot = lds + SB_RING0 + (G % SB_DEPTH) * SB_SLOT + lane * 16;
            bf16x8 ah[4][2], al[4][2]; f32x4 nn[4];
#pragma unroll
            for (int jt = 0; jt < 4; ++jt) { nn[jt] = *(const LAS f32x4*)(slot + (16 + jt) * 1024);
#pragma unroll
                for (int ks = 0; ks < 2; ++ks) { ah[jt][ks] = *(const LAS bf16x8*)(slot + ((jt * 2 + ks) * 2 + 0) * 1024); al[jt][ks] = *(const LAS bf16x8*)(slot + ((jt * 2 + ks) * 2 + 1) * 1024); } }
#pragma unroll
            for (int jt = 0; jt < 4; ++jt) { unsigned hh[4], ll[4];
#pragma unroll
                for (int r = 0; r < 4; ++r) { hh[r] = f2bf(S[jt][r]); ll[r] = f2bf(S[jt][r] - __builtin_bit_cast(float, hh[r] << 16)); }
                u32x2 wh = {hh[0] | (hh[1] << 16), hh[2] | (hh[3] << 16)}, wl = {ll[0] | (ll[1] << 16), ll[2] | (ll[3] << 16)};
                *(u32x2*)(S0 + (size_t)(16 * iq + fr) * 64 + 16 * jt + 4 * fq) = wh;
                *(LAS u32x2*)(lds + (fr * SST + 16 * jt + 4 * fq) * 2) = wh; *(LAS u32x2*)(lds + 4096 + (fr * SST + 16 * jt + 4 * fq) * 2) = wl; }
            LDS_WAIT();
            bf16x8 bh[2], bl[2];
#pragma unroll
            for (int ks = 0; ks < 2; ++ks) { bh[ks] = *(const LAS bf16x8*)(lds + (fr * SST + 32 * ks + 8 * fq) * 2); bl[ks] = *(const LAS bf16x8*)(lds + 4096 + (fr * SST + 32 * ks + 8 * fq) * 2); }
#pragma unroll
            for (int jt = 0; jt < 4; ++jt) { f32x4 acc = nn[jt];
#pragma unroll
                for (int ks = 0; ks < 2; ++ks) { acc = mfma16(ah[jt][ks], bh[ks], acc); acc = mfma16(ah[jt][ks], bl[ks], acc); acc = mfma16(al[jt][ks], bh[ks], acc); }
                S[jt] = acc; }
            LDS_WAIT();
            FL[0] = G + 1;
            j3 = j3 == 2 ? 0 : j3 + 1;
        }
        float* so = p->out + O_WKVP + (((size_t)li * NB + b) * H + h) * 4096;
#pragma unroll
        for (int jt = 0; jt < 4; ++jt) *(f32x4*)(so + (size_t)(16 * iq + fr) * 64 + 16 * jt + 4 * fq) = S[jt];
    }
}

__device__ __forceinline__ void phase_scanC(KP p, const Ctx& c, int li) {
    unsigned char* ws = p->ws; const int lane = c.lane, fr = lane & 15, fq = lane >> 4, hb = c.wave >> 2, tt = c.wave & 3;
    const float* Vb = (const float*)(ws + (li ? WS_V1 : WS_V0)); const bf16_t* HID = (const bf16_t*)(ws + WS_HID); const bf16_t* W2G = (const bf16_t*)(ws + WS_W2G) + (size_t)li * 1024 * 128;
    bf16_t* YG = (bf16_t*)(ws + WS_YG);
    for (int up = blockIdx.x; up < NUNIT_A / 2; up += gridDim.x) {
        const int u = 2 * up + hb; const int b = u / (NCH * H), n = (u / H) % NCH, h = u % H; const int row = b * TP + 64 * n + 16 * tt + fr;
        const bf16_t* RP = (const bf16_t*)(ws + WS_RP) + (size_t)u * 4096; const float* YL = (const float*)(ws + WS_YL) + (size_t)u * 4096; const bf16_t* S0 = (const bf16_t*)(ws + WS_S0) + (size_t)u * 4096;
        f32x4 acc[4], ag[4];
#pragma unroll
        for (int it = 0; it < 4; ++it) { acc[it] = *(const f32x4*)(YL + (size_t)(16 * tt + fr) * 64 + 16 * it + 4 * fq); ag[it] = (f32x4){0.f, 0.f, 0.f, 0.f}; }
#pragma unroll
        for (int ks = 0; ks < 2; ++ks) { const bf16x8 bq = *(const bf16x8*)(RP + (size_t)(16 * tt + fr) * 64 + 32 * ks + 8 * fq);
#pragma unroll
            for (int it = 0; it < 4; ++it) acc[it] = mfma16(*(const bf16x8*)(S0 + (size_t)(16 * it + fr) * 64 + 32 * ks + 8 * fq), bq, acc[it]); }
        const bf16_t* hgp = launder_p(HID + (size_t)row * LHID + 160 + 8 * fq); const bf16_t* wgp = launder_p(W2G + (size_t)(64 * h + fr) * 128 + 8 * fq);
#pragma unroll
        for (int ks = 0; ks < 4; ++ks) { const bf16x8 bq = *(const bf16x8*)(hgp + 32 * ks);
#pragma unroll
            for (int it = 0; it < 4; ++it) ag[it] = mfma16(*(const bf16x8*)(wgp + it * 16 * 128 + 32 * ks), bq, ag[it]); }
        float s = 0.f;
#pragma unroll
        for (int it = 0; it < 4; ++it) s += (acc[it][0] + acc[it][1]) + (acc[it][2] + acc[it][3]);
        s = sum_rows4(s); const float mean = s * (1.0f / 64.0f);
        float q = 0.f;
#pragma unroll
        for (int it = 0; it < 4; ++it) { const f32x4 d = acc[it] - mean; q += (d[0] * d[0] + d[1] * d[1]) + (d[2] * d[2] + d[3] * d[3]); }
        q = sum_rows4(q); const float rstd = frsq(q * (1.0f / 64.0f) + GN_EPS);
        const float rks = ((const float*)(ws + WS_RKS))[(size_t)row * 16 + h];
#pragma unroll
        for (int it = 0; it < 4; ++it) { const int C = 64 * h + 16 * it + 4 * fq; const size_t pc = (size_t)li * D + C;
            const f32x4 lw = *(const f32x4*)(p->in[I_LNW] + pc), lb = *(const f32x4*)(p->in[I_LNB] + pc), v = *(const f32x4*)(Vb + (size_t)row * D + C);
            const f32x4 o = ((acc[it] - mean) * rstd * lw + lb + v * rks) * ag[it];
            u32x2 w; w.x = pk2(o[0], o[1]); w.y = pk2(o[2], o[3]); *(u32x2*)(YG + (size_t)row * D + C) = w; }
    }
}
__device__ __forceinline__ void ld8bf(const bf16_t* p, float (&o)[8]) { const u32x4 w = *(const u32x4*)p; o[0] = bflo(w.x); o[1] = bfhi(w.x); o[2] = bflo(w.y); o[3] = bfhi(w.y); o[4] = bflo(w.z); o[5] = bfhi(w.z); o[6] = bflo(w.w); o[7] = bfhi(w.w); }
__device__ __forceinline__ void ld8f(const float* p, float (&o)[8]) { const f32x4 a = *(const f32x4*)p, b = *(const f32x4*)(p + 4); o[0] = a[0]; o[1] = a[1]; o[2] = a[2]; o[3] = a[3]; o[4] = b[0]; o[5] = b[1]; o[6] = b[2]; o[7] = b[3]; }
__device__ __forceinline__ void phase_conv(KP p, const Ctx& c, int layer) {
    const bf16_t* U = (const bf16_t*)(p->ws + WS_U); const bf16_t* GT = (const bf16_t*)(p->ws + WS_GT); bf16_t* HH = (bf16_t*)(p->ws + WS_HH);
    const float* cw = p->in[I_CONVW] + (size_t)layer * 3 * DFF; const float* cb = p->in[I_CONVB] + (size_t)layer * DFF; const float* st = p->in[I_SCONV] + (size_t)layer * SB * 2 * DFF;
    constexpr int NF8 = DFF / 8;
    for (int e = c.gtid; e < R * NF8; e += c.gsz) { const int row = e / NF8, f = 8 * (e % NF8);
        int t, b; if (row < MP) { t = row & (TP - 1); b = -1; } else { t = (row - MP) & 3; b = (row - MP) >> 2; }
        float u0[8], u1[8], u2[8], g[8], w0[8], w1[8], w2[8], bb[8];
        ld8bf(U + (size_t)row * DFF + f, u2); ld8bf(GT + (size_t)row * DFF + f, g);
        if (t >= 1) ld8bf(U + (size_t)(row - 1) * DFF + f, u1); else if (b >= 0) ld8f(st + ((size_t)b * 2 + 1) * DFF + f, u1); else {
#pragma unroll
            for (int i = 0; i < 8; ++i) u1[i] = 0.f; }
        if (t >= 2) ld8bf(U + (size_t)(row - 2) * DFF + f, u0); else if (b >= 0) ld8f(st + ((size_t)b * 2 + t) * DFF + f, u0); else {
#pragma unroll
            for (int i = 0; i < 8; ++i) u0[i] = 0.f; }
        ld8f(cw + f, w0); ld8f(cw + DFF + f, w1); ld8f(cw + 2 * DFF + f, w2); ld8f(cb + f, bb);
        float o[8];
#pragma unroll
        for (int i = 0; i < 8; ++i) o[i] = gelu_tanh(bb[i] + w0[i] * u0[i] + w1[i] * u1[i] + w2[i] * u2[i]) * g[i];
        u32x4 w; w.x = pk2(o[0], o[1]); w.y = pk2(o[2], o[3]); w.z = pk2(o[4], o[5]); w.w = pk2(o[6], o[7]);
        *(u32x4*)(HH + (size_t)row * DFF + f) = w; }
}

__device__ __forceinline__ void phase_kvpost(KP p, const Ctx& c) {
    const float* KVF = (const float*)(p->ws + WS_KVF); unsigned char* ws = p->ws; const int lane = c.lane, g = lane >> 4, d0 = 4 * (lane & 15);
    const f32x4 gs = *(const f32x4*)(p->in[I_KNG] + 64 + d0), gw = *(const f32x4*)(p->in[I_KNG] + 128 + d0);
    bf16_t* CA = (bf16_t*)(ws + WS_CMPA); bf16_t* KS = (bf16_t*)(ws + WS_KS); bf16_t* VS = (bf16_t*)(ws + WS_VS); bf16_t* KW = (bf16_t*)(ws + WS_KW); bf16_t* VW = (bf16_t*)(ws + WS_VW);
    for (int chunk = c.gw; chunk < R / 8; chunk += c.ngw) {
        unsigned vs_[4][4], vw_[4][4];
#pragma unroll
        for (int e = 0; e < 8; ++e) { const int row = chunk * 8 + e; const float* src = KVF + (size_t)row * NKV + 4 * lane;
            f32x4 v[6];
#pragma unroll
            for (int pt = 0; pt < 6; ++pt) v[pt] = *(const f32x4*)(src + pt * 256);
            { float s = (v[2][0] * v[2][0] + v[2][1] * v[2][1]) + (v[2][2] * v[2][2] + v[2][3] * v[2][3]);
              s = row16_sum(s); const float rs = frsq(s * (1.0f / 64.0f) + NORM_EPS); v[2] = v[2] * rs * gs; }
            { float s = (v[4][0] * v[4][0] + v[4][1] * v[4][1]) + (v[4][2] * v[4][2] + v[4][3] * v[4][3]);
              s = row16_sum(s); const float rs = frsq(s * (1.0f / 64.0f) + NORM_EPS); v[4] = v[4] * rs * gw; }
            float* okv = p->out + O_KV + (size_t)row * D + 4 * lane;
#pragma unroll
            for (int pt = 0; pt < 4; ++pt) *(f32x4*)(okv + pt * 256) = v[pt];
            if (row < MP) { const int b = row >> 13, t = row & (TP - 1);
                if (t >= TP - WIN) { float* ow = p->out + O_WINP + ((size_t)(b * WIN + (t - (TP - WIN))) * 2) * 256 + 4 * lane; *(f32x4*)ow = v[4]; *(f32x4*)(ow + 256) = v[5]; }
                const size_t hb = (size_t)(b * G + g);
                { u32x2 w; w.x = pk2(v[0][0], v[0][1]); w.y = pk2(v[0][2], v[0][3]); *(u32x2*)(CA + (hb * 512 + (t >> 4)) * 1024 + (t & 15) * 64 + d0) = w; }
                { u32x2 w; w.x = pk2(v[1][0], v[1][1]); w.y = pk2(v[1][2], v[1][3]); *(u32x2*)(CA + ((size_t)4096 + hb * 512 + (t >> 4)) * 1024 + (t & 15) * 64 + d0) = w; }
                { u32x2 w; w.x = pk2(v[2][0], v[2][1]); w.y = pk2(v[2][2], v[2][3]); *(u32x2*)(KS + (hb * TP + t) * 64 + d0) = w; }
                { u32x2 w; w.x = pk2(v[4][0], v[4][1]); w.y = pk2(v[4][2], v[4][3]); *(u32x2*)(KW + (hb * TP + t) * 64 + d0) = w; }
#pragma unroll
                for (int d = 0; d < 4; ++d) { const unsigned a = f2bf(v[3][d]), bq = f2bf(v[5][d]);
                    if (e & 1) { vs_[d][e >> 1] |= a << 16; vw_[d][e >> 1] |= bq << 16; } else { vs_[d][e >> 1] = a; vw_[d][e >> 1] = bq; } }
            } else { const int b = (row - MP) >> 2, t = (row - MP) & 3;
                float* ow = p->out + O_WINS + ((size_t)(b * WIN + 508 + t) * 2) * 256 + 4 * lane; *(f32x4*)ow = v[4]; *(f32x4*)(ow + 256) = v[5]; }
        }
        if (chunk * 8 < MP) { const int row = chunk * 8, b = row >> 13, t = row & (TP - 1); const size_t hb = (size_t)(b * G + g);
#pragma unroll
            for (int d = 0; d < 4; ++d) { *(u32x4*)(VS + (hb * 64 + d0 + d) * TP + t) = (u32x4){vs_[d][0], vs_[d][1], vs_[d][2], vs_[d][3]};
                *(u32x4*)(VW + (hb * 64 + d0 + d) * TP + t) = (u32x4){vw_[d][0], vw_[d][1], vw_[d][2], vw_[d][3]}; } }
    }
}

__device__ __forceinline__ void phase_cmp2(KP p, const Ctx& c) {
    unsigned char* ws = p->ws; const float* PC = (const float*)(ws + WS_PCMP); const int lane = c.lane, fr = lane & 15, fq = lane >> 4;
    const bf16_t* W2H = (const bf16_t*)(ws + WS_CW2T); const bf16_t* W2L = W2H + 2 * 64 * 128;
    constexpr int NPI = NB * G * 32, NSI = SB * G * 8, TOT = 2 * (NPI + NSI);
    for (int it = c.gw; it < TOT; it += c.ngw) {
        const bool samp = it >= 2 * NPI; const int r = samp ? it - 2 * NPI : it; const int kv = samp ? r / NSI : r / NPI; const int idx = samp ? r % NSI : r % NPI;
        const int hb = samp ? (idx >> 3) : (idx >> 5), n0 = 16 * (samp ? (idx & 7) : (idx & 31)), ncmp = samp ? NCMP_S : NCMP_P, nper = samp ? 128 : 512;
        const int n = n0 + fr; const bool live = n < ncmp;
        const size_t prow = (samp ? (size_t)8192 + (size_t)kv * 65536 : (size_t)kv * 4096) + (size_t)hb * nper + (live ? n : ncmp - 1);
        const float* cb = (const float*)(ws + WS_CBIAS) + kv * 128;
        bf16x8 hh[4], hl[4];
#pragma unroll
        for (int ks = 0; ks < 4; ++ks) { const int k0 = 32 * ks + 8 * fq; unsigned uh[8], ul[8];
            const f32x4 a0 = *(const f32x4*)(PC + prow * 256 + k0), a1 = *(const f32x4*)(PC + prow * 256 + k0 + 4);
            const f32x4 b0 = *(const f32x4*)(PC + (prow + 1) * 256 + 128 + k0), b1 = *(const f32x4*)(PC + (prow + 1) * 256 + 128 + k0 + 4);
            const f32x4 c0 = *(const f32x4*)(cb + k0), c1 = *(const f32x4*)(cb + k0 + 4);
#pragma unroll
            for (int e = 0; e < 8; ++e) { const float x = e < 4 ? a0[e] + b0[e] + c0[e] : a1[e - 4] + b1[e - 4] + c1[e - 4]; const float hv = gelu_tanh(x);
                uh[e] = f2bf(hv); ul[e] = f2bf(hv - __builtin_bit_cast(float, uh[e] << 16)); }
            const u32x4 wh = {uh[0] | (uh[1] << 16), uh[2] | (uh[3] << 16), uh[4] | (uh[5] << 16), uh[6] | (uh[7] << 16)}, wl = {ul[0] | (ul[1] << 16), ul[2] | (ul[3] << 16), ul[4] | (ul[5] << 16), ul[6] | (ul[7] << 16)};
            hh[ks] = __builtin_bit_cast(bf16x8, wh); hl[ks] = __builtin_bit_cast(bf16x8, wl); }
        f32x4 acc[4];
#pragma unroll
        for (int dt = 0; dt < 4; ++dt) { acc[dt] = *(const f32x4*)(p->in[I_CB2] + kv * 64 + 16 * dt + 4 * fq);
#pragma unroll
            for (int ks = 0; ks < 4; ++ks) { const size_t wo = (size_t)(kv * 64 + 16 * dt + fr) * 128 + 32 * ks + 8 * fq; const bf16x8 wh = *(const bf16x8*)(W2H + wo), wl = *(const bf16x8*)(W2L + wo);
                acc[dt] = mfma16(wh, hh[ks], acc[dt]); acc[dt] = mfma16(wh, hl[ks], acc[dt]); acc[dt] = mfma16(wl, hh[ks], acc[dt]); } }
        if (kv == 0) { float ss = 0.f;
#pragma unroll
            for (int dt = 0; dt < 4; ++dt) ss += (acc[dt][0] * acc[dt][0] + acc[dt][1] * acc[dt][1]) + (acc[dt][2] * acc[dt][2] + acc[dt][3] * acc[dt][3]);
            ss = sum_rows4(ss); const float rs = frsq(ss * (1.0f / 64.0f) + NORM_EPS);
#pragma unroll
            for (int dt = 0; dt < 4; ++dt) acc[dt] = acc[dt] * rs * *(const f32x4*)(p->in[I_KNG] + 16 * dt + 4 * fq); }
#pragma unroll
        for (int dt = 0; dt < 4; ++dt) { const f32x4 o = live ? acc[dt] : (f32x4){0.f, 0.f, 0.f, 0.f}; const int d = 16 * dt + 4 * fq;
            if (samp) *(f32x4*)((float*)(ws + (kv ? WS_CVS : WS_CKS)) + ((size_t)hb * 128 + n) * 64 + d) = o;
            else if (kv == 0) { u32x2 w; w.x = pk2(o[0], o[1]); w.y = pk2(o[2], o[3]); *(u32x2*)((bf16_t*)(ws + WS_CK) + ((size_t)hb * 512 + n) * 64 + d) = w; }
            else {
#pragma unroll
                for (int e = 0; e < 4; ++e) ((bf16_t*)(ws + WS_CV))[((size_t)hb * 64 + d + e) * 512 + n] = (bf16_t)f2bf(o[e]); } }
    }
}

__device__ __forceinline__ void phase_qpost(KP p, const Ctx& c, int lb) {
    const float* QF = (const float*)(p->ws + WS_QF); bf16_t* Q = (bf16_t*)(p->ws + WS_Q); const int lane = c.lane;
    const f32x4 gq = *(const f32x4*)(p->in[I_QNG] + lb * 64 + 4 * (lane & 15));
    for (int row = c.gw; row < R; row += c.ngw) { const float* src = QF + (size_t)row * NQP;
        f32x4 v[4]; load_row(src, lane, v);
#pragma unroll
        for (int j = 0; j < 4; ++j) { float s = (v[j][0] * v[j][0] + v[j][1] * v[j][1]) + (v[j][2] * v[j][2] + v[j][3] * v[j][3]);
            s = row16_sum(s);
            const float rs = (frsq(s * (1.0f / 64.0f) + NORM_EPS)) * (0.125f * 1.4426950408889634f); v[j] = v[j] * rs * gq; }
        store_row_bf16(Q + (size_t)row * D, lane, v);
    }
}
constexpr int AT_K0 = 0, AT_V0 = 9216, AT_K1 = 18432, AT_V1 = 27648, AT_IMP = 36864, IMPS = 132, AT_SELM = AT_IMP + 64 * IMPS * 4, AT_ANY = AT_SELM + 1024;
static_assert(AT_ANY + 16 <= RING_BYTES, "attention LDS map");
struct TileSrc { const bf16_t* K; const bf16_t* VT; int vts; };
__device__ __forceinline__ void tile_load(const TileSrc& s, int key0, int tid, u32x4& rk, u32x4& rv) {
    const int row = tid >> 3, ch = tid & 7;
    rk = *(const u32x4*)(s.K + (size_t)(key0 + row) * 64 + 8 * ch); rv = *(const u32x4*)(s.VT + (size_t)row * s.vts + key0 + 8 * ch);
}
__device__ __forceinline__ void tile_load_async(const TileSrc& s, int key0, int tid, u32x4& rk, u32x4& rv) {
    const int row = tid >> 3, ch = tid & 7;
    const bf16_t* pk = s.K + (size_t)(key0 + row) * 64 + 8 * ch; const bf16_t* pv = s.VT + (size_t)row * s.vts + key0 + 8 * ch;
    asm volatile("global_load_dwordx4 %0, %2, off\n\tglobal_load_dwordx4 %1, %3, off" : "=&v"(rk), "=&v"(rv) : "v"(pk), "v"(pv) : "memory");
}
#define TILE_WAIT(N_, RK_, RV_) asm volatile("s_waitcnt vmcnt(" #N_ ")" : "+v"(RK_), "+v"(RV_) :: "memory")
__device__ __forceinline__ void tile_store(LAS unsigned char* lds, int buf, int tid, const u32x4& rk, const u32x4& rv) {
    const int row = tid >> 3, ch = tid & 7;
    *(LAS u32x4*)(lds + (buf ? AT_K1 : AT_K0) + (row * SST + 8 * ch) * 2) = rk; *(LAS u32x4*)(lds + (buf ? AT_V1 : AT_V0) + (row * SST + 8 * ch) * 2) = rv;
}
__device__ __forceinline__ int first_bit4(unsigned a, unsigned b, unsigned c, unsigned d) { return a ? __ffs(a) - 1 : (b ? 32 + __ffs(b) - 1 : (c ? 64 + __ffs(c) - 1 : (d ? 96 + __ffs(d) - 1 : -1))); }
__device__ __forceinline__ float ex2(float x) { return __builtin_amdgcn_exp2f(x); }

__device__ __forceinline__ void set_bit4(int s, unsigned& t0, unsigned& t1, unsigned& t2, unsigned& t3) { const unsigned bit = 1u << (s & 31); const int w = s >> 5; t0 |= (w == 0) ? bit : 0u; t1 |= (w == 1) ? bit : 0u; t2 |= (w == 2) ? bit : 0u; t3 |= (w == 3) ? bit : 0u; }
__device__ __forceinline__ void clr_bit4(int s, unsigned& t0, unsigned& t1, unsigned& t2, unsigned& t3) { const unsigned bit = 1u << (s & 31); const int w = s >> 5; t0 &= ~((w == 0) ? bit : 0u); t1 &= ~((w == 1) ? bit : 0u); t2 &= ~((w == 2) ? bit : 0u); t3 &= ~((w == 3) ? bit : 0u); }
__device__ __forceinline__ unsigned get_word4(int s, unsigned a, unsigned b, unsigned c, unsigned d) { const int w = s >> 5; return ((w == 0) ? a : 0u) | ((w == 1) ? b : 0u) | ((w == 2) ? c : 0u) | ((w == 3) ? d : 0u); }
__device__ __forceinline__ float dpp_xor1(float x) { return __builtin_bit_cast(float, __builtin_amdgcn_update_dpp(0, __builtin_bit_cast(int, x), 0xB1, 0xF, 0xF, true)); }
__device__ __forceinline__ float dpp_xor2(float x) { return __builtin_bit_cast(float, __builtin_amdgcn_update_dpp(0, __builtin_bit_cast(int, x), 0x4E, 0xF, 0xF, true)); }
template <int MODE, bool EDGE> __device__ __forceinline__ void attn_tile(LAS unsigned char* lds, int buf, const bf16x8 (&qf)[4], int key0, int qpos, int r, int hf,
                                                                          float& l, f32x16 (&O)[2], float invl, bool selbit, LAS float* impq) {
    if (MODE == 3) { if (__ballot(selbit) == 0ull) { asm volatile("" : "+v"(O[0]), "+v"(O[1]), "+v"(l)); return; } }
    const float sbias = selbit ? 0.f : -1.0e30f;
    const int oK = buf ? AT_K1 : AT_K0, oV = buf ? AT_V1 : AT_V0;
#pragma unroll
    for (int kt = 0; kt < 2; ++kt) {
        f32x16 S;
#pragma unroll
        for (int i = 0; i < 16; ++i) S[i] = (MODE == 3) ? sbias : 0.f;
#pragma unroll
        for (int ks = 0; ks < 4; ++ks) S = mfma32(*(const LAS bf16x8*)(lds + oK + ((32 * kt + r) * SST + 16 * ks + 8 * hf) * 2), qf[ks], S);
        float ls = 0.f;
#pragma unroll
        for (int i = 0; i < 16; ++i) { float pv = ex2(S[i]);
            if (EDGE) { const int key = key0 + 32 * kt + (i & 3) + 8 * (i >> 2) + 4 * hf; bool v;
                if (MODE <= 1) v = (16 * key + 31 <= qpos); else if (MODE == 2) v = (key <= qpos) && (key + WIN > qpos); else v = (key <= qpos);
                pv = v ? pv : 0.f; }
            if (MODE == 1) pv *= invl;
            S[i] = pv; ls += pv; }
        if (MODE != 1) l += ls;
        if (MODE >= 1) {
#pragma unroll
            for (int sp = 0; sp < 2; ++sp) {
                u32x4 pw; pw.x = pg8::cvt_pk_bf16(S[8 * sp + 0], S[8 * sp + 1]); pw.y = pg8::cvt_pk_bf16(S[8 * sp + 2], S[8 * sp + 3]); pw.z = pg8::cvt_pk_bf16(S[8 * sp + 4], S[8 * sp + 5]); pw.w = pg8::cvt_pk_bf16(S[8 * sp + 6], S[8 * sp + 7]);
                const bf16x8 pf = __builtin_bit_cast(bf16x8, pw);
#pragma unroll
                for (int dt = 0; dt < 2; ++dt) { const int d = 32 * dt + r, kb = 32 * kt + 16 * sp + 4 * hf;
                    const u32x2 lo = *(const LAS u32x2*)(lds + oV + (d * SST + kb) * 2), hi = *(const LAS u32x2*)(lds + oV + (d * SST + kb + 8) * 2);
                    const u32x4 vw = {lo.x, lo.y, hi.x, hi.y};
                    O[dt] = mfma32(__builtin_bit_cast(bf16x8, vw), pf, O[dt]); } }
        }
        if (MODE == 1) {
            float own[4], nxt[4];
#pragma unroll
            for (int gq = 0; gq < 4; ++gq) { const float p3 = S[4 * gq + 3]; float o = 2.0f * (S[4 * gq] + S[4 * gq + 1] + S[4 * gq + 2]) + p3, n = p3;
                o += dpp_xor1(o); o += dpp_xor2(o); n += dpp_xor1(n); n += dpp_xor2(n); own[gq] = o; nxt[gq] = n; }
            const int sbb = (key0 >> 2) + 8 * kt + hf;
            if ((r & 3) == 0) {
#pragma unroll
                for (int gq = 0; gq < 4; ++gq) impq[sbb + 2 * gq] += own[gq]; }
            asm volatile("s_waitcnt lgkmcnt(0)" ::: "memory");
            if ((r & 3) == 0) {
#pragma unroll
                for (int gq = 0; gq < 4; ++gq) impq[sbb + 2 * gq + 1] += nxt[gq]; }
            asm volatile("s_waitcnt lgkmcnt(0)" ::: "memory");
        }
    }
}

template <int MODE> __device__ __forceinline__ void run_tiles(LAS unsigned char* lds, const TileSrc& src, unsigned t0, unsigned t1, unsigned t2, unsigned t3, int qt,
                                                              const bf16x8 (&qf)[4], int qpos, int r, int hf, int tid,
                                                              float& l, f32x16 (&O)[2], float invl, unsigned s0, unsigned s1, unsigned s2, unsigned s3, LAS float* impq, const int alias = 0) {
#define TSEL(n_) ((alias ? ((n_) & 7) : (n_)) * 64)
    tid = launder_v(tid); r = tid & 31; hf = (tid >> 5) & 1;
    int cur = first_bit4(t0, t1, t2, t3); if (cur < 0) return;
    const int first = cur;
    clr_bit4(cur, t0, t1, t2, t3); int n1 = first_bit4(t0, t1, t2, t3); if (n1 >= 0) clr_bit4(n1, t0, t1, t2, t3);
    int n2 = first_bit4(t0, t1, t2, t3); if (n2 >= 0) clr_bit4(n2, t0, t1, t2, t3);
    int n3 = first_bit4(t0, t1, t2, t3); if (n3 >= 0) clr_bit4(n3, t0, t1, t2, t3);
    u32x4 rkA, rvA, rkB, rvB, rkC, rvC; { u32x4 rk, rv; tile_load(src, TSEL(cur), tid, rk, rv); int b0 = 0; tile_store(lds, b0, tid, rk, rv); }
    tile_load_async(src, TSEL(n1 >= 0 ? n1 : first), tid, rkA, rvA);
    tile_load_async(src, TSEL(n2 >= 0 ? n2 : first), tid, rkB, rvB);
    tile_load_async(src, TSEL(n3 >= 0 ? n3 : first), tid, rkC, rvC);
    int buf = 0;
    __syncthreads();
#define RT_STEP(RK_, RV_) { \
        if (cur >= 0) { \
            const unsigned sw = get_word4(cur, s0, s1, s2, s3); \
            const bool sb = ((sw >> (cur & 31)) & 1u) != 0u; \
            if (MODE <= 1) attn_tile<MODE, true>(lds, buf, qf, cur * 64, qpos, r, hf, l, O, invl, sb, impq); \
            else { const bool edge = (cur == qt) || (MODE == 2 && cur == qt - 8); \
                if (edge) attn_tile<MODE, true>(lds, buf, qf, cur * 64, qpos, r, hf, l, O, invl, sb, impq); \
                else attn_tile<MODE, false>(lds, buf, qf, cur * 64, qpos, r, hf, l, O, invl, sb, impq); } } \
        TILE_WAIT(4, RK_, RV_); \
        tile_store(lds, buf ^ 1, tid, RK_, RV_); \
        __syncthreads(); \
        const int n4 = first_bit4(t0, t1, t2, t3); if (n4 >= 0) clr_bit4(n4, t0, t1, t2, t3); \
        tile_load_async(src, TSEL(n4 >= 0 ? n4 : first), tid, RK_, RV_); \
        buf ^= 1; cur = n1; n1 = n2; n2 = n3; n3 = n4; }
    do {
        RT_STEP(rkA, rvA)
        RT_STEP(rkB, rvB)
        RT_STEP(rkC, rvC)
    } while (cur >= 0);
#undef RT_STEP
    asm volatile("s_waitcnt vmcnt(0)" : "+v"(rkA), "+v"(rvA), "+v"(rkB), "+v"(rvB), "+v"(rkC), "+v"(rvC) :: "memory");
    __syncthreads();
}
__device__ __forceinline__ void attn_prompt_unit(KP p, const Ctx& c, int k, const int stop, const int lb) {
    LAS unsigned char* lds = c.lds; unsigned char* ws = p->ws; int tid_m; asm volatile("v_mbcnt_lo_u32_b32 %0, -1, 0\n\tv_mbcnt_hi_u32_b32 %0, -1, %0" : "=v"(tid_m));
    const int wave = c.wave, tid = tid_m + 64 * wave, lane = tid & 63, r = lane & 31, hf = lane >> 5;
    const int qt = 127 - (k >> 3), hb = k & 7, b = hb >> 2, g = hb & 3, q0 = 64 * qt;
    const int qi = 8 * wave + (r >> 2), head = 4 * g + (r & 3), qpos = q0 + qi, row = b * TP + qpos;
    bf16x8 qf[4];
    { const float* QFp = (const float*)(ws + WS_QF) + (size_t)row * NQP + head * 64 + 8 * hf; const float* gqp = p->in[I_QNG] + lb * 64 + 8 * hf;
      f32x4 qv[4][2]; float ss = 0.f;
#pragma unroll
      for (int ks = 0; ks < 4; ++ks) { qv[ks][0] = *(const f32x4*)(QFp + 16 * ks); qv[ks][1] = *(const f32x4*)(QFp + 16 * ks + 4);
#pragma unroll
          for (int e = 0; e < 4; ++e) ss += qv[ks][0][e] * qv[ks][0][e] + qv[ks][1][e] * qv[ks][1][e]; }
      ss = sum_xor32(ss);
      const float rs = frsq(ss * (1.0f / 64.0f) + NORM_EPS) * (0.125f * 1.4426950408889634f);
#pragma unroll
      for (int ks = 0; ks < 4; ++ks) { const f32x4 g0 = *(const f32x4*)(gqp + 16 * ks), g1 = *(const f32x4*)(gqp + 16 * ks + 4); const f32x4 a = qv[ks][0] * rs * g0, bq = qv[ks][1] * rs * g1;
          const u32x4 wq = {pk2(a[0], a[1]), pk2(a[2], a[3]), pk2(bq[0], bq[1]), pk2(bq[2], bq[3])}; qf[ks] = __builtin_bit_cast(bf16x8, wq); } }
    const float* gate = (const float*)(ws + WS_GATE) + (size_t)row * 48 + head * 3; const float g_c = gate[0], g_s = gate[1], g_w = gate[2];
    LAS float* imp = (LAS float*)(lds + AT_IMP); LAS unsigned* selm = (LAS unsigned*)(lds + AT_SELM); LAS unsigned* anym = (LAS unsigned*)(lds + AT_ANY);
    for (int e = tid; e < 64 * IMPS; e += 512) imp[e] = 0.f;
    if (tid < 4) anym[tid] = 0u;
    __syncthreads();
    f32x16 O[2]; unsigned OUTP[2][8];
#pragma unroll
    for (int dt = 0; dt < 2; ++dt)
#pragma unroll
        for (int i = 0; i < 16; ++i) O[dt][i] = 0.f;
    {
        const TileSrc src{(const bf16_t*)(ws + WS_CK) + (size_t)hb * 512 * 64, (const bf16_t*)(ws + WS_CV) + (size_t)hb * 64 * 512, 512};
        const int nmax = q0 + 63 - 31; const int ntc = nmax >= 0 ? (nmax >> 10) + 1 : 0;
        const unsigned tm = ntc >= 32 ? 0xffffffffu : ((1u << ntc) - 1u);
        float l = 0.f;
        run_tiles<0>(lds, src, tm, 0u, 0u, 0u, qt, qf, qpos, r, hf, tid, l, O, 0.f, 0u, 0u, 0u, 0u, imp);
        l = sum_xor32(l); const float invl = l > 0.f ? 1.0f / l : 0.f;
        run_tiles<1>(lds, src, tm, 0u, 0u, 0u, qt, qf, qpos, r, hf, tid, l, O, invl, 0u, 0u, 0u, 0u, imp + qi * IMPS);
#pragma unroll
        for (int dt = 0; dt < 2; ++dt) {
#pragma unroll
            for (int i = 0; i < 8; ++i) { OUTP[dt][i] = pg8::cvt_pk_bf16(O[dt][2 * i] * g_c, O[dt][2 * i + 1] * g_c); asm volatile("" : "+v"(OUTP[dt][i])); }
#pragma unroll
            for (int i = 0; i < 16; ++i) O[dt][i] = 0.f; }
    }
    __syncthreads();
    if (stop == 1) return;
    {
        unsigned k0[8], k1[8], T[8]; int Kq[8];
#pragma unroll
        for (int e = 0; e < 8; ++e) { const int qq = 8 * wave + e, qp = q0 + qq, qb = qp >> 6;
            const bool c0 = (64 * lane <= qp), c1 = (64 * (lane + 64) <= qp);
            const unsigned a0_ = (lane == 0 || lane == qb || lane == qb - 1) ? 0xffffffffu : __builtin_bit_cast(unsigned, imp[qq * IMPS + lane]);
            const unsigned a1_ = (lane + 64 == qb || lane + 64 == qb - 1) ? 0xffffffffu : __builtin_bit_cast(unsigned, imp[qq * IMPS + lane + 64]);
            k0[e] = c0 ? a0_ : 0u; k1[e] = c1 ? a1_ : 0u;
            Kq[e] = qb + 1 < 16 ? qb + 1 : 16; T[e] = 0u; }
        for (int bit = 31; bit >= 0; --bit) {
#pragma unroll
            for (int e = 0; e < 8; ++e) { const unsigned cand = T[e] | (1u << bit);
                const int cnt = __popcll(__ballot(k0[e] >= cand)) + __popcll(__ballot(k1[e] >= cand)); if (cnt >= Kq[e]) T[e] = cand; } }
#pragma unroll
        for (int e = 0; e < 8; ++e) { const int qq = 8 * wave + e, qp = q0 + qq;
            const bool c0 = (64 * lane <= qp), c1 = (64 * (lane + 64) <= qp);
            unsigned long long mlo = __ballot(k0[e] > T[e]), mhi = __ballot(k1[e] > T[e]), elo = __ballot(c0 && k0[e] == T[e]), ehi = __ballot(c1 && k1[e] == T[e]);
            int need = Kq[e] - (__popcll(mlo) + __popcll(mhi));
            for (; need > 0; --need) { if (elo) { mlo |= elo & (~elo + 1ull); elo &= elo - 1ull; } else { mhi |= ehi & (~ehi + 1ull); ehi &= ehi - 1ull; } }
            const unsigned m0 = (unsigned)mlo, m1 = (unsigned)(mlo >> 32), m2 = (unsigned)mhi, m3 = (unsigned)(mhi >> 32);
            if (lane == 0) { selm[qq * 4 + 0] = m0; selm[qq * 4 + 1] = m1; selm[qq * 4 + 2] = m2; selm[qq * 4 + 3] = m3;
                atomicOr((unsigned*)&anym[0], m0); atomicOr((unsigned*)&anym[1], m1); atomicOr((unsigned*)&anym[2], m2); atomicOr((unsigned*)&anym[3], m3); } }
    }
    __syncthreads();
    if (stop == 2) return;
    {
        const TileSrc src{(const bf16_t*)(ws + WS_KW) + (size_t)hb * TP * 64, (const bf16_t*)(ws + WS_VW) + (size_t)hb * 64 * TP, TP};
        const int tlo = qt >= 8 ? qt - 8 : 0; unsigned t0 = 0u, t1 = 0u, t2 = 0u, t3 = 0u;
        for (int s = tlo; s <= qt; ++s) set_bit4(s, t0, t1, t2, t3);
        float l = 0.f;
        run_tiles<2>(lds, src, t0, t1, t2, t3, qt, qf, qpos, r, hf, tid, l, O, 0.f, 0u, 0u, 0u, 0u, imp);
        l = sum_xor32(l); const float sc = l > 0.f ? g_w / l : 0.f;
#pragma unroll
        for (int dt = 0; dt < 2; ++dt) {
#pragma unroll
            for (int i = 0; i < 8; ++i) { OUTP[dt][i] = pg8::cvt_pk_bf16(bflo(OUTP[dt][i]) + O[dt][2 * i] * sc, bfhi(OUTP[dt][i]) + O[dt][2 * i + 1] * sc); asm volatile("" : "+v"(OUTP[dt][i])); }
#pragma unroll
            for (int i = 0; i < 16; ++i) O[dt][i] = 0.f; }
    }
    if (stop == 3) { __syncthreads(); return; }
    {
        const TileSrc src{(const bf16_t*)(ws + WS_KS) + (size_t)hb * TP * 64, (const bf16_t*)(ws + WS_VS) + (size_t)hb * 64 * TP, TP};
        const unsigned sz_ = (stop == 5) ? 0u : 0xffffffffu;
        const unsigned s0 = selm[qi * 4 + 0] & sz_, s1 = selm[qi * 4 + 1] & sz_, s2 = selm[qi * 4 + 2] & sz_, s3 = selm[qi * 4 + 3] & sz_;
        const unsigned a0 = __builtin_amdgcn_readfirstlane(anym[0]), a1 = __builtin_amdgcn_readfirstlane(anym[1]), a2 = __builtin_amdgcn_readfirstlane(anym[2]), a3 = __builtin_amdgcn_readfirstlane(anym[3]);
        float l = 0.f;
        run_tiles<3>(lds, src, a0, a1, a2, a3, qt, qf, qpos, r, hf, tid, l, O, 0.f, s0, s1, s2, s3, imp, stop == 4 ? 1 : 0);
        if (stop >= 4) { if (l == 12345.678f) ((float*)(ws + WS_GATE))[0] = O[0][0] + O[1][0]; __syncthreads(); return; }
        l = sum_xor32(l); const float sc = l > 0.f ? g_s / l : 0.f;
#pragma unroll
        for (int dt = 0; dt < 2; ++dt)
#pragma unroll
            for (int i = 0; i < 8; ++i) OUTP[dt][i] = pg8::cvt_pk_bf16(bflo(OUTP[dt][i]) + O[dt][2 * i] * sc, bfhi(OUTP[dt][i]) + O[dt][2 * i + 1] * sc);
    }
    bf16_t* AO = (bf16_t*)(ws + WS_YG) + (size_t)row * D + head * 64;
#pragma unroll
    for (int dt = 0; dt < 2; ++dt)
#pragma unroll
        for (int gq = 0; gq < 4; ++gq) { u32x2 w; w.x = OUTP[dt][2 * gq]; w.y = OUTP[dt][2 * gq + 1]; *(u32x2*)(AO + 32 * dt + 8 * gq + 4 * hf) = w; }
    __syncthreads();
}

constexpr int SA_RED = 0, SA_REDW = 2 * 16 * 65 * 4, SA_OC = SA_RED + SA_REDW, SA_EC = SA_OC + 2 * 4096, SA_LC = SA_EC + 2 * 4096, SA_PN = SA_LC + 256, SA_SEL = SA_PN + 4 * 512;
static_assert(SA_SEL + 64 <= RING_BYTES, "sample attention LDS map");
__device__ __forceinline__ bf16x8 pack8(const f32x4 a, const f32x4 b) { const u32x4 w = {pk2(a[0], a[1]), pk2(a[2], a[3]), pk2(b[0], b[1]), pk2(b[2], b[3])}; return __builtin_bit_cast(bf16x8, w); }
__device__ __forceinline__ void sa_qk(const float* kb, size_t stride, int nrows, const bf16x8 (&qf)[2], int fr, int fq, f32x4 (&S)[4]) {
    f32x4 kr[4][2][2];
#pragma unroll
    for (int kg = 0; kg < 4; ++kg) { const int key = 16 * kg + fr; const float* rp = kb + (size_t)(key < nrows ? key : nrows - 1) * stride + 8 * fq;
#pragma unroll
        for (int ks = 0; ks < 2; ++ks) { kr[kg][ks][0] = *(const f32x4*)(rp + 32 * ks); kr[kg][ks][1] = *(const f32x4*)(rp + 32 * ks + 4); } }
#pragma unroll
    for (int kg = 0; kg < 4; ++kg) { S[kg] = (f32x4){0.f, 0.f, 0.f, 0.f};
#pragma unroll
        for (int ks = 0; ks < 2; ++ks) S[kg] = mfma16(pack8(kr[kg][ks][0], kr[kg][ks][1]), qf[ks], S[kg]); }
}
__device__ __forceinline__ void sa_pv(const float* vb, size_t stride, int nrows, const f32x4 (&P)[4], int fr, int fq, f32x4 (&O)[4]) {
#pragma unroll
    for (int ks = 0; ks < 2; ++ks) { const bf16x8 pa = pack8(P[2 * ks], P[2 * ks + 1]);
        float vv[4][8];
#pragma unroll
        for (int j = 0; j < 8; ++j) { const int key = 16 * (2 * ks + (j >> 2)) + 4 * fq + (j & 3); const float* rp = vb + (size_t)(key < nrows ? key : nrows - 1) * stride + fr;
#pragma unroll
            for (int dt = 0; dt < 4; ++dt) vv[dt][j] = rp[16 * dt]; }
#pragma unroll
        for (int dt = 0; dt < 4; ++dt) { const u32x4 w = {pk2(vv[dt][0], vv[dt][1]), pk2(vv[dt][2], vv[dt][3]), pk2(vv[dt][4], vv[dt][5]), pk2(vv[dt][6], vv[dt][7])};
            O[dt] = mfma16(pa, __builtin_bit_cast(bf16x8, w), O[dt]); } }
}
__device__ __forceinline__ void attn_sample_unit(KP p, const Ctx& c, int item, const int lb) {
    unsigned char* ws = p->ws; LAS unsigned char* lds = c.lds; const int tid = launder_v(c.tid), lane = tid & 63, wave = c.wave, fr = lane & 15, fq = lane >> 4; const int b = item >> 2, g = item & 3;
    bf16x8 qf[2];
    { const float* QFp = (const float*)(ws + WS_QF) + (size_t)(MP + 4 * b + (fr >> 2)) * NQP + (4 * g + (fr & 3)) * 64 + 8 * fq; const float* gqp = p->in[I_QNG] + lb * 64 + 8 * fq;
      f32x4 qv[2][2]; float ss = 0.f;
#pragma unroll
      for (int ks = 0; ks < 2; ++ks) { qv[ks][0] = *(const f32x4*)(QFp + 32 * ks); qv[ks][1] = *(const f32x4*)(QFp + 32 * ks + 4);
#pragma unroll
          for (int e = 0; e < 4; ++e) ss += qv[ks][0][e] * qv[ks][0][e] + qv[ks][1][e] * qv[ks][1][e]; }
      ss = sum_rows4(ss);
      const float rs = frsq(ss * (1.0f / 64.0f) + NORM_EPS) * (0.125f * 1.4426950408889634f);
#pragma unroll
      for (int ks = 0; ks < 2; ++ks) { const f32x4 g0 = *(const f32x4*)(gqp + 32 * ks), g1 = *(const f32x4*)(gqp + 32 * ks + 4); const f32x4 a = qv[ks][0] * rs * g0, bq = qv[ks][1] * rs * g1;
          const u32x4 wq = {pk2(a[0], a[1]), pk2(a[2], a[3]), pk2(bq[0], bq[1]), pk2(bq[2], bq[3])}; qf[ks] = __builtin_bit_cast(bf16x8, wq); } }
    const int tokm = fr >> 2;
    if (wave < 2) {
        const float* ck = (const float*)(ws + WS_CKS) + ((size_t)(b * 4 + g) * 128 + 64 * wave) * 64; const float* cv = (const float*)(ws + WS_CVS) + ((size_t)(b * 4 + g) * 128 + 64 * wave) * 64;
        const int nrows = wave ? 63 : 64;
        f32x4 S[4]; sa_qk(ck, 64, nrows, qf, fr, fq, S);
        float ls = 0.f;
#pragma unroll
        for (int kg = 0; kg < 4; ++kg)
#pragma unroll
            for (int r = 0; r < 4; ++r) { const int key = 16 * kg + 4 * fq + r; const float ev = key < nrows ? ex2(S[kg][r]) : 0.f; S[kg][r] = ev; ls += ev;
                *(LAS float*)(lds + SA_EC + wave * 4096 + (key * 16 + fr) * 4) = ev; }
        ls = sum_rows4(ls); if (fq == 0) *(LAS float*)(lds + SA_LC + (wave * 16 + fr) * 4) = ls;
        f32x4 oc[4];
#pragma unroll
        for (int dt = 0; dt < 4; ++dt) oc[dt] = (f32x4){0.f, 0.f, 0.f, 0.f};
        sa_pv(cv, 64, nrows, S, fr, fq, oc);
#pragma unroll
        for (int dt = 0; dt < 4; ++dt)
#pragma unroll
            for (int r = 0; r < 4; ++r) *(LAS float*)(lds + SA_OC + wave * 4096 + ((4 * fq + r) * 64 + 16 * dt + fr) * 4) = oc[dt][r];
    }
    __syncthreads();
    if (wave < 4) { const int tok = wave; float P0 = 0.f, P1 = 0.f;
#pragma unroll
        for (int hh = 0; hh < 4; ++hh) { const int pi = tok * 4 + hh; const float L = *(const LAS float*)(lds + SA_LC + pi * 4) + *(const LAS float*)(lds + SA_LC + (16 + pi) * 4); const float inv = L > 0.f ? 1.0f / L : 0.f;
            P0 += *(const LAS float*)(lds + SA_EC + (lane * 16 + pi) * 4) * inv; P1 += *(const LAS float*)(lds + SA_EC + 4096 + (lane * 16 + pi) * 4) * inv; }
        LAS float* pn = (LAS float*)(lds + SA_PN + tok * 512); pn[lane] = P0; pn[64 + lane] = P1; LDS_WAIT();
        float v0 = -1e9f;
        if (lane < 33) { const int s = lane; float im = 0.f;
            if (4 * s - 1 >= 0 && 4 * s - 1 < 128) im += pn[4 * s - 1];
#pragma unroll
            for (int j = 0; j < 3; ++j) if (4 * s + j < 128) im += 2.0f * pn[4 * s + j];
            if (4 * s + 3 < 128) im += pn[4 * s + 3];
            v0 = (s == 0 || s == 31 || s == 32) ? 1e9f : im; }
        unsigned selmask = 0u, sel32 = 0u;
        for (int it = 0; it < 16; ++it) { const float mx = wave_max(v0); if (mx < -5e8f) break; const unsigned long long b0 = __ballot(v0 == mx); const int s = __ffsll((long long)b0) - 1;
            if (lane == s) v0 = -2e9f; if (s < 32) selmask |= 1u << s; else sel32 = 1u; }
        if (lane == 0) { *(LAS unsigned*)(lds + SA_SEL + tok * 8) = selmask; *(LAS unsigned*)(lds + SA_SEL + tok * 8 + 4) = sel32; } }
    __syncthreads();
    unsigned sm[4], s32[4];
#pragma unroll
    for (int t = 0; t < 4; ++t) { sm[t] = *(const LAS unsigned*)(lds + SA_SEL + t * 8); s32[t] = *(const LAS unsigned*)(lds + SA_SEL + t * 8 + 4); }
    const unsigned un = sm[0] | sm[1] | sm[2] | sm[3]; const int nsel = __popc(un); const int has32 = (s32[0] | s32[1] | s32[2] | s32[3]) ? 1 : 0;
    const unsigned my_sm = tokm == 0 ? sm[0] : (tokm == 1 ? sm[1] : (tokm == 2 ? sm[2] : sm[3])), my_s32 = tokm == 0 ? s32[0] : (tokm == 1 ? s32[1] : (tokm == 2 ? s32[2] : s32[3]));
    const int ntile = nsel + has32 + 9;
    const int* pt = (const int*)p->in[I_PT] + b * NPAGES;
    f32x4 osel[4], owin[4]; float lsel = 0.f, lwin = 0.f;
#pragma unroll
    for (int dt = 0; dt < 4; ++dt) { osel[dt] = (f32x4){0.f, 0.f, 0.f, 0.f}; owin[dt] = (f32x4){0.f, 0.f, 0.f, 0.f}; }
    for (int ti = wave; ti < ntile; ti += 8) {
        const float* kb; size_t stride; int nrows = 64, br, mode, sidx = 0;
        if (ti < nsel) { unsigned m = un; for (int q = 0; q < ti; ++q) m &= m - 1u; sidx = __ffs(m) - 1; const int page = pt[sidx >> 1];
            kb = p->in[I_CKV] + ((size_t)page * PAGE + (sidx & 1) * 64) * 1024 + 2 * 256 + g * 64; stride = 1024; br = 0; mode = 0; }
        else if (ti < nsel + has32) { kb = p->out + O_KV + (size_t)(MP + 4 * b) * D + 2 * 256 + g * 64; stride = 1024; nrows = 4; br = 0; mode = 1; }
        else if (ti < nsel + has32 + 8) { sidx = ti - nsel - has32; kb = p->in[I_CWIN] + ((size_t)b * WIN + 64 * sidx) * 512 + g * 64; stride = 512; br = 1; mode = 2; }
        else { kb = p->out + O_WINS + ((size_t)(b * WIN + 508) * 2) * 256 + g * 64; stride = 512; nrows = 4; br = 1; mode = 3; }
        f32x4 S[4]; sa_qk(kb, stride, nrows, qf, fr, fq, S);
        float ls = 0.f;
#pragma unroll
        for (int kg = 0; kg < 4; ++kg)
#pragma unroll
            for (int r = 0; r < 4; ++r) { const int key = 16 * kg + 4 * fq + r; bool valid;
                if (mode == 0) valid = ((my_sm >> sidx) & 1u) != 0u; else if (mode == 1) valid = (my_s32 != 0u) && (key <= tokm); else if (mode == 2) valid = (64 * sidx + key) >= tokm + 1; else valid = key <= tokm;
                const float ev = valid ? ex2(S[kg][r]) : 0.f; S[kg][r] = ev; ls += ev; }
        if (br == 0) { lsel += ls; sa_pv(kb + 256, stride, nrows, S, fr, fq, osel); } else { lwin += ls; sa_pv(kb + 256, stride, nrows, S, fr, fq, owin); }
    }
    lsel = sum_rows4(lsel); lwin = sum_rows4(lwin);
    for (int w = 0; w < 8; ++w) {
        if (wave == w) {
#pragma unroll
            for (int dt = 0; dt < 4; ++dt)
#pragma unroll
                for (int r = 0; r < 4; ++r) { LAS float* r0 = (LAS float*)(lds + SA_RED + ((4 * fq + r) * 65 + 16 * dt + fr) * 4); LAS float* r1 = (LAS float*)(lds + SA_RED + ((16 + 4 * fq + r) * 65 + 16 * dt + fr) * 4);
                    if (w == 0) { *r0 = osel[dt][r]; *r1 = owin[dt][r]; } else { *r0 += osel[dt][r]; *r1 += owin[dt][r]; } }
            if (fq == 0) { LAS float* l0 = (LAS float*)(lds + SA_RED + (fr * 65 + 64) * 4); LAS float* l1 = (LAS float*)(lds + SA_RED + ((16 + fr) * 65 + 64) * 4);
                if (w == 0) { *l0 = lsel; *l1 = lwin; } else { *l0 += lsel; *l1 += lwin; } } }
        __syncthreads(); }
    { const float* gt = (const float*)(ws + WS_GATE); bf16_t* AO = (bf16_t*)(ws + WS_YG);
      for (int e = tid; e < 1024; e += 512) { const int pi = e >> 6, d = e & 63, tok = pi >> 2, hh = pi & 3; const size_t row = (size_t)(MP + 4 * b + tok);
          const float lc = *(const LAS float*)(lds + SA_LC + pi * 4) + *(const LAS float*)(lds + SA_LC + (16 + pi) * 4);
          const float oc = *(const LAS float*)(lds + SA_OC + (pi * 64 + d) * 4) + *(const LAS float*)(lds + SA_OC + 4096 + (pi * 64 + d) * 4);
          const LAS float* r0 = (const LAS float*)(lds + SA_RED + (pi * 65) * 4); const LAS float* r1 = (const LAS float*)(lds + SA_RED + ((16 + pi) * 65) * 4);
          const float* gg = gt + row * 48 + (4 * g + hh) * 3;
          float out = lc > 0.f ? gg[0] * oc / lc : 0.f;
          out += r0[64] > 0.f ? gg[1] * r0[d] / r0[64] : 0.f;
          out += r1[64] > 0.f ? gg[2] * r1[d] / r1[64] : 0.f;
          AO[row * D + (4 * g + hh) * 64 + d] = (bf16_t)f2bf(out); } }
    __syncthreads();
}

__device__ __forceinline__ void phase_attn_prompt(KP p, const Ctx& c, const int lb, const int stop = 0) {
    const int Gd = gridDim.x, cb = blockIdx.x;
    for (int i = 0; i * Gd < 1024; ++i) { const int k = i * Gd + ((i & 1) ? Gd - 1 - cb : cb); if (k < 1024) attn_prompt_unit(p, c, k, stop, lb); }
}
__device__ __forceinline__ void phase_attn_sample(KP p, const Ctx& c, const int lb) {
    for (int it = blockIdx.x; it < SB * G; it += gridDim.x) attn_sample_unit(p, c, it, lb);
}
#ifndef MK_MULTI
#define MK_MULTI 0
#endif
#if defined(PROBE_SCALE) || defined(SELFTEST)
constexpr int NPH = 44;
#elif defined(PROBE_ATTN2)
constexpr int NPH = 45;
#else
constexpr int NPH = 43;
#endif
#ifdef SPLITK
#define RESID_SPLIT(n) (n)
#else
#define RESID_SPLIT(n) 0
#endif

__global__ void __launch_bounds__(512, 2) mega(Params p) {
    extern __shared__ __attribute__((aligned(16))) unsigned char lds_raw[];
    LAS unsigned char* const lds0 = (LAS unsigned char*)lds_raw;
    volatile LAS unsigned* MISC = (volatile LAS unsigned*)(lds0 + MISC_OFF);
    for (int u = threadIdx.x; u < (LDS_BYTES - RING_BYTES) / 4; u += 512) ((LAS unsigned*)(lds0 + RING_BYTES))[u] = 0u;
    __syncthreads();
    const KP kp0 = (KP)__builtin_amdgcn_kernarg_segment_ptr();
    const int ph_lo = kp0->ph_lo, ph_hi = kp0->ph_hi, use_bar = kp0->use_bar;
    XcdBarrier bar; bar.bar = (unsigned*)(kp0->ws + WS_CTL); bar.x = 0; bar.st = nullptr;
    if (use_bar) bar = xcd_barrier_post((unsigned*)(kp0->ws + WS_CTL), MISC + 8);
    const int wave_s = __builtin_amdgcn_readfirstlane((int)threadIdx.x >> 6);
#define TID_MBCNT 1
#ifdef TID_MBCNT
#define TID_SRC(T_) asm volatile("v_mbcnt_lo_u32_b32 %0, -1, 0\n\tv_mbcnt_hi_u32_b32 %0, -1, %0" : "=v"(T_)); T_ += 64 * wave_s;
#else
#define TID_SRC(T_) T_ = threadIdx.x; asm volatile("" : "+v"(T_));
#endif
    int ph = 0;
#define PHASE_BEGIN if (ph >= ph_lo && ph < ph_hi) { KP p = kp0; asm volatile("" : "+s"(p)); int tid_; TID_SRC(tid_) \
        Ctx c; c.lds = lds0; c.tid = tid_; c.lane = tid_ & 63; c.wave = __builtin_amdgcn_readfirstlane(tid_ >> 6); c.gw = blockIdx.x * 8 + c.wave; c.ngw = gridDim.x * 8; c.gtid = blockIdx.x * 512 + tid_; c.gsz = gridDim.x * 512; \
        unsigned char* ws = p->ws; float* X = p->out + O_Y; (void)ws; (void)X;
#define PHASE_END   if (use_bar) { int te_; TID_SRC(te_) xcd_barrier(bar, te_ == 0); } } ++ph;

    PHASE_BEGIN phase_prologue(p, c); PHASE_END
#ifdef PROBE_BAR
    for (int xb = 0; xb < PROBE_BAR; ++xb) { if (use_bar) xcd_barrier(bar, threadIdx.x == 0); }
#endif

    for (int layer = 0; layer < NLAY; ++layer) {
        if (layer < 2) {
            const int li = layer;
            PHASE_BEGIN phase_mix(p, c, li); PHASE_END
            PHASE_BEGIN {
                pg8::Gemm g{(const bf16_t*)(ws + WS_XM), (const bf16_t*)(ws + WS_WRKV) + (size_t)li * 3072 * 1024, 3 * R, 3072, 1024, 1024};
                pg8::GroupOrder S; S.init((int)gridDim.x, (int)blockIdx.x); S.add(0, 0, 64, 0, 4); S.add(1, 66, 64, 4, 4); S.add(2, 132, 64, 8, 4);
                pg8::EpiF32G E{(float*)(ws + WS_RK_R), (float*)(ws + WS_RK_K), (float*)(ws + (li ? WS_V1 : WS_V0)), nullptr, D, 4, 66};
                pg8::gemm_phase<pg8::EpiF32G, pg8::GroupOrder, true, true>(c.lds, g, S, E, c.tid);
                {
                    const bf16_t* XMs = (const bf16_t*)(ws + WS_XM); const bf16_t* Wr = (const bf16_t*)(ws + WS_WRKV) + (size_t)li * 3072 * 1024;
                    for (int it = blockIdx.x + gridDim.x * c.wave; it < 768; it += c.ngw) { const int j = it >> 8, r = it & 255, row0 = MP + 32 * (r & 15), col0 = 64 * (r >> 4);
                        float* C = (float*)(ws + (j == 0 ? WS_RK_R : (j == 1 ? WS_RK_K : (li ? WS_V1 : WS_V0))));
                        f32x4 acc[4][2]; skinny_mma<4>(XMs + (size_t)j * R * D, 1024, Wr + (size_t)j * 1024 * 1024, 1024, 1024, row0, col0, c.lane, acc);
                        const int fr = c.lane & 15, fq = c.lane >> 4;
#pragma unroll
                        for (int nt = 0; nt < 4; ++nt)
#pragma unroll
                            for (int mt = 0; mt < 2; ++mt) *(f32x4*)(C + (size_t)(row0 + 16 * mt + fr) * D + col0 + 16 * nt + 4 * fq) = acc[nt][mt]; }
                }
                phase_lora1(p, c, li);
            } PHASE_END
            PHASE_BEGIN phase_scanA(p, c, li); PHASE_END
            PHASE_BEGIN phase_scanB(p, c, li); PHASE_END
            PHASE_BEGIN phase_scanC(p, c, li); PHASE_END
        } else {
            const int lb = layer - 2;
            if (layer == 2) {
                PHASE_BEGIN phase_norm(c, X, p->in[I_KVNG], (bf16_t*)(ws + WS_XN2), p->in[I_NORMG] + (size_t)(layer * 2) * D, (bf16_t*)(ws + WS_XN)); PHASE_END
                PHASE_BEGIN {
                    pg8::Gemm g{(const bf16_t*)(ws + WS_XN2), (const bf16_t*)(ws + WS_WKVT), R, NKV, 1024, 1024};
                    pg8::GroupOrder S; S.init((int)gridDim.x, (int)blockIdx.x); S.add(0, 0, 66, 0, 6);
                    pg8::EpiF32G E{(float*)(ws + WS_KVF), nullptr, nullptr, nullptr, NKV, 1 << 20, 0};
                    pg8::gemm_phase<pg8::EpiF32G, pg8::GroupOrder, true, true>(c.lds, g, S, E, c.tid);
                } PHASE_END
                PHASE_BEGIN phase_kvpost(p, c); PHASE_END
                PHASE_BEGIN {
                    pg8::Gemm g{(const bf16_t*)(ws + WS_CMPA), (const bf16_t*)(ws + WS_CW1T), (int)CMPA_ROWS, 512, 1024, 1024};
                    pg8::GroupOrder S; S.init((int)gridDim.x, (int)blockIdx.x); S.add(0, 0, 16, 0, 1); S.add(1, 16, 16, 1, 1); S.add(2, 32, 256, 0, 1); S.add(3, 288, 256, 1, 1);
                    pg8::EpiF32G E{(float*)(ws + WS_PCMP), (float*)(ws + WS_PCMP), nullptr, nullptr, 256, 1, 0};
                    pg8::gemm_phase<pg8::EpiF32G, pg8::GroupOrder, true, true>(c.lds, g, S, E, c.tid);
                } PHASE_END
                PHASE_BEGIN phase_cmp2(p, c); PHASE_END
            } else {
                PHASE_BEGIN phase_norm(c, X, p->in[I_NORMG] + (size_t)(layer * 2) * D, (bf16_t*)(ws + WS_XN), nullptr, nullptr); PHASE_END
            }
            PHASE_BEGIN {
                const bf16_t* XNp = (const bf16_t*)(ws + WS_XN); const bf16_t* Wq = (const bf16_t*)(ws + WS_WQT) + (size_t)lb * NQP * 1024; float* QFp = (float*)(ws + WS_QF);
                pg8::Gemm g{XNp, Wq, R, NQP, 1024, 1024};
                pg8::GroupOrder S; S.init((int)gridDim.x, (int)blockIdx.x); S.add(0, 0, 64, 0, 4);
                pg8::EpiF32G E{QFp, nullptr, nullptr, nullptr, NQP, 1 << 20, 0};
                pg8::gemm_phase<pg8::EpiF32G, pg8::GroupOrder, true, true>(c.lds, g, S, E, c.tid);
                float* GATEp = (float*)(ws + WS_GATE);
                for (int it = blockIdx.x + gridDim.x * c.wave; it < 256 + R / 32; it += c.ngw) { const int ln = launder_v(c.lane), fr = ln & 15, fq = ln >> 4;
                    if (it < 256) { const int row0 = MP + 32 * (it & 15), col0 = 64 * (it >> 4);
                        f32x4 acc[4][2]; skinny_mma<4>(XNp, 1024, Wq, 1024, 1024, row0, col0, ln, acc);
#pragma unroll
                        for (int nt = 0; nt < 4; ++nt)
#pragma unroll
                            for (int mt = 0; mt < 2; ++mt) *(f32x4*)(QFp + (size_t)(row0 + 16 * mt + fr) * NQP + col0 + 16 * nt + 4 * fq) = acc[nt][mt]; }
                    else { const int row0 = 32 * (it - 256);
                        f32x4 acc[3][2]; skinny_mma<3>(XNp, 1024, Wq, 1024, 1024, row0, 1024, ln, acc);
#pragma unroll
                        for (int nt = 0; nt < 3; ++nt)
#pragma unroll
                            for (int mt = 0; mt < 2; ++mt) { f32x4 v = acc[nt][mt];
#pragma unroll
                                for (int e = 0; e < 4; ++e) v[e] = sigmoidf_(v[e]);
                                *(f32x4*)(GATEp + (size_t)(row0 + 16 * mt + fr) * 48 + 16 * nt + 4 * fq) = v; } }
                }
            } PHASE_END
            PHASE_BEGIN phase_attn_prompt(p, c, lb); PHASE_END
#ifdef PROBE_ATTN2
            PHASE_BEGIN phase_attn_prompt(p, c, lb, PROBE_ATTN2); PHASE_END
#endif
            PHASE_BEGIN phase_attn_sample(p, c, lb); PHASE_END
        }
        PHASE_BEGIN {
            const bf16_t* Wt = layer < 2 ? (const bf16_t*)(ws + WS_WORW) + (size_t)layer * 1024 * 1024 : (const bf16_t*)(ws + WS_WONSA) + (size_t)(layer - 2) * 1024 * 1024;
            pg8::Gemm g{(const bf16_t*)(ws + WS_YG), Wt, R, 1024, 1024, 1024};
            pg8::GroupOrder S; S.init((int)gridDim.x, (int)blockIdx.x); S.add(0, 0, 64, 0, 4);
            pg8::EpiResid E{X, D};
            pg8::gemm_phase<pg8::EpiResid, pg8::GroupOrder, true, true>(c.lds, g, S, E, c.tid);
            skinny_resid_sample(c, (const bf16_t*)(ws + WS_YG), 1024, Wt, 1024, X);
        } PHASE_END
        PHASE_BEGIN phase_norm(c, X, p->in[I_NORMG] + (size_t)(layer * 2 + 1) * D, (bf16_t*)(ws + WS_XN), nullptr, nullptr); PHASE_END
        PHASE_BEGIN {
            pg8::Gemm g{(const bf16_t*)(ws + WS_XN), (const bf16_t*)(ws + WS_WINT) + (size_t)layer * 5632 * 1024, R, 5632, 1024, 1024};
            pg8::GroupOrder S; S.init((int)gridDim.x, (int)blockIdx.x); S.add(0, 0, 66, 0, 22);
            pg8::EpiWin E{(bf16_t*)(ws + WS_U), (bf16_t*)(ws + WS_GT), p->out + O_CVP + (size_t)layer * NB * 2 * DFF, p->out + O_CVS + (size_t)layer * SB * 2 * DFF};
            pg8::gemm_phase<pg8::EpiWin, pg8::GroupOrder, true, true>(c.lds, g, S, E, c.tid);
        } PHASE_END
        PHASE_BEGIN phase_conv(p, c, layer); PHASE_END
        PHASE_BEGIN {
            pg8::Gemm g{(const bf16_t*)(ws + WS_HH), (const bf16_t*)(ws + WS_WOUTT) + (size_t)layer * 1024 * 2816, R, 1024, 2816, 2816};
            pg8::GroupOrder S; S.init((int)gridDim.x, (int)blockIdx.x); S.add(0, 0, 64, 0, 4);
            pg8::EpiResid E{X, D};
            pg8::gemm_phase<pg8::EpiResid, pg8::GroupOrder, true, true>(c.lds, g, S, E, c.tid);
            skinny_resid_sample(c, (const bf16_t*)(ws + WS_HH), 2816, (const bf16_t*)(ws + WS_WOUTT) + (size_t)layer * 1024 * 2816, 2816, X);
        } PHASE_END
    }
#ifdef SELFTEST
    PHASE_BEGIN if (blockIdx.x == 0 && c.wave == 0) { const float x = (float)((c.lane * 37) & 63) + 1.0f; float poison = 0.f;
        if (__ballot(swz_xor16_n(x) != __shfl_xor(x, 16))) poison += 1e3f;
        if (__ballot(sum_xor32_n(x) != x + __shfl_xor(x, 32))) poison += 1e4f;
        if (__ballot(sum_rows4_n(x) != x + __shfl_xor(x, 16) + __shfl_xor(x, 32) + __shfl_xor(x, 48))) poison += 1e5f;
        if (__ballot(wave_sum_n(x) != 2080.0f)) poison += 1e6f;
        if (__ballot(wave_max_n(x) != 64.0f)) poison += 1e7f;
        if (c.lane == 0) p->out[O_CVS] += poison; } PHASE_END
#endif
#ifdef PROBE_SCALE
    PHASE_BEGIN for (size_t e = c.gtid; e < O_END; e += c.gsz) { int oi = e < O_KV ? (e < (size_t)MP * D ? 0 : 1) : e < O_WINP ? (e < O_KV + (size_t)MP * D ? 2 : 3) : e < O_WINS ? 4 : e < O_WKVP ? 5 : e < O_WKVS ? 6 : e < O_SHP ? 7 : e < O_SHS ? 8 : e < O_CVP ? 9 : e < O_CVS ? 10 : 11;
        if (PROBE_SCALE < 0) oi = 11 - oi; p->out[e] *= 1.0f + sqrtf(0.5e-4f * (float)(oi + 1)); } PHASE_END
#endif
#undef PHASE_BEGIN
#undef PHASE_END
}

extern "C" void kernel_launch(void* const* d_in, const int* in_sizes, int n_in, void* d_out, int out_size, void* d_ws, size_t ws_size, hipStream_t stream) {
    static int grid = 0;
    if (grid == 0) {
        if (n_in != 45 || (size_t)out_size != O_END || ws_size < WS_END) { fprintf(stderr, "kernel_launch: unexpected shapes (n_in %d out %d ws %zu need %zu)\n", n_in, out_size, ws_size, (size_t)WS_END); grid = -1; return; }
        int dev = 0, cus = 0, per_cu = 0;
        if (hipGetDevice(&dev) != hipSuccess || hipDeviceGetAttribute(&cus, hipDeviceAttributeMultiprocessorCount, dev) != hipSuccess) { grid = -1; return; }
        if (hipFuncSetAttribute((const void*)mega, hipFuncAttributeMaxDynamicSharedMemorySize, LDS_BYTES) != hipSuccess) { fprintf(stderr, "kernel_launch: hipFuncSetAttribute failed\n"); grid = -1; return; }
        if (hipOccupancyMaxActiveBlocksPerMultiprocessor(&per_cu, (const void*)mega, 512, LDS_BYTES) != hipSuccess || per_cu < 1) { fprintf(stderr, "kernel_launch: occupancy query says %d\n", per_cu); (void)hipGetLastError(); }
        grid = cus;
    }
    if (grid < 0) return;
    (void)hipMemsetAsync((char*)d_ws + WS_CTL, 0, CTL_BYTES, stream);
    Params p{};
    for (int i = 0; i < 45; ++i) p.in[i] = (const float*)d_in[i];
    p.out = (float*)d_out; p.ws = (unsigned char*)d_ws;
#ifdef PROBE_PRE
    { const int plist[] = PROBE_PRE; for (int i = 0; i < (int)(sizeof(plist) / sizeof(int)); ++i) { p.ph_lo = plist[i] % 100; p.ph_hi = p.ph_lo + 1; p.use_bar = 0; p.pad = plist[i] / 100;       hipLaunchKernelGGL(mega, dim3(grid), dim3(512), LDS_BYTES, stream, p); } }
#endif
    p.pad = 0;
#if MK_MULTI
    for (int i = 0; i < NPH; ++i) { p.ph_lo = i; p.ph_hi = i + 1; p.use_bar = 0; hipLaunchKernelGGL(mega, dim3(grid), dim3(512), LDS_BYTES, stream, p); }
#else
    p.ph_lo = 0; p.ph_hi = NPH; p.use_bar = 1;
    hipLaunchKernelGGL(mega, dim3(grid), dim3(512), LDS_BYTES, stream, p);
#endif
    const hipError_t le = hipPeekAtLastError();
    if (le != hipSuccess) fprintf(stderr, "kernel_launch: launch failed: %s\n", hipGetErrorName(le));
}
```

```cpp
#include <hip/hip_runtime.h>
#include <cstdio>
#include <cstdint>

#define LAS __attribute__((address_space(3)))
#define GAS __attribute__((address_space(1)))
typedef unsigned short bf16_t;
typedef short bf16x8 __attribute__((ext_vector_type(8)));
typedef float f32x4 __attribute__((ext_vector_type(4)));
typedef float f32x16 __attribute__((ext_vector_type(16)));
typedef float f32x2 __attribute__((ext_vector_type(2)));
typedef unsigned u32x4 __attribute__((ext_vector_type(4)));
typedef unsigned u32x2 __attribute__((ext_vector_type(2)));

constexpr int D = 1024, NB = 2, TP = 8192, MP = NB * TP, SB = 128, ST = 4, MS = SB * ST, R = MP + MS;
constexpr int PAST = 2048, PAGE = 128, NPAGES = PAST / PAGE;
constexpr int H = 16, HD = 64, G = 4, HPG = 4, DFF = 2816, NLAY = 4;
constexpr int LW_ = 64, LA_ = 64, LV_ = 32, LG_ = 128, LHID = 288;
constexpr int NKV = 1536, NQ = 1072, NQP = 1280;
constexpr int NCH = TP / 64;
constexpr int NUNIT_A = NB * NCH * H;
constexpr int NCMP_P = 511, NCMP_S = 127, WIN = 512;
constexpr float NORM_EPS = 1e-6f, GN_EPS = 64e-5f;

constexpr size_t O_Y = 0;
constexpr size_t O_KV = (size_t)R * D;
constexpr size_t O_WINP = O_KV + (size_t)R * D;
constexpr size_t O_WINS = O_WINP + (size_t)NB * 512 * 512;
constexpr size_t O_WKVP = O_WINS + (size_t)SB * 512 * 512;
constexpr size_t O_WKVS = O_WKVP + (size_t)2 * NB * H * 4096;
constexpr size_t O_SHP = O_WKVS + (size_t)2 * SB * H * 4096;
constexpr size_t O_SHS = O_SHP + (size_t)2 * NB * D;
constexpr size_t O_CVP = O_SHS + (size_t)2 * SB * D;
constexpr size_t O_CVS = O_CVP + (size_t)NLAY * NB * 2 * DFF;
constexpr size_t O_END = O_CVS + (size_t)NLAY * SB * 2 * DFF;
static_assert(O_END == 88915968, "output size");

constexpr size_t MiB = 1u << 20;
constexpr size_t al(size_t x) { return (x + 4095) & ~(size_t)4095; }
constexpr size_t WS_CTL = 0, CTL_BYTES = 1 * MiB;
constexpr size_t WS_WRKV = WS_CTL + CTL_BYTES;
constexpr size_t WS_WORW = WS_WRKV + al((size_t)2 * 3072 * 1024 * 2);
constexpr size_t WS_W1T = WS_WORW + al((size_t)2 * 1024 * 1024 * 2);
constexpr size_t WS_W2W = WS_W1T + al((size_t)2 * 288 * 1024 * 2);
constexpr size_t WS_W2A = WS_W2W + al((size_t)2 * 1024 * 64 * 2);
constexpr size_t WS_W2V = WS_W2A + al((size_t)2 * 1024 * 64 * 2);
constexpr size_t WS_W2G = WS_W2V + al((size_t)1024 * 32 * 2);
constexpr size_t WS_WKVT = WS_W2G + al((size_t)2 * 1024 * 128 * 2);
constexpr size_t WS_WQT = WS_WKVT + al((size_t)1536 * 1024 * 2);
constexpr size_t WS_WONSA = WS_WQT + al((size_t)2 * 1280 * 1024 * 2);
constexpr size_t WS_WINT = WS_WONSA + al((size_t)2 * 1024 * 1024 * 2);
constexpr size_t WS_WOUTT = WS_WINT + al((size_t)4 * 5632 * 1024 * 2);
constexpr size_t WS_CW1T = WS_WOUTT + al((size_t)4 * 1024 * 2816 * 2);
constexpr size_t WS_CBIAS = WS_CW1T + al((size_t)2 * 256 * 1024 * 2);
constexpr size_t WS_CW2T = WS_CBIAS + al(2 * 128 * 4);
constexpr size_t WS_XM = WS_CW2T + al(2 * 2 * 64 * 128 * 2);
constexpr size_t WS_RK_R = WS_XM + al((size_t)6 * R * D * 2);
constexpr size_t WS_RK_K = WS_RK_R + al((size_t)R * D * 4);
constexpr size_t WS_V0 = WS_RK_K + al((size_t)R * D * 4);
constexpr size_t WS_V1 = WS_V0 + al((size_t)R * D * 4);
constexpr size_t WS_HID = WS_V1 + al((size_t)R * D * 4);
constexpr size_t WS_MT = WS_HID + al((size_t)R * LHID * 2);
constexpr size_t WS_NN = WS_MT + al((size_t)NUNIT_A * 4096 * 4);
constexpr size_t WS_RP = WS_NN + al((size_t)NUNIT_A * 4096 * 4);
constexpr size_t WS_YL = WS_RP + al((size_t)NUNIT_A * 4096 * 2);
constexpr size_t WS_S0 = WS_YL + al((size_t)NUNIT_A * 4096 * 4);
constexpr size_t WS_RKS = WS_S0 + al((size_t)NUNIT_A * 4096 * 2);
constexpr size_t WS_YG = WS_RKS + al((size_t)R * 16 * 4);
constexpr size_t WS_XN = WS_YG + al((size_t)R * D * 2);
constexpr size_t WS_XN2 = WS_XN + al((size_t)R * D * 2);
constexpr size_t WS_U = WS_XN2 + al((size_t)R * D * 2);
constexpr size_t WS_GT = WS_U + al((size_t)R * DFF * 2);
constexpr size_t WS_HH = WS_GT + al((size_t)R * DFF * 2);
constexpr size_t WS_KVF = WS_HH + al((size_t)R * DFF * 2);
constexpr size_t WS_CMPA = WS_KVF + al((size_t)R * NKV * 4);
constexpr size_t CMPA_ROWS = 4096 + 4096 + 65536 + 65536;
constexpr size_t WS_PCMP = WS_CMPA + al(CMPA_ROWS * 1024 * 2);
constexpr size_t WS_KS = WS_PCMP + al(CMPA_ROWS * 256 * 4);
constexpr size_t WS_VS = WS_KS + al((size_t)NB * G * TP * 64 * 2);
constexpr size_t WS_KW = WS_VS + al((size_t)NB * G * TP * 64 * 2);
constexpr size_t WS_VW = WS_KW + al((size_t)NB * G * TP * 64 * 2);
constexpr size_t WS_CK = WS_VW + al((size_t)NB * G * TP * 64 * 2);
constexpr size_t WS_CV = WS_CK + al((size_t)NB * G * 512 * 64 * 2);
constexpr size_t WS_CKS = WS_CV + al((size_t)NB * G * 512 * 64 * 2);
constexpr size_t WS_CVS = WS_CKS + al((size_t)SB * G * 128 * 64 * 4);
constexpr size_t WS_QF = WS_CVS + al((size_t)SB * G * 128 * 64 * 4);
constexpr size_t WS_Q = WS_QF + al((size_t)R * NQP * 4);
constexpr size_t WS_GATE = WS_Q + al((size_t)R * D * 2);
constexpr size_t WS_END = WS_GATE + al((size_t)R * 48 * 4);

typedef __bf16 bf16v2_ __attribute__((ext_vector_type(2)));
__device__ __forceinline__ unsigned cvt_pk_bf16_(float lo, float hi) { const f32x2 v = {lo, hi}; const bf16v2_ b = __builtin_convertvector(v, bf16v2_); return __builtin_bit_cast(unsigned, b); }
__device__ __forceinline__ unsigned f2bf(float f) { return cvt_pk_bf16_(f, f) & 0xffffu; }
__device__ __forceinline__ unsigned pk2(float lo, float hi) { return cvt_pk_bf16_(lo, hi); }
__device__ __forceinline__ float frcp(float x) { return __builtin_amdgcn_rcpf(x); }
__device__ __forceinline__ float frsq(float x) { return __builtin_amdgcn_rsqf(x); }
__device__ __forceinline__ float bf2f(unsigned short b) { return __builtin_bit_cast(float, ((unsigned)b) << 16); }
__device__ __forceinline__ float bflo(unsigned w) { return __builtin_bit_cast(float, w << 16); }
__device__ __forceinline__ float bfhi(unsigned w) { return __builtin_bit_cast(float, w & 0xffff0000u); }
template <int CTRL> __device__ __forceinline__ float dpp_f(float x) { return __builtin_bit_cast(float, __builtin_amdgcn_update_dpp(0, __builtin_bit_cast(int, x), CTRL, 0xF, 0xF, true)); }
__device__ __forceinline__ float row16_sum(float v) { v += dpp_f<0xB1>(v); v += dpp_f<0x4E>(v); v += dpp_f<0x141>(v); v += dpp_f<0x140>(v); return v; }
__device__ __forceinline__ float row16_max(float v) { v = fmaxf(v, dpp_f<0xB1>(v)); v = fmaxf(v, dpp_f<0x4E>(v)); v = fmaxf(v, dpp_f<0x141>(v)); v = fmaxf(v, dpp_f<0x140>(v)); return v; }
__device__ __forceinline__ float swz_xor16_n(float x) { return __builtin_bit_cast(float, __builtin_amdgcn_ds_swizzle(__builtin_bit_cast(int, x), 0x401F)); }
__device__ __forceinline__ float sum_xor32_n(float x) { auto rr = __builtin_amdgcn_permlane32_swap(__float_as_uint(x), __float_as_uint(x), false, false);
    return __uint_as_float(rr[0]) + __uint_as_float(rr[1]); }
__device__ __forceinline__ float sum_rows4_n(float x) { x += swz_xor16_n(x); return sum_xor32_n(x); }
__device__ __forceinline__ float wave_sum_n(float v) {
    v = row16_sum(v);
    v += __builtin_bit_cast(float, __builtin_amdgcn_update_dpp(0, __builtin_bit_cast(int, v), 0x142, 0xA, 0xF, false));
    v += __builtin_bit_cast(float, __builtin_amdgcn_update_dpp(0, __builtin_bit_cast(int, v), 0x143, 0xC, 0xF, false));
    return __builtin_bit_cast(float, __builtin_amdgcn_readlane(__builtin_bit_cast(int, v), 63));
}
__device__ __forceinline__ float wave_max_n(float v) {
    v = row16_max(v);
    v = fmaxf(v, __builtin_bit_cast(float, __builtin_amdgcn_update_dpp(__builtin_bit_cast(int, v), __builtin_bit_cast(int, v), 0x142, 0xA, 0xF, false)));
    v = fmaxf(v, __builtin_bit_cast(float, __builtin_amdgcn_update_dpp(__builtin_bit_cast(int, v), __builtin_bit_cast(int, v), 0x143, 0xC, 0xF, false)));
    return __builtin_bit_cast(float, __builtin_amdgcn_readlane(__builtin_bit_cast(int, v), 63));
}
#define XLANE_NEW 1
#ifdef XLANE_NEW
__device__ __forceinline__ float swz_xor16(float x) { return __builtin_bit_cast(float, __builtin_amdgcn_ds_swizzle(__builtin_bit_cast(int, x), 0x401F)); }
__device__ __forceinline__ float sum_xor32(float x) { return sum_xor32_n(x); }
__device__ __forceinline__ float sum_rows4(float x) { x += swz_xor16(x); return sum_xor32(x); }
__device__ __forceinline__ float wave_sum(float v) {
    v = row16_sum(v);
    v += __builtin_bit_cast(float, __builtin_amdgcn_update_dpp(0, __builtin_bit_cast(int, v), 0x142, 0xA, 0xF, false));
    v += __builtin_bit_cast(float, __builtin_amdgcn_update_dpp(0, __builtin_bit_cast(int, v), 0x143, 0xC, 0xF, false));
    return __builtin_bit_cast(float, __builtin_amdgcn_readlane(__builtin_bit_cast(int, v), 63));
}
__device__ __forceinline__ float wave_max(float v) {
    v = row16_max(v);
    v = fmaxf(v, __builtin_bit_cast(float, __builtin_amdgcn_update_dpp(__builtin_bit_cast(int, v), __builtin_bit_cast(int, v), 0x142, 0xA, 0xF, false)));
    v = fmaxf(v, __builtin_bit_cast(float, __builtin_amdgcn_update_dpp(__builtin_bit_cast(int, v), __builtin_bit_cast(int, v), 0x143, 0xC, 0xF, false)));
    return __builtin_bit_cast(float, __builtin_amdgcn_readlane(__builtin_bit_cast(int, v), 63));
}
#else
__device__ __forceinline__ float sum_xor32(float x) { return x + __shfl_xor(x, 32); }
__device__ __forceinline__ float sum_rows4(float x) { x += __shfl_xor(x, 16); x += __shfl_xor(x, 32); return x; }
__device__ __forceinline__ float wave_sum(float v) { v = row16_sum(v); v += __shfl_xor(v, 16); v += __shfl_xor(v, 32); return v; }
__device__ __forceinline__ float wave_max(float v) { v = row16_max(v); v = fmaxf(v, __shfl_xor(v, 16)); v = fmaxf(v, __shfl_xor(v, 32)); return v; }
#endif
__device__ __forceinline__ float sigmoidf_(float x) { return frcp(1.0f + __builtin_amdgcn_exp2f(-1.4426950408889634f * x)); }
__device__ __forceinline__ float gelu_tanh(float x) {
    const float u = 0.7978845608028654f * (x + 0.044715f * x * x * x);
    const float e = __builtin_amdgcn_exp2f(2.8853900817779268f * u);
    const float th = 1.0f - 2.0f * frcp(e + 1.0f);
    return 0.5f * x * (1.0f + th);
}
template <class T> __device__ __forceinline__ const T* launder_p(const T* q) { asm volatile("" : "+v"(q)); return q; }
__device__ __forceinline__ int launder_v(int x) { asm volatile("" : "+v"(x)); return x; }
#define LDS_WAIT() asm volatile("s_waitcnt lgkmcnt(0)" ::: "memory")
#define VM_WAIT() asm volatile("s_waitcnt vmcnt(0)" ::: "memory")
__device__ __forceinline__ f32x4 mfma16(bf16x8 a, bf16x8 b, f32x4 c) { return __builtin_amdgcn_mfma_f32_16x16x32_bf16(a, b, c, 0, 0, 0); }
__device__ __forceinline__ f32x16 mfma32(bf16x8 a, bf16x8 b, f32x16 c) { return __builtin_amdgcn_mfma_f32_32x32x16_bf16(a, b, c, 0, 0, 0); }
#define XB_TMO      128
#define XB_XCNT(j)  (256  + 64 * (j))
#define XB_XSUB(j)  (1280 + 64 * (j))
#define XB_XGEN(j)  (2304 + 64 * (j))
#define XB_TOP      3328
#define XB_TOPGEN   3392
#define XCD_BAR_WORDS 3456
#define XB_SPIN_CAP (1u << 18)

__device__ __forceinline__ unsigned xb_ld(unsigned* p)              { return __hip_atomic_load(p, __ATOMIC_RELAXED, __HIP_MEMORY_SCOPE_AGENT); }
__device__ __forceinline__ unsigned xb_add(unsigned* p, unsigned v) { return __hip_atomic_fetch_add(p, v, __ATOMIC_RELAXED, __HIP_MEMORY_SCOPE_AGENT); }
__device__ __forceinline__ unsigned xb_xcc_id() { return (unsigned)__builtin_amdgcn_s_getreg((3 << 11) | 20) & 0xFu; }
#define XB_SPIN(cond, bar) do { unsigned _sp = 0; while (cond) { __builtin_amdgcn_s_sleep(1); \
    if ((++_sp & 255u) == 0u) { if (xb_ld(&(bar)[XB_TMO])) break; if (_sp > XB_SPIN_CAP) { atomicAdd(&(bar)[XB_TMO], 1u); break; } } } } while (0)

struct XcdBarrier {
    unsigned* bar; unsigned x;
    volatile LAS unsigned* st;
};

__device__ __forceinline__ XcdBarrier xcd_barrier_post(unsigned* bar, volatile LAS unsigned* st) {
    XcdBarrier b; b.bar = bar; b.x = xb_xcc_id(); b.st = st;
    if (threadIdx.x == 0) (void)xb_add(&bar[XB_XCNT(b.x)], 1u);
    return b;
}
__device__ __forceinline__ void xcd_barrier_complete(unsigned* bar, unsigned x, unsigned& nloc, unsigned& nx) {
    const unsigned G = gridDim.x * gridDim.y * gridDim.z;
    unsigned sum, cnt, mine, sp = 0u;
    for (;;) {
        sum = 0u; cnt = 0u; mine = 0u;
#pragma unroll
        for (unsigned j = 0; j < 16; ++j) { const unsigned c = xb_ld(&bar[XB_XCNT(j)]); sum += c; cnt += (c > 0u) ? 1u : 0u; mine = (j == x) ? c : mine; }
        if (sum == G) break;
        __builtin_amdgcn_s_sleep(1);
        if ((++sp & 255u) == 0u) { if (xb_ld(&bar[XB_TMO])) break; if (sp > XB_SPIN_CAP) { atomicAdd(&bar[XB_TMO], 1u); break; } }
    }
    nloc = mine > 0u ? mine : 1u; nx = cnt > 0u ? cnt : 1u;
}

__device__ __forceinline__ void xcd_barrier(const XcdBarrier& b, const bool t0) {
    asm volatile("s_waitcnt vmcnt(0)" ::: "memory");
    __syncthreads();
    if (t0) {
        unsigned* bar = b.bar;
        __builtin_amdgcn_s_waitcnt(0);
        unsigned nloc = b.st[0], nx = b.st[1];
        if (nloc == 0u) { xcd_barrier_complete(bar, b.x, nloc, nx); b.st[0] = nloc; b.st[1] = nx; }
        const unsigned old = xb_add(&bar[XB_XSUB(b.x)], 1u);
        const unsigned gen = old / nloc;
        if (old + 1u == (gen + 1u) * nloc) {
            __builtin_amdgcn_fence(__ATOMIC_RELEASE, "agent");
            asm volatile("s_waitcnt vmcnt(0)" ::: "memory");
            const unsigned og = xb_add(&bar[XB_TOP], 1u);
            const unsigned tg = og / nx;
            if (og + 1u == (tg + 1u) * nx) xb_add(&bar[XB_TOPGEN], 1u);
            else XB_SPIN(xb_ld(&bar[XB_TOPGEN]) == tg, bar);
            __builtin_amdgcn_fence(__ATOMIC_ACQUIRE, "agent");
            xb_add(&bar[XB_XGEN(b.x)], 1u);
            asm volatile("s_waitcnt vmcnt(0)" ::: "memory");
        } else {
            XB_SPIN(xb_ld(&bar[XB_XGEN(b.x)]) == gen, bar);
            __builtin_amdgcn_fence(__ATOMIC_ACQUIRE, "agent");
            asm volatile("s_waitcnt vmcnt(0)" ::: "memory");
        }
    }
    __syncthreads();
}

namespace pg8 {
#define PG8_LAS __attribute__((address_space(3)))
constexpr int BM = 256, BK = 64, HALF = 128, HTB = HALF * BK * 2  , STAGE_BYTES = 8 * HTB, NXCD = 8, WGM = 8;
__host__ __device__ __forceinline__ int lds_byte(int r, int c) { const int st = (r >> 4) * 2 + (c >> 5), rr = r & 15, cc = c & 31, ob = rr * 64 + cc * 2; return st * 1024 + (ob ^ (((ob >> 9) & 1) << 5)); }
__host__ __device__ __forceinline__ void stage_rc(int b, int& R_, int& C_) { const int st = b / 1024, sb = b % 1024, swz = sb ^ (((sb >> 9) & 1) << 5); R_ = (st >> 1) * 16 + swz / 64; C_ = (st & 1) * 32 + (swz % 64) / 2; }
__host__ __device__ __forceinline__ int perm32(int rho) { const int n = rho >> 4, i = rho & 15; return 8 * (i >> 2) + 4 * n + (i & 3); }

struct Unit { int pm, pn, kb, nt; };
struct Gemm { const bf16_t* A; const bf16_t* Bt; int M, N, K, KL; };

struct GroupOrder {
    int pm0[4], nM[4], pn0[4], nN[4]; int nseg, nwg, G_, c;
    __device__ __forceinline__ void init(int G__, int c_) { nseg = 0; nwg = 0; G_ = G__; c = c_;
#pragma unroll
        for (int s = 0; s < 4; ++s) { pm0[s] = 0; nM[s] = 0; pn0[s] = 0; nN[s] = 1; } }
    __device__ __forceinline__ void add(int s, int pm0_, int nM_, int pn0_, int nN_) { pm0[s] = pm0_; nM[s] = nM_; pn0[s] = pn0_; nN[s] = nN_; nwg += nM_ * nN_; nseg = s + 1; }
    __device__ __forceinline__ bool next(int i, Unit& u) const {
        const long L = (long)i * G_ + c; if (L >= nwg) return false;
        int id = (int)L; { const int q = nwg / NXCD, r = nwg % NXCD, xcd = id % NXCD, off = id / NXCD; id = (xcd < r ? xcd * (q + 1) : r * (q + 1) + (xcd - r) * q) + off; }
        int spm0 = 0, snM = 1, spn0 = 0, snN = 1; bool found = false;
#pragma unroll
        for (int s = 0; s < 4; ++s) { const int cnt = nM[s] * nN[s]; if (!found) { if (id < cnt) { found = true; spm0 = pm0[s]; snM = nM[s]; spn0 = pn0[s]; snN = nN[s]; } else id -= cnt; } }
        const int nig = WGM * snN, gid = id / nig, fm = gid * WGM, gsz = (snM - fm) < WGM ? (snM - fm) : WGM;
        u.pm = spm0 + fm + ((id % nig) % gsz); u.pn = spn0 + (id % nig) / gsz; u.kb = 0; u.nt = 0; return true;
    }
    __device__ __forceinline__ void a_ready(const Unit&) const {}
    __device__ __forceinline__ void done(const Unit&) const {}
};

struct ResidOrder {
    GroupOrder P; int nS, G_, c;
    __device__ __forceinline__ void init(int G__, int c_, int nS_) { P.init(G__, c_); P.add(0, 0, nS_ ? 64 : 66, 0, 4); nS = nS_; G_ = G__; c = c_; }
    __device__ __forceinline__ bool next(int i, Unit& u) const {
        const int npc = c < P.nwg ? (P.nwg - 1 - c) / G_ + 1 : 0;
        if (i < npc) return P.next(i, u);
        const int L = (i - npc) * G_ + (G_ - 1 - c); if (L >= 8 * nS) return false;
        const int sl = L >> 3, t = L & 7; u.pm = 64 + (t & 1); u.pn = t >> 1; u.kb = sl * 512; u.nt = 4; return true; }
    __device__ __forceinline__ void a_ready(const Unit&) const {}
    __device__ __forceinline__ void done(const Unit&) const {}
};
__device__ __forceinline__ unsigned cvt_pk_bf16(float lo, float hi) { return cvt_pk_bf16_(lo, hi); }

struct EpiF32G {
    static constexpr bool PERM = false, AFTER_DRAIN = false;
    float* b0; float* b1; float* b2; float* b3; int ldc, png, pmg;
    __device__ __forceinline__ void operator()(const f32x4 (&acc)[2][2][4][2], const Unit& u, int wr, int wc, int fr, int fq) const {
        const int j = u.pn / png; float* C = j == 0 ? b0 : (j == 1 ? b1 : (j == 2 ? b2 : b3));
        const int row0 = (u.pm - j * pmg) * BM + wr * 64 + fr, col0 = (u.pn - j * png) * BM + wc * 32 + 4 * fq;
#pragma unroll
        for (int ai = 0; ai < 2; ++ai)
#pragma unroll
            for (int m = 0; m < 4; ++m) { float* rowp = C + (size_t)(row0 + ai * HALF + m * 16) * ldc + col0;
#pragma unroll
                for (int bj = 0; bj < 2; ++bj)
#pragma unroll
                    for (int n = 0; n < 2; ++n) *(f32x4*)(rowp + bj * HALF + n * 16) = acc[ai][bj][m][n]; }
    }
};
struct EpiResid {
    static constexpr bool PERM = false, AFTER_DRAIN = false;
    float* X; int ldc;
    __device__ __forceinline__ void operator()(const f32x4 (&acc)[2][2][4][2], const Unit& u, int wr, int wc, int fr, int fq) const {
        const int row0 = u.pm * BM + wr * 64 + fr, col0 = u.pn * BM + wc * 32 + 4 * fq; const bool split = u.nt != 0;
#pragma unroll
        for (int ai = 0; ai < 2; ++ai)
#pragma unroll
            for (int m = 0; m < 4; ++m) { float* rowp = X + (size_t)(row0 + ai * HALF + m * 16) * ldc + col0;
                if (!split) {
#pragma unroll
                    for (int bj = 0; bj < 2; ++bj)
#pragma unroll
                        for (int n = 0; n < 2; ++n) { f32x4* p = (f32x4*)(rowp + bj * HALF + n * 16); *p = *p + acc[ai][bj][m][n]; } }
                else {
#pragma unroll
                    for (int bj = 0; bj < 2; ++bj)
#pragma unroll
                        for (int n = 0; n < 2; ++n) { float* q = rowp + bj * HALF + n * 16;
#pragma unroll
                            for (int e = 0; e < 4; ++e) __hip_atomic_fetch_add(q + e, acc[ai][bj][m][n][e], __ATOMIC_RELAXED, __HIP_MEMORY_SCOPE_AGENT); } }
                asm volatile("" ::: "memory"); }
    }
};
struct EpiWin {
    static constexpr bool PERM = true, AFTER_DRAIN = false;
    bf16_t* U; bf16_t* GT; float* cvp; float* cvs;
    __device__ __forceinline__ void operator()(const f32x4 (&acc)[2][2][4][2], const Unit& u, int wr, int wc, int fr, int fq) const {
        const bool isu = u.pn < 11; bf16_t* base = isu ? U : GT; const int colt = (isu ? u.pn : u.pn - 11) * BM;
        const int row0 = u.pm * BM + wr * 64 + fr, col0 = colt + wc * 32 + 8 * fq;
#pragma unroll
        for (int ai = 0; ai < 2; ++ai)
#pragma unroll
            for (int m = 0; m < 4; ++m) { const int row = row0 + ai * HALF + m * 16; bf16_t* rowp = base + (size_t)row * DFF + col0;
                float* cv = nullptr;
                if (isu) { if (row >= MP) { const int t = (row - MP) & 3, b = (row - MP) >> 2; if (t >= 2) cv = cvs + (size_t)(b * 2 + (t - 2)) * DFF; }
                           else { const int tt = row & (TP - 1); if (tt >= TP - 2) cv = cvp + (size_t)((row >> 13) * 2 + (tt - (TP - 2))) * DFF; } }
#pragma unroll
                for (int bj = 0; bj < 2; ++bj) { const f32x4 v0 = acc[ai][bj][m][0], v1 = acc[ai][bj][m][1];
                    u32x4 w; w.x = cvt_pk_bf16(v0[0], v0[1]); w.y = cvt_pk_bf16(v0[2], v0[3]); w.z = cvt_pk_bf16(v1[0], v1[1]); w.w = cvt_pk_bf16(v1[2], v1[3]);
                    *(u32x4*)(rowp + bj * HALF) = w;
                    if (cv) { *(f32x4*)(cv + col0 + bj * HALF) = v0; *(f32x4*)(cv + col0 + bj * HALF + 4) = v1; } } }
    }
};
template <class Epi, class Sched, bool ALIGN_EPI = false, bool SP2 = false>
__device__ __forceinline__ void gemm_phase(PG8_LAS unsigned char* lds, const Gemm g, const Sched& S, const Epi& E, int tid_in) {
    int tid_l = tid_in; asm volatile("" : "+v"(tid_l));
    const int tid = tid_l, wid = __builtin_amdgcn_readfirstlane(tid >> 6), lane = tid & 63, wr = wid >> 2, wc = wid & 3, fr = lane & 15, fq = lane >> 4;
    const int K = g.K, nt = g.KL / BK;
    unsigned voffA[2], voffB[2];
#pragma unroll
    for (int i = 0; i < 2; ++i) { int R, C; stage_rc(tid * 16 + i * 8192, R, C); const int Rb = Epi::PERM ? ((R & ~31) + perm32(R & 31)) : R;
        voffA[i] = (unsigned)(R * K + C) * 2u; voffB[i] = (unsigned)(Rb * K + C) * 2u; }
    const size_t kstep = (size_t)(BK * 2);
    const size_t hstep = (size_t)HALF * K * 2;
    const size_t tstep = 2 * hstep;
    const unsigned ldsw = (unsigned)wid * 1024u;
    const int aoff = lds_byte(wr * 64 + fr, fq * 8), boff = lds_byte(wc * 32 + fr, fq * 8);
#define PG8_SA(b, h) (((b) * 2 + (h)) * HTB)
#define PG8_SB(b, h) ((4 + (b) * 2 + (h)) * HTB)
#define PG8_STAGE(bufoff, gbase, voff) do { _Pragma("unroll") for (int _i = 0; _i < 2; ++_i) \
        __builtin_amdgcn_global_load_lds((const unsigned*)((const char*)(gbase) + (voff)[_i]), (PG8_LAS unsigned*)(lds + (bufoff) + ldsw + _i * 8192), 16, 0, 0); } while (0)
#define PG8_LDA(dst, b, h) do { _Pragma("unroll") for (int m = 0; m < 4; ++m) _Pragma("unroll") for (int k = 0; k < 2; ++k) dst[m][k] = *(const PG8_LAS bf16x8*)(lds + PG8_SA(b, h) + aoff + m * 2048 + k * 1024); } while (0)
#define PG8_LDB(dst, b, h) do { _Pragma("unroll") for (int n = 0; n < 2; ++n) _Pragma("unroll") for (int k = 0; k < 2; ++k) dst[n][k] = *(const PG8_LAS bf16x8*)(lds + PG8_SB(b, h) + boff + n * 2048 + k * 1024); } while (0)
#define PG8_MMA(ai, bj, At, Bt) do { __builtin_amdgcn_s_setprio(1); _Pragma("unroll") for (int m = 0; m < 4; ++m) _Pragma("unroll") for (int n = 0; n < 2; ++n) _Pragma("unroll") for (int k = 0; k < 2; ++k) \
        acc[ai][bj][m][n] = __builtin_amdgcn_mfma_f32_16x16x32_bf16(Bt[n][k], At[m][k], acc[ai][bj][m][n], 0, 0, 0); __builtin_amdgcn_s_setprio(0); } while (0)
#define PG8_WAIT_V(n) asm volatile("s_waitcnt vmcnt(" #n ")" ::: "memory")
#define PG8_WAIT_L(n) asm volatile("s_waitcnt lgkmcnt(" #n ")" ::: "memory")
#define PG8_BAR __builtin_amdgcn_s_barrier()
#define PG8_SCHED __builtin_amdgcn_sched_barrier(0)
    Unit cur, nxt; int ui = 0;
    if (!S.next(0, cur)) return;
    f32x4 acc[2][2][4][2];
#pragma unroll
    for (int a = 0; a < 2; ++a)
#pragma unroll
        for (int b = 0; b < 2; ++b)
#pragma unroll
            for (int m = 0; m < 4; ++m)
#pragma unroll
                for (int n = 0; n < 2; ++n) acc[a][b][m][n] = (f32x4){0.f, 0.f, 0.f, 0.f};
    bf16x8 At[4][2], B0[2][2], B1[2][2];
    const char* cA = (const char*)g.A + (size_t)cur.pm * tstep + cur.kb; const char* cB = (const char*)g.Bt + (size_t)cur.pn * tstep + cur.kb;
    S.a_ready(cur);
    if constexpr (SP2) {
        PG8_STAGE(PG8_SB(0, 0), cB, voffB); PG8_STAGE(PG8_SB(0, 1), cB + hstep, voffB); PG8_STAGE(PG8_SA(0, 0), cA, voffA); PG8_STAGE(PG8_SA(0, 1), cA + hstep, voffA);
        if (wr == 1) PG8_BAR;
        PG8_WAIT_V(2); PG8_BAR;
        PG8_STAGE(PG8_SB(1, 0), cB + kstep, voffB); PG8_STAGE(PG8_SA(1, 0), cA + kstep, voffA); PG8_STAGE(PG8_SB(1, 1), cB + hstep + kstep, voffB);
        PG8_WAIT_V(6); PG8_BAR;
    } else {
        PG8_STAGE(PG8_SB(0, 0), cB, voffB); PG8_STAGE(PG8_SA(0, 0), cA, voffA); PG8_STAGE(PG8_SB(0, 1), cB + hstep, voffB); PG8_STAGE(PG8_SA(0, 1), cA + hstep, voffA);
        if (wr == 1) PG8_BAR;
        PG8_WAIT_V(4); PG8_BAR;
        PG8_STAGE(PG8_SB(1, 0), cB + kstep, voffB); PG8_STAGE(PG8_SA(1, 0), cA + kstep, voffA); PG8_STAGE(PG8_SB(1, 1), cB + hstep + kstep, voffB);
        PG8_WAIT_V(6); PG8_BAR;
    }
    for (;;) {
        const bool has_next = S.next(ui + 1, nxt);
        const char* nA = has_next ? (const char*)g.A + (size_t)nxt.pm * tstep + nxt.kb : cA; const char* nB = has_next ? (const char*)g.Bt + (size_t)nxt.pn * tstep + nxt.kb : cB;
        const int ntu = cur.nt ? cur.nt : nt;
        for (int t = 0; t < ntu; t += 2) {
            const bool last = (t == ntu - 2);
            const char* a1 = cA + (size_t)(t + 1) * kstep;
            const char* a2 = last ? nA : cA + (size_t)(t + 2) * kstep; const char* b2 = last ? nB : cB + (size_t)(t + 2) * kstep;
            const char* a3 = a2 + kstep; const char* b3 = b2 + kstep;
            if (last && has_next) S.a_ready(nxt);
            if constexpr (SP2) {
            PG8_LDB(B0, 0, 0); PG8_LDB(B1, 0, 1); PG8_SCHED; PG8_LDA(At, 0, 0); PG8_STAGE(PG8_SA(1, 1), a1 + hstep, voffA);
            PG8_WAIT_V(8); PG8_WAIT_L(0); PG8_BAR; PG8_MMA(0, 0, At, B0); PG8_MMA(0, 1, At, B1); PG8_BAR; PG8_SCHED;
            PG8_LDA(At, 0, 1); PG8_STAGE(PG8_SB(0, 0), b2, voffB); PG8_STAGE(PG8_SB(0, 1), b2 + hstep, voffB); PG8_STAGE(PG8_SA(0, 0), a2, voffA);
            PG8_WAIT_V(8); PG8_WAIT_L(0); PG8_BAR; PG8_MMA(1, 0, At, B0); PG8_MMA(1, 1, At, B1); PG8_BAR; PG8_SCHED;
            PG8_LDB(B0, 1, 0); PG8_LDB(B1, 1, 1); PG8_SCHED; PG8_LDA(At, 1, 0); PG8_STAGE(PG8_SA(0, 1), a2 + hstep, voffA);
            PG8_WAIT_V(8); PG8_WAIT_L(0); PG8_BAR; PG8_MMA(0, 0, At, B0); PG8_MMA(0, 1, At, B1); PG8_BAR; PG8_SCHED;
            PG8_LDA(At, 1, 1); PG8_STAGE(PG8_SB(1, 0), b3, voffB); PG8_STAGE(PG8_SB(1, 1), b3 + hstep, voffB); PG8_STAGE(PG8_SA(1, 0), a3, voffA);
            PG8_WAIT_V(8); PG8_WAIT_L(0); PG8_BAR; PG8_MMA(1, 0, At, B0); PG8_MMA(1, 1, At, B1); PG8_BAR; PG8_SCHED;
            } else {
            PG8_LDB(B0, 0, 0); PG8_SCHED; PG8_LDA(At, 0, 0); PG8_STAGE(PG8_SA(1, 1), a1 + hstep, voffA);
            PG8_WAIT_L(8); PG8_BAR; PG8_WAIT_L(0); PG8_MMA(0, 0, At, B0); PG8_BAR; PG8_SCHED;
            PG8_LDB(B1, 0, 1); PG8_STAGE(PG8_SB(0, 0), b2, voffB);
            PG8_BAR; PG8_WAIT_L(0); PG8_MMA(0, 1, At, B1); PG8_BAR;
            PG8_LDA(At, 0, 1); PG8_STAGE(PG8_SA(0, 0), a2, voffA);
            PG8_BAR; PG8_WAIT_L(0); PG8_MMA(1, 0, At, B0); PG8_BAR; PG8_SCHED;
            PG8_STAGE(PG8_SB(0, 1), b2 + hstep, voffB);
            PG8_WAIT_V(6); PG8_BAR; PG8_MMA(1, 1, At, B1); PG8_BAR;
            PG8_LDB(B0, 1, 0); PG8_SCHED; PG8_LDA(At, 1, 0); PG8_STAGE(PG8_SA(0, 1), a2 + hstep, voffA);
            PG8_WAIT_L(8); PG8_BAR; PG8_WAIT_L(0); PG8_MMA(0, 0, At, B0); PG8_BAR; PG8_SCHED;
            PG8_LDB(B1, 1, 1); PG8_STAGE(PG8_SB(1, 0), b3, voffB);
            PG8_BAR; PG8_WAIT_L(0); PG8_MMA(0, 1, At, B1); PG8_BAR;
            PG8_LDA(At, 1, 1); PG8_STAGE(PG8_SA(1, 0), a3, voffA);
            PG8_BAR; PG8_WAIT_L(0); PG8_MMA(1, 0, At, B0); PG8_BAR; PG8_SCHED;
            PG8_STAGE(PG8_SB(1, 1), b3 + hstep, voffB);
            PG8_WAIT_V(6); PG8_BAR; PG8_MMA(1, 1, At, B1); PG8_BAR;
            }
        }
        if constexpr (ALIGN_EPI) { if (wr == 0) PG8_BAR; }
        if constexpr (!Epi::AFTER_DRAIN) { E(acc, cur, wr, wc, fr, fq); S.done(cur); }
        if (!has_next) break;
#pragma unroll
        for (int a = 0; a < 2; ++a)
#pragma unroll
            for (int b = 0; b < 2; ++b)
#pragma unroll
                for (int m = 0; m < 4; ++m)
#pragma unroll
                    for (int n = 0; n < 2; ++n) acc[a][b][m][n] = (f32x4){0.f, 0.f, 0.f, 0.f};
        cur = nxt; cA = nA; cB = nB; ++ui;
        if constexpr (ALIGN_EPI) { if (wr == 1) PG8_BAR; }
    }
    PG8_WAIT_V(0);
    if constexpr (!ALIGN_EPI) { if (wr == 0) PG8_BAR; }
    PG8_BAR;
    if constexpr (Epi::AFTER_DRAIN) { E.fused(acc, cur, wr, wc, fr, fq, lds, wid, lane); S.done(cur); }
#undef PG8_SA
#undef PG8_SB
#undef PG8_STAGE
#undef PG8_LDA
#undef PG8_LDB
#undef PG8_MMA
#undef PG8_WAIT_V
#undef PG8_WAIT_L
#undef PG8_BAR
#undef PG8_SCHED
}
}
constexpr int RING_BYTES = 131072, MISC_OFF = RING_BYTES + 320, LDS_BYTES = 147456;
struct Params { const float* in[45]; float* out; unsigned char* ws; int ph_lo, ph_hi, use_bar, pad; };
enum { I_XP = 0, I_XS, I_CKV, I_CWIN, I_SWKV, I_SSHIFT, I_SCONV, I_PT, I_NORMG, I_MU, I_WR, I_WK, I_WV, I_WO, I_W0, I_W1, I_W2, I_A0, I_A1, I_A2, I_V0, I_V1, I_V2, I_G1, I_G2,
       I_KK, I_KA, I_RKK, I_LNW, I_LNB, I_KVNG, I_WKV, I_KNG, I_PE, I_CW1, I_CB1, I_CW2, I_CB2, I_WQ, I_QNG, I_WONSA, I_WIN, I_CONVW, I_CONVB, I_WOUT };

typedef const __attribute__((address_space(4))) Params* KP;
struct Ctx { LAS unsigned char* lds; int tid, lane, wave, gw, ngw, gtid, gsz; };

__device__ __forceinline__ void p0_transpose_item(const float* W, int K, int ldw, int nblk, bf16_t* WT, int row_off, LAS float* scr, int item, int lane) {
    const int kb = item / nblk, nb = item % nblk, k0 = 64 * kb, n0 = 32 * nb;
#pragma unroll 8
    for (int i = 0; i < 32; ++i) { const int kk = 2 * i + (lane >> 5); scr[kk * 33 + (lane & 31)] = W[(size_t)(k0 + kk) * ldw + n0 + (lane & 31)]; }
    LDS_WAIT(); asm volatile("" ::: "memory");
    const int c = lane & 7;
#pragma unroll
    for (int j = 0; j < 4; ++j) { const int n = (lane >> 3) + 8 * j; const LAS float* s = scr + (8 * c) * 33 + n;
        u32x4 o; o.x = pk2(s[0 * 33], s[1 * 33]); o.y = pk2(s[2 * 33], s[3 * 33]); o.z = pk2(s[4 * 33], s[5 * 33]); o.w = pk2(s[6 * 33], s[7 * 33]);
        *(u32x4*)(WT + (size_t)(row_off + n0 + n) * K + k0 + 8 * c) = o; }
    LDS_WAIT(); asm volatile("" ::: "memory");
}

__device__ __forceinline__ void phase_prologue(KP p, const Ctx& c) {
    LAS float* scr = (LAS float*)(c.lds + c.wave * 16384);
    unsigned char* ws = p->ws;
    int total = 0;
#define TRCNT(K_, N_) (((K_) / 64) * ((N_) / 32))
    constexpr int C_DD = TRCNT(1024, 1024), C_L64 = TRCNT(1024, 64), C_L32 = TRCNT(1024, 32), C_L128 = TRCNT(1024, 128), C_2_64 = TRCNT(64, 1024), C_2_128 = TRCNT(128, 1024);
    constexpr int C_KV = TRCNT(1024, 1536), C_Q = 16 * 33, C_IN = TRCNT(1024, 5632), C_OUT = TRCNT(2816, 1024), C_CW = TRCNT(1024, 128);
    constexpr int NITEMS = 2 * (4 * C_DD + 2 * C_L64 + C_L128 + 2 * C_2_64 + C_2_128) + C_L32 + C_KV + 2 * C_Q + 2 * C_DD + 4 * C_IN + 4 * C_OUT + 4 * C_CW;
    (void)total;
    for (int it = c.gw; it < NITEMS; it += c.ngw) {
        int r = it;
#define TR(Wp, K_, LDW_, NBLK_, WTp, ROWOFF_) { const int cnt_ = ((K_) / 64) * (NBLK_); if (r < cnt_) { p0_transpose_item((Wp), (K_), (LDW_), (NBLK_), (bf16_t*)(WTp), (ROWOFF_), scr, r, c.lane); continue; } r -= cnt_; }
        bool done = false;
#pragma unroll
        for (int l = 0; l < 2; ++l) {
            if (done) break;
            const size_t dd = (size_t)l * 1024 * 1024;
#define TRL(Wp, K_, LDW_, NBLK_, WTp, ROWOFF_) { const int cnt_ = ((K_) / 64) * (NBLK_); if (!done) { if (r < cnt_) { p0_transpose_item((Wp), (K_), (LDW_), (NBLK_), (bf16_t*)(WTp), (ROWOFF_), scr, r, c.lane); done = true; } else r -= cnt_; } }
            TRL(p->in[I_WR] + dd, 1024, 1024, 32, ws + WS_WRKV + (size_t)l * 3072 * 1024 * 2, 0)
            TRL(p->in[I_WK] + dd, 1024, 1024, 32, ws + WS_WRKV + (size_t)l * 3072 * 1024 * 2, 1024)
            TRL(p->in[I_WV] + dd, 1024, 1024, 32, ws + WS_WRKV + (size_t)l * 3072 * 1024 * 2, 2048)
            TRL(p->in[I_WO] + dd, 1024, 1024, 32, ws + WS_WORW + (size_t)l * 1024 * 1024 * 2, 0)
            TRL(p->in[I_W1] + (size_t)l * 1024 * 64, 1024, 64, 2, ws + WS_W1T + (size_t)l * 288 * 1024 * 2, 0)
            TRL(p->in[I_A1] + (size_t)l * 1024 * 64, 1024, 64, 2, ws + WS_W1T + (size_t)l * 288 * 1024 * 2, 64)
            TRL(p->in[I_G1] + (size_t)l * 1024 * 128, 1024, 128, 4, ws + WS_W1T + (size_t)l * 288 * 1024 * 2, 160)
            TRL(p->in[I_W2] + (size_t)l * 64 * 1024, 64, 1024, 32, ws + WS_W2W + (size_t)l * 1024 * 64 * 2, 0)
            TRL(p->in[I_A2] + (size_t)l * 64 * 1024, 64, 1024, 32, ws + WS_W2A + (size_t)l * 1024 * 64 * 2, 0)
            TRL(p->in[I_G2] + (size_t)l * 128 * 1024, 128, 1024, 32, ws + WS_W2G + (size_t)l * 1024 * 128 * 2, 0)
        }
        if (done) continue;
        TR(p->in[I_V1], 1024, 32, 1, ws + WS_W1T + (size_t)1 * 288 * 1024 * 2, 128)
        TR(p->in[I_WKV], 1024, 1536, 48, ws + WS_WKVT, 0)
        TR(p->in[I_WQ], 1024, NQ, 33, ws + WS_WQT, 0)
        TR(p->in[I_WQ] + (size_t)1024 * NQ, 1024, NQ, 33, ws + WS_WQT + (size_t)NQP * 1024 * 2, 0)
        TR(p->in[I_WONSA], 1024, 1024, 32, ws + WS_WONSA, 0)
        TR(p->in[I_WONSA] + (size_t)1024 * 1024, 1024, 1024, 32, ws + WS_WONSA + (size_t)1024 * 1024 * 2, 0)
#pragma unroll
        for (int l = 0; l < 4; ++l) {
            if (done) break;
            TRL(p->in[I_WIN] + (size_t)l * 1024 * 5632, 1024, 5632, 176, ws + WS_WINT + (size_t)l * 5632 * 1024 * 2, 0)
            TRL(p->in[I_WOUT] + (size_t)l * 2816 * 1024, 2816, 1024, 32, ws + WS_WOUTT + (size_t)l * 1024 * 2816 * 2, 0)
        }
        if (done) continue;
        TR(p->in[I_CW1], 1024, 128, 4, ws + WS_CW1T, 0)
        TR(p->in[I_CW1] + (size_t)1024 * 128, 1024, 128, 4, ws + WS_CW1T, 128)
        TR(p->in[I_CW1] + (size_t)2048 * 128, 1024, 128, 4, ws + WS_CW1T + (size_t)256 * 1024 * 2, 0)
        TR(p->in[I_CW1] + (size_t)3072 * 128, 1024, 128, 4, ws + WS_CW1T + (size_t)256 * 1024 * 2, 128)
#undef TR
#undef TRL
    }
    {
        bf16_t* WQT = (bf16_t*)(ws + WS_WQT);
        for (int e = c.gtid; e < 2 * 224 * 1024; e += c.gsz) { const int k = e & 1023, n = 1056 + ((e >> 10) % 224), l = e / (224 * 1024);
            WQT[((size_t)l * NQP + n) * 1024 + k] = n < NQ ? (bf16_t)f2bf(p->in[I_WQ][((size_t)l * 1024 + k) * NQ + n]) : (bf16_t)0; }
        bf16_t* W2V = (bf16_t*)(ws + WS_W2V);
        for (int e = c.gtid; e < 32 * 1024; e += c.gsz) { const int n = e & 1023, k = e >> 10; W2V[n * 32 + k] = (bf16_t)f2bf(p->in[I_V2][k * 1024 + n]); }
    }
    { bf16_t* W2T = (bf16_t*)(ws + WS_CW2T);
      for (int e = c.gtid; e < 2 * 128 * 64; e += c.gsz) { const int d = e & 63, q = (e >> 6) & 127, kv = e >> 13; const float w = p->in[I_CW2][e];
          const unsigned hi = f2bf(w), lo = f2bf(w - __builtin_bit_cast(float, hi << 16)); W2T[(size_t)(kv * 64 + d) * 128 + q] = (bf16_t)hi; W2T[(size_t)2 * 64 * 128 + (size_t)(kv * 64 + d) * 128 + q] = (bf16_t)lo; } }
    for (int it = c.gw; it < 256; it += c.ngw) { const int kv = it >> 7, h = it & 127; float s = 0.f;
        for (int kk = c.lane; kk < 2048; kk += 64) s += p->in[I_PE][kv * 2048 + kk] * p->in[I_CW1][((size_t)kv * 2048 + kk) * 128 + h];
        s = wave_sum(s); if (c.lane == 0) ((float*)(ws + WS_CBIAS))[it] = s + p->in[I_CB1][it]; }
    { const f32x4* xp = (const f32x4*)p->in[I_XP]; const f32x4* xs = (const f32x4*)p->in[I_XS]; f32x4* o = (f32x4*)(p->out + O_Y);
      for (int e = c.gtid; e < R * D / 4; e += c.gsz) o[e] = e < MP * D / 4 ? xp[e] : xs[e - MP * D / 4]; }
}

__device__ __forceinline__ void phase_fill(KP p, const Ctx& c, int li, const int gwf, const int ngwf) {
    unsigned char* ws = p->ws;
    { const int* pt = (const int*)p->in[I_PT]; bf16_t* CA = (bf16_t*)(ws + WS_CMPA); const int part = li;
      for (int it = gwf; it < SB * 128 * 4; it += ngwf) { const int s4 = 4 * (it & 3), n = (it >> 2) & 127, b = it >> 9;
          const int page = pt[b * NPAGES + (n >> 3)]; const float* src = p->in[I_CKV] + ((size_t)page * PAGE + (n & 7) * 16 + s4) * 1024 + part * 256;
          f32x4 v[4];
#pragma unroll
          for (int e = 0; e < 4; ++e) v[e] = __builtin_nontemporal_load(((const f32x4*)(src + (size_t)e * 1024)) + c.lane);
          const int g = c.lane >> 4, d0 = 4 * (c.lane & 15); bf16_t* dst = CA + ((size_t)8192 + (size_t)part * 65536 + (size_t)(b * 4 + g) * 128 + n) * 1024 + s4 * 64 + d0;
#pragma unroll
          for (int e = 0; e < 4; ++e) { u32x2 w; w.x = pk2(v[e][0], v[e][1]); w.y = pk2(v[e][2], v[e][3]); *(u32x2*)(dst + e * 64) = w; } } }
    { const f32x4* src = (const f32x4*)p->in[I_CWIN]; f32x4* dst = (f32x4*)(p->out + O_WINS); constexpr int HALF_N = SB * 508 * 128 / 2;
      for (int e0 = li * HALF_N + gwf * 256 + c.lane; e0 < (li + 1) * HALF_N; e0 += ngwf * 256) { f32x4 v[4];
#pragma unroll
          for (int q = 0; q < 4; ++q) { const int e = e0 + 64 * q; if (e < (li + 1) * HALF_N) { const int b = e / (508 * 128), rr = e % (508 * 128); v[q] = __builtin_nontemporal_load(src + (size_t)b * 512 * 128 + 4 * 128 + rr); } }
#pragma unroll
          for (int q = 0; q < 4; ++q) { const int e = e0 + 64 * q; if (e < (li + 1) * HALF_N) { const int b = e / (508 * 128), rr = e % (508 * 128); __builtin_nontemporal_store(v[q], dst + (size_t)b * 512 * 128 + rr); } } } }
}

template <int NT> __device__ __forceinline__ void skinny_mma(const bf16_t* A, int lda, const bf16_t* Wt, int ldw, int K, int row0, int col0, int lane, f32x4 (&acc)[NT][2]) {
    const int fr = lane & 15, fq = lane >> 4;
#pragma unroll
    for (int nt = 0; nt < NT; ++nt) { acc[nt][0] = (f32x4){0.f, 0.f, 0.f, 0.f}; acc[nt][1] = (f32x4){0.f, 0.f, 0.f, 0.f}; }
    const bf16_t* xa = A + (size_t)(row0 + fr) * lda + 8 * fq; const bf16_t* xb = xa + (size_t)16 * lda;
    const bf16_t* wa = Wt + (size_t)(col0 + fr) * ldw + 8 * fq;
    const char* pa = (const char*)xa; const char* pb = (const char*)xb; const char* pw[NT];
#pragma unroll
    for (int nt = 0; nt < NT; ++nt) pw[nt] = (const char*)(wa + (size_t)nt * 16 * ldw);
    for (int k4 = 0; k4 < K / 128; ++k4) {
        bf16x8 fb[4][2], fa[4][NT];
#pragma unroll
        for (int u = 0; u < 4; ++u) { fb[u][0] = *(const bf16x8*)(pa + 64 * u); fb[u][1] = *(const bf16x8*)(pb + 64 * u);
#pragma unroll
            for (int nt = 0; nt < NT; ++nt) fa[u][nt] = *(const bf16x8*)(pw[nt] + 64 * u); }
        __builtin_amdgcn_sched_barrier(0);
#pragma unroll
        for (int u = 0; u < 4; ++u)
#pragma unroll
            for (int nt = 0; nt < NT; ++nt) { acc[nt][0] = mfma16(fa[u][nt], fb[u][0], acc[nt][0]); acc[nt][1] = mfma16(fa[u][nt], fb[u][1], acc[nt][1]); }
        pa += 256; pb += 256;
#pragma unroll
        for (int nt = 0; nt < NT; ++nt) pw[nt] += 256;
        __builtin_amdgcn_sched_barrier(0);
    }
}
__device__ __forceinline__ void skinny_resid_sample(const Ctx& c, const bf16_t* A, int lda, const bf16_t* Wt, int K, float* X) {
    const int ln = launder_v(c.lane), fr = ln & 15, fq = ln >> 4, w = c.wave;
    const int nch = K >> 7, c0 = (nch * w) >> 3, c1 = (nch * (w + 1)) >> 3;
    LAS f32x4* part = (LAS f32x4*)c.lds;
    __syncthreads();
    for (int it = blockIdx.x; it < 256; it += gridDim.x) { const int row0 = MP + 32 * (it & 15), col0 = 64 * (it >> 4);
        f32x4 acc[4][2]; skinny_mma<4>(A + 128 * c0, lda, Wt + 128 * c0, lda, 128 * (c1 - c0), row0, col0, c.lane, acc);
#pragma unroll
        for (int nt = 0; nt < 4; ++nt)
#pragma unroll
            for (int mt = 0; mt < 2; ++mt) part[(w * 8 + nt * 2 + mt) * 64 + ln] = acc[nt][mt];
        const int nt = w >> 1, mt = w & 1; f32x4* q = (f32x4*)(X + (size_t)(row0 + 16 * mt + fr) * D + col0 + 16 * nt + 4 * fq); f32x4 s = *q;
        __syncthreads();
#pragma unroll
        for (int ww = 0; ww < 8; ++ww) s = s + part[(ww * 8 + w) * 64 + ln];
        *q = s;
        __syncthreads(); }
}
__device__ __forceinline__ void skinny_store(const Ctx& c, const bf16_t* A, const bf16_t* Wt, int K, float* C, int ldc, int rbase, int nrb, int ncb, int it0, int nit_total) {
    const int fr = c.lane & 15, fq = c.lane >> 4;
    for (int it = c.gw - it0; it < nrb * ncb; it += c.ngw) { if (it < 0) continue; const int row0 = rbase + 32 * (it % nrb), col0 = 64 * (it / nrb);
        f32x4 acc[4][2]; skinny_mma<4>(A, K, Wt, K, K, row0, col0, c.lane, acc);
#pragma unroll
        for (int nt = 0; nt < 4; ++nt)
#pragma unroll
            for (int mt = 0; mt < 2; ++mt) *(f32x4*)(C + (size_t)(row0 + 16 * mt + fr) * ldc + col0 + 16 * nt + 4 * fq) = acc[nt][mt]; }
    (void)nit_total;
}

__device__ __forceinline__ void load_row(const float* p, int lane, f32x4 (&v)[4]) {
#pragma unroll
    for (int j = 0; j < 4; ++j) v[j] = ((const f32x4*)p)[lane + 64 * j];
}
__device__ __forceinline__ float row_rstd(const f32x4 (&v)[4]) {
    float s = 0.f;
#pragma unroll
    for (int j = 0; j < 4; ++j) s += (v[j][0] * v[j][0] + v[j][1] * v[j][1]) + (v[j][2] * v[j][2] + v[j][3] * v[j][3]);
    s = wave_sum(s); return frsq(s * (1.0f / D) + NORM_EPS);
}
__device__ __forceinline__ void store_row_bf16(bf16_t* o, int lane, const f32x4 (&v)[4]) {
#pragma unroll
    for (int j = 0; j < 4; ++j) { u32x2 w; w.x = pk2(v[j][0], v[j][1]); w.y = pk2(v[j][2], v[j][3]); ((u32x2*)o)[lane + 64 * j] = w; }
}

__device__ __forceinline__ void phase_norm(const Ctx& c, const float* X, const float* g1, bf16_t* o1, const float* g2, bf16_t* o2) {
    f32x4 ga[4], gb[4]; load_row(g1, c.lane, ga); if (g2) load_row(g2, c.lane, gb);
    for (int row = c.gw; row < R; row += c.ngw) {
        f32x4 v[4]; load_row(X + (size_t)row * D, c.lane, v); const float rs = row_rstd(v);
        f32x4 y[4];
#pragma unroll
        for (int j = 0; j < 4; ++j) y[j] = v[j] * rs * ga[j];
        store_row_bf16(o1 + (size_t)row * D, c.lane, y);
        if (g2) {
#pragma unroll
            for (int j = 0; j < 4; ++j) y[j] = v[j] * rs * gb[j];
            store_row_bf16(o2 + (size_t)row * D, c.lane, y); }
    }
}

__device__ __forceinline__ void phase_mix(KP p, const Ctx& c, int li) {
    const float* X = p->out + O_Y; const float* gain = p->in[I_NORMG] + (size_t)(li * 2) * D; const float* mu = p->in[I_MU] + (size_t)li * 6 * D;
    bf16_t* XM = (bf16_t*)(p->ws + WS_XM);
    f32x4 ga[4]; load_row(gain, c.lane, ga);
    {
        const int r0 = (int)(((long)c.gw * R) / c.ngw), r1 = (int)(((long)(c.gw + 1) * R) / c.ngw); f32x4 prev[4];
        {
            const bool seq_start = r0 < MP ? ((r0 & (TP - 1)) == 0) : (((r0 - MP) & 3) == 0);
            if (!seq_start && r0 < r1) { f32x4 v[4]; load_row(X + (size_t)(r0 - 1) * D, c.lane, v); const float rs = row_rstd(v);
#pragma unroll
                for (int j = 0; j < 4; ++j) prev[j] = v[j] * rs * ga[j]; }
        }
        for (int row = r0; row < r1; ++row) {
            const bool seq_start = row < MP ? ((row & (TP - 1)) == 0) : (((row - MP) & 3) == 0);
            if (seq_start) {
                if (row < MP) {
#pragma unroll
                    for (int j = 0; j < 4; ++j) prev[j] = (f32x4){0.f, 0.f, 0.f, 0.f}; }
                else load_row(p->in[I_SSHIFT] + ((size_t)li * SB + ((row - MP) >> 2)) * D, c.lane, prev);
            }
            f32x4 v[4]; load_row(X + (size_t)row * D, c.lane, v); const float rs = row_rstd(v);
            f32x4 xn[4];
#pragma unroll
            for (int j = 0; j < 4; ++j) xn[j] = v[j] * rs * ga[j];
#pragma unroll
            for (int m = 0; m < 6; ++m) {
                f32x4 y[4];
#pragma unroll
                for (int j = 0; j < 4; ++j) { const int mi = m == 1 ? 2 : (m == 2 ? 3 : (m == 3 ? 1 : m));
                    const f32x4 mm = ((const f32x4*)(mu + (size_t)mi * D))[c.lane + 64 * j]; y[j] = xn[j] + (prev[j] - xn[j]) * mm; }
                store_row_bf16(XM + ((size_t)m * R + row) * D, c.lane, y);
            }
            const bool seq_end = row < MP ? ((row & (TP - 1)) == TP - 1) : (((row - MP) & 3) == 3);
            if (seq_end) { float* so = row < MP ? p->out + O_SHP + ((size_t)li * NB + (row >> 13)) * D : p->out + O_SHS + ((size_t)li * SB + ((row - MP) >> 2)) * D;
#pragma unroll
                for (int j = 0; j < 4; ++j) ((f32x4*)so)[c.lane + 64 * j] = xn[j]; }
#pragma unroll
            for (int j = 0; j < 4; ++j) prev[j] = xn[j];
        }
    }
}
template <int NT, int ACT> __device__ __forceinline__ void lora1_item(const bf16_t* X, const bf16_t* W, bf16_t* HID, int coloff, int rb, int lane) {
    lane = launder_v(lane);
    const int fr = lane & 15, fq = lane >> 4;
    f32x4 acc[NT][2]; skinny_mma<NT>(X, 1024, W, 1024, 1024, rb * 32, coloff, lane, acc);
#pragma unroll
    for (int nt = 0; nt < NT; ++nt)
#pragma unroll
        for (int mt = 0; mt < 2; ++mt) { f32x4 v = acc[nt][mt];
#pragma unroll
            for (int r = 0; r < 4; ++r) { if (ACT == 1) { const float e = __builtin_amdgcn_exp2f(2.8853900817779268f * v[r]); v[r] = 1.0f - 2.0f * frcp(e + 1.0f); } if (ACT == 2) v[r] = sigmoidf_(v[r]); }
            u32x2 w; w.x = pk2(v[0], v[1]); w.y = pk2(v[2], v[3]);
            *(u32x2*)(HID + (size_t)(rb * 32 + mt * 16 + fr) * LHID + coloff + nt * 16 + 4 * fq) = w; }
}
__device__ __forceinline__ void phase_lora1(KP p, const Ctx& c, int li) {
    const bf16_t* XM = (const bf16_t*)(p->ws + WS_XM); const bf16_t* W = (const bf16_t*)(p->ws + WS_W1T) + (size_t)li * 288 * 1024; bf16_t* HID = (bf16_t*)(p->ws + WS_HID);
    constexpr int NRB = R / 32;
    for (int it = blockIdx.x + gridDim.x * c.wave; it < 5 * NRB; it += c.ngw) { const int q = it / NRB, rb = it % NRB;
        if (q == 0) lora1_item<4, 1>(XM + (size_t)3 * R * D, W, HID, 0, rb, c.lane);
        else if (q == 1) lora1_item<4, 0>(XM + (size_t)4 * R * D, W, HID, 64, rb, c.lane);
        else if (q == 2) { if (li == 1) lora1_item<2, 0>(XM + (size_t)2 * R * D, W, HID, 128, rb, c.lane); }
        else if (q == 3) lora1_item<4, 2>(XM + (size_t)5 * R * D, W, HID, 160, rb, c.lane);
        else lora1_item<4, 2>(XM + (size_t)5 * R * D, W, HID, 224, rb, c.lane);
    }
}

constexpr int SST = 72, MAT = 64 * SST * 2;
constexpr int O_AT = 0, O_BT = MAT, O_KT = 2 * MAT, O_RT = 3 * MAT, O_VT = 4 * MAT, O_BH = 5 * MAT, O_KH = 6 * MAT, O_XT = 7 * MAT, O_AAB = 9 * MAT, O_AAK = 10 * MAT, O_ARB = 11 * MAT, O_ARK = 12 * MAT;
constexpr int O_TD = 13 * MAT, O_SCR = O_TD + 2048, O_CS = O_SCR + 4096, O_WC = O_CS + 2048, O_LW = O_XT, O_LA = O_XT + 16384, O_LV = O_XT + 32768;
static_assert(O_WC + 256 <= RING_BYTES && O_LV + 16384 <= O_TD, "scan LDS map");
__device__ __forceinline__ bf16x8 ldsfrag(LAS unsigned char* lds, int off, int row, int col) { return *(const LAS bf16x8*)(lds + off + (row * SST + col) * 2); }
__device__ __forceinline__ void lds_st4(LAS unsigned char* lds, int off, int row, int col, f32x4 v) { u32x2 w; w.x = pk2(v[0], v[1]); w.y = pk2(v[2], v[3]); *(LAS u32x2*)(lds + off + (row * SST + col) * 2) = w; }
__device__ __forceinline__ f32x4 lds_ld4(LAS unsigned char* lds, int off, int row, int col) { const u32x2 w = *(const LAS u32x2*)(lds + off + (row * SST + col) * 2); return (f32x4){bflo(w.x), bfhi(w.x), bflo(w.y), bfhi(w.y)}; }

__device__ __forceinline__ void scanA_unit(KP p, const Ctx& c, int li, int u) {
    LAS unsigned char* lds = c.lds; unsigned char* ws = p->ws; const int stop = p->pad;
    const int lane = c.lane, wave = c.wave, fr = lane & 15, fq = lane >> 4;
    const int b = u / (NCH * H), n = (u / H) % NCH, h = u % H, row0 = b * TP + 64 * n;
    const float* Rb = (const float*)(ws + WS_RK_R); const float* Kb = (const float*)(ws + WS_RK_K);
    float* Vb = (float*)(ws + (li ? WS_V1 : WS_V0)); const float* V0b = (const float*)(ws + WS_V0);
    const bf16_t* HID = (const bf16_t*)(ws + WS_HID);
    {
        const int tt = wave & 3, chh = wave >> 2;
        const bf16_t* hrow = launder_p(HID + (size_t)(row0 + 16 * tt + fr) * LHID + 8 * fq);
        const bf16_t* W2W = (const bf16_t*)(ws + WS_W2W) + (size_t)li * 1024 * 64; const bf16_t* W2A = (const bf16_t*)(ws + WS_W2A) + (size_t)li * 1024 * 64; const bf16_t* W2V = (const bf16_t*)(ws + WS_W2V);
#pragma unroll
        for (int cti = 0; cti < 2; ++cti) { const int ct = 2 * chh + cti, C = 64 * h + 16 * ct + fr;
            f32x4 aw = {0.f, 0.f, 0.f, 0.f}, aa = {0.f, 0.f, 0.f, 0.f}, av = {0.f, 0.f, 0.f, 0.f};
#pragma unroll
            for (int ks = 0; ks < 2; ++ks) {
                aw = mfma16(*(const bf16x8*)(W2W + (size_t)C * 64 + 32 * ks + 8 * fq), *(const bf16x8*)(hrow + 32 * ks), aw);
                aa = mfma16(*(const bf16x8*)(W2A + (size_t)C * 64 + 32 * ks + 8 * fq), *(const bf16x8*)(hrow + 64 + 32 * ks), aa); }
            if (li) av = mfma16(*(const bf16x8*)(W2V + (size_t)C * 32 + 8 * fq), *(const bf16x8*)(hrow + 128), av);
            const int t = 16 * tt + fr, cc = 16 * ct + 4 * fq;
            *(LAS f32x4*)(lds + O_LW + (t * 64 + cc) * 4) = aw; *(LAS f32x4*)(lds + O_LA + (t * 64 + cc) * 4) = aa; *(LAS f32x4*)(lds + O_LV + (t * 64 + cc) * 4) = av; }
    }
    __syncthreads();
    if (stop == 1) return;
    {
        const int cc = lane, tq = wave, C = 64 * h + cc; const size_t pc = (size_t)li * D + C;
        const float w0 = p->in[I_W0][pc], a0 = p->in[I_A0][pc], kkc = p->in[I_KK][pc], kac = p->in[I_KA][pc], rkc = p->in[I_RKK][pc], v0 = li ? p->in[I_V0][C] : 0.f;
        float wlg[8], Lin[8], rr[8], k2[8], vv[8], aa[8], bb[8], rk8[8]; float run = 0.f;
        float r8[8], k8[8], v8[8], f8[8];
#pragma unroll
        for (int e = 0; e < 8; ++e) { const size_t gi = (size_t)(row0 + 8 * tq + e) * D + C; r8[e] = Rb[gi]; k8[e] = Kb[gi]; v8[e] = Vb[gi]; f8[e] = V0b[gi]; }
#pragma unroll
        for (int e = 0; e < 8; ++e) { const int t = 8 * tq + e;
            const float r = r8[e], k = k8[e]; float v = v8[e];
            const float lw = *(const LAS float*)(lds + O_LW + (t * 64 + cc) * 4), la = *(const LAS float*)(lds + O_LA + (t * 64 + cc) * 4), lv = *(const LAS float*)(lds + O_LV + (t * 64 + cc) * 4);
            const float z = -(w0 + lw); const float sp = fmaxf(z, 0.f) + __logf(1.0f + __expf(-fabsf(z))); const float wl = -__expf(-sp - 0.5f);
            const float asig = sigmoidf_(a0 + la);
            { const float vg = sigmoidf_(v0 + lv); const float vm = v + (f8[e] - v) * vg; v = li ? vm : v; }
            const float kkr = k * kkc; const float ss = wave_sum(kkr * kkr); const float kkn = kkr * frsq(fmaxf(ss, 1e-24f));
            const float kmod = k * (1.0f + (asig - 1.0f) * kac);
            rk8[e] = wave_sum(r * kmod * rkc);
            run += wl; wlg[e] = wl; Lin[e] = run; rr[e] = r; k2[e] = kmod; vv[e] = v; aa[e] = -kkn; bb[e] = kkn * asig; }
        if (li) {
#pragma unroll
            for (int e = 0; e < 8; ++e) Vb[(size_t)(row0 + 8 * tq + e) * D + C] = vv[e]; }
        if (cc == 0) {
#pragma unroll
            for (int e = 0; e < 8; ++e) ((float*)(ws + WS_RKS))[(size_t)(row0 + 8 * tq + e) * 16 + h] = rk8[e]; }
        *(LAS float*)(lds + O_CS + (tq * 64 + cc) * 4) = run;
        __syncthreads();
        float off = 0.f, tot = 0.f;
#pragma unroll
        for (int q = 0; q < 8; ++q) { const float x = *(const LAS float*)(lds + O_CS + (q * 64 + cc) * 4); tot += x; if (q < tq) off += x; }
        u32x4 wa, wv, wb, wk; unsigned pa[8], pv[8], pb[8], pk[8];
#pragma unroll
        for (int e = 0; e < 8; ++e) { const int t = 8 * tq + e; const float L = off + Lin[e], Lp = L - wlg[e];
            const float eL = __expf(L), eLp = __expf(Lp), enL = __expf(-L), eT = __expf(tot - L);
            const float at = aa[e] * eLp, bt = bb[e] * enL, kt = k2[e] * enL, rt = rr[e] * eL, bh = bb[e] * eT, kh = k2[e] * eT;
            *(LAS bf16_t*)(lds + O_AT + (t * SST + cc) * 2) = (bf16_t)f2bf(at); *(LAS bf16_t*)(lds + O_BT + (t * SST + cc) * 2) = (bf16_t)f2bf(bt);
            *(LAS bf16_t*)(lds + O_KT + (t * SST + cc) * 2) = (bf16_t)f2bf(kt); *(LAS bf16_t*)(lds + O_RT + (t * SST + cc) * 2) = (bf16_t)f2bf(rt);
            pa[e] = f2bf(at); pv[e] = f2bf(vv[e]); pb[e] = f2bf(bh); pk[e] = f2bf(kh); }
        wa = (u32x4){pa[0] | (pa[1] << 16), pa[2] | (pa[3] << 16), pa[4] | (pa[5] << 16), pa[6] | (pa[7] << 16)};
        wv = (u32x4){pv[0] | (pv[1] << 16), pv[2] | (pv[3] << 16), pv[4] | (pv[5] << 16), pv[6] | (pv[7] << 16)};
        wb = (u32x4){pb[0] | (pb[1] << 16), pb[2] | (pb[3] << 16), pb[4] | (pb[5] << 16), pb[6] | (pb[7] << 16)};
        wk = (u32x4){pk[0] | (pk[1] << 16), pk[2] | (pk[3] << 16), pk[4] | (pk[5] << 16), pk[6] | (pk[7] << 16)};
        *(LAS u32x4*)(lds + O_XT + (cc * SST + 8 * tq) * 2) = wa; *(LAS u32x4*)(lds + O_VT + (cc * SST + 8 * tq) * 2) = wv;
        *(LAS u32x4*)(lds + O_BH + (cc * SST + 8 * tq) * 2) = wb; *(LAS u32x4*)(lds + O_KH + (cc * SST + 8 * tq) * 2) = wk;
        if (tq == 0) *(LAS float*)(lds + O_WC + cc * 4) = __expf(tot);
    }
    __syncthreads();
    if (stop == 2) return;
    {
        const int mi = wave >> 1, ph = wave & 1; const int oY = (mi & 1) ? O_KT : O_BT, oX = (mi < 2) ? O_AT : O_RT; const bool strict = mi < 2;
        const int oO = mi == 0 ? O_AAB : (mi == 1 ? O_AAK : (mi == 2 ? O_ARB : O_ARK));
#pragma unroll
        for (int sti = 0; sti < 2; ++sti) { const int st = 2 * ph + sti;
#pragma unroll
            for (int tt = 0; tt < 4; ++tt) { f32x4 acc = {0.f, 0.f, 0.f, 0.f};
                if (st <= tt) {
#pragma unroll
                    for (int ks = 0; ks < 2; ++ks) acc = mfma16(ldsfrag(lds, oY, 16 * st + fr, 32 * ks + 8 * fq), ldsfrag(lds, oX, 16 * tt + fr, 32 * ks + 8 * fq), acc);
                    const int t = 16 * tt + fr;
#pragma unroll
                    for (int r = 0; r < 4; ++r) { const int s = 16 * st + 4 * fq + r; const bool keep = strict ? (s < t) : (s <= t); acc[r] = keep ? acc[r] : 0.f; } }
                if (st <= tt) lds_st4(lds, oO, 16 * tt + fr, 16 * st + 4 * fq, acc);
                else { u32x2 zz; int z0 = 0; asm volatile("" : "+v"(z0)); zz.x = (unsigned)z0; zz.y = (unsigned)z0; *(LAS u32x2*)(lds + oO + ((16 * tt + fr) * SST + 16 * st + 4 * fq) * 2) = zz; } } }
    }
    __syncthreads();
    if (stop == 3) return;
    {
        const int tt = wave & 3, ih = wave >> 2;
#pragma unroll
        for (int iti = 0; iti < 2; ++iti) { const int it = 2 * ih + iti; f32x4 acc = {0.f, 0.f, 0.f, 0.f};
#pragma unroll
            for (int ks = 0; ks < 2; ++ks) acc = mfma16(ldsfrag(lds, O_AAK, 16 * tt + fr, 32 * ks + 8 * fq), ldsfrag(lds, O_VT, 16 * it + fr, 32 * ks + 8 * fq), acc);
            lds_st4(lds, O_XT, 64 + 16 * it + fr, 16 * tt + 4 * fq, acc); }
        if (wave < 4 && lane < 16) { const int I = wave; float x[16];
#pragma unroll
            for (int t = 0; t < 16; ++t) { float s = (t == lane) ? 1.0f : 0.0f;
#pragma unroll
                for (int q = 0; q < t; ++q) s += bf2f(*(const LAS bf16_t*)(lds + O_AAB + ((16 * I + t) * SST + 16 * I + q) * 2)) * x[q];
                x[t] = s; *(LAS bf16_t*)(lds + O_TD + ((I * 16 + t) * 16 + lane) * 2) = (bf16_t)f2bf(s); } }
    }
    __syncthreads();
    if (stop == 5) return;
    {
        const int colb = 16 * wave; const bf16x8 zero8 = {0, 0, 0, 0, 0, 0, 0, 0};
#pragma unroll
        for (int I = 0; I < 4; ++I) {
            f32x4 acc = lds_ld4(lds, O_XT, colb + fr, 16 * I + 4 * fq);
#pragma unroll
            for (int ks = 0; ks < 2; ++ks) if (32 * ks < 16 * I) { const bool ok = (32 * ks + 8 * fq) < 16 * I;
                const bf16x8 a = ok ? ldsfrag(lds, O_AAB, 16 * I + fr, 32 * ks + 8 * fq) : zero8, bq = ok ? ldsfrag(lds, O_XT, colb + fr, 32 * ks + 8 * fq) : zero8;
                acc = mfma16(a, bq, acc); }
            { u32x2 w; w.x = pk2(acc[0], acc[1]); w.y = pk2(acc[2], acc[3]); *(LAS u32x2*)(lds + O_SCR + wave * 512 + (fr * 16 + 4 * fq) * 2) = w; }
            LDS_WAIT();
            const bf16x8 ta = fq < 2 ? *(const LAS bf16x8*)(lds + O_TD + ((I * 16 + fr) * 16 + 8 * fq) * 2) : zero8;
            const bf16x8 tb = fq < 2 ? *(const LAS bf16x8*)(lds + O_SCR + wave * 512 + (fr * 16 + 8 * fq) * 2) : zero8;
            const f32x4 res = mfma16(ta, tb, (f32x4){0.f, 0.f, 0.f, 0.f});
            lds_st4(lds, O_XT, colb + fr, 16 * I + 4 * fq, res);
            LDS_WAIT();
        }
    }
    __syncthreads();
    if (stop == 6) return;
    constexpr int S_RP = 0, S_MH = MAT, S_ML = 2 * MAT, S_YL = 3 * MAT, YLS = 68, S_NN = S_YL + 64 * YLS * 4;
    static_assert(S_NN + 64 * YLS * 4 <= O_XT, "staging must stay below the next unit's step-1 area");
    {
        const int tb = wave & 3, hb = wave >> 2;
        u32x2 rp[2], mh[2], ml[2]; f32x4 yl[2], nv[2];
#pragma unroll
        for (int qi = 0; qi < 2; ++qi) { const int rt = 2 * hb + qi;
            { f32x4 acc = lds_ld4(lds, O_RT, 16 * tb + fr, 16 * rt + 4 * fq);
#pragma unroll
              for (int ks = 0; ks < 2; ++ks) acc = mfma16(ldsfrag(lds, O_XT, 16 * rt + fr, 32 * ks + 8 * fq), ldsfrag(lds, O_ARB, 16 * tb + fr, 32 * ks + 8 * fq), acc);
              rp[qi].x = pk2(acc[0], acc[1]); rp[qi].y = pk2(acc[2], acc[3]); }
            { f32x4 acc = {0.f, 0.f, 0.f, 0.f};
#pragma unroll
              for (int ks = 0; ks < 2; ++ks) { acc = mfma16(ldsfrag(lds, O_XT, 64 + 16 * rt + fr, 32 * ks + 8 * fq), ldsfrag(lds, O_ARB, 16 * tb + fr, 32 * ks + 8 * fq), acc);
                  acc = mfma16(ldsfrag(lds, O_VT, 16 * rt + fr, 32 * ks + 8 * fq), ldsfrag(lds, O_ARK, 16 * tb + fr, 32 * ks + 8 * fq), acc); }
              yl[qi] = acc; }
            { f32x4 acc = {0.f, 0.f, 0.f, 0.f};
#pragma unroll
              for (int ks = 0; ks < 2; ++ks) acc = mfma16(ldsfrag(lds, O_XT, 16 * rt + fr, 32 * ks + 8 * fq), ldsfrag(lds, O_BH, 16 * tb + fr, 32 * ks + 8 * fq), acc);
              const int j = 16 * tb + fr; const float wc = *(const LAS float*)(lds + O_WC + j * 4);
#pragma unroll
              for (int r = 0; r < 4; ++r) if (16 * rt + 4 * fq + r == j) acc[r] += wc;
              unsigned hh[4], ll[4];
#pragma unroll
              for (int r = 0; r < 4; ++r) { hh[r] = f2bf(acc[r]); ll[r] = f2bf(acc[r] - __builtin_bit_cast(float, hh[r] << 16)); }
              mh[qi] = (u32x2){hh[0] | (hh[1] << 16), hh[2] | (hh[3] << 16)}; ml[qi] = (u32x2){ll[0] | (ll[1] << 16), ll[2] | (ll[3] << 16)}; }
            { f32x4 acc = {0.f, 0.f, 0.f, 0.f};
#pragma unroll
              for (int ks = 0; ks < 2; ++ks) { acc = mfma16(ldsfrag(lds, O_BH, 16 * rt + fr, 32 * ks + 8 * fq), ldsfrag(lds, O_XT, 64 + 16 * tb + fr, 32 * ks + 8 * fq), acc);
                  acc = mfma16(ldsfrag(lds, O_KH, 16 * rt + fr, 32 * ks + 8 * fq), ldsfrag(lds, O_VT, 16 * tb + fr, 32 * ks + 8 * fq), acc); }
              nv[qi] = acc; }
        }
        __syncthreads();
#pragma unroll
        for (int qi = 0; qi < 2; ++qi) { const int rt = 2 * hb + qi, row = 16 * tb + fr, col = 16 * rt + 4 * fq;
            *(LAS u32x2*)(lds + S_RP + (row * SST + col) * 2) = rp[qi]; *(LAS u32x2*)(lds + S_MH + (row * SST + col) * 2) = mh[qi]; *(LAS u32x2*)(lds + S_ML + (row * SST + col) * 2) = ml[qi];
            *(LAS f32x4*)(lds + S_YL + (row * YLS + col) * 4) = yl[qi]; *(LAS f32x4*)(lds + S_NN + (row * YLS + col) * 4) = nv[qi]; }
        __syncthreads();
        unsigned char* gRP = ws + WS_RP + (size_t)u * 8192; unsigned char* gYL = ws + WS_YL + (size_t)u * 16384;
        unsigned char* gMH = ws + WS_MT + (size_t)u * 8192; unsigned char* gML = gMH + (size_t)NUNIT_A * 8192; unsigned char* gNN = ws + WS_NN + (size_t)u * 16384;
        const int tid = 64 * wave + lane;
        { const int row = tid >> 3, ch = tid & 7, lo = (row * SST) * 2 + ch * 16;
          *(u32x4*)(gRP + tid * 16) = *(const LAS u32x4*)(lds + S_RP + lo); *(u32x4*)(gMH + tid * 16) = *(const LAS u32x4*)(lds + S_MH + lo); *(u32x4*)(gML + tid * 16) = *(const LAS u32x4*)(lds + S_ML + lo); }
#pragma unroll
        for (int k = 0; k < 2; ++k) { const int cidx = tid + 512 * k, row = cidx >> 4, c4 = cidx & 15, lo = (row * YLS) * 4 + c4 * 16;
            *(u32x4*)(gYL + cidx * 16) = *(const LAS u32x4*)(lds + S_YL + lo); *(u32x4*)(gNN + cidx * 16) = *(const LAS u32x4*)(lds + S_NN + lo); }
    }
}

__device__ __forceinline__ void scan_sample_item(KP p, const Ctx& c, int li, int item) {
    unsigned char* ws = p->ws; const int lane = c.lane, b = item >> 4, h = item & 15, C = 64 * h + lane; const size_t pc = (size_t)li * D + C;
    LAS float* sc = (LAS float*)(c.lds + c.wave * 16384);
    const float* Rb = (const float*)(ws + WS_RK_R); const float* Kb = (const float*)(ws + WS_RK_K);
    float* Vb = (float*)(ws + (li ? WS_V1 : WS_V0)); const float* V0b = (const float*)(ws + WS_V0);
    const bf16_t* HID = (const bf16_t*)(ws + WS_HID) + (size_t)(MP + 4 * b) * LHID;
    for (int e = lane; e < 4 * LHID; e += 64) sc[e] = bf2f(HID[e]);
    LDS_WAIT();
    float lw[4] = {0.f, 0.f, 0.f, 0.f}, la[4] = {0.f, 0.f, 0.f, 0.f}, lv[4] = {0.f, 0.f, 0.f, 0.f}, lg[4] = {0.f, 0.f, 0.f, 0.f};
    {
        const bf16_t* W2W = (const bf16_t*)(ws + WS_W2W) + ((size_t)li * 1024 + C) * 64; const bf16_t* W2A = (const bf16_t*)(ws + WS_W2A) + ((size_t)li * 1024 + C) * 64;
        const bf16_t* W2V = (const bf16_t*)(ws + WS_W2V) + (size_t)C * 32; const bf16_t* W2G = (const bf16_t*)(ws + WS_W2G) + ((size_t)li * 1024 + C) * 128;
#define LORA2_BLK(WP, QB, HOFF, ACC) { const u32x4 w8 = *(const u32x4*)((WP) + 8 * (QB)); \
            const float wf0 = bflo(w8.x), wf1 = bfhi(w8.x), wf2 = bflo(w8.y), wf3 = bfhi(w8.y), wf4 = bflo(w8.z), wf5 = bfhi(w8.z), wf6 = bflo(w8.w), wf7 = bfhi(w8.w); \
            _Pragma("unroll") for (int t = 0; t < 4; ++t) { const f32x4 h0 = *(const LAS f32x4*)(sc + t * LHID + (HOFF) + 8 * (QB)), h1 = *(const LAS f32x4*)(sc + t * LHID + (HOFF) + 8 * (QB) + 4); \
                ACC[t] += (h0[0] * wf0 + h0[1] * wf1) + (h0[2] * wf2 + h0[3] * wf3) + (h1[0] * wf4 + h1[1] * wf5) + (h1[2] * wf6 + h1[3] * wf7); } \
            asm volatile("" : "+v"(ACC[0]), "+v"(ACC[1]), "+v"(ACC[2]), "+v"(ACC[3]) :: "memory"); }
#pragma unroll
        for (int qb = 0; qb < 8; ++qb) { LORA2_BLK(W2W, qb, 0, lw) LORA2_BLK(W2A, qb, 64, la) }
        if (li) {
#pragma unroll
            for (int qb = 0; qb < 4; ++qb) LORA2_BLK(W2V, qb, 128, lv) }
#pragma unroll
        for (int qb = 0; qb < 16; ++qb) LORA2_BLK(W2G, qb, 160, lg)
#undef LORA2_BLK
    }
    const float w0 = p->in[I_W0][pc], a0 = p->in[I_A0][pc], kkc = p->in[I_KK][pc], kac = p->in[I_KA][pc], rkc = p->in[I_RKK][pc], v0 = li ? p->in[I_V0][C] : 0.f;
    const float lnw = p->in[I_LNW][pc], lnb = p->in[I_LNB][pc];
    float S[64];
    { const f32x4* sp = (const f32x4*)(p->in[I_SWKV] + (((size_t)li * SB + b) * H + h) * 4096 + lane * 64);
#pragma unroll
      for (int q = 0; q < 16; ++q) { const f32x4 x = sp[q]; S[4 * q] = x[0]; S[4 * q + 1] = x[1]; S[4 * q + 2] = x[2]; S[4 * q + 3] = x[3]; } }
    LAS float* bc = sc + 1280;
    bf16_t* YG = (bf16_t*)(ws + WS_YG);
#pragma unroll
    for (int t = 0; t < 4; ++t) { const size_t gi = (size_t)(MP + 4 * b + t) * D + C;
        const float r = Rb[gi], k = Kb[gi]; float v = Vb[gi];
        const float z = -(w0 + lw[t]); const float sp = fmaxf(z, 0.f) + __logf(1.0f + __expf(-fabsf(z))); const float wdec = __expf(-__expf(-sp - 0.5f));
        const float asig = sigmoidf_(a0 + la[t]);
        if (li) { const float vg = sigmoidf_(v0 + lv[t]); const float vf = V0b[gi]; v = v + (vf - v) * vg; }
        const float kkr = k * kkc; const float ss = wave_sum(kkr * kkr); const float kkn = kkr * frsq(fmaxf(ss, 1e-24f));
        const float kmod = k * (1.0f + (asig - 1.0f) * kac);
        const float rks = wave_sum(r * kmod * rkc);
        LDS_WAIT();
        bc[lane] = wdec; bc[64 + lane] = -kkn; bc[128 + lane] = kkn * asig; bc[192 + lane] = kmod; bc[256 + lane] = r;
        LDS_WAIT();
        float sa = 0.f;
#pragma unroll
        for (int q = 0; q < 16; ++q) { const f32x4 av = *(const LAS f32x4*)(bc + 64 + 4 * q); sa += S[4 * q] * av[0] + S[4 * q + 1] * av[1] + S[4 * q + 2] * av[2] + S[4 * q + 3] * av[3]; }
        float y = 0.f;
#pragma unroll
        for (int q = 0; q < 16; ++q) { const f32x4 wv = *(const LAS f32x4*)(bc + 4 * q), bv = *(const LAS f32x4*)(bc + 128 + 4 * q), kv = *(const LAS f32x4*)(bc + 192 + 4 * q), rv = *(const LAS f32x4*)(bc + 256 + 4 * q);
#pragma unroll
            for (int e = 0; e < 4; ++e) { const float s = S[4 * q + e] * wv[e] + sa * bv[e] + v * kv[e]; S[4 * q + e] = s; y += s * rv[e]; } }
        const float mean = wave_sum(y) * (1.0f / 64.0f); const float dy = y - mean; const float var = wave_sum(dy * dy) * (1.0f / 64.0f);
        const float yn = dy * (frsq(var + GN_EPS)) * lnw + lnb;
        YG[gi] = (bf16_t)f2bf((yn + rks * v) * lg[t]);
    }
    { f32x4* so = (f32x4*)(p->out + O_WKVS + (((size_t)li * SB + b) * H + h) * 4096 + lane * 64);
#pragma unroll
      for (int q = 0; q < 16; ++q) so[q] = (f32x4){S[4 * q], S[4 * q + 1], S[4 * q + 2], S[4 * q + 3]}; }
    LDS_WAIT();
}

__device__ __forceinline__ void phase_scanA(KP p, const Ctx& c, int li) {
    const int stop = p->pad;
    if (stop != 9) for (int u = blockIdx.x; u < NUNIT_A; u += gridDim.x) scanA_unit(p, c, li, u);
    __syncthreads();
    if (stop == 0 || stop == 9) for (int it = c.gw; it < SB * H; it += c.ngw) scan_sample_item(p, c, li, it);
}

__device__ __forceinline__ void hilo(const f32x4 x0, const f32x4 x1, bf16x8& hi, bf16x8& lo) {
    unsigned h[8], l[8];
#pragma unroll
    for (int e = 0; e < 8; ++e) { const float x = e < 4 ? x0[e] : x1[e - 4]; h[e] = f2bf(x); l[e] = f2bf(x - __builtin_bit_cast(float, h[e] << 16)); }
    u32x4 hv = {h[0] | (h[1] << 16), h[2] | (h[3] << 16), h[4] | (h[5] << 16), h[6] | (h[7] << 16)}, lv = {l[0] | (l[1] << 16), l[2] | (l[3] << 16), l[4] | (l[5] << 16), l[6] | (l[7] << 16)};
    hi = __builtin_bit_cast(bf16x8, hv); lo = __builtin_bit_cast(bf16x8, lv);
}
constexpr int SB_SLOT = 20480, SB_RING0 = 8192, SB_DEPTH = 6;
static_assert(SB_RING0 + SB_DEPTH * SB_SLOT <= RING_BYTES, "chain ring");
__device__ __forceinline__ void phase_scanB(KP p, const Ctx& c, int li) {
    unsigned char* ws = p->ws; LAS unsigned char* lds = c.lds; const int lane = c.lane, fr = lane & 15, fq = lane >> 4, wave = c.wave;
    volatile LAS int* FL = (volatile LAS int*)(lds + RING_BYTES);
    if (c.tid < 4) FL[c.tid] = 0;
    __syncthreads();
    const int ncb = (int)gridDim.x < 128 ? (int)gridDim.x : 128;
    if (wave >= 4 || (int)blockIdx.x >= ncb) {
        const int gwf = (int)blockIdx.x < ncb ? (int)blockIdx.x * 4 + (wave - 4) : ncb * 4 + ((int)blockIdx.x - ncb) * 8 + wave, ngwf = ncb * 4 + ((int)gridDim.x - ncb) * 8;
        phase_fill(p, c, li, gwf, ngwf); return; }
    if (wave != 0) {
        const int j = wave - 1; int prevG = -1, kc = 0;
        for (int ch = blockIdx.x; ch < 128; ch += gridDim.x, ++kc) { const int b = ch >> 6, h = (ch >> 2) & 15, iq = ch & 3;
            for (int n = j; n < NCH; n += 3) { const int G = kc * NCH + n;
                if (G >= SB_DEPTH) { unsigned sp = 0; while (FL[0] < G - (SB_DEPTH - 1)) { __builtin_amdgcn_s_sleep(1); if (++sp > (1u << 22)) break; } }
                LAS unsigned char* slot = lds + SB_RING0 + (G % SB_DEPTH) * SB_SLOT;
                const size_t u = (size_t)(b * NCH + n) * H + h; const bf16_t* MTH = (const bf16_t*)(ws + WS_MT) + u * 4096; const bf16_t* MTL = MTH + (size_t)NUNIT_A * 4096; const float* NN = (const float*)(ws + WS_NN) + u * 4096;
#pragma unroll
                for (int jt = 0; jt < 4; ++jt)
#pragma unroll
                    for (int ks = 0; ks < 2; ++ks) {
                        __builtin_amdgcn_global_load_lds((const unsigned*)(MTH + (size_t)(16 * jt + fr) * 64 + 32 * ks + 8 * fq), (LAS unsigned*)(slot + ((jt * 2 + ks) * 2 + 0) * 1024), 16, 0, 0);
                        __builtin_amdgcn_global_load_lds((const unsigned*)(MTL + (size_t)(16 * jt + fr) * 64 + 32 * ks + 8 * fq), (LAS unsigned*)(slot + ((jt * 2 + ks) * 2 + 1) * 1024), 16, 0, 0); }
#pragma unroll
                for (int jt = 0; jt < 4; ++jt)
                    __builtin_amdgcn_global_load_lds((const unsigned*)(NN + (size_t)(16 * iq + fr) * 64 + 16 * jt + 4 * fq), (LAS unsigned*)(slot + (16 + jt) * 1024), 16, 0, 0);
                asm volatile("s_waitcnt vmcnt(20)" ::: "memory");
                if (prevG >= 0) FL[1 + j] = prevG + 1;
                prevG = G; } }
        asm volatile("s_waitcnt vmcnt(0)" ::: "memory");
        if (prevG >= 0) FL[1 + j] = prevG + 1;
        return; }
    int kc = 0;
    for (int ch = blockIdx.x; ch < 128; ch += gridDim.x, ++kc) {
        const int b = ch >> 6, h = (ch >> 2) & 15, iq = ch & 3;
        f32x4 S[4];
#pragma unroll
        for (int jt = 0; jt < 4; ++jt) S[jt] = (f32x4){0.f, 0.f, 0.f, 0.f};
        int j3 = 0;
        for (int n = 0; n < NCH; ++n) { const int G = kc * NCH + n;
            const size_t u = (size_t)(b * NCH + n) * H + h; bf16_t* S0 = (bf16_t*)(ws + WS_S0) + u * 4096;
            { unsigned sp = 0; while (FL[1 + j3] < G + 1) { __builtin_amdgcn_s_sleep(1); if (++sp > (1u << 22)) break; } }
            const LAS unsigned char* slot = lds + SB_RING0 + (G % SB_DEPTH) * SB_SLOT + lane * 16;
            bf16x8 ah[4][2], al[4][2]; f32x4 nn[4];
#pragma unroll
            for (int jt = 0; jt < 4; ++jt) { nn[jt] = *(const LAS f32x4*)(slot + (16 + jt) * 1024);
#pragma unroll
                for (int ks = 0; ks < 2; ++ks) { ah[jt][ks] = *(const LAS bf16x8*)(slot + ((jt * 2 + ks) * 2 + 0) * 1024); al[jt][ks] = *(const LAS bf16x8*)(slot + ((jt * 2 + ks) * 2 + 1) * 1024); } }
#pragma unroll
            for (int jt = 0; jt < 4; ++jt) { unsigned hh[4], ll[4];
#pragma unroll
                for (int r = 0; r < 4; ++r) { hh[r] = f2bf(S[jt][r]); ll[r] = f2bf(S[jt][r] - __builtin_bit_cast(float, hh[r] << 16)); }
                u32x2 wh = {hh[0] | (hh[1] << 16), hh[2] | (hh[3] << 16)}, wl = {ll[0] | (ll[1] << 16), ll[2] | (ll[3] << 16)};
                *(u32x2*)(S0 + (size_t)(16 * iq + fr) * 64 + 16 * jt + 4 * fq) = wh;
                *(LAS u32x2*)(lds + (fr * SST + 16 * jt + 4 * fq) * 2) = wh; *(LAS u32x2*)(lds + 4096 + (fr * SST + 16 * jt + 4 * fq) * 2) = wl; }
            LDS_WAIT();
            bf16x8 bh[2], bl[2];
#pragma unroll
            for (int ks = 0; ks < 2; ++ks) { bh[ks] = *(const LAS bf16x8*)(lds + (fr * SST + 32 * ks + 8 * fq) * 2); bl[ks] = *(const LAS bf16x8*)(lds + 4096 + (fr * SST + 32 * ks + 8 * fq) * 2); }
#pragma unroll
            for (int jt = 0; jt < 4; ++jt) { f32x4 acc = nn[jt];
#pragma unroll
                for (int ks = 0; ks < 2; ++ks) { acc = mfma16(ah[jt][ks], bh[ks], acc); acc = mfma16(ah[jt][ks], bl[ks], acc); acc = mfma16(al[jt][ks], bh[ks], acc); }
                S[jt] = acc; }
            LDS_WAIT();
            FL[0] = G + 1;
            j3 = j3 == 2 ? 0 : j3 + 1;
        }
        float* so = p->out + O_WKVP + (((size_t)li * NB + b) * H + h) * 4096;
#pragma unroll
        for (int jt = 0; jt < 4; ++jt) *(f32x4*)(so + (size_t)(16 * iq + fr) * 64 + 16 * jt + 4 * fq) = S[jt];
    }
}

__device__ __forceinline__ void phase_scanC(KP p, const Ctx& c, int li) {
    unsigned char* ws = p->ws; const int lane = c.lane, fr = lane & 15, fq = lane >> 4, hb = c.wave >> 2, tt = c.wave & 3;
    const float* Vb = (const float*)(ws + (li ? WS_V1 : WS_V0)); const bf16_t* HID = (const bf16_t*)(ws + WS_HID); const bf16_t* W2G = (const bf16_t*)(ws + WS_W2G) + (size_t)li * 1024 * 128;
    bf16_t* YG = (bf16_t*)(ws + WS_YG);
    for (int up = blockIdx.x; up < NUNIT_A / 2; up += gridDim.x) {
        const int u = 2 * up + hb; const int b = u / (NCH * H), n = (u / H) % NCH, h = u % H; const int row = b * TP + 64 * n + 16 * tt + fr;
        const bf16_t* RP = (const bf16_t*)(ws + WS_RP) + (size_t)u * 4096; const float* YL = (const float*)(ws + WS_YL) + (size_t)u * 4096; const bf16_t* S0 = (const bf16_t*)(ws + WS_S0) + (size_t)u * 4096;
        f32x4 acc[4], ag[4];
#pragma unroll
        for (int it = 0; it < 4; ++it) { acc[it] = *(const f32x4*)(YL + (size_t)(16 * tt + fr) * 64 + 16 * it + 4 * fq); ag[it] = (f32x4){0.f, 0.f, 0.f, 0.f}; }
#pragma unroll
        for (int ks = 0; ks < 2; ++ks) { const bf16x8 bq = *(const bf16x8*)(RP + (size_t)(16 * tt + fr) * 64 + 32 * ks + 8 * fq);
#pragma unroll
            for (int it = 0; it < 4; ++it) acc[it] = mfma16(*(const bf16x8*)(S0 + (size_t)(16 * it + fr) * 64 + 32 * ks + 8 * fq), bq, acc[it]); }
        const bf16_t* hgp = launder_p(HID + (size_t)row * LHID + 160 + 8 * fq); const bf16_t* wgp = launder_p(W2G + (size_t)(64 * h + fr) * 128 + 8 * fq);
#pragma unroll
        for (int ks = 0; ks < 4; ++ks) { const bf16x8 bq = *(const bf16x8*)(hgp + 32 * ks);
#pragma unroll
            for (int it = 0; it < 4; ++it) ag[it] = mfma16(*(const bf16x8*)(wgp + it * 16 * 128 + 32 * ks), bq, ag[it]); }
        float s = 0.f;
#pragma unroll
        for (int it = 0; it < 4; ++it) s += (acc[it][0] + acc[it][1]) + (acc[it][2] + acc[it][3]);
        s = sum_rows4(s); const float mean = s * (1.0f / 64.0f);
        float q = 0.f;
#pragma unroll
        for (int it = 0; it < 4; ++it) { const f32x4 d = acc[it] - mean; q += (d[0] * d[0] + d[1] * d[1]) + (d[2] * d[2] + d[3] * d[3]); }
        q = sum_rows4(q); const float rstd = frsq(q * (1.0f / 64.0f) + GN_EPS);
        const float rks = ((const float*)(ws + WS_RKS))[(size_t)row * 16 + h];
#pragma unroll
        for (int it = 0; it < 4; ++it) { const int C = 64 * h + 16 * it + 4 * fq; const size_t pc = (size_t)li * D + C;
            const f32x4 lw = *(const f32x4*)(p->in[I_LNW] + pc), lb = *(const f32x4*)(p->in[I_LNB] + pc), v = *(const f32x4*)(Vb + (size_t)row * D + C);
            const f32x4 o = ((acc[it] - mean) * rstd * lw + lb + v * rks) * ag[it];
            u32x2 w; w.x = pk2(o[0], o[1]); w.y = pk2(o[2], o[3]); *(u32x2*)(YG + (size_t)row * D + C) = w; }
    }
}
__device__ __forceinline__ void ld8bf(const bf16_t* p, float (&o)[8]) { const u32x4 w = *(const u32x4*)p; o[0] = bflo(w.x); o[1] = bfhi(w.x); o[2] = bflo(w.y); o[3] = bfhi(w.y); o[4] = bflo(w.z); o[5] = bfhi(w.z); o[6] = bflo(w.w); o[7] = bfhi(w.w); }
__device__ __forceinline__ void ld8f(const float* p, float (&o)[8]) { const f32x4 a = *(const f32x4*)p, b = *(const f32x4*)(p + 4); o[0] = a[0]; o[1] = a[1]; o[2] = a[2]; o[3] = a[3]; o[4] = b[0]; o[5] = b[1]; o[6] = b[2]; o[7] = b[3]; }
__device__ __forceinline__ void phase_conv(KP p, const Ctx& c, int layer) {
    const bf16_t* U = (const bf16_t*)(p->ws + WS_U); const bf16_t* GT = (const bf16_t*)(p->ws + WS_GT); bf16_t* HH = (bf16_t*)(p->ws + WS_HH);
    const float* cw = p->in[I_CONVW] + (size_t)layer * 3 * DFF; const float* cb = p->in[I_CONVB] + (size_t)layer * DFF; const float* st = p->in[I_SCONV] + (size_t)layer * SB * 2 * DFF;
    constexpr int NF8 = DFF / 8, NPS = MP / 64, NITEM = (NPS + SB) * NF8;
    for (int e = c.gtid; e < NITEM; e += c.gsz) { const int sidx = e / NF8, f = 8 * (e % NF8);
        int row0, nrow; float u0[8], u1[8];
        if (sidx < NPS) { row0 = 64 * sidx; nrow = 64;
            if ((row0 & (TP - 1)) == 0) {
#pragma unroll
                for (int i = 0; i < 8; ++i) { u0[i] = 0.f; u1[i] = 0.f; } }
            else { ld8bf(U + (size_t)(row0 - 1) * DFF + f, u1); ld8bf(U + (size_t)(row0 - 2) * DFF + f, u0); } }
        else { const int b = sidx - NPS; row0 = MP + 4 * b; nrow = 4; ld8f(st + ((size_t)b * 2 + 1) * DFF + f, u1); ld8f(st + ((size_t)b * 2) * DFF + f, u0); }
        float w0[8], w1[8], w2[8], bb[8];
        ld8f(cw + f, w0); ld8f(cw + DFF + f, w1); ld8f(cw + 2 * DFF + f, w2); ld8f(cb + f, bb);
        for (int r = 0; r < nrow; r += 4) {
            u32x4 ur[4], gr[4];
#pragma unroll
            for (int q = 0; q < 4; ++q) { ur[q] = *(const u32x4*)(U + (size_t)(row0 + r + q) * DFF + f); gr[q] = *(const u32x4*)(GT + (size_t)(row0 + r + q) * DFF + f); }
#pragma unroll
            for (int q = 0; q < 4; ++q) { float u2[8], g[8];
                u2[0] = bflo(ur[q].x); u2[1] = bfhi(ur[q].x); u2[2] = bflo(ur[q].y); u2[3] = bfhi(ur[q].y); u2[4] = bflo(ur[q].z); u2[5] = bfhi(ur[q].z); u2[6] = bflo(ur[q].w); u2[7] = bfhi(ur[q].w);
                g[0] = bflo(gr[q].x); g[1] = bfhi(gr[q].x); g[2] = bflo(gr[q].y); g[3] = bfhi(gr[q].y); g[4] = bflo(gr[q].z); g[5] = bfhi(gr[q].z); g[6] = bflo(gr[q].w); g[7] = bfhi(gr[q].w);
                float o[8];
#pragma unroll
                for (int i = 0; i < 8; ++i) { o[i] = gelu_tanh(bb[i] + w0[i] * u0[i] + w1[i] * u1[i] + w2[i] * u2[i]) * g[i]; u0[i] = u1[i]; u1[i] = u2[i]; }
                u32x4 w; w.x = pk2(o[0], o[1]); w.y = pk2(o[2], o[3]); w.z = pk2(o[4], o[5]); w.w = pk2(o[6], o[7]);
                *(u32x4*)(HH + (size_t)(row0 + r + q) * DFF + f) = w; }
        }
    }
}

__device__ __forceinline__ void phase_kvpost(KP p, const Ctx& c) {
    const float* KVF = (const float*)(p->ws + WS_KVF); unsigned char* ws = p->ws; const int lane = c.lane, g = lane >> 4, d0 = 4 * (lane & 15);
    const f32x4 gs = *(const f32x4*)(p->in[I_KNG] + 64 + d0), gw = *(const f32x4*)(p->in[I_KNG] + 128 + d0);
    bf16_t* CA = (bf16_t*)(ws + WS_CMPA); bf16_t* KS = (bf16_t*)(ws + WS_KS); bf16_t* VS = (bf16_t*)(ws + WS_VS); bf16_t* KW = (bf16_t*)(ws + WS_KW); bf16_t* VW = (bf16_t*)(ws + WS_VW);
    for (int chunk = c.gw; chunk < R / 8; chunk += c.ngw) {
        unsigned vs_[4][4], vw_[4][4];
#pragma unroll
        for (int e = 0; e < 8; ++e) { const int row = chunk * 8 + e; const float* src = KVF + (size_t)row * NKV + 4 * lane;
            f32x4 v[6];
#pragma unroll
            for (int pt = 0; pt < 6; ++pt) v[pt] = *(const f32x4*)(src + pt * 256);
            { float s = (v[2][0] * v[2][0] + v[2][1] * v[2][1]) + (v[2][2] * v[2][2] + v[2][3] * v[2][3]);
              s = row16_sum(s); const float rs = frsq(s * (1.0f / 64.0f) + NORM_EPS); v[2] = v[2] * rs * gs; }
            { float s = (v[4][0] * v[4][0] + v[4][1] * v[4][1]) + (v[4][2] * v[4][2] + v[4][3] * v[4][3]);
              s = row16_sum(s); const float rs = frsq(s * (1.0f / 64.0f) + NORM_EPS); v[4] = v[4] * rs * gw; }
            float* okv = p->out + O_KV + (size_t)row * D + 4 * lane;
#pragma unroll
            for (int pt = 0; pt < 4; ++pt) *(f32x4*)(okv + pt * 256) = v[pt];
            if (row < MP) { const int b = row >> 13, t = row & (TP - 1);
                if (t >= TP - WIN) { float* ow = p->out + O_WINP + ((size_t)(b * WIN + (t - (TP - WIN))) * 2) * 256 + 4 * lane; *(f32x4*)ow = v[4]; *(f32x4*)(ow + 256) = v[5]; }
                const size_t hb = (size_t)(b * G + g);
                { u32x2 w; w.x = pk2(v[0][0], v[0][1]); w.y = pk2(v[0][2], v[0][3]); *(u32x2*)(CA + (hb * 512 + (t >> 4)) * 1024 + (t & 15) * 64 + d0) = w; }
                { u32x2 w; w.x = pk2(v[1][0], v[1][1]); w.y = pk2(v[1][2], v[1][3]); *(u32x2*)(CA + ((size_t)4096 + hb * 512 + (t >> 4)) * 1024 + (t & 15) * 64 + d0) = w; }
                { u32x2 w; w.x = pk2(v[2][0], v[2][1]); w.y = pk2(v[2][2], v[2][3]); *(u32x2*)(KS + (hb * TP + t) * 64 + d0) = w; }
                { u32x2 w; w.x = pk2(v[4][0], v[4][1]); w.y = pk2(v[4][2], v[4][3]); *(u32x2*)(KW + (hb * TP + t) * 64 + d0) = w; }
#pragma unroll
                for (int d = 0; d < 4; ++d) { const unsigned a = f2bf(v[3][d]), bq = f2bf(v[5][d]);
                    if (e & 1) { vs_[d][e >> 1] |= a << 16; vw_[d][e >> 1] |= bq << 16; } else { vs_[d][e >> 1] = a; vw_[d][e >> 1] = bq; } }
            } else { const int b = (row - MP) >> 2, t = (row - MP) & 3;
                float* ow = p->out + O_WINS + ((size_t)(b * WIN + 508 + t) * 2) * 256 + 4 * lane; *(f32x4*)ow = v[4]; *(f32x4*)(ow + 256) = v[5]; }
        }
        if (chunk * 8 < MP) { const int row = chunk * 8, b = row >> 13, t = row & (TP - 1); const size_t hb = (size_t)(b * G + g);
#pragma unroll
            for (int d = 0; d < 4; ++d) { *(u32x4*)(VS + (hb * 64 + d0 + d) * TP + t) = (u32x4){vs_[d][0], vs_[d][1], vs_[d][2], vs_[d][3]};
                *(u32x4*)(VW + (hb * 64 + d0 + d) * TP + t) = (u32x4){vw_[d][0], vw_[d][1], vw_[d][2], vw_[d][3]}; } }
    }
}

__device__ __forceinline__ void phase_cmp2(KP p, const Ctx& c) {
    unsigned char* ws = p->ws; const float* PC = (const float*)(ws + WS_PCMP); const int lane = c.lane, fr = lane & 15, fq = lane >> 4;
    const bf16_t* W2H = (const bf16_t*)(ws + WS_CW2T); const bf16_t* W2L = W2H + 2 * 64 * 128;
    constexpr int NPI = NB * G * 32, NSI = SB * G * 8, TOT = 2 * (NPI + NSI);
    for (int it = c.gw; it < TOT; it += c.ngw) {
        const bool samp = it >= 2 * NPI; const int r = samp ? it - 2 * NPI : it; const int kv = samp ? r / NSI : r / NPI; const int idx = samp ? r % NSI : r % NPI;
        const int hb = samp ? (idx >> 3) : (idx >> 5), n0 = 16 * (samp ? (idx & 7) : (idx & 31)), ncmp = samp ? NCMP_S : NCMP_P, nper = samp ? 128 : 512;
        const int n = n0 + fr; const bool live = n < ncmp;
        const size_t prow = (samp ? (size_t)8192 + (size_t)kv * 65536 : (size_t)kv * 4096) + (size_t)hb * nper + (live ? n : ncmp - 1);
        const float* cb = (const float*)(ws + WS_CBIAS) + kv * 128;
        bf16x8 hh[4], hl[4];
#pragma unroll
        for (int ks = 0; ks < 4; ++ks) { const int k0 = 32 * ks + 8 * fq; unsigned uh[8], ul[8];
            const f32x4 a0 = *(const f32x4*)(PC + prow * 256 + k0), a1 = *(const f32x4*)(PC + prow * 256 + k0 + 4);
            const f32x4 b0 = *(const f32x4*)(PC + (prow + 1) * 256 + 128 + k0), b1 = *(const f32x4*)(PC + (prow + 1) * 256 + 128 + k0 + 4);
            const f32x4 c0 = *(const f32x4*)(cb + k0), c1 = *(const f32x4*)(cb + k0 + 4);
#pragma unroll
            for (int e = 0; e < 8; ++e) { const float x = e < 4 ? a0[e] + b0[e] + c0[e] : a1[e - 4] + b1[e - 4] + c1[e - 4]; const float hv = gelu_tanh(x);
                uh[e] = f2bf(hv); ul[e] = f2bf(hv - __builtin_bit_cast(float, uh[e] << 16)); }
            const u32x4 wh = {uh[0] | (uh[1] << 16), uh[2] | (uh[3] << 16), uh[4] | (uh[5] << 16), uh[6] | (uh[7] << 16)}, wl = {ul[0] | (ul[1] << 16), ul[2] | (ul[3] << 16), ul[4] | (ul[5] << 16), ul[6] | (ul[7] << 16)};
            hh[ks] = __builtin_bit_cast(bf16x8, wh); hl[ks] = __builtin_bit_cast(bf16x8, wl); }
        f32x4 acc[4];
#pragma unroll
        for (int dt = 0; dt < 4; ++dt) { acc[dt] = *(const f32x4*)(p->in[I_CB2] + kv * 64 + 16 * dt + 4 * fq);
#pragma unroll
            for (int ks = 0; ks < 4; ++ks) { const size_t wo = (size_t)(kv * 64 + 16 * dt + fr) * 128 + 32 * ks + 8 * fq; const bf16x8 wh = *(const bf16x8*)(W2H + wo), wl = *(const bf16x8*)(W2L + wo);
                acc[dt] = mfma16(wh, hh[ks], acc[dt]); acc[dt] = mfma16(wh, hl[ks], acc[dt]); acc[dt] = mfma16(wl, hh[ks], acc[dt]); } }
        if (kv == 0) { float ss = 0.f;
#pragma unroll
            for (int dt = 0; dt < 4; ++dt) ss += (acc[dt][0] * acc[dt][0] + acc[dt][1] * acc[dt][1]) + (acc[dt][2] * acc[dt][2] + acc[dt][3] * acc[dt][3]);
            ss = sum_rows4(ss); const float rs = frsq(ss * (1.0f / 64.0f) + NORM_EPS);
#pragma unroll
            for (int dt = 0; dt < 4; ++dt) acc[dt] = acc[dt] * rs * *(const f32x4*)(p->in[I_KNG] + 16 * dt + 4 * fq); }
#pragma unroll
        for (int dt = 0; dt < 4; ++dt) { const f32x4 o = live ? acc[dt] : (f32x4){0.f, 0.f, 0.f, 0.f}; const int d = 16 * dt + 4 * fq;
            if (samp) *(f32x4*)((float*)(ws + (kv ? WS_CVS : WS_CKS)) + ((size_t)hb * 128 + n) * 64 + d) = o;
            else if (kv == 0) { u32x2 w; w.x = pk2(o[0], o[1]); w.y = pk2(o[2], o[3]); *(u32x2*)((bf16_t*)(ws + WS_CK) + ((size_t)hb * 512 + n) * 64 + d) = w; }
            else {
#pragma unroll
                for (int e = 0; e < 4; ++e) ((bf16_t*)(ws + WS_CV))[((size_t)hb * 64 + d + e) * 512 + n] = (bf16_t)f2bf(o[e]); } }
    }
}

__device__ __forceinline__ void phase_qpost(KP p, const Ctx& c, int lb) {
    const float* QF = (const float*)(p->ws + WS_QF); bf16_t* Q = (bf16_t*)(p->ws + WS_Q); const int lane = c.lane;
    const f32x4 gq = *(const f32x4*)(p->in[I_QNG] + lb * 64 + 4 * (lane & 15));
    for (int row = c.gw; row < R; row += c.ngw) { const float* src = QF + (size_t)row * NQP;
        f32x4 v[4]; load_row(src, lane, v);
#pragma unroll
        for (int j = 0; j < 4; ++j) { float s = (v[j][0] * v[j][0] + v[j][1] * v[j][1]) + (v[j][2] * v[j][2] + v[j][3] * v[j][3]);
            s = row16_sum(s);
            const float rs = (frsq(s * (1.0f / 64.0f) + NORM_EPS)) * (0.125f * 1.4426950408889634f); v[j] = v[j] * rs * gq; }
        store_row_bf16(Q + (size_t)row * D, lane, v);
    }
}
constexpr int AT_K0 = 0, AT_V0 = 9216, AT_K1 = 18432, AT_V1 = 27648, AT_IMP = 36864, IMPS = 132, AT_SELM = AT_IMP + 64 * IMPS * 4, AT_ANY = AT_SELM + 1024;
static_assert(AT_ANY + 16 <= RING_BYTES, "attention LDS map");
struct TileSrc { const bf16_t* K; const bf16_t* VT; int vts; };
__device__ __forceinline__ void tile_load(const TileSrc& s, int key0, int tid, u32x4& rk, u32x4& rv) {
    const int row = tid >> 3, ch = tid & 7;
    rk = *(const u32x4*)(s.K + (size_t)(key0 + row) * 64 + 8 * ch); rv = *(const u32x4*)(s.VT + (size_t)row * s.vts + key0 + 8 * ch);
}
__device__ __forceinline__ void tile_load_async(const TileSrc& s, int key0, int tid, u32x4& rk, u32x4& rv) {
    const int row = tid >> 3, ch = tid & 7;
    const bf16_t* pk = s.K + (size_t)(key0 + row) * 64 + 8 * ch; const bf16_t* pv = s.VT + (size_t)row * s.vts + key0 + 8 * ch;
    asm volatile("global_load_dwordx4 %0, %2, off\n\tglobal_load_dwordx4 %1, %3, off" : "=&v"(rk), "=&v"(rv) : "v"(pk), "v"(pv) : "memory");
}
#define TILE_WAIT(N_, RK_, RV_) asm volatile("s_waitcnt vmcnt(" #N_ ")" : "+v"(RK_), "+v"(RV_) :: "memory")
__device__ __forceinline__ void tile_store(LAS unsigned char* lds, int buf, int tid, const u32x4& rk, const u32x4& rv) {
    const int row = tid >> 3, ch = tid & 7;
    *(LAS u32x4*)(lds + (buf ? AT_K1 : AT_K0) + (row * SST + 8 * ch) * 2) = rk; *(LAS u32x4*)(lds + (buf ? AT_V1 : AT_V0) + (row * SST + 8 * ch) * 2) = rv;
}
__device__ __forceinline__ int first_bit4(unsigned a, unsigned b, unsigned c, unsigned d) { return a ? __ffs(a) - 1 : (b ? 32 + __ffs(b) - 1 : (c ? 64 + __ffs(c) - 1 : (d ? 96 + __ffs(d) - 1 : -1))); }
__device__ __forceinline__ float ex2(float x) { return __builtin_amdgcn_exp2f(x); }

__device__ __forceinline__ void set_bit4(int s, unsigned& t0, unsigned& t1, unsigned& t2, unsigned& t3) { const unsigned bit = 1u << (s & 31); const int w = s >> 5; t0 |= (w == 0) ? bit : 0u; t1 |= (w == 1) ? bit : 0u; t2 |= (w == 2) ? bit : 0u; t3 |= (w == 3) ? bit : 0u; }
__device__ __forceinline__ void clr_bit4(int s, unsigned& t0, unsigned& t1, unsigned& t2, unsigned& t3) { const unsigned bit = 1u << (s & 31); const int w = s >> 5; t0 &= ~((w == 0) ? bit : 0u); t1 &= ~((w == 1) ? bit : 0u); t2 &= ~((w == 2) ? bit : 0u); t3 &= ~((w == 3) ? bit : 0u); }
__device__ __forceinline__ unsigned get_word4(int s, unsigned a, unsigned b, unsigned c, unsigned d) { const int w = s >> 5; return ((w == 0) ? a : 0u) | ((w == 1) ? b : 0u) | ((w == 2) ? c : 0u) | ((w == 3) ? d : 0u); }
__device__ __forceinline__ float dpp_xor1(float x) { return __builtin_bit_cast(float, __builtin_amdgcn_update_dpp(0, __builtin_bit_cast(int, x), 0xB1, 0xF, 0xF, true)); }
__device__ __forceinline__ float dpp_xor2(float x) { return __builtin_bit_cast(float, __builtin_amdgcn_update_dpp(0, __builtin_bit_cast(int, x), 0x4E, 0xF, 0xF, true)); }
template <int MODE, bool EDGE> __device__ __forceinline__ void attn_tile(LAS unsigned char* lds, int buf, const bf16x8 (&qf)[4], int key0, int qpos, int r, int hf,
                                                                          float& l, f32x16 (&O)[2], float invl, bool selbit, LAS float* impq) {
    if (MODE == 3) { if (__ballot(selbit) == 0ull) { asm volatile("" : "+v"(O[0]), "+v"(O[1]), "+v"(l)); return; } }
    const float sbias = selbit ? 0.f : -1.0e30f;
    const int oK = buf ? AT_K1 : AT_K0, oV = buf ? AT_V1 : AT_V0;
#pragma unroll
    for (int kt = 0; kt < 2; ++kt) {
        f32x16 S;
#pragma unroll
        for (int i = 0; i < 16; ++i) S[i] = (MODE == 3) ? sbias : 0.f;
#pragma unroll
        for (int ks = 0; ks < 4; ++ks) S = mfma32(*(const LAS bf16x8*)(lds + oK + ((32 * kt + r) * SST + 16 * ks + 8 * hf) * 2), qf[ks], S);
        float ls = 0.f;
#pragma unroll
        for (int i = 0; i < 16; ++i) { float pv = ex2(S[i]);
            if (EDGE) { const int key = key0 + 32 * kt + (i & 3) + 8 * (i >> 2) + 4 * hf; bool v;
                if (MODE <= 1) v = (16 * key + 31 <= qpos); else if (MODE == 2) v = (key <= qpos) && (key + WIN > qpos); else v = (key <= qpos);
                pv = v ? pv : 0.f; }
            if (MODE == 1) pv *= invl;
            S[i] = pv; ls += pv; }
        if (MODE != 1) l += ls;
        if (MODE >= 1) {
#pragma unroll
            for (int sp = 0; sp < 2; ++sp) {
                u32x4 pw; pw.x = pg8::cvt_pk_bf16(S[8 * sp + 0], S[8 * sp + 1]); pw.y = pg8::cvt_pk_bf16(S[8 * sp + 2], S[8 * sp + 3]); pw.z = pg8::cvt_pk_bf16(S[8 * sp + 4], S[8 * sp + 5]); pw.w = pg8::cvt_pk_bf16(S[8 * sp + 6], S[8 * sp + 7]);
                const bf16x8 pf = __builtin_bit_cast(bf16x8, pw);
#pragma unroll
                for (int dt = 0; dt < 2; ++dt) { const int d = 32 * dt + r, kb = 32 * kt + 16 * sp + 4 * hf;
                    const u32x2 lo = *(const LAS u32x2*)(lds + oV + (d * SST + kb) * 2), hi = *(const LAS u32x2*)(lds + oV + (d * SST + kb + 8) * 2);
                    const u32x4 vw = {lo.x, lo.y, hi.x, hi.y};
                    O[dt] = mfma32(__builtin_bit_cast(bf16x8, vw), pf, O[dt]); } }
        }
        if (MODE == 1) {
            float own[4], nxt[4];
#pragma unroll
            for (int gq = 0; gq < 4; ++gq) { const float p3 = S[4 * gq + 3]; float o = 2.0f * (S[4 * gq] + S[4 * gq + 1] + S[4 * gq + 2]) + p3, n = p3;
                o += dpp_xor1(o); o += dpp_xor2(o); n += dpp_xor1(n); n += dpp_xor2(n); own[gq] = o; nxt[gq] = n; }
            const int sbb = (key0 >> 2) + 8 * kt + hf;
            if ((r & 3) == 0) {
#pragma unroll
                for (int gq = 0; gq < 4; ++gq) impq[sbb + 2 * gq] += own[gq]; }
            asm volatile("s_waitcnt lgkmcnt(0)" ::: "memory");
            if ((r & 3) == 0) {
#pragma unroll
                for (int gq = 0; gq < 4; ++gq) impq[sbb + 2 * gq + 1] += nxt[gq]; }
            asm volatile("s_waitcnt lgkmcnt(0)" ::: "memory");
        }
    }
}

template <int MODE> __device__ __forceinline__ void run_tiles(LAS unsigned char* lds, const TileSrc& src, unsigned t0, unsigned t1, unsigned t2, unsigned t3, int qt,
                                                              const bf16x8 (&qf)[4], int qpos, int r, int hf, int tid,
                                                              float& l, f32x16 (&O)[2], float invl, unsigned s0, unsigned s1, unsigned s2, unsigned s3, LAS float* impq, const int alias = 0) {
#define TSEL(n_) ((alias ? ((n_) & 7) : (n_)) * 64)
    tid = launder_v(tid); r = tid & 31; hf = (tid >> 5) & 1;
    int cur = first_bit4(t0, t1, t2, t3); if (cur < 0) return;
    const int first = cur;
    clr_bit4(cur, t0, t1, t2, t3); int n1 = first_bit4(t0, t1, t2, t3); if (n1 >= 0) clr_bit4(n1, t0, t1, t2, t3);
    int n2 = first_bit4(t0, t1, t2, t3); if (n2 >= 0) clr_bit4(n2, t0, t1, t2, t3);
    int n3 = first_bit4(t0, t1, t2, t3); if (n3 >= 0) clr_bit4(n3, t0, t1, t2, t3);
    u32x4 rkA, rvA, rkB, rvB, rkC, rvC; { u32x4 rk, rv; tile_load(src, TSEL(cur), tid, rk, rv); int b0 = 0; tile_store(lds, b0, tid, rk, rv); }
    tile_load_async(src, TSEL(n1 >= 0 ? n1 : first), tid, rkA, rvA);
    tile_load_async(src, TSEL(n2 >= 0 ? n2 : first), tid, rkB, rvB);
    tile_load_async(src, TSEL(n3 >= 0 ? n3 : first), tid, rkC, rvC);
    int buf = 0;
    __syncthreads();
#define RT_STEP(RK_, RV_) { \
        if (cur >= 0) { \
            const unsigned sw = get_word4(cur, s0, s1, s2, s3); \
            const bool sb = ((sw >> (cur & 31)) & 1u) != 0u; \
            if (MODE <= 1) attn_tile<MODE, true>(lds, buf, qf, cur * 64, qpos, r, hf, l, O, invl, sb, impq); \
            else { const bool edge = (cur == qt) || (MODE == 2 && cur == qt - 8); \
                if (edge) attn_tile<MODE, true>(lds, buf, qf, cur * 64, qpos, r, hf, l, O, invl, sb, impq); \
                else attn_tile<MODE, false>(lds, buf, qf, cur * 64, qpos, r, hf, l, O, invl, sb, impq); } } \
        TILE_WAIT(4, RK_, RV_); \
        tile_store(lds, buf ^ 1, tid, RK_, RV_); \
        __syncthreads(); \
        const int n4 = first_bit4(t0, t1, t2, t3); if (n4 >= 0) clr_bit4(n4, t0, t1, t2, t3); \
        tile_load_async(src, TSEL(n4 >= 0 ? n4 : first), tid, RK_, RV_); \
        buf ^= 1; cur = n1; n1 = n2; n2 = n3; n3 = n4; }
    do {
        RT_STEP(rkA, rvA)
        RT_STEP(rkB, rvB)
        RT_STEP(rkC, rvC)
    } while (cur >= 0);
#undef RT_STEP
    asm volatile("s_waitcnt vmcnt(0)" : "+v"(rkA), "+v"(rvA), "+v"(rkB), "+v"(rvB), "+v"(rkC), "+v"(rvC) :: "memory");
    __syncthreads();
}
__device__ __forceinline__ void attn_prompt_unit(KP p, const Ctx& c, int k, const int stop, const int lb) {
    LAS unsigned char* lds = c.lds; unsigned char* ws = p->ws; int tid_m; asm volatile("v_mbcnt_lo_u32_b32 %0, -1, 0\n\tv_mbcnt_hi_u32_b32 %0, -1, %0" : "=v"(tid_m));
    const int wave = c.wave, tid = tid_m + 64 * wave, lane = tid & 63, r = lane & 31, hf = lane >> 5;
    const int qt = 127 - (k >> 3), hb = k & 7, b = hb >> 2, g = hb & 3, q0 = 64 * qt;
    const int qi = 8 * wave + (r >> 2), head = 4 * g + (r & 3), qpos = q0 + qi, row = b * TP + qpos;
    bf16x8 qf[4];
    { const float* QFp = (const float*)(ws + WS_QF) + (size_t)row * NQP + head * 64 + 8 * hf; const float* gqp = p->in[I_QNG] + lb * 64 + 8 * hf;
      f32x4 qv[4][2]; float ss = 0.f;
#pragma unroll
      for (int ks = 0; ks < 4; ++ks) { qv[ks][0] = *(const f32x4*)(QFp + 16 * ks); qv[ks][1] = *(const f32x4*)(QFp + 16 * ks + 4);
#pragma unroll
          for (int e = 0; e < 4; ++e) ss += qv[ks][0][e] * qv[ks][0][e] + qv[ks][1][e] * qv[ks][1][e]; }
      ss = sum_xor32(ss);
      const float rs = frsq(ss * (1.0f / 64.0f) + NORM_EPS) * (0.125f * 1.4426950408889634f);
#pragma unroll
      for (int ks = 0; ks < 4; ++ks) { const f32x4 g0 = *(const f32x4*)(gqp + 16 * ks), g1 = *(const f32x4*)(gqp + 16 * ks + 4); const f32x4 a = qv[ks][0] * rs * g0, bq = qv[ks][1] * rs * g1;
          const u32x4 wq = {pk2(a[0], a[1]), pk2(a[2], a[3]), pk2(bq[0], bq[1]), pk2(bq[2], bq[3])}; qf[ks] = __builtin_bit_cast(bf16x8, wq); } }
    const float* gate = (const float*)(ws + WS_GATE) + (size_t)row * 48 + head * 3; const float g_c = gate[0], g_s = gate[1], g_w = gate[2];
    LAS float* imp = (LAS float*)(lds + AT_IMP); LAS unsigned* selm = (LAS unsigned*)(lds + AT_SELM); LAS unsigned* anym = (LAS unsigned*)(lds + AT_ANY);
    for (int e = tid; e < 64 * IMPS; e += 512) imp[e] = 0.f;
    if (tid < 4) anym[tid] = 0u;
    __syncthreads();
    f32x16 O[2]; unsigned OUTP[2][8];
#pragma unroll
    for (int dt = 0; dt < 2; ++dt)
#pragma unroll
        for (int i = 0; i < 16; ++i) O[dt][i] = 0.f;
    {
        const TileSrc src{(const bf16_t*)(ws + WS_CK) + (size_t)hb * 512 * 64, (const bf16_t*)(ws + WS_CV) + (size_t)hb * 64 * 512, 512};
        const int nmax = q0 + 63 - 31; const int ntc = nmax >= 0 ? (nmax >> 10) + 1 : 0;
        const unsigned tm = ntc >= 32 ? 0xffffffffu : ((1u << ntc) - 1u);
        float l = 0.f;
        run_tiles<0>(lds, src, tm, 0u, 0u, 0u, qt, qf, qpos, r, hf, tid, l, O, 0.f, 0u, 0u, 0u, 0u, imp);
        l = sum_xor32(l); const float invl = l > 0.f ? 1.0f / l : 0.f;
        run_tiles<1>(lds, src, tm, 0u, 0u, 0u, qt, qf, qpos, r, hf, tid, l, O, invl, 0u, 0u, 0u, 0u, imp + qi * IMPS);
#pragma unroll
        for (int dt = 0; dt < 2; ++dt) {
#pragma unroll
            for (int i = 0; i < 8; ++i) { OUTP[dt][i] = pg8::cvt_pk_bf16(O[dt][2 * i] * g_c, O[dt][2 * i + 1] * g_c); asm volatile("" : "+v"(OUTP[dt][i])); }
#pragma unroll
            for (int i = 0; i < 16; ++i) O[dt][i] = 0.f; }
    }
    __syncthreads();
    if (stop == 1) return;
    {
        unsigned k0[8], k1[8], T[8]; int Kq[8];
#pragma unroll
        for (int e = 0; e < 8; ++e) { const int qq = 8 * wave + e, qp = q0 + qq, qb = qp >> 6;
            const bool c0 = (64 * lane <= qp), c1 = (64 * (lane + 64) <= qp);
            const unsigned a0_ = (lane == 0 || lane == qb || lane == qb - 1) ? 0xffffffffu : __builtin_bit_cast(unsigned, imp[qq * IMPS + lane]);
            const unsigned a1_ = (lane + 64 == qb || lane + 64 == qb - 1) ? 0xffffffffu : __builtin_bit_cast(unsigned, imp[qq * IMPS + lane + 64]);
            k0[e] = c0 ? a0_ : 0u; k1[e] = c1 ? a1_ : 0u;
            Kq[e] = qb + 1 < 16 ? qb + 1 : 16; T[e] = 0u; }
        for (int bit = 31; bit >= 0; --bit) {
#pragma unroll
            for (int e = 0; e < 8; ++e) { const unsigned cand = T[e] | (1u << bit);
                const int cnt = __popcll(__ballot(k0[e] >= cand)) + __popcll(__ballot(k1[e] >= cand)); if (cnt >= Kq[e]) T[e] = cand; } }
#pragma unroll
        for (int e = 0; e < 8; ++e) { const int qq = 8 * wave + e, qp = q0 + qq;
            const bool c0 = (64 * lane <= qp), c1 = (64 * (lane + 64) <= qp);
            unsigned long long mlo = __ballot(k0[e] > T[e]), mhi = __ballot(k1[e] > T[e]), elo = __ballot(c0 && k0[e] == T[e]), ehi = __ballot(c1 && k1[e] == T[e]);
            int need = Kq[e] - (__popcll(mlo) + __popcll(mhi));
            for (; need > 0; --need) { if (elo) { mlo |= elo & (~elo + 1ull); elo &= elo - 1ull; } else { mhi |= ehi & (~ehi + 1ull); ehi &= ehi - 1ull; } }
            const unsigned m0 = (unsigned)mlo, m1 = (unsigned)(mlo >> 32), m2 = (unsigned)mhi, m3 = (unsigned)(mhi >> 32);
            if (lane == 0) { selm[qq * 4 + 0] = m0; selm[qq * 4 + 1] = m1; selm[qq * 4 + 2] = m2; selm[qq * 4 + 3] = m3;
                atomicOr((unsigned*)&anym[0], m0); atomicOr((unsigned*)&anym[1], m1); atomicOr((unsigned*)&anym[2], m2); atomicOr((unsigned*)&anym[3], m3); } }
    }
    __syncthreads();
    if (stop == 2) return;
    {
        const TileSrc src{(const bf16_t*)(ws + WS_KW) + (size_t)hb * TP * 64, (const bf16_t*)(ws + WS_VW) + (size_t)hb * 64 * TP, TP};
        const int tlo = qt >= 8 ? qt - 8 : 0; unsigned t0 = 0u, t1 = 0u, t2 = 0u, t3 = 0u;
        for (int s = tlo; s <= qt; ++s) set_bit4(s, t0, t1, t2, t3);
        float l = 0.f;
        run_tiles<2>(lds, src, t0, t1, t2, t3, qt, qf, qpos, r, hf, tid, l, O, 0.f, 0u, 0u, 0u, 0u, imp);
        l = sum_xor32(l); const float sc = l > 0.f ? g_w / l : 0.f;
#pragma unroll
        for (int dt = 0; dt < 2; ++dt) {
#pragma unroll
            for (int i = 0; i < 8; ++i) { OUTP[dt][i] = pg8::cvt_pk_bf16(bflo(OUTP[dt][i]) + O[dt][2 * i] * sc, bfhi(OUTP[dt][i]) + O[dt][2 * i + 1] * sc); asm volatile("" : "+v"(OUTP[dt][i])); }
#pragma unroll
            for (int i = 0; i < 16; ++i) O[dt][i] = 0.f; }
    }
    if (stop == 3) { __syncthreads(); return; }
    {
        const TileSrc src{(const bf16_t*)(ws + WS_KS) + (size_t)hb * TP * 64, (const bf16_t*)(ws + WS_VS) + (size_t)hb * 64 * TP, TP};
        const unsigned sz_ = (stop == 5) ? 0u : 0xffffffffu;
        const unsigned s0 = selm[qi * 4 + 0] & sz_, s1 = selm[qi * 4 + 1] & sz_, s2 = selm[qi * 4 + 2] & sz_, s3 = selm[qi * 4 + 3] & sz_;
        const unsigned a0 = __builtin_amdgcn_readfirstlane(anym[0]), a1 = __builtin_amdgcn_readfirstlane(anym[1]), a2 = __builtin_amdgcn_readfirstlane(anym[2]), a3 = __builtin_amdgcn_readfirstlane(anym[3]);
        float l = 0.f;
        run_tiles<3>(lds, src, a0, a1, a2, a3, qt, qf, qpos, r, hf, tid, l, O, 0.f, s0, s1, s2, s3, imp, stop == 4 ? 1 : 0);
        if (stop >= 4) { if (l == 12345.678f) ((float*)(ws + WS_GATE))[0] = O[0][0] + O[1][0]; __syncthreads(); return; }
        l = sum_xor32(l); const float sc = l > 0.f ? g_s / l : 0.f;
#pragma unroll
        for (int dt = 0; dt < 2; ++dt)
#pragma unroll
            for (int i = 0; i < 8; ++i) OUTP[dt][i] = pg8::cvt_pk_bf16(bflo(OUTP[dt][i]) + O[dt][2 * i] * sc, bfhi(OUTP[dt][i]) + O[dt][2 * i + 1] * sc);
    }
    bf16_t* AO = (bf16_t*)(ws + WS_YG) + (size_t)row * D + head * 64;
#pragma unroll
    for (int dt = 0; dt < 2; ++dt)
#pragma unroll
        for (int gq = 0; gq < 4; ++gq) { u32x2 w; w.x = OUTP[dt][2 * gq]; w.y = OUTP[dt][2 * gq + 1]; *(u32x2*)(AO + 32 * dt + 8 * gq + 4 * hf) = w; }
    __syncthreads();
}

constexpr int SA_RED = 0, SA_REDW = 2 * 16 * 65 * 4, SA_OC = SA_RED + SA_REDW, SA_EC = SA_OC + 2 * 4096, SA_LC = SA_EC + 2 * 4096, SA_PN = SA_LC + 256, SA_SEL = SA_PN + 4 * 512;
static_assert(SA_SEL + 64 <= RING_BYTES, "sample attention LDS map");
__device__ __forceinline__ bf16x8 pack8(const f32x4 a, const f32x4 b) { const u32x4 w = {pk2(a[0], a[1]), pk2(a[2], a[3]), pk2(b[0], b[1]), pk2(b[2], b[3])}; return __builtin_bit_cast(bf16x8, w); }
__device__ __forceinline__ void sa_qk(const float* kb, size_t stride, int nrows, const bf16x8 (&qf)[2], int fr, int fq, f32x4 (&S)[4]) {
    f32x4 kr[4][2][2];
#pragma unroll
    for (int kg = 0; kg < 4; ++kg) { const int key = 16 * kg + fr; const float* rp = kb + (size_t)(key < nrows ? key : nrows - 1) * stride + 8 * fq;
#pragma unroll
        for (int ks = 0; ks < 2; ++ks) { kr[kg][ks][0] = *(const f32x4*)(rp + 32 * ks); kr[kg][ks][1] = *(const f32x4*)(rp + 32 * ks + 4); } }
#pragma unroll
    for (int kg = 0; kg < 4; ++kg) { S[kg] = (f32x4){0.f, 0.f, 0.f, 0.f};
#pragma unroll
        for (int ks = 0; ks < 2; ++ks) S[kg] = mfma16(pack8(kr[kg][ks][0], kr[kg][ks][1]), qf[ks], S[kg]); }
}
__device__ __forceinline__ void sa_pv(const float* vb, size_t stride, int nrows, const f32x4 (&P)[4], int fr, int fq, f32x4 (&O)[4]) {
#pragma unroll
    for (int ks = 0; ks < 2; ++ks) { const bf16x8 pa = pack8(P[2 * ks], P[2 * ks + 1]);
        float vv[4][8];
#pragma unroll
        for (int j = 0; j < 8; ++j) { const int key = 16 * (2 * ks + (j >> 2)) + 4 * fq + (j & 3); const float* rp = vb + (size_t)(key < nrows ? key : nrows - 1) * stride + fr;
#pragma unroll
            for (int dt = 0; dt < 4; ++dt) vv[dt][j] = rp[16 * dt]; }
#pragma unroll
        for (int dt = 0; dt < 4; ++dt) { const u32x4 w = {pk2(vv[dt][0], vv[dt][1]), pk2(vv[dt][2], vv[dt][3]), pk2(vv[dt][4], vv[dt][5]), pk2(vv[dt][6], vv[dt][7])};
            O[dt] = mfma16(pa, __builtin_bit_cast(bf16x8, w), O[dt]); } }
}
__device__ __forceinline__ void attn_sample_unit(KP p, const Ctx& c, int item, const int lb) {
    unsigned char* ws = p->ws; LAS unsigned char* lds = c.lds; const int tid = launder_v(c.tid), lane = tid & 63, wave = c.wave, fr = lane & 15, fq = lane >> 4; const int b = item >> 2, g = item & 3;
    bf16x8 qf[2];
    { const float* QFp = (const float*)(ws + WS_QF) + (size_t)(MP + 4 * b + (fr >> 2)) * NQP + (4 * g + (fr & 3)) * 64 + 8 * fq; const float* gqp = p->in[I_QNG] + lb * 64 + 8 * fq;
      f32x4 qv[2][2]; float ss = 0.f;
#pragma unroll
      for (int ks = 0; ks < 2; ++ks) { qv[ks][0] = *(const f32x4*)(QFp + 32 * ks); qv[ks][1] = *(const f32x4*)(QFp + 32 * ks + 4);
#pragma unroll
          for (int e = 0; e < 4; ++e) ss += qv[ks][0][e] * qv[ks][0][e] + qv[ks][1][e] * qv[ks][1][e]; }
      ss = sum_rows4(ss);
      const float rs = frsq(ss * (1.0f / 64.0f) + NORM_EPS) * (0.125f * 1.4426950408889634f);
#pragma unroll
      for (int ks = 0; ks < 2; ++ks) { const f32x4 g0 = *(const f32x4*)(gqp + 32 * ks), g1 = *(const f32x4*)(gqp + 32 * ks + 4); const f32x4 a = qv[ks][0] * rs * g0, bq = qv[ks][1] * rs * g1;
          const u32x4 wq = {pk2(a[0], a[1]), pk2(a[2], a[3]), pk2(bq[0], bq[1]), pk2(bq[2], bq[3])}; qf[ks] = __builtin_bit_cast(bf16x8, wq); } }
    const int tokm = fr >> 2;
    if (wave < 2) {
        const float* ck = (const float*)(ws + WS_CKS) + ((size_t)(b * 4 + g) * 128 + 64 * wave) * 64; const float* cv = (const float*)(ws + WS_CVS) + ((size_t)(b * 4 + g) * 128 + 64 * wave) * 64;
        const int nrows = wave ? 63 : 64;
        f32x4 S[4]; sa_qk(ck, 64, nrows, qf, fr, fq, S);
        float ls = 0.f;
#pragma unroll
        for (int kg = 0; kg < 4; ++kg)
#pragma unroll
            for (int r = 0; r < 4; ++r) { const int key = 16 * kg + 4 * fq + r; const float ev = key < nrows ? ex2(S[kg][r]) : 0.f; S[kg][r] = ev; ls += ev;
                *(LAS float*)(lds + SA_EC + wave * 4096 + (key * 16 + fr) * 4) = ev; }
        ls = sum_rows4(ls); if (fq == 0) *(LAS float*)(lds + SA_LC + (wave * 16 + fr) * 4) = ls;
        f32x4 oc[4];
#pragma unroll
        for (int dt = 0; dt < 4; ++dt) oc[dt] = (f32x4){0.f, 0.f, 0.f, 0.f};
        sa_pv(cv, 64, nrows, S, fr, fq, oc);
#pragma unroll
        for (int dt = 0; dt < 4; ++dt)
#pragma unroll
            for (int r = 0; r < 4; ++r) *(LAS float*)(lds + SA_OC + wave * 4096 + ((4 * fq + r) * 64 + 16 * dt + fr) * 4) = oc[dt][r];
    }
    __syncthreads();
    if (wave < 4) { const int tok = wave; float P0 = 0.f, P1 = 0.f;
#pragma unroll
        for (int hh = 0; hh < 4; ++hh) { const int pi = tok * 4 + hh; const float L = *(const LAS float*)(lds + SA_LC + pi * 4) + *(const LAS float*)(lds + SA_LC + (16 + pi) * 4); const float inv = L > 0.f ? 1.0f / L : 0.f;
            P0 += *(const LAS float*)(lds + SA_EC + (lane * 16 + pi) * 4) * inv; P1 += *(const LAS float*)(lds + SA_EC + 4096 + (lane * 16 + pi) * 4) * inv; }
        LAS float* pn = (LAS float*)(lds + SA_PN + tok * 512); pn[lane] = P0; pn[64 + lane] = P1; LDS_WAIT();
        float v0 = -1e9f;
        if (lane < 33) { const int s = lane; float im = 0.f;
            if (4 * s - 1 >= 0 && 4 * s - 1 < 128) im += pn[4 * s - 1];
#pragma unroll
            for (int j = 0; j < 3; ++j) if (4 * s + j < 128) im += 2.0f * pn[4 * s + j];
            if (4 * s + 3 < 128) im += pn[4 * s + 3];
            v0 = (s == 0 || s == 31 || s == 32) ? 1e9f : im; }
        unsigned selmask = 0u, sel32 = 0u;
        for (int it = 0; it < 16; ++it) { const float mx = wave_max(v0); if (mx < -5e8f) break; const unsigned long long b0 = __ballot(v0 == mx); const int s = __ffsll((long long)b0) - 1;
            if (lane == s) v0 = -2e9f; if (s < 32) selmask |= 1u << s; else sel32 = 1u; }
        if (lane == 0) { *(LAS unsigned*)(lds + SA_SEL + tok * 8) = selmask; *(LAS unsigned*)(lds + SA_SEL + tok * 8 + 4) = sel32; } }
    __syncthreads();
    unsigned sm[4], s32[4];
#pragma unroll
    for (int t = 0; t < 4; ++t) { sm[t] = *(const LAS unsigned*)(lds + SA_SEL + t * 8); s32[t] = *(const LAS unsigned*)(lds + SA_SEL + t * 8 + 4); }
    const unsigned un = sm[0] | sm[1] | sm[2] | sm[3]; const int nsel = __popc(un); const int has32 = (s32[0] | s32[1] | s32[2] | s32[3]) ? 1 : 0;
    const unsigned my_sm = tokm == 0 ? sm[0] : (tokm == 1 ? sm[1] : (tokm == 2 ? sm[2] : sm[3])), my_s32 = tokm == 0 ? s32[0] : (tokm == 1 ? s32[1] : (tokm == 2 ? s32[2] : s32[3]));
    const int ntile = nsel + has32 + 9;
    const int* pt = (const int*)p->in[I_PT] + b * NPAGES;
    f32x4 osel[4], owin[4]; float lsel = 0.f, lwin = 0.f;
#pragma unroll
    for (int dt = 0; dt < 4; ++dt) { osel[dt] = (f32x4){0.f, 0.f, 0.f, 0.f}; owin[dt] = (f32x4){0.f, 0.f, 0.f, 0.f}; }
    for (int ti = wave; ti < ntile; ti += 8) {
        const float* kb; size_t stride; int nrows = 64, br, mode, sidx = 0;
        if (ti < nsel) { unsigned m = un; for (int q = 0; q < ti; ++q) m &= m - 1u; sidx = __ffs(m) - 1; const int page = pt[sidx >> 1];
            kb = p->in[I_CKV] + ((size_t)page * PAGE + (sidx & 1) * 64) * 1024 + 2 * 256 + g * 64; stride = 1024; br = 0; mode = 0; }
        else if (ti < nsel + has32) { kb = p->out + O_KV + (size_t)(MP + 4 * b) * D + 2 * 256 + g * 64; stride = 1024; nrows = 4; br = 0; mode = 1; }
        else if (ti < nsel + has32 + 8) { sidx = ti - nsel - has32; kb = p->in[I_CWIN] + ((size_t)b * WIN + 64 * sidx) * 512 + g * 64; stride = 512; br = 1; mode = 2; }
        else { kb = p->out + O_WINS + ((size_t)(b * WIN + 508) * 2) * 256 + g * 64; stride = 512; nrows = 4; br = 1; mode = 3; }
        f32x4 S[4]; sa_qk(kb, stride, nrows, qf, fr, fq, S);
        float ls = 0.f;
#pragma unroll
        for (int kg = 0; kg < 4; ++kg)
#pragma unroll
            for (int r = 0; r < 4; ++r) { const int key = 16 * kg + 4 * fq + r; bool valid;
                if (mode == 0) valid = ((my_sm >> sidx) & 1u) != 0u; else if (mode == 1) valid = (my_s32 != 0u) && (key <= tokm); else if (mode == 2) valid = (64 * sidx + key) >= tokm + 1; else valid = key <= tokm;
                const float ev = valid ? ex2(S[kg][r]) : 0.f; S[kg][r] = ev; ls += ev; }
        if (br == 0) { lsel += ls; sa_pv(kb + 256, stride, nrows, S, fr, fq, osel); } else { lwin += ls; sa_pv(kb + 256, stride, nrows, S, fr, fq, owin); }
    }
    lsel = sum_rows4(lsel); lwin = sum_rows4(lwin);
    for (int w = 0; w < 8; ++w) {
        if (wave == w) {
#pragma unroll
            for (int dt = 0; dt < 4; ++dt)
#pragma unroll
                for (int r = 0; r < 4; ++r) { LAS float* r0 = (LAS float*)(lds + SA_RED + ((4 * fq + r) * 65 + 16 * dt + fr) * 4); LAS float* r1 = (LAS float*)(lds + SA_RED + ((16 + 4 * fq + r) * 65 + 16 * dt + fr) * 4);
                    if (w == 0) { *r0 = osel[dt][r]; *r1 = owin[dt][r]; } else { *r0 += osel[dt][r]; *r1 += owin[dt][r]; } }
            if (fq == 0) { LAS float* l0 = (LAS float*)(lds + SA_RED + (fr * 65 + 64) * 4); LAS float* l1 = (LAS float*)(lds + SA_RED + ((16 + fr) * 65 + 64) * 4);
                if (w == 0) { *l0 = lsel; *l1 = lwin; } else { *l0 += lsel; *l1 += lwin; } } }
        __syncthreads(); }
    { const float* gt = (const float*)(ws + WS_GATE); bf16_t* AO = (bf16_t*)(ws + WS_YG);
      for (int e = tid; e < 1024; e += 512) { const int pi = e >> 6, d = e & 63, tok = pi >> 2, hh = pi & 3; const size_t row = (size_t)(MP + 4 * b + tok);
          const float lc = *(const LAS float*)(lds + SA_LC + pi * 4) + *(const LAS float*)(lds + SA_LC + (16 + pi) * 4);
          const float oc = *(const LAS float*)(lds + SA_OC + (pi * 64 + d) * 4) + *(const LAS float*)(lds + SA_OC + 4096 + (pi * 64 + d) * 4);
          const LAS float* r0 = (const LAS float*)(lds + SA_RED + (pi * 65) * 4); const LAS float* r1 = (const LAS float*)(lds + SA_RED + ((16 + pi) * 65) * 4);
          const float* gg = gt + row * 48 + (4 * g + hh) * 3;
          float out = lc > 0.f ? gg[0] * oc / lc : 0.f;
          out += r0[64] > 0.f ? gg[1] * r0[d] / r0[64] : 0.f;
          out += r1[64] > 0.f ? gg[2] * r1[d] / r1[64] : 0.f;
          AO[row * D + (4 * g + hh) * 64 + d] = (bf16_t)f2bf(out); } }
    __syncthreads();
}

__device__ __forceinline__ void phase_attn_prompt(KP p, const Ctx& c, const int lb, const int stop = 0) {
    const int Gd = gridDim.x, cb = blockIdx.x;
    for (int i = 0; i * Gd < 1024; ++i) { const int k = i * Gd + ((i & 1) ? Gd - 1 - cb : cb); if (k < 1024) attn_prompt_unit(p, c, k, stop, lb); }
}
__device__ __forceinline__ void phase_attn_sample(KP p, const Ctx& c, const int lb) {
    for (int it = blockIdx.x; it < SB * G; it += gridDim.x) attn_sample_unit(p, c, it, lb);
}
#ifndef MK_MULTI
#define MK_MULTI 0
#endif
#if defined(PROBE_SCALE) || defined(SELFTEST)
constexpr int NPH = 44;
#elif defined(PROBE_ATTN2)
constexpr int NPH = 45;
#else
constexpr int NPH = 43;
#endif
#ifdef SPLITK
#define RESID_SPLIT(n) (n)
#else
#define RESID_SPLIT(n) 0
#endif

__global__ void __launch_bounds__(512, 2) mega(Params p) {
    extern __shared__ __attribute__((aligned(16))) unsigned char lds_raw[];
    LAS unsigned char* const lds0 = (LAS unsigned char*)lds_raw;
    volatile LAS unsigned* MISC = (volatile LAS unsigned*)(lds0 + MISC_OFF);
    for (int u = threadIdx.x; u < (LDS_BYTES - RING_BYTES) / 4; u += 512) ((LAS unsigned*)(lds0 + RING_BYTES))[u] = 0u;
    __syncthreads();
    const KP kp0 = (KP)__builtin_amdgcn_kernarg_segment_ptr();
    const int ph_lo = kp0->ph_lo, ph_hi = kp0->ph_hi, use_bar = kp0->use_bar;
    XcdBarrier bar; bar.bar = (unsigned*)(kp0->ws + WS_CTL); bar.x = 0; bar.st = nullptr;
    if (use_bar) bar = xcd_barrier_post((unsigned*)(kp0->ws + WS_CTL), MISC + 8);
    const int wave_s = __builtin_amdgcn_readfirstlane((int)threadIdx.x >> 6);
#define TID_MBCNT 1
#ifdef TID_MBCNT
#define TID_SRC(T_) asm volatile("v_mbcnt_lo_u32_b32 %0, -1, 0\n\tv_mbcnt_hi_u32_b32 %0, -1, %0" : "=v"(T_)); T_ += 64 * wave_s;
#else
#define TID_SRC(T_) T_ = threadIdx.x; asm volatile("" : "+v"(T_));
#endif
    int ph = 0;
#define PHASE_BEGIN if (ph >= ph_lo && ph < ph_hi) { KP p = kp0; asm volatile("" : "+s"(p)); int tid_; TID_SRC(tid_) \
        Ctx c; c.lds = lds0; c.tid = tid_; c.lane = tid_ & 63; c.wave = __builtin_amdgcn_readfirstlane(tid_ >> 6); c.gw = blockIdx.x * 8 + c.wave; c.ngw = gridDim.x * 8; c.gtid = blockIdx.x * 512 + tid_; c.gsz = gridDim.x * 512; \
        unsigned char* ws = p->ws; float* X = p->out + O_Y; (void)ws; (void)X;
#define PHASE_END   if (use_bar) { int te_; TID_SRC(te_) xcd_barrier(bar, te_ == 0); } } ++ph;

    PHASE_BEGIN phase_prologue(p, c); PHASE_END
#ifdef PROBE_BAR
    for (int xb = 0; xb < PROBE_BAR; ++xb) { if (use_bar) xcd_barrier(bar, threadIdx.x == 0); }
#endif

    for (int layer = 0; layer < NLAY; ++layer) {
        if (layer < 2) {
            const int li = layer;
            PHASE_BEGIN phase_mix(p, c, li); PHASE_END
            PHASE_BEGIN {
                pg8::Gemm g{(const bf16_t*)(ws + WS_XM), (const bf16_t*)(ws + WS_WRKV) + (size_t)li * 3072 * 1024, 3 * R, 3072, 1024, 1024};
                pg8::GroupOrder S; S.init((int)gridDim.x, (int)blockIdx.x); S.add(0, 0, 64, 0, 4); S.add(1, 66, 64, 4, 4); S.add(2, 132, 64, 8, 4);
                pg8::EpiF32G E{(float*)(ws + WS_RK_R), (float*)(ws + WS_RK_K), (float*)(ws + (li ? WS_V1 : WS_V0)), nullptr, D, 4, 66};
                pg8::gemm_phase<pg8::EpiF32G, pg8::GroupOrder, true, true>(c.lds, g, S, E, c.tid);
                {
                    const bf16_t* XMs = (const bf16_t*)(ws + WS_XM); const bf16_t* Wr = (const bf16_t*)(ws + WS_WRKV) + (size_t)li * 3072 * 1024;
                    for (int it = blockIdx.x + gridDim.x * c.wave; it < 768; it += c.ngw) { const int j = it >> 8, r = it & 255, row0 = MP + 32 * (r & 15), col0 = 64 * (r >> 4);
                        float* C = (float*)(ws + (j == 0 ? WS_RK_R : (j == 1 ? WS_RK_K : (li ? WS_V1 : WS_V0))));
                        f32x4 acc[4][2]; skinny_mma<4>(XMs + (size_t)j * R * D, 1024, Wr + (size_t)j * 1024 * 1024, 1024, 1024, row0, col0, c.lane, acc);
                        const int fr = c.lane & 15, fq = c.lane >> 4;
#pragma unroll
                        for (int nt = 0; nt < 4; ++nt)
#pragma unroll
                            for (int mt = 0; mt < 2; ++mt) *(f32x4*)(C + (size_t)(row0 + 16 * mt + fr) * D + col0 + 16 * nt + 4 * fq) = acc[nt][mt]; }
                }
                phase_lora1(p, c, li);
            } PHASE_END
            PHASE_BEGIN phase_scanA(p, c, li); PHASE_END
            PHASE_BEGIN phase_scanB(p, c, li); PHASE_END
            PHASE_BEGIN phase_scanC(p, c, li); PHASE_END
        } else {
            const int lb = layer - 2;
            if (layer == 2) {
                PHASE_BEGIN phase_norm(c, X, p->in[I_KVNG], (bf16_t*)(ws + WS_XN2), p->in[I_NORMG] + (size_t)(layer * 2) * D, (bf16_t*)(ws + WS_XN)); PHASE_END
                PHASE_BEGIN {
                    pg8::Gemm g{(const bf16_t*)(ws + WS_XN2), (const bf16_t*)(ws + WS_WKVT), R, NKV, 1024, 1024};
                    pg8::GroupOrder S; S.init((int)gridDim.x, (int)blockIdx.x); S.add(0, 0, 66, 0, 6);
                    pg8::EpiF32G E{(float*)(ws + WS_KVF), nullptr, nullptr, nullptr, NKV, 1 << 20, 0};
                    pg8::gemm_phase<pg8::EpiF32G, pg8::GroupOrder, true, true>(c.lds, g, S, E, c.tid);
                } PHASE_END
                PHASE_BEGIN phase_kvpost(p, c); PHASE_END
                PHASE_BEGIN {
                    pg8::Gemm g{(const bf16_t*)(ws + WS_CMPA), (const bf16_t*)(ws + WS_CW1T), (int)CMPA_ROWS, 512, 1024, 1024};
                    pg8::GroupOrder S; S.init((int)gridDim.x, (int)blockIdx.x); S.add(0, 0, 16, 0, 1); S.add(1, 16, 16, 1, 1); S.add(2, 32, 256, 0, 1); S.add(3, 288, 256, 1, 1);
                    pg8::EpiF32G E{(float*)(ws + WS_PCMP), (float*)(ws + WS_PCMP), nullptr, nullptr, 256, 1, 0};
                    pg8::gemm_phase<pg8::EpiF32G, pg8::GroupOrder, true, true>(c.lds, g, S, E, c.tid);
                } PHASE_END
                PHASE_BEGIN phase_cmp2(p, c); PHASE_END
            } else {
                PHASE_BEGIN phase_norm(c, X, p->in[I_NORMG] + (size_t)(layer * 2) * D, (bf16_t*)(ws + WS_XN), nullptr, nullptr); PHASE_END
            }
            PHASE_BEGIN {
                const bf16_t* XNp = (const bf16_t*)(ws + WS_XN); const bf16_t* Wq = (const bf16_t*)(ws + WS_WQT) + (size_t)lb * NQP * 1024; float* QFp = (float*)(ws + WS_QF);
                pg8::Gemm g{XNp, Wq, R, NQP, 1024, 1024};
                pg8::GroupOrder S; S.init((int)gridDim.x, (int)blockIdx.x); S.add(0, 0, 64, 0, 4);
                pg8::EpiF32G E{QFp, nullptr, nullptr, nullptr, NQP, 1 << 20, 0};
                pg8::gemm_phase<pg8::EpiF32G, pg8::GroupOrder, true, true>(c.lds, g, S, E, c.tid);
                float* GATEp = (float*)(ws + WS_GATE);
                for (int it = blockIdx.x + gridDim.x * c.wave; it < 256 + R / 32; it += c.ngw) { const int ln = launder_v(c.lane), fr = ln & 15, fq = ln >> 4;
                    if (it < 256) { const int row0 = MP + 32 * (it & 15), col0 = 64 * (it >> 4);
                        f32x4 acc[4][2]; skinny_mma<4>(XNp, 1024, Wq, 1024, 1024, row0, col0, ln, acc);
#pragma unroll
                        for (int nt = 0; nt < 4; ++nt)
#pragma unroll
                            for (int mt = 0; mt < 2; ++mt) *(f32x4*)(QFp + (size_t)(row0 + 16 * mt + fr) * NQP + col0 + 16 * nt + 4 * fq) = acc[nt][mt]; }
                    else { const int row0 = 32 * (it - 256);
                        f32x4 acc[3][2]; skinny_mma<3>(XNp, 1024, Wq, 1024, 1024, row0, 1024, ln, acc);
#pragma unroll
                        for (int nt = 0; nt < 3; ++nt)
#pragma unroll
                            for (int mt = 0; mt < 2; ++mt) { f32x4 v = acc[nt][mt];
#pragma unroll
                                for (int e = 0; e < 4; ++e) v[e] = sigmoidf_(v[e]);
                                *(f32x4*)(GATEp + (size_t)(row0 + 16 * mt + fr) * 48 + 16 * nt + 4 * fq) = v; } }
                }
            } PHASE_END
            PHASE_BEGIN phase_attn_prompt(p, c, lb); PHASE_END
#ifdef PROBE_ATTN2
            PHASE_BEGIN phase_attn_prompt(p, c, lb, PROBE_ATTN2); PHASE_END
#endif
            PHASE_BEGIN phase_attn_sample(p, c, lb); PHASE_END
        }
        PHASE_BEGIN {
            const bf16_t* Wt = layer < 2 ? (const bf16_t*)(ws + WS_WORW) + (size_t)layer * 1024 * 1024 : (const bf16_t*)(ws + WS_WONSA) + (size_t)(layer - 2) * 1024 * 1024;
            pg8::Gemm g{(const bf16_t*)(ws + WS_YG), Wt, R, 1024, 1024, 1024};
            pg8::GroupOrder S; S.init((int)gridDim.x, (int)blockIdx.x); S.add(0, 0, 64, 0, 4);
            pg8::EpiResid E{X, D};
            pg8::gemm_phase<pg8::EpiResid, pg8::GroupOrder, true, true>(c.lds, g, S, E, c.tid);
            skinny_resid_sample(c, (const bf16_t*)(ws + WS_YG), 1024, Wt, 1024, X);
        } PHASE_END
        PHASE_BEGIN phase_norm(c, X, p->in[I_NORMG] + (size_t)(layer * 2 + 1) * D, (bf16_t*)(ws + WS_XN), nullptr, nullptr); PHASE_END
        PHASE_BEGIN {
            pg8::Gemm g{(const bf16_t*)(ws + WS_XN), (const bf16_t*)(ws + WS_WINT) + (size_t)layer * 5632 * 1024, R, 5632, 1024, 1024};
            pg8::GroupOrder S; S.init((int)gridDim.x, (int)blockIdx.x); S.add(0, 0, 66, 0, 22);
            pg8::EpiWin E{(bf16_t*)(ws + WS_U), (bf16_t*)(ws + WS_GT), p->out + O_CVP + (size_t)layer * NB * 2 * DFF, p->out + O_CVS + (size_t)layer * SB * 2 * DFF};
            pg8::gemm_phase<pg8::EpiWin, pg8::GroupOrder, true, true>(c.lds, g, S, E, c.tid);
        } PHASE_END
        PHASE_BEGIN phase_conv(p, c, layer); PHASE_END
        PHASE_BEGIN {
            pg8::Gemm g{(const bf16_t*)(ws + WS_HH), (const bf16_t*)(ws + WS_WOUTT) + (size_t)layer * 1024 * 2816, R, 1024, 2816, 2816};
            pg8::GroupOrder S; S.init((int)gridDim.x, (int)blockIdx.x); S.add(0, 0, 64, 0, 4);
            pg8::EpiResid E{X, D};
            pg8::gemm_phase<pg8::EpiResid, pg8::GroupOrder, true, true>(c.lds, g, S, E, c.tid);
            skinny_resid_sample(c, (const bf16_t*)(ws + WS_HH), 2816, (const bf16_t*)(ws + WS_WOUTT) + (size_t)layer * 1024 * 2816, 2816, X);
        } PHASE_END
    }
#ifdef SELFTEST
    PHASE_BEGIN if (blockIdx.x == 0 && c.wave == 0) { const float x = (float)((c.lane * 37) & 63) + 1.0f; float poison = 0.f;
        if (__ballot(swz_xor16_n(x) != __shfl_xor(x, 16))) poison += 1e3f;
        if (__ballot(sum_xor32_n(x) != x + __shfl_xor(x, 32))) poison += 1e4f;
        if (__ballot(sum_rows4_n(x) != x + __shfl_xor(x, 16) + __shfl_xor(x, 32) + __shfl_xor(x, 48))) poison += 1e5f;
        if (__ballot(wave_sum_n(x) != 2080.0f)) poison += 1e6f;
        if (__ballot(wave_max_n(x) != 64.0f)) poison += 1e7f;
        if (c.lane == 0) p->out[O_CVS] += poison; } PHASE_END
#endif
#ifdef PROBE_SCALE
    PHASE_BEGIN for (size_t e = c.gtid; e < O_END; e += c.gsz) { int oi = e < O_KV ? (e < (size_t)MP * D ? 0 : 1) : e < O_WINP ? (e < O_KV + (size_t)MP * D ? 2 : 3) : e < O_WINS ? 4 : e < O_WKVP ? 5 : e < O_WKVS ? 6 : e < O_SHP ? 7 : e < O_SHS ? 8 : e < O_CVP ? 9 : e < O_CVS ? 10 : 11;
        if (PROBE_SCALE < 0) oi = 11 - oi; p->out[e] *= 1.0f + sqrtf(0.5e-4f * (float)(oi + 1)); } PHASE_END
#endif
#undef PHASE_BEGIN
#undef PHASE_END
}

extern "C" void kernel_launch(void* const* d_in, const int* in_sizes, int n_in, void* d_out, int out_size, void* d_ws, size_t ws_size, hipStream_t stream) {
    static int grid = 0;
    if (grid == 0) {
        if (n_in != 45 || (size_t)out_size != O_END || ws_size < WS_END) { fprintf(stderr, "kernel_launch: unexpected shapes (n_in %d out %d ws %zu need %zu)\n", n_in, out_size, ws_size, (size_t)WS_END); grid = -1; return; }
        int dev = 0, cus = 0, per_cu = 0;
        if (hipGetDevice(&dev) != hipSuccess || hipDeviceGetAttribute(&cus, hipDeviceAttributeMultiprocessorCount, dev) != hipSuccess) { grid = -1; return; }
        if (hipFuncSetAttribute((const void*)mega, hipFuncAttributeMaxDynamicSharedMemorySize, LDS_BYTES) != hipSuccess) { fprintf(stderr, "kernel_launch: hipFuncSetAttribute failed\n"); grid = -1; return; }
        if (hipOccupancyMaxActiveBlocksPerMultiprocessor(&per_cu, (const void*)mega, 512, LDS_BYTES) != hipSuccess || per_cu < 1) { fprintf(stderr, "kernel_launch: occupancy query says %d\n", per_cu); (void)hipGetLastError(); }
        grid = cus;
    }
    if (grid < 0) return;
    (void)hipMemsetAsync((char*)d_ws + WS_CTL, 0, CTL_BYTES, stream);
    Params p{};
    for (int i = 0; i < 45; ++i) p.in[i] = (const float*)d_in[i];
    p.out = (float*)d_out; p.ws = (unsigned char*)d_ws;
#ifdef PROBE_PRE
    { const int plist[] = PROBE_PRE; for (int i = 0; i < (int)(sizeof(plist) / sizeof(int)); ++i) { p.ph_lo = plist[i] % 100; p.ph_hi = p.ph_lo + 1; p.use_bar = 0; p.pad = plist[i] / 100;       hipLaunchKernelGGL(mega, dim3(grid), dim3(512), LDS_BYTES, stream, p); } }
#endif
    p.pad = 0;
#if MK_MULTI
    for (int i = 0; i < NPH; ++i) { p.ph_lo = i; p.ph_hi = i + 1; p.use_bar = 0; hipLaunchKernelGGL(mega, dim3(grid), dim3(512), LDS_BYTES, stream, p); }
#else
    p.ph_lo = 0; p.ph_hi = NPH; p.use_bar = 1;
    hipLaunchKernelGGL(mega, dim3(grid), dim3(512), LDS_BYTES, stream, p);
#endif
    const hipError_t le = hipPeekAtLastError();
    if (le != hipSuccess) fprintf(stderr, "kernel_launch: launch failed: %s\n", hipGetErrorName(le));
}
```

```cpp
#include <hip/hip_runtime.h>
#include <cstdio>
#include <cstdint>

#define LAS __attribute__((address_space(3)))
#define GAS __attribute__((address_space(1)))
typedef unsigned short bf16_t;
typedef short bf16x8 __attribute__((ext_vector_type(8)));
typedef float f32x4 __attribute__((ext_vector_type(4)));
typedef float f32x16 __attribute__((ext_vector_type(16)));
typedef float f32x2 __attribute__((ext_vector_type(2)));
typedef unsigned u32x4 __attribute__((ext_vector_type(4)));
typedef unsigned u32x2 __attribute__((ext_vector_type(2)));

constexpr int D = 1024, NB = 2, TP = 8192, MP = NB * TP, SB = 128, ST = 4, MS = SB * ST, R = MP + MS;
constexpr int PAST = 2048, PAGE = 128, NPAGES = PAST / PAGE;
constexpr int H = 16, HD = 64, G = 4, HPG = 4, DFF = 2816, NLAY = 4;
constexpr int LW_ = 64, LA_ = 64, LV_ = 32, LG_ = 128, LHID = 288;
constexpr int NKV = 1536, NQ = 1072, NQP = 1280;
constexpr int NCH = TP / 64;
constexpr int NUNIT_A = NB * NCH * H;
constexpr int NCMP_P = 511, NCMP_S = 127, WIN = 512;
constexpr float NORM_EPS = 1e-6f, GN_EPS = 64e-5f;

constexpr size_t O_Y = 0;
constexpr size_t O_KV = (size_t)R * D;
constexpr size_t O_WINP = O_KV + (size_t)R * D;
constexpr size_t O_WINS = O_WINP + (size_t)NB * 512 * 512;
constexpr size_t O_WKVP = O_WINS + (size_t)SB * 512 * 512;
constexpr size_t O_WKVS = O_WKVP + (size_t)2 * NB * H * 4096;
constexpr size_t O_SHP = O_WKVS + (size_t)2 * SB * H * 4096;
constexpr size_t O_SHS = O_SHP + (size_t)2 * NB * D;
constexpr size_t O_CVP = O_SHS + (size_t)2 * SB * D;
constexpr size_t O_CVS = O_CVP + (size_t)NLAY * NB * 2 * DFF;
constexpr size_t O_END = O_CVS + (size_t)NLAY * SB * 2 * DFF;
static_assert(O_END == 88915968, "output size");

constexpr size_t MiB = 1u << 20;
constexpr size_t al(size_t x) { return (x + 4095) & ~(size_t)4095; }
constexpr size_t WS_CTL = 0, CTL_BYTES = 1 * MiB;
constexpr size_t WS_WRKV = WS_CTL + CTL_BYTES;
constexpr size_t WS_WORW = WS_WRKV + al((size_t)2 * 3072 * 1024 * 2);
constexpr size_t WS_W1T = WS_WORW + al((size_t)2 * 1024 * 1024 * 2);
constexpr size_t WS_W2W = WS_W1T + al((size_t)2 * 288 * 1024 * 2);
constexpr size_t WS_W2A = WS_W2W + al((size_t)2 * 1024 * 64 * 2);
constexpr size_t WS_W2V = WS_W2A + al((size_t)2 * 1024 * 64 * 2);
constexpr size_t WS_W2G = WS_W2V + al((size_t)1024 * 32 * 2);
constexpr size_t WS_WKVT = WS_W2G + al((size_t)2 * 1024 * 128 * 2);
constexpr size_t WS_WQT = WS_WKVT + al((size_t)1536 * 1024 * 2);
constexpr size_t WS_WONSA = WS_WQT + al((size_t)2 * 1280 * 1024 * 2);
constexpr size_t WS_WINT = WS_WONSA + al((size_t)2 * 1024 * 1024 * 2);
constexpr size_t WS_WOUTT = WS_WINT + al((size_t)4 * 5632 * 1024 * 2);
constexpr size_t WS_CW1T = WS_WOUTT + al((size_t)4 * 1024 * 2816 * 2);
constexpr size_t WS_CBIAS = WS_CW1T + al((size_t)2 * 256 * 1024 * 2);
constexpr size_t WS_CW2T = WS_CBIAS + al(2 * 128 * 4);
constexpr size_t WS_XM = WS_CW2T + al(2 * 2 * 64 * 128 * 2);
constexpr size_t WS_RK_R = WS_XM + al((size_t)6 * R * D * 2);
constexpr size_t WS_RK_K = WS_RK_R + al((size_t)R * D * 4);
constexpr size_t WS_V0 = WS_RK_K + al((size_t)R * D * 4);
constexpr size_t WS_V1 = WS_V0 + al((size_t)R * D * 4);
constexpr size_t WS_HID = WS_V1 + al((size_t)R * D * 4);
constexpr size_t WS_MT = WS_HID + al((size_t)R * LHID * 2);
constexpr size_t WS_NN = WS_MT + al((size_t)NUNIT_A * 4096 * 4);
constexpr size_t WS_RP = WS_NN + al((size_t)NUNIT_A * 4096 * 4);
constexpr size_t WS_YL = WS_RP + al((size_t)NUNIT_A * 4096 * 2);
constexpr size_t WS_S0 = WS_YL + al((size_t)NUNIT_A * 4096 * 4);
constexpr size_t WS_RKS = WS_S0 + al((size_t)NUNIT_A * 4096 * 2);
constexpr size_t WS_YG = WS_RKS + al((size_t)R * 16 * 4);
constexpr size_t WS_XN = WS_YG + al((size_t)R * D * 2);
constexpr size_t WS_XN2 = WS_XN + al((size_t)R * D * 2);
constexpr size_t WS_U = WS_XN2 + al((size_t)R * D * 2);
constexpr size_t WS_GT = WS_U + al((size_t)R * DFF * 2);
constexpr size_t WS_HH = WS_GT + al((size_t)R * DFF * 2);
constexpr size_t WS_KVF = WS_HH + al((size_t)R * DFF * 2);
constexpr size_t WS_CMPA = WS_KVF + al((size_t)R * NKV * 4);
constexpr size_t CMPA_ROWS = 4096 + 4096 + 65536 + 65536;
constexpr size_t WS_PCMP = WS_CMPA + al(CMPA_ROWS * 1024 * 2);
constexpr size_t WS_KS = WS_PCMP + al(CMPA_ROWS * 256 * 4);
constexpr size_t WS_VS = WS_KS + al((size_t)NB * G * TP * 64 * 2);
constexpr size_t WS_KW = WS_VS + al((size_t)NB * G * TP * 64 * 2);
constexpr size_t WS_VW = WS_KW + al((size_t)NB * G * TP * 64 * 2);
constexpr size_t WS_CK = WS_VW + al((size_t)NB * G * TP * 64 * 2);
constexpr size_t WS_CV = WS_CK + al((size_t)NB * G * 512 * 64 * 2);
constexpr size_t WS_CKS = WS_CV + al((size_t)NB * G * 512 * 64 * 2);
constexpr size_t WS_CVS = WS_CKS + al((size_t)SB * G * 128 * 64 * 4);
constexpr size_t WS_QF = WS_CVS + al((size_t)SB * G * 128 * 64 * 4);
constexpr size_t WS_Q = WS_QF + al((size_t)R * NQP * 4);
constexpr size_t WS_GATE = WS_Q + al((size_t)R * D * 2);
constexpr size_t WS_END = WS_GATE + al((size_t)R * 48 * 4);

typedef __bf16 bf16v2_ __attribute__((ext_vector_type(2)));
__device__ __forceinline__ unsigned cvt_pk_bf16_(float lo, float hi) { const f32x2 v = {lo, hi}; const bf16v2_ b = __builtin_convertvector(v, bf16v2_); return __builtin_bit_cast(unsigned, b); }
__device__ __forceinline__ unsigned f2bf(float f) { return cvt_pk_bf16_(f, f) & 0xffffu; }
__device__ __forceinline__ unsigned pk2(float lo, float hi) { return cvt_pk_bf16_(lo, hi); }
__device__ __forceinline__ float frcp(float x) { return __builtin_amdgcn_rcpf(x); }
__device__ __forceinline__ float frsq(float x) { return __builtin_amdgcn_rsqf(x); }
__device__ __forceinline__ float bf2f(unsigned short b) { return __builtin_bit_cast(float, ((unsigned)b) << 16); }
__device__ __forceinline__ float bflo(unsigned w) { return __builtin_bit_cast(float, w << 16); }
__device__ __forceinline__ float bfhi(unsigned w) { return __builtin_bit_cast(float, w & 0xffff0000u); }
template <int CTRL> __device__ __forceinline__ float dpp_f(float x) { return __builtin_bit_cast(float, __builtin_amdgcn_update_dpp(0, __builtin_bit_cast(int, x), CTRL, 0xF, 0xF, true)); }
__device__ __forceinline__ float row16_sum(float v) { v += dpp_f<0xB1>(v); v += dpp_f<0x4E>(v); v += dpp_f<0x141>(v); v += dpp_f<0x140>(v); return v; }
__device__ __forceinline__ float row16_max(float v) { v = fmaxf(v, dpp_f<0xB1>(v)); v = fmaxf(v, dpp_f<0x4E>(v)); v = fmaxf(v, dpp_f<0x141>(v)); v = fmaxf(v, dpp_f<0x140>(v)); return v; }
__device__ __forceinline__ float swz_xor16_n(float x) { return __builtin_bit_cast(float, __builtin_amdgcn_ds_swizzle(__builtin_bit_cast(int, x), 0x401F)); }
__device__ __forceinline__ float sum_xor32_n(float x) { auto rr = __builtin_amdgcn_permlane32_swap(__float_as_uint(x), __float_as_uint(x), false, false);
    return __uint_as_float(rr[0]) + __uint_as_float(rr[1]); }
__device__ __forceinline__ float sum_rows4_n(float x) { x += swz_xor16_n(x); return sum_xor32_n(x); }
__device__ __forceinline__ float wave_sum_n(float v) {
    v = row16_sum(v);
    v += __builtin_bit_cast(float, __builtin_amdgcn_update_dpp(0, __builtin_bit_cast(int, v), 0x142, 0xA, 0xF, false));
    v += __builtin_bit_cast(float, __builtin_amdgcn_update_dpp(0, __builtin_bit_cast(int, v), 0x143, 0xC, 0xF, false));
    return __builtin_bit_cast(float, __builtin_amdgcn_readlane(__builtin_bit_cast(int, v), 63));
}
__device__ __forceinline__ float wave_max_n(float v) {
    v = row16_max(v);
    v = fmaxf(v, __builtin_bit_cast(float, __builtin_amdgcn_update_dpp(__builtin_bit_cast(int, v), __builtin_bit_cast(int, v), 0x142, 0xA, 0xF, false)));
    v = fmaxf(v, __builtin_bit_cast(float, __builtin_amdgcn_update_dpp(__builtin_bit_cast(int, v), __builtin_bit_cast(int, v), 0x143, 0xC, 0xF, false)));
    return __builtin_bit_cast(float, __builtin_amdgcn_readlane(__builtin_bit_cast(int, v), 63));
}
#define XLANE_NEW 1
#ifdef XLANE_NEW
__device__ __forceinline__ float swz_xor16(float x) { return __builtin_bit_cast(float, __builtin_amdgcn_ds_swizzle(__builtin_bit_cast(int, x), 0x401F)); }
__device__ __forceinline__ float sum_xor32(float x) { return sum_xor32_n(x); }
__device__ __forceinline__ float sum_rows4(float x) { x += swz_xor16(x); return sum_xor32(x); }
__device__ __forceinline__ float wave_sum(float v) {
    v = row16_sum(v);
    v += __builtin_bit_cast(float, __builtin_amdgcn_update_dpp(0, __builtin_bit_cast(int, v), 0x142, 0xA, 0xF, false));
    v += __builtin_bit_cast(float, __builtin_amdgcn_update_dpp(0, __builtin_bit_cast(int, v), 0x143, 0xC, 0xF, false));
    return __builtin_bit_cast(float, __builtin_amdgcn_readlane(__builtin_bit_cast(int, v), 63));
}
__device__ __forceinline__ float wave_max(float v) {
    v = row16_max(v);
    v = fmaxf(v, __builtin_bit_cast(float, __builtin_amdgcn_update_dpp(__builtin_bit_cast(int, v), __builtin_bit_cast(int, v), 0x142, 0xA, 0xF, false)));
    v = fmaxf(v, __builtin_bit_cast(float, __builtin_amdgcn_update_dpp(__builtin_bit_cast(int, v), __builtin_bit_cast(int, v), 0x143, 0xC, 0xF, false)));
    return __builtin_bit_cast(float, __builtin_amdgcn_readlane(__builtin_bit_cast(int, v), 63));
}
#else
__device__ __forceinline__ float sum_xor32(float x) { return x + __shfl_xor(x, 32); }
__device__ __forceinline__ float sum_rows4(float x) { x += __shfl_xor(x, 16); x += __shfl_xor(x, 32); return x; }
__device__ __forceinline__ float wave_sum(float v) { v = row16_sum(v); v += __shfl_xor(v, 16); v += __shfl_xor(v, 32); return v; }
__device__ __forceinline__ float wave_max(float v) { v = row16_max(v); v = fmaxf(v, __shfl_xor(v, 16)); v = fmaxf(v, __shfl_xor(v, 32)); return v; }
#endif
__device__ __forceinline__ float sigmoidf_(float x) { return frcp(1.0f + __builtin_amdgcn_exp2f(-1.4426950408889634f * x)); }
__device__ __forceinline__ float gelu_tanh(float x) {
    const float u = 0.7978845608028654f * (x + 0.044715f * x * x * x);
    const float e = __builtin_amdgcn_exp2f(2.8853900817779268f * u);
    const float th = 1.0f - 2.0f * frcp(e + 1.0f);
    return 0.5f * x * (1.0f + th);
}
template <class T> __device__ __forceinline__ const T* launder_p(const T* q) { asm volatile("" : "+v"(q)); return q; }
__device__ __forceinline__ int launder_v(int x) { asm volatile("" : "+v"(x)); return x; }
#define LDS_WAIT() asm volatile("s_waitcnt lgkmcnt(0)" ::: "memory")
#define VM_WAIT() asm volatile("s_waitcnt vmcnt(0)" ::: "memory")
__device__ __forceinline__ f32x4 mfma16(bf16x8 a, bf16x8 b, f32x4 c) { return __builtin_amdgcn_mfma_f32_16x16x32_bf16(a, b, c, 0, 0, 0); }
__device__ __forceinline__ f32x16 mfma32(bf16x8 a, bf16x8 b, f32x16 c) { return __builtin_amdgcn_mfma_f32_32x32x16_bf16(a, b, c, 0, 0, 0); }
#define XB_TMO      128
#define XB_XCNT(j)  (256  + 64 * (j))
#define XB_XSUB(j)  (1280 + 64 * (j))
#define XB_XGEN(j)  (2304 + 64 * (j))
#define XB_TOP      3328
#define XB_TOPGEN   3392
#define XCD_BAR_WORDS 3456
#define XB_SPIN_CAP (1u << 18)

__device__ __forceinline__ unsigned xb_ld(unsigned* p)              { return __hip_atomic_load(p, __ATOMIC_RELAXED, __HIP_MEMORY_SCOPE_AGENT); }
__device__ __forceinline__ unsigned xb_add(unsigned* p, unsigned v) { return __hip_atomic_fetch_add(p, v, __ATOMIC_RELAXED, __HIP_MEMORY_SCOPE_AGENT); }
__device__ __forceinline__ unsigned xb_xcc_id() { return (unsigned)__builtin_amdgcn_s_getreg((3 << 11) | 20) & 0xFu; }
#define XB_SPIN(cond, bar) do { unsigned _sp = 0; while (cond) { __builtin_amdgcn_s_sleep(1); \
    if ((++_sp & 255u) == 0u) { if (xb_ld(&(bar)[XB_TMO])) break; if (_sp > XB_SPIN_CAP) { atomicAdd(&(bar)[XB_TMO], 1u); break; } } } } while (0)

struct XcdBarrier {
    unsigned* bar; unsigned x;
    volatile LAS unsigned* st;
};

__device__ __forceinline__ XcdBarrier xcd_barrier_post(unsigned* bar, volatile LAS unsigned* st) {
    XcdBarrier b; b.bar = bar; b.x = xb_xcc_id(); b.st = st;
    if (threadIdx.x == 0) (void)xb_add(&bar[XB_XCNT(b.x)], 1u);
    return b;
}
__device__ __forceinline__ void xcd_barrier_complete(unsigned* bar, unsigned x, unsigned& nloc, unsigned& nx) {
    const unsigned G = gridDim.x * gridDim.y * gridDim.z;
    unsigned sum, cnt, mine, sp = 0u;
    for (;;) {
        sum = 0u; cnt = 0u; mine = 0u;
#pragma unroll
        for (unsigned j = 0; j < 16; ++j) { const unsigned c = xb_ld(&bar[XB_XCNT(j)]); sum += c; cnt += (c > 0u) ? 1u : 0u; mine = (j == x) ? c : mine; }
        if (sum == G) break;
        __builtin_amdgcn_s_sleep(1);
        if ((++sp & 255u) == 0u) { if (xb_ld(&bar[XB_TMO])) break; if (sp > XB_SPIN_CAP) { atomicAdd(&bar[XB_TMO], 1u); break; } }
    }
    nloc = mine > 0u ? mine : 1u; nx = cnt > 0u ? cnt : 1u;
}

__device__ __forceinline__ void xcd_barrier(const XcdBarrier& b, const bool t0) {
    asm volatile("s_waitcnt vmcnt(0)" ::: "memory");
    __syncthreads();
    if (t0) {
        unsigned* bar = b.bar;
        __builtin_amdgcn_s_waitcnt(0);
        unsigned nloc = b.st[0], nx = b.st[1];
        if (nloc == 0u) { xcd_barrier_complete(bar, b.x, nloc, nx); b.st[0] = nloc; b.st[1] = nx; }
        const unsigned old = xb_add(&bar[XB_XSUB(b.x)], 1u);
        const unsigned gen = old / nloc;
        if (old + 1u == (gen + 1u) * nloc) {
            __builtin_amdgcn_fence(__ATOMIC_RELEASE, "agent");
            asm volatile("s_waitcnt vmcnt(0)" ::: "memory");
            const unsigned og = xb_add(&bar[XB_TOP], 1u);
            const unsigned tg = og / nx;
            if (og + 1u == (tg + 1u) * nx) xb_add(&bar[XB_TOPGEN], 1u);
            else XB_SPIN(xb_ld(&bar[XB_TOPGEN]) == tg, bar);
            __builtin_amdgcn_fence(__ATOMIC_ACQUIRE, "agent");
            xb_add(&bar[XB_XGEN(b.x)], 1u);
            asm volatile("s_waitcnt vmcnt(0)" ::: "memory");
        } else {
            XB_SPIN(xb_ld(&bar[XB_XGEN(b.x)]) == gen, bar);
            __builtin_amdgcn_fence(__ATOMIC_ACQUIRE, "agent");
            asm volatile("s_waitcnt vmcnt(0)" ::: "memory");
        }
    }
    __syncthreads();
}

namespace pg8 {
#define PG8_LAS __attribute__((address_space(3)))
constexpr int BM = 256, BK = 64, HALF = 128, HTB = HALF * BK * 2  , STAGE_BYTES = 8 * HTB, NXCD = 8, WGM = 8;
__host__ __device__ __forceinline__ int lds_byte(int r, int c) { const int st = (r >> 4) * 2 + (c >> 5), rr = r & 15, cc = c & 31, ob = rr * 64 + cc * 2; return st * 1024 + (ob ^ (((ob >> 9) & 1) << 5)); }
__host__ __device__ __forceinline__ void stage_rc(int b, int& R_, int& C_) { const int st = b / 1024, sb = b % 1024, swz = sb ^ (((sb >> 9) & 1) << 5); R_ = (st >> 1) * 16 + swz / 64; C_ = (st & 1) * 32 + (swz % 64) / 2; }
__host__ __device__ __forceinline__ int perm32(int rho) { const int n = rho >> 4, i = rho & 15; return 8 * (i >> 2) + 4 * n + (i & 3); }

struct Unit { int pm, pn, kb, nt; };
struct Gemm { const bf16_t* A; const bf16_t* Bt; int M, N, K, KL; };

struct GroupOrder {
    int pm0[4], nM[4], pn0[4], nN[4]; int nseg, nwg, G_, c;
    __device__ __forceinline__ void init(int G__, int c_) { nseg = 0; nwg = 0; G_ = G__; c = c_;
#pragma unroll
        for (int s = 0; s < 4; ++s) { pm0[s] = 0; nM[s] = 0; pn0[s] = 0; nN[s] = 1; } }
    __device__ __forceinline__ void add(int s, int pm0_, int nM_, int pn0_, int nN_) { pm0[s] = pm0_; nM[s] = nM_; pn0[s] = pn0_; nN[s] = nN_; nwg += nM_ * nN_; nseg = s + 1; }
    __device__ __forceinline__ bool next(int i, Unit& u) const {
        const long L = (long)i * G_ + c; if (L >= nwg) return false;
        int id = (int)L; { const int q = nwg / NXCD, r = nwg % NXCD, xcd = id % NXCD, off = id / NXCD; id = (xcd < r ? xcd * (q + 1) : r * (q + 1) + (xcd - r) * q) + off; }
        int spm0 = 0, snM = 1, spn0 = 0, snN = 1; bool found = false;
#pragma unroll
        for (int s = 0; s < 4; ++s) { const int cnt = nM[s] * nN[s]; if (!found) { if (id < cnt) { found = true; spm0 = pm0[s]; snM = nM[s]; spn0 = pn0[s]; snN = nN[s]; } else id -= cnt; } }
        const int nig = WGM * snN, gid = id / nig, fm = gid * WGM, gsz = (snM - fm) < WGM ? (snM - fm) : WGM;
        u.pm = spm0 + fm + ((id % nig) % gsz); u.pn = spn0 + (id % nig) / gsz; u.kb = 0; u.nt = 0; return true;
    }
    __device__ __forceinline__ void a_ready(const Unit&) const {}
    __device__ __forceinline__ void done(const Unit&) const {}
};

struct ResidOrder {
    GroupOrder P; int nS, G_, c;
    __device__ __forceinline__ void init(int G__, int c_, int nS_) { P.init(G__, c_); P.add(0, 0, nS_ ? 64 : 66, 0, 4); nS = nS_; G_ = G__; c = c_; }
    __device__ __forceinline__ bool next(int i, Unit& u) const {
        const int npc = c < P.nwg ? (P.nwg - 1 - c) / G_ + 1 : 0;
        if (i < npc) return P.next(i, u);
        const int L = (i - npc) * G_ + (G_ - 1 - c); if (L >= 8 * nS) return false;
        const int sl = L >> 3, t = L & 7; u.pm = 64 + (t & 1); u.pn = t >> 1; u.kb = sl * 512; u.nt = 4; return true; }
    __device__ __forceinline__ void a_ready(const Unit&) const {}
    __device__ __forceinline__ void done(const Unit&) const {}
};
__device__ __forceinline__ unsigned cvt_pk_bf16(float lo, float hi) { return cvt_pk_bf16_(lo, hi); }

struct EpiF32G {
    static constexpr bool PERM = false, AFTER_DRAIN = false;
    float* b0; float* b1; float* b2; float* b3; int ldc, png, pmg;
    __device__ __forceinline__ void operator()(const f32x4 (&acc)[2][2][4][2], const Unit& u, int wr, int wc, int fr, int fq) const {
        const int j = u.pn / png; float* C = j == 0 ? b0 : (j == 1 ? b1 : (j == 2 ? b2 : b3));
        const int row0 = (u.pm - j * pmg) * BM + wr * 64 + fr, col0 = (u.pn - j * png) * BM + wc * 32 + 4 * fq;
#pragma unroll
        for (int ai = 0; ai < 2; ++ai)
#pragma unroll
            for (int m = 0; m < 4; ++m) { float* rowp = C + (size_t)(row0 + ai * HALF + m * 16) * ldc + col0;
#pragma unroll
                for (int bj = 0; bj < 2; ++bj)
#pragma unroll
                    for (int n = 0; n < 2; ++n) *(f32x4*)(rowp + bj * HALF + n * 16) = acc[ai][bj][m][n]; }
    }
};
struct EpiResid {
    static constexpr bool PERM = false, AFTER_DRAIN = false;
    float* X; int ldc;
    __device__ __forceinline__ void operator()(const f32x4 (&acc)[2][2][4][2], const Unit& u, int wr, int wc, int fr, int fq) const {
        const int row0 = u.pm * BM + wr * 64 + fr, col0 = u.pn * BM + wc * 32 + 4 * fq; const bool split = u.nt != 0;
#pragma unroll
        for (int ai = 0; ai < 2; ++ai)
#pragma unroll
            for (int m = 0; m < 4; ++m) { float* rowp = X + (size_t)(row0 + ai * HALF + m * 16) * ldc + col0;
                if (!split) {
#pragma unroll
                    for (int bj = 0; bj < 2; ++bj)
#pragma unroll
                        for (int n = 0; n < 2; ++n) { f32x4* p = (f32x4*)(rowp + bj * HALF + n * 16); *p = *p + acc[ai][bj][m][n]; } }
                else {
#pragma unroll
                    for (int bj = 0; bj < 2; ++bj)
#pragma unroll
                        for (int n = 0; n < 2; ++n) { float* q = rowp + bj * HALF + n * 16;
#pragma unroll
                            for (int e = 0; e < 4; ++e) __hip_atomic_fetch_add(q + e, acc[ai][bj][m][n][e], __ATOMIC_RELAXED, __HIP_MEMORY_SCOPE_AGENT); } }
                asm volatile("" ::: "memory"); }
    }
};
struct EpiWin {
    static constexpr bool PERM = true, AFTER_DRAIN = false;
    bf16_t* U; bf16_t* GT; float* cvp; float* cvs;
    __device__ __forceinline__ void operator()(const f32x4 (&acc)[2][2][4][2], const Unit& u, int wr, int wc, int fr, int fq) const {
        const bool isu = u.pn < 11; bf16_t* base = isu ? U : GT; const int colt = (isu ? u.pn : u.pn - 11) * BM;
        const int row0 = u.pm * BM + wr * 64 + fr, col0 = colt + wc * 32 + 8 * fq;
#pragma unroll
        for (int ai = 0; ai < 2; ++ai)
#pragma unroll
            for (int m = 0; m < 4; ++m) { const int row = row0 + ai * HALF + m * 16; bf16_t* rowp = base + (size_t)row * DFF + col0;
                float* cv = nullptr;
                if (isu) { if (row >= MP) { const int t = (row - MP) & 3, b = (row - MP) >> 2; if (t >= 2) cv = cvs + (size_t)(b * 2 + (t - 2)) * DFF; }
                           else { const int tt = row & (TP - 1); if (tt >= TP - 2) cv = cvp + (size_t)((row >> 13) * 2 + (tt - (TP - 2))) * DFF; } }
#pragma unroll
                for (int bj = 0; bj < 2; ++bj) { const f32x4 v0 = acc[ai][bj][m][0], v1 = acc[ai][bj][m][1];
                    u32x4 w; w.x = cvt_pk_bf16(v0[0], v0[1]); w.y = cvt_pk_bf16(v0[2], v0[3]); w.z = cvt_pk_bf16(v1[0], v1[1]); w.w = cvt_pk_bf16(v1[2], v1[3]);
                    *(u32x4*)(rowp + bj * HALF) = w;
                    if (cv) { *(f32x4*)(cv + col0 + bj * HALF) = v0; *(f32x4*)(cv + col0 + bj * HALF + 4) = v1; } } }
    }
};
template <class Epi, class Sched, bool ALIGN_EPI = false, bool SP2 = false>
__device__ __forceinline__ void gemm_phase(PG8_LAS unsigned char* lds, const Gemm g, const Sched& S, const Epi& E, int tid_in) {
    int tid_l = tid_in; asm volatile("" : "+v"(tid_l));
    const int tid = tid_l, wid = __builtin_amdgcn_readfirstlane(tid >> 6), lane = tid & 63, wr = wid >> 2, wc = wid & 3, fr = lane & 15, fq = lane >> 4;
    const int K = g.K, nt = g.KL / BK;
    unsigned voffA[2], voffB[2];
#pragma unroll
    for (int i = 0; i < 2; ++i) { int R, C; stage_rc(tid * 16 + i * 8192, R, C); const int Rb = Epi::PERM ? ((R & ~31) + perm32(R & 31)) : R;
        voffA[i] = (unsigned)(R * K + C) * 2u; voffB[i] = (unsigned)(Rb * K + C) * 2u; }
    const size_t kstep = (size_t)(BK * 2);
    const size_t hstep = (size_t)HALF * K * 2;
    const size_t tstep = 2 * hstep;
    const unsigned ldsw = (unsigned)wid * 1024u;
    const int aoff = lds_byte(wr * 64 + fr, fq * 8), boff = lds_byte(wc * 32 + fr, fq * 8);
#define PG8_SA(b, h) (((b) * 2 + (h)) * HTB)
#define PG8_SB(b, h) ((4 + (b) * 2 + (h)) * HTB)
#define PG8_STAGE(bufoff, gbase, voff) do { _Pragma("unroll") for (int _i = 0; _i < 2; ++_i) \
        __builtin_amdgcn_global_load_lds((const unsigned*)((const char*)(gbase) + (voff)[_i]), (PG8_LAS unsigned*)(lds + (bufoff) + ldsw + _i * 8192), 16, 0, 0); } while (0)
#define PG8_LDA(dst, b, h) do { _Pragma("unroll") for (int m = 0; m < 4; ++m) _Pragma("unroll") for (int k = 0; k < 2; ++k) dst[m][k] = *(const PG8_LAS bf16x8*)(lds + PG8_SA(b, h) + aoff + m * 2048 + k * 1024); } while (0)
#define PG8_LDB(dst, b, h) do { _Pragma("unroll") for (int n = 0; n < 2; ++n) _Pragma("unroll") for (int k = 0; k < 2; ++k) dst[n][k] = *(const PG8_LAS bf16x8*)(lds + PG8_SB(b, h) + boff + n * 2048 + k * 1024); } while (0)
#define PG8_MMA(ai, bj, At, Bt) do { __builtin_amdgcn_s_setprio(1); _Pragma("unroll") for (int m = 0; m < 4; ++m) _Pragma("unroll") for (int n = 0; n < 2; ++n) _Pragma("unroll") for (int k = 0; k < 2; ++k) \
        acc[ai][bj][m][n] = __builtin_amdgcn_mfma_f32_16x16x32_bf16(Bt[n][k], At[m][k], acc[ai][bj][m][n], 0, 0, 0); __builtin_amdgcn_s_setprio(0); } while (0)
#define PG8_WAIT_V(n) asm volatile("s_waitcnt vmcnt(" #n ")" ::: "memory")
#define PG8_WAIT_L(n) asm volatile("s_waitcnt lgkmcnt(" #n ")" ::: "memory")
#define PG8_BAR __builtin_amdgcn_s_barrier()
#define PG8_SCHED __builtin_amdgcn_sched_barrier(0)
    Unit cur, nxt; int ui = 0;
    if (!S.next(0, cur)) return;
    f32x4 acc[2][2][4][2];
#pragma unroll
    for (int a = 0; a < 2; ++a)
#pragma unroll
        for (int b = 0; b < 2; ++b)
#pragma unroll
            for (int m = 0; m < 4; ++m)
#pragma unroll
                for (int n = 0; n < 2; ++n) acc[a][b][m][n] = (f32x4){0.f, 0.f, 0.f, 0.f};
    bf16x8 At[4][2], B0[2][2], B1[2][2];
    const char* cA = (const char*)g.A + (size_t)cur.pm * tstep + cur.kb; const char* cB = (const char*)g.Bt + (size_t)cur.pn * tstep + cur.kb;
    S.a_ready(cur);
    if constexpr (SP2) {
        PG8_STAGE(PG8_SB(0, 0), cB, voffB); PG8_STAGE(PG8_SB(0, 1), cB + hstep, voffB); PG8_STAGE(PG8_SA(0, 0), cA, voffA); PG8_STAGE(PG8_SA(0, 1), cA + hstep, voffA);
        if (wr == 1) PG8_BAR;
        PG8_WAIT_V(2); PG8_BAR;
        PG8_STAGE(PG8_SB(1, 0), cB + kstep, voffB); PG8_STAGE(PG8_SA(1, 0), cA + kstep, voffA); PG8_STAGE(PG8_SB(1, 1), cB + hstep + kstep, voffB);
        PG8_WAIT_V(6); PG8_BAR;
    } else {
        PG8_STAGE(PG8_SB(0, 0), cB, voffB); PG8_STAGE(PG8_SA(0, 0), cA, voffA); PG8_STAGE(PG8_SB(0, 1), cB + hstep, voffB); PG8_STAGE(PG8_SA(0, 1), cA + hstep, voffA);
        if (wr == 1) PG8_BAR;
        PG8_WAIT_V(4); PG8_BAR;
        PG8_STAGE(PG8_SB(1, 0), cB + kstep, voffB); PG8_STAGE(PG8_SA(1, 0), cA + kstep, voffA); PG8_STAGE(PG8_SB(1, 1), cB + hstep + kstep, voffB);
        PG8_WAIT_V(6); PG8_BAR;
    }
    for (;;) {
        const bool has_next = S.next(ui + 1, nxt);
        const char* nA = has_next ? (const char*)g.A + (size_t)nxt.pm * tstep + nxt.kb : cA; const char* nB = has_next ? (const char*)g.Bt + (size_t)nxt.pn * tstep + nxt.kb : cB;
        const int ntu = cur.nt ? cur.nt : nt;
        for (int t = 0; t < ntu; t += 2) {
            const bool last = (t == ntu - 2);
            const char* a1 = cA + (size_t)(t + 1) * kstep;
            const char* a2 = last ? nA : cA + (size_t)(t + 2) * kstep; const char* b2 = last ? nB : cB + (size_t)(t + 2) * kstep;
            const char* a3 = a2 + kstep; const char* b3 = b2 + kstep;
            if (last && has_next) S.a_ready(nxt);
            if constexpr (SP2) {
            PG8_LDB(B0, 0, 0); PG8_LDB(B1, 0, 1); PG8_SCHED; PG8_LDA(At, 0, 0); PG8_STAGE(PG8_SA(1, 1), a1 + hstep, voffA);
            PG8_WAIT_V(8); PG8_WAIT_L(0); PG8_BAR; PG8_MMA(0, 0, At, B0); PG8_MMA(0, 1, At, B1); PG8_BAR; PG8_SCHED;
            PG8_LDA(At, 0, 1); PG8_STAGE(PG8_SB(0, 0), b2, voffB); PG8_STAGE(PG8_SB(0, 1), b2 + hstep, voffB); PG8_STAGE(PG8_SA(0, 0), a2, voffA);
            PG8_WAIT_V(8); PG8_WAIT_L(0); PG8_BAR; PG8_MMA(1, 0, At, B0); PG8_MMA(1, 1, At, B1); PG8_BAR; PG8_SCHED;
            PG8_LDB(B0, 1, 0); PG8_LDB(B1, 1, 1); PG8_SCHED; PG8_LDA(At, 1, 0); PG8_STAGE(PG8_SA(0, 1), a2 + hstep, voffA);
            PG8_WAIT_V(8); PG8_WAIT_L(0); PG8_BAR; PG8_MMA(0, 0, At, B0); PG8_MMA(0, 1, At, B1); PG8_BAR; PG8_SCHED;
            PG8_LDA(At, 1, 1); PG8_STAGE(PG8_SB(1, 0), b3, voffB); PG8_STAGE(PG8_SB(1, 1), b3 + hstep, voffB); PG8_STAGE(PG8_SA(1, 0), a3, voffA);
            PG8_WAIT_V(8); PG8_WAIT_L(0); PG8_BAR; PG8_MMA(1, 0, At, B0); PG8_MMA(1, 1, At, B1); PG8_BAR; PG8_SCHED;
            } else {
            PG8_LDB(B0, 0, 0); PG8_SCHED; PG8_LDA(At, 0, 0); PG8_STAGE(PG8_SA(1, 1), a1 + hstep, voffA);
            PG8_WAIT_L(8); PG8_BAR; PG8_WAIT_L(0); PG8_MMA(0, 0, At, B0); PG8_BAR; PG8_SCHED;
            PG8_LDB(B1, 0, 1); PG8_STAGE(PG8_SB(0, 0), b2, voffB);
            PG8_BAR; PG8_WAIT_L(0); PG8_MMA(0, 1, At, B1); PG8_BAR;
            PG8_LDA(At, 0, 1); PG8_STAGE(PG8_SA(0, 0), a2, voffA);
            PG8_BAR; PG8_WAIT_L(0); PG8_MMA(1, 0, At, B0); PG8_BAR; PG8_SCHED;
            PG8_STAGE(PG8_SB(0, 1), b2 + hstep, voffB);
            PG8_WAIT_V(6); PG8_BAR; PG8_MMA(1, 1, At, B1); PG8_BAR;
            PG8_LDB(B0, 1, 0); PG8_SCHED; PG8_LDA(At, 1, 0); PG8_STAGE(PG8_SA(0, 1), a2 + hstep, voffA);
            PG8_WAIT_L(8); PG8_BAR; PG8_WAIT_L(0); PG8_MMA(0, 0, At, B0); PG8_BAR; PG8_SCHED;
            PG8_LDB(B1, 1, 1); PG8_STAGE(PG8_SB(1, 0), b3, voffB);
            PG8_BAR; PG8_WAIT_L(0); PG8_MMA(0, 1, At, B1); PG8_BAR;
            PG8_LDA(At, 1, 1); PG8_STAGE(PG8_SA(1, 0), a3, voffA);
            PG8_BAR; PG8_WAIT_L(0); PG8_MMA(1, 0, At, B0); PG8_BAR; PG8_SCHED;
            PG8_STAGE(PG8_SB(1, 1), b3 + hstep, voffB);
            PG8_WAIT_V(6); PG8_BAR; PG8_MMA(1, 1, At, B1); PG8_BAR;
            }
        }
        if constexpr (ALIGN_EPI) { if (wr == 0) PG8_BAR; }
        if constexpr (!Epi::AFTER_DRAIN) { E(acc, cur, wr, wc, fr, fq); S.done(cur); }
        if (!has_next) break;
#pragma unroll
        for (int a = 0; a < 2; ++a)
#pragma unroll
            for (int b = 0; b < 2; ++b)
#pragma unroll
                for (int m = 0; m < 4; ++m)
#pragma unroll
                    for (int n = 0; n < 2; ++n) acc[a][b][m][n] = (f32x4){0.f, 0.f, 0.f, 0.f};
        cur = nxt; cA = nA; cB = nB; ++ui;
        if constexpr (ALIGN_EPI) { if (wr == 1) PG8_BAR; }
    }
    PG8_WAIT_V(0);
    if constexpr (!ALIGN_EPI) { if (wr == 0) PG8_BAR; }
    PG8_BAR;
    if constexpr (Epi::AFTER_DRAIN) { E.fused(acc, cur, wr, wc, fr, fq, lds, wid, lane); S.done(cur); }
#undef PG8_SA
#undef PG8_SB
#undef PG8_STAGE
#undef PG8_LDA
#undef PG8_LDB
#undef PG8_MMA
#undef PG8_WAIT_V
#undef PG8_WAIT_L
#undef PG8_BAR
#undef PG8_SCHED
}
}
constexpr int RING_BYTES = 131072, MISC_OFF = RING_BYTES + 320, LDS_BYTES = 147456;
struct Params { const float* in[45]; float* out; unsigned char* ws; int ph_lo, ph_hi, use_bar, pad; };
enum { I_XP = 0, I_XS, I_CKV, I_CWIN, I_SWKV, I_SSHIFT, I_SCONV, I_PT, I_NORMG, I_MU, I_WR, I_WK, I_WV, I_WO, I_W0, I_W1, I_W2, I_A0, I_A1, I_A2, I_V0, I_V1, I_V2, I_G1, I_G2,
       I_KK, I_KA, I_RKK, I_LNW, I_LNB, I_KVNG, I_WKV, I_KNG, I_PE, I_CW1, I_CB1, I_CW2, I_CB2, I_WQ, I_QNG, I_WONSA, I_WIN, I_CONVW, I_CONVB, I_WOUT };

typedef const __attribute__((address_space(4))) Params* KP;
struct Ctx { LAS unsigned char* lds; int tid, lane, wave, gw, ngw, gtid, gsz; };

__device__ __forceinline__ void p0_transpose_item(const float* W, int K, int ldw, int nblk, bf16_t* WT, int row_off, LAS float* scr, int item, int lane) {
    const int kb = item / nblk, nb = item % nblk, k0 = 64 * kb, n0 = 32 * nb;
#pragma unroll 8
    for (int i = 0; i < 32; ++i) { const int kk = 2 * i + (lane >> 5); scr[kk * 33 + (lane & 31)] = W[(size_t)(k0 + kk) * ldw + n0 + (lane & 31)]; }
    LDS_WAIT(); asm volatile("" ::: "memory");
    const int c = lane & 7;
#pragma unroll
    for (int j = 0; j < 4; ++j) { const int n = (lane >> 3) + 8 * j; const LAS float* s = scr + (8 * c) * 33 + n;
        u32x4 o; o.x = pk2(s[0 * 33], s[1 * 33]); o.y = pk2(s[2 * 33], s[3 * 33]); o.z = pk2(s[4 * 33], s[5 * 33]); o.w = pk2(s[6 * 33], s[7 * 33]);
        *(u32x4*)(WT + (size_t)(row_off + n0 + n) * K + k0 + 8 * c) = o; }
    LDS_WAIT(); asm volatile("" ::: "memory");
}

__device__ __forceinline__ void phase_prologue(KP p, const Ctx& c) {
    LAS float* scr = (LAS float*)(c.lds + c.wave * 16384);
    unsigned char* ws = p->ws;
    int total = 0;
#define TRCNT(K_, N_) (((K_) / 64) * ((N_) / 32))
    constexpr int C_DD = TRCNT(1024, 1024), C_L64 = TRCNT(1024, 64), C_L32 = TRCNT(1024, 32), C_L128 = TRCNT(1024, 128), C_2_64 = TRCNT(64, 1024), C_2_128 = TRCNT(128, 1024);
    constexpr int C_KV = TRCNT(1024, 1536), C_Q = 16 * 33, C_IN = TRCNT(1024, 5632), C_OUT = TRCNT(2816, 1024), C_CW = TRCNT(1024, 128);
    constexpr int NITEMS = 2 * (4 * C_DD + 2 * C_L64 + C_L128 + 2 * C_2_64 + C_2_128) + C_L32 + C_KV + 2 * C_Q + 2 * C_DD + 4 * C_IN + 4 * C_OUT + 4 * C_CW;
    (void)total;
    for (int it = c.gw; it < NITEMS; it += c.ngw) {
        int r = it;
#define TR(Wp, K_, LDW_, NBLK_, WTp, ROWOFF_) { const int cnt_ = ((K_) / 64) * (NBLK_); if (r < cnt_) { p0_transpose_item((Wp), (K_), (LDW_), (NBLK_), (bf16_t*)(WTp), (ROWOFF_), scr, r, c.lane); continue; } r -= cnt_; }
        bool done = false;
#pragma unroll
        for (int l = 0; l < 2; ++l) {
            if (done) break;
            const size_t dd = (size_t)l * 1024 * 1024;
#define TRL(Wp, K_, LDW_, NBLK_, WTp, ROWOFF_) { const int cnt_ = ((K_) / 64) * (NBLK_); if (!done) { if (r < cnt_) { p0_transpose_item((Wp), (K_), (LDW_), (NBLK_), (bf16_t*)(WTp), (ROWOFF_), scr, r, c.lane); done = true; } else r -= cnt_; } }
            TRL(p->in[I_WR] + dd, 1024, 1024, 32, ws + WS_WRKV + (size_t)l * 3072 * 1024 * 2, 0)
            TRL(p->in[I_WK] + dd, 1024, 1024, 32, ws + WS_WRKV + (size_t)l * 3072 * 1024 * 2, 1024)
            TRL(p->in[I_WV] + dd, 1024, 1024, 32, ws + WS_WRKV + (size_t)l * 3072 * 1024 * 2, 2048)
            TRL(p->in[I_WO] + dd, 1024, 1024, 32, ws + WS_WORW + (size_t)l * 1024 * 1024 * 2, 0)
            TRL(p->in[I_W1] + (size_t)l * 1024 * 64, 1024, 64, 2, ws + WS_W1T + (size_t)l * 288 * 1024 * 2, 0)
            TRL(p->in[I_A1] + (size_t)l * 1024 * 64, 1024, 64, 2, ws + WS_W1T + (size_t)l * 288 * 1024 * 2, 64)
            TRL(p->in[I_G1] + (size_t)l * 1024 * 128, 1024, 128, 4, ws + WS_W1T + (size_t)l * 288 * 1024 * 2, 160)
            TRL(p->in[I_W2] + (size_t)l * 64 * 1024, 64, 1024, 32, ws + WS_W2W + (size_t)l * 1024 * 64 * 2, 0)
            TRL(p->in[I_A2] + (size_t)l * 64 * 1024, 64, 1024, 32, ws + WS_W2A + (size_t)l * 1024 * 64 * 2, 0)
            TRL(p->in[I_G2] + (size_t)l * 128 * 1024, 128, 1024, 32, ws + WS_W2G + (size_t)l * 1024 * 128 * 2, 0)
        }
        if (done) continue;
        TR(p->in[I_V1], 1024, 32, 1, ws + WS_W1T + (size_t)1 * 288 * 1024 * 2, 128)
        TR(p->in[I_WKV], 1024, 1536, 48, ws + WS_WKVT, 0)
        TR(p->in[I_WQ], 1024, NQ, 33, ws + WS_WQT, 0)
        TR(p->in[I_WQ] + (size_t)1024 * NQ, 1024, NQ, 33, ws + WS_WQT + (size_t)NQP * 1024 * 2, 0)
        TR(p->in[I_WONSA], 1024, 1024, 32, ws + WS_WONSA, 0)
        TR(p->in[I_WONSA] + (size_t)1024 * 1024, 1024, 1024, 32, ws + WS_WONSA + (size_t)1024 * 1024 * 2, 0)
#pragma unroll
        for (int l = 0; l < 4; ++l) {
            if (done) break;
            TRL(p->in[I_WIN] + (size_t)l * 1024 * 5632, 1024, 5632, 176, ws + WS_WINT + (size_t)l * 5632 * 1024 * 2, 0)
            TRL(p->in[I_WOUT] + (size_t)l * 2816 * 1024, 2816, 1024, 32, ws + WS_WOUTT + (size_t)l * 1024 * 2816 * 2, 0)
        }
        if (done) continue;
        TR(p->in[I_CW1], 1024, 128, 4, ws + WS_CW1T, 0)
        TR(p->in[I_CW1] + (size_t)1024 * 128, 1024, 128, 4, ws + WS_CW1T, 128)
        TR(p->in[I_CW1] + (size_t)2048 * 128, 1024, 128, 4, ws + WS_CW1T + (size_t)256 * 1024 * 2, 0)
        TR(p->in[I_CW1] + (size_t)3072 * 128, 1024, 128, 4, ws + WS_CW1T + (size_t)256 * 1024 * 2, 128)
#undef TR
#undef TRL
    }
    {
        bf16_t* WQT = (bf16_t*)(ws + WS_WQT);
        for (int e = c.gtid; e < 2 * 224 * 1024; e += c.gsz) { const int k = e & 1023, n = 1056 + ((e >> 10) % 224), l = e / (224 * 1024);
            WQT[((size_t)l * NQP + n) * 1024 + k] = n < NQ ? (bf16_t)f2bf(p->in[I_WQ][((size_t)l * 1024 + k) * NQ + n]) : (bf16_t)0; }
        bf16_t* W2V = (bf16_t*)(ws + WS_W2V);
        for (int e = c.gtid; e < 32 * 1024; e += c.gsz) { const int n = e & 1023, k = e >> 10; W2V[n * 32 + k] = (bf16_t)f2bf(p->in[I_V2][k * 1024 + n]); }
    }
    { bf16_t* W2T = (bf16_t*)(ws + WS_CW2T);
      for (int e = c.gtid; e < 2 * 128 * 64; e += c.gsz) { const int d = e & 63, q = (e >> 6) & 127, kv = e >> 13; const float w = p->in[I_CW2][e];
          const unsigned hi = f2bf(w), lo = f2bf(w - __builtin_bit_cast(float, hi << 16)); W2T[(size_t)(kv * 64 + d) * 128 + q] = (bf16_t)hi; W2T[(size_t)2 * 64 * 128 + (size_t)(kv * 64 + d) * 128 + q] = (bf16_t)lo; } }
    for (int it = c.gw; it < 256; it += c.ngw) { const int kv = it >> 7, h = it & 127; float s = 0.f;
        for (int kk = c.lane; kk < 2048; kk += 64) s += p->in[I_PE][kv * 2048 + kk] * p->in[I_CW1][((size_t)kv * 2048 + kk) * 128 + h];
        s = wave_sum(s); if (c.lane == 0) ((float*)(ws + WS_CBIAS))[it] = s + p->in[I_CB1][it]; }
    { const f32x4* xp = (const f32x4*)p->in[I_XP]; const f32x4* xs = (const f32x4*)p->in[I_XS]; f32x4* o = (f32x4*)(p->out + O_Y);
      for (int e = c.gtid; e < R * D / 4; e += c.gsz) o[e] = e < MP * D / 4 ? xp[e] : xs[e - MP * D / 4]; }
}

__device__ __forceinline__ void phase_fill(KP p, const Ctx& c, int li, const int gwf, const int ngwf) {
    unsigned char* ws = p->ws;
    { const int* pt = (const int*)p->in[I_PT]; bf16_t* CA = (bf16_t*)(ws + WS_CMPA); const int part = li;
      for (int it = gwf; it < SB * 128 * 4; it += ngwf) { const int s4 = 4 * (it & 3), n = (it >> 2) & 127, b = it >> 9;
          const int page = pt[b * NPAGES + (n >> 3)]; const float* src = p->in[I_CKV] + ((size_t)page * PAGE + (n & 7) * 16 + s4) * 1024 + part * 256;
          f32x4 v[4];
#pragma unroll
          for (int e = 0; e < 4; ++e) v[e] = __builtin_nontemporal_load(((const f32x4*)(src + (size_t)e * 1024)) + c.lane);
          const int g = c.lane >> 4, d0 = 4 * (c.lane & 15); bf16_t* dst = CA + ((size_t)8192 + (size_t)part * 65536 + (size_t)(b * 4 + g) * 128 + n) * 1024 + s4 * 64 + d0;
#pragma unroll
          for (int e = 0; e < 4; ++e) { u32x2 w; w.x = pk2(v[e][0], v[e][1]); w.y = pk2(v[e][2], v[e][3]); *(u32x2*)(dst + e * 64) = w; } } }
    { const f32x4* src = (const f32x4*)p->in[I_CWIN]; f32x4* dst = (f32x4*)(p->out + O_WINS); constexpr int HALF_N = SB * 508 * 128 / 2;
      for (int e0 = li * HALF_N + gwf * 256 + c.lane; e0 < (li + 1) * HALF_N; e0 += ngwf * 256) { f32x4 v[4];
#pragma unroll
          for (int q = 0; q < 4; ++q) { const int e = e0 + 64 * q; if (e < (li + 1) * HALF_N) { const int b = e / (508 * 128), rr = e % (508 * 128); v[q] = __builtin_nontemporal_load(src + (size_t)b * 512 * 128 + 4 * 128 + rr); } }
#pragma unroll
          for (int q = 0; q < 4; ++q) { const int e = e0 + 64 * q; if (e < (li + 1) * HALF_N) { const int b = e / (508 * 128), rr = e % (508 * 128); __builtin_nontemporal_store(v[q], dst + (size_t)b * 512 * 128 + rr); } } } }
}

template <int NT> __device__ __forceinline__ void skinny_mma(const bf16_t* A, int lda, const bf16_t* Wt, int ldw, int K, int row0, int col0, int lane, f32x4 (&acc)[NT][2]) {
    const int fr = lane & 15, fq = lane >> 4;
#pragma unroll
    for (int nt = 0; nt < NT; ++nt) { acc[nt][0] = (f32x4){0.f, 0.f, 0.f, 0.f}; acc[nt][1] = (f32x4){0.f, 0.f, 0.f, 0.f}; }
    const bf16_t* xa = A + (size_t)(row0 + fr) * lda + 8 * fq; const bf16_t* xb = xa + (size_t)16 * lda;
    const bf16_t* wa = Wt + (size_t)(col0 + fr) * ldw + 8 * fq;
    const char* pa = (const char*)xa; const char* pb = (const char*)xb; const char* pw[NT];
#pragma unroll
    for (int nt = 0; nt < NT; ++nt) pw[nt] = (const char*)(wa + (size_t)nt * 16 * ldw);
    for (int k4 = 0; k4 < K / 128; ++k4) {
        bf16x8 fb[4][2], fa[4][NT];
#pragma unroll
        for (int u = 0; u < 4; ++u) { fb[u][0] = *(const bf16x8*)(pa + 64 * u); fb[u][1] = *(const bf16x8*)(pb + 64 * u);
#pragma unroll
            for (int nt = 0; nt < NT; ++nt) fa[u][nt] = *(const bf16x8*)(pw[nt] + 64 * u); }
        __builtin_amdgcn_sched_barrier(0);
#pragma unroll
        for (int u = 0; u < 4; ++u)
#pragma unroll
            for (int nt = 0; nt < NT; ++nt) { acc[nt][0] = mfma16(fa[u][nt], fb[u][0], acc[nt][0]); acc[nt][1] = mfma16(fa[u][nt], fb[u][1], acc[nt][1]); }
        pa += 256; pb += 256;
#pragma unroll
        for (int nt = 0; nt < NT; ++nt) pw[nt] += 256;
        __builtin_amdgcn_sched_barrier(0);
    }
}
__device__ __forceinline__ void skinny_resid_sample(const Ctx& c, const bf16_t* A, int lda, const bf16_t* Wt, int K, float* X) {
    const int ln = launder_v(c.lane), fr = ln & 15, fq = ln >> 4, w = c.wave;
    const int nch = K >> 7, c0 = (nch * w) >> 3, c1 = (nch * (w + 1)) >> 3;
    LAS f32x4* part = (LAS f32x4*)c.lds;
    __syncthreads();
    for (int it = blockIdx.x; it < 256; it += gridDim.x) { const int row0 = MP + 32 * (it & 15), col0 = 64 * (it >> 4);
        f32x4 acc[4][2]; skinny_mma<4>(A + 128 * c0, lda, Wt + 128 * c0, lda, 128 * (c1 - c0), row0, col0, c.lane, acc);
#pragma unroll
        for (int nt = 0; nt < 4; ++nt)
#pragma unroll
            for (int mt = 0; mt < 2; ++mt) part[(w * 8 + nt * 2 + mt) * 64 + ln] = acc[nt][mt];
        const int nt = w >> 1, mt = w & 1; f32x4* q = (f32x4*)(X + (size_t)(row0 + 16 * mt + fr) * D + col0 + 16 * nt + 4 * fq); f32x4 s = *q;
        __syncthreads();
#pragma unroll
        for (int ww = 0; ww < 8; ++ww) s = s + part[(ww * 8 + w) * 64 + ln];
        *q = s;
        __syncthreads(); }
}
__device__ __forceinline__ void skinny_store(const Ctx& c, const bf16_t* A, const bf16_t* Wt, int K, float* C, int ldc, int rbase, int nrb, int ncb, int it0, int nit_total) {
    const int fr = c.lane & 15, fq = c.lane >> 4;
    for (int it = c.gw - it0; it < nrb * ncb; it += c.ngw) { if (it < 0) continue; const int row0 = rbase + 32 * (it % nrb), col0 = 64 * (it / nrb);
        f32x4 acc[4][2]; skinny_mma<4>(A, K, Wt, K, K, row0, col0, c.lane, acc);
#pragma unroll
        for (int nt = 0; nt < 4; ++nt)
#pragma unroll
            for (int mt = 0; mt < 2; ++mt) *(f32x4*)(C + (size_t)(row0 + 16 * mt + fr) * ldc + col0 + 16 * nt + 4 * fq) = acc[nt][mt]; }
    (void)nit_total;
}

__device__ __forceinline__ void load_row(const float* p, int lane, f32x4 (&v)[4]) {
#pragma unroll
    for (int j = 0; j < 4; ++j) v[j] = ((const f32x4*)p)[lane + 64 * j];
}
__device__ __forceinline__ float row_rstd(const f32x4 (&v)[4]) {
    float s = 0.f;
#pragma unroll
    for (int j = 0; j < 4; ++j) s += (v[j][0] * v[j][0] + v[j][1] * v[j][1]) + (v[j][2] * v[j][2] + v[j][3] * v[j][3]);
    s = wave_sum(s); return frsq(s * (1.0f / D) + NORM_EPS);
}
__device__ __forceinline__ void store_row_bf16(bf16_t* o, int lane, const f32x4 (&v)[4]) {
#pragma unroll
    for (int j = 0; j < 4; ++j) { u32x2 w; w.x = pk2(v[j][0], v[j][1]); w.y = pk2(v[j][2], v[j][3]); ((u32x2*)o)[lane + 64 * j] = w; }
}

__device__ __forceinline__ void phase_norm(const Ctx& c, const float* X, const float* g1, bf16_t* o1, const float* g2, bf16_t* o2) {
    f32x4 ga[4], gb[4]; load_row(g1, c.lane, ga); if (g2) load_row(g2, c.lane, gb);
    for (int row = c.gw; row < R; row += c.ngw) {
        f32x4 v[4]; load_row(X + (size_t)row * D, c.lane, v); const float rs = row_rstd(v);
        f32x4 y[4];
#pragma unroll
        for (int j = 0; j < 4; ++j) y[j] = v[j] * rs * ga[j];
        store_row_bf16(o1 + (size_t)row * D, c.lane, y);
        if (g2) {
#pragma unroll
            for (int j = 0; j < 4; ++j) y[j] = v[j] * rs * gb[j];
            store_row_bf16(o2 + (size_t)row * D, c.lane, y); }
    }
}

__device__ __forceinline__ void phase_mix(KP p, const Ctx& c, int li) {
    const float* X = p->out + O_Y; const float* gain = p->in[I_NORMG] + (size_t)(li * 2) * D; const float* mu = p->in[I_MU] + (size_t)li * 6 * D;
    bf16_t* XM = (bf16_t*)(p->ws + WS_XM);
    f32x4 ga[4]; load_row(gain, c.lane, ga);
    {
        const int r0 = (int)(((long)c.gw * R) / c.ngw), r1 = (int)(((long)(c.gw + 1) * R) / c.ngw); f32x4 prev[4];
        {
            const bool seq_start = r0 < MP ? ((r0 & (TP - 1)) == 0) : (((r0 - MP) & 3) == 0);
            if (!seq_start && r0 < r1) { f32x4 v[4]; load_row(X + (size_t)(r0 - 1) * D, c.lane, v); const float rs = row_rstd(v);
#pragma unroll
                for (int j = 0; j < 4; ++j) prev[j] = v[j] * rs * ga[j]; }
        }
        for (int row = r0; row < r1; ++row) {
            const bool seq_start = row < MP ? ((row & (TP - 1)) == 0) : (((row - MP) & 3) == 0);
            if (seq_start) {
                if (row < MP) {
#pragma unroll
                    for (int j = 0; j < 4; ++j) prev[j] = (f32x4){0.f, 0.f, 0.f, 0.f}; }
                else load_row(p->in[I_SSHIFT] + ((size_t)li * SB + ((row - MP) >> 2)) * D, c.lane, prev);
            }
            f32x4 v[4]; load_row(X + (size_t)row * D, c.lane, v); const float rs = row_rstd(v);
            f32x4 xn[4];
#pragma unroll
            for (int j = 0; j < 4; ++j) xn[j] = v[j] * rs * ga[j];
#pragma unroll
            for (int m = 0; m < 6; ++m) {
                f32x4 y[4];
#pragma unroll
                for (int j = 0; j < 4; ++j) { const int mi = m == 1 ? 2 : (m == 2 ? 3 : (m == 3 ? 1 : m));
                    const f32x4 mm = ((const f32x4*)(mu + (size_t)mi * D))[c.lane + 64 * j]; y[j] = xn[j] + (prev[j] - xn[j]) * mm; }
                store_row_bf16(XM + ((size_t)m * R + row) * D, c.lane, y);
            }
            const bool seq_end = row < MP ? ((row & (TP - 1)) == TP - 1) : (((row - MP) & 3) == 3);
            if (seq_end) { float* so = row < MP ? p->out + O_SHP + ((size_t)li * NB + (row >> 13)) * D : p->out + O_SHS + ((size_t)li * SB + ((row - MP) >> 2)) * D;
#pragma unroll
                for (int j = 0; j < 4; ++j) ((f32x4*)so)[c.lane + 64 * j] = xn[j]; }
#pragma unroll
            for (int j = 0; j < 4; ++j) prev[j] = xn[j];
        }
    }
}
template <int NT, int ACT> __device__ __forceinline__ void lora1_item(const bf16_t* X, const bf16_t* W, bf16_t* HID, int coloff, int rb, int lane) {
    lane = launder_v(lane);
    const int fr = lane & 15, fq = lane >> 4;
    f32x4 acc[NT][2]; skinny_mma<NT>(X, 1024, W, 1024, 1024, rb * 32, coloff, lane, acc);
#pragma unroll
    for (int nt = 0; nt < NT; ++nt)
#pragma unroll
        for (int mt = 0; mt < 2; ++mt) { f32x4 v = acc[nt][mt];
#pragma unroll
            for (int r = 0; r < 4; ++r) { if (ACT == 1) { const float e = __builtin_amdgcn_exp2f(2.8853900817779268f * v[r]); v[r] = 1.0f - 2.0f * frcp(e + 1.0f); } if (ACT == 2) v[r] = sigmoidf_(v[r]); }
            u32x2 w; w.x = pk2(v[0], v[1]); w.y = pk2(v[2], v[3]);
            *(u32x2*)(HID + (size_t)(rb * 32 + mt * 16 + fr) * LHID + coloff + nt * 16 + 4 * fq) = w; }
}
__device__ __forceinline__ void phase_lora1(KP p, const Ctx& c, int li) {
    const bf16_t* XM = (const bf16_t*)(p->ws + WS_XM); const bf16_t* W = (const bf16_t*)(p->ws + WS_W1T) + (size_t)li * 288 * 1024; bf16_t* HID = (bf16_t*)(p->ws + WS_HID);
    constexpr int NRB = R / 32;
    for (int it = blockIdx.x + gridDim.x * c.wave; it < 5 * NRB; it += c.ngw) { const int q = it / NRB, rb = it % NRB;
        if (q == 0) lora1_item<4, 1>(XM + (size_t)3 * R * D, W, HID, 0, rb, c.lane);
        else if (q == 1) lora1_item<4, 0>(XM + (size_t)4 * R * D, W, HID, 64, rb, c.lane);
        else if (q == 2) { if (li == 1) lora1_item<2, 0>(XM + (size_t)2 * R * D, W, HID, 128, rb, c.lane); }
        else if (q == 3) lora1_item<4, 2>(XM + (size_t)5 * R * D, W, HID, 160, rb, c.lane);
        else lora1_item<4, 2>(XM + (size_t)5 * R * D, W, HID, 224, rb, c.lane);
    }
}

constexpr int SST = 72, MAT = 64 * SST * 2;
constexpr int O_AT = 0, O_BT = MAT, O_KT = 2 * MAT, O_RT = 3 * MAT, O_VT = 4 * MAT, O_BH = 5 * MAT, O_KH = 6 * MAT, O_XT = 7 * MAT, O_AAB = 9 * MAT, O_AAK = 10 * MAT, O_ARB = 11 * MAT, O_ARK = 12 * MAT;
constexpr int O_TD = 13 * MAT, O_SCR = O_TD + 2048, O_CS = O_SCR + 4096, O_WC = O_CS + 2048, O_LW = O_XT, O_LA = O_XT + 16384, O_LV = O_XT + 32768;
static_assert(O_WC + 256 <= RING_BYTES && O_LV + 16384 <= O_TD, "scan LDS map");
__device__ __forceinline__ bf16x8 ldsfrag(LAS unsigned char* lds, int off, int row, int col) { return *(const LAS bf16x8*)(lds + off + (row * SST + col) * 2); }
__device__ __forceinline__ void lds_st4(LAS unsigned char* lds, int off, int row, int col, f32x4 v) { u32x2 w; w.x = pk2(v[0], v[1]); w.y = pk2(v[2], v[3]); *(LAS u32x2*)(lds + off + (row * SST + col) * 2) = w; }
__device__ __forceinline__ f32x4 lds_ld4(LAS unsigned char* lds, int off, int row, int col) { const u32x2 w = *(const LAS u32x2*)(lds + off + (row * SST + col) * 2); return (f32x4){bflo(w.x), bfhi(w.x), bflo(w.y), bfhi(w.y)}; }

__device__ __forceinline__ void scanA_unit(KP p, const Ctx& c, int li, int u) {
    LAS unsigned char* lds = c.lds; unsigned char* ws = p->ws; const int stop = p->pad;
    const int lane = c.lane, wave = c.wave, fr = lane & 15, fq = lane >> 4;
    const int b = u / (NCH * H), n = (u / H) % NCH, h = u % H, row0 = b * TP + 64 * n;
    const float* Rb = (const float*)(ws + WS_RK_R); const float* Kb = (const float*)(ws + WS_RK_K);
    float* Vb = (float*)(ws + (li ? WS_V1 : WS_V0)); const float* V0b = (const float*)(ws + WS_V0);
    const bf16_t* HID = (const bf16_t*)(ws + WS_HID);
    {
        const int tt = wave & 3, chh = wave >> 2;
        const bf16_t* hrow = launder_p(HID + (size_t)(row0 + 16 * tt + fr) * LHID + 8 * fq);
        const bf16_t* W2W = (const bf16_t*)(ws + WS_W2W) + (size_t)li * 1024 * 64; const bf16_t* W2A = (const bf16_t*)(ws + WS_W2A) + (size_t)li * 1024 * 64; const bf16_t* W2V = (const bf16_t*)(ws + WS_W2V);
#pragma unroll
        for (int cti = 0; cti < 2; ++cti) { const int ct = 2 * chh + cti, C = 64 * h + 16 * ct + fr;
            f32x4 aw = {0.f, 0.f, 0.f, 0.f}, aa = {0.f, 0.f, 0.f, 0.f}, av = {0.f, 0.f, 0.f, 0.f};
#pragma unroll
            for (int ks = 0; ks < 2; ++ks) {
                aw = mfma16(*(const bf16x8*)(W2W + (size_t)C * 64 + 32 * ks + 8 * fq), *(const bf16x8*)(hrow + 32 * ks), aw);
                aa = mfma16(*(const bf16x8*)(W2A + (size_t)C * 64 + 32 * ks + 8 * fq), *(const bf16x8*)(hrow + 64 + 32 * ks), aa); }
            if (li) av = mfma16(*(const bf16x8*)(W2V + (size_t)C * 32 + 8 * fq), *(const bf16x8*)(hrow + 128), av);
            const int t = 16 * tt + fr, cc = 16 * ct + 4 * fq;
            *(LAS f32x4*)(lds + O_LW + (t * 64 + cc) * 4) = aw; *(LAS f32x4*)(lds + O_LA + (t * 64 + cc) * 4) = aa; *(LAS f32x4*)(lds + O_LV + (t * 64 + cc) * 4) = av; }
    }
    __syncthreads();
    if (stop == 1) return;
    {
        const int cc = lane, tq = wave, C = 64 * h + cc; const size_t pc = (size_t)li * D + C;
        const float w0 = p->in[I_W0][pc], a0 = p->in[I_A0][pc], kkc = p->in[I_KK][pc], kac = p->in[I_KA][pc], rkc = p->in[I_RKK][pc], v0 = li ? p->in[I_V0][C] : 0.f;
        float wlg[8], Lin[8], rr[8], k2[8], vv[8], aa[8], bb[8], rk8[8]; float run = 0.f;
        float r8[8], k8[8], v8[8], f8[8];
#pragma unroll
        for (int e = 0; e < 8; ++e) { const size_t gi = (size_t)(row0 + 8 * tq + e) * D + C; r8[e] = Rb[gi]; k8[e] = Kb[gi]; v8[e] = Vb[gi]; f8[e] = V0b[gi]; }
#pragma unroll
        for (int e = 0; e < 8; ++e) { const int t = 8 * tq + e;
            const float r = r8[e], k = k8[e]; float v = v8[e];
            const float lw = *(const LAS float*)(lds + O_LW + (t * 64 + cc) * 4), la = *(const LAS float*)(lds + O_LA + (t * 64 + cc) * 4), lv = *(const LAS float*)(lds + O_LV + (t * 64 + cc) * 4);
            const float z = -(w0 + lw); const float sp = fmaxf(z, 0.f) + __logf(1.0f + __expf(-fabsf(z))); const float wl = -__expf(-sp - 0.5f);
            const float asig = sigmoidf_(a0 + la);
            { const float vg = sigmoidf_(v0 + lv); const float vm = v + (f8[e] - v) * vg; v = li ? vm : v; }
            const float kkr = k * kkc; const float ss = wave_sum(kkr * kkr); const float kkn = kkr * frsq(fmaxf(ss, 1e-24f));
            const float kmod = k * (1.0f + (asig - 1.0f) * kac);
            rk8[e] = wave_sum(r * kmod * rkc);
            run += wl; wlg[e] = wl; Lin[e] = run; rr[e] = r; k2[e] = kmod; vv[e] = v; aa[e] = -kkn; bb[e] = kkn * asig; }
        if (li) {
#pragma unroll
            for (int e = 0; e < 8; ++e) Vb[(size_t)(row0 + 8 * tq + e) * D + C] = vv[e]; }
        if (cc == 0) {
#pragma unroll
            for (int e = 0; e < 8; ++e) ((float*)(ws + WS_RKS))[(size_t)(row0 + 8 * tq + e) * 16 + h] = rk8[e]; }
        *(LAS float*)(lds + O_CS + (tq * 64 + cc) * 4) = run;
        __syncthreads();
        float off = 0.f, tot = 0.f;
#pragma unroll
        for (int q = 0; q < 8; ++q) { const float x = *(const LAS float*)(lds + O_CS + (q * 64 + cc) * 4); tot += x; if (q < tq) off += x; }
        u32x4 wa, wv, wb, wk; unsigned pa[8], pv[8], pb[8], pk[8];
#pragma unroll
        for (int e = 0; e < 8; ++e) { const int t = 8 * tq + e; const float L = off + Lin[e], Lp = L - wlg[e];
            const float eL = __expf(L), eLp = __expf(Lp), enL = __expf(-L), eT = __expf(tot - L);
            const float at = aa[e] * eLp, bt = bb[e] * enL, kt = k2[e] * enL, rt = rr[e] * eL, bh = bb[e] * eT, kh = k2[e] * eT;
            *(LAS bf16_t*)(lds + O_AT + (t * SST + cc) * 2) = (bf16_t)f2bf(at); *(LAS bf16_t*)(lds + O_BT + (t * SST + cc) * 2) = (bf16_t)f2bf(bt);
            *(LAS bf16_t*)(lds + O_KT + (t * SST + cc) * 2) = (bf16_t)f2bf(kt); *(LAS bf16_t*)(lds + O_RT + (t * SST + cc) * 2) = (bf16_t)f2bf(rt);
            pa[e] = f2bf(at); pv[e] = f2bf(vv[e]); pb[e] = f2bf(bh); pk[e] = f2bf(kh); }
        wa = (u32x4){pa[0] | (pa[1] << 16), pa[2] | (pa[3] << 16), pa[4] | (pa[5] << 16), pa[6] | (pa[7] << 16)};
        wv = (u32x4){pv[0] | (pv[1] << 16), pv[2] | (pv[3] << 16), pv[4] | (pv[5] << 16), pv[6] | (pv[7] << 16)};
        wb = (u32x4){pb[0] | (pb[1] << 16), pb[2] | (pb[3] << 16), pb[4] | (pb[5] << 16), pb[6] | (pb[7] << 16)};
        wk = (u32x4){pk[0] | (pk[1] << 16), pk[2] | (pk[3] << 16), pk[4] | (pk[5] << 16), pk[6] | (pk[7] << 16)};
        *(LAS u32x4*)(lds + O_XT + (cc * SST + 8 * tq) * 2) = wa; *(LAS u32x4*)(lds + O_VT + (cc * SST + 8 * tq) * 2) = wv;
        *(LAS u32x4*)(lds + O_BH + (cc * SST + 8 * tq) * 2) = wb; *(LAS u32x4*)(lds + O_KH + (cc * SST + 8 * tq) * 2) = wk;
        if (tq == 0) *(LAS float*)(lds + O_WC + cc * 4) = __expf(tot);
    }
    __syncthreads();
    if (stop == 2) return;
    {
        const int mi = wave >> 1, ph = wave & 1; const int oY = (mi & 1) ? O_KT : O_BT, oX = (mi < 2) ? O_AT : O_RT; const bool strict = mi < 2;
        const int oO = mi == 0 ? O_AAB : (mi == 1 ? O_AAK : (mi == 2 ? O_ARB : O_ARK));
#pragma unroll
        for (int sti = 0; sti < 2; ++sti) { const int st = 2 * ph + sti;
#pragma unroll
            for (int tt = 0; tt < 4; ++tt) { f32x4 acc = {0.f, 0.f, 0.f, 0.f};
                if (st <= tt) {
#pragma unroll
                    for (int ks = 0; ks < 2; ++ks) acc = mfma16(ldsfrag(lds, oY, 16 * st + fr, 32 * ks + 8 * fq), ldsfrag(lds, oX, 16 * tt + fr, 32 * ks + 8 * fq), acc);
                    const int t = 16 * tt + fr;
#pragma unroll
                    for (int r = 0; r < 4; ++r) { const int s = 16 * st + 4 * fq + r; const bool keep = strict ? (s < t) : (s <= t); acc[r] = keep ? acc[r] : 0.f; } }
                if (st <= tt) lds_st4(lds, oO, 16 * tt + fr, 16 * st + 4 * fq, acc);
                else { u32x2 zz; int z0 = 0; asm volatile("" : "+v"(z0)); zz.x = (unsigned)z0; zz.y = (unsigned)z0; *(LAS u32x2*)(lds + oO + ((16 * tt + fr) * SST + 16 * st + 4 * fq) * 2) = zz; } } }
    }
    __syncthreads();
    if (stop == 3) return;
    {
        const int tt = wave & 3, ih = wave >> 2;
#pragma unroll
        for (int iti = 0; iti < 2; ++iti) { const int it = 2 * ih + iti; f32x4 acc = {0.f, 0.f, 0.f, 0.f};
#pragma unroll
            for (int ks = 0; ks < 2; ++ks) acc = mfma16(ldsfrag(lds, O_AAK, 16 * tt + fr, 32 * ks + 8 * fq), ldsfrag(lds, O_VT, 16 * it + fr, 32 * ks + 8 * fq), acc);
            lds_st4(lds, O_XT, 64 + 16 * it + fr, 16 * tt + 4 * fq, acc); }
        if (wave < 4 && lane < 16) { const int I = wave; float x[16];
#pragma unroll
            for (int t = 0; t < 16; ++t) { float s = (t == lane) ? 1.0f : 0.0f;
#pragma unroll
                for (int q = 0; q < t; ++q) s += bf2f(*(const LAS bf16_t*)(lds + O_AAB + ((16 * I + t) * SST + 16 * I + q) * 2)) * x[q];
                x[t] = s; *(LAS bf16_t*)(lds + O_TD + ((I * 16 + t) * 16 + lane) * 2) = (bf16_t)f2bf(s); } }
    }
    __syncthreads();
    if (stop == 5) return;
    {
        const int colb = 16 * wave; const bf16x8 zero8 = {0, 0, 0, 0, 0, 0, 0, 0};
#pragma unroll
        for (int I = 0; I < 4; ++I) {
            f32x4 acc = lds_ld4(lds, O_XT, colb + fr, 16 * I + 4 * fq);
#pragma unroll
            for (int ks = 0; ks < 2; ++ks) if (32 * ks < 16 * I) { const bool ok = (32 * ks + 8 * fq) < 16 * I;
                const bf16x8 a = ok ? ldsfrag(lds, O_AAB, 16 * I + fr, 32 * ks + 8 * fq) : zero8, bq = ok ? ldsfrag(lds, O_XT, colb + fr, 32 * ks + 8 * fq) : zero8;
                acc = mfma16(a, bq, acc); }
            { u32x2 w; w.x = pk2(acc[0], acc[1]); w.y = pk2(acc[2], acc[3]); *(LAS u32x2*)(lds + O_SCR + wave * 512 + (fr * 16 + 4 * fq) * 2) = w; }
            LDS_WAIT();
            const bf16x8 ta = fq < 2 ? *(const LAS bf16x8*)(lds + O_TD + ((I * 16 + fr) * 16 + 8 * fq) * 2) : zero8;
            const bf16x8 tb = fq < 2 ? *(const LAS bf16x8*)(lds + O_SCR + wave * 512 + (fr * 16 + 8 * fq) * 2) : zero8;
            const f32x4 res = mfma16(ta, tb, (f32x4){0.f, 0.f, 0.f, 0.f});
            lds_st4(lds, O_XT, colb + fr, 16 * I + 4 * fq, res);
            LDS_WAIT();
        }
    }
    __syncthreads();
    if (stop == 6) return;
    constexpr int S_RP = 0, S_MH = MAT, S_ML = 2 * MAT, S_YL = 3 * MAT, YLS = 68, S_NN = S_YL + 64 * YLS * 4;
    static_assert(S_NN + 64 * YLS * 4 <= O_XT, "staging must stay below the next unit's step-1 area");
    {
        const int tb = wave & 3, hb = wave >> 2;
        u32x2 rp[2], mh[2], ml[2]; f32x4 yl[2], nv[2];
#pragma unroll
        for (int qi = 0; qi < 2; ++qi) { const int rt = 2 * hb + qi;
            { f32x4 acc = lds_ld4(lds, O_RT, 16 * tb + fr, 16 * rt + 4 * fq);
#pragma unroll
              for (int ks = 0; ks < 2; ++ks) acc = mfma16(ldsfrag(lds, O_XT, 16 * rt + fr, 32 * ks + 8 * fq), ldsfrag(lds, O_ARB, 16 * tb + fr, 32 * ks + 8 * fq), acc);
              rp[qi].x = pk2(acc[0], acc[1]); rp[qi].y = pk2(acc[2], acc[3]); }
            { f32x4 acc = {0.f, 0.f, 0.f, 0.f};
#pragma unroll
              for (int ks = 0; ks < 2; ++ks) { acc = mfma16(ldsfrag(lds, O_XT, 64 + 16 * rt + fr, 32 * ks + 8 * fq), ldsfrag(lds, O_ARB, 16 * tb + fr, 32 * ks + 8 * fq), acc);
                  acc = mfma16(ldsfrag(lds, O_VT, 16 * rt + fr, 32 * ks + 8 * fq), ldsfrag(lds, O_ARK, 16 * tb + fr, 32 * ks + 8 * fq), acc); }
              yl[qi] = acc; }
            { f32x4 acc = {0.f, 0.f, 0.f, 0.f};
#pragma unroll
              for (int ks = 0; ks < 2; ++ks) acc = mfma16(ldsfrag(lds, O_XT, 16 * rt + fr, 32 * ks + 8 * fq), ldsfrag(lds, O_BH, 16 * tb + fr, 32 * ks + 8 * fq), acc);
              const int j = 16 * tb + fr; const float wc = *(const LAS float*)(lds + O_WC + j * 4);
#pragma unroll
              for (int r = 0; r < 4; ++r) if (16 * rt + 4 * fq + r == j) acc[r] += wc;
              unsigned hh[4], ll[4];
#pragma unroll
              for (int r = 0; r < 4; ++r) { hh[r] = f2bf(acc[r]); ll[r] = f2bf(acc[r] - __builtin_bit_cast(float, hh[r] << 16)); }
              mh[qi] = (u32x2){hh[0] | (hh[1] << 16), hh[2] | (hh[3] << 16)}; ml[qi] = (u32x2){ll[0] | (ll[1] << 16), ll[2] | (ll[3] << 16)}; }
            { f32x4 acc = {0.f, 0.f, 0.f, 0.f};
#pragma unroll
              for (int ks = 0; ks < 2; ++ks) { acc = mfma16(ldsfrag(lds, O_BH, 16 * rt + fr, 32 * ks + 8 * fq), ldsfrag(lds, O_XT, 64 + 16 * tb + fr, 32 * ks + 8 * fq), acc);
                  acc = mfma16(ldsfrag(lds, O_KH, 16 * rt + fr, 32 * ks + 8 * fq), ldsfrag(lds, O_VT, 16 * tb + fr, 32 * ks + 8 * fq), acc); }
              nv[qi] = acc; }
        }
        __syncthreads();
#pragma unroll
        for (int qi = 0; qi < 2; ++qi) { const int rt = 2 * hb + qi, row = 16 * tb + fr, col = 16 * rt + 4 * fq;
            *(LAS u32x2*)(lds + S_RP + (row * SST + col) * 2) = rp[qi]; *(LAS u32x2*)(lds + S_MH + (row * SST + col) * 2) = mh[qi]; *(LAS u32x2*)(lds + S_ML + (row * SST + col) * 2) = ml[qi];
            *(LAS f32x4*)(lds + S_YL + (row * YLS + col) * 4) = yl[qi]; *(LAS f32x4*)(lds + S_NN + (row * YLS + col) * 4) = nv[qi]; }
        __syncthreads();
        unsigned char* gRP = ws + WS_RP + (size_t)u * 8192; unsigned char* gYL = ws + WS_YL + (size_t)u * 16384;
        unsigned char* gMH = ws + WS_MT + (size_t)u * 8192; unsigned char* gML = gMH + (size_t)NUNIT_A * 8192; unsigned char* gNN = ws + WS_NN + (size_t)u * 16384;
        const int tid = 64 * wave + lane;
        { const int row = tid >> 3, ch = tid & 7, lo = (row * SST) * 2 + ch * 16;
          *(u32x4*)(gRP + tid * 16) = *(const LAS u32x4*)(lds + S_RP + lo); *(u32x4*)(gMH + tid * 16) = *(const LAS u32x4*)(lds + S_MH + lo); *(u32x4*)(gML + tid * 16) = *(const LAS u32x4*)(lds + S_ML + lo); }
#pragma unroll
        for (int k = 0; k < 2; ++k) { const int cidx = tid + 512 * k, row = cidx >> 4, c4 = cidx & 15, lo = (row * YLS) * 4 + c4 * 16;
            *(u32x4*)(gYL + cidx * 16) = *(const LAS u32x4*)(lds + S_YL + lo); *(u32x4*)(gNN + cidx * 16) = *(const LAS u32x4*)(lds + S_NN + lo); }
    }
}

__device__ __forceinline__ void scan_sample_item(KP p, const Ctx& c, int li, int item) {
    unsigned char* ws = p->ws; const int lane = c.lane, b = item >> 4, h = item & 15, C = 64 * h + lane; const size_t pc = (size_t)li * D + C;
    LAS float* sc = (LAS float*)(c.lds + c.wave * 16384);
    const float* Rb = (const float*)(ws + WS_RK_R); const float* Kb = (const float*)(ws + WS_RK_K);
    float* Vb = (float*)(ws + (li ? WS_V1 : WS_V0)); const float* V0b = (const float*)(ws + WS_V0);
    const bf16_t* HID = (const bf16_t*)(ws + WS_HID) + (size_t)(MP + 4 * b) * LHID;
    for (int e = lane; e < 4 * LHID; e += 64) sc[e] = bf2f(HID[e]);
    LDS_WAIT();
    float lw[4] = {0.f, 0.f, 0.f, 0.f}, la[4] = {0.f, 0.f, 0.f, 0.f}, lv[4] = {0.f, 0.f, 0.f, 0.f}, lg[4] = {0.f, 0.f, 0.f, 0.f};
    {
        const bf16_t* W2W = (const bf16_t*)(ws + WS_W2W) + ((size_t)li * 1024 + C) * 64; const bf16_t* W2A = (const bf16_t*)(ws + WS_W2A) + ((size_t)li * 1024 + C) * 64;
        const bf16_t* W2V = (const bf16_t*)(ws + WS_W2V) + (size_t)C * 32; const bf16_t* W2G = (const bf16_t*)(ws + WS_W2G) + ((size_t)li * 1024 + C) * 128;
#define LORA2_BLK(WP, QB, HOFF, ACC) { const u32x4 w8 = *(const u32x4*)((WP) + 8 * (QB)); \
            const float wf0 = bflo(w8.x), wf1 = bfhi(w8.x), wf2 = bflo(w8.y), wf3 = bfhi(w8.y), wf4 = bflo(w8.z), wf5 = bfhi(w8.z), wf6 = bflo(w8.w), wf7 = bfhi(w8.w); \
            _Pragma("unroll") for (int t = 0; t < 4; ++t) { const f32x4 h0 = *(const LAS f32x4*)(sc + t * LHID + (HOFF) + 8 * (QB)), h1 = *(const LAS f32x4*)(sc + t * LHID + (HOFF) + 8 * (QB) + 4); \
                ACC[t] += (h0[0] * wf0 + h0[1] * wf1) + (h0[2] * wf2 + h0[3] * wf3) + (h1[0] * wf4 + h1[1] * wf5) + (h1[2] * wf6 + h1[3] * wf7); } \
            asm volatile("" : "+v"(ACC[0]), "+v"(ACC[1]), "+v"(ACC[2]), "+v"(ACC[3]) :: "memory"); }
#pragma unroll
        for (int qb = 0; qb < 8; ++qb) { LORA2_BLK(W2W, qb, 0, lw) LORA2_BLK(W2A, qb, 64, la) }
        if (li) {
#pragma unroll
            for (int qb = 0; qb < 4; ++qb) LORA2_BLK(W2V, qb, 128, lv) }
#pragma unroll
        for (int qb = 0; qb < 16; ++qb) LORA2_BLK(W2G, qb, 160, lg)
#undef LORA2_BLK
    }
    const float w0 = p->in[I_W0][pc], a0 = p->in[I_A0][pc], kkc = p->in[I_KK][pc], kac = p->in[I_KA][pc], rkc = p->in[I_RKK][pc], v0 = li ? p->in[I_V0][C] : 0.f;
    const float lnw = p->in[I_LNW][pc], lnb = p->in[I_LNB][pc];
    float S[64];
    { const f32x4* sp = (const f32x4*)(p->in[I_SWKV] + (((size_t)li * SB + b) * H + h) * 4096 + lane * 64);
#pragma unroll
      for (int q = 0; q < 16; ++q) { const f32x4 x = sp[q]; S[4 * q] = x[0]; S[4 * q + 1] = x[1]; S[4 * q + 2] = x[2]; S[4 * q + 3] = x[3]; } }
    LAS float* bc = sc + 1280;
    bf16_t* YG = (bf16_t*)(ws + WS_YG);
#pragma unroll
    for (int t = 0; t < 4; ++t) { const size_t gi = (size_t)(MP + 4 * b + t) * D + C;
        const float r = Rb[gi], k = Kb[gi]; float v = Vb[gi];
        const float z = -(w0 + lw[t]); const float sp = fmaxf(z, 0.f) + __logf(1.0f + __expf(-fabsf(z))); const float wdec = __expf(-__expf(-sp - 0.5f));
        const float asig = sigmoidf_(a0 + la[t]);
        if (li) { const float vg = sigmoidf_(v0 + lv[t]); const float vf = V0b[gi]; v = v + (vf - v) * vg; }
        const float kkr = k * kkc; const float ss = wave_sum(kkr * kkr); const float kkn = kkr * frsq(fmaxf(ss, 1e-24f));
        const float kmod = k * (1.0f + (asig - 1.0f) * kac);
        const float rks = wave_sum(r * kmod * rkc);
        LDS_WAIT();
        bc[lane] = wdec; bc[64 + lane] = -kkn; bc[128 + lane] = kkn * asig; bc[192 + lane] = kmod; bc[256 + lane] = r;
        LDS_WAIT();
        float sa = 0.f;
#pragma unroll
        for (int q = 0; q < 16; ++q) { const f32x4 av = *(const LAS f32x4*)(bc + 64 + 4 * q); sa += S[4 * q] * av[0] + S[4 * q + 1] * av[1] + S[4 * q + 2] * av[2] + S[4 * q + 3] * av[3]; }
        float y = 0.f;
#pragma unroll
        for (int q = 0; q < 16; ++q) { const f32x4 wv = *(const LAS f32x4*)(bc + 4 * q), bv = *(const LAS f32x4*)(bc + 128 + 4 * q), kv = *(const LAS f32x4*)(bc + 192 + 4 * q), rv = *(const LAS f32x4*)(bc + 256 + 4 * q);
#pragma unroll
            for (int e = 0; e < 4; ++e) { const float s = S[4 * q + e] * wv[e] + sa * bv[e] + v * kv[e]; S[4 * q + e] = s; y += s * rv[e]; } }
        const float mean = wave_sum(y) * (1.0f / 64.0f); const float dy = y - mean; const float var = wave_sum(dy * dy) * (1.0f / 64.0f);
        const float yn = dy * (frsq(var + GN_EPS)) * lnw + lnb;
        YG[gi] = (bf16_t)f2bf((yn + rks * v) * lg[t]);
    }
    { f32x4* so = (f32x4*)(p->out + O_WKVS + (((size_t)li * SB + b) * H + h) * 4096 + lane * 64);
#pragma unroll
      for (int q = 0; q < 16; ++q) so[q] = (f32x4){S[4 * q], S[4 * q + 1], S[4 * q + 2], S[4 * q + 3]}; }
    LDS_WAIT();
}

__device__ __forceinline__ void phase_scanA(KP p, const Ctx& c, int li) {
    const int stop = p->pad;
    if (stop != 9) for (int u = blockIdx.x; u < NUNIT_A; u += gridDim.x) scanA_unit(p, c, li, u);
    __syncthreads();
    if (stop == 0 || stop == 9) for (int it = c.gw; it < SB * H; it += c.ngw) scan_sample_item(p, c, li, it);
}

__device__ __forceinline__ void hilo(const f32x4 x0, const f32x4 x1, bf16x8& hi, bf16x8& lo) {
    unsigned h[8], l[8];
#pragma unroll
    for (int e = 0; e < 8; ++e) { const float x = e < 4 ? x0[e] : x1[e - 4]; h[e] = f2bf(x); l[e] = f2bf(x - __builtin_bit_cast(float, h[e] << 16)); }
    u32x4 hv = {h[0] | (h[1] << 16), h[2] | (h[3] << 16), h[4] | (h[5] << 16), h[6] | (h[7] << 16)}, lv = {l[0] | (l[1] << 16), l[2] | (l[3] << 16), l[4] | (l[5] << 16), l[6] | (l[7] << 16)};
    hi = __builtin_bit_cast(bf16x8, hv); lo = __builtin_bit_cast(bf16x8, lv);
}
constexpr int SB_SLOT = 20480, SB_RING0 = 8192, SB_DEPTH = 6;
static_assert(SB_RING0 + SB_DEPTH * SB_SLOT <= RING_BYTES, "chain ring");
__device__ __forceinline__ void phase_scanB(KP p, const Ctx& c, int li) {
    unsigned char* ws = p->ws; LAS unsigned char* lds = c.lds; const int lane = c.lane, fr = lane & 15, fq = lane >> 4, wave = c.wave;
    volatile LAS int* FL = (volatile LAS int*)(lds + RING_BYTES);
    if (c.tid < 4) FL[c.tid] = 0;
    __syncthreads();
    const int ncb = (int)gridDim.x < 128 ? (int)gridDim.x : 128;
    if (wave >= 4 || (int)blockIdx.x >= ncb) {
        const int gwf = (int)blockIdx.x < ncb ? (int)blockIdx.x * 4 + (wave - 4) : ncb * 4 + ((int)blockIdx.x - ncb) * 8 + wave, ngwf = ncb * 4 + ((int)gridDim.x - ncb) * 8;
        phase_fill(p, c, li, gwf, ngwf); return; }
    if (wave != 0) {
        const int j = wave - 1; int prevG = -1, kc = 0;
        for (int ch = blockIdx.x; ch < 128; ch += gridDim.x, ++kc) { const int b = ch >> 6, h = (ch >> 2) & 15, iq = ch & 3;
            for (int n = j; n < NCH; n += 3) { const int G = kc * NCH + n;
                if (G >= SB_DEPTH) { unsigned sp = 0; while (FL[0] < G - (SB_DEPTH - 1)) { __builtin_amdgcn_s_sleep(1); if (++sp > (1u << 22)) break; } }
                LAS unsigned char* slot = lds + SB_RING0 + (G % SB_DEPTH) * SB_SLOT;
                const size_t u = (size_t)(b * NCH + n) * H + h; const bf16_t* MTH = (const bf16_t*)(ws + WS_MT) + u * 4096; const bf16_t* MTL = MTH + (size_t)NUNIT_A * 4096; const float* NN = (const float*)(ws + WS_NN) + u * 4096;
#pragma unroll
                for (int jt = 0; jt < 4; ++jt)
#pragma unroll
                    for (int ks = 0; ks < 2; ++ks) {
                        __builtin_amdgcn_global_load_lds((const unsigned*)(MTH + (size_t)(16 * jt + fr) * 64 + 32 * ks + 8 * fq), (LAS unsigned*)(slot + ((jt * 2 + ks) * 2 + 0) * 1024), 16, 0, 0);
                        __builtin_amdgcn_global_load_lds((const unsigned*)(MTL + (size_t)(16 * jt + fr) * 64 + 32 * ks + 8 * fq), (LAS unsigned*)(slot + ((jt * 2 + ks) * 2 + 1) * 1024), 16, 0, 0); }
#pragma unroll
                for (int jt = 0; jt < 4; ++jt)
                    __builtin_amdgcn_global_load_lds((const unsigned*)(NN + (size_t)(16 * iq + fr) * 64 + 16 * jt + 4 * fq), (LAS unsigned*)(slot + (16 + jt) * 1024), 16, 0, 0);
                asm volatile("s_waitcnt vmcnt(20)" ::: "memory");
                if (prevG >= 0) FL[1 + j] = prevG + 1;
                prevG = G; } }
        asm volatile("s_waitcnt vmcnt(0)" ::: "memory");
        if (prevG >= 0) FL[1 + j] = prevG + 1;
        return; }
    int kc = 0;
    for (int ch = blockIdx.x; ch < 128; ch += gridDim.x, ++kc) {
        const int b = ch >> 6, h = (ch >> 2) & 15, iq = ch & 3;
        f32x4 S[4];
#pragma unroll
        for (int jt = 0; jt < 4; ++jt) S[jt] = (f32x4){0.f, 0.f, 0.f, 0.f};
        int j3 = 0;
        for (int n = 0; n < NCH; ++n) { const int G = kc * NCH + n;
            const size_t u = (size_t)(b * NCH + n) * H + h; bf16_t* S0 = (bf16_t*)(ws + WS_S0) + u * 4096;
            { unsigned sp = 0; while (FL[1 + j3] < G + 1) { __builtin_amdgcn_s_sleep(1); if (++sp > (1u << 22)) break; } }
            const LAS unsigned char* slot = lds + SB_RING0 + (G % SB_DEPTH) * SB_SLOT + lane * 16;
            bf16x8 ah[4][2], al[4][2]; f32x4 nn[4];
#pragma unroll
            for (int jt = 0; jt < 4; ++jt) { nn[jt] = *(const LAS f32x4*)(slot + (16 + jt) * 1024);
#pragma unroll
                for (int ks = 0; ks < 2; ++ks) { ah[jt][ks] = *(const LAS bf16x8*)(slot + ((jt * 2 + ks) * 2 + 0) * 1024); al[jt][ks] = *(const LAS bf16x8*)(slot + ((jt * 2 + ks) * 2 + 1) * 1024); } }
#pragma unroll
            for (int jt = 0; jt < 4; ++jt) { unsigned hh[4], ll[4];
#pragma unroll
                for (int r = 0; r < 4; ++r) { hh[r] = f2bf(S[jt][r]); ll[r] = f2bf(S[jt][r] - __builtin_bit_cast(float, hh[r] << 16)); }
                u32x2 wh = {hh[0] | (hh[1] << 16), hh[2] | (hh[3] << 16)}, wl = {ll[0] | (ll[1] << 16), ll[2] | (ll[3] << 16)};
                *(u32x2*)(S0 + (size_t)(16 * iq + fr) * 64 + 16 * jt + 4 * fq) = wh;
                *(LAS u32x2*)(lds + (fr * SST + 16 * jt + 4 * fq) * 2) = wh; *(LAS u32x2*)(lds + 4096 + (fr * SST + 16 * jt + 4 * fq) * 2) = wl; }
            LDS_WAIT();
            bf16x8 bh[2], bl[2];
#pragma unroll
            for (int ks = 0; ks < 2; ++ks) { bh[ks] = *(const LAS bf16x8*)(lds + (fr * SST + 32 * ks + 8 * fq) * 2); bl[ks] = *(const LAS bf16x8*)(lds + 4096 + (fr * SST + 32 * ks + 8 * fq) * 2); }
#pragma unroll
            for (int jt = 0; jt < 4; ++jt) { f32x4 acc = nn[jt];
#pragma unroll
                for (int ks = 0; ks < 2; ++ks) { acc = mfma16(ah[jt][ks], bh[ks], acc); acc = mfma16(ah[jt][ks], bl[ks], acc); acc = mfma16(al[jt][ks], bh[ks], acc); }
                S[jt] = acc; }
            LDS_WAIT();
            FL[0] = G + 1;
            j3 = j3 == 2 ? 0 : j3 + 1;
        }
        float* so = p->out + O_WKVP + (((size_t)li * NB + b) * H + h) * 4096;
#pragma unroll
        for (int jt = 0; jt < 4; ++jt) *(f32x4*)(so + (size_t)(16 * iq + fr) * 64 + 16 * jt + 4 * fq) = S[jt];
    }
}

__device__ __forceinline__ void phase_scanC(KP p, const Ctx& c, int li) {
    unsigned char* ws = p->ws; const int lane = c.lane, fr = lane & 15, fq = lane >> 4, hb = c.wave >> 2, tt = c.wave & 3;
    const float* Vb = (const float*)(ws + (li ? WS_V1 : WS_V0)); const bf16_t* HID = (const bf16_t*)(ws + WS_HID); const bf16_t* W2G = (const bf16_t*)(ws + WS_W2G) + (size_t)li * 1024 * 128;
    bf16_t* YG = (bf16_t*)(ws + WS_YG);
    for (int up = blockIdx.x; up < NUNIT_A / 2; up += gridDim.x) {
        const int u = 2 * up + hb; const int b = u / (NCH * H), n = (u / H) % NCH, h = u % H; const int row = b * TP + 64 * n + 16 * tt + fr;
        const bf16_t* RP = (const bf16_t*)(ws + WS_RP) + (size_t)u * 4096; const float* YL = (const float*)(ws + WS_YL) + (size_t)u * 4096; const bf16_t* S0 = (const bf16_t*)(ws + WS_S0) + (size_t)u * 4096;
        f32x4 acc[4], ag[4];
#pragma unroll
        for (int it = 0; it < 4; ++it) { acc[it] = *(const f32x4*)(YL + (size_t)(16 * tt + fr) * 64 + 16 * it + 4 * fq); ag[it] = (f32x4){0.f, 0.f, 0.f, 0.f}; }
#pragma unroll
        for (int ks = 0; ks < 2; ++ks) { const bf16x8 bq = *(const bf16x8*)(RP + (size_t)(16 * tt + fr) * 64 + 32 * ks + 8 * fq);
#pragma unroll
            for (int it = 0; it < 4; ++it) acc[it] = mfma16(*(const bf16x8*)(S0 + (size_t)(16 * it + fr) * 64 + 32 * ks + 8 * fq), bq, acc[it]); }
        const bf16_t* hgp = launder_p(HID + (size_t)row * LHID + 160 + 8 * fq); const bf16_t* wgp = launder_p(W2G + (size_t)(64 * h + fr) * 128 + 8 * fq);
#pragma unroll
        for (int ks = 0; ks < 4; ++ks) { const bf16x8 bq = *(const bf16x8*)(hgp + 32 * ks);
#pragma unroll
            for (int it = 0; it < 4; ++it) ag[it] = mfma16(*(const bf16x8*)(wgp + it * 16 * 128 + 32 * ks), bq, ag[it]); }
        float s = 0.f;
#pragma unroll
        for (int it = 0; it < 4; ++it) s += (acc[it][0] + acc[it][1]) + (acc[it][2] + acc[it][3]);
        s = sum_rows4(s); const float mean = s * (1.0f / 64.0f);
        float q = 0.f;
#pragma unroll
        for (int it = 0; it < 4; ++it) { const f32x4 d = acc[it] - mean; q += (d[0] * d[0] + d[1] * d[1]) + (d[2] * d[2] + d[3] * d[3]); }
        q = sum_rows4(q); const float rstd = frsq(q * (1.0f / 64.0f) + GN_EPS);
        const float rks = ((const float*)(ws + WS_RKS))[(size_t)row * 16 + h];
#pragma unroll
        for (int it = 0; it < 4; ++it) { const int C = 64 * h + 16 * it + 4 * fq; const size_t pc = (size_t)li * D + C;
            const f32x4 lw = *(const f32x4*)(p->in[I_LNW] + pc), lb = *(const f32x4*)(p->in[I_LNB] + pc), v = *(const f32x4*)(Vb + (size_t)row * D + C);
            const f32x4 o = ((acc[it] - mean) * rstd * lw + lb + v * rks) * ag[it];
            u32x2 w; w.x = pk2(o[0], o[1]); w.y = pk2(o[2], o[3]); *(u32x2*)(YG + (size_t)row * D + C) = w; }
    }
}
__device__ __forceinline__ void ld8bf(const bf16_t* p, float (&o)[8]) { const u32x4 w = *(const u32x4*)p; o[0] = bflo(w.x); o[1] = bfhi(w.x); o[2] = bflo(w.y); o[3] = bfhi(w.y); o[4] = bflo(w.z); o[5] = bfhi(w.z); o[6] = bflo(w.w); o[7] = bfhi(w.w); }
__device__ __forceinline__ void ld8f(const float* p, float (&o)[8]) { const f32x4 a = *(const f32x4*)p, b = *(const f32x4*)(p + 4); o[0] = a[0]; o[1] = a[1]; o[2] = a[2]; o[3] = a[3]; o[4] = b[0]; o[5] = b[1]; o[6] = b[2]; o[7] = b[3]; }
__device__ __forceinline__ void phase_conv(KP p, const Ctx& c, int layer) {
    const bf16_t* U = (const bf16_t*)(p->ws + WS_U); const bf16_t* GT = (const bf16_t*)(p->ws + WS_GT); bf16_t* HH = (bf16_t*)(p->ws + WS_HH);
    const float* cw = p->in[I_CONVW] + (size_t)layer * 3 * DFF; const float* cb = p->in[I_CONVB] + (size_t)layer * DFF; const float* st = p->in[I_SCONV] + (size_t)layer * SB * 2 * DFF;
    constexpr int NF8 = DFF / 8, NPS = MP / 64, NITEM = (NPS + SB) * NF8;
    for (int e = c.gtid; e < NITEM; e += c.gsz) { const int sidx = e / NF8, f = 8 * (e % NF8);
        int row0, nrow; float u0[8], u1[8];
        if (sidx < NPS) { row0 = 64 * sidx; nrow = 64;
            if ((row0 & (TP - 1)) == 0) {
#pragma unroll
                for (int i = 0; i < 8; ++i) { u0[i] = 0.f; u1[i] = 0.f; } }
            else { ld8bf(U + (size_t)(row0 - 1) * DFF + f, u1); ld8bf(U + (size_t)(row0 - 2) * DFF + f, u0); } }
        else { const int b = sidx - NPS; row0 = MP + 4 * b; nrow = 4; ld8f(st + ((size_t)b * 2 + 1) * DFF + f, u1); ld8f(st + ((size_t)b * 2) * DFF + f, u0); }
        float w0[8], w1[8], w2[8], bb[8];
        ld8f(cw + f, w0); ld8f(cw + DFF + f, w1); ld8f(cw + 2 * DFF + f, w2); ld8f(cb + f, bb);
        for (int r = 0; r < nrow; r += 4) {
            u32x4 ur[4], gr[4];
#pragma unroll
            for (int q = 0; q < 4; ++q) { ur[q] = *(const u32x4*)(U + (size_t)(row0 + r + q) * DFF + f); gr[q] = *(const u32x4*)(GT + (size_t)(row0 + r + q) * DFF + f); }
#pragma unroll
            for (int q = 0; q < 4; ++q) { float u2[8], g[8];
                u2[0] = bflo(ur[q].x); u2[1] = bfhi(ur[q].x); u2[2] = bflo(ur[q].y); u2[3] = bfhi(ur[q].y); u2[4] = bflo(ur[q].z); u2[5] = bfhi(ur[q].z); u2[6] = bflo(ur[q].w); u2[7] = bfhi(ur[q].w);
                g[0] = bflo(gr[q].x); g[1] = bfhi(gr[q].x); g[2] = bflo(gr[q].y); g[3] = bfhi(gr[q].y); g[4] = bflo(gr[q].z); g[5] = bfhi(gr[q].z); g[6] = bflo(gr[q].w); g[7] = bfhi(gr[q].w);
                float o[8];
#pragma unroll
                for (int i = 0; i < 8; ++i) { o[i] = gelu_tanh(bb[i] + w0[i] * u0[i] + w1[i] * u1[i] + w2[i] * u2[i]) * g[i]; u0[i] = u1[i]; u1[i] = u2[i]; }
                u32x4 w; w.x = pk2(o[0], o[1]); w.y = pk2(o[2], o[3]); w.z = pk2(o[4], o[5]); w.w = pk2(o[6], o[7]);
                *(u32x4*)(HH + (size_t)(row0 + r + q) * DFF + f) = w; }
        }
    }
}

__device__ __forceinline__ void phase_kvpost(KP p, const Ctx& c) {
    const float* KVF = (const float*)(p->ws + WS_KVF); unsigned char* ws = p->ws; const int lane = c.lane, g = lane >> 4, d0 = 4 * (lane & 15);
    const f32x4 gs = *(const f32x4*)(p->in[I_KNG] + 64 + d0), gw = *(const f32x4*)(p->in[I_KNG] + 128 + d0);
    bf16_t* CA = (bf16_t*)(ws + WS_CMPA); bf16_t* KS = (bf16_t*)(ws + WS_KS); bf16_t* VS = (bf16_t*)(ws + WS_VS); bf16_t* KW = (bf16_t*)(ws + WS_KW); bf16_t* VW = (bf16_t*)(ws + WS_VW);
    for (int chunk = c.gw; chunk < R / 8; chunk += c.ngw) {
        unsigned vs_[4][4], vw_[4][4];
#pragma unroll
        for (int e = 0; e < 8; ++e) { const int row = chunk * 8 + e; const float* src = KVF + (size_t)row * NKV + 4 * lane;
            f32x4 v[6];
#pragma unroll
            for (int pt = 0; pt < 6; ++pt) v[pt] = *(const f32x4*)(src + pt * 256);
            { float s = (v[2][0] * v[2][0] + v[2][1] * v[2][1]) + (v[2][2] * v[2][2] + v[2][3] * v[2][3]);
              s = row16_sum(s); const float rs = frsq(s * (1.0f / 64.0f) + NORM_EPS); v[2] = v[2] * rs * gs; }
            { float s = (v[4][0] * v[4][0] + v[4][1] * v[4][1]) + (v[4][2] * v[4][2] + v[4][3] * v[4][3]);
              s = row16_sum(s); const float rs = frsq(s * (1.0f / 64.0f) + NORM_EPS); v[4] = v[4] * rs * gw; }
            float* okv = p->out + O_KV + (size_t)row * D + 4 * lane;
#pragma unroll
            for (int pt = 0; pt < 4; ++pt) *(f32x4*)(okv + pt * 256) = v[pt];
            if (row < MP) { const int b = row >> 13, t = row & (TP - 1);
                if (t >= TP - WIN) { float* ow = p->out + O_WINP + ((size_t)(b * WIN + (t - (TP - WIN))) * 2) * 256 + 4 * lane; *(f32x4*)ow = v[4]; *(f32x4*)(ow + 256) = v[5]; }
                const size_t hb = (size_t)(b * G + g);
                { u32x2 w; w.x = pk2(v[0][0], v[0][1]); w.y = pk2(v[0][2], v[0][3]); *(u32x2*)(CA + (hb * 512 + (t >> 4)) * 1024 + (t & 15) * 64 + d0) = w; }
                { u32x2 w; w.x = pk2(v[1][0], v[1][1]); w.y = pk2(v[1][2], v[1][3]); *(u32x2*)(CA + ((size_t)4096 + hb * 512 + (t >> 4)) * 1024 + (t & 15) * 64 + d0) = w; }
                { u32x2 w; w.x = pk2(v[2][0], v[2][1]); w.y = pk2(v[2][2], v[2][3]); *(u32x2*)(KS + (hb * TP + t) * 64 + d0) = w; }
                { u32x2 w; w.x = pk2(v[4][0], v[4][1]); w.y = pk2(v[4][2], v[4][3]); *(u32x2*)(KW + (hb * TP + t) * 64 + d0) = w; }
#pragma unroll
                for (int d = 0; d < 4; ++d) { const unsigned a = f2bf(v[3][d]), bq = f2bf(v[5][d]);
                    if (e & 1) { vs_[d][e >> 1] |= a << 16; vw_[d][e >> 1] |= bq << 16; } else { vs_[d][e >> 1] = a; vw_[d][e >> 1] = bq; } }
            } else { const int b = (row - MP) >> 2, t = (row - MP) & 3;
                float* ow = p->out + O_WINS + ((size_t)(b * WIN + 508 + t) * 2) * 256 + 4 * lane; *(f32x4*)ow = v[4]; *(f32x4*)(ow + 256) = v[5]; }
        }
        if (chunk * 8 < MP) { const int row = chunk * 8, b = row >> 13, t = row & (TP - 1); const size_t hb = (size_t)(b * G + g);
#pragma unroll
            for (int d = 0; d < 4; ++d) { *(u32x4*)(VS + (hb * 64 + d0 + d) * TP + t) = (u32x4){vs_[d][0], vs_[d][1], vs_[d][2], vs_[d][3]};
                *(u32x4*)(VW + (hb * 64 + d0 + d) * TP + t) = (u32x4){vw_[d][0], vw_[d][1], vw_[d][2], vw_[d][3]}; } }
    }
}

__device__ __forceinline__ void phase_cmp2(KP p, const Ctx& c) {
    unsigned char* ws = p->ws; const float* PC = (const float*)(ws + WS_PCMP); const int lane = c.lane, fr = lane & 15, fq = lane >> 4;
    const bf16_t* W2H = (const bf16_t*)(ws + WS_CW2T); const bf16_t* W2L = W2H + 2 * 64 * 128;
    constexpr int NPI = NB * G * 32, NSI = SB * G * 8, TOT = 2 * (NPI + NSI);
    for (int it = c.gw; it < TOT; it += c.ngw) {
        const bool samp = it >= 2 * NPI; const int r = samp ? it - 2 * NPI : it; const int kv = samp ? r / NSI : r / NPI; const int idx = samp ? r % NSI : r % NPI;
        const int hb = samp ? (idx >> 3) : (idx >> 5), n0 = 16 * (samp ? (idx & 7) : (idx & 31)), ncmp = samp ? NCMP_S : NCMP_P, nper = samp ? 128 : 512;
        const int n = n0 + fr; const bool live = n < ncmp;
        const size_t prow = (samp ? (size_t)8192 + (size_t)kv * 65536 : (size_t)kv * 4096) + (size_t)hb * nper + (live ? n : ncmp - 1);
        const float* cb = (const float*)(ws + WS_CBIAS) + kv * 128;
        bf16x8 hh[4], hl[4];
#pragma unroll
        for (int ks = 0; ks < 4; ++ks) { const int k0 = 32 * ks + 8 * fq; unsigned uh[8], ul[8];
            const f32x4 a0 = *(const f32x4*)(PC + prow * 256 + k0), a1 = *(const f32x4*)(PC + prow * 256 + k0 + 4);
            const f32x4 b0 = *(const f32x4*)(PC + (prow + 1) * 256 + 128 + k0), b1 = *(const f32x4*)(PC + (prow + 1) * 256 + 128 + k0 + 4);
            const f32x4 c0 = *(const f32x4*)(cb + k0), c1 = *(const f32x4*)(cb + k0 + 4);
#pragma unroll
            for (int e = 0; e < 8; ++e) { const float x = e < 4 ? a0[e] + b0[e] + c0[e] : a1[e - 4] + b1[e - 4] + c1[e - 4]; const float hv = gelu_tanh(x);
                uh[e] = f2bf(hv); ul[e] = f2bf(hv - __builtin_bit_cast(float, uh[e] << 16)); }
            const u32x4 wh = {uh[0] | (uh[1] << 16), uh[2] | (uh[3] << 16), uh[4] | (uh[5] << 16), uh[6] | (uh[7] << 16)}, wl = {ul[0] | (ul[1] << 16), ul[2] | (ul[3] << 16), ul[4] | (ul[5] << 16), ul[6] | (ul[7] << 16)};
            hh[ks] = __builtin_bit_cast(bf16x8, wh); hl[ks] = __builtin_bit_cast(bf16x8, wl); }
        f32x4 acc[4];
#pragma unroll
        for (int dt = 0; dt < 4; ++dt) { acc[dt] = *(const f32x4*)(p->in[I_CB2] + kv * 64 + 16 * dt + 4 * fq);
#pragma unroll
            for (int ks = 0; ks < 4; ++ks) { const size_t wo = (size_t)(kv * 64 + 16 * dt + fr) * 128 + 32 * ks + 8 * fq; const bf16x8 wh = *(const bf16x8*)(W2H + wo), wl = *(const bf16x8*)(W2L + wo);
                acc[dt] = mfma16(wh, hh[ks], acc[dt]); acc[dt] = mfma16(wh, hl[ks], acc[dt]); acc[dt] = mfma16(wl, hh[ks], acc[dt]); } }
        if (kv == 0) { float ss = 0.f;
#pragma unroll
            for (int dt = 0; dt < 4; ++dt) ss += (acc[dt][0] * acc[dt][0] + acc[dt][1] * acc[dt][1]) + (acc[dt][2] * acc[dt][2] + acc[dt][3] * acc[dt][3]);
            ss = sum_rows4(ss); const float rs = frsq(ss * (1.0f / 64.0f) + NORM_EPS);
#pragma unroll
            for (int dt = 0; dt < 4; ++dt) acc[dt] = acc[dt] * rs * *(const f32x4*)(p->in[I_KNG] + 16 * dt + 4 * fq); }
#pragma unroll
        for (int dt = 0; dt < 4; ++dt) { const f32x4 o = live ? acc[dt] : (f32x4){0.f, 0.f, 0.f, 0.f}; const int d = 16 * dt + 4 * fq;
            if (samp) *(f32x4*)((float*)(ws + (kv ? WS_CVS : WS_CKS)) + ((size_t)hb * 128 + n) * 64 + d) = o;
            else if (kv == 0) { u32x2 w; w.x = pk2(o[0], o[1]); w.y = pk2(o[2], o[3]); *(u32x2*)((bf16_t*)(ws + WS_CK) + ((size_t)hb * 512 + n) * 64 + d) = w; }
            else {
#pragma unroll
                for (int e = 0; e < 4; ++e) ((bf16_t*)(ws + WS_CV))[((size_t)hb * 64 + d + e) * 512 + n] = (bf16_t)f2bf(o[e]); } }
    }
}

__device__ __forceinline__ void phase_qpost(KP p, const Ctx& c, int lb) {
    const float* QF = (const float*)(p->ws + WS_QF); bf16_t* Q = (bf16_t*)(p->ws + WS_Q); const int lane = c.lane;
    const f32x4 gq = *(const f32x4*)(p->in[I_QNG] + lb * 64 + 4 * (lane & 15));
    for (int row = c.gw; row < R; row += c.ngw) { const float* src = QF + (size_t)row * NQP;
        f32x4 v[4]; load_row(src, lane, v);
#pragma unroll
        for (int j = 0; j < 4; ++j) { float s = (v[j][0] * v[j][0] + v[j][1] * v[j][1]) + (v[j][2] * v[j][2] + v[j][3] * v[j][3]);
            s = row16_sum(s);
            const float rs = (frsq(s * (1.0f / 64.0f) + NORM_EPS)) * (0.125f * 1.4426950408889634f); v[j] = v[j] * rs * gq; }
        store_row_bf16(Q + (size_t)row * D, lane, v);
    }
}
constexpr int AT_K0 = 0, AT_V0 = 9216, AT_K1 = 18432, AT_V1 = 27648, AT_IMP = 36864, IMPS = 132, AT_SELM = AT_IMP + 64 * IMPS * 4, AT_ANY = AT_SELM + 1024;
static_assert(AT_ANY + 16 <= RING_BYTES, "attention LDS map");
struct TileSrc { const bf16_t* K; const bf16_t* VT; int vts; };
__device__ __forceinline__ void tile_load(const TileSrc& s, int key0, int tid, u32x4& rk, u32x4& rv) {
    const int row = tid >> 3, ch = tid & 7;
    rk = *(const u32x4*)(s.K + (size_t)(key0 + row) * 64 + 8 * ch); rv = *(const u32x4*)(s.VT + (size_t)row * s.vts + key0 + 8 * ch);
}
__device__ __forceinline__ void tile_load_async(const TileSrc& s, int key0, int tid, u32x4& rk, u32x4& rv) {
    const int row = tid >> 3, ch = tid & 7;
    const bf16_t* pk = s.K + (size_t)(key0 + row) * 64 + 8 * ch; const bf16_t* pv = s.VT + (size_t)row * s.vts + key0 + 8 * ch;
    asm volatile("global_load_dwordx4 %0, %2, off\n\tglobal_load_dwordx4 %1, %3, off" : "=&v"(rk), "=&v"(rv) : "v"(pk), "v"(pv) : "memory");
}
#define TILE_WAIT(N_, RK_, RV_) asm volatile("s_waitcnt vmcnt(" #N_ ")" : "+v"(RK_), "+v"(RV_) :: "memory")
__device__ __forceinline__ void tile_store(LAS unsigned char* lds, int buf, int tid, const u32x4& rk, const u32x4& rv) {
    const int row = tid >> 3, ch = tid & 7;
    *(LAS u32x4*)(lds + (buf ? AT_K1 : AT_K0) + (row * SST + 8 * ch) * 2) = rk; *(LAS u32x4*)(lds + (buf ? AT_V1 : AT_V0) + (row * SST + 8 * ch) * 2) = rv;
}
__device__ __forceinline__ int first_bit4(unsigned a, unsigned b, unsigned c, unsigned d) { return a ? __ffs(a) - 1 : (b ? 32 + __ffs(b) - 1 : (c ? 64 + __ffs(c) - 1 : (d ? 96 + __ffs(d) - 1 : -1))); }
__device__ __forceinline__ float ex2(float x) { return __builtin_amdgcn_exp2f(x); }

__device__ __forceinline__ void set_bit4(int s, unsigned& t0, unsigned& t1, unsigned& t2, unsigned& t3) { const unsigned bit = 1u << (s & 31); const int w = s >> 5; t0 |= (w == 0) ? bit : 0u; t1 |= (w == 1) ? bit : 0u; t2 |= (w == 2) ? bit : 0u; t3 |= (w == 3) ? bit : 0u; }
__device__ __forceinline__ void clr_bit4(int s, unsigned& t0, unsigned& t1, unsigned& t2, unsigned& t3) { const unsigned bit = 1u << (s & 31); const int w = s >> 5; t0 &= ~((w == 0) ? bit : 0u); t1 &= ~((w == 1) ? bit : 0u); t2 &= ~((w == 2) ? bit : 0u); t3 &= ~((w == 3) ? bit : 0u); }
__device__ __forceinline__ unsigned get_word4(int s, unsigned a, unsigned b, unsigned c, unsigned d) { const int w = s >> 5; return ((w == 0) ? a : 0u) | ((w == 1) ? b : 0u) | ((w == 2) ? c : 0u) | ((w == 3) ? d : 0u); }
__device__ __forceinline__ float dpp_xor1(float x) { return __builtin_bit_cast(float, __builtin_amdgcn_update_dpp(0, __builtin_bit_cast(int, x), 0xB1, 0xF, 0xF, true)); }
__device__ __forceinline__ float dpp_xor2(float x) { return __builtin_bit_cast(float, __builtin_amdgcn_update_dpp(0, __builtin_bit_cast(int, x), 0x4E, 0xF, 0xF, true)); }
template <int MODE, bool EDGE> __device__ __forceinline__ void attn_tile(LAS unsigned char* lds, int buf, const bf16x8 (&qf)[4], int key0, int qpos, int r, int hf,
                                                                          float& l, f32x16 (&O)[2], float invl, bool selbit, LAS float* impq) {
    if (MODE == 3) { if (__ballot(selbit) == 0ull) { asm volatile("" : "+v"(O[0]), "+v"(O[1]), "+v"(l)); return; } }
    const unsigned smask = selbit ? 0xffffffffu : 0u;
    const int oK = buf ? AT_K1 : AT_K0, oV = buf ? AT_V1 : AT_V0;
#pragma unroll
    for (int kt = 0; kt < 2; ++kt) {
        f32x16 S;
#pragma unroll
        for (int i = 0; i < 16; ++i) S[i] = 0.f;
#pragma unroll
        for (int ks = 0; ks < 4; ++ks) S = mfma32(*(const LAS bf16x8*)(lds + oK + ((32 * kt + r) * SST + 16 * ks + 8 * hf) * 2), qf[ks], S);
        float ls = 0.f;
#pragma unroll
        for (int i = 0; i < 16; ++i) { float pv = ex2(S[i]);
            if (EDGE) { const int key = key0 + 32 * kt + (i & 3) + 8 * (i >> 2) + 4 * hf; bool v;
                if (MODE <= 1) v = (16 * key + 31 <= qpos); else if (MODE == 2) v = (key <= qpos) && (key + WIN > qpos); else v = (key <= qpos);
                pv = v ? pv : 0.f; }
            if (MODE == 1) pv *= invl;
            S[i] = pv; ls += pv; }
        if (MODE == 3) ls = selbit ? ls : 0.f;
        if (MODE != 1) l += ls;
        if (MODE >= 1) {
#pragma unroll
            for (int sp = 0; sp < 2; ++sp) {
                u32x4 pw; pw.x = pg8::cvt_pk_bf16(S[8 * sp + 0], S[8 * sp + 1]); pw.y = pg8::cvt_pk_bf16(S[8 * sp + 2], S[8 * sp + 3]); pw.z = pg8::cvt_pk_bf16(S[8 * sp + 4], S[8 * sp + 5]); pw.w = pg8::cvt_pk_bf16(S[8 * sp + 6], S[8 * sp + 7]);
                if (MODE == 3) { pw.x &= smask; pw.y &= smask; pw.z &= smask; pw.w &= smask; }
                const bf16x8 pf = __builtin_bit_cast(bf16x8, pw);
#pragma unroll
                for (int dt = 0; dt < 2; ++dt) { const int d = 32 * dt + r, kb = 32 * kt + 16 * sp + 4 * hf;
                    const u32x2 lo = *(const LAS u32x2*)(lds + oV + (d * SST + kb) * 2), hi = *(const LAS u32x2*)(lds + oV + (d * SST + kb + 8) * 2);
                    const u32x4 vw = {lo.x, lo.y, hi.x, hi.y};
                    O[dt] = mfma32(__builtin_bit_cast(bf16x8, vw), pf, O[dt]); } }
        }
        if (MODE == 1) {
            float own[4], nxt[4];
#pragma unroll
            for (int gq = 0; gq < 4; ++gq) { const float p3 = S[4 * gq + 3]; float o = 2.0f * (S[4 * gq] + S[4 * gq + 1] + S[4 * gq + 2]) + p3, n = p3;
                o += dpp_xor1(o); o += dpp_xor2(o); n += dpp_xor1(n); n += dpp_xor2(n); own[gq] = o; nxt[gq] = n; }
            const int sbb = (key0 >> 2) + 8 * kt + hf;
            if ((r & 3) == 0) {
#pragma unroll
                for (int gq = 0; gq < 4; ++gq) impq[sbb + 2 * gq] += own[gq]; }
            asm volatile("s_waitcnt lgkmcnt(0)" ::: "memory");
            if ((r & 3) == 0) {
#pragma unroll
                for (int gq = 0; gq < 4; ++gq) impq[sbb + 2 * gq + 1] += nxt[gq]; }
            asm volatile("s_waitcnt lgkmcnt(0)" ::: "memory");
        }
    }
}

template <int MODE> __device__ __forceinline__ void run_tiles(LAS unsigned char* lds, const TileSrc& src, unsigned t0, unsigned t1, unsigned t2, unsigned t3, int qt,
                                                              const bf16x8 (&qf)[4], int qpos, int r, int hf, int tid,
                                                              float& l, f32x16 (&O)[2], float invl, unsigned s0, unsigned s1, unsigned s2, unsigned s3, LAS float* impq, const int alias = 0) {
#define TSEL(n_) ((alias ? ((n_) & 7) : (n_)) * 64)
    tid = launder_v(tid); r = tid & 31; hf = (tid >> 5) & 1;
    int cur = first_bit4(t0, t1, t2, t3); if (cur < 0) return;
    const int first = cur;
    clr_bit4(cur, t0, t1, t2, t3); int n1 = first_bit4(t0, t1, t2, t3); if (n1 >= 0) clr_bit4(n1, t0, t1, t2, t3);
    int n2 = first_bit4(t0, t1, t2, t3); if (n2 >= 0) clr_bit4(n2, t0, t1, t2, t3);
    int n3 = first_bit4(t0, t1, t2, t3); if (n3 >= 0) clr_bit4(n3, t0, t1, t2, t3);
    u32x4 rkA, rvA, rkB, rvB, rkC, rvC; { u32x4 rk, rv; tile_load(src, TSEL(cur), tid, rk, rv); int b0 = 0; tile_store(lds, b0, tid, rk, rv); }
    tile_load_async(src, TSEL(n1 >= 0 ? n1 : first), tid, rkA, rvA);
    tile_load_async(src, TSEL(n2 >= 0 ? n2 : first), tid, rkB, rvB);
    tile_load_async(src, TSEL(n3 >= 0 ? n3 : first), tid, rkC, rvC);
    int buf = 0;
    __syncthreads();
#define RT_STEP(RK_, RV_) { \
        if (cur >= 0) { \
            const unsigned sw = get_word4(cur, s0, s1, s2, s3); \
            const bool sb = ((sw >> (cur & 31)) & 1u) != 0u; \
            if (MODE <= 1) attn_tile<MODE, true>(lds, buf, qf, cur * 64, qpos, r, hf, l, O, invl, sb, impq); \
            else { const bool edge = (cur == qt) || (MODE == 2 && cur == qt - 8); \
                if (edge) attn_tile<MODE, true>(lds, buf, qf, cur * 64, qpos, r, hf, l, O, invl, sb, impq); \
                else attn_tile<MODE, false>(lds, buf, qf, cur * 64, qpos, r, hf, l, O, invl, sb, impq); } } \
        TILE_WAIT(4, RK_, RV_); \
        tile_store(lds, buf ^ 1, tid, RK_, RV_); \
        __syncthreads(); \
        const int n4 = first_bit4(t0, t1, t2, t3); if (n4 >= 0) clr_bit4(n4, t0, t1, t2, t3); \
        tile_load_async(src, TSEL(n4 >= 0 ? n4 : first), tid, RK_, RV_); \
        buf ^= 1; cur = n1; n1 = n2; n2 = n3; n3 = n4; }
    do {
        RT_STEP(rkA, rvA)
        RT_STEP(rkB, rvB)
        RT_STEP(rkC, rvC)
    } while (cur >= 0);
#undef RT_STEP
    asm volatile("s_waitcnt vmcnt(0)" : "+v"(rkA), "+v"(rvA), "+v"(rkB), "+v"(rvB), "+v"(rkC), "+v"(rvC) :: "memory");
    __syncthreads();
}
__device__ __forceinline__ void attn_prompt_unit(KP p, const Ctx& c, int k, const int stop, const int lb) {
    LAS unsigned char* lds = c.lds; unsigned char* ws = p->ws; int tid_m; asm volatile("v_mbcnt_lo_u32_b32 %0, -1, 0\n\tv_mbcnt_hi_u32_b32 %0, -1, %0" : "=v"(tid_m));
    const int wave = c.wave, tid = tid_m + 64 * wave, lane = tid & 63, r = lane & 31, hf = lane >> 5;
    const int qt = 127 - (k >> 3), hb = k & 7, b = hb >> 2, g = hb & 3, q0 = 64 * qt;
    const int qi = 8 * wave + (r >> 2), head = 4 * g + (r & 3), qpos = q0 + qi, row = b * TP + qpos;
    bf16x8 qf[4];
    { const float* QFp = (const float*)(ws + WS_QF) + (size_t)row * NQP + head * 64 + 8 * hf; const float* gqp = p->in[I_QNG] + lb * 64 + 8 * hf;
      f32x4 qv[4][2]; float ss = 0.f;
#pragma unroll
      for (int ks = 0; ks < 4; ++ks) { qv[ks][0] = *(const f32x4*)(QFp + 16 * ks); qv[ks][1] = *(const f32x4*)(QFp + 16 * ks + 4);
#pragma unroll
          for (int e = 0; e < 4; ++e) ss += qv[ks][0][e] * qv[ks][0][e] + qv[ks][1][e] * qv[ks][1][e]; }
      ss = sum_xor32(ss);
      const float rs = frsq(ss * (1.0f / 64.0f) + NORM_EPS) * (0.125f * 1.4426950408889634f);
#pragma unroll
      for (int ks = 0; ks < 4; ++ks) { const f32x4 g0 = *(const f32x4*)(gqp + 16 * ks), g1 = *(const f32x4*)(gqp + 16 * ks + 4); const f32x4 a = qv[ks][0] * rs * g0, bq = qv[ks][1] * rs * g1;
          const u32x4 wq = {pk2(a[0], a[1]), pk2(a[2], a[3]), pk2(bq[0], bq[1]), pk2(bq[2], bq[3])}; qf[ks] = __builtin_bit_cast(bf16x8, wq); } }
    const float* gate = (const float*)(ws + WS_GATE) + (size_t)row * 48 + head * 3; const float g_c = gate[0], g_s = gate[1], g_w = gate[2];
    LAS float* imp = (LAS float*)(lds + AT_IMP); LAS unsigned* selm = (LAS unsigned*)(lds + AT_SELM); LAS unsigned* anym = (LAS unsigned*)(lds + AT_ANY);
    for (int e = tid; e < 64 * IMPS; e += 512) imp[e] = 0.f;
    if (tid < 4) anym[tid] = 0u;
    __syncthreads();
    f32x16 O[2]; unsigned OUTP[2][8];
#pragma unroll
    for (int dt = 0; dt < 2; ++dt)
#pragma unroll
        for (int i = 0; i < 16; ++i) O[dt][i] = 0.f;
    {
        const TileSrc src{(const bf16_t*)(ws + WS_CK) + (size_t)hb * 512 * 64, (const bf16_t*)(ws + WS_CV) + (size_t)hb * 64 * 512, 512};
        const int nmax = q0 + 63 - 31; const int ntc = nmax >= 0 ? (nmax >> 10) + 1 : 0;
        const unsigned tm = ntc >= 32 ? 0xffffffffu : ((1u << ntc) - 1u);
        float l = 0.f;
        run_tiles<0>(lds, src, tm, 0u, 0u, 0u, qt, qf, qpos, r, hf, tid, l, O, 0.f, 0u, 0u, 0u, 0u, imp);
        l = sum_xor32(l); const float invl = l > 0.f ? 1.0f / l : 0.f;
        run_tiles<1>(lds, src, tm, 0u, 0u, 0u, qt, qf, qpos, r, hf, tid, l, O, invl, 0u, 0u, 0u, 0u, imp + qi * IMPS);
#pragma unroll
        for (int dt = 0; dt < 2; ++dt) {
#pragma unroll
            for (int i = 0; i < 8; ++i) { OUTP[dt][i] = pg8::cvt_pk_bf16(O[dt][2 * i] * g_c, O[dt][2 * i + 1] * g_c); asm volatile("" : "+v"(OUTP[dt][i])); }
#pragma unroll
            for (int i = 0; i < 16; ++i) O[dt][i] = 0.f; }
    }
    __syncthreads();
    if (stop == 1) return;
    {
        unsigned k0[8], k1[8], T[8]; int Kq[8];
#pragma unroll
        for (int e = 0; e < 8; ++e) { const int qq = 8 * wave + e, qp = q0 + qq, qb = qp >> 6;
            const bool c0 = (64 * lane <= qp), c1 = (64 * (lane + 64) <= qp);
            const unsigned a0_ = (lane == 0 || lane == qb || lane == qb - 1) ? 0xffffffffu : __builtin_bit_cast(unsigned, imp[qq * IMPS + lane]);
            const unsigned a1_ = (lane + 64 == qb || lane + 64 == qb - 1) ? 0xffffffffu : __builtin_bit_cast(unsigned, imp[qq * IMPS + lane + 64]);
            k0[e] = c0 ? a0_ : 0u; k1[e] = c1 ? a1_ : 0u;
            Kq[e] = qb + 1 < 16 ? qb + 1 : 16; T[e] = 0u; }
        if (qt < 64) {
            for (int bit = 31; bit >= 0; --bit) {
#pragma unroll
                for (int e = 0; e < 8; ++e) { const unsigned cand = T[e] | (1u << bit);
                    const int cnt = __popcll(__ballot(k0[e] >= cand)); if (cnt >= Kq[e]) T[e] = cand; } } }
        else {
            for (int bit = 31; bit >= 0; --bit) {
#pragma unroll
                for (int e = 0; e < 8; ++e) { const unsigned cand = T[e] | (1u << bit);
                    const int cnt = __popcll(__ballot(k0[e] >= cand)) + __popcll(__ballot(k1[e] >= cand)); if (cnt >= Kq[e]) T[e] = cand; } } }
#pragma unroll
        for (int e = 0; e < 8; ++e) { const int qq = 8 * wave + e, qp = q0 + qq;
            const bool c0 = (64 * lane <= qp), c1 = (64 * (lane + 64) <= qp);
            unsigned long long mlo = __ballot(k0[e] > T[e]), mhi = __ballot(k1[e] > T[e]), elo = __ballot(c0 && k0[e] == T[e]), ehi = __ballot(c1 && k1[e] == T[e]);
            int need = Kq[e] - (__popcll(mlo) + __popcll(mhi));
            for (; need > 0; --need) { if (elo) { mlo |= elo & (~elo + 1ull); elo &= elo - 1ull; } else { mhi |= ehi & (~ehi + 1ull); ehi &= ehi - 1ull; } }
            const unsigned m0 = (unsigned)mlo, m1 = (unsigned)(mlo >> 32), m2 = (unsigned)mhi, m3 = (unsigned)(mhi >> 32);
            if (lane == 0) { selm[qq * 4 + 0] = m0; selm[qq * 4 + 1] = m1; selm[qq * 4 + 2] = m2; selm[qq * 4 + 3] = m3;
                atomicOr((unsigned*)&anym[0], m0); atomicOr((unsigned*)&anym[1], m1); atomicOr((unsigned*)&anym[2], m2); atomicOr((unsigned*)&anym[3], m3); } }
    }
    __syncthreads();
    if (stop == 2) return;
    {
        const TileSrc src{(const bf16_t*)(ws + WS_KW) + (size_t)hb * TP * 64, (const bf16_t*)(ws + WS_VW) + (size_t)hb * 64 * TP, TP};
        const int tlo = qt >= 8 ? qt - 8 : 0; unsigned t0 = 0u, t1 = 0u, t2 = 0u, t3 = 0u;
        for (int s = tlo; s <= qt; ++s) set_bit4(s, t0, t1, t2, t3);
        float l = 0.f;
        run_tiles<2>(lds, src, t0, t1, t2, t3, qt, qf, qpos, r, hf, tid, l, O, 0.f, 0u, 0u, 0u, 0u, imp);
        l = sum_xor32(l); const float sc = l > 0.f ? g_w / l : 0.f;
#pragma unroll
        for (int dt = 0; dt < 2; ++dt) {
#pragma unroll
            for (int i = 0; i < 8; ++i) { OUTP[dt][i] = pg8::cvt_pk_bf16(bflo(OUTP[dt][i]) + O[dt][2 * i] * sc, bfhi(OUTP[dt][i]) + O[dt][2 * i + 1] * sc); asm volatile("" : "+v"(OUTP[dt][i])); }
#pragma unroll
            for (int i = 0; i < 16; ++i) O[dt][i] = 0.f; }
    }
    if (stop == 3) { __syncthreads(); return; }
    {
        const TileSrc src{(const bf16_t*)(ws + WS_KS) + (size_t)hb * TP * 64, (const bf16_t*)(ws + WS_VS) + (size_t)hb * 64 * TP, TP};
        const unsigned sz_ = (stop == 5) ? 0u : 0xffffffffu;
        const unsigned s0 = selm[qi * 4 + 0] & sz_, s1 = selm[qi * 4 + 1] & sz_, s2 = selm[qi * 4 + 2] & sz_, s3 = selm[qi * 4 + 3] & sz_;
        const unsigned a0 = __builtin_amdgcn_readfirstlane(anym[0]), a1 = __builtin_amdgcn_readfirstlane(anym[1]), a2 = __builtin_amdgcn_readfirstlane(anym[2]), a3 = __builtin_amdgcn_readfirstlane(anym[3]);
        float l = 0.f;
        run_tiles<3>(lds, src, a0, a1, a2, a3, qt, qf, qpos, r, hf, tid, l, O, 0.f, s0, s1, s2, s3, imp, stop == 4 ? 1 : 0);
        if (stop >= 4) { if (l == 12345.678f) ((float*)(ws + WS_GATE))[0] = O[0][0] + O[1][0]; __syncthreads(); return; }
        l = sum_xor32(l); const float sc = l > 0.f ? g_s / l : 0.f;
#pragma unroll
        for (int dt = 0; dt < 2; ++dt)
#pragma unroll
            for (int i = 0; i < 8; ++i) OUTP[dt][i] = pg8::cvt_pk_bf16(bflo(OUTP[dt][i]) + O[dt][2 * i] * sc, bfhi(OUTP[dt][i]) + O[dt][2 * i + 1] * sc);
    }
    bf16_t* AO = (bf16_t*)(ws + WS_YG) + (size_t)row * D + head * 64;
#pragma unroll
    for (int dt = 0; dt < 2; ++dt)
#pragma unroll
        for (int gq = 0; gq < 4; ++gq) { u32x2 w; w.x = OUTP[dt][2 * gq]; w.y = OUTP[dt][2 * gq + 1]; *(u32x2*)(AO + 32 * dt + 8 * gq + 4 * hf) = w; }
    __syncthreads();
}

constexpr int SA_RED = 0, SA_REDW = 2 * 16 * 65 * 4, SA_OC = SA_RED + SA_REDW, SA_EC = SA_OC + 2 * 4096, SA_LC = SA_EC + 2 * 4096, SA_PN = SA_LC + 256, SA_SEL = SA_PN + 4 * 512;
static_assert(SA_SEL + 64 <= RING_BYTES, "sample attention LDS map");
__device__ __forceinline__ bf16x8 pack8(const f32x4 a, const f32x4 b) { const u32x4 w = {pk2(a[0], a[1]), pk2(a[2], a[3]), pk2(b[0], b[1]), pk2(b[2], b[3])}; return __builtin_bit_cast(bf16x8, w); }
__device__ __forceinline__ void sa_qk(const float* kb, size_t stride, int nrows, const bf16x8 (&qf)[2], int fr, int fq, f32x4 (&S)[4]) {
    f32x4 kr[4][2][2];
#pragma unroll
    for (int kg = 0; kg < 4; ++kg) { const int key = 16 * kg + fr; const float* rp = kb + (size_t)(key < nrows ? key : nrows - 1) * stride + 8 * fq;
#pragma unroll
        for (int ks = 0; ks < 2; ++ks) { kr[kg][ks][0] = *(const f32x4*)(rp + 32 * ks); kr[kg][ks][1] = *(const f32x4*)(rp + 32 * ks + 4); } }
#pragma unroll
    for (int kg = 0; kg < 4; ++kg) { S[kg] = (f32x4){0.f, 0.f, 0.f, 0.f};
#pragma unroll
        for (int ks = 0; ks < 2; ++ks) S[kg] = mfma16(pack8(kr[kg][ks][0], kr[kg][ks][1]), qf[ks], S[kg]); }
}
__device__ __forceinline__ void sa_pv(const float* vb, size_t stride, int nrows, const f32x4 (&P)[4], int fr, int fq, f32x4 (&O)[4]) {
#pragma unroll
    for (int ks = 0; ks < 2; ++ks) { const bf16x8 pa = pack8(P[2 * ks], P[2 * ks + 1]);
        float vv[4][8];
#pragma unroll
        for (int j = 0; j < 8; ++j) { const int key = 16 * (2 * ks + (j >> 2)) + 4 * fq + (j & 3); const float* rp = vb + (size_t)(key < nrows ? key : nrows - 1) * stride + fr;
#pragma unroll
            for (int dt = 0; dt < 4; ++dt) vv[dt][j] = rp[16 * dt]; }
#pragma unroll
        for (int dt = 0; dt < 4; ++dt) { const u32x4 w = {pk2(vv[dt][0], vv[dt][1]), pk2(vv[dt][2], vv[dt][3]), pk2(vv[dt][4], vv[dt][5]), pk2(vv[dt][6], vv[dt][7])};
            O[dt] = mfma16(pa, __builtin_bit_cast(bf16x8, w), O[dt]); } }
}
__device__ __forceinline__ void attn_sample_unit(KP p, const Ctx& c, int item, const int lb) {
    unsigned char* ws = p->ws; LAS unsigned char* lds = c.lds; const int tid = launder_v(c.tid), lane = tid & 63, wave = c.wave, fr = lane & 15, fq = lane >> 4; const int b = item >> 2, g = item & 3;
    bf16x8 qf[2];
    { const float* QFp = (const float*)(ws + WS_QF) + (size_t)(MP + 4 * b + (fr >> 2)) * NQP + (4 * g + (fr & 3)) * 64 + 8 * fq; const float* gqp = p->in[I_QNG] + lb * 64 + 8 * fq;
      f32x4 qv[2][2]; float ss = 0.f;
#pragma unroll
      for (int ks = 0; ks < 2; ++ks) { qv[ks][0] = *(const f32x4*)(QFp + 32 * ks); qv[ks][1] = *(const f32x4*)(QFp + 32 * ks + 4);
#pragma unroll
          for (int e = 0; e < 4; ++e) ss += qv[ks][0][e] * qv[ks][0][e] + qv[ks][1][e] * qv[ks][1][e]; }
      ss = sum_rows4(ss);
      const float rs = frsq(ss * (1.0f / 64.0f) + NORM_EPS) * (0.125f * 1.4426950408889634f);
#pragma unroll
      for (int ks = 0; ks < 2; ++ks) { const f32x4 g0 = *(const f32x4*)(gqp + 32 * ks), g1 = *(const f32x4*)(gqp + 32 * ks + 4); const f32x4 a = qv[ks][0] * rs * g0, bq = qv[ks][1] * rs * g1;
          const u32x4 wq = {pk2(a[0], a[1]), pk2(a[2], a[3]), pk2(bq[0], bq[1]), pk2(bq[2], bq[3])}; qf[ks] = __builtin_bit_cast(bf16x8, wq); } }
    const int tokm = fr >> 2;
    if (wave < 2) {
        const float* ck = (const float*)(ws + WS_CKS) + ((size_t)(b * 4 + g) * 128 + 64 * wave) * 64; const float* cv = (const float*)(ws + WS_CVS) + ((size_t)(b * 4 + g) * 128 + 64 * wave) * 64;
        const int nrows = wave ? 63 : 64;
        f32x4 S[4]; sa_qk(ck, 64, nrows, qf, fr, fq, S);
        float ls = 0.f;
#pragma unroll
        for (int kg = 0; kg < 4; ++kg)
#pragma unroll
            for (int r = 0; r < 4; ++r) { const int key = 16 * kg + 4 * fq + r; const float ev = key < nrows ? ex2(S[kg][r]) : 0.f; S[kg][r] = ev; ls += ev;
                *(LAS float*)(lds + SA_EC + wave * 4096 + (key * 16 + fr) * 4) = ev; }
        ls = sum_rows4(ls); if (fq == 0) *(LAS float*)(lds + SA_LC + (wave * 16 + fr) * 4) = ls;
        f32x4 oc[4];
#pragma unroll
        for (int dt = 0; dt < 4; ++dt) oc[dt] = (f32x4){0.f, 0.f, 0.f, 0.f};
        sa_pv(cv, 64, nrows, S, fr, fq, oc);
#pragma unroll
        for (int dt = 0; dt < 4; ++dt)
#pragma unroll
            for (int r = 0; r < 4; ++r) *(LAS float*)(lds + SA_OC + wave * 4096 + ((4 * fq + r) * 64 + 16 * dt + fr) * 4) = oc[dt][r];
    }
    __syncthreads();
    if (wave < 4) { const int tok = wave; float P0 = 0.f, P1 = 0.f;
#pragma unroll
        for (int hh = 0; hh < 4; ++hh) { const int pi = tok * 4 + hh; const float L = *(const LAS float*)(lds + SA_LC + pi * 4) + *(const LAS float*)(lds + SA_LC + (16 + pi) * 4); const float inv = L > 0.f ? 1.0f / L : 0.f;
            P0 += *(const LAS float*)(lds + SA_EC + (lane * 16 + pi) * 4) * inv; P1 += *(const LAS float*)(lds + SA_EC + 4096 + (lane * 16 + pi) * 4) * inv; }
        LAS float* pn = (LAS float*)(lds + SA_PN + tok * 512); pn[lane] = P0; pn[64 + lane] = P1; LDS_WAIT();
        float v0 = -1e9f;
        if (lane < 33) { const int s = lane; float im = 0.f;
            if (4 * s - 1 >= 0 && 4 * s - 1 < 128) im += pn[4 * s - 1];
#pragma unroll
            for (int j = 0; j < 3; ++j) if (4 * s + j < 128) im += 2.0f * pn[4 * s + j];
            if (4 * s + 3 < 128) im += pn[4 * s + 3];
            v0 = (s == 0 || s == 31 || s == 32) ? 1e9f : im; }
        unsigned selmask = 0u, sel32 = 0u;
        for (int it = 0; it < 16; ++it) { const float mx = wave_max(v0); if (mx < -5e8f) break; const unsigned long long b0 = __ballot(v0 == mx); const int s = __ffsll((long long)b0) - 1;
            if (lane == s) v0 = -2e9f; if (s < 32) selmask |= 1u << s; else sel32 = 1u; }
        if (lane == 0) { *(LAS unsigned*)(lds + SA_SEL + tok * 8) = selmask; *(LAS unsigned*)(lds + SA_SEL + tok * 8 + 4) = sel32; } }
    __syncthreads();
    unsigned sm[4], s32[4];
#pragma unroll
    for (int t = 0; t < 4; ++t) { sm[t] = *(const LAS unsigned*)(lds + SA_SEL + t * 8); s32[t] = *(const LAS unsigned*)(lds + SA_SEL + t * 8 + 4); }
    const unsigned un = sm[0] | sm[1] | sm[2] | sm[3]; const int nsel = __popc(un); const int has32 = (s32[0] | s32[1] | s32[2] | s32[3]) ? 1 : 0;
    const unsigned my_sm = tokm == 0 ? sm[0] : (tokm == 1 ? sm[1] : (tokm == 2 ? sm[2] : sm[3])), my_s32 = tokm == 0 ? s32[0] : (tokm == 1 ? s32[1] : (tokm == 2 ? s32[2] : s32[3]));
    const int ntile = nsel + has32 + 9;
    const int* pt = (const int*)p->in[I_PT] + b * NPAGES;
    f32x4 osel[4], owin[4]; float lsel = 0.f, lwin = 0.f;
#pragma unroll
    for (int dt = 0; dt < 4; ++dt) { osel[dt] = (f32x4){0.f, 0.f, 0.f, 0.f}; owin[dt] = (f32x4){0.f, 0.f, 0.f, 0.f}; }
    for (int ti = wave; ti < ntile; ti += 8) {
        const float* kb; size_t stride; int nrows = 64, br, mode, sidx = 0;
        if (ti < nsel) { unsigned m = un; for (int q = 0; q < ti; ++q) m &= m - 1u; sidx = __ffs(m) - 1; const int page = pt[sidx >> 1];
            kb = p->in[I_CKV] + ((size_t)page * PAGE + (sidx & 1) * 64) * 1024 + 2 * 256 + g * 64; stride = 1024; br = 0; mode = 0; }
        else if (ti < nsel + has32) { kb = p->out + O_KV + (size_t)(MP + 4 * b) * D + 2 * 256 + g * 64; stride = 1024; nrows = 4; br = 0; mode = 1; }
        else if (ti < nsel + has32 + 8) { sidx = ti - nsel - has32; kb = p->in[I_CWIN] + ((size_t)b * WIN + 64 * sidx) * 512 + g * 64; stride = 512; br = 1; mode = 2; }
        else { kb = p->out + O_WINS + ((size_t)(b * WIN + 508) * 2) * 256 + g * 64; stride = 512; nrows = 4; br = 1; mode = 3; }
        f32x4 S[4]; sa_qk(kb, stride, nrows, qf, fr, fq, S);
        float ls = 0.f;
#pragma unroll
        for (int kg = 0; kg < 4; ++kg)
#pragma unroll
            for (int r = 0; r < 4; ++r) { const int key = 16 * kg + 4 * fq + r; bool valid;
                if (mode == 0) valid = ((my_sm >> sidx) & 1u) != 0u; else if (mode == 1) valid = (my_s32 != 0u) && (key <= tokm); else if (mode == 2) valid = (64 * sidx + key) >= tokm + 1; else valid = key <= tokm;
                const float ev = valid ? ex2(S[kg][r]) : 0.f; S[kg][r] = ev; ls += ev; }
        if (br == 0) { lsel += ls; sa_pv(kb + 256, stride, nrows, S, fr, fq, osel); } else { lwin += ls; sa_pv(kb + 256, stride, nrows, S, fr, fq, owin); }
    }
    lsel = sum_rows4(lsel); lwin = sum_rows4(lwin);
    for (int w = 0; w < 8; ++w) {
        if (wave == w) {
#pragma unroll
            for (int dt = 0; dt < 4; ++dt)
#pragma unroll
                for (int r = 0; r < 4; ++r) { LAS float* r0 = (LAS float*)(lds + SA_RED + ((4 * fq + r) * 65 + 16 * dt + fr) * 4); LAS float* r1 = (LAS float*)(lds + SA_RED + ((16 + 4 * fq + r) * 65 + 16 * dt + fr) * 4);
                    if (w == 0) { *r0 = osel[dt][r]; *r1 = owin[dt][r]; } else { *r0 += osel[dt][r]; *r1 += owin[dt][r]; } }
            if (fq == 0) { LAS float* l0 = (LAS float*)(lds + SA_RED + (fr * 65 + 64) * 4); LAS float* l1 = (LAS float*)(lds + SA_RED + ((16 + fr) * 65 + 64) * 4);
                if (w == 0) { *l0 = lsel; *l1 = lwin; } else { *l0 += lsel; *l1 += lwin; } } }
        __syncthreads(); }
    { const float* gt = (const float*)(ws + WS_GATE); bf16_t* AO = (bf16_t*)(ws + WS_YG);
      for (int e = tid; e < 1024; e += 512) { const int pi = e >> 6, d = e & 63, tok = pi >> 2, hh = pi & 3; const size_t row = (size_t)(MP + 4 * b + tok);
          const float lc = *(const LAS float*)(lds + SA_LC + pi * 4) + *(const LAS float*)(lds + SA_LC + (16 + pi) * 4);
          const float oc = *(const LAS float*)(lds + SA_OC + (pi * 64 + d) * 4) + *(const LAS float*)(lds + SA_OC + 4096 + (pi * 64 + d) * 4);
          const LAS float* r0 = (const LAS float*)(lds + SA_RED + (pi * 65) * 4); const LAS float* r1 = (const LAS float*)(lds + SA_RED + ((16 + pi) * 65) * 4);
          const float* gg = gt + row * 48 + (4 * g + hh) * 3;
          float out = lc > 0.f ? gg[0] * oc / lc : 0.f;
          out += r0[64] > 0.f ? gg[1] * r0[d] / r0[64] : 0.f;
          out += r1[64] > 0.f ? gg[2] * r1[d] / r1[64] : 0.f;
          AO[row * D + (4 * g + hh) * 64 + d] = (bf16_t)f2bf(out); } }
    __syncthreads();
}

__device__ __forceinline__ void phase_attn_prompt(KP p, const Ctx& c, const int lb, const int stop = 0) {
    const int Gd = gridDim.x, cb = blockIdx.x;
    for (int i = 0; i * Gd < 1024; ++i) { const int k = i * Gd + ((i & 1) ? Gd - 1 - cb : cb); if (k < 1024) attn_prompt_unit(p, c, k, stop, lb); }
}
__device__ __forceinline__ void phase_attn_sample(KP p, const Ctx& c, const int lb) {
    for (int it = blockIdx.x; it < SB * G; it += gridDim.x) attn_sample_unit(p, c, it, lb);
}
#ifndef MK_MULTI
#define MK_MULTI 0
#endif
#if defined(PROBE_SCALE) || defined(SELFTEST)
constexpr int NPH = 44;
#elif defined(PROBE_ATTN2)
constexpr int NPH = 45;
#else
constexpr int NPH = 43;
#endif
#ifdef SPLITK
#define RESID_SPLIT(n) (n)
#else
#define RESID_SPLIT(n) 0
#endif

__global__ void __launch_bounds__(512, 2) mega(Params p) {
    extern __shared__ __attribute__((aligned(16))) unsigned char lds_raw[];
    LAS unsigned char* const lds0 = (LAS unsigned char*)lds_raw;
    volatile LAS unsigned* MISC = (volatile LAS unsigned*)(lds0 + MISC_OFF);
    for (int u = threadIdx.x; u < (LDS_BYTES - RING_BYTES) / 4; u += 512) ((LAS unsigned*)(lds0 + RING_BYTES))[u] = 0u;
    __syncthreads();
    const KP kp0 = (KP)__builtin_amdgcn_kernarg_segment_ptr();
    const int ph_lo = kp0->ph_lo, ph_hi = kp0->ph_hi, use_bar = kp0->use_bar;
    XcdBarrier bar; bar.bar = (unsigned*)(kp0->ws + WS_CTL); bar.x = 0; bar.st = nullptr;
    if (use_bar) bar = xcd_barrier_post((unsigned*)(kp0->ws + WS_CTL), MISC + 8);
    const int wave_s = __builtin_amdgcn_readfirstlane((int)threadIdx.x >> 6);
#define TID_MBCNT 1
#ifdef TID_MBCNT
#define TID_SRC(T_) asm volatile("v_mbcnt_lo_u32_b32 %0, -1, 0\n\tv_mbcnt_hi_u32_b32 %0, -1, %0" : "=v"(T_)); T_ += 64 * wave_s;
#else
#define TID_SRC(T_) T_ = threadIdx.x; asm volatile("" : "+v"(T_));
#endif
    int ph = 0;
#define PHASE_BEGIN if (ph >= ph_lo && ph < ph_hi) { KP p = kp0; asm volatile("" : "+s"(p)); int tid_; TID_SRC(tid_) \
        Ctx c; c.lds = lds0; c.tid = tid_; c.lane = tid_ & 63; c.wave = __builtin_amdgcn_readfirstlane(tid_ >> 6); c.gw = blockIdx.x * 8 + c.wave; c.ngw = gridDim.x * 8; c.gtid = blockIdx.x * 512 + tid_; c.gsz = gridDim.x * 512; \
        unsigned char* ws = p->ws; float* X = p->out + O_Y; (void)ws; (void)X;
#define PHASE_END   if (use_bar) { int te_; TID_SRC(te_) xcd_barrier(bar, te_ == 0); } } ++ph;

    PHASE_BEGIN phase_prologue(p, c); PHASE_END
#ifdef PROBE_BAR
    for (int xb = 0; xb < PROBE_BAR; ++xb) { if (use_bar) xcd_barrier(bar, threadIdx.x == 0); }
#endif

    for (int layer = 0; layer < NLAY; ++layer) {
        if (layer < 2) {
            const int li = layer;
            PHASE_BEGIN phase_mix(p, c, li); PHASE_END
            PHASE_BEGIN {
                pg8::Gemm g{(const bf16_t*)(ws + WS_XM), (const bf16_t*)(ws + WS_WRKV) + (size_t)li * 3072 * 1024, 3 * R, 3072, 1024, 1024};
                pg8::GroupOrder S; S.init((int)gridDim.x, (int)blockIdx.x); S.add(0, 0, 64, 0, 4); S.add(1, 66, 64, 4, 4); S.add(2, 132, 64, 8, 4);
                pg8::EpiF32G E{(float*)(ws + WS_RK_R), (float*)(ws + WS_RK_K), (float*)(ws + (li ? WS_V1 : WS_V0)), nullptr, D, 4, 66};
                pg8::gemm_phase<pg8::EpiF32G, pg8::GroupOrder, true, true>(c.lds, g, S, E, c.tid);
                {
                    const bf16_t* XMs = (const bf16_t*)(ws + WS_XM); const bf16_t* Wr = (const bf16_t*)(ws + WS_WRKV) + (size_t)li * 3072 * 1024;
                    for (int it = blockIdx.x + gridDim.x * c.wave; it < 768; it += c.ngw) { const int j = it >> 8, r = it & 255, row0 = MP + 32 * (r & 15), col0 = 64 * (r >> 4);
                        float* C = (float*)(ws + (j == 0 ? WS_RK_R : (j == 1 ? WS_RK_K : (li ? WS_V1 : WS_V0))));
                        f32x4 acc[4][2]; skinny_mma<4>(XMs + (size_t)j * R * D, 1024, Wr + (size_t)j * 1024 * 1024, 1024, 1024, row0, col0, c.lane, acc);
                        const int fr = c.lane & 15, fq = c.lane >> 4;
#pragma unroll
                        for (int nt = 0; nt < 4; ++nt)
#pragma unroll
                            for (int mt = 0; mt < 2; ++mt) *(f32x4*)(C + (size_t)(row0 + 16 * mt + fr) * D + col0 + 16 * nt + 4 * fq) = acc[nt][mt]; }
                }
                phase_lora1(p, c, li);
            } PHASE_END
            PHASE_BEGIN phase_scanA(p, c, li); PHASE_END
            PHASE_BEGIN phase_scanB(p, c, li); PHASE_END
            PHASE_BEGIN phase_scanC(p, c, li); PHASE_END
        } else {
            const int lb = layer - 2;
            if (layer == 2) {
                PHASE_BEGIN phase_norm(c, X, p->in[I_KVNG], (bf16_t*)(ws + WS_XN2), p->in[I_NORMG] + (size_t)(layer * 2) * D, (bf16_t*)(ws + WS_XN)); PHASE_END
                PHASE_BEGIN {
                    pg8::Gemm g{(const bf16_t*)(ws + WS_XN2), (const bf16_t*)(ws + WS_WKVT), R, NKV, 1024, 1024};
                    pg8::GroupOrder S; S.init((int)gridDim.x, (int)blockIdx.x); S.add(0, 0, 66, 0, 6);
                    pg8::EpiF32G E{(float*)(ws + WS_KVF), nullptr, nullptr, nullptr, NKV, 1 << 20, 0};
                    pg8::gemm_phase<pg8::EpiF32G, pg8::GroupOrder, true, true>(c.lds, g, S, E, c.tid);
                } PHASE_END
                PHASE_BEGIN phase_kvpost(p, c); PHASE_END
                PHASE_BEGIN {
                    pg8::Gemm g{(const bf16_t*)(ws + WS_CMPA), (const bf16_t*)(ws + WS_CW1T), (int)CMPA_ROWS, 512, 1024, 1024};
                    pg8::GroupOrder S; S.init((int)gridDim.x, (int)blockIdx.x); S.add(0, 0, 16, 0, 1); S.add(1, 16, 16, 1, 1); S.add(2, 32, 256, 0, 1); S.add(3, 288, 256, 1, 1);
                    pg8::EpiF32G E{(float*)(ws + WS_PCMP), (float*)(ws + WS_PCMP), nullptr, nullptr, 256, 1, 0};
                    pg8::gemm_phase<pg8::EpiF32G, pg8::GroupOrder, true, true>(c.lds, g, S, E, c.tid);
                } PHASE_END
                PHASE_BEGIN phase_cmp2(p, c); PHASE_END
            } else {
                PHASE_BEGIN phase_norm(c, X, p->in[I_NORMG] + (size_t)(layer * 2) * D, (bf16_t*)(ws + WS_XN), nullptr, nullptr); PHASE_END
            }
            PHASE_BEGIN {
                const bf16_t* XNp = (const bf16_t*)(ws + WS_XN); const bf16_t* Wq = (const bf16_t*)(ws + WS_WQT) + (size_t)lb * NQP * 1024; float* QFp = (float*)(ws + WS_QF);
                pg8::Gemm g{XNp, Wq, R, NQP, 1024, 1024};
                pg8::GroupOrder S; S.init((int)gridDim.x, (int)blockIdx.x); S.add(0, 0, 64, 0, 4);
                pg8::EpiF32G E{QFp, nullptr, nullptr, nullptr, NQP, 1 << 20, 0};
                pg8::gemm_phase<pg8::EpiF32G, pg8::GroupOrder, true, true>(c.lds, g, S, E, c.tid);
                float* GATEp = (float*)(ws + WS_GATE);
                for (int it = blockIdx.x + gridDim.x * c.wave; it < 256 + R / 32; it += c.ngw) { const int ln = launder_v(c.lane), fr = ln & 15, fq = ln >> 4;
                    if (it < 256) { const int row0 = MP + 32 * (it & 15), col0 = 64 * (it >> 4);
                        f32x4 acc[4][2]; skinny_mma<4>(XNp, 1024, Wq, 1024, 1024, row0, col0, ln, acc);
#pragma unroll
                        for (int nt = 0; nt < 4; ++nt)
#pragma unroll
                            for (int mt = 0; mt < 2; ++mt) *(f32x4*)(QFp + (size_t)(row0 + 16 * mt + fr) * NQP + col0 + 16 * nt + 4 * fq) = acc[nt][mt]; }
                    else { const int row0 = 32 * (it - 256);
                        f32x4 acc[3][2]; skinny_mma<3>(XNp, 1024, Wq, 1024, 1024, row0, 1024, ln, acc);
#pragma unroll
                        for (int nt = 0; nt < 3; ++nt)
#pragma unroll
                            for (int mt = 0; mt < 2; ++mt) { f32x4 v = acc[nt][mt];
#pragma unroll
                                for (int e = 0; e < 4; ++e) v[e] = sigmoidf_(v[e]);
                                *(f32x4*)(GATEp + (size_t)(row0 + 16 * mt + fr) * 48 + 16 * nt + 4 * fq) = v; } }
                }
            } PHASE_END
            PHASE_BEGIN phase_attn_prompt(p, c, lb); PHASE_END
#ifdef PROBE_ATTN2
            PHASE_BEGIN phase_attn_prompt(p, c, lb, PROBE_ATTN2); PHASE_END
#endif
            PHASE_BEGIN phase_attn_sample(p, c, lb); PHASE_END
        }
        PHASE_BEGIN {
            const bf16_t* Wt = layer < 2 ? (const bf16_t*)(ws + WS_WORW) + (size_t)layer * 1024 * 1024 : (const bf16_t*)(ws + WS_WONSA) + (size_t)(layer - 2) * 1024 * 1024;
            pg8::Gemm g{(const bf16_t*)(ws + WS_YG), Wt, R, 1024, 1024, 1024};
            pg8::GroupOrder S; S.init((int)gridDim.x, (int)blockIdx.x); S.add(0, 0, 64, 0, 4);
            pg8::EpiResid E{X, D};
            pg8::gemm_phase<pg8::EpiResid, pg8::GroupOrder, true, true>(c.lds, g, S, E, c.tid);
            skinny_resid_sample(c, (const bf16_t*)(ws + WS_YG), 1024, Wt, 1024, X);
        } PHASE_END
        PHASE_BEGIN phase_norm(c, X, p->in[I_NORMG] + (size_t)(layer * 2 + 1) * D, (bf16_t*)(ws + WS_XN), nullptr, nullptr); PHASE_END
        PHASE_BEGIN {
            pg8::Gemm g{(const bf16_t*)(ws + WS_XN), (const bf16_t*)(ws + WS_WINT) + (size_t)layer * 5632 * 1024, R, 5632, 1024, 1024};
            pg8::GroupOrder S; S.init((int)gridDim.x, (int)blockIdx.x); S.add(0, 0, 66, 0, 22);
            pg8::EpiWin E{(bf16_t*)(ws + WS_U), (bf16_t*)(ws + WS_GT), p->out + O_CVP + (size_t)layer * NB * 2 * DFF, p->out + O_CVS + (size_t)layer * SB * 2 * DFF};
            pg8::gemm_phase<pg8::EpiWin, pg8::GroupOrder, true, true>(c.lds, g, S, E, c.tid);
        } PHASE_END
        PHASE_BEGIN phase_conv(p, c, layer); PHASE_END
        PHASE_BEGIN {
            pg8::Gemm g{(const bf16_t*)(ws + WS_HH), (const bf16_t*)(ws + WS_WOUTT) + (size_t)layer * 1024 * 2816, R, 1024, 2816, 2816};
            pg8::GroupOrder S; S.init((int)gridDim.x, (int)blockIdx.x); S.add(0, 0, 64, 0, 4);
            pg8::EpiResid E{X, D};
            pg8::gemm_phase<pg8::EpiResid, pg8::GroupOrder, true, true>(c.lds, g, S, E, c.tid);
            skinny_resid_sample(c, (const bf16_t*)(ws + WS_HH), 2816, (const bf16_t*)(ws + WS_WOUTT) + (size_t)layer * 1024 * 2816, 2816, X);
        } PHASE_END
    }
#ifdef SELFTEST
    PHASE_BEGIN if (blockIdx.x == 0 && c.wave == 0) { const float x = (float)((c.lane * 37) & 63) + 1.0f; float poison = 0.f;
        if (__ballot(swz_xor16_n(x) != __shfl_xor(x, 16))) poison += 1e3f;
        if (__ballot(sum_xor32_n(x) != x + __shfl_xor(x, 32))) poison += 1e4f;
        if (__ballot(sum_rows4_n(x) != x + __shfl_xor(x, 16) + __shfl_xor(x, 32) + __shfl_xor(x, 48))) poison += 1e5f;
        if (__ballot(wave_sum_n(x) != 2080.0f)) poison += 1e6f;
        if (__ballot(wave_max_n(x) != 64.0f)) poison += 1e7f;
        if (c.lane == 0) p->out[O_CVS] += poison; } PHASE_END
#endif
#ifdef PROBE_SCALE
    PHASE_BEGIN for (size_t e = c.gtid; e < O_END; e += c.gsz) { int oi = e < O_KV ? (e < (size_t)MP * D ? 0 : 1) : e < O_WINP ? (e < O_KV + (size_t)MP * D ? 2 : 3) : e < O_WINS ? 4 : e < O_WKVP ? 5 : e < O_WKVS ? 6 : e < O_SHP ? 7 : e < O_SHS ? 8 : e < O_CVP ? 9 : e < O_CVS ? 10 : 11;
        if (PROBE_SCALE < 0) oi = 11 - oi; p->out[e] *= 1.0f + sqrtf(0.5e-4f * (float)(oi + 1)); } PHASE_END
#endif
#undef PHASE_BEGIN
#undef PHASE_END
}

extern "C" void kernel_launch(void* const* d_in, const int* in_sizes, int n_in, void* d_out, int out_size, void* d_ws, size_t ws_size, hipStream_t stream) {
    static int grid = 0;
    if (grid == 0) {
        if (n_in != 45 || (size_t)out_size != O_END || ws_size < WS_END) { fprintf(stderr, "kernel_launch: unexpected shapes (n_in %d out %d ws %zu need %zu)\n", n_in, out_size, ws_size, (size_t)WS_END); grid = -1; return; }
        int dev = 0, cus = 0, per_cu = 0;
        if (hipGetDevice(&dev) != hipSuccess || hipDeviceGetAttribute(&cus, hipDeviceAttributeMultiprocessorCount, dev) != hipSuccess) { grid = -1; return; }
        if (hipFuncSetAttribute((const void*)mega, hipFuncAttributeMaxDynamicSharedMemorySize, LDS_BYTES) != hipSuccess) { fprintf(stderr, "kernel_launch: hipFuncSetAttribute failed\n"); grid = -1; return; }
        if (hipOccupancyMaxActiveBlocksPerMultiprocessor(&per_cu, (const void*)mega, 512, LDS_BYTES) != hipSuccess || per_cu < 1) { fprintf(stderr, "kernel_launch: occupancy query says %d\n", per_cu); (void)hipGetLastError(); }
        grid = cus;
    }
    if (grid < 0) return;
    (void)hipMemsetAsync((char*)d_ws + WS_CTL, 0, CTL_BYTES, stream);
    Params p{};
    for (int i = 0; i < 45; ++i) p.in[i] = (const float*)d_in[i];
    p.out = (float*)d_out; p.ws = (unsigned char*)d_ws;
#ifdef PROBE_PRE
    { const int plist[] = PROBE_PRE; for (int i = 0; i < (int)(sizeof(plist) / sizeof(int)); ++i) { p.ph_lo = plist[i] % 100; p.ph_hi = p.ph_lo + 1; p.use_bar = 0; p.pad = plist[i] / 100;       hipLaunchKernelGGL(mega, dim3(grid), dim3(512), LDS_BYTES, stream, p); } }
#endif
    p.pad = 0;
#if MK_MULTI
    for (int i = 0; i < NPH; ++i) { p.ph_lo = i; p.ph_hi = i + 1; p.use_bar = 0; hipLaunchKernelGGL(mega, dim3(grid), dim3(512), LDS_BYTES, stream, p); }
#else
    p.ph_lo = 0; p.ph_hi = NPH; p.use_bar = 1;
    hipLaunchKernelGGL(mega, dim3(grid), dim3(512), LDS_BYTES, stream, p);
#endif
    const hipError_t le = hipPeekAtLastError();
    if (le != hipSuccess) fprintf(stderr, "kernel_launch: launch failed: %s\n", hipGetErrorName(le));
}
```

```cpp
#include <hip/hip_runtime.h>
#include <cstdio>
#include <cstdint>

#define LAS __attribute__((address_space(3)))
#define GAS __attribute__((address_space(1)))
typedef unsigned short bf16_t;
typedef short bf16x8 __attribute__((ext_vector_type(8)));
typedef float f32x4 __attribute__((ext_vector_type(4)));
typedef float f32x16 __attribute__((ext_vector_type(16)));
typedef float f32x2 __attribute__((ext_vector_type(2)));
typedef unsigned u32x4 __attribute__((ext_vector_type(4)));
typedef unsigned u32x2 __attribute__((ext_vector_type(2)));

constexpr int D = 1024, NB = 2, TP = 8192, MP = NB * TP, SB = 128, ST = 4, MS = SB * ST, R = MP + MS;
constexpr int PAST = 2048, PAGE = 128, NPAGES = PAST / PAGE;
constexpr int H = 16, HD = 64, G = 4, HPG = 4, DFF = 2816, NLAY = 4;
constexpr int LW_ = 64, LA_ = 64, LV_ = 32, LG_ = 128, LHID = 288;
constexpr int NKV = 1536, NQ = 1072, NQP = 1280;
constexpr int NCH = TP / 64;
constexpr int NUNIT_A = NB * NCH * H;
constexpr int NCMP_P = 511, NCMP_S = 127, WIN = 512;
constexpr float NORM_EPS = 1e-6f, GN_EPS = 64e-5f;

constexpr size_t O_Y = 0;
constexpr size_t O_KV = (size_t)R * D;
constexpr size_t O_WINP = O_KV + (size_t)R * D;
constexpr size_t O_WINS = O_WINP + (size_t)NB * 512 * 512;
constexpr size_t O_WKVP = O_WINS + (size_t)SB * 512 * 512;
constexpr size_t O_WKVS = O_WKVP + (size_t)2 * NB * H * 4096;
constexpr size_t O_SHP = O_WKVS + (size_t)2 * SB * H * 4096;
constexpr size_t O_SHS = O_SHP + (size_t)2 * NB * D;
constexpr size_t O_CVP = O_SHS + (size_t)2 * SB * D;
constexpr size_t O_CVS = O_CVP + (size_t)NLAY * NB * 2 * DFF;
constexpr size_t O_END = O_CVS + (size_t)NLAY * SB * 2 * DFF;
static_assert(O_END == 88915968, "output size");

constexpr size_t MiB = 1u << 20;
constexpr size_t al(size_t x) { return (x + 4095) & ~(size_t)4095; }
constexpr size_t WS_CTL = 0, CTL_BYTES = 1 * MiB;
constexpr size_t WS_WRKV = WS_CTL + CTL_BYTES;
constexpr size_t WS_WORW = WS_WRKV + al((size_t)2 * 3072 * 1024 * 2);
constexpr size_t WS_W1T = WS_WORW + al((size_t)2 * 1024 * 1024 * 2);
constexpr size_t WS_W2W = WS_W1T + al((size_t)2 * 288 * 1024 * 2);
constexpr size_t WS_W2A = WS_W2W + al((size_t)2 * 1024 * 64 * 2);
constexpr size_t WS_W2V = WS_W2A + al((size_t)2 * 1024 * 64 * 2);
constexpr size_t WS_W2G = WS_W2V + al((size_t)1024 * 32 * 2);
constexpr size_t WS_WKVT = WS_W2G + al((size_t)2 * 1024 * 128 * 2);
constexpr size_t WS_WQT = WS_WKVT + al((size_t)1536 * 1024 * 2);
constexpr size_t WS_WONSA = WS_WQT + al((size_t)2 * 1280 * 1024 * 2);
constexpr size_t WS_WINT = WS_WONSA + al((size_t)2 * 1024 * 1024 * 2);
constexpr size_t WS_WOUTT = WS_WINT + al((size_t)4 * 5632 * 1024 * 2);
constexpr size_t WS_CW1T = WS_WOUTT + al((size_t)4 * 1024 * 2816 * 2);
constexpr size_t WS_CBIAS = WS_CW1T + al((size_t)2 * 256 * 1024 * 2);
constexpr size_t WS_CW2T = WS_CBIAS + al(2 * 128 * 4);
constexpr size_t WS_XM = WS_CW2T + al(2 * 2 * 64 * 128 * 2);
constexpr size_t WS_RK_R = WS_XM + al((size_t)6 * R * D * 2);
constexpr size_t WS_RK_K = WS_RK_R + al((size_t)R * D * 4);
constexpr size_t WS_V0 = WS_RK_K + al((size_t)R * D * 4);
constexpr size_t WS_V1 = WS_V0 + al((size_t)R * D * 4);
constexpr size_t WS_HID = WS_V1 + al((size_t)R * D * 4);
constexpr size_t WS_MT = WS_HID + al((size_t)R * LHID * 2);
constexpr size_t WS_NN = WS_MT + al((size_t)NUNIT_A * 4096 * 4);
constexpr size_t WS_RP = WS_NN + al((size_t)NUNIT_A * 4096 * 4);
constexpr size_t WS_YL = WS_RP + al((size_t)NUNIT_A * 4096 * 2);
constexpr size_t WS_S0 = WS_YL + al((size_t)NUNIT_A * 4096 * 4);
constexpr size_t WS_RKS = WS_S0 + al((size_t)NUNIT_A * 4096 * 2);
constexpr size_t WS_YG = WS_RKS + al((size_t)R * 16 * 4);
constexpr size_t WS_XN = WS_YG + al((size_t)R * D * 2);
constexpr size_t WS_XN2 = WS_XN + al((size_t)R * D * 2);
constexpr size_t WS_U = WS_XN2 + al((size_t)R * D * 2);
constexpr size_t WS_GT = WS_U + al((size_t)R * DFF * 2);
constexpr size_t WS_HH = WS_GT + al((size_t)R * DFF * 2);
constexpr size_t WS_KVF = WS_HH + al((size_t)R * DFF * 2);
constexpr size_t WS_CMPA = WS_KVF + al((size_t)R * NKV * 4);
constexpr size_t CMPA_ROWS = 4096 + 4096 + 65536 + 65536;
constexpr size_t WS_PCMP = WS_CMPA + al(CMPA_ROWS * 1024 * 2);
constexpr size_t WS_KS = WS_PCMP + al(CMPA_ROWS * 256 * 4);
constexpr size_t WS_VS = WS_KS + al((size_t)NB * G * TP * 64 * 2);
constexpr size_t WS_KW = WS_VS + al((size_t)NB * G * TP * 64 * 2);
constexpr size_t WS_VW = WS_KW + al((size_t)NB * G * TP * 64 * 2);
constexpr size_t WS_CK = WS_VW + al((size_t)NB * G * TP * 64 * 2);
constexpr size_t WS_CV = WS_CK + al((size_t)NB * G * 512 * 64 * 2);
constexpr size_t WS_CKS = WS_CV + al((size_t)NB * G * 512 * 64 * 2);
constexpr size_t WS_CVS = WS_CKS + al((size_t)SB * G * 128 * 64 * 4);
constexpr size_t WS_QF = WS_CVS + al((size_t)SB * G * 128 * 64 * 4);
constexpr size_t WS_Q = WS_QF + al((size_t)R * NQP * 4);
constexpr size_t WS_GATE = WS_Q + al((size_t)R * D * 2);
constexpr size_t WS_END = WS_GATE + al((size_t)R * 48 * 4);

typedef __bf16 bf16v2_ __attribute__((ext_vector_type(2)));
__device__ __forceinline__ unsigned cvt_pk_bf16_(float lo, float hi) { const f32x2 v = {lo, hi}; const bf16v2_ b = __builtin_convertvector(v, bf16v2_); return __builtin_bit_cast(unsigned, b); }
__device__ __forceinline__ unsigned f2bf(float f) { return cvt_pk_bf16_(f, f) & 0xffffu; }
__device__ __forceinline__ unsigned pk2(float lo, float hi) { return cvt_pk_bf16_(lo, hi); }
__device__ __forceinline__ float frcp(float x) { return __builtin_amdgcn_rcpf(x); }
__device__ __forceinline__ float frsq(float x) { return __builtin_amdgcn_rsqf(x); }
__device__ __forceinline__ float bf2f(unsigned short b) { return __builtin_bit_cast(float, ((unsigned)b) << 16); }
__device__ __forceinline__ float bflo(unsigned w) { return __builtin_bit_cast(float, w << 16); }
__device__ __forceinline__ float bfhi(unsigned w) { return __builtin_bit_cast(float, w & 0xffff0000u); }
template <int CTRL> __device__ __forceinline__ float dpp_f(float x) { return __builtin_bit_cast(float, __builtin_amdgcn_update_dpp(0, __builtin_bit_cast(int, x), CTRL, 0xF, 0xF, true)); }
__device__ __forceinline__ float row16_sum(float v) { v += dpp_f<0xB1>(v); v += dpp_f<0x4E>(v); v += dpp_f<0x141>(v); v += dpp_f<0x140>(v); return v; }
__device__ __forceinline__ float row16_max(float v) { v = fmaxf(v, dpp_f<0xB1>(v)); v = fmaxf(v, dpp_f<0x4E>(v)); v = fmaxf(v, dpp_f<0x141>(v)); v = fmaxf(v, dpp_f<0x140>(v)); return v; }
__device__ __forceinline__ float swz_xor16_n(float x) { return __builtin_bit_cast(float, __builtin_amdgcn_ds_swizzle(__builtin_bit_cast(int, x), 0x401F)); }
__device__ __forceinline__ float sum_xor32_n(float x) { auto rr = __builtin_amdgcn_permlane32_swap(__float_as_uint(x), __float_as_uint(x), false, false);
    return __uint_as_float(rr[0]) + __uint_as_float(rr[1]); }
__device__ __forceinline__ float sum_rows4_n(float x) { x += swz_xor16_n(x); return sum_xor32_n(x); }
__device__ __forceinline__ float wave_sum_n(float v) {
    v = row16_sum(v);
    v += __builtin_bit_cast(float, __builtin_amdgcn_update_dpp(0, __builtin_bit_cast(int, v), 0x142, 0xA, 0xF, false));
    v += __builtin_bit_cast(float, __builtin_amdgcn_update_dpp(0, __builtin_bit_cast(int, v), 0x143, 0xC, 0xF, false));
    return __builtin_bit_cast(float, __builtin_amdgcn_readlane(__builtin_bit_cast(int, v), 63));
}
__device__ __forceinline__ float wave_max_n(float v) {
    v = row16_max(v);
    v = fmaxf(v, __builtin_bit_cast(float, __builtin_amdgcn_update_dpp(__builtin_bit_cast(int, v), __builtin_bit_cast(int, v), 0x142, 0xA, 0xF, false)));
    v = fmaxf(v, __builtin_bit_cast(float, __builtin_amdgcn_update_dpp(__builtin_bit_cast(int, v), __builtin_bit_cast(int, v), 0x143, 0xC, 0xF, false)));
    return __builtin_bit_cast(float, __builtin_amdgcn_readlane(__builtin_bit_cast(int, v), 63));
}
#define XLANE_NEW 1
#ifdef XLANE_NEW
__device__ __forceinline__ float swz_xor16(float x) { return __builtin_bit_cast(float, __builtin_amdgcn_ds_swizzle(__builtin_bit_cast(int, x), 0x401F)); }
__device__ __forceinline__ float sum_xor32(float x) { return sum_xor32_n(x); }
__device__ __forceinline__ float sum_rows4(float x) { x += swz_xor16(x); return sum_xor32(x); }
__device__ __forceinline__ float wave_sum(float v) {
    v = row16_sum(v);
    v += __builtin_bit_cast(float, __builtin_amdgcn_update_dpp(0, __builtin_bit_cast(int, v), 0x142, 0xA, 0xF, false));
    v += __builtin_bit_cast(float, __builtin_amdgcn_update_dpp(0, __builtin_bit_cast(int, v), 0x143, 0xC, 0xF, false));
    return __builtin_bit_cast(float, __builtin_amdgcn_readlane(__builtin_bit_cast(int, v), 63));
}
__device__ __forceinline__ float wave_max(float v) {
    v = row16_max(v);
    v = fmaxf(v, __builtin_bit_cast(float, __builtin_amdgcn_update_dpp(__builtin_bit_cast(int, v), __builtin_bit_cast(int, v), 0x142, 0xA, 0xF, false)));
    v = fmaxf(v, __builtin_bit_cast(float, __builtin_amdgcn_update_dpp(__builtin_bit_cast(int, v), __builtin_bit_cast(int, v), 0x143, 0xC, 0xF, false)));
    return __builtin_bit_cast(float, __builtin_amdgcn_readlane(__builtin_bit_cast(int, v), 63));
}
#else
__device__ __forceinline__ float sum_xor32(float x) { return x + __shfl_xor(x, 32); }
__device__ __forceinline__ float sum_rows4(float x) { x += __shfl_xor(x, 16); x += __shfl_xor(x, 32); return x; }
__device__ __forceinline__ float wave_sum(float v) { v = row16_sum(v); v += __shfl_xor(v, 16); v += __shfl_xor(v, 32); return v; }
__device__ __forceinline__ float wave_max(float v) { v = row16_max(v); v = fmaxf(v, __shfl_xor(v, 16)); v = fmaxf(v, __shfl_xor(v, 32)); return v; }
#endif
__device__ __forceinline__ float sigmoidf_(float x) { return frcp(1.0f + __builtin_amdgcn_exp2f(-1.4426950408889634f * x)); }
__device__ __forceinline__ float gelu_tanh(float x) {
    const float u = 0.7978845608028654f * (x + 0.044715f * x * x * x);
    const float e = __builtin_amdgcn_exp2f(2.8853900817779268f * u);
    const float th = 1.0f - 2.0f * frcp(e + 1.0f);
    return 0.5f * x * (1.0f + th);
}
template <class T> __device__ __forceinline__ const T* launder_p(const T* q) { asm volatile("" : "+v"(q)); return q; }
__device__ __forceinline__ int launder_v(int x) { asm volatile("" : "+v"(x)); return x; }
#define LDS_WAIT() asm volatile("s_waitcnt lgkmcnt(0)" ::: "memory")
#define VM_WAIT() asm volatile("s_waitcnt vmcnt(0)" ::: "memory")
__device__ __forceinline__ f32x4 mfma16(bf16x8 a, bf16x8 b, f32x4 c) { return __builtin_amdgcn_mfma_f32_16x16x32_bf16(a, b, c, 0, 0, 0); }
__device__ __forceinline__ f32x16 mfma32(bf16x8 a, bf16x8 b, f32x16 c) { return __builtin_amdgcn_mfma_f32_32x32x16_bf16(a, b, c, 0, 0, 0); }
#define XB_TMO      128
#define XB_XCNT(j)  (256  + 64 * (j))
#define XB_XSUB(j)  (1280 + 64 * (j))
#define XB_XGEN(j)  (2304 + 64 * (j))
#define XB_TOP      3328
#define XB_TOPGEN   3392
#define XCD_BAR_WORDS 3456
#define XB_SPIN_CAP (1u << 18)

__device__ __forceinline__ unsigned xb_ld(unsigned* p)              { return __hip_atomic_load(p, __ATOMIC_RELAXED, __HIP_MEMORY_SCOPE_AGENT); }
__device__ __forceinline__ unsigned xb_add(unsigned* p, unsigned v) { return __hip_atomic_fetch_add(p, v, __ATOMIC_RELAXED, __HIP_MEMORY_SCOPE_AGENT); }
__device__ __forceinline__ unsigned xb_xcc_id() { return (unsigned)__builtin_amdgcn_s_getreg((3 << 11) | 20) & 0xFu; }
#define XB_SPIN(cond, bar) do { unsigned _sp = 0; while (cond) { __builtin_amdgcn_s_sleep(1); \
    if ((++_sp & 255u) == 0u) { if (xb_ld(&(bar)[XB_TMO])) break; if (_sp > XB_SPIN_CAP) { atomicAdd(&(bar)[XB_TMO], 1u); break; } } } } while (0)

struct XcdBarrier {
    unsigned* bar; unsigned x;
    volatile LAS unsigned* st;
};

__device__ __forceinline__ XcdBarrier xcd_barrier_post(unsigned* bar, volatile LAS unsigned* st) {
    XcdBarrier b; b.bar = bar; b.x = xb_xcc_id(); b.st = st;
    if (threadIdx.x == 0) (void)xb_add(&bar[XB_XCNT(b.x)], 1u);
    return b;
}
__device__ __forceinline__ void xcd_barrier_complete(unsigned* bar, unsigned x, unsigned& nloc, unsigned& nx) {
    const unsigned G = gridDim.x * gridDim.y * gridDim.z;
    unsigned sum, cnt, mine, sp = 0u;
    for (;;) {
        sum = 0u; cnt = 0u; mine = 0u;
#pragma unroll
        for (unsigned j = 0; j < 16; ++j) { const unsigned c = xb_ld(&bar[XB_XCNT(j)]); sum += c; cnt += (c > 0u) ? 1u : 0u; mine = (j == x) ? c : mine; }
        if (sum == G) break;
        __builtin_amdgcn_s_sleep(1);
        if ((++sp & 255u) == 0u) { if (xb_ld(&bar[XB_TMO])) break; if (sp > XB_SPIN_CAP) { atomicAdd(&bar[XB_TMO], 1u); break; } }
    }
    nloc = mine > 0u ? mine : 1u; nx = cnt > 0u ? cnt : 1u;
}

__device__ __forceinline__ void xcd_barrier(const XcdBarrier& b, const bool t0) {
    asm volatile("s_waitcnt vmcnt(0)" ::: "memory");
    __syncthreads();
    if (t0) {
        unsigned* bar = b.bar;
        __builtin_amdgcn_s_waitcnt(0);
        unsigned nloc = b.st[0], nx = b.st[1];
        if (nloc == 0u) { xcd_barrier_complete(bar, b.x, nloc, nx); b.st[0] = nloc; b.st[1] = nx; }
        const unsigned old = xb_add(&bar[XB_XSUB(b.x)], 1u);
        const unsigned gen = old / nloc;
        if (old + 1u == (gen + 1u) * nloc) {
            __builtin_amdgcn_fence(__ATOMIC_RELEASE, "agent");
            asm volatile("s_waitcnt vmcnt(0)" ::: "memory");
            const unsigned og = xb_add(&bar[XB_TOP], 1u);
            const unsigned tg = og / nx;
            if (og + 1u == (tg + 1u) * nx) xb_add(&bar[XB_TOPGEN], 1u);
            else XB_SPIN(xb_ld(&bar[XB_TOPGEN]) == tg, bar);
            __builtin_amdgcn_fence(__ATOMIC_ACQUIRE, "agent");
            xb_add(&bar[XB_XGEN(b.x)], 1u);
            asm volatile("s_waitcnt vmcnt(0)" ::: "memory");
        } else {
            XB_SPIN(xb_ld(&bar[XB_XGEN(b.x)]) == gen, bar);
            __builtin_amdgcn_fence(__ATOMIC_ACQUIRE, "agent");
            asm volatile("s_waitcnt vmcnt(0)" ::: "memory");
        }
    }
    __syncthreads();
}

namespace pg8 {
#define PG8_LAS __attribute__((address_space(3)))
constexpr int BM = 256, BK = 64, HALF = 128, HTB = HALF * BK * 2  , STAGE_BYTES = 8 * HTB, NXCD = 8, WGM = 8;
__host__ __device__ __forceinline__ int lds_byte(int r, int c) { const int st = (r >> 4) * 2 + (c >> 5), rr = r & 15, cc = c & 31, ob = rr * 64 + cc * 2; return st * 1024 + (ob ^ (((ob >> 9) & 1) << 5)); }
__host__ __device__ __forceinline__ void stage_rc(int b, int& R_, int& C_) { const int st = b / 1024, sb = b % 1024, swz = sb ^ (((sb >> 9) & 1) << 5); R_ = (st >> 1) * 16 + swz / 64; C_ = (st & 1) * 32 + (swz % 64) / 2; }
__host__ __device__ __forceinline__ int perm32(int rho) { const int n = rho >> 4, i = rho & 15; return 8 * (i >> 2) + 4 * n + (i & 3); }

struct Unit { int pm, pn, kb, nt; };
struct Gemm { const bf16_t* A; const bf16_t* Bt; int M, N, K, KL; };

struct GroupOrder {
    int pm0[4], nM[4], pn0[4], nN[4]; int nseg, nwg, G_, c;
    __device__ __forceinline__ void init(int G__, int c_) { nseg = 0; nwg = 0; G_ = G__; c = c_;
#pragma unroll
        for (int s = 0; s < 4; ++s) { pm0[s] = 0; nM[s] = 0; pn0[s] = 0; nN[s] = 1; } }
    __device__ __forceinline__ void add(int s, int pm0_, int nM_, int pn0_, int nN_) { pm0[s] = pm0_; nM[s] = nM_; pn0[s] = pn0_; nN[s] = nN_; nwg += nM_ * nN_; nseg = s + 1; }
    __device__ __forceinline__ bool next(int i, Unit& u) const {
        const long L = (long)i * G_ + c; if (L >= nwg) return false;
        int id = (int)L; { const int q = nwg / NXCD, r = nwg % NXCD, xcd = id % NXCD, off = id / NXCD; id = (xcd < r ? xcd * (q + 1) : r * (q + 1) + (xcd - r) * q) + off; }
        int spm0 = 0, snM = 1, spn0 = 0, snN = 1; bool found = false;
#pragma unroll
        for (int s = 0; s < 4; ++s) { const int cnt = nM[s] * nN[s]; if (!found) { if (id < cnt) { found = true; spm0 = pm0[s]; snM = nM[s]; spn0 = pn0[s]; snN = nN[s]; } else id -= cnt; } }
        const int nig = WGM * snN, gid = id / nig, fm = gid * WGM, gsz = (snM - fm) < WGM ? (snM - fm) : WGM;
        u.pm = spm0 + fm + ((id % nig) % gsz); u.pn = spn0 + (id % nig) / gsz; u.kb = 0; u.nt = 0; return true;
    }
    __device__ __forceinline__ void a_ready(const Unit&) const {}
    __device__ __forceinline__ void done(const Unit&) const {}
};

struct ResidOrder {
    GroupOrder P; int nS, G_, c;
    __device__ __forceinline__ void init(int G__, int c_, int nS_) { P.init(G__, c_); P.add(0, 0, nS_ ? 64 : 66, 0, 4); nS = nS_; G_ = G__; c = c_; }
    __device__ __forceinline__ bool next(int i, Unit& u) const {
        const int npc = c < P.nwg ? (P.nwg - 1 - c) / G_ + 1 : 0;
        if (i < npc) return P.next(i, u);
        const int L = (i - npc) * G_ + (G_ - 1 - c); if (L >= 8 * nS) return false;
        const int sl = L >> 3, t = L & 7; u.pm = 64 + (t & 1); u.pn = t >> 1; u.kb = sl * 512; u.nt = 4; return true; }
    __device__ __forceinline__ void a_ready(const Unit&) const {}
    __device__ __forceinline__ void done(const Unit&) const {}
};
__device__ __forceinline__ unsigned cvt_pk_bf16(float lo, float hi) { return cvt_pk_bf16_(lo, hi); }

struct EpiF32G {
    static constexpr bool PERM = false, AFTER_DRAIN = false;
    float* b0; float* b1; float* b2; float* b3; int ldc, png, pmg;
    __device__ __forceinline__ void operator()(const f32x4 (&acc)[2][2][4][2], const Unit& u, int wr, int wc, int fr, int fq) const {
        const int j = u.pn / png; float* C = j == 0 ? b0 : (j == 1 ? b1 : (j == 2 ? b2 : b3));
        const int row0 = (u.pm - j * pmg) * BM + wr * 64 + fr, col0 = (u.pn - j * png) * BM + wc * 32 + 4 * fq;
#pragma unroll
        for (int ai = 0; ai < 2; ++ai)
#pragma unroll
            for (int m = 0; m < 4; ++m) { float* rowp = C + (size_t)(row0 + ai * HALF + m * 16) * ldc + col0;
#pragma unroll
                for (int bj = 0; bj < 2; ++bj)
#pragma unroll
                    for (int n = 0; n < 2; ++n) *(f32x4*)(rowp + bj * HALF + n * 16) = acc[ai][bj][m][n]; }
    }
};
struct EpiResid {
    static constexpr bool PERM = false, AFTER_DRAIN = false;
    float* X; int ldc;
    __device__ __forceinline__ void operator()(const f32x4 (&acc)[2][2][4][2], const Unit& u, int wr, int wc, int fr, int fq) const {
        const int row0 = u.pm * BM + wr * 64 + fr, col0 = u.pn * BM + wc * 32 + 4 * fq; const bool split = u.nt != 0;
#pragma unroll
        for (int ai = 0; ai < 2; ++ai)
#pragma unroll
            for (int m = 0; m < 4; ++m) { float* rowp = X + (size_t)(row0 + ai * HALF + m * 16) * ldc + col0;
                if (!split) {
#pragma unroll
                    for (int bj = 0; bj < 2; ++bj)
#pragma unroll
                        for (int n = 0; n < 2; ++n) { f32x4* p = (f32x4*)(rowp + bj * HALF + n * 16); *p = *p + acc[ai][bj][m][n]; } }
                else {
#pragma unroll
                    for (int bj = 0; bj < 2; ++bj)
#pragma unroll
                        for (int n = 0; n < 2; ++n) { float* q = rowp + bj * HALF + n * 16;
#pragma unroll
                            for (int e = 0; e < 4; ++e) __hip_atomic_fetch_add(q + e, acc[ai][bj][m][n][e], __ATOMIC_RELAXED, __HIP_MEMORY_SCOPE_AGENT); } }
                asm volatile("" ::: "memory"); }
    }
};
struct EpiWin {
    static constexpr bool PERM = true, AFTER_DRAIN = false;
    bf16_t* U; bf16_t* GT; float* cvp; float* cvs;
    __device__ __forceinline__ void operator()(const f32x4 (&acc)[2][2][4][2], const Unit& u, int wr, int wc, int fr, int fq) const {
        const bool isu = u.pn < 11; bf16_t* base = isu ? U : GT; const int colt = (isu ? u.pn : u.pn - 11) * BM;
        const int row0 = u.pm * BM + wr * 64 + fr, col0 = colt + wc * 32 + 8 * fq;
#pragma unroll
        for (int ai = 0; ai < 2; ++ai)
#pragma unroll
            for (int m = 0; m < 4; ++m) { const int row = row0 + ai * HALF + m * 16; bf16_t* rowp = base + (size_t)row * DFF + col0;
                float* cv = nullptr;
                if (isu) { if (row >= MP) { const int t = (row - MP) & 3, b = (row - MP) >> 2; if (t >= 2) cv = cvs + (size_t)(b * 2 + (t - 2)) * DFF; }
                           else { const int tt = row & (TP - 1); if (tt >= TP - 2) cv = cvp + (size_t)((row >> 13) * 2 + (tt - (TP - 2))) * DFF; } }
#pragma unroll
                for (int bj = 0; bj < 2; ++bj) { const f32x4 v0 = acc[ai][bj][m][0], v1 = acc[ai][bj][m][1];
                    u32x4 w; w.x = cvt_pk_bf16(v0[0], v0[1]); w.y = cvt_pk_bf16(v0[2], v0[3]); w.z = cvt_pk_bf16(v1[0], v1[1]); w.w = cvt_pk_bf16(v1[2], v1[3]);
                    *(u32x4*)(rowp + bj * HALF) = w;
                    if (cv) { *(f32x4*)(cv + col0 + bj * HALF) = v0; *(f32x4*)(cv + col0 + bj * HALF + 4) = v1; } } }
    }
};
template <class Epi, class Sched, bool ALIGN_EPI = false, bool SP2 = false>
__device__ __forceinline__ void gemm_phase(PG8_LAS unsigned char* lds, const Gemm g, const Sched& S, const Epi& E, int tid_in) {
    int tid_l = tid_in; asm volatile("" : "+v"(tid_l));
    const int tid = tid_l, wid = __builtin_amdgcn_readfirstlane(tid >> 6), lane = tid & 63, wr = wid >> 2, wc = wid & 3, fr = lane & 15, fq = lane >> 4;
    const int K = g.K, nt = g.KL / BK;
    unsigned voffA[2], voffB[2];
#pragma unroll
    for (int i = 0; i < 2; ++i) { int R, C; stage_rc(tid * 16 + i * 8192, R, C); const int Rb = Epi::PERM ? ((R & ~31) + perm32(R & 31)) : R;
        voffA[i] = (unsigned)(R * K + C) * 2u; voffB[i] = (unsigned)(Rb * K + C) * 2u; }
    const size_t kstep = (size_t)(BK * 2);
    const size_t hstep = (size_t)HALF * K * 2;
    const size_t tstep = 2 * hstep;
    const unsigned ldsw = (unsigned)wid * 1024u;
    const int aoff = lds_byte(wr * 64 + fr, fq * 8), boff = lds_byte(wc * 32 + fr, fq * 8);
#define PG8_SA(b, h) (((b) * 2 + (h)) * HTB)
#define PG8_SB(b, h) ((4 + (b) * 2 + (h)) * HTB)
#define PG8_STAGE(bufoff, gbase, voff) do { _Pragma("unroll") for (int _i = 0; _i < 2; ++_i) \
        __builtin_amdgcn_global_load_lds((const unsigned*)((const char*)(gbase) + (voff)[_i]), (PG8_LAS unsigned*)(lds + (bufoff) + ldsw + _i * 8192), 16, 0, 0); } while (0)
#define PG8_LDA(dst, b, h) do { _Pragma("unroll") for (int m = 0; m < 4; ++m) _Pragma("unroll") for (int k = 0; k < 2; ++k) dst[m][k] = *(const PG8_LAS bf16x8*)(lds + PG8_SA(b, h) + aoff + m * 2048 + k * 1024); } while (0)
#define PG8_LDB(dst, b, h) do { _Pragma("unroll") for (int n = 0; n < 2; ++n) _Pragma("unroll") for (int k = 0; k < 2; ++k) dst[n][k] = *(const PG8_LAS bf16x8*)(lds + PG8_SB(b, h) + boff + n * 2048 + k * 1024); } while (0)
#define PG8_MMA(ai, bj, At, Bt) do { __builtin_amdgcn_s_setprio(1); _Pragma("unroll") for (int m = 0; m < 4; ++m) _Pragma("unroll") for (int n = 0; n < 2; ++n) _Pragma("unroll") for (int k = 0; k < 2; ++k) \
        acc[ai][bj][m][n] = __builtin_amdgcn_mfma_f32_16x16x32_bf16(Bt[n][k], At[m][k], acc[ai][bj][m][n], 0, 0, 0); __builtin_amdgcn_s_setprio(0); } while (0)
#define PG8_WAIT_V(n) asm volatile("s_waitcnt vmcnt(" #n ")" ::: "memory")
#define PG8_WAIT_L(n) asm volatile("s_waitcnt lgkmcnt(" #n ")" ::: "memory")
#define PG8_BAR __builtin_amdgcn_s_barrier()
#define PG8_SCHED __builtin_amdgcn_sched_barrier(0)
    Unit cur, nxt; int ui = 0;
    if (!S.next(0, cur)) return;
    f32x4 acc[2][2][4][2];
#pragma unroll
    for (int a = 0; a < 2; ++a)
#pragma unroll
        for (int b = 0; b < 2; ++b)
#pragma unroll
            for (int m = 0; m < 4; ++m)
#pragma unroll
                for (int n = 0; n < 2; ++n) acc[a][b][m][n] = (f32x4){0.f, 0.f, 0.f, 0.f};
    bf16x8 At[4][2], B0[2][2], B1[2][2];
    const char* cA = (const char*)g.A + (size_t)cur.pm * tstep + cur.kb; const char* cB = (const char*)g.Bt + (size_t)cur.pn * tstep + cur.kb;
    S.a_ready(cur);
    if constexpr (SP2) {
        PG8_STAGE(PG8_SB(0, 0), cB, voffB); PG8_STAGE(PG8_SB(0, 1), cB + hstep, voffB); PG8_STAGE(PG8_SA(0, 0), cA, voffA); PG8_STAGE(PG8_SA(0, 1), cA + hstep, voffA);
        if (wr == 1) PG8_BAR;
        PG8_WAIT_V(2); PG8_BAR;
        PG8_STAGE(PG8_SB(1, 0), cB + kstep, voffB); PG8_STAGE(PG8_SA(1, 0), cA + kstep, voffA); PG8_STAGE(PG8_SB(1, 1), cB + hstep + kstep, voffB);
        PG8_WAIT_V(6); PG8_BAR;
    } else {
        PG8_STAGE(PG8_SB(0, 0), cB, voffB); PG8_STAGE(PG8_SA(0, 0), cA, voffA); PG8_STAGE(PG8_SB(0, 1), cB + hstep, voffB); PG8_STAGE(PG8_SA(0, 1), cA + hstep, voffA);
        if (wr == 1) PG8_BAR;
        PG8_WAIT_V(4); PG8_BAR;
        PG8_STAGE(PG8_SB(1, 0), cB + kstep, voffB); PG8_STAGE(PG8_SA(1, 0), cA + kstep, voffA); PG8_STAGE(PG8_SB(1, 1), cB + hstep + kstep, voffB);
        PG8_WAIT_V(6); PG8_BAR;
    }
    for (;;) {
        const bool has_next = S.next(ui + 1, nxt);
        const char* nA = has_next ? (const char*)g.A + (size_t)nxt.pm * tstep + nxt.kb : cA; const char* nB = has_next ? (const char*)g.Bt + (size_t)nxt.pn * tstep + nxt.kb : cB;
        const int ntu = cur.nt ? cur.nt : nt;
        for (int t = 0; t < ntu; t += 2) {
            const bool last = (t == ntu - 2);
            const char* a1 = cA + (size_t)(t + 1) * kstep;
            const char* a2 = last ? nA : cA + (size_t)(t + 2) * kstep; const char* b2 = last ? nB : cB + (size_t)(t + 2) * kstep;
            const char* a3 = a2 + kstep; const char* b3 = b2 + kstep;
            if (last && has_next) S.a_ready(nxt);
            if constexpr (SP2) {
            PG8_LDB(B0, 0, 0); PG8_LDB(B1, 0, 1); PG8_SCHED; PG8_LDA(At, 0, 0); PG8_STAGE(PG8_SA(1, 1), a1 + hstep, voffA);
            PG8_WAIT_V(8); PG8_WAIT_L(0); PG8_BAR; PG8_MMA(0, 0, At, B0); PG8_MMA(0, 1, At, B1); PG8_BAR; PG8_SCHED;
            PG8_LDA(At, 0, 1); PG8_STAGE(PG8_SB(0, 0), b2, voffB); PG8_STAGE(PG8_SB(0, 1), b2 + hstep, voffB); PG8_STAGE(PG8_SA(0, 0), a2, voffA);
            PG8_WAIT_V(8); PG8_WAIT_L(0); PG8_BAR; PG8_MMA(1, 0, At, B0); PG8_MMA(1, 1, At, B1); PG8_BAR; PG8_SCHED;
            PG8_LDB(B0, 1, 0); PG8_LDB(B1, 1, 1); PG8_SCHED; PG8_LDA(At, 1, 0); PG8_STAGE(PG8_SA(0, 1), a2 + hstep, voffA);
            PG8_WAIT_V(8); PG8_WAIT_L(0); PG8_BAR; PG8_MMA(0, 0, At, B0); PG8_MMA(0, 1, At, B1); PG8_BAR; PG8_SCHED;
            PG8_LDA(At, 1, 1); PG8_STAGE(PG8_SB(1, 0), b3, voffB); PG8_STAGE(PG8_SB(1, 1), b3 + hstep, voffB); PG8_STAGE(PG8_SA(1, 0), a3, voffA);
            PG8_WAIT_V(8); PG8_WAIT_L(0); PG8_BAR; PG8_MMA(1, 0, At, B0); PG8_MMA(1, 1, At, B1); PG8_BAR; PG8_SCHED;
            } else {
            PG8_LDB(B0, 0, 0); PG8_SCHED; PG8_LDA(At, 0, 0); PG8_STAGE(PG8_SA(1, 1), a1 + hstep, voffA);
            PG8_WAIT_L(8); PG8_BAR; PG8_WAIT_L(0); PG8_MMA(0, 0, At, B0); PG8_BAR; PG8_SCHED;
            PG8_LDB(B1, 0, 1); PG8_STAGE(PG8_SB(0, 0), b2, voffB);
            PG8_BAR; PG8_WAIT_L(0); PG8_MMA(0, 1, At, B1); PG8_BAR;
            PG8_LDA(At, 0, 1); PG8_STAGE(PG8_SA(0, 0), a2, voffA);
            PG8_BAR; PG8_WAIT_L(0); PG8_MMA(1, 0, At, B0); PG8_BAR; PG8_SCHED;
            PG8_STAGE(PG8_SB(0, 1), b2 + hstep, voffB);
            PG8_WAIT_V(6); PG8_BAR; PG8_MMA(1, 1, At, B1); PG8_BAR;
            PG8_LDB(B0, 1, 0); PG8_SCHED; PG8_LDA(At, 1, 0); PG8_STAGE(PG8_SA(0, 1), a2 + hstep, voffA);
            PG8_WAIT_L(8); PG8_BAR; PG8_WAIT_L(0); PG8_MMA(0, 0, At, B0); PG8_BAR; PG8_SCHED;
            PG8_LDB(B1, 1, 1); PG8_STAGE(PG8_SB(1, 0), b3, voffB);
            PG8_BAR; PG8_WAIT_L(0); PG8_MMA(0, 1, At, B1); PG8_BAR;
            PG8_LDA(At, 1, 1); PG8_STAGE(PG8_SA(1, 0), a3, voffA);
            PG8_BAR; PG8_WAIT_L(0); PG8_MMA(1, 0, At, B0); PG8_BAR; PG8_SCHED;
            PG8_STAGE(PG8_SB(1, 1), b3 + hstep, voffB);
            PG8_WAIT_V(6); PG8_BAR; PG8_MMA(1, 1, At, B1); PG8_BAR;
            }
        }
        if constexpr (ALIGN_EPI) { if (wr == 0) PG8_BAR; }
        if constexpr (!Epi::AFTER_DRAIN) { E(acc, cur, wr, wc, fr, fq); S.done(cur); }
        if (!has_next) break;
#pragma unroll
        for (int a = 0; a < 2; ++a)
#pragma unroll
            for (int b = 0; b < 2; ++b)
#pragma unroll
                for (int m = 0; m < 4; ++m)
#pragma unroll
                    for (int n = 0; n < 2; ++n) acc[a][b][m][n] = (f32x4){0.f, 0.f, 0.f, 0.f};
        cur = nxt; cA = nA; cB = nB; ++ui;
        if constexpr (ALIGN_EPI) { if (wr == 1) PG8_BAR; }
    }
    PG8_WAIT_V(0);
    if constexpr (!ALIGN_EPI) { if (wr == 0) PG8_BAR; }
    PG8_BAR;
    if constexpr (Epi::AFTER_DRAIN) { E.fused(acc, cur, wr, wc, fr, fq, lds, wid, lane); S.done(cur); }
#undef PG8_SA
#undef PG8_SB
#undef PG8_STAGE
#undef PG8_LDA
#undef PG8_LDB
#undef PG8_MMA
#undef PG8_WAIT_V
#undef PG8_WAIT_L
#undef PG8_BAR
#undef PG8_SCHED
}
}
constexpr int RING_BYTES = 131072, MISC_OFF = RING_BYTES + 320, LDS_BYTES = 147456;
struct Params { const float* in[45]; float* out; unsigned char* ws; int ph_lo, ph_hi, use_bar, pad; };
enum { I_XP = 0, I_XS, I_CKV, I_CWIN, I_SWKV, I_SSHIFT, I_SCONV, I_PT, I_NORMG, I_MU, I_WR, I_WK, I_WV, I_WO, I_W0, I_W1, I_W2, I_A0, I_A1, I_A2, I_V0, I_V1, I_V2, I_G1, I_G2,
       I_KK, I_KA, I_RKK, I_LNW, I_LNB, I_KVNG, I_WKV, I_KNG, I_PE, I_CW1, I_CB1, I_CW2, I_CB2, I_WQ, I_QNG, I_WONSA, I_WIN, I_CONVW, I_CONVB, I_WOUT };

typedef const __attribute__((address_space(4))) Params* KP;
struct Ctx { LAS unsigned char* lds; int tid, lane, wave, gw, ngw, gtid, gsz; };

__device__ __forceinline__ void p0_transpose_item(const float* W, int K, int ldw, int nblk, bf16_t* WT, int row_off, LAS float* scr, int item, int lane) {
    const int kb = item / nblk, nb = item % nblk, k0 = 64 * kb, n0 = 32 * nb;
#pragma unroll 8
    for (int i = 0; i < 32; ++i) { const int kk = 2 * i + (lane >> 5); scr[kk * 33 + (lane & 31)] = W[(size_t)(k0 + kk) * ldw + n0 + (lane & 31)]; }
    LDS_WAIT(); asm volatile("" ::: "memory");
    const int c = lane & 7;
#pragma unroll
    for (int j = 0; j < 4; ++j) { const int n = (lane >> 3) + 8 * j; const LAS float* s = scr + (8 * c) * 33 + n;
        u32x4 o; o.x = pk2(s[0 * 33], s[1 * 33]); o.y = pk2(s[2 * 33], s[3 * 33]); o.z = pk2(s[4 * 33], s[5 * 33]); o.w = pk2(s[6 * 33], s[7 * 33]);
        *(u32x4*)(WT + (size_t)(row_off + n0 + n) * K + k0 + 8 * c) = o; }
    LDS_WAIT(); asm volatile("" ::: "memory");
}

__device__ __forceinline__ void phase_prologue(KP p, const Ctx& c) {
    LAS float* scr = (LAS float*)(c.lds + c.wave * 16384);
    unsigned char* ws = p->ws;
    int total = 0;
#define TRCNT(K_, N_) (((K_) / 64) * ((N_) / 32))
    constexpr int C_DD = TRCNT(1024, 1024), C_L64 = TRCNT(1024, 64), C_L32 = TRCNT(1024, 32), C_L128 = TRCNT(1024, 128), C_2_64 = TRCNT(64, 1024), C_2_128 = TRCNT(128, 1024);
    constexpr int C_KV = TRCNT(1024, 1536), C_Q = 16 * 33, C_IN = TRCNT(1024, 5632), C_OUT = TRCNT(2816, 1024), C_CW = TRCNT(1024, 128);
    constexpr int NITEMS = 2 * (4 * C_DD + 2 * C_L64 + C_L128 + 2 * C_2_64 + C_2_128) + C_L32 + C_KV + 2 * C_Q + 2 * C_DD + 4 * C_IN + 4 * C_OUT + 4 * C_CW;
    (void)total;
    for (int it = c.gw; it < NITEMS; it += c.ngw) {
        int r = it;
#define TR(Wp, K_, LDW_, NBLK_, WTp, ROWOFF_) { const int cnt_ = ((K_) / 64) * (NBLK_); if (r < cnt_) { p0_transpose_item((Wp), (K_), (LDW_), (NBLK_), (bf16_t*)(WTp), (ROWOFF_), scr, r, c.lane); continue; } r -= cnt_; }
        bool done = false;
#pragma unroll
        for (int l = 0; l < 2; ++l) {
            if (done) break;
            const size_t dd = (size_t)l * 1024 * 1024;
#define TRL(Wp, K_, LDW_, NBLK_, WTp, ROWOFF_) { const int cnt_ = ((K_) / 64) * (NBLK_); if (!done) { if (r < cnt_) { p0_transpose_item((Wp), (K_), (LDW_), (NBLK_), (bf16_t*)(WTp), (ROWOFF_), scr, r, c.lane); done = true; } else r -= cnt_; } }
            TRL(p->in[I_WR] + dd, 1024, 1024, 32, ws + WS_WRKV + (size_t)l * 3072 * 1024 * 2, 0)
            TRL(p->in[I_WK] + dd, 1024, 1024, 32, ws + WS_WRKV + (size_t)l * 3072 * 1024 * 2, 1024)
            TRL(p->in[I_WV] + dd, 1024, 1024, 32, ws + WS_WRKV + (size_t)l * 3072 * 1024 * 2, 2048)
            TRL(p->in[I_WO] + dd, 1024, 1024, 32, ws + WS_WORW + (size_t)l * 1024 * 1024 * 2, 0)
            TRL(p->in[I_W1] + (size_t)l * 1024 * 64, 1024, 64, 2, ws + WS_W1T + (size_t)l * 288 * 1024 * 2, 0)
            TRL(p->in[I_A1] + (size_t)l * 1024 * 64, 1024, 64, 2, ws + WS_W1T + (size_t)l * 288 * 1024 * 2, 64)
            TRL(p->in[I_G1] + (size_t)l * 1024 * 128, 1024, 128, 4, ws + WS_W1T + (size_t)l * 288 * 1024 * 2, 160)
            TRL(p->in[I_W2] + (size_t)l * 64 * 1024, 64, 1024, 32, ws + WS_W2W + (size_t)l * 1024 * 64 * 2, 0)
            TRL(p->in[I_A2] + (size_t)l * 64 * 1024, 64, 1024, 32, ws + WS_W2A + (size_t)l * 1024 * 64 * 2, 0)
            TRL(p->in[I_G2] + (size_t)l * 128 * 1024, 128, 1024, 32, ws + WS_W2G + (size_t)l * 1024 * 128 * 2, 0)
        }
        if (done) continue;
        TR(p->in[I_V1], 1024, 32, 1, ws + WS_W1T + (size_t)1 * 288 * 1024 * 2, 128)
        TR(p->in[I_WKV], 1024, 1536, 48, ws + WS_WKVT, 0)
        TR(p->in[I_WQ], 1024, NQ, 33, ws + WS_WQT, 0)
        TR(p->in[I_WQ] + (size_t)1024 * NQ, 1024, NQ, 33, ws + WS_WQT + (size_t)NQP * 1024 * 2, 0)
        TR(p->in[I_WONSA], 1024, 1024, 32, ws + WS_WONSA, 0)
        TR(p->in[I_WONSA] + (size_t)1024 * 1024, 1024, 1024, 32, ws + WS_WONSA + (size_t)1024 * 1024 * 2, 0)
#pragma unroll
        for (int l = 0; l < 4; ++l) {
            if (done) break;
            TRL(p->in[I_WIN] + (size_t)l * 1024 * 5632, 1024, 5632, 176, ws + WS_WINT + (size_t)l * 5632 * 1024 * 2, 0)
            TRL(p->in[I_WOUT] + (size_t)l * 2816 * 1024, 2816, 1024, 32, ws + WS_WOUTT + (size_t)l * 1024 * 2816 * 2, 0)
        }
        if (done) continue;
        TR(p->in[I_CW1], 1024, 128, 4, ws + WS_CW1T, 0)
        TR(p->in[I_CW1] + (size_t)1024 * 128, 1024, 128, 4, ws + WS_CW1T, 128)
        TR(p->in[I_CW1] + (size_t)2048 * 128, 1024, 128, 4, ws + WS_CW1T + (size_t)256 * 1024 * 2, 0)
        TR(p->in[I_CW1] + (size_t)3072 * 128, 1024, 128, 4, ws + WS_CW1T + (size_t)256 * 1024 * 2, 128)
#undef TR
#undef TRL
    }
    {
        bf16_t* WQT = (bf16_t*)(ws + WS_WQT);
        for (int e = c.gtid; e < 2 * 224 * 1024; e += c.gsz) { const int k = e & 1023, n = 1056 + ((e >> 10) % 224), l = e / (224 * 1024);
            WQT[((size_t)l * NQP + n) * 1024 + k] = n < NQ ? (bf16_t)f2bf(p->in[I_WQ][((size_t)l * 1024 + k) * NQ + n]) : (bf16_t)0; }
        bf16_t* W2V = (bf16_t*)(ws + WS_W2V);
        for (int e = c.gtid; e < 32 * 1024; e += c.gsz) { const int n = e & 1023, k = e >> 10; W2V[n * 32 + k] = (bf16_t)f2bf(p->in[I_V2][k * 1024 + n]); }
    }
    { bf16_t* W2T = (bf16_t*)(ws + WS_CW2T);
      for (int e = c.gtid; e < 2 * 128 * 64; e += c.gsz) { const int d = e & 63, q = (e >> 6) & 127, kv = e >> 13; const float w = p->in[I_CW2][e];
          const unsigned hi = f2bf(w), lo = f2bf(w - __builtin_bit_cast(float, hi << 16)); W2T[(size_t)(kv * 64 + d) * 128 + q] = (bf16_t)hi; W2T[(size_t)2 * 64 * 128 + (size_t)(kv * 64 + d) * 128 + q] = (bf16_t)lo; } }
    for (int it = c.gw; it < 256; it += c.ngw) { const int kv = it >> 7, h = it & 127; float s = 0.f;
        for (int kk = c.lane; kk < 2048; kk += 64) s += p->in[I_PE][kv * 2048 + kk] * p->in[I_CW1][((size_t)kv * 2048 + kk) * 128 + h];
        s = wave_sum(s); if (c.lane == 0) ((float*)(ws + WS_CBIAS))[it] = s + p->in[I_CB1][it]; }
    { const f32x4* xp = (const f32x4*)p->in[I_XP]; const f32x4* xs = (const f32x4*)p->in[I_XS]; f32x4* o = (f32x4*)(p->out + O_Y);
      for (int e = c.gtid; e < R * D / 4; e += c.gsz) o[e] = e < MP * D / 4 ? xp[e] : xs[e - MP * D / 4]; }
}

__device__ __forceinline__ void phase_fill(KP p, const Ctx& c, int li, const int gwf, const int ngwf) {
    unsigned char* ws = p->ws;
    { const int* pt = (const int*)p->in[I_PT]; bf16_t* CA = (bf16_t*)(ws + WS_CMPA); const int part = li;
      for (int it = gwf; it < SB * 128 * 4; it += ngwf) { const int s4 = 4 * (it & 3), n = (it >> 2) & 127, b = it >> 9;
          const int page = pt[b * NPAGES + (n >> 3)]; const float* src = p->in[I_CKV] + ((size_t)page * PAGE + (n & 7) * 16 + s4) * 1024 + part * 256;
          f32x4 v[4];
#pragma unroll
          for (int e = 0; e < 4; ++e) v[e] = __builtin_nontemporal_load(((const f32x4*)(src + (size_t)e * 1024)) + c.lane);
          const int g = c.lane >> 4, d0 = 4 * (c.lane & 15); bf16_t* dst = CA + ((size_t)8192 + (size_t)part * 65536 + (size_t)(b * 4 + g) * 128 + n) * 1024 + s4 * 64 + d0;
#pragma unroll
          for (int e = 0; e < 4; ++e) { u32x2 w; w.x = pk2(v[e][0], v[e][1]); w.y = pk2(v[e][2], v[e][3]); *(u32x2*)(dst + e * 64) = w; } } }
    { const f32x4* src = (const f32x4*)p->in[I_CWIN]; f32x4* dst = (f32x4*)(p->out + O_WINS); constexpr int HALF_N = SB * 508 * 128 / 2;
      for (int e0 = li * HALF_N + gwf * 256 + c.lane; e0 < (li + 1) * HALF_N; e0 += ngwf * 256) { f32x4 v[4];
#pragma unroll
          for (int q = 0; q < 4; ++q) { const int e = e0 + 64 * q; if (e < (li + 1) * HALF_N) { const int b = e / (508 * 128), rr = e % (508 * 128); v[q] = __builtin_nontemporal_load(src + (size_t)b * 512 * 128 + 4 * 128 + rr); } }
#pragma unroll
          for (int q = 0; q < 4; ++q) { const int e = e0 + 64 * q; if (e < (li + 1) * HALF_N) { const int b = e / (508 * 128), rr = e % (508 * 128); __builtin_nontemporal_store(v[q], dst + (size_t)b * 512 * 128 + rr); } } } }
}

template <int NT> __device__ __forceinline__ void skinny_mma(const bf16_t* A, int lda, const bf16_t* Wt, int ldw, int K, int row0, int col0, int lane, f32x4 (&acc)[NT][2]) {
    const int fr = lane & 15, fq = lane >> 4;
#pragma unroll
    for (int nt = 0; nt < NT; ++nt) { acc[nt][0] = (f32x4){0.f, 0.f, 0.f, 0.f}; acc[nt][1] = (f32x4){0.f, 0.f, 0.f, 0.f}; }
    const bf16_t* xa = A + (size_t)(row0 + fr) * lda + 8 * fq; const bf16_t* xb = xa + (size_t)16 * lda;
    const bf16_t* wa = Wt + (size_t)(col0 + fr) * ldw + 8 * fq;
    const char* pa = (const char*)xa; const char* pb = (const char*)xb; const char* pw[NT];
#pragma unroll
    for (int nt = 0; nt < NT; ++nt) pw[nt] = (const char*)(wa + (size_t)nt * 16 * ldw);
    for (int k4 = 0; k4 < K / 128; ++k4) {
        bf16x8 fb[4][2], fa[4][NT];
#pragma unroll
        for (int u = 0; u < 4; ++u) { fb[u][0] = *(const bf16x8*)(pa + 64 * u); fb[u][1] = *(const bf16x8*)(pb + 64 * u);
#pragma unroll
            for (int nt = 0; nt < NT; ++nt) fa[u][nt] = *(const bf16x8*)(pw[nt] + 64 * u); }
        __builtin_amdgcn_sched_barrier(0);
#pragma unroll
        for (int u = 0; u < 4; ++u)
#pragma unroll
            for (int nt = 0; nt < NT; ++nt) { acc[nt][0] = mfma16(fa[u][nt], fb[u][0], acc[nt][0]); acc[nt][1] = mfma16(fa[u][nt], fb[u][1], acc[nt][1]); }
        pa += 256; pb += 256;
#pragma unroll
        for (int nt = 0; nt < NT; ++nt) pw[nt] += 256;
        __builtin_amdgcn_sched_barrier(0);
    }
}
__device__ __forceinline__ void skinny_resid_sample(const Ctx& c, const bf16_t* A, int lda, const bf16_t* Wt, int K, float* X) {
    const int ln = launder_v(c.lane), fr = ln & 15, fq = ln >> 4, w = c.wave;
    const int nch = K >> 7, c0 = (nch * w) >> 3, c1 = (nch * (w + 1)) >> 3;
    LAS f32x4* part = (LAS f32x4*)c.lds;
    __syncthreads();
    for (int it = blockIdx.x; it < 256; it += gridDim.x) { const int row0 = MP + 32 * (it & 15), col0 = 64 * (it >> 4);
        f32x4 acc[4][2]; skinny_mma<4>(A + 128 * c0, lda, Wt + 128 * c0, lda, 128 * (c1 - c0), row0, col0, c.lane, acc);
#pragma unroll
        for (int nt = 0; nt < 4; ++nt)
#pragma unroll
            for (int mt = 0; mt < 2; ++mt) part[(w * 8 + nt * 2 + mt) * 64 + ln] = acc[nt][mt];
        const int nt = w >> 1, mt = w & 1; f32x4* q = (f32x4*)(X + (size_t)(row0 + 16 * mt + fr) * D + col0 + 16 * nt + 4 * fq); f32x4 s = *q;
        __syncthreads();
#pragma unroll
        for (int ww = 0; ww < 8; ++ww) s = s + part[(ww * 8 + w) * 64 + ln];
        *q = s;
        __syncthreads(); }
}
__device__ __forceinline__ void skinny_store(const Ctx& c, const bf16_t* A, const bf16_t* Wt, int K, float* C, int ldc, int rbase, int nrb, int ncb, int it0, int nit_total) {
    const int fr = c.lane & 15, fq = c.lane >> 4;
    for (int it = c.gw - it0; it < nrb * ncb; it += c.ngw) { if (it < 0) continue; const int row0 = rbase + 32 * (it % nrb), col0 = 64 * (it / nrb);
        f32x4 acc[4][2]; skinny_mma<4>(A, K, Wt, K, K, row0, col0, c.lane, acc);
#pragma unroll
        for (int nt = 0; nt < 4; ++nt)
#pragma unroll
            for (int mt = 0; mt < 2; ++mt) *(f32x4*)(C + (size_t)(row0 + 16 * mt + fr) * ldc + col0 + 16 * nt + 4 * fq) = acc[nt][mt]; }
    (void)nit_total;
}

__device__ __forceinline__ void load_row(const float* p, int lane, f32x4 (&v)[4]) {
#pragma unroll
    for (int j = 0; j < 4; ++j) v[j] = ((const f32x4*)p)[lane + 64 * j];
}
__device__ __forceinline__ float row_rstd(const f32x4 (&v)[4]) {
    float s = 0.f;
#pragma unroll
    for (int j = 0; j < 4; ++j) s += (v[j][0] * v[j][0] + v[j][1] * v[j][1]) + (v[j][2] * v[j][2] + v[j][3] * v[j][3]);
    s = wave_sum(s); return frsq(s * (1.0f / D) + NORM_EPS);
}
__device__ __forceinline__ void store_row_bf16(bf16_t* o, int lane, const f32x4 (&v)[4]) {
#pragma unroll
    for (int j = 0; j < 4; ++j) { u32x2 w; w.x = pk2(v[j][0], v[j][1]); w.y = pk2(v[j][2], v[j][3]); ((u32x2*)o)[lane + 64 * j] = w; }
}

__device__ __forceinline__ void phase_norm(const Ctx& c, const float* X, const float* g1, bf16_t* o1, const float* g2, bf16_t* o2) {
    f32x4 ga[4], gb[4]; load_row(g1, c.lane, ga); if (g2) load_row(g2, c.lane, gb);
    for (int row = c.gw; row < R; row += c.ngw) {
        f32x4 v[4]; load_row(X + (size_t)row * D, c.lane, v); const float rs = row_rstd(v);
        f32x4 y[4];
#pragma unroll
        for (int j = 0; j < 4; ++j) y[j] = v[j] * rs * ga[j];
        store_row_bf16(o1 + (size_t)row * D, c.lane, y);
        if (g2) {
#pragma unroll
            for (int j = 0; j < 4; ++j) y[j] = v[j] * rs * gb[j];
            store_row_bf16(o2 + (size_t)row * D, c.lane, y); }
    }
}

__device__ __forceinline__ void phase_mix(KP p, const Ctx& c, int li) {
    const float* X = p->out + O_Y; const float* gain = p->in[I_NORMG] + (size_t)(li * 2) * D; const float* mu = p->in[I_MU] + (size_t)li * 6 * D;
    bf16_t* XM = (bf16_t*)(p->ws + WS_XM);
    f32x4 ga[4]; load_row(gain, c.lane, ga);
    {
        const int r0 = (int)(((long)c.gw * R) / c.ngw), r1 = (int)(((long)(c.gw + 1) * R) / c.ngw); f32x4 prev[4];
        {
            const bool seq_start = r0 < MP ? ((r0 & (TP - 1)) == 0) : (((r0 - MP) & 3) == 0);
            if (!seq_start && r0 < r1) { f32x4 v[4]; load_row(X + (size_t)(r0 - 1) * D, c.lane, v); const float rs = row_rstd(v);
#pragma unroll
                for (int j = 0; j < 4; ++j) prev[j] = v[j] * rs * ga[j]; }
        }
        for (int row = r0; row < r1; ++row) {
            const bool seq_start = row < MP ? ((row & (TP - 1)) == 0) : (((row - MP) & 3) == 0);
            if (seq_start) {
                if (row < MP) {
#pragma unroll
                    for (int j = 0; j < 4; ++j) prev[j] = (f32x4){0.f, 0.f, 0.f, 0.f}; }
                else load_row(p->in[I_SSHIFT] + ((size_t)li * SB + ((row - MP) >> 2)) * D, c.lane, prev);
            }
            f32x4 v[4]; load_row(X + (size_t)row * D, c.lane, v); const float rs = row_rstd(v);
            f32x4 xn[4];
#pragma unroll
            for (int j = 0; j < 4; ++j) xn[j] = v[j] * rs * ga[j];
#pragma unroll
            for (int m = 0; m < 6; ++m) {
                f32x4 y[4];
#pragma unroll
                for (int j = 0; j < 4; ++j) { const int mi = m == 1 ? 2 : (m == 2 ? 3 : (m == 3 ? 1 : m));
                    const f32x4 mm = ((const f32x4*)(mu + (size_t)mi * D))[c.lane + 64 * j]; y[j] = xn[j] + (prev[j] - xn[j]) * mm; }
                store_row_bf16(XM + ((size_t)m * R + row) * D, c.lane, y);
            }
            const bool seq_end = row < MP ? ((row & (TP - 1)) == TP - 1) : (((row - MP) & 3) == 3);
            if (seq_end) { float* so = row < MP ? p->out + O_SHP + ((size_t)li * NB + (row >> 13)) * D : p->out + O_SHS + ((size_t)li * SB + ((row - MP) >> 2)) * D;
#pragma unroll
                for (int j = 0; j < 4; ++j) ((f32x4*)so)[c.lane + 64 * j] = xn[j]; }
#pragma unroll
            for (int j = 0; j < 4; ++j) prev[j] = xn[j];
        }
    }
}
template <int NT, int ACT> __device__ __forceinline__ void lora1_item(const bf16_t* X, const bf16_t* W, bf16_t* HID, int coloff, int rb, int lane) {
    lane = launder_v(lane);
    const int fr = lane & 15, fq = lane >> 4;
    f32x4 acc[NT][2]; skinny_mma<NT>(X, 1024, W, 1024, 1024, rb * 32, coloff, lane, acc);
#pragma unroll
    for (int nt = 0; nt < NT; ++nt)
#pragma unroll
        for (int mt = 0; mt < 2; ++mt) { f32x4 v = acc[nt][mt];
#pragma unroll
            for (int r = 0; r < 4; ++r) { if (ACT == 1) { const float e = __builtin_amdgcn_exp2f(2.8853900817779268f * v[r]); v[r] = 1.0f - 2.0f * frcp(e + 1.0f); } if (ACT == 2) v[r] = sigmoidf_(v[r]); }
            u32x2 w; w.x = pk2(v[0], v[1]); w.y = pk2(v[2], v[3]);
            *(u32x2*)(HID + (size_t)(rb * 32 + mt * 16 + fr) * LHID + coloff + nt * 16 + 4 * fq) = w; }
}
__device__ __forceinline__ void phase_lora1(KP p, const Ctx& c, int li) {
    const bf16_t* XM = (const bf16_t*)(p->ws + WS_XM); const bf16_t* W = (const bf16_t*)(p->ws + WS_W1T) + (size_t)li * 288 * 1024; bf16_t* HID = (bf16_t*)(p->ws + WS_HID);
    constexpr int NRB = R / 32;
    for (int it = blockIdx.x + gridDim.x * c.wave; it < 5 * NRB; it += c.ngw) { const int q = it / NRB, rb = it % NRB;
        if (q == 0) lora1_item<4, 1>(XM + (size_t)3 * R * D, W, HID, 0, rb, c.lane);
        else if (q == 1) lora1_item<4, 0>(XM + (size_t)4 * R * D, W, HID, 64, rb, c.lane);
        else if (q == 2) { if (li == 1) lora1_item<2, 0>(XM + (size_t)2 * R * D, W, HID, 128, rb, c.lane); }
        else if (q == 3) lora1_item<4, 2>(XM + (size_t)5 * R * D, W, HID, 160, rb, c.lane);
        else lora1_item<4, 2>(XM + (size_t)5 * R * D, W, HID, 224, rb, c.lane);
    }
}

constexpr int SST = 72, MAT = 64 * SST * 2;
constexpr int O_AT = 0, O_BT = MAT, O_KT = 2 * MAT, O_RT = 3 * MAT, O_VT = 4 * MAT, O_BH = 5 * MAT, O_KH = 6 * MAT, O_XT = 7 * MAT, O_AAB = 9 * MAT, O_AAK = 10 * MAT, O_ARB = 11 * MAT, O_ARK = 12 * MAT;
constexpr int O_TD = 13 * MAT, O_SCR = O_TD + 2048, O_CS = O_SCR + 4096, O_WC = O_CS + 2048, O_LW = O_XT, O_LA = O_XT + 16384, O_LV = O_XT + 32768;
static_assert(O_WC + 256 <= RING_BYTES && O_LV + 16384 <= O_TD, "scan LDS map");
__device__ __forceinline__ bf16x8 ldsfrag(LAS unsigned char* lds, int off, int row, int col) { return *(const LAS bf16x8*)(lds + off + (row * SST + col) * 2); }
__device__ __forceinline__ void lds_st4(LAS unsigned char* lds, int off, int row, int col, f32x4 v) { u32x2 w; w.x = pk2(v[0], v[1]); w.y = pk2(v[2], v[3]); *(LAS u32x2*)(lds + off + (row * SST + col) * 2) = w; }
__device__ __forceinline__ f32x4 lds_ld4(LAS unsigned char* lds, int off, int row, int col) { const u32x2 w = *(const LAS u32x2*)(lds + off + (row * SST + col) * 2); return (f32x4){bflo(w.x), bfhi(w.x), bflo(w.y), bfhi(w.y)}; }

__device__ __forceinline__ void scanA_unit(KP p, const Ctx& c, int li, int u) {
    LAS unsigned char* lds = c.lds; unsigned char* ws = p->ws; const int stop = p->pad;
    const int lane = c.lane, wave = c.wave, fr = lane & 15, fq = lane >> 4;
    const int b = u / (NCH * H), n = (u / H) % NCH, h = u % H, row0 = b * TP + 64 * n;
    const float* Rb = (const float*)(ws + WS_RK_R); const float* Kb = (const float*)(ws + WS_RK_K);
    float* Vb = (float*)(ws + (li ? WS_V1 : WS_V0)); const float* V0b = (const float*)(ws + WS_V0);
    const bf16_t* HID = (const bf16_t*)(ws + WS_HID);
    {
        const int tt = wave & 3, chh = wave >> 2;
        const bf16_t* hrow = launder_p(HID + (size_t)(row0 + 16 * tt + fr) * LHID + 8 * fq);
        const bf16_t* W2W = (const bf16_t*)(ws + WS_W2W) + (size_t)li * 1024 * 64; const bf16_t* W2A = (const bf16_t*)(ws + WS_W2A) + (size_t)li * 1024 * 64; const bf16_t* W2V = (const bf16_t*)(ws + WS_W2V);
#pragma unroll
        for (int cti = 0; cti < 2; ++cti) { const int ct = 2 * chh + cti, C = 64 * h + 16 * ct + fr;
            f32x4 aw = {0.f, 0.f, 0.f, 0.f}, aa = {0.f, 0.f, 0.f, 0.f}, av = {0.f, 0.f, 0.f, 0.f};
#pragma unroll
            for (int ks = 0; ks < 2; ++ks) {
                aw = mfma16(*(const bf16x8*)(W2W + (size_t)C * 64 + 32 * ks + 8 * fq), *(const bf16x8*)(hrow + 32 * ks), aw);
                aa = mfma16(*(const bf16x8*)(W2A + (size_t)C * 64 + 32 * ks + 8 * fq), *(const bf16x8*)(hrow + 64 + 32 * ks), aa); }
            if (li) av = mfma16(*(const bf16x8*)(W2V + (size_t)C * 32 + 8 * fq), *(const bf16x8*)(hrow + 128), av);
            const int t = 16 * tt + fr, cc = 16 * ct + 4 * fq;
            *(LAS f32x4*)(lds + O_LW + (t * 64 + cc) * 4) = aw; *(LAS f32x4*)(lds + O_LA + (t * 64 + cc) * 4) = aa; *(LAS f32x4*)(lds + O_LV + (t * 64 + cc) * 4) = av; }
    }
    __syncthreads();
    if (stop == 1) return;
    {
        const int cc = lane, tq = wave, C = 64 * h + cc; const size_t pc = (size_t)li * D + C;
        const float w0 = p->in[I_W0][pc], a0 = p->in[I_A0][pc], kkc = p->in[I_KK][pc], kac = p->in[I_KA][pc], rkc = p->in[I_RKK][pc], v0 = li ? p->in[I_V0][C] : 0.f;
        float wlg[8], Lin[8], rr[8], k2[8], vv[8], aa[8], bb[8], rk8[8]; float run = 0.f;
        float r8[8], k8[8], v8[8], f8[8];
#pragma unroll
        for (int e = 0; e < 8; ++e) { const size_t gi = (size_t)(row0 + 8 * tq + e) * D + C; r8[e] = Rb[gi]; k8[e] = Kb[gi]; v8[e] = Vb[gi]; f8[e] = V0b[gi]; }
#pragma unroll
        for (int e = 0; e < 8; ++e) { const int t = 8 * tq + e;
            const float r = r8[e], k = k8[e]; float v = v8[e];
            const float lw = *(const LAS float*)(lds + O_LW + (t * 64 + cc) * 4), la = *(const LAS float*)(lds + O_LA + (t * 64 + cc) * 4), lv = *(const LAS float*)(lds + O_LV + (t * 64 + cc) * 4);
            const float z = -(w0 + lw); const float sp = fmaxf(z, 0.f) + __logf(1.0f + __expf(-fabsf(z))); const float wl = -__expf(-sp - 0.5f);
            const float asig = sigmoidf_(a0 + la);
            { const float vg = sigmoidf_(v0 + lv); const float vm = v + (f8[e] - v) * vg; v = li ? vm : v; }
            const float kkr = k * kkc; const float ss = wave_sum(kkr * kkr); const float kkn = kkr * frsq(fmaxf(ss, 1e-24f));
            const float kmod = k * (1.0f + (asig - 1.0f) * kac);
            rk8[e] = wave_sum(r * kmod * rkc);
            run += wl; wlg[e] = wl; Lin[e] = run; rr[e] = r; k2[e] = kmod; vv[e] = v; aa[e] = -kkn; bb[e] = kkn * asig; }
        if (li) {
#pragma unroll
            for (int e = 0; e < 8; ++e) Vb[(size_t)(row0 + 8 * tq + e) * D + C] = vv[e]; }
        if (cc == 0) {
#pragma unroll
            for (int e = 0; e < 8; ++e) ((float*)(ws + WS_RKS))[(size_t)(row0 + 8 * tq + e) * 16 + h] = rk8[e]; }
        *(LAS float*)(lds + O_CS + (tq * 64 + cc) * 4) = run;
        __syncthreads();
        float off = 0.f, tot = 0.f;
#pragma unroll
        for (int q = 0; q < 8; ++q) { const float x = *(const LAS float*)(lds + O_CS + (q * 64 + cc) * 4); tot += x; if (q < tq) off += x; }
        u32x4 wa, wv, wb, wk; unsigned pa[8], pv[8], pb[8], pk[8];
#pragma unroll
        for (int e = 0; e < 8; ++e) { const int t = 8 * tq + e; const float L = off + Lin[e], Lp = L - wlg[e];
            const float eL = __expf(L), eLp = __expf(Lp), enL = __expf(-L), eT = __expf(tot - L);
            const float at = aa[e] * eLp, bt = bb[e] * enL, kt = k2[e] * enL, rt = rr[e] * eL, bh = bb[e] * eT, kh = k2[e] * eT;
            *(LAS bf16_t*)(lds + O_AT + (t * SST + cc) * 2) = (bf16_t)f2bf(at); *(LAS bf16_t*)(lds + O_BT + (t * SST + cc) * 2) = (bf16_t)f2bf(bt);
            *(LAS bf16_t*)(lds + O_KT + (t * SST + cc) * 2) = (bf16_t)f2bf(kt); *(LAS bf16_t*)(lds + O_RT + (t * SST + cc) * 2) = (bf16_t)f2bf(rt);
            pa[e] = f2bf(at); pv[e] = f2bf(vv[e]); pb[e] = f2bf(bh); pk[e] = f2bf(kh); }
        wa = (u32x4){pa[0] | (pa[1] << 16), pa[2] | (pa[3] << 16), pa[4] | (pa[5] << 16), pa[6] | (pa[7] << 16)};
        wv = (u32x4){pv[0] | (pv[1] << 16), pv[2] | (pv[3] << 16), pv[4] | (pv[5] << 16), pv[6] | (pv[7] << 16)};
        wb = (u32x4){pb[0] | (pb[1] << 16), pb[2] | (pb[3] << 16), pb[4] | (pb[5] << 16), pb[6] | (pb[7] << 16)};
        wk = (u32x4){pk[0] | (pk[1] << 16), pk[2] | (pk[3] << 16), pk[4] | (pk[5] << 16), pk[6] | (pk[7] << 16)};
        *(LAS u32x4*)(lds + O_XT + (cc * SST + 8 * tq) * 2) = wa; *(LAS u32x4*)(lds + O_VT + (cc * SST + 8 * tq) * 2) = wv;
        *(LAS u32x4*)(lds + O_BH + (cc * SST + 8 * tq) * 2) = wb; *(LAS u32x4*)(lds + O_KH + (cc * SST + 8 * tq) * 2) = wk;
        if (tq == 0) *(LAS float*)(lds + O_WC + cc * 4) = __expf(tot);
    }
    __syncthreads();
    if (stop == 2) return;
    {
        const int mi = wave >> 1, ph = wave & 1; const int oY = (mi & 1) ? O_KT : O_BT, oX = (mi < 2) ? O_AT : O_RT; const bool strict = mi < 2;
        const int oO = mi == 0 ? O_AAB : (mi == 1 ? O_AAK : (mi == 2 ? O_ARB : O_ARK));
#pragma unroll
        for (int sti = 0; sti < 2; ++sti) { const int st = 2 * ph + sti;
#pragma unroll
            for (int tt = 0; tt < 4; ++tt) { f32x4 acc = {0.f, 0.f, 0.f, 0.f};
                if (st <= tt) {
#pragma unroll
                    for (int ks = 0; ks < 2; ++ks) acc = mfma16(ldsfrag(lds, oY, 16 * st + fr, 32 * ks + 8 * fq), ldsfrag(lds, oX, 16 * tt + fr, 32 * ks + 8 * fq), acc);
                    const int t = 16 * tt + fr;
#pragma unroll
                    for (int r = 0; r < 4; ++r) { const int s = 16 * st + 4 * fq + r; const bool keep = strict ? (s < t) : (s <= t); acc[r] = keep ? acc[r] : 0.f; } }
                if (st <= tt) lds_st4(lds, oO, 16 * tt + fr, 16 * st + 4 * fq, acc);
                else { u32x2 zz; int z0 = 0; asm volatile("" : "+v"(z0)); zz.x = (unsigned)z0; zz.y = (unsigned)z0; *(LAS u32x2*)(lds + oO + ((16 * tt + fr) * SST + 16 * st + 4 * fq) * 2) = zz; } } }
    }
    __syncthreads();
    if (stop == 3) return;
    {
        const int tt = wave & 3, ih = wave >> 2;
#pragma unroll
        for (int iti = 0; iti < 2; ++iti) { const int it = 2 * ih + iti; f32x4 acc = {0.f, 0.f, 0.f, 0.f};
#pragma unroll
            for (int ks = 0; ks < 2; ++ks) acc = mfma16(ldsfrag(lds, O_AAK, 16 * tt + fr, 32 * ks + 8 * fq), ldsfrag(lds, O_VT, 16 * it + fr, 32 * ks + 8 * fq), acc);
            lds_st4(lds, O_XT, 64 + 16 * it + fr, 16 * tt + 4 * fq, acc); }
        if (wave < 4 && lane < 16) { const int I = wave; float x[16];
#pragma unroll
            for (int t = 0; t < 16; ++t) { float s = (t == lane) ? 1.0f : 0.0f;
#pragma unroll
                for (int q = 0; q < t; ++q) s += bf2f(*(const LAS bf16_t*)(lds + O_AAB + ((16 * I + t) * SST + 16 * I + q) * 2)) * x[q];
                x[t] = s; *(LAS bf16_t*)(lds + O_TD + ((I * 16 + t) * 16 + lane) * 2) = (bf16_t)f2bf(s); } }
    }
    __syncthreads();
    if (stop == 5) return;
    {
        const int colb = 16 * wave; const bf16x8 zero8 = {0, 0, 0, 0, 0, 0, 0, 0};
#pragma unroll
        for (int I = 0; I < 4; ++I) {
            f32x4 acc = lds_ld4(lds, O_XT, colb + fr, 16 * I + 4 * fq);
#pragma unroll
            for (int ks = 0; ks < 2; ++ks) if (32 * ks < 16 * I) { const bool ok = (32 * ks + 8 * fq) < 16 * I;
                const bf16x8 a = ok ? ldsfrag(lds, O_AAB, 16 * I + fr, 32 * ks + 8 * fq) : zero8, bq = ok ? ldsfrag(lds, O_XT, colb + fr, 32 * ks + 8 * fq) : zero8;
                acc = mfma16(a, bq, acc); }
            { u32x2 w; w.x = pk2(acc[0], acc[1]); w.y = pk2(acc[2], acc[3]); *(LAS u32x2*)(lds + O_SCR + wave * 512 + (fr * 16 + 4 * fq) * 2) = w; }
            LDS_WAIT();
            const bf16x8 ta = fq < 2 ? *(const LAS bf16x8*)(lds + O_TD + ((I * 16 + fr) * 16 + 8 * fq) * 2) : zero8;
            const bf16x8 tb = fq < 2 ? *(const LAS bf16x8*)(lds + O_SCR + wave * 512 + (fr * 16 + 8 * fq) * 2) : zero8;
            const f32x4 res = mfma16(ta, tb, (f32x4){0.f, 0.f, 0.f, 0.f});
            lds_st4(lds, O_XT, colb + fr, 16 * I + 4 * fq, res);
            LDS_WAIT();
        }
    }
    __syncthreads();
    if (stop == 6) return;
    constexpr int S_RP = 0, S_MH = MAT, S_ML = 2 * MAT, S_YL = 3 * MAT, YLS = 68, S_NN = S_YL + 64 * YLS * 4;
    static_assert(S_NN + 64 * YLS * 4 <= O_XT, "staging must stay below the next unit's step-1 area");
    {
        const int tb = wave & 3, hb = wave >> 2;
        u32x2 rp[2], mh[2], ml[2]; f32x4 yl[2], nv[2];
#pragma unroll
        for (int qi = 0; qi < 2; ++qi) { const int rt = 2 * hb + qi;
            { f32x4 acc = lds_ld4(lds, O_RT, 16 * tb + fr, 16 * rt + 4 * fq);
#pragma unroll
              for (int ks = 0; ks < 2; ++ks) acc = mfma16(ldsfrag(lds, O_XT, 16 * rt + fr, 32 * ks + 8 * fq), ldsfrag(lds, O_ARB, 16 * tb + fr, 32 * ks + 8 * fq), acc);
              rp[qi].x = pk2(acc[0], acc[1]); rp[qi].y = pk2(acc[2], acc[3]); }
            { f32x4 acc = {0.f, 0.f, 0.f, 0.f};
#pragma unroll
              for (int ks = 0; ks < 2; ++ks) { acc = mfma16(ldsfrag(lds, O_XT, 64 + 16 * rt + fr, 32 * ks + 8 * fq), ldsfrag(lds, O_ARB, 16 * tb + fr, 32 * ks + 8 * fq), acc);
                  acc = mfma16(ldsfrag(lds, O_VT, 16 * rt + fr, 32 * ks + 8 * fq), ldsfrag(lds, O_ARK, 16 * tb + fr, 32 * ks + 8 * fq), acc); }
              yl[qi] = acc; }
            { f32x4 acc = {0.f, 0.f, 0.f, 0.f};
#pragma unroll
              for (int ks = 0; ks < 2; ++ks) acc = mfma16(ldsfrag(lds, O_XT, 16 * rt + fr, 32 * ks + 8 * fq), ldsfrag(lds, O_BH, 16 * tb + fr, 32 * ks + 8 * fq), acc);
              const int j = 16 * tb + fr; const float wc = *(const LAS float*)(lds + O_WC + j * 4);
#pragma unroll
              for (int r = 0; r < 4; ++r) if (16 * rt + 4 * fq + r == j) acc[r] += wc;
              unsigned hh[4], ll[4];
#pragma unroll
              for (int r = 0; r < 4; ++r) { hh[r] = f2bf(acc[r]); ll[r] = f2bf(acc[r] - __builtin_bit_cast(float, hh[r] << 16)); }
              mh[qi] = (u32x2){hh[0] | (hh[1] << 16), hh[2] | (hh[3] << 16)}; ml[qi] = (u32x2){ll[0] | (ll[1] << 16), ll[2] | (ll[3] << 16)}; }
            { f32x4 acc = {0.f, 0.f, 0.f, 0.f};
#pragma unroll
              for (int ks = 0; ks < 2; ++ks) { acc = mfma16(ldsfrag(lds, O_BH, 16 * rt + fr, 32 * ks + 8 * fq), ldsfrag(lds, O_XT, 64 + 16 * tb + fr, 32 * ks + 8 * fq), acc);
                  acc = mfma16(ldsfrag(lds, O_KH, 16 * rt + fr, 32 * ks + 8 * fq), ldsfrag(lds, O_VT, 16 * tb + fr, 32 * ks + 8 * fq), acc); }
              nv[qi] = acc; }
        }
        __syncthreads();
#pragma unroll
        for (int qi = 0; qi < 2; ++qi) { const int rt = 2 * hb + qi, row = 16 * tb + fr, col = 16 * rt + 4 * fq;
            *(LAS u32x2*)(lds + S_RP + (row * SST + col) * 2) = rp[qi]; *(LAS u32x2*)(lds + S_MH + (row * SST + col) * 2) = mh[qi]; *(LAS u32x2*)(lds + S_ML + (row * SST + col) * 2) = ml[qi];
            *(LAS f32x4*)(lds + S_YL + (row * YLS + col) * 4) = yl[qi]; *(LAS f32x4*)(lds + S_NN + (row * YLS + col) * 4) = nv[qi]; }
        __syncthreads();
        unsigned char* gRP = ws + WS_RP + (size_t)u * 8192; unsigned char* gYL = ws + WS_YL + (size_t)u * 16384;
        unsigned char* gMH = ws + WS_MT + (size_t)u * 8192; unsigned char* gML = gMH + (size_t)NUNIT_A * 8192; unsigned char* gNN = ws + WS_NN + (size_t)u * 16384;
        const int tid = 64 * wave + lane;
        { const int row = tid >> 3, ch = tid & 7, lo = (row * SST) * 2 + ch * 16;
          *(u32x4*)(gRP + tid * 16) = *(const LAS u32x4*)(lds + S_RP + lo); *(u32x4*)(gMH + tid * 16) = *(const LAS u32x4*)(lds + S_MH + lo); *(u32x4*)(gML + tid * 16) = *(const LAS u32x4*)(lds + S_ML + lo); }
#pragma unroll
        for (int k = 0; k < 2; ++k) { const int cidx = tid + 512 * k, row = cidx >> 4, c4 = cidx & 15, lo = (row * YLS) * 4 + c4 * 16;
            *(u32x4*)(gYL + cidx * 16) = *(const LAS u32x4*)(lds + S_YL + lo); *(u32x4*)(gNN + cidx * 16) = *(const LAS u32x4*)(lds + S_NN + lo); }
    }
}

__device__ __forceinline__ void scan_sample_item(KP p, const Ctx& c, int li, int item) {
    unsigned char* ws = p->ws; const int lane = c.lane, b = item >> 4, h = item & 15, C = 64 * h + lane; const size_t pc = (size_t)li * D + C;
    LAS float* sc = (LAS float*)(c.lds + c.wave * 16384);
    const float* Rb = (const float*)(ws + WS_RK_R); const float* Kb = (const float*)(ws + WS_RK_K);
    float* Vb = (float*)(ws + (li ? WS_V1 : WS_V0)); const float* V0b = (const float*)(ws + WS_V0);
    const bf16_t* HID = (const bf16_t*)(ws + WS_HID) + (size_t)(MP + 4 * b) * LHID;
    for (int e = lane; e < 4 * LHID; e += 64) sc[e] = bf2f(HID[e]);
    LDS_WAIT();
    float lw[4] = {0.f, 0.f, 0.f, 0.f}, la[4] = {0.f, 0.f, 0.f, 0.f}, lv[4] = {0.f, 0.f, 0.f, 0.f}, lg[4] = {0.f, 0.f, 0.f, 0.f};
    {
        const bf16_t* W2W = (const bf16_t*)(ws + WS_W2W) + ((size_t)li * 1024 + C) * 64; const bf16_t* W2A = (const bf16_t*)(ws + WS_W2A) + ((size_t)li * 1024 + C) * 64;
        const bf16_t* W2V = (const bf16_t*)(ws + WS_W2V) + (size_t)C * 32; const bf16_t* W2G = (const bf16_t*)(ws + WS_W2G) + ((size_t)li * 1024 + C) * 128;
#define LORA2_BLK(WP, QB, HOFF, ACC) { const u32x4 w8 = *(const u32x4*)((WP) + 8 * (QB)); \
            const float wf0 = bflo(w8.x), wf1 = bfhi(w8.x), wf2 = bflo(w8.y), wf3 = bfhi(w8.y), wf4 = bflo(w8.z), wf5 = bfhi(w8.z), wf6 = bflo(w8.w), wf7 = bfhi(w8.w); \
            _Pragma("unroll") for (int t = 0; t < 4; ++t) { const f32x4 h0 = *(const LAS f32x4*)(sc + t * LHID + (HOFF) + 8 * (QB)), h1 = *(const LAS f32x4*)(sc + t * LHID + (HOFF) + 8 * (QB) + 4); \
                ACC[t] += (h0[0] * wf0 + h0[1] * wf1) + (h0[2] * wf2 + h0[3] * wf3) + (h1[0] * wf4 + h1[1] * wf5) + (h1[2] * wf6 + h1[3] * wf7); } \
            asm volatile("" : "+v"(ACC[0]), "+v"(ACC[1]), "+v"(ACC[2]), "+v"(ACC[3]) :: "memory"); }
#pragma unroll
        for (int qb = 0; qb < 8; ++qb) { LORA2_BLK(W2W, qb, 0, lw) LORA2_BLK(W2A, qb, 64, la) }
        if (li) {
#pragma unroll
            for (int qb = 0; qb < 4; ++qb) LORA2_BLK(W2V, qb, 128, lv) }
#pragma unroll
        for (int qb = 0; qb < 16; ++qb) LORA2_BLK(W2G, qb, 160, lg)
#undef LORA2_BLK
    }
    const float w0 = p->in[I_W0][pc], a0 = p->in[I_A0][pc], kkc = p->in[I_KK][pc], kac = p->in[I_KA][pc], rkc = p->in[I_RKK][pc], v0 = li ? p->in[I_V0][C] : 0.f;
    const float lnw = p->in[I_LNW][pc], lnb = p->in[I_LNB][pc];
    float S[64];
    { const f32x4* sp = (const f32x4*)(p->in[I_SWKV] + (((size_t)li * SB + b) * H + h) * 4096 + lane * 64);
#pragma unroll
      for (int q = 0; q < 16; ++q) { const f32x4 x = sp[q]; S[4 * q] = x[0]; S[4 * q + 1] = x[1]; S[4 * q + 2] = x[2]; S[4 * q + 3] = x[3]; } }
    LAS float* bc = sc + 1280;
    bf16_t* YG = (bf16_t*)(ws + WS_YG);
#pragma unroll
    for (int t = 0; t < 4; ++t) { const size_t gi = (size_t)(MP + 4 * b + t) * D + C;
        const float r = Rb[gi], k = Kb[gi]; float v = Vb[gi];
        const float z = -(w0 + lw[t]); const float sp = fmaxf(z, 0.f) + __logf(1.0f + __expf(-fabsf(z))); const float wdec = __expf(-__expf(-sp - 0.5f));
        const float asig = sigmoidf_(a0 + la[t]);
        if (li) { const float vg = sigmoidf_(v0 + lv[t]); const float vf = V0b[gi]; v = v + (vf - v) * vg; }
        const float kkr = k * kkc; const float ss = wave_sum(kkr * kkr); const float kkn = kkr * frsq(fmaxf(ss, 1e-24f));
        const float kmod = k * (1.0f + (asig - 1.0f) * kac);
        const float rks = wave_sum(r * kmod * rkc);
        LDS_WAIT();
        bc[lane] = wdec; bc[64 + lane] = -kkn; bc[128 + lane] = kkn * asig; bc[192 + lane] = kmod; bc[256 + lane] = r;
        LDS_WAIT();
        float sa = 0.f;
#pragma unroll
        for (int q = 0; q < 16; ++q) { const f32x4 av = *(const LAS f32x4*)(bc + 64 + 4 * q); sa += S[4 * q] * av[0] + S[4 * q + 1] * av[1] + S[4 * q + 2] * av[2] + S[4 * q + 3] * av[3]; }
        float y = 0.f;
#pragma unroll
        for (int q = 0; q < 16; ++q) { const f32x4 wv = *(const LAS f32x4*)(bc + 4 * q), bv = *(const LAS f32x4*)(bc + 128 + 4 * q), kv = *(const LAS f32x4*)(bc + 192 + 4 * q), rv = *(const LAS f32x4*)(bc + 256 + 4 * q);
#pragma unroll
            for (int e = 0; e < 4; ++e) { const float s = S[4 * q + e] * wv[e] + sa * bv[e] + v * kv[e]; S[4 * q + e] = s; y += s * rv[e]; } }
        const float mean = wave_sum(y) * (1.0f / 64.0f); const float dy = y - mean; const float var = wave_sum(dy * dy) * (1.0f / 64.0f);
        const float yn = dy * (frsq(var + GN_EPS)) * lnw + lnb;
        YG[gi] = (bf16_t)f2bf((yn + rks * v) * lg[t]);
    }
    { f32x4* so = (f32x4*)(p->out + O_WKVS + (((size_t)li * SB + b) * H + h) * 4096 + lane * 64);
#pragma unroll
      for (int q = 0; q < 16; ++q) so[q] = (f32x4){S[4 * q], S[4 * q + 1], S[4 * q + 2], S[4 * q + 3]}; }
    LDS_WAIT();
}

__device__ __forceinline__ void phase_scanA(KP p, const Ctx& c, int li) {
    const int stop = p->pad;
    if (stop != 9) for (int u = blockIdx.x; u < NUNIT_A; u += gridDim.x) scanA_unit(p, c, li, u);
    __syncthreads();
    if (stop == 0 || stop == 9) for (int it = c.gw; it < SB * H; it += c.ngw) scan_sample_item(p, c, li, it);
}

__device__ __forceinline__ void hilo(const f32x4 x0, const f32x4 x1, bf16x8& hi, bf16x8& lo) {
    unsigned h[8], l[8];
#pragma unroll
    for (int e = 0; e < 8; ++e) { const float x = e < 4 ? x0[e] : x1[e - 4]; h[e] = f2bf(x); l[e] = f2bf(x - __builtin_bit_cast(float, h[e] << 16)); }
    u32x4 hv = {h[0] | (h[1] << 16), h[2] | (h[3] << 16), h[4] | (h[5] << 16), h[6] | (h[7] << 16)}, lv = {l[0] | (l[1] << 16), l[2] | (l[3] << 16), l[4] | (l[5] << 16), l[6] | (l[7] << 16)};
    hi = __builtin_bit_cast(bf16x8, hv); lo = __builtin_bit_cast(bf16x8, lv);
}
constexpr int SB_SLOT = 20480, SB_RING0 = 8192, SB_DEPTH = 6;
static_assert(SB_RING0 + SB_DEPTH * SB_SLOT <= RING_BYTES, "chain ring");
__device__ __forceinline__ void phase_scanB(KP p, const Ctx& c, int li) {
    unsigned char* ws = p->ws; LAS unsigned char* lds = c.lds; const int lane = c.lane, fr = lane & 15, fq = lane >> 4, wave = c.wave;
    volatile LAS int* FL = (volatile LAS int*)(lds + RING_BYTES);
    if (c.tid < 4) FL[c.tid] = 0;
    __syncthreads();
    const int ncb = (int)gridDim.x < 128 ? (int)gridDim.x : 128;
    if (wave >= 4 || (int)blockIdx.x >= ncb) {
        const int gwf = (int)blockIdx.x < ncb ? (int)blockIdx.x * 4 + (wave - 4) : ncb * 4 + ((int)blockIdx.x - ncb) * 8 + wave, ngwf = ncb * 4 + ((int)gridDim.x - ncb) * 8;
        phase_fill(p, c, li, gwf, ngwf); return; }
    if (wave != 0) {
        const int j = wave - 1; int prevG = -1, kc = 0;
        for (int ch = blockIdx.x; ch < 128; ch += gridDim.x, ++kc) { const int cx_ = ch & 7, cy_ = ch >> 3, iq = cy_ & 3, bh_ = cx_ + 8 * (cy_ >> 2), b = bh_ >> 4, h = bh_ & 15;
            for (int n = j; n < NCH; n += 3) { const int G = kc * NCH + n;
                if (G >= SB_DEPTH) { unsigned sp = 0; while (FL[0] < G - (SB_DEPTH - 1)) { __builtin_amdgcn_s_sleep(1); if (++sp > (1u << 22)) break; } }
                LAS unsigned char* slot = lds + SB_RING0 + (G % SB_DEPTH) * SB_SLOT;
                const size_t u = (size_t)(b * NCH + n) * H + h; const bf16_t* MTH = (const bf16_t*)(ws + WS_MT) + u * 4096; const bf16_t* MTL = MTH + (size_t)NUNIT_A * 4096; const float* NN = (const float*)(ws + WS_NN) + u * 4096;
#pragma unroll
                for (int jt = 0; jt < 4; ++jt)
#pragma unroll
                    for (int ks = 0; ks < 2; ++ks) {
                        __builtin_amdgcn_global_load_lds((const unsigned*)(MTH + (size_t)(16 * jt + fr) * 64 + 32 * ks + 8 * fq), (LAS unsigned*)(slot + ((jt * 2 + ks) * 2 + 0) * 1024), 16, 0, 0);
                        __builtin_amdgcn_global_load_lds((const unsigned*)(MTL + (size_t)(16 * jt + fr) * 64 + 32 * ks + 8 * fq), (LAS unsigned*)(slot + ((jt * 2 + ks) * 2 + 1) * 1024), 16, 0, 0); }
#pragma unroll
                for (int jt = 0; jt < 4; ++jt)
                    __builtin_amdgcn_global_load_lds((const unsigned*)(NN + (size_t)(16 * iq + fr) * 64 + 16 * jt + 4 * fq), (LAS unsigned*)(slot + (16 + jt) * 1024), 16, 0, 0);
                asm volatile("s_waitcnt vmcnt(20)" ::: "memory");
                if (prevG >= 0) FL[1 + j] = prevG + 1;
                prevG = G; } }
        asm volatile("s_waitcnt vmcnt(0)" ::: "memory");
        if (prevG >= 0) FL[1 + j] = prevG + 1;
        return; }
    int kc = 0;
    for (int ch = blockIdx.x; ch < 128; ch += gridDim.x, ++kc) {
        const int cx_ = ch & 7, cy_ = ch >> 3, iq = cy_ & 3, bh_ = cx_ + 8 * (cy_ >> 2), b = bh_ >> 4, h = bh_ & 15;
        f32x4 S[4];
#pragma unroll
        for (int jt = 0; jt < 4; ++jt) S[jt] = (f32x4){0.f, 0.f, 0.f, 0.f};
        int j3 = 0;
        for (int n = 0; n < NCH; ++n) { const int G = kc * NCH + n;
            const size_t u = (size_t)(b * NCH + n) * H + h; bf16_t* S0 = (bf16_t*)(ws + WS_S0) + u * 4096;
            { unsigned sp = 0; while (FL[1 + j3] < G + 1) { __builtin_amdgcn_s_sleep(1); if (++sp > (1u << 22)) break; } }
            const LAS unsigned char* slot = lds + SB_RING0 + (G % SB_DEPTH) * SB_SLOT + lane * 16;
            bf16x8 ah[4][2], al[4][2]; f32x4 nn[4];
#pragma unroll
            for (int jt = 0; jt < 4; ++jt) { nn[jt] = *(const LAS f32x4*)(slot + (16 + jt) * 1024);
#pragma unroll
                for (int ks = 0; ks < 2; ++ks) { ah[jt][ks] = *(const LAS bf16x8*)(slot + ((jt * 2 + ks) * 2 + 0) * 1024); al[jt][ks] = *(const LAS bf16x8*)(slot + ((jt * 2 + ks) * 2 + 1) * 1024); } }
#pragma unroll
            for (int jt = 0; jt < 4; ++jt) { unsigned hh[4], ll[4];
#pragma unroll
                for (int r = 0; r < 4; ++r) { hh[r] = f2bf(S[jt][r]); ll[r] = f2bf(S[jt][r] - __builtin_bit_cast(float, hh[r] << 16)); }
                u32x2 wh = {hh[0] | (hh[1] << 16), hh[2] | (hh[3] << 16)}, wl = {ll[0] | (ll[1] << 16), ll[2] | (ll[3] << 16)};
                *(u32x2*)(S0 + (size_t)(16 * iq + fr) * 64 + 16 * jt + 4 * fq) = wh;
                *(LAS u32x2*)(lds + (fr * SST + 16 * jt + 4 * fq) * 2) = wh; *(LAS u32x2*)(lds + 4096 + (fr * SST + 16 * jt + 4 * fq) * 2) = wl; }
            LDS_WAIT();
            bf16x8 bh[2], bl[2];
#pragma unroll
            for (int ks = 0; ks < 2; ++ks) { bh[ks] = *(const LAS bf16x8*)(lds + (fr * SST + 32 * ks + 8 * fq) * 2); bl[ks] = *(const LAS bf16x8*)(lds + 4096 + (fr * SST + 32 * ks + 8 * fq) * 2); }
#pragma unroll
            for (int jt = 0; jt < 4; ++jt) { f32x4 acc = nn[jt];
#pragma unroll
                for (int ks = 0; ks < 2; ++ks) { acc = mfma16(ah[jt][ks], bh[ks], acc); acc = mfma16(ah[jt][ks], bl[ks], acc); acc = mfma16(al[jt][ks], bh[ks], acc); }
                S[jt] = acc; }
            LDS_WAIT();
            FL[0] = G + 1;
            j3 = j3 == 2 ? 0 : j3 + 1;
        }
        float* so = p->out + O_WKVP + (((size_t)li * NB + b) * H + h) * 4096;
#pragma unroll
        for (int jt = 0; jt < 4; ++jt) *(f32x4*)(so + (size_t)(16 * iq + fr) * 64 + 16 * jt + 4 * fq) = S[jt];
    }
}

__device__ __forceinline__ void phase_scanC(KP p, const Ctx& c, int li) {
    unsigned char* ws = p->ws; const int lane = c.lane, fr = lane & 15, fq = lane >> 4, hb = c.wave >> 2, tt = c.wave & 3;
    const float* Vb = (const float*)(ws + (li ? WS_V1 : WS_V0)); const bf16_t* HID = (const bf16_t*)(ws + WS_HID); const bf16_t* W2G = (const bf16_t*)(ws + WS_W2G) + (size_t)li * 1024 * 128;
    bf16_t* YG = (bf16_t*)(ws + WS_YG);
    for (int up = blockIdx.x; up < NUNIT_A / 2; up += gridDim.x) {
        const int u = 2 * up + hb; const int b = u / (NCH * H), n = (u / H) % NCH, h = u % H; const int row = b * TP + 64 * n + 16 * tt + fr;
        const bf16_t* RP = (const bf16_t*)(ws + WS_RP) + (size_t)u * 4096; const float* YL = (const float*)(ws + WS_YL) + (size_t)u * 4096; const bf16_t* S0 = (const bf16_t*)(ws + WS_S0) + (size_t)u * 4096;
        f32x4 acc[4], ag[4];
#pragma unroll
        for (int it = 0; it < 4; ++it) { acc[it] = *(const f32x4*)(YL + (size_t)(16 * tt + fr) * 64 + 16 * it + 4 * fq); ag[it] = (f32x4){0.f, 0.f, 0.f, 0.f}; }
#pragma unroll
        for (int ks = 0; ks < 2; ++ks) { const bf16x8 bq = *(const bf16x8*)(RP + (size_t)(16 * tt + fr) * 64 + 32 * ks + 8 * fq);
#pragma unroll
            for (int it = 0; it < 4; ++it) acc[it] = mfma16(*(const bf16x8*)(S0 + (size_t)(16 * it + fr) * 64 + 32 * ks + 8 * fq), bq, acc[it]); }
        const bf16_t* hgp = launder_p(HID + (size_t)row * LHID + 160 + 8 * fq); const bf16_t* wgp = launder_p(W2G + (size_t)(64 * h + fr) * 128 + 8 * fq);
#pragma unroll
        for (int ks = 0; ks < 4; ++ks) { const bf16x8 bq = *(const bf16x8*)(hgp + 32 * ks);
#pragma unroll
            for (int it = 0; it < 4; ++it) ag[it] = mfma16(*(const bf16x8*)(wgp + it * 16 * 128 + 32 * ks), bq, ag[it]); }
        float s = 0.f;
#pragma unroll
        for (int it = 0; it < 4; ++it) s += (acc[it][0] + acc[it][1]) + (acc[it][2] + acc[it][3]);
        s = sum_rows4(s); const float mean = s * (1.0f / 64.0f);
        float q = 0.f;
#pragma unroll
        for (int it = 0; it < 4; ++it) { const f32x4 d = acc[it] - mean; q += (d[0] * d[0] + d[1] * d[1]) + (d[2] * d[2] + d[3] * d[3]); }
        q = sum_rows4(q); const float rstd = frsq(q * (1.0f / 64.0f) + GN_EPS);
        const float rks = ((const float*)(ws + WS_RKS))[(size_t)row * 16 + h];
#pragma unroll
        for (int it = 0; it < 4; ++it) { const int C = 64 * h + 16 * it + 4 * fq; const size_t pc = (size_t)li * D + C;
            const f32x4 lw = *(const f32x4*)(p->in[I_LNW] + pc), lb = *(const f32x4*)(p->in[I_LNB] + pc), v = *(const f32x4*)(Vb + (size_t)row * D + C);
            const f32x4 o = ((acc[it] - mean) * rstd * lw + lb + v * rks) * ag[it];
            u32x2 w; w.x = pk2(o[0], o[1]); w.y = pk2(o[2], o[3]); *(u32x2*)(YG + (size_t)row * D + C) = w; }
    }
}
__device__ __forceinline__ void ld8bf(const bf16_t* p, float (&o)[8]) { const u32x4 w = *(const u32x4*)p; o[0] = bflo(w.x); o[1] = bfhi(w.x); o[2] = bflo(w.y); o[3] = bfhi(w.y); o[4] = bflo(w.z); o[5] = bfhi(w.z); o[6] = bflo(w.w); o[7] = bfhi(w.w); }
__device__ __forceinline__ void ld8f(const float* p, float (&o)[8]) { const f32x4 a = *(const f32x4*)p, b = *(const f32x4*)(p + 4); o[0] = a[0]; o[1] = a[1]; o[2] = a[2]; o[3] = a[3]; o[4] = b[0]; o[5] = b[1]; o[6] = b[2]; o[7] = b[3]; }
__device__ __forceinline__ void phase_conv(KP p, const Ctx& c, int layer) {
    const bf16_t* U = (const bf16_t*)(p->ws + WS_U); const bf16_t* GT = (const bf16_t*)(p->ws + WS_GT); bf16_t* HH = (bf16_t*)(p->ws + WS_HH);
    const float* cw = p->in[I_CONVW] + (size_t)layer * 3 * DFF; const float* cb = p->in[I_CONVB] + (size_t)layer * DFF; const float* st = p->in[I_SCONV] + (size_t)layer * SB * 2 * DFF;
    constexpr int NF8 = DFF / 8, NPS = MP / 64, NITEM = (NPS + SB) * NF8;
    for (int e = c.gtid; e < NITEM; e += c.gsz) { const int sidx = e / NF8, f = 8 * (e % NF8);
        int row0, nrow; float u0[8], u1[8];
        if (sidx < NPS) { row0 = 64 * sidx; nrow = 64;
            if ((row0 & (TP - 1)) == 0) {
#pragma unroll
                for (int i = 0; i < 8; ++i) { u0[i] = 0.f; u1[i] = 0.f; } }
            else { ld8bf(U + (size_t)(row0 - 1) * DFF + f, u1); ld8bf(U + (size_t)(row0 - 2) * DFF + f, u0); } }
        else { const int b = sidx - NPS; row0 = MP + 4 * b; nrow = 4; ld8f(st + ((size_t)b * 2 + 1) * DFF + f, u1); ld8f(st + ((size_t)b * 2) * DFF + f, u0); }
        float w0[8], w1[8], w2[8], bb[8];
        ld8f(cw + f, w0); ld8f(cw + DFF + f, w1); ld8f(cw + 2 * DFF + f, w2); ld8f(cb + f, bb);
        for (int r = 0; r < nrow; r += 4) {
            u32x4 ur[4], gr[4];
#pragma unroll
            for (int q = 0; q < 4; ++q) { ur[q] = *(const u32x4*)(U + (size_t)(row0 + r + q) * DFF + f); gr[q] = *(const u32x4*)(GT + (size_t)(row0 + r + q) * DFF + f); }
#pragma unroll
            for (int q = 0; q < 4; ++q) { float u2[8], g[8];
                u2[0] = bflo(ur[q].x); u2[1] = bfhi(ur[q].x); u2[2] = bflo(ur[q].y); u2[3] = bfhi(ur[q].y); u2[4] = bflo(ur[q].z); u2[5] = bfhi(ur[q].z); u2[6] = bflo(ur[q].w); u2[7] = bfhi(ur[q].w);
                g[0] = bflo(gr[q].x); g[1] = bfhi(gr[q].x); g[2] = bflo(gr[q].y); g[3] = bfhi(gr[q].y); g[4] = bflo(gr[q].z); g[5] = bfhi(gr[q].z); g[6] = bflo(gr[q].w); g[7] = bfhi(gr[q].w);
                float o[8];
#pragma unroll
                for (int i = 0; i < 8; ++i) { o[i] = gelu_tanh(bb[i] + w0[i] * u0[i] + w1[i] * u1[i] + w2[i] * u2[i]) * g[i]; u0[i] = u1[i]; u1[i] = u2[i]; }
                u32x4 w; w.x = pk2(o[0], o[1]); w.y = pk2(o[2], o[3]); w.z = pk2(o[4], o[5]); w.w = pk2(o[6], o[7]);
                *(u32x4*)(HH + (size_t)(row0 + r + q) * DFF + f) = w; }
        }
    }
}

__device__ __forceinline__ void phase_kvpost(KP p, const Ctx& c) {
    const float* KVF = (const float*)(p->ws + WS_KVF); unsigned char* ws = p->ws; const int lane = c.lane, g = lane >> 4, d0 = 4 * (lane & 15);
    const f32x4 gs = *(const f32x4*)(p->in[I_KNG] + 64 + d0), gw = *(const f32x4*)(p->in[I_KNG] + 128 + d0);
    bf16_t* CA = (bf16_t*)(ws + WS_CMPA); bf16_t* KS = (bf16_t*)(ws + WS_KS); bf16_t* VS = (bf16_t*)(ws + WS_VS); bf16_t* KW = (bf16_t*)(ws + WS_KW); bf16_t* VW = (bf16_t*)(ws + WS_VW);
    for (int chunk = c.gw; chunk < R / 8; chunk += c.ngw) {
        unsigned vs_[4][4], vw_[4][4];
#pragma unroll
        for (int e = 0; e < 8; ++e) { const int row = chunk * 8 + e; const float* src = KVF + (size_t)row * NKV + 4 * lane;
            f32x4 v[6];
#pragma unroll
            for (int pt = 0; pt < 6; ++pt) v[pt] = *(const f32x4*)(src + pt * 256);
            { float s = (v[2][0] * v[2][0] + v[2][1] * v[2][1]) + (v[2][2] * v[2][2] + v[2][3] * v[2][3]);
              s = row16_sum(s); const float rs = frsq(s * (1.0f / 64.0f) + NORM_EPS); v[2] = v[2] * rs * gs; }
            { float s = (v[4][0] * v[4][0] + v[4][1] * v[4][1]) + (v[4][2] * v[4][2] + v[4][3] * v[4][3]);
              s = row16_sum(s); const float rs = frsq(s * (1.0f / 64.0f) + NORM_EPS); v[4] = v[4] * rs * gw; }
            float* okv = p->out + O_KV + (size_t)row * D + 4 * lane;
#pragma unroll
            for (int pt = 0; pt < 4; ++pt) *(f32x4*)(okv + pt * 256) = v[pt];
            if (row < MP) { const int b = row >> 13, t = row & (TP - 1);
                if (t >= TP - WIN) { float* ow = p->out + O_WINP + ((size_t)(b * WIN + (t - (TP - WIN))) * 2) * 256 + 4 * lane; *(f32x4*)ow = v[4]; *(f32x4*)(ow + 256) = v[5]; }
                const size_t hb = (size_t)(b * G + g);
                { u32x2 w; w.x = pk2(v[0][0], v[0][1]); w.y = pk2(v[0][2], v[0][3]); *(u32x2*)(CA + (hb * 512 + (t >> 4)) * 1024 + (t & 15) * 64 + d0) = w; }
                { u32x2 w; w.x = pk2(v[1][0], v[1][1]); w.y = pk2(v[1][2], v[1][3]); *(u32x2*)(CA + ((size_t)4096 + hb * 512 + (t >> 4)) * 1024 + (t & 15) * 64 + d0) = w; }
                { u32x2 w; w.x = pk2(v[2][0], v[2][1]); w.y = pk2(v[2][2], v[2][3]); *(u32x2*)(KS + (hb * TP + t) * 64 + d0) = w; }
                { u32x2 w; w.x = pk2(v[4][0], v[4][1]); w.y = pk2(v[4][2], v[4][3]); *(u32x2*)(KW + (hb * TP + t) * 64 + d0) = w; }
#pragma unroll
                for (int d = 0; d < 4; ++d) { const unsigned a = f2bf(v[3][d]), bq = f2bf(v[5][d]);
                    if (e & 1) { vs_[d][e >> 1] |= a << 16; vw_[d][e >> 1] |= bq << 16; } else { vs_[d][e >> 1] = a; vw_[d][e >> 1] = bq; } }
            } else { const int b = (row - MP) >> 2, t = (row - MP) & 3;
                float* ow = p->out + O_WINS + ((size_t)(b * WIN + 508 + t) * 2) * 256 + 4 * lane; *(f32x4*)ow = v[4]; *(f32x4*)(ow + 256) = v[5]; }
        }
        if (chunk * 8 < MP) { const int row = chunk * 8, b = row >> 13, t = row & (TP - 1); const size_t hb = (size_t)(b * G + g);
#pragma unroll
            for (int d = 0; d < 4; ++d) { *(u32x4*)(VS + (hb * 64 + d0 + d) * TP + t) = (u32x4){vs_[d][0], vs_[d][1], vs_[d][2], vs_[d][3]};
                *(u32x4*)(VW + (hb * 64 + d0 + d) * TP + t) = (u32x4){vw_[d][0], vw_[d][1], vw_[d][2], vw_[d][3]}; } }
    }
}

__device__ __forceinline__ void phase_cmp2(KP p, const Ctx& c) {
    unsigned char* ws = p->ws; const float* PC = (const float*)(ws + WS_PCMP); const int lane = c.lane, fr = lane & 15, fq = lane >> 4;
    const bf16_t* W2H = (const bf16_t*)(ws + WS_CW2T); const bf16_t* W2L = W2H + 2 * 64 * 128;
    constexpr int NPI = NB * G * 32, NSI = SB * G * 8, TOT = 2 * (NPI + NSI);
    for (int it = c.gw; it < TOT; it += c.ngw) {
        const bool samp = it >= 2 * NPI; const int r = samp ? it - 2 * NPI : it; const int kv = samp ? r / NSI : r / NPI; const int idx = samp ? r % NSI : r % NPI;
        const int hb = samp ? (idx >> 3) : (idx >> 5), n0 = 16 * (samp ? (idx & 7) : (idx & 31)), ncmp = samp ? NCMP_S : NCMP_P, nper = samp ? 128 : 512;
        const int n = n0 + fr; const bool live = n < ncmp;
        const size_t prow = (samp ? (size_t)8192 + (size_t)kv * 65536 : (size_t)kv * 4096) + (size_t)hb * nper + (live ? n : ncmp - 1);
        const float* cb = (const float*)(ws + WS_CBIAS) + kv * 128;
        bf16x8 hh[4], hl[4];
#pragma unroll
        for (int ks = 0; ks < 4; ++ks) { const int k0 = 32 * ks + 8 * fq; unsigned uh[8], ul[8];
            const f32x4 a0 = *(const f32x4*)(PC + prow * 256 + k0), a1 = *(const f32x4*)(PC + prow * 256 + k0 + 4);
            const f32x4 b0 = *(const f32x4*)(PC + (prow + 1) * 256 + 128 + k0), b1 = *(const f32x4*)(PC + (prow + 1) * 256 + 128 + k0 + 4);
            const f32x4 c0 = *(const f32x4*)(cb + k0), c1 = *(const f32x4*)(cb + k0 + 4);
#pragma unroll
            for (int e = 0; e < 8; ++e) { const float x = e < 4 ? a0[e] + b0[e] + c0[e] : a1[e - 4] + b1[e - 4] + c1[e - 4]; const float hv = gelu_tanh(x);
                uh[e] = f2bf(hv); ul[e] = f2bf(hv - __builtin_bit_cast(float, uh[e] << 16)); }
            const u32x4 wh = {uh[0] | (uh[1] << 16), uh[2] | (uh[3] << 16), uh[4] | (uh[5] << 16), uh[6] | (uh[7] << 16)}, wl = {ul[0] | (ul[1] << 16), ul[2] | (ul[3] << 16), ul[4] | (ul[5] << 16), ul[6] | (ul[7] << 16)};
            hh[ks] = __builtin_bit_cast(bf16x8, wh); hl[ks] = __builtin_bit_cast(bf16x8, wl); }
        f32x4 acc[4];
#pragma unroll
        for (int dt = 0; dt < 4; ++dt) { acc[dt] = *(const f32x4*)(p->in[I_CB2] + kv * 64 + 16 * dt + 4 * fq);
#pragma unroll
            for (int ks = 0; ks < 4; ++ks) { const size_t wo = (size_t)(kv * 64 + 16 * dt + fr) * 128 + 32 * ks + 8 * fq; const bf16x8 wh = *(const bf16x8*)(W2H + wo), wl = *(const bf16x8*)(W2L + wo);
                acc[dt] = mfma16(wh, hh[ks], acc[dt]); acc[dt] = mfma16(wh, hl[ks], acc[dt]); acc[dt] = mfma16(wl, hh[ks], acc[dt]); } }
        if (kv == 0) { float ss = 0.f;
#pragma unroll
            for (int dt = 0; dt < 4; ++dt) ss += (acc[dt][0] * acc[dt][0] + acc[dt][1] * acc[dt][1]) + (acc[dt][2] * acc[dt][2] + acc[dt][3] * acc[dt][3]);
            ss = sum_rows4(ss); const float rs = frsq(ss * (1.0f / 64.0f) + NORM_EPS);
#pragma unroll
            for (int dt = 0; dt < 4; ++dt) acc[dt] = acc[dt] * rs * *(const f32x4*)(p->in[I_KNG] + 16 * dt + 4 * fq); }
#pragma unroll
        for (int dt = 0; dt < 4; ++dt) { const f32x4 o = live ? acc[dt] : (f32x4){0.f, 0.f, 0.f, 0.f}; const int d = 16 * dt + 4 * fq;
            if (samp) *(f32x4*)((float*)(ws + (kv ? WS_CVS : WS_CKS)) + ((size_t)hb * 128 + n) * 64 + d) = o;
            else if (kv == 0) { u32x2 w; w.x = pk2(o[0], o[1]); w.y = pk2(o[2], o[3]); *(u32x2*)((bf16_t*)(ws + WS_CK) + ((size_t)hb * 512 + n) * 64 + d) = w; }
            else {
#pragma unroll
                for (int e = 0; e < 4; ++e) ((bf16_t*)(ws + WS_CV))[((size_t)hb * 64 + d + e) * 512 + n] = (bf16_t)f2bf(o[e]); } }
    }
}

__device__ __forceinline__ void phase_qpost(KP p, const Ctx& c, int lb) {
    const float* QF = (const float*)(p->ws + WS_QF); bf16_t* Q = (bf16_t*)(p->ws + WS_Q); const int lane = c.lane;
    const f32x4 gq = *(const f32x4*)(p->in[I_QNG] + lb * 64 + 4 * (lane & 15));
    for (int row = c.gw; row < R; row += c.ngw) { const float* src = QF + (size_t)row * NQP;
        f32x4 v[4]; load_row(src, lane, v);
#pragma unroll
        for (int j = 0; j < 4; ++j) { float s = (v[j][0] * v[j][0] + v[j][1] * v[j][1]) + (v[j][2] * v[j][2] + v[j][3] * v[j][3]);
            s = row16_sum(s);
            const float rs = (frsq(s * (1.0f / 64.0f) + NORM_EPS)) * (0.125f * 1.4426950408889634f); v[j] = v[j] * rs * gq; }
        store_row_bf16(Q + (size_t)row * D, lane, v);
    }
}
constexpr int AT_K0 = 0, AT_V0 = 9216, AT_K1 = 18432, AT_V1 = 27648, AT_IMP = 36864, IMPS = 132, AT_SELM = AT_IMP + 64 * IMPS * 4, AT_ANY = AT_SELM + 1024;
static_assert(AT_ANY + 16 <= RING_BYTES, "attention LDS map");
struct TileSrc { const bf16_t* K; const bf16_t* VT; int vts; };
__device__ __forceinline__ void tile_load(const TileSrc& s, int key0, int tid, u32x4& rk, u32x4& rv) {
    const int row = tid >> 3, ch = tid & 7;
    rk = *(const u32x4*)(s.K + (size_t)(key0 + row) * 64 + 8 * ch); rv = *(const u32x4*)(s.VT + (size_t)row * s.vts + key0 + 8 * ch);
}
__device__ __forceinline__ void tile_load_async(const TileSrc& s, int key0, int tid, u32x4& rk, u32x4& rv) {
    const int row = tid >> 3, ch = tid & 7;
    const bf16_t* pk = s.K + (size_t)(key0 + row) * 64 + 8 * ch; const bf16_t* pv = s.VT + (size_t)row * s.vts + key0 + 8 * ch;
    asm volatile("global_load_dwordx4 %0, %2, off\n\tglobal_load_dwordx4 %1, %3, off" : "=&v"(rk), "=&v"(rv) : "v"(pk), "v"(pv) : "memory");
}
#define TILE_WAIT(N_, RK_, RV_) asm volatile("s_waitcnt vmcnt(" #N_ ")" : "+v"(RK_), "+v"(RV_) :: "memory")
__device__ __forceinline__ void tile_store(LAS unsigned char* lds, int buf, int tid, const u32x4& rk, const u32x4& rv) {
    const int row = tid >> 3, ch = tid & 7;
    *(LAS u32x4*)(lds + (buf ? AT_K1 : AT_K0) + (row * SST + 8 * ch) * 2) = rk; *(LAS u32x4*)(lds + (buf ? AT_V1 : AT_V0) + (row * SST + 8 * ch) * 2) = rv;
}
__device__ __forceinline__ int first_bit4(unsigned a, unsigned b, unsigned c, unsigned d) { return a ? __ffs(a) - 1 : (b ? 32 + __ffs(b) - 1 : (c ? 64 + __ffs(c) - 1 : (d ? 96 + __ffs(d) - 1 : -1))); }
__device__ __forceinline__ float ex2(float x) { return __builtin_amdgcn_exp2f(x); }

__device__ __forceinline__ void set_bit4(int s, unsigned& t0, unsigned& t1, unsigned& t2, unsigned& t3) { const unsigned bit = 1u << (s & 31); const int w = s >> 5; t0 |= (w == 0) ? bit : 0u; t1 |= (w == 1) ? bit : 0u; t2 |= (w == 2) ? bit : 0u; t3 |= (w == 3) ? bit : 0u; }
__device__ __forceinline__ void clr_bit4(int s, unsigned& t0, unsigned& t1, unsigned& t2, unsigned& t3) { const unsigned bit = 1u << (s & 31); const int w = s >> 5; t0 &= ~((w == 0) ? bit : 0u); t1 &= ~((w == 1) ? bit : 0u); t2 &= ~((w == 2) ? bit : 0u); t3 &= ~((w == 3) ? bit : 0u); }
__device__ __forceinline__ unsigned get_word4(int s, unsigned a, unsigned b, unsigned c, unsigned d) { const int w = s >> 5; return ((w == 0) ? a : 0u) | ((w == 1) ? b : 0u) | ((w == 2) ? c : 0u) | ((w == 3) ? d : 0u); }
__device__ __forceinline__ float dpp_xor1(float x) { return __builtin_bit_cast(float, __builtin_amdgcn_update_dpp(0, __builtin_bit_cast(int, x), 0xB1, 0xF, 0xF, true)); }
__device__ __forceinline__ float dpp_xor2(float x) { return __builtin_bit_cast(float, __builtin_amdgcn_update_dpp(0, __builtin_bit_cast(int, x), 0x4E, 0xF, 0xF, true)); }
template <int MODE, bool EDGE> __device__ __forceinline__ void attn_tile(LAS unsigned char* lds, int buf, const bf16x8 (&qf)[4], int key0, int qpos, int r, int hf,
                                                                          float& l, f32x16 (&O)[2], float invl, bool selbit, LAS float* impq) {
    if (MODE == 3) { if (__ballot(selbit) == 0ull) { asm volatile("" : "+v"(O[0]), "+v"(O[1]), "+v"(l)); return; } }
    const unsigned smask = selbit ? 0xffffffffu : 0u;
    const int oK = buf ? AT_K1 : AT_K0, oV = buf ? AT_V1 : AT_V0;
#pragma unroll
    for (int kt = 0; kt < 2; ++kt) {
        f32x16 S;
#pragma unroll
        for (int i = 0; i < 16; ++i) S[i] = 0.f;
#pragma unroll
        for (int ks = 0; ks < 4; ++ks) S = mfma32(*(const LAS bf16x8*)(lds + oK + ((32 * kt + r) * SST + 16 * ks + 8 * hf) * 2), qf[ks], S);
        float ls = 0.f;
#pragma unroll
        for (int i = 0; i < 16; ++i) { float pv = ex2(S[i]);
            if (EDGE) { const int key = key0 + 32 * kt + (i & 3) + 8 * (i >> 2) + 4 * hf; bool v;
                if (MODE <= 1) v = (16 * key + 31 <= qpos); else if (MODE == 2) v = (key <= qpos) && (key + WIN > qpos); else v = (key <= qpos);
                pv = v ? pv : 0.f; }
            if (MODE == 1) pv *= invl;
            S[i] = pv; ls += pv; }
        if (MODE == 3) ls = selbit ? ls : 0.f;
        if (MODE != 1) l += ls;
        if (MODE >= 1) {
#pragma unroll
            for (int sp = 0; sp < 2; ++sp) {
                u32x4 pw; pw.x = pg8::cvt_pk_bf16(S[8 * sp + 0], S[8 * sp + 1]); pw.y = pg8::cvt_pk_bf16(S[8 * sp + 2], S[8 * sp + 3]); pw.z = pg8::cvt_pk_bf16(S[8 * sp + 4], S[8 * sp + 5]); pw.w = pg8::cvt_pk_bf16(S[8 * sp + 6], S[8 * sp + 7]);
                if (MODE == 3) { pw.x &= smask; pw.y &= smask; pw.z &= smask; pw.w &= smask; }
                const bf16x8 pf = __builtin_bit_cast(bf16x8, pw);
#pragma unroll
                for (int dt = 0; dt < 2; ++dt) { const int d = 32 * dt + r, kb = 32 * kt + 16 * sp + 4 * hf;
                    const u32x2 lo = *(const LAS u32x2*)(lds + oV + (d * SST + kb) * 2), hi = *(const LAS u32x2*)(lds + oV + (d * SST + kb + 8) * 2);
                    const u32x4 vw = {lo.x, lo.y, hi.x, hi.y};
                    O[dt] = mfma32(__builtin_bit_cast(bf16x8, vw), pf, O[dt]); } }
        }
        if (MODE == 1) {
            float own[4], nxt[4];
#pragma unroll
            for (int gq = 0; gq < 4; ++gq) { const float p3 = S[4 * gq + 3]; float o = 2.0f * (S[4 * gq] + S[4 * gq + 1] + S[4 * gq + 2]) + p3, n = p3;
                o += dpp_xor1(o); o += dpp_xor2(o); n += dpp_xor1(n); n += dpp_xor2(n); own[gq] = o; nxt[gq] = n; }
            const int sbb = (key0 >> 2) + 8 * kt + hf;
            if ((r & 3) == 0) {
#pragma unroll
                for (int gq = 0; gq < 4; ++gq) impq[sbb + 2 * gq] += own[gq]; }
            asm volatile("s_waitcnt lgkmcnt(0)" ::: "memory");
            if ((r & 3) == 0) {
#pragma unroll
                for (int gq = 0; gq < 4; ++gq) impq[sbb + 2 * gq + 1] += nxt[gq]; }
            asm volatile("s_waitcnt lgkmcnt(0)" ::: "memory");
        }
    }
}

template <int MODE> __device__ __forceinline__ void run_tiles(LAS unsigned char* lds, const TileSrc& src, unsigned t0, unsigned t1, unsigned t2, unsigned t3, int qt,
                                                              const bf16x8 (&qf)[4], int qpos, int r, int hf, int tid,
                                                              float& l, f32x16 (&O)[2], float invl, unsigned s0, unsigned s1, unsigned s2, unsigned s3, LAS float* impq, const int alias = 0) {
#define TSEL(n_) ((alias ? ((n_) & 7) : (n_)) * 64)
    tid = launder_v(tid); r = tid & 31; hf = (tid >> 5) & 1;
    int cur = first_bit4(t0, t1, t2, t3); if (cur < 0) return;
    const int first = cur;
    clr_bit4(cur, t0, t1, t2, t3); int n1 = first_bit4(t0, t1, t2, t3); if (n1 >= 0) clr_bit4(n1, t0, t1, t2, t3);
    int n2 = first_bit4(t0, t1, t2, t3); if (n2 >= 0) clr_bit4(n2, t0, t1, t2, t3);
    int n3 = first_bit4(t0, t1, t2, t3); if (n3 >= 0) clr_bit4(n3, t0, t1, t2, t3);
    u32x4 rkA, rvA, rkB, rvB, rkC, rvC; { u32x4 rk, rv; tile_load(src, TSEL(cur), tid, rk, rv); int b0 = 0; tile_store(lds, b0, tid, rk, rv); }
    tile_load_async(src, TSEL(n1 >= 0 ? n1 : first), tid, rkA, rvA);
    tile_load_async(src, TSEL(n2 >= 0 ? n2 : first), tid, rkB, rvB);
    tile_load_async(src, TSEL(n3 >= 0 ? n3 : first), tid, rkC, rvC);
    int buf = 0;
    __syncthreads();
#define RT_STEP(RK_, RV_) { \
        if (cur >= 0) { \
            const unsigned sw = get_word4(cur, s0, s1, s2, s3); \
            const bool sb = ((sw >> (cur & 31)) & 1u) != 0u; \
            if (MODE <= 1) attn_tile<MODE, true>(lds, buf, qf, cur * 64, qpos, r, hf, l, O, invl, sb, impq); \
            else { const bool edge = (cur == qt) || (MODE == 2 && cur == qt - 8); \
                if (edge) attn_tile<MODE, true>(lds, buf, qf, cur * 64, qpos, r, hf, l, O, invl, sb, impq); \
                else attn_tile<MODE, false>(lds, buf, qf, cur * 64, qpos, r, hf, l, O, invl, sb, impq); } } \
        TILE_WAIT(4, RK_, RV_); \
        tile_store(lds, buf ^ 1, tid, RK_, RV_); \
        __syncthreads(); \
        const int n4 = first_bit4(t0, t1, t2, t3); if (n4 >= 0) clr_bit4(n4, t0, t1, t2, t3); \
        tile_load_async(src, TSEL(n4 >= 0 ? n4 : first), tid, RK_, RV_); \
        buf ^= 1; cur = n1; n1 = n2; n2 = n3; n3 = n4; }
    do {
        RT_STEP(rkA, rvA)
        RT_STEP(rkB, rvB)
        RT_STEP(rkC, rvC)
    } while (cur >= 0);
#undef RT_STEP
    asm volatile("s_waitcnt vmcnt(0)" : "+v"(rkA), "+v"(rvA), "+v"(rkB), "+v"(rvB), "+v"(rkC), "+v"(rvC) :: "memory");
    __syncthreads();
}
__device__ __forceinline__ void attn_prompt_unit(KP p, const Ctx& c, int k, const int stop, const int lb) {
    LAS unsigned char* lds = c.lds; unsigned char* ws = p->ws; int tid_m; asm volatile("v_mbcnt_lo_u32_b32 %0, -1, 0\n\tv_mbcnt_hi_u32_b32 %0, -1, %0" : "=v"(tid_m));
    const int wave = c.wave, tid = tid_m + 64 * wave, lane = tid & 63, r = lane & 31, hf = lane >> 5;
    const int qt = 127 - (k >> 3), hb = k & 7, b = hb >> 2, g = hb & 3, q0 = 64 * qt;
    const int qi = 8 * wave + (r >> 2), head = 4 * g + (r & 3), qpos = q0 + qi, row = b * TP + qpos;
    bf16x8 qf[4];
    { const float* QFp = (const float*)(ws + WS_QF) + (size_t)row * NQP + head * 64 + 8 * hf; const float* gqp = p->in[I_QNG] + lb * 64 + 8 * hf;
      f32x4 qv[4][2]; float ss = 0.f;
#pragma unroll
      for (int ks = 0; ks < 4; ++ks) { qv[ks][0] = *(const f32x4*)(QFp + 16 * ks); qv[ks][1] = *(const f32x4*)(QFp + 16 * ks + 4);
#pragma unroll
          for (int e = 0; e < 4; ++e) ss += qv[ks][0][e] * qv[ks][0][e] + qv[ks][1][e] * qv[ks][1][e]; }
      ss = sum_xor32(ss);
      const float rs = frsq(ss * (1.0f / 64.0f) + NORM_EPS) * (0.125f * 1.4426950408889634f);
#pragma unroll
      for (int ks = 0; ks < 4; ++ks) { const f32x4 g0 = *(const f32x4*)(gqp + 16 * ks), g1 = *(const f32x4*)(gqp + 16 * ks + 4); const f32x4 a = qv[ks][0] * rs * g0, bq = qv[ks][1] * rs * g1;
          const u32x4 wq = {pk2(a[0], a[1]), pk2(a[2], a[3]), pk2(bq[0], bq[1]), pk2(bq[2], bq[3])}; qf[ks] = __builtin_bit_cast(bf16x8, wq); } }
    const float* gate = (const float*)(ws + WS_GATE) + (size_t)row * 48 + head * 3; const float g_c = gate[0], g_s = gate[1], g_w = gate[2];
    LAS float* imp = (LAS float*)(lds + AT_IMP); LAS unsigned* selm = (LAS unsigned*)(lds + AT_SELM); LAS unsigned* anym = (LAS unsigned*)(lds + AT_ANY);
    for (int e = tid; e < 64 * IMPS; e += 512) imp[e] = 0.f;
    if (tid < 4) anym[tid] = 0u;
    __syncthreads();
    f32x16 O[2]; unsigned OUTP[2][8];
#pragma unroll
    for (int dt = 0; dt < 2; ++dt)
#pragma unroll
        for (int i = 0; i < 16; ++i) O[dt][i] = 0.f;
    {
        const TileSrc src{(const bf16_t*)(ws + WS_CK) + (size_t)hb * 512 * 64, (const bf16_t*)(ws + WS_CV) + (size_t)hb * 64 * 512, 512};
        const int nmax = q0 + 63 - 31; const int ntc = nmax >= 0 ? (nmax >> 10) + 1 : 0;
        const unsigned tm = ntc >= 32 ? 0xffffffffu : ((1u << ntc) - 1u);
        float l = 0.f;
        run_tiles<0>(lds, src, tm, 0u, 0u, 0u, qt, qf, qpos, r, hf, tid, l, O, 0.f, 0u, 0u, 0u, 0u, imp);
        l = sum_xor32(l); const float invl = l > 0.f ? 1.0f / l : 0.f;
        run_tiles<1>(lds, src, tm, 0u, 0u, 0u, qt, qf, qpos, r, hf, tid, l, O, invl, 0u, 0u, 0u, 0u, imp + qi * IMPS);
#pragma unroll
        for (int dt = 0; dt < 2; ++dt) {
#pragma unroll
            for (int i = 0; i < 8; ++i) { OUTP[dt][i] = pg8::cvt_pk_bf16(O[dt][2 * i] * g_c, O[dt][2 * i + 1] * g_c); asm volatile("" : "+v"(OUTP[dt][i])); }
#pragma unroll
            for (int i = 0; i < 16; ++i) O[dt][i] = 0.f; }
    }
    __syncthreads();
    if (stop == 1) return;
    {
        unsigned k0[8], k1[8], T[8]; int Kq[8];
#pragma unroll
        for (int e = 0; e < 8; ++e) { const int qq = 8 * wave + e, qp = q0 + qq, qb = qp >> 6;
            const bool c0 = (64 * lane <= qp), c1 = (64 * (lane + 64) <= qp);
            const unsigned a0_ = (lane == 0 || lane == qb || lane == qb - 1) ? 0xffffffffu : __builtin_bit_cast(unsigned, imp[qq * IMPS + lane]);
            const unsigned a1_ = (lane + 64 == qb || lane + 64 == qb - 1) ? 0xffffffffu : __builtin_bit_cast(unsigned, imp[qq * IMPS + lane + 64]);
            k0[e] = c0 ? a0_ : 0u; k1[e] = c1 ? a1_ : 0u;
            Kq[e] = qb + 1 < 16 ? qb + 1 : 16; T[e] = 0u; }
        if (qt < 64) {
            for (int bit = 31; bit >= 0; --bit) {
#pragma unroll
                for (int e = 0; e < 8; ++e) { const unsigned cand = T[e] | (1u << bit);
                    const int cnt = __popcll(__ballot(k0[e] >= cand)); if (cnt >= Kq[e]) T[e] = cand; } } }
        else {
            for (int bit = 31; bit >= 0; --bit) {
#pragma unroll
                for (int e = 0; e < 8; ++e) { const unsigned cand = T[e] | (1u << bit);
                    const int cnt = __popcll(__ballot(k0[e] >= cand)) + __popcll(__ballot(k1[e] >= cand)); if (cnt >= Kq[e]) T[e] = cand; } } }
#pragma unroll
        for (int e = 0; e < 8; ++e) { const int qq = 8 * wave + e, qp = q0 + qq;
            const bool c0 = (64 * lane <= qp), c1 = (64 * (lane + 64) <= qp);
            unsigned long long mlo = __ballot(k0[e] > T[e]), mhi = __ballot(k1[e] > T[e]), elo = __ballot(c0 && k0[e] == T[e]), ehi = __ballot(c1 && k1[e] == T[e]);
            int need = Kq[e] - (__popcll(mlo) + __popcll(mhi));
            for (; need > 0; --need) { if (elo) { mlo |= elo & (~elo + 1ull); elo &= elo - 1ull; } else { mhi |= ehi & (~ehi + 1ull); ehi &= ehi - 1ull; } }
            const unsigned m0 = (unsigned)mlo, m1 = (unsigned)(mlo >> 32), m2 = (unsigned)mhi, m3 = (unsigned)(mhi >> 32);
            if (lane == 0) { selm[qq * 4 + 0] = m0; selm[qq * 4 + 1] = m1; selm[qq * 4 + 2] = m2; selm[qq * 4 + 3] = m3;
                atomicOr((unsigned*)&anym[0], m0); atomicOr((unsigned*)&anym[1], m1); atomicOr((unsigned*)&anym[2], m2); atomicOr((unsigned*)&anym[3], m3); } }
    }
    __syncthreads();
    if (stop == 2) return;
    {
        const TileSrc src{(const bf16_t*)(ws + WS_KW) + (size_t)hb * TP * 64, (const bf16_t*)(ws + WS_VW) + (size_t)hb * 64 * TP, TP};
        const int tlo = qt >= 8 ? qt - 8 : 0; unsigned t0 = 0u, t1 = 0u, t2 = 0u, t3 = 0u;
        for (int s = tlo; s <= qt; ++s) set_bit4(s, t0, t1, t2, t3);
        float l = 0.f;
        run_tiles<2>(lds, src, t0, t1, t2, t3, qt, qf, qpos, r, hf, tid, l, O, 0.f, 0u, 0u, 0u, 0u, imp);
        l = sum_xor32(l); const float sc = l > 0.f ? g_w / l : 0.f;
#pragma unroll
        for (int dt = 0; dt < 2; ++dt) {
#pragma unroll
            for (int i = 0; i < 8; ++i) { OUTP[dt][i] = pg8::cvt_pk_bf16(bflo(OUTP[dt][i]) + O[dt][2 * i] * sc, bfhi(OUTP[dt][i]) + O[dt][2 * i + 1] * sc); asm volatile("" : "+v"(OUTP[dt][i])); }
#pragma unroll
            for (int i = 0; i < 16; ++i) O[dt][i] = 0.f; }
    }
    if (stop == 3) { __syncthreads(); return; }
    {
        const TileSrc src{(const bf16_t*)(ws + WS_KS) + (size_t)hb * TP * 64, (const bf16_t*)(ws + WS_VS) + (size_t)hb * 64 * TP, TP};
        const unsigned sz_ = (stop == 5) ? 0u : 0xffffffffu;
        const unsigned s0 = selm[qi * 4 + 0] & sz_, s1 = selm[qi * 4 + 1] & sz_, s2 = selm[qi * 4 + 2] & sz_, s3 = selm[qi * 4 + 3] & sz_;
        const unsigned a0 = __builtin_amdgcn_readfirstlane(anym[0]), a1 = __builtin_amdgcn_readfirstlane(anym[1]), a2 = __builtin_amdgcn_readfirstlane(anym[2]), a3 = __builtin_amdgcn_readfirstlane(anym[3]);
        float l = 0.f;
        run_tiles<3>(lds, src, a0, a1, a2, a3, qt, qf, qpos, r, hf, tid, l, O, 0.f, s0, s1, s2, s3, imp, stop == 4 ? 1 : 0);
        if (stop >= 4) { if (l == 12345.678f) ((float*)(ws + WS_GATE))[0] = O[0][0] + O[1][0]; __syncthreads(); return; }
        l = sum_xor32(l); const float sc = l > 0.f ? g_s / l : 0.f;
#pragma unroll
        for (int dt = 0; dt < 2; ++dt)
#pragma unroll
            for (int i = 0; i < 8; ++i) OUTP[dt][i] = pg8::cvt_pk_bf16(bflo(OUTP[dt][i]) + O[dt][2 * i] * sc, bfhi(OUTP[dt][i]) + O[dt][2 * i + 1] * sc);
    }
    bf16_t* AO = (bf16_t*)(ws + WS_YG) + (size_t)row * D + head * 64;
#pragma unroll
    for (int dt = 0; dt < 2; ++dt)
#pragma unroll
        for (int gq = 0; gq < 4; ++gq) { u32x2 w; w.x = OUTP[dt][2 * gq]; w.y = OUTP[dt][2 * gq + 1]; *(u32x2*)(AO + 32 * dt + 8 * gq + 4 * hf) = w; }
    __syncthreads();
}

constexpr int SA_RED = 0, SA_REDW = 2 * 16 * 65 * 4, SA_OC = SA_RED + SA_REDW, SA_EC = SA_OC + 2 * 4096, SA_LC = SA_EC + 2 * 4096, SA_PN = SA_LC + 256, SA_SEL = SA_PN + 4 * 512;
static_assert(SA_SEL + 64 <= RING_BYTES, "sample attention LDS map");
__device__ __forceinline__ bf16x8 pack8(const f32x4 a, const f32x4 b) { const u32x4 w = {pk2(a[0], a[1]), pk2(a[2], a[3]), pk2(b[0], b[1]), pk2(b[2], b[3])}; return __builtin_bit_cast(bf16x8, w); }
__device__ __forceinline__ void sa_qk(const float* kb, size_t stride, int nrows, const bf16x8 (&qf)[2], int fr, int fq, f32x4 (&S)[4]) {
    f32x4 kr[4][2][2];
#pragma unroll
    for (int kg = 0; kg < 4; ++kg) { const int key = 16 * kg + fr; const float* rp = kb + (size_t)(key < nrows ? key : nrows - 1) * stride + 8 * fq;
#pragma unroll
        for (int ks = 0; ks < 2; ++ks) { kr[kg][ks][0] = *(const f32x4*)(rp + 32 * ks); kr[kg][ks][1] = *(const f32x4*)(rp + 32 * ks + 4); } }
#pragma unroll
    for (int kg = 0; kg < 4; ++kg) { S[kg] = (f32x4){0.f, 0.f, 0.f, 0.f};
#pragma unroll
        for (int ks = 0; ks < 2; ++ks) S[kg] = mfma16(pack8(kr[kg][ks][0], kr[kg][ks][1]), qf[ks], S[kg]); }
}
__device__ __forceinline__ void sa_pv(const float* vb, size_t stride, int nrows, const f32x4 (&P)[4], int fr, int fq, f32x4 (&O)[4]) {
#pragma unroll
    for (int ks = 0; ks < 2; ++ks) { const bf16x8 pa = pack8(P[2 * ks], P[2 * ks + 1]);
        float vv[4][8];
#pragma unroll
        for (int j = 0; j < 8; ++j) { const int key = 16 * (2 * ks + (j >> 2)) + 4 * fq + (j & 3); const float* rp = vb + (size_t)(key < nrows ? key : nrows - 1) * stride + fr;
#pragma unroll
            for (int dt = 0; dt < 4; ++dt) vv[dt][j] = rp[16 * dt]; }
#pragma unroll
        for (int dt = 0; dt < 4; ++dt) { const u32x4 w = {pk2(vv[dt][0], vv[dt][1]), pk2(vv[dt][2], vv[dt][3]), pk2(vv[dt][4], vv[dt][5]), pk2(vv[dt][6], vv[dt][7])};
            O[dt] = mfma16(pa, __builtin_bit_cast(bf16x8, w), O[dt]); } }
}
__device__ __forceinline__ void attn_sample_unit(KP p, const Ctx& c, int item, const int lb) {
    unsigned char* ws = p->ws; LAS unsigned char* lds = c.lds; const int tid = launder_v(c.tid), lane = tid & 63, wave = c.wave, fr = lane & 15, fq = lane >> 4; const int b = item >> 2, g = item & 3;
    bf16x8 qf[2];
    { const float* QFp = (const float*)(ws + WS_QF) + (size_t)(MP + 4 * b + (fr >> 2)) * NQP + (4 * g + (fr & 3)) * 64 + 8 * fq; const float* gqp = p->in[I_QNG] + lb * 64 + 8 * fq;
      f32x4 qv[2][2]; float ss = 0.f;
#pragma unroll
      for (int ks = 0; ks < 2; ++ks) { qv[ks][0] = *(const f32x4*)(QFp + 32 * ks); qv[ks][1] = *(const f32x4*)(QFp + 32 * ks + 4);
#pragma unroll
          for (int e = 0; e < 4; ++e) ss += qv[ks][0][e] * qv[ks][0][e] + qv[ks][1][e] * qv[ks][1][e]; }
      ss = sum_rows4(ss);
      const float rs = frsq(ss * (1.0f / 64.0f) + NORM_EPS) * (0.125f * 1.4426950408889634f);
#pragma unroll
      for (int ks = 0; ks < 2; ++ks) { const f32x4 g0 = *(const f32x4*)(gqp + 32 * ks), g1 = *(const f32x4*)(gqp + 32 * ks + 4); const f32x4 a = qv[ks][0] * rs * g0, bq = qv[ks][1] * rs * g1;
          const u32x4 wq = {pk2(a[0], a[1]), pk2(a[2], a[3]), pk2(bq[0], bq[1]), pk2(bq[2], bq[3])}; qf[ks] = __builtin_bit_cast(bf16x8, wq); } }
    const int tokm = fr >> 2;
    if (wave < 2) {
        const float* ck = (const float*)(ws + WS_CKS) + ((size_t)(b * 4 + g) * 128 + 64 * wave) * 64; const float* cv = (const float*)(ws + WS_CVS) + ((size_t)(b * 4 + g) * 128 + 64 * wave) * 64;
        const int nrows = wave ? 63 : 64;
        f32x4 S[4]; sa_qk(ck, 64, nrows, qf, fr, fq, S);
        float ls = 0.f;
#pragma unroll
        for (int kg = 0; kg < 4; ++kg)
#pragma unroll
            for (int r = 0; r < 4; ++r) { const int key = 16 * kg + 4 * fq + r; const float ev = key < nrows ? ex2(S[kg][r]) : 0.f; S[kg][r] = ev; ls += ev;
                *(LAS float*)(lds + SA_EC + wave * 4096 + (key * 16 + fr) * 4) = ev; }
        ls = sum_rows4(ls); if (fq == 0) *(LAS float*)(lds + SA_LC + (wave * 16 + fr) * 4) = ls;
        f32x4 oc[4];
#pragma unroll
        for (int dt = 0; dt < 4; ++dt) oc[dt] = (f32x4){0.f, 0.f, 0.f, 0.f};
        sa_pv(cv, 64, nrows, S, fr, fq, oc);
#pragma unroll
        for (int dt = 0; dt < 4; ++dt)
#pragma unroll
            for (int r = 0; r < 4; ++r) *(LAS float*)(lds + SA_OC + wave * 4096 + ((4 * fq + r) * 64 + 16 * dt + fr) * 4) = oc[dt][r];
    }
    __syncthreads();
    if (wave < 4) { const int tok = wave; float P0 = 0.f, P1 = 0.f;
#pragma unroll
        for (int hh = 0; hh < 4; ++hh) { const int pi = tok * 4 + hh; const float L = *(const LAS float*)(lds + SA_LC + pi * 4) + *(const LAS float*)(lds + SA_LC + (16 + pi) * 4); const float inv = L > 0.f ? 1.0f / L : 0.f;
            P0 += *(const LAS float*)(lds + SA_EC + (lane * 16 + pi) * 4) * inv; P1 += *(const LAS float*)(lds + SA_EC + 4096 + (lane * 16 + pi) * 4) * inv; }
        LAS float* pn = (LAS float*)(lds + SA_PN + tok * 512); pn[lane] = P0; pn[64 + lane] = P1; LDS_WAIT();
        float v0 = -1e9f;
        if (lane < 33) { const int s = lane; float im = 0.f;
            if (4 * s - 1 >= 0 && 4 * s - 1 < 128) im += pn[4 * s - 1];
#pragma unroll
            for (int j = 0; j < 3; ++j) if (4 * s + j < 128) im += 2.0f * pn[4 * s + j];
            if (4 * s + 3 < 128) im += pn[4 * s + 3];
            v0 = (s == 0 || s == 31 || s == 32) ? 1e9f : im; }
        unsigned selmask = 0u, sel32 = 0u;
        for (int it = 0; it < 16; ++it) { const float mx = wave_max(v0); if (mx < -5e8f) break; const unsigned long long b0 = __ballot(v0 == mx); const int s = __ffsll((long long)b0) - 1;
            if (lane == s) v0 = -2e9f; if (s < 32) selmask |= 1u << s; else sel32 = 1u; }
        if (lane == 0) { *(LAS unsigned*)(lds + SA_SEL + tok * 8) = selmask; *(LAS unsigned*)(lds + SA_SEL + tok * 8 + 4) = sel32; } }
    __syncthreads();
    unsigned sm[4], s32[4];
#pragma unroll
    for (int t = 0; t < 4; ++t) { sm[t] = *(const LAS unsigned*)(lds + SA_SEL + t * 8); s32[t] = *(const LAS unsigned*)(lds + SA_SEL + t * 8 + 4); }
    const unsigned un = sm[0] | sm[1] | sm[2] | sm[3]; const int nsel = __popc(un); const int has32 = (s32[0] | s32[1] | s32[2] | s32[3]) ? 1 : 0;
    const unsigned my_sm = tokm == 0 ? sm[0] : (tokm == 1 ? sm[1] : (tokm == 2 ? sm[2] : sm[3])), my_s32 = tokm == 0 ? s32[0] : (tokm == 1 ? s32[1] : (tokm == 2 ? s32[2] : s32[3]));
    const int ntile = nsel + has32 + 9;
    const int* pt = (const int*)p->in[I_PT] + b * NPAGES;
    f32x4 osel[4], owin[4]; float lsel = 0.f, lwin = 0.f;
#pragma unroll
    for (int dt = 0; dt < 4; ++dt) { osel[dt] = (f32x4){0.f, 0.f, 0.f, 0.f}; owin[dt] = (f32x4){0.f, 0.f, 0.f, 0.f}; }
    for (int ti = wave; ti < ntile; ti += 8) {
        const float* kb; size_t stride; int nrows = 64, br, mode, sidx = 0;
        if (ti < nsel) { unsigned m = un; for (int q = 0; q < ti; ++q) m &= m - 1u; sidx = __ffs(m) - 1; const int page = pt[sidx >> 1];
            kb = p->in[I_CKV] + ((size_t)page * PAGE + (sidx & 1) * 64) * 1024 + 2 * 256 + g * 64; stride = 1024; br = 0; mode = 0; }
        else if (ti < nsel + has32) { kb = p->out + O_KV + (size_t)(MP + 4 * b) * D + 2 * 256 + g * 64; stride = 1024; nrows = 4; br = 0; mode = 1; }
        else if (ti < nsel + has32 + 8) { sidx = ti - nsel - has32; kb = p->in[I_CWIN] + ((size_t)b * WIN + 64 * sidx) * 512 + g * 64; stride = 512; br = 1; mode = 2; }
        else { kb = p->out + O_WINS + ((size_t)(b * WIN + 508) * 2) * 256 + g * 64; stride = 512; nrows = 4; br = 1; mode = 3; }
        f32x4 S[4]; sa_qk(kb, stride, nrows, qf, fr, fq, S);
        float ls = 0.f;
#pragma unroll
        for (int kg = 0; kg < 4; ++kg)
#pragma unroll
            for (int r = 0; r < 4; ++r) { const int key = 16 * kg + 4 * fq + r; bool valid;
                if (mode == 0) valid = ((my_sm >> sidx) & 1u) != 0u; else if (mode == 1) valid = (my_s32 != 0u) && (key <= tokm); else if (mode == 2) valid = (64 * sidx + key) >= tokm + 1; else valid = key <= tokm;
                const float ev = valid ? ex2(S[kg][r]) : 0.f; S[kg][r] = ev; ls += ev; }
        if (br == 0) { lsel += ls; sa_pv(kb + 256, stride, nrows, S, fr, fq, osel); } else { lwin += ls; sa_pv(kb + 256, stride, nrows, S, fr, fq, owin); }
    }
    lsel = sum_rows4(lsel); lwin = sum_rows4(lwin);
    for (int w = 0; w < 8; ++w) {
        if (wave == w) {
#pragma unroll
            for (int dt = 0; dt < 4; ++dt)
#pragma unroll
                for (int r = 0; r < 4; ++r) { LAS float* r0 = (LAS float*)(lds + SA_RED + ((4 * fq + r) * 65 + 16 * dt + fr) * 4); LAS float* r1 = (LAS float*)(lds + SA_RED + ((16 + 4 * fq + r) * 65 + 16 * dt + fr) * 4);
                    if (w == 0) { *r0 = osel[dt][r]; *r1 = owin[dt][r]; } else { *r0 += osel[dt][r]; *r1 += owin[dt][r]; } }
            if (fq == 0) { LAS float* l0 = (LAS float*)(lds + SA_RED + (fr * 65 + 64) * 4); LAS float* l1 = (LAS float*)(lds + SA_RED + ((16 + fr) * 65 + 64) * 4);
                if (w == 0) { *l0 = lsel; *l1 = lwin; } else { *l0 += lsel; *l1 += lwin; } } }
        __syncthreads(); }
    { const float* gt = (const float*)(ws + WS_GATE); bf16_t* AO = (bf16_t*)(ws + WS_YG);
      for (int e = tid; e < 1024; e += 512) { const int pi = e >> 6, d = e & 63, tok = pi >> 2, hh = pi & 3; const size_t row = (size_t)(MP + 4 * b + tok);
          const float lc = *(const LAS float*)(lds + SA_LC + pi * 4) + *(const LAS float*)(lds + SA_LC + (16 + pi) * 4);
          const float oc = *(const LAS float*)(lds + SA_OC + (pi * 64 + d) * 4) + *(const LAS float*)(lds + SA_OC + 4096 + (pi * 64 + d) * 4);
          const LAS float* r0 = (const LAS float*)(lds + SA_RED + (pi * 65) * 4); const LAS float* r1 = (const LAS float*)(lds + SA_RED + ((16 + pi) * 65) * 4);
          const float* gg = gt + row * 48 + (4 * g + hh) * 3;
          float out = lc > 0.f ? gg[0] * oc / lc : 0.f;
          out += r0[64] > 0.f ? gg[1] * r0[d] / r0[64] : 0.f;
          out += r1[64] > 0.f ? gg[2] * r1[d] / r1[64] : 0.f;
          AO[row * D + (4 * g + hh) * 64 + d] = (bf16_t)f2bf(out); } }
    __syncthreads();
}

__device__ __forceinline__ void phase_attn_prompt(KP p, const Ctx& c, const int lb, const int stop = 0) {
    const int Gd = gridDim.x, cb = blockIdx.x;
    for (int i = 0; i * Gd < 1024; ++i) { const int k = i * Gd + ((i & 1) ? Gd - 1 - cb : cb); if (k < 1024) attn_prompt_unit(p, c, k, stop, lb); }
}
__device__ __forceinline__ void phase_attn_sample(KP p, const Ctx& c, const int lb) {
    for (int it = blockIdx.x; it < SB * G; it += gridDim.x) attn_sample_unit(p, c, it, lb);
}
#ifndef MK_MULTI
#define MK_MULTI 0
#endif
#if defined(PROBE_SCALE) || defined(SELFTEST)
constexpr int NPH = 44;
#elif defined(PROBE_ATTN2)
constexpr int NPH = 45;
#else
constexpr int NPH = 43;
#endif
#ifdef SPLITK
#define RESID_SPLIT(n) (n)
#else
#define RESID_SPLIT(n) 0
#endif

__global__ void __launch_bounds__(512, 2) mega(Params p) {
    extern __shared__ __attribute__((aligned(16))) unsigned char lds_raw[];
    LAS unsigned char* const lds0 = (LAS unsigned char*)lds_raw;
    volatile LAS unsigned* MISC = (volatile LAS unsigned*)(lds0 + MISC_OFF);
    for (int u = threadIdx.x; u < (LDS_BYTES - RING_BYTES) / 4; u += 512) ((LAS unsigned*)(lds0 + RING_BYTES))[u] = 0u;
    __syncthreads();
    const KP kp0 = (KP)__builtin_amdgcn_kernarg_segment_ptr();
    const int ph_lo = kp0->ph_lo, ph_hi = kp0->ph_hi, use_bar = kp0->use_bar;
    XcdBarrier bar; bar.bar = (unsigned*)(kp0->ws + WS_CTL); bar.x = 0; bar.st = nullptr;
    if (use_bar) bar = xcd_barrier_post((unsigned*)(kp0->ws + WS_CTL), MISC + 8);
    const int wave_s = __builtin_amdgcn_readfirstlane((int)threadIdx.x >> 6);
#define TID_MBCNT 1
#ifdef TID_MBCNT
#define TID_SRC(T_) asm volatile("v_mbcnt_lo_u32_b32 %0, -1, 0\n\tv_mbcnt_hi_u32_b32 %0, -1, %0" : "=v"(T_)); T_ += 64 * wave_s;
#else
#define TID_SRC(T_) T_ = threadIdx.x; asm volatile("" : "+v"(T_));
#endif
    int ph = 0;
#define PHASE_BEGIN if (ph >= ph_lo && ph < ph_hi) { KP p = kp0; asm volatile("" : "+s"(p)); int tid_; TID_SRC(tid_) \
        Ctx c; c.lds = lds0; c.tid = tid_; c.lane = tid_ & 63; c.wave = __builtin_amdgcn_readfirstlane(tid_ >> 6); c.gw = blockIdx.x * 8 + c.wave; c.ngw = gridDim.x * 8; c.gtid = blockIdx.x * 512 + tid_; c.gsz = gridDim.x * 512; \
        unsigned char* ws = p->ws; float* X = p->out + O_Y; (void)ws; (void)X;
#define PHASE_END   if (use_bar) { int te_; TID_SRC(te_) xcd_barrier(bar, te_ == 0); } } ++ph;

    PHASE_BEGIN phase_prologue(p, c); PHASE_END
#ifdef PROBE_BAR
    for (int xb = 0; xb < PROBE_BAR; ++xb) { if (use_bar) xcd_barrier(bar, threadIdx.x == 0); }
#endif

    for (int layer = 0; layer < NLAY; ++layer) {
        if (layer < 2) {
            const int li = layer;
            PHASE_BEGIN phase_mix(p, c, li); PHASE_END
            PHASE_BEGIN {
                pg8::Gemm g{(const bf16_t*)(ws + WS_XM), (const bf16_t*)(ws + WS_WRKV) + (size_t)li * 3072 * 1024, 3 * R, 3072, 1024, 1024};
                pg8::GroupOrder S; S.init((int)gridDim.x, (int)blockIdx.x); S.add(0, 0, 64, 0, 4); S.add(1, 66, 64, 4, 4); S.add(2, 132, 64, 8, 4);
                pg8::EpiF32G E{(float*)(ws + WS_RK_R), (float*)(ws + WS_RK_K), (float*)(ws + (li ? WS_V1 : WS_V0)), nullptr, D, 4, 66};
                pg8::gemm_phase<pg8::EpiF32G, pg8::GroupOrder, true, true>(c.lds, g, S, E, c.tid);
                {
                    const bf16_t* XMs = (const bf16_t*)(ws + WS_XM); const bf16_t* Wr = (const bf16_t*)(ws + WS_WRKV) + (size_t)li * 3072 * 1024;
                    for (int it = blockIdx.x + gridDim.x * c.wave; it < 768; it += c.ngw) { const int j = it >> 8, r = it & 255, row0 = MP + 32 * (r & 15), col0 = 64 * (r >> 4);
                        float* C = (float*)(ws + (j == 0 ? WS_RK_R : (j == 1 ? WS_RK_K : (li ? WS_V1 : WS_V0))));
                        f32x4 acc[4][2]; skinny_mma<4>(XMs + (size_t)j * R * D, 1024, Wr + (size_t)j * 1024 * 1024, 1024, 1024, row0, col0, c.lane, acc);
                        const int fr = c.lane & 15, fq = c.lane >> 4;
#pragma unroll
                        for (int nt = 0; nt < 4; ++nt)
#pragma unroll
                            for (int mt = 0; mt < 2; ++mt) *(f32x4*)(C + (size_t)(row0 + 16 * mt + fr) * D + col0 + 16 * nt + 4 * fq) = acc[nt][mt]; }
                }
                phase_lora1(p, c, li);
            } PHASE_END
            PHASE_BEGIN phase_scanA(p, c, li); PHASE_END
            PHASE_BEGIN phase_scanB(p, c, li); PHASE_END
            PHASE_BEGIN phase_scanC(p, c, li); PHASE_END
        } else {
            const int lb = layer - 2;
            if (layer == 2) {
                PHASE_BEGIN phase_norm(c, X, p->in[I_KVNG], (bf16_t*)(ws + WS_XN2), p->in[I_NORMG] + (size_t)(layer * 2) * D, (bf16_t*)(ws + WS_XN)); PHASE_END
                PHASE_BEGIN {
                    pg8::Gemm g{(const bf16_t*)(ws + WS_XN2), (const bf16_t*)(ws + WS_WKVT), R, NKV, 1024, 1024};
                    pg8::GroupOrder S; S.init((int)gridDim.x, (int)blockIdx.x); S.add(0, 0, 66, 0, 6);
                    pg8::EpiF32G E{(float*)(ws + WS_KVF), nullptr, nullptr, nullptr, NKV, 1 << 20, 0};
                    pg8::gemm_phase<pg8::EpiF32G, pg8::GroupOrder, true, true>(c.lds, g, S, E, c.tid);
                } PHASE_END
                PHASE_BEGIN phase_kvpost(p, c); PHASE_END
                PHASE_BEGIN {
                    pg8::Gemm g{(const bf16_t*)(ws + WS_CMPA), (const bf16_t*)(ws + WS_CW1T), (int)CMPA_ROWS, 512, 1024, 1024};
                    pg8::GroupOrder S; S.init((int)gridDim.x, (int)blockIdx.x); S.add(0, 0, 16, 0, 1); S.add(1, 16, 16, 1, 1); S.add(2, 32, 256, 0, 1); S.add(3, 288, 256, 1, 1);
                    pg8::EpiF32G E{(float*)(ws + WS_PCMP), (float*)(ws + WS_PCMP), nullptr, nullptr, 256, 1, 0};
                    pg8::gemm_phase<pg8::EpiF32G, pg8::GroupOrder, true, true>(c.lds, g, S, E, c.tid);
                } PHASE_END
                PHASE_BEGIN phase_cmp2(p, c); PHASE_END
            } else {
                PHASE_BEGIN phase_norm(c, X, p->in[I_NORMG] + (size_t)(layer * 2) * D, (bf16_t*)(ws + WS_XN), nullptr, nullptr); PHASE_END
            }
            PHASE_BEGIN {
                const bf16_t* XNp = (const bf16_t*)(ws + WS_XN); const bf16_t* Wq = (const bf16_t*)(ws + WS_WQT) + (size_t)lb * NQP * 1024; float* QFp = (float*)(ws + WS_QF);
                pg8::Gemm g{XNp, Wq, R, NQP, 1024, 1024};
                pg8::GroupOrder S; S.init((int)gridDim.x, (int)blockIdx.x); S.add(0, 0, 64, 0, 4);
                pg8::EpiF32G E{QFp, nullptr, nullptr, nullptr, NQP, 1 << 20, 0};
                pg8::gemm_phase<pg8::EpiF32G, pg8::GroupOrder, true, true>(c.lds, g, S, E, c.tid);
                float* GATEp = (float*)(ws + WS_GATE);
                for (int it = blockIdx.x + gridDim.x * c.wave; it < 256 + R / 32; it += c.ngw) { const int ln = launder_v(c.lane), fr = ln & 15, fq = ln >> 4;
                    if (it < 256) { const int row0 = MP + 32 * (it & 15), col0 = 64 * (it >> 4);
                        f32x4 acc[4][2]; skinny_mma<4>(XNp, 1024, Wq, 1024, 1024, row0, col0, ln, acc);
#pragma unroll
                        for (int nt = 0; nt < 4; ++nt)
#pragma unroll
                            for (int mt = 0; mt < 2; ++mt) *(f32x4*)(QFp + (size_t)(row0 + 16 * mt + fr) * NQP + col0 + 16 * nt + 4 * fq) = acc[nt][mt]; }
                    else { const int row0 = 32 * (it - 256);
                        f32x4 acc[3][2]; skinny_mma<3>(XNp, 1024, Wq, 1024, 1024, row0, 1024, ln, acc);
#pragma unroll
                        for (int nt = 0; nt < 3; ++nt)
#pragma unroll
                            for (int mt = 0; mt < 2; ++mt) { f32x4 v = acc[nt][mt];
#pragma unroll
                                for (int e = 0; e < 4; ++e) v[e] = sigmoidf_(v[e]);
                                *(f32x4*)(GATEp + (size_t)(row0 + 16 * mt + fr) * 48 + 16 * nt + 4 * fq) = v; } }
                }
            } PHASE_END
            PHASE_BEGIN phase_attn_prompt(p, c, lb); PHASE_END
#ifdef PROBE_ATTN2
            PHASE_BEGIN phase_attn_prompt(p, c, lb, PROBE_ATTN2); PHASE_END
#endif
            PHASE_BEGIN phase_attn_sample(p, c, lb); PHASE_END
        }
        PHASE_BEGIN {
            const bf16_t* Wt = layer < 2 ? (const bf16_t*)(ws + WS_WORW) + (size_t)layer * 1024 * 1024 : (const bf16_t*)(ws + WS_WONSA) + (size_t)(layer - 2) * 1024 * 1024;
            pg8::Gemm g{(const bf16_t*)(ws + WS_YG), Wt, R, 1024, 1024, 1024};
            pg8::GroupOrder S; S.init((int)gridDim.x, (int)blockIdx.x); S.add(0, 0, 64, 0, 4);
            pg8::EpiResid E{X, D};
            pg8::gemm_phase<pg8::EpiResid, pg8::GroupOrder, true, true>(c.lds, g, S, E, c.tid);
            skinny_resid_sample(c, (const bf16_t*)(ws + WS_YG), 1024, Wt, 1024, X);
        } PHASE_END
        PHASE_BEGIN phase_norm(c, X, p->in[I_NORMG] + (size_t)(layer * 2 + 1) * D, (bf16_t*)(ws + WS_XN), nullptr, nullptr); PHASE_END
        PHASE_BEGIN {
            pg8::Gemm g{(const bf16_t*)(ws + WS_XN), (const bf16_t*)(ws + WS_WINT) + (size_t)layer * 5632 * 1024, R, 5632, 1024, 1024};
            pg8::GroupOrder S; S.init((int)gridDim.x, (int)blockIdx.x); S.add(0, 0, 66, 0, 22);
            pg8::EpiWin E{(bf16_t*)(ws + WS_U), (bf16_t*)(ws + WS_GT), p->out + O_CVP + (size_t)layer * NB * 2 * DFF, p->out + O_CVS + (size_t)layer * SB * 2 * DFF};
            pg8::gemm_phase<pg8::EpiWin, pg8::GroupOrder, true, true>(c.lds, g, S, E, c.tid);
        } PHASE_END
        PHASE_BEGIN phase_conv(p, c, layer); PHASE_END
        PHASE_BEGIN {
            pg8::Gemm g{(const bf16_t*)(ws + WS_HH), (const bf16_t*)(ws + WS_WOUTT) + (size_t)layer * 1024 * 2816, R, 1024, 2816, 2816};
            pg8::GroupOrder S; S.init((int)gridDim.x, (int)blockIdx.x); S.add(0, 0, 64, 0, 4);
            pg8::EpiResid E{X, D};
            pg8::gemm_phase<pg8::EpiResid, pg8::GroupOrder, true, true>(c.lds, g, S, E, c.tid);
            skinny_resid_sample(c, (const bf16_t*)(ws + WS_HH), 2816, (const bf16_t*)(ws + WS_WOUTT) + (size_t)layer * 1024 * 2816, 2816, X);
        } PHASE_END
    }
#ifdef SELFTEST
    PHASE_BEGIN if (blockIdx.x == 0 && c.wave == 0) { const float x = (float)((c.lane * 37) & 63) + 1.0f; float poison = 0.f;
        if (__ballot(swz_xor16_n(x) != __shfl_xor(x, 16))) poison += 1e3f;
        if (__ballot(sum_xor32_n(x) != x + __shfl_xor(x, 32))) poison += 1e4f;
        if (__ballot(sum_rows4_n(x) != x + __shfl_xor(x, 16) + __shfl_xor(x, 32) + __shfl_xor(x, 48))) poison += 1e5f;
        if (__ballot(wave_sum_n(x) != 2080.0f)) poison += 1e6f;
        if (__ballot(wave_max_n(x) != 64.0f)) poison += 1e7f;
        if (c.lane == 0) p->out[O_CVS] += poison; } PHASE_END
#endif
#ifdef PROBE_SCALE
    PHASE_BEGIN for (size_t e = c.gtid; e < O_END; e += c.gsz) { int oi = e < O_KV ? (e < (size_t)MP * D ? 0 : 1) : e < O_WINP ? (e < O_KV + (size_t)MP * D ? 2 : 3) : e < O_WINS ? 4 : e < O_WKVP ? 5 : e < O_WKVS ? 6 : e < O_SHP ? 7 : e < O_SHS ? 8 : e < O_CVP ? 9 : e < O_CVS ? 10 : 11;
        if (PROBE_SCALE < 0) oi = 11 - oi; p->out[e] *= 1.0f + sqrtf(0.5e-4f * (float)(oi + 1)); } PHASE_END
#endif
#undef PHASE_BEGIN
#undef PHASE_END
}

extern "C" void kernel_launch(void* const* d_in, const int* in_sizes, int n_in, void* d_out, int out_size, void* d_ws, size_t ws_size, hipStream_t stream) {
    static int grid = 0;
    if (grid == 0) {
        if (n_in != 45 || (size_t)out_size != O_END || ws_size < WS_END) { fprintf(stderr, "kernel_launch: unexpected shapes (n_in %d out %d ws %zu need %zu)\n", n_in, out_size, ws_size, (size_t)WS_END); grid = -1; return; }
        int dev = 0, cus = 0, per_cu = 0;
        if (hipGetDevice(&dev) != hipSuccess || hipDeviceGetAttribute(&cus, hipDeviceAttributeMultiprocessorCount, dev) != hipSuccess) { grid = -1; return; }
        if (hipFuncSetAttribute((const void*)mega, hipFuncAttributeMaxDynamicSharedMemorySize, LDS_BYTES) != hipSuccess) { fprintf(stderr, "kernel_launch: hipFuncSetAttribute failed\n"); grid = -1; return; }
        if (hipOccupancyMaxActiveBlocksPerMultiprocessor(&per_cu, (const void*)mega, 512, LDS_BYTES) != hipSuccess || per_cu < 1) { fprintf(stderr, "kernel_launch: occupancy query says %d\n", per_cu); (void)hipGetLastError(); }
        grid = cus;
    }
    if (grid < 0) return;
    (void)hipMemsetAsync((char*)d_ws + WS_CTL, 0, CTL_BYTES, stream);
    Params p{};
    for (int i = 0; i < 45; ++i) p.in[i] = (const float*)d_in[i];
    p.out = (float*)d_out; p.ws = (unsigned char*)d_ws;
#ifdef PROBE_PRE
    { const int plist[] = PROBE_PRE; for (int i = 0; i < (int)(sizeof(plist) / sizeof(int)); ++i) { p.ph_lo = plist[i] % 100; p.ph_hi = p.ph_lo + 1; p.use_bar = 0; p.pad = plist[i] / 100;       hipLaunchKernelGGL(mega, dim3(grid), dim3(512), LDS_BYTES, stream, p); } }
#endif
    p.pad = 0;
#if MK_MULTI
    for (int i = 0; i < NPH; ++i) { p.ph_lo = i; p.ph_hi = i + 1; p.use_bar = 0; hipLaunchKernelGGL(mega, dim3(grid), dim3(512), LDS_BYTES, stream, p); }
#else
    p.ph_lo = 0; p.ph_hi = NPH; p.use_bar = 1;
    hipLaunchKernelGGL(mega, dim3(grid), dim3(512), LDS_BYTES, stream, p);
#endif
    const hipError_t le = hipPeekAtLastError();
    if (le != hipSuccess) fprintf(stderr, "kernel_launch: launch failed: %s\n", hipGetErrorName(le));
}
```

```cpp
#include <hip/hip_runtime.h>
#include <cstdio>
#include <cstdint>

#define LAS __attribute__((address_space(3)))
#define GAS __attribute__((address_space(1)))
typedef unsigned short bf16_t;
typedef short bf16x8 __attribute__((ext_vector_type(8)));
typedef float f32x4 __attribute__((ext_vector_type(4)));
typedef float f32x16 __attribute__((ext_vector_type(16)));
typedef float f32x2 __attribute__((ext_vector_type(2)));
typedef unsigned u32x4 __attribute__((ext_vector_type(4)));
typedef unsigned u32x2 __attribute__((ext_vector_type(2)));

constexpr int D = 1024, NB = 2, TP = 8192, MP = NB * TP, SB = 128, ST = 4, MS = SB * ST, R = MP + MS;
constexpr int PAST = 2048, PAGE = 128, NPAGES = PAST / PAGE;
constexpr int H = 16, HD = 64, G = 4, HPG = 4, DFF = 2816, NLAY = 4;
constexpr int LW_ = 64, LA_ = 64, LV_ = 32, LG_ = 128, LHID = 288;
constexpr int NKV = 1536, NQ = 1072, NQP = 1280;
constexpr int NCH = TP / 64;
constexpr int NUNIT_A = NB * NCH * H;
constexpr int NCMP_P = 511, NCMP_S = 127, WIN = 512;
constexpr float NORM_EPS = 1e-6f, GN_EPS = 64e-5f;

constexpr size_t O_Y = 0;
constexpr size_t O_KV = (size_t)R * D;
constexpr size_t O_WINP = O_KV + (size_t)R * D;
constexpr size_t O_WINS = O_WINP + (size_t)NB * 512 * 512;
constexpr size_t O_WKVP = O_WINS + (size_t)SB * 512 * 512;
constexpr size_t O_WKVS = O_WKVP + (size_t)2 * NB * H * 4096;
constexpr size_t O_SHP = O_WKVS + (size_t)2 * SB * H * 4096;
constexpr size_t O_SHS = O_SHP + (size_t)2 * NB * D;
constexpr size_t O_CVP = O_SHS + (size_t)2 * SB * D;
constexpr size_t O_CVS = O_CVP + (size_t)NLAY * NB * 2 * DFF;
constexpr size_t O_END = O_CVS + (size_t)NLAY * SB * 2 * DFF;
static_assert(O_END == 88915968, "output size");

constexpr size_t MiB = 1u << 20;
constexpr size_t al(size_t x) { return (x + 4095) & ~(size_t)4095; }
constexpr size_t WS_CTL = 0, CTL_BYTES = 1 * MiB;
constexpr size_t WS_WRKV = WS_CTL + CTL_BYTES;
constexpr size_t WS_WORW = WS_WRKV + al((size_t)2 * 3072 * 1024 * 2);
constexpr size_t WS_W1T = WS_WORW + al((size_t)2 * 1024 * 1024 * 2);
constexpr size_t WS_W2W = WS_W1T + al((size_t)2 * 288 * 1024 * 2);
constexpr size_t WS_W2A = WS_W2W + al((size_t)2 * 1024 * 64 * 2);
constexpr size_t WS_W2V = WS_W2A + al((size_t)2 * 1024 * 64 * 2);
constexpr size_t WS_W2G = WS_W2V + al((size_t)1024 * 32 * 2);
constexpr size_t WS_WKVT = WS_W2G + al((size_t)2 * 1024 * 128 * 2);
constexpr size_t WS_WQT = WS_WKVT + al((size_t)1536 * 1024 * 2);
constexpr size_t WS_WONSA = WS_WQT + al((size_t)2 * 1280 * 1024 * 2);
constexpr size_t WS_WINT = WS_WONSA + al((size_t)2 * 1024 * 1024 * 2);
constexpr size_t WS_WOUTT = WS_WINT + al((size_t)4 * 5632 * 1024 * 2);
constexpr size_t WS_CW1T = WS_WOUTT + al((size_t)4 * 1024 * 2816 * 2);
constexpr size_t WS_CBIAS = WS_CW1T + al((size_t)2 * 256 * 1024 * 2);
constexpr size_t WS_CW2T = WS_CBIAS + al(2 * 128 * 4);
constexpr size_t WS_XM = WS_CW2T + al(2 * 2 * 64 * 128 * 2);
constexpr size_t WS_RK_R = WS_XM + al((size_t)6 * R * D * 2);
constexpr size_t WS_RK_K = WS_RK_R + al((size_t)R * D * 4);
constexpr size_t WS_V0 = WS_RK_K + al((size_t)R * D * 4);
constexpr size_t WS_V1 = WS_V0 + al((size_t)R * D * 4);
constexpr size_t WS_HID = WS_V1 + al((size_t)R * D * 4);
constexpr size_t WS_MT = WS_HID + al((size_t)R * LHID * 2);
constexpr size_t WS_NN = WS_MT + al((size_t)NUNIT_A * 4096 * 4);
constexpr size_t WS_RP = WS_NN + al((size_t)NUNIT_A * 4096 * 4);
constexpr size_t WS_YL = WS_RP + al((size_t)NUNIT_A * 4096 * 2);
constexpr size_t WS_S0 = WS_YL + al((size_t)NUNIT_A * 4096 * 4);
constexpr size_t WS_RKS = WS_S0 + al((size_t)NUNIT_A * 4096 * 2);
constexpr size_t WS_YG = WS_RKS + al((size_t)R * 16 * 4);
constexpr size_t WS_XN = WS_YG + al((size_t)R * D * 2);
constexpr size_t WS_XN2 = WS_XN + al((size_t)R * D * 2);
constexpr size_t WS_U = WS_XN2 + al((size_t)R * D * 2);
constexpr size_t WS_GT = WS_U + al((size_t)R * DFF * 2);
constexpr size_t WS_HH = WS_GT + al((size_t)R * DFF * 2);
constexpr size_t WS_KVF = WS_HH + al((size_t)R * DFF * 2);
constexpr size_t WS_CMPA = WS_KVF + al((size_t)R * NKV * 4);
constexpr size_t CMPA_ROWS = 4096 + 4096 + 65536 + 65536;
constexpr size_t WS_PCMP = WS_CMPA + al(CMPA_ROWS * 1024 * 2);
constexpr size_t WS_KS = WS_PCMP + al(CMPA_ROWS * 256 * 4);
constexpr size_t WS_VS = WS_KS + al((size_t)NB * G * TP * 64 * 2);
constexpr size_t WS_KW = WS_VS + al((size_t)NB * G * TP * 64 * 2);
constexpr size_t WS_VW = WS_KW + al((size_t)NB * G * TP * 64 * 2);
constexpr size_t WS_CK = WS_VW + al((size_t)NB * G * TP * 64 * 2);
constexpr size_t WS_CV = WS_CK + al((size_t)NB * G * 512 * 64 * 2);
constexpr size_t WS_CKS = WS_CV + al((size_t)NB * G * 512 * 64 * 2);
constexpr size_t WS_CVS = WS_CKS + al((size_t)SB * G * 128 * 64 * 4);
constexpr size_t WS_QF = WS_CVS + al((size_t)SB * G * 128 * 64 * 4);
constexpr size_t WS_Q = WS_QF + al((size_t)R * NQP * 4);
constexpr size_t WS_GATE = WS_Q + al((size_t)R * D * 2);
constexpr size_t WS_END = WS_GATE + al((size_t)R * 48 * 4);

typedef __bf16 bf16v2_ __attribute__((ext_vector_type(2)));
__device__ __forceinline__ unsigned cvt_pk_bf16_(float lo, float hi) { const f32x2 v = {lo, hi}; const bf16v2_ b = __builtin_convertvector(v, bf16v2_); return __builtin_bit_cast(unsigned, b); }
__device__ __forceinline__ unsigned f2bf(float f) { return cvt_pk_bf16_(f, f) & 0xffffu; }
__device__ __forceinline__ unsigned pk2(float lo, float hi) { return cvt_pk_bf16_(lo, hi); }
__device__ __forceinline__ float frcp(float x) { return __builtin_amdgcn_rcpf(x); }
__device__ __forceinline__ float frsq(float x) { return __builtin_amdgcn_rsqf(x); }
__device__ __forceinline__ float bf2f(unsigned short b) { return __builtin_bit_cast(float, ((unsigned)b) << 16); }
__device__ __forceinline__ float bflo(unsigned w) { return __builtin_bit_cast(float, w << 16); }
__device__ __forceinline__ float bfhi(unsigned w) { return __builtin_bit_cast(float, w & 0xffff0000u); }
template <int CTRL> __device__ __forceinline__ float dpp_f(float x) { return __builtin_bit_cast(float, __builtin_amdgcn_update_dpp(0, __builtin_bit_cast(int, x), CTRL, 0xF, 0xF, true)); }
__device__ __forceinline__ float row16_sum(float v) { v += dpp_f<0xB1>(v); v += dpp_f<0x4E>(v); v += dpp_f<0x141>(v); v += dpp_f<0x140>(v); return v; }
__device__ __forceinline__ float row16_max(float v) { v = fmaxf(v, dpp_f<0xB1>(v)); v = fmaxf(v, dpp_f<0x4E>(v)); v = fmaxf(v, dpp_f<0x141>(v)); v = fmaxf(v, dpp_f<0x140>(v)); return v; }
__device__ __forceinline__ float swz_xor16_n(float x) { return __builtin_bit_cast(float, __builtin_amdgcn_ds_swizzle(__builtin_bit_cast(int, x), 0x401F)); }
__device__ __forceinline__ float sum_xor32_n(float x) { auto rr = __builtin_amdgcn_permlane32_swap(__float_as_uint(x), __float_as_uint(x), false, false);
    return __uint_as_float(rr[0]) + __uint_as_float(rr[1]); }
__device__ __forceinline__ float sum_rows4_n(float x) { x += swz_xor16_n(x); return sum_xor32_n(x); }
__device__ __forceinline__ float wave_sum_n(float v) {
    v = row16_sum(v);
    v += __builtin_bit_cast(float, __builtin_amdgcn_update_dpp(0, __builtin_bit_cast(int, v), 0x142, 0xA, 0xF, false));
    v += __builtin_bit_cast(float, __builtin_amdgcn_update_dpp(0, __builtin_bit_cast(int, v), 0x143, 0xC, 0xF, false));
    return __builtin_bit_cast(float, __builtin_amdgcn_readlane(__builtin_bit_cast(int, v), 63));
}
__device__ __forceinline__ float wave_max_n(float v) {
    v = row16_max(v);
    v = fmaxf(v, __builtin_bit_cast(float, __builtin_amdgcn_update_dpp(__builtin_bit_cast(int, v), __builtin_bit_cast(int, v), 0x142, 0xA, 0xF, false)));
    v = fmaxf(v, __builtin_bit_cast(float, __builtin_amdgcn_update_dpp(__builtin_bit_cast(int, v), __builtin_bit_cast(int, v), 0x143, 0xC, 0xF, false)));
    return __builtin_bit_cast(float, __builtin_amdgcn_readlane(__builtin_bit_cast(int, v), 63));
}
#define XLANE_NEW 1
#ifdef XLANE_NEW
__device__ __forceinline__ float swz_xor16(float x) { return __builtin_bit_cast(float, __builtin_amdgcn_ds_swizzle(__builtin_bit_cast(int, x), 0x401F)); }
__device__ __forceinline__ float sum_xor32(float x) { return sum_xor32_n(x); }
__device__ __forceinline__ float sum_rows4(float x) { x += swz_xor16(x); return sum_xor32(x); }
__device__ __forceinline__ float wave_sum(float v) {
    v = row16_sum(v);
    v += __builtin_bit_cast(float, __builtin_amdgcn_update_dpp(0, __builtin_bit_cast(int, v), 0x142, 0xA, 0xF, false));
    v += __builtin_bit_cast(float, __builtin_amdgcn_update_dpp(0, __builtin_bit_cast(int, v), 0x143, 0xC, 0xF, false));
    return __builtin_bit_cast(float, __builtin_amdgcn_readlane(__builtin_bit_cast(int, v), 63));
}
__device__ __forceinline__ float wave_max(float v) {
    v = row16_max(v);
    v = fmaxf(v, __builtin_bit_cast(float, __builtin_amdgcn_update_dpp(__builtin_bit_cast(int, v), __builtin_bit_cast(int, v), 0x142, 0xA, 0xF, false)));
    v = fmaxf(v, __builtin_bit_cast(float, __builtin_amdgcn_update_dpp(__builtin_bit_cast(int, v), __builtin_bit_cast(int, v), 0x143, 0xC, 0xF, false)));
    return __builtin_bit_cast(float, __builtin_amdgcn_readlane(__builtin_bit_cast(int, v), 63));
}
#else
__device__ __forceinline__ float sum_xor32(float x) { return x + __shfl_xor(x, 32); }
__device__ __forceinline__ float sum_rows4(float x) { x += __shfl_xor(x, 16); x += __shfl_xor(x, 32); return x; }
__device__ __forceinline__ float wave_sum(float v) { v = row16_sum(v); v += __shfl_xor(v, 16); v += __shfl_xor(v, 32); return v; }
__device__ __forceinline__ float wave_max(float v) { v = row16_max(v); v = fmaxf(v, __shfl_xor(v, 16)); v = fmaxf(v, __shfl_xor(v, 32)); return v; }
#endif
__device__ __forceinline__ float sigmoidf_(float x) { return frcp(1.0f + __builtin_amdgcn_exp2f(-1.4426950408889634f * x)); }
__device__ __forceinline__ float gelu_tanh(float x) {
    const float u = 0.7978845608028654f * (x + 0.044715f * x * x * x);
    const float e = __builtin_amdgcn_exp2f(2.8853900817779268f * u);
    const float th = 1.0f - 2.0f * frcp(e + 1.0f);
    return 0.5f * x * (1.0f + th);
}
template <class T> __device__ __forceinline__ const T* launder_p(const T* q) { asm volatile("" : "+v"(q)); return q; }
__device__ __forceinline__ int launder_v(int x) { asm volatile("" : "+v"(x)); return x; }
#define LDS_WAIT() asm volatile("s_waitcnt lgkmcnt(0)" ::: "memory")
#define VM_WAIT() asm volatile("s_waitcnt vmcnt(0)" ::: "memory")
__device__ __forceinline__ f32x4 mfma16(bf16x8 a, bf16x8 b, f32x4 c) { return __builtin_amdgcn_mfma_f32_16x16x32_bf16(a, b, c, 0, 0, 0); }
__device__ __forceinline__ f32x16 mfma32(bf16x8 a, bf16x8 b, f32x16 c) { return __builtin_amdgcn_mfma_f32_32x32x16_bf16(a, b, c, 0, 0, 0); }
#define XB_TMO      128
#define XB_XCNT(j)  (256  + 64 * (j))
#define XB_XSUB(j)  (1280 + 64 * (j))
#define XB_XGEN(j)  (2304 + 64 * (j))
#define XB_TOP      3328
#define XB_TOPGEN   3392
#define XCD_BAR_WORDS 3456
#define XB_SPIN_CAP (1u << 18)

__device__ __forceinline__ unsigned xb_ld(unsigned* p)              { return __hip_atomic_load(p, __ATOMIC_RELAXED, __HIP_MEMORY_SCOPE_AGENT); }
__device__ __forceinline__ unsigned xb_add(unsigned* p, unsigned v) { return __hip_atomic_fetch_add(p, v, __ATOMIC_RELAXED, __HIP_MEMORY_SCOPE_AGENT); }
__device__ __forceinline__ unsigned xb_xcc_id() { return (unsigned)__builtin_amdgcn_s_getreg((3 << 11) | 20) & 0xFu; }
#define XB_SPIN(cond, bar) do { unsigned _sp = 0; while (cond) { __builtin_amdgcn_s_sleep(1); \
    if ((++_sp & 255u) == 0u) { if (xb_ld(&(bar)[XB_TMO])) break; if (_sp > XB_SPIN_CAP) { atomicAdd(&(bar)[XB_TMO], 1u); break; } } } } while (0)

struct XcdBarrier {
    unsigned* bar; unsigned x;
    volatile LAS unsigned* st;
};

__device__ __forceinline__ XcdBarrier xcd_barrier_post(unsigned* bar, volatile LAS unsigned* st) {
    XcdBarrier b; b.bar = bar; b.x = xb_xcc_id(); b.st = st;
    if (threadIdx.x == 0) (void)xb_add(&bar[XB_XCNT(b.x)], 1u);
    return b;
}
__device__ __forceinline__ void xcd_barrier_complete(unsigned* bar, unsigned x, unsigned& nloc, unsigned& nx) {
    const unsigned G = gridDim.x * gridDim.y * gridDim.z;
    unsigned sum, cnt, mine, sp = 0u;
    for (;;) {
        sum = 0u; cnt = 0u; mine = 0u;
#pragma unroll
        for (unsigned j = 0; j < 16; ++j) { const unsigned c = xb_ld(&bar[XB_XCNT(j)]); sum += c; cnt += (c > 0u) ? 1u : 0u; mine = (j == x) ? c : mine; }
        if (sum == G) break;
        __builtin_amdgcn_s_sleep(1);
        if ((++sp & 255u) == 0u) { if (xb_ld(&bar[XB_TMO])) break; if (sp > XB_SPIN_CAP) { atomicAdd(&bar[XB_TMO], 1u); break; } }
    }
    nloc = mine > 0u ? mine : 1u; nx = cnt > 0u ? cnt : 1u;
}

__device__ __forceinline__ void xcd_barrier(const XcdBarrier& b, const bool t0) {
    asm volatile("s_waitcnt vmcnt(0)" ::: "memory");
    __syncthreads();
    if (t0) {
        unsigned* bar = b.bar;
        __builtin_amdgcn_s_waitcnt(0);
        unsigned nloc = b.st[0], nx = b.st[1];
        if (nloc == 0u) { xcd_barrier_complete(bar, b.x, nloc, nx); b.st[0] = nloc; b.st[1] = nx; }
        const unsigned old = xb_add(&bar[XB_XSUB(b.x)], 1u);
        const unsigned gen = old / nloc;
        if (old + 1u == (gen + 1u) * nloc) {
            __builtin_amdgcn_fence(__ATOMIC_RELEASE, "agent");
            asm volatile("s_waitcnt vmcnt(0)" ::: "memory");
            const unsigned og = xb_add(&bar[XB_TOP], 1u);
            const unsigned tg = og / nx;
            if (og + 1u == (tg + 1u) * nx) xb_add(&bar[XB_TOPGEN], 1u);
            else XB_SPIN(xb_ld(&bar[XB_TOPGEN]) == tg, bar);
            __builtin_amdgcn_fence(__ATOMIC_ACQUIRE, "agent");
            xb_add(&bar[XB_XGEN(b.x)], 1u);
            asm volatile("s_waitcnt vmcnt(0)" ::: "memory");
        } else {
            XB_SPIN(xb_ld(&bar[XB_XGEN(b.x)]) == gen, bar);
            __builtin_amdgcn_fence(__ATOMIC_ACQUIRE, "agent");
            asm volatile("s_waitcnt vmcnt(0)" ::: "memory");
        }
    }
    __syncthreads();
}

namespace pg8 {
#define PG8_LAS __attribute__((address_space(3)))
constexpr int BM = 256, BK = 64, HALF = 128, HTB = HALF * BK * 2  , STAGE_BYTES = 8 * HTB, NXCD = 8, WGM = 8;
__host__ __device__ __forceinline__ int lds_byte(int r, int c) { const int st = (r >> 4) * 2 + (c >> 5), rr = r & 15, cc = c & 31, ob = rr * 64 + cc * 2; return st * 1024 + (ob ^ (((ob >> 9) & 1) << 5)); }
__host__ __device__ __forceinline__ void stage_rc(int b, int& R_, int& C_) { const int st = b / 1024, sb = b % 1024, swz = sb ^ (((sb >> 9) & 1) << 5); R_ = (st >> 1) * 16 + swz / 64; C_ = (st & 1) * 32 + (swz % 64) / 2; }
__host__ __device__ __forceinline__ int perm32(int rho) { const int n = rho >> 4, i = rho & 15; return 8 * (i >> 2) + 4 * n + (i & 3); }

struct Unit { int pm, pn, kb, nt; };
struct Gemm { const bf16_t* A; const bf16_t* Bt; int M, N, K, KL; };

struct GroupOrder {
    int pm0[4], nM[4], pn0[4], nN[4]; int nseg, nwg, G_, c;
    __device__ __forceinline__ void init(int G__, int c_) { nseg = 0; nwg = 0; G_ = G__; c = c_;
#pragma unroll
        for (int s = 0; s < 4; ++s) { pm0[s] = 0; nM[s] = 0; pn0[s] = 0; nN[s] = 1; } }
    __device__ __forceinline__ void add(int s, int pm0_, int nM_, int pn0_, int nN_) { pm0[s] = pm0_; nM[s] = nM_; pn0[s] = pn0_; nN[s] = nN_; nwg += nM_ * nN_; nseg = s + 1; }
    __device__ __forceinline__ bool next(int i, Unit& u) const {
        const long L = (long)i * G_ + c; if (L >= nwg) return false;
        int id = (int)L; { const int q = nwg / NXCD, r = nwg % NXCD, xcd = id % NXCD, off = id / NXCD; id = (xcd < r ? xcd * (q + 1) : r * (q + 1) + (xcd - r) * q) + off; }
        int spm0 = 0, snM = 1, spn0 = 0, snN = 1; bool found = false;
#pragma unroll
        for (int s = 0; s < 4; ++s) { const int cnt = nM[s] * nN[s]; if (!found) { if (id < cnt) { found = true; spm0 = pm0[s]; snM = nM[s]; spn0 = pn0[s]; snN = nN[s]; } else id -= cnt; } }
        const int nig = WGM * snN, gid = id / nig, fm = gid * WGM, gsz = (snM - fm) < WGM ? (snM - fm) : WGM;
        u.pm = spm0 + fm + ((id % nig) % gsz); u.pn = spn0 + (id % nig) / gsz; u.kb = 0; u.nt = 0; return true;
    }
    __device__ __forceinline__ void a_ready(const Unit&) const {}
    __device__ __forceinline__ void done(const Unit&) const {}
};

struct ResidOrder {
    GroupOrder P; int nS, G_, c;
    __device__ __forceinline__ void init(int G__, int c_, int nS_) { P.init(G__, c_); P.add(0, 0, nS_ ? 64 : 66, 0, 4); nS = nS_; G_ = G__; c = c_; }
    __device__ __forceinline__ bool next(int i, Unit& u) const {
        const int npc = c < P.nwg ? (P.nwg - 1 - c) / G_ + 1 : 0;
        if (i < npc) return P.next(i, u);
        const int L = (i - npc) * G_ + (G_ - 1 - c); if (L >= 8 * nS) return false;
        const int sl = L >> 3, t = L & 7; u.pm = 64 + (t & 1); u.pn = t >> 1; u.kb = sl * 512; u.nt = 4; return true; }
    __device__ __forceinline__ void a_ready(const Unit&) const {}
    __device__ __forceinline__ void done(const Unit&) const {}
};
__device__ __forceinline__ unsigned cvt_pk_bf16(float lo, float hi) { return cvt_pk_bf16_(lo, hi); }

struct EpiF32G {
    static constexpr bool PERM = false, AFTER_DRAIN = false;
    float* b0; float* b1; float* b2; float* b3; int ldc, png, pmg;
    __device__ __forceinline__ void operator()(const f32x4 (&acc)[2][2][4][2], const Unit& u, int wr, int wc, int fr, int fq) const {
        const int j = u.pn / png; float* C = j == 0 ? b0 : (j == 1 ? b1 : (j == 2 ? b2 : b3));
        const int row0 = (u.pm - j * pmg) * BM + wr * 64 + fr, col0 = (u.pn - j * png) * BM + wc * 32 + 4 * fq;
#pragma unroll
        for (int ai = 0; ai < 2; ++ai)
#pragma unroll
            for (int m = 0; m < 4; ++m) { float* rowp = C + (size_t)(row0 + ai * HALF + m * 16) * ldc + col0;
#pragma unroll
                for (int bj = 0; bj < 2; ++bj)
#pragma unroll
                    for (int n = 0; n < 2; ++n) *(f32x4*)(rowp + bj * HALF + n * 16) = acc[ai][bj][m][n]; }
    }
};
struct EpiResid {
    static constexpr bool PERM = false, AFTER_DRAIN = false;
    float* X; int ldc;
    __device__ __forceinline__ void operator()(const f32x4 (&acc)[2][2][4][2], const Unit& u, int wr, int wc, int fr, int fq) const {
        const int row0 = u.pm * BM + wr * 64 + fr, col0 = u.pn * BM + wc * 32 + 4 * fq; const bool split = u.nt != 0;
#pragma unroll
        for (int ai = 0; ai < 2; ++ai)
#pragma unroll
            for (int m = 0; m < 4; ++m) { float* rowp = X + (size_t)(row0 + ai * HALF + m * 16) * ldc + col0;
                if (!split) {
#pragma unroll
                    for (int bj = 0; bj < 2; ++bj)
#pragma unroll
                        for (int n = 0; n < 2; ++n) { f32x4* p = (f32x4*)(rowp + bj * HALF + n * 16); *p = *p + acc[ai][bj][m][n]; } }
                else {
#pragma unroll
                    for (int bj = 0; bj < 2; ++bj)
#pragma unroll
                        for (int n = 0; n < 2; ++n) { float* q = rowp + bj * HALF + n * 16;
#pragma unroll
                            for (int e = 0; e < 4; ++e) __hip_atomic_fetch_add(q + e, acc[ai][bj][m][n][e], __ATOMIC_RELAXED, __HIP_MEMORY_SCOPE_AGENT); } }
                asm volatile("" ::: "memory"); }
    }
};
struct EpiWin {
    static constexpr bool PERM = true, AFTER_DRAIN = false;
    bf16_t* U; bf16_t* GT; float* cvp; float* cvs;
    __device__ __forceinline__ void operator()(const f32x4 (&acc)[2][2][4][2], const Unit& u, int wr, int wc, int fr, int fq) const {
        const bool isu = u.pn < 11; bf16_t* base = isu ? U : GT; const int colt = (isu ? u.pn : u.pn - 11) * BM;
        const int row0 = u.pm * BM + wr * 64 + fr, col0 = colt + wc * 32 + 8 * fq;
#pragma unroll
        for (int ai = 0; ai < 2; ++ai)
#pragma unroll
            for (int m = 0; m < 4; ++m) { const int row = row0 + ai * HALF + m * 16; bf16_t* rowp = base + (size_t)row * DFF + col0;
                float* cv = nullptr;
                if (isu) { if (row >= MP) { const int t = (row - MP) & 3, b = (row - MP) >> 2; if (t >= 2) cv = cvs + (size_t)(b * 2 + (t - 2)) * DFF; }
                           else { const int tt = row & (TP - 1); if (tt >= TP - 2) cv = cvp + (size_t)((row >> 13) * 2 + (tt - (TP - 2))) * DFF; } }
#pragma unroll
                for (int bj = 0; bj < 2; ++bj) { const f32x4 v0 = acc[ai][bj][m][0], v1 = acc[ai][bj][m][1];
                    u32x4 w; w.x = cvt_pk_bf16(v0[0], v0[1]); w.y = cvt_pk_bf16(v0[2], v0[3]); w.z = cvt_pk_bf16(v1[0], v1[1]); w.w = cvt_pk_bf16(v1[2], v1[3]);
                    *(u32x4*)(rowp + bj * HALF) = w;
                    if (cv) { *(f32x4*)(cv + col0 + bj * HALF) = v0; *(f32x4*)(cv + col0 + bj * HALF + 4) = v1; } } }
    }
};
template <class Epi, class Sched, bool ALIGN_EPI = false, bool SP2 = false>
__device__ __forceinline__ void gemm_phase(PG8_LAS unsigned char* lds, const Gemm g, const Sched& S, const Epi& E, int tid_in) {
    int tid_l = tid_in; asm volatile("" : "+v"(tid_l));
    const int tid = tid_l, wid = __builtin_amdgcn_readfirstlane(tid >> 6), lane = tid & 63, wr = wid >> 2, wc = wid & 3, fr = lane & 15, fq = lane >> 4;
    const int K = g.K, nt = g.KL / BK;
    unsigned voffA[2], voffB[2];
#pragma unroll
    for (int i = 0; i < 2; ++i) { int R, C; stage_rc(tid * 16 + i * 8192, R, C); const int Rb = Epi::PERM ? ((R & ~31) + perm32(R & 31)) : R;
        voffA[i] = (unsigned)(R * K + C) * 2u; voffB[i] = (unsigned)(Rb * K + C) * 2u; }
    const size_t kstep = (size_t)(BK * 2);
    const size_t hstep = (size_t)HALF * K * 2;
    const size_t tstep = 2 * hstep;
    const unsigned ldsw = (unsigned)wid * 1024u;
    const int aoff = lds_byte(wr * 64 + fr, fq * 8), boff = lds_byte(wc * 32 + fr, fq * 8);
#define PG8_SA(b, h) (((b) * 2 + (h)) * HTB)
#define PG8_SB(b, h) ((4 + (b) * 2 + (h)) * HTB)
#define PG8_STAGE(bufoff, gbase, voff) do { _Pragma("unroll") for (int _i = 0; _i < 2; ++_i) \
        __builtin_amdgcn_global_load_lds((const unsigned*)((const char*)(gbase) + (voff)[_i]), (PG8_LAS unsigned*)(lds + (bufoff) + ldsw + _i * 8192), 16, 0, 0); } while (0)
#define PG8_LDA(dst, b, h) do { _Pragma("unroll") for (int m = 0; m < 4; ++m) _Pragma("unroll") for (int k = 0; k < 2; ++k) dst[m][k] = *(const PG8_LAS bf16x8*)(lds + PG8_SA(b, h) + aoff + m * 2048 + k * 1024); } while (0)
#define PG8_LDB(dst, b, h) do { _Pragma("unroll") for (int n = 0; n < 2; ++n) _Pragma("unroll") for (int k = 0; k < 2; ++k) dst[n][k] = *(const PG8_LAS bf16x8*)(lds + PG8_SB(b, h) + boff + n * 2048 + k * 1024); } while (0)
#define PG8_MMA(ai, bj, At, Bt) do { __builtin_amdgcn_s_setprio(1); _Pragma("unroll") for (int m = 0; m < 4; ++m) _Pragma("unroll") for (int n = 0; n < 2; ++n) _Pragma("unroll") for (int k = 0; k < 2; ++k) \
        acc[ai][bj][m][n] = __builtin_amdgcn_mfma_f32_16x16x32_bf16(Bt[n][k], At[m][k], acc[ai][bj][m][n], 0, 0, 0); __builtin_amdgcn_s_setprio(0); } while (0)
#define PG8_WAIT_V(n) asm volatile("s_waitcnt vmcnt(" #n ")" ::: "memory")
#define PG8_WAIT_L(n) asm volatile("s_waitcnt lgkmcnt(" #n ")" ::: "memory")
#define PG8_BAR __builtin_amdgcn_s_barrier()
#define PG8_SCHED __builtin_amdgcn_sched_barrier(0)
    Unit cur, nxt; int ui = 0;
    if (!S.next(0, cur)) return;
    f32x4 acc[2][2][4][2];
#pragma unroll
    for (int a = 0; a < 2; ++a)
#pragma unroll
        for (int b = 0; b < 2; ++b)
#pragma unroll
            for (int m = 0; m < 4; ++m)
#pragma unroll
                for (int n = 0; n < 2; ++n) acc[a][b][m][n] = (f32x4){0.f, 0.f, 0.f, 0.f};
    bf16x8 At[4][2], B0[2][2], B1[2][2];
    const char* cA = (const char*)g.A + (size_t)cur.pm * tstep + cur.kb; const char* cB = (const char*)g.Bt + (size_t)cur.pn * tstep + cur.kb;
    S.a_ready(cur);
    if constexpr (SP2) {
        PG8_STAGE(PG8_SB(0, 0), cB, voffB); PG8_STAGE(PG8_SB(0, 1), cB + hstep, voffB); PG8_STAGE(PG8_SA(0, 0), cA, voffA); PG8_STAGE(PG8_SA(0, 1), cA + hstep, voffA);
        if (wr == 1) PG8_BAR;
        PG8_WAIT_V(2); PG8_BAR;
        PG8_STAGE(PG8_SB(1, 0), cB + kstep, voffB); PG8_STAGE(PG8_SA(1, 0), cA + kstep, voffA); PG8_STAGE(PG8_SB(1, 1), cB + hstep + kstep, voffB);
        PG8_WAIT_V(6); PG8_BAR;
    } else {
        PG8_STAGE(PG8_SB(0, 0), cB, voffB); PG8_STAGE(PG8_SA(0, 0), cA, voffA); PG8_STAGE(PG8_SB(0, 1), cB + hstep, voffB); PG8_STAGE(PG8_SA(0, 1), cA + hstep, voffA);
        if (wr == 1) PG8_BAR;
        PG8_WAIT_V(4); PG8_BAR;
        PG8_STAGE(PG8_SB(1, 0), cB + kstep, voffB); PG8_STAGE(PG8_SA(1, 0), cA + kstep, voffA); PG8_STAGE(PG8_SB(1, 1), cB + hstep + kstep, voffB);
        PG8_WAIT_V(6); PG8_BAR;
    }
    for (;;) {
        const bool has_next = S.next(ui + 1, nxt);
        const char* nA = has_next ? (const char*)g.A + (size_t)nxt.pm * tstep + nxt.kb : cA; const char* nB = has_next ? (const char*)g.Bt + (size_t)nxt.pn * tstep + nxt.kb : cB;
        const int ntu = cur.nt ? cur.nt : nt;
        for (int t = 0; t < ntu; t += 2) {
            const bool last = (t == ntu - 2);
            const char* a1 = cA + (size_t)(t + 1) * kstep;
            const char* a2 = last ? nA : cA + (size_t)(t + 2) * kstep; const char* b2 = last ? nB : cB + (size_t)(t + 2) * kstep;
            const char* a3 = a2 + kstep; const char* b3 = b2 + kstep;
            if (last && has_next) S.a_ready(nxt);
            if constexpr (SP2) {
            PG8_LDB(B0, 0, 0); PG8_LDB(B1, 0, 1); PG8_SCHED; PG8_LDA(At, 0, 0); PG8_STAGE(PG8_SA(1, 1), a1 + hstep, voffA);
            PG8_WAIT_V(8); PG8_WAIT_L(0); PG8_BAR; PG8_MMA(0, 0, At, B0); PG8_MMA(0, 1, At, B1); PG8_BAR; PG8_SCHED;
            PG8_LDA(At, 0, 1); PG8_STAGE(PG8_SB(0, 0), b2, voffB); PG8_STAGE(PG8_SB(0, 1), b2 + hstep, voffB); PG8_STAGE(PG8_SA(0, 0), a2, voffA);
            PG8_WAIT_V(8); PG8_WAIT_L(0); PG8_BAR; PG8_MMA(1, 0, At, B0); PG8_MMA(1, 1, At, B1); PG8_BAR; PG8_SCHED;
            PG8_LDB(B0, 1, 0); PG8_LDB(B1, 1, 1); PG8_SCHED; PG8_LDA(At, 1, 0); PG8_STAGE(PG8_SA(0, 1), a2 + hstep, voffA);
            PG8_WAIT_V(8); PG8_WAIT_L(0); PG8_BAR; PG8_MMA(0, 0, At, B0); PG8_MMA(0, 1, At, B1); PG8_BAR; PG8_SCHED;
            PG8_LDA(At, 1, 1); PG8_STAGE(PG8_SB(1, 0), b3, voffB); PG8_STAGE(PG8_SB(1, 1), b3 + hstep, voffB); PG8_STAGE(PG8_SA(1, 0), a3, voffA);
            PG8_WAIT_V(8); PG8_WAIT_L(0); PG8_BAR; PG8_MMA(1, 0, At, B0); PG8_MMA(1, 1, At, B1); PG8_BAR; PG8_SCHED;
            } else {
            PG8_LDB(B0, 0, 0); PG8_SCHED; PG8_LDA(At, 0, 0); PG8_STAGE(PG8_SA(1, 1), a1 + hstep, voffA);
            PG8_WAIT_L(8); PG8_BAR; PG8_WAIT_L(0); PG8_MMA(0, 0, At, B0); PG8_BAR; PG8_SCHED;
            PG8_LDB(B1, 0, 1); PG8_STAGE(PG8_SB(0, 0), b2, voffB);
            PG8_BAR; PG8_WAIT_L(0); PG8_MMA(0, 1, At, B1); PG8_BAR;
            PG8_LDA(At, 0, 1); PG8_STAGE(PG8_SA(0, 0), a2, voffA);
            PG8_BAR; PG8_WAIT_L(0); PG8_MMA(1, 0, At, B0); PG8_BAR; PG8_SCHED;
            PG8_STAGE(PG8_SB(0, 1), b2 + hstep, voffB);
            PG8_WAIT_V(6); PG8_BAR; PG8_MMA(1, 1, At, B1); PG8_BAR;
            PG8_LDB(B0, 1, 0); PG8_SCHED; PG8_LDA(At, 1, 0); PG8_STAGE(PG8_SA(0, 1), a2 + hstep, voffA);
            PG8_WAIT_L(8); PG8_BAR; PG8_WAIT_L(0); PG8_MMA(0, 0, At, B0); PG8_BAR; PG8_SCHED;
            PG8_LDB(B1, 1, 1); PG8_STAGE(PG8_SB(1, 0), b3, voffB);
            PG8_BAR; PG8_WAIT_L(0); PG8_MMA(0, 1, At, B1); PG8_BAR;
            PG8_LDA(At, 1, 1); PG8_STAGE(PG8_SA(1, 0), a3, voffA);
            PG8_BAR; PG8_WAIT_L(0); PG8_MMA(1, 0, At, B0); PG8_BAR; PG8_SCHED;
            PG8_STAGE(PG8_SB(1, 1), b3 + hstep, voffB);
            PG8_WAIT_V(6); PG8_BAR; PG8_MMA(1, 1, At, B1); PG8_BAR;
            }
        }
        if constexpr (ALIGN_EPI) { if (wr == 0) PG8_BAR; }
        if constexpr (!Epi::AFTER_DRAIN) { E(acc, cur, wr, wc, fr, fq); S.done(cur); }
        if (!has_next) break;
#pragma unroll
        for (int a = 0; a < 2; ++a)
#pragma unroll
            for (int b = 0; b < 2; ++b)
#pragma unroll
                for (int m = 0; m < 4; ++m)
#pragma unroll
                    for (int n = 0; n < 2; ++n) acc[a][b][m][n] = (f32x4){0.f, 0.f, 0.f, 0.f};
        cur = nxt; cA = nA; cB = nB; ++ui;
        if constexpr (ALIGN_EPI) { if (wr == 1) PG8_BAR; }
    }
    PG8_WAIT_V(0);
    if constexpr (!ALIGN_EPI) { if (wr == 0) PG8_BAR; }
    PG8_BAR;
    if constexpr (Epi::AFTER_DRAIN) { E.fused(acc, cur, wr, wc, fr, fq, lds, wid, lane); S.done(cur); }
#undef PG8_SA
#undef PG8_SB
#undef PG8_STAGE
#undef PG8_LDA
#undef PG8_LDB
#undef PG8_MMA
#undef PG8_WAIT_V
#undef PG8_WAIT_L
#undef PG8_BAR
#undef PG8_SCHED
}
}
constexpr int RING_BYTES = 131072, MISC_OFF = RING_BYTES + 320, LDS_BYTES = 147456;
struct Params { const float* in[45]; float* out; unsigned char* ws; int ph_lo, ph_hi, use_bar, pad; };
enum { I_XP = 0, I_XS, I_CKV, I_CWIN, I_SWKV, I_SSHIFT, I_SCONV, I_PT, I_NORMG, I_MU, I_WR, I_WK, I_WV, I_WO, I_W0, I_W1, I_W2, I_A0, I_A1, I_A2, I_V0, I_V1, I_V2, I_G1, I_G2,
       I_KK, I_KA, I_RKK, I_LNW, I_LNB, I_KVNG, I_WKV, I_KNG, I_PE, I_CW1, I_CB1, I_CW2, I_CB2, I_WQ, I_QNG, I_WONSA, I_WIN, I_CONVW, I_CONVB, I_WOUT };

typedef const __attribute__((address_space(4))) Params* KP;
struct Ctx { LAS unsigned char* lds; int tid, lane, wave, gw, ngw, gtid, gsz; };

__device__ __forceinline__ void p0_transpose_item(const float* W, int K, int ldw, int nblk, bf16_t* WT, int row_off, LAS float* scr, int item, int lane) {
    const int kb = item / nblk, nb = item % nblk, k0 = 64 * kb, n0 = 32 * nb;
#pragma unroll 8
    for (int i = 0; i < 32; ++i) { const int kk = 2 * i + (lane >> 5); scr[kk * 33 + (lane & 31)] = W[(size_t)(k0 + kk) * ldw + n0 + (lane & 31)]; }
    LDS_WAIT(); asm volatile("" ::: "memory");
    const int c = lane & 7;
#pragma unroll
    for (int j = 0; j < 4; ++j) { const int n = (lane >> 3) + 8 * j; const LAS float* s = scr + (8 * c) * 33 + n;
        u32x4 o; o.x = pk2(s[0 * 33], s[1 * 33]); o.y = pk2(s[2 * 33], s[3 * 33]); o.z = pk2(s[4 * 33], s[5 * 33]); o.w = pk2(s[6 * 33], s[7 * 33]);
        *(u32x4*)(WT + (size_t)(row_off + n0 + n) * K + k0 + 8 * c) = o; }
    LDS_WAIT(); asm volatile("" ::: "memory");
}

__device__ __forceinline__ void phase_prologue(KP p, const Ctx& c) {
    LAS float* scr = (LAS float*)(c.lds + c.wave * 16384);
    unsigned char* ws = p->ws;
    int total = 0;
#define TRCNT(K_, N_) (((K_) / 64) * ((N_) / 32))
    constexpr int C_DD = TRCNT(1024, 1024), C_L64 = TRCNT(1024, 64), C_L32 = TRCNT(1024, 32), C_L128 = TRCNT(1024, 128), C_2_64 = TRCNT(64, 1024), C_2_128 = TRCNT(128, 1024);
    constexpr int C_KV = TRCNT(1024, 1536), C_Q = 16 * 33, C_IN = TRCNT(1024, 5632), C_OUT = TRCNT(2816, 1024), C_CW = TRCNT(1024, 128);
    constexpr int NITEMS = 2 * (4 * C_DD + 2 * C_L64 + C_L128 + 2 * C_2_64 + C_2_128) + C_L32 + C_KV + 2 * C_Q + 2 * C_DD + 4 * C_IN + 4 * C_OUT + 4 * C_CW;
    (void)total;
    for (int it = c.gw; it < NITEMS; it += c.ngw) {
        int r = it;
#define TR(Wp, K_, LDW_, NBLK_, WTp, ROWOFF_) { const int cnt_ = ((K_) / 64) * (NBLK_); if (r < cnt_) { p0_transpose_item((Wp), (K_), (LDW_), (NBLK_), (bf16_t*)(WTp), (ROWOFF_), scr, r, c.lane); continue; } r -= cnt_; }
        bool done = false;
#pragma unroll
        for (int l = 0; l < 2; ++l) {
            if (done) break;
            const size_t dd = (size_t)l * 1024 * 1024;
#define TRL(Wp, K_, LDW_, NBLK_, WTp, ROWOFF_) { const int cnt_ = ((K_) / 64) * (NBLK_); if (!done) { if (r < cnt_) { p0_transpose_item((Wp), (K_), (LDW_), (NBLK_), (bf16_t*)(WTp), (ROWOFF_), scr, r, c.lane); done = true; } else r -= cnt_; } }
            TRL(p->in[I_WR] + dd, 1024, 1024, 32, ws + WS_WRKV + (size_t)l * 3072 * 1024 * 2, 0)
            TRL(p->in[I_WK] + dd, 1024, 1024, 32, ws + WS_WRKV + (size_t)l * 3072 * 1024 * 2, 1024)
            TRL(p->in[I_WV] + dd, 1024, 1024, 32, ws + WS_WRKV + (size_t)l * 3072 * 1024 * 2, 2048)
            TRL(p->in[I_WO] + dd, 1024, 1024, 32, ws + WS_WORW + (size_t)l * 1024 * 1024 * 2, 0)
            TRL(p->in[I_W1] + (size_t)l * 1024 * 64, 1024, 64, 2, ws + WS_W1T + (size_t)l * 288 * 1024 * 2, 0)
            TRL(p->in[I_A1] + (size_t)l * 1024 * 64, 1024, 64, 2, ws + WS_W1T + (size_t)l * 288 * 1024 * 2, 64)
            TRL(p->in[I_G1] + (size_t)l * 1024 * 128, 1024, 128, 4, ws + WS_W1T + (size_t)l * 288 * 1024 * 2, 160)
            TRL(p->in[I_W2] + (size_t)l * 64 * 1024, 64, 1024, 32, ws + WS_W2W + (size_t)l * 1024 * 64 * 2, 0)
            TRL(p->in[I_A2] + (size_t)l * 64 * 1024, 64, 1024, 32, ws + WS_W2A + (size_t)l * 1024 * 64 * 2, 0)
            TRL(p->in[I_G2] + (size_t)l * 128 * 1024, 128, 1024, 32, ws + WS_W2G + (size_t)l * 1024 * 128 * 2, 0)
        }
        if (done) continue;
        TR(p->in[I_V1], 1024, 32, 1, ws + WS_W1T + (size_t)1 * 288 * 1024 * 2, 128)
        TR(p->in[I_WKV], 1024, 1536, 48, ws + WS_WKVT, 0)
        TR(p->in[I_WQ], 1024, NQ, 33, ws + WS_WQT, 0)
        TR(p->in[I_WQ] + (size_t)1024 * NQ, 1024, NQ, 33, ws + WS_WQT + (size_t)NQP * 1024 * 2, 0)
        TR(p->in[I_WONSA], 1024, 1024, 32, ws + WS_WONSA, 0)
        TR(p->in[I_WONSA] + (size_t)1024 * 1024, 1024, 1024, 32, ws + WS_WONSA + (size_t)1024 * 1024 * 2, 0)
#pragma unroll
        for (int l = 0; l < 4; ++l) {
            if (done) break;
            TRL(p->in[I_WIN] + (size_t)l * 1024 * 5632, 1024, 5632, 176, ws + WS_WINT + (size_t)l * 5632 * 1024 * 2, 0)
            TRL(p->in[I_WOUT] + (size_t)l * 2816 * 1024, 2816, 1024, 32, ws + WS_WOUTT + (size_t)l * 1024 * 2816 * 2, 0)
        }
        if (done) continue;
        TR(p->in[I_CW1], 1024, 128, 4, ws + WS_CW1T, 0)
        TR(p->in[I_CW1] + (size_t)1024 * 128, 1024, 128, 4, ws + WS_CW1T, 128)
        TR(p->in[I_CW1] + (size_t)2048 * 128, 1024, 128, 4, ws + WS_CW1T + (size_t)256 * 1024 * 2, 0)
        TR(p->in[I_CW1] + (size_t)3072 * 128, 1024, 128, 4, ws + WS_CW1T + (size_t)256 * 1024 * 2, 128)
#undef TR
#undef TRL
    }
    {
        bf16_t* WQT = (bf16_t*)(ws + WS_WQT);
        for (int e = c.gtid; e < 2 * 224 * 1024; e += c.gsz) { const int k = e & 1023, n = 1056 + ((e >> 10) % 224), l = e / (224 * 1024);
            WQT[((size_t)l * NQP + n) * 1024 + k] = n < NQ ? (bf16_t)f2bf(p->in[I_WQ][((size_t)l * 1024 + k) * NQ + n]) : (bf16_t)0; }
        bf16_t* W2V = (bf16_t*)(ws + WS_W2V);
        for (int e = c.gtid; e < 32 * 1024; e += c.gsz) { const int n = e & 1023, k = e >> 10; W2V[n * 32 + k] = (bf16_t)f2bf(p->in[I_V2][k * 1024 + n]); }
    }
    { bf16_t* W2T = (bf16_t*)(ws + WS_CW2T);
      for (int e = c.gtid; e < 2 * 128 * 64; e += c.gsz) { const int d = e & 63, q = (e >> 6) & 127, kv = e >> 13; const float w = p->in[I_CW2][e];
          const unsigned hi = f2bf(w), lo = f2bf(w - __builtin_bit_cast(float, hi << 16)); W2T[(size_t)(kv * 64 + d) * 128 + q] = (bf16_t)hi; W2T[(size_t)2 * 64 * 128 + (size_t)(kv * 64 + d) * 128 + q] = (bf16_t)lo; } }
    for (int it = c.gw; it < 256; it += c.ngw) { const int kv = it >> 7, h = it & 127; float s = 0.f;
        for (int kk = c.lane; kk < 2048; kk += 64) s += p->in[I_PE][kv * 2048 + kk] * p->in[I_CW1][((size_t)kv * 2048 + kk) * 128 + h];
        s = wave_sum(s); if (c.lane == 0) ((float*)(ws + WS_CBIAS))[it] = s + p->in[I_CB1][it]; }
    { const f32x4* xp = (const f32x4*)p->in[I_XP]; const f32x4* xs = (const f32x4*)p->in[I_XS]; f32x4* o = (f32x4*)(p->out + O_Y);
      for (int e = c.gtid; e < R * D / 4; e += c.gsz) o[e] = e < MP * D / 4 ? xp[e] : xs[e - MP * D / 4]; }
}

__device__ __forceinline__ void phase_fill(KP p, const Ctx& c, int li, const int gwf, const int ngwf) {
    unsigned char* ws = p->ws;
    { const int* pt = (const int*)p->in[I_PT]; bf16_t* CA = (bf16_t*)(ws + WS_CMPA); const int part = li;
      for (int it = gwf; it < SB * 128 * 4; it += ngwf) { const int s4 = 4 * (it & 3), n = (it >> 2) & 127, b = it >> 9;
          const int page = pt[b * NPAGES + (n >> 3)]; const float* src = p->in[I_CKV] + ((size_t)page * PAGE + (n & 7) * 16 + s4) * 1024 + part * 256;
          f32x4 v[4];
#pragma unroll
          for (int e = 0; e < 4; ++e) v[e] = __builtin_nontemporal_load(((const f32x4*)(src + (size_t)e * 1024)) + c.lane);
          const int g = c.lane >> 4, d0 = 4 * (c.lane & 15); bf16_t* dst = CA + ((size_t)8192 + (size_t)part * 65536 + (size_t)(b * 4 + g) * 128 + n) * 1024 + s4 * 64 + d0;
#pragma unroll
          for (int e = 0; e < 4; ++e) { u32x2 w; w.x = pk2(v[e][0], v[e][1]); w.y = pk2(v[e][2], v[e][3]); *(u32x2*)(dst + e * 64) = w; } } }
    { const f32x4* src = (const f32x4*)p->in[I_CWIN]; f32x4* dst = (f32x4*)(p->out + O_WINS); constexpr int HALF_N = SB * 508 * 128 / 2;
      for (int e0 = li * HALF_N + gwf * 256 + c.lane; e0 < (li + 1) * HALF_N; e0 += ngwf * 256) { f32x4 v[4];
#pragma unroll
          for (int q = 0; q < 4; ++q) { const int e = e0 + 64 * q; if (e < (li + 1) * HALF_N) { const int b = e / (508 * 128), rr = e % (508 * 128); v[q] = __builtin_nontemporal_load(src + (size_t)b * 512 * 128 + 4 * 128 + rr); } }
#pragma unroll
          for (int q = 0; q < 4; ++q) { const int e = e0 + 64 * q; if (e < (li + 1) * HALF_N) { const int b = e / (508 * 128), rr = e % (508 * 128); __builtin_nontemporal_store(v[q], dst + (size_t)b * 512 * 128 + rr); } } } }
}

template <int NT> __device__ __forceinline__ void skinny_mma(const bf16_t* A, int lda, const bf16_t* Wt, int ldw, int K, int row0, int col0, int lane, f32x4 (&acc)[NT][2]) {
    const int fr = lane & 15, fq = lane >> 4;
#pragma unroll
    for (int nt = 0; nt < NT; ++nt) { acc[nt][0] = (f32x4){0.f, 0.f, 0.f, 0.f}; acc[nt][1] = (f32x4){0.f, 0.f, 0.f, 0.f}; }
    const bf16_t* xa = A + (size_t)(row0 + fr) * lda + 8 * fq; const bf16_t* xb = xa + (size_t)16 * lda;
    const bf16_t* wa = Wt + (size_t)(col0 + fr) * ldw + 8 * fq;
    const char* pa = (const char*)xa; const char* pb = (const char*)xb; const char* pw[NT];
#pragma unroll
    for (int nt = 0; nt < NT; ++nt) pw[nt] = (const char*)(wa + (size_t)nt * 16 * ldw);
    for (int k4 = 0; k4 < K / 128; ++k4) {
        bf16x8 fb[4][2], fa[4][NT];
#pragma unroll
        for (int u = 0; u < 4; ++u) { fb[u][0] = *(const bf16x8*)(pa + 64 * u); fb[u][1] = *(const bf16x8*)(pb + 64 * u);
#pragma unroll
            for (int nt = 0; nt < NT; ++nt) fa[u][nt] = *(const bf16x8*)(pw[nt] + 64 * u); }
        __builtin_amdgcn_sched_barrier(0);
#pragma unroll
        for (int u = 0; u < 4; ++u)
#pragma unroll
            for (int nt = 0; nt < NT; ++nt) { acc[nt][0] = mfma16(fa[u][nt], fb[u][0], acc[nt][0]); acc[nt][1] = mfma16(fa[u][nt], fb[u][1], acc[nt][1]); }
        pa += 256; pb += 256;
#pragma unroll
        for (int nt = 0; nt < NT; ++nt) pw[nt] += 256;
        __builtin_amdgcn_sched_barrier(0);
    }
}
__device__ __forceinline__ void skinny_resid_sample(const Ctx& c, const bf16_t* A, int lda, const bf16_t* Wt, int K, float* X) {
    const int ln = launder_v(c.lane), fr = ln & 15, fq = ln >> 4, w = c.wave;
    const int nch = K >> 7, c0 = (nch * w) >> 3, c1 = (nch * (w + 1)) >> 3;
    LAS f32x4* part = (LAS f32x4*)c.lds;
    __syncthreads();
    for (int it = blockIdx.x; it < 256; it += gridDim.x) { const int row0 = MP + 32 * (it & 15), col0 = 64 * (it >> 4);
        f32x4 acc[4][2]; skinny_mma<4>(A + 128 * c0, lda, Wt + 128 * c0, lda, 128 * (c1 - c0), row0, col0, c.lane, acc);
#pragma unroll
        for (int nt = 0; nt < 4; ++nt)
#pragma unroll
            for (int mt = 0; mt < 2; ++mt) part[(w * 8 + nt * 2 + mt) * 64 + ln] = acc[nt][mt];
        const int nt = w >> 1, mt = w & 1; f32x4* q = (f32x4*)(X + (size_t)(row0 + 16 * mt + fr) * D + col0 + 16 * nt + 4 * fq); f32x4 s = *q;
        __syncthreads();
#pragma unroll
        for (int ww = 0; ww < 8; ++ww) s = s + part[(ww * 8 + w) * 64 + ln];
        *q = s;
        __syncthreads(); }
}
__device__ __forceinline__ void skinny_store(const Ctx& c, const bf16_t* A, const bf16_t* Wt, int K, float* C, int ldc, int rbase, int nrb, int ncb, int it0, int nit_total) {
    const int fr = c.lane & 15, fq = c.lane >> 4;
    for (int it = c.gw - it0; it < nrb * ncb; it += c.ngw) { if (it < 0) continue; const int row0 = rbase + 32 * (it % nrb), col0 = 64 * (it / nrb);
        f32x4 acc[4][2]; skinny_mma<4>(A, K, Wt, K, K, row0, col0, c.lane, acc);
#pragma unroll
        for (int nt = 0; nt < 4; ++nt)
#pragma unroll
            for (int mt = 0; mt < 2; ++mt) *(f32x4*)(C + (size_t)(row0 + 16 * mt + fr) * ldc + col0 + 16 * nt + 4 * fq) = acc[nt][mt]; }
    (void)nit_total;
}

__device__ __forceinline__ void load_row(const float* p, int lane, f32x4 (&v)[4]) {
#pragma unroll
    for (int j = 0; j < 4; ++j) v[j] = ((const f32x4*)p)[lane + 64 * j];
}
__device__ __forceinline__ float row_rstd(const f32x4 (&v)[4]) {
    float s = 0.f;
#pragma unroll
    for (int j = 0; j < 4; ++j) s += (v[j][0] * v[j][0] + v[j][1] * v[j][1]) + (v[j][2] * v[j][2] + v[j][3] * v[j][3]);
    s = wave_sum(s); return frsq(s * (1.0f / D) + NORM_EPS);
}
__device__ __forceinline__ void store_row_bf16(bf16_t* o, int lane, const f32x4 (&v)[4]) {
#pragma unroll
    for (int j = 0; j < 4; ++j) { u32x2 w; w.x = pk2(v[j][0], v[j][1]); w.y = pk2(v[j][2], v[j][3]); ((u32x2*)o)[lane + 64 * j] = w; }
}

__device__ __forceinline__ void phase_norm(const Ctx& c, const float* X, const float* g1, bf16_t* o1, const float* g2, bf16_t* o2) {
    f32x4 ga[4], gb[4]; load_row(g1, c.lane, ga); if (g2) load_row(g2, c.lane, gb);
    for (int row = c.gw; row < R; row += c.ngw) {
        f32x4 v[4]; load_row(X + (size_t)row * D, c.lane, v); const float rs = row_rstd(v);
        f32x4 y[4];
#pragma unroll
        for (int j = 0; j < 4; ++j) y[j] = v[j] * rs * ga[j];
        store_row_bf16(o1 + (size_t)row * D, c.lane, y);
        if (g2) {
#pragma unroll
            for (int j = 0; j < 4; ++j) y[j] = v[j] * rs * gb[j];
            store_row_bf16(o2 + (size_t)row * D, c.lane, y); }
    }
}

__device__ __forceinline__ void phase_mix(KP p, const Ctx& c, int li) {
    const float* X = p->out + O_Y; const float* gain = p->in[I_NORMG] + (size_t)(li * 2) * D; const float* mu = p->in[I_MU] + (size_t)li * 6 * D;
    bf16_t* XM = (bf16_t*)(p->ws + WS_XM);
    f32x4 ga[4]; load_row(gain, c.lane, ga);
    {
        const int r0 = (int)(((long)c.gw * R) / c.ngw), r1 = (int)(((long)(c.gw + 1) * R) / c.ngw); f32x4 prev[4];
        {
            const bool seq_start = r0 < MP ? ((r0 & (TP - 1)) == 0) : (((r0 - MP) & 3) == 0);
            if (!seq_start && r0 < r1) { f32x4 v[4]; load_row(X + (size_t)(r0 - 1) * D, c.lane, v); const float rs = row_rstd(v);
#pragma unroll
                for (int j = 0; j < 4; ++j) prev[j] = v[j] * rs * ga[j]; }
        }
        for (int row = r0; row < r1; ++row) {
            const bool seq_start = row < MP ? ((row & (TP - 1)) == 0) : (((row - MP) & 3) == 0);
            if (seq_start) {
                if (row < MP) {
#pragma unroll
                    for (int j = 0; j < 4; ++j) prev[j] = (f32x4){0.f, 0.f, 0.f, 0.f}; }
                else load_row(p->in[I_SSHIFT] + ((size_t)li * SB + ((row - MP) >> 2)) * D, c.lane, prev);
            }
            f32x4 v[4]; load_row(X + (size_t)row * D, c.lane, v); const float rs = row_rstd(v);
            f32x4 xn[4];
#pragma unroll
            for (int j = 0; j < 4; ++j) xn[j] = v[j] * rs * ga[j];
#pragma unroll
            for (int m = 0; m < 6; ++m) {
                f32x4 y[4];
#pragma unroll
                for (int j = 0; j < 4; ++j) { const int mi = m == 1 ? 2 : (m == 2 ? 3 : (m == 3 ? 1 : m));
                    const f32x4 mm = ((const f32x4*)(mu + (size_t)mi * D))[c.lane + 64 * j]; y[j] = xn[j] + (prev[j] - xn[j]) * mm; }
                store_row_bf16(XM + ((size_t)m * R + row) * D, c.lane, y);
            }
            const bool seq_end = row < MP ? ((row & (TP - 1)) == TP - 1) : (((row - MP) & 3) == 3);
            if (seq_end) { float* so = row < MP ? p->out + O_SHP + ((size_t)li * NB + (row >> 13)) * D : p->out + O_SHS + ((size_t)li * SB + ((row - MP) >> 2)) * D;
#pragma unroll
                for (int j = 0; j < 4; ++j) ((f32x4*)so)[c.lane + 64 * j] = xn[j]; }
#pragma unroll
            for (int j = 0; j < 4; ++j) prev[j] = xn[j];
        }
    }
}
template <int NT, int ACT> __device__ __forceinline__ void lora1_item(const bf16_t* X, const bf16_t* W, bf16_t* HID, int coloff, int rb, int lane) {
    lane = launder_v(lane);
    const int fr = lane & 15, fq = lane >> 4;
    f32x4 acc[NT][2]; skinny_mma<NT>(X, 1024, W, 1024, 1024, rb * 32, coloff, lane, acc);
#pragma unroll
    for (int nt = 0; nt < NT; ++nt)
#pragma unroll
        for (int mt = 0; mt < 2; ++mt) { f32x4 v = acc[nt][mt];
#pragma unroll
            for (int r = 0; r < 4; ++r) { if (ACT == 1) { const float e = __builtin_amdgcn_exp2f(2.8853900817779268f * v[r]); v[r] = 1.0f - 2.0f * frcp(e + 1.0f); } if (ACT == 2) v[r] = sigmoidf_(v[r]); }
            u32x2 w; w.x = pk2(v[0], v[1]); w.y = pk2(v[2], v[3]);
            *(u32x2*)(HID + (size_t)(rb * 32 + mt * 16 + fr) * LHID + coloff + nt * 16 + 4 * fq) = w; }
}
__device__ __forceinline__ void phase_lora1(KP p, const Ctx& c, int li) {
    const bf16_t* XM = (const bf16_t*)(p->ws + WS_XM); const bf16_t* W = (const bf16_t*)(p->ws + WS_W1T) + (size_t)li * 288 * 1024; bf16_t* HID = (bf16_t*)(p->ws + WS_HID);
    constexpr int NRB = R / 32;
    for (int it = blockIdx.x + gridDim.x * c.wave; it < 5 * NRB; it += c.ngw) { const int q = it / NRB, rb = it % NRB;
        if (q == 0) lora1_item<4, 1>(XM + (size_t)3 * R * D, W, HID, 0, rb, c.lane);
        else if (q == 1) lora1_item<4, 0>(XM + (size_t)4 * R * D, W, HID, 64, rb, c.lane);
        else if (q == 2) { if (li == 1) lora1_item<2, 0>(XM + (size_t)2 * R * D, W, HID, 128, rb, c.lane); }
        else if (q == 3) lora1_item<4, 2>(XM + (size_t)5 * R * D, W, HID, 160, rb, c.lane);
        else lora1_item<4, 2>(XM + (size_t)5 * R * D, W, HID, 224, rb, c.lane);
    }
}

constexpr int SST = 72, MAT = 64 * SST * 2;
constexpr int O_AT = 0, O_BT = MAT, O_KT = 2 * MAT, O_RT = 3 * MAT, O_VT = 4 * MAT, O_BH = 5 * MAT, O_KH = 6 * MAT, O_XT = 7 * MAT, O_AAB = 9 * MAT, O_AAK = 10 * MAT, O_ARB = 11 * MAT, O_ARK = 12 * MAT;
constexpr int O_TD = 13 * MAT, O_SCR = O_TD + 2048, O_CS = O_SCR + 4096, O_WC = O_CS + 2048, O_LW = O_XT, O_LA = O_XT + 16384, O_LV = O_XT + 32768;
static_assert(O_WC + 256 <= RING_BYTES && O_LV + 16384 <= O_TD, "scan LDS map");
__device__ __forceinline__ bf16x8 ldsfrag(LAS unsigned char* lds, int off, int row, int col) { return *(const LAS bf16x8*)(lds + off + (row * SST + col) * 2); }
__device__ __forceinline__ void lds_st4(LAS unsigned char* lds, int off, int row, int col, f32x4 v) { u32x2 w; w.x = pk2(v[0], v[1]); w.y = pk2(v[2], v[3]); *(LAS u32x2*)(lds + off + (row * SST + col) * 2) = w; }
__device__ __forceinline__ f32x4 lds_ld4(LAS unsigned char* lds, int off, int row, int col) { const u32x2 w = *(const LAS u32x2*)(lds + off + (row * SST + col) * 2); return (f32x4){bflo(w.x), bfhi(w.x), bflo(w.y), bfhi(w.y)}; }

__device__ __forceinline__ void scanA_unit(KP p, const Ctx& c, int li, int u) {
    LAS unsigned char* lds = c.lds; unsigned char* ws = p->ws; const int stop = p->pad;
    const int lane = c.lane, wave = c.wave, fr = lane & 15, fq = lane >> 4;
    const int b = u / (NCH * H), n = (u / H) % NCH, h = u % H, row0 = b * TP + 64 * n;
    const float* Rb = (const float*)(ws + WS_RK_R); const float* Kb = (const float*)(ws + WS_RK_K);
    float* Vb = (float*)(ws + (li ? WS_V1 : WS_V0)); const float* V0b = (const float*)(ws + WS_V0);
    const bf16_t* HID = (const bf16_t*)(ws + WS_HID);
    {
        const int tt = wave & 3, chh = wave >> 2;
        const bf16_t* hrow = launder_p(HID + (size_t)(row0 + 16 * tt + fr) * LHID + 8 * fq);
        const bf16_t* W2W = (const bf16_t*)(ws + WS_W2W) + (size_t)li * 1024 * 64; const bf16_t* W2A = (const bf16_t*)(ws + WS_W2A) + (size_t)li * 1024 * 64; const bf16_t* W2V = (const bf16_t*)(ws + WS_W2V);
#pragma unroll
        for (int cti = 0; cti < 2; ++cti) { const int ct = 2 * chh + cti, C = 64 * h + 16 * ct + fr;
            f32x4 aw = {0.f, 0.f, 0.f, 0.f}, aa = {0.f, 0.f, 0.f, 0.f}, av = {0.f, 0.f, 0.f, 0.f};
#pragma unroll
            for (int ks = 0; ks < 2; ++ks) {
                aw = mfma16(*(const bf16x8*)(W2W + (size_t)C * 64 + 32 * ks + 8 * fq), *(const bf16x8*)(hrow + 32 * ks), aw);
                aa = mfma16(*(const bf16x8*)(W2A + (size_t)C * 64 + 32 * ks + 8 * fq), *(const bf16x8*)(hrow + 64 + 32 * ks), aa); }
            if (li) av = mfma16(*(const bf16x8*)(W2V + (size_t)C * 32 + 8 * fq), *(const bf16x8*)(hrow + 128), av);
            const int t = 16 * tt + fr, cc = 16 * ct + 4 * fq;
            *(LAS f32x4*)(lds + O_LW + (t * 64 + cc) * 4) = aw; *(LAS f32x4*)(lds + O_LA + (t * 64 + cc) * 4) = aa; *(LAS f32x4*)(lds + O_LV + (t * 64 + cc) * 4) = av; }
    }
    __syncthreads();
    if (stop == 1) return;
    {
        const int cc = lane, tq = wave, C = 64 * h + cc; const size_t pc = (size_t)li * D + C;
        const float w0 = p->in[I_W0][pc], a0 = p->in[I_A0][pc], kkc = p->in[I_KK][pc], kac = p->in[I_KA][pc], rkc = p->in[I_RKK][pc], v0 = li ? p->in[I_V0][C] : 0.f;
        float wlg[8], Lin[8], rr[8], k2[8], vv[8], aa[8], bb[8], rk8[8]; float run = 0.f;
        float r8[8], k8[8], v8[8], f8[8];
#pragma unroll
        for (int e = 0; e < 8; ++e) { const size_t gi = (size_t)(row0 + 8 * tq + e) * D + C; r8[e] = Rb[gi]; k8[e] = Kb[gi]; v8[e] = Vb[gi]; f8[e] = V0b[gi]; }
#pragma unroll
        for (int e = 0; e < 8; ++e) { const int t = 8 * tq + e;
            const float r = r8[e], k = k8[e]; float v = v8[e];
            const float lw = *(const LAS float*)(lds + O_LW + (t * 64 + cc) * 4), la = *(const LAS float*)(lds + O_LA + (t * 64 + cc) * 4), lv = *(const LAS float*)(lds + O_LV + (t * 64 + cc) * 4);
            const float z = -(w0 + lw); const float sp = fmaxf(z, 0.f) + __logf(1.0f + __expf(-fabsf(z))); const float wl = -__expf(-sp - 0.5f);
            const float asig = sigmoidf_(a0 + la);
            { const float vg = sigmoidf_(v0 + lv); const float vm = v + (f8[e] - v) * vg; v = li ? vm : v; }
            const float kkr = k * kkc; const float ss = wave_sum(kkr * kkr); const float kkn = kkr * frsq(fmaxf(ss, 1e-24f));
            const float kmod = k * (1.0f + (asig - 1.0f) * kac);
            rk8[e] = wave_sum(r * kmod * rkc);
            run += wl; wlg[e] = wl; Lin[e] = run; rr[e] = r; k2[e] = kmod; vv[e] = v; aa[e] = -kkn; bb[e] = kkn * asig; }
        if (li) {
#pragma unroll
            for (int e = 0; e < 8; ++e) Vb[(size_t)(row0 + 8 * tq + e) * D + C] = vv[e]; }
        if (cc == 0) {
#pragma unroll
            for (int e = 0; e < 8; ++e) ((float*)(ws + WS_RKS))[(size_t)(row0 + 8 * tq + e) * 16 + h] = rk8[e]; }
        *(LAS float*)(lds + O_CS + (tq * 64 + cc) * 4) = run;
        __syncthreads();
        float off = 0.f, tot = 0.f;
#pragma unroll
        for (int q = 0; q < 8; ++q) { const float x = *(const LAS float*)(lds + O_CS + (q * 64 + cc) * 4); tot += x; if (q < tq) off += x; }
        u32x4 wa, wv, wb, wk; unsigned pa[8], pv[8], pb[8], pk[8];
#pragma unroll
        for (int e = 0; e < 8; ++e) { const int t = 8 * tq + e; const float L = off + Lin[e], Lp = L - wlg[e];
            const float eL = __expf(L), eLp = __expf(Lp), enL = __expf(-L), eT = __expf(tot - L);
            const float at = aa[e] * eLp, bt = bb[e] * enL, kt = k2[e] * enL, rt = rr[e] * eL, bh = bb[e] * eT, kh = k2[e] * eT;
            *(LAS bf16_t*)(lds + O_AT + (t * SST + cc) * 2) = (bf16_t)f2bf(at); *(LAS bf16_t*)(lds + O_BT + (t * SST + cc) * 2) = (bf16_t)f2bf(bt);
            *(LAS bf16_t*)(lds + O_KT + (t * SST + cc) * 2) = (bf16_t)f2bf(kt); *(LAS bf16_t*)(lds + O_RT + (t * SST + cc) * 2) = (bf16_t)f2bf(rt);
            pa[e] = f2bf(at); pv[e] = f2bf(vv[e]); pb[e] = f2bf(bh); pk[e] = f2bf(kh); }
        wa = (u32x4){pa[0] | (pa[1] << 16), pa[2] | (pa[3] << 16), pa[4] | (pa[5] << 16), pa[6] | (pa[7] << 16)};
        wv = (u32x4){pv[0] | (pv[1] << 16), pv[2] | (pv[3] << 16), pv[4] | (pv[5] << 16), pv[6] | (pv[7] << 16)};
        wb = (u32x4){pb[0] | (pb[1] << 16), pb[2] | (pb[3] << 16), pb[4] | (pb[5] << 16), pb[6] | (pb[7] << 16)};
        wk = (u32x4){pk[0] | (pk[1] << 16), pk[2] | (pk[3] << 16), pk[4] | (pk[5] << 16), pk[6] | (pk[7] << 16)};
        *(LAS u32x4*)(lds + O_XT + (cc * SST + 8 * tq) * 2) = wa; *(LAS u32x4*)(lds + O_VT + (cc * SST + 8 * tq) * 2) = wv;
        *(LAS u32x4*)(lds + O_BH + (cc * SST + 8 * tq) * 2) = wb; *(LAS u32x4*)(lds + O_KH + (cc * SST + 8 * tq) * 2) = wk;
        if (tq == 0) *(LAS float*)(lds + O_WC + cc * 4) = __expf(tot);
    }
    __syncthreads();
    if (stop == 2) return;
    {
        const int mi = wave >> 1, ph = wave & 1; const int oY = (mi & 1) ? O_KT : O_BT, oX = (mi < 2) ? O_AT : O_RT; const bool strict = mi < 2;
        const int oO = mi == 0 ? O_AAB : (mi == 1 ? O_AAK : (mi == 2 ? O_ARB : O_ARK));
#pragma unroll
        for (int sti = 0; sti < 2; ++sti) { const int st = 2 * ph + sti;
#pragma unroll
            for (int tt = 0; tt < 4; ++tt) { f32x4 acc = {0.f, 0.f, 0.f, 0.f};
                if (st <= tt) {
#pragma unroll
                    for (int ks = 0; ks < 2; ++ks) acc = mfma16(ldsfrag(lds, oY, 16 * st + fr, 32 * ks + 8 * fq), ldsfrag(lds, oX, 16 * tt + fr, 32 * ks + 8 * fq), acc);
                    const int t = 16 * tt + fr;
#pragma unroll
                    for (int r = 0; r < 4; ++r) { const int s = 16 * st + 4 * fq + r; const bool keep = strict ? (s < t) : (s <= t); acc[r] = keep ? acc[r] : 0.f; } }
                if (st <= tt) lds_st4(lds, oO, 16 * tt + fr, 16 * st + 4 * fq, acc);
                else { u32x2 zz; int z0 = 0; asm volatile("" : "+v"(z0)); zz.x = (unsigned)z0; zz.y = (unsigned)z0; *(LAS u32x2*)(lds + oO + ((16 * tt + fr) * SST + 16 * st + 4 * fq) * 2) = zz; } } }
    }
    __syncthreads();
    if (stop == 3) return;
    {
        const int tt = wave & 3, ih = wave >> 2;
#pragma unroll
        for (int iti = 0; iti < 2; ++iti) { const int it = 2 * ih + iti; f32x4 acc = {0.f, 0.f, 0.f, 0.f};
#pragma unroll
            for (int ks = 0; ks < 2; ++ks) acc = mfma16(ldsfrag(lds, O_AAK, 16 * tt + fr, 32 * ks + 8 * fq), ldsfrag(lds, O_VT, 16 * it + fr, 32 * ks + 8 * fq), acc);
            lds_st4(lds, O_XT, 64 + 16 * it + fr, 16 * tt + 4 * fq, acc); }
        if (wave < 4 && lane < 16) { const int I = wave; float x[16];
#pragma unroll
            for (int t = 0; t < 16; ++t) { float s = (t == lane) ? 1.0f : 0.0f;
#pragma unroll
                for (int q = 0; q < t; ++q) s += bf2f(*(const LAS bf16_t*)(lds + O_AAB + ((16 * I + t) * SST + 16 * I + q) * 2)) * x[q];
                x[t] = s; *(LAS bf16_t*)(lds + O_TD + ((I * 16 + t) * 16 + lane) * 2) = (bf16_t)f2bf(s); } }
    }
    __syncthreads();
    if (stop == 5) return;
    {
        const int colb = 16 * wave; const bf16x8 zero8 = {0, 0, 0, 0, 0, 0, 0, 0};
#pragma unroll
        for (int I = 0; I < 4; ++I) {
            f32x4 acc = lds_ld4(lds, O_XT, colb + fr, 16 * I + 4 * fq);
#pragma unroll
            for (int ks = 0; ks < 2; ++ks) if (32 * ks < 16 * I) { const bool ok = (32 * ks + 8 * fq) < 16 * I;
                const bf16x8 a = ok ? ldsfrag(lds, O_AAB, 16 * I + fr, 32 * ks + 8 * fq) : zero8, bq = ok ? ldsfrag(lds, O_XT, colb + fr, 32 * ks + 8 * fq) : zero8;
                acc = mfma16(a, bq, acc); }
            { u32x2 w; w.x = pk2(acc[0], acc[1]); w.y = pk2(acc[2], acc[3]); *(LAS u32x2*)(lds + O_SCR + wave * 512 + (fr * 16 + 4 * fq) * 2) = w; }
            LDS_WAIT();
            const bf16x8 ta = fq < 2 ? *(const LAS bf16x8*)(lds + O_TD + ((I * 16 + fr) * 16 + 8 * fq) * 2) : zero8;
            const bf16x8 tb = fq < 2 ? *(const LAS bf16x8*)(lds + O_SCR + wave * 512 + (fr * 16 + 8 * fq) * 2) : zero8;
            const f32x4 res = mfma16(ta, tb, (f32x4){0.f, 0.f, 0.f, 0.f});
            lds_st4(lds, O_XT, colb + fr, 16 * I + 4 * fq, res);
            LDS_WAIT();
        }
    }
    __syncthreads();
    if (stop == 6) return;
    constexpr int S_RP = 0, S_MH = MAT, S_ML = 2 * MAT, S_YL = 3 * MAT, YLS = 68, S_NN = S_YL + 64 * YLS * 4;
    static_assert(S_NN + 64 * YLS * 4 <= O_XT, "staging must stay below the next unit's step-1 area");
    {
        const int tb = wave & 3, hb = wave >> 2;
        u32x2 rp[2], mh[2], ml[2]; f32x4 yl[2], nv[2];
#pragma unroll
        for (int qi = 0; qi < 2; ++qi) { const int rt = 2 * hb + qi;
            { f32x4 acc = lds_ld4(lds, O_RT, 16 * tb + fr, 16 * rt + 4 * fq);
#pragma unroll
              for (int ks = 0; ks < 2; ++ks) acc = mfma16(ldsfrag(lds, O_XT, 16 * rt + fr, 32 * ks + 8 * fq), ldsfrag(lds, O_ARB, 16 * tb + fr, 32 * ks + 8 * fq), acc);
              rp[qi].x = pk2(acc[0], acc[1]); rp[qi].y = pk2(acc[2], acc[3]); }
            { f32x4 acc = {0.f, 0.f, 0.f, 0.f};
#pragma unroll
              for (int ks = 0; ks < 2; ++ks) { acc = mfma16(ldsfrag(lds, O_XT, 64 + 16 * rt + fr, 32 * ks + 8 * fq), ldsfrag(lds, O_ARB, 16 * tb + fr, 32 * ks + 8 * fq), acc);
                  acc = mfma16(ldsfrag(lds, O_VT, 16 * rt + fr, 32 * ks + 8 * fq), ldsfrag(lds, O_ARK, 16 * tb + fr, 32 * ks + 8 * fq), acc); }
              yl[qi] = acc; }
            { f32x4 acc = {0.f, 0.f, 0.f, 0.f};
#pragma unroll
              for (int ks = 0; ks < 2; ++ks) acc = mfma16(ldsfrag(lds, O_XT, 16 * rt + fr, 32 * ks + 8 * fq), ldsfrag(lds, O_BH, 16 * tb + fr, 32 * ks + 8 * fq), acc);
              const int j = 16 * tb + fr; const float wc = *(const LAS float*)(lds + O_WC + j * 4);
#pragma unroll
              for (int r = 0; r < 4; ++r) if (16 * rt + 4 * fq + r == j) acc[r] += wc;
              unsigned hh[4], ll[4];
#pragma unroll
              for (int r = 0; r < 4; ++r) { hh[r] = f2bf(acc[r]); ll[r] = f2bf(acc[r] - __builtin_bit_cast(float, hh[r] << 16)); }
              mh[qi] = (u32x2){hh[0] | (hh[1] << 16), hh[2] | (hh[3] << 16)}; ml[qi] = (u32x2){ll[0] | (ll[1] << 16), ll[2] | (ll[3] << 16)}; }
            { f32x4 acc = {0.f, 0.f, 0.f, 0.f};
#pragma unroll
              for (int ks = 0; ks < 2; ++ks) { acc = mfma16(ldsfrag(lds, O_BH, 16 * rt + fr, 32 * ks + 8 * fq), ldsfrag(lds, O_XT, 64 + 16 * tb + fr, 32 * ks + 8 * fq), acc);
                  acc = mfma16(ldsfrag(lds, O_KH, 16 * rt + fr, 32 * ks + 8 * fq), ldsfrag(lds, O_VT, 16 * tb + fr, 32 * ks + 8 * fq), acc); }
              nv[qi] = acc; }
        }
        __syncthreads();
#pragma unroll
        for (int qi = 0; qi < 2; ++qi) { const int rt = 2 * hb + qi, row = 16 * tb + fr, col = 16 * rt + 4 * fq;
            *(LAS u32x2*)(lds + S_RP + (row * SST + col) * 2) = rp[qi]; *(LAS u32x2*)(lds + S_MH + (row * SST + col) * 2) = mh[qi]; *(LAS u32x2*)(lds + S_ML + (row * SST + col) * 2) = ml[qi];
            *(LAS f32x4*)(lds + S_YL + (row * YLS + col) * 4) = yl[qi]; *(LAS f32x4*)(lds + S_NN + (row * YLS + col) * 4) = nv[qi]; }
        __syncthreads();
        unsigned char* gRP = ws + WS_RP + (size_t)u * 8192; unsigned char* gYL = ws + WS_YL + (size_t)u * 16384;
        unsigned char* gMH = ws + WS_MT + (size_t)u * 8192; unsigned char* gML = gMH + (size_t)NUNIT_A * 8192; unsigned char* gNN = ws + WS_NN + (size_t)u * 16384;
        const int tid = 64 * wave + lane;
        { const int row = tid >> 3, ch = tid & 7, lo = (row * SST) * 2 + ch * 16;
          *(u32x4*)(gRP + tid * 16) = *(const LAS u32x4*)(lds + S_RP + lo); *(u32x4*)(gMH + tid * 16) = *(const LAS u32x4*)(lds + S_MH + lo); *(u32x4*)(gML + tid * 16) = *(const LAS u32x4*)(lds + S_ML + lo); }
#pragma unroll
        for (int k = 0; k < 2; ++k) { const int cidx = tid + 512 * k, row = cidx >> 4, c4 = cidx & 15, lo = (row * YLS) * 4 + c4 * 16;
            *(u32x4*)(gYL + cidx * 16) = *(const LAS u32x4*)(lds + S_YL + lo); *(u32x4*)(gNN + cidx * 16) = *(const LAS u32x4*)(lds + S_NN + lo); }
    }
}

__device__ __forceinline__ void scan_sample_item(KP p, const Ctx& c, int li, int item) {
    unsigned char* ws = p->ws; const int lane = c.lane, b = item >> 4, h = item & 15, C = 64 * h + lane; const size_t pc = (size_t)li * D + C;
    LAS float* sc = (LAS float*)(c.lds + c.wave * 16384);
    const float* Rb = (const float*)(ws + WS_RK_R); const float* Kb = (const float*)(ws + WS_RK_K);
    float* Vb = (float*)(ws + (li ? WS_V1 : WS_V0)); const float* V0b = (const float*)(ws + WS_V0);
    const bf16_t* HID = (const bf16_t*)(ws + WS_HID) + (size_t)(MP + 4 * b) * LHID;
    for (int e = lane; e < 4 * LHID; e += 64) sc[e] = bf2f(HID[e]);
    LDS_WAIT();
    float lw[4] = {0.f, 0.f, 0.f, 0.f}, la[4] = {0.f, 0.f, 0.f, 0.f}, lv[4] = {0.f, 0.f, 0.f, 0.f}, lg[4] = {0.f, 0.f, 0.f, 0.f};
    {
        const bf16_t* W2W = (const bf16_t*)(ws + WS_W2W) + ((size_t)li * 1024 + C) * 64; const bf16_t* W2A = (const bf16_t*)(ws + WS_W2A) + ((size_t)li * 1024 + C) * 64;
        const bf16_t* W2V = (const bf16_t*)(ws + WS_W2V) + (size_t)C * 32; const bf16_t* W2G = (const bf16_t*)(ws + WS_W2G) + ((size_t)li * 1024 + C) * 128;
#define LORA2_BLK(WP, QB, HOFF, ACC) { const u32x4 w8 = *(const u32x4*)((WP) + 8 * (QB)); \
            const float wf0 = bflo(w8.x), wf1 = bfhi(w8.x), wf2 = bflo(w8.y), wf3 = bfhi(w8.y), wf4 = bflo(w8.z), wf5 = bfhi(w8.z), wf6 = bflo(w8.w), wf7 = bfhi(w8.w); \
            _Pragma("unroll") for (int t = 0; t < 4; ++t) { const f32x4 h0 = *(const LAS f32x4*)(sc + t * LHID + (HOFF) + 8 * (QB)), h1 = *(const LAS f32x4*)(sc + t * LHID + (HOFF) + 8 * (QB) + 4); \
                ACC[t] += (h0[0] * wf0 + h0[1] * wf1) + (h0[2] * wf2 + h0[3] * wf3) + (h1[0] * wf4 + h1[1] * wf5) + (h1[2] * wf6 + h1[3] * wf7); } \
            asm volatile("" : "+v"(ACC[0]), "+v"(ACC[1]), "+v"(ACC[2]), "+v"(ACC[3]) :: "memory"); }
#pragma unroll
        for (int qb = 0; qb < 8; ++qb) { LORA2_BLK(W2W, qb, 0, lw) LORA2_BLK(W2A, qb, 64, la) }
        if (li) {
#pragma unroll
            for (int qb = 0; qb < 4; ++qb) LORA2_BLK(W2V, qb, 128, lv) }
#pragma unroll
        for (int qb = 0; qb < 16; ++qb) LORA2_BLK(W2G, qb, 160, lg)
#undef LORA2_BLK
    }
    const float w0 = p->in[I_W0][pc], a0 = p->in[I_A0][pc], kkc = p->in[I_KK][pc], kac = p->in[I_KA][pc], rkc = p->in[I_RKK][pc], v0 = li ? p->in[I_V0][C] : 0.f;
    const float lnw = p->in[I_LNW][pc], lnb = p->in[I_LNB][pc];
    float S[64];
    { const f32x4* sp = (const f32x4*)(p->in[I_SWKV] + (((size_t)li * SB + b) * H + h) * 4096 + lane * 64);
#pragma unroll
      for (int q = 0; q < 16; ++q) { const f32x4 x = sp[q]; S[4 * q] = x[0]; S[4 * q + 1] = x[1]; S[4 * q + 2] = x[2]; S[4 * q + 3] = x[3]; } }
    LAS float* bc = sc + 1280;
    bf16_t* YG = (bf16_t*)(ws + WS_YG);
#pragma unroll
    for (int t = 0; t < 4; ++t) { const size_t gi = (size_t)(MP + 4 * b + t) * D + C;
        const float r = Rb[gi], k = Kb[gi]; float v = Vb[gi];
        const float z = -(w0 + lw[t]); const float sp = fmaxf(z, 0.f) + __logf(1.0f + __expf(-fabsf(z))); const float wdec = __expf(-__expf(-sp - 0.5f));
        const float asig = sigmoidf_(a0 + la[t]);
        if (li) { const float vg = sigmoidf_(v0 + lv[t]); const float vf = V0b[gi]; v = v + (vf - v) * vg; }
        const float kkr = k * kkc; const float ss = wave_sum(kkr * kkr); const float kkn = kkr * frsq(fmaxf(ss, 1e-24f));
        const float kmod = k * (1.0f + (asig - 1.0f) * kac);
        const float rks = wave_sum(r * kmod * rkc);
        LDS_WAIT();
        bc[lane] = wdec; bc[64 + lane] = -kkn; bc[128 + lane] = kkn * asig; bc[192 + lane] = kmod; bc[256 + lane] = r;
        LDS_WAIT();
        float sa = 0.f;
#pragma unroll
        for (int q = 0; q < 16; ++q) { const f32x4 av = *(const LAS f32x4*)(bc + 64 + 4 * q); sa += S[4 * q] * av[0] + S[4 * q + 1] * av[1] + S[4 * q + 2] * av[2] + S[4 * q + 3] * av[3]; }
        float y = 0.f;
#pragma unroll
        for (int q = 0; q < 16; ++q) { const f32x4 wv = *(const LAS f32x4*)(bc + 4 * q), bv = *(const LAS f32x4*)(bc + 128 + 4 * q), kv = *(const LAS f32x4*)(bc + 192 + 4 * q), rv = *(const LAS f32x4*)(bc + 256 + 4 * q);
#pragma unroll
            for (int e = 0; e < 4; ++e) { const float s = S[4 * q + e] * wv[e] + sa * bv[e] + v * kv[e]; S[4 * q + e] = s; y += s * rv[e]; } }
        const float mean = wave_sum(y) * (1.0f / 64.0f); const float dy = y - mean; const float var = wave_sum(dy * dy) * (1.0f / 64.0f);
        const float yn = dy * (frsq(var + GN_EPS)) * lnw + lnb;
        YG[gi] = (bf16_t)f2bf((yn + rks * v) * lg[t]);
    }
    { f32x4* so = (f32x4*)(p->out + O_WKVS + (((size_t)li * SB + b) * H + h) * 4096 + lane * 64);
#pragma unroll
      for (int q = 0; q < 16; ++q) so[q] = (f32x4){S[4 * q], S[4 * q + 1], S[4 * q + 2], S[4 * q + 3]}; }
    LDS_WAIT();
}

__device__ __forceinline__ void phase_scanA(KP p, const Ctx& c, int li) {
    const int stop = p->pad;
    if (stop != 9) for (int u0 = blockIdx.x, kr = 0; u0 < NUNIT_A; u0 += gridDim.x, ++kr) { int u = u0;
        if (gridDim.x == 256) { const int x = blockIdx.x & 7, y = blockIdx.x >> 3; u = ((kr * 16 + 2 * x + (y >> 4)) << 4) + (y & 15); }
        scanA_unit(p, c, li, u); }
    __syncthreads();
    if (stop == 0 || stop == 9) for (int it = c.gw; it < SB * H; it += c.ngw) scan_sample_item(p, c, li, it);
}

__device__ __forceinline__ void hilo(const f32x4 x0, const f32x4 x1, bf16x8& hi, bf16x8& lo) {
    unsigned h[8], l[8];
#pragma unroll
    for (int e = 0; e < 8; ++e) { const float x = e < 4 ? x0[e] : x1[e - 4]; h[e] = f2bf(x); l[e] = f2bf(x - __builtin_bit_cast(float, h[e] << 16)); }
    u32x4 hv = {h[0] | (h[1] << 16), h[2] | (h[3] << 16), h[4] | (h[5] << 16), h[6] | (h[7] << 16)}, lv = {l[0] | (l[1] << 16), l[2] | (l[3] << 16), l[4] | (l[5] << 16), l[6] | (l[7] << 16)};
    hi = __builtin_bit_cast(bf16x8, hv); lo = __builtin_bit_cast(bf16x8, lv);
}
constexpr int SB_SLOT = 20480, SB_RING0 = 8192, SB_DEPTH = 6;
static_assert(SB_RING0 + SB_DEPTH * SB_SLOT <= RING_BYTES, "chain ring");
__device__ __forceinline__ void phase_scanB(KP p, const Ctx& c, int li) {
    unsigned char* ws = p->ws; LAS unsigned char* lds = c.lds; const int lane = c.lane, fr = lane & 15, fq = lane >> 4, wave = c.wave;
    volatile LAS int* FL = (volatile LAS int*)(lds + RING_BYTES);
    if (c.tid < 4) FL[c.tid] = 0;
    __syncthreads();
    const int ncb = (int)gridDim.x < 128 ? (int)gridDim.x : 128;
    if (wave >= 4 || (int)blockIdx.x >= ncb) {
        const int gwf = (int)blockIdx.x < ncb ? (int)blockIdx.x * 4 + (wave - 4) : ncb * 4 + ((int)blockIdx.x - ncb) * 8 + wave, ngwf = ncb * 4 + ((int)gridDim.x - ncb) * 8;
        phase_fill(p, c, li, gwf, ngwf); return; }
    if (wave != 0) {
        const int j = wave - 1; int prevG = -1, kc = 0;
        for (int ch = blockIdx.x; ch < 128; ch += gridDim.x, ++kc) { const int cx_ = ch & 7, cy_ = ch >> 3, iq = cy_ & 3, bh_ = cx_ + 8 * (cy_ >> 2), b = bh_ >> 4, h = bh_ & 15;
            for (int n = j; n < NCH; n += 3) { const int G = kc * NCH + n;
                if (G >= SB_DEPTH) { unsigned sp = 0; while (FL[0] < G - (SB_DEPTH - 1)) { __builtin_amdgcn_s_sleep(1); if (++sp > (1u << 22)) break; } }
                LAS unsigned char* slot = lds + SB_RING0 + (G % SB_DEPTH) * SB_SLOT;
                const size_t u = (size_t)(b * NCH + n) * H + h; const bf16_t* MTH = (const bf16_t*)(ws + WS_MT) + u * 4096; const bf16_t* MTL = MTH + (size_t)NUNIT_A * 4096; const float* NN = (const float*)(ws + WS_NN) + u * 4096;
#pragma unroll
                for (int jt = 0; jt < 4; ++jt)
#pragma unroll
                    for (int ks = 0; ks < 2; ++ks) {
                        __builtin_amdgcn_global_load_lds((const unsigned*)(MTH + (size_t)(16 * jt + fr) * 64 + 32 * ks + 8 * fq), (LAS unsigned*)(slot + ((jt * 2 + ks) * 2 + 0) * 1024), 16, 0, 0);
                        __builtin_amdgcn_global_load_lds((const unsigned*)(MTL + (size_t)(16 * jt + fr) * 64 + 32 * ks + 8 * fq), (LAS unsigned*)(slot + ((jt * 2 + ks) * 2 + 1) * 1024), 16, 0, 0); }
#pragma unroll
                for (int jt = 0; jt < 4; ++jt)
                    __builtin_amdgcn_global_load_lds((const unsigned*)(NN + (size_t)(16 * iq + fr) * 64 + 16 * jt + 4 * fq), (LAS unsigned*)(slot + (16 + jt) * 1024), 16, 0, 0);
                asm volatile("s_waitcnt vmcnt(20)" ::: "memory");
                if (prevG >= 0) FL[1 + j] = prevG + 1;
                prevG = G; } }
        asm volatile("s_waitcnt vmcnt(0)" ::: "memory");
        if (prevG >= 0) FL[1 + j] = prevG + 1;
        return; }
    int kc = 0;
    for (int ch = blockIdx.x; ch < 128; ch += gridDim.x, ++kc) {
        const int cx_ = ch & 7, cy_ = ch >> 3, iq = cy_ & 3, bh_ = cx_ + 8 * (cy_ >> 2), b = bh_ >> 4, h = bh_ & 15;
        f32x4 S[4];
#pragma unroll
        for (int jt = 0; jt < 4; ++jt) S[jt] = (f32x4){0.f, 0.f, 0.f, 0.f};
        int j3 = 0;
        for (int n = 0; n < NCH; ++n) { const int G = kc * NCH + n;
            const size_t u = (size_t)(b * NCH + n) * H + h; bf16_t* S0 = (bf16_t*)(ws + WS_S0) + u * 4096;
            { unsigned sp = 0; while (FL[1 + j3] < G + 1) { __builtin_amdgcn_s_sleep(1); if (++sp > (1u << 22)) break; } }
            const LAS unsigned char* slot = lds + SB_RING0 + (G % SB_DEPTH) * SB_SLOT + lane * 16;
            bf16x8 ah[4][2], al[4][2]; f32x4 nn[4];
#pragma unroll
            for (int jt = 0; jt < 4; ++jt) { nn[jt] = *(const LAS f32x4*)(slot + (16 + jt) * 1024);
#pragma unroll
                for (int ks = 0; ks < 2; ++ks) { ah[jt][ks] = *(const LAS bf16x8*)(slot + ((jt * 2 + ks) * 2 + 0) * 1024); al[jt][ks] = *(const LAS bf16x8*)(slot + ((jt * 2 + ks) * 2 + 1) * 1024); } }
#pragma unroll
            for (int jt = 0; jt < 4; ++jt) { unsigned hh[4], ll[4];
#pragma unroll
                for (int r = 0; r < 4; ++r) { hh[r] = f2bf(S[jt][r]); ll[r] = f2bf(S[jt][r] - __builtin_bit_cast(float, hh[r] << 16)); }
                u32x2 wh = {hh[0] | (hh[1] << 16), hh[2] | (hh[3] << 16)}, wl = {ll[0] | (ll[1] << 16), ll[2] | (ll[3] << 16)};
                *(u32x2*)(S0 + (size_t)(16 * iq + fr) * 64 + 16 * jt + 4 * fq) = wh;
                *(LAS u32x2*)(lds + (fr * SST + 16 * jt + 4 * fq) * 2) = wh; *(LAS u32x2*)(lds + 4096 + (fr * SST + 16 * jt + 4 * fq) * 2) = wl; }
            LDS_WAIT();
            bf16x8 bh[2], bl[2];
#pragma unroll
            for (int ks = 0; ks < 2; ++ks) { bh[ks] = *(const LAS bf16x8*)(lds + (fr * SST + 32 * ks + 8 * fq) * 2); bl[ks] = *(const LAS bf16x8*)(lds + 4096 + (fr * SST + 32 * ks + 8 * fq) * 2); }
#pragma unroll
            for (int jt = 0; jt < 4; ++jt) { f32x4 acc = nn[jt];
#pragma unroll
                for (int ks = 0; ks < 2; ++ks) { acc = mfma16(ah[jt][ks], bh[ks], acc); acc = mfma16(ah[jt][ks], bl[ks], acc); acc = mfma16(al[jt][ks], bh[ks], acc); }
                S[jt] = acc; }
            LDS_WAIT();
            FL[0] = G + 1;
            j3 = j3 == 2 ? 0 : j3 + 1;
        }
        float* so = p->out + O_WKVP + (((size_t)li * NB + b) * H + h) * 4096;
#pragma unroll
        for (int jt = 0; jt < 4; ++jt) *(f32x4*)(so + (size_t)(16 * iq + fr) * 64 + 16 * jt + 4 * fq) = S[jt];
    }
}

__device__ __forceinline__ void phase_scanC(KP p, const Ctx& c, int li) {
    unsigned char* ws = p->ws; const int lane = c.lane, fr = lane & 15, fq = lane >> 4, hb = c.wave >> 2, tt = c.wave & 3;
    const float* Vb = (const float*)(ws + (li ? WS_V1 : WS_V0)); const bf16_t* HID = (const bf16_t*)(ws + WS_HID); const bf16_t* W2G = (const bf16_t*)(ws + WS_W2G) + (size_t)li * 1024 * 128;
    bf16_t* YG = (bf16_t*)(ws + WS_YG);
    for (int up0 = blockIdx.x, kr = 0; up0 < NUNIT_A / 2; up0 += gridDim.x, ++kr) { int up = up0;
        if (gridDim.x == 256) { const int x = blockIdx.x & 7, y = blockIdx.x >> 3; up = ((kr * 32 + 4 * x + (y >> 3)) << 3) + (y & 7); }
        const int u = 2 * up + hb; const int b = u / (NCH * H), n = (u / H) % NCH, h = u % H; const int row = b * TP + 64 * n + 16 * tt + fr;
        const bf16_t* RP = (const bf16_t*)(ws + WS_RP) + (size_t)u * 4096; const float* YL = (const float*)(ws + WS_YL) + (size_t)u * 4096; const bf16_t* S0 = (const bf16_t*)(ws + WS_S0) + (size_t)u * 4096;
        f32x4 acc[4], ag[4];
#pragma unroll
        for (int it = 0; it < 4; ++it) { acc[it] = *(const f32x4*)(YL + (size_t)(16 * tt + fr) * 64 + 16 * it + 4 * fq); ag[it] = (f32x4){0.f, 0.f, 0.f, 0.f}; }
#pragma unroll
        for (int ks = 0; ks < 2; ++ks) { const bf16x8 bq = *(const bf16x8*)(RP + (size_t)(16 * tt + fr) * 64 + 32 * ks + 8 * fq);
#pragma unroll
            for (int it = 0; it < 4; ++it) acc[it] = mfma16(*(const bf16x8*)(S0 + (size_t)(16 * it + fr) * 64 + 32 * ks + 8 * fq), bq, acc[it]); }
        const bf16_t* hgp = launder_p(HID + (size_t)row * LHID + 160 + 8 * fq); const bf16_t* wgp = launder_p(W2G + (size_t)(64 * h + fr) * 128 + 8 * fq);
#pragma unroll
        for (int ks = 0; ks < 4; ++ks) { const bf16x8 bq = *(const bf16x8*)(hgp + 32 * ks);
#pragma unroll
            for (int it = 0; it < 4; ++it) ag[it] = mfma16(*(const bf16x8*)(wgp + it * 16 * 128 + 32 * ks), bq, ag[it]); }
        float s = 0.f;
#pragma unroll
        for (int it = 0; it < 4; ++it) s += (acc[it][0] + acc[it][1]) + (acc[it][2] + acc[it][3]);
        s = sum_rows4(s); const float mean = s * (1.0f / 64.0f);
        float q = 0.f;
#pragma unroll
        for (int it = 0; it < 4; ++it) { const f32x4 d = acc[it] - mean; q += (d[0] * d[0] + d[1] * d[1]) + (d[2] * d[2] + d[3] * d[3]); }
        q = sum_rows4(q); const float rstd = frsq(q * (1.0f / 64.0f) + GN_EPS);
        const float rks = ((const float*)(ws + WS_RKS))[(size_t)row * 16 + h];
#pragma unroll
        for (int it = 0; it < 4; ++it) { const int C = 64 * h + 16 * it + 4 * fq; const size_t pc = (size_t)li * D + C;
            const f32x4 lw = *(const f32x4*)(p->in[I_LNW] + pc), lb = *(const f32x4*)(p->in[I_LNB] + pc), v = *(const f32x4*)(Vb + (size_t)row * D + C);
            const f32x4 o = ((acc[it] - mean) * rstd * lw + lb + v * rks) * ag[it];
            u32x2 w; w.x = pk2(o[0], o[1]); w.y = pk2(o[2], o[3]); *(u32x2*)(YG + (size_t)row * D + C) = w; }
    }
}
__device__ __forceinline__ void ld8bf(const bf16_t* p, float (&o)[8]) { const u32x4 w = *(const u32x4*)p; o[0] = bflo(w.x); o[1] = bfhi(w.x); o[2] = bflo(w.y); o[3] = bfhi(w.y); o[4] = bflo(w.z); o[5] = bfhi(w.z); o[6] = bflo(w.w); o[7] = bfhi(w.w); }
__device__ __forceinline__ void ld8f(const float* p, float (&o)[8]) { const f32x4 a = *(const f32x4*)p, b = *(const f32x4*)(p + 4); o[0] = a[0]; o[1] = a[1]; o[2] = a[2]; o[3] = a[3]; o[4] = b[0]; o[5] = b[1]; o[6] = b[2]; o[7] = b[3]; }
__device__ __forceinline__ void phase_conv(KP p, const Ctx& c, int layer) {
    const bf16_t* U = (const bf16_t*)(p->ws + WS_U); const bf16_t* GT = (const bf16_t*)(p->ws + WS_GT); bf16_t* HH = (bf16_t*)(p->ws + WS_HH);
    const float* cw = p->in[I_CONVW] + (size_t)layer * 3 * DFF; const float* cb = p->in[I_CONVB] + (size_t)layer * DFF; const float* st = p->in[I_SCONV] + (size_t)layer * SB * 2 * DFF;
    constexpr int NF8 = DFF / 8, NPS = MP / 64, NITEM = (NPS + SB) * NF8;
    for (int e = c.gtid; e < NITEM; e += c.gsz) { const int sidx = e / NF8, f = 8 * (e % NF8);
        int row0, nrow; float u0[8], u1[8];
        if (sidx < NPS) { row0 = 64 * sidx; nrow = 64;
            if ((row0 & (TP - 1)) == 0) {
#pragma unroll
                for (int i = 0; i < 8; ++i) { u0[i] = 0.f; u1[i] = 0.f; } }
            else { ld8bf(U + (size_t)(row0 - 1) * DFF + f, u1); ld8bf(U + (size_t)(row0 - 2) * DFF + f, u0); } }
        else { const int b = sidx - NPS; row0 = MP + 4 * b; nrow = 4; ld8f(st + ((size_t)b * 2 + 1) * DFF + f, u1); ld8f(st + ((size_t)b * 2) * DFF + f, u0); }
        float w0[8], w1[8], w2[8], bb[8];
        ld8f(cw + f, w0); ld8f(cw + DFF + f, w1); ld8f(cw + 2 * DFF + f, w2); ld8f(cb + f, bb);
        for (int r = 0; r < nrow; r += 4) {
            u32x4 ur[4], gr[4];
#pragma unroll
            for (int q = 0; q < 4; ++q) { ur[q] = *(const u32x4*)(U + (size_t)(row0 + r + q) * DFF + f); gr[q] = *(const u32x4*)(GT + (size_t)(row0 + r + q) * DFF + f); }
#pragma unroll
            for (int q = 0; q < 4; ++q) { float u2[8], g[8];
                u2[0] = bflo(ur[q].x); u2[1] = bfhi(ur[q].x); u2[2] = bflo(ur[q].y); u2[3] = bfhi(ur[q].y); u2[4] = bflo(ur[q].z); u2[5] = bfhi(ur[q].z); u2[6] = bflo(ur[q].w); u2[7] = bfhi(ur[q].w);
                g[0] = bflo(gr[q].x); g[1] = bfhi(gr[q].x); g[2] = bflo(gr[q].y); g[3] = bfhi(gr[q].y); g[4] = bflo(gr[q].z); g[5] = bfhi(gr[q].z); g[6] = bflo(gr[q].w); g[7] = bfhi(gr[q].w);
                float o[8];
#pragma unroll
                for (int i = 0; i < 8; ++i) { o[i] = gelu_tanh(bb[i] + w0[i] * u0[i] + w1[i] * u1[i] + w2[i] * u2[i]) * g[i]; u0[i] = u1[i]; u1[i] = u2[i]; }
                u32x4 w; w.x = pk2(o[0], o[1]); w.y = pk2(o[2], o[3]); w.z = pk2(o[4], o[5]); w.w = pk2(o[6], o[7]);
                *(u32x4*)(HH + (size_t)(row0 + r + q) * DFF + f) = w; }
        }
    }
}

__device__ __forceinline__ void phase_kvpost(KP p, const Ctx& c) {
    const float* KVF = (const float*)(p->ws + WS_KVF); unsigned char* ws = p->ws; const int lane = c.lane, g = lane >> 4, d0 = 4 * (lane & 15);
    const f32x4 gs = *(const f32x4*)(p->in[I_KNG] + 64 + d0), gw = *(const f32x4*)(p->in[I_KNG] + 128 + d0);
    bf16_t* CA = (bf16_t*)(ws + WS_CMPA); bf16_t* KS = (bf16_t*)(ws + WS_KS); bf16_t* VS = (bf16_t*)(ws + WS_VS); bf16_t* KW = (bf16_t*)(ws + WS_KW); bf16_t* VW = (bf16_t*)(ws + WS_VW);
    for (int chunk = c.gw; chunk < R / 8; chunk += c.ngw) {
        unsigned vs_[4][4], vw_[4][4];
#pragma unroll
        for (int e = 0; e < 8; ++e) { const int row = chunk * 8 + e; const float* src = KVF + (size_t)row * NKV + 4 * lane;
            f32x4 v[6];
#pragma unroll
            for (int pt = 0; pt < 6; ++pt) v[pt] = *(const f32x4*)(src + pt * 256);
            { float s = (v[2][0] * v[2][0] + v[2][1] * v[2][1]) + (v[2][2] * v[2][2] + v[2][3] * v[2][3]);
              s = row16_sum(s); const float rs = frsq(s * (1.0f / 64.0f) + NORM_EPS); v[2] = v[2] * rs * gs; }
            { float s = (v[4][0] * v[4][0] + v[4][1] * v[4][1]) + (v[4][2] * v[4][2] + v[4][3] * v[4][3]);
              s = row16_sum(s); const float rs = frsq(s * (1.0f / 64.0f) + NORM_EPS); v[4] = v[4] * rs * gw; }
            float* okv = p->out + O_KV + (size_t)row * D + 4 * lane;
#pragma unroll
            for (int pt = 0; pt < 4; ++pt) *(f32x4*)(okv + pt * 256) = v[pt];
            if (row < MP) { const int b = row >> 13, t = row & (TP - 1);
                if (t >= TP - WIN) { float* ow = p->out + O_WINP + ((size_t)(b * WIN + (t - (TP - WIN))) * 2) * 256 + 4 * lane; *(f32x4*)ow = v[4]; *(f32x4*)(ow + 256) = v[5]; }
                const size_t hb = (size_t)(b * G + g);
                { u32x2 w; w.x = pk2(v[0][0], v[0][1]); w.y = pk2(v[0][2], v[0][3]); *(u32x2*)(CA + (hb * 512 + (t >> 4)) * 1024 + (t & 15) * 64 + d0) = w; }
                { u32x2 w; w.x = pk2(v[1][0], v[1][1]); w.y = pk2(v[1][2], v[1][3]); *(u32x2*)(CA + ((size_t)4096 + hb * 512 + (t >> 4)) * 1024 + (t & 15) * 64 + d0) = w; }
                { u32x2 w; w.x = pk2(v[2][0], v[2][1]); w.y = pk2(v[2][2], v[2][3]); *(u32x2*)(KS + (hb * TP + t) * 64 + d0) = w; }
                { u32x2 w; w.x = pk2(v[4][0], v[4][1]); w.y = pk2(v[4][2], v[4][3]); *(u32x2*)(KW + (hb * TP + t) * 64 + d0) = w; }
#pragma unroll
                for (int d = 0; d < 4; ++d) { const unsigned a = f2bf(v[3][d]), bq = f2bf(v[5][d]);
                    if (e & 1) { vs_[d][e >> 1] |= a << 16; vw_[d][e >> 1] |= bq << 16; } else { vs_[d][e >> 1] = a; vw_[d][e >> 1] = bq; } }
            } else { const int b = (row - MP) >> 2, t = (row - MP) & 3;
                float* ow = p->out + O_WINS + ((size_t)(b * WIN + 508 + t) * 2) * 256 + 4 * lane; *(f32x4*)ow = v[4]; *(f32x4*)(ow + 256) = v[5]; }
        }
        if (chunk * 8 < MP) { const int row = chunk * 8, b = row >> 13, t = row & (TP - 1); const size_t hb = (size_t)(b * G + g);
#pragma unroll
            for (int d = 0; d < 4; ++d) { *(u32x4*)(VS + (hb * 64 + d0 + d) * TP + t) = (u32x4){vs_[d][0], vs_[d][1], vs_[d][2], vs_[d][3]};
                *(u32x4*)(VW + (hb * 64 + d0 + d) * TP + t) = (u32x4){vw_[d][0], vw_[d][1], vw_[d][2], vw_[d][3]}; } }
    }
}

__device__ __forceinline__ void phase_cmp2(KP p, const Ctx& c) {
    unsigned char* ws = p->ws; const float* PC = (const float*)(ws + WS_PCMP); const int lane = c.lane, fr = lane & 15, fq = lane >> 4;
    const bf16_t* W2H = (const bf16_t*)(ws + WS_CW2T); const bf16_t* W2L = W2H + 2 * 64 * 128;
    constexpr int NPI = NB * G * 32, NSI = SB * G * 8, TOT = 2 * (NPI + NSI);
    for (int it = c.gw; it < TOT; it += c.ngw) {
        const bool samp = it >= 2 * NPI; const int r = samp ? it - 2 * NPI : it; const int kv = samp ? r / NSI : r / NPI; const int idx = samp ? r % NSI : r % NPI;
        const int hb = samp ? (idx >> 3) : (idx >> 5), n0 = 16 * (samp ? (idx & 7) : (idx & 31)), ncmp = samp ? NCMP_S : NCMP_P, nper = samp ? 128 : 512;
        const int n = n0 + fr; const bool live = n < ncmp;
        const size_t prow = (samp ? (size_t)8192 + (size_t)kv * 65536 : (size_t)kv * 4096) + (size_t)hb * nper + (live ? n : ncmp - 1);
        const float* cb = (const float*)(ws + WS_CBIAS) + kv * 128;
        bf16x8 hh[4], hl[4];
#pragma unroll
        for (int ks = 0; ks < 4; ++ks) { const int k0 = 32 * ks + 8 * fq; unsigned uh[8], ul[8];
            const f32x4 a0 = *(const f32x4*)(PC + prow * 256 + k0), a1 = *(const f32x4*)(PC + prow * 256 + k0 + 4);
            const f32x4 b0 = *(const f32x4*)(PC + (prow + 1) * 256 + 128 + k0), b1 = *(const f32x4*)(PC + (prow + 1) * 256 + 128 + k0 + 4);
            const f32x4 c0 = *(const f32x4*)(cb + k0), c1 = *(const f32x4*)(cb + k0 + 4);
#pragma unroll
            for (int e = 0; e < 8; ++e) { const float x = e < 4 ? a0[e] + b0[e] + c0[e] : a1[e - 4] + b1[e - 4] + c1[e - 4]; const float hv = gelu_tanh(x);
                uh[e] = f2bf(hv); ul[e] = f2bf(hv - __builtin_bit_cast(float, uh[e] << 16)); }
            const u32x4 wh = {uh[0] | (uh[1] << 16), uh[2] | (uh[3] << 16), uh[4] | (uh[5] << 16), uh[6] | (uh[7] << 16)}, wl = {ul[0] | (ul[1] << 16), ul[2] | (ul[3] << 16), ul[4] | (ul[5] << 16), ul[6] | (ul[7] << 16)};
            hh[ks] = __builtin_bit_cast(bf16x8, wh); hl[ks] = __builtin_bit_cast(bf16x8, wl); }
        f32x4 acc[4];
#pragma unroll
        for (int dt = 0; dt < 4; ++dt) { acc[dt] = *(const f32x4*)(p->in[I_CB2] + kv * 64 + 16 * dt + 4 * fq);
#pragma unroll
            for (int ks = 0; ks < 4; ++ks) { const size_t wo = (size_t)(kv * 64 + 16 * dt + fr) * 128 + 32 * ks + 8 * fq; const bf16x8 wh = *(const bf16x8*)(W2H + wo), wl = *(const bf16x8*)(W2L + wo);
                acc[dt] = mfma16(wh, hh[ks], acc[dt]); acc[dt] = mfma16(wh, hl[ks], acc[dt]); acc[dt] = mfma16(wl, hh[ks], acc[dt]); } }
        if (kv == 0) { float ss = 0.f;
#pragma unroll
            for (int dt = 0; dt < 4; ++dt) ss += (acc[dt][0] * acc[dt][0] + acc[dt][1] * acc[dt][1]) + (acc[dt][2] * acc[dt][2] + acc[dt][3] * acc[dt][3]);
            ss = sum_rows4(ss); const float rs = frsq(ss * (1.0f / 64.0f) + NORM_EPS);
#pragma unroll
            for (int dt = 0; dt < 4; ++dt) acc[dt] = acc[dt] * rs * *(const f32x4*)(p->in[I_KNG] + 16 * dt + 4 * fq); }
#pragma unroll
        for (int dt = 0; dt < 4; ++dt) { const f32x4 o = live ? acc[dt] : (f32x4){0.f, 0.f, 0.f, 0.f}; const int d = 16 * dt + 4 * fq;
            if (samp) *(f32x4*)((float*)(ws + (kv ? WS_CVS : WS_CKS)) + ((size_t)hb * 128 + n) * 64 + d) = o;
            else if (kv == 0) { u32x2 w; w.x = pk2(o[0], o[1]); w.y = pk2(o[2], o[3]); *(u32x2*)((bf16_t*)(ws + WS_CK) + ((size_t)hb * 512 + n) * 64 + d) = w; }
            else {
#pragma unroll
                for (int e = 0; e < 4; ++e) ((bf16_t*)(ws + WS_CV))[((size_t)hb * 64 + d + e) * 512 + n] = (bf16_t)f2bf(o[e]); } }
    }
}

__device__ __forceinline__ void phase_qpost(KP p, const Ctx& c, int lb) {
    const float* QF = (const float*)(p->ws + WS_QF); bf16_t* Q = (bf16_t*)(p->ws + WS_Q); const int lane = c.lane;
    const f32x4 gq = *(const f32x4*)(p->in[I_QNG] + lb * 64 + 4 * (lane & 15));
    for (int row = c.gw; row < R; row += c.ngw) { const float* src = QF + (size_t)row * NQP;
        f32x4 v[4]; load_row(src, lane, v);
#pragma unroll
        for (int j = 0; j < 4; ++j) { float s = (v[j][0] * v[j][0] + v[j][1] * v[j][1]) + (v[j][2] * v[j][2] + v[j][3] * v[j][3]);
            s = row16_sum(s);
            const float rs = (frsq(s * (1.0f / 64.0f) + NORM_EPS)) * (0.125f * 1.4426950408889634f); v[j] = v[j] * rs * gq; }
        store_row_bf16(Q + (size_t)row * D, lane, v);
    }
}
constexpr int AT_K0 = 0, AT_V0 = 9216, AT_K1 = 18432, AT_V1 = 27648, AT_IMP = 36864, IMPS = 132, AT_SELM = AT_IMP + 64 * IMPS * 4, AT_ANY = AT_SELM + 1024;
static_assert(AT_ANY + 16 <= RING_BYTES, "attention LDS map");
struct TileSrc { const bf16_t* K; const bf16_t* VT; int vts; };
__device__ __forceinline__ void tile_load(const TileSrc& s, int key0, int tid, u32x4& rk, u32x4& rv) {
    const int row = tid >> 3, ch = tid & 7;
    rk = *(const u32x4*)(s.K + (size_t)(key0 + row) * 64 + 8 * ch); rv = *(const u32x4*)(s.VT + (size_t)row * s.vts + key0 + 8 * ch);
}
__device__ __forceinline__ void tile_load_async(const TileSrc& s, int key0, int tid, u32x4& rk, u32x4& rv) {
    const int row = tid >> 3, ch = tid & 7;
    const bf16_t* pk = s.K + (size_t)(key0 + row) * 64 + 8 * ch; const bf16_t* pv = s.VT + (size_t)row * s.vts + key0 + 8 * ch;
    asm volatile("global_load_dwordx4 %0, %2, off\n\tglobal_load_dwordx4 %1, %3, off" : "=&v"(rk), "=&v"(rv) : "v"(pk), "v"(pv) : "memory");
}
#define TILE_WAIT(N_, RK_, RV_) asm volatile("s_waitcnt vmcnt(" #N_ ")" : "+v"(RK_), "+v"(RV_) :: "memory")
__device__ __forceinline__ void tile_store(LAS unsigned char* lds, int buf, int tid, const u32x4& rk, const u32x4& rv) {
    const int row = tid >> 3, ch = tid & 7;
    *(LAS u32x4*)(lds + (buf ? AT_K1 : AT_K0) + (row * SST + 8 * ch) * 2) = rk; *(LAS u32x4*)(lds + (buf ? AT_V1 : AT_V0) + (row * SST + 8 * ch) * 2) = rv;
}
__device__ __forceinline__ int first_bit4(unsigned a, unsigned b, unsigned c, unsigned d) { return a ? __ffs(a) - 1 : (b ? 32 + __ffs(b) - 1 : (c ? 64 + __ffs(c) - 1 : (d ? 96 + __ffs(d) - 1 : -1))); }
__device__ __forceinline__ float ex2(float x) { return __builtin_amdgcn_exp2f(x); }

__device__ __forceinline__ void set_bit4(int s, unsigned& t0, unsigned& t1, unsigned& t2, unsigned& t3) { const unsigned bit = 1u << (s & 31); const int w = s >> 5; t0 |= (w == 0) ? bit : 0u; t1 |= (w == 1) ? bit : 0u; t2 |= (w == 2) ? bit : 0u; t3 |= (w == 3) ? bit : 0u; }
__device__ __forceinline__ void clr_bit4(int s, unsigned& t0, unsigned& t1, unsigned& t2, unsigned& t3) { const unsigned bit = 1u << (s & 31); const int w = s >> 5; t0 &= ~((w == 0) ? bit : 0u); t1 &= ~((w == 1) ? bit : 0u); t2 &= ~((w == 2) ? bit : 0u); t3 &= ~((w == 3) ? bit : 0u); }
__device__ __forceinline__ unsigned get_word4(int s, unsigned a, unsigned b, unsigned c, unsigned d) { const int w = s >> 5; return ((w == 0) ? a : 0u) | ((w == 1) ? b : 0u) | ((w == 2) ? c : 0u) | ((w == 3) ? d : 0u); }
__device__ __forceinline__ float dpp_xor1(float x) { return __builtin_bit_cast(float, __builtin_amdgcn_update_dpp(0, __builtin_bit_cast(int, x), 0xB1, 0xF, 0xF, true)); }
__device__ __forceinline__ float dpp_xor2(float x) { return __builtin_bit_cast(float, __builtin_amdgcn_update_dpp(0, __builtin_bit_cast(int, x), 0x4E, 0xF, 0xF, true)); }
template <int MODE, bool EDGE> __device__ __forceinline__ void attn_tile(LAS unsigned char* lds, int buf, const bf16x8 (&qf)[4], int key0, int qpos, int r, int hf,
                                                                          float& l, f32x16 (&O)[2], float invl, bool selbit, LAS float* impq) {
    if (MODE == 3) { if (__ballot(selbit) == 0ull) { asm volatile("" : "+v"(O[0]), "+v"(O[1]), "+v"(l)); return; } }
    const unsigned smask = selbit ? 0xffffffffu : 0u;
    const int oK = buf ? AT_K1 : AT_K0, oV = buf ? AT_V1 : AT_V0;
#pragma unroll
    for (int kt = 0; kt < 2; ++kt) {
        f32x16 S;
#pragma unroll
        for (int i = 0; i < 16; ++i) S[i] = 0.f;
#pragma unroll
        for (int ks = 0; ks < 4; ++ks) S = mfma32(*(const LAS bf16x8*)(lds + oK + ((32 * kt + r) * SST + 16 * ks + 8 * hf) * 2), qf[ks], S);
        float ls = 0.f;
#pragma unroll
        for (int i = 0; i < 16; ++i) { float pv = ex2(S[i]);
            if (EDGE) { const int key = key0 + 32 * kt + (i & 3) + 8 * (i >> 2) + 4 * hf; bool v;
                if (MODE <= 1) v = (16 * key + 31 <= qpos); else if (MODE == 2) v = (key <= qpos) && (key + WIN > qpos); else v = (key <= qpos);
                pv = v ? pv : 0.f; }
            if (MODE == 1) pv *= invl;
            S[i] = pv; ls += pv; }
        if (MODE == 3) ls = selbit ? ls : 0.f;
        if (MODE != 1) l += ls;
        if (MODE >= 1) {
#pragma unroll
            for (int sp = 0; sp < 2; ++sp) {
                u32x4 pw; pw.x = pg8::cvt_pk_bf16(S[8 * sp + 0], S[8 * sp + 1]); pw.y = pg8::cvt_pk_bf16(S[8 * sp + 2], S[8 * sp + 3]); pw.z = pg8::cvt_pk_bf16(S[8 * sp + 4], S[8 * sp + 5]); pw.w = pg8::cvt_pk_bf16(S[8 * sp + 6], S[8 * sp + 7]);
                if (MODE == 3) { pw.x &= smask; pw.y &= smask; pw.z &= smask; pw.w &= smask; }
                const bf16x8 pf = __builtin_bit_cast(bf16x8, pw);
#pragma unroll
                for (int dt = 0; dt < 2; ++dt) { const int d = 32 * dt + r, kb = 32 * kt + 16 * sp + 4 * hf;
                    const u32x2 lo = *(const LAS u32x2*)(lds + oV + (d * SST + kb) * 2), hi = *(const LAS u32x2*)(lds + oV + (d * SST + kb + 8) * 2);
                    const u32x4 vw = {lo.x, lo.y, hi.x, hi.y};
                    O[dt] = mfma32(__builtin_bit_cast(bf16x8, vw), pf, O[dt]); } }
        }
        if (MODE == 1) {
            float own[4], nxt[4];
#pragma unroll
            for (int gq = 0; gq < 4; ++gq) { const float p3 = S[4 * gq + 3]; float o = 2.0f * (S[4 * gq] + S[4 * gq + 1] + S[4 * gq + 2]) + p3, n = p3;
                o += dpp_xor1(o); o += dpp_xor2(o); n += dpp_xor1(n); n += dpp_xor2(n); own[gq] = o; nxt[gq] = n; }
            const int sbb = (key0 >> 2) + 8 * kt + hf;
            if ((r & 3) == 0) {
#pragma unroll
                for (int gq = 0; gq < 4; ++gq) impq[sbb + 2 * gq] += own[gq]; }
            asm volatile("s_waitcnt lgkmcnt(0)" ::: "memory");
            if ((r & 3) == 0) {
#pragma unroll
                for (int gq = 0; gq < 4; ++gq) impq[sbb + 2 * gq + 1] += nxt[gq]; }
            asm volatile("s_waitcnt lgkmcnt(0)" ::: "memory");
        }
    }
}

template <int MODE> __device__ __forceinline__ void run_tiles(LAS unsigned char* lds, const TileSrc& src, unsigned t0, unsigned t1, unsigned t2, unsigned t3, int qt,
                                                              const bf16x8 (&qf)[4], int qpos, int r, int hf, int tid,
                                                              float& l, f32x16 (&O)[2], float invl, unsigned s0, unsigned s1, unsigned s2, unsigned s3, LAS float* impq, const int alias = 0) {
#define TSEL(n_) ((alias ? ((n_) & 7) : (n_)) * 64)
    tid = launder_v(tid); r = tid & 31; hf = (tid >> 5) & 1;
    int cur = first_bit4(t0, t1, t2, t3); if (cur < 0) return;
    const int first = cur;
    clr_bit4(cur, t0, t1, t2, t3); int n1 = first_bit4(t0, t1, t2, t3); if (n1 >= 0) clr_bit4(n1, t0, t1, t2, t3);
    int n2 = first_bit4(t0, t1, t2, t3); if (n2 >= 0) clr_bit4(n2, t0, t1, t2, t3);
    int n3 = first_bit4(t0, t1, t2, t3); if (n3 >= 0) clr_bit4(n3, t0, t1, t2, t3);
    u32x4 rkA, rvA, rkB, rvB, rkC, rvC; { u32x4 rk, rv; tile_load(src, TSEL(cur), tid, rk, rv); int b0 = 0; tile_store(lds, b0, tid, rk, rv); }
    tile_load_async(src, TSEL(n1 >= 0 ? n1 : first), tid, rkA, rvA);
    tile_load_async(src, TSEL(n2 >= 0 ? n2 : first), tid, rkB, rvB);
    tile_load_async(src, TSEL(n3 >= 0 ? n3 : first), tid, rkC, rvC);
    int buf = 0;
    __syncthreads();
#define RT_STEP(RK_, RV_) { \
        if (cur >= 0) { \
            const unsigned sw = get_word4(cur, s0, s1, s2, s3); \
            const bool sb = ((sw >> (cur & 31)) & 1u) != 0u; \
            if (MODE <= 1) attn_tile<MODE, true>(lds, buf, qf, cur * 64, qpos, r, hf, l, O, invl, sb, impq); \
            else { const bool edge = (cur == qt) || (MODE == 2 && cur == qt - 8); \
                if (edge) attn_tile<MODE, true>(lds, buf, qf, cur * 64, qpos, r, hf, l, O, invl, sb, impq); \
                else attn_tile<MODE, false>(lds, buf, qf, cur * 64, qpos, r, hf, l, O, invl, sb, impq); } } \
        TILE_WAIT(4, RK_, RV_); \
        tile_store(lds, buf ^ 1, tid, RK_, RV_); \
        __syncthreads(); \
        const int n4 = first_bit4(t0, t1, t2, t3); if (n4 >= 0) clr_bit4(n4, t0, t1, t2, t3); \
        tile_load_async(src, TSEL(n4 >= 0 ? n4 : first), tid, RK_, RV_); \
        buf ^= 1; cur = n1; n1 = n2; n2 = n3; n3 = n4; }
    do {
        RT_STEP(rkA, rvA)
        RT_STEP(rkB, rvB)
        RT_STEP(rkC, rvC)
    } while (cur >= 0);
#undef RT_STEP
    asm volatile("s_waitcnt vmcnt(0)" : "+v"(rkA), "+v"(rvA), "+v"(rkB), "+v"(rvB), "+v"(rkC), "+v"(rvC) :: "memory");
    __syncthreads();
}
__device__ __forceinline__ void attn_prompt_unit(KP p, const Ctx& c, int k, const int stop, const int lb) {
    LAS unsigned char* lds = c.lds; unsigned char* ws = p->ws; int tid_m; asm volatile("v_mbcnt_lo_u32_b32 %0, -1, 0\n\tv_mbcnt_hi_u32_b32 %0, -1, %0" : "=v"(tid_m));
    const int wave = c.wave, tid = tid_m + 64 * wave, lane = tid & 63, r = lane & 31, hf = lane >> 5;
    const int qt = 127 - (k >> 3), hb = k & 7, b = hb >> 2, g = hb & 3, q0 = 64 * qt;
    const int qi = 8 * wave + (r >> 2), head = 4 * g + (r & 3), qpos = q0 + qi, row = b * TP + qpos;
    bf16x8 qf[4];
    { const float* QFp = (const float*)(ws + WS_QF) + (size_t)row * NQP + head * 64 + 8 * hf; const float* gqp = p->in[I_QNG] + lb * 64 + 8 * hf;
      f32x4 qv[4][2]; float ss = 0.f;
#pragma unroll
      for (int ks = 0; ks < 4; ++ks) { qv[ks][0] = *(const f32x4*)(QFp + 16 * ks); qv[ks][1] = *(const f32x4*)(QFp + 16 * ks + 4);
#pragma unroll
          for (int e = 0; e < 4; ++e) ss += qv[ks][0][e] * qv[ks][0][e] + qv[ks][1][e] * qv[ks][1][e]; }
      ss = sum_xor32(ss);
      const float rs = frsq(ss * (1.0f / 64.0f) + NORM_EPS) * (0.125f * 1.4426950408889634f);
#pragma unroll
      for (int ks = 0; ks < 4; ++ks) { const f32x4 g0 = *(const f32x4*)(gqp + 16 * ks), g1 = *(const f32x4*)(gqp + 16 * ks + 4); const f32x4 a = qv[ks][0] * rs * g0, bq = qv[ks][1] * rs * g1;
          const u32x4 wq = {pk2(a[0], a[1]), pk2(a[2], a[3]), pk2(bq[0], bq[1]), pk2(bq[2], bq[3])}; qf[ks] = __builtin_bit_cast(bf16x8, wq); } }
    const float* gate = (const float*)(ws + WS_GATE) + (size_t)row * 48 + head * 3; const float g_c = gate[0], g_s = gate[1], g_w = gate[2];
    LAS float* imp = (LAS float*)(lds + AT_IMP); LAS unsigned* selm = (LAS unsigned*)(lds + AT_SELM); LAS unsigned* anym = (LAS unsigned*)(lds + AT_ANY);
    for (int e = tid; e < 64 * IMPS; e += 512) imp[e] = 0.f;
    if (tid < 4) anym[tid] = 0u;
    __syncthreads();
    f32x16 O[2]; unsigned OUTP[2][8];
#pragma unroll
    for (int dt = 0; dt < 2; ++dt)
#pragma unroll
        for (int i = 0; i < 16; ++i) O[dt][i] = 0.f;
    {
        const TileSrc src{(const bf16_t*)(ws + WS_CK) + (size_t)hb * 512 * 64, (const bf16_t*)(ws + WS_CV) + (size_t)hb * 64 * 512, 512};
        const int nmax = q0 + 63 - 31; const int ntc = nmax >= 0 ? (nmax >> 10) + 1 : 0;
        const unsigned tm = ntc >= 32 ? 0xffffffffu : ((1u << ntc) - 1u);
        float l = 0.f;
        run_tiles<0>(lds, src, tm, 0u, 0u, 0u, qt, qf, qpos, r, hf, tid, l, O, 0.f, 0u, 0u, 0u, 0u, imp);
        l = sum_xor32(l); const float invl = l > 0.f ? 1.0f / l : 0.f;
        run_tiles<1>(lds, src, tm, 0u, 0u, 0u, qt, qf, qpos, r, hf, tid, l, O, invl, 0u, 0u, 0u, 0u, imp + qi * IMPS);
#pragma unroll
        for (int dt = 0; dt < 2; ++dt) {
#pragma unroll
            for (int i = 0; i < 8; ++i) { OUTP[dt][i] = pg8::cvt_pk_bf16(O[dt][2 * i] * g_c, O[dt][2 * i + 1] * g_c); asm volatile("" : "+v"(OUTP[dt][i])); }
#pragma unroll
            for (int i = 0; i < 16; ++i) O[dt][i] = 0.f; }
    }
    __syncthreads();
    if (stop == 1) return;
    {
        unsigned k0[8], k1[8], T[8]; int Kq[8];
#pragma unroll
        for (int e = 0; e < 8; ++e) { const int qq = 8 * wave + e, qp = q0 + qq, qb = qp >> 6;
            const bool c0 = (64 * lane <= qp), c1 = (64 * (lane + 64) <= qp);
            const unsigned a0_ = (lane == 0 || lane == qb || lane == qb - 1) ? 0xffffffffu : __builtin_bit_cast(unsigned, imp[qq * IMPS + lane]);
            const unsigned a1_ = (lane + 64 == qb || lane + 64 == qb - 1) ? 0xffffffffu : __builtin_bit_cast(unsigned, imp[qq * IMPS + lane + 64]);
            k0[e] = c0 ? a0_ : 0u; k1[e] = c1 ? a1_ : 0u;
            Kq[e] = qb + 1 < 16 ? qb + 1 : 16; T[e] = 0u; }
        if (qt < 64) {
            for (int bit = 31; bit >= 0; --bit) {
#pragma unroll
                for (int e = 0; e < 8; ++e) { const unsigned cand = T[e] | (1u << bit);
                    const int cnt = __popcll(__ballot(k0[e] >= cand)); if (cnt >= Kq[e]) T[e] = cand; } } }
        else {
            for (int bit = 31; bit >= 0; --bit) {
#pragma unroll
                for (int e = 0; e < 8; ++e) { const unsigned cand = T[e] | (1u << bit);
                    const int cnt = __popcll(__ballot(k0[e] >= cand)) + __popcll(__ballot(k1[e] >= cand)); if (cnt >= Kq[e]) T[e] = cand; } } }
#pragma unroll
        for (int e = 0; e < 8; ++e) { const int qq = 8 * wave + e, qp = q0 + qq;
            const bool c0 = (64 * lane <= qp), c1 = (64 * (lane + 64) <= qp);
            unsigned long long mlo = __ballot(k0[e] > T[e]), mhi = __ballot(k1[e] > T[e]), elo = __ballot(c0 && k0[e] == T[e]), ehi = __ballot(c1 && k1[e] == T[e]);
            int need = Kq[e] - (__popcll(mlo) + __popcll(mhi));
            for (; need > 0; --need) { if (elo) { mlo |= elo & (~elo + 1ull); elo &= elo - 1ull; } else { mhi |= ehi & (~ehi + 1ull); ehi &= ehi - 1ull; } }
            const unsigned m0 = (unsigned)mlo, m1 = (unsigned)(mlo >> 32), m2 = (unsigned)mhi, m3 = (unsigned)(mhi >> 32);
            if (lane == 0) { selm[qq * 4 + 0] = m0; selm[qq * 4 + 1] = m1; selm[qq * 4 + 2] = m2; selm[qq * 4 + 3] = m3;
                atomicOr((unsigned*)&anym[0], m0); atomicOr((unsigned*)&anym[1], m1); atomicOr((unsigned*)&anym[2], m2); atomicOr((unsigned*)&anym[3], m3); } }
    }
    __syncthreads();
    if (stop == 2) return;
    {
        const TileSrc src{(const bf16_t*)(ws + WS_KW) + (size_t)hb * TP * 64, (const bf16_t*)(ws + WS_VW) + (size_t)hb * 64 * TP, TP};
        const int tlo = qt >= 8 ? qt - 8 : 0; unsigned t0 = 0u, t1 = 0u, t2 = 0u, t3 = 0u;
        for (int s = tlo; s <= qt; ++s) set_bit4(s, t0, t1, t2, t3);
        float l = 0.f;
        run_tiles<2>(lds, src, t0, t1, t2, t3, qt, qf, qpos, r, hf, tid, l, O, 0.f, 0u, 0u, 0u, 0u, imp);
        l = sum_xor32(l); const float sc = l > 0.f ? g_w / l : 0.f;
#pragma unroll
        for (int dt = 0; dt < 2; ++dt) {
#pragma unroll
            for (int i = 0; i < 8; ++i) { OUTP[dt][i] = pg8::cvt_pk_bf16(bflo(OUTP[dt][i]) + O[dt][2 * i] * sc, bfhi(OUTP[dt][i]) + O[dt][2 * i + 1] * sc); asm volatile("" : "+v"(OUTP[dt][i])); }
#pragma unroll
            for (int i = 0; i < 16; ++i) O[dt][i] = 0.f; }
    }
    if (stop == 3) { __syncthreads(); return; }
    {
        const TileSrc src{(const bf16_t*)(ws + WS_KS) + (size_t)hb * TP * 64, (const bf16_t*)(ws + WS_VS) + (size_t)hb * 64 * TP, TP};
        const unsigned sz_ = (stop == 5) ? 0u : 0xffffffffu;
        const unsigned s0 = selm[qi * 4 + 0] & sz_, s1 = selm[qi * 4 + 1] & sz_, s2 = selm[qi * 4 + 2] & sz_, s3 = selm[qi * 4 + 3] & sz_;
        const unsigned a0 = __builtin_amdgcn_readfirstlane(anym[0]), a1 = __builtin_amdgcn_readfirstlane(anym[1]), a2 = __builtin_amdgcn_readfirstlane(anym[2]), a3 = __builtin_amdgcn_readfirstlane(anym[3]);
        float l = 0.f;
        run_tiles<3>(lds, src, a0, a1, a2, a3, qt, qf, qpos, r, hf, tid, l, O, 0.f, s0, s1, s2, s3, imp, stop == 4 ? 1 : 0);
        if (stop >= 4) { if (l == 12345.678f) ((float*)(ws + WS_GATE))[0] = O[0][0] + O[1][0]; __syncthreads(); return; }
        l = sum_xor32(l); const float sc = l > 0.f ? g_s / l : 0.f;
#pragma unroll
        for (int dt = 0; dt < 2; ++dt)
#pragma unroll
            for (int i = 0; i < 8; ++i) OUTP[dt][i] = pg8::cvt_pk_bf16(bflo(OUTP[dt][i]) + O[dt][2 * i] * sc, bfhi(OUTP[dt][i]) + O[dt][2 * i + 1] * sc);
    }
    bf16_t* AO = (bf16_t*)(ws + WS_YG) + (size_t)row * D + head * 64;
#pragma unroll
    for (int dt = 0; dt < 2; ++dt)
#pragma unroll
        for (int gq = 0; gq < 4; ++gq) { u32x2 w; w.x = OUTP[dt][2 * gq]; w.y = OUTP[dt][2 * gq + 1]; *(u32x2*)(AO + 32 * dt + 8 * gq + 4 * hf) = w; }
    __syncthreads();
}

constexpr int SA_RED = 0, SA_REDW = 2 * 16 * 65 * 4, SA_OC = SA_RED + SA_REDW, SA_EC = SA_OC + 2 * 4096, SA_LC = SA_EC + 2 * 4096, SA_PN = SA_LC + 256, SA_SEL = SA_PN + 4 * 512;
static_assert(SA_SEL + 64 <= RING_BYTES, "sample attention LDS map");
__device__ __forceinline__ bf16x8 pack8(const f32x4 a, const f32x4 b) { const u32x4 w = {pk2(a[0], a[1]), pk2(a[2], a[3]), pk2(b[0], b[1]), pk2(b[2], b[3])}; return __builtin_bit_cast(bf16x8, w); }
__device__ __forceinline__ void sa_qk(const float* kb, size_t stride, int nrows, const bf16x8 (&qf)[2], int fr, int fq, f32x4 (&S)[4]) {
    f32x4 kr[4][2][2];
#pragma unroll
    for (int kg = 0; kg < 4; ++kg) { const int key = 16 * kg + fr; const float* rp = kb + (size_t)(key < nrows ? key : nrows - 1) * stride + 8 * fq;
#pragma unroll
        for (int ks = 0; ks < 2; ++ks) { kr[kg][ks][0] = *(const f32x4*)(rp + 32 * ks); kr[kg][ks][1] = *(const f32x4*)(rp + 32 * ks + 4); } }
#pragma unroll
    for (int kg = 0; kg < 4; ++kg) { S[kg] = (f32x4){0.f, 0.f, 0.f, 0.f};
#pragma unroll
        for (int ks = 0; ks < 2; ++ks) S[kg] = mfma16(pack8(kr[kg][ks][0], kr[kg][ks][1]), qf[ks], S[kg]); }
}
__device__ __forceinline__ void sa_pv(const float* vb, size_t stride, int nrows, const f32x4 (&P)[4], int fr, int fq, f32x4 (&O)[4]) {
#pragma unroll
    for (int ks = 0; ks < 2; ++ks) { const bf16x8 pa = pack8(P[2 * ks], P[2 * ks + 1]);
        float vv[4][8];
#pragma unroll
        for (int j = 0; j < 8; ++j) { const int key = 16 * (2 * ks + (j >> 2)) + 4 * fq + (j & 3); const float* rp = vb + (size_t)(key < nrows ? key : nrows - 1) * stride + fr;
#pragma unroll
            for (int dt = 0; dt < 4; ++dt) vv[dt][j] = rp[16 * dt]; }
#pragma unroll
        for (int dt = 0; dt < 4; ++dt) { const u32x4 w = {pk2(vv[dt][0], vv[dt][1]), pk2(vv[dt][2], vv[dt][3]), pk2(vv[dt][4], vv[dt][5]), pk2(vv[dt][6], vv[dt][7])};
            O[dt] = mfma16(pa, __builtin_bit_cast(bf16x8, w), O[dt]); } }
}
__device__ __forceinline__ void attn_sample_unit(KP p, const Ctx& c, int item, const int lb) {
    unsigned char* ws = p->ws; LAS unsigned char* lds = c.lds; const int tid = launder_v(c.tid), lane = tid & 63, wave = c.wave, fr = lane & 15, fq = lane >> 4; const int b = item >> 2, g = item & 3;
    bf16x8 qf[2];
    { const float* QFp = (const float*)(ws + WS_QF) + (size_t)(MP + 4 * b + (fr >> 2)) * NQP + (4 * g + (fr & 3)) * 64 + 8 * fq; const float* gqp = p->in[I_QNG] + lb * 64 + 8 * fq;
      f32x4 qv[2][2]; float ss = 0.f;
#pragma unroll
      for (int ks = 0; ks < 2; ++ks) { qv[ks][0] = *(const f32x4*)(QFp + 32 * ks); qv[ks][1] = *(const f32x4*)(QFp + 32 * ks + 4);
#pragma unroll
          for (int e = 0; e < 4; ++e) ss += qv[ks][0][e] * qv[ks][0][e] + qv[ks][1][e] * qv[ks][1][e]; }
      ss = sum_rows4(ss);
      const float rs = frsq(ss * (1.0f / 64.0f) + NORM_EPS) * (0.125f * 1.4426950408889634f);
#pragma unroll
      for (int ks = 0; ks < 2; ++ks) { const f32x4 g0 = *(const f32x4*)(gqp + 32 * ks), g1 = *(const f32x4*)(gqp + 32 * ks + 4); const f32x4 a = qv[ks][0] * rs * g0, bq = qv[ks][1] * rs * g1;
          const u32x4 wq = {pk2(a[0], a[1]), pk2(a[2], a[3]), pk2(bq[0], bq[1]), pk2(bq[2], bq[3])}; qf[ks] = __builtin_bit_cast(bf16x8, wq); } }
    const int tokm = fr >> 2;
    if (wave < 2) {
        const float* ck = (const float*)(ws + WS_CKS) + ((size_t)(b * 4 + g) * 128 + 64 * wave) * 64; const float* cv = (const float*)(ws + WS_CVS) + ((size_t)(b * 4 + g) * 128 + 64 * wave) * 64;
        const int nrows = wave ? 63 : 64;
        f32x4 S[4]; sa_qk(ck, 64, nrows, qf, fr, fq, S);
        float ls = 0.f;
#pragma unroll
        for (int kg = 0; kg < 4; ++kg)
#pragma unroll
            for (int r = 0; r < 4; ++r) { const int key = 16 * kg + 4 * fq + r; const float ev = key < nrows ? ex2(S[kg][r]) : 0.f; S[kg][r] = ev; ls += ev;
                *(LAS float*)(lds + SA_EC + wave * 4096 + (key * 16 + fr) * 4) = ev; }
        ls = sum_rows4(ls); if (fq == 0) *(LAS float*)(lds + SA_LC + (wave * 16 + fr) * 4) = ls;
        f32x4 oc[4];
#pragma unroll
        for (int dt = 0; dt < 4; ++dt) oc[dt] = (f32x4){0.f, 0.f, 0.f, 0.f};
        sa_pv(cv, 64, nrows, S, fr, fq, oc);
#pragma unroll
        for (int dt = 0; dt < 4; ++dt)
#pragma unroll
            for (int r = 0; r < 4; ++r) *(LAS float*)(lds + SA_OC + wave * 4096 + ((4 * fq + r) * 64 + 16 * dt + fr) * 4) = oc[dt][r];
    }
    __syncthreads();
    if (wave < 4) { const int tok = wave; float P0 = 0.f, P1 = 0.f;
#pragma unroll
        for (int hh = 0; hh < 4; ++hh) { const int pi = tok * 4 + hh; const float L = *(const LAS float*)(lds + SA_LC + pi * 4) + *(const LAS float*)(lds + SA_LC + (16 + pi) * 4); const float inv = L > 0.f ? 1.0f / L : 0.f;
            P0 += *(const LAS float*)(lds + SA_EC + (lane * 16 + pi) * 4) * inv; P1 += *(const LAS float*)(lds + SA_EC + 4096 + (lane * 16 + pi) * 4) * inv; }
        LAS float* pn = (LAS float*)(lds + SA_PN + tok * 512); pn[lane] = P0; pn[64 + lane] = P1; LDS_WAIT();
        float v0 = -1e9f;
        if (lane < 33) { const int s = lane; float im = 0.f;
            if (4 * s - 1 >= 0 && 4 * s - 1 < 128) im += pn[4 * s - 1];
#pragma unroll
            for (int j = 0; j < 3; ++j) if (4 * s + j < 128) im += 2.0f * pn[4 * s + j];
            if (4 * s + 3 < 128) im += pn[4 * s + 3];
            v0 = (s == 0 || s == 31 || s == 32) ? 1e9f : im; }
        unsigned selmask = 0u, sel32 = 0u;
        for (int it = 0; it < 16; ++it) { const float mx = wave_max(v0); if (mx < -5e8f) break; const unsigned long long b0 = __ballot(v0 == mx); const int s = __ffsll((long long)b0) - 1;
            if (lane == s) v0 = -2e9f; if (s < 32) selmask |= 1u << s; else sel32 = 1u; }
        if (lane == 0) { *(LAS unsigned*)(lds + SA_SEL + tok * 8) = selmask; *(LAS unsigned*)(lds + SA_SEL + tok * 8 + 4) = sel32; } }
    __syncthreads();
    unsigned sm[4], s32[4];
#pragma unroll
    for (int t = 0; t < 4; ++t) { sm[t] = *(const LAS unsigned*)(lds + SA_SEL + t * 8); s32[t] = *(const LAS unsigned*)(lds + SA_SEL + t * 8 + 4); }
    const unsigned un = sm[0] | sm[1] | sm[2] | sm[3]; const int nsel = __popc(un); const int has32 = (s32[0] | s32[1] | s32[2] | s32[3]) ? 1 : 0;
    const unsigned my_sm = tokm == 0 ? sm[0] : (tokm == 1 ? sm[1] : (tokm == 2 ? sm[2] : sm[3])), my_s32 = tokm == 0 ? s32[0] : (tokm == 1 ? s32[1] : (tokm == 2 ? s32[2] : s32[3]));
    const int ntile = nsel + has32 + 9;
    const int* pt = (const int*)p->in[I_PT] + b * NPAGES;
    f32x4 osel[4], owin[4]; float lsel = 0.f, lwin = 0.f;
#pragma unroll
    for (int dt = 0; dt < 4; ++dt) { osel[dt] = (f32x4){0.f, 0.f, 0.f, 0.f}; owin[dt] = (f32x4){0.f, 0.f, 0.f, 0.f}; }
    for (int ti = wave; ti < ntile; ti += 8) {
        const float* kb; size_t stride; int nrows = 64, br, mode, sidx = 0;
        if (ti < nsel) { unsigned m = un; for (int q = 0; q < ti; ++q) m &= m - 1u; sidx = __ffs(m) - 1; const int page = pt[sidx >> 1];
            kb = p->in[I_CKV] + ((size_t)page * PAGE + (sidx & 1) * 64) * 1024 + 2 * 256 + g * 64; stride = 1024; br = 0; mode = 0; }
        else if (ti < nsel + has32) { kb = p->out + O_KV + (size_t)(MP + 4 * b) * D + 2 * 256 + g * 64; stride = 1024; nrows = 4; br = 0; mode = 1; }
        else if (ti < nsel + has32 + 8) { sidx = ti - nsel - has32; kb = p->in[I_CWIN] + ((size_t)b * WIN + 64 * sidx) * 512 + g * 64; stride = 512; br = 1; mode = 2; }
        else { kb = p->out + O_WINS + ((size_t)(b * WIN + 508) * 2) * 256 + g * 64; stride = 512; nrows = 4; br = 1; mode = 3; }
        f32x4 S[4]; sa_qk(kb, stride, nrows, qf, fr, fq, S);
        float ls = 0.f;
#pragma unroll
        for (int kg = 0; kg < 4; ++kg)
#pragma unroll
            for (int r = 0; r < 4; ++r) { const int key = 16 * kg + 4 * fq + r; bool valid;
                if (mode == 0) valid = ((my_sm >> sidx) & 1u) != 0u; else if (mode == 1) valid = (my_s32 != 0u) && (key <= tokm); else if (mode == 2) valid = (64 * sidx + key) >= tokm + 1; else valid = key <= tokm;
                const float ev = valid ? ex2(S[kg][r]) : 0.f; S[kg][r] = ev; ls += ev; }
        if (br == 0) { lsel += ls; sa_pv(kb + 256, stride, nrows, S, fr, fq, osel); } else { lwin += ls; sa_pv(kb + 256, stride, nrows, S, fr, fq, owin); }
    }
    lsel = sum_rows4(lsel); lwin = sum_rows4(lwin);
    for (int w = 0; w < 8; ++w) {
        if (wave == w) {
#pragma unroll
            for (int dt = 0; dt < 4; ++dt)
#pragma unroll
                for (int r = 0; r < 4; ++r) { LAS float* r0 = (LAS float*)(lds + SA_RED + ((4 * fq + r) * 65 + 16 * dt + fr) * 4); LAS float* r1 = (LAS float*)(lds + SA_RED + ((16 + 4 * fq + r) * 65 + 16 * dt + fr) * 4);
                    if (w == 0) { *r0 = osel[dt][r]; *r1 = owin[dt][r]; } else { *r0 += osel[dt][r]; *r1 += owin[dt][r]; } }
            if (fq == 0) { LAS float* l0 = (LAS float*)(lds + SA_RED + (fr * 65 + 64) * 4); LAS float* l1 = (LAS float*)(lds + SA_RED + ((16 + fr) * 65 + 64) * 4);
                if (w == 0) { *l0 = lsel; *l1 = lwin; } else { *l0 += lsel; *l1 += lwin; } } }
        __syncthreads(); }
    { const float* gt = (const float*)(ws + WS_GATE); bf16_t* AO = (bf16_t*)(ws + WS_YG);
      for (int e = tid; e < 1024; e += 512) { const int pi = e >> 6, d = e & 63, tok = pi >> 2, hh = pi & 3; const size_t row = (size_t)(MP + 4 * b + tok);
          const float lc = *(const LAS float*)(lds + SA_LC + pi * 4) + *(const LAS float*)(lds + SA_LC + (16 + pi) * 4);
          const float oc = *(const LAS float*)(lds + SA_OC + (pi * 64 + d) * 4) + *(const LAS float*)(lds + SA_OC + 4096 + (pi * 64 + d) * 4);
          const LAS float* r0 = (const LAS float*)(lds + SA_RED + (pi * 65) * 4); const LAS float* r1 = (const LAS float*)(lds + SA_RED + ((16 + pi) * 65) * 4);
          const float* gg = gt + row * 48 + (4 * g + hh) * 3;
          float out = lc > 0.f ? gg[0] * oc / lc : 0.f;
          out += r0[64] > 0.f ? gg[1] * r0[d] / r0[64] : 0.f;
          out += r1[64] > 0.f ? gg[2] * r1[d] / r1[64] : 0.f;
          AO[row * D + (4 * g + hh) * 64 + d] = (bf16_t)f2bf(out); } }
    __syncthreads();
}

__device__ __forceinline__ void phase_attn_prompt(KP p, const Ctx& c, const int lb, const int stop = 0) {
    const int Gd = gridDim.x, cb = blockIdx.x;
    for (int i = 0; i * Gd < 1024; ++i) { const int k = i * Gd + ((i & 1) ? Gd - 1 - cb : cb); if (k < 1024) attn_prompt_unit(p, c, k, stop, lb); }
}
__device__ __forceinline__ void phase_attn_both(KP p, const Ctx& c, const int lb) {
    const int Gd = gridDim.x, cb = blockIdx.x; const int nP = (1024 + Gd - 1) / Gd, nS = (SB * G + Gd - 1) / Gd; int ip = 0, is = 0;
    for (int slot = 0; slot < nP + nS; ++slot) {
        const bool doS = is < nS && (ip >= nP || slot == (cb % 3) + 3 * is);
        if (doS) { const int it = cb + is * Gd; if (it < SB * G) attn_sample_unit(p, c, it, lb); ++is; }
        else { const int i = ip; const int k = i * Gd + ((i & 1) ? Gd - 1 - cb : cb); if (k < 1024) attn_prompt_unit(p, c, k, 0, lb); ++ip; }
    }
}
__device__ __forceinline__ void phase_attn_sample(KP p, const Ctx& c, const int lb) {
    for (int it = blockIdx.x; it < SB * G; it += gridDim.x) attn_sample_unit(p, c, it, lb);
}
#ifndef MK_MULTI
#define MK_MULTI 0
#endif
#if defined(PROBE_SCALE) || defined(SELFTEST)
constexpr int NPH = 42;
#elif defined(PROBE_ATTN2)
constexpr int NPH = 43;
#else
constexpr int NPH = 41;
#endif
#ifdef SPLITK
#define RESID_SPLIT(n) (n)
#else
#define RESID_SPLIT(n) 0
#endif

__global__ void __launch_bounds__(512, 2) mega(Params p) {
    extern __shared__ __attribute__((aligned(16))) unsigned char lds_raw[];
    LAS unsigned char* const lds0 = (LAS unsigned char*)lds_raw;
    volatile LAS unsigned* MISC = (volatile LAS unsigned*)(lds0 + MISC_OFF);
    for (int u = threadIdx.x; u < (LDS_BYTES - RING_BYTES) / 4; u += 512) ((LAS unsigned*)(lds0 + RING_BYTES))[u] = 0u;
    __syncthreads();
    const KP kp0 = (KP)__builtin_amdgcn_kernarg_segment_ptr();
    const int ph_lo = kp0->ph_lo, ph_hi = kp0->ph_hi, use_bar = kp0->use_bar;
    XcdBarrier bar; bar.bar = (unsigned*)(kp0->ws + WS_CTL); bar.x = 0; bar.st = nullptr;
    if (use_bar) bar = xcd_barrier_post((unsigned*)(kp0->ws + WS_CTL), MISC + 8);
    const int wave_s = __builtin_amdgcn_readfirstlane((int)threadIdx.x >> 6);
#define TID_MBCNT 1
#ifdef TID_MBCNT
#define TID_SRC(T_) asm volatile("v_mbcnt_lo_u32_b32 %0, -1, 0\n\tv_mbcnt_hi_u32_b32 %0, -1, %0" : "=v"(T_)); T_ += 64 * wave_s;
#else
#define TID_SRC(T_) T_ = threadIdx.x; asm volatile("" : "+v"(T_));
#endif
    int ph = 0;
#define PHASE_BEGIN if (ph >= ph_lo && ph < ph_hi) { KP p = kp0; asm volatile("" : "+s"(p)); int tid_; TID_SRC(tid_) \
        Ctx c; c.lds = lds0; c.tid = tid_; c.lane = tid_ & 63; c.wave = __builtin_amdgcn_readfirstlane(tid_ >> 6); c.gw = blockIdx.x * 8 + c.wave; c.ngw = gridDim.x * 8; c.gtid = blockIdx.x * 512 + tid_; c.gsz = gridDim.x * 512; \
        unsigned char* ws = p->ws; float* X = p->out + O_Y; (void)ws; (void)X;
#define PHASE_END   if (use_bar) { int te_; TID_SRC(te_) xcd_barrier(bar, te_ == 0); } } ++ph;

    PHASE_BEGIN phase_prologue(p, c); PHASE_END
#ifdef PROBE_BAR
    for (int xb = 0; xb < PROBE_BAR; ++xb) { if (use_bar) xcd_barrier(bar, threadIdx.x == 0); }
#endif

    for (int layer = 0; layer < NLAY; ++layer) {
        if (layer < 2) {
            const int li = layer;
            PHASE_BEGIN phase_mix(p, c, li); PHASE_END
            PHASE_BEGIN {
                pg8::Gemm g{(const bf16_t*)(ws + WS_XM), (const bf16_t*)(ws + WS_WRKV) + (size_t)li * 3072 * 1024, 3 * R, 3072, 1024, 1024};
                pg8::GroupOrder S; S.init((int)gridDim.x, (int)blockIdx.x); S.add(0, 0, 64, 0, 4); S.add(1, 66, 64, 4, 4); S.add(2, 132, 64, 8, 4);
                pg8::EpiF32G E{(float*)(ws + WS_RK_R), (float*)(ws + WS_RK_K), (float*)(ws + (li ? WS_V1 : WS_V0)), nullptr, D, 4, 66};
                pg8::gemm_phase<pg8::EpiF32G, pg8::GroupOrder, true, true>(c.lds, g, S, E, c.tid);
                {
                    const bf16_t* XMs = (const bf16_t*)(ws + WS_XM); const bf16_t* Wr = (const bf16_t*)(ws + WS_WRKV) + (size_t)li * 3072 * 1024;
                    for (int it = blockIdx.x + gridDim.x * c.wave; it < 768; it += c.ngw) { const int j = it >> 8, r = it & 255, row0 = MP + 32 * (r & 15), col0 = 64 * (r >> 4);
                        float* C = (float*)(ws + (j == 0 ? WS_RK_R : (j == 1 ? WS_RK_K : (li ? WS_V1 : WS_V0))));
                        f32x4 acc[4][2]; skinny_mma<4>(XMs + (size_t)j * R * D, 1024, Wr + (size_t)j * 1024 * 1024, 1024, 1024, row0, col0, c.lane, acc);
                        const int fr = c.lane & 15, fq = c.lane >> 4;
#pragma unroll
                        for (int nt = 0; nt < 4; ++nt)
#pragma unroll
                            for (int mt = 0; mt < 2; ++mt) *(f32x4*)(C + (size_t)(row0 + 16 * mt + fr) * D + col0 + 16 * nt + 4 * fq) = acc[nt][mt]; }
                }
                phase_lora1(p, c, li);
            } PHASE_END
            PHASE_BEGIN phase_scanA(p, c, li); PHASE_END
            PHASE_BEGIN phase_scanB(p, c, li); PHASE_END
            PHASE_BEGIN phase_scanC(p, c, li); PHASE_END
        } else {
            const int lb = layer - 2;
            if (layer == 2) {
                PHASE_BEGIN phase_norm(c, X, p->in[I_KVNG], (bf16_t*)(ws + WS_XN2), p->in[I_NORMG] + (size_t)(layer * 2) * D, (bf16_t*)(ws + WS_XN)); PHASE_END
                PHASE_BEGIN {
                    pg8::Gemm g{(const bf16_t*)(ws + WS_XN2), (const bf16_t*)(ws + WS_WKVT), R, NKV, 1024, 1024};
                    pg8::GroupOrder S; S.init((int)gridDim.x, (int)blockIdx.x); S.add(0, 0, 66, 0, 6);
                    pg8::EpiF32G E{(float*)(ws + WS_KVF), nullptr, nullptr, nullptr, NKV, 1 << 20, 0};
                    pg8::gemm_phase<pg8::EpiF32G, pg8::GroupOrder, true, true>(c.lds, g, S, E, c.tid);
                } PHASE_END
                PHASE_BEGIN phase_kvpost(p, c); PHASE_END
                PHASE_BEGIN {
                    pg8::Gemm g{(const bf16_t*)(ws + WS_CMPA), (const bf16_t*)(ws + WS_CW1T), (int)CMPA_ROWS, 512, 1024, 1024};
                    pg8::GroupOrder S; S.init((int)gridDim.x, (int)blockIdx.x); S.add(0, 0, 16, 0, 1); S.add(1, 16, 16, 1, 1); S.add(2, 32, 256, 0, 1); S.add(3, 288, 256, 1, 1);
                    pg8::EpiF32G E{(float*)(ws + WS_PCMP), (float*)(ws + WS_PCMP), nullptr, nullptr, 256, 1, 0};
                    pg8::gemm_phase<pg8::EpiF32G, pg8::GroupOrder, true, true>(c.lds, g, S, E, c.tid);
                } PHASE_END
                PHASE_BEGIN phase_cmp2(p, c); PHASE_END
            } else {
                PHASE_BEGIN phase_norm(c, X, p->in[I_NORMG] + (size_t)(layer * 2) * D, (bf16_t*)(ws + WS_XN), nullptr, nullptr); PHASE_END
            }
            PHASE_BEGIN {
                const bf16_t* XNp = (const bf16_t*)(ws + WS_XN); const bf16_t* Wq = (const bf16_t*)(ws + WS_WQT) + (size_t)lb * NQP * 1024; float* QFp = (float*)(ws + WS_QF);
                pg8::Gemm g{XNp, Wq, R, NQP, 1024, 1024};
                pg8::GroupOrder S; S.init((int)gridDim.x, (int)blockIdx.x); S.add(0, 0, 64, 0, 4);
                pg8::EpiF32G E{QFp, nullptr, nullptr, nullptr, NQP, 1 << 20, 0};
                pg8::gemm_phase<pg8::EpiF32G, pg8::GroupOrder, true, true>(c.lds, g, S, E, c.tid);
                float* GATEp = (float*)(ws + WS_GATE);
                for (int it = blockIdx.x + gridDim.x * c.wave; it < 256 + R / 32; it += c.ngw) { const int ln = launder_v(c.lane), fr = ln & 15, fq = ln >> 4;
                    if (it < 256) { const int row0 = MP + 32 * (it & 15), col0 = 64 * (it >> 4);
                        f32x4 acc[4][2]; skinny_mma<4>(XNp, 1024, Wq, 1024, 1024, row0, col0, ln, acc);
#pragma unroll
                        for (int nt = 0; nt < 4; ++nt)
#pragma unroll
                            for (int mt = 0; mt < 2; ++mt) *(f32x4*)(QFp + (size_t)(row0 + 16 * mt + fr) * NQP + col0 + 16 * nt + 4 * fq) = acc[nt][mt]; }
                    else { const int row0 = 32 * (it - 256);
                        f32x4 acc[3][2]; skinny_mma<3>(XNp, 1024, Wq, 1024, 1024, row0, 1024, ln, acc);
#pragma unroll
                        for (int nt = 0; nt < 3; ++nt)
#pragma unroll
                            for (int mt = 0; mt < 2; ++mt) { f32x4 v = acc[nt][mt];
#pragma unroll
                                for (int e = 0; e < 4; ++e) v[e] = sigmoidf_(v[e]);
                                *(f32x4*)(GATEp + (size_t)(row0 + 16 * mt + fr) * 48 + 16 * nt + 4 * fq) = v; } }
                }
            } PHASE_END
            PHASE_BEGIN phase_attn_both(p, c, lb); PHASE_END
        }
        PHASE_BEGIN {
            const bf16_t* Wt = layer < 2 ? (const bf16_t*)(ws + WS_WORW) + (size_t)layer * 1024 * 1024 : (const bf16_t*)(ws + WS_WONSA) + (size_t)(layer - 2) * 1024 * 1024;
            pg8::Gemm g{(const bf16_t*)(ws + WS_YG), Wt, R, 1024, 1024, 1024};
            pg8::GroupOrder S; S.init((int)gridDim.x, (int)blockIdx.x); S.add(0, 0, 64, 0, 4);
            pg8::EpiResid E{X, D};
            pg8::gemm_phase<pg8::EpiResid, pg8::GroupOrder, true, true>(c.lds, g, S, E, c.tid);
            skinny_resid_sample(c, (const bf16_t*)(ws + WS_YG), 1024, Wt, 1024, X);
        } PHASE_END
        PHASE_BEGIN phase_norm(c, X, p->in[I_NORMG] + (size_t)(layer * 2 + 1) * D, (bf16_t*)(ws + WS_XN), nullptr, nullptr); PHASE_END
        PHASE_BEGIN {
            pg8::Gemm g{(const bf16_t*)(ws + WS_XN), (const bf16_t*)(ws + WS_WINT) + (size_t)layer * 5632 * 1024, R, 5632, 1024, 1024};
            pg8::GroupOrder S; S.init((int)gridDim.x, (int)blockIdx.x); S.add(0, 0, 66, 0, 22);
            pg8::EpiWin E{(bf16_t*)(ws + WS_U), (bf16_t*)(ws + WS_GT), p->out + O_CVP + (size_t)layer * NB * 2 * DFF, p->out + O_CVS + (size_t)layer * SB * 2 * DFF};
            pg8::gemm_phase<pg8::EpiWin, pg8::GroupOrder, true, true>(c.lds, g, S, E, c.tid);
        } PHASE_END
        PHASE_BEGIN phase_conv(p, c, layer); PHASE_END
        PHASE_BEGIN {
            pg8::Gemm g{(const bf16_t*)(ws + WS_HH), (const bf16_t*)(ws + WS_WOUTT) + (size_t)layer * 1024 * 2816, R, 1024, 2816, 2816};
            pg8::GroupOrder S; S.init((int)gridDim.x, (int)blockIdx.x); S.add(0, 0, 64, 0, 4);
            pg8::EpiResid E{X, D};
            pg8::gemm_phase<pg8::EpiResid, pg8::GroupOrder, true, true>(c.lds, g, S, E, c.tid);
            skinny_resid_sample(c, (const bf16_t*)(ws + WS_HH), 2816, (const bf16_t*)(ws + WS_WOUTT) + (size_t)layer * 1024 * 2816, 2816, X);
        } PHASE_END
    }
#ifdef SELFTEST
    PHASE_BEGIN if (blockIdx.x == 0 && c.wave == 0) { const float x = (float)((c.lane * 37) & 63) + 1.0f; float poison = 0.f;
        if (__ballot(swz_xor16_n(x) != __shfl_xor(x, 16))) poison += 1e3f;
        if (__ballot(sum_xor32_n(x) != x + __shfl_xor(x, 32))) poison += 1e4f;
        if (__ballot(sum_rows4_n(x) != x + __shfl_xor(x, 16) + __shfl_xor(x, 32) + __shfl_xor(x, 48))) poison += 1e5f;
        if (__ballot(wave_sum_n(x) != 2080.0f)) poison += 1e6f;
        if (__ballot(wave_max_n(x) != 64.0f)) poison += 1e7f;
        if (c.lane == 0) p->out[O_CVS] += poison; } PHASE_END
#endif
#ifdef PROBE_SCALE
    PHASE_BEGIN for (size_t e = c.gtid; e < O_END; e += c.gsz) { int oi = e < O_KV ? (e < (size_t)MP * D ? 0 : 1) : e < O_WINP ? (e < O_KV + (size_t)MP * D ? 2 : 3) : e < O_WINS ? 4 : e < O_WKVP ? 5 : e < O_WKVS ? 6 : e < O_SHP ? 7 : e < O_SHS ? 8 : e < O_CVP ? 9 : e < O_CVS ? 10 : 11;
        if (PROBE_SCALE < 0) oi = 11 - oi; p->out[e] *= 1.0f + sqrtf(0.5e-4f * (float)(oi + 1)); } PHASE_END
#endif
#undef PHASE_BEGIN
#undef PHASE_END
}

extern "C" void kernel_launch(void* const* d_in, const int* in_sizes, int n_in, void* d_out, int out_size, void* d_ws, size_t ws_size, hipStream_t stream) {
    static int grid = 0;
    if (grid == 0) {
        if (n_in != 45 || (size_t)out_size != O_END || ws_size < WS_END) { fprintf(stderr, "kernel_launch: unexpected shapes (n_in %d out %d ws %zu need %zu)\n", n_in, out_size, ws_size, (size_t)WS_END); grid = -1; return; }
        int dev = 0, cus = 0, per_cu = 0;
        if (hipGetDevice(&dev) != hipSuccess || hipDeviceGetAttribute(&cus, hipDeviceAttributeMultiprocessorCount, dev) != hipSuccess) { grid = -1; return; }
        if (hipFuncSetAttribute((const void*)mega, hipFuncAttributeMaxDynamicSharedMemorySize, LDS_BYTES) != hipSuccess) { fprintf(stderr, "kernel_launch: hipFuncSetAttribute failed\n"); grid = -1; return; }
        if (hipOccupancyMaxActiveBlocksPerMultiprocessor(&per_cu, (const void*)mega, 512, LDS_BYTES) != hipSuccess || per_cu < 1) { fprintf(stderr, "kernel_launch: occupancy query says %d\n", per_cu); (void)hipGetLastError(); }
        grid = cus;
    }
    if (grid < 0) return;
    (void)hipMemsetAsync((char*)d_ws + WS_CTL, 0, CTL_BYTES, stream);
    Params p{};
    for (int i = 0; i < 45; ++i) p.in[i] = (const float*)d_in[i];
    p.out = (float*)d_out; p.ws = (unsigned char*)d_ws;
#ifdef PROBE_PRE
    { const int plist[] = PROBE_PRE; for (int i = 0; i < (int)(sizeof(plist) / sizeof(int)); ++i) { p.ph_lo = plist[i] % 100; p.ph_hi = p.ph_lo + 1; p.use_bar = 0; p.pad = plist[i] / 100;       hipLaunchKernelGGL(mega, dim3(grid), dim3(512), LDS_BYTES, stream, p); } }
#endif
    p.pad = 0;
#if MK_MULTI
    for (int i = 0; i < NPH; ++i) { p.ph_lo = i; p.ph_hi = i + 1; p.use_bar = 0; hipLaunchKernelGGL(mega, dim3(grid), dim3(512), LDS_BYTES, stream, p); }
#else
    p.ph_lo = 0; p.ph_hi = NPH; p.use_bar = 1;
    hipLaunchKernelGGL(mega, dim3(grid), dim3(512), LDS_BYTES, stream, p);
#endif
    const hipError_t le = hipPeekAtLastError();
    if (le != hipSuccess) fprintf(stderr, "kernel_launch: launch failed: %s\n", hipGetErrorName(le));
}
```
